# Optimizing an MI355X kernel written in HIP

```python
import math
import jax, jax.numpy as jnp
from jax import lax
import numpy as np

D_MODEL = 1024
BATCH = 2
SEQ = 16384
DEPTH = 4

MIX_WIDTH = D_MODEL
HALF_W = MIX_WIDTH // 2
HEAD_DIM = 64
A_HEADS = HALF_W // (2 * HEAD_DIM)
A_QK_W = A_HEADS * 2 * HEAD_DIM
A_V_W = A_HEADS * 2 * HEAD_DIM
B_HEADS = HALF_W // HEAD_DIM
B_W = B_HEADS * HEAD_DIM
IDX_HEADS = 8
IDX_DIM = 32
DSA_TOPK = 256
C_HEADS = HALF_W // HEAD_DIM
C_W = C_HEADS * HEAD_DIM
MOBA_BLOCK = 256
MOBA_TOPK = 3
S5_GROUP_CH = 16
S5_GROUPS = HALF_W // S5_GROUP_CH
S5_STATE = 64
S5_W = S5_GROUPS * S5_GROUP_CH
ROPE_THETA = 500000.0
ROT_HEAD = HEAD_DIM // 4
ROT_IDX = IDX_DIM // 4
Q_BLOCK = 128
MOBA_QBLOCK = 64
N_GROUPS = 4
EXPERTS_PER_GROUP = 8
N_EXPERTS = N_GROUPS * EXPERTS_PER_GROUP
TOPK_FINE = 2
EXPERT_FF = 512
MOE_BLOCK = 128
NORM_EPS = 1e-6
N_EVEN = (DEPTH + 1) // 2
N_ODD = DEPTH // 2
EVEN_SPLIT = (A_QK_W, A_QK_W, A_V_W, B_W, B_W, B_W, IDX_HEADS * IDX_DIM, IDX_DIM, IDX_HEADS)
EVEN_IN = sum(EVEN_SPLIT)
ODD_SPLIT = (C_W, C_W, C_W, S5_W)
ODD_IN = sum(ODD_SPLIT)

kernel_name = "hybrid_diff_dsa_moba_s5_hmoe"

F32 = jnp.float32


def rms_norm(x, gain=None):
    xf = x.astype(F32)
    y = xf * lax.rsqrt(jnp.mean(xf * xf, axis=-1, keepdims=True) + NORM_EPS)
    if gain is not None:
        y = y * gain.astype(F32)
    return y.astype(x.dtype)


def rope_tables(n_pos, rot_dim):
    pos = jnp.arange(n_pos, dtype=F32)
    inv = ROPE_THETA ** (-(jnp.arange(0, rot_dim, 2, dtype=F32) / rot_dim))
    ang = pos[:, None] * inv[None, :]
    return jnp.cos(ang), jnp.sin(ang)


def apply_rope(x, cos, sin):
    half = cos.shape[-1]
    bshape = (1, cos.shape[0]) + (1,) * (x.ndim - 3) + (half,)
    cs = cos.reshape(bshape).astype(x.dtype)
    sn = sin.reshape(bshape).astype(x.dtype)
    x1 = x[..., :half]
    x2 = x[..., half:2 * half]
    return jnp.concatenate([x1 * cs - x2 * sn, x2 * cs + x1 * sn, x[..., 2 * half:]], axis=-1)


def _split(z, sizes):
    out, start = [], 0
    for s in sizes:
        out.append(z[..., start:start + s])
        start += s
    return out


def diff_attention(q, k, v, lam, lam_init, subln_g):
    bsz, seq, n_h, _, d = q.shape
    nqb = seq // Q_BLOCK
    scale = d ** -0.5
    q_blocks = q.reshape(bsz, nqb, Q_BLOCK, n_h, 2, d).swapaxes(0, 1)
    k_pos = jnp.arange(seq)

    def one_block(args):
        q_blk, blk = args
        q_pos = blk * Q_BLOCK + jnp.arange(Q_BLOCK)
        s = jnp.einsum('bqhcd,bkhcd->bhcqk', q_blk, k, preferred_element_type=F32) * scale
        s = jnp.where(k_pos[None, :] <= q_pos[:, None], s, -jnp.inf)
        p = jax.nn.softmax(s, axis=-1)
        attn = p[:, :, 0] - lam * p[:, :, 1]
        return jnp.einsum('bhqk,bkhe->bqhe', attn.astype(v.dtype), v)

    o = lax.map(one_block, (q_blocks, jnp.arange(nqb)))
    o = o.swapaxes(0, 1).reshape(bsz, seq, n_h, v.shape[-1])
    o = rms_norm(o, subln_g) * (1.0 - lam_init)
    return o.reshape(bsz, seq, n_h * v.shape[-1])


def dsa_attention(q, k, v, q_idx, k_idx, w_idx):
    bsz, seq, n_h, d = q.shape
    n_sel = min(DSA_TOPK, seq // 4)
    nqb = seq // Q_BLOCK
    scale = d ** -0.5
    k_pos = jnp.arange(seq)
    b_idx = jnp.arange(bsz)[:, None, None]

    def to_blocks(t):
        return t.reshape((bsz, nqb, Q_BLOCK) + t.shape[2:]).swapaxes(0, 1)

    def one_block(args):
        q_blk, qi_blk, wi_blk, blk = args
        q_pos = blk * Q_BLOCK + jnp.arange(Q_BLOCK)
        logits = jnp.einsum('bqhd,bsd->bqhs', qi_blk, k_idx, preferred_element_type=F32)
        score = jnp.einsum('bqh,bqhs->bqs', wi_blk.astype(F32), jax.nn.relu(logits))
        score = jnp.where((k_pos[None, :] <= q_pos[:, None])[None], score, -jnp.inf)
        _, sel = lax.top_k(score, n_sel)
        valid = sel <= q_pos[None, :, None]
        k_sel = k[b_idx, sel]
        v_sel = v[b_idx, sel]
        s = jnp.einsum('bqhd,bqnhd->bqhn', q_blk, k_sel, preferred_element_type=F32) * scale
        s = jnp.where(valid[:, :, None, :], s, -jnp.inf)
        p = jax.nn.softmax(s, axis=-1)
        return jnp.einsum('bqhn,bqnhd->bqhd', p.astype(v.dtype), v_sel)

    o = lax.map(one_block, (to_blocks(q), to_blocks(q_idx), to_blocks(w_idx), jnp.arange(nqb)))
    return o.swapaxes(0, 1).reshape(bsz, seq, n_h * d)


def moba_attention(q, k, v):
    bsz, seq, n_h, d = q.shape
    n_blk = -(-seq // MOBA_BLOCK)
    n_sel = max(1, min(MOBA_TOPK, n_blk - 1))
    pad = n_blk * MOBA_BLOCK - seq
    scale = d ** -0.5
    k_pad = jnp.pad(k, ((0, 0), (0, pad), (0, 0), (0, 0)))
    v_pad = jnp.pad(v, ((0, 0), (0, pad), (0, 0), (0, 0)))
    k_blocks = k_pad.reshape(bsz, n_blk, MOBA_BLOCK, n_h, d)
    k_mean = jnp.mean(k_blocks.astype(F32), axis=2)
    k_bt = k_blocks.transpose(0, 1, 3, 2, 4)
    v_bt = v_pad.reshape(bsz, n_blk, MOBA_BLOCK, n_h, d).transpose(0, 1, 3, 2, 4)
    nqb = seq // MOBA_QBLOCK
    q_blocks = q.reshape(bsz, nqb, MOBA_QBLOCK, n_h, d).swapaxes(0, 1)
    b_idx = jnp.arange(bsz)[:, None, None, None]
    h_idx = jnp.arange(n_h)[None, None, :, None]

    def one_block(args):
        q_blk, blk = args
        q_start = blk * MOBA_QBLOCK
        q_pos = q_start + jnp.arange(MOBA_QBLOCK)
        own = q_start // MOBA_BLOCK
        gate = jnp.einsum('bqhd,bnhd->bqhn', q_blk.astype(F32), k_mean)
        gate = jnp.where(jnp.arange(n_blk) < own, gate, -jnp.inf)
        _, sel = lax.top_k(gate, n_sel)
        valid = sel < own
        k_sel = k_bt[b_idx, sel, h_idx]
        v_sel = v_bt[b_idx, sel, h_idx]
        s_sel = jnp.einsum('bqhd,bqhnpd->bqhnp', q_blk, k_sel, preferred_element_type=F32) * scale
        s_sel = jnp.where(valid[..., None], s_sel, -jnp.inf)
        s_sel = s_sel.reshape(bsz, MOBA_QBLOCK, n_h, n_sel * MOBA_BLOCK)
        k_own = lax.dynamic_slice_in_dim(k_pad, own * MOBA_BLOCK, MOBA_BLOCK, axis=1)
        v_own = lax.dynamic_slice_in_dim(v_pad, own * MOBA_BLOCK, MOBA_BLOCK, axis=1)
        own_pos = own * MOBA_BLOCK + jnp.arange(MOBA_BLOCK)
        s_own = jnp.einsum('bqhd,bphd->bqhp', q_blk, k_own, preferred_element_type=F32) * scale
        s_own = jnp.where((own_pos[None, :] <= q_pos[:, None])[None, :, None, :], s_own, -jnp.inf)
        p = jax.nn.softmax(jnp.concatenate([s_sel, s_own], axis=-1), axis=-1).astype(v.dtype)
        p_sel = p[..., :n_sel * MOBA_BLOCK].reshape(bsz, MOBA_QBLOCK, n_h, n_sel, MOBA_BLOCK)
        p_own = p[..., n_sel * MOBA_BLOCK:]
        return (jnp.einsum('bqhnp,bqhnpd->bqhd', p_sel, v_sel)
                + jnp.einsum('bqhp,bphd->bqhd', p_own, v_own))

    o = lax.map(one_block, (q_blocks, jnp.arange(nqb)))
    return o.swapaxes(0, 1).reshape(bsz, seq, n_h * d)


def _ssm_combine(left, right):
    a1r, a1i, b1r, b1i = left
    a2r, a2i, b2r, b2i = right
    return (a1r * a2r - a1i * a2i,
            a1r * a2i + a1i * a2r,
            a2r * b1r - a2i * b1i + b2r,
            a2r * b1i + a2i * b1r + b2i)


def s5_scan(u, lam_re, lam_im, b_re, b_im, c_re, c_im, d_skip, log_dt):
    lam_re, lam_im = lam_re.astype(F32), lam_im.astype(F32)
    dt = jnp.exp(log_dt.astype(F32))[:, None]
    mag = jnp.exp(lam_re * dt)
    abar_re = mag * jnp.cos(lam_im * dt)
    abar_im = mag * jnp.sin(lam_im * dt)
    den = lam_re * lam_re + lam_im * lam_im
    coef_re = ((abar_re - 1.0) * lam_re + abar_im * lam_im) / den
    coef_im = (abar_im * lam_re - (abar_re - 1.0) * lam_im) / den
    b_re, b_im = b_re.astype(F32), b_im.astype(F32)
    bbar_re = coef_re[..., None] * b_re - coef_im[..., None] * b_im
    bbar_im = coef_re[..., None] * b_im + coef_im[..., None] * b_re
    uf = u.astype(F32)
    bu_re = jnp.einsum('gpc,bsgc->sbgp', bbar_re, uf)
    bu_im = jnp.einsum('gpc,bsgc->sbgp', bbar_im, uf)
    seq = u.shape[1]
    a_re = jnp.broadcast_to(abar_re[None, None], (seq, 1) + abar_re.shape)
    a_im = jnp.broadcast_to(abar_im[None, None], (seq, 1) + abar_im.shape)
    _, _, h_re, h_im = lax.associative_scan(_ssm_combine, (a_re, a_im, bu_re, bu_im), axis=0)
    y = (jnp.einsum('gcp,sbgp->bsgc', c_re.astype(F32), h_re)
         - jnp.einsum('gcp,sbgp->bsgc', c_im.astype(F32), h_im)
         + d_skip.astype(F32) * uf)
    return y.astype(u.dtype)


def even_mixer(h, w_in, w_out, a_qn, a_kn, a_lq1, a_lk1, a_lq2, a_lk2, a_subln,
               b_qn, b_kn, idx_kn, lam_init, rope_head, rope_idx):
    bsz, seq, _ = h.shape
    cos_h, sin_h = rope_head
    cos_i, sin_i = rope_idx
    z = h @ w_in
    aq, ak, av, bq, bk, bv, iq, ik, iw = _split(z, EVEN_SPLIT)
    aq = apply_rope(rms_norm(aq.reshape(bsz, seq, A_HEADS, 2, HEAD_DIM), a_qn), cos_h, sin_h)
    ak = apply_rope(rms_norm(ak.reshape(bsz, seq, A_HEADS, 2, HEAD_DIM), a_kn), cos_h, sin_h)
    av = av.reshape(bsz, seq, A_HEADS, 2 * HEAD_DIM)
    lam = (jnp.exp(jnp.sum(a_lq1.astype(F32) * a_lk1.astype(F32)))
           - jnp.exp(jnp.sum(a_lq2.astype(F32) * a_lk2.astype(F32))) + lam_init)
    o_a = diff_attention(aq, ak, av, lam, lam_init, a_subln)
    bq = apply_rope(rms_norm(bq.reshape(bsz, seq, B_HEADS, HEAD_DIM), b_qn), cos_h, sin_h)
    bk = apply_rope(rms_norm(bk.reshape(bsz, seq, B_HEADS, HEAD_DIM), b_kn), cos_h, sin_h)
    bv = bv.reshape(bsz, seq, B_HEADS, HEAD_DIM)
    iq = apply_rope(iq.reshape(bsz, seq, IDX_HEADS, IDX_DIM), cos_i, sin_i)
    ik = apply_rope(rms_norm(ik, idx_kn), cos_i, sin_i)
    o_b = dsa_attention(bq, bk, bv, iq, ik, iw)
    return jnp.concatenate([o_a, o_b], axis=-1) @ w_out


def odd_mixer(h, w_in, w_out, c_qn, c_kn, lam_re, lam_im, b_re, b_im, c_re, c_im,
              d_skip, log_dt, glu_w, glu_b, rope_head):
    bsz, seq, _ = h.shape
    cos_h, sin_h = rope_head
    z = h @ w_in
    cq, ck, cv, u = _split(z, ODD_SPLIT)
    cq = apply_rope(rms_norm(cq.reshape(bsz, seq, C_HEADS, HEAD_DIM), c_qn), cos_h, sin_h)
    ck = apply_rope(rms_norm(ck.reshape(bsz, seq, C_HEADS, HEAD_DIM), c_kn), cos_h, sin_h)
    cv = cv.reshape(bsz, seq, C_HEADS, HEAD_DIM)
    o_c = moba_attention(cq, ck, cv)
    y = s5_scan(u.reshape(bsz, seq, S5_GROUPS, S5_GROUP_CH), lam_re, lam_im, b_re, b_im,
                c_re, c_im, d_skip, log_dt).reshape(bsz, seq, S5_W)
    y = jax.nn.gelu(y)
    y = y * jax.nn.sigmoid(y @ glu_w + glu_b)
    return jnp.concatenate([o_c, y], axis=-1) @ w_out


def hier_moe(h, wg, bg, we, be, w1, w3, w2):
    bsz, seq, dm = h.shape
    n_tok = bsz * seq
    xf = h.reshape(n_tok, dm)
    coarse = (xf @ wg).astype(F32) + bg.astype(F32)
    grp = jnp.argmax(coarse, axis=-1)
    tok = jnp.arange(n_tok)
    p_grp = jax.nn.softmax(coarse, axis=-1)[tok, grp][:, None]
    fine = ((xf @ we).astype(F32) + be.astype(F32)).reshape(n_tok, N_GROUPS, EXPERTS_PER_GROUP)
    fine_g = fine[tok, grp]
    top_v, top_i = lax.top_k(fine_g, TOPK_FINE)
    weight = p_grp * jax.nn.softmax(top_v, axis=-1)
    expert = grp[:, None] * EXPERTS_PER_GROUP + top_i
    n_asg = n_tok * TOPK_FINE
    flat_e = expert.reshape(n_asg)
    flat_t = jnp.arange(n_asg) // TOPK_FINE
    flat_w = weight.reshape(n_asg)
    order = jnp.argsort(flat_e, stable=True)
    se = flat_e[order]
    counts = jnp.bincount(flat_e, length=N_EXPERTS)
    padded = ((counts + MOE_BLOCK - 1) // MOE_BLOCK) * MOE_BLOCK
    start = jnp.cumsum(counts) - counts
    pend = jnp.cumsum(padded)
    pstart = pend - padded
    dest = pstart[se] + (jnp.arange(n_asg) - start[se])
    n_pad = n_asg + N_EXPERTS * MOE_BLOCK
    n_blk = n_pad // MOE_BLOCK
    buf_tok = jnp.full((n_pad,), n_tok, dtype=jnp.int32).at[dest].set(flat_t[order].astype(jnp.int32))
    buf_w = jnp.zeros((n_pad,), F32).at[dest].set(flat_w[order])
    blk_e = jnp.clip(jnp.searchsorted(pend, jnp.arange(n_blk) * MOE_BLOCK, side='right'), 0, N_EXPERTS - 1)
    x_pad = jnp.concatenate([xf, jnp.zeros((1, dm), xf.dtype)], axis=0)
    xb = x_pad[buf_tok].reshape(n_blk, MOE_BLOCK, dm)

    def expert_block(args):
        xi, e = args
        hid = jax.nn.silu(xi @ w1[e]) * (xi @ w3[e])
        return hid @ w2[e]

    yb = lax.map(expert_block, (xb, blk_e)).reshape(n_pad, dm)
    yb = yb * buf_w[:, None].astype(yb.dtype)
    out = jnp.zeros((n_tok + 1, dm), yb.dtype).at[buf_tok].add(yb)[:n_tok]
    return out.reshape(bsz, seq, dm)


def setup_inputs(seed: int = 0) -> dict:
    key = jax.random.key(seed)
    ks = iter(jax.random.split(key, 64))

    def nrm(shape, scale):
        return jax.random.normal(next(ks), shape, F32) * scale

    def gain(shape):
        return 1.0 + nrm(shape, 0.1)

    d = D_MODEL
    inputs = {
        "x": nrm((BATCH, SEQ, d), 1.0),
        "c": nrm((BATCH, d), 1.0),
        "ada_w": nrm((DEPTH, d, 6 * d), 0.5 * d ** -0.5),
        "ada_b": nrm((DEPTH, 6 * d), 0.02),
        "moe_wg": nrm((DEPTH, d, N_GROUPS), d ** -0.5),
        "moe_bg": nrm((DEPTH, N_GROUPS), 0.01),
        "moe_we": nrm((DEPTH, d, N_EXPERTS), d ** -0.5),
        "moe_be": nrm((DEPTH, N_EXPERTS), 0.01),
        "moe_w1": nrm((DEPTH, N_EXPERTS, d, EXPERT_FF), d ** -0.5),
        "moe_w3": nrm((DEPTH, N_EXPERTS, d, EXPERT_FF), d ** -0.5),
        "moe_w2": nrm((DEPTH, N_EXPERTS, EXPERT_FF, d), EXPERT_FF ** -0.5),
        "ev_w_in": nrm((N_EVEN, d, EVEN_IN), d ** -0.5),
        "ev_w_out": nrm((N_EVEN, MIX_WIDTH, d), MIX_WIDTH ** -0.5),
        "a_qn": gain((N_EVEN, HEAD_DIM)),
        "a_kn": gain((N_EVEN, HEAD_DIM)),
        "a_lq1": nrm((N_EVEN, HEAD_DIM), 0.1),
        "a_lk1": nrm((N_EVEN, HEAD_DIM), 0.1),
        "a_lq2": nrm((N_EVEN, HEAD_DIM), 0.1),
        "a_lk2": nrm((N_EVEN, HEAD_DIM), 0.1),
        "a_subln": gain((N_EVEN, 2 * HEAD_DIM)),
        "b_qn": gain((N_EVEN, HEAD_DIM)),
        "b_kn": gain((N_EVEN, HEAD_DIM)),
        "b_idx_kn": gain((N_EVEN, IDX_DIM)),
        "od_w_in": nrm((N_ODD, d, ODD_IN), d ** -0.5),
        "od_w_out": nrm((N_ODD, MIX_WIDTH, d), MIX_WIDTH ** -0.5),
        "c_qn": gain((N_ODD, HEAD_DIM)),
        "c_kn": gain((N_ODD, HEAD_DIM)),
        "s5_lam_re": -0.5 + nrm((N_ODD, S5_GROUPS, S5_STATE), 0.01),
        "s5_lam_im": jnp.pi * jnp.arange(S5_STATE, dtype=F32) + nrm((N_ODD, S5_GROUPS, S5_STATE), 0.01),
        "s5_b_re": nrm((N_ODD, S5_GROUPS, S5_STATE, S5_GROUP_CH), (2 * S5_GROUP_CH) ** -0.5),
        "s5_b_im": nrm((N_ODD, S5_GROUPS, S5_STATE, S5_GROUP_CH), (2 * S5_GROUP_CH) ** -0.5),
        "s5_c_re": nrm((N_ODD, S5_GROUPS, S5_GROUP_CH, S5_STATE), 0.5),
        "s5_c_im": nrm((N_ODD, S5_GROUPS, S5_GROUP_CH, S5_STATE), 0.5),
        "s5_d": nrm((N_ODD, S5_GROUPS, S5_GROUP_CH), 0.5),
        "s5_log_dt": jax.random.uniform(next(ks), (N_ODD, S5_GROUPS), F32,
                                        minval=math.log(1e-3), maxval=math.log(1e-1)),
        "s5_glu_w": nrm((N_ODD, S5_W, S5_W), S5_W ** -0.5),
        "s5_glu_b": nrm((N_ODD, S5_W), 0.02),
    }
    return inputs


def reference(x, c, ada_w, ada_b, moe_wg, moe_bg, moe_we, moe_be, moe_w1, moe_w3, moe_w2,
              ev_w_in, ev_w_out, a_qn, a_kn, a_lq1, a_lk1, a_lq2, a_lk2, a_subln,
              b_qn, b_kn, b_idx_kn, od_w_in, od_w_out, c_qn, c_kn,
              s5_lam_re, s5_lam_im, s5_b_re, s5_b_im, s5_c_re, s5_c_im, s5_d, s5_log_dt,
              s5_glu_w, s5_glu_b):
    seq = x.shape[1]
    rope_head = rope_tables(seq, ROT_HEAD)
    rope_idx = rope_tables(seq, ROT_IDX)
    c_act = jax.nn.silu(c)
    for l in range(DEPTH):
        mod = c_act @ ada_w[l] + ada_b[l]
        sh1, sc1, g1, sh2, sc2, g2 = jnp.split(mod, 6, axis=-1)
        h = rms_norm(x) * (1.0 + sc1[:, None, :]) + sh1[:, None, :]
        i = l // 2
        if l % 2 == 0:
            lam_init = 0.8 - 0.6 * math.exp(-0.3 * l)
            y = even_mixer(h, ev_w_in[i], ev_w_out[i], a_qn[i], a_kn[i], a_lq1[i], a_lk1[i],
                           a_lq2[i], a_lk2[i], a_subln[i], b_qn[i], b_kn[i], b_idx_kn[i],
                           lam_init, rope_head, rope_idx)
        else:
            y = odd_mixer(h, od_w_in[i], od_w_out[i], c_qn[i], c_kn[i], s5_lam_re[i], s5_lam_im[i],
                          s5_b_re[i], s5_b_im[i], s5_c_re[i], s5_c_im[i], s5_d[i], s5_log_dt[i],
                          s5_glu_w[i], s5_glu_b[i], rope_head)
        x = x + g1[:, None, :] * y
        h = rms_norm(x) * (1.0 + sc2[:, None, :]) + sh2[:, None, :]
        x = x + g2[:, None, :] * hier_moe(h, moe_wg[l], moe_bg[l], moe_we[l], moe_be[l],
                                          moe_w1[l], moe_w3[l], moe_w2[l])
    return x
```

```cpp
#include <hip/hip_runtime.h>
#include <cstdio>
#include <cstdint>
#include <hip/hip_bf16.h>
#include <cmath>
#ifndef MK_ONE_LAUNCH
#define MK_ONE_LAUNCH 1
#endif
namespace pg8 {
#define PG8_LAS __attribute__((address_space(3)))
typedef unsigned short bf16_t;
typedef short bf16x8 __attribute__((ext_vector_type(8)));
typedef float f32x4 __attribute__((ext_vector_type(4)));
typedef unsigned u32x4 __attribute__((ext_vector_type(4)));
constexpr int BM = 256, BK = 64, HALF = 128, HTB = HALF * BK * 2  , STAGE_BYTES = 8 * HTB, NXCD = 8, WGM = 8;

__host__ __device__ __forceinline__ int lds_byte(int r, int c) { const int st = (r >> 4) * 2 + (c >> 5), rr = r & 15, cc = c & 31, ob = rr * 64 + cc * 2; return st * 1024 + (ob ^ (((ob >> 9) & 1) << 5)); }
__host__ __device__ __forceinline__ void stage_rc(int b, int& R, int& C) { const int st = b / 1024, sb = b % 1024, swz = sb ^ (((sb >> 9) & 1) << 5); R = (st >> 1) * 16 + swz / 64; C = (st & 1) * 32 + (swz % 64) / 2; }
__host__ __device__ __forceinline__ int perm32(int rho) { const int n = rho >> 4, i = rho & 15; return 8 * (i >> 2) + 4 * n + (i & 3); }

struct Unit { int pm, pn, be; };
struct Gemm { const bf16_t* A; const bf16_t* Bt; int M, N, K; size_t bstride; };

struct StaticOrder {
    int nM, nN, nwg, G, c;
    __host__ __device__ void init(int M, int N, int G_, int c_) { nM = M / BM; nN = N / BM; nwg = nM * nN; G = G_; c = c_; }
    __host__ __device__ bool next(int i, Unit& u) const {
        const long L = (long)i * G + c; if (L >= nwg) return false;
        int wgid = (int)L; { const int q = nwg / NXCD, r = nwg % NXCD, xcd = wgid % NXCD, off = wgid / NXCD; wgid = (xcd < r ? xcd * (q + 1) : r * (q + 1) + (xcd - r) * q) + off; }
        const int nig = WGM * nN, gid = wgid / nig, fm = gid * WGM, gsz = (nM - fm) < WGM ? (nM - fm) : WGM;
        u.pm = fm + ((wgid % nig) % gsz); u.pn = (wgid % nig) / gsz; u.be = 0; return true;
    }
    __device__ __forceinline__ void a_ready(const Unit&) const {}
    __device__ __forceinline__ void done(const Unit&) const {}
};

__device__ __forceinline__ unsigned cvt_pk_bf16(float lo, float hi) { unsigned r; asm volatile("v_cvt_pk_bf16_f32 %0, %1, %2" : "=v"(r) : "v"(lo), "v"(hi)); return r; }
typedef float f32x2 __attribute__((ext_vector_type(2)));
struct NoRows { static constexpr bool GATHER = false; __device__ __forceinline__ unsigned operator()(const Unit&, int) const { return 0u; } };
template <class Epi, class Sched, bool ALIGN_EPI = false, bool SP2 = false, class Rows = NoRows>
__device__ __forceinline__ void gemm_phase(PG8_LAS unsigned char* lds, const Gemm g, const Sched& S, const Epi& E, const int tid_in, const Rows& RW = Rows()) {
    const int tid = tid_in, wid = __builtin_amdgcn_readfirstlane(tid >> 6), lane = tid & 63, wr = wid >> 2, wc = wid & 3, fr = lane & 15, fq = lane >> 4;
    const int K = g.K, nt = K / BK;
    unsigned voffA[2], voffB[2];
#pragma unroll
    for (int i = 0; i < 2; ++i) { int R, C; stage_rc(tid * 16 + i * 8192, R, C); const int Rb = Epi::PERM ? ((R & ~31) + perm32(R & 31)) : R;
        voffA[i] = (unsigned)(R * K + C) * 2u; voffB[i] = (unsigned)(Rb * K + C) * 2u; }
    const size_t kstep = (size_t)(BK * 2);
    const size_t hstep = (size_t)HALF * K * 2;
    const size_t tstep = 2 * hstep;
    const unsigned ldsw = (unsigned)wid * 1024u;
    const int aoff = lds_byte(wr * 64 + fr, fq * 8), boff = lds_byte(wc * 32 + fr, fq * 8);
#define PG8_SA(b, h) (((b) * 2 + (h)) * HTB)
#define PG8_SB(b, h) ((4 + (b) * 2 + (h)) * HTB)
#define PG8_STAGE(bufoff, gbase, voff) do { _Pragma("unroll") for (int _i = 0; _i < 2; ++_i) \
        __builtin_amdgcn_global_load_lds((const unsigned*)((const char*)(gbase) + (voff)[_i]), (PG8_LAS unsigned*)(lds + (bufoff) + ldsw + _i * 8192), 16, 0, 0); } while (0)
#define PG8_LDA(dst, b, h) do { _Pragma("unroll") for (int m = 0; m < 4; ++m) _Pragma("unroll") for (int k = 0; k < 2; ++k) dst[m][k] = *(const PG8_LAS bf16x8*)(lds + PG8_SA(b, h) + aoff + m * 2048 + k * 1024); } while (0)
#define PG8_LDB(dst, b, h) do { _Pragma("unroll") for (int n = 0; n < 2; ++n) _Pragma("unroll") for (int k = 0; k < 2; ++k) dst[n][k] = *(const PG8_LAS bf16x8*)(lds + PG8_SB(b, h) + boff + n * 2048 + k * 1024); } while (0)
#define PG8_MMA(ai, bj, At, Bt) do { __builtin_amdgcn_s_setprio(1); _Pragma("unroll") for (int m = 0; m < 4; ++m) _Pragma("unroll") for (int n = 0; n < 2; ++n) _Pragma("unroll") for (int k = 0; k < 2; ++k) \
        acc[ai][bj][m][n] = __builtin_amdgcn_mfma_f32_16x16x32_bf16(Bt[n][k], At[m][k], acc[ai][bj][m][n], 0, 0, 0); __builtin_amdgcn_s_setprio(0); } while (0)
#define PG8_WAIT_V(n) asm volatile("s_waitcnt vmcnt(" #n ")" ::: "memory")
#define PG8_WAIT_L(n) asm volatile("s_waitcnt lgkmcnt(" #n ")" ::: "memory")
#define PG8_BAR __builtin_amdgcn_s_barrier()
#define PG8_SCHED __builtin_amdgcn_sched_barrier(0)
    Unit cur, nxt; int ui = 0;
    if (!S.next(0, cur)) return;
    f32x4 acc[2][2][4][2];
#pragma unroll
    for (int a = 0; a < 2; ++a)
#pragma unroll
        for (int b = 0; b < 2; ++b)
#pragma unroll
            for (int m = 0; m < 4; ++m)
#pragma unroll
                for (int n = 0; n < 2; ++n) { float z0_ = 0.f; asm volatile("" : "+v"(z0_)); acc[a][b][m][n] = (f32x4){z0_, z0_, z0_, z0_}; }
    bf16x8 At[4][2], B0[2][2], B1[2][2];
    const char* cA = Rows::GATHER ? (const char*)g.A : (const char*)g.A + (size_t)cur.pm * tstep; const char* cB = (const char*)g.Bt + (size_t)cur.be * g.bstride + (size_t)cur.pn * tstep;
    int Rr[2], Cc[2];
#pragma unroll
    for (int i = 0; i < 2; ++i) stage_rc(tid * 16 + i * 8192, Rr[i], Cc[i]);
    unsigned voffAh[2][2], voffAn[2][2];
#pragma unroll
    for (int h = 0; h < 2; ++h)
#pragma unroll
        for (int i = 0; i < 2; ++i) { voffAh[h][i] = Rows::GATHER ? RW(cur, h * HALF + Rr[i]) + (unsigned)Cc[i] * 2u : voffA[i] + (unsigned)h * (unsigned)hstep; voffAn[h][i] = voffAh[h][i]; }
    S.a_ready(cur);
    if constexpr (SP2) {
        PG8_STAGE(PG8_SB(0, 0), cB, voffB); PG8_STAGE(PG8_SB(0, 1), cB + hstep, voffB); PG8_STAGE(PG8_SA(0, 0), cA, voffAh[0]); PG8_STAGE(PG8_SA(0, 1), cA, voffAh[1]);
        if (wr == 1) PG8_BAR;
        PG8_WAIT_V(2); PG8_BAR;
        PG8_STAGE(PG8_SB(1, 0), cB + kstep, voffB); PG8_STAGE(PG8_SA(1, 0), cA + kstep, voffAh[0]); PG8_STAGE(PG8_SB(1, 1), cB + hstep + kstep, voffB);
        PG8_WAIT_V(6); PG8_BAR;
    } else {
        PG8_STAGE(PG8_SB(0, 0), cB, voffB); PG8_STAGE(PG8_SA(0, 0), cA, voffAh[0]); PG8_STAGE(PG8_SB(0, 1), cB + hstep, voffB); PG8_STAGE(PG8_SA(0, 1), cA, voffAh[1]);
        if (wr == 1) PG8_BAR;
        PG8_WAIT_V(4); PG8_BAR;
        PG8_STAGE(PG8_SB(1, 0), cB + kstep, voffB); PG8_STAGE(PG8_SA(1, 0), cA + kstep, voffAh[0]); PG8_STAGE(PG8_SB(1, 1), cB + hstep + kstep, voffB);
        PG8_WAIT_V(6); PG8_BAR;
    }
    for (;;) {
        const bool has_next = S.next(ui + 1, nxt);
        const char* nA = Rows::GATHER ? (const char*)g.A : (has_next ? (const char*)g.A + (size_t)nxt.pm * tstep : cA);
        if constexpr (Rows::GATHER) { if (has_next) {
#pragma unroll
            for (int h = 0; h < 2; ++h)
#pragma unroll
                for (int i = 0; i < 2; ++i) voffAn[h][i] = RW(nxt, h * HALF + Rr[i]) + (unsigned)Cc[i] * 2u; } } const char* nB = has_next ? (const char*)g.Bt + (size_t)nxt.be * g.bstride + (size_t)nxt.pn * tstep : cB;
        for (int t = 0; t < nt; t += 2) {
            const bool last = (t == nt - 2); const bool gsel = Rows::GATHER && last && has_next;
            const char* a1 = cA + (size_t)(t + 1) * kstep;
            const char* a2 = last ? nA : cA + (size_t)(t + 2) * kstep; const char* b2 = last ? nB : cB + (size_t)(t + 2) * kstep;
            const char* a3 = a2 + kstep; const char* b3 = b2 + kstep;
            if (last && has_next) S.a_ready(nxt);
            if constexpr (SP2) {
            PG8_LDB(B0, 0, 0); PG8_LDB(B1, 0, 1); PG8_SCHED; PG8_LDA(At, 0, 0); PG8_STAGE(PG8_SA(1, 1), a1, voffAh[1]);
            PG8_WAIT_V(8); PG8_WAIT_L(0); PG8_BAR; PG8_MMA(0, 0, At, B0); PG8_MMA(0, 1, At, B1); PG8_BAR; PG8_SCHED;
            PG8_LDA(At, 0, 1); PG8_STAGE(PG8_SB(0, 0), b2, voffB); PG8_STAGE(PG8_SB(0, 1), b2 + hstep, voffB); PG8_STAGE(PG8_SA(0, 0), a2, (gsel ? voffAn[0] : voffAh[0]));
            PG8_WAIT_V(8); PG8_WAIT_L(0); PG8_BAR; PG8_MMA(1, 0, At, B0); PG8_MMA(1, 1, At, B1); PG8_BAR; PG8_SCHED;
            PG8_LDB(B0, 1, 0); PG8_LDB(B1, 1, 1); PG8_SCHED; PG8_LDA(At, 1, 0); PG8_STAGE(PG8_SA(0, 1), a2, (gsel ? voffAn[1] : voffAh[1]));
            PG8_WAIT_V(8); PG8_WAIT_L(0); PG8_BAR; PG8_MMA(0, 0, At, B0); PG8_MMA(0, 1, At, B1); PG8_BAR; PG8_SCHED;
            PG8_LDA(At, 1, 1); PG8_STAGE(PG8_SB(1, 0), b3, voffB); PG8_STAGE(PG8_SB(1, 1), b3 + hstep, voffB); PG8_STAGE(PG8_SA(1, 0), a3, (gsel ? voffAn[0] : voffAh[0]));
            PG8_WAIT_V(8); PG8_WAIT_L(0); PG8_BAR; PG8_MMA(1, 0, At, B0); PG8_MMA(1, 1, At, B1); PG8_BAR; PG8_SCHED;
            } else {
            PG8_LDB(B0, 0, 0); PG8_SCHED; PG8_LDA(At, 0, 0); PG8_STAGE(PG8_SA(1, 1), a1, voffAh[1]);
            PG8_WAIT_L(8); PG8_BAR; PG8_WAIT_L(0); PG8_MMA(0, 0, At, B0); PG8_BAR; PG8_SCHED;
            PG8_LDB(B1, 0, 1); PG8_STAGE(PG8_SB(0, 0), b2, voffB);
            PG8_BAR; PG8_WAIT_L(0); PG8_MMA(0, 1, At, B1); PG8_BAR;
            PG8_LDA(At, 0, 1); PG8_STAGE(PG8_SA(0, 0), a2, (gsel ? voffAn[0] : voffAh[0]));
            PG8_BAR; PG8_WAIT_L(0); PG8_MMA(1, 0, At, B0); PG8_BAR; PG8_SCHED;
            PG8_STAGE(PG8_SB(0, 1), b2 + hstep, voffB);
            PG8_WAIT_V(6); PG8_BAR; PG8_MMA(1, 1, At, B1); PG8_BAR;
            PG8_LDB(B0, 1, 0); PG8_SCHED; PG8_LDA(At, 1, 0); PG8_STAGE(PG8_SA(0, 1), a2, (gsel ? voffAn[1] : voffAh[1]));
            PG8_WAIT_L(8); PG8_BAR; PG8_WAIT_L(0); PG8_MMA(0, 0, At, B0); PG8_BAR; PG8_SCHED;
            PG8_LDB(B1, 1, 1); PG8_STAGE(PG8_SB(1, 0), b3, voffB);
            PG8_BAR; PG8_WAIT_L(0); PG8_MMA(0, 1, At, B1); PG8_BAR;
            PG8_LDA(At, 1, 1); PG8_STAGE(PG8_SA(1, 0), a3, (gsel ? voffAn[0] : voffAh[0]));
            PG8_BAR; PG8_WAIT_L(0); PG8_MMA(1, 0, At, B0); PG8_BAR; PG8_SCHED;
            PG8_STAGE(PG8_SB(1, 1), b3 + hstep, voffB);
            PG8_WAIT_V(6); PG8_BAR; PG8_MMA(1, 1, At, B1); PG8_BAR;
            }
        }
        if constexpr (ALIGN_EPI) { if (wr == 0) PG8_BAR; }
        if constexpr (!Epi::AFTER_DRAIN) { int l2_; asm volatile("v_mbcnt_lo_u32_b32 %0, -1, 0\n\tv_mbcnt_hi_u32_b32 %0, -1, %0" : "=v"(l2_)); E(acc, cur, wr, wc, l2_ & 15, l2_ >> 4); S.done(cur); }
        if (!has_next) break;
#pragma unroll
        for (int a = 0; a < 2; ++a)
#pragma unroll
            for (int b = 0; b < 2; ++b)
#pragma unroll
                for (int m = 0; m < 4; ++m)
#pragma unroll
                    for (int n = 0; n < 2; ++n) { float z0_ = 0.f; asm volatile("" : "+v"(z0_)); acc[a][b][m][n] = (f32x4){z0_, z0_, z0_, z0_}; }
        cur = nxt; cA = nA; cB = nB; ++ui;
        if constexpr (Rows::GATHER) {
#pragma unroll
            for (int h = 0; h < 2; ++h)
#pragma unroll
                for (int i = 0; i < 2; ++i) voffAh[h][i] = voffAn[h][i]; }
        if constexpr (ALIGN_EPI) { if (wr == 1) PG8_BAR; }
    }
    PG8_WAIT_V(0);
    if constexpr (!ALIGN_EPI) { if (wr == 0) PG8_BAR; }
    PG8_BAR;
    if constexpr (Epi::AFTER_DRAIN) { E.fused(acc, cur, wr, wc, fr, fq, lds, wid, lane); S.done(cur); }
#undef PG8_SA
#undef PG8_SB
#undef PG8_STAGE
#undef PG8_LDA
#undef PG8_LDB
#undef PG8_MMA
#undef PG8_WAIT_V
#undef PG8_WAIT_L
#undef PG8_BAR
#undef PG8_SCHED
}
}
namespace attn_body {
using bf16=__hip_bfloat16;
using bf16x8=__attribute__((ext_vector_type(8)))short;
using s16x4=__attribute__((ext_vector_type(4)))short;
using f32x16=__attribute__((ext_vector_type(16)))float;
using u32x4=__attribute__((ext_vector_type(4)))unsigned;
constexpr int D=64;
constexpr int NW=8,QBLK=32,QB=QBLK*NW,KVBLK=64;
constexpr int ATTN_UNIT_ROWS=QB;
__device__ __forceinline__ int crow(int r,int hi){return (r&3)+8*(r>>2)+4*hi;}
#define SBAR() __builtin_amdgcn_sched_barrier(0)
__device__ __forceinline__ void cmask(f32x16&p0,f32x16&p1,int jb,int qrel,int hi){
  const float NEG=-INFINITY; int kb=64*jb+4*hi;
  #pragma unroll
  for(int r=0;r<16;++r){int kv=kb+(r&3)+8*(r>>2); if(kv>qrel)p0[r]=NEG; if(kv+32>qrel)p1[r]=NEG;}
}

constexpr int NSLOT=3, SLOTB=8192;
constexpr int LDS_K=0, LDS_V=NSLOT*SLOTB, LDS_WS=2*NSLOT*SLOTB, LDS_OST=LDS_WS+NW*64*4, LDS_BYTES=LDS_OST+NW*4096;
constexpr float C2=0.125f*1.4426950408889634f;
__device__ __forceinline__ void glds16(const void*gsrc,unsigned lds_dst){unsigned keep;
  asm volatile("s_mov_b32 %0, m0\n\ts_mov_b32 m0, %2\n\ts_nop 0\n\tglobal_load_lds_dwordx4 %1, off\n\ts_mov_b32 m0, %0":"=&s"(keep):"v"(gsrc),"s"(lds_dst):"memory");}
__device__ __forceinline__ float max3f(float a,float b,float c){float r;asm("v_max3_f32 %0, %1, %2, %3":"=v"(r):"v"(a),"v"(b),"v"(c));return r;}
__device__ __forceinline__ float max2f(float a,float b){float r;asm("v_max_f32_e32 %0, %1, %2":"=v"(r):"v"(a),"v"(b));return r;}
__device__ __forceinline__ float fadd_s(float a,float b){float r;asm("v_add_f32_e32 %0, %1, %2":"=v"(r):"v"(a),"v"(b));return r;}
__device__ __forceinline__ float fsub_s(float a,float b){float r;asm("v_sub_f32_e32 %0, %1, %2":"=v"(r):"v"(a),"v"(b));return r;}
typedef float f32x2_t __attribute__((ext_vector_type(2))); typedef __bf16 bf16x2_t __attribute__((ext_vector_type(2)));
__device__ __forceinline__ unsigned cvtpk_s(float lo,float hi){f32x2_t v={lo,hi};bf16x2_t b=__builtin_convertvector(v,bf16x2_t);return __builtin_bit_cast(unsigned,b);}
#define WAIT_BAR(N) asm volatile("s_waitcnt vmcnt(" #N ") lgkmcnt(0)\n\ts_barrier":::"memory")

__device__ __forceinline__ void qkt(f32x16&p0,f32x16&p1,const char*Kslot,const bf16x8*qr,const f32x16&negm,int r32,int hi){
  const char*kb=Kslot+hi*1024+r32*16;
  #pragma unroll
  for(int d0=0;d0<4;++d0){
    const bf16x8 b0=*reinterpret_cast<const bf16x8*>(kb+d0*2048);
    const bf16x8 b1=*reinterpret_cast<const bf16x8*>(kb+d0*2048+512);
    if(d0==0){p0=__builtin_amdgcn_mfma_f32_32x32x16_bf16(b0,qr[0],negm,0,0,0);p1=__builtin_amdgcn_mfma_f32_32x32x16_bf16(b1,qr[0],negm,0,0,0);}
    else{p0=__builtin_amdgcn_mfma_f32_32x32x16_bf16(b0,qr[d0],p0,0,0,0);p1=__builtin_amdgcn_mfma_f32_32x32x16_bf16(b1,qr[d0],p1,0,0,0);}}
}
typedef __attribute__((address_space(3))) const char* lds_cptr;
typedef short v4i16_t __attribute__((ext_vector_type(4)));
__device__ __forceinline__ void kload8(bf16x8*kf,lds_cptr kp){
  kf[0]=*(const __attribute__((address_space(3))) bf16x8*)(kp);      kf[1]=*(const __attribute__((address_space(3))) bf16x8*)(kp+512);
  kf[2]=*(const __attribute__((address_space(3))) bf16x8*)(kp+2048); kf[3]=*(const __attribute__((address_space(3))) bf16x8*)(kp+2560);
  kf[4]=*(const __attribute__((address_space(3))) bf16x8*)(kp+4096); kf[5]=*(const __attribute__((address_space(3))) bf16x8*)(kp+4608);
  kf[6]=*(const __attribute__((address_space(3))) bf16x8*)(kp+6144); kf[7]=*(const __attribute__((address_space(3))) bf16x8*)(kp+6656);
}
__device__ __forceinline__ void kload2(bf16x8*kf,lds_cptr kp,int j){ kf[2*j]=*(const __attribute__((address_space(3))) bf16x8*)(kp+j*2048); kf[2*j+1]=*(const __attribute__((address_space(3))) bf16x8*)(kp+j*2048+512); }
__device__ __forceinline__ s16x4 vtr(lds_cptr p){ return __builtin_bit_cast(s16x4,__builtin_amdgcn_ds_read_tr16_b64_v4i16((__attribute__((address_space(3))) v4i16_t*)p)); }
__device__ __forceinline__ float rowmax(const f32x16&p0,const f32x16&p1){
  float a=max3f(p0[0],p0[1],p1[0]),b=max3f(p0[2],p0[3],p1[1]);a=max3f(a,p1[2],p1[3]);
  #pragma unroll
  for(int r=4;r<16;r+=4){a=max3f(a,p0[r],p0[r+1]);b=max3f(b,p0[r+2],p0[r+3]);a=max3f(a,p1[r],p1[r+1]);b=max3f(b,p1[r+2],p1[r+3]);}
  const float m=max2f(a,b);
  auto rr=__builtin_amdgcn_permlane32_swap(__float_as_uint(m),__float_as_uint(m),false,false);
  return max2f(__uint_as_float(rr[0]),__uint_as_float(rr[1]));
}
__device__ __forceinline__ void pv(f32x16*o,int vb,bf16x8 pa0,bf16x8 pa1,bf16x8 pa2,bf16x8 pa3){
  #pragma unroll
  for(int d0=0;d0<2;++d0){s16x4 lo[4],hi[4];
    #pragma unroll
    for(int ks=0;ks<4;++ks){
      asm volatile("ds_read_b64_tr_b16 %0,%1 offset:%c2":"=&v"(lo[ks]):"v"(vb),"i"(d0*4096+ks*1024):"memory");
      asm volatile("ds_read_b64_tr_b16 %0,%1 offset:%c2":"=&v"(hi[ks]):"v"(vb),"i"(d0*4096+ks*1024+512):"memory");}
    asm volatile("s_waitcnt lgkmcnt(0)":::"memory");SBAR();
    #define PK(k) (bf16x8){lo[k][0],lo[k][1],lo[k][2],lo[k][3],hi[k][0],hi[k][1],hi[k][2],hi[k][3]}
    o[d0]=__builtin_amdgcn_mfma_f32_32x32x16_bf16(pa0,PK(0),o[d0],0,0,0);
    o[d0]=__builtin_amdgcn_mfma_f32_32x32x16_bf16(pa1,PK(1),o[d0],0,0,0);
    o[d0]=__builtin_amdgcn_mfma_f32_32x32x16_bf16(pa2,PK(2),o[d0],0,0,0);
    o[d0]=__builtin_amdgcn_mfma_f32_32x32x16_bf16(pa3,PK(3),o[d0],0,0,0);
    #undef PK
  }
}

#ifndef ATTN_STORE16
#define ATTN_STORE16(p,v) (*(u32x4*)(p)=(v))
#endif
template<int THRL,int PIN,int POUT> __device__ __forceinline__ void attn_unit(int qb,const bf16*Qh,const bf16*__restrict__ Kh,const bf16*__restrict__ Vh,bf16*Oh,char*shm,const int wid_in){
  constexpr int DM=PIN;
  int lane; asm volatile("v_mbcnt_lo_u32_b32 %0, -1, 0\n\tv_mbcnt_hi_u32_b32 %0, -1, %0" : "=v"(lane));
  const int wid=wid_in; const int tid=wid*64+lane; const int r32=lane&31,hi=lane>>5;
  const int q0=qb*QB;
  const bf16*Qw=Qh+(long)(q0+wid*QBLK)*DM;
  const unsigned lds0=(unsigned)(uintptr_t)shm;
  float*wsf=(float*)(shm+LDS_WS)+wid*64;
  const bf16*ksrc=Kh+(long)lane*DM+wid*8;
  const bf16*vsrc=Vh+(long)(16*(wid&3)+(lane>>2))*DM+(wid>>2)*32+(lane&3)*8;
  const unsigned kdst=lds0+LDS_K+wid*1024, vdst=lds0+LDS_V+wid*1024;
  #define DMA_K(t,slot) glds16(ksrc+(long)(t)*KVBLK*DM,(unsigned)__builtin_amdgcn_readfirstlane(kdst+(slot)))
  #define DMA_V(t,slot) glds16(vsrc+(long)(t)*KVBLK*DM,(unsigned)__builtin_amdgcn_readfirstlane(vdst+(slot)))
  const int vb0=(int)(lds0+LDS_V)+((lane>>4)&1)*32+(lane&3)*8+(4*hi+((lane&15)>>2))*64;
  const char*Kbase=shm+LDS_K; bf16x8 kf[8];
  const lds_cptr shm3=(lds_cptr)shm; const lds_cptr kp0=shm3+LDS_K+hi*1024+r32*16; const lds_cptr vp0=shm3+LDS_V+((lane>>4)&1)*32+(lane&3)*8+(4*hi+((lane&15)>>2))*64;
  const int NT=(q0+QB)/KVBLK;
  DMA_K(0,0);DMA_V(0,0);DMA_K(1,SLOTB);
  bf16x8 qr[4];
  #pragma unroll
  for(int d0=0;d0<4;++d0)qr[d0]=*reinterpret_cast<const bf16x8*>(&Qw[(long)r32*DM+d0*16+hi*8]);
  float mhat=0.f,l_reg=0.f;f32x16 o[2];f32x16 negm;{float z0_=0.f;asm volatile("":"+v"(z0_));
  #pragma unroll
  for(int r=0;r<16;++r){o[0][r]=z0_;o[1][r]=z0_;negm[r]=z0_;}}asm volatile("":"+v"(negm));
  const int qrel=wid*QBLK+r32;
  #define CMASK(P0,P1,t) do{int jb_=(t)-(NT-4); if(jb_>=0)cmask(P0,P1,jb_,qrel,hi);}while(0)
  bool resc=false;
  #define START(P0,P1) do{ const float rm=rowmax(P0,P1); resc=false; \
    { const float dl=rm; mhat=fadd_s(mhat,dl); \
      _Pragma("unroll") for(int r=0;r<16;++r){P0[r]=fsub_s(P0[r],dl);P1[r]=fsub_s(P1[r],dl);} \
      _Pragma("unroll") for(int r=0;r<16;++r)negm[r]=-mhat; asm volatile("":"+v"(negm)); } \
    _Pragma("unroll") for(int r=0;r<16;++r)P0[r]=__builtin_amdgcn_exp2f(P0[r]); }while(0)
  #define RESC() do{ if(resc){ asm volatile("s_waitcnt lgkmcnt(0)":::"memory"); \
      _Pragma("unroll") for(int d_=0;d_<2;++d_) _Pragma("unroll") for(int r=0;r<16;++r)o[d_][r]*=wsf[crow(r,hi)]; } }while(0)
  f32x16 pA0,pA1,pB0,pB1;
  int sl_prev=0,sl_cur=0,sl_next=SLOTB;
  #define ROT() do{sl_prev=sl_cur;sl_cur=sl_next;sl_next=(sl_next==(NSLOT-1)*SLOTB)?0:sl_next+SLOTB;}while(0)
  DMA_K(2,2*SLOTB);
  WAIT_BAR(3);
  qkt(pA0,pA1,Kbase,qr,negm,r32,hi);asm volatile("s_nop 15\n\ts_nop 7":"+v"(pA0),"+v"(pA1));CMASK(pA0,pA1,0);
  START(pA0,pA1);
  _Pragma("unroll") for(int r=0;r<16;++r)pA1[r]=__builtin_amdgcn_exp2f(pA1[r]);
  WAIT_BAR(0);
  DMA_K(3,0);DMA_V(1,SLOTB);
  ROT();
  kload8(kf,kp0+sl_cur);
  WAIT_BAR(2);
  s16x4 vlo[8],vhi[8]; u32x4 pw0,pw1,pw2,pw3;
  #define PKW(P,B) cvtpk_s(P[B],P[B+1])
  #define PAF(k) __builtin_bit_cast(bf16x8,pw##k)
  #define VFR(i) (bf16x8){vlo[i][0],vlo[i][1],vlo[i][2],vlo[i][3],vhi[i][0],vhi[i][1],vhi[i][2],vhi[i][3]}
  #define PIN(x) asm volatile("":"+v"(x))
  #define MX3(a,b,c) __builtin_fmaxf(__builtin_fmaxf((a),(b)),(c))
  #define GAPA(MF,A0,A1,A2,A3,W0,W1,PW) do{ MF; sacc+=A0; sacc+=A1; sacc+=A2; sacc+=A3; PIN(sacc); W0; W1; PIN(PW); SBAR(); }while(0)
  #define EX(v) __builtin_amdgcn_exp2f(v)
  #define GAPB(MF,X,B) do{ MF; X[B]=EX(X[B]); X[B+1]=EX(X[B+1]); X[B+2]=EX(X[B+2]); X[B+3]=EX(X[B+3]); PIN(X); SBAR(); }while(0)
  #define VRD(i) do{ vlo[i]=vtr(vp_+(((i)>>2)*4096+((i)&3)*1024)); vhi[i]=vtr(vp_+(((i)>>2)*4096+((i)&3)*1024+512)); }while(0)
  #define KRD(G,j) do{ if(G){ kload2(kf,kp0+sl_next,j); SBAR(); } }while(0)
  #define STEP(C0,C1,P0,P1,t,GK,GV,GL) do{ SBAR(); \
    const lds_cptr vp_=vp0+sl_prev; \
    VRD(0); SBAR(); float sacc=(P0[0]+P0[1]); \
    GAPA(C0=__builtin_amdgcn_mfma_f32_32x32x16_bf16(kf[0],qr[0],negm,0,0,0), P0[2],P0[3],P0[4],P0[5],     pw0[0]=PKW(P0,0), pw0[1]=PKW(P0,2), pw0); \
    VRD(4); SBAR(); GAPA(C1=__builtin_amdgcn_mfma_f32_32x32x16_bf16(kf[1],qr[0],negm,0,0,0), P0[6],P0[7],P0[8],P0[9],     pw0[2]=PKW(P0,4), pw0[3]=PKW(P0,6), pw0); \
    VRD(1); SBAR(); GAPA(C0=__builtin_amdgcn_mfma_f32_32x32x16_bf16(kf[2],qr[1],C0,0,0,0),   P0[10],P0[11],P0[12],P0[13], pw1[0]=PKW(P0,8), pw1[1]=PKW(P0,10), pw1); \
    VRD(5); SBAR(); GAPA(C1=__builtin_amdgcn_mfma_f32_32x32x16_bf16(kf[3],qr[1],C1,0,0,0),   P0[14],P0[15],P1[0],P1[1],   pw1[2]=PKW(P0,12),pw1[3]=PKW(P0,14), pw1); \
    VRD(2); SBAR(); GAPA(C0=__builtin_amdgcn_mfma_f32_32x32x16_bf16(kf[4],qr[2],C0,0,0,0),   P1[2],P1[3],P1[4],P1[5],     pw2[0]=PKW(P1,0), pw2[1]=PKW(P1,2), pw2); \
    VRD(6); SBAR(); GAPA(C1=__builtin_amdgcn_mfma_f32_32x32x16_bf16(kf[5],qr[2],C1,0,0,0),   P1[6],P1[7],P1[8],P1[9],     pw2[2]=PKW(P1,4), pw2[3]=PKW(P1,6), pw2); \
    VRD(3); SBAR(); GAPA(C0=__builtin_amdgcn_mfma_f32_32x32x16_bf16(kf[6],qr[3],C0,0,0,0),   P1[10],P1[11],P1[12],P1[13], pw3[0]=PKW(P1,8), pw3[1]=PKW(P1,10), pw3); \
    VRD(7); SBAR(); GAPA(C1=__builtin_amdgcn_mfma_f32_32x32x16_bf16(kf[7],qr[3],C1,0,0,0),   P1[14],P1[15],0.f,0.f,       pw3[2]=PKW(P1,12),pw3[3]=PKW(P1,14), pw3); \
    l_reg+=sacc; \
    if(GK){DMA_K((t)+3,sl_cur);} if(GV){DMA_V((t)+1,sl_next);} \
    CMASK(C0,C1,t); \
    { float a=MX3(C0[0],C0[1],C1[0]),b=MX3(C0[2],C0[3],C1[1]); a=MX3(a,C1[2],C1[3]); \
      _Pragma("unroll") for(int r=4;r<16;r+=4){a=MX3(a,C0[r],C0[r+1]);b=MX3(b,C0[r+2],C0[r+3]);a=MX3(a,C1[r],C1[r+1]);b=MX3(b,C1[r+2],C1[r+3]);} \
      float rm=__builtin_fmaxf(a,b); { auto rr=__builtin_amdgcn_permlane32_swap(__float_as_uint(rm),__float_as_uint(rm),false,false); rm=__builtin_fmaxf(__uint_as_float(rr[0]),__uint_as_float(rr[1])); } \
      resc=false; \
      if(__builtin_expect(__any(rm>(float)THRL),0)){ const float dl=__builtin_fmaxf(rm,0.f); mhat+=dl; \
        _Pragma("unroll") for(int r=0;r<16;++r){C0[r]-=dl;C1[r]-=dl;} \
        _Pragma("unroll") for(int r=0;r<16;++r)negm[r]=-mhat; asm volatile("":"+v"(negm)); \
        const float f=__builtin_amdgcn_exp2f(-dl); l_reg*=f; if(hi==0)wsf[r32]=f; resc=true; } } \
    SBAR(); \
    GAPB(o[0]=__builtin_amdgcn_mfma_f32_32x32x16_bf16(PAF(0),VFR(0),o[0],0,0,0), C0,0); \
    GAPB(o[1]=__builtin_amdgcn_mfma_f32_32x32x16_bf16(PAF(0),VFR(4),o[1],0,0,0), C0,4); \
    KRD(GL,0); GAPB(o[0]=__builtin_amdgcn_mfma_f32_32x32x16_bf16(PAF(1),VFR(1),o[0],0,0,0), C0,8); \
    KRD(GL,1); GAPB(o[1]=__builtin_amdgcn_mfma_f32_32x32x16_bf16(PAF(1),VFR(5),o[1],0,0,0), C0,12); \
    KRD(GL,2); GAPB(o[0]=__builtin_amdgcn_mfma_f32_32x32x16_bf16(PAF(2),VFR(2),o[0],0,0,0), C1,0); \
    KRD(GL,3); GAPB(o[1]=__builtin_amdgcn_mfma_f32_32x32x16_bf16(PAF(2),VFR(6),o[1],0,0,0), C1,4); \
    GAPB(o[0]=__builtin_amdgcn_mfma_f32_32x32x16_bf16(PAF(3),VFR(3),o[0],0,0,0), C1,8); \
    GAPB(o[1]=__builtin_amdgcn_mfma_f32_32x32x16_bf16(PAF(3),VFR(7),o[1],0,0,0), C1,12); \
    }while(0)
  int t=1;
  #undef CMASK
  #define CMASK(P0,P1,t) do{}while(0)
  for(;t+5<NT;t+=2){
    STEP(pB0,pB1,pA0,pA1,t,true,true,true);     WAIT_BAR(2); RESC(); ROT();
    STEP(pA0,pA1,pB0,pB1,t+1,true,true,true);   WAIT_BAR(2); RESC(); ROT();
  }
  #undef CMASK
  #define CMASK(P0,P1,t) do{int jb_=(t)-(NT-4); if(jb_>=0)cmask(P0,P1,jb_,qrel,hi);}while(0)
  #define ENDW(tt) do{ if((tt)+3<NT){WAIT_BAR(2);} else if((tt)+2<NT){WAIT_BAR(1);} else {WAIT_BAR(0);} }while(0)
  for(;t+1<NT;t+=2){
    STEP(pB0,pB1,pA0,pA1,t,(t+3<NT),(t+1<NT),(t+1<NT));       ENDW(t);   RESC(); ROT();
    STEP(pA0,pA1,pB0,pB1,t+1,(t+4<NT),(t+2<NT),(t+2<NT));     ENDW(t+1); RESC(); ROT();
  }
  STEP(pB0,pB1,pA0,pA1,NT-1,false,false,false); RESC();
  { float sacc=pB0[0]+pB0[1]; _Pragma("unroll") for(int r=2;r<16;++r)sacc+=pB0[r]; _Pragma("unroll") for(int r=0;r<16;++r)sacc+=pB1[r]; l_reg+=sacc;
    pw0=(u32x4){PKW(pB0,0),PKW(pB0,2),PKW(pB0,4),PKW(pB0,6)};pw1=(u32x4){PKW(pB0,8),PKW(pB0,10),PKW(pB0,12),PKW(pB0,14)};pw2=(u32x4){PKW(pB1,0),PKW(pB1,2),PKW(pB1,4),PKW(pB1,6)};pw3=(u32x4){PKW(pB1,8),PKW(pB1,10),PKW(pB1,12),PKW(pB1,14)};
    SBAR(); pv(o,vb0+sl_cur,PAF(0),PAF(1),PAF(2),PAF(3)); }
  #undef PKW
  #undef PAF
  #undef VFR
  #undef PIN
  #undef MX3
  #undef GAPA
  #undef GAPB
  #undef EX
  #undef VRD
  #undef KRD
  #undef STEP
  #undef ENDW
  {auto rr=__builtin_amdgcn_permlane32_swap(__float_as_uint(l_reg),__float_as_uint(l_reg),false,false);l_reg=__uint_as_float(rr[0])+__uint_as_float(rr[1]);}
  if(hi==0)wsf[32+r32]=l_reg;asm volatile("s_waitcnt lgkmcnt(0)":::"memory");
  float rli[16];
  #pragma unroll
  for(int r=0;r<16;++r)rli[r]=__builtin_amdgcn_rcpf(wsf[32+crow(r,hi)]);
  bf16*Ow=Oh+(long)(q0+wid*QBLK)*POUT;
  { bf16*stg=(bf16*)(shm+LDS_OST)+wid*2048;
    #pragma unroll
    for(int r=0;r<16;++r){const int orow=crow(r,hi);
      #pragma unroll
      for(int d0=0;d0<2;++d0)stg[orow*64+d0*32+r32]=__float2bfloat16(o[d0][r]*rli[r]);}
    asm volatile("s_waitcnt lgkmcnt(0)":::"memory");
    #pragma unroll
    for(int i=0;i<4;++i){const int row=i*8+(lane>>3),ch=lane&7; const u32x4 v=*(const u32x4*)(stg+row*64+ch*8); ATTN_STORE16(Ow+(long)row*POUT+ch*8,v);} }
  asm volatile("s_waitcnt lgkmcnt(0)\n\ts_barrier":::"memory");
  #undef DMA_K
  #undef DMA_V
  #undef CMASK
  #undef START
  #undef RESC
  #undef ROT
}
constexpr int ATTN_LDS_BYTES=LDS_BYTES;
#undef SBAR
#undef WAIT_BAR
}

#define LAS __attribute__((address_space(3)))
typedef unsigned short bf16_t;
typedef float f32x4 __attribute__((ext_vector_type(4)));
typedef unsigned u32x4 __attribute__((ext_vector_type(4)));
typedef unsigned u32x2 __attribute__((ext_vector_type(2)));
typedef float f32x2 __attribute__((ext_vector_type(2)));
typedef _Float16 f16x8 __attribute__((ext_vector_type(8)));
typedef _Float16 f16x4 __attribute__((ext_vector_type(4)));

constexpr int NB = 2, S = 16384, T = NB * S, D = 1024, DEPTH = 4;
constexpr int EV_N = 3368, EV_NP = 3584, EV_ZP = 3072, OD_N = 2048;
constexpr float EPS = 1e-6f;
constexpr float LOG2E = 1.4426950408889634f;
constexpr float QSCALE = 0.125f * LOG2E;
constexpr int NWAVES = 8, NTHREADS = 512;
constexpr int LDS_BYTES = 163840;
constexpr int LDS_MISC = 131072;
constexpr int LDS_BARW = LDS_BYTES - 64;
constexpr int LDS_PTBL = LDS_BYTES - 512;

constexpr size_t MiB = 1u << 20;
constexpr size_t WS_CTL = 0, CTL_ZERO_BYTES = 1 * MiB;
constexpr size_t WS_MOD = 1 * MiB;
constexpr size_t WS_MODP = 1 * MiB + 256 * 1024;
constexpr size_t WS_ROPE = 2 * MiB;
constexpr size_t WS_S5A = 4 * MiB;
constexpr size_t WS_S5B = 4 * MiB + 64 * 1024;
constexpr size_t WS_LAM = 6 * MiB;
constexpr size_t WS_KM = 6 * MiB + 4096;
constexpr size_t WS_WRH = 6 * MiB + 512 * 1024;
constexpr size_t WS_KMH = 7 * MiB + 512 * 1024;
constexpr size_t WS_WEVIN = 8 * MiB;
constexpr size_t WS_WEVOUT = 22 * MiB;
constexpr size_t WS_WODIN = 26 * MiB;
constexpr size_t WS_WODOUT = 34 * MiB;
constexpr size_t WS_WGLU = 38 * MiB;
constexpr size_t WS_W13 = 40 * MiB;
constexpr size_t WS_W2 = 104 * MiB;
constexpr size_t WS_H = 136 * MiB;
constexpr size_t WS_O = 200 * MiB;
constexpr size_t WS_Z = 264 * MiB;
constexpr size_t WS_XG = 264 * MiB;
constexpr size_t WS_Y = 264 * MiB;
constexpr size_t WS_HID = 408 * MiB;
constexpr size_t WS_IQ = 456 * MiB;
constexpr size_t WS_YG = 456 * MiB;
constexpr size_t WS_IKW = 488 * MiB;
constexpr size_t WS_IQH = 496 * MiB;
constexpr size_t WS_IKH = 512 * MiB;
constexpr size_t WS_IW = 514 * MiB;
constexpr size_t WS_SEL = 516 * MiB;
constexpr size_t WS_YMIX = 548 * MiB;
constexpr size_t WS_LTOK = 612 * MiB;
constexpr size_t WS_TOKES = 616 * MiB;
constexpr size_t WS_TOKW = 617 * MiB;
constexpr size_t WS_TOKROW = 618 * MiB;
constexpr size_t WS_UG = 516 * MiB;
constexpr size_t WS_S5E = 496 * MiB;
constexpr size_t WS_S5HC = 488 * MiB;
constexpr size_t WS_S5KT = 620 * MiB;
constexpr size_t WS_S5WT = 624 * MiB;
constexpr size_t WS_S5A2 = 640 * MiB;
constexpr size_t WS_S5PW = 656 * MiB;
constexpr size_t WS_MLIST = 660 * MiB;
constexpr size_t WS_MPO = 724 * MiB;
constexpr size_t WS_MML = 852 * MiB;
constexpr size_t WS_MASKW = 724 * MiB;
constexpr size_t WS_NSEL = 860 * MiB;
constexpr size_t WS_XB = 862 * MiB;
constexpr size_t WS_END = 926 * MiB;
constexpr int XG_ROWS = 73728;
constexpr int CW_BAR = 4096;
constexpr int CW_MCNT = 16384;
constexpr int CW_CNT = 8192;

#define XB_TMO      128
#define XB_XCNT(j)  (256  + 64 * (j))
#define XB_XSUB(j)  (1280 + 64 * (j))
#define XB_XGEN(j)  (2304 + 64 * (j))
#define XB_TOP      3328
#define XB_TOPGEN   3392
#define XCD_BAR_WORDS 3456
#define XB_SPIN_CAP (1u << 24)

__device__ __forceinline__ unsigned xb_ld(unsigned* p)              { return __hip_atomic_load(p, __ATOMIC_RELAXED, __HIP_MEMORY_SCOPE_AGENT); }
__device__ __forceinline__ unsigned xb_add(unsigned* p, unsigned v) { return __hip_atomic_fetch_add(p, v, __ATOMIC_RELAXED, __HIP_MEMORY_SCOPE_AGENT); }
__device__ __forceinline__ unsigned xb_xcc_id() { return (unsigned)__builtin_amdgcn_s_getreg((3 << 11) | 20) & 0xFu; }
#define XB_SPIN(cond, bar) do { unsigned _sp = 0; while (cond) { __builtin_amdgcn_s_sleep(1); \
    if ((++_sp & 255u) == 0u) { if (xb_ld(&(bar)[XB_TMO])) break; if (_sp > XB_SPIN_CAP) { atomicAdd(&(bar)[XB_TMO], 1u); break; } } } } while (0)

struct XcdBarrier { unsigned* bar; unsigned x; volatile LAS unsigned* st; };

__device__ __forceinline__ XcdBarrier xcd_barrier_post(unsigned* bar, volatile LAS unsigned* st, bool leader) {
    XcdBarrier b; b.bar = bar; b.x = xb_xcc_id(); b.st = st;
    if (leader) (void)xb_add(&bar[XB_XCNT(b.x)], 1u);
    return b;
}
__device__ __forceinline__ void xcd_barrier_complete(unsigned* bar, unsigned x, unsigned& nloc, unsigned& nx) {
    const unsigned G = gridDim.x * gridDim.y * gridDim.z;
    unsigned sum, cnt, mine, sp = 0u;
    for (;;) {
        sum = 0u; cnt = 0u; mine = 0u;
#pragma unroll
        for (unsigned j = 0; j < 16; ++j) { const unsigned c = xb_ld(&bar[XB_XCNT(j)]); sum += c; cnt += (c > 0u) ? 1u : 0u; mine = (j == x) ? c : mine; }
        if (sum == G) break;
        __builtin_amdgcn_s_sleep(1);
        if ((++sp & 255u) == 0u) { if (xb_ld(&bar[XB_TMO])) break; if (sp > XB_SPIN_CAP) { atomicAdd(&bar[XB_TMO], 1u); break; } }
    }
    nloc = mine > 0u ? mine : 1u; nx = cnt > 0u ? cnt : 1u;
}
__device__ __forceinline__ void xcd_barrier(const XcdBarrier& b, bool leader) {
    asm volatile("s_waitcnt vmcnt(0)" ::: "memory");
    __syncthreads();
    if (leader) {
        unsigned* bar = b.bar;
        __builtin_amdgcn_s_waitcnt(0);
        unsigned nloc = b.st[0], nx = b.st[1];
        if (nloc == 0u) { xcd_barrier_complete(bar, b.x, nloc, nx); b.st[0] = nloc; b.st[1] = nx; }
        const unsigned old = xb_add(&bar[XB_XSUB(b.x)], 1u);
        const unsigned gen = old / nloc;
        if (old + 1u == (gen + 1u) * nloc) {
            __builtin_amdgcn_fence(__ATOMIC_RELEASE, "agent");
            asm volatile("s_waitcnt vmcnt(0)" ::: "memory");
            const unsigned og = xb_add(&bar[XB_TOP], 1u);
            const unsigned tg = og / nx;
            if (og + 1u == (tg + 1u) * nx) xb_add(&bar[XB_TOPGEN], 1u);
            else XB_SPIN(xb_ld(&bar[XB_TOPGEN]) == tg, bar);
            __builtin_amdgcn_fence(__ATOMIC_ACQUIRE, "agent");
            xb_add(&bar[XB_XGEN(b.x)], 1u);
            asm volatile("s_waitcnt vmcnt(0)" ::: "memory");
        } else {
            XB_SPIN(xb_ld(&bar[XB_XGEN(b.x)]) == gen, bar);
            __builtin_amdgcn_fence(__ATOMIC_ACQUIRE, "agent");
            asm volatile("s_waitcnt vmcnt(0)" ::: "memory");
        }
    }
    __syncthreads();
}

#define LDS_WAIT() asm volatile("s_waitcnt lgkmcnt(0)" ::: "memory")
__device__ __forceinline__ float bflo(unsigned w) { return __uint_as_float(w << 16); }
__device__ __forceinline__ float bfhi(unsigned w) { return __uint_as_float(w & 0xffff0000u); }
__device__ __forceinline__ unsigned pk2(float lo, float hi) { typedef float f32x2_ __attribute__((ext_vector_type(2))); typedef __bf16 bf16x2_ __attribute__((ext_vector_type(2))); const f32x2_ v = {lo, hi}; return __builtin_bit_cast(unsigned, __builtin_convertvector(v, bf16x2_)); }
__device__ __forceinline__ unsigned f2bf(float f) { return pk2(f, 0.f) & 0xffffu; }
__device__ __forceinline__ float shx_(float v, int m, int lane) { return __int_as_float(__builtin_amdgcn_ds_bpermute((lane ^ m) << 2, __float_as_int(v))); }
__device__ __forceinline__ unsigned shi_(unsigned v, int src) { return (unsigned)__builtin_amdgcn_ds_bpermute(src << 2, (int)v); }
#define SHX(v, m) shx_((v), (m), lane)
__device__ __forceinline__ float dpp_xor1(float v) { return __int_as_float(__builtin_amdgcn_update_dpp(0, __float_as_int(v), 0xB1, 0xF, 0xF, true)); }
__device__ __forceinline__ float dpp_xor2(float v) { return __int_as_float(__builtin_amdgcn_update_dpp(0, __float_as_int(v), 0x4E, 0xF, 0xF, true)); }
__device__ __forceinline__ float half_sum(float v) { const auto r = __builtin_amdgcn_permlane32_swap(__float_as_uint(v), __float_as_uint(v), false, false); return __uint_as_float(r[0]) + __uint_as_float(r[1]); }
__device__ __forceinline__ float half_max(float v) { const auto r = __builtin_amdgcn_permlane32_swap(__float_as_uint(v), __float_as_uint(v), false, false); return fmaxf(__uint_as_float(r[0]), __uint_as_float(r[1])); }
__device__ __forceinline__ float wave_sum_(float v, int lane) {
    v += dpp_xor1(v); v += dpp_xor2(v); v += shx_(v, 4, lane); v += shx_(v, 8, lane); v += shx_(v, 16, lane); return half_sum(v);
}

#define wave_sum(v) wave_sum_((v), lane)
__device__ __forceinline__ float wave_max_(float v, int lane) {
#pragma unroll
    for (int o = 1; o < 64; o <<= 1) v = fmaxf(v, shx_(v, o, lane));
    return v;
}
__device__ __forceinline__ bool qk_bounded(const float* gq, const float* gk, int lane) {
    const float a = wave_max_(fabsf(gq[lane]), lane), b = wave_max_(fabsf(gk[lane]), lane);
    return 64.0f * QSCALE * a * b <= 60.0f;
}
__device__ __forceinline__ void unpack8(const u32x4 w, float (&v)[8]) {
    v[0] = bflo(w.x); v[1] = bfhi(w.x); v[2] = bflo(w.y); v[3] = bfhi(w.y); v[4] = bflo(w.z); v[5] = bfhi(w.z); v[6] = bflo(w.w); v[7] = bfhi(w.w);
}
__device__ __forceinline__ u32x4 pack8(const float (&v)[8]) { u32x4 w; w.x = pk2(v[0], v[1]); w.y = pk2(v[2], v[3]); w.z = pk2(v[4], v[5]); w.w = pk2(v[6], v[7]); return w; }
__device__ __forceinline__ float gelu_tanh(float y) {
    const float z = 0.7978845608028654f * (y + 0.044715f * y * y * y);
    const float e = __builtin_amdgcn_exp2f(2.885390081777927f * z);
    const float th = 1.0f - 2.0f * __builtin_amdgcn_rcpf(e + 1.0f);
    return 0.5f * y * (1.0f + th);
}
__device__ __forceinline__ float sigmoidf_(float v) { return __builtin_amdgcn_rcpf(1.0f + __builtin_amdgcn_exp2f(-1.4426950408889634f * v)); }
__device__ __forceinline__ unsigned ordkey(float f) { const unsigned u = __float_as_uint(f); return u ^ ((unsigned)((int)u >> 31) | 0x80000000u); }

struct EpiPlain {
    static constexpr bool PERM = true, AFTER_DRAIN = false;
    bf16_t* O; int ldc;
    __device__ __forceinline__ void operator()(const pg8::f32x4 (&acc)[2][2][4][2], const pg8::Unit& u, int wr, int wc, int fr, int fq) const {
        const int row0 = u.pm * 256 + wr * 64 + fr, col0 = u.pn * 256 + wc * 32 + 8 * fq;
#pragma unroll
        for (int ai = 0; ai < 2; ++ai)
#pragma unroll
            for (int m = 0; m < 4; ++m) { bf16_t* rowp = O + (size_t)(row0 + ai * 128 + m * 16) * ldc + col0;
#pragma unroll
                for (int bj = 0; bj < 2; ++bj) { const pg8::f32x4 v0 = acc[ai][bj][m][0], v1 = acc[ai][bj][m][1];
                    u32x4 w; w.x = pk2(v0[0], v0[1]); w.y = pk2(v0[2], v0[3]); w.z = pk2(v1[0], v1[1]); w.w = pk2(v1[2], v1[3]);
                    *(u32x4*)(rowp + bj * 128) = w; } }
    }
};
__device__ __forceinline__ void epi_khead(const pg8::f32x4 (&acc)[2][2][4][2], bf16_t* Z, int ldz, int colbase, const float* gain, const float* COSH, const float* SINH, int row0, int wc, int fr, int fq) {
    const int lane = fr + 16 * fq;
    float g[2][8];
#pragma unroll
    for (int bj = 0; bj < 2; ++bj)
#pragma unroll
        for (int e = 0; e < 8; ++e) g[bj][e] = gain[bj * 32 + 8 * fq + e];
#pragma unroll
    for (int ai = 0; ai < 2; ++ai)
#pragma unroll
        for (int m = 0; m < 4; ++m) { const int row = row0 + ai * 128 + m * 16; const int pos = row & (S - 1);
            float v[2][8]; float ss = 0.f;
#pragma unroll
            for (int bj = 0; bj < 2; ++bj)
#pragma unroll
                for (int e = 0; e < 4; ++e) { v[bj][e] = acc[ai][bj][m][0][e]; v[bj][4 + e] = acc[ai][bj][m][1][e]; ss += v[bj][e] * v[bj][e] + v[bj][4 + e] * v[bj][4 + e]; }
            ss += shx_(ss, 16, lane); ss = half_sum(ss);
            const float r = rsqrtf(ss * (1.0f / 64.0f) + EPS);
#pragma unroll
            for (int bj = 0; bj < 2; ++bj)
#pragma unroll
                for (int e = 0; e < 8; ++e) v[bj][e] *= r * g[bj][e];
#pragma unroll
            for (int e = 0; e < 8; ++e) { const float oth = shx_(v[0][e], 16, lane); const float cs = COSH[pos * 8 + e], sn = SINH[pos * 8 + e];
                if (fq == 0) v[0][e] = v[0][e] * cs - oth * sn; else if (fq == 1) v[0][e] = v[0][e] * cs + oth * sn; }
            bf16_t* zp = Z + (size_t)row * ldz + colbase + wc * 64 + 8 * fq;
            *(u32x4*)zp = pack8(v[0]); *(u32x4*)(zp + 32) = pack8(v[1]); }
}
struct EpiEvenIn {
    static constexpr bool PERM = true, AFTER_DRAIN = false;
    bf16_t* Z; _Float16* IQH; _Float16* IKH; float* IW; const float* a_kn; const float* b_kn; const float* idx_kn; const float* COSH; const float* SINH; const float* COSI; const float* SINI;
    __device__ __forceinline__ void operator()(const pg8::f32x4 (&acc)[2][2][4][2], const pg8::Unit& u, int wr, int wc, int fr, int fq) const {
        const int row0 = u.pm * 256 + wr * 64 + fr; const int lane = fr + 16 * fq;
        if (u.pn == 2 || u.pn == 3) epi_khead(acc, Z, EV_ZP, 512 + (u.pn & 1) * 256, a_kn, COSH, SINH, row0, wc, fr, fq);
        else if (u.pn == 8 || u.pn == 9) epi_khead(acc, Z, EV_ZP, 2048 + (u.pn & 1) * 256, b_kn, COSH, SINH, row0, wc, fr, fq);
        else if (u.pn < 12) {
            const int col0 = u.pn * 256 + wc * 32 + 8 * fq;
#pragma unroll
            for (int ai = 0; ai < 2; ++ai)
#pragma unroll
                for (int m = 0; m < 4; ++m) { bf16_t* rowp = Z + (size_t)(row0 + ai * 128 + m * 16) * EV_ZP + col0;
#pragma unroll
                    for (int bj = 0; bj < 2; ++bj) { const pg8::f32x4 v0 = acc[ai][bj][m][0], v1 = acc[ai][bj][m][1];
                        u32x4 w; w.x = pk2(v0[0], v0[1]); w.y = pk2(v0[2], v0[3]); w.z = pk2(v1[0], v1[1]); w.w = pk2(v1[2], v1[3]);
                        *(u32x4*)(rowp + bj * 128) = w; } }
        } else if (u.pn == 12) {
#pragma unroll
            for (int ai = 0; ai < 2; ++ai)
#pragma unroll
                for (int m = 0; m < 4; ++m) { const int row = row0 + ai * 128 + m * 16; const int pos = row & (S - 1);
                    const f32x4 cs = *(const f32x4*)(COSI + pos * 4), sn = *(const f32x4*)(SINI + pos * 4);
#pragma unroll
                    for (int bj = 0; bj < 2; ++bj) { pg8::f32x4 v0 = acc[ai][bj][m][0], v1 = acc[ai][bj][m][1];
                        if (fq == 0) { const pg8::f32x4 a0 = v0, a1 = v1;
#pragma unroll
                            for (int e = 0; e < 4; ++e) { v0[e] = a0[e] * cs[e] - a1[e] * sn[e]; v1[e] = a1[e] * cs[e] + a0[e] * sn[e]; } }
                        f16x8 hq;
#pragma unroll
                        for (int e = 0; e < 4; ++e) { hq[e] = (_Float16)v0[e]; hq[4 + e] = (_Float16)v1[e]; }
                        *(f16x8*)(IQH + (size_t)row * 256 + bj * 128 + wc * 32 + 8 * fq) = hq; } }
        } else {
            if (wc == 0) {
                float g[8];
#pragma unroll
                for (int e = 0; e < 8; ++e) g[e] = idx_kn[8 * fq + e];
#pragma unroll
                for (int ai = 0; ai < 2; ++ai)
#pragma unroll
                    for (int m = 0; m < 4; ++m) { const int row = row0 + ai * 128 + m * 16; const int pos = row & (S - 1);
                        float v[8]; float ss = 0.f;
#pragma unroll
                        for (int e = 0; e < 4; ++e) { v[e] = acc[ai][0][m][0][e]; v[4 + e] = acc[ai][0][m][1][e]; ss += v[e] * v[e] + v[4 + e] * v[4 + e]; }
                        ss += shx_(ss, 16, lane); ss = half_sum(ss);
                        const float r = rsqrtf(ss * (1.0f / 32.0f) + EPS);
#pragma unroll
                        for (int e = 0; e < 8; ++e) v[e] *= r * g[e];
                        if (fq == 0) {
#pragma unroll
                            for (int e = 0; e < 4; ++e) { const float x1 = v[e], x2 = v[4 + e]; const float cs = COSI[pos * 4 + e], sn = SINI[pos * 4 + e]; v[e] = x1 * cs - x2 * sn; v[4 + e] = x2 * cs + x1 * sn; } }
                        f16x8 hk;
#pragma unroll
                        for (int e = 0; e < 8; ++e) hk[e] = (_Float16)v[e];
                        *(f16x8*)(IKH + (size_t)row * 32 + 8 * fq) = hk; }
            } else if (wc == 1 && fq == 0) {
#pragma unroll
                for (int ai = 0; ai < 2; ++ai)
#pragma unroll
                    for (int m = 0; m < 4; ++m) { float* wp = IW + (size_t)(row0 + ai * 128 + m * 16) * 8; *(pg8::f32x4*)wp = acc[ai][0][m][0]; *(pg8::f32x4*)(wp + 4) = acc[ai][0][m][1]; }
            }
        }
    }
};
struct EpiOddIn {
    static constexpr bool PERM = true, AFTER_DRAIN = false;
    bf16_t* Z; bf16_t* UG; const float* c_kn; const float* COSH; const float* SINH;
    __device__ __forceinline__ void operator()(const pg8::f32x4 (&acc)[2][2][4][2], const pg8::Unit& u, int wr, int wc, int fr, int fq) const {
        const int row0 = u.pm * 256 + wr * 64 + fr, col0 = u.pn * 256 + wc * 32 + 8 * fq;
        if (u.pn == 2 || u.pn == 3) { epi_khead(acc, Z, OD_N, 512 + (u.pn & 1) * 256, c_kn, COSH, SINH, row0, wc, fr, fq); return; }
#pragma unroll
        for (int ai = 0; ai < 2; ++ai)
#pragma unroll
            for (int m = 0; m < 4; ++m) { const size_t row = (size_t)(row0 + ai * 128 + m * 16);
#pragma unroll
                for (int bj = 0; bj < 2; ++bj) { const pg8::f32x4 v0 = acc[ai][bj][m][0], v1 = acc[ai][bj][m][1]; const int col = col0 + bj * 128;
                    u32x4 w; w.x = pk2(v0[0], v0[1]); w.y = pk2(v0[2], v0[3]); w.z = pk2(v1[0], v1[1]); w.w = pk2(v1[2], v1[3]);
                    if (u.pn < 6) *(u32x4*)(Z + row * OD_N + col) = w;
                    else { const int cu = col - 1536; *(u32x4*)(UG + ((size_t)(cu >> 4) * T + row) * 16 + (cu & 15)) = w; } } }
    }
};
__device__ __forceinline__ void load_q_normed(attn_body::bf16x8 (&qr)[4], const bf16_t* zrow, const float* gain, const float* COSH, const float* SINH, int pos, int hi, int lane) {
    float v[4][8]; float ss = 0.f;
#pragma unroll
    for (int d0 = 0; d0 < 4; ++d0) { unpack8(*(const u32x4*)(zrow + d0 * 16 + hi * 8), v[d0]);
#pragma unroll
        for (int e = 0; e < 8; ++e) ss += v[d0][e] * v[d0][e]; }
    ss = half_sum(ss);
    const float r = rsqrtf(ss * (1.0f / 64.0f) + EPS) * QSCALE;
#pragma unroll
    for (int d0 = 0; d0 < 4; ++d0)
#pragma unroll
        for (int e = 0; e < 8; ++e) v[d0][e] *= r * gain[d0 * 16 + hi * 8 + e];
#pragma unroll
    for (int e = 0; e < 8; ++e) { const float oth = shx_(v[0][e], 32, lane); const float cs = COSH[pos * 8 + e], sn = SINH[pos * 8 + e];
        v[0][e] = hi ? v[0][e] * cs + oth * sn : v[0][e] * cs - oth * sn; }
#pragma unroll
    for (int d0 = 0; d0 < 4; ++d0) qr[d0] = __builtin_bit_cast(attn_body::bf16x8, pack8(v[d0]));
}
struct EpiSwiGLU {
    static constexpr bool PERM = true, AFTER_DRAIN = false;
    bf16_t* HID;
    __device__ __forceinline__ void operator()(const pg8::f32x4 (&acc)[2][2][4][2], const pg8::Unit& u, int wr, int wc, int fr, int fq) const {
        const int row0 = u.pm * 256 + wr * 64 + fr, col0 = (u.pn * 256 + wc * 32 + 8 * fq) >> 1;
#pragma unroll
        for (int ai = 0; ai < 2; ++ai)
#pragma unroll
            for (int m = 0; m < 4; ++m) { bf16_t* rowp = HID + (size_t)(row0 + ai * 128 + m * 16) * 512 + col0;
#pragma unroll
                for (int bj = 0; bj < 2; ++bj) { const pg8::f32x4 v0 = acc[ai][bj][m][0], v1 = acc[ai][bj][m][1];
                    const float h0 = v0[0] * sigmoidf_(v0[0]) * v0[1], h1 = v0[2] * sigmoidf_(v0[2]) * v0[3];
                    const float h2 = v1[0] * sigmoidf_(v1[0]) * v1[1], h3 = v1[2] * sigmoidf_(v1[2]) * v1[3];
                    u32x2 w; w.x = pk2(h0, h1); w.y = pk2(h2, h3);
                    *(u32x2*)(rowp + bj * 64) = w; } }
    }
};
struct EpiGLU {
    static constexpr bool PERM = true, AFTER_DRAIN = false;
    bf16_t* O; const bf16_t* YG; const float* gb;
    __device__ __forceinline__ void operator()(const pg8::f32x4 (&acc)[2][2][4][2], const pg8::Unit& u, int wr, int wc, int fr, int fq) const {
        const int row0 = u.pm * 256 + wr * 64 + fr, col0 = u.pn * 256 + wc * 32 + 8 * fq;
#pragma unroll
        for (int ai = 0; ai < 2; ++ai)
#pragma unroll
            for (int bj = 0; bj < 2; ++bj) {
                const int c = col0 + bj * 128;
                u32x4 yr[4];
#pragma unroll
                for (int m = 0; m < 4; ++m) yr[m] = *(const u32x4*)(YG + (size_t)(row0 + ai * 128 + m * 16) * 512 + c);
                const pg8::f32x4 b0 = *(const pg8::f32x4*)(gb + c), b1 = *(const pg8::f32x4*)(gb + c + 4);
                __builtin_amdgcn_sched_barrier(0);
#pragma unroll
                for (int m = 0; m < 4; ++m) { const size_t row = (size_t)(row0 + ai * 128 + m * 16);
                    const pg8::f32x4 v0 = acc[ai][bj][m][0], v1 = acc[ai][bj][m][1];
                    float y[8]; unpack8(yr[m], y);
                    float o[8];
#pragma unroll
                    for (int j = 0; j < 4; ++j) { o[j] = y[j] * sigmoidf_(v0[j] + b0[j]); o[4 + j] = y[4 + j] * sigmoidf_(v1[j] + b1[j]); }
                    *(u32x4*)(O + row * 1024 + 512 + c) = pack8(o); }
                __builtin_amdgcn_sched_barrier(0);
            }
    }
};
struct MoeOrder {
    int nN, nunits, G, c; const LAS int* tile_e;
    __device__ __forceinline__ bool next(int i, pg8::Unit& u) const { const int L = i * G + c; if (L >= nunits) return false;
        int w = L; { const int q = nunits / 8, r = nunits % 8, xcd = w % 8, off = w / 8; w = (xcd < r ? xcd * (q + 1) : r * (q + 1) + (xcd - r) * q) + off; }
        u.pm = w / nN; u.pn = w % nN; u.be = tile_e[u.pm]; return true; }
    __device__ __forceinline__ void a_ready(const pg8::Unit&) const {}
    __device__ __forceinline__ void done(const pg8::Unit&) const {}
};

__device__ __forceinline__ int wt_row(int n, int row_mul, int row_add) {
    if (row_mul > 0) return n * row_mul + row_add;
    const int tile = n >> 8, w = n & 255;
    const bool ktile = (tile == 2 || tile == 3) || (row_mul == -1 && (tile == 8 || tile == 9));
    return ktile ? tile * 256 + ((w & 63) >> 5) * 128 + (w >> 6) * 32 + (w & 31) : n;
}
__device__ __forceinline__ void transpose_item(const float* W, int K, int N, bf16_t* WT, int row_mul, int row_add, LAS float* scr, int item, int nblk, int lane) {
    const int kb = item / nblk, nb = item % nblk, k0 = 64 * kb, n0 = 32 * nb;
    const int nn = n0 + (lane & 31);
    float tv[32];
#pragma unroll
    for (int i = 0; i < 32; ++i) { const int kk = 2 * i + (lane >> 5); tv[i] = (nn < N) ? W[(size_t)(k0 + kk) * N + nn] : 0.f; }
#pragma unroll
    for (int i = 0; i < 32; ++i) { const int kk = 2 * i + (lane >> 5); scr[kk * 33 + (lane & 31)] = tv[i]; }
    LDS_WAIT(); asm volatile("" ::: "memory");
    const int c = lane & 7;
#pragma unroll
    for (int j = 0; j < 4; ++j) { const int n = (lane >> 3) + 8 * j; const LAS float* s = scr + (8 * c) * 33 + n;
        u32x4 o; o.x = pk2(s[0 * 33], s[1 * 33]); o.y = pk2(s[2 * 33], s[3 * 33]); o.z = pk2(s[4 * 33], s[5 * 33]); o.w = pk2(s[6 * 33], s[7 * 33]);
        *(u32x4*)(WT + (size_t)wt_row(n0 + n, row_mul, row_add) * K + k0 + 8 * c) = o; }
    LDS_WAIT(); asm volatile("" ::: "memory");
}
__device__ __forceinline__ void norm_mod_row(const float* xrow, const float* sh, const float* sc, bf16_t* orow, int lane) {
    f32x4 v[4]; float ss = 0.f;
#pragma unroll
    for (int j = 0; j < 4; ++j) { v[j] = *(const f32x4*)(xrow + 4 * lane + 256 * j); ss += (v[j].x * v[j].x + v[j].y * v[j].y) + (v[j].z * v[j].z + v[j].w * v[j].w); }
    const float r = rsqrtf(wave_sum(ss) * (1.0f / 1024.0f) + EPS);
#pragma unroll
    for (int j = 0; j < 4; ++j) { const f32x4 a = *(const f32x4*)(sc + 4 * lane + 256 * j), b = *(const f32x4*)(sh + 4 * lane + 256 * j);
        u32x2 w; w.x = pk2(v[j].x * r * (1.f + a.x) + b.x, v[j].y * r * (1.f + a.y) + b.y); w.y = pk2(v[j].z * r * (1.f + a.z) + b.z, v[j].w * r * (1.f + a.w) + b.w);
        *(u32x2*)(orow + 4 * lane + 256 * j) = w; }
}

__device__ __forceinline__ void attn_key(const bf16_t* kp, const bf16_t* vp, const float (&q)[64], float& m, float& l, float (&o)[64]) {
    float s = 0.f;
#pragma unroll
    for (int i = 0; i < 8; ++i) { float kv[8]; unpack8(*(const u32x4*)(kp + 8 * i), kv);
#pragma unroll
        for (int j = 0; j < 8; ++j) s += q[8 * i + j] * kv[j]; }
    const float mn = fmaxf(m, s);
    const float f = __builtin_amdgcn_exp2f(m - mn), p = __builtin_amdgcn_exp2f(s - mn);
    l = l * f + p; m = mn;
#pragma unroll
    for (int i = 0; i < 8; ++i) { float vv[8]; unpack8(*(const u32x4*)(vp + 8 * i), vv);
#pragma unroll
        for (int j = 0; j < 8; ++j) o[8 * i + j] = o[8 * i + j] * f + p * vv[j]; }
}
__device__ __forceinline__ void load_q64(const bf16_t* qp, float scale, float (&q)[64]) {
#pragma unroll
    for (int i = 0; i < 8; ++i) { float t[8]; unpack8(*(const u32x4*)(qp + 8 * i), t);
#pragma unroll
        for (int j = 0; j < 8; ++j) q[8 * i + j] = t[j] * scale; }
}

struct Args { const void* in[37]; float* out; unsigned char* ws; int ph_lo, ph_hi, probe_var, pad; };
#ifndef PROBE_GEMM_REPS
#define PROBE_GEMM_REPS 1
#endif
#if PROBE_GEMM_REPS == 2
template <class Sc> struct Twice { Sc S; int n1;
    __device__ __forceinline__ bool next(int i, pg8::Unit& u) const { return i < n1 ? S.next(i, u) : S.next(i - n1, u); }
    __device__ __forceinline__ void a_ready(const pg8::Unit&) const {}
    __device__ __forceinline__ void done(const pg8::Unit&) const {} };
#define PROBE_SCHED(T) Twice<T>
#define PROBE_WRAP(T, v) Twice<T> PS_; PS_.S = v; { int n1_ = 0; pg8::Unit tu_; while (v.next(n1_, tu_)) ++n1_; PS_.n1 = n1_; }
#else
#define PROBE_SCHED(T) T
#define PROBE_WRAP(T, v) const T& PS_ = v
#endif
#ifdef PROBE_BAR2
#define PROBE_EXTRA_BAR(b) xcd_barrier(b, lsg(wid0) == 0 && lane_id_v() == 0);
#else
#define PROBE_EXTRA_BAR(b)
#endif
constexpr int N_PHASES = 3 + 2 * (8 + 10);

template <int NV, bool MASKED, bool CAUSAL, int PIN, int POUT, bool NOMAX = false>
__device__ __forceinline__ void flash_unit(LAS unsigned char* L0, const bf16_t* Qb, const bf16_t* Kb, const bf16_t* Vb, bf16_t* Ob, const unsigned* mbase, int qb, int wid, int lane, const float* qgain, const float* COSH, const float* SINH) {
    const int r32 = lane & 31, hi = lane >> 5;
    LAS unsigned char* ldsKs = L0; LAS unsigned char* ldsVs = L0 + 16384;
    LAS float* wsf = (LAS float*)(L0 + 16384 + NV * 16384 + wid * 256);
    LAS bf16_t* stg = (LAS bf16_t*)(L0 + 16384 + NV * 16384 + 2048 + wid * 4096);
    const int qrow = qb * 256 + wid * 32 + r32;
    attn_body::bf16x8 qr[4];
    load_q_normed(qr, Qb + (size_t)qrow * PIN, qgain, COSH, SINH, qrow, hi, lane);
    const int NT = 4 * (qb + 1);
    const bf16_t* kbp = Kb + (size_t)lane * PIN + wid * 8;
    const bf16_t* vbp = Vb + (size_t)(16 * (wid & 3) + (lane >> 2)) * PIN + (wid >> 2) * 32 + (lane & 3) * 8;
    const unsigned* mwp = MASKED ? mbase + (size_t)qrow * 2 + hi : nullptr;
    u32x4 kreg = *(const u32x4*)kbp, vreg[NV]; unsigned mw = 0u, mwn = 0u;
#pragma unroll
    for (int j = 0; j < NV; ++j) vreg[j] = *(const u32x4*)(vbp + j * 64);
    if (MASKED) mw = mwp[0];
    *(LAS u32x4*)(ldsKs + wid * 1024 + lane * 16) = kreg;
#pragma unroll
    for (int j = 0; j < NV; ++j) *(LAS u32x4*)(ldsVs + j * 16384 + wid * 1024 + lane * 16) = vreg[j];
    __syncthreads();
    float mhat = 0.f, lsum = 0.f;
    attn_body::f32x16 o[2 * NV], negm;
#pragma unroll
    for (int r = 0; r < 16; ++r) { negm[r] = 0.f;
#pragma unroll
        for (int j = 0; j < 2 * NV; ++j) o[j][r] = 0.f; }
    const int vb0 = (int)(unsigned)(unsigned long long)ldsVs + ((lane >> 4) & 1) * 32 + (lane & 3) * 8 + (4 * hi + ((lane & 15) >> 2)) * 64;
    for (int t = 0; t < NT; ++t) {
        const int slot = (t & 1) * 8192;
        if (t + 1 < NT) { kreg = *(const u32x4*)(kbp + (size_t)(t + 1) * 64 * PIN);
#pragma unroll
            for (int j = 0; j < NV; ++j) vreg[j] = *(const u32x4*)(vbp + (size_t)(t + 1) * 64 * PIN + j * 64);
            if (MASKED) mwn = mwp[(size_t)(t + 1) * S * 2]; }
        attn_body::f32x16 p0 = negm, p1 = negm;
        { const LAS unsigned char* kb = ldsKs + slot + hi * 1024 + r32 * 16;
#pragma unroll
          for (int d0 = 0; d0 < 4; ++d0) {
              const attn_body::bf16x8 b0 = *(const LAS attn_body::bf16x8*)(kb + d0 * 2048), b1 = *(const LAS attn_body::bf16x8*)(kb + d0 * 2048 + 512);
              p0 = __builtin_amdgcn_mfma_f32_32x32x16_bf16(b0, qr[d0], p0, 0, 0, 0);
              p1 = __builtin_amdgcn_mfma_f32_32x32x16_bf16(b1, qr[d0], p1, 0, 0, 0); } }
        if (CAUSAL) { const int jb = t - (NT - 4); if (jb >= 0) attn_body::cmask(p0, p1, jb, wid * 32 + r32, hi); }
        float rm = 0.f;
        if (!NOMAX) { rm = fmaxf(p0[0], p1[0]);
#pragma unroll
            for (int r = 1; r < 16; ++r) rm = fmaxf(rm, fmaxf(p0[r], p1[r]));
            rm = half_max(rm); }
        bool resc = false;
        if (!NOMAX && __any(rm > 8.0f)) {
            const float dl = fmaxf(rm, 0.f); mhat += dl;
#pragma unroll
            for (int r = 0; r < 16; ++r) { p0[r] -= dl; p1[r] -= dl; negm[r] = -mhat; }
            const float f = __builtin_amdgcn_exp2f(-dl); lsum *= f; if (hi == 0) wsf[r32] = f; resc = true;
        }
        const int wb = (int)mw; float ssum = 0.f;
#pragma unroll
        for (int r = 0; r < 16; ++r) {
            float e0 = __builtin_amdgcn_exp2f(p0[r]), e1 = __builtin_amdgcn_exp2f(p1[r]);
            if (MASKED) { e0 = __uint_as_float(__float_as_uint(e0) & (unsigned)__builtin_amdgcn_sbfe(wb, r, 1)); e1 = __uint_as_float(__float_as_uint(e1) & (unsigned)__builtin_amdgcn_sbfe(wb, 16 + r, 1)); }
            p0[r] = e0; p1[r] = e1; ssum += e0 + e1; }
        lsum += ssum;
        u32x4 pw0, pw1, pw2, pw3;
#pragma unroll
        for (int k = 0; k < 4; ++k) { pw0[k] = attn_body::cvtpk_s(p0[2 * k], p0[2 * k + 1]); pw1[k] = attn_body::cvtpk_s(p0[8 + 2 * k], p0[9 + 2 * k]);
            pw2[k] = attn_body::cvtpk_s(p1[2 * k], p1[2 * k + 1]); pw3[k] = attn_body::cvtpk_s(p1[8 + 2 * k], p1[9 + 2 * k]); }
        if (resc) { LDS_WAIT();
#pragma unroll
            for (int r = 0; r < 16; ++r) { const float f = wsf[attn_body::crow(r, hi)];
#pragma unroll
                for (int j = 0; j < 2 * NV; ++j) o[j][r] *= f; } }
#pragma unroll
        for (int j = 0; j < NV; ++j)
            attn_body::pv(o + 2 * j, vb0 + j * 16384 + slot, __builtin_bit_cast(attn_body::bf16x8, pw0), __builtin_bit_cast(attn_body::bf16x8, pw1), __builtin_bit_cast(attn_body::bf16x8, pw2), __builtin_bit_cast(attn_body::bf16x8, pw3));
        if (t + 1 < NT) { const int ns = ((t + 1) & 1) * 8192; *(LAS u32x4*)(ldsKs + ns + wid * 1024 + lane * 16) = kreg;
#pragma unroll
            for (int j = 0; j < NV; ++j) *(LAS u32x4*)(ldsVs + j * 16384 + ns + wid * 1024 + lane * 16) = vreg[j]; }
        mw = mwn;
        __syncthreads();
    }
    lsum += shx_(lsum, 32, lane);
    if (hi == 0) wsf[r32] = lsum;
    LDS_WAIT();
    float rl[16];
#pragma unroll
    for (int r = 0; r < 16; ++r) rl[r] = __builtin_amdgcn_rcpf(wsf[attn_body::crow(r, hi)]);
#pragma unroll
    for (int j = 0; j < NV; ++j) {
#pragma unroll
        for (int r = 0; r < 16; ++r) { const int orow = attn_body::crow(r, hi);
            stg[orow * 64 + r32] = (bf16_t)f2bf(o[2 * j][r] * rl[r]); stg[orow * 64 + 32 + r32] = (bf16_t)f2bf(o[2 * j + 1][r] * rl[r]); }
        LDS_WAIT();
#pragma unroll
        for (int q = 0; q < 4; ++q) { const int row = q * 8 + (lane >> 3), ch = lane & 7;
            *(u32x4*)(Ob + (size_t)(qb * 256 + wid * 32 + row) * POUT + j * 64 + ch * 8) = *(const LAS u32x4*)(stg + row * 64 + ch * 8); }
        LDS_WAIT();
    }
    __syncthreads();
}
template <int NV, bool MASKED, bool CAUSAL, int PIN, int POUT, bool NOMAX = false>
__device__ __forceinline__ void flash_unit_q2(LAS unsigned char* L0, const bf16_t* Qb, const bf16_t* Kb, const bf16_t* Vb, bf16_t* Ob, const unsigned* mbase, int qb, int wid, int lane, const float* qgain, const float* COSH, const float* SINH) {
    typedef __attribute__((address_space(3))) attn_body::v4i16_t* vtr_ptr;
    const int r32 = lane & 31, hi = lane >> 5;
    LAS unsigned char* ldsKs = L0; LAS unsigned char* ldsVs = L0 + 16384;
    LAS float* wsf = (LAS float*)(L0 + 16384 + NV * 16384 + wid * 512);
    LAS bf16_t* stg = (LAS bf16_t*)(L0 + 16384 + NV * 16384 + 4096 + wid * 4096);
    const int q0 = qb * 512 + wid * 64;
    attn_body::bf16x8 qr[2][4];
#pragma unroll
    for (int nq = 0; nq < 2; ++nq) load_q_normed(qr[nq], Qb + (size_t)(q0 + nq * 32 + r32) * PIN, qgain, COSH, SINH, q0 + nq * 32 + r32, hi, lane);
    const int NT = 8 * (qb + 1);
    const bf16_t* kbp = Kb + (size_t)lane * PIN + wid * 8;
    const bf16_t* vbp = Vb + (size_t)(16 * (wid & 3) + (lane >> 2)) * PIN + (wid >> 2) * 32 + (lane & 3) * 8;
    const unsigned* mwp = MASKED ? mbase + (size_t)(q0 + r32) * 2 + hi : nullptr;
    const int stoff = wid * 1024 + lane * 16;
    u32x4 kreg = *(const u32x4*)kbp, vreg[NV]; unsigned mw[2] = {0u, 0u}, mwn[2] = {0u, 0u};
#pragma unroll
    for (int j = 0; j < NV; ++j) vreg[j] = *(const u32x4*)(vbp + j * 64);
    if (MASKED) { mw[0] = mwp[0]; mw[1] = mwp[64]; }
    *(LAS u32x4*)(ldsKs + stoff) = kreg;
#pragma unroll
    for (int j = 0; j < NV; ++j) *(LAS u32x4*)(ldsVs + j * 16384 + stoff) = vreg[j];
    __syncthreads();
    float mhat[2] = {0.f, 0.f}, lsum[2] = {0.f, 0.f}; bool refmoved = false;
    attn_body::f32x16 o[2][2 * NV];
#pragma unroll
    for (int r = 0; r < 16; ++r)
#pragma unroll
        for (int j = 0; j < 2 * NV; ++j) { o[0][j][r] = 0.f; o[1][j][r] = 0.f; }
    const LAS unsigned char* kfb = ldsKs + hi * 1024 + r32 * 16;
    const LAS unsigned char* vfb = ldsVs + ((lane >> 4) & 1) * 32 + (lane & 3) * 8 + (4 * hi + ((lane & 15) >> 2)) * 64;
    for (int t = 0; t < NT; ++t) {
        const int slot = (t & 1) * 8192;
        if (t + 1 < NT) { kreg = *(const u32x4*)(kbp + (size_t)(t + 1) * 64 * PIN);
#pragma unroll
            for (int j = 0; j < NV; ++j) vreg[j] = *(const u32x4*)(vbp + (size_t)(t + 1) * 64 * PIN + j * 64);
            if (MASKED) { mwn[0] = mwp[(size_t)(t + 1) * S * 2]; mwn[1] = mwp[(size_t)(t + 1) * S * 2 + 64]; } }
#pragma unroll
        for (int kh = 0; kh < 2; ++kh) {
            attn_body::f32x16 p[2];
#pragma unroll
            for (int r = 0; r < 16; ++r) { p[0][r] = 0.f; p[1][r] = 0.f; }
#pragma unroll
            for (int d0 = 0; d0 < 4; ++d0) {
                const attn_body::bf16x8 kf = *(const LAS attn_body::bf16x8*)(kfb + slot + d0 * 2048 + kh * 512);
                p[0] = __builtin_amdgcn_mfma_f32_32x32x16_bf16(kf, qr[0][d0], p[0], 0, 0, 0);
                p[1] = __builtin_amdgcn_mfma_f32_32x32x16_bf16(kf, qr[1][d0], p[1], 0, 0, 0); }
            if (refmoved) {
#pragma unroll
                for (int nq = 0; nq < 2; ++nq)
#pragma unroll
                    for (int r = 0; r < 16; ++r) p[nq][r] -= mhat[nq]; }
            if (CAUSAL) { const int kbase = t * 64 + kh * 32;
                if (kbase + 31 > q0) {
#pragma unroll
                    for (int nq = 0; nq < 2; ++nq)
#pragma unroll
                        for (int r = 0; r < 16; ++r) if (kbase + attn_body::crow(r, hi) > q0 + nq * 32 + r32) p[nq][r] = -INFINITY; } }
            float rm[2] = {0.f, 0.f};
            if (!NOMAX)
#pragma unroll
            for (int nq = 0; nq < 2; ++nq) { float m_ = p[nq][0];
#pragma unroll
                for (int r = 1; r < 16; ++r) m_ = fmaxf(m_, p[nq][r]);
                rm[nq] = half_max(m_); }
            bool resc = false;
            if (!NOMAX && __any(fmaxf(rm[0], rm[1]) > 8.0f)) {
#pragma unroll
                for (int nq = 0; nq < 2; ++nq) { const float dl = fmaxf(rm[nq], 0.f); mhat[nq] += dl;
#pragma unroll
                    for (int r = 0; r < 16; ++r) p[nq][r] -= dl;
                    const float f = __builtin_amdgcn_exp2f(-dl); lsum[nq] *= f; if (hi == 0) wsf[nq * 32 + r32] = f; }
                resc = true; refmoved = true;
            }
            attn_body::bf16x8 pa[2][2];
#pragma unroll
            for (int nq = 0; nq < 2; ++nq) { const int wb = (int)mw[nq]; float ssum = 0.f;
#pragma unroll
                for (int r = 0; r < 16; ++r) { float e = __builtin_amdgcn_exp2f(p[nq][r]);
                    if (MASKED) e = __uint_as_float(__float_as_uint(e) & (unsigned)__builtin_amdgcn_sbfe(wb, kh * 16 + r, 1));
                    p[nq][r] = e; ssum += e; }
                lsum[nq] += ssum;
                u32x4 pw0, pw1;
#pragma unroll
                for (int k = 0; k < 4; ++k) { pw0[k] = attn_body::cvtpk_s(p[nq][2 * k], p[nq][2 * k + 1]); pw1[k] = attn_body::cvtpk_s(p[nq][8 + 2 * k], p[nq][9 + 2 * k]); }
                pa[nq][0] = __builtin_bit_cast(attn_body::bf16x8, pw0); pa[nq][1] = __builtin_bit_cast(attn_body::bf16x8, pw1); }
            if (resc) { LDS_WAIT();
#pragma unroll
                for (int nq = 0; nq < 2; ++nq)
#pragma unroll
                    for (int r = 0; r < 16; ++r) { const float f = wsf[nq * 32 + attn_body::crow(r, hi)];
#pragma unroll
                        for (int j = 0; j < 2 * NV; ++j) o[nq][j][r] *= f; } }
#pragma unroll
            for (int blk = 0; blk < 2 * NV; ++blk)
#pragma unroll
                for (int k2 = 0; k2 < 2; ++k2) {
                    const LAS unsigned char* vb = vfb + (blk >> 1) * 16384 + slot + (blk & 1) * 4096 + (kh * 2 + k2) * 1024;
                    const attn_body::s16x4 lo_ = __builtin_bit_cast(attn_body::s16x4, __builtin_amdgcn_ds_read_tr16_b64_v4i16((vtr_ptr)vb)), hi_ = __builtin_bit_cast(attn_body::s16x4, __builtin_amdgcn_ds_read_tr16_b64_v4i16((vtr_ptr)(vb + 512)));
                    const attn_body::bf16x8 vf = (attn_body::bf16x8){lo_[0], lo_[1], lo_[2], lo_[3], hi_[0], hi_[1], hi_[2], hi_[3]};
                    o[0][blk] = __builtin_amdgcn_mfma_f32_32x32x16_bf16(pa[0][k2], vf, o[0][blk], 0, 0, 0);
                    o[1][blk] = __builtin_amdgcn_mfma_f32_32x32x16_bf16(pa[1][k2], vf, o[1][blk], 0, 0, 0); }
        }
        if (t + 1 < NT) { const int ns = 8192 - slot; *(LAS u32x4*)(ldsKs + ns + stoff) = kreg;
#pragma unroll
            for (int j = 0; j < NV; ++j) *(LAS u32x4*)(ldsVs + j * 16384 + ns + stoff) = vreg[j]; }
        mw[0] = mwn[0]; mw[1] = mwn[1];
        __syncthreads();
    }
#pragma unroll
    for (int nq = 0; nq < 2; ++nq) { lsum[nq] += shx_(lsum[nq], 32, lane); if (hi == 0) wsf[nq * 32 + r32] = lsum[nq]; }
    LDS_WAIT();
#pragma unroll
    for (int nq = 0; nq < 2; ++nq)
#pragma unroll
      for (int j = 0; j < NV; ++j) {
#pragma unroll
        for (int r = 0; r < 16; ++r) { const int orow = attn_body::crow(r, hi); const float rl = __builtin_amdgcn_rcpf(wsf[nq * 32 + orow]);
            stg[orow * 64 + r32] = (bf16_t)f2bf(o[nq][2 * j][r] * rl); stg[orow * 64 + 32 + r32] = (bf16_t)f2bf(o[nq][2 * j + 1][r] * rl); }
        LDS_WAIT();
#pragma unroll
        for (int q = 0; q < 4; ++q) { const int row = q * 8 + (lane >> 3), ch = lane & 7;
            *(u32x4*)(Ob + (size_t)(q0 + nq * 32 + row) * POUT + j * 64 + ch * 8) = *(const LAS u32x4*)(stg + row * 64 + ch * 8); }
        LDS_WAIT();
      }
    __syncthreads();
}
struct MoeRows {
    static constexpr bool GATHER = true;
    const LAS int* rb; const int* LTOK;
    __device__ __forceinline__ unsigned operator()(const pg8::Unit& u, int r) const { const int e = u.be; const int slot = u.pm * 256 + r - rb[e];
        const int tok = slot < rb[32 + e] ? LTOK[e * 32768 + slot] : 0; return (unsigned)tok * 2048u; }
};
__device__ __forceinline__ void moe_convert(const float* w1, const float* w3, const float* w2, bf16_t* W13, bf16_t* W2, LAS float* scr, int gw, int NGW, int lane) {
    for (int it = gw; it < 32 * 768; it += NGW) {
        const int e = it / 768; int r = it % 768;
        if (r < 256) { transpose_item(w1 + (size_t)e * 1024 * 512, 1024, 512, W13 + (size_t)e * 1024 * 1024, 2, 0, scr, r, 16, lane); continue; } r -= 256;
        if (r < 256) { transpose_item(w3 + (size_t)e * 1024 * 512, 1024, 512, W13 + (size_t)e * 1024 * 1024, 2, 1, scr, r, 16, lane); continue; } r -= 256;
        transpose_item(w2 + (size_t)e * 512 * 1024, 512, 1024, W2 + (size_t)e * 1024 * 512, 1, 0, scr, r, 32, lane);
    }
}
__device__ __forceinline__ void moe_tables(unsigned* ctl, int l, LAS int* tile_e, LAS int* rb, LAS int* nt_p, int tid) {
    if (tid < 64) {
        const int ln = tid;
        const int cnt = ln < 32 ? (int)__hip_atomic_load(ctl + CW_CNT + (l * 32 + (ln & 31)) * 64, __ATOMIC_RELAXED, __HIP_MEMORY_SCOPE_AGENT) : 0;
        const int ntile = (cnt + 255) >> 8;
        int inc = ntile;
#pragma unroll
        for (int off = 1; off < 32; off <<= 1) { const int v = (int)shi_((unsigned)inc, ln - off); if (ln >= off) inc += v; }
        if (ln < 32) { rb[ln] = (inc - ntile) * 256; rb[32 + ln] = cnt; }
        if (ln == 31) nt_p[0] = inc;
    }
    __syncthreads();
    const int nt = nt_p[0];
    for (int t = tid; t < nt; t += NTHREADS) {
        int lo = 0, hi = 31;
        while (lo < hi) { const int mid = (lo + hi + 1) >> 1; if (rb[mid] <= t * 256) lo = mid; else hi = mid - 1; }
        tile_e[t] = lo;
    }
    __syncthreads();
}

template <bool FIRST>
__device__ __forceinline__ float f_pass1(const float* __restrict__ xs_row, bf16_t* __restrict__ xb_row, const bf16_t* __restrict__ y_row, const LAS float* gate, const int kc) {
    float ss = 0.f;
#pragma unroll 1
    for (int s0 = 0; s0 < 32; s0 += 8) {
        u32x4 xr[8], yr[8]; f32x4 xa[8], xc[8];
#pragma unroll
        for (int k = 0; k < 8; ++k) { const int col = 32 * (s0 + k) + 8 * kc;
            if constexpr (FIRST) { xa[k] = *(const f32x4*)(xs_row + col); xc[k] = *(const f32x4*)(xs_row + col + 4); } else xr[k] = *(const u32x4*)(xb_row + col);
            yr[k] = *(const u32x4*)(y_row + col); }
        __builtin_amdgcn_sched_barrier(0);
#pragma unroll
        for (int k = 0; k < 8; ++k) { const int col = 32 * (s0 + k) + 8 * kc;
            f32x4 x0, x1;
            if constexpr (FIRST) { x0 = xa[k]; x1 = xc[k]; }
            else { float xv_[8]; unpack8(xr[k], xv_); x0 = (f32x4){xv_[0], xv_[1], xv_[2], xv_[3]}; x1 = (f32x4){xv_[4], xv_[5], xv_[6], xv_[7]}; }
            float yv[8]; unpack8(yr[k], yv);
            const f32x4 g0 = *(const LAS f32x4*)(gate + col), g1 = *(const LAS f32x4*)(gate + col + 4);
            float nv_[8] = {x0.x + g0.x * yv[0], x0.y + g0.y * yv[1], x0.z + g0.z * yv[2], x0.w + g0.w * yv[3], x1.x + g1.x * yv[4], x1.y + g1.y * yv[5], x1.z + g1.z * yv[6], x1.w + g1.w * yv[7]};
            const u32x4 xw = pack8(nv_); *(u32x4*)(xb_row + col) = xw;
            float rv_[8]; unpack8(xw, rv_);
#pragma unroll
            for (int e = 0; e < 8; ++e) ss += rv_[e] * rv_[e]; }
        __builtin_amdgcn_sched_barrier(0);
    }
    return ss;
}
__device__ __forceinline__ void f_pass2(const bf16_t* __restrict__ xb_row, bf16_t* __restrict__ h_row, const LAS float* modl, const bf16_t* __restrict__ wh, const bf16_t* __restrict__ wl, const float rn, const int kc, f32x4 (&acc)[3]) {
#pragma unroll 1
    for (int s0 = 0; s0 < 32; s0 += 4) {
        u32x4 xr[4]; pg8::bf16x8 bh[4][3], bl[4][3];
#pragma unroll
        for (int k = 0; k < 4; ++k) { const int col = 32 * (s0 + k) + 8 * kc; xr[k] = *(const u32x4*)(xb_row + col);
#pragma unroll
            for (int ct = 0; ct < 3; ++ct) { bh[k][ct] = *(const pg8::bf16x8*)(wh + (size_t)ct * 16 * 1024 + 32 * (s0 + k)); bl[k][ct] = *(const pg8::bf16x8*)(wl + (size_t)ct * 16 * 1024 + 32 * (s0 + k)); } }
        __builtin_amdgcn_sched_barrier(0);
#pragma unroll
        for (int k = 0; k < 4; ++k) { const int col = 32 * (s0 + k) + 8 * kc;
            f32x4 x0, x1; { float xv_[8]; unpack8(xr[k], xv_); x0 = (f32x4){xv_[0], xv_[1], xv_[2], xv_[3]}; x1 = (f32x4){xv_[4], xv_[5], xv_[6], xv_[7]}; }
            const f32x4 c0 = *(const LAS f32x4*)(modl + 2048 + col), c1 = *(const LAS f32x4*)(modl + 2048 + col + 4), s0_ = *(const LAS f32x4*)(modl + 1024 + col), s1_ = *(const LAS f32x4*)(modl + 1024 + col + 4);
            float hv[8];
            hv[0] = x0.x * rn * (1.f + c0.x) + s0_.x; hv[1] = x0.y * rn * (1.f + c0.y) + s0_.y; hv[2] = x0.z * rn * (1.f + c0.z) + s0_.z; hv[3] = x0.w * rn * (1.f + c0.w) + s0_.w;
            hv[4] = x1.x * rn * (1.f + c1.x) + s1_.x; hv[5] = x1.y * rn * (1.f + c1.y) + s1_.y; hv[6] = x1.z * rn * (1.f + c1.z) + s1_.z; hv[7] = x1.w * rn * (1.f + c1.w) + s1_.w;
            const u32x4 hh = pack8(hv);
            *(u32x4*)(h_row + col) = hh;
            float hl[8]; { float hf[8]; unpack8(hh, hf);
#pragma unroll
                for (int e = 0; e < 8; ++e) hl[e] = hv[e] - hf[e]; }
            const u32x4 hlw = pack8(hl);
            const pg8::bf16x8 ah = __builtin_bit_cast(pg8::bf16x8, hh), al = __builtin_bit_cast(pg8::bf16x8, hlw);
#pragma unroll
            for (int ct = 0; ct < 3; ++ct) {
                acc[ct] = __builtin_amdgcn_mfma_f32_16x16x32_bf16(ah, bh[k][ct], acc[ct], 0, 0, 0);
                acc[ct] = __builtin_amdgcn_mfma_f32_16x16x32_bf16(ah, bl[k][ct], acc[ct], 0, 0, 0);
                acc[ct] = __builtin_amdgcn_mfma_f32_16x16x32_bf16(al, bh[k][ct], acc[ct], 0, 0, 0);
            } }
        __builtin_amdgcn_sched_barrier(0);
    }
}

__device__ __forceinline__ int lane_id_v() { int v; asm volatile("v_mbcnt_lo_u32_b32 %0, -1, 0\n\tv_mbcnt_hi_u32_b32 %0, -1, %0" : "=v"(v)); return v; }
__device__ __forceinline__ unsigned long long lsg64(unsigned long long v) { asm volatile("" : "+s"(v)); return v; }
__device__ __forceinline__ int lsg(int v) { asm volatile("" : "+s"(v)); return v; }
__device__ __forceinline__ int lvg(int v) { asm volatile("" : "+v"(v)); return v; }
__device__ __forceinline__ LAS unsigned char* lsgp(LAS unsigned char* p) { unsigned v = (unsigned)(unsigned long long)p; asm volatile("" : "+s"(v)); return (LAS unsigned char*)(unsigned long long)v; }
__device__ __forceinline__ void* ldptr(const LAS unsigned long long* tbl, int k) {
    const unsigned long long v = tbl[k];
    const unsigned lo = __builtin_amdgcn_readfirstlane((unsigned)v), hi = __builtin_amdgcn_readfirstlane((unsigned)(v >> 32));
    return (void*)(__attribute__((address_space(1))) void*)(((unsigned long long)hi << 32) | lo);
}
#define DECL_PTRS() \
    const int wid = lsg(wid0), lane = lane_id_v(), tid = wid * 64 + lane; \
    const int G = lsg(G0), c = lsg(c0), l = lsg(l0), i = l >> 1; \
    const int gw = c * NWAVES + wid, NGW = G * NWAVES, gt = c * NTHREADS + tid, NGT = G * NTHREADS; \
    LAS unsigned char* lds = (LAS unsigned char*)lsgp(lds0); LAS unsigned char* glds = lds; LAS float* scr = (LAS float*)(lds + wid * 16384); \
    const LAS unsigned long long* ptbl = (const LAS unsigned long long*)(lds + LDS_PTBL); \
    unsigned char* ws = (unsigned char*)ldptr(ptbl, 38); unsigned* ctl = (unsigned*)(ws + WS_CTL); \
    const float* xin = (const float*)ldptr(ptbl, 0); \
    const float* cin = (const float*)ldptr(ptbl, 1); \
    const float* ada_w = (const float*)ldptr(ptbl, 2); \
    const float* ada_b = (const float*)ldptr(ptbl, 3); \
    const float* moe_wg = (const float*)ldptr(ptbl, 4); \
    const float* moe_bg = (const float*)ldptr(ptbl, 5); \
    const float* moe_we = (const float*)ldptr(ptbl, 6); \
    const float* moe_be = (const float*)ldptr(ptbl, 7); \
    const float* moe_w1 = (const float*)ldptr(ptbl, 8); \
    const float* moe_w3 = (const float*)ldptr(ptbl, 9); \
    const float* moe_w2 = (const float*)ldptr(ptbl, 10); \
    const float* ev_w_in = (const float*)ldptr(ptbl, 11); \
    const float* ev_w_out = (const float*)ldptr(ptbl, 12); \
    const float* a_qn = (const float*)ldptr(ptbl, 13); \
    const float* a_kn = (const float*)ldptr(ptbl, 14); \
    const float* a_lq1 = (const float*)ldptr(ptbl, 15); \
    const float* a_lk1 = (const float*)ldptr(ptbl, 16); \
    const float* a_lq2 = (const float*)ldptr(ptbl, 17); \
    const float* a_lk2 = (const float*)ldptr(ptbl, 18); \
    const float* a_subln = (const float*)ldptr(ptbl, 19); \
    const float* b_qn = (const float*)ldptr(ptbl, 20); \
    const float* b_kn = (const float*)ldptr(ptbl, 21); \
    const float* b_idx_kn = (const float*)ldptr(ptbl, 22); \
    const float* od_w_in = (const float*)ldptr(ptbl, 23); \
    const float* od_w_out = (const float*)ldptr(ptbl, 24); \
    const float* c_qn = (const float*)ldptr(ptbl, 25); \
    const float* c_kn = (const float*)ldptr(ptbl, 26); \
    const float* s5_lam_re = (const float*)ldptr(ptbl, 27); \
    const float* s5_lam_im = (const float*)ldptr(ptbl, 28); \
    const float* s5_b_re = (const float*)ldptr(ptbl, 29); \
    const float* s5_b_im = (const float*)ldptr(ptbl, 30); \
    const float* s5_c_re = (const float*)ldptr(ptbl, 31); \
    const float* s5_c_im = (const float*)ldptr(ptbl, 32); \
    const float* s5_d = (const float*)ldptr(ptbl, 33); \
    const float* s5_log_dt = (const float*)ldptr(ptbl, 34); \
    const float* s5_glu_w = (const float*)ldptr(ptbl, 35); \
    const float* s5_glu_b = (const float*)ldptr(ptbl, 36); \
    float* out = (float*)ldptr(ptbl, 37); \
    float* MOD = (float*)(ws + WS_MOD); \
    float* MODP = (float*)(ws + WS_MODP); \
    float* COSH = (float*)(ws + WS_ROPE); \
    float* SINH = COSH + S * 8; \
    float* COSI = SINH + S * 8; \
    float* SINI = COSI + S * 4; \
    float* S5A = (float*)(ws + WS_S5A); \
    float* S5B = (float*)(ws + WS_S5B); \
    float* LAM = (float*)(ws + WS_LAM); \
    float* KM = (float*)(ws + WS_KM); \
    bf16_t* KMH = (bf16_t*)(ws + WS_KMH); \
    bf16_t* WRH = (bf16_t*)(ws + WS_WRH); \
    bf16_t* WRL = (bf16_t*)(ws + WS_WRH + 393216); \
    bf16_t* KML = (bf16_t*)(ws + WS_KMH + 131072); \
    bf16_t* Wevin = (bf16_t*)(ws + WS_WEVIN); \
    bf16_t* Wevout = (bf16_t*)(ws + WS_WEVOUT); \
    bf16_t* Wodin = (bf16_t*)(ws + WS_WODIN); \
    bf16_t* Wodout = (bf16_t*)(ws + WS_WODOUT); \
    bf16_t* Wglu = (bf16_t*)(ws + WS_WGLU); \
    bf16_t* W13 = (bf16_t*)(ws + WS_W13); \
    bf16_t* W2 = (bf16_t*)(ws + WS_W2); \
    bf16_t* H = (bf16_t*)(ws + WS_H); \
    bf16_t* O = (bf16_t*)(ws + WS_O); \
    bf16_t* Z = (bf16_t*)(ws + WS_Z); \
    bf16_t* XG = (bf16_t*)(ws + WS_XG); \
    bf16_t* Y = (bf16_t*)(ws + WS_Y); \
    bf16_t* HID = (bf16_t*)(ws + WS_HID); \
    float* IQ = (float*)(ws + WS_IQ); \
    bf16_t* YG = (bf16_t*)(ws + WS_YG); \
    float* IKW = (float*)(ws + WS_IKW); \
    _Float16* IQH = (_Float16*)(ws + WS_IQH); \
    _Float16* IKH = (_Float16*)(ws + WS_IKH); \
    float* IW = (float*)(ws + WS_IW); \
    int* SEL = (int*)(ws + WS_SEL); \
    bf16_t* YMIX = (bf16_t*)(ws + WS_YMIX); \
    int* TOKES = (int*)(ws + WS_TOKES); \
    int* LTOK = (int*)(ws + WS_LTOK); \
    float* TOKW = (float*)(ws + WS_TOKW); \
    int* TOKROW = (int*)(ws + WS_TOKROW); \
    bf16_t* UG = (bf16_t*)(ws + WS_UG); \
    float* S5E = (float*)(ws + WS_S5E); \
    bf16_t* S5HC = (bf16_t*)(ws + WS_S5HC); \
    bf16_t* S5KT = (bf16_t*)(ws + WS_S5KT); \
    bf16_t* S5WT = (bf16_t*)(ws + WS_S5WT); \
    bf16_t* S5A2 = (bf16_t*)(ws + WS_S5A2); \
    float* S5PW = (float*)(ws + WS_S5PW); \
    int* MLIST = (int*)(ws + WS_MLIST); \
    bf16_t* MPO = (bf16_t*)(ws + WS_MPO); \
    float* MML = (float*)(ws + WS_MML); \
    int* NSEL = (int*)(ws + WS_NSEL); \
    unsigned* MASKW = (unsigned*)(ws + WS_MASKW); \
    bf16_t* XB = (bf16_t*)(ws + WS_XB);
__global__ void __launch_bounds__(NTHREADS, 2) fwd(Args a) {
    extern __shared__ __attribute__((aligned(16))) unsigned char lds_raw[];
    LAS unsigned char* lds = (LAS unsigned char*)lds_raw;
    const int tid0 = threadIdx.x; const int wid0 = __builtin_amdgcn_readfirstlane(tid0 >> 6);
    const int G0 = gridDim.x, c0 = blockIdx.x;
    unsigned* ctl0 = (unsigned*)(a.ws + WS_CTL);
    LAS unsigned char* lds0 = lds;
    const int lo = a.ph_lo, hi = a.ph_hi;

    LAS unsigned long long* ptbl = (LAS unsigned long long*)(lds + LDS_PTBL);
    if (tid0 == 0) {
#define PT_(k) ptbl[k] = (unsigned long long)a.in[k];
        PT_(0) PT_(1) PT_(2) PT_(3) PT_(4) PT_(5) PT_(6) PT_(7) PT_(8) PT_(9) PT_(10) PT_(11) PT_(12) PT_(13) PT_(14) PT_(15) PT_(16) PT_(17) PT_(18)
        PT_(19) PT_(20) PT_(21) PT_(22) PT_(23) PT_(24) PT_(25) PT_(26) PT_(27) PT_(28) PT_(29) PT_(30) PT_(31) PT_(32) PT_(33) PT_(34) PT_(35) PT_(36)
#undef PT_
        ptbl[37] = (unsigned long long)a.out; ptbl[38] = (unsigned long long)a.ws;
    }
    if (tid0 < 4) ((LAS unsigned*)(lds + LDS_BARW))[tid0] = 0u;
    __syncthreads();
    XcdBarrier bar; bar.bar = ctl0 + CW_BAR; bar.x = 0; bar.st = (volatile LAS unsigned*)(lds + LDS_BARW);
    if (hi - lo > 1) bar = xcd_barrier_post(ctl0 + CW_BAR, (volatile LAS unsigned*)(lds + LDS_BARW), tid0 == 0);
    int ph = 0, l0 = 0;
#define PH_ON() (ph >= lo && ph < hi)
#define PH_END() do { if (ph >= lo && ph + 1 < hi) { XcdBarrier bb_; bb_.bar = (unsigned*)lsg64((unsigned long long)bar.bar); bb_.x = bar.x; bb_.st = bar.st; xcd_barrier(bb_, lsg(wid0) == 0 && lane_id_v() == 0); PROBE_EXTRA_BAR(bb_) } ++ph; } while (0)

    if (PH_ON()) { DECL_PTRS();
        {
            constexpr int I_EVIN = 16 * 112, I_SQ = 16 * 32, I_ODIN = 16 * 64, I_GLU = 8 * 16;
            constexpr int I_PER = I_EVIN + I_SQ + I_ODIN + I_SQ + I_GLU;
            for (int it = gw; it < 2 * I_PER; it += NGW) {
                const int i = it / I_PER; int r = it % I_PER;
                if (r < I_EVIN) { transpose_item(ev_w_in + (size_t)i * 1024 * EV_N, 1024, EV_N, Wevin + (size_t)i * EV_NP * 1024, -1, 0, scr, r, 112, lane); continue; } r -= I_EVIN;
                if (r < I_SQ) { transpose_item(ev_w_out + (size_t)i * 1024 * 1024, 1024, 1024, Wevout + (size_t)i * 1024 * 1024, 1, 0, scr, r, 32, lane); continue; } r -= I_SQ;
                if (r < I_ODIN) { transpose_item(od_w_in + (size_t)i * 1024 * 2048, 1024, 2048, Wodin + (size_t)i * 2048 * 1024, -2, 0, scr, r, 64, lane); continue; } r -= I_ODIN;
                if (r < I_SQ) { transpose_item(od_w_out + (size_t)i * 1024 * 1024, 1024, 1024, Wodout + (size_t)i * 1024 * 1024, 1, 0, scr, r, 32, lane); continue; } r -= I_SQ;
                transpose_item(s5_glu_w + (size_t)i * 512 * 512, 512, 512, Wglu + (size_t)i * 512 * 512, 1, 0, scr, r, 16, lane);
            }
        }
        __syncthreads();
        {
            LAS float* cact = (LAS float*)lds;
            for (int i = tid; i < 2048; i += NTHREADS) { const float v = cin[i]; cact[i] = v / (1.0f + __expf(-v)); }
            __syncthreads();
            for (int idx = gt; idx < 4 * 4 * 6144; idx += NGT) {
                const int kq = idx / 24576, rem = idx % 24576, l = rem / 6144, n = rem % 6144;
                const float* w = ada_w + ((size_t)l * 1024 + kq * 256) * 6144 + n;
                float a0 = 0.f, a1 = 0.f;
#pragma unroll 32
                for (int k = 0; k < 256; ++k) { const float wv = w[(size_t)k * 6144]; a0 += cact[kq * 256 + k] * wv; a1 += cact[1024 + kq * 256 + k] * wv; }
                MODP[((size_t)(kq * 4 + l) * 2 + 0) * 6144 + n] = a0;
                MODP[((size_t)(kq * 4 + l) * 2 + 1) * 6144 + n] = a1;
            }
            __syncthreads();
        }
        for (int idx = gt; idx < S * 12; idx += NGT) {
            if (idx < S * 8) { const int pos = idx >> 3, j = idx & 7; const float inv = (float)pow(500000.0, -(double)(2 * j) / 16.0); const float ang = (float)pos * inv;
                COSH[idx] = (float)cos((double)ang); SINH[idx] = (float)sin((double)ang); }
            else { const int k = idx - S * 8; const int pos = k >> 2, j = k & 3; const float inv = (float)pow(500000.0, -(double)(2 * j) / 8.0); const float ang = (float)pos * inv;
                COSI[k] = (float)cos((double)ang); SINI[k] = (float)sin((double)ang); }
        }
        for (int idx = gt; idx < 2 * 32 * 64; idx += NGT) {
            const int i = idx >> 11, g = (idx >> 6) & 31;
            const float dt = expf(s5_log_dt[i * 32 + g]);
            const float lr = s5_lam_re[idx], li = s5_lam_im[idx];
            const float mag = expf(lr * dt);
            const float ar = mag * (float)cos((double)(li * dt)), ai = mag * (float)sin((double)(li * dt));
            const float den = lr * lr + li * li;
            const float cr = ((ar - 1.0f) * lr + ai * li) / den, ci = (ai * lr - (ar - 1.0f) * li) / den;
            S5A[idx * 2] = ar; S5A[idx * 2 + 1] = ai;
            { float pr = 1.f, pi_ = 0.f; for (int n = 0; n <= 64; ++n) { S5PW[((size_t)idx * 65 + n) * 2] = pr; S5PW[((size_t)idx * 65 + n) * 2 + 1] = pi_; const float nr = pr * ar - pi_ * ai, ni = pr * ai + pi_ * ar; pr = nr; pi_ = ni; } }
            { float brv[16], biv[16];
#pragma unroll
              for (int cc = 0; cc < 16; ++cc) { brv[cc] = s5_b_re[(size_t)idx * 16 + cc]; biv[cc] = s5_b_im[(size_t)idx * 16 + cc]; }
              __builtin_amdgcn_sched_barrier(0);
#pragma unroll
              for (int cc = 0; cc < 16; ++cc) { const float br = brv[cc], bi = biv[cc];
                  *(f32x2*)(S5B + ((size_t)idx * 16 + cc) * 2) = (f32x2){cr * br - ci * bi, cr * bi + ci * br}; } }
        }
        for (int idx = gt; idx < DEPTH * 48 * 1024; idx += NGT) {
            const int k = idx & 1023, col = (idx >> 10) % 48, ll = idx / (48 * 1024);
            const float w = col < 4 ? moe_wg[((size_t)ll * 1024 + k) * 4 + col] : col < 36 ? moe_we[((size_t)ll * 1024 + k) * 32 + col - 4] : 0.f;
            const unsigned hb = f2bf(w); WRH[idx] = (bf16_t)hb; WRL[idx] = (bf16_t)f2bf(w - __uint_as_float(hb << 16));
        }
        if (gw < 2) { const int i = gw;
            const float s1 = wave_sum(a_lq1[i * 64 + lane] * a_lk1[i * 64 + lane]), s2 = wave_sum(a_lq2[i * 64 + lane] * a_lk2[i * 64 + lane]);
            const float lam_init = 0.8f - 0.6f * expf(-0.3f * (float)(2 * i));
            if (lane == 0) LAM[i] = expf(s1) - expf(s2) + lam_init; }
    }
    PH_END();
    if (PH_ON()) { DECL_PTRS();
        for (int idx = gt; idx < 4 * 2 * 6144; idx += NGT) {
            const int l = idx / 12288, b = (idx / 6144) & 1, n = idx % 6144;
            float v = ada_b[l * 6144 + n];
#pragma unroll
            for (int kq = 0; kq < 4; ++kq) v += MODP[((size_t)(kq * 4 + l) * 2 + b) * 6144 + n];
            MOD[idx] = v;
        }
        for (int idx = gt; idx < 2 * 32 * 65 * 256; idx += NGT) {
            const int ci = idx & 15, co = (idx >> 4) & 15, tr = (idx >> 8) % 65, ig = idx / (65 * 256);
            float acc = 0.f;
            if (tr > 0) {
                const int tau = tr - 1;
#pragma unroll 16
                for (int p = 0; p < 64; ++p) { const int sp = ig * 64 + p;
                    const float cr = s5_c_re[((size_t)ig * 16 + co) * 64 + p], cim_ = s5_c_im[((size_t)ig * 16 + co) * 64 + p];
                    const f32x2 pw_ = *(const f32x2*)(S5PW + ((size_t)sp * 65 + tau) * 2), bb_ = *(const f32x2*)(S5B + ((size_t)sp * 16 + ci) * 2);
                    const float pr = pw_.x, pi_ = pw_.y, br = bb_.x, bi = bb_.y;
                    const float xr = cr * pr - cim_ * pi_, xi = cr * pi_ + cim_ * pr;
                    acc += xr * br - xi * bi; }
            }
            S5KT[((size_t)ig * 65 + tr) * 384 + co * 24 + ci] = (bf16_t)f2bf(acc);
        }
        constexpr int NW_ = 2 * 32 * 128 * 1024;
        for (int idx0 = gt; idx0 < NW_; idx0 += NGT * 8) {
            f32x2 pw_[8], bb_[8];
#pragma unroll
            for (int u = 0; u < 8; ++u) { const int idx = min(idx0 + u * NGT, NW_ - 1);
                const int k = idx & 1023, row = (idx >> 10) & 127, ig = idx >> 17; const int s = k >> 4, ci = k & 15, p = row >> 1; const int sp = ig * 64 + p;
                pw_[u] = *(const f32x2*)(S5PW + ((size_t)sp * 65 + (63 - s)) * 2); bb_[u] = *(const f32x2*)(S5B + ((size_t)sp * 16 + ci) * 2); }
            __builtin_amdgcn_sched_barrier(0);
#pragma unroll
            for (int u = 0; u < 8; ++u) { const int idx = idx0 + u * NGT;
                if (idx < NW_) { const int ri = (idx >> 10) & 1; const float pr = pw_[u].x, pi_ = pw_[u].y, br = bb_[u].x, bi = bb_[u].y;
                    S5WT[idx] = (bf16_t)f2bf(ri ? (pr * bi + pi_ * br) : (pr * br - pi_ * bi)); } }
            __builtin_amdgcn_sched_barrier(0);
        }
        for (int idx0 = gt; idx0 < NW_; idx0 += NGT * 8) {
            f32x2 pw_[8]; float crv[8], civ[8];
#pragma unroll
            for (int u = 0; u < 8; ++u) { const int idx = min(idx0 + u * NGT, NW_ - 1);
                const int k = idx & 127, rowt = (idx >> 7) & 1023, ig = idx >> 17; const int t = rowt >> 4, co = rowt & 15, p = k >> 1; const int sp = ig * 64 + p;
                crv[u] = s5_c_re[((size_t)ig * 16 + co) * 64 + p]; civ[u] = s5_c_im[((size_t)ig * 16 + co) * 64 + p];
                pw_[u] = *(const f32x2*)(S5PW + ((size_t)sp * 65 + t + 1) * 2); }
            __builtin_amdgcn_sched_barrier(0);
#pragma unroll
            for (int u = 0; u < 8; ++u) { const int idx = idx0 + u * NGT;
                if (idx < NW_) { const int ri = idx & 1; const float cr = crv[u], cim_ = civ[u], pr = pw_[u].x, pi_ = pw_[u].y;
                    S5A2[idx] = (bf16_t)f2bf(ri ? -(cr * pi_ + cim_ * pr) : (cr * pr - cim_ * pi_)); } }
            __builtin_amdgcn_sched_barrier(0);
        }
    }
    PH_END();
    if (PH_ON()) { DECL_PTRS();
        for (int t0 = gw * 4; t0 < T; t0 += NGW * 4) {
            const int b = t0 / S; const float* mo = MOD + (size_t)(0 * 2 + b) * 6144;
            f32x4 v[4][4], sc1[4], sh1[4];
#pragma unroll
            for (int u = 0; u < 4; ++u)
#pragma unroll
                for (int j = 0; j < 4; ++j) v[u][j] = *(const f32x4*)(xin + (size_t)(t0 + u) * 1024 + 4 * lane + 256 * j);
#pragma unroll
            for (int j = 0; j < 4; ++j) { sc1[j] = *(const f32x4*)(mo + 1024 + 4 * lane + 256 * j); sh1[j] = *(const f32x4*)(mo + 4 * lane + 256 * j); }
            __builtin_amdgcn_sched_barrier(0);
#pragma unroll
            for (int u = 0; u < 4; ++u) { float ss = 0.f;
#pragma unroll
                for (int j = 0; j < 4; ++j) ss += (v[u][j].x * v[u][j].x + v[u][j].y * v[u][j].y) + (v[u][j].z * v[u][j].z + v[u][j].w * v[u][j].w);
                const float rn = rsqrtf(wave_sum(ss) * (1.0f / 1024.0f) + EPS);
#pragma unroll
                for (int j = 0; j < 4; ++j) { const int col = 4 * lane + 256 * j;
                    u32x2 w; w.x = pk2(v[u][j].x * rn * (1.f + sc1[j].x) + sh1[j].x, v[u][j].y * rn * (1.f + sc1[j].y) + sh1[j].y); w.y = pk2(v[u][j].z * rn * (1.f + sc1[j].z) + sh1[j].z, v[u][j].w * rn * (1.f + sc1[j].w) + sh1[j].w);
                    *(u32x2*)(H + (size_t)(t0 + u) * 1024 + col) = w; } }
            __builtin_amdgcn_sched_barrier(0);
        }
    }
    PH_END();

    for (l0 = 0; l0 < DEPTH; ++l0) {
        if ((l0 & 1) == 0) {
            if (PH_ON()) { DECL_PTRS();
                pg8::Gemm g{H, Wevin + (size_t)i * EV_NP * 1024, T, EV_NP, 1024, 0}; pg8::StaticOrder So; So.init(T, EV_NP, G, c);
                EpiEvenIn E{Z, IQH, IKH, IW, a_kn + i * 64, b_kn + i * 64, b_idx_kn + i * 32, COSH, SINH, COSI, SINI};
                { PROBE_WRAP(pg8::StaticOrder, So); pg8::gemm_phase<EpiEvenIn, PROBE_SCHED(pg8::StaticOrder), true, true>(glds, g, PS_, E, tid); }
            }
            PH_END();
            if (PH_ON()) { DECL_PTRS();
                moe_convert(moe_w1 + (size_t)l * 32 * 1024 * 512, moe_w3 + (size_t)l * 32 * 1024 * 512, moe_w2 + (size_t)l * 32 * 512 * 1024, W13, W2, scr, gw, NGW, lane);
                __syncthreads();
                {
                    LAS unsigned short* kq = (LAS unsigned short*)lds;
                    const int qi = tid >> 7, ht = tid & 127;
                    LAS unsigned short* kqq = kq + qi * 16384;
                    LAS unsigned* hist = (LAS unsigned*)(lds + LDS_MISC + qi * 6400);
                    LAS unsigned* bits = hist + 1024;
                    LAS unsigned* misc = hist + 1536;
                    for (int it = 0;; ++it) {
                        const int L = it * G + c; if (L >= 8192) break;
                        const int uu = (L & 1) ? (8191 - (L >> 1)) : (L >> 1);
                        const int b = uu >> 12, pp = uu & 4095;
                        const size_t tA = (size_t)b * S + 4 * pp;
                        const int nD = 4 * pp + 4;
#pragma unroll
                        for (int q = 0; q < 8; ++q) hist[ht + 128 * q] = 0u;
                        __syncthreads();
#ifdef PROBE_MASK
                        if (a.probe_var != 2)
#endif
                        {
                            const int r32 = lane & 31, hi = lane >> 5;
                            typedef _Float16 f16x8_t __attribute__((ext_vector_type(8)));
                            f16x8_t qa[2];
#pragma unroll
                            for (int s = 0; s < 2; ++s) qa[s] = *(const f16x8_t*)(IQH + (tA + 2 * ((r32 >> 2) & 1) + (r32 >> 4)) * 256 + (4 * ((r32 >> 3) & 1) + (r32 & 3)) * 32 + 16 * s + 8 * hi);
                            f32x4 wq[4];
#pragma unroll
                            for (int q = 0; q < 4; ++q) wq[q] = *(const f32x4*)(IW + (tA + 2 * hi + (q >> 1)) * 8 + 4 * (q & 1));
                            const int ntile = (nD + 31) >> 5;
                            const _Float16* kbase = IKH + ((size_t)b * S + r32) * 32 + 8 * hi;
                            f16x8_t kb[4][2], kn[4][2];
#pragma unroll
                            for (int u = 0; u < 4; ++u) { const int tile = min(wid + NWAVES * u, ntile - 1);
                                kb[u][0] = *(const f16x8_t*)(kbase + (size_t)tile * 1024); kb[u][1] = *(const f16x8_t*)(kbase + (size_t)tile * 1024 + 16); }
                            for (int tile0 = wid; tile0 < ntile; tile0 += NWAVES * 4) {
#pragma unroll
                                for (int u = 0; u < 4; ++u) { const int tile = min(tile0 + NWAVES * (4 + u), ntile - 1);
                                    kn[u][0] = *(const f16x8_t*)(kbase + (size_t)tile * 1024); kn[u][1] = *(const f16x8_t*)(kbase + (size_t)tile * 1024 + 16); }
#pragma unroll
                                for (int u = 0; u < 4; ++u) {
                                    const int tile = tile0 + NWAVES * u;
                                    attn_body::f32x16 acc;
#pragma unroll
                                    for (int r = 0; r < 16; ++r) acc[r] = 0.f;
                                    acc = __builtin_amdgcn_mfma_f32_32x32x16_f16(qa[0], kb[u][0], acc, 0, 0, 0);
                                    acc = __builtin_amdgcn_mfma_f32_32x32x16_f16(qa[1], kb[u][1], acc, 0, 0, 0);
                                    float sq[4];
#pragma unroll
                                    for (int q = 0; q < 4; ++q) sq[q] = wq[q].x * fmaxf(acc[4 * q], 0.f) + wq[q].y * fmaxf(acc[4 * q + 1], 0.f) + wq[q].z * fmaxf(acc[4 * q + 2], 0.f) + wq[q].w * fmaxf(acc[4 * q + 3], 0.f);
                                    if (tile < ntile) {
                                        const float sa = sq[0] + sq[1], sb = sq[2] + sq[3];
                                        const unsigned h0 = (unsigned)__builtin_bit_cast(unsigned short, (_Float16)sa), h1 = (unsigned)__builtin_bit_cast(unsigned short, (_Float16)sb);
                                        const unsigned k0_ = (h0 ^ ((unsigned)__builtin_amdgcn_sbfe((int)h0, 15, 1) | 0x8000u)) & 0xFFFFu, k1_ = (h1 ^ ((unsigned)__builtin_amdgcn_sbfe((int)h1, 15, 1) | 0x8000u)) & 0xFFFFu;
                                        const int kidx = tile * 32 + r32;
                                        kq[(2 * hi) * 16384 + kidx] = (unsigned short)k0_;
                                        kq[(2 * hi + 1) * 16384 + kidx] = (unsigned short)k1_;
                                        LAS unsigned* hq0 = (LAS unsigned*)(lds + LDS_MISC + (2 * hi) * 6400); LAS unsigned* hq1 = (LAS unsigned*)(lds + LDS_MISC + (2 * hi + 1) * 6400);
                                        __hip_atomic_fetch_add(&hq0[(kidx <= 4 * pp + 2 * hi) ? ((k0_ >> 8) << 2) + (lane & 3) : 1536 + 32 + (lane & 3)], 1u, __ATOMIC_RELAXED, __HIP_MEMORY_SCOPE_WORKGROUP);
                                        __hip_atomic_fetch_add(&hq1[(kidx <= 4 * pp + 2 * hi + 1) ? ((k1_ >> 8) << 2) + (lane & 3) : 1536 + 32 + (lane & 3)], 1u, __ATOMIC_RELAXED, __HIP_MEMORY_SCOPE_WORKGROUP);
                                    }
                                }
#pragma unroll
                                for (int u = 0; u < 4; ++u) { kb[u][0] = kn[u][0]; kb[u][1] = kn[u][1]; }
                            }
                        }
                        __syncthreads();
#ifdef PROBE_MASK
                        if (a.probe_var == 1) continue;
#endif
                        const int n = 4 * pp + 1 + qi;
                        const bool small = n <= 256;
                        if (ht == 0) { misc[0] = 0u; misc[1] = 256u; misc[2] = 0u; }
                        const LAS unsigned* kq32 = (const LAS unsigned*)kqq;
                        const int npair = (n + 1) >> 1;
                        for (int pass = 0; pass < 2; ++pass) {
                            if (pass) {
#pragma unroll
                                for (int q = 0; q < 8; ++q) hist[ht + 128 * q] = 0u; }
                            __syncthreads();
                            const int shift = 8 - 8 * pass;
                            if (!small && pass) {
                                const unsigned prefix = misc[0];
                                for (int W = ht; 32 * W < n; W += 128) {
                                    const unsigned vmask = (n - 32 * W >= 32) ? 0xFFFFFFFFu : ((1u << (n - 32 * W)) - 1u);
                                    const LAS u32x4* kp = (const LAS u32x4*)(kq32 + 16 * W);
                                    unsigned mm = 0u;
#pragma unroll
                                    for (int q4 = 0; q4 < 4; ++q4) { const u32x4 w4 = kp[q4];
#pragma unroll
                                        for (int e = 0; e < 4; ++e) { const unsigned w = w4[e]; const int j = 8 * q4 + 2 * e;
                                            mm |= (unsigned)((w & 0xFF00u) == prefix) << j; mm |= (unsigned)(((w >> 16) & 0xFF00u) == prefix) << (j + 1); } }
                                    mm &= vmask;
                                    const LAS unsigned short* k16 = kqq + 32 * W;
                                    while (mm) { const int j = __ffs(mm) - 1; mm &= mm - 1u;
                                        __hip_atomic_fetch_add(&hist[(((unsigned)k16[j] & 255u) << 2) + (lane & 3)], 1u, __ATOMIC_RELAXED, __HIP_MEMORY_SCOPE_WORKGROUP); }
                                }
                            }
                            __syncthreads();
                            if (!small && ht < 64) {
                                unsigned cb[4];
#pragma unroll
                                for (int q = 0; q < 4; ++q) { const u32x4 a0 = *(const LAS u32x4*)(hist + (4 * ht + q) * 4); cb[q] = (a0.x + a0.y) + (a0.z + a0.w); }
                                const unsigned c0 = cb[0], c1 = cb[1], c2 = cb[2], c3 = cb[3];
                                const unsigned tot = c0 + c1 + c2 + c3;
                                unsigned Ssum = tot;
#pragma unroll
                                for (int off = 1; off < 64; off <<= 1) { const unsigned v = shi_(Ssum, lane + off); if (ht + off < 64) Ssum += v; }
                                const unsigned above = Ssum - tot, krem = misc[1];
                                if (above < krem && krem <= Ssum) {
                                    unsigned run = above, bin, eq;
                                    if (run + c3 >= krem) { bin = 3; eq = c3; }
                                    else { run += c3; if (run + c2 >= krem) { bin = 2; eq = c2; }
                                        else { run += c2; if (run + c1 >= krem) { bin = 1; eq = c1; } else { run += c1; bin = 0; eq = c0; } } }
                                    misc[0] = misc[0] | ((4u * ht + bin) << shift); misc[1] = krem - run; misc[2] = eq;
                                }
                            }
                            __syncthreads();
                        }
#ifdef PROBE_MASK
                        if (a.probe_var == 8) { __syncthreads(); continue; }
#endif
                        const unsigned Tkey = misc[0], krem = misc[1], cnteq = misc[2];
                        LAS unsigned* eqb = hist;
                        const bool all_eq = (cnteq == krem);
                        for (int W = ht; W < 512; W += 128) {
                            unsigned sel = 0u, eqm = 0u;
                            if (32 * W < n) {
                                const unsigned vmask = (n - 32 * W >= 32) ? 0xFFFFFFFFu : ((1u << (n - 32 * W)) - 1u);
                                if (small) sel = vmask;
                                else {
                                    const LAS u32x4* kp = (const LAS u32x4*)(kq32 + 16 * W);
#pragma unroll
                                    for (int q4 = 0; q4 < 4; ++q4) { const u32x4 w4 = kp[q4];
#pragma unroll
                                        for (int e = 0; e < 4; ++e) { const unsigned w = w4[e]; const int j = 8 * q4 + 2 * e;
                                            const unsigned k0 = w & 0xFFFFu, k1 = w >> 16;
                                            sel |= (unsigned)(k0 > Tkey) << j; sel |= (unsigned)(k1 > Tkey) << (j + 1);
                                            eqm |= (unsigned)(k0 == Tkey) << j; eqm |= (unsigned)(k1 == Tkey) << (j + 1); } }
                                    if (all_eq) { sel |= eqm; eqm = 0u; }
                                    sel &= vmask; eqm &= vmask;
                                }
                            }
                            bits[W] = sel; eqb[W] = eqm;
                        }
                        __syncthreads();
                        if (!small && !all_eq && ht < 64) {
                            unsigned wv_[8]; unsigned cnt = 0u;
#pragma unroll
                            for (int q = 0; q < 8; ++q) { wv_[q] = eqb[8 * ht + q]; cnt += (unsigned)__popc(wv_[q]); }
                            unsigned inc = cnt;
#pragma unroll
                            for (int off = 1; off < 64; off <<= 1) { const unsigned v = shi_(inc, lane - off); if (lane >= off) inc += v; }
                            unsigned before = inc - cnt;
#pragma unroll
                            for (int q = 0; q < 8; ++q) { unsigned w = wv_[q], keep = 0u;
                                while (w && before < krem) { const unsigned lowb = w & (0u - w); keep |= lowb; w ^= lowb; ++before; }
                                before += (unsigned)__popc(w);
                                if (keep) __hip_atomic_fetch_or(&bits[8 * ht + q], keep, __ATOMIC_RELAXED, __HIP_MEMORY_SCOPE_WORKGROUP); }
                        }
                        __syncthreads();
                        {
                            const int qpos = 4 * pp + qi; const int tmax = 8 * (qpos >> 9) + 7;
#pragma unroll
                            for (int j = 0; j < 2; ++j) { const int tt = 2 * ht + j;
                                if (tt <= tmax) { const unsigned W0 = bits[2 * tt], W1 = bits[2 * tt + 1];
                                    unsigned e0 = W0 & 0x0F0F0F0Fu, e1 = W1 & 0x0F0F0F0Fu, o0 = (W0 >> 4) & 0x0F0F0F0Fu, o1 = (W1 >> 4) & 0x0F0F0F0Fu;
                                    e0 = (e0 | (e0 >> 4)) & 0x00FF00FFu; e0 = (e0 | (e0 >> 8)) & 0xFFFFu; e1 = (e1 | (e1 >> 4)) & 0x00FF00FFu; e1 = (e1 | (e1 >> 8)) & 0xFFFFu;
                                    o0 = (o0 | (o0 >> 4)) & 0x00FF00FFu; o0 = (o0 | (o0 >> 8)) & 0xFFFFu; o1 = (o1 | (o1 >> 4)) & 0x00FF00FFu; o1 = (o1 | (o1 >> 8)) & 0xFFFFu;
                                    u32x2 pm; pm.x = e0 | (e1 << 16); pm.y = o0 | (o1 << 16);
                                    *(u32x2*)(MASKW + (((size_t)(b * 256 + tt)) * S + qpos) * 2) = pm; } }
                        }
                        __syncthreads();
                    }
                }
                __syncthreads();
                {
                    bf16_t* OA = YMIX;
                    const int vcu = (G % 8 == 0) ? (c % 8) * (G / 8) + c / 8 : c;
                    const int nu = (G == 256) ? 4 : (1024 - vcu + G - 1) / G;
                    for (int iu = 0; iu < nu; ++iu) {
                        const int lane = lane_id_v(), wid = lsg(wid0);
                        LAS unsigned char* L0 = lsgp(lds0);
                        int combo, qb;
                        if (G == 256) { combo = vcu >> 4; const int s_ = vcu & 15; qb = iu == 0 ? s_ : iu == 1 ? 31 - s_ : iu == 2 ? 32 + s_ : 63 - s_; }
                        else { const int u = vcu + iu * G; combo = u & 15; qb = 63 - (u >> 4); }
                        const int b = combo >> 3, hc = combo & 7;
                        const bf16_t* zb = Z + (size_t)b * S * EV_ZP;
                        if (qk_bounded(a_qn + i * 64, a_kn + i * 64, lane))
                            flash_unit<2, false, true, EV_ZP, 1024, true>(L0, zb + hc * 64, zb + 512 + hc * 64, zb + 1024 + (hc >> 1) * 128, OA + (size_t)b * S * 1024 + hc * 128, nullptr, qb, wid, lane, a_qn + i * 64, COSH, SINH);
                        else
                            flash_unit<2, false, true, EV_ZP, 1024, false>(L0, zb + hc * 64, zb + 512 + hc * 64, zb + 1024 + (hc >> 1) * 128, OA + (size_t)b * S * 1024 + hc * 128, nullptr, qb, wid, lane, a_qn + i * 64, COSH, SINH);
                    }
                }
            }
            PH_END();
            if (PH_ON()) { DECL_PTRS();
                {
                    const bf16_t* OA = YMIX; const float lamv = LAM[i]; const float lam_init = 0.8f - 0.6f * expf(-0.3f * (float)l);
                    const int h = lane >> 4, vj = (lane >> 3) & 1, d8 = (lane & 7) * 8;
                    float gn[8];
#pragma unroll
                    for (int e = 0; e < 8; ++e) gn[e] = a_subln[i * 128 + vj * 64 + d8 + e] * (1.0f - lam_init);
                    for (int t0 = gw * 4; t0 < T; t0 += NGW * 4) {
                        u32x4 r1[4], r2[4];
#pragma unroll
                        for (int u = 0; u < 4; ++u) { r1[u] = *(const u32x4*)(OA + (size_t)(t0 + u) * 1024 + ((h * 2 + 0) * 2 + vj) * 64 + d8); r2[u] = *(const u32x4*)(OA + (size_t)(t0 + u) * 1024 + ((h * 2 + 1) * 2 + vj) * 64 + d8); }
                        __builtin_amdgcn_sched_barrier(0);
#pragma unroll
                        for (int u = 0; u < 4; ++u) {
                            float o1[8], o2[8], dd[8]; unpack8(r1[u], o1); unpack8(r2[u], o2);
                            float ss = 0.f;
#pragma unroll
                            for (int e = 0; e < 8; ++e) { dd[e] = o1[e] - lamv * o2[e]; ss += dd[e] * dd[e]; }
                            ss += dpp_xor1(ss); ss += dpp_xor2(ss); ss += SHX(ss, 4); ss += SHX(ss, 8);
                            const float r = rsqrtf(ss * (1.0f / 128.0f) + EPS);
#pragma unroll
                            for (int e = 0; e < 8; ++e) dd[e] = dd[e] * r * gn[e];
                            *(u32x4*)(O + (size_t)(t0 + u) * 1024 + h * 128 + vj * 64 + d8) = pack8(dd);
                        }
                        __builtin_amdgcn_sched_barrier(0);
                    }
                }
                {
                    const int vcu = (G % 8 == 0) ? (c % 8) * (G / 8) + c / 8 : c;
                    const int nu = (G == 256) ? 2 : (512 - vcu + G - 1) / G;
                    for (int iu = 0; iu < nu; ++iu) {
                        const int lane = lane_id_v(), wid = lsg(wid0);
                        LAS unsigned char* L0 = lsgp(lds0);
                        int combo, qb;
                        if (G == 256) { combo = vcu >> 4; const int s_ = vcu & 15; qb = iu == 0 ? s_ : 31 - s_; }
                        else { const int u = vcu + iu * G; combo = u & 15; qb = 31 - (u >> 4); }
                        const int b = combo >> 3, h = combo & 7;
                        const bf16_t* zb = Z + (size_t)b * S * EV_ZP;
                        if (qk_bounded(b_qn + i * 64, b_kn + i * 64, lane))
                            flash_unit_q2<1, true, false, EV_ZP, 1024, true>(L0, zb + 1536 + h * 64, zb + 2048 + h * 64, zb + 2560 + h * 64, O + (size_t)b * S * 1024 + 512 + h * 64, MASKW + (size_t)b * 256 * S * 2, qb, wid, lane, b_qn + i * 64, COSH, SINH);
                        else
                            flash_unit_q2<1, true, false, EV_ZP, 1024, false>(L0, zb + 1536 + h * 64, zb + 2048 + h * 64, zb + 2560 + h * 64, O + (size_t)b * S * 1024 + 512 + h * 64, MASKW + (size_t)b * 256 * S * 2, qb, wid, lane, b_qn + i * 64, COSH, SINH);
                    }
                }
            }
            PH_END();
        } else {
            if (PH_ON()) { DECL_PTRS();
                pg8::Gemm g{H, Wodin + (size_t)i * OD_N * 1024, T, OD_N, 1024, 0}; pg8::StaticOrder So; So.init(T, OD_N, G, c);
                EpiOddIn E{Z, UG, c_kn + i * 64, COSH, SINH};
                { PROBE_WRAP(pg8::StaticOrder, So); pg8::gemm_phase<EpiOddIn, PROBE_SCHED(pg8::StaticOrder), true, true>(glds, g, PS_, E, tid); }
            }
            PH_END();
            if (PH_ON()) { DECL_PTRS();
                moe_convert(moe_w1 + (size_t)l * 32 * 1024 * 512, moe_w3 + (size_t)l * 32 * 1024 * 512, moe_w2 + (size_t)l * 32 * 512 * 1024, W13, W2, scr, gw, NGW, lane);
                __syncthreads();
                for (int u = gw; u < NB * 64 * 8; u += NGW) {
                    const int h = u & 7, blk = (u >> 3) & 63, b = u >> 9;
                    const int rs = lane >> 3, d8 = (lane & 7) * 8;
                    const bf16_t* kp = Z + ((size_t)b * S + blk * 256 + rs) * OD_N + 512 + h * 64 + d8;
                    u32x4 kr[32];
#pragma unroll
                    for (int j = 0; j < 32; ++j) kr[j] = *(const u32x4*)(kp + (size_t)(8 * j) * OD_N);
                    __builtin_amdgcn_sched_barrier(0);
                    float sm[8];
#pragma unroll
                    for (int e = 0; e < 8; ++e) sm[e] = 0.f;
#pragma unroll
                    for (int j = 0; j < 32; ++j) { float kv[8]; unpack8(kr[j], kv);
#pragma unroll
                        for (int e = 0; e < 8; ++e) sm[e] += kv[e]; }
#pragma unroll
                    for (int e = 0; e < 8; ++e) { sm[e] += SHX(sm[e], 8); sm[e] += SHX(sm[e], 16); sm[e] += SHX(sm[e], 32); sm[e] *= (1.0f / 256.0f); }
                    if (rs == 0) {
                        *(f32x4*)(KM + (size_t)u * 64 + d8) = (f32x4){sm[0], sm[1], sm[2], sm[3]}; *(f32x4*)(KM + (size_t)u * 64 + d8 + 4) = (f32x4){sm[4], sm[5], sm[6], sm[7]};
                        const u32x4 hw = pack8(sm); float hf[8], lo[8]; unpack8(hw, hf);
#pragma unroll
                        for (int e = 0; e < 8; ++e) lo[e] = sm[e] - hf[e];
                        *(u32x4*)(KMH + ((size_t)(b * 8 + h) * 64 + blk) * 64 + d8) = hw; *(u32x4*)(KML + ((size_t)(b * 8 + h) * 64 + blk) * 64 + d8) = pack8(lo);
                    }
                }
                {
                    const int r32 = lane & 31, hi = lane >> 5;
                    LAS unsigned char* ldsU = lds;
                    LAS float* red = (LAS float*)(lds + 69632);
                    for (int task = c; task < 512; task += G) {
                        const int g = task >> 4, cs = task & 15;
                        for (int q = tid; q < 32 * 128; q += NTHREADS) { const int j = q >> 7, off = (q & 127) * 16;
                            *(LAS u32x4*)(ldsU + j * 2064 + off) = *(const u32x4*)((const unsigned char*)UG + ((size_t)g * T + (size_t)(cs * 32 + j) * 64) * 32 + off); }
                        __syncthreads();
                        const int rb = wid & 3, kh = wid >> 2;
                        attn_body::f32x16 acc;
#pragma unroll
                        for (int r = 0; r < 16; ++r) acc[r] = 0.f;
                        const bf16_t* wrow = S5WT + ((size_t)(i * 32 + g) * 128 + rb * 32 + r32) * 1024 + hi * 8;
#pragma unroll 8
                        for (int ks = kh * 32; ks < kh * 32 + 32; ++ks) {
                            const attn_body::bf16x8 A = *(const attn_body::bf16x8*)(wrow + ks * 16);
                            const attn_body::bf16x8 B = *(const LAS attn_body::bf16x8*)(ldsU + r32 * 2064 + ks * 32 + hi * 16);
                            acc = __builtin_amdgcn_mfma_f32_32x32x16_bf16(A, B, acc, 0, 0, 0);
                        }
                        if (kh == 1) {
#pragma unroll
                            for (int r = 0; r < 16; ++r) red[(rb * 64 + lane) * 16 + r] = acc[r];
                        }
                        __syncthreads();
                        if (kh == 0) {
                            float* ep = S5E + ((size_t)(cs * 32 + r32) * 32 + g) * 128 + rb * 32 + 4 * hi;
#pragma unroll
                            for (int q4 = 0; q4 < 4; ++q4) { f32x4 o;
                                o.x = acc[4 * q4] + red[(rb * 64 + lane) * 16 + 4 * q4]; o.y = acc[4 * q4 + 1] + red[(rb * 64 + lane) * 16 + 4 * q4 + 1];
                                o.z = acc[4 * q4 + 2] + red[(rb * 64 + lane) * 16 + 4 * q4 + 2]; o.w = acc[4 * q4 + 3] + red[(rb * 64 + lane) * 16 + 4 * q4 + 3];
                                *(f32x4*)(ep + 8 * q4) = o; }
                        }
                        __syncthreads();
                    }
                }
            }
            PH_END();
            if (PH_ON()) { DECL_PTRS();
#ifndef SKIP_S5
                {
                    for (int idx = gt; idx < NB * 32 * 64; idx += NGT) {
                        const int b = idx >> 11, g = (idx >> 6) & 31, p = idx & 63;
                        const int sp = (i * 32 + g) * 64 + p;
                        const float aLr = S5PW[((size_t)sp * 65 + 64) * 2], aLi = S5PW[((size_t)sp * 65 + 64) * 2 + 1];
                        float hr = 0.f, hi_ = 0.f;
                        for (int c0 = 0; c0 < 256; c0 += 32) {
                            float er[32], ei[32];
#pragma unroll
                            for (int k = 0; k < 32; ++k) { const float* ep = S5E + ((size_t)(b * 256 + c0 + k) * 32 + g) * 128 + 2 * p; er[k] = ep[0]; ei[k] = ep[1]; }
                            __builtin_amdgcn_sched_barrier(0);
#pragma unroll
                            for (int k = 0; k < 32; ++k) {
                                *(unsigned*)(S5HC + ((size_t)(b * 256 + c0 + k) * 32 + g) * 128 + 2 * p) = pk2(hr, hi_);
                                const float nr = aLr * hr - aLi * hi_ + er[k], ni = aLr * hi_ + aLi * hr + ei[k]; hr = nr; hi_ = ni; }
                        }
                    }
                }
#endif
                {
                    unsigned* mcnt = ctl + CW_MCNT + i * 1024;
                    const int r32 = lane & 31, hi = lane >> 5;
                    for (int u = c; u < NB * 8 * 64; u += G) {
                        const int tb = u & 63, h = (u >> 6) & 7, b = u >> 9;
                        const int pos = tb * 256 + wid * 32 + r32; const size_t t = (size_t)b * S + pos;
                        float tv[3] = {-INFINITY, -INFINITY, -INFINITY}; int ti[3] = {1 << 20, 1 << 20, 1 << 20};
                        if (tb > 0) {
                            attn_body::bf16x8 qr[4];
                            load_q_normed(qr, Z + t * OD_N + h * 64, c_qn + i * 64, COSH, SINH, pos, hi, lane);
                            attn_body::f32x16 g0, g1;
#pragma unroll
                            for (int r = 0; r < 16; ++r) { g0[r] = 0.f; g1[r] = 0.f; }
                            const bf16_t* kh = KMH + ((size_t)(b * 8 + h) * 64 + r32) * 64 + hi * 8; const bf16_t* kl = KML + ((size_t)(b * 8 + h) * 64 + r32) * 64 + hi * 8;
#pragma unroll
                            for (int d0 = 0; d0 < 4; ++d0) {
                                g0 = __builtin_amdgcn_mfma_f32_32x32x16_bf16(*(const attn_body::bf16x8*)(kh + d0 * 16), qr[d0], g0, 0, 0, 0);
                                g0 = __builtin_amdgcn_mfma_f32_32x32x16_bf16(*(const attn_body::bf16x8*)(kl + d0 * 16), qr[d0], g0, 0, 0, 0);
                                if (tb > 32) { g1 = __builtin_amdgcn_mfma_f32_32x32x16_bf16(*(const attn_body::bf16x8*)(kh + 32 * 64 + d0 * 16), qr[d0], g1, 0, 0, 0);
                                               g1 = __builtin_amdgcn_mfma_f32_32x32x16_bf16(*(const attn_body::bf16x8*)(kl + 32 * 64 + d0 * 16), qr[d0], g1, 0, 0, 0); } }
#pragma unroll
                            for (int half = 0; half < 2; ++half)
#pragma unroll
                                for (int r = 0; r < 16; ++r) { const int n = half * 32 + attn_body::crow(r, hi); const float gv = (n < tb) ? (half ? g1[r] : g0[r]) : -INFINITY;
                                    if (gv > tv[0]) { tv[2] = tv[1]; ti[2] = ti[1]; tv[1] = tv[0]; ti[1] = ti[0]; tv[0] = gv; ti[0] = n; }
                                    else if (gv > tv[1]) { tv[2] = tv[1]; ti[2] = ti[1]; tv[1] = gv; ti[1] = n; }
                                    else if (gv > tv[2]) { tv[2] = gv; ti[2] = n; } }
                            float pv_[3]; int pi_[3];
#pragma unroll
                            for (int k = 0; k < 3; ++k) { pv_[k] = SHX(tv[k], 32); pi_[k] = (int)shi_((unsigned)ti[k], lane ^ 32); }
                            float mv[3]; int mi[3]; int ia = 0, ib = 0;
#pragma unroll
                            for (int k = 0; k < 3; ++k) {
                                const float av = ia == 0 ? tv[0] : ia == 1 ? tv[1] : ia == 2 ? tv[2] : -INFINITY; const int ai = ia == 0 ? ti[0] : ia == 1 ? ti[1] : ia == 2 ? ti[2] : (1 << 20);
                                const float bv = ib == 0 ? pv_[0] : ib == 1 ? pv_[1] : ib == 2 ? pv_[2] : -INFINITY; const int bi = ib == 0 ? pi_[0] : ib == 1 ? pi_[1] : ib == 2 ? pi_[2] : (1 << 20);
                                const bool ta = (av > bv) || (av == bv && ai < bi);
                                mv[k] = ta ? av : bv; mi[k] = ta ? ai : bi; if (ta) ++ia; else ++ib; }
#pragma unroll
                            for (int k = 0; k < 3; ++k) { tv[k] = mv[k]; ti[k] = mi[k]; }
                        }
#ifdef PROBE_MASK
                        if (a.probe_var == 3) { if (ti[0] + ti[1] + ti[2] == -12345) NSEL[0] = 1; continue; }
#endif
                        if (hi == 0) {
                            unsigned idx[3];
#pragma unroll
                            for (int sI = 0; sI < 3; ++sI) { idx[sI] = 0u;
                                if (tv[sI] > -INFINITY) idx[sI] = __hip_atomic_fetch_add(mcnt + (b * 8 + h) * 64 + ti[sI], 1u, __ATOMIC_RELAXED, __HIP_MEMORY_SCOPE_AGENT); }
                            int nsel = 0;
#pragma unroll
                            for (int sI = 0; sI < 3; ++sI)
                                if (tv[sI] > -INFINITY) { const int li = (b * 8 + h) * 64 + ti[sI]; MLIST[(size_t)li * 16384 + idx[sI]] = (pos << 2) | nsel; ++nsel; }
                            NSEL[t * 8 + h] = nsel;
                        }
                    }
                }
            }
            PH_END();
            if (PH_ON()) { DECL_PTRS();
                {
                    const unsigned* mcnt = ctl + CW_MCNT + i * 1024;
                    LAS int* pref = (LAS int*)(lds + LDS_MISC);
                    if (wid == 0) {
                        int loc[16]; int sum = 0;
#pragma unroll
                        for (int k = 0; k < 16; ++k) loc[k] = (int)__hip_atomic_load(mcnt + lane * 16 + k, __ATOMIC_RELAXED, __HIP_MEMORY_SCOPE_AGENT);
                        __builtin_amdgcn_sched_barrier(0);
#pragma unroll
                        for (int k = 0; k < 16; ++k) { const int cnt = loc[k]; loc[k] = sum; sum += (cnt + 255) >> 8; }
                        int inc = sum;
#pragma unroll
                        for (int off = 1; off < 64; off <<= 1) { const int v = (int)shi_((unsigned)inc, lane - off); if (lane >= off) inc += v; }
                        const int base = inc - sum;
#pragma unroll
                        for (int k = 0; k < 16; ++k) pref[lane * 16 + k] = base + loc[k];
                        if (lane == 63) pref[1024] = inc;
                    }
                    __syncthreads();
                    const int NTsel = pref[1024];
                    for (int task = c; task < NTsel + 1024; task += G) {
                        const int lane = lane_id_v(), wid = lsg(wid0), r32 = lane & 31, hi = lane >> 5;
                        LAS unsigned char* ldsKs = lsgp(lds0); LAS unsigned char* ldsVs = ldsKs + 32768;
                        LAS bf16_t* stg = (LAS bf16_t*)(ldsKs + 65536 + wid * 4096); LAS float* wsf = (LAS float*)(ldsKs + 98304 + wid * 256); LAS int* rowd = (LAS int*)(ldsKs + 100352 + wid * 128);
                        const bool own_task = task >= NTsel;
                        int li, chunk = 0;
                        if (own_task) li = task - NTsel;
                        else { int lo_ = 0, hi_ = 1023; while (lo_ < hi_) { const int mid = (lo_ + hi_ + 1) >> 1; if (pref[mid] <= task) lo_ = mid; else hi_ = mid - 1; } li = lo_; chunk = task - pref[li]; }
                        const int b = li >> 9, h = (li >> 6) & 7, blk = li & 63;
                        const int e_ = chunk * 256 + wid * 32 + r32;
                        const int cnt = own_task ? 256 : (int)__hip_atomic_load(mcnt + li, __ATOMIC_RELAXED, __HIP_MEMORY_SCOPE_AGENT);
                        const int ent_ = own_task ? 0 : MLIST[(size_t)li * 16384 + e_];
                        u32x4 kst[4], vst[4];
                        {
                            const bf16_t* kbp = Z + ((size_t)b * S + blk * 256) * OD_N + 512 + h * 64;
                            const bf16_t* vbp = Z + ((size_t)b * S + blk * 256) * OD_N + 1024 + h * 64;
#pragma unroll
                            for (int kt = 0; kt < 4; ++kt) {
                                kst[kt] = *(const u32x4*)(kbp + (size_t)(kt * 64 + lane) * OD_N + wid * 8);
                                vst[kt] = *(const u32x4*)(vbp + (size_t)(kt * 64 + 16 * (wid & 3) + (lane >> 2)) * OD_N + (wid >> 2) * 32 + (lane & 3) * 8);
                            }
                        }
                        __builtin_amdgcn_sched_barrier(0);
                        int posq, slot; bool valid;
                        if (own_task) { posq = blk * 256 + wid * 32 + r32; slot = 3; valid = true; }
                        else { valid = e_ < cnt; posq = valid ? (ent_ >> 2) : 0; slot = ent_ & 3; }
                        const size_t tq = (size_t)b * S + posq;
                        const int dest = valid ? (int)((tq * 8 + h) * 4 + slot) : -1;
                        attn_body::bf16x8 qr[4];
                        load_q_normed(qr, Z + tq * OD_N + h * 64, c_qn + i * 64, COSH, SINH, posq, hi, lane);
#pragma unroll
                        for (int kt = 0; kt < 4; ++kt) { *(LAS u32x4*)(ldsKs + kt * 8192 + wid * 1024 + lane * 16) = kst[kt]; *(LAS u32x4*)(ldsVs + kt * 8192 + wid * 1024 + lane * 16) = vst[kt]; }
                        __syncthreads();
                        attn_body::f32x16 p0[4], p1[4];
#pragma unroll
                        for (int kt = 0; kt < 4; ++kt) {
#pragma unroll
                            for (int r = 0; r < 16; ++r) { p0[kt][r] = 0.f; p1[kt][r] = 0.f; }
                            const LAS unsigned char* kb = ldsKs + kt * 8192 + hi * 1024 + r32 * 16;
#pragma unroll
                            for (int d0 = 0; d0 < 4; ++d0) {
                                const attn_body::bf16x8 b0 = *(const LAS attn_body::bf16x8*)(kb + d0 * 2048), b1 = *(const LAS attn_body::bf16x8*)(kb + d0 * 2048 + 512);
                                p0[kt] = __builtin_amdgcn_mfma_f32_32x32x16_bf16(b0, qr[d0], p0[kt], 0, 0, 0);
                                p1[kt] = __builtin_amdgcn_mfma_f32_32x32x16_bf16(b1, qr[d0], p1[kt], 0, 0, 0);
                            }
                        }
                        if (own_task) {
                            const int qrel = wid * 32 + r32;
#pragma unroll
                            for (int kt = 0; kt < 4; ++kt)
#pragma unroll
                                for (int r = 0; r < 16; ++r) { const int kv = kt * 64 + attn_body::crow(r, hi); if (kv > qrel) p0[kt][r] = -INFINITY; if (kv + 32 > qrel) p1[kt][r] = -INFINITY; }
                        }
                        float mx = -INFINITY;
#pragma unroll
                        for (int kt = 0; kt < 4; ++kt)
#pragma unroll
                            for (int r = 0; r < 16; ++r) mx = fmaxf(mx, fmaxf(p0[kt][r], p1[kt][r]));
                        mx = fmaxf(mx, SHX(mx, 32));
                        float ls = 0.f;
#pragma unroll
                        for (int kt = 0; kt < 4; ++kt)
#pragma unroll
                            for (int r = 0; r < 16; ++r) { p0[kt][r] = __builtin_amdgcn_exp2f(p0[kt][r] - mx); p1[kt][r] = __builtin_amdgcn_exp2f(p1[kt][r] - mx); ls += p0[kt][r] + p1[kt][r]; }
                        ls += SHX(ls, 32);
                        attn_body::f32x16 o[2];
#pragma unroll
                        for (int r = 0; r < 16; ++r) { o[0][r] = 0.f; o[1][r] = 0.f; }
                        const int vb0 = (int)(unsigned)(unsigned long long)ldsVs + ((lane >> 4) & 1) * 32 + (lane & 3) * 8 + (4 * hi + ((lane & 15) >> 2)) * 64;
#pragma unroll
                        for (int kt = 0; kt < 4; ++kt) {
                            u32x4 pw0, pw1, pw2, pw3;
#pragma unroll
                            for (int k = 0; k < 4; ++k) { pw0[k] = attn_body::cvtpk_s(p0[kt][2 * k], p0[kt][2 * k + 1]); pw1[k] = attn_body::cvtpk_s(p0[kt][8 + 2 * k], p0[kt][9 + 2 * k]);
                                pw2[k] = attn_body::cvtpk_s(p1[kt][2 * k], p1[kt][2 * k + 1]); pw3[k] = attn_body::cvtpk_s(p1[kt][8 + 2 * k], p1[kt][9 + 2 * k]); }
                            attn_body::pv(o, vb0 + kt * 8192, __builtin_bit_cast(attn_body::bf16x8, pw0), __builtin_bit_cast(attn_body::bf16x8, pw1), __builtin_bit_cast(attn_body::bf16x8, pw2), __builtin_bit_cast(attn_body::bf16x8, pw3));
                        }
                        if (hi == 0) { wsf[r32] = ls; rowd[r32] = dest; if (valid) { MML[(size_t)dest * 2] = mx; MML[(size_t)dest * 2 + 1] = ls; } }
                        LDS_WAIT();
#pragma unroll
                        for (int r = 0; r < 16; ++r) { const int orow = attn_body::crow(r, hi); const float rl = __builtin_amdgcn_rcpf(wsf[orow]);
                            stg[orow * 64 + r32] = (bf16_t)f2bf(o[0][r] * rl); stg[orow * 64 + 32 + r32] = (bf16_t)f2bf(o[1][r] * rl); }
                        LDS_WAIT();
#pragma unroll
                        for (int q = 0; q < 4; ++q) { const int row = q * 8 + (lane >> 3), ch = lane & 7; const int dd = rowd[row];
                            if (dd >= 0) *(u32x4*)(MPO + (size_t)dd * 64 + ch * 8) = *(const LAS u32x4*)(stg + row * 64 + ch * 8); }
                        __syncthreads();
                    }
                }
                {
                const int r32 = lane & 31, hi = lane >> 5;
                LAS unsigned char* ldsU = lds;
                LAS unsigned char* ldsK = lds + 69632;
                for (int task = c; task < 512; task += G) {
                    const int g = task >> 4, cs = task & 15, ig = i * 32 + g;
                    for (int q = tid; q < 32 * 128; q += NTHREADS) { const int j = q >> 7, off = (q & 127) * 16;
                        *(LAS u32x4*)(ldsU + j * 2064 + off) = *(const u32x4*)((const unsigned char*)UG + ((size_t)g * T + (size_t)(cs * 32 + j) * 64) * 32 + off); }
                    for (int q = tid; q < 65 * 48; q += NTHREADS) *(LAS u32x4*)(ldsK + q * 16) = *(const u32x4*)((const unsigned char*)S5KT + (size_t)ig * 65 * 768 + q * 16);
                    __syncthreads();
                    const int gc = cs * 32 + r32;
                    const float* dsk = s5_d + ig * 16;
                    const f32x4 dd0 = *(const f32x4*)(dsk + 4 * hi), dd1 = *(const f32x4*)(dsk + 8 + 4 * hi);
                    attn_body::bf16x8 hcr[8];
                    { const bf16_t* hc = S5HC + ((size_t)gc * 32 + g) * 128 + hi * 8;
#pragma unroll
                      for (int kk = 0; kk < 8; ++kk) hcr[kk] = *(const attn_body::bf16x8*)(hc + kk * 16); }
#pragma unroll 1
                    for (int rr = 0; rr < 4; ++rr) {
                        const int r = rr == 0 ? wid : rr == 1 ? 15 - wid : rr == 2 ? 16 + wid : 31 - wid;
                        attn_body::f32x16 acc;
#pragma unroll
                        for (int q = 0; q < 16; ++q) acc[q] = 0.f;
                        attn_body::bf16x8 a2r[8];
                        { const bf16_t* a2 = S5A2 + ((size_t)ig * 1024 + r * 32 + r32) * 128 + hi * 8;
#pragma unroll
                          for (int kk = 0; kk < 8; ++kk) a2r[kk] = *(const attn_body::bf16x8*)(a2 + kk * 16); }
                        __builtin_amdgcn_sched_barrier(0);
                        const LAS unsigned char* kbase = ldsK + (r32 >> 4) * 768 + (r32 & 15) * 48 + hi * 16;
                        const LAS unsigned char* ubase = ldsU + r32 * 2064 + hi * 16;
                        for (int s = 0; s <= 2 * r + 1; ++s) {
                            const attn_body::bf16x8 A = *(const LAS attn_body::bf16x8*)(kbase + (2 * r - s + 1) * 768);
                            const attn_body::bf16x8 B = *(const LAS attn_body::bf16x8*)(ubase + s * 32);
                            acc = __builtin_amdgcn_mfma_f32_32x32x16_bf16(A, B, acc, 0, 0, 0);
                        }
#pragma unroll
                        for (int kk = 0; kk < 8; ++kk) acc = __builtin_amdgcn_mfma_f32_32x32x16_bf16(a2r[kk], hcr[kk], acc, 0, 0, 0);
#pragma unroll
                        for (int q4 = 0; q4 < 4; ++q4) {
                            const int rowb = 8 * q4 + 4 * hi, dt_ = rowb >> 4, co0 = rowb & 15, t = 2 * r + dt_;
                            const u32x2 uw = *(const LAS u32x2*)(ldsU + r32 * 2064 + t * 32 + co0 * 2);
                            const f32x4 dd = (q4 & 1) ? dd1 : dd0;
                            const float y0 = acc[4 * q4] + dd.x * bflo(uw.x), y1 = acc[4 * q4 + 1] + dd.y * bfhi(uw.x), y2 = acc[4 * q4 + 2] + dd.z * bflo(uw.y), y3 = acc[4 * q4 + 3] + dd.w * bfhi(uw.y);
                            u32x2 w; w.x = pk2(gelu_tanh(y0), gelu_tanh(y1)); w.y = pk2(gelu_tanh(y2), gelu_tanh(y3));
                            *(u32x2*)(YG + ((size_t)gc * 64 + t) * 512 + g * 16 + co0) = w;
                        }
                    }
                    __syncthreads();
                }
                }
            }
            PH_END();
            if (PH_ON()) { DECL_PTRS();
                {
                    const int h = lane >> 3, d8 = (lane & 7) * 8;
                    for (int t0 = gw * 4; t0 < T; t0 += NGW * 4) {
                        int nsel[4]; f32x2 ml[4][4]; u32x4 po[4][4];
#pragma unroll
                        for (int u = 0; u < 4; ++u) { const size_t base = ((size_t)(t0 + u) * 8 + h) * 4; nsel[u] = NSEL[(size_t)(t0 + u) * 8 + h];
#pragma unroll
                            for (int s = 0; s < 4; ++s) { ml[u][s] = *(const f32x2*)(MML + (base + s) * 2); po[u][s] = *(const u32x4*)(MPO + (base + s) * 64 + d8); } }
                        __builtin_amdgcn_sched_barrier(0);
#pragma unroll
                        for (int u = 0; u < 4; ++u) {
                            float mm[4], ll[4];
#pragma unroll
                            for (int s = 0; s < 4; ++s) { const bool on = (s == 3) || (s < nsel[u]); mm[s] = on ? ml[u][s].x : -INFINITY; ll[s] = on ? ml[u][s].y : 0.f; }
                            const float M = fmaxf(fmaxf(mm[0], mm[1]), fmaxf(mm[2], mm[3]));
                            float acc[8], wsum = 0.f;
#pragma unroll
                            for (int e = 0; e < 8; ++e) acc[e] = 0.f;
#pragma unroll
                            for (int s = 0; s < 4; ++s) { const bool on = (s == 3) || (s < nsel[u]);
                                const float w = on ? ll[s] * __builtin_amdgcn_exp2f(mm[s] - M) : 0.f; float ov[8]; unpack8(po[u][s], ov); wsum += w;
#pragma unroll
                                for (int e = 0; e < 8; ++e) acc[e] += on ? w * ov[e] : 0.f; }
                            const float inv = 1.0f / wsum;
#pragma unroll
                            for (int e = 0; e < 8; ++e) acc[e] *= inv;
                            *(u32x4*)(O + (size_t)(t0 + u) * 1024 + h * 64 + d8) = pack8(acc);
                        }
                        __builtin_amdgcn_sched_barrier(0);
                    }
                }
                pg8::Gemm g{YG, Wglu + (size_t)i * 512 * 512, T, 512, 512, 0}; pg8::StaticOrder So; So.init(T, 512, G, c);
                EpiGLU E{O, YG, s5_glu_b + i * 512};
                { PROBE_WRAP(pg8::StaticOrder, So); pg8::gemm_phase<EpiGLU, PROBE_SCHED(pg8::StaticOrder), true, true>(glds, g, PS_, E, tid); }
            }
            PH_END();
        }
        if (PH_ON()) { DECL_PTRS();
            pg8::Gemm g{O, ((l & 1) ? Wodout : Wevout) + (size_t)i * 1024 * 1024, T, 1024, 1024, 0}; pg8::StaticOrder So; So.init(T, 1024, G, c);
            EpiPlain E{YMIX, 1024};
            { PROBE_WRAP(pg8::StaticOrder, So); pg8::gemm_phase<EpiPlain, PROBE_SCHED(pg8::StaticOrder), true, true>(glds, g, PS_, E, tid); }
        }
        PH_END();
        if (PH_ON()) { DECL_PTRS();
#ifdef PROBE_MASK
            const bool first_x = (l == 0 && a.probe_var != -5);
#else
            const bool first_x = (l == 0);
#endif
            const float* xs = xin;
            LAS int* r_e = (LAS int*)(lds + 0);
            LAS float* r_w = (LAS float*)(lds + 1024);
            LAS int* r_rank = (LAS int*)(lds + 2048);
            LAS int* lcnt = (LAS int*)(lds + 3072);
            LAS int* lbase = (LAS int*)(lds + 3200);
            const float* wg_l = moe_wg + (size_t)l * 1024 * 4; const float* we_l = moe_we + (size_t)l * 1024 * 32;
            for (int chunk = c; chunk < T / 128; chunk += G) {
                if (tid < 32) lcnt[tid] = 0;
                LAS float* modl = (LAS float*)(lds + 32768);
                { const float* mo_ = MOD + (size_t)(l * 2 + (int)(((size_t)chunk * 128) / S)) * 6144 + 2048;
                  for (int q = tid; q < 768; q += NTHREADS) *(LAS f32x4*)(modl + 4 * q) = *(const f32x4*)(mo_ + 4 * q); }
                __syncthreads();
                {
                    const int rloc = lane & 15, kc = lane >> 4; const int r = wid * 16 + rloc; const size_t t = (size_t)chunk * 128 + r; const int b = (int)(((size_t)chunk * 128) / S);
                    const float* mo = MOD + (size_t)(l * 2 + b) * 6144;
                    float ss;
                    if (first_x) ss = f_pass1<true>(xs + t * 1024, XB + t * 1024, YMIX + t * 1024, modl, kc);
                    else ss = f_pass1<false>(xs + t * 1024, XB + t * 1024, YMIX + t * 1024, modl, kc);
                    ss += SHX(ss, 16); ss += SHX(ss, 32);
                    const float rn = rsqrtf(ss * (1.0f / 1024.0f) + EPS);
                    f32x4 acc[3];
#pragma unroll
                    for (int ct = 0; ct < 3; ++ct) acc[ct] = (f32x4){0.f, 0.f, 0.f, 0.f};
                    const bf16_t* wh = WRH + ((size_t)l * 48 + rloc) * 1024 + 8 * kc; const bf16_t* wl = WRL + ((size_t)l * 48 + rloc) * 1024 + 8 * kc;
                    f_pass2(XB + t * 1024, H + t * 1024, modl, wh, wl, rn, kc, acc);
                    LAS float* lg = (LAS float*)(lds + 4096 + wid * 3072);
#pragma unroll
                    for (int ct = 0; ct < 3; ++ct) { lg[(4 * kc + 0) * 48 + ct * 16 + rloc] = acc[ct].x; lg[(4 * kc + 1) * 48 + ct * 16 + rloc] = acc[ct].y; lg[(4 * kc + 2) * 48 + ct * 16 + rloc] = acc[ct].z; lg[(4 * kc + 3) * 48 + ct * 16 + rloc] = acc[ct].w; }
                    LDS_WAIT();
                    if (lane < 16) {
                        const LAS float* lr = lg + lane * 48;
                        float cg[4];
#pragma unroll
                        for (int e = 0; e < 4; ++e) cg[e] = lr[e] + moe_bg[l * 4 + e];
                        int grp = 0; float cm = cg[0];
#pragma unroll
                        for (int e = 1; e < 4; ++e) if (cg[e] > cm) { cm = cg[e]; grp = e; }
                        float den = 0.f;
#pragma unroll
                        for (int e = 0; e < 4; ++e) den += __expf(cg[e] - cm);
                        const float pg = 1.0f / den;
                        float fe[8];
#pragma unroll
                        for (int e = 0; e < 8; ++e) fe[e] = lr[4 + grp * 8 + e] + moe_be[l * 32 + grp * 8 + e];
                        int j0 = 0; float f0 = fe[0];
#pragma unroll
                        for (int e = 1; e < 8; ++e) if (fe[e] > f0) { f0 = fe[e]; j0 = e; }
                        int j1 = -1; float f1 = -INFINITY;
#pragma unroll
                        for (int e = 0; e < 8; ++e) if (e != j0 && fe[e] > f1) { f1 = fe[e]; j1 = e; }
                        const float ex = __expf(f1 - f0); const float sA = 1.0f / (1.0f + ex), sB = ex / (1.0f + ex);
                        const int rr_ = wid * 16 + lane;
                        r_e[2 * rr_] = grp * 8 + j0; r_w[2 * rr_] = pg * sA; r_e[2 * rr_ + 1] = grp * 8 + j1; r_w[2 * rr_ + 1] = pg * sB;
                    }
                }
                __syncthreads();
#ifdef PROBE_MASK
                if (a.probe_var == 5) { if (tid < 256 && r_e[tid] == -777) TOKES[0] = 0; __syncthreads(); continue; }
#endif
                if (tid < 256) r_rank[tid] = __hip_atomic_fetch_add(&lcnt[r_e[tid]], 1, __ATOMIC_RELAXED, __HIP_MEMORY_SCOPE_WORKGROUP);
                __syncthreads();
                if (tid < 32) lbase[tid] = (int)__hip_atomic_fetch_add(ctl + CW_CNT + (l * 32 + tid) * 64, (unsigned)lcnt[tid], __ATOMIC_RELAXED, __HIP_MEMORY_SCOPE_AGENT);
                __syncthreads();
                if (tid < 256) { const size_t t = (size_t)chunk * 128 + (tid >> 1); const int k = tid & 1; const int e = r_e[tid]; const int slot = lbase[e] + r_rank[tid];
                    TOKES[t * 2 + k] = e * 32768 + slot; TOKW[t * 2 + k] = r_w[tid]; LTOK[e * 32768 + slot] = (int)t; }
                __syncthreads();
            }
        }
        PH_END();
        if (PH_ON()) { DECL_PTRS();
            LAS int* tile_e = (LAS int*)(lds + LDS_MISC); LAS int* rb = tile_e + 320; LAS int* nt_p = tile_e + 400;
            moe_tables(ctl, l, tile_e, rb, nt_p, tid);
            const int nR = nt_p[0];
            pg8::Gemm g{H, W13, nR * 256, 1024, 1024, (size_t)1024 * 1024 * 2}; MoeOrder Mo{4, nR * 4, G, c, tile_e};
            EpiSwiGLU E{HID}; MoeRows RW{rb, LTOK};
            { PROBE_WRAP(MoeOrder, Mo); pg8::gemm_phase<EpiSwiGLU, PROBE_SCHED(MoeOrder), true, true, MoeRows>(glds, g, PS_, E, tid, RW); }
        }
        PH_END();
        if (PH_ON()) { DECL_PTRS();
            LAS int* tile_e = (LAS int*)(lds + LDS_MISC); LAS int* rb = tile_e + 320; LAS int* nt_p = tile_e + 400;
            moe_tables(ctl, l, tile_e, rb, nt_p, tid);
            const int nR = nt_p[0];
            pg8::Gemm g{HID, W2, nR * 256, 1024, 512, (size_t)1024 * 512 * 2}; MoeOrder Mo{4, nR * 4, G, c, tile_e};
            EpiPlain E{Y, 1024};
            { PROBE_WRAP(MoeOrder, Mo); pg8::gemm_phase<EpiPlain, PROBE_SCHED(MoeOrder), true, true>(glds, g, PS_, E, tid); }
        }
        PH_END();
        if (PH_ON()) { DECL_PTRS();
            LAS int* tile_e = (LAS int*)(lds + LDS_MISC); LAS int* rb = tile_e + 320; LAS int* nt_p = tile_e + 400;
            moe_tables(ctl, l, tile_e, rb, nt_p, tid);
            constexpr int RJ = 4;
            for (int t0 = gw * RJ; t0 < T; t0 += NGW * RJ) {
                const int b = t0 / S; const float* mo = MOD + (size_t)(l * 2 + b) * 6144;
                int r0[RJ], r1[RJ]; float w0[RJ], w1[RJ];
#pragma unroll
                for (int u = 0; u < RJ; ++u) { const int t = t0 + u; { const int e0_ = TOKES[2 * t], e1_ = TOKES[2 * t + 1]; r0[u] = rb[e0_ >> 15] + (e0_ & 32767); r1[u] = rb[e1_ >> 15] + (e1_ & 32767); } w0[u] = TOKW[2 * t]; w1[u] = TOKW[2 * t + 1];
#ifdef PROBE_MASK
                    if (a.probe_var == 4 || a.probe_var == -4) { w0[u] *= 0.5f; w1[u] *= 0.5f; }
#endif
                }
                f32x4 v[RJ][4]; u32x2 ya[RJ][4], yb[RJ][4];
#pragma unroll
                for (int u = 0; u < RJ; ++u)
#pragma unroll
                    for (int j = 0; j < 4; ++j) { const int col = 4 * lane + 256 * j; { const u32x2 xw = *(const u32x2*)(XB + (size_t)(t0 + u) * 1024 + col); v[u][j] = (f32x4){bflo(xw.x), bfhi(xw.x), bflo(xw.y), bfhi(xw.y)}; }
                        ya[u][j] = *(const u32x2*)(Y + (size_t)r0[u] * 1024 + col); yb[u][j] = *(const u32x2*)(Y + (size_t)r1[u] * 1024 + col); }
                f32x4 gg[4];
#pragma unroll
                for (int j = 0; j < 4; ++j) gg[j] = *(const f32x4*)(mo + 5120 + 4 * lane + 256 * j);
                float ss[RJ];
#pragma unroll
                for (int u = 0; u < RJ; ++u) { ss[u] = 0.f;
#pragma unroll
                    for (int j = 0; j < 4; ++j) { const int col = 4 * lane + 256 * j; const f32x4 xv = v[u][j]; f32x4 nv;
                        nv.x = xv.x + gg[j].x * (w0[u] * bflo(ya[u][j].x) + w1[u] * bflo(yb[u][j].x)); nv.y = xv.y + gg[j].y * (w0[u] * bfhi(ya[u][j].x) + w1[u] * bfhi(yb[u][j].x));
                        nv.z = xv.z + gg[j].z * (w0[u] * bflo(ya[u][j].y) + w1[u] * bflo(yb[u][j].y)); nv.w = xv.w + gg[j].w * (w0[u] * bfhi(ya[u][j].y) + w1[u] * bfhi(yb[u][j].y));
                        if (l + 1 < DEPTH) { u32x2 xw; xw.x = pk2(nv.x, nv.y); xw.y = pk2(nv.z, nv.w); *(u32x2*)(XB + (size_t)(t0 + u) * 1024 + col) = xw; nv = (f32x4){bflo(xw.x), bfhi(xw.x), bflo(xw.y), bfhi(xw.y)}; }
                        else *(f32x4*)(out + (size_t)(t0 + u) * 1024 + col) = nv;
                        v[u][j] = nv; ss[u] += (nv.x * nv.x + nv.y * nv.y) + (nv.z * nv.z + nv.w * nv.w); } }
                if (l + 1 < DEPTH) {
                    const float* mn = MOD + (size_t)((l + 1) * 2 + b) * 6144;
                    f32x4 sc1[4], sh1[4];
#pragma unroll
                    for (int j = 0; j < 4; ++j) { sc1[j] = *(const f32x4*)(mn + 1024 + 4 * lane + 256 * j); sh1[j] = *(const f32x4*)(mn + 4 * lane + 256 * j); }
#pragma unroll
                    for (int u = 0; u < RJ; ++u) { const float rn = rsqrtf(wave_sum(ss[u]) * (1.0f / 1024.0f) + EPS);
#pragma unroll
                        for (int j = 0; j < 4; ++j) { const int col = 4 * lane + 256 * j;
                            u32x2 w; w.x = pk2(v[u][j].x * rn * (1.f + sc1[j].x) + sh1[j].x, v[u][j].y * rn * (1.f + sc1[j].y) + sh1[j].y); w.y = pk2(v[u][j].z * rn * (1.f + sc1[j].z) + sh1[j].z, v[u][j].w * rn * (1.f + sc1[j].w) + sh1[j].w);
                            *(u32x2*)(H + (size_t)(t0 + u) * 1024 + col) = w; } }
                }
            }
        }
        PH_END();
    }
#undef PH_ON
#undef PH_END
}

extern "C" void kernel_launch(void* const* d_in, const int* in_sizes, int n_in, void* d_out, int out_size, void* d_ws, size_t ws_size, hipStream_t stream) {
    static int grid = 0;
    if (grid == 0) {
        if (n_in != 37 || out_size != T * D || ws_size < WS_END) { fprintf(stderr, "kernel_launch: unexpected shapes (n_in %d, out %d, ws %zu); nothing launched\n", n_in, out_size, ws_size); grid = -1; return; }
        int dev = 0, cus = 0, per_cu = 0;
        if (hipGetDevice(&dev) != hipSuccess || hipDeviceGetAttribute(&cus, hipDeviceAttributeMultiprocessorCount, dev) != hipSuccess) { grid = -1; return; }
        if (hipFuncSetAttribute((const void*)fwd, hipFuncAttributeMaxDynamicSharedMemorySize, LDS_BYTES) != hipSuccess) { fprintf(stderr, "kernel_launch: hipFuncSetAttribute failed\n"); grid = -1; return; }
        if (hipOccupancyMaxActiveBlocksPerMultiprocessor(&per_cu, (const void*)fwd, NTHREADS, LDS_BYTES) != hipSuccess || per_cu < 1) fprintf(stderr, "kernel_launch: occupancy query says %d\n", per_cu);
        (void)hipGetLastError();
        grid = cus;
    }
    if (grid < 0) return;
    if (hipMemsetAsync((char*)d_ws + WS_CTL, 0, CTL_ZERO_BYTES, stream) != hipSuccess) return;
    Args a{};
    for (int i = 0; i < 37; ++i) a.in[i] = d_in[i];
    a.out = (float*)d_out; a.ws = (unsigned char*)d_ws;
#ifdef PROBE_MASK
#ifndef PROBE_VAR
#define PROBE_VAR 0
#endif
    {
        int types[N_PHASES]; int n = 0; types[n++] = 0; types[n++] = 1; types[n++] = 2;
        for (int l = 0; l < DEPTH; ++l) { if ((l & 1) == 0) { for (int k = 3; k <= 7; ++k) if (k != 4 && k != 6) types[n++] = k; } else { for (int k = 8; k <= 13; ++k) if (k != 9) types[n++] = k; } for (int k = 14; k <= 19; ++k) if (k != 16) types[n++] = k; }
        for (int p = 0; p < N_PHASES; ++p) { a.ph_lo = p; a.ph_hi = p + 1; const int reps = ((PROBE_MASK >> types[p]) & 1) ? 2 : 1;
            for (int r = 0; r < reps; ++r) { a.probe_var = (reps == 2) ? ((r == 0) ? PROBE_VAR : -PROBE_VAR) : 0; hipLaunchKernelGGL(fwd, dim3(grid), dim3(NTHREADS), LDS_BYTES, stream, a); } }
    }
#elif MK_ONE_LAUNCH
    a.ph_lo = 0; a.ph_hi = N_PHASES;
    hipLaunchKernelGGL(fwd, dim3(grid), dim3(NTHREADS), LDS_BYTES, stream, a);
#else
    for (int p = 0; p < N_PHASES; ++p) { a.ph_lo = p; a.ph_hi = p + 1; hipLaunchKernelGGL(fwd, dim3(grid), dim3(NTHREADS), LDS_BYTES, stream, a); }
#endif
}
```

```cpp
#include <hip/hip_runtime.h>
#include <cstdio>
#include <cstdint>
#include <hip/hip_bf16.h>
#include <cmath>
#ifndef MK_ONE_LAUNCH
#define MK_ONE_LAUNCH 1
#endif
namespace pg8 {
#define PG8_LAS __attribute__((address_space(3)))
typedef unsigned short bf16_t;
typedef short bf16x8 __attribute__((ext_vector_type(8)));
typedef float f32x4 __attribute__((ext_vector_type(4)));
typedef unsigned u32x4 __attribute__((ext_vector_type(4)));
constexpr int BM = 256, BK = 64, HALF = 128, HTB = HALF * BK * 2  , STAGE_BYTES = 8 * HTB, NXCD = 8, WGM = 8;

__host__ __device__ __forceinline__ int lds_byte(int r, int c) { const int st = (r >> 4) * 2 + (c >> 5), rr = r & 15, cc = c & 31, ob = rr * 64 + cc * 2; return st * 1024 + (ob ^ (((ob >> 9) & 1) << 5)); }
__host__ __device__ __forceinline__ void stage_rc(int b, int& R, int& C) { const int st = b / 1024, sb = b % 1024, swz = sb ^ (((sb >> 9) & 1) << 5); R = (st >> 1) * 16 + swz / 64; C = (st & 1) * 32 + (swz % 64) / 2; }
__host__ __device__ __forceinline__ int perm32(int rho) { const int n = rho >> 4, i = rho & 15; return 8 * (i >> 2) + 4 * n + (i & 3); }

struct Unit { int pm, pn, be; };
struct Gemm { const bf16_t* A; const bf16_t* Bt; int M, N, K; size_t bstride; };

struct StaticOrder {
    int nM, nN, nwg, G, c;
    __host__ __device__ void init(int M, int N, int G_, int c_) { nM = M / BM; nN = N / BM; nwg = nM * nN; G = G_; c = c_; }
    __host__ __device__ bool next(int i, Unit& u) const {
        const long L = (long)i * G + c; if (L >= nwg) return false;
        int wgid = (int)L; { const int q = nwg / NXCD, r = nwg % NXCD, xcd = wgid % NXCD, off = wgid / NXCD; wgid = (xcd < r ? xcd * (q + 1) : r * (q + 1) + (xcd - r) * q) + off; }
        const int nig = WGM * nN, gid = wgid / nig, fm = gid * WGM, gsz = (nM - fm) < WGM ? (nM - fm) : WGM;
        u.pm = fm + ((wgid % nig) % gsz); u.pn = (wgid % nig) / gsz; u.be = 0; return true;
    }
    __device__ __forceinline__ void a_ready(const Unit&) const {}
    __device__ __forceinline__ void done(const Unit&) const {}
};

__device__ __forceinline__ unsigned cvt_pk_bf16(float lo, float hi) { unsigned r; asm volatile("v_cvt_pk_bf16_f32 %0, %1, %2" : "=v"(r) : "v"(lo), "v"(hi)); return r; }
typedef float f32x2 __attribute__((ext_vector_type(2)));
struct NoRows { static constexpr bool GATHER = false; __device__ __forceinline__ unsigned operator()(const Unit&, int) const { return 0u; } };
template <class Epi, class Sched, bool ALIGN_EPI = false, bool SP2 = false, class Rows = NoRows>
__device__ __forceinline__ void gemm_phase(PG8_LAS unsigned char* lds, const Gemm g, const Sched& S, const Epi& E, const int tid_in, const Rows& RW = Rows()) {
    const int tid = tid_in, wid = __builtin_amdgcn_readfirstlane(tid >> 6), lane = tid & 63, wr = wid >> 2, wc = wid & 3, fr = lane & 15, fq = lane >> 4;
    const int K = g.K, nt = K / BK;
    unsigned voffA[2], voffB[2];
#pragma unroll
    for (int i = 0; i < 2; ++i) { int R, C; stage_rc(tid * 16 + i * 8192, R, C); const int Rb = Epi::PERM ? ((R & ~31) + perm32(R & 31)) : R;
        voffA[i] = (unsigned)(R * K + C) * 2u; voffB[i] = (unsigned)(Rb * K + C) * 2u; }
    const size_t kstep = (size_t)(BK * 2);
    const size_t hstep = (size_t)HALF * K * 2;
    const size_t tstep = 2 * hstep;
    const unsigned ldsw = (unsigned)wid * 1024u;
    const int aoff = lds_byte(wr * 64 + fr, fq * 8), boff = lds_byte(wc * 32 + fr, fq * 8);
#define PG8_SA(b, h) (((b) * 2 + (h)) * HTB)
#define PG8_SB(b, h) ((4 + (b) * 2 + (h)) * HTB)
#define PG8_STAGE(bufoff, gbase, voff) do { _Pragma("unroll") for (int _i = 0; _i < 2; ++_i) \
        __builtin_amdgcn_global_load_lds((const unsigned*)((const char*)(gbase) + (voff)[_i]), (PG8_LAS unsigned*)(lds + (bufoff) + ldsw + _i * 8192), 16, 0, 0); } while (0)
#define PG8_LDA(dst, b, h) do { _Pragma("unroll") for (int m = 0; m < 4; ++m) _Pragma("unroll") for (int k = 0; k < 2; ++k) dst[m][k] = *(const PG8_LAS bf16x8*)(lds + PG8_SA(b, h) + aoff + m * 2048 + k * 1024); } while (0)
#define PG8_LDB(dst, b, h) do { _Pragma("unroll") for (int n = 0; n < 2; ++n) _Pragma("unroll") for (int k = 0; k < 2; ++k) dst[n][k] = *(const PG8_LAS bf16x8*)(lds + PG8_SB(b, h) + boff + n * 2048 + k * 1024); } while (0)
#define PG8_MMA(ai, bj, At, Bt) do { __builtin_amdgcn_s_setprio(1); _Pragma("unroll") for (int m = 0; m < 4; ++m) _Pragma("unroll") for (int n = 0; n < 2; ++n) _Pragma("unroll") for (int k = 0; k < 2; ++k) \
        acc[ai][bj][m][n] = __builtin_amdgcn_mfma_f32_16x16x32_bf16(Bt[n][k], At[m][k], acc[ai][bj][m][n], 0, 0, 0); __builtin_amdgcn_s_setprio(0); } while (0)
#define PG8_WAIT_V(n) asm volatile("s_waitcnt vmcnt(" #n ")" ::: "memory")
#define PG8_WAIT_L(n) asm volatile("s_waitcnt lgkmcnt(" #n ")" ::: "memory")
#define PG8_BAR __builtin_amdgcn_s_barrier()
#define PG8_SCHED __builtin_amdgcn_sched_barrier(0)
    Unit cur, nxt; int ui = 0;
    if (!S.next(0, cur)) return;
    f32x4 acc[2][2][4][2];
#pragma unroll
    for (int a = 0; a < 2; ++a)
#pragma unroll
        for (int b = 0; b < 2; ++b)
#pragma unroll
            for (int m = 0; m < 4; ++m)
#pragma unroll
                for (int n = 0; n < 2; ++n) { float z0_ = 0.f; asm volatile("" : "+v"(z0_)); acc[a][b][m][n] = (f32x4){z0_, z0_, z0_, z0_}; }
    bf16x8 At[4][2], B0[2][2], B1[2][2];
    const char* cA = Rows::GATHER ? (const char*)g.A : (const char*)g.A + (size_t)cur.pm * tstep; const char* cB = (const char*)g.Bt + (size_t)cur.be * g.bstride + (size_t)cur.pn * tstep;
    int Rr[2], Cc[2];
#pragma unroll
    for (int i = 0; i < 2; ++i) stage_rc(tid * 16 + i * 8192, Rr[i], Cc[i]);
    unsigned voffAh[2][2], voffAn[2][2];
#pragma unroll
    for (int h = 0; h < 2; ++h)
#pragma unroll
        for (int i = 0; i < 2; ++i) { voffAh[h][i] = Rows::GATHER ? RW(cur, h * HALF + Rr[i]) + (unsigned)Cc[i] * 2u : voffA[i] + (unsigned)h * (unsigned)hstep; voffAn[h][i] = voffAh[h][i]; }
    S.a_ready(cur);
    if constexpr (SP2) {
        PG8_STAGE(PG8_SB(0, 0), cB, voffB); PG8_STAGE(PG8_SB(0, 1), cB + hstep, voffB); PG8_STAGE(PG8_SA(0, 0), cA, voffAh[0]); PG8_STAGE(PG8_SA(0, 1), cA, voffAh[1]);
        if (wr == 1) PG8_BAR;
        PG8_WAIT_V(2); PG8_BAR;
        PG8_STAGE(PG8_SB(1, 0), cB + kstep, voffB); PG8_STAGE(PG8_SA(1, 0), cA + kstep, voffAh[0]); PG8_STAGE(PG8_SB(1, 1), cB + hstep + kstep, voffB);
        PG8_WAIT_V(6); PG8_BAR;
    } else {
        PG8_STAGE(PG8_SB(0, 0), cB, voffB); PG8_STAGE(PG8_SA(0, 0), cA, voffAh[0]); PG8_STAGE(PG8_SB(0, 1), cB + hstep, voffB); PG8_STAGE(PG8_SA(0, 1), cA, voffAh[1]);
        if (wr == 1) PG8_BAR;
        PG8_WAIT_V(4); PG8_BAR;
        PG8_STAGE(PG8_SB(1, 0), cB + kstep, voffB); PG8_STAGE(PG8_SA(1, 0), cA + kstep, voffAh[0]); PG8_STAGE(PG8_SB(1, 1), cB + hstep + kstep, voffB);
        PG8_WAIT_V(6); PG8_BAR;
    }
    for (;;) {
        const bool has_next = S.next(ui + 1, nxt);
        const char* nA = Rows::GATHER ? (const char*)g.A : (has_next ? (const char*)g.A + (size_t)nxt.pm * tstep : cA);
        if constexpr (Rows::GATHER) { if (has_next) {
#pragma unroll
            for (int h = 0; h < 2; ++h)
#pragma unroll
                for (int i = 0; i < 2; ++i) voffAn[h][i] = RW(nxt, h * HALF + Rr[i]) + (unsigned)Cc[i] * 2u; } } const char* nB = has_next ? (const char*)g.Bt + (size_t)nxt.be * g.bstride + (size_t)nxt.pn * tstep : cB;
        for (int t = 0; t < nt; t += 2) {
            const bool last = (t == nt - 2); const bool gsel = Rows::GATHER && last && has_next;
            const char* a1 = cA + (size_t)(t + 1) * kstep;
            const char* a2 = last ? nA : cA + (size_t)(t + 2) * kstep; const char* b2 = last ? nB : cB + (size_t)(t + 2) * kstep;
            const char* a3 = a2 + kstep; const char* b3 = b2 + kstep;
            if (last && has_next) S.a_ready(nxt);
            if constexpr (SP2) {
            PG8_LDB(B0, 0, 0); PG8_LDB(B1, 0, 1); PG8_SCHED; PG8_LDA(At, 0, 0); PG8_STAGE(PG8_SA(1, 1), a1, voffAh[1]);
            PG8_WAIT_V(8); PG8_WAIT_L(0); PG8_BAR; PG8_MMA(0, 0, At, B0); PG8_MMA(0, 1, At, B1); PG8_BAR; PG8_SCHED;
            PG8_LDA(At, 0, 1); PG8_STAGE(PG8_SB(0, 0), b2, voffB); PG8_STAGE(PG8_SB(0, 1), b2 + hstep, voffB); PG8_STAGE(PG8_SA(0, 0), a2, (gsel ? voffAn[0] : voffAh[0]));
            PG8_WAIT_V(8); PG8_WAIT_L(0); PG8_BAR; PG8_MMA(1, 0, At, B0); PG8_MMA(1, 1, At, B1); PG8_BAR; PG8_SCHED;
            PG8_LDB(B0, 1, 0); PG8_LDB(B1, 1, 1); PG8_SCHED; PG8_LDA(At, 1, 0); PG8_STAGE(PG8_SA(0, 1), a2, (gsel ? voffAn[1] : voffAh[1]));
            PG8_WAIT_V(8); PG8_WAIT_L(0); PG8_BAR; PG8_MMA(0, 0, At, B0); PG8_MMA(0, 1, At, B1); PG8_BAR; PG8_SCHED;
            PG8_LDA(At, 1, 1); PG8_STAGE(PG8_SB(1, 0), b3, voffB); PG8_STAGE(PG8_SB(1, 1), b3 + hstep, voffB); PG8_STAGE(PG8_SA(1, 0), a3, (gsel ? voffAn[0] : voffAh[0]));
            PG8_WAIT_V(8); PG8_WAIT_L(0); PG8_BAR; PG8_MMA(1, 0, At, B0); PG8_MMA(1, 1, At, B1); PG8_BAR; PG8_SCHED;
            } else {
            PG8_LDB(B0, 0, 0); PG8_SCHED; PG8_LDA(At, 0, 0); PG8_STAGE(PG8_SA(1, 1), a1, voffAh[1]);
            PG8_WAIT_L(8); PG8_BAR; PG8_WAIT_L(0); PG8_MMA(0, 0, At, B0); PG8_BAR; PG8_SCHED;
            PG8_LDB(B1, 0, 1); PG8_STAGE(PG8_SB(0, 0), b2, voffB);
            PG8_BAR; PG8_WAIT_L(0); PG8_MMA(0, 1, At, B1); PG8_BAR;
            PG8_LDA(At, 0, 1); PG8_STAGE(PG8_SA(0, 0), a2, (gsel ? voffAn[0] : voffAh[0]));
            PG8_BAR; PG8_WAIT_L(0); PG8_MMA(1, 0, At, B0); PG8_BAR; PG8_SCHED;
            PG8_STAGE(PG8_SB(0, 1), b2 + hstep, voffB);
            PG8_WAIT_V(6); PG8_BAR; PG8_MMA(1, 1, At, B1); PG8_BAR;
            PG8_LDB(B0, 1, 0); PG8_SCHED; PG8_LDA(At, 1, 0); PG8_STAGE(PG8_SA(0, 1), a2, (gsel ? voffAn[1] : voffAh[1]));
            PG8_WAIT_L(8); PG8_BAR; PG8_WAIT_L(0); PG8_MMA(0, 0, At, B0); PG8_BAR; PG8_SCHED;
            PG8_LDB(B1, 1, 1); PG8_STAGE(PG8_SB(1, 0), b3, voffB);
            PG8_BAR; PG8_WAIT_L(0); PG8_MMA(0, 1, At, B1); PG8_BAR;
            PG8_LDA(At, 1, 1); PG8_STAGE(PG8_SA(1, 0), a3, (gsel ? voffAn[0] : voffAh[0]));
            PG8_BAR; PG8_WAIT_L(0); PG8_MMA(1, 0, At, B0); PG8_BAR; PG8_SCHED;
            PG8_STAGE(PG8_SB(1, 1), b3 + hstep, voffB);
            PG8_WAIT_V(6); PG8_BAR; PG8_MMA(1, 1, At, B1); PG8_BAR;
            }
        }
        if constexpr (ALIGN_EPI) { if (wr == 0) PG8_BAR; }
        if constexpr (!Epi::AFTER_DRAIN) { int l2_; asm volatile("v_mbcnt_lo_u32_b32 %0, -1, 0\n\tv_mbcnt_hi_u32_b32 %0, -1, %0" : "=v"(l2_)); E(acc, cur, wr, wc, l2_ & 15, l2_ >> 4); S.done(cur); }
        if (!has_next) break;
#pragma unroll
        for (int a = 0; a < 2; ++a)
#pragma unroll
            for (int b = 0; b < 2; ++b)
#pragma unroll
                for (int m = 0; m < 4; ++m)
#pragma unroll
                    for (int n = 0; n < 2; ++n) { float z0_ = 0.f; asm volatile("" : "+v"(z0_)); acc[a][b][m][n] = (f32x4){z0_, z0_, z0_, z0_}; }
        cur = nxt; cA = nA; cB = nB; ++ui;
        if constexpr (Rows::GATHER) {
#pragma unroll
            for (int h = 0; h < 2; ++h)
#pragma unroll
                for (int i = 0; i < 2; ++i) voffAh[h][i] = voffAn[h][i]; }
        if constexpr (ALIGN_EPI) { if (wr == 1) PG8_BAR; }
    }
    PG8_WAIT_V(0);
    if constexpr (!ALIGN_EPI) { if (wr == 0) PG8_BAR; }
    PG8_BAR;
    if constexpr (Epi::AFTER_DRAIN) { E.fused(acc, cur, wr, wc, fr, fq, lds, wid, lane); S.done(cur); }
#undef PG8_SA
#undef PG8_SB
#undef PG8_STAGE
#undef PG8_LDA
#undef PG8_LDB
#undef PG8_MMA
#undef PG8_WAIT_V
#undef PG8_WAIT_L
#undef PG8_BAR
#undef PG8_SCHED
}
}
namespace attn_body {
using bf16=__hip_bfloat16;
using bf16x8=__attribute__((ext_vector_type(8)))short;
using s16x4=__attribute__((ext_vector_type(4)))short;
using f32x16=__attribute__((ext_vector_type(16)))float;
using u32x4=__attribute__((ext_vector_type(4)))unsigned;
constexpr int D=64;
constexpr int NW=8,QBLK=32,QB=QBLK*NW,KVBLK=64;
constexpr int ATTN_UNIT_ROWS=QB;
__device__ __forceinline__ int crow(int r,int hi){return (r&3)+8*(r>>2)+4*hi;}
#define SBAR() __builtin_amdgcn_sched_barrier(0)
__device__ __forceinline__ void cmask(f32x16&p0,f32x16&p1,int jb,int qrel,int hi){
  const float NEG=-INFINITY; int kb=64*jb+4*hi;
  #pragma unroll
  for(int r=0;r<16;++r){int kv=kb+(r&3)+8*(r>>2); if(kv>qrel)p0[r]=NEG; if(kv+32>qrel)p1[r]=NEG;}
}

constexpr int NSLOT=3, SLOTB=8192;
constexpr int LDS_K=0, LDS_V=NSLOT*SLOTB, LDS_WS=2*NSLOT*SLOTB, LDS_OST=LDS_WS+NW*64*4, LDS_BYTES=LDS_OST+NW*4096;
constexpr float C2=0.125f*1.4426950408889634f;
__device__ __forceinline__ void glds16(const void*gsrc,unsigned lds_dst){unsigned keep;
  asm volatile("s_mov_b32 %0, m0\n\ts_mov_b32 m0, %2\n\ts_nop 0\n\tglobal_load_lds_dwordx4 %1, off\n\ts_mov_b32 m0, %0":"=&s"(keep):"v"(gsrc),"s"(lds_dst):"memory");}
__device__ __forceinline__ float max3f(float a,float b,float c){float r;asm("v_max3_f32 %0, %1, %2, %3":"=v"(r):"v"(a),"v"(b),"v"(c));return r;}
__device__ __forceinline__ float max2f(float a,float b){float r;asm("v_max_f32_e32 %0, %1, %2":"=v"(r):"v"(a),"v"(b));return r;}
__device__ __forceinline__ float fadd_s(float a,float b){float r;asm("v_add_f32_e32 %0, %1, %2":"=v"(r):"v"(a),"v"(b));return r;}
__device__ __forceinline__ float fsub_s(float a,float b){float r;asm("v_sub_f32_e32 %0, %1, %2":"=v"(r):"v"(a),"v"(b));return r;}
typedef float f32x2_t __attribute__((ext_vector_type(2))); typedef __bf16 bf16x2_t __attribute__((ext_vector_type(2)));
__device__ __forceinline__ unsigned cvtpk_s(float lo,float hi){f32x2_t v={lo,hi};bf16x2_t b=__builtin_convertvector(v,bf16x2_t);return __builtin_bit_cast(unsigned,b);}
#define WAIT_BAR(N) asm volatile("s_waitcnt vmcnt(" #N ") lgkmcnt(0)\n\ts_barrier":::"memory")

__device__ __forceinline__ void qkt(f32x16&p0,f32x16&p1,const char*Kslot,const bf16x8*qr,const f32x16&negm,int r32,int hi){
  const char*kb=Kslot+hi*1024+r32*16;
  #pragma unroll
  for(int d0=0;d0<4;++d0){
    const bf16x8 b0=*reinterpret_cast<const bf16x8*>(kb+d0*2048);
    const bf16x8 b1=*reinterpret_cast<const bf16x8*>(kb+d0*2048+512);
    if(d0==0){p0=__builtin_amdgcn_mfma_f32_32x32x16_bf16(b0,qr[0],negm,0,0,0);p1=__builtin_amdgcn_mfma_f32_32x32x16_bf16(b1,qr[0],negm,0,0,0);}
    else{p0=__builtin_amdgcn_mfma_f32_32x32x16_bf16(b0,qr[d0],p0,0,0,0);p1=__builtin_amdgcn_mfma_f32_32x32x16_bf16(b1,qr[d0],p1,0,0,0);}}
}
typedef __attribute__((address_space(3))) const char* lds_cptr;
typedef short v4i16_t __attribute__((ext_vector_type(4)));
__device__ __forceinline__ void kload8(bf16x8*kf,lds_cptr kp){
  kf[0]=*(const __attribute__((address_space(3))) bf16x8*)(kp);      kf[1]=*(const __attribute__((address_space(3))) bf16x8*)(kp+512);
  kf[2]=*(const __attribute__((address_space(3))) bf16x8*)(kp+2048); kf[3]=*(const __attribute__((address_space(3))) bf16x8*)(kp+2560);
  kf[4]=*(const __attribute__((address_space(3))) bf16x8*)(kp+4096); kf[5]=*(const __attribute__((address_space(3))) bf16x8*)(kp+4608);
  kf[6]=*(const __attribute__((address_space(3))) bf16x8*)(kp+6144); kf[7]=*(const __attribute__((address_space(3))) bf16x8*)(kp+6656);
}
__device__ __forceinline__ void kload2(bf16x8*kf,lds_cptr kp,int j){ kf[2*j]=*(const __attribute__((address_space(3))) bf16x8*)(kp+j*2048); kf[2*j+1]=*(const __attribute__((address_space(3))) bf16x8*)(kp+j*2048+512); }
__device__ __forceinline__ s16x4 vtr(lds_cptr p){ return __builtin_bit_cast(s16x4,__builtin_amdgcn_ds_read_tr16_b64_v4i16((__attribute__((address_space(3))) v4i16_t*)p)); }
__device__ __forceinline__ float rowmax(const f32x16&p0,const f32x16&p1){
  float a=max3f(p0[0],p0[1],p1[0]),b=max3f(p0[2],p0[3],p1[1]);a=max3f(a,p1[2],p1[3]);
  #pragma unroll
  for(int r=4;r<16;r+=4){a=max3f(a,p0[r],p0[r+1]);b=max3f(b,p0[r+2],p0[r+3]);a=max3f(a,p1[r],p1[r+1]);b=max3f(b,p1[r+2],p1[r+3]);}
  const float m=max2f(a,b);
  auto rr=__builtin_amdgcn_permlane32_swap(__float_as_uint(m),__float_as_uint(m),false,false);
  return max2f(__uint_as_float(rr[0]),__uint_as_float(rr[1]));
}
__device__ __forceinline__ void pv(f32x16*o,int vb,bf16x8 pa0,bf16x8 pa1,bf16x8 pa2,bf16x8 pa3){
  #pragma unroll
  for(int d0=0;d0<2;++d0){s16x4 lo[4],hi[4];
    #pragma unroll
    for(int ks=0;ks<4;++ks){
      asm volatile("ds_read_b64_tr_b16 %0,%1 offset:%c2":"=&v"(lo[ks]):"v"(vb),"i"(d0*4096+ks*1024):"memory");
      asm volatile("ds_read_b64_tr_b16 %0,%1 offset:%c2":"=&v"(hi[ks]):"v"(vb),"i"(d0*4096+ks*1024+512):"memory");}
    asm volatile("s_waitcnt lgkmcnt(0)":::"memory");SBAR();
    #define PK(k) (bf16x8){lo[k][0],lo[k][1],lo[k][2],lo[k][3],hi[k][0],hi[k][1],hi[k][2],hi[k][3]}
    o[d0]=__builtin_amdgcn_mfma_f32_32x32x16_bf16(pa0,PK(0),o[d0],0,0,0);
    o[d0]=__builtin_amdgcn_mfma_f32_32x32x16_bf16(pa1,PK(1),o[d0],0,0,0);
    o[d0]=__builtin_amdgcn_mfma_f32_32x32x16_bf16(pa2,PK(2),o[d0],0,0,0);
    o[d0]=__builtin_amdgcn_mfma_f32_32x32x16_bf16(pa3,PK(3),o[d0],0,0,0);
    #undef PK
  }
}

#ifndef ATTN_STORE16
#define ATTN_STORE16(p,v) (*(u32x4*)(p)=(v))
#endif
template<int THRL,int PIN,int POUT> __device__ __forceinline__ void attn_unit(int qb,const bf16*Qh,const bf16*__restrict__ Kh,const bf16*__restrict__ Vh,bf16*Oh,char*shm,const int wid_in){
  constexpr int DM=PIN;
  int lane; asm volatile("v_mbcnt_lo_u32_b32 %0, -1, 0\n\tv_mbcnt_hi_u32_b32 %0, -1, %0" : "=v"(lane));
  const int wid=wid_in; const int tid=wid*64+lane; const int r32=lane&31,hi=lane>>5;
  const int q0=qb*QB;
  const bf16*Qw=Qh+(long)(q0+wid*QBLK)*DM;
  const unsigned lds0=(unsigned)(uintptr_t)shm;
  float*wsf=(float*)(shm+LDS_WS)+wid*64;
  const bf16*ksrc=Kh+(long)lane*DM+wid*8;
  const bf16*vsrc=Vh+(long)(16*(wid&3)+(lane>>2))*DM+(wid>>2)*32+(lane&3)*8;
  const unsigned kdst=lds0+LDS_K+wid*1024, vdst=lds0+LDS_V+wid*1024;
  #define DMA_K(t,slot) glds16(ksrc+(long)(t)*KVBLK*DM,(unsigned)__builtin_amdgcn_readfirstlane(kdst+(slot)))
  #define DMA_V(t,slot) glds16(vsrc+(long)(t)*KVBLK*DM,(unsigned)__builtin_amdgcn_readfirstlane(vdst+(slot)))
  const int vb0=(int)(lds0+LDS_V)+((lane>>4)&1)*32+(lane&3)*8+(4*hi+((lane&15)>>2))*64;
  const char*Kbase=shm+LDS_K; bf16x8 kf[8];
  const lds_cptr shm3=(lds_cptr)shm; const lds_cptr kp0=shm3+LDS_K+hi*1024+r32*16; const lds_cptr vp0=shm3+LDS_V+((lane>>4)&1)*32+(lane&3)*8+(4*hi+((lane&15)>>2))*64;
  const int NT=(q0+QB)/KVBLK;
  DMA_K(0,0);DMA_V(0,0);DMA_K(1,SLOTB);
  bf16x8 qr[4];
  #pragma unroll
  for(int d0=0;d0<4;++d0)qr[d0]=*reinterpret_cast<const bf16x8*>(&Qw[(long)r32*DM+d0*16+hi*8]);
  float mhat=0.f,l_reg=0.f;f32x16 o[2];f32x16 negm;{float z0_=0.f;asm volatile("":"+v"(z0_));
  #pragma unroll
  for(int r=0;r<16;++r){o[0][r]=z0_;o[1][r]=z0_;negm[r]=z0_;}}asm volatile("":"+v"(negm));
  const int qrel=wid*QBLK+r32;
  #define CMASK(P0,P1,t) do{int jb_=(t)-(NT-4); if(jb_>=0)cmask(P0,P1,jb_,qrel,hi);}while(0)
  bool resc=false;
  #define START(P0,P1) do{ const float rm=rowmax(P0,P1); resc=false; \
    { const float dl=rm; mhat=fadd_s(mhat,dl); \
      _Pragma("unroll") for(int r=0;r<16;++r){P0[r]=fsub_s(P0[r],dl);P1[r]=fsub_s(P1[r],dl);} \
      _Pragma("unroll") for(int r=0;r<16;++r)negm[r]=-mhat; asm volatile("":"+v"(negm)); } \
    _Pragma("unroll") for(int r=0;r<16;++r)P0[r]=__builtin_amdgcn_exp2f(P0[r]); }while(0)
  #define RESC() do{ if(resc){ asm volatile("s_waitcnt lgkmcnt(0)":::"memory"); \
      _Pragma("unroll") for(int d_=0;d_<2;++d_) _Pragma("unroll") for(int r=0;r<16;++r)o[d_][r]*=wsf[crow(r,hi)]; } }while(0)
  f32x16 pA0,pA1,pB0,pB1;
  int sl_prev=0,sl_cur=0,sl_next=SLOTB;
  #define ROT() do{sl_prev=sl_cur;sl_cur=sl_next;sl_next=(sl_next==(NSLOT-1)*SLOTB)?0:sl_next+SLOTB;}while(0)
  DMA_K(2,2*SLOTB);
  WAIT_BAR(3);
  qkt(pA0,pA1,Kbase,qr,negm,r32,hi);asm volatile("s_nop 15\n\ts_nop 7":"+v"(pA0),"+v"(pA1));CMASK(pA0,pA1,0);
  START(pA0,pA1);
  _Pragma("unroll") for(int r=0;r<16;++r)pA1[r]=__builtin_amdgcn_exp2f(pA1[r]);
  WAIT_BAR(0);
  DMA_K(3,0);DMA_V(1,SLOTB);
  ROT();
  kload8(kf,kp0+sl_cur);
  WAIT_BAR(2);
  s16x4 vlo[8],vhi[8]; u32x4 pw0,pw1,pw2,pw3;
  #define PKW(P,B) cvtpk_s(P[B],P[B+1])
  #define PAF(k) __builtin_bit_cast(bf16x8,pw##k)
  #define VFR(i) (bf16x8){vlo[i][0],vlo[i][1],vlo[i][2],vlo[i][3],vhi[i][0],vhi[i][1],vhi[i][2],vhi[i][3]}
  #define PIN(x) asm volatile("":"+v"(x))
  #define MX3(a,b,c) __builtin_fmaxf(__builtin_fmaxf((a),(b)),(c))
  #define GAPA(MF,A0,A1,A2,A3,W0,W1,PW) do{ MF; sacc+=A0; sacc+=A1; sacc+=A2; sacc+=A3; PIN(sacc); W0; W1; PIN(PW); SBAR(); }while(0)
  #define EX(v) __builtin_amdgcn_exp2f(v)
  #define GAPB(MF,X,B) do{ MF; X[B]=EX(X[B]); X[B+1]=EX(X[B+1]); X[B+2]=EX(X[B+2]); X[B+3]=EX(X[B+3]); PIN(X); SBAR(); }while(0)
  #define VRD(i) do{ vlo[i]=vtr(vp_+(((i)>>2)*4096+((i)&3)*1024)); vhi[i]=vtr(vp_+(((i)>>2)*4096+((i)&3)*1024+512)); }while(0)
  #define KRD(G,j) do{ if(G){ kload2(kf,kp0+sl_next,j); SBAR(); } }while(0)
  #define STEP(C0,C1,P0,P1,t,GK,GV,GL) do{ SBAR(); \
    const lds_cptr vp_=vp0+sl_prev; \
    VRD(0); SBAR(); float sacc=(P0[0]+P0[1]); \
    GAPA(C0=__builtin_amdgcn_mfma_f32_32x32x16_bf16(kf[0],qr[0],negm,0,0,0), P0[2],P0[3],P0[4],P0[5],     pw0[0]=PKW(P0,0), pw0[1]=PKW(P0,2), pw0); \
    VRD(4); SBAR(); GAPA(C1=__builtin_amdgcn_mfma_f32_32x32x16_bf16(kf[1],qr[0],negm,0,0,0), P0[6],P0[7],P0[8],P0[9],     pw0[2]=PKW(P0,4), pw0[3]=PKW(P0,6), pw0); \
    VRD(1); SBAR(); GAPA(C0=__builtin_amdgcn_mfma_f32_32x32x16_bf16(kf[2],qr[1],C0,0,0,0),   P0[10],P0[11],P0[12],P0[13], pw1[0]=PKW(P0,8), pw1[1]=PKW(P0,10), pw1); \
    VRD(5); SBAR(); GAPA(C1=__builtin_amdgcn_mfma_f32_32x32x16_bf16(kf[3],qr[1],C1,0,0,0),   P0[14],P0[15],P1[0],P1[1],   pw1[2]=PKW(P0,12),pw1[3]=PKW(P0,14), pw1); \
    VRD(2); SBAR(); GAPA(C0=__builtin_amdgcn_mfma_f32_32x32x16_bf16(kf[4],qr[2],C0,0,0,0),   P1[2],P1[3],P1[4],P1[5],     pw2[0]=PKW(P1,0), pw2[1]=PKW(P1,2), pw2); \
    VRD(6); SBAR(); GAPA(C1=__builtin_amdgcn_mfma_f32_32x32x16_bf16(kf[5],qr[2],C1,0,0,0),   P1[6],P1[7],P1[8],P1[9],     pw2[2]=PKW(P1,4), pw2[3]=PKW(P1,6), pw2); \
    VRD(3); SBAR(); GAPA(C0=__builtin_amdgcn_mfma_f32_32x32x16_bf16(kf[6],qr[3],C0,0,0,0),   P1[10],P1[11],P1[12],P1[13], pw3[0]=PKW(P1,8), pw3[1]=PKW(P1,10), pw3); \
    VRD(7); SBAR(); GAPA(C1=__builtin_amdgcn_mfma_f32_32x32x16_bf16(kf[7],qr[3],C1,0,0,0),   P1[14],P1[15],0.f,0.f,       pw3[2]=PKW(P1,12),pw3[3]=PKW(P1,14), pw3); \
    l_reg+=sacc; \
    if(GK){DMA_K((t)+3,sl_cur);} if(GV){DMA_V((t)+1,sl_next);} \
    CMASK(C0,C1,t); \
    { float a=MX3(C0[0],C0[1],C1[0]),b=MX3(C0[2],C0[3],C1[1]); a=MX3(a,C1[2],C1[3]); \
      _Pragma("unroll") for(int r=4;r<16;r+=4){a=MX3(a,C0[r],C0[r+1]);b=MX3(b,C0[r+2],C0[r+3]);a=MX3(a,C1[r],C1[r+1]);b=MX3(b,C1[r+2],C1[r+3]);} \
      float rm=__builtin_fmaxf(a,b); { auto rr=__builtin_amdgcn_permlane32_swap(__float_as_uint(rm),__float_as_uint(rm),false,false); rm=__builtin_fmaxf(__uint_as_float(rr[0]),__uint_as_float(rr[1])); } \
      resc=false; \
      if(__builtin_expect(__any(rm>(float)THRL),0)){ const float dl=__builtin_fmaxf(rm,0.f); mhat+=dl; \
        _Pragma("unroll") for(int r=0;r<16;++r){C0[r]-=dl;C1[r]-=dl;} \
        _Pragma("unroll") for(int r=0;r<16;++r)negm[r]=-mhat; asm volatile("":"+v"(negm)); \
        const float f=__builtin_amdgcn_exp2f(-dl); l_reg*=f; if(hi==0)wsf[r32]=f; resc=true; } } \
    SBAR(); \
    GAPB(o[0]=__builtin_amdgcn_mfma_f32_32x32x16_bf16(PAF(0),VFR(0),o[0],0,0,0), C0,0); \
    GAPB(o[1]=__builtin_amdgcn_mfma_f32_32x32x16_bf16(PAF(0),VFR(4),o[1],0,0,0), C0,4); \
    KRD(GL,0); GAPB(o[0]=__builtin_amdgcn_mfma_f32_32x32x16_bf16(PAF(1),VFR(1),o[0],0,0,0), C0,8); \
    KRD(GL,1); GAPB(o[1]=__builtin_amdgcn_mfma_f32_32x32x16_bf16(PAF(1),VFR(5),o[1],0,0,0), C0,12); \
    KRD(GL,2); GAPB(o[0]=__builtin_amdgcn_mfma_f32_32x32x16_bf16(PAF(2),VFR(2),o[0],0,0,0), C1,0); \
    KRD(GL,3); GAPB(o[1]=__builtin_amdgcn_mfma_f32_32x32x16_bf16(PAF(2),VFR(6),o[1],0,0,0), C1,4); \
    GAPB(o[0]=__builtin_amdgcn_mfma_f32_32x32x16_bf16(PAF(3),VFR(3),o[0],0,0,0), C1,8); \
    GAPB(o[1]=__builtin_amdgcn_mfma_f32_32x32x16_bf16(PAF(3),VFR(7),o[1],0,0,0), C1,12); \
    }while(0)
  int t=1;
  #undef CMASK
  #define CMASK(P0,P1,t) do{}while(0)
  for(;t+5<NT;t+=2){
    STEP(pB0,pB1,pA0,pA1,t,true,true,true);     WAIT_BAR(2); RESC(); ROT();
    STEP(pA0,pA1,pB0,pB1,t+1,true,true,true);   WAIT_BAR(2); RESC(); ROT();
  }
  #undef CMASK
  #define CMASK(P0,P1,t) do{int jb_=(t)-(NT-4); if(jb_>=0)cmask(P0,P1,jb_,qrel,hi);}while(0)
  #define ENDW(tt) do{ if((tt)+3<NT){WAIT_BAR(2);} else if((tt)+2<NT){WAIT_BAR(1);} else {WAIT_BAR(0);} }while(0)
  for(;t+1<NT;t+=2){
    STEP(pB0,pB1,pA0,pA1,t,(t+3<NT),(t+1<NT),(t+1<NT));       ENDW(t);   RESC(); ROT();
    STEP(pA0,pA1,pB0,pB1,t+1,(t+4<NT),(t+2<NT),(t+2<NT));     ENDW(t+1); RESC(); ROT();
  }
  STEP(pB0,pB1,pA0,pA1,NT-1,false,false,false); RESC();
  { float sacc=pB0[0]+pB0[1]; _Pragma("unroll") for(int r=2;r<16;++r)sacc+=pB0[r]; _Pragma("unroll") for(int r=0;r<16;++r)sacc+=pB1[r]; l_reg+=sacc;
    pw0=(u32x4){PKW(pB0,0),PKW(pB0,2),PKW(pB0,4),PKW(pB0,6)};pw1=(u32x4){PKW(pB0,8),PKW(pB0,10),PKW(pB0,12),PKW(pB0,14)};pw2=(u32x4){PKW(pB1,0),PKW(pB1,2),PKW(pB1,4),PKW(pB1,6)};pw3=(u32x4){PKW(pB1,8),PKW(pB1,10),PKW(pB1,12),PKW(pB1,14)};
    SBAR(); pv(o,vb0+sl_cur,PAF(0),PAF(1),PAF(2),PAF(3)); }
  #undef PKW
  #undef PAF
  #undef VFR
  #undef PIN
  #undef MX3
  #undef GAPA
  #undef GAPB
  #undef EX
  #undef VRD
  #undef KRD
  #undef STEP
  #undef ENDW
  {auto rr=__builtin_amdgcn_permlane32_swap(__float_as_uint(l_reg),__float_as_uint(l_reg),false,false);l_reg=__uint_as_float(rr[0])+__uint_as_float(rr[1]);}
  if(hi==0)wsf[32+r32]=l_reg;asm volatile("s_waitcnt lgkmcnt(0)":::"memory");
  float rli[16];
  #pragma unroll
  for(int r=0;r<16;++r)rli[r]=__builtin_amdgcn_rcpf(wsf[32+crow(r,hi)]);
  bf16*Ow=Oh+(long)(q0+wid*QBLK)*POUT;
  { bf16*stg=(bf16*)(shm+LDS_OST)+wid*2048;
    #pragma unroll
    for(int r=0;r<16;++r){const int orow=crow(r,hi);
      #pragma unroll
      for(int d0=0;d0<2;++d0)stg[orow*64+d0*32+r32]=__float2bfloat16(o[d0][r]*rli[r]);}
    asm volatile("s_waitcnt lgkmcnt(0)":::"memory");
    #pragma unroll
    for(int i=0;i<4;++i){const int row=i*8+(lane>>3),ch=lane&7; const u32x4 v=*(const u32x4*)(stg+row*64+ch*8); ATTN_STORE16(Ow+(long)row*POUT+ch*8,v);} }
  asm volatile("s_waitcnt lgkmcnt(0)\n\ts_barrier":::"memory");
  #undef DMA_K
  #undef DMA_V
  #undef CMASK
  #undef START
  #undef RESC
  #undef ROT
}
constexpr int ATTN_LDS_BYTES=LDS_BYTES;
#undef SBAR
#undef WAIT_BAR
}

#define LAS __attribute__((address_space(3)))
typedef unsigned short bf16_t;
typedef float f32x4 __attribute__((ext_vector_type(4)));
typedef unsigned u32x4 __attribute__((ext_vector_type(4)));
typedef unsigned u32x2 __attribute__((ext_vector_type(2)));
typedef float f32x2 __attribute__((ext_vector_type(2)));
typedef _Float16 f16x8 __attribute__((ext_vector_type(8)));
typedef _Float16 f16x4 __attribute__((ext_vector_type(4)));

constexpr int NB = 2, S = 16384, T = NB * S, D = 1024, DEPTH = 4;
constexpr int EV_N = 3368, EV_NP = 3584, EV_ZP = 3072, OD_N = 2048;
constexpr float EPS = 1e-6f;
constexpr float LOG2E = 1.4426950408889634f;
constexpr float QSCALE = 0.125f * LOG2E;
constexpr int NWAVES = 8, NTHREADS = 512;
constexpr int LDS_BYTES = 163840;
constexpr int LDS_MISC = 131072;
constexpr int LDS_BARW = LDS_BYTES - 64;
constexpr int LDS_PTBL = LDS_BYTES - 512;

constexpr size_t MiB = 1u << 20;
constexpr size_t WS_CTL = 0, CTL_ZERO_BYTES = 1 * MiB;
constexpr size_t WS_MOD = 1 * MiB;
constexpr size_t WS_MODP = 1 * MiB + 256 * 1024;
constexpr size_t WS_ROPE = 2 * MiB;
constexpr size_t WS_S5A = 4 * MiB;
constexpr size_t WS_S5B = 4 * MiB + 64 * 1024;
constexpr size_t WS_LAM = 6 * MiB;
constexpr size_t WS_KM = 6 * MiB + 4096;
constexpr size_t WS_WRH = 6 * MiB + 512 * 1024;
constexpr size_t WS_KMH = 7 * MiB + 512 * 1024;
constexpr size_t WS_WEVIN = 8 * MiB;
constexpr size_t WS_WEVOUT = 22 * MiB;
constexpr size_t WS_WODIN = 26 * MiB;
constexpr size_t WS_WODOUT = 34 * MiB;
constexpr size_t WS_WGLU = 38 * MiB;
constexpr size_t WS_W13 = 40 * MiB;
constexpr size_t WS_W2 = 104 * MiB;
constexpr size_t WS_H = 136 * MiB;
constexpr size_t WS_O = 200 * MiB;
constexpr size_t WS_Z = 264 * MiB;
constexpr size_t WS_XG = 264 * MiB;
constexpr size_t WS_Y = 264 * MiB;
constexpr size_t WS_HID = 408 * MiB;
constexpr size_t WS_IQ = 456 * MiB;
constexpr size_t WS_YG = 456 * MiB;
constexpr size_t WS_IKW = 488 * MiB;
constexpr size_t WS_IQH = 496 * MiB;
constexpr size_t WS_IKH = 512 * MiB;
constexpr size_t WS_IW = 514 * MiB;
constexpr size_t WS_SEL = 516 * MiB;
constexpr size_t WS_YMIX = 548 * MiB;
constexpr size_t WS_LTOK = 612 * MiB;
constexpr size_t WS_TOKES = 616 * MiB;
constexpr size_t WS_TOKW = 617 * MiB;
constexpr size_t WS_TOKROW = 618 * MiB;
constexpr size_t WS_UG = 516 * MiB;
constexpr size_t WS_S5E = 496 * MiB;
constexpr size_t WS_S5HC = 488 * MiB;
constexpr size_t WS_S5KT = 620 * MiB;
constexpr size_t WS_S5WT = 624 * MiB;
constexpr size_t WS_S5A2 = 640 * MiB;
constexpr size_t WS_S5PW = 656 * MiB;
constexpr size_t WS_MLIST = 660 * MiB;
constexpr size_t WS_MPO = 724 * MiB;
constexpr size_t WS_MML = 852 * MiB;
constexpr size_t WS_MASKW = 724 * MiB;
constexpr size_t WS_NSEL = 860 * MiB;
constexpr size_t WS_XB = 862 * MiB;
constexpr size_t WS_END = 926 * MiB;
constexpr int XG_ROWS = 73728;
constexpr int CW_BAR = 4096;
constexpr int CW_MCNT = 16384;
constexpr int CW_CNT = 8192;

#define XB_TMO      128
#define XB_XCNT(j)  (256  + 64 * (j))
#define XB_XSUB(j)  (1280 + 64 * (j))
#define XB_XGEN(j)  (2304 + 64 * (j))
#define XB_TOP      3328
#define XB_TOPGEN   3392
#define XCD_BAR_WORDS 3456
#define XB_SPIN_CAP (1u << 24)

__device__ __forceinline__ unsigned xb_ld(unsigned* p)              { return __hip_atomic_load(p, __ATOMIC_RELAXED, __HIP_MEMORY_SCOPE_AGENT); }
__device__ __forceinline__ unsigned xb_add(unsigned* p, unsigned v) { return __hip_atomic_fetch_add(p, v, __ATOMIC_RELAXED, __HIP_MEMORY_SCOPE_AGENT); }
__device__ __forceinline__ unsigned xb_xcc_id() { return (unsigned)__builtin_amdgcn_s_getreg((3 << 11) | 20) & 0xFu; }
#define XB_SPIN(cond, bar) do { unsigned _sp = 0; while (cond) { __builtin_amdgcn_s_sleep(1); \
    if ((++_sp & 255u) == 0u) { if (xb_ld(&(bar)[XB_TMO])) break; if (_sp > XB_SPIN_CAP) { atomicAdd(&(bar)[XB_TMO], 1u); break; } } } } while (0)

struct XcdBarrier { unsigned* bar; unsigned x; volatile LAS unsigned* st; };

__device__ __forceinline__ XcdBarrier xcd_barrier_post(unsigned* bar, volatile LAS unsigned* st, bool leader) {
    XcdBarrier b; b.bar = bar; b.x = xb_xcc_id(); b.st = st;
    if (leader) (void)xb_add(&bar[XB_XCNT(b.x)], 1u);
    return b;
}
__device__ __forceinline__ void xcd_barrier_complete(unsigned* bar, unsigned x, unsigned& nloc, unsigned& nx) {
    const unsigned G = gridDim.x * gridDim.y * gridDim.z;
    unsigned sum, cnt, mine, sp = 0u;
    for (;;) {
        sum = 0u; cnt = 0u; mine = 0u;
#pragma unroll
        for (unsigned j = 0; j < 16; ++j) { const unsigned c = xb_ld(&bar[XB_XCNT(j)]); sum += c; cnt += (c > 0u) ? 1u : 0u; mine = (j == x) ? c : mine; }
        if (sum == G) break;
        __builtin_amdgcn_s_sleep(1);
        if ((++sp & 255u) == 0u) { if (xb_ld(&bar[XB_TMO])) break; if (sp > XB_SPIN_CAP) { atomicAdd(&bar[XB_TMO], 1u); break; } }
    }
    nloc = mine > 0u ? mine : 1u; nx = cnt > 0u ? cnt : 1u;
}
__device__ __forceinline__ void xcd_barrier(const XcdBarrier& b, bool leader) {
    asm volatile("s_waitcnt vmcnt(0)" ::: "memory");
    __syncthreads();
    if (leader) {
        unsigned* bar = b.bar;
        __builtin_amdgcn_s_waitcnt(0);
        unsigned nloc = b.st[0], nx = b.st[1];
        if (nloc == 0u) { xcd_barrier_complete(bar, b.x, nloc, nx); b.st[0] = nloc; b.st[1] = nx; }
        const unsigned old = xb_add(&bar[XB_XSUB(b.x)], 1u);
        const unsigned gen = old / nloc;
        if (old + 1u == (gen + 1u) * nloc) {
            __builtin_amdgcn_fence(__ATOMIC_RELEASE, "agent");
            asm volatile("s_waitcnt vmcnt(0)" ::: "memory");
            const unsigned og = xb_add(&bar[XB_TOP], 1u);
            const unsigned tg = og / nx;
            if (og + 1u == (tg + 1u) * nx) xb_add(&bar[XB_TOPGEN], 1u);
            else XB_SPIN(xb_ld(&bar[XB_TOPGEN]) == tg, bar);
            __builtin_amdgcn_fence(__ATOMIC_ACQUIRE, "agent");
            xb_add(&bar[XB_XGEN(b.x)], 1u);
            asm volatile("s_waitcnt vmcnt(0)" ::: "memory");
        } else {
            XB_SPIN(xb_ld(&bar[XB_XGEN(b.x)]) == gen, bar);
            __builtin_amdgcn_fence(__ATOMIC_ACQUIRE, "agent");
            asm volatile("s_waitcnt vmcnt(0)" ::: "memory");
        }
    }
    __syncthreads();
}

#define LDS_WAIT() asm volatile("s_waitcnt lgkmcnt(0)" ::: "memory")
__device__ __forceinline__ float bflo(unsigned w) { return __uint_as_float(w << 16); }
__device__ __forceinline__ float bfhi(unsigned w) { return __uint_as_float(w & 0xffff0000u); }
__device__ __forceinline__ unsigned pk2(float lo, float hi) { typedef float f32x2_ __attribute__((ext_vector_type(2))); typedef __bf16 bf16x2_ __attribute__((ext_vector_type(2))); const f32x2_ v = {lo, hi}; return __builtin_bit_cast(unsigned, __builtin_convertvector(v, bf16x2_)); }
__device__ __forceinline__ unsigned f2bf(float f) { return pk2(f, 0.f) & 0xffffu; }
__device__ __forceinline__ float shx_(float v, int m, int lane) { return __int_as_float(__builtin_amdgcn_ds_bpermute((lane ^ m) << 2, __float_as_int(v))); }
__device__ __forceinline__ unsigned shi_(unsigned v, int src) { return (unsigned)__builtin_amdgcn_ds_bpermute(src << 2, (int)v); }
#define SHX(v, m) shx_((v), (m), lane)
__device__ __forceinline__ float dpp_xor1(float v) { return __int_as_float(__builtin_amdgcn_update_dpp(0, __float_as_int(v), 0xB1, 0xF, 0xF, true)); }
__device__ __forceinline__ float dpp_xor2(float v) { return __int_as_float(__builtin_amdgcn_update_dpp(0, __float_as_int(v), 0x4E, 0xF, 0xF, true)); }
__device__ __forceinline__ float half_sum(float v) { const auto r = __builtin_amdgcn_permlane32_swap(__float_as_uint(v), __float_as_uint(v), false, false); return __uint_as_float(r[0]) + __uint_as_float(r[1]); }
__device__ __forceinline__ float half_max(float v) { const auto r = __builtin_amdgcn_permlane32_swap(__float_as_uint(v), __float_as_uint(v), false, false); return fmaxf(__uint_as_float(r[0]), __uint_as_float(r[1])); }
__device__ __forceinline__ float wave_sum_(float v, int lane) {
    v += dpp_xor1(v); v += dpp_xor2(v); v += shx_(v, 4, lane); v += shx_(v, 8, lane); v += shx_(v, 16, lane); return half_sum(v);
}

#define wave_sum(v) wave_sum_((v), lane)
__device__ __forceinline__ float wave_max_(float v, int lane) {
#pragma unroll
    for (int o = 1; o < 64; o <<= 1) v = fmaxf(v, shx_(v, o, lane));
    return v;
}
__device__ __forceinline__ bool qk_bounded(const float* gq, const float* gk, int lane) {
    const float a = wave_max_(fabsf(gq[lane]), lane), b = wave_max_(fabsf(gk[lane]), lane);
    return 64.0f * QSCALE * a * b <= 60.0f;
}
__device__ __forceinline__ void unpack8(const u32x4 w, float (&v)[8]) {
    v[0] = bflo(w.x); v[1] = bfhi(w.x); v[2] = bflo(w.y); v[3] = bfhi(w.y); v[4] = bflo(w.z); v[5] = bfhi(w.z); v[6] = bflo(w.w); v[7] = bfhi(w.w);
}
__device__ __forceinline__ u32x4 pack8(const float (&v)[8]) { u32x4 w; w.x = pk2(v[0], v[1]); w.y = pk2(v[2], v[3]); w.z = pk2(v[4], v[5]); w.w = pk2(v[6], v[7]); return w; }
__device__ __forceinline__ float gelu_tanh(float y) {
    const float z = 0.7978845608028654f * (y + 0.044715f * y * y * y);
    const float e = __builtin_amdgcn_exp2f(2.885390081777927f * z);
    const float th = 1.0f - 2.0f * __builtin_amdgcn_rcpf(e + 1.0f);
    return 0.5f * y * (1.0f + th);
}
__device__ __forceinline__ float sigmoidf_(float v) { return __builtin_amdgcn_rcpf(1.0f + __builtin_amdgcn_exp2f(-1.4426950408889634f * v)); }
__device__ __forceinline__ unsigned ordkey(float f) { const unsigned u = __float_as_uint(f); return u ^ ((unsigned)((int)u >> 31) | 0x80000000u); }

struct EpiPlain {
    static constexpr bool PERM = true, AFTER_DRAIN = false;
    bf16_t* O; int ldc;
    __device__ __forceinline__ void operator()(const pg8::f32x4 (&acc)[2][2][4][2], const pg8::Unit& u, int wr, int wc, int fr, int fq) const {
        const int row0 = u.pm * 256 + wr * 64 + fr, col0 = u.pn * 256 + wc * 32 + 8 * fq;
#pragma unroll
        for (int ai = 0; ai < 2; ++ai)
#pragma unroll
            for (int m = 0; m < 4; ++m) { bf16_t* rowp = O + (size_t)(row0 + ai * 128 + m * 16) * ldc + col0;
#pragma unroll
                for (int bj = 0; bj < 2; ++bj) { const pg8::f32x4 v0 = acc[ai][bj][m][0], v1 = acc[ai][bj][m][1];
                    u32x4 w; w.x = pk2(v0[0], v0[1]); w.y = pk2(v0[2], v0[3]); w.z = pk2(v1[0], v1[1]); w.w = pk2(v1[2], v1[3]);
                    *(u32x4*)(rowp + bj * 128) = w; } }
    }
};
__device__ __forceinline__ void epi_khead(const pg8::f32x4 (&acc)[2][2][4][2], bf16_t* Z, int ldz, int colbase, const float* gain, const float* COSH, const float* SINH, int row0, int wc, int fr, int fq) {
    const int lane = fr + 16 * fq;
    float g[2][8];
#pragma unroll
    for (int bj = 0; bj < 2; ++bj)
#pragma unroll
        for (int e = 0; e < 8; ++e) g[bj][e] = gain[bj * 32 + 8 * fq + e];
#pragma unroll
    for (int ai = 0; ai < 2; ++ai)
#pragma unroll
        for (int m = 0; m < 4; ++m) { const int row = row0 + ai * 128 + m * 16; const int pos = row & (S - 1);
            float v[2][8]; float ss = 0.f;
#pragma unroll
            for (int bj = 0; bj < 2; ++bj)
#pragma unroll
                for (int e = 0; e < 4; ++e) { v[bj][e] = acc[ai][bj][m][0][e]; v[bj][4 + e] = acc[ai][bj][m][1][e]; ss += v[bj][e] * v[bj][e] + v[bj][4 + e] * v[bj][4 + e]; }
            ss += shx_(ss, 16, lane); ss = half_sum(ss);
            const float r = rsqrtf(ss * (1.0f / 64.0f) + EPS);
#pragma unroll
            for (int bj = 0; bj < 2; ++bj)
#pragma unroll
                for (int e = 0; e < 8; ++e) v[bj][e] *= r * g[bj][e];
#pragma unroll
            for (int e = 0; e < 8; ++e) { const float oth = shx_(v[0][e], 16, lane); const float cs = COSH[pos * 8 + e], sn = SINH[pos * 8 + e];
                if (fq == 0) v[0][e] = v[0][e] * cs - oth * sn; else if (fq == 1) v[0][e] = v[0][e] * cs + oth * sn; }
            bf16_t* zp = Z + (size_t)row * ldz + colbase + wc * 64 + 8 * fq;
            *(u32x4*)zp = pack8(v[0]); *(u32x4*)(zp + 32) = pack8(v[1]); }
}
struct EpiEvenIn {
    static constexpr bool PERM = true, AFTER_DRAIN = false;
    bf16_t* Z; _Float16* IQH; _Float16* IKH; float* IW; const float* a_kn; const float* b_kn; const float* idx_kn; const float* COSH; const float* SINH; const float* COSI; const float* SINI;
    __device__ __forceinline__ void operator()(const pg8::f32x4 (&acc)[2][2][4][2], const pg8::Unit& u, int wr, int wc, int fr, int fq) const {
        const int row0 = u.pm * 256 + wr * 64 + fr; const int lane = fr + 16 * fq;
        if (u.pn == 2 || u.pn == 3) epi_khead(acc, Z, EV_ZP, 512 + (u.pn & 1) * 256, a_kn, COSH, SINH, row0, wc, fr, fq);
        else if (u.pn == 8 || u.pn == 9) epi_khead(acc, Z, EV_ZP, 2048 + (u.pn & 1) * 256, b_kn, COSH, SINH, row0, wc, fr, fq);
        else if (u.pn < 12) {
            const int col0 = u.pn * 256 + wc * 32 + 8 * fq;
#pragma unroll
            for (int ai = 0; ai < 2; ++ai)
#pragma unroll
                for (int m = 0; m < 4; ++m) { bf16_t* rowp = Z + (size_t)(row0 + ai * 128 + m * 16) * EV_ZP + col0;
#pragma unroll
                    for (int bj = 0; bj < 2; ++bj) { const pg8::f32x4 v0 = acc[ai][bj][m][0], v1 = acc[ai][bj][m][1];
                        u32x4 w; w.x = pk2(v0[0], v0[1]); w.y = pk2(v0[2], v0[3]); w.z = pk2(v1[0], v1[1]); w.w = pk2(v1[2], v1[3]);
                        *(u32x4*)(rowp + bj * 128) = w; } }
        } else if (u.pn == 12) {
#pragma unroll
            for (int ai = 0; ai < 2; ++ai)
#pragma unroll
                for (int m = 0; m < 4; ++m) { const int row = row0 + ai * 128 + m * 16; const int pos = row & (S - 1);
                    const f32x4 cs = *(const f32x4*)(COSI + pos * 4), sn = *(const f32x4*)(SINI + pos * 4);
#pragma unroll
                    for (int bj = 0; bj < 2; ++bj) { pg8::f32x4 v0 = acc[ai][bj][m][0], v1 = acc[ai][bj][m][1];
                        if (fq == 0) { const pg8::f32x4 a0 = v0, a1 = v1;
#pragma unroll
                            for (int e = 0; e < 4; ++e) { v0[e] = a0[e] * cs[e] - a1[e] * sn[e]; v1[e] = a1[e] * cs[e] + a0[e] * sn[e]; } }
                        f16x8 hq;
#pragma unroll
                        for (int e = 0; e < 4; ++e) { hq[e] = (_Float16)v0[e]; hq[4 + e] = (_Float16)v1[e]; }
                        *(f16x8*)(IQH + (size_t)row * 256 + bj * 128 + wc * 32 + 8 * fq) = hq; } }
        } else {
            if (wc == 0) {
                float g[8];
#pragma unroll
                for (int e = 0; e < 8; ++e) g[e] = idx_kn[8 * fq + e];
#pragma unroll
                for (int ai = 0; ai < 2; ++ai)
#pragma unroll
                    for (int m = 0; m < 4; ++m) { const int row = row0 + ai * 128 + m * 16; const int pos = row & (S - 1);
                        float v[8]; float ss = 0.f;
#pragma unroll
                        for (int e = 0; e < 4; ++e) { v[e] = acc[ai][0][m][0][e]; v[4 + e] = acc[ai][0][m][1][e]; ss += v[e] * v[e] + v[4 + e] * v[4 + e]; }
                        ss += shx_(ss, 16, lane); ss = half_sum(ss);
                        const float r = rsqrtf(ss * (1.0f / 32.0f) + EPS);
#pragma unroll
                        for (int e = 0; e < 8; ++e) v[e] *= r * g[e];
                        if (fq == 0) {
#pragma unroll
                            for (int e = 0; e < 4; ++e) { const float x1 = v[e], x2 = v[4 + e]; const float cs = COSI[pos * 4 + e], sn = SINI[pos * 4 + e]; v[e] = x1 * cs - x2 * sn; v[4 + e] = x2 * cs + x1 * sn; } }
                        f16x8 hk;
#pragma unroll
                        for (int e = 0; e < 8; ++e) hk[e] = (_Float16)v[e];
                        *(f16x8*)(IKH + (size_t)row * 32 + 8 * fq) = hk; }
            } else if (wc == 1 && fq == 0) {
#pragma unroll
                for (int ai = 0; ai < 2; ++ai)
#pragma unroll
                    for (int m = 0; m < 4; ++m) { float* wp = IW + (size_t)(row0 + ai * 128 + m * 16) * 8; *(pg8::f32x4*)wp = acc[ai][0][m][0]; *(pg8::f32x4*)(wp + 4) = acc[ai][0][m][1]; }
            }
        }
    }
};
struct EpiOddIn {
    static constexpr bool PERM = true, AFTER_DRAIN = false;
    bf16_t* Z; bf16_t* UG; const float* c_kn; const float* COSH; const float* SINH;
    __device__ __forceinline__ void operator()(const pg8::f32x4 (&acc)[2][2][4][2], const pg8::Unit& u, int wr, int wc, int fr, int fq) const {
        const int row0 = u.pm * 256 + wr * 64 + fr, col0 = u.pn * 256 + wc * 32 + 8 * fq;
        if (u.pn == 2 || u.pn == 3) { epi_khead(acc, Z, OD_N, 512 + (u.pn & 1) * 256, c_kn, COSH, SINH, row0, wc, fr, fq); return; }
#pragma unroll
        for (int ai = 0; ai < 2; ++ai)
#pragma unroll
            for (int m = 0; m < 4; ++m) { const size_t row = (size_t)(row0 + ai * 128 + m * 16);
#pragma unroll
                for (int bj = 0; bj < 2; ++bj) { const pg8::f32x4 v0 = acc[ai][bj][m][0], v1 = acc[ai][bj][m][1]; const int col = col0 + bj * 128;
                    u32x4 w; w.x = pk2(v0[0], v0[1]); w.y = pk2(v0[2], v0[3]); w.z = pk2(v1[0], v1[1]); w.w = pk2(v1[2], v1[3]);
                    if (u.pn < 6) *(u32x4*)(Z + row * OD_N + col) = w;
                    else { const int cu = col - 1536; *(u32x4*)(UG + ((size_t)(cu >> 4) * T + row) * 16 + (cu & 15)) = w; } } }
    }
};
__device__ __forceinline__ void load_q_normed(attn_body::bf16x8 (&qr)[4], const bf16_t* zrow, const float* gain, const float* COSH, const float* SINH, int pos, int hi, int lane) {
    float v[4][8]; float ss = 0.f;
#pragma unroll
    for (int d0 = 0; d0 < 4; ++d0) { unpack8(*(const u32x4*)(zrow + d0 * 16 + hi * 8), v[d0]);
#pragma unroll
        for (int e = 0; e < 8; ++e) ss += v[d0][e] * v[d0][e]; }
    ss = half_sum(ss);
    const float r = rsqrtf(ss * (1.0f / 64.0f) + EPS) * QSCALE;
#pragma unroll
    for (int d0 = 0; d0 < 4; ++d0)
#pragma unroll
        for (int e = 0; e < 8; ++e) v[d0][e] *= r * gain[d0 * 16 + hi * 8 + e];
#pragma unroll
    for (int e = 0; e < 8; ++e) { const float oth = shx_(v[0][e], 32, lane); const float cs = COSH[pos * 8 + e], sn = SINH[pos * 8 + e];
        v[0][e] = hi ? v[0][e] * cs + oth * sn : v[0][e] * cs - oth * sn; }
#pragma unroll
    for (int d0 = 0; d0 < 4; ++d0) qr[d0] = __builtin_bit_cast(attn_body::bf16x8, pack8(v[d0]));
}
struct EpiSwiGLU {
    static constexpr bool PERM = true, AFTER_DRAIN = false;
    bf16_t* HID;
    __device__ __forceinline__ void operator()(const pg8::f32x4 (&acc)[2][2][4][2], const pg8::Unit& u, int wr, int wc, int fr, int fq) const {
        const int row0 = u.pm * 256 + wr * 64 + fr, col0 = (u.pn * 256 + wc * 32 + 8 * fq) >> 1;
#pragma unroll
        for (int ai = 0; ai < 2; ++ai)
#pragma unroll
            for (int m = 0; m < 4; ++m) { bf16_t* rowp = HID + (size_t)(row0 + ai * 128 + m * 16) * 512 + col0;
#pragma unroll
                for (int bj = 0; bj < 2; ++bj) { const pg8::f32x4 v0 = acc[ai][bj][m][0], v1 = acc[ai][bj][m][1];
                    const float h0 = v0[0] * sigmoidf_(v0[0]) * v0[1], h1 = v0[2] * sigmoidf_(v0[2]) * v0[3];
                    const float h2 = v1[0] * sigmoidf_(v1[0]) * v1[1], h3 = v1[2] * sigmoidf_(v1[2]) * v1[3];
                    u32x2 w; w.x = pk2(h0, h1); w.y = pk2(h2, h3);
                    *(u32x2*)(rowp + bj * 64) = w; } }
    }
};
struct EpiGLU {
    static constexpr bool PERM = true, AFTER_DRAIN = false;
    bf16_t* O; const bf16_t* YG; const float* gb;
    __device__ __forceinline__ void operator()(const pg8::f32x4 (&acc)[2][2][4][2], const pg8::Unit& u, int wr, int wc, int fr, int fq) const {
        const int row0 = u.pm * 256 + wr * 64 + fr, col0 = u.pn * 256 + wc * 32 + 8 * fq;
#pragma unroll
        for (int ai = 0; ai < 2; ++ai)
#pragma unroll
            for (int bj = 0; bj < 2; ++bj) {
                const int c = col0 + bj * 128;
                u32x4 yr[4];
#pragma unroll
                for (int m = 0; m < 4; ++m) yr[m] = *(const u32x4*)(YG + (size_t)(row0 + ai * 128 + m * 16) * 512 + c);
                const pg8::f32x4 b0 = *(const pg8::f32x4*)(gb + c), b1 = *(const pg8::f32x4*)(gb + c + 4);
                __builtin_amdgcn_sched_barrier(0);
#pragma unroll
                for (int m = 0; m < 4; ++m) { const size_t row = (size_t)(row0 + ai * 128 + m * 16);
                    const pg8::f32x4 v0 = acc[ai][bj][m][0], v1 = acc[ai][bj][m][1];
                    float y[8]; unpack8(yr[m], y);
                    float o[8];
#pragma unroll
                    for (int j = 0; j < 4; ++j) { o[j] = y[j] * sigmoidf_(v0[j] + b0[j]); o[4 + j] = y[4 + j] * sigmoidf_(v1[j] + b1[j]); }
                    *(u32x4*)(O + row * 1024 + 512 + c) = pack8(o); }
                __builtin_amdgcn_sched_barrier(0);
            }
    }
};
struct MoeOrder {
    int nN, nunits, G, c; const LAS int* tile_e;
    __device__ __forceinline__ bool next(int i, pg8::Unit& u) const { const int L = i * G + c; if (L >= nunits) return false;
        int w = L; { const int q = nunits / 8, r = nunits % 8, xcd = w % 8, off = w / 8; w = (xcd < r ? xcd * (q + 1) : r * (q + 1) + (xcd - r) * q) + off; }
        u.pm = w / nN; u.pn = w % nN; u.be = tile_e[u.pm]; return true; }
    __device__ __forceinline__ void a_ready(const pg8::Unit&) const {}
    __device__ __forceinline__ void done(const pg8::Unit&) const {}
};

__device__ __forceinline__ int wt_row(int n, int row_mul, int row_add) {
    if (row_mul > 0) return n * row_mul + row_add;
    const int tile = n >> 8, w = n & 255;
    const bool ktile = (tile == 2 || tile == 3) || (row_mul == -1 && (tile == 8 || tile == 9));
    return ktile ? tile * 256 + ((w & 63) >> 5) * 128 + (w >> 6) * 32 + (w & 31) : n;
}
__device__ __forceinline__ void transpose_item(const float* W, int K, int N, bf16_t* WT, int row_mul, int row_add, LAS float* scr, int item, int nblk, int lane) {
    const int kb = item / nblk, nb = item % nblk, k0 = 64 * kb, n0 = 32 * nb;
    const int nn = n0 + (lane & 31);
    float tv[32];
#pragma unroll
    for (int i = 0; i < 32; ++i) { const int kk = 2 * i + (lane >> 5); tv[i] = (nn < N) ? W[(size_t)(k0 + kk) * N + nn] : 0.f; }
#pragma unroll
    for (int i = 0; i < 32; ++i) { const int kk = 2 * i + (lane >> 5); scr[kk * 33 + (lane & 31)] = tv[i]; }
    LDS_WAIT(); asm volatile("" ::: "memory");
    const int c = lane & 7;
#pragma unroll
    for (int j = 0; j < 4; ++j) { const int n = (lane >> 3) + 8 * j; const LAS float* s = scr + (8 * c) * 33 + n;
        u32x4 o; o.x = pk2(s[0 * 33], s[1 * 33]); o.y = pk2(s[2 * 33], s[3 * 33]); o.z = pk2(s[4 * 33], s[5 * 33]); o.w = pk2(s[6 * 33], s[7 * 33]);
        *(u32x4*)(WT + (size_t)wt_row(n0 + n, row_mul, row_add) * K + k0 + 8 * c) = o; }
    LDS_WAIT(); asm volatile("" ::: "memory");
}
__device__ __forceinline__ void norm_mod_row(const float* xrow, const float* sh, const float* sc, bf16_t* orow, int lane) {
    f32x4 v[4]; float ss = 0.f;
#pragma unroll
    for (int j = 0; j < 4; ++j) { v[j] = *(const f32x4*)(xrow + 4 * lane + 256 * j); ss += (v[j].x * v[j].x + v[j].y * v[j].y) + (v[j].z * v[j].z + v[j].w * v[j].w); }
    const float r = rsqrtf(wave_sum(ss) * (1.0f / 1024.0f) + EPS);
#pragma unroll
    for (int j = 0; j < 4; ++j) { const f32x4 a = *(const f32x4*)(sc + 4 * lane + 256 * j), b = *(const f32x4*)(sh + 4 * lane + 256 * j);
        u32x2 w; w.x = pk2(v[j].x * r * (1.f + a.x) + b.x, v[j].y * r * (1.f + a.y) + b.y); w.y = pk2(v[j].z * r * (1.f + a.z) + b.z, v[j].w * r * (1.f + a.w) + b.w);
        *(u32x2*)(orow + 4 * lane + 256 * j) = w; }
}

__device__ __forceinline__ void attn_key(const bf16_t* kp, const bf16_t* vp, const float (&q)[64], float& m, float& l, float (&o)[64]) {
    float s = 0.f;
#pragma unroll
    for (int i = 0; i < 8; ++i) { float kv[8]; unpack8(*(const u32x4*)(kp + 8 * i), kv);
#pragma unroll
        for (int j = 0; j < 8; ++j) s += q[8 * i + j] * kv[j]; }
    const float mn = fmaxf(m, s);
    const float f = __builtin_amdgcn_exp2f(m - mn), p = __builtin_amdgcn_exp2f(s - mn);
    l = l * f + p; m = mn;
#pragma unroll
    for (int i = 0; i < 8; ++i) { float vv[8]; unpack8(*(const u32x4*)(vp + 8 * i), vv);
#pragma unroll
        for (int j = 0; j < 8; ++j) o[8 * i + j] = o[8 * i + j] * f + p * vv[j]; }
}
__device__ __forceinline__ void load_q64(const bf16_t* qp, float scale, float (&q)[64]) {
#pragma unroll
    for (int i = 0; i < 8; ++i) { float t[8]; unpack8(*(const u32x4*)(qp + 8 * i), t);
#pragma unroll
        for (int j = 0; j < 8; ++j) q[8 * i + j] = t[j] * scale; }
}

struct Args { const void* in[37]; float* out; unsigned char* ws; int ph_lo, ph_hi, probe_var, pad; };
#ifndef PROBE_GEMM_REPS
#define PROBE_GEMM_REPS 1
#endif
#if PROBE_GEMM_REPS == 2
template <class Sc> struct Twice { Sc S; int n1;
    __device__ __forceinline__ bool next(int i, pg8::Unit& u) const { return i < n1 ? S.next(i, u) : S.next(i - n1, u); }
    __device__ __forceinline__ void a_ready(const pg8::Unit&) const {}
    __device__ __forceinline__ void done(const pg8::Unit&) const {} };
#define PROBE_SCHED(T) Twice<T>
#define PROBE_WRAP(T, v) Twice<T> PS_; PS_.S = v; { int n1_ = 0; pg8::Unit tu_; while (v.next(n1_, tu_)) ++n1_; PS_.n1 = n1_; }
#else
#define PROBE_SCHED(T) T
#define PROBE_WRAP(T, v) const T& PS_ = v
#endif
#ifdef PROBE_BAR2
#define PROBE_EXTRA_BAR(b) xcd_barrier(b, lsg(wid0) == 0 && lane_id_v() == 0);
#else
#define PROBE_EXTRA_BAR(b)
#endif
constexpr int N_PHASES = 3 + 2 * (8 + 10);

template <int NV, bool MASKED, bool CAUSAL, int PIN, int POUT, bool NOMAX = false>
__device__ __forceinline__ void flash_unit(LAS unsigned char* L0, const bf16_t* Qb, const bf16_t* Kb, const bf16_t* Vb, bf16_t* Ob, const unsigned* mbase, int qb, int wid, int lane, const float* qgain, const float* COSH, const float* SINH) {
    const int r32 = lane & 31, hi = lane >> 5;
    LAS unsigned char* ldsKs = L0; LAS unsigned char* ldsVs = L0 + 16384;
    LAS float* wsf = (LAS float*)(L0 + 16384 + NV * 16384 + wid * 256);
    LAS bf16_t* stg = (LAS bf16_t*)(L0 + 16384 + NV * 16384 + 2048 + wid * 4096);
    const int qrow = qb * 256 + wid * 32 + r32;
    attn_body::bf16x8 qr[4];
    load_q_normed(qr, Qb + (size_t)qrow * PIN, qgain, COSH, SINH, qrow, hi, lane);
    const int NT = 4 * (qb + 1);
    const bf16_t* kbp = Kb + (size_t)lane * PIN + wid * 8;
    const bf16_t* vbp = Vb + (size_t)(16 * (wid & 3) + (lane >> 2)) * PIN + (wid >> 2) * 32 + (lane & 3) * 8;
    const unsigned* mwp = MASKED ? mbase + (size_t)qrow * 2 + hi : nullptr;
    u32x4 kreg = *(const u32x4*)kbp, vreg[NV]; unsigned mw = 0u, mwn = 0u;
#pragma unroll
    for (int j = 0; j < NV; ++j) vreg[j] = *(const u32x4*)(vbp + j * 64);
    if (MASKED) mw = mwp[0];
    *(LAS u32x4*)(ldsKs + wid * 1024 + lane * 16) = kreg;
#pragma unroll
    for (int j = 0; j < NV; ++j) *(LAS u32x4*)(ldsVs + j * 16384 + wid * 1024 + lane * 16) = vreg[j];
    __syncthreads();
    float mhat = 0.f, lsum = 0.f;
    attn_body::f32x16 o[2 * NV], negm;
#pragma unroll
    for (int r = 0; r < 16; ++r) { negm[r] = 0.f;
#pragma unroll
        for (int j = 0; j < 2 * NV; ++j) o[j][r] = 0.f; }
    const int vb0 = (int)(unsigned)(unsigned long long)ldsVs + ((lane >> 4) & 1) * 32 + (lane & 3) * 8 + (4 * hi + ((lane & 15) >> 2)) * 64;
    for (int t = 0; t < NT; ++t) {
        const int slot = (t & 1) * 8192;
        if (t + 1 < NT) { kreg = *(const u32x4*)(kbp + (size_t)(t + 1) * 64 * PIN);
#pragma unroll
            for (int j = 0; j < NV; ++j) vreg[j] = *(const u32x4*)(vbp + (size_t)(t + 1) * 64 * PIN + j * 64);
            if (MASKED) mwn = mwp[(size_t)(t + 1) * S * 2]; }
        attn_body::f32x16 p0 = negm, p1 = negm;
        { const LAS unsigned char* kb = ldsKs + slot + hi * 1024 + r32 * 16;
#pragma unroll
          for (int d0 = 0; d0 < 4; ++d0) {
              const attn_body::bf16x8 b0 = *(const LAS attn_body::bf16x8*)(kb + d0 * 2048), b1 = *(const LAS attn_body::bf16x8*)(kb + d0 * 2048 + 512);
              p0 = __builtin_amdgcn_mfma_f32_32x32x16_bf16(b0, qr[d0], p0, 0, 0, 0);
              p1 = __builtin_amdgcn_mfma_f32_32x32x16_bf16(b1, qr[d0], p1, 0, 0, 0); } }
        if (CAUSAL) { const int jb = t - (NT - 4); if (jb >= 0) attn_body::cmask(p0, p1, jb, wid * 32 + r32, hi); }
        float rm = 0.f;
        if (!NOMAX) { rm = fmaxf(p0[0], p1[0]);
#pragma unroll
            for (int r = 1; r < 16; ++r) rm = fmaxf(rm, fmaxf(p0[r], p1[r]));
            rm = half_max(rm); }
        bool resc = false;
        if (!NOMAX && __any(rm > 8.0f)) {
            const float dl = fmaxf(rm, 0.f); mhat += dl;
#pragma unroll
            for (int r = 0; r < 16; ++r) { p0[r] -= dl; p1[r] -= dl; negm[r] = -mhat; }
            const float f = __builtin_amdgcn_exp2f(-dl); lsum *= f; if (hi == 0) wsf[r32] = f; resc = true;
        }
        const int wb = (int)mw; float ssum = 0.f;
#pragma unroll
        for (int r = 0; r < 16; ++r) {
            float e0 = __builtin_amdgcn_exp2f(p0[r]), e1 = __builtin_amdgcn_exp2f(p1[r]);
            if (MASKED) { e0 = __uint_as_float(__float_as_uint(e0) & (unsigned)__builtin_amdgcn_sbfe(wb, r, 1)); e1 = __uint_as_float(__float_as_uint(e1) & (unsigned)__builtin_amdgcn_sbfe(wb, 16 + r, 1)); }
            p0[r] = e0; p1[r] = e1; ssum += e0 + e1; }
        lsum += ssum;
        u32x4 pw0, pw1, pw2, pw3;
#pragma unroll
        for (int k = 0; k < 4; ++k) { pw0[k] = attn_body::cvtpk_s(p0[2 * k], p0[2 * k + 1]); pw1[k] = attn_body::cvtpk_s(p0[8 + 2 * k], p0[9 + 2 * k]);
            pw2[k] = attn_body::cvtpk_s(p1[2 * k], p1[2 * k + 1]); pw3[k] = attn_body::cvtpk_s(p1[8 + 2 * k], p1[9 + 2 * k]); }
        if (resc) { LDS_WAIT();
#pragma unroll
            for (int r = 0; r < 16; ++r) { const float f = wsf[attn_body::crow(r, hi)];
#pragma unroll
                for (int j = 0; j < 2 * NV; ++j) o[j][r] *= f; } }
#pragma unroll
        for (int j = 0; j < NV; ++j)
            attn_body::pv(o + 2 * j, vb0 + j * 16384 + slot, __builtin_bit_cast(attn_body::bf16x8, pw0), __builtin_bit_cast(attn_body::bf16x8, pw1), __builtin_bit_cast(attn_body::bf16x8, pw2), __builtin_bit_cast(attn_body::bf16x8, pw3));
        if (t + 1 < NT) { const int ns = ((t + 1) & 1) * 8192; *(LAS u32x4*)(ldsKs + ns + wid * 1024 + lane * 16) = kreg;
#pragma unroll
            for (int j = 0; j < NV; ++j) *(LAS u32x4*)(ldsVs + j * 16384 + ns + wid * 1024 + lane * 16) = vreg[j]; }
        mw = mwn;
        __syncthreads();
    }
    lsum += shx_(lsum, 32, lane);
    if (hi == 0) wsf[r32] = lsum;
    LDS_WAIT();
    float rl[16];
#pragma unroll
    for (int r = 0; r < 16; ++r) rl[r] = __builtin_amdgcn_rcpf(wsf[attn_body::crow(r, hi)]);
#pragma unroll
    for (int j = 0; j < NV; ++j) {
#pragma unroll
        for (int r = 0; r < 16; ++r) { const int orow = attn_body::crow(r, hi);
            stg[orow * 64 + r32] = (bf16_t)f2bf(o[2 * j][r] * rl[r]); stg[orow * 64 + 32 + r32] = (bf16_t)f2bf(o[2 * j + 1][r] * rl[r]); }
        LDS_WAIT();
#pragma unroll
        for (int q = 0; q < 4; ++q) { const int row = q * 8 + (lane >> 3), ch = lane & 7;
            *(u32x4*)(Ob + (size_t)(qb * 256 + wid * 32 + row) * POUT + j * 64 + ch * 8) = *(const LAS u32x4*)(stg + row * 64 + ch * 8); }
        LDS_WAIT();
    }
    __syncthreads();
}
template <int NV, bool MASKED, bool CAUSAL, int PIN, int POUT, bool NOMAX = false>
__device__ __forceinline__ void flash_unit_q2(LAS unsigned char* L0, const bf16_t* Qb, const bf16_t* Kb, const bf16_t* Vb, bf16_t* Ob, const unsigned* mbase, int qb, int wid, int lane, const float* qgain, const float* COSH, const float* SINH) {
    typedef __attribute__((address_space(3))) attn_body::v4i16_t* vtr_ptr;
    const int r32 = lane & 31, hi = lane >> 5;
    LAS unsigned char* ldsKs = L0; LAS unsigned char* ldsVs = L0 + 16384;
    LAS float* wsf = (LAS float*)(L0 + 16384 + NV * 16384 + wid * 512);
    LAS bf16_t* stg = (LAS bf16_t*)(L0 + 16384 + NV * 16384 + 4096 + wid * 4096);
    const int q0 = qb * 512 + wid * 64;
    attn_body::bf16x8 qr[2][4];
#pragma unroll
    for (int nq = 0; nq < 2; ++nq) load_q_normed(qr[nq], Qb + (size_t)(q0 + nq * 32 + r32) * PIN, qgain, COSH, SINH, q0 + nq * 32 + r32, hi, lane);
    const int NT = 8 * (qb + 1);
    const bf16_t* kbp = Kb + (size_t)lane * PIN + wid * 8;
    const bf16_t* vbp = Vb + (size_t)(16 * (wid & 3) + (lane >> 2)) * PIN + (wid >> 2) * 32 + (lane & 3) * 8;
    const unsigned* mwp = MASKED ? mbase + (size_t)(q0 + r32) * 2 + hi : nullptr;
    const int stoff = wid * 1024 + lane * 16;
    u32x4 kreg = *(const u32x4*)kbp, vreg[NV]; unsigned mw[2] = {0u, 0u}, mwn[2] = {0u, 0u};
#pragma unroll
    for (int j = 0; j < NV; ++j) vreg[j] = *(const u32x4*)(vbp + j * 64);
    if (MASKED) { mw[0] = mwp[0]; mw[1] = mwp[64]; }
    *(LAS u32x4*)(ldsKs + stoff) = kreg;
#pragma unroll
    for (int j = 0; j < NV; ++j) *(LAS u32x4*)(ldsVs + j * 16384 + stoff) = vreg[j];
    __syncthreads();
    float mhat[2] = {0.f, 0.f}, lsum[2] = {0.f, 0.f}; bool refmoved = false;
    attn_body::f32x16 o[2][2 * NV];
#pragma unroll
    for (int r = 0; r < 16; ++r)
#pragma unroll
        for (int j = 0; j < 2 * NV; ++j) { o[0][j][r] = 0.f; o[1][j][r] = 0.f; }
    const LAS unsigned char* kfb = ldsKs + hi * 1024 + r32 * 16;
    const LAS unsigned char* vfb = ldsVs + ((lane >> 4) & 1) * 32 + (lane & 3) * 8 + (4 * hi + ((lane & 15) >> 2)) * 64;
    for (int t = 0; t < NT; ++t) {
        const int slot = (t & 1) * 8192;
        if (t + 1 < NT) { kreg = *(const u32x4*)(kbp + (size_t)(t + 1) * 64 * PIN);
#pragma unroll
            for (int j = 0; j < NV; ++j) vreg[j] = *(const u32x4*)(vbp + (size_t)(t + 1) * 64 * PIN + j * 64);
            if (MASKED) { mwn[0] = mwp[(size_t)(t + 1) * S * 2]; mwn[1] = mwp[(size_t)(t + 1) * S * 2 + 64]; } }
#pragma unroll
        for (int kh = 0; kh < 2; ++kh) {
            attn_body::f32x16 p[2];
#pragma unroll
            for (int r = 0; r < 16; ++r) { p[0][r] = 0.f; p[1][r] = 0.f; }
#pragma unroll
            for (int d0 = 0; d0 < 4; ++d0) {
                const attn_body::bf16x8 kf = *(const LAS attn_body::bf16x8*)(kfb + slot + d0 * 2048 + kh * 512);
                p[0] = __builtin_amdgcn_mfma_f32_32x32x16_bf16(kf, qr[0][d0], p[0], 0, 0, 0);
                p[1] = __builtin_amdgcn_mfma_f32_32x32x16_bf16(kf, qr[1][d0], p[1], 0, 0, 0); }
            if (refmoved) {
#pragma unroll
                for (int nq = 0; nq < 2; ++nq)
#pragma unroll
                    for (int r = 0; r < 16; ++r) p[nq][r] -= mhat[nq]; }
            if (CAUSAL) { const int kbase = t * 64 + kh * 32;
                if (kbase + 31 > q0) {
#pragma unroll
                    for (int nq = 0; nq < 2; ++nq)
#pragma unroll
                        for (int r = 0; r < 16; ++r) if (kbase + attn_body::crow(r, hi) > q0 + nq * 32 + r32) p[nq][r] = -INFINITY; } }
            float rm[2] = {0.f, 0.f};
            if (!NOMAX)
#pragma unroll
            for (int nq = 0; nq < 2; ++nq) { float m_ = p[nq][0];
#pragma unroll
                for (int r = 1; r < 16; ++r) m_ = fmaxf(m_, p[nq][r]);
                rm[nq] = half_max(m_); }
            bool resc = false;
            if (!NOMAX && __any(fmaxf(rm[0], rm[1]) > 8.0f)) {
#pragma unroll
                for (int nq = 0; nq < 2; ++nq) { const float dl = fmaxf(rm[nq], 0.f); mhat[nq] += dl;
#pragma unroll
                    for (int r = 0; r < 16; ++r) p[nq][r] -= dl;
                    const float f = __builtin_amdgcn_exp2f(-dl); lsum[nq] *= f; if (hi == 0) wsf[nq * 32 + r32] = f; }
                resc = true; refmoved = true;
            }
            attn_body::bf16x8 pa[2][2];
#pragma unroll
            for (int nq = 0; nq < 2; ++nq) { const int wb = (int)mw[nq]; float ssum = 0.f;
#pragma unroll
                for (int r = 0; r < 16; ++r) { float e = __builtin_amdgcn_exp2f(p[nq][r]);
                    if (MASKED) e = __uint_as_float(__float_as_uint(e) & (unsigned)__builtin_amdgcn_sbfe(wb, kh * 16 + r, 1));
                    p[nq][r] = e; ssum += e; }
                lsum[nq] += ssum;
                u32x4 pw0, pw1;
#pragma unroll
                for (int k = 0; k < 4; ++k) { pw0[k] = attn_body::cvtpk_s(p[nq][2 * k], p[nq][2 * k + 1]); pw1[k] = attn_body::cvtpk_s(p[nq][8 + 2 * k], p[nq][9 + 2 * k]); }
                pa[nq][0] = __builtin_bit_cast(attn_body::bf16x8, pw0); pa[nq][1] = __builtin_bit_cast(attn_body::bf16x8, pw1); }
            if (resc) { LDS_WAIT();
#pragma unroll
                for (int nq = 0; nq < 2; ++nq)
#pragma unroll
                    for (int r = 0; r < 16; ++r) { const float f = wsf[nq * 32 + attn_body::crow(r, hi)];
#pragma unroll
                        for (int j = 0; j < 2 * NV; ++j) o[nq][j][r] *= f; } }
#pragma unroll
            for (int blk = 0; blk < 2 * NV; ++blk)
#pragma unroll
                for (int k2 = 0; k2 < 2; ++k2) {
                    const LAS unsigned char* vb = vfb + (blk >> 1) * 16384 + slot + (blk & 1) * 4096 + (kh * 2 + k2) * 1024;
                    const attn_body::s16x4 lo_ = __builtin_bit_cast(attn_body::s16x4, __builtin_amdgcn_ds_read_tr16_b64_v4i16((vtr_ptr)vb)), hi_ = __builtin_bit_cast(attn_body::s16x4, __builtin_amdgcn_ds_read_tr16_b64_v4i16((vtr_ptr)(vb + 512)));
                    const attn_body::bf16x8 vf = (attn_body::bf16x8){lo_[0], lo_[1], lo_[2], lo_[3], hi_[0], hi_[1], hi_[2], hi_[3]};
                    o[0][blk] = __builtin_amdgcn_mfma_f32_32x32x16_bf16(pa[0][k2], vf, o[0][blk], 0, 0, 0);
                    o[1][blk] = __builtin_amdgcn_mfma_f32_32x32x16_bf16(pa[1][k2], vf, o[1][blk], 0, 0, 0); }
        }
        if (t + 1 < NT) { const int ns = 8192 - slot; *(LAS u32x4*)(ldsKs + ns + stoff) = kreg;
#pragma unroll
            for (int j = 0; j < NV; ++j) *(LAS u32x4*)(ldsVs + j * 16384 + ns + stoff) = vreg[j]; }
        mw[0] = mwn[0]; mw[1] = mwn[1];
        __syncthreads();
    }
#pragma unroll
    for (int nq = 0; nq < 2; ++nq) { lsum[nq] += shx_(lsum[nq], 32, lane); if (hi == 0) wsf[nq * 32 + r32] = lsum[nq]; }
    LDS_WAIT();
#pragma unroll
    for (int nq = 0; nq < 2; ++nq)
#pragma unroll
      for (int j = 0; j < NV; ++j) {
#pragma unroll
        for (int r = 0; r < 16; ++r) { const int orow = attn_body::crow(r, hi); const float rl = __builtin_amdgcn_rcpf(wsf[nq * 32 + orow]);
            stg[orow * 64 + r32] = (bf16_t)f2bf(o[nq][2 * j][r] * rl); stg[orow * 64 + 32 + r32] = (bf16_t)f2bf(o[nq][2 * j + 1][r] * rl); }
        LDS_WAIT();
#pragma unroll
        for (int q = 0; q < 4; ++q) { const int row = q * 8 + (lane >> 3), ch = lane & 7;
            *(u32x4*)(Ob + (size_t)(q0 + nq * 32 + row) * POUT + j * 64 + ch * 8) = *(const LAS u32x4*)(stg + row * 64 + ch * 8); }
        LDS_WAIT();
      }
    __syncthreads();
}
struct MoeRows {
    static constexpr bool GATHER = true;
    const LAS int* rb; const int* LTOK;
    __device__ __forceinline__ unsigned operator()(const pg8::Unit& u, int r) const { const int e = u.be; const int slot = u.pm * 256 + r - rb[e];
        const int tok = slot < rb[32 + e] ? LTOK[e * 32768 + slot] : 0; return (unsigned)tok * 2048u; }
};
__device__ __forceinline__ void moe_convert(const float* w1, const float* w3, const float* w2, bf16_t* W13, bf16_t* W2, LAS float* scr, int gw, int NGW, int lane) {
    for (int it = gw; it < 32 * 768; it += NGW) {
        const int e = it / 768; int r = it % 768;
        if (r < 256) { transpose_item(w1 + (size_t)e * 1024 * 512, 1024, 512, W13 + (size_t)e * 1024 * 1024, 2, 0, scr, r, 16, lane); continue; } r -= 256;
        if (r < 256) { transpose_item(w3 + (size_t)e * 1024 * 512, 1024, 512, W13 + (size_t)e * 1024 * 1024, 2, 1, scr, r, 16, lane); continue; } r -= 256;
        transpose_item(w2 + (size_t)e * 512 * 1024, 512, 1024, W2 + (size_t)e * 1024 * 512, 1, 0, scr, r, 32, lane);
    }
}
__device__ __forceinline__ void moe_tables(unsigned* ctl, int l, LAS int* tile_e, LAS int* rb, LAS int* nt_p, int tid) {
    if (tid < 64) {
        const int ln = tid;
        const int cnt = ln < 32 ? (int)__hip_atomic_load(ctl + CW_CNT + (l * 32 + (ln & 31)) * 64, __ATOMIC_RELAXED, __HIP_MEMORY_SCOPE_AGENT) : 0;
        const int ntile = (cnt + 255) >> 8;
        int inc = ntile;
#pragma unroll
        for (int off = 1; off < 32; off <<= 1) { const int v = (int)shi_((unsigned)inc, ln - off); if (ln >= off) inc += v; }
        if (ln < 32) { rb[ln] = (inc - ntile) * 256; rb[32 + ln] = cnt; }
        if (ln == 31) nt_p[0] = inc;
    }
    __syncthreads();
    const int nt = nt_p[0];
    for (int t = tid; t < nt; t += NTHREADS) {
        int lo = 0, hi = 31;
        while (lo < hi) { const int mid = (lo + hi + 1) >> 1; if (rb[mid] <= t * 256) lo = mid; else hi = mid - 1; }
        tile_e[t] = lo;
    }
    __syncthreads();
}

template <bool FIRST>
__device__ __forceinline__ float f_pass1(const float* __restrict__ xs_row, bf16_t* __restrict__ xb_row, const bf16_t* __restrict__ y_row, const LAS float* gate, const int kc) {
    float ss = 0.f;
#pragma unroll 1
    for (int s0 = 0; s0 < 32; s0 += 8) {
        u32x4 xr[8], yr[8]; f32x4 xa[8], xc[8];
#pragma unroll
        for (int k = 0; k < 8; ++k) { const int col = 32 * (s0 + k) + 8 * kc;
            if constexpr (FIRST) { xa[k] = *(const f32x4*)(xs_row + col); xc[k] = *(const f32x4*)(xs_row + col + 4); } else xr[k] = *(const u32x4*)(xb_row + col);
            yr[k] = *(const u32x4*)(y_row + col); }
        __builtin_amdgcn_sched_barrier(0);
#pragma unroll
        for (int k = 0; k < 8; ++k) { const int col = 32 * (s0 + k) + 8 * kc;
            f32x4 x0, x1;
            if constexpr (FIRST) { x0 = xa[k]; x1 = xc[k]; }
            else { float xv_[8]; unpack8(xr[k], xv_); x0 = (f32x4){xv_[0], xv_[1], xv_[2], xv_[3]}; x1 = (f32x4){xv_[4], xv_[5], xv_[6], xv_[7]}; }
            float yv[8]; unpack8(yr[k], yv);
            const f32x4 g0 = *(const LAS f32x4*)(gate + col), g1 = *(const LAS f32x4*)(gate + col + 4);
            float nv_[8] = {x0.x + g0.x * yv[0], x0.y + g0.y * yv[1], x0.z + g0.z * yv[2], x0.w + g0.w * yv[3], x1.x + g1.x * yv[4], x1.y + g1.y * yv[5], x1.z + g1.z * yv[6], x1.w + g1.w * yv[7]};
            const u32x4 xw = pack8(nv_); *(u32x4*)(xb_row + col) = xw;
            float rv_[8]; unpack8(xw, rv_);
#pragma unroll
            for (int e = 0; e < 8; ++e) ss += rv_[e] * rv_[e]; }
        __builtin_amdgcn_sched_barrier(0);
    }
    return ss;
}
__device__ __forceinline__ void f_pass2(const bf16_t* __restrict__ xb_row, bf16_t* __restrict__ h_row, const LAS float* modl, const bf16_t* __restrict__ wh, const bf16_t* __restrict__ wl, const float rn, const int kc, f32x4 (&acc)[3]) {
#pragma unroll 1
    for (int s0 = 0; s0 < 32; s0 += 4) {
        u32x4 xr[4]; pg8::bf16x8 bh[4][3], bl[4][3];
#pragma unroll
        for (int k = 0; k < 4; ++k) { const int col = 32 * (s0 + k) + 8 * kc; xr[k] = *(const u32x4*)(xb_row + col);
#pragma unroll
            for (int ct = 0; ct < 3; ++ct) { bh[k][ct] = *(const pg8::bf16x8*)(wh + (size_t)ct * 16 * 1024 + 32 * (s0 + k)); bl[k][ct] = *(const pg8::bf16x8*)(wl + (size_t)ct * 16 * 1024 + 32 * (s0 + k)); } }
        __builtin_amdgcn_sched_barrier(0);
#pragma unroll
        for (int k = 0; k < 4; ++k) { const int col = 32 * (s0 + k) + 8 * kc;
            f32x4 x0, x1; { float xv_[8]; unpack8(xr[k], xv_); x0 = (f32x4){xv_[0], xv_[1], xv_[2], xv_[3]}; x1 = (f32x4){xv_[4], xv_[5], xv_[6], xv_[7]}; }
            const f32x4 c0 = *(const LAS f32x4*)(modl + 2048 + col), c1 = *(const LAS f32x4*)(modl + 2048 + col + 4), s0_ = *(const LAS f32x4*)(modl + 1024 + col), s1_ = *(const LAS f32x4*)(modl + 1024 + col + 4);
            float hv[8];
            hv[0] = x0.x * rn * (1.f + c0.x) + s0_.x; hv[1] = x0.y * rn * (1.f + c0.y) + s0_.y; hv[2] = x0.z * rn * (1.f + c0.z) + s0_.z; hv[3] = x0.w * rn * (1.f + c0.w) + s0_.w;
            hv[4] = x1.x * rn * (1.f + c1.x) + s1_.x; hv[5] = x1.y * rn * (1.f + c1.y) + s1_.y; hv[6] = x1.z * rn * (1.f + c1.z) + s1_.z; hv[7] = x1.w * rn * (1.f + c1.w) + s1_.w;
            const u32x4 hh = pack8(hv);
            *(u32x4*)(h_row + col) = hh;
            float hl[8]; { float hf[8]; unpack8(hh, hf);
#pragma unroll
                for (int e = 0; e < 8; ++e) hl[e] = hv[e] - hf[e]; }
            const u32x4 hlw = pack8(hl);
            const pg8::bf16x8 ah = __builtin_bit_cast(pg8::bf16x8, hh), al = __builtin_bit_cast(pg8::bf16x8, hlw);
#pragma unroll
            for (int ct = 0; ct < 3; ++ct) {
                acc[ct] = __builtin_amdgcn_mfma_f32_16x16x32_bf16(ah, bh[k][ct], acc[ct], 0, 0, 0);
                acc[ct] = __builtin_amdgcn_mfma_f32_16x16x32_bf16(ah, bl[k][ct], acc[ct], 0, 0, 0);
                acc[ct] = __builtin_amdgcn_mfma_f32_16x16x32_bf16(al, bh[k][ct], acc[ct], 0, 0, 0);
            } }
        __builtin_amdgcn_sched_barrier(0);
    }
}

__device__ __forceinline__ float relu_i(float x) { return __builtin_bit_cast(float, max(__builtin_bit_cast(int, x), 0)); }
__device__ __forceinline__ int lane_id_v() { int v; asm volatile("v_mbcnt_lo_u32_b32 %0, -1, 0\n\tv_mbcnt_hi_u32_b32 %0, -1, %0" : "=v"(v)); return v; }
__device__ __forceinline__ unsigned long long lsg64(unsigned long long v) { asm volatile("" : "+s"(v)); return v; }
__device__ __forceinline__ int lsg(int v) { asm volatile("" : "+s"(v)); return v; }
__device__ __forceinline__ int lvg(int v) { asm volatile("" : "+v"(v)); return v; }
__device__ __forceinline__ LAS unsigned char* lsgp(LAS unsigned char* p) { unsigned v = (unsigned)(unsigned long long)p; asm volatile("" : "+s"(v)); return (LAS unsigned char*)(unsigned long long)v; }
__device__ __forceinline__ void* ldptr(const LAS unsigned long long* tbl, int k) {
    const unsigned long long v = tbl[k];
    const unsigned lo = __builtin_amdgcn_readfirstlane((unsigned)v), hi = __builtin_amdgcn_readfirstlane((unsigned)(v >> 32));
    return (void*)(__attribute__((address_space(1))) void*)(((unsigned long long)hi << 32) | lo);
}
#define DECL_PTRS() \
    const int wid = lsg(wid0), lane = lane_id_v(), tid = wid * 64 + lane; \
    const int G = lsg(G0), c = lsg(c0), l = lsg(l0), i = l >> 1; \
    const int gw = c * NWAVES + wid, NGW = G * NWAVES, gt = c * NTHREADS + tid, NGT = G * NTHREADS; \
    LAS unsigned char* lds = (LAS unsigned char*)lsgp(lds0); LAS unsigned char* glds = lds; LAS float* scr = (LAS float*)(lds + wid * 16384); \
    const LAS unsigned long long* ptbl = (const LAS unsigned long long*)(lds + LDS_PTBL); \
    unsigned char* ws = (unsigned char*)ldptr(ptbl, 38); unsigned* ctl = (unsigned*)(ws + WS_CTL); \
    const float* xin = (const float*)ldptr(ptbl, 0); \
    const float* cin = (const float*)ldptr(ptbl, 1); \
    const float* ada_w = (const float*)ldptr(ptbl, 2); \
    const float* ada_b = (const float*)ldptr(ptbl, 3); \
    const float* moe_wg = (const float*)ldptr(ptbl, 4); \
    const float* moe_bg = (const float*)ldptr(ptbl, 5); \
    const float* moe_we = (const float*)ldptr(ptbl, 6); \
    const float* moe_be = (const float*)ldptr(ptbl, 7); \
    const float* moe_w1 = (const float*)ldptr(ptbl, 8); \
    const float* moe_w3 = (const float*)ldptr(ptbl, 9); \
    const float* moe_w2 = (const float*)ldptr(ptbl, 10); \
    const float* ev_w_in = (const float*)ldptr(ptbl, 11); \
    const float* ev_w_out = (const float*)ldptr(ptbl, 12); \
    const float* a_qn = (const float*)ldptr(ptbl, 13); \
    const float* a_kn = (const float*)ldptr(ptbl, 14); \
    const float* a_lq1 = (const float*)ldptr(ptbl, 15); \
    const float* a_lk1 = (const float*)ldptr(ptbl, 16); \
    const float* a_lq2 = (const float*)ldptr(ptbl, 17); \
    const float* a_lk2 = (const float*)ldptr(ptbl, 18); \
    const float* a_subln = (const float*)ldptr(ptbl, 19); \
    const float* b_qn = (const float*)ldptr(ptbl, 20); \
    const float* b_kn = (const float*)ldptr(ptbl, 21); \
    const float* b_idx_kn = (const float*)ldptr(ptbl, 22); \
    const float* od_w_in = (const float*)ldptr(ptbl, 23); \
    const float* od_w_out = (const float*)ldptr(ptbl, 24); \
    const float* c_qn = (const float*)ldptr(ptbl, 25); \
    const float* c_kn = (const float*)ldptr(ptbl, 26); \
    const float* s5_lam_re = (const float*)ldptr(ptbl, 27); \
    const float* s5_lam_im = (const float*)ldptr(ptbl, 28); \
    const float* s5_b_re = (const float*)ldptr(ptbl, 29); \
    const float* s5_b_im = (const float*)ldptr(ptbl, 30); \
    const float* s5_c_re = (const float*)ldptr(ptbl, 31); \
    const float* s5_c_im = (const float*)ldptr(ptbl, 32); \
    const float* s5_d = (const float*)ldptr(ptbl, 33); \
    const float* s5_log_dt = (const float*)ldptr(ptbl, 34); \
    const float* s5_glu_w = (const float*)ldptr(ptbl, 35); \
    const float* s5_glu_b = (const float*)ldptr(ptbl, 36); \
    float* out = (float*)ldptr(ptbl, 37); \
    float* MOD = (float*)(ws + WS_MOD); \
    float* MODP = (float*)(ws + WS_MODP); \
    float* COSH = (float*)(ws + WS_ROPE); \
    float* SINH = COSH + S * 8; \
    float* COSI = SINH + S * 8; \
    float* SINI = COSI + S * 4; \
    float* S5A = (float*)(ws + WS_S5A); \
    float* S5B = (float*)(ws + WS_S5B); \
    float* LAM = (float*)(ws + WS_LAM); \
    float* KM = (float*)(ws + WS_KM); \
    bf16_t* KMH = (bf16_t*)(ws + WS_KMH); \
    bf16_t* WRH = (bf16_t*)(ws + WS_WRH); \
    bf16_t* WRL = (bf16_t*)(ws + WS_WRH + 393216); \
    bf16_t* KML = (bf16_t*)(ws + WS_KMH + 131072); \
    bf16_t* Wevin = (bf16_t*)(ws + WS_WEVIN); \
    bf16_t* Wevout = (bf16_t*)(ws + WS_WEVOUT); \
    bf16_t* Wodin = (bf16_t*)(ws + WS_WODIN); \
    bf16_t* Wodout = (bf16_t*)(ws + WS_WODOUT); \
    bf16_t* Wglu = (bf16_t*)(ws + WS_WGLU); \
    bf16_t* W13 = (bf16_t*)(ws + WS_W13); \
    bf16_t* W2 = (bf16_t*)(ws + WS_W2); \
    bf16_t* H = (bf16_t*)(ws + WS_H); \
    bf16_t* O = (bf16_t*)(ws + WS_O); \
    bf16_t* Z = (bf16_t*)(ws + WS_Z); \
    bf16_t* XG = (bf16_t*)(ws + WS_XG); \
    bf16_t* Y = (bf16_t*)(ws + WS_Y); \
    bf16_t* HID = (bf16_t*)(ws + WS_HID); \
    float* IQ = (float*)(ws + WS_IQ); \
    bf16_t* YG = (bf16_t*)(ws + WS_YG); \
    float* IKW = (float*)(ws + WS_IKW); \
    _Float16* IQH = (_Float16*)(ws + WS_IQH); \
    _Float16* IKH = (_Float16*)(ws + WS_IKH); \
    float* IW = (float*)(ws + WS_IW); \
    int* SEL = (int*)(ws + WS_SEL); \
    bf16_t* YMIX = (bf16_t*)(ws + WS_YMIX); \
    int* TOKES = (int*)(ws + WS_TOKES); \
    int* LTOK = (int*)(ws + WS_LTOK); \
    float* TOKW = (float*)(ws + WS_TOKW); \
    int* TOKROW = (int*)(ws + WS_TOKROW); \
    bf16_t* UG = (bf16_t*)(ws + WS_UG); \
    float* S5E = (float*)(ws + WS_S5E); \
    bf16_t* S5HC = (bf16_t*)(ws + WS_S5HC); \
    bf16_t* S5KT = (bf16_t*)(ws + WS_S5KT); \
    bf16_t* S5WT = (bf16_t*)(ws + WS_S5WT); \
    bf16_t* S5A2 = (bf16_t*)(ws + WS_S5A2); \
    float* S5PW = (float*)(ws + WS_S5PW); \
    int* MLIST = (int*)(ws + WS_MLIST); \
    bf16_t* MPO = (bf16_t*)(ws + WS_MPO); \
    float* MML = (float*)(ws + WS_MML); \
    int* NSEL = (int*)(ws + WS_NSEL); \
    unsigned* MASKW = (unsigned*)(ws + WS_MASKW); \
    bf16_t* XB = (bf16_t*)(ws + WS_XB);
__global__ void __launch_bounds__(NTHREADS, 2) fwd(Args a) {
    extern __shared__ __attribute__((aligned(16))) unsigned char lds_raw[];
    LAS unsigned char* lds = (LAS unsigned char*)lds_raw;
    const int tid0 = threadIdx.x; const int wid0 = __builtin_amdgcn_readfirstlane(tid0 >> 6);
    const int G0 = gridDim.x, c0 = blockIdx.x;
    unsigned* ctl0 = (unsigned*)(a.ws + WS_CTL);
    LAS unsigned char* lds0 = lds;
    const int lo = a.ph_lo, hi = a.ph_hi;

    LAS unsigned long long* ptbl = (LAS unsigned long long*)(lds + LDS_PTBL);
    if (tid0 == 0) {
#define PT_(k) ptbl[k] = (unsigned long long)a.in[k];
        PT_(0) PT_(1) PT_(2) PT_(3) PT_(4) PT_(5) PT_(6) PT_(7) PT_(8) PT_(9) PT_(10) PT_(11) PT_(12) PT_(13) PT_(14) PT_(15) PT_(16) PT_(17) PT_(18)
        PT_(19) PT_(20) PT_(21) PT_(22) PT_(23) PT_(24) PT_(25) PT_(26) PT_(27) PT_(28) PT_(29) PT_(30) PT_(31) PT_(32) PT_(33) PT_(34) PT_(35) PT_(36)
#undef PT_
        ptbl[37] = (unsigned long long)a.out; ptbl[38] = (unsigned long long)a.ws;
    }
    if (tid0 < 4) ((LAS unsigned*)(lds + LDS_BARW))[tid0] = 0u;
    __syncthreads();
    XcdBarrier bar; bar.bar = ctl0 + CW_BAR; bar.x = 0; bar.st = (volatile LAS unsigned*)(lds + LDS_BARW);
    if (hi - lo > 1) bar = xcd_barrier_post(ctl0 + CW_BAR, (volatile LAS unsigned*)(lds + LDS_BARW), tid0 == 0);
    int ph = 0, l0 = 0;
#define PH_ON() (ph >= lo && ph < hi)
#define PH_END() do { if (ph >= lo && ph + 1 < hi) { XcdBarrier bb_; bb_.bar = (unsigned*)lsg64((unsigned long long)bar.bar); bb_.x = bar.x; bb_.st = bar.st; xcd_barrier(bb_, lsg(wid0) == 0 && lane_id_v() == 0); PROBE_EXTRA_BAR(bb_) } ++ph; } while (0)

    if (PH_ON()) { DECL_PTRS();
        {
            constexpr int I_EVIN = 16 * 112, I_SQ = 16 * 32, I_ODIN = 16 * 64, I_GLU = 8 * 16;
            constexpr int I_PER = I_EVIN + I_SQ + I_ODIN + I_SQ + I_GLU;
            for (int it = gw; it < 2 * I_PER; it += NGW) {
                const int i = it / I_PER; int r = it % I_PER;
                if (r < I_EVIN) { transpose_item(ev_w_in + (size_t)i * 1024 * EV_N, 1024, EV_N, Wevin + (size_t)i * EV_NP * 1024, -1, 0, scr, r, 112, lane); continue; } r -= I_EVIN;
                if (r < I_SQ) { transpose_item(ev_w_out + (size_t)i * 1024 * 1024, 1024, 1024, Wevout + (size_t)i * 1024 * 1024, 1, 0, scr, r, 32, lane); continue; } r -= I_SQ;
                if (r < I_ODIN) { transpose_item(od_w_in + (size_t)i * 1024 * 2048, 1024, 2048, Wodin + (size_t)i * 2048 * 1024, -2, 0, scr, r, 64, lane); continue; } r -= I_ODIN;
                if (r < I_SQ) { transpose_item(od_w_out + (size_t)i * 1024 * 1024, 1024, 1024, Wodout + (size_t)i * 1024 * 1024, 1, 0, scr, r, 32, lane); continue; } r -= I_SQ;
                transpose_item(s5_glu_w + (size_t)i * 512 * 512, 512, 512, Wglu + (size_t)i * 512 * 512, 1, 0, scr, r, 16, lane);
            }
        }
        __syncthreads();
        {
            LAS float* cact = (LAS float*)lds;
            for (int i = tid; i < 2048; i += NTHREADS) { const float v = cin[i]; cact[i] = v / (1.0f + __expf(-v)); }
            __syncthreads();
            for (int idx = gt; idx < 4 * 4 * 6144; idx += NGT) {
                const int kq = idx / 24576, rem = idx % 24576, l = rem / 6144, n = rem % 6144;
                const float* w = ada_w + ((size_t)l * 1024 + kq * 256) * 6144 + n;
                float a0 = 0.f, a1 = 0.f;
#pragma unroll 32
                for (int k = 0; k < 256; ++k) { const float wv = w[(size_t)k * 6144]; a0 += cact[kq * 256 + k] * wv; a1 += cact[1024 + kq * 256 + k] * wv; }
                MODP[((size_t)(kq * 4 + l) * 2 + 0) * 6144 + n] = a0;
                MODP[((size_t)(kq * 4 + l) * 2 + 1) * 6144 + n] = a1;
            }
            __syncthreads();
        }
        for (int idx = gt; idx < S * 12; idx += NGT) {
            if (idx < S * 8) { const int pos = idx >> 3, j = idx & 7; const float inv = (float)pow(500000.0, -(double)(2 * j) / 16.0); const float ang = (float)pos * inv;
                COSH[idx] = (float)cos((double)ang); SINH[idx] = (float)sin((double)ang); }
            else { const int k = idx - S * 8; const int pos = k >> 2, j = k & 3; const float inv = (float)pow(500000.0, -(double)(2 * j) / 8.0); const float ang = (float)pos * inv;
                COSI[k] = (float)cos((double)ang); SINI[k] = (float)sin((double)ang); }
        }
        for (int idx = gt; idx < 2 * 32 * 64; idx += NGT) {
            const int i = idx >> 11, g = (idx >> 6) & 31;
            const float dt = expf(s5_log_dt[i * 32 + g]);
            const float lr = s5_lam_re[idx], li = s5_lam_im[idx];
            const float mag = expf(lr * dt);
            const float ar = mag * (float)cos((double)(li * dt)), ai = mag * (float)sin((double)(li * dt));
            const float den = lr * lr + li * li;
            const float cr = ((ar - 1.0f) * lr + ai * li) / den, ci = (ai * lr - (ar - 1.0f) * li) / den;
            S5A[idx * 2] = ar; S5A[idx * 2 + 1] = ai;
            { float pr = 1.f, pi_ = 0.f; for (int n = 0; n <= 64; ++n) { S5PW[((size_t)idx * 65 + n) * 2] = pr; S5PW[((size_t)idx * 65 + n) * 2 + 1] = pi_; const float nr = pr * ar - pi_ * ai, ni = pr * ai + pi_ * ar; pr = nr; pi_ = ni; } }
            { float brv[16], biv[16];
#pragma unroll
              for (int cc = 0; cc < 16; ++cc) { brv[cc] = s5_b_re[(size_t)idx * 16 + cc]; biv[cc] = s5_b_im[(size_t)idx * 16 + cc]; }
              __builtin_amdgcn_sched_barrier(0);
#pragma unroll
              for (int cc = 0; cc < 16; ++cc) { const float br = brv[cc], bi = biv[cc];
                  *(f32x2*)(S5B + ((size_t)idx * 16 + cc) * 2) = (f32x2){cr * br - ci * bi, cr * bi + ci * br}; } }
        }
        for (int idx = gt; idx < DEPTH * 48 * 1024; idx += NGT) {
            const int k = idx & 1023, col = (idx >> 10) % 48, ll = idx / (48 * 1024);
            const float w = col < 4 ? moe_wg[((size_t)ll * 1024 + k) * 4 + col] : col < 36 ? moe_we[((size_t)ll * 1024 + k) * 32 + col - 4] : 0.f;
            const unsigned hb = f2bf(w); WRH[idx] = (bf16_t)hb; WRL[idx] = (bf16_t)f2bf(w - __uint_as_float(hb << 16));
        }
        if (gw < 2) { const int i = gw;
            const float s1 = wave_sum(a_lq1[i * 64 + lane] * a_lk1[i * 64 + lane]), s2 = wave_sum(a_lq2[i * 64 + lane] * a_lk2[i * 64 + lane]);
            const float lam_init = 0.8f - 0.6f * expf(-0.3f * (float)(2 * i));
            if (lane == 0) LAM[i] = expf(s1) - expf(s2) + lam_init; }
    }
    PH_END();
    if (PH_ON()) { DECL_PTRS();
        for (int idx = gt; idx < 4 * 2 * 6144; idx += NGT) {
            const int l = idx / 12288, b = (idx / 6144) & 1, n = idx % 6144;
            float v = ada_b[l * 6144 + n];
#pragma unroll
            for (int kq = 0; kq < 4; ++kq) v += MODP[((size_t)(kq * 4 + l) * 2 + b) * 6144 + n];
            MOD[idx] = v;
        }
        for (int idx = gt; idx < 2 * 32 * 65 * 256; idx += NGT) {
            const int ci = idx & 15, co = (idx >> 4) & 15, tr = (idx >> 8) % 65, ig = idx / (65 * 256);
            float acc = 0.f;
            if (tr > 0) {
                const int tau = tr - 1;
#pragma unroll 16
                for (int p = 0; p < 64; ++p) { const int sp = ig * 64 + p;
                    const float cr = s5_c_re[((size_t)ig * 16 + co) * 64 + p], cim_ = s5_c_im[((size_t)ig * 16 + co) * 64 + p];
                    const f32x2 pw_ = *(const f32x2*)(S5PW + ((size_t)sp * 65 + tau) * 2), bb_ = *(const f32x2*)(S5B + ((size_t)sp * 16 + ci) * 2);
                    const float pr = pw_.x, pi_ = pw_.y, br = bb_.x, bi = bb_.y;
                    const float xr = cr * pr - cim_ * pi_, xi = cr * pi_ + cim_ * pr;
                    acc += xr * br - xi * bi; }
            }
            S5KT[((size_t)ig * 65 + tr) * 384 + co * 24 + ci] = (bf16_t)f2bf(acc);
        }
        constexpr int NW_ = 2 * 32 * 128 * 1024;
        for (int idx0 = gt; idx0 < NW_; idx0 += NGT * 8) {
            f32x2 pw_[8], bb_[8];
#pragma unroll
            for (int u = 0; u < 8; ++u) { const int idx = min(idx0 + u * NGT, NW_ - 1);
                const int k = idx & 1023, row = (idx >> 10) & 127, ig = idx >> 17; const int s = k >> 4, ci = k & 15, p = row >> 1; const int sp = ig * 64 + p;
                pw_[u] = *(const f32x2*)(S5PW + ((size_t)sp * 65 + (63 - s)) * 2); bb_[u] = *(const f32x2*)(S5B + ((size_t)sp * 16 + ci) * 2); }
            __builtin_amdgcn_sched_barrier(0);
#pragma unroll
            for (int u = 0; u < 8; ++u) { const int idx = idx0 + u * NGT;
                if (idx < NW_) { const int ri = (idx >> 10) & 1; const float pr = pw_[u].x, pi_ = pw_[u].y, br = bb_[u].x, bi = bb_[u].y;
                    S5WT[idx] = (bf16_t)f2bf(ri ? (pr * bi + pi_ * br) : (pr * br - pi_ * bi)); } }
            __builtin_amdgcn_sched_barrier(0);
        }
        for (int idx0 = gt; idx0 < NW_; idx0 += NGT * 8) {
            f32x2 pw_[8]; float crv[8], civ[8];
#pragma unroll
            for (int u = 0; u < 8; ++u) { const int idx = min(idx0 + u * NGT, NW_ - 1);
                const int k = idx & 127, rowt = (idx >> 7) & 1023, ig = idx >> 17; const int t = rowt >> 4, co = rowt & 15, p = k >> 1; const int sp = ig * 64 + p;
                crv[u] = s5_c_re[((size_t)ig * 16 + co) * 64 + p]; civ[u] = s5_c_im[((size_t)ig * 16 + co) * 64 + p];
                pw_[u] = *(const f32x2*)(S5PW + ((size_t)sp * 65 + t + 1) * 2); }
            __builtin_amdgcn_sched_barrier(0);
#pragma unroll
            for (int u = 0; u < 8; ++u) { const int idx = idx0 + u * NGT;
                if (idx < NW_) { const int ri = idx & 1; const float cr = crv[u], cim_ = civ[u], pr = pw_[u].x, pi_ = pw_[u].y;
                    S5A2[idx] = (bf16_t)f2bf(ri ? -(cr * pi_ + cim_ * pr) : (cr * pr - cim_ * pi_)); } }
            __builtin_amdgcn_sched_barrier(0);
        }
    }
    PH_END();
    if (PH_ON()) { DECL_PTRS();
        for (int t0 = gw * 4; t0 < T; t0 += NGW * 4) {
            const int b = t0 / S; const float* mo = MOD + (size_t)(0 * 2 + b) * 6144;
            f32x4 v[4][4], sc1[4], sh1[4];
#pragma unroll
            for (int u = 0; u < 4; ++u)
#pragma unroll
                for (int j = 0; j < 4; ++j) v[u][j] = *(const f32x4*)(xin + (size_t)(t0 + u) * 1024 + 4 * lane + 256 * j);
#pragma unroll
            for (int j = 0; j < 4; ++j) { sc1[j] = *(const f32x4*)(mo + 1024 + 4 * lane + 256 * j); sh1[j] = *(const f32x4*)(mo + 4 * lane + 256 * j); }
            __builtin_amdgcn_sched_barrier(0);
#pragma unroll
            for (int u = 0; u < 4; ++u) { float ss = 0.f;
#pragma unroll
                for (int j = 0; j < 4; ++j) ss += (v[u][j].x * v[u][j].x + v[u][j].y * v[u][j].y) + (v[u][j].z * v[u][j].z + v[u][j].w * v[u][j].w);
                const float rn = rsqrtf(wave_sum(ss) * (1.0f / 1024.0f) + EPS);
#pragma unroll
                for (int j = 0; j < 4; ++j) { const int col = 4 * lane + 256 * j;
                    u32x2 w; w.x = pk2(v[u][j].x * rn * (1.f + sc1[j].x) + sh1[j].x, v[u][j].y * rn * (1.f + sc1[j].y) + sh1[j].y); w.y = pk2(v[u][j].z * rn * (1.f + sc1[j].z) + sh1[j].z, v[u][j].w * rn * (1.f + sc1[j].w) + sh1[j].w);
                    *(u32x2*)(H + (size_t)(t0 + u) * 1024 + col) = w; } }
            __builtin_amdgcn_sched_barrier(0);
        }
    }
    PH_END();

    for (l0 = 0; l0 < DEPTH; ++l0) {
        if ((l0 & 1) == 0) {
            if (PH_ON()) { DECL_PTRS();
                pg8::Gemm g{H, Wevin + (size_t)i * EV_NP * 1024, T, EV_NP, 1024, 0}; pg8::StaticOrder So; So.init(T, EV_NP, G, c);
                EpiEvenIn E{Z, IQH, IKH, IW, a_kn + i * 64, b_kn + i * 64, b_idx_kn + i * 32, COSH, SINH, COSI, SINI};
                { PROBE_WRAP(pg8::StaticOrder, So); pg8::gemm_phase<EpiEvenIn, PROBE_SCHED(pg8::StaticOrder), true, true>(glds, g, PS_, E, tid); }
            }
            PH_END();
            if (PH_ON()) { DECL_PTRS();
                moe_convert(moe_w1 + (size_t)l * 32 * 1024 * 512, moe_w3 + (size_t)l * 32 * 1024 * 512, moe_w2 + (size_t)l * 32 * 512 * 1024, W13, W2, scr, gw, NGW, lane);
                __syncthreads();
                {
                    LAS unsigned short* kq = (LAS unsigned short*)lds;
                    const int qi = tid >> 7, ht = tid & 127;
                    LAS unsigned short* kqq = kq + qi * 16384;
                    LAS unsigned* hist = (LAS unsigned*)(lds + LDS_MISC + qi * 6400);
                    LAS unsigned* bits = hist + 1024;
                    LAS unsigned* misc = hist + 1536;
                    for (int it = 0;; ++it) {
                        const int L = it * G + c; if (L >= 8192) break;
                        const int uu = (L & 1) ? (8191 - (L >> 1)) : (L >> 1);
                        const int b = uu >> 12, pp = uu & 4095;
                        const size_t tA = (size_t)b * S + 4 * pp;
                        const int nD = 4 * pp + 4;
#pragma unroll
                        for (int q = 0; q < 8; ++q) hist[ht + 128 * q] = 0u;
                        __syncthreads();
#ifdef PROBE_MASK
                        if (a.probe_var != 2)
#endif
                        {
                            const int r32 = lane & 31, hi = lane >> 5;
                            typedef _Float16 f16x8_t __attribute__((ext_vector_type(8)));
                            f16x8_t qa[2];
#pragma unroll
                            for (int s = 0; s < 2; ++s) qa[s] = *(const f16x8_t*)(IQH + (tA + 2 * ((r32 >> 2) & 1) + (r32 >> 4)) * 256 + (4 * ((r32 >> 3) & 1) + (r32 & 3)) * 32 + 16 * s + 8 * hi);
                            f32x4 wq[4];
#pragma unroll
                            for (int q = 0; q < 4; ++q) wq[q] = *(const f32x4*)(IW + (tA + 2 * hi + (q >> 1)) * 8 + 4 * (q & 1));
                            const int ntile = (nD + 31) >> 5;
                            const _Float16* kbase = IKH + ((size_t)b * S + r32) * 32 + 8 * hi;
                            f16x8_t kb[4][2], kn[4][2];
#pragma unroll
                            for (int u = 0; u < 4; ++u) { const int tile = min(wid + NWAVES * u, ntile - 1);
                                kb[u][0] = *(const f16x8_t*)(kbase + (size_t)tile * 1024); kb[u][1] = *(const f16x8_t*)(kbase + (size_t)tile * 1024 + 16); }
                            for (int tile0 = wid; tile0 < ntile; tile0 += NWAVES * 4) {
#pragma unroll
                                for (int u = 0; u < 4; ++u) { const int tile = min(tile0 + NWAVES * (4 + u), ntile - 1);
                                    kn[u][0] = *(const f16x8_t*)(kbase + (size_t)tile * 1024); kn[u][1] = *(const f16x8_t*)(kbase + (size_t)tile * 1024 + 16); }
#pragma unroll
                                for (int u = 0; u < 4; ++u) {
                                    const int tile = tile0 + NWAVES * u;
                                    attn_body::f32x16 acc;
#pragma unroll
                                    for (int r = 0; r < 16; ++r) acc[r] = 0.f;
                                    acc = __builtin_amdgcn_mfma_f32_32x32x16_f16(qa[0], kb[u][0], acc, 0, 0, 0);
                                    acc = __builtin_amdgcn_mfma_f32_32x32x16_f16(qa[1], kb[u][1], acc, 0, 0, 0);
                                    float sq[4];
#pragma unroll
                                    for (int q = 0; q < 4; ++q) sq[q] = wq[q].x * relu_i(acc[4 * q]) + wq[q].y * relu_i(acc[4 * q + 1]) + wq[q].z * relu_i(acc[4 * q + 2]) + wq[q].w * relu_i(acc[4 * q + 3]);
                                    if (tile < ntile) {
                                        const float sa = sq[0] + sq[1], sb = sq[2] + sq[3];
                                        const unsigned h0 = (unsigned)__builtin_bit_cast(unsigned short, (_Float16)sa), h1 = (unsigned)__builtin_bit_cast(unsigned short, (_Float16)sb);
                                        const unsigned k0_ = (h0 ^ ((unsigned)__builtin_amdgcn_sbfe((int)h0, 15, 1) | 0x8000u)) & 0xFFFFu, k1_ = (h1 ^ ((unsigned)__builtin_amdgcn_sbfe((int)h1, 15, 1) | 0x8000u)) & 0xFFFFu;
                                        const int kidx = tile * 32 + r32;
                                        kq[(2 * hi) * 16384 + kidx] = (unsigned short)k0_;
                                        kq[(2 * hi + 1) * 16384 + kidx] = (unsigned short)k1_;
                                        LAS unsigned* hq0 = (LAS unsigned*)(lds + LDS_MISC + (2 * hi) * 6400); LAS unsigned* hq1 = (LAS unsigned*)(lds + LDS_MISC + (2 * hi + 1) * 6400);
                                        __hip_atomic_fetch_add(&hq0[(kidx <= 4 * pp + 2 * hi) ? ((k0_ >> 8) << 2) + (lane & 3) : 1536 + 32 + (lane & 3)], 1u, __ATOMIC_RELAXED, __HIP_MEMORY_SCOPE_WORKGROUP);
                                        __hip_atomic_fetch_add(&hq1[(kidx <= 4 * pp + 2 * hi + 1) ? ((k1_ >> 8) << 2) + (lane & 3) : 1536 + 32 + (lane & 3)], 1u, __ATOMIC_RELAXED, __HIP_MEMORY_SCOPE_WORKGROUP);
                                    }
                                }
#pragma unroll
                                for (int u = 0; u < 4; ++u) { kb[u][0] = kn[u][0]; kb[u][1] = kn[u][1]; }
                            }
                        }
                        __syncthreads();
#ifdef PROBE_MASK
                        if (a.probe_var == 1) continue;
#endif
                        const int n = 4 * pp + 1 + qi;
                        const bool small = n <= 256;
                        if (ht == 0) { misc[0] = 0u; misc[1] = 256u; misc[2] = 0u; }
                        const LAS unsigned* kq32 = (const LAS unsigned*)kqq;
                        const int npair = (n + 1) >> 1;
                        for (int pass = 0; pass < 2; ++pass) {
                            if (pass) {
#pragma unroll
                                for (int q = 0; q < 8; ++q) hist[ht + 128 * q] = 0u; }
                            __syncthreads();
                            const int shift = 8 - 8 * pass;
                            if (!small && pass) {
                                const unsigned prefix = misc[0];
                                for (int W = ht; 32 * W < n; W += 128) {
                                    const unsigned vmask = (n - 32 * W >= 32) ? 0xFFFFFFFFu : ((1u << (n - 32 * W)) - 1u);
                                    const LAS u32x4* kp = (const LAS u32x4*)(kq32 + 16 * W);
                                    unsigned mm = 0u;
#pragma unroll
                                    for (int q4 = 0; q4 < 4; ++q4) { const u32x4 w4 = kp[q4];
#pragma unroll
                                        for (int e = 0; e < 4; ++e) { const unsigned w = w4[e]; const int j = 8 * q4 + 2 * e;
                                            mm |= (unsigned)((w & 0xFF00u) == prefix) << j; mm |= (unsigned)(((w >> 16) & 0xFF00u) == prefix) << (j + 1); } }
                                    mm &= vmask;
                                    const LAS unsigned short* k16 = kqq + 32 * W;
                                    while (mm) { const int j = __ffs(mm) - 1; mm &= mm - 1u;
                                        __hip_atomic_fetch_add(&hist[(((unsigned)k16[j] & 255u) << 2) + (lane & 3)], 1u, __ATOMIC_RELAXED, __HIP_MEMORY_SCOPE_WORKGROUP); }
                                }
                            }
                            __syncthreads();
                            if (!small && ht < 64) {
                                unsigned cb[4];
#pragma unroll
                                for (int q = 0; q < 4; ++q) { const u32x4 a0 = *(const LAS u32x4*)(hist + (4 * ht + q) * 4); cb[q] = (a0.x + a0.y) + (a0.z + a0.w); }
                                const unsigned c0 = cb[0], c1 = cb[1], c2 = cb[2], c3 = cb[3];
                                const unsigned tot = c0 + c1 + c2 + c3;
                                unsigned Ssum = tot;
#pragma unroll
                                for (int off = 1; off < 64; off <<= 1) { const unsigned v = shi_(Ssum, lane + off); if (ht + off < 64) Ssum += v; }
                                const unsigned above = Ssum - tot, krem = misc[1];
                                if (above < krem && krem <= Ssum) {
                                    unsigned run = above, bin, eq;
                                    if (run + c3 >= krem) { bin = 3; eq = c3; }
                                    else { run += c3; if (run + c2 >= krem) { bin = 2; eq = c2; }
                                        else { run += c2; if (run + c1 >= krem) { bin = 1; eq = c1; } else { run += c1; bin = 0; eq = c0; } } }
                                    misc[0] = misc[0] | ((4u * ht + bin) << shift); misc[1] = krem - run; misc[2] = eq;
                                }
                            }
                            __syncthreads();
                        }
#ifdef PROBE_MASK
                        if (a.probe_var == 8) { __syncthreads(); continue; }
#endif
                        const unsigned Tkey = misc[0], krem = misc[1], cnteq = misc[2];
                        LAS unsigned* eqb = hist;
                        const bool all_eq = (cnteq == krem);
                        for (int W = ht; W < 512; W += 128) {
                            unsigned sel = 0u, eqm = 0u;
                            if (32 * W < n) {
                                const unsigned vmask = (n - 32 * W >= 32) ? 0xFFFFFFFFu : ((1u << (n - 32 * W)) - 1u);
                                if (small) sel = vmask;
                                else {
                                    const LAS u32x4* kp = (const LAS u32x4*)(kq32 + 16 * W);
#pragma unroll
                                    for (int q4 = 0; q4 < 4; ++q4) { const u32x4 w4 = kp[q4];
#pragma unroll
                                        for (int e = 0; e < 4; ++e) { const unsigned w = w4[e]; const int j = 8 * q4 + 2 * e;
                                            const unsigned k0 = w & 0xFFFFu, k1 = w >> 16;
                                            sel |= (unsigned)(k0 > Tkey) << j; sel |= (unsigned)(k1 > Tkey) << (j + 1);
                                            eqm |= (unsigned)(k0 == Tkey) << j; eqm |= (unsigned)(k1 == Tkey) << (j + 1); } }
                                    if (all_eq) { sel |= eqm; eqm = 0u; }
                                    sel &= vmask; eqm &= vmask;
                                }
                            }
                            bits[W] = sel; eqb[W] = eqm;
                        }
                        __syncthreads();
                        if (!small && !all_eq && ht < 64) {
                            unsigned wv_[8]; unsigned cnt = 0u;
#pragma unroll
                            for (int q = 0; q < 8; ++q) { wv_[q] = eqb[8 * ht + q]; cnt += (unsigned)__popc(wv_[q]); }
                            unsigned inc = cnt;
#pragma unroll
                            for (int off = 1; off < 64; off <<= 1) { const unsigned v = shi_(inc, lane - off); if (lane >= off) inc += v; }
                            unsigned before = inc - cnt;
#pragma unroll
                            for (int q = 0; q < 8; ++q) { unsigned w = wv_[q], keep = 0u;
                                while (w && before < krem) { const unsigned lowb = w & (0u - w); keep |= lowb; w ^= lowb; ++before; }
                                before += (unsigned)__popc(w);
                                if (keep) __hip_atomic_fetch_or(&bits[8 * ht + q], keep, __ATOMIC_RELAXED, __HIP_MEMORY_SCOPE_WORKGROUP); }
                        }
                        __syncthreads();
                        {
                            const int qpos = 4 * pp + qi; const int tmax = 8 * (qpos >> 9) + 7;
#pragma unroll
                            for (int j = 0; j < 2; ++j) { const int tt = 2 * ht + j;
                                if (tt <= tmax) { const unsigned W0 = bits[2 * tt], W1 = bits[2 * tt + 1];
                                    unsigned e0 = W0 & 0x0F0F0F0Fu, e1 = W1 & 0x0F0F0F0Fu, o0 = (W0 >> 4) & 0x0F0F0F0Fu, o1 = (W1 >> 4) & 0x0F0F0F0Fu;
                                    e0 = (e0 | (e0 >> 4)) & 0x00FF00FFu; e0 = (e0 | (e0 >> 8)) & 0xFFFFu; e1 = (e1 | (e1 >> 4)) & 0x00FF00FFu; e1 = (e1 | (e1 >> 8)) & 0xFFFFu;
                                    o0 = (o0 | (o0 >> 4)) & 0x00FF00FFu; o0 = (o0 | (o0 >> 8)) & 0xFFFFu; o1 = (o1 | (o1 >> 4)) & 0x00FF00FFu; o1 = (o1 | (o1 >> 8)) & 0xFFFFu;
                                    u32x2 pm; pm.x = e0 | (e1 << 16); pm.y = o0 | (o1 << 16);
                                    *(u32x2*)(MASKW + (((size_t)(b * 256 + tt)) * S + qpos) * 2) = pm; } }
                        }
                        __syncthreads();
                    }
                }
                __syncthreads();
                {
                    bf16_t* OA = YMIX;
                    const int vcu = (G % 8 == 0) ? (c % 8) * (G / 8) + c / 8 : c;
                    const int nu = (G == 256) ? 4 : (1024 - vcu + G - 1) / G;
                    for (int iu = 0; iu < nu; ++iu) {
                        const int lane = lane_id_v(), wid = lsg(wid0);
                        LAS unsigned char* L0 = lsgp(lds0);
                        int combo, qb;
                        if (G == 256) { combo = vcu >> 4; const int s_ = vcu & 15; qb = iu == 0 ? s_ : iu == 1 ? 31 - s_ : iu == 2 ? 32 + s_ : 63 - s_; }
                        else { const int u = vcu + iu * G; combo = u & 15; qb = 63 - (u >> 4); }
                        const int b = combo >> 3, hc = combo & 7;
                        const bf16_t* zb = Z + (size_t)b * S * EV_ZP;
                        if (qk_bounded(a_qn + i * 64, a_kn + i * 64, lane))
                            flash_unit<2, false, true, EV_ZP, 1024, true>(L0, zb + hc * 64, zb + 512 + hc * 64, zb + 1024 + (hc >> 1) * 128, OA + (size_t)b * S * 1024 + hc * 128, nullptr, qb, wid, lane, a_qn + i * 64, COSH, SINH);
                        else
                            flash_unit<2, false, true, EV_ZP, 1024, false>(L0, zb + hc * 64, zb + 512 + hc * 64, zb + 1024 + (hc >> 1) * 128, OA + (size_t)b * S * 1024 + hc * 128, nullptr, qb, wid, lane, a_qn + i * 64, COSH, SINH);
                    }
                }
            }
            PH_END();
            if (PH_ON()) { DECL_PTRS();
                {
                    const bf16_t* OA = YMIX; const float lamv = LAM[i]; const float lam_init = 0.8f - 0.6f * expf(-0.3f * (float)l);
                    const int h = lane >> 4, vj = (lane >> 3) & 1, d8 = (lane & 7) * 8;
                    float gn[8];
#pragma unroll
                    for (int e = 0; e < 8; ++e) gn[e] = a_subln[i * 128 + vj * 64 + d8 + e] * (1.0f - lam_init);
                    for (int t0 = gw * 4; t0 < T; t0 += NGW * 4) {
                        u32x4 r1[4], r2[4];
#pragma unroll
                        for (int u = 0; u < 4; ++u) { r1[u] = *(const u32x4*)(OA + (size_t)(t0 + u) * 1024 + ((h * 2 + 0) * 2 + vj) * 64 + d8); r2[u] = *(const u32x4*)(OA + (size_t)(t0 + u) * 1024 + ((h * 2 + 1) * 2 + vj) * 64 + d8); }
                        __builtin_amdgcn_sched_barrier(0);
#pragma unroll
                        for (int u = 0; u < 4; ++u) {
                            float o1[8], o2[8], dd[8]; unpack8(r1[u], o1); unpack8(r2[u], o2);
                            float ss = 0.f;
#pragma unroll
                            for (int e = 0; e < 8; ++e) { dd[e] = o1[e] - lamv * o2[e]; ss += dd[e] * dd[e]; }
                            ss += dpp_xor1(ss); ss += dpp_xor2(ss); ss += SHX(ss, 4); ss += SHX(ss, 8);
                            const float r = rsqrtf(ss * (1.0f / 128.0f) + EPS);
#pragma unroll
                            for (int e = 0; e < 8; ++e) dd[e] = dd[e] * r * gn[e];
                            *(u32x4*)(O + (size_t)(t0 + u) * 1024 + h * 128 + vj * 64 + d8) = pack8(dd);
                        }
                        __builtin_amdgcn_sched_barrier(0);
                    }
                }
                {
                    const int vcu = (G % 8 == 0) ? (c % 8) * (G / 8) + c / 8 : c;
                    const int nu = (G == 256) ? 2 : (512 - vcu + G - 1) / G;
                    for (int iu = 0; iu < nu; ++iu) {
                        const int lane = lane_id_v(), wid = lsg(wid0);
                        LAS unsigned char* L0 = lsgp(lds0);
                        int combo, qb;
                        if (G == 256) { combo = vcu >> 4; const int s_ = vcu & 15; qb = iu == 0 ? s_ : 31 - s_; }
                        else { const int u = vcu + iu * G; combo = u & 15; qb = 31 - (u >> 4); }
                        const int b = combo >> 3, h = combo & 7;
                        const bf16_t* zb = Z + (size_t)b * S * EV_ZP;
                        if (qk_bounded(b_qn + i * 64, b_kn + i * 64, lane))
                            flash_unit_q2<1, true, false, EV_ZP, 1024, true>(L0, zb + 1536 + h * 64, zb + 2048 + h * 64, zb + 2560 + h * 64, O + (size_t)b * S * 1024 + 512 + h * 64, MASKW + (size_t)b * 256 * S * 2, qb, wid, lane, b_qn + i * 64, COSH, SINH);
                        else
                            flash_unit_q2<1, true, false, EV_ZP, 1024, false>(L0, zb + 1536 + h * 64, zb + 2048 + h * 64, zb + 2560 + h * 64, O + (size_t)b * S * 1024 + 512 + h * 64, MASKW + (size_t)b * 256 * S * 2, qb, wid, lane, b_qn + i * 64, COSH, SINH);
                    }
                }
            }
            PH_END();
        } else {
            if (PH_ON()) { DECL_PTRS();
                pg8::Gemm g{H, Wodin + (size_t)i * OD_N * 1024, T, OD_N, 1024, 0}; pg8::StaticOrder So; So.init(T, OD_N, G, c);
                EpiOddIn E{Z, UG, c_kn + i * 64, COSH, SINH};
                { PROBE_WRAP(pg8::StaticOrder, So); pg8::gemm_phase<EpiOddIn, PROBE_SCHED(pg8::StaticOrder), true, true>(glds, g, PS_, E, tid); }
            }
            PH_END();
            if (PH_ON()) { DECL_PTRS();
                moe_convert(moe_w1 + (size_t)l * 32 * 1024 * 512, moe_w3 + (size_t)l * 32 * 1024 * 512, moe_w2 + (size_t)l * 32 * 512 * 1024, W13, W2, scr, gw, NGW, lane);
                __syncthreads();
                for (int u = gw; u < NB * 64 * 8; u += NGW) {
                    const int h = u & 7, blk = (u >> 3) & 63, b = u >> 9;
                    const int rs = lane >> 3, d8 = (lane & 7) * 8;
                    const bf16_t* kp = Z + ((size_t)b * S + blk * 256 + rs) * OD_N + 512 + h * 64 + d8;
                    u32x4 kr[32];
#pragma unroll
                    for (int j = 0; j < 32; ++j) kr[j] = *(const u32x4*)(kp + (size_t)(8 * j) * OD_N);
                    __builtin_amdgcn_sched_barrier(0);
                    float sm[8];
#pragma unroll
                    for (int e = 0; e < 8; ++e) sm[e] = 0.f;
#pragma unroll
                    for (int j = 0; j < 32; ++j) { float kv[8]; unpack8(kr[j], kv);
#pragma unroll
                        for (int e = 0; e < 8; ++e) sm[e] += kv[e]; }
#pragma unroll
                    for (int e = 0; e < 8; ++e) { sm[e] += SHX(sm[e], 8); sm[e] += SHX(sm[e], 16); sm[e] += SHX(sm[e], 32); sm[e] *= (1.0f / 256.0f); }
                    if (rs == 0) {
                        *(f32x4*)(KM + (size_t)u * 64 + d8) = (f32x4){sm[0], sm[1], sm[2], sm[3]}; *(f32x4*)(KM + (size_t)u * 64 + d8 + 4) = (f32x4){sm[4], sm[5], sm[6], sm[7]};
                        const u32x4 hw = pack8(sm); float hf[8], lo[8]; unpack8(hw, hf);
#pragma unroll
                        for (int e = 0; e < 8; ++e) lo[e] = sm[e] - hf[e];
                        *(u32x4*)(KMH + ((size_t)(b * 8 + h) * 64 + blk) * 64 + d8) = hw; *(u32x4*)(KML + ((size_t)(b * 8 + h) * 64 + blk) * 64 + d8) = pack8(lo);
                    }
                }
                {
                    const int r32 = lane & 31, hi = lane >> 5;
                    LAS unsigned char* ldsU = lds;
                    LAS float* red = (LAS float*)(lds + 69632);
                    for (int task = c; task < 512; task += G) {
                        const int g = task >> 4, cs = task & 15;
                        for (int q = tid; q < 32 * 128; q += NTHREADS) { const int j = q >> 7, off = (q & 127) * 16;
                            *(LAS u32x4*)(ldsU + j * 2064 + off) = *(const u32x4*)((const unsigned char*)UG + ((size_t)g * T + (size_t)(cs * 32 + j) * 64) * 32 + off); }
                        __syncthreads();
                        const int rb = wid & 3, kh = wid >> 2;
                        attn_body::f32x16 acc;
#pragma unroll
                        for (int r = 0; r < 16; ++r) acc[r] = 0.f;
                        const bf16_t* wrow = S5WT + ((size_t)(i * 32 + g) * 128 + rb * 32 + r32) * 1024 + hi * 8;
#pragma unroll 8
                        for (int ks = kh * 32; ks < kh * 32 + 32; ++ks) {
                            const attn_body::bf16x8 A = *(const attn_body::bf16x8*)(wrow + ks * 16);
                            const attn_body::bf16x8 B = *(const LAS attn_body::bf16x8*)(ldsU + r32 * 2064 + ks * 32 + hi * 16);
                            acc = __builtin_amdgcn_mfma_f32_32x32x16_bf16(A, B, acc, 0, 0, 0);
                        }
                        if (kh == 1) {
#pragma unroll
                            for (int r = 0; r < 16; ++r) red[(rb * 64 + lane) * 16 + r] = acc[r];
                        }
                        __syncthreads();
                        if (kh == 0) {
                            float* ep = S5E + ((size_t)(cs * 32 + r32) * 32 + g) * 128 + rb * 32 + 4 * hi;
#pragma unroll
                            for (int q4 = 0; q4 < 4; ++q4) { f32x4 o;
                                o.x = acc[4 * q4] + red[(rb * 64 + lane) * 16 + 4 * q4]; o.y = acc[4 * q4 + 1] + red[(rb * 64 + lane) * 16 + 4 * q4 + 1];
                                o.z = acc[4 * q4 + 2] + red[(rb * 64 + lane) * 16 + 4 * q4 + 2]; o.w = acc[4 * q4 + 3] + red[(rb * 64 + lane) * 16 + 4 * q4 + 3];
                                *(f32x4*)(ep + 8 * q4) = o; }
                        }
                        __syncthreads();
                    }
                }
            }
            PH_END();
            if (PH_ON()) { DECL_PTRS();
#ifndef SKIP_S5
                {
                    for (int idx = gt; idx < NB * 32 * 64; idx += NGT) {
                        const int b = idx >> 11, g = (idx >> 6) & 31, p = idx & 63;
                        const int sp = (i * 32 + g) * 64 + p;
                        const float aLr = S5PW[((size_t)sp * 65 + 64) * 2], aLi = S5PW[((size_t)sp * 65 + 64) * 2 + 1];
                        float hr = 0.f, hi_ = 0.f;
                        for (int c0 = 0; c0 < 256; c0 += 32) {
                            float er[32], ei[32];
#pragma unroll
                            for (int k = 0; k < 32; ++k) { const float* ep = S5E + ((size_t)(b * 256 + c0 + k) * 32 + g) * 128 + 2 * p; er[k] = ep[0]; ei[k] = ep[1]; }
                            __builtin_amdgcn_sched_barrier(0);
#pragma unroll
                            for (int k = 0; k < 32; ++k) {
                                *(unsigned*)(S5HC + ((size_t)(b * 256 + c0 + k) * 32 + g) * 128 + 2 * p) = pk2(hr, hi_);
                                const float nr = aLr * hr - aLi * hi_ + er[k], ni = aLr * hi_ + aLi * hr + ei[k]; hr = nr; hi_ = ni; }
                        }
                    }
                }
#endif
                {
                    unsigned* mcnt = ctl + CW_MCNT + i * 1024;
                    const int r32 = lane & 31, hi = lane >> 5;
                    for (int u = c; u < NB * 8 * 64; u += G) {
                        const int tb = u & 63, h = (u >> 6) & 7, b = u >> 9;
                        const int pos = tb * 256 + wid * 32 + r32; const size_t t = (size_t)b * S + pos;
                        float tv[3] = {-INFINITY, -INFINITY, -INFINITY}; int ti[3] = {1 << 20, 1 << 20, 1 << 20};
                        if (tb > 0) {
                            attn_body::bf16x8 qr[4];
                            load_q_normed(qr, Z + t * OD_N + h * 64, c_qn + i * 64, COSH, SINH, pos, hi, lane);
                            attn_body::f32x16 g0, g1;
#pragma unroll
                            for (int r = 0; r < 16; ++r) { g0[r] = 0.f; g1[r] = 0.f; }
                            const bf16_t* kh = KMH + ((size_t)(b * 8 + h) * 64 + r32) * 64 + hi * 8; const bf16_t* kl = KML + ((size_t)(b * 8 + h) * 64 + r32) * 64 + hi * 8;
#pragma unroll
                            for (int d0 = 0; d0 < 4; ++d0) {
                                g0 = __builtin_amdgcn_mfma_f32_32x32x16_bf16(*(const attn_body::bf16x8*)(kh + d0 * 16), qr[d0], g0, 0, 0, 0);
                                g0 = __builtin_amdgcn_mfma_f32_32x32x16_bf16(*(const attn_body::bf16x8*)(kl + d0 * 16), qr[d0], g0, 0, 0, 0);
                                if (tb > 32) { g1 = __builtin_amdgcn_mfma_f32_32x32x16_bf16(*(const attn_body::bf16x8*)(kh + 32 * 64 + d0 * 16), qr[d0], g1, 0, 0, 0);
                                               g1 = __builtin_amdgcn_mfma_f32_32x32x16_bf16(*(const attn_body::bf16x8*)(kl + 32 * 64 + d0 * 16), qr[d0], g1, 0, 0, 0); } }
#pragma unroll
                            for (int half = 0; half < 2; ++half)
#pragma unroll
                                for (int r = 0; r < 16; ++r) { const int n = half * 32 + attn_body::crow(r, hi); const float gv = (n < tb) ? (half ? g1[r] : g0[r]) : -INFINITY;
                                    if (gv > tv[0]) { tv[2] = tv[1]; ti[2] = ti[1]; tv[1] = tv[0]; ti[1] = ti[0]; tv[0] = gv; ti[0] = n; }
                                    else if (gv > tv[1]) { tv[2] = tv[1]; ti[2] = ti[1]; tv[1] = gv; ti[1] = n; }
                                    else if (gv > tv[2]) { tv[2] = gv; ti[2] = n; } }
                            float pv_[3]; int pi_[3];
#pragma unroll
                            for (int k = 0; k < 3; ++k) { pv_[k] = SHX(tv[k], 32); pi_[k] = (int)shi_((unsigned)ti[k], lane ^ 32); }
                            float mv[3]; int mi[3]; int ia = 0, ib = 0;
#pragma unroll
                            for (int k = 0; k < 3; ++k) {
                                const float av = ia == 0 ? tv[0] : ia == 1 ? tv[1] : ia == 2 ? tv[2] : -INFINITY; const int ai = ia == 0 ? ti[0] : ia == 1 ? ti[1] : ia == 2 ? ti[2] : (1 << 20);
                                const float bv = ib == 0 ? pv_[0] : ib == 1 ? pv_[1] : ib == 2 ? pv_[2] : -INFINITY; const int bi = ib == 0 ? pi_[0] : ib == 1 ? pi_[1] : ib == 2 ? pi_[2] : (1 << 20);
                                const bool ta = (av > bv) || (av == bv && ai < bi);
                                mv[k] = ta ? av : bv; mi[k] = ta ? ai : bi; if (ta) ++ia; else ++ib; }
#pragma unroll
                            for (int k = 0; k < 3; ++k) { tv[k] = mv[k]; ti[k] = mi[k]; }
                        }
#ifdef PROBE_MASK
                        if (a.probe_var == 3) { if (ti[0] + ti[1] + ti[2] == -12345) NSEL[0] = 1; continue; }
#endif
                        if (hi == 0) {
                            unsigned idx[3];
#pragma unroll
                            for (int sI = 0; sI < 3; ++sI) { idx[sI] = 0u;
                                if (tv[sI] > -INFINITY) idx[sI] = __hip_atomic_fetch_add(mcnt + (b * 8 + h) * 64 + ti[sI], 1u, __ATOMIC_RELAXED, __HIP_MEMORY_SCOPE_AGENT); }
                            int nsel = 0;
#pragma unroll
                            for (int sI = 0; sI < 3; ++sI)
                                if (tv[sI] > -INFINITY) { const int li = (b * 8 + h) * 64 + ti[sI]; MLIST[(size_t)li * 16384 + idx[sI]] = (pos << 2) | nsel; ++nsel; }
                            NSEL[t * 8 + h] = nsel;
                        }
                    }
                }
            }
            PH_END();
            if (PH_ON()) { DECL_PTRS();
                {
                    const unsigned* mcnt = ctl + CW_MCNT + i * 1024;
                    LAS int* pref = (LAS int*)(lds + LDS_MISC);
                    if (wid == 0) {
                        int loc[16]; int sum = 0;
#pragma unroll
                        for (int k = 0; k < 16; ++k) loc[k] = (int)__hip_atomic_load(mcnt + lane * 16 + k, __ATOMIC_RELAXED, __HIP_MEMORY_SCOPE_AGENT);
                        __builtin_amdgcn_sched_barrier(0);
#pragma unroll
                        for (int k = 0; k < 16; ++k) { const int cnt = loc[k]; loc[k] = sum; sum += (cnt + 255) >> 8; }
                        int inc = sum;
#pragma unroll
                        for (int off = 1; off < 64; off <<= 1) { const int v = (int)shi_((unsigned)inc, lane - off); if (lane >= off) inc += v; }
                        const int base = inc - sum;
#pragma unroll
                        for (int k = 0; k < 16; ++k) pref[lane * 16 + k] = base + loc[k];
                        if (lane == 63) pref[1024] = inc;
                    }
                    __syncthreads();
                    const int NTsel = pref[1024];
                    for (int task = c; task < NTsel + 1024; task += G) {
                        const int lane = lane_id_v(), wid = lsg(wid0), r32 = lane & 31, hi = lane >> 5;
                        LAS unsigned char* ldsKs = lsgp(lds0); LAS unsigned char* ldsVs = ldsKs + 32768;
                        LAS bf16_t* stg = (LAS bf16_t*)(ldsKs + 65536 + wid * 4096); LAS float* wsf = (LAS float*)(ldsKs + 98304 + wid * 256); LAS int* rowd = (LAS int*)(ldsKs + 100352 + wid * 128);
                        const bool own_task = task >= NTsel;
                        int li, chunk = 0;
                        if (own_task) li = task - NTsel;
                        else { int lo_ = 0, hi_ = 1023; while (lo_ < hi_) { const int mid = (lo_ + hi_ + 1) >> 1; if (pref[mid] <= task) lo_ = mid; else hi_ = mid - 1; } li = lo_; chunk = task - pref[li]; }
                        const int b = li >> 9, h = (li >> 6) & 7, blk = li & 63;
                        const int e_ = chunk * 256 + wid * 32 + r32;
                        const int cnt = own_task ? 256 : (int)__hip_atomic_load(mcnt + li, __ATOMIC_RELAXED, __HIP_MEMORY_SCOPE_AGENT);
                        const int ent_ = own_task ? 0 : MLIST[(size_t)li * 16384 + e_];
                        u32x4 kst[4], vst[4];
                        {
                            const bf16_t* kbp = Z + ((size_t)b * S + blk * 256) * OD_N + 512 + h * 64;
                            const bf16_t* vbp = Z + ((size_t)b * S + blk * 256) * OD_N + 1024 + h * 64;
#pragma unroll
                            for (int kt = 0; kt < 4; ++kt) {
                                kst[kt] = *(const u32x4*)(kbp + (size_t)(kt * 64 + lane) * OD_N + wid * 8);
                                vst[kt] = *(const u32x4*)(vbp + (size_t)(kt * 64 + 16 * (wid & 3) + (lane >> 2)) * OD_N + (wid >> 2) * 32 + (lane & 3) * 8);
                            }
                        }
                        __builtin_amdgcn_sched_barrier(0);
                        int posq, slot; bool valid;
                        if (own_task) { posq = blk * 256 + wid * 32 + r32; slot = 3; valid = true; }
                        else { valid = e_ < cnt; posq = valid ? (ent_ >> 2) : 0; slot = ent_ & 3; }
                        const size_t tq = (size_t)b * S + posq;
                        const int dest = valid ? (int)((tq * 8 + h) * 4 + slot) : -1;
                        attn_body::bf16x8 qr[4];
                        load_q_normed(qr, Z + tq * OD_N + h * 64, c_qn + i * 64, COSH, SINH, posq, hi, lane);
#pragma unroll
                        for (int kt = 0; kt < 4; ++kt) { *(LAS u32x4*)(ldsKs + kt * 8192 + wid * 1024 + lane * 16) = kst[kt]; *(LAS u32x4*)(ldsVs + kt * 8192 + wid * 1024 + lane * 16) = vst[kt]; }
                        __syncthreads();
                        attn_body::f32x16 p0[4], p1[4];
#pragma unroll
                        for (int kt = 0; kt < 4; ++kt) {
#pragma unroll
                            for (int r = 0; r < 16; ++r) { p0[kt][r] = 0.f; p1[kt][r] = 0.f; }
                            const LAS unsigned char* kb = ldsKs + kt * 8192 + hi * 1024 + r32 * 16;
#pragma unroll
                            for (int d0 = 0; d0 < 4; ++d0) {
                                const attn_body::bf16x8 b0 = *(const LAS attn_body::bf16x8*)(kb + d0 * 2048), b1 = *(const LAS attn_body::bf16x8*)(kb + d0 * 2048 + 512);
                                p0[kt] = __builtin_amdgcn_mfma_f32_32x32x16_bf16(b0, qr[d0], p0[kt], 0, 0, 0);
                                p1[kt] = __builtin_amdgcn_mfma_f32_32x32x16_bf16(b1, qr[d0], p1[kt], 0, 0, 0);
                            }
                        }
                        if (own_task) {
                            const int qrel = wid * 32 + r32;
#pragma unroll
                            for (int kt = 0; kt < 4; ++kt)
#pragma unroll
                                for (int r = 0; r < 16; ++r) { const int kv = kt * 64 + attn_body::crow(r, hi); if (kv > qrel) p0[kt][r] = -INFINITY; if (kv + 32 > qrel) p1[kt][r] = -INFINITY; }
                        }
                        float mx = -INFINITY;
#pragma unroll
                        for (int kt = 0; kt < 4; ++kt)
#pragma unroll
                            for (int r = 0; r < 16; ++r) mx = fmaxf(mx, fmaxf(p0[kt][r], p1[kt][r]));
                        mx = fmaxf(mx, SHX(mx, 32));
                        float ls = 0.f;
#pragma unroll
                        for (int kt = 0; kt < 4; ++kt)
#pragma unroll
                            for (int r = 0; r < 16; ++r) { p0[kt][r] = __builtin_amdgcn_exp2f(p0[kt][r] - mx); p1[kt][r] = __builtin_amdgcn_exp2f(p1[kt][r] - mx); ls += p0[kt][r] + p1[kt][r]; }
                        ls += SHX(ls, 32);
                        attn_body::f32x16 o[2];
#pragma unroll
                        for (int r = 0; r < 16; ++r) { o[0][r] = 0.f; o[1][r] = 0.f; }
                        const int vb0 = (int)(unsigned)(unsigned long long)ldsVs + ((lane >> 4) & 1) * 32 + (lane & 3) * 8 + (4 * hi + ((lane & 15) >> 2)) * 64;
#pragma unroll
                        for (int kt = 0; kt < 4; ++kt) {
                            u32x4 pw0, pw1, pw2, pw3;
#pragma unroll
                            for (int k = 0; k < 4; ++k) { pw0[k] = attn_body::cvtpk_s(p0[kt][2 * k], p0[kt][2 * k + 1]); pw1[k] = attn_body::cvtpk_s(p0[kt][8 + 2 * k], p0[kt][9 + 2 * k]);
                                pw2[k] = attn_body::cvtpk_s(p1[kt][2 * k], p1[kt][2 * k + 1]); pw3[k] = attn_body::cvtpk_s(p1[kt][8 + 2 * k], p1[kt][9 + 2 * k]); }
                            attn_body::pv(o, vb0 + kt * 8192, __builtin_bit_cast(attn_body::bf16x8, pw0), __builtin_bit_cast(attn_body::bf16x8, pw1), __builtin_bit_cast(attn_body::bf16x8, pw2), __builtin_bit_cast(attn_body::bf16x8, pw3));
                        }
                        if (hi == 0) { wsf[r32] = ls; rowd[r32] = dest; if (valid) { MML[(size_t)dest * 2] = mx; MML[(size_t)dest * 2 + 1] = ls; } }
                        LDS_WAIT();
#pragma unroll
                        for (int r = 0; r < 16; ++r) { const int orow = attn_body::crow(r, hi); const float rl = __builtin_amdgcn_rcpf(wsf[orow]);
                            stg[orow * 64 + r32] = (bf16_t)f2bf(o[0][r] * rl); stg[orow * 64 + 32 + r32] = (bf16_t)f2bf(o[1][r] * rl); }
                        LDS_WAIT();
#pragma unroll
                        for (int q = 0; q < 4; ++q) { const int row = q * 8 + (lane >> 3), ch = lane & 7; const int dd = rowd[row];
                            if (dd >= 0) *(u32x4*)(MPO + (size_t)dd * 64 + ch * 8) = *(const LAS u32x4*)(stg + row * 64 + ch * 8); }
                        __syncthreads();
                    }
                }
                {
                const int r32 = lane & 31, hi = lane >> 5;
                LAS unsigned char* ldsU = lds;
                LAS unsigned char* ldsK = lds + 69632;
                for (int task = c; task < 512; task += G) {
                    const int g = task >> 4, cs = task & 15, ig = i * 32 + g;
                    for (int q = tid; q < 32 * 128; q += NTHREADS) { const int j = q >> 7, off = (q & 127) * 16;
                        *(LAS u32x4*)(ldsU + j * 2064 + off) = *(const u32x4*)((const unsigned char*)UG + ((size_t)g * T + (size_t)(cs * 32 + j) * 64) * 32 + off); }
                    for (int q = tid; q < 65 * 48; q += NTHREADS) *(LAS u32x4*)(ldsK + q * 16) = *(const u32x4*)((const unsigned char*)S5KT + (size_t)ig * 65 * 768 + q * 16);
                    __syncthreads();
                    const int gc = cs * 32 + r32;
                    const float* dsk = s5_d + ig * 16;
                    const f32x4 dd0 = *(const f32x4*)(dsk + 4 * hi), dd1 = *(const f32x4*)(dsk + 8 + 4 * hi);
                    attn_body::bf16x8 hcr[8];
                    { const bf16_t* hc = S5HC + ((size_t)gc * 32 + g) * 128 + hi * 8;
#pragma unroll
                      for (int kk = 0; kk < 8; ++kk) hcr[kk] = *(const attn_body::bf16x8*)(hc + kk * 16); }
#pragma unroll 1
                    for (int rr = 0; rr < 4; ++rr) {
                        const int r = rr == 0 ? wid : rr == 1 ? 15 - wid : rr == 2 ? 16 + wid : 31 - wid;
                        attn_body::f32x16 acc;
#pragma unroll
                        for (int q = 0; q < 16; ++q) acc[q] = 0.f;
                        attn_body::bf16x8 a2r[8];
                        { const bf16_t* a2 = S5A2 + ((size_t)ig * 1024 + r * 32 + r32) * 128 + hi * 8;
#pragma unroll
                          for (int kk = 0; kk < 8; ++kk) a2r[kk] = *(const attn_body::bf16x8*)(a2 + kk * 16); }
                        __builtin_amdgcn_sched_barrier(0);
                        const LAS unsigned char* kbase = ldsK + (r32 >> 4) * 768 + (r32 & 15) * 48 + hi * 16;
                        const LAS unsigned char* ubase = ldsU + r32 * 2064 + hi * 16;
                        for (int s = 0; s <= 2 * r + 1; ++s) {
                            const attn_body::bf16x8 A = *(const LAS attn_body::bf16x8*)(kbase + (2 * r - s + 1) * 768);
                            const attn_body::bf16x8 B = *(const LAS attn_body::bf16x8*)(ubase + s * 32);
                            acc = __builtin_amdgcn_mfma_f32_32x32x16_bf16(A, B, acc, 0, 0, 0);
                        }
#pragma unroll
                        for (int kk = 0; kk < 8; ++kk) acc = __builtin_amdgcn_mfma_f32_32x32x16_bf16(a2r[kk], hcr[kk], acc, 0, 0, 0);
#pragma unroll
                        for (int q4 = 0; q4 < 4; ++q4) {
                            const int rowb = 8 * q4 + 4 * hi, dt_ = rowb >> 4, co0 = rowb & 15, t = 2 * r + dt_;
                            const u32x2 uw = *(const LAS u32x2*)(ldsU + r32 * 2064 + t * 32 + co0 * 2);
                            const f32x4 dd = (q4 & 1) ? dd1 : dd0;
                            const float y0 = acc[4 * q4] + dd.x * bflo(uw.x), y1 = acc[4 * q4 + 1] + dd.y * bfhi(uw.x), y2 = acc[4 * q4 + 2] + dd.z * bflo(uw.y), y3 = acc[4 * q4 + 3] + dd.w * bfhi(uw.y);
                            u32x2 w; w.x = pk2(gelu_tanh(y0), gelu_tanh(y1)); w.y = pk2(gelu_tanh(y2), gelu_tanh(y3));
                            *(u32x2*)(YG + ((size_t)gc * 64 + t) * 512 + g * 16 + co0) = w;
                        }
                    }
                    __syncthreads();
                }
                }
            }
            PH_END();
            if (PH_ON()) { DECL_PTRS();
                {
                    const int h = lane >> 3, d8 = (lane & 7) * 8;
                    for (int t0 = gw * 4; t0 < T; t0 += NGW * 4) {
                        int nsel[4]; f32x2 ml[4][4]; u32x4 po[4][4];
#pragma unroll
                        for (int u = 0; u < 4; ++u) { const size_t base = ((size_t)(t0 + u) * 8 + h) * 4; nsel[u] = NSEL[(size_t)(t0 + u) * 8 + h];
#pragma unroll
                            for (int s = 0; s < 4; ++s) { ml[u][s] = *(const f32x2*)(MML + (base + s) * 2); po[u][s] = *(const u32x4*)(MPO + (base + s) * 64 + d8); } }
                        __builtin_amdgcn_sched_barrier(0);
#pragma unroll
                        for (int u = 0; u < 4; ++u) {
                            float mm[4], ll[4];
#pragma unroll
                            for (int s = 0; s < 4; ++s) { const bool on = (s == 3) || (s < nsel[u]); mm[s] = on ? ml[u][s].x : -INFINITY; ll[s] = on ? ml[u][s].y : 0.f; }
                            const float M = fmaxf(fmaxf(mm[0], mm[1]), fmaxf(mm[2], mm[3]));
                            float acc[8], wsum = 0.f;
#pragma unroll
                            for (int e = 0; e < 8; ++e) acc[e] = 0.f;
#pragma unroll
                            for (int s = 0; s < 4; ++s) { const bool on = (s == 3) || (s < nsel[u]);
                                const float w = on ? ll[s] * __builtin_amdgcn_exp2f(mm[s] - M) : 0.f; float ov[8]; unpack8(po[u][s], ov); wsum += w;
#pragma unroll
                                for (int e = 0; e < 8; ++e) acc[e] += on ? w * ov[e] : 0.f; }
                            const float inv = 1.0f / wsum;
#pragma unroll
                            for (int e = 0; e < 8; ++e) acc[e] *= inv;
                            *(u32x4*)(O + (size_t)(t0 + u) * 1024 + h * 64 + d8) = pack8(acc);
                        }
                        __builtin_amdgcn_sched_barrier(0);
                    }
                }
                pg8::Gemm g{YG, Wglu + (size_t)i * 512 * 512, T, 512, 512, 0}; pg8::StaticOrder So; So.init(T, 512, G, c);
                EpiGLU E{O, YG, s5_glu_b + i * 512};
                { PROBE_WRAP(pg8::StaticOrder, So); pg8::gemm_phase<EpiGLU, PROBE_SCHED(pg8::StaticOrder), true, true>(glds, g, PS_, E, tid); }
            }
            PH_END();
        }
        if (PH_ON()) { DECL_PTRS();
            pg8::Gemm g{O, ((l & 1) ? Wodout : Wevout) + (size_t)i * 1024 * 1024, T, 1024, 1024, 0}; pg8::StaticOrder So; So.init(T, 1024, G, c);
            EpiPlain E{YMIX, 1024};
            { PROBE_WRAP(pg8::StaticOrder, So); pg8::gemm_phase<EpiPlain, PROBE_SCHED(pg8::StaticOrder), true, true>(glds, g, PS_, E, tid); }
        }
        PH_END();
        if (PH_ON()) { DECL_PTRS();
#ifdef PROBE_MASK
            const bool first_x = (l == 0 && a.probe_var != -5);
#else
            const bool first_x = (l == 0);
#endif
            const float* xs = xin;
            LAS int* r_e = (LAS int*)(lds + 0);
            LAS float* r_w = (LAS float*)(lds + 1024);
            LAS int* r_rank = (LAS int*)(lds + 2048);
            LAS int* lcnt = (LAS int*)(lds + 3072);
            LAS int* lbase = (LAS int*)(lds + 3200);
            const float* wg_l = moe_wg + (size_t)l * 1024 * 4; const float* we_l = moe_we + (size_t)l * 1024 * 32;
            for (int chunk = c; chunk < T / 128; chunk += G) {
                if (tid < 32) lcnt[tid] = 0;
                LAS float* modl = (LAS float*)(lds + 32768);
                { const float* mo_ = MOD + (size_t)(l * 2 + (int)(((size_t)chunk * 128) / S)) * 6144 + 2048;
                  for (int q = tid; q < 768; q += NTHREADS) *(LAS f32x4*)(modl + 4 * q) = *(const f32x4*)(mo_ + 4 * q); }
                __syncthreads();
                {
                    const int rloc = lane & 15, kc = lane >> 4; const int r = wid * 16 + rloc; const size_t t = (size_t)chunk * 128 + r; const int b = (int)(((size_t)chunk * 128) / S);
                    const float* mo = MOD + (size_t)(l * 2 + b) * 6144;
                    float ss;
                    if (first_x) ss = f_pass1<true>(xs + t * 1024, XB + t * 1024, YMIX + t * 1024, modl, kc);
                    else ss = f_pass1<false>(xs + t * 1024, XB + t * 1024, YMIX + t * 1024, modl, kc);
                    ss += SHX(ss, 16); ss += SHX(ss, 32);
                    const float rn = rsqrtf(ss * (1.0f / 1024.0f) + EPS);
                    f32x4 acc[3];
#pragma unroll
                    for (int ct = 0; ct < 3; ++ct) acc[ct] = (f32x4){0.f, 0.f, 0.f, 0.f};
                    const bf16_t* wh = WRH + ((size_t)l * 48 + rloc) * 1024 + 8 * kc; const bf16_t* wl = WRL + ((size_t)l * 48 + rloc) * 1024 + 8 * kc;
                    f_pass2(XB + t * 1024, H + t * 1024, modl, wh, wl, rn, kc, acc);
                    LAS float* lg = (LAS float*)(lds + 4096 + wid * 3072);
#pragma unroll
                    for (int ct = 0; ct < 3; ++ct) { lg[(4 * kc + 0) * 48 + ct * 16 + rloc] = acc[ct].x; lg[(4 * kc + 1) * 48 + ct * 16 + rloc] = acc[ct].y; lg[(4 * kc + 2) * 48 + ct * 16 + rloc] = acc[ct].z; lg[(4 * kc + 3) * 48 + ct * 16 + rloc] = acc[ct].w; }
                    LDS_WAIT();
                    if (lane < 16) {
                        const LAS float* lr = lg + lane * 48;
                        float cg[4];
#pragma unroll
                        for (int e = 0; e < 4; ++e) cg[e] = lr[e] + moe_bg[l * 4 + e];
                        int grp = 0; float cm = cg[0];
#pragma unroll
                        for (int e = 1; e < 4; ++e) if (cg[e] > cm) { cm = cg[e]; grp = e; }
                        float den = 0.f;
#pragma unroll
                        for (int e = 0; e < 4; ++e) den += __expf(cg[e] - cm);
                        const float pg = 1.0f / den;
                        float fe[8];
#pragma unroll
                        for (int e = 0; e < 8; ++e) fe[e] = lr[4 + grp * 8 + e] + moe_be[l * 32 + grp * 8 + e];
                        int j0 = 0; float f0 = fe[0];
#pragma unroll
                        for (int e = 1; e < 8; ++e) if (fe[e] > f0) { f0 = fe[e]; j0 = e; }
                        int j1 = -1; float f1 = -INFINITY;
#pragma unroll
                        for (int e = 0; e < 8; ++e) if (e != j0 && fe[e] > f1) { f1 = fe[e]; j1 = e; }
                        const float ex = __expf(f1 - f0); const float sA = 1.0f / (1.0f + ex), sB = ex / (1.0f + ex);
                        const int rr_ = wid * 16 + lane;
                        r_e[2 * rr_] = grp * 8 + j0; r_w[2 * rr_] = pg * sA; r_e[2 * rr_ + 1] = grp * 8 + j1; r_w[2 * rr_ + 1] = pg * sB;
                    }
                }
                __syncthreads();
#ifdef PROBE_MASK
                if (a.probe_var == 5) { if (tid < 256 && r_e[tid] == -777) TOKES[0] = 0; __syncthreads(); continue; }
#endif
                if (tid < 256) r_rank[tid] = __hip_atomic_fetch_add(&lcnt[r_e[tid]], 1, __ATOMIC_RELAXED, __HIP_MEMORY_SCOPE_WORKGROUP);
                __syncthreads();
                if (tid < 32) lbase[tid] = (int)__hip_atomic_fetch_add(ctl + CW_CNT + (l * 32 + tid) * 64, (unsigned)lcnt[tid], __ATOMIC_RELAXED, __HIP_MEMORY_SCOPE_AGENT);
                __syncthreads();
                if (tid < 256) { const size_t t = (size_t)chunk * 128 + (tid >> 1); const int k = tid & 1; const int e = r_e[tid]; const int slot = lbase[e] + r_rank[tid];
                    TOKES[t * 2 + k] = e * 32768 + slot; TOKW[t * 2 + k] = r_w[tid]; LTOK[e * 32768 + slot] = (int)t; }
                __syncthreads();
            }
        }
        PH_END();
        if (PH_ON()) { DECL_PTRS();
            LAS int* tile_e = (LAS int*)(lds + LDS_MISC); LAS int* rb = tile_e + 320; LAS int* nt_p = tile_e + 400;
            moe_tables(ctl, l, tile_e, rb, nt_p, tid);
            const int nR = nt_p[0];
            pg8::Gemm g{H, W13, nR * 256, 1024, 1024, (size_t)1024 * 1024 * 2}; MoeOrder Mo{4, nR * 4, G, c, tile_e};
            EpiSwiGLU E{HID}; MoeRows RW{rb, LTOK};
            { PROBE_WRAP(MoeOrder, Mo); pg8::gemm_phase<EpiSwiGLU, PROBE_SCHED(MoeOrder), true, true, MoeRows>(glds, g, PS_, E, tid, RW); }
        }
        PH_END();
        if (PH_ON()) { DECL_PTRS();
            LAS int* tile_e = (LAS int*)(lds + LDS_MISC); LAS int* rb = tile_e + 320; LAS int* nt_p = tile_e + 400;
            moe_tables(ctl, l, tile_e, rb, nt_p, tid);
            const int nR = nt_p[0];
            pg8::Gemm g{HID, W2, nR * 256, 1024, 512, (size_t)1024 * 512 * 2}; MoeOrder Mo{4, nR * 4, G, c, tile_e};
            EpiPlain E{Y, 1024};
            { PROBE_WRAP(MoeOrder, Mo); pg8::gemm_phase<EpiPlain, PROBE_SCHED(MoeOrder), true, true>(glds, g, PS_, E, tid); }
        }
        PH_END();
        if (PH_ON()) { DECL_PTRS();
            LAS int* tile_e = (LAS int*)(lds + LDS_MISC); LAS int* rb = tile_e + 320; LAS int* nt_p = tile_e + 400;
            moe_tables(ctl, l, tile_e, rb, nt_p, tid);
            constexpr int RJ = 4;
            for (int t0 = gw * RJ; t0 < T; t0 += NGW * RJ) {
                const int b = t0 / S; const float* mo = MOD + (size_t)(l * 2 + b) * 6144;
                int r0[RJ], r1[RJ]; float w0[RJ], w1[RJ];
#pragma unroll
                for (int u = 0; u < RJ; ++u) { const int t = t0 + u; { const int e0_ = TOKES[2 * t], e1_ = TOKES[2 * t + 1]; r0[u] = rb[e0_ >> 15] + (e0_ & 32767); r1[u] = rb[e1_ >> 15] + (e1_ & 32767); } w0[u] = TOKW[2 * t]; w1[u] = TOKW[2 * t + 1];
#ifdef PROBE_MASK
                    if (a.probe_var == 4 || a.probe_var == -4) { w0[u] *= 0.5f; w1[u] *= 0.5f; }
#endif
                }
                f32x4 v[RJ][4]; u32x2 ya[RJ][4], yb[RJ][4];
#pragma unroll
                for (int u = 0; u < RJ; ++u)
#pragma unroll
                    for (int j = 0; j < 4; ++j) { const int col = 4 * lane + 256 * j; { const u32x2 xw = *(const u32x2*)(XB + (size_t)(t0 + u) * 1024 + col); v[u][j] = (f32x4){bflo(xw.x), bfhi(xw.x), bflo(xw.y), bfhi(xw.y)}; }
                        ya[u][j] = *(const u32x2*)(Y + (size_t)r0[u] * 1024 + col); yb[u][j] = *(const u32x2*)(Y + (size_t)r1[u] * 1024 + col); }
                f32x4 gg[4];
#pragma unroll
                for (int j = 0; j < 4; ++j) gg[j] = *(const f32x4*)(mo + 5120 + 4 * lane + 256 * j);
                float ss[RJ];
#pragma unroll
                for (int u = 0; u < RJ; ++u) { ss[u] = 0.f;
#pragma unroll
                    for (int j = 0; j < 4; ++j) { const int col = 4 * lane + 256 * j; const f32x4 xv = v[u][j]; f32x4 nv;
                        nv.x = xv.x + gg[j].x * (w0[u] * bflo(ya[u][j].x) + w1[u] * bflo(yb[u][j].x)); nv.y = xv.y + gg[j].y * (w0[u] * bfhi(ya[u][j].x) + w1[u] * bfhi(yb[u][j].x));
                        nv.z = xv.z + gg[j].z * (w0[u] * bflo(ya[u][j].y) + w1[u] * bflo(yb[u][j].y)); nv.w = xv.w + gg[j].w * (w0[u] * bfhi(ya[u][j].y) + w1[u] * bfhi(yb[u][j].y));
                        if (l + 1 < DEPTH) { u32x2 xw; xw.x = pk2(nv.x, nv.y); xw.y = pk2(nv.z, nv.w); *(u32x2*)(XB + (size_t)(t0 + u) * 1024 + col) = xw; nv = (f32x4){bflo(xw.x), bfhi(xw.x), bflo(xw.y), bfhi(xw.y)}; }
                        else *(f32x4*)(out + (size_t)(t0 + u) * 1024 + col) = nv;
                        v[u][j] = nv; ss[u] += (nv.x * nv.x + nv.y * nv.y) + (nv.z * nv.z + nv.w * nv.w); } }
                if (l + 1 < DEPTH) {
                    const float* mn = MOD + (size_t)((l + 1) * 2 + b) * 6144;
                    f32x4 sc1[4], sh1[4];
#pragma unroll
                    for (int j = 0; j < 4; ++j) { sc1[j] = *(const f32x4*)(mn + 1024 + 4 * lane + 256 * j); sh1[j] = *(const f32x4*)(mn + 4 * lane + 256 * j); }
#pragma unroll
                    for (int u = 0; u < RJ; ++u) { const float rn = rsqrtf(wave_sum(ss[u]) * (1.0f / 1024.0f) + EPS);
#pragma unroll
                        for (int j = 0; j < 4; ++j) { const int col = 4 * lane + 256 * j;
                            u32x2 w; w.x = pk2(v[u][j].x * rn * (1.f + sc1[j].x) + sh1[j].x, v[u][j].y * rn * (1.f + sc1[j].y) + sh1[j].y); w.y = pk2(v[u][j].z * rn * (1.f + sc1[j].z) + sh1[j].z, v[u][j].w * rn * (1.f + sc1[j].w) + sh1[j].w);
                            *(u32x2*)(H + (size_t)(t0 + u) * 1024 + col) = w; } }
                }
            }
        }
        PH_END();
    }
#undef PH_ON
#undef PH_END
}

extern "C" void kernel_launch(void* const* d_in, const int* in_sizes, int n_in, void* d_out, int out_size, void* d_ws, size_t ws_size, hipStream_t stream) {
    static int grid = 0;
    if (grid == 0) {
        if (n_in != 37 || out_size != T * D || ws_size < WS_END) { fprintf(stderr, "kernel_launch: unexpected shapes (n_in %d, out %d, ws %zu); nothing launched\n", n_in, out_size, ws_size); grid = -1; return; }
        int dev = 0, cus = 0, per_cu = 0;
        if (hipGetDevice(&dev) != hipSuccess || hipDeviceGetAttribute(&cus, hipDeviceAttributeMultiprocessorCount, dev) != hipSuccess) { grid = -1; return; }
        if (hipFuncSetAttribute((const void*)fwd, hipFuncAttributeMaxDynamicSharedMemorySize, LDS_BYTES) != hipSuccess) { fprintf(stderr, "kernel_launch: hipFuncSetAttribute failed\n"); grid = -1; return; }
        if (hipOccupancyMaxActiveBlocksPerMultiprocessor(&per_cu, (const void*)fwd, NTHREADS, LDS_BYTES) != hipSuccess || per_cu < 1) fprintf(stderr, "kernel_launch: occupancy query says %d\n", per_cu);
        (void)hipGetLastError();
        grid = cus;
    }
    if (grid < 0) return;
    if (hipMemsetAsync((char*)d_ws + WS_CTL, 0, CTL_ZERO_BYTES, stream) != hipSuccess) return;
    Args a{};
    for (int i = 0; i < 37; ++i) a.in[i] = d_in[i];
    a.out = (float*)d_out; a.ws = (unsigned char*)d_ws;
#ifdef PROBE_MASK
#ifndef PROBE_VAR
#define PROBE_VAR 0
#endif
    {
        int types[N_PHASES]; int n = 0; types[n++] = 0; types[n++] = 1; types[n++] = 2;
        for (int l = 0; l < DEPTH; ++l) { if ((l & 1) == 0) { for (int k = 3; k <= 7; ++k) if (k != 4 && k != 6) types[n++] = k; } else { for (int k = 8; k <= 13; ++k) if (k != 9) types[n++] = k; } for (int k = 14; k <= 19; ++k) if (k != 16) types[n++] = k; }
        for (int p = 0; p < N_PHASES; ++p) { a.ph_lo = p; a.ph_hi = p + 1; const int reps = ((PROBE_MASK >> types[p]) & 1) ? 2 : 1;
            for (int r = 0; r < reps; ++r) { a.probe_var = (reps == 2) ? ((r == 0) ? PROBE_VAR : -PROBE_VAR) : 0; hipLaunchKernelGGL(fwd, dim3(grid), dim3(NTHREADS), LDS_BYTES, stream, a); } }
    }
#elif MK_ONE_LAUNCH
    a.ph_lo = 0; a.ph_hi = N_PHASES;
    hipLaunchKernelGGL(fwd, dim3(grid), dim3(NTHREADS), LDS_BYTES, stream, a);
#else
    for (int p = 0; p < N_PHASES; ++p) { a.ph_lo = p; a.ph_hi = p + 1; hipLaunchKernelGGL(fwd, dim3(grid), dim3(NTHREADS), LDS_BYTES, stream, a); }
#endif
}
```

```cpp
#include <hip/hip_runtime.h>
#include <cstdio>
#include <cstdint>
#include <hip/hip_bf16.h>
#include <cmath>
#ifndef MK_ONE_LAUNCH
#define MK_ONE_LAUNCH 1
#endif
namespace pg8 {
#define PG8_LAS __attribute__((address_space(3)))
typedef unsigned short bf16_t;
typedef short bf16x8 __attribute__((ext_vector_type(8)));
typedef float f32x4 __attribute__((ext_vector_type(4)));
typedef unsigned u32x4 __attribute__((ext_vector_type(4)));
constexpr int BM = 256, BK = 64, HALF = 128, HTB = HALF * BK * 2  , STAGE_BYTES = 8 * HTB, NXCD = 8, WGM = 8;

__host__ __device__ __forceinline__ int lds_byte(int r, int c) { const int st = (r >> 4) * 2 + (c >> 5), rr = r & 15, cc = c & 31, ob = rr * 64 + cc * 2; return st * 1024 + (ob ^ (((ob >> 9) & 1) << 5)); }
__host__ __device__ __forceinline__ void stage_rc(int b, int& R, int& C) { const int st = b / 1024, sb = b % 1024, swz = sb ^ (((sb >> 9) & 1) << 5); R = (st >> 1) * 16 + swz / 64; C = (st & 1) * 32 + (swz % 64) / 2; }
__host__ __device__ __forceinline__ int perm32(int rho) { const int n = rho >> 4, i = rho & 15; return 8 * (i >> 2) + 4 * n + (i & 3); }

struct Unit { int pm, pn, be; };
struct Gemm { const bf16_t* A; const bf16_t* Bt; int M, N, K; size_t bstride; };

struct StaticOrder {
    int nM, nN, nwg, G, c;
    __host__ __device__ void init(int M, int N, int G_, int c_) { nM = M / BM; nN = N / BM; nwg = nM * nN; G = G_; c = c_; }
    __host__ __device__ bool next(int i, Unit& u) const {
        const long L = (long)i * G + c; if (L >= nwg) return false;
        int wgid = (int)L; { const int q = nwg / NXCD, r = nwg % NXCD, xcd = wgid % NXCD, off = wgid / NXCD; wgid = (xcd < r ? xcd * (q + 1) : r * (q + 1) + (xcd - r) * q) + off; }
        const int nig = WGM * nN, gid = wgid / nig, fm = gid * WGM, gsz = (nM - fm) < WGM ? (nM - fm) : WGM;
        u.pm = fm + ((wgid % nig) % gsz); u.pn = (wgid % nig) / gsz; u.be = 0; return true;
    }
    __device__ __forceinline__ void a_ready(const Unit&) const {}
    __device__ __forceinline__ void done(const Unit&) const {}
};

__device__ __forceinline__ unsigned cvt_pk_bf16(float lo, float hi) { unsigned r; asm volatile("v_cvt_pk_bf16_f32 %0, %1, %2" : "=v"(r) : "v"(lo), "v"(hi)); return r; }
typedef float f32x2 __attribute__((ext_vector_type(2)));
struct NoRows { static constexpr bool GATHER = false; __device__ __forceinline__ unsigned operator()(const Unit&, int) const { return 0u; } };
template <class Epi, class Sched, bool ALIGN_EPI = false, bool SP2 = false, class Rows = NoRows>
__device__ __forceinline__ void gemm_phase(PG8_LAS unsigned char* lds, const Gemm g, const Sched& S, const Epi& E, const int tid_in, const Rows& RW = Rows()) {
    const int tid = tid_in, wid = __builtin_amdgcn_readfirstlane(tid >> 6), lane = tid & 63, wr = wid >> 2, wc = wid & 3, fr = lane & 15, fq = lane >> 4;
    const int K = g.K, nt = K / BK;
    unsigned voffA[2], voffB[2];
#pragma unroll
    for (int i = 0; i < 2; ++i) { int R, C; stage_rc(tid * 16 + i * 8192, R, C); const int Rb = Epi::PERM ? ((R & ~31) + perm32(R & 31)) : R;
        voffA[i] = (unsigned)(R * K + C) * 2u; voffB[i] = (unsigned)(Rb * K + C) * 2u; }
    const size_t kstep = (size_t)(BK * 2);
    const size_t hstep = (size_t)HALF * K * 2;
    const size_t tstep = 2 * hstep;
    const unsigned ldsw = (unsigned)wid * 1024u;
    const int aoff = lds_byte(wr * 64 + fr, fq * 8), boff = lds_byte(wc * 32 + fr, fq * 8);
#define PG8_SA(b, h) (((b) * 2 + (h)) * HTB)
#define PG8_SB(b, h) ((4 + (b) * 2 + (h)) * HTB)
#define PG8_STAGE(bufoff, gbase, voff) do { _Pragma("unroll") for (int _i = 0; _i < 2; ++_i) \
        __builtin_amdgcn_global_load_lds((const unsigned*)((const char*)(gbase) + (voff)[_i]), (PG8_LAS unsigned*)(lds + (bufoff) + ldsw + _i * 8192), 16, 0, 0); } while (0)
#define PG8_LDA(dst, b, h) do { _Pragma("unroll") for (int m = 0; m < 4; ++m) _Pragma("unroll") for (int k = 0; k < 2; ++k) dst[m][k] = *(const PG8_LAS bf16x8*)(lds + PG8_SA(b, h) + aoff + m * 2048 + k * 1024); } while (0)
#define PG8_LDB(dst, b, h) do { _Pragma("unroll") for (int n = 0; n < 2; ++n) _Pragma("unroll") for (int k = 0; k < 2; ++k) dst[n][k] = *(const PG8_LAS bf16x8*)(lds + PG8_SB(b, h) + boff + n * 2048 + k * 1024); } while (0)
#define PG8_MMA(ai, bj, At, Bt) do { __builtin_amdgcn_s_setprio(1); _Pragma("unroll") for (int m = 0; m < 4; ++m) _Pragma("unroll") for (int n = 0; n < 2; ++n) _Pragma("unroll") for (int k = 0; k < 2; ++k) \
        acc[ai][bj][m][n] = __builtin_amdgcn_mfma_f32_16x16x32_bf16(Bt[n][k], At[m][k], acc[ai][bj][m][n], 0, 0, 0); __builtin_amdgcn_s_setprio(0); } while (0)
#define PG8_WAIT_V(n) asm volatile("s_waitcnt vmcnt(" #n ")" ::: "memory")
#define PG8_WAIT_L(n) asm volatile("s_waitcnt lgkmcnt(" #n ")" ::: "memory")
#define PG8_BAR __builtin_amdgcn_s_barrier()
#define PG8_SCHED __builtin_amdgcn_sched_barrier(0)
    Unit cur, nxt; int ui = 0;
    if (!S.next(0, cur)) return;
    f32x4 acc[2][2][4][2];
#pragma unroll
    for (int a = 0; a < 2; ++a)
#pragma unroll
        for (int b = 0; b < 2; ++b)
#pragma unroll
            for (int m = 0; m < 4; ++m)
#pragma unroll
                for (int n = 0; n < 2; ++n) { float z0_ = 0.f; asm volatile("" : "+v"(z0_)); acc[a][b][m][n] = (f32x4){z0_, z0_, z0_, z0_}; }
    bf16x8 At[4][2], B0[2][2], B1[2][2];
    const char* cA = Rows::GATHER ? (const char*)g.A : (const char*)g.A + (size_t)cur.pm * tstep; const char* cB = (const char*)g.Bt + (size_t)cur.be * g.bstride + (size_t)cur.pn * tstep;
    int Rr[2], Cc[2];
#pragma unroll
    for (int i = 0; i < 2; ++i) stage_rc(tid * 16 + i * 8192, Rr[i], Cc[i]);
    unsigned voffAh[2][2], voffAn[2][2];
#pragma unroll
    for (int h = 0; h < 2; ++h)
#pragma unroll
        for (int i = 0; i < 2; ++i) { voffAh[h][i] = Rows::GATHER ? RW(cur, h * HALF + Rr[i]) + (unsigned)Cc[i] * 2u : voffA[i] + (unsigned)h * (unsigned)hstep; voffAn[h][i] = voffAh[h][i]; }
    S.a_ready(cur);
    if constexpr (SP2) {
        PG8_STAGE(PG8_SB(0, 0), cB, voffB); PG8_STAGE(PG8_SB(0, 1), cB + hstep, voffB); PG8_STAGE(PG8_SA(0, 0), cA, voffAh[0]); PG8_STAGE(PG8_SA(0, 1), cA, voffAh[1]);
        if (wr == 1) PG8_BAR;
        PG8_WAIT_V(2); PG8_BAR;
        PG8_STAGE(PG8_SB(1, 0), cB + kstep, voffB); PG8_STAGE(PG8_SA(1, 0), cA + kstep, voffAh[0]); PG8_STAGE(PG8_SB(1, 1), cB + hstep + kstep, voffB);
        PG8_WAIT_V(6); PG8_BAR;
    } else {
        PG8_STAGE(PG8_SB(0, 0), cB, voffB); PG8_STAGE(PG8_SA(0, 0), cA, voffAh[0]); PG8_STAGE(PG8_SB(0, 1), cB + hstep, voffB); PG8_STAGE(PG8_SA(0, 1), cA, voffAh[1]);
        if (wr == 1) PG8_BAR;
        PG8_WAIT_V(4); PG8_BAR;
        PG8_STAGE(PG8_SB(1, 0), cB + kstep, voffB); PG8_STAGE(PG8_SA(1, 0), cA + kstep, voffAh[0]); PG8_STAGE(PG8_SB(1, 1), cB + hstep + kstep, voffB);
        PG8_WAIT_V(6); PG8_BAR;
    }
    for (;;) {
        const bool has_next = S.next(ui + 1, nxt);
        const char* nA = Rows::GATHER ? (const char*)g.A : (has_next ? (const char*)g.A + (size_t)nxt.pm * tstep : cA);
        if constexpr (Rows::GATHER) { if (has_next) {
#pragma unroll
            for (int h = 0; h < 2; ++h)
#pragma unroll
                for (int i = 0; i < 2; ++i) voffAn[h][i] = RW(nxt, h * HALF + Rr[i]) + (unsigned)Cc[i] * 2u; } } const char* nB = has_next ? (const char*)g.Bt + (size_t)nxt.be * g.bstride + (size_t)nxt.pn * tstep : cB;
        for (int t = 0; t < nt; t += 2) {
            const bool last = (t == nt - 2); const bool gsel = Rows::GATHER && last && has_next;
            const char* a1 = cA + (size_t)(t + 1) * kstep;
            const char* a2 = last ? nA : cA + (size_t)(t + 2) * kstep; const char* b2 = last ? nB : cB + (size_t)(t + 2) * kstep;
            const char* a3 = a2 + kstep; const char* b3 = b2 + kstep;
            if (last && has_next) S.a_ready(nxt);
            if constexpr (SP2) {
            PG8_LDB(B0, 0, 0); PG8_LDB(B1, 0, 1); PG8_SCHED; PG8_LDA(At, 0, 0); PG8_STAGE(PG8_SA(1, 1), a1, voffAh[1]);
            PG8_WAIT_V(8); PG8_WAIT_L(0); PG8_BAR; PG8_MMA(0, 0, At, B0); PG8_MMA(0, 1, At, B1); PG8_BAR; PG8_SCHED;
            PG8_LDA(At, 0, 1); PG8_STAGE(PG8_SB(0, 0), b2, voffB); PG8_STAGE(PG8_SB(0, 1), b2 + hstep, voffB); PG8_STAGE(PG8_SA(0, 0), a2, (gsel ? voffAn[0] : voffAh[0]));
            PG8_WAIT_V(8); PG8_WAIT_L(0); PG8_BAR; PG8_MMA(1, 0, At, B0); PG8_MMA(1, 1, At, B1); PG8_BAR; PG8_SCHED;
            PG8_LDB(B0, 1, 0); PG8_LDB(B1, 1, 1); PG8_SCHED; PG8_LDA(At, 1, 0); PG8_STAGE(PG8_SA(0, 1), a2, (gsel ? voffAn[1] : voffAh[1]));
            PG8_WAIT_V(8); PG8_WAIT_L(0); PG8_BAR; PG8_MMA(0, 0, At, B0); PG8_MMA(0, 1, At, B1); PG8_BAR; PG8_SCHED;
            PG8_LDA(At, 1, 1); PG8_STAGE(PG8_SB(1, 0), b3, voffB); PG8_STAGE(PG8_SB(1, 1), b3 + hstep, voffB); PG8_STAGE(PG8_SA(1, 0), a3, (gsel ? voffAn[0] : voffAh[0]));
            PG8_WAIT_V(8); PG8_WAIT_L(0); PG8_BAR; PG8_MMA(1, 0, At, B0); PG8_MMA(1, 1, At, B1); PG8_BAR; PG8_SCHED;
            } else {
            PG8_LDB(B0, 0, 0); PG8_SCHED; PG8_LDA(At, 0, 0); PG8_STAGE(PG8_SA(1, 1), a1, voffAh[1]);
            PG8_WAIT_L(8); PG8_BAR; PG8_WAIT_L(0); PG8_MMA(0, 0, At, B0); PG8_BAR; PG8_SCHED;
            PG8_LDB(B1, 0, 1); PG8_STAGE(PG8_SB(0, 0), b2, voffB);
            PG8_BAR; PG8_WAIT_L(0); PG8_MMA(0, 1, At, B1); PG8_BAR;
            PG8_LDA(At, 0, 1); PG8_STAGE(PG8_SA(0, 0), a2, (gsel ? voffAn[0] : voffAh[0]));
            PG8_BAR; PG8_WAIT_L(0); PG8_MMA(1, 0, At, B0); PG8_BAR; PG8_SCHED;
            PG8_STAGE(PG8_SB(0, 1), b2 + hstep, voffB);
            PG8_WAIT_V(6); PG8_BAR; PG8_MMA(1, 1, At, B1); PG8_BAR;
            PG8_LDB(B0, 1, 0); PG8_SCHED; PG8_LDA(At, 1, 0); PG8_STAGE(PG8_SA(0, 1), a2, (gsel ? voffAn[1] : voffAh[1]));
            PG8_WAIT_L(8); PG8_BAR; PG8_WAIT_L(0); PG8_MMA(0, 0, At, B0); PG8_BAR; PG8_SCHED;
            PG8_LDB(B1, 1, 1); PG8_STAGE(PG8_SB(1, 0), b3, voffB);
            PG8_BAR; PG8_WAIT_L(0); PG8_MMA(0, 1, At, B1); PG8_BAR;
            PG8_LDA(At, 1, 1); PG8_STAGE(PG8_SA(1, 0), a3, (gsel ? voffAn[0] : voffAh[0]));
            PG8_BAR; PG8_WAIT_L(0); PG8_MMA(1, 0, At, B0); PG8_BAR; PG8_SCHED;
            PG8_STAGE(PG8_SB(1, 1), b3 + hstep, voffB);
            PG8_WAIT_V(6); PG8_BAR; PG8_MMA(1, 1, At, B1); PG8_BAR;
            }
        }
        if constexpr (ALIGN_EPI) { if (wr == 0) PG8_BAR; }
        if constexpr (!Epi::AFTER_DRAIN) { int l2_; asm volatile("v_mbcnt_lo_u32_b32 %0, -1, 0\n\tv_mbcnt_hi_u32_b32 %0, -1, %0" : "=v"(l2_)); E(acc, cur, wr, wc, l2_ & 15, l2_ >> 4); S.done(cur); }
        if (!has_next) break;
#pragma unroll
        for (int a = 0; a < 2; ++a)
#pragma unroll
            for (int b = 0; b < 2; ++b)
#pragma unroll
                for (int m = 0; m < 4; ++m)
#pragma unroll
                    for (int n = 0; n < 2; ++n) { float z0_ = 0.f; asm volatile("" : "+v"(z0_)); acc[a][b][m][n] = (f32x4){z0_, z0_, z0_, z0_}; }
        cur = nxt; cA = nA; cB = nB; ++ui;
        if constexpr (Rows::GATHER) {
#pragma unroll
            for (int h = 0; h < 2; ++h)
#pragma unroll
                for (int i = 0; i < 2; ++i) voffAh[h][i] = voffAn[h][i]; }
        if constexpr (ALIGN_EPI) { if (wr == 1) PG8_BAR; }
    }
    PG8_WAIT_V(0);
    if constexpr (!ALIGN_EPI) { if (wr == 0) PG8_BAR; }
    PG8_BAR;
    if constexpr (Epi::AFTER_DRAIN) { E.fused(acc, cur, wr, wc, fr, fq, lds, wid, lane); S.done(cur); }
#undef PG8_SA
#undef PG8_SB
#undef PG8_STAGE
#undef PG8_LDA
#undef PG8_LDB
#undef PG8_MMA
#undef PG8_WAIT_V
#undef PG8_WAIT_L
#undef PG8_BAR
#undef PG8_SCHED
}
}
namespace attn_body {
using bf16=__hip_bfloat16;
using bf16x8=__attribute__((ext_vector_type(8)))short;
using s16x4=__attribute__((ext_vector_type(4)))short;
using f32x16=__attribute__((ext_vector_type(16)))float;
using u32x4=__attribute__((ext_vector_type(4)))unsigned;
constexpr int D=64;
constexpr int NW=8,QBLK=32,QB=QBLK*NW,KVBLK=64;
constexpr int ATTN_UNIT_ROWS=QB;
__device__ __forceinline__ int crow(int r,int hi){return (r&3)+8*(r>>2)+4*hi;}
#define SBAR() __builtin_amdgcn_sched_barrier(0)
__device__ __forceinline__ void cmask(f32x16&p0,f32x16&p1,int jb,int qrel,int hi){
  const float NEG=-INFINITY; int kb=64*jb+4*hi;
  #pragma unroll
  for(int r=0;r<16;++r){int kv=kb+(r&3)+8*(r>>2); if(kv>qrel)p0[r]=NEG; if(kv+32>qrel)p1[r]=NEG;}
}

constexpr int NSLOT=3, SLOTB=8192;
constexpr int LDS_K=0, LDS_V=NSLOT*SLOTB, LDS_WS=2*NSLOT*SLOTB, LDS_OST=LDS_WS+NW*64*4, LDS_BYTES=LDS_OST+NW*4096;
constexpr float C2=0.125f*1.4426950408889634f;
__device__ __forceinline__ void glds16(const void*gsrc,unsigned lds_dst){unsigned keep;
  asm volatile("s_mov_b32 %0, m0\n\ts_mov_b32 m0, %2\n\ts_nop 0\n\tglobal_load_lds_dwordx4 %1, off\n\ts_mov_b32 m0, %0":"=&s"(keep):"v"(gsrc),"s"(lds_dst):"memory");}
__device__ __forceinline__ float max3f(float a,float b,float c){float r;asm("v_max3_f32 %0, %1, %2, %3":"=v"(r):"v"(a),"v"(b),"v"(c));return r;}
__device__ __forceinline__ float max2f(float a,float b){float r;asm("v_max_f32_e32 %0, %1, %2":"=v"(r):"v"(a),"v"(b));return r;}
__device__ __forceinline__ float fadd_s(float a,float b){float r;asm("v_add_f32_e32 %0, %1, %2":"=v"(r):"v"(a),"v"(b));return r;}
__device__ __forceinline__ float fsub_s(float a,float b){float r;asm("v_sub_f32_e32 %0, %1, %2":"=v"(r):"v"(a),"v"(b));return r;}
typedef float f32x2_t __attribute__((ext_vector_type(2))); typedef __bf16 bf16x2_t __attribute__((ext_vector_type(2)));
__device__ __forceinline__ unsigned cvtpk_s(float lo,float hi){f32x2_t v={lo,hi};bf16x2_t b=__builtin_convertvector(v,bf16x2_t);return __builtin_bit_cast(unsigned,b);}
#define WAIT_BAR(N) asm volatile("s_waitcnt vmcnt(" #N ") lgkmcnt(0)\n\ts_barrier":::"memory")

__device__ __forceinline__ void qkt(f32x16&p0,f32x16&p1,const char*Kslot,const bf16x8*qr,const f32x16&negm,int r32,int hi){
  const char*kb=Kslot+hi*1024+r32*16;
  #pragma unroll
  for(int d0=0;d0<4;++d0){
    const bf16x8 b0=*reinterpret_cast<const bf16x8*>(kb+d0*2048);
    const bf16x8 b1=*reinterpret_cast<const bf16x8*>(kb+d0*2048+512);
    if(d0==0){p0=__builtin_amdgcn_mfma_f32_32x32x16_bf16(b0,qr[0],negm,0,0,0);p1=__builtin_amdgcn_mfma_f32_32x32x16_bf16(b1,qr[0],negm,0,0,0);}
    else{p0=__builtin_amdgcn_mfma_f32_32x32x16_bf16(b0,qr[d0],p0,0,0,0);p1=__builtin_amdgcn_mfma_f32_32x32x16_bf16(b1,qr[d0],p1,0,0,0);}}
}
typedef __attribute__((address_space(3))) const char* lds_cptr;
typedef short v4i16_t __attribute__((ext_vector_type(4)));
__device__ __forceinline__ void kload8(bf16x8*kf,lds_cptr kp){
  kf[0]=*(const __attribute__((address_space(3))) bf16x8*)(kp);      kf[1]=*(const __attribute__((address_space(3))) bf16x8*)(kp+512);
  kf[2]=*(const __attribute__((address_space(3))) bf16x8*)(kp+2048); kf[3]=*(const __attribute__((address_space(3))) bf16x8*)(kp+2560);
  kf[4]=*(const __attribute__((address_space(3))) bf16x8*)(kp+4096); kf[5]=*(const __attribute__((address_space(3))) bf16x8*)(kp+4608);
  kf[6]=*(const __attribute__((address_space(3))) bf16x8*)(kp+6144); kf[7]=*(const __attribute__((address_space(3))) bf16x8*)(kp+6656);
}
__device__ __forceinline__ void kload2(bf16x8*kf,lds_cptr kp,int j){ kf[2*j]=*(const __attribute__((address_space(3))) bf16x8*)(kp+j*2048); kf[2*j+1]=*(const __attribute__((address_space(3))) bf16x8*)(kp+j*2048+512); }
__device__ __forceinline__ s16x4 vtr(lds_cptr p){ return __builtin_bit_cast(s16x4,__builtin_amdgcn_ds_read_tr16_b64_v4i16((__attribute__((address_space(3))) v4i16_t*)p)); }
__device__ __forceinline__ float rowmax(const f32x16&p0,const f32x16&p1){
  float a=max3f(p0[0],p0[1],p1[0]),b=max3f(p0[2],p0[3],p1[1]);a=max3f(a,p1[2],p1[3]);
  #pragma unroll
  for(int r=4;r<16;r+=4){a=max3f(a,p0[r],p0[r+1]);b=max3f(b,p0[r+2],p0[r+3]);a=max3f(a,p1[r],p1[r+1]);b=max3f(b,p1[r+2],p1[r+3]);}
  const float m=max2f(a,b);
  auto rr=__builtin_amdgcn_permlane32_swap(__float_as_uint(m),__float_as_uint(m),false,false);
  return max2f(__uint_as_float(rr[0]),__uint_as_float(rr[1]));
}
__device__ __forceinline__ void pv(f32x16*o,int vb,bf16x8 pa0,bf16x8 pa1,bf16x8 pa2,bf16x8 pa3){
  #pragma unroll
  for(int d0=0;d0<2;++d0){s16x4 lo[4],hi[4];
    #pragma unroll
    for(int ks=0;ks<4;++ks){
      asm volatile("ds_read_b64_tr_b16 %0,%1 offset:%c2":"=&v"(lo[ks]):"v"(vb),"i"(d0*4096+ks*1024):"memory");
      asm volatile("ds_read_b64_tr_b16 %0,%1 offset:%c2":"=&v"(hi[ks]):"v"(vb),"i"(d0*4096+ks*1024+512):"memory");}
    asm volatile("s_waitcnt lgkmcnt(0)":::"memory");SBAR();
    #define PK(k) (bf16x8){lo[k][0],lo[k][1],lo[k][2],lo[k][3],hi[k][0],hi[k][1],hi[k][2],hi[k][3]}
    o[d0]=__builtin_amdgcn_mfma_f32_32x32x16_bf16(pa0,PK(0),o[d0],0,0,0);
    o[d0]=__builtin_amdgcn_mfma_f32_32x32x16_bf16(pa1,PK(1),o[d0],0,0,0);
    o[d0]=__builtin_amdgcn_mfma_f32_32x32x16_bf16(pa2,PK(2),o[d0],0,0,0);
    o[d0]=__builtin_amdgcn_mfma_f32_32x32x16_bf16(pa3,PK(3),o[d0],0,0,0);
    #undef PK
  }
}

#ifndef ATTN_STORE16
#define ATTN_STORE16(p,v) (*(u32x4*)(p)=(v))
#endif
template<int THRL,int PIN,int POUT> __device__ __forceinline__ void attn_unit(int qb,const bf16*Qh,const bf16*__restrict__ Kh,const bf16*__restrict__ Vh,bf16*Oh,char*shm,const int wid_in){
  constexpr int DM=PIN;
  int lane; asm volatile("v_mbcnt_lo_u32_b32 %0, -1, 0\n\tv_mbcnt_hi_u32_b32 %0, -1, %0" : "=v"(lane));
  const int wid=wid_in; const int tid=wid*64+lane; const int r32=lane&31,hi=lane>>5;
  const int q0=qb*QB;
  const bf16*Qw=Qh+(long)(q0+wid*QBLK)*DM;
  const unsigned lds0=(unsigned)(uintptr_t)shm;
  float*wsf=(float*)(shm+LDS_WS)+wid*64;
  const bf16*ksrc=Kh+(long)lane*DM+wid*8;
  const bf16*vsrc=Vh+(long)(16*(wid&3)+(lane>>2))*DM+(wid>>2)*32+(lane&3)*8;
  const unsigned kdst=lds0+LDS_K+wid*1024, vdst=lds0+LDS_V+wid*1024;
  #define DMA_K(t,slot) glds16(ksrc+(long)(t)*KVBLK*DM,(unsigned)__builtin_amdgcn_readfirstlane(kdst+(slot)))
  #define DMA_V(t,slot) glds16(vsrc+(long)(t)*KVBLK*DM,(unsigned)__builtin_amdgcn_readfirstlane(vdst+(slot)))
  const int vb0=(int)(lds0+LDS_V)+((lane>>4)&1)*32+(lane&3)*8+(4*hi+((lane&15)>>2))*64;
  const char*Kbase=shm+LDS_K; bf16x8 kf[8];
  const lds_cptr shm3=(lds_cptr)shm; const lds_cptr kp0=shm3+LDS_K+hi*1024+r32*16; const lds_cptr vp0=shm3+LDS_V+((lane>>4)&1)*32+(lane&3)*8+(4*hi+((lane&15)>>2))*64;
  const int NT=(q0+QB)/KVBLK;
  DMA_K(0,0);DMA_V(0,0);DMA_K(1,SLOTB);
  bf16x8 qr[4];
  #pragma unroll
  for(int d0=0;d0<4;++d0)qr[d0]=*reinterpret_cast<const bf16x8*>(&Qw[(long)r32*DM+d0*16+hi*8]);
  float mhat=0.f,l_reg=0.f;f32x16 o[2];f32x16 negm;{float z0_=0.f;asm volatile("":"+v"(z0_));
  #pragma unroll
  for(int r=0;r<16;++r){o[0][r]=z0_;o[1][r]=z0_;negm[r]=z0_;}}asm volatile("":"+v"(negm));
  const int qrel=wid*QBLK+r32;
  #define CMASK(P0,P1,t) do{int jb_=(t)-(NT-4); if(jb_>=0)cmask(P0,P1,jb_,qrel,hi);}while(0)
  bool resc=false;
  #define START(P0,P1) do{ const float rm=rowmax(P0,P1); resc=false; \
    { const float dl=rm; mhat=fadd_s(mhat,dl); \
      _Pragma("unroll") for(int r=0;r<16;++r){P0[r]=fsub_s(P0[r],dl);P1[r]=fsub_s(P1[r],dl);} \
      _Pragma("unroll") for(int r=0;r<16;++r)negm[r]=-mhat; asm volatile("":"+v"(negm)); } \
    _Pragma("unroll") for(int r=0;r<16;++r)P0[r]=__builtin_amdgcn_exp2f(P0[r]); }while(0)
  #define RESC() do{ if(resc){ asm volatile("s_waitcnt lgkmcnt(0)":::"memory"); \
      _Pragma("unroll") for(int d_=0;d_<2;++d_) _Pragma("unroll") for(int r=0;r<16;++r)o[d_][r]*=wsf[crow(r,hi)]; } }while(0)
  f32x16 pA0,pA1,pB0,pB1;
  int sl_prev=0,sl_cur=0,sl_next=SLOTB;
  #define ROT() do{sl_prev=sl_cur;sl_cur=sl_next;sl_next=(sl_next==(NSLOT-1)*SLOTB)?0:sl_next+SLOTB;}while(0)
  DMA_K(2,2*SLOTB);
  WAIT_BAR(3);
  qkt(pA0,pA1,Kbase,qr,negm,r32,hi);asm volatile("s_nop 15\n\ts_nop 7":"+v"(pA0),"+v"(pA1));CMASK(pA0,pA1,0);
  START(pA0,pA1);
  _Pragma("unroll") for(int r=0;r<16;++r)pA1[r]=__builtin_amdgcn_exp2f(pA1[r]);
  WAIT_BAR(0);
  DMA_K(3,0);DMA_V(1,SLOTB);
  ROT();
  kload8(kf,kp0+sl_cur);
  WAIT_BAR(2);
  s16x4 vlo[8],vhi[8]; u32x4 pw0,pw1,pw2,pw3;
  #define PKW(P,B) cvtpk_s(P[B],P[B+1])
  #define PAF(k) __builtin_bit_cast(bf16x8,pw##k)
  #define VFR(i) (bf16x8){vlo[i][0],vlo[i][1],vlo[i][2],vlo[i][3],vhi[i][0],vhi[i][1],vhi[i][2],vhi[i][3]}
  #define PIN(x) asm volatile("":"+v"(x))
  #define MX3(a,b,c) __builtin_fmaxf(__builtin_fmaxf((a),(b)),(c))
  #define GAPA(MF,A0,A1,A2,A3,W0,W1,PW) do{ MF; sacc+=A0; sacc+=A1; sacc+=A2; sacc+=A3; PIN(sacc); W0; W1; PIN(PW); SBAR(); }while(0)
  #define EX(v) __builtin_amdgcn_exp2f(v)
  #define GAPB(MF,X,B) do{ MF; X[B]=EX(X[B]); X[B+1]=EX(X[B+1]); X[B+2]=EX(X[B+2]); X[B+3]=EX(X[B+3]); PIN(X); SBAR(); }while(0)
  #define VRD(i) do{ vlo[i]=vtr(vp_+(((i)>>2)*4096+((i)&3)*1024)); vhi[i]=vtr(vp_+(((i)>>2)*4096+((i)&3)*1024+512)); }while(0)
  #define KRD(G,j) do{ if(G){ kload2(kf,kp0+sl_next,j); SBAR(); } }while(0)
  #define STEP(C0,C1,P0,P1,t,GK,GV,GL) do{ SBAR(); \
    const lds_cptr vp_=vp0+sl_prev; \
    VRD(0); SBAR(); float sacc=(P0[0]+P0[1]); \
    GAPA(C0=__builtin_amdgcn_mfma_f32_32x32x16_bf16(kf[0],qr[0],negm,0,0,0), P0[2],P0[3],P0[4],P0[5],     pw0[0]=PKW(P0,0), pw0[1]=PKW(P0,2), pw0); \
    VRD(4); SBAR(); GAPA(C1=__builtin_amdgcn_mfma_f32_32x32x16_bf16(kf[1],qr[0],negm,0,0,0), P0[6],P0[7],P0[8],P0[9],     pw0[2]=PKW(P0,4), pw0[3]=PKW(P0,6), pw0); \
    VRD(1); SBAR(); GAPA(C0=__builtin_amdgcn_mfma_f32_32x32x16_bf16(kf[2],qr[1],C0,0,0,0),   P0[10],P0[11],P0[12],P0[13], pw1[0]=PKW(P0,8), pw1[1]=PKW(P0,10), pw1); \
    VRD(5); SBAR(); GAPA(C1=__builtin_amdgcn_mfma_f32_32x32x16_bf16(kf[3],qr[1],C1,0,0,0),   P0[14],P0[15],P1[0],P1[1],   pw1[2]=PKW(P0,12),pw1[3]=PKW(P0,14), pw1); \
    VRD(2); SBAR(); GAPA(C0=__builtin_amdgcn_mfma_f32_32x32x16_bf16(kf[4],qr[2],C0,0,0,0),   P1[2],P1[3],P1[4],P1[5],     pw2[0]=PKW(P1,0), pw2[1]=PKW(P1,2), pw2); \
    VRD(6); SBAR(); GAPA(C1=__builtin_amdgcn_mfma_f32_32x32x16_bf16(kf[5],qr[2],C1,0,0,0),   P1[6],P1[7],P1[8],P1[9],     pw2[2]=PKW(P1,4), pw2[3]=PKW(P1,6), pw2); \
    VRD(3); SBAR(); GAPA(C0=__builtin_amdgcn_mfma_f32_32x32x16_bf16(kf[6],qr[3],C0,0,0,0),   P1[10],P1[11],P1[12],P1[13], pw3[0]=PKW(P1,8), pw3[1]=PKW(P1,10), pw3); \
    VRD(7); SBAR(); GAPA(C1=__builtin_amdgcn_mfma_f32_32x32x16_bf16(kf[7],qr[3],C1,0,0,0),   P1[14],P1[15],0.f,0.f,       pw3[2]=PKW(P1,12),pw3[3]=PKW(P1,14), pw3); \
    l_reg+=sacc; \
    if(GK){DMA_K((t)+3,sl_cur);} if(GV){DMA_V((t)+1,sl_next);} \
    CMASK(C0,C1,t); \
    { float a=MX3(C0[0],C0[1],C1[0]),b=MX3(C0[2],C0[3],C1[1]); a=MX3(a,C1[2],C1[3]); \
      _Pragma("unroll") for(int r=4;r<16;r+=4){a=MX3(a,C0[r],C0[r+1]);b=MX3(b,C0[r+2],C0[r+3]);a=MX3(a,C1[r],C1[r+1]);b=MX3(b,C1[r+2],C1[r+3]);} \
      float rm=__builtin_fmaxf(a,b); { auto rr=__builtin_amdgcn_permlane32_swap(__float_as_uint(rm),__float_as_uint(rm),false,false); rm=__builtin_fmaxf(__uint_as_float(rr[0]),__uint_as_float(rr[1])); } \
      resc=false; \
      if(__builtin_expect(__any(rm>(float)THRL),0)){ const float dl=__builtin_fmaxf(rm,0.f); mhat+=dl; \
        _Pragma("unroll") for(int r=0;r<16;++r){C0[r]-=dl;C1[r]-=dl;} \
        _Pragma("unroll") for(int r=0;r<16;++r)negm[r]=-mhat; asm volatile("":"+v"(negm)); \
        const float f=__builtin_amdgcn_exp2f(-dl); l_reg*=f; if(hi==0)wsf[r32]=f; resc=true; } } \
    SBAR(); \
    GAPB(o[0]=__builtin_amdgcn_mfma_f32_32x32x16_bf16(PAF(0),VFR(0),o[0],0,0,0), C0,0); \
    GAPB(o[1]=__builtin_amdgcn_mfma_f32_32x32x16_bf16(PAF(0),VFR(4),o[1],0,0,0), C0,4); \
    KRD(GL,0); GAPB(o[0]=__builtin_amdgcn_mfma_f32_32x32x16_bf16(PAF(1),VFR(1),o[0],0,0,0), C0,8); \
    KRD(GL,1); GAPB(o[1]=__builtin_amdgcn_mfma_f32_32x32x16_bf16(PAF(1),VFR(5),o[1],0,0,0), C0,12); \
    KRD(GL,2); GAPB(o[0]=__builtin_amdgcn_mfma_f32_32x32x16_bf16(PAF(2),VFR(2),o[0],0,0,0), C1,0); \
    KRD(GL,3); GAPB(o[1]=__builtin_amdgcn_mfma_f32_32x32x16_bf16(PAF(2),VFR(6),o[1],0,0,0), C1,4); \
    GAPB(o[0]=__builtin_amdgcn_mfma_f32_32x32x16_bf16(PAF(3),VFR(3),o[0],0,0,0), C1,8); \
    GAPB(o[1]=__builtin_amdgcn_mfma_f32_32x32x16_bf16(PAF(3),VFR(7),o[1],0,0,0), C1,12); \
    }while(0)
  int t=1;
  #undef CMASK
  #define CMASK(P0,P1,t) do{}while(0)
  for(;t+5<NT;t+=2){
    STEP(pB0,pB1,pA0,pA1,t,true,true,true);     WAIT_BAR(2); RESC(); ROT();
    STEP(pA0,pA1,pB0,pB1,t+1,true,true,true);   WAIT_BAR(2); RESC(); ROT();
  }
  #undef CMASK
  #define CMASK(P0,P1,t) do{int jb_=(t)-(NT-4); if(jb_>=0)cmask(P0,P1,jb_,qrel,hi);}while(0)
  #define ENDW(tt) do{ if((tt)+3<NT){WAIT_BAR(2);} else if((tt)+2<NT){WAIT_BAR(1);} else {WAIT_BAR(0);} }while(0)
  for(;t+1<NT;t+=2){
    STEP(pB0,pB1,pA0,pA1,t,(t+3<NT),(t+1<NT),(t+1<NT));       ENDW(t);   RESC(); ROT();
    STEP(pA0,pA1,pB0,pB1,t+1,(t+4<NT),(t+2<NT),(t+2<NT));     ENDW(t+1); RESC(); ROT();
  }
  STEP(pB0,pB1,pA0,pA1,NT-1,false,false,false); RESC();
  { float sacc=pB0[0]+pB0[1]; _Pragma("unroll") for(int r=2;r<16;++r)sacc+=pB0[r]; _Pragma("unroll") for(int r=0;r<16;++r)sacc+=pB1[r]; l_reg+=sacc;
    pw0=(u32x4){PKW(pB0,0),PKW(pB0,2),PKW(pB0,4),PKW(pB0,6)};pw1=(u32x4){PKW(pB0,8),PKW(pB0,10),PKW(pB0,12),PKW(pB0,14)};pw2=(u32x4){PKW(pB1,0),PKW(pB1,2),PKW(pB1,4),PKW(pB1,6)};pw3=(u32x4){PKW(pB1,8),PKW(pB1,10),PKW(pB1,12),PKW(pB1,14)};
    SBAR(); pv(o,vb0+sl_cur,PAF(0),PAF(1),PAF(2),PAF(3)); }
  #undef PKW
  #undef PAF
  #undef VFR
  #undef PIN
  #undef MX3
  #undef GAPA
  #undef GAPB
  #undef EX
  #undef VRD
  #undef KRD
  #undef STEP
  #undef ENDW
  {auto rr=__builtin_amdgcn_permlane32_swap(__float_as_uint(l_reg),__float_as_uint(l_reg),false,false);l_reg=__uint_as_float(rr[0])+__uint_as_float(rr[1]);}
  if(hi==0)wsf[32+r32]=l_reg;asm volatile("s_waitcnt lgkmcnt(0)":::"memory");
  float rli[16];
  #pragma unroll
  for(int r=0;r<16;++r)rli[r]=__builtin_amdgcn_rcpf(wsf[32+crow(r,hi)]);
  bf16*Ow=Oh+(long)(q0+wid*QBLK)*POUT;
  { bf16*stg=(bf16*)(shm+LDS_OST)+wid*2048;
    #pragma unroll
    for(int r=0;r<16;++r){const int orow=crow(r,hi);
      #pragma unroll
      for(int d0=0;d0<2;++d0)stg[orow*64+d0*32+r32]=__float2bfloat16(o[d0][r]*rli[r]);}
    asm volatile("s_waitcnt lgkmcnt(0)":::"memory");
    #pragma unroll
    for(int i=0;i<4;++i){const int row=i*8+(lane>>3),ch=lane&7; const u32x4 v=*(const u32x4*)(stg+row*64+ch*8); ATTN_STORE16(Ow+(long)row*POUT+ch*8,v);} }
  asm volatile("s_waitcnt lgkmcnt(0)\n\ts_barrier":::"memory");
  #undef DMA_K
  #undef DMA_V
  #undef CMASK
  #undef START
  #undef RESC
  #undef ROT
}
constexpr int ATTN_LDS_BYTES=LDS_BYTES;
#undef SBAR
#undef WAIT_BAR
}

#define LAS __attribute__((address_space(3)))
typedef unsigned short bf16_t;
typedef float f32x4 __attribute__((ext_vector_type(4)));
typedef unsigned u32x4 __attribute__((ext_vector_type(4)));
typedef unsigned u32x2 __attribute__((ext_vector_type(2)));
typedef float f32x2 __attribute__((ext_vector_type(2)));
typedef _Float16 f16x8 __attribute__((ext_vector_type(8)));
typedef _Float16 f16x4 __attribute__((ext_vector_type(4)));

constexpr int NB = 2, S = 16384, T = NB * S, D = 1024, DEPTH = 4;
constexpr int EV_N = 3368, EV_NP = 3584, EV_ZP = 3072, OD_N = 2048;
constexpr float EPS = 1e-6f;
constexpr float LOG2E = 1.4426950408889634f;
constexpr float QSCALE = 0.125f * LOG2E;
constexpr int NWAVES = 8, NTHREADS = 512;
constexpr int LDS_BYTES = 163840;
constexpr int LDS_MISC = 131072;
constexpr int LDS_BARW = LDS_BYTES - 64;
constexpr int LDS_PTBL = LDS_BYTES - 512;

constexpr size_t MiB = 1u << 20;
constexpr size_t WS_CTL = 0, CTL_ZERO_BYTES = 1 * MiB;
constexpr size_t WS_MOD = 1 * MiB;
constexpr size_t WS_MODP = 1 * MiB + 256 * 1024;
constexpr size_t WS_ROPE = 2 * MiB;
constexpr size_t WS_S5A = 4 * MiB;
constexpr size_t WS_S5B = 4 * MiB + 64 * 1024;
constexpr size_t WS_LAM = 6 * MiB;
constexpr size_t WS_KM = 6 * MiB + 4096;
constexpr size_t WS_WRH = 6 * MiB + 512 * 1024;
constexpr size_t WS_KMH = 7 * MiB + 512 * 1024;
constexpr size_t WS_WEVIN = 8 * MiB;
constexpr size_t WS_WEVOUT = 22 * MiB;
constexpr size_t WS_WODIN = 26 * MiB;
constexpr size_t WS_WODOUT = 34 * MiB;
constexpr size_t WS_WGLU = 38 * MiB;
constexpr size_t WS_W13 = 40 * MiB;
constexpr size_t WS_W2 = 104 * MiB;
constexpr size_t WS_H = 136 * MiB;
constexpr size_t WS_O = 200 * MiB;
constexpr size_t WS_Z = 264 * MiB;
constexpr size_t WS_XG = 264 * MiB;
constexpr size_t WS_Y = 264 * MiB;
constexpr size_t WS_HID = 408 * MiB;
constexpr size_t WS_IQ = 456 * MiB;
constexpr size_t WS_YG = 456 * MiB;
constexpr size_t WS_IKW = 488 * MiB;
constexpr size_t WS_IQH = 496 * MiB;
constexpr size_t WS_IKH = 512 * MiB;
constexpr size_t WS_IW = 514 * MiB;
constexpr size_t WS_SEL = 516 * MiB;
constexpr size_t WS_YMIX = 548 * MiB;
constexpr size_t WS_LTOK = 612 * MiB;
constexpr size_t WS_TOKES = 616 * MiB;
constexpr size_t WS_TOKW = 617 * MiB;
constexpr size_t WS_TOKROW = 618 * MiB;
constexpr size_t WS_UG = 516 * MiB;
constexpr size_t WS_S5E = 496 * MiB;
constexpr size_t WS_S5HC = 488 * MiB;
constexpr size_t WS_S5KT = 620 * MiB;
constexpr size_t WS_S5WT = 624 * MiB;
constexpr size_t WS_S5A2 = 640 * MiB;
constexpr size_t WS_S5PW = 656 * MiB;
constexpr size_t WS_MLIST = 660 * MiB;
constexpr size_t WS_MPO = 724 * MiB;
constexpr size_t WS_MML = 852 * MiB;
constexpr size_t WS_MASKW = 724 * MiB;
constexpr size_t WS_NSEL = 860 * MiB;
constexpr size_t WS_XB = 862 * MiB;
constexpr size_t WS_END = 926 * MiB;
constexpr int XG_ROWS = 73728;
constexpr int CW_BAR = 4096;
constexpr int CW_MCNT = 16384;
constexpr int CW_CNT = 8192;

#define XB_TMO      128
#define XB_XCNT(j)  (256  + 64 * (j))
#define XB_XSUB(j)  (1280 + 64 * (j))
#define XB_XGEN(j)  (2304 + 64 * (j))
#define XB_TOP      3328
#define XB_TOPGEN   3392
#define XCD_BAR_WORDS 3456
#define XB_SPIN_CAP (1u << 24)

__device__ __forceinline__ unsigned xb_ld(unsigned* p)              { return __hip_atomic_load(p, __ATOMIC_RELAXED, __HIP_MEMORY_SCOPE_AGENT); }
__device__ __forceinline__ unsigned xb_add(unsigned* p, unsigned v) { return __hip_atomic_fetch_add(p, v, __ATOMIC_RELAXED, __HIP_MEMORY_SCOPE_AGENT); }
__device__ __forceinline__ unsigned xb_xcc_id() { return (unsigned)__builtin_amdgcn_s_getreg((3 << 11) | 20) & 0xFu; }
#define XB_SPIN(cond, bar) do { unsigned _sp = 0; while (cond) { __builtin_amdgcn_s_sleep(1); \
    if ((++_sp & 255u) == 0u) { if (xb_ld(&(bar)[XB_TMO])) break; if (_sp > XB_SPIN_CAP) { atomicAdd(&(bar)[XB_TMO], 1u); break; } } } } while (0)

struct XcdBarrier { unsigned* bar; unsigned x; volatile LAS unsigned* st; };

__device__ __forceinline__ XcdBarrier xcd_barrier_post(unsigned* bar, volatile LAS unsigned* st, bool leader) {
    XcdBarrier b; b.bar = bar; b.x = xb_xcc_id(); b.st = st;
    if (leader) (void)xb_add(&bar[XB_XCNT(b.x)], 1u);
    return b;
}
__device__ __forceinline__ void xcd_barrier_complete(unsigned* bar, unsigned x, unsigned& nloc, unsigned& nx) {
    const unsigned G = gridDim.x * gridDim.y * gridDim.z;
    unsigned sum, cnt, mine, sp = 0u;
    for (;;) {
        sum = 0u; cnt = 0u; mine = 0u;
#pragma unroll
        for (unsigned j = 0; j < 16; ++j) { const unsigned c = xb_ld(&bar[XB_XCNT(j)]); sum += c; cnt += (c > 0u) ? 1u : 0u; mine = (j == x) ? c : mine; }
        if (sum == G) break;
        __builtin_amdgcn_s_sleep(1);
        if ((++sp & 255u) == 0u) { if (xb_ld(&bar[XB_TMO])) break; if (sp > XB_SPIN_CAP) { atomicAdd(&bar[XB_TMO], 1u); break; } }
    }
    nloc = mine > 0u ? mine : 1u; nx = cnt > 0u ? cnt : 1u;
}
__device__ __forceinline__ void xcd_barrier(const XcdBarrier& b, bool leader) {
    asm volatile("s_waitcnt vmcnt(0)" ::: "memory");
    __syncthreads();
    if (leader) {
        unsigned* bar = b.bar;
        __builtin_amdgcn_s_waitcnt(0);
        unsigned nloc = b.st[0], nx = b.st[1];
        if (nloc == 0u) { xcd_barrier_complete(bar, b.x, nloc, nx); b.st[0] = nloc; b.st[1] = nx; }
        const unsigned old = xb_add(&bar[XB_XSUB(b.x)], 1u);
        const unsigned gen = old / nloc;
        if (old + 1u == (gen + 1u) * nloc) {
            __builtin_amdgcn_fence(__ATOMIC_RELEASE, "agent");
            asm volatile("s_waitcnt vmcnt(0)" ::: "memory");
            const unsigned og = xb_add(&bar[XB_TOP], 1u);
            const unsigned tg = og / nx;
            if (og + 1u == (tg + 1u) * nx) xb_add(&bar[XB_TOPGEN], 1u);
            else XB_SPIN(xb_ld(&bar[XB_TOPGEN]) == tg, bar);
            __builtin_amdgcn_fence(__ATOMIC_ACQUIRE, "agent");
            xb_add(&bar[XB_XGEN(b.x)], 1u);
            asm volatile("s_waitcnt vmcnt(0)" ::: "memory");
        } else {
            XB_SPIN(xb_ld(&bar[XB_XGEN(b.x)]) == gen, bar);
            __builtin_amdgcn_fence(__ATOMIC_ACQUIRE, "agent");
            asm volatile("s_waitcnt vmcnt(0)" ::: "memory");
        }
    }
    __syncthreads();
}

#define LDS_WAIT() asm volatile("s_waitcnt lgkmcnt(0)" ::: "memory")
__device__ __forceinline__ float bflo(unsigned w) { return __uint_as_float(w << 16); }
__device__ __forceinline__ float bfhi(unsigned w) { return __uint_as_float(w & 0xffff0000u); }
__device__ __forceinline__ unsigned pk2(float lo, float hi) { typedef float f32x2_ __attribute__((ext_vector_type(2))); typedef __bf16 bf16x2_ __attribute__((ext_vector_type(2))); const f32x2_ v = {lo, hi}; return __builtin_bit_cast(unsigned, __builtin_convertvector(v, bf16x2_)); }
__device__ __forceinline__ unsigned f2bf(float f) { return pk2(f, 0.f) & 0xffffu; }
__device__ __forceinline__ float shx_(float v, int m, int lane) { return __int_as_float(__builtin_amdgcn_ds_bpermute((lane ^ m) << 2, __float_as_int(v))); }
__device__ __forceinline__ unsigned shi_(unsigned v, int src) { return (unsigned)__builtin_amdgcn_ds_bpermute(src << 2, (int)v); }
#define SHX(v, m) shx_((v), (m), lane)
__device__ __forceinline__ float dpp_xor1(float v) { return __int_as_float(__builtin_amdgcn_update_dpp(0, __float_as_int(v), 0xB1, 0xF, 0xF, true)); }
__device__ __forceinline__ float dpp_xor2(float v) { return __int_as_float(__builtin_amdgcn_update_dpp(0, __float_as_int(v), 0x4E, 0xF, 0xF, true)); }
__device__ __forceinline__ float half_sum(float v) { const auto r = __builtin_amdgcn_permlane32_swap(__float_as_uint(v), __float_as_uint(v), false, false); return __uint_as_float(r[0]) + __uint_as_float(r[1]); }
__device__ __forceinline__ float half_max(float v) { const auto r = __builtin_amdgcn_permlane32_swap(__float_as_uint(v), __float_as_uint(v), false, false); return fmaxf(__uint_as_float(r[0]), __uint_as_float(r[1])); }
__device__ __forceinline__ float wave_sum_(float v, int lane) {
    v += dpp_xor1(v); v += dpp_xor2(v); v += shx_(v, 4, lane); v += shx_(v, 8, lane); v += shx_(v, 16, lane); return half_sum(v);
}

#define wave_sum(v) wave_sum_((v), lane)
__device__ __forceinline__ float wave_max_(float v, int lane) {
#pragma unroll
    for (int o = 1; o < 64; o <<= 1) v = fmaxf(v, shx_(v, o, lane));
    return v;
}
__device__ __forceinline__ bool qk_bounded(const float* gq, const float* gk, int lane) {
    const float a = wave_max_(fabsf(gq[lane]), lane), b = wave_max_(fabsf(gk[lane]), lane);
    return 64.0f * QSCALE * a * b <= 60.0f;
}
__device__ __forceinline__ void unpack8(const u32x4 w, float (&v)[8]) {
    v[0] = bflo(w.x); v[1] = bfhi(w.x); v[2] = bflo(w.y); v[3] = bfhi(w.y); v[4] = bflo(w.z); v[5] = bfhi(w.z); v[6] = bflo(w.w); v[7] = bfhi(w.w);
}
__device__ __forceinline__ u32x4 pack8(const float (&v)[8]) { u32x4 w; w.x = pk2(v[0], v[1]); w.y = pk2(v[2], v[3]); w.z = pk2(v[4], v[5]); w.w = pk2(v[6], v[7]); return w; }
__device__ __forceinline__ float gelu_tanh(float y) {
    const float z = 0.7978845608028654f * (y + 0.044715f * y * y * y);
    const float e = __builtin_amdgcn_exp2f(2.885390081777927f * z);
    const float th = 1.0f - 2.0f * __builtin_amdgcn_rcpf(e + 1.0f);
    return 0.5f * y * (1.0f + th);
}
__device__ __forceinline__ float sigmoidf_(float v) { return __builtin_amdgcn_rcpf(1.0f + __builtin_amdgcn_exp2f(-1.4426950408889634f * v)); }
__device__ __forceinline__ unsigned ordkey(float f) { const unsigned u = __float_as_uint(f); return u ^ ((unsigned)((int)u >> 31) | 0x80000000u); }

struct EpiPlain {
    static constexpr bool PERM = true, AFTER_DRAIN = false;
    bf16_t* O; int ldc;
    __device__ __forceinline__ void operator()(const pg8::f32x4 (&acc)[2][2][4][2], const pg8::Unit& u, int wr, int wc, int fr, int fq) const {
        const int row0 = u.pm * 256 + wr * 64 + fr, col0 = u.pn * 256 + wc * 32 + 8 * fq;
#pragma unroll
        for (int ai = 0; ai < 2; ++ai)
#pragma unroll
            for (int m = 0; m < 4; ++m) { bf16_t* rowp = O + (size_t)(row0 + ai * 128 + m * 16) * ldc + col0;
#pragma unroll
                for (int bj = 0; bj < 2; ++bj) { const pg8::f32x4 v0 = acc[ai][bj][m][0], v1 = acc[ai][bj][m][1];
                    u32x4 w; w.x = pk2(v0[0], v0[1]); w.y = pk2(v0[2], v0[3]); w.z = pk2(v1[0], v1[1]); w.w = pk2(v1[2], v1[3]);
                    *(u32x4*)(rowp + bj * 128) = w; } }
    }
};
__device__ __forceinline__ void epi_khead(const pg8::f32x4 (&acc)[2][2][4][2], bf16_t* Z, int ldz, int colbase, const float* gain, const float* COSH, const float* SINH, int row0, int wc, int fr, int fq) {
    const int lane = fr + 16 * fq;
    float g[2][8];
#pragma unroll
    for (int bj = 0; bj < 2; ++bj)
#pragma unroll
        for (int e = 0; e < 8; ++e) g[bj][e] = gain[bj * 32 + 8 * fq + e];
#pragma unroll
    for (int ai = 0; ai < 2; ++ai)
#pragma unroll
        for (int m = 0; m < 4; ++m) { const int row = row0 + ai * 128 + m * 16; const int pos = row & (S - 1);
            float v[2][8]; float ss = 0.f;
#pragma unroll
            for (int bj = 0; bj < 2; ++bj)
#pragma unroll
                for (int e = 0; e < 4; ++e) { v[bj][e] = acc[ai][bj][m][0][e]; v[bj][4 + e] = acc[ai][bj][m][1][e]; ss += v[bj][e] * v[bj][e] + v[bj][4 + e] * v[bj][4 + e]; }
            ss += shx_(ss, 16, lane); ss = half_sum(ss);
            const float r = rsqrtf(ss * (1.0f / 64.0f) + EPS);
#pragma unroll
            for (int bj = 0; bj < 2; ++bj)
#pragma unroll
                for (int e = 0; e < 8; ++e) v[bj][e] *= r * g[bj][e];
#pragma unroll
            for (int e = 0; e < 8; ++e) { const float oth = shx_(v[0][e], 16, lane); const float cs = COSH[pos * 8 + e], sn = SINH[pos * 8 + e];
                if (fq == 0) v[0][e] = v[0][e] * cs - oth * sn; else if (fq == 1) v[0][e] = v[0][e] * cs + oth * sn; }
            bf16_t* zp = Z + (size_t)row * ldz + colbase + wc * 64 + 8 * fq;
            *(u32x4*)zp = pack8(v[0]); *(u32x4*)(zp + 32) = pack8(v[1]); }
}
struct EpiEvenIn {
    static constexpr bool PERM = true, AFTER_DRAIN = false;
    bf16_t* Z; _Float16* IQH; _Float16* IKH; float* IW; const float* a_kn; const float* b_kn; const float* idx_kn; const float* COSH; const float* SINH; const float* COSI; const float* SINI;
    __device__ __forceinline__ void operator()(const pg8::f32x4 (&acc)[2][2][4][2], const pg8::Unit& u, int wr, int wc, int fr, int fq) const {
        const int row0 = u.pm * 256 + wr * 64 + fr; const int lane = fr + 16 * fq;
        if (u.pn == 2 || u.pn == 3) epi_khead(acc, Z, EV_ZP, 512 + (u.pn & 1) * 256, a_kn, COSH, SINH, row0, wc, fr, fq);
        else if (u.pn == 8 || u.pn == 9) epi_khead(acc, Z, EV_ZP, 2048 + (u.pn & 1) * 256, b_kn, COSH, SINH, row0, wc, fr, fq);
        else if (u.pn < 12) {
            const int col0 = u.pn * 256 + wc * 32 + 8 * fq;
#pragma unroll
            for (int ai = 0; ai < 2; ++ai)
#pragma unroll
                for (int m = 0; m < 4; ++m) { bf16_t* rowp = Z + (size_t)(row0 + ai * 128 + m * 16) * EV_ZP + col0;
#pragma unroll
                    for (int bj = 0; bj < 2; ++bj) { const pg8::f32x4 v0 = acc[ai][bj][m][0], v1 = acc[ai][bj][m][1];
                        u32x4 w; w.x = pk2(v0[0], v0[1]); w.y = pk2(v0[2], v0[3]); w.z = pk2(v1[0], v1[1]); w.w = pk2(v1[2], v1[3]);
                        *(u32x4*)(rowp + bj * 128) = w; } }
        } else if (u.pn == 12) {
#pragma unroll
            for (int ai = 0; ai < 2; ++ai)
#pragma unroll
                for (int m = 0; m < 4; ++m) { const int row = row0 + ai * 128 + m * 16; const int pos = row & (S - 1);
                    const f32x4 cs = *(const f32x4*)(COSI + pos * 4), sn = *(const f32x4*)(SINI + pos * 4);
#pragma unroll
                    for (int bj = 0; bj < 2; ++bj) { pg8::f32x4 v0 = acc[ai][bj][m][0], v1 = acc[ai][bj][m][1];
                        if (fq == 0) { const pg8::f32x4 a0 = v0, a1 = v1;
#pragma unroll
                            for (int e = 0; e < 4; ++e) { v0[e] = a0[e] * cs[e] - a1[e] * sn[e]; v1[e] = a1[e] * cs[e] + a0[e] * sn[e]; } }
                        f16x8 hq;
#pragma unroll
                        for (int e = 0; e < 4; ++e) { hq[e] = (_Float16)v0[e]; hq[4 + e] = (_Float16)v1[e]; }
                        *(f16x8*)(IQH + (size_t)row * 256 + bj * 128 + wc * 32 + 8 * fq) = hq; } }
        } else {
            if (wc == 0) {
                float g[8];
#pragma unroll
                for (int e = 0; e < 8; ++e) g[e] = idx_kn[8 * fq + e];
#pragma unroll
                for (int ai = 0; ai < 2; ++ai)
#pragma unroll
                    for (int m = 0; m < 4; ++m) { const int row = row0 + ai * 128 + m * 16; const int pos = row & (S - 1);
                        float v[8]; float ss = 0.f;
#pragma unroll
                        for (int e = 0; e < 4; ++e) { v[e] = acc[ai][0][m][0][e]; v[4 + e] = acc[ai][0][m][1][e]; ss += v[e] * v[e] + v[4 + e] * v[4 + e]; }
                        ss += shx_(ss, 16, lane); ss = half_sum(ss);
                        const float r = rsqrtf(ss * (1.0f / 32.0f) + EPS);
#pragma unroll
                        for (int e = 0; e < 8; ++e) v[e] *= r * g[e];
                        if (fq == 0) {
#pragma unroll
                            for (int e = 0; e < 4; ++e) { const float x1 = v[e], x2 = v[4 + e]; const float cs = COSI[pos * 4 + e], sn = SINI[pos * 4 + e]; v[e] = x1 * cs - x2 * sn; v[4 + e] = x2 * cs + x1 * sn; } }
                        f16x8 hk;
#pragma unroll
                        for (int e = 0; e < 8; ++e) hk[e] = (_Float16)v[e];
                        *(f16x8*)(IKH + (size_t)row * 32 + 8 * fq) = hk; }
            } else if (wc == 1 && fq == 0) {
#pragma unroll
                for (int ai = 0; ai < 2; ++ai)
#pragma unroll
                    for (int m = 0; m < 4; ++m) { float* wp = IW + (size_t)(row0 + ai * 128 + m * 16) * 8; *(pg8::f32x4*)wp = acc[ai][0][m][0]; *(pg8::f32x4*)(wp + 4) = acc[ai][0][m][1]; }
            }
        }
    }
};
struct EpiOddIn {
    static constexpr bool PERM = true, AFTER_DRAIN = false;
    bf16_t* Z; bf16_t* UG; const float* c_kn; const float* COSH; const float* SINH;
    __device__ __forceinline__ void operator()(const pg8::f32x4 (&acc)[2][2][4][2], const pg8::Unit& u, int wr, int wc, int fr, int fq) const {
        const int row0 = u.pm * 256 + wr * 64 + fr, col0 = u.pn * 256 + wc * 32 + 8 * fq;
        if (u.pn == 2 || u.pn == 3) { epi_khead(acc, Z, OD_N, 512 + (u.pn & 1) * 256, c_kn, COSH, SINH, row0, wc, fr, fq); return; }
#pragma unroll
        for (int ai = 0; ai < 2; ++ai)
#pragma unroll
            for (int m = 0; m < 4; ++m) { const size_t row = (size_t)(row0 + ai * 128 + m * 16);
#pragma unroll
                for (int bj = 0; bj < 2; ++bj) { const pg8::f32x4 v0 = acc[ai][bj][m][0], v1 = acc[ai][bj][m][1]; const int col = col0 + bj * 128;
                    u32x4 w; w.x = pk2(v0[0], v0[1]); w.y = pk2(v0[2], v0[3]); w.z = pk2(v1[0], v1[1]); w.w = pk2(v1[2], v1[3]);
                    if (u.pn < 6) *(u32x4*)(Z + row * OD_N + col) = w;
                    else { const int cu = col - 1536; *(u32x4*)(UG + ((size_t)(cu >> 4) * T + row) * 16 + (cu & 15)) = w; } } }
    }
};
__device__ __forceinline__ void load_q_normed(attn_body::bf16x8 (&qr)[4], const bf16_t* zrow, const float* gain, const float* COSH, const float* SINH, int pos, int hi, int lane) {
    float v[4][8]; float ss = 0.f;
#pragma unroll
    for (int d0 = 0; d0 < 4; ++d0) { unpack8(*(const u32x4*)(zrow + d0 * 16 + hi * 8), v[d0]);
#pragma unroll
        for (int e = 0; e < 8; ++e) ss += v[d0][e] * v[d0][e]; }
    ss = half_sum(ss);
    const float r = rsqrtf(ss * (1.0f / 64.0f) + EPS) * QSCALE;
#pragma unroll
    for (int d0 = 0; d0 < 4; ++d0)
#pragma unroll
        for (int e = 0; e < 8; ++e) v[d0][e] *= r * gain[d0 * 16 + hi * 8 + e];
#pragma unroll
    for (int e = 0; e < 8; ++e) { const float oth = shx_(v[0][e], 32, lane); const float cs = COSH[pos * 8 + e], sn = SINH[pos * 8 + e];
        v[0][e] = hi ? v[0][e] * cs + oth * sn : v[0][e] * cs - oth * sn; }
#pragma unroll
    for (int d0 = 0; d0 < 4; ++d0) qr[d0] = __builtin_bit_cast(attn_body::bf16x8, pack8(v[d0]));
}
struct EpiSwiGLU {
    static constexpr bool PERM = true, AFTER_DRAIN = false;
    bf16_t* HID;
    __device__ __forceinline__ void operator()(const pg8::f32x4 (&acc)[2][2][4][2], const pg8::Unit& u, int wr, int wc, int fr, int fq) const {
        const int row0 = u.pm * 256 + wr * 64 + fr, col0 = (u.pn * 256 + wc * 32 + 8 * fq) >> 1;
#pragma unroll
        for (int ai = 0; ai < 2; ++ai)
#pragma unroll
            for (int m = 0; m < 4; ++m) { bf16_t* rowp = HID + (size_t)(row0 + ai * 128 + m * 16) * 512 + col0;
#pragma unroll
                for (int bj = 0; bj < 2; ++bj) { const pg8::f32x4 v0 = acc[ai][bj][m][0], v1 = acc[ai][bj][m][1];
                    const float h0 = v0[0] * sigmoidf_(v0[0]) * v0[1], h1 = v0[2] * sigmoidf_(v0[2]) * v0[3];
                    const float h2 = v1[0] * sigmoidf_(v1[0]) * v1[1], h3 = v1[2] * sigmoidf_(v1[2]) * v1[3];
                    u32x2 w; w.x = pk2(h0, h1); w.y = pk2(h2, h3);
                    *(u32x2*)(rowp + bj * 64) = w; } }
    }
};
struct EpiGLU {
    static constexpr bool PERM = true, AFTER_DRAIN = false;
    bf16_t* O; const bf16_t* YG; const float* gb;
    __device__ __forceinline__ void operator()(const pg8::f32x4 (&acc)[2][2][4][2], const pg8::Unit& u, int wr, int wc, int fr, int fq) const {
        const int row0 = u.pm * 256 + wr * 64 + fr, col0 = u.pn * 256 + wc * 32 + 8 * fq;
#pragma unroll
        for (int ai = 0; ai < 2; ++ai)
#pragma unroll
            for (int bj = 0; bj < 2; ++bj) {
                const int c = col0 + bj * 128;
                u32x4 yr[4];
#pragma unroll
                for (int m = 0; m < 4; ++m) yr[m] = *(const u32x4*)(YG + (size_t)(row0 + ai * 128 + m * 16) * 512 + c);
                const pg8::f32x4 b0 = *(const pg8::f32x4*)(gb + c), b1 = *(const pg8::f32x4*)(gb + c + 4);
                __builtin_amdgcn_sched_barrier(0);
#pragma unroll
                for (int m = 0; m < 4; ++m) { const size_t row = (size_t)(row0 + ai * 128 + m * 16);
                    const pg8::f32x4 v0 = acc[ai][bj][m][0], v1 = acc[ai][bj][m][1];
                    float y[8]; unpack8(yr[m], y);
                    float o[8];
#pragma unroll
                    for (int j = 0; j < 4; ++j) { o[j] = y[j] * sigmoidf_(v0[j] + b0[j]); o[4 + j] = y[4 + j] * sigmoidf_(v1[j] + b1[j]); }
                    *(u32x4*)(O + row * 1024 + 512 + c) = pack8(o); }
                __builtin_amdgcn_sched_barrier(0);
            }
    }
};
struct MoeOrder {
    int nN, nunits, G, c; const LAS int* tile_e;
    __device__ __forceinline__ bool next(int i, pg8::Unit& u) const { const int L = i * G + c; if (L >= nunits) return false;
        int w = L; { const int q = nunits / 8, r = nunits % 8, xcd = w % 8, off = w / 8; w = (xcd < r ? xcd * (q + 1) : r * (q + 1) + (xcd - r) * q) + off; }
        u.pm = w / nN; u.pn = w % nN; u.be = tile_e[u.pm]; return true; }
    __device__ __forceinline__ void a_ready(const pg8::Unit&) const {}
    __device__ __forceinline__ void done(const pg8::Unit&) const {}
};

__device__ __forceinline__ int wt_row(int n, int row_mul, int row_add) {
    if (row_mul > 0) return n * row_mul + row_add;
    const int tile = n >> 8, w = n & 255;
    const bool ktile = (tile == 2 || tile == 3) || (row_mul == -1 && (tile == 8 || tile == 9));
    return ktile ? tile * 256 + ((w & 63) >> 5) * 128 + (w >> 6) * 32 + (w & 31) : n;
}
__device__ __forceinline__ void transpose_item(const float* W, int K, int N, bf16_t* WT, int row_mul, int row_add, LAS float* scr, int item, int nblk, int lane) {
    const int kb = item / nblk, nb = item % nblk, k0 = 64 * kb, n0 = 32 * nb;
    const int nn = n0 + (lane & 31);
    float tv[32];
#pragma unroll
    for (int i = 0; i < 32; ++i) { const int kk = 2 * i + (lane >> 5); tv[i] = (nn < N) ? W[(size_t)(k0 + kk) * N + nn] : 0.f; }
#pragma unroll
    for (int i = 0; i < 32; ++i) { const int kk = 2 * i + (lane >> 5); scr[kk * 33 + (lane & 31)] = tv[i]; }
    LDS_WAIT(); asm volatile("" ::: "memory");
    const int c = lane & 7;
#pragma unroll
    for (int j = 0; j < 4; ++j) { const int n = (lane >> 3) + 8 * j; const LAS float* s = scr + (8 * c) * 33 + n;
        u32x4 o; o.x = pk2(s[0 * 33], s[1 * 33]); o.y = pk2(s[2 * 33], s[3 * 33]); o.z = pk2(s[4 * 33], s[5 * 33]); o.w = pk2(s[6 * 33], s[7 * 33]);
        *(u32x4*)(WT + (size_t)wt_row(n0 + n, row_mul, row_add) * K + k0 + 8 * c) = o; }
    LDS_WAIT(); asm volatile("" ::: "memory");
}
__device__ __forceinline__ void norm_mod_row(const float* xrow, const float* sh, const float* sc, bf16_t* orow, int lane) {
    f32x4 v[4]; float ss = 0.f;
#pragma unroll
    for (int j = 0; j < 4; ++j) { v[j] = *(const f32x4*)(xrow + 4 * lane + 256 * j); ss += (v[j].x * v[j].x + v[j].y * v[j].y) + (v[j].z * v[j].z + v[j].w * v[j].w); }
    const float r = rsqrtf(wave_sum(ss) * (1.0f / 1024.0f) + EPS);
#pragma unroll
    for (int j = 0; j < 4; ++j) { const f32x4 a = *(const f32x4*)(sc + 4 * lane + 256 * j), b = *(const f32x4*)(sh + 4 * lane + 256 * j);
        u32x2 w; w.x = pk2(v[j].x * r * (1.f + a.x) + b.x, v[j].y * r * (1.f + a.y) + b.y); w.y = pk2(v[j].z * r * (1.f + a.z) + b.z, v[j].w * r * (1.f + a.w) + b.w);
        *(u32x2*)(orow + 4 * lane + 256 * j) = w; }
}

__device__ __forceinline__ void attn_key(const bf16_t* kp, const bf16_t* vp, const float (&q)[64], float& m, float& l, float (&o)[64]) {
    float s = 0.f;
#pragma unroll
    for (int i = 0; i < 8; ++i) { float kv[8]; unpack8(*(const u32x4*)(kp + 8 * i), kv);
#pragma unroll
        for (int j = 0; j < 8; ++j) s += q[8 * i + j] * kv[j]; }
    const float mn = fmaxf(m, s);
    const float f = __builtin_amdgcn_exp2f(m - mn), p = __builtin_amdgcn_exp2f(s - mn);
    l = l * f + p; m = mn;
#pragma unroll
    for (int i = 0; i < 8; ++i) { float vv[8]; unpack8(*(const u32x4*)(vp + 8 * i), vv);
#pragma unroll
        for (int j = 0; j < 8; ++j) o[8 * i + j] = o[8 * i + j] * f + p * vv[j]; }
}
__device__ __forceinline__ void load_q64(const bf16_t* qp, float scale, float (&q)[64]) {
#pragma unroll
    for (int i = 0; i < 8; ++i) { float t[8]; unpack8(*(const u32x4*)(qp + 8 * i), t);
#pragma unroll
        for (int j = 0; j < 8; ++j) q[8 * i + j] = t[j] * scale; }
}

struct Args { const void* in[37]; float* out; unsigned char* ws; int ph_lo, ph_hi, probe_var, pad; };
#ifndef PROBE_GEMM_REPS
#define PROBE_GEMM_REPS 1
#endif
#if PROBE_GEMM_REPS == 2
template <class Sc> struct Twice { Sc S; int n1;
    __device__ __forceinline__ bool next(int i, pg8::Unit& u) const { return i < n1 ? S.next(i, u) : S.next(i - n1, u); }
    __device__ __forceinline__ void a_ready(const pg8::Unit&) const {}
    __device__ __forceinline__ void done(const pg8::Unit&) const {} };
#define PROBE_SCHED(T) Twice<T>
#define PROBE_WRAP(T, v) Twice<T> PS_; PS_.S = v; { int n1_ = 0; pg8::Unit tu_; while (v.next(n1_, tu_)) ++n1_; PS_.n1 = n1_; }
#else
#define PROBE_SCHED(T) T
#define PROBE_WRAP(T, v) const T& PS_ = v
#endif
#ifdef PROBE_BAR2
#define PROBE_EXTRA_BAR(b) xcd_barrier(b, lsg(wid0) == 0 && lane_id_v() == 0);
#else
#define PROBE_EXTRA_BAR(b)
#endif
constexpr int N_PHASES = 3 + 2 * (8 + 10);

template <int NV, bool MASKED, bool CAUSAL, int PIN, int POUT, bool NOMAX = false>
__device__ __forceinline__ void flash_unit(LAS unsigned char* L0, const bf16_t* Qb, const bf16_t* Kb, const bf16_t* Vb, bf16_t* Ob, const unsigned* mbase, int qb, int wid, int lane, const float* qgain, const float* COSH, const float* SINH) {
    const int r32 = lane & 31, hi = lane >> 5;
    LAS unsigned char* ldsKs = L0; LAS unsigned char* ldsVs = L0 + 16384;
    LAS float* wsf = (LAS float*)(L0 + 16384 + NV * 16384 + wid * 256);
    LAS bf16_t* stg = (LAS bf16_t*)(L0 + 16384 + NV * 16384 + 2048 + wid * 4096);
    const int qrow = qb * 256 + wid * 32 + r32;
    attn_body::bf16x8 qr[4];
    load_q_normed(qr, Qb + (size_t)qrow * PIN, qgain, COSH, SINH, qrow, hi, lane);
    const int NT = 4 * (qb + 1);
    const bf16_t* kbp = Kb + (size_t)lane * PIN + wid * 8;
    const bf16_t* vbp = Vb + (size_t)(16 * (wid & 3) + (lane >> 2)) * PIN + (wid >> 2) * 32 + (lane & 3) * 8;
    const unsigned* mwp = MASKED ? mbase + (size_t)qrow * 2 + hi : nullptr;
    u32x4 kreg = *(const u32x4*)kbp, vreg[NV]; unsigned mw = 0u, mwn = 0u;
#pragma unroll
    for (int j = 0; j < NV; ++j) vreg[j] = *(const u32x4*)(vbp + j * 64);
    if (MASKED) mw = mwp[0];
    *(LAS u32x4*)(ldsKs + wid * 1024 + lane * 16) = kreg;
#pragma unroll
    for (int j = 0; j < NV; ++j) *(LAS u32x4*)(ldsVs + j * 16384 + wid * 1024 + lane * 16) = vreg[j];
    __syncthreads();
    float mhat = 0.f, lsum = 0.f;
    attn_body::f32x16 o[2 * NV], negm;
#pragma unroll
    for (int r = 0; r < 16; ++r) { negm[r] = 0.f;
#pragma unroll
        for (int j = 0; j < 2 * NV; ++j) o[j][r] = 0.f; }
    const int vb0 = (int)(unsigned)(unsigned long long)ldsVs + ((lane >> 4) & 1) * 32 + (lane & 3) * 8 + (4 * hi + ((lane & 15) >> 2)) * 64;
    for (int t = 0; t < NT; ++t) {
        const int slot = (t & 1) * 8192;
        if (t + 1 < NT) { kreg = *(const u32x4*)(kbp + (size_t)(t + 1) * 64 * PIN);
#pragma unroll
            for (int j = 0; j < NV; ++j) vreg[j] = *(const u32x4*)(vbp + (size_t)(t + 1) * 64 * PIN + j * 64);
            if (MASKED) mwn = mwp[(size_t)(t + 1) * S * 2]; }
        attn_body::f32x16 p0 = negm, p1 = negm;
        { const LAS unsigned char* kb = ldsKs + slot + hi * 1024 + r32 * 16;
#pragma unroll
          for (int d0 = 0; d0 < 4; ++d0) {
              const attn_body::bf16x8 b0 = *(const LAS attn_body::bf16x8*)(kb + d0 * 2048), b1 = *(const LAS attn_body::bf16x8*)(kb + d0 * 2048 + 512);
              p0 = __builtin_amdgcn_mfma_f32_32x32x16_bf16(b0, qr[d0], p0, 0, 0, 0);
              p1 = __builtin_amdgcn_mfma_f32_32x32x16_bf16(b1, qr[d0], p1, 0, 0, 0); } }
        if (CAUSAL) { const int jb = t - (NT - 4); if (jb >= 0) attn_body::cmask(p0, p1, jb, wid * 32 + r32, hi); }
        float rm = 0.f;
        if (!NOMAX) { rm = fmaxf(p0[0], p1[0]);
#pragma unroll
            for (int r = 1; r < 16; ++r) rm = fmaxf(rm, fmaxf(p0[r], p1[r]));
            rm = half_max(rm); }
        bool resc = false;
        if (!NOMAX && __any(rm > 8.0f)) {
            const float dl = fmaxf(rm, 0.f); mhat += dl;
#pragma unroll
            for (int r = 0; r < 16; ++r) { p0[r] -= dl; p1[r] -= dl; negm[r] = -mhat; }
            const float f = __builtin_amdgcn_exp2f(-dl); lsum *= f; if (hi == 0) wsf[r32] = f; resc = true;
        }
        const int wb = (int)mw; float ssum = 0.f;
#pragma unroll
        for (int r = 0; r < 16; ++r) {
            float e0 = __builtin_amdgcn_exp2f(p0[r]), e1 = __builtin_amdgcn_exp2f(p1[r]);
            if (MASKED) { e0 = __uint_as_float(__float_as_uint(e0) & (unsigned)__builtin_amdgcn_sbfe(wb, r, 1)); e1 = __uint_as_float(__float_as_uint(e1) & (unsigned)__builtin_amdgcn_sbfe(wb, 16 + r, 1)); }
            p0[r] = e0; p1[r] = e1; ssum += e0 + e1; }
        lsum += ssum;
        u32x4 pw0, pw1, pw2, pw3;
#pragma unroll
        for (int k = 0; k < 4; ++k) { pw0[k] = attn_body::cvtpk_s(p0[2 * k], p0[2 * k + 1]); pw1[k] = attn_body::cvtpk_s(p0[8 + 2 * k], p0[9 + 2 * k]);
            pw2[k] = attn_body::cvtpk_s(p1[2 * k], p1[2 * k + 1]); pw3[k] = attn_body::cvtpk_s(p1[8 + 2 * k], p1[9 + 2 * k]); }
        if (resc) { LDS_WAIT();
#pragma unroll
            for (int r = 0; r < 16; ++r) { const float f = wsf[attn_body::crow(r, hi)];
#pragma unroll
                for (int j = 0; j < 2 * NV; ++j) o[j][r] *= f; } }
#pragma unroll
        for (int j = 0; j < NV; ++j)
            attn_body::pv(o + 2 * j, vb0 + j * 16384 + slot, __builtin_bit_cast(attn_body::bf16x8, pw0), __builtin_bit_cast(attn_body::bf16x8, pw1), __builtin_bit_cast(attn_body::bf16x8, pw2), __builtin_bit_cast(attn_body::bf16x8, pw3));
        if (t + 1 < NT) { const int ns = ((t + 1) & 1) * 8192; *(LAS u32x4*)(ldsKs + ns + wid * 1024 + lane * 16) = kreg;
#pragma unroll
            for (int j = 0; j < NV; ++j) *(LAS u32x4*)(ldsVs + j * 16384 + ns + wid * 1024 + lane * 16) = vreg[j]; }
        mw = mwn;
        __syncthreads();
    }
    lsum += shx_(lsum, 32, lane);
    if (hi == 0) wsf[r32] = lsum;
    LDS_WAIT();
    float rl[16];
#pragma unroll
    for (int r = 0; r < 16; ++r) rl[r] = __builtin_amdgcn_rcpf(wsf[attn_body::crow(r, hi)]);
#pragma unroll
    for (int j = 0; j < NV; ++j) {
#pragma unroll
        for (int r = 0; r < 16; ++r) { const int orow = attn_body::crow(r, hi);
            stg[orow * 64 + r32] = (bf16_t)f2bf(o[2 * j][r] * rl[r]); stg[orow * 64 + 32 + r32] = (bf16_t)f2bf(o[2 * j + 1][r] * rl[r]); }
        LDS_WAIT();
#pragma unroll
        for (int q = 0; q < 4; ++q) { const int row = q * 8 + (lane >> 3), ch = lane & 7;
            *(u32x4*)(Ob + (size_t)(qb * 256 + wid * 32 + row) * POUT + j * 64 + ch * 8) = *(const LAS u32x4*)(stg + row * 64 + ch * 8); }
        LDS_WAIT();
    }
    __syncthreads();
}
template <int NV, bool MASKED, bool CAUSAL, int PIN, int POUT, bool NOMAX = false>
__device__ __forceinline__ void flash_unit_q2(LAS unsigned char* L0, const bf16_t* Qb, const bf16_t* Kb, const bf16_t* Vb, bf16_t* Ob, const unsigned* mbase, int qb, int wid, int lane, const float* qgain, const float* COSH, const float* SINH) {
    typedef __attribute__((address_space(3))) attn_body::v4i16_t* vtr_ptr;
    const int r32 = lane & 31, hi = lane >> 5;
    LAS unsigned char* ldsKs = L0; LAS unsigned char* ldsVs = L0 + 16384;
    LAS float* wsf = (LAS float*)(L0 + 16384 + NV * 16384 + wid * 512);
    LAS bf16_t* stg = (LAS bf16_t*)(L0 + 16384 + NV * 16384 + 4096 + wid * 4096);
    const int q0 = qb * 512 + wid * 64;
    attn_body::bf16x8 qr[2][4];
#pragma unroll
    for (int nq = 0; nq < 2; ++nq) load_q_normed(qr[nq], Qb + (size_t)(q0 + nq * 32 + r32) * PIN, qgain, COSH, SINH, q0 + nq * 32 + r32, hi, lane);
    const int NT = 8 * (qb + 1);
    const bf16_t* kbp = Kb + (size_t)lane * PIN + wid * 8;
    const bf16_t* vbp = Vb + (size_t)(16 * (wid & 3) + (lane >> 2)) * PIN + (wid >> 2) * 32 + (lane & 3) * 8;
    const unsigned* mwp = MASKED ? mbase + (size_t)(q0 + r32) * 2 + hi : nullptr;
    const int stoff = wid * 1024 + lane * 16;
    u32x4 kreg = *(const u32x4*)kbp, vreg[NV]; unsigned mw[2] = {0u, 0u}, mwn[2] = {0u, 0u};
#pragma unroll
    for (int j = 0; j < NV; ++j) vreg[j] = *(const u32x4*)(vbp + j * 64);
    if (MASKED) { mw[0] = mwp[0]; mw[1] = mwp[64]; }
    *(LAS u32x4*)(ldsKs + stoff) = kreg;
#pragma unroll
    for (int j = 0; j < NV; ++j) *(LAS u32x4*)(ldsVs + j * 16384 + stoff) = vreg[j];
    __syncthreads();
    float mhat[2] = {0.f, 0.f}, lsum[2] = {0.f, 0.f}; bool refmoved = false;
    attn_body::f32x16 o[2][2 * NV];
#pragma unroll
    for (int r = 0; r < 16; ++r)
#pragma unroll
        for (int j = 0; j < 2 * NV; ++j) { o[0][j][r] = 0.f; o[1][j][r] = 0.f; }
    const LAS unsigned char* kfb = ldsKs + hi * 1024 + r32 * 16;
    const LAS unsigned char* vfb = ldsVs + ((lane >> 4) & 1) * 32 + (lane & 3) * 8 + (4 * hi + ((lane & 15) >> 2)) * 64;
    for (int t = 0; t < NT; ++t) {
        const int slot = (t & 1) * 8192;
        if (t + 1 < NT) { kreg = *(const u32x4*)(kbp + (size_t)(t + 1) * 64 * PIN);
#pragma unroll
            for (int j = 0; j < NV; ++j) vreg[j] = *(const u32x4*)(vbp + (size_t)(t + 1) * 64 * PIN + j * 64);
            if (MASKED) { mwn[0] = mwp[(size_t)(t + 1) * S * 2]; mwn[1] = mwp[(size_t)(t + 1) * S * 2 + 64]; } }
#pragma unroll
        for (int kh = 0; kh < 2; ++kh) {
            attn_body::f32x16 p[2];
#pragma unroll
            for (int r = 0; r < 16; ++r) { p[0][r] = 0.f; p[1][r] = 0.f; }
#pragma unroll
            for (int d0 = 0; d0 < 4; ++d0) {
                const attn_body::bf16x8 kf = *(const LAS attn_body::bf16x8*)(kfb + slot + d0 * 2048 + kh * 512);
                p[0] = __builtin_amdgcn_mfma_f32_32x32x16_bf16(kf, qr[0][d0], p[0], 0, 0, 0);
                p[1] = __builtin_amdgcn_mfma_f32_32x32x16_bf16(kf, qr[1][d0], p[1], 0, 0, 0); }
            if (refmoved) {
#pragma unroll
                for (int nq = 0; nq < 2; ++nq)
#pragma unroll
                    for (int r = 0; r < 16; ++r) p[nq][r] -= mhat[nq]; }
            if (CAUSAL) { const int kbase = t * 64 + kh * 32;
                if (kbase + 31 > q0) {
#pragma unroll
                    for (int nq = 0; nq < 2; ++nq)
#pragma unroll
                        for (int r = 0; r < 16; ++r) if (kbase + attn_body::crow(r, hi) > q0 + nq * 32 + r32) p[nq][r] = -INFINITY; } }
            float rm[2] = {0.f, 0.f};
            if (!NOMAX)
#pragma unroll
            for (int nq = 0; nq < 2; ++nq) { float m_ = p[nq][0];
#pragma unroll
                for (int r = 1; r < 16; ++r) m_ = fmaxf(m_, p[nq][r]);
                rm[nq] = half_max(m_); }
            bool resc = false;
            if (!NOMAX && __any(fmaxf(rm[0], rm[1]) > 8.0f)) {
#pragma unroll
                for (int nq = 0; nq < 2; ++nq) { const float dl = fmaxf(rm[nq], 0.f); mhat[nq] += dl;
#pragma unroll
                    for (int r = 0; r < 16; ++r) p[nq][r] -= dl;
                    const float f = __builtin_amdgcn_exp2f(-dl); lsum[nq] *= f; if (hi == 0) wsf[nq * 32 + r32] = f; }
                resc = true; refmoved = true;
            }
            attn_body::bf16x8 pa[2][2];
#pragma unroll
            for (int nq = 0; nq < 2; ++nq) { const int wb = (int)mw[nq]; f32x2 ss2 = {0.f, 0.f};
#pragma unroll
                for (int r = 0; r < 16; ++r) { float e = __builtin_amdgcn_exp2f(p[nq][r]);
                    if (MASKED) { unsigned mk; asm("v_bfe_i32 %0, %1, %2, 1" : "=v"(mk) : "v"(wb), "n"(kh * 16 + r)); e = __uint_as_float(__float_as_uint(e) & mk); }
                    p[nq][r] = e; }
#pragma unroll
                for (int r = 0; r < 16; r += 2) ss2 += (f32x2){p[nq][r], p[nq][r + 1]};
                lsum[nq] += ss2.x + ss2.y;
                u32x4 pw0, pw1;
#pragma unroll
                for (int k = 0; k < 4; ++k) { pw0[k] = attn_body::cvtpk_s(p[nq][2 * k], p[nq][2 * k + 1]); pw1[k] = attn_body::cvtpk_s(p[nq][8 + 2 * k], p[nq][9 + 2 * k]); }
                pa[nq][0] = __builtin_bit_cast(attn_body::bf16x8, pw0); pa[nq][1] = __builtin_bit_cast(attn_body::bf16x8, pw1); }
            if (resc) { LDS_WAIT();
#pragma unroll
                for (int nq = 0; nq < 2; ++nq)
#pragma unroll
                    for (int r = 0; r < 16; ++r) { const float f = wsf[nq * 32 + attn_body::crow(r, hi)];
#pragma unroll
                        for (int j = 0; j < 2 * NV; ++j) o[nq][j][r] *= f; } }
#pragma unroll
            for (int blk = 0; blk < 2 * NV; ++blk)
#pragma unroll
                for (int k2 = 0; k2 < 2; ++k2) {
                    const LAS unsigned char* vb = vfb + (blk >> 1) * 16384 + slot + (blk & 1) * 4096 + (kh * 2 + k2) * 1024;
                    const attn_body::s16x4 lo_ = __builtin_bit_cast(attn_body::s16x4, __builtin_amdgcn_ds_read_tr16_b64_v4i16((vtr_ptr)vb)), hi_ = __builtin_bit_cast(attn_body::s16x4, __builtin_amdgcn_ds_read_tr16_b64_v4i16((vtr_ptr)(vb + 512)));
                    const attn_body::bf16x8 vf = (attn_body::bf16x8){lo_[0], lo_[1], lo_[2], lo_[3], hi_[0], hi_[1], hi_[2], hi_[3]};
                    o[0][blk] = __builtin_amdgcn_mfma_f32_32x32x16_bf16(pa[0][k2], vf, o[0][blk], 0, 0, 0);
                    o[1][blk] = __builtin_amdgcn_mfma_f32_32x32x16_bf16(pa[1][k2], vf, o[1][blk], 0, 0, 0); }
        }
        if (t + 1 < NT) { const int ns = 8192 - slot; *(LAS u32x4*)(ldsKs + ns + stoff) = kreg;
#pragma unroll
            for (int j = 0; j < NV; ++j) *(LAS u32x4*)(ldsVs + j * 16384 + ns + stoff) = vreg[j]; }
        mw[0] = mwn[0]; mw[1] = mwn[1];
        __syncthreads();
    }
#pragma unroll
    for (int nq = 0; nq < 2; ++nq) { lsum[nq] += shx_(lsum[nq], 32, lane); if (hi == 0) wsf[nq * 32 + r32] = lsum[nq]; }
    LDS_WAIT();
#pragma unroll
    for (int nq = 0; nq < 2; ++nq)
#pragma unroll
      for (int j = 0; j < NV; ++j) {
#pragma unroll
        for (int r = 0; r < 16; ++r) { const int orow = attn_body::crow(r, hi); const float rl = __builtin_amdgcn_rcpf(wsf[nq * 32 + orow]);
            stg[orow * 64 + r32] = (bf16_t)f2bf(o[nq][2 * j][r] * rl); stg[orow * 64 + 32 + r32] = (bf16_t)f2bf(o[nq][2 * j + 1][r] * rl); }
        LDS_WAIT();
#pragma unroll
        for (int q = 0; q < 4; ++q) { const int row = q * 8 + (lane >> 3), ch = lane & 7;
            *(u32x4*)(Ob + (size_t)(q0 + nq * 32 + row) * POUT + j * 64 + ch * 8) = *(const LAS u32x4*)(stg + row * 64 + ch * 8); }
        LDS_WAIT();
      }
    __syncthreads();
}
struct MoeRows {
    static constexpr bool GATHER = true;
    const LAS int* rb; const int* LTOK;
    __device__ __forceinline__ unsigned operator()(const pg8::Unit& u, int r) const { const int e = u.be; const int slot = u.pm * 256 + r - rb[e];
        const int tok = slot < rb[32 + e] ? LTOK[e * 32768 + slot] : 0; return (unsigned)tok * 2048u; }
};
__device__ __forceinline__ void moe_convert(const float* w1, const float* w3, const float* w2, bf16_t* W13, bf16_t* W2, LAS float* scr, int gw, int NGW, int lane) {
    for (int it = gw; it < 32 * 768; it += NGW) {
        const int e = it / 768; int r = it % 768;
        if (r < 256) { transpose_item(w1 + (size_t)e * 1024 * 512, 1024, 512, W13 + (size_t)e * 1024 * 1024, 2, 0, scr, r, 16, lane); continue; } r -= 256;
        if (r < 256) { transpose_item(w3 + (size_t)e * 1024 * 512, 1024, 512, W13 + (size_t)e * 1024 * 1024, 2, 1, scr, r, 16, lane); continue; } r -= 256;
        transpose_item(w2 + (size_t)e * 512 * 1024, 512, 1024, W2 + (size_t)e * 1024 * 512, 1, 0, scr, r, 32, lane);
    }
}
__device__ __forceinline__ void moe_tables(unsigned* ctl, int l, LAS int* tile_e, LAS int* rb, LAS int* nt_p, int tid) {
    if (tid < 64) {
        const int ln = tid;
        const int cnt = ln < 32 ? (int)__hip_atomic_load(ctl + CW_CNT + (l * 32 + (ln & 31)) * 64, __ATOMIC_RELAXED, __HIP_MEMORY_SCOPE_AGENT) : 0;
        const int ntile = (cnt + 255) >> 8;
        int inc = ntile;
#pragma unroll
        for (int off = 1; off < 32; off <<= 1) { const int v = (int)shi_((unsigned)inc, ln - off); if (ln >= off) inc += v; }
        if (ln < 32) { rb[ln] = (inc - ntile) * 256; rb[32 + ln] = cnt; }
        if (ln == 31) nt_p[0] = inc;
    }
    __syncthreads();
    const int nt = nt_p[0];
    for (int t = tid; t < nt; t += NTHREADS) {
        int lo = 0, hi = 31;
        while (lo < hi) { const int mid = (lo + hi + 1) >> 1; if (rb[mid] <= t * 256) lo = mid; else hi = mid - 1; }
        tile_e[t] = lo;
    }
    __syncthreads();
}

template <bool FIRST>
__device__ __forceinline__ float f_pass1(const float* __restrict__ xs_row, bf16_t* __restrict__ xb_row, const bf16_t* __restrict__ y_row, const LAS float* gate, const int kc) {
    float ss = 0.f;
#pragma unroll 1
    for (int s0 = 0; s0 < 32; s0 += 8) {
        u32x4 xr[8], yr[8]; f32x4 xa[8], xc[8];
#pragma unroll
        for (int k = 0; k < 8; ++k) { const int col = 32 * (s0 + k) + 8 * kc;
            if constexpr (FIRST) { xa[k] = *(const f32x4*)(xs_row + col); xc[k] = *(const f32x4*)(xs_row + col + 4); } else xr[k] = *(const u32x4*)(xb_row + col);
            yr[k] = *(const u32x4*)(y_row + col); }
        __builtin_amdgcn_sched_barrier(0);
#pragma unroll
        for (int k = 0; k < 8; ++k) { const int col = 32 * (s0 + k) + 8 * kc;
            f32x4 x0, x1;
            if constexpr (FIRST) { x0 = xa[k]; x1 = xc[k]; }
            else { float xv_[8]; unpack8(xr[k], xv_); x0 = (f32x4){xv_[0], xv_[1], xv_[2], xv_[3]}; x1 = (f32x4){xv_[4], xv_[5], xv_[6], xv_[7]}; }
            float yv[8]; unpack8(yr[k], yv);
            const f32x4 g0 = *(const LAS f32x4*)(gate + col), g1 = *(const LAS f32x4*)(gate + col + 4);
            float nv_[8] = {x0.x + g0.x * yv[0], x0.y + g0.y * yv[1], x0.z + g0.z * yv[2], x0.w + g0.w * yv[3], x1.x + g1.x * yv[4], x1.y + g1.y * yv[5], x1.z + g1.z * yv[6], x1.w + g1.w * yv[7]};
            const u32x4 xw = pack8(nv_); *(u32x4*)(xb_row + col) = xw;
            float rv_[8]; unpack8(xw, rv_);
#pragma unroll
            for (int e = 0; e < 8; ++e) ss += rv_[e] * rv_[e]; }
        __builtin_amdgcn_sched_barrier(0);
    }
    return ss;
}
__device__ __forceinline__ void f_pass2(const bf16_t* __restrict__ xb_row, bf16_t* __restrict__ h_row, const LAS float* modl, const bf16_t* __restrict__ wh, const bf16_t* __restrict__ wl, const float rn, const int kc, f32x4 (&acc)[3]) {
#pragma unroll 1
    for (int s0 = 0; s0 < 32; s0 += 4) {
        u32x4 xr[4]; pg8::bf16x8 bh[4][3], bl[4][3];
#pragma unroll
        for (int k = 0; k < 4; ++k) { const int col = 32 * (s0 + k) + 8 * kc; xr[k] = *(const u32x4*)(xb_row + col);
#pragma unroll
            for (int ct = 0; ct < 3; ++ct) { bh[k][ct] = *(const pg8::bf16x8*)(wh + (size_t)ct * 16 * 1024 + 32 * (s0 + k)); bl[k][ct] = *(const pg8::bf16x8*)(wl + (size_t)ct * 16 * 1024 + 32 * (s0 + k)); } }
        __builtin_amdgcn_sched_barrier(0);
#pragma unroll
        for (int k = 0; k < 4; ++k) { const int col = 32 * (s0 + k) + 8 * kc;
            f32x4 x0, x1; { float xv_[8]; unpack8(xr[k], xv_); x0 = (f32x4){xv_[0], xv_[1], xv_[2], xv_[3]}; x1 = (f32x4){xv_[4], xv_[5], xv_[6], xv_[7]}; }
            const f32x4 c0 = *(const LAS f32x4*)(modl + 2048 + col), c1 = *(const LAS f32x4*)(modl + 2048 + col + 4), s0_ = *(const LAS f32x4*)(modl + 1024 + col), s1_ = *(const LAS f32x4*)(modl + 1024 + col + 4);
            float hv[8];
            hv[0] = x0.x * rn * (1.f + c0.x) + s0_.x; hv[1] = x0.y * rn * (1.f + c0.y) + s0_.y; hv[2] = x0.z * rn * (1.f + c0.z) + s0_.z; hv[3] = x0.w * rn * (1.f + c0.w) + s0_.w;
            hv[4] = x1.x * rn * (1.f + c1.x) + s1_.x; hv[5] = x1.y * rn * (1.f + c1.y) + s1_.y; hv[6] = x1.z * rn * (1.f + c1.z) + s1_.z; hv[7] = x1.w * rn * (1.f + c1.w) + s1_.w;
            const u32x4 hh = pack8(hv);
            *(u32x4*)(h_row + col) = hh;
            float hl[8]; { float hf[8]; unpack8(hh, hf);
#pragma unroll
                for (int e = 0; e < 8; ++e) hl[e] = hv[e] - hf[e]; }
            const u32x4 hlw = pack8(hl);
            const pg8::bf16x8 ah = __builtin_bit_cast(pg8::bf16x8, hh), al = __builtin_bit_cast(pg8::bf16x8, hlw);
#pragma unroll
            for (int ct = 0; ct < 3; ++ct) {
                acc[ct] = __builtin_amdgcn_mfma_f32_16x16x32_bf16(ah, bh[k][ct], acc[ct], 0, 0, 0);
                acc[ct] = __builtin_amdgcn_mfma_f32_16x16x32_bf16(ah, bl[k][ct], acc[ct], 0, 0, 0);
                acc[ct] = __builtin_amdgcn_mfma_f32_16x16x32_bf16(al, bh[k][ct], acc[ct], 0, 0, 0);
            } }
        __builtin_amdgcn_sched_barrier(0);
    }
}

__device__ __forceinline__ float relu_i(float x) { return __builtin_bit_cast(float, max(__builtin_bit_cast(int, x), 0)); }
__device__ __forceinline__ unsigned pk_gt_u16(unsigned a, unsigned b, unsigned ones) { unsigned d; asm("v_pk_sub_u16 %0, %1, %2 clamp" : "=v"(d) : "v"(a), "v"(b)); unsigned r; asm("v_pk_min_u16 %0, %1, %2" : "=v"(r) : "v"(d), "v"(ones)); return r; }
__device__ __forceinline__ unsigned spread16(unsigned x) { x = (x | (x << 8)) & 0x00FF00FFu; x = (x | (x << 4)) & 0x0F0F0F0Fu; x = (x | (x << 2)) & 0x33333333u; x = (x | (x << 1)) & 0x55555555u; return x; }
__device__ __forceinline__ unsigned ilv16(unsigned a) { return spread16(a & 0xFFFFu) | (spread16(a >> 16) << 1); }
__device__ __forceinline__ int lane_id_v() { int v; asm volatile("v_mbcnt_lo_u32_b32 %0, -1, 0\n\tv_mbcnt_hi_u32_b32 %0, -1, %0" : "=v"(v)); return v; }
__device__ __forceinline__ unsigned long long lsg64(unsigned long long v) { asm volatile("" : "+s"(v)); return v; }
__device__ __forceinline__ int lsg(int v) { asm volatile("" : "+s"(v)); return v; }
__device__ __forceinline__ int lvg(int v) { asm volatile("" : "+v"(v)); return v; }
__device__ __forceinline__ LAS unsigned char* lsgp(LAS unsigned char* p) { unsigned v = (unsigned)(unsigned long long)p; asm volatile("" : "+s"(v)); return (LAS unsigned char*)(unsigned long long)v; }
__device__ __forceinline__ void* ldptr(const LAS unsigned long long* tbl, int k) {
    const unsigned long long v = tbl[k];
    const unsigned lo = __builtin_amdgcn_readfirstlane((unsigned)v), hi = __builtin_amdgcn_readfirstlane((unsigned)(v >> 32));
    return (void*)(__attribute__((address_space(1))) void*)(((unsigned long long)hi << 32) | lo);
}
#define DECL_PTRS() \
    const int wid = lsg(wid0), lane = lane_id_v(), tid = wid * 64 + lane; \
    const int G = lsg(G0), c = lsg(c0), l = lsg(l0), i = l >> 1; \
    const int gw = c * NWAVES + wid, NGW = G * NWAVES, gt = c * NTHREADS + tid, NGT = G * NTHREADS; \
    LAS unsigned char* lds = (LAS unsigned char*)lsgp(lds0); LAS unsigned char* glds = lds; LAS float* scr = (LAS float*)(lds + wid * 16384); \
    const LAS unsigned long long* ptbl = (const LAS unsigned long long*)(lds + LDS_PTBL); \
    unsigned char* ws = (unsigned char*)ldptr(ptbl, 38); unsigned* ctl = (unsigned*)(ws + WS_CTL); \
    const float* xin = (const float*)ldptr(ptbl, 0); \
    const float* cin = (const float*)ldptr(ptbl, 1); \
    const float* ada_w = (const float*)ldptr(ptbl, 2); \
    const float* ada_b = (const float*)ldptr(ptbl, 3); \
    const float* moe_wg = (const float*)ldptr(ptbl, 4); \
    const float* moe_bg = (const float*)ldptr(ptbl, 5); \
    const float* moe_we = (const float*)ldptr(ptbl, 6); \
    const float* moe_be = (const float*)ldptr(ptbl, 7); \
    const float* moe_w1 = (const float*)ldptr(ptbl, 8); \
    const float* moe_w3 = (const float*)ldptr(ptbl, 9); \
    const float* moe_w2 = (const float*)ldptr(ptbl, 10); \
    const float* ev_w_in = (const float*)ldptr(ptbl, 11); \
    const float* ev_w_out = (const float*)ldptr(ptbl, 12); \
    const float* a_qn = (const float*)ldptr(ptbl, 13); \
    const float* a_kn = (const float*)ldptr(ptbl, 14); \
    const float* a_lq1 = (const float*)ldptr(ptbl, 15); \
    const float* a_lk1 = (const float*)ldptr(ptbl, 16); \
    const float* a_lq2 = (const float*)ldptr(ptbl, 17); \
    const float* a_lk2 = (const float*)ldptr(ptbl, 18); \
    const float* a_subln = (const float*)ldptr(ptbl, 19); \
    const float* b_qn = (const float*)ldptr(ptbl, 20); \
    const float* b_kn = (const float*)ldptr(ptbl, 21); \
    const float* b_idx_kn = (const float*)ldptr(ptbl, 22); \
    const float* od_w_in = (const float*)ldptr(ptbl, 23); \
    const float* od_w_out = (const float*)ldptr(ptbl, 24); \
    const float* c_qn = (const float*)ldptr(ptbl, 25); \
    const float* c_kn = (const float*)ldptr(ptbl, 26); \
    const float* s5_lam_re = (const float*)ldptr(ptbl, 27); \
    const float* s5_lam_im = (const float*)ldptr(ptbl, 28); \
    const float* s5_b_re = (const float*)ldptr(ptbl, 29); \
    const float* s5_b_im = (const float*)ldptr(ptbl, 30); \
    const float* s5_c_re = (const float*)ldptr(ptbl, 31); \
    const float* s5_c_im = (const float*)ldptr(ptbl, 32); \
    const float* s5_d = (const float*)ldptr(ptbl, 33); \
    const float* s5_log_dt = (const float*)ldptr(ptbl, 34); \
    const float* s5_glu_w = (const float*)ldptr(ptbl, 35); \
    const float* s5_glu_b = (const float*)ldptr(ptbl, 36); \
    float* out = (float*)ldptr(ptbl, 37); \
    float* MOD = (float*)(ws + WS_MOD); \
    float* MODP = (float*)(ws + WS_MODP); \
    float* COSH = (float*)(ws + WS_ROPE); \
    float* SINH = COSH + S * 8; \
    float* COSI = SINH + S * 8; \
    float* SINI = COSI + S * 4; \
    float* S5A = (float*)(ws + WS_S5A); \
    float* S5B = (float*)(ws + WS_S5B); \
    float* LAM = (float*)(ws + WS_LAM); \
    float* KM = (float*)(ws + WS_KM); \
    bf16_t* KMH = (bf16_t*)(ws + WS_KMH); \
    bf16_t* WRH = (bf16_t*)(ws + WS_WRH); \
    bf16_t* WRL = (bf16_t*)(ws + WS_WRH + 393216); \
    bf16_t* KML = (bf16_t*)(ws + WS_KMH + 131072); \
    bf16_t* Wevin = (bf16_t*)(ws + WS_WEVIN); \
    bf16_t* Wevout = (bf16_t*)(ws + WS_WEVOUT); \
    bf16_t* Wodin = (bf16_t*)(ws + WS_WODIN); \
    bf16_t* Wodout = (bf16_t*)(ws + WS_WODOUT); \
    bf16_t* Wglu = (bf16_t*)(ws + WS_WGLU); \
    bf16_t* W13 = (bf16_t*)(ws + WS_W13); \
    bf16_t* W2 = (bf16_t*)(ws + WS_W2); \
    bf16_t* H = (bf16_t*)(ws + WS_H); \
    bf16_t* O = (bf16_t*)(ws + WS_O); \
    bf16_t* Z = (bf16_t*)(ws + WS_Z); \
    bf16_t* XG = (bf16_t*)(ws + WS_XG); \
    bf16_t* Y = (bf16_t*)(ws + WS_Y); \
    bf16_t* HID = (bf16_t*)(ws + WS_HID); \
    float* IQ = (float*)(ws + WS_IQ); \
    bf16_t* YG = (bf16_t*)(ws + WS_YG); \
    float* IKW = (float*)(ws + WS_IKW); \
    _Float16* IQH = (_Float16*)(ws + WS_IQH); \
    _Float16* IKH = (_Float16*)(ws + WS_IKH); \
    float* IW = (float*)(ws + WS_IW); \
    int* SEL = (int*)(ws + WS_SEL); \
    bf16_t* YMIX = (bf16_t*)(ws + WS_YMIX); \
    int* TOKES = (int*)(ws + WS_TOKES); \
    int* LTOK = (int*)(ws + WS_LTOK); \
    float* TOKW = (float*)(ws + WS_TOKW); \
    int* TOKROW = (int*)(ws + WS_TOKROW); \
    bf16_t* UG = (bf16_t*)(ws + WS_UG); \
    float* S5E = (float*)(ws + WS_S5E); \
    bf16_t* S5HC = (bf16_t*)(ws + WS_S5HC); \
    bf16_t* S5KT = (bf16_t*)(ws + WS_S5KT); \
    bf16_t* S5WT = (bf16_t*)(ws + WS_S5WT); \
    bf16_t* S5A2 = (bf16_t*)(ws + WS_S5A2); \
    float* S5PW = (float*)(ws + WS_S5PW); \
    int* MLIST = (int*)(ws + WS_MLIST); \
    bf16_t* MPO = (bf16_t*)(ws + WS_MPO); \
    float* MML = (float*)(ws + WS_MML); \
    int* NSEL = (int*)(ws + WS_NSEL); \
    unsigned* MASKW = (unsigned*)(ws + WS_MASKW); \
    bf16_t* XB = (bf16_t*)(ws + WS_XB);
__global__ void __launch_bounds__(NTHREADS, 2) fwd(Args a) {
    extern __shared__ __attribute__((aligned(16))) unsigned char lds_raw[];
    LAS unsigned char* lds = (LAS unsigned char*)lds_raw;
    const int tid0 = threadIdx.x; const int wid0 = __builtin_amdgcn_readfirstlane(tid0 >> 6);
    const int G0 = gridDim.x, c0 = blockIdx.x;
    unsigned* ctl0 = (unsigned*)(a.ws + WS_CTL);
    LAS unsigned char* lds0 = lds;
    const int lo = a.ph_lo, hi = a.ph_hi;

    LAS unsigned long long* ptbl = (LAS unsigned long long*)(lds + LDS_PTBL);
    if (tid0 == 0) {
#define PT_(k) ptbl[k] = (unsigned long long)a.in[k];
        PT_(0) PT_(1) PT_(2) PT_(3) PT_(4) PT_(5) PT_(6) PT_(7) PT_(8) PT_(9) PT_(10) PT_(11) PT_(12) PT_(13) PT_(14) PT_(15) PT_(16) PT_(17) PT_(18)
        PT_(19) PT_(20) PT_(21) PT_(22) PT_(23) PT_(24) PT_(25) PT_(26) PT_(27) PT_(28) PT_(29) PT_(30) PT_(31) PT_(32) PT_(33) PT_(34) PT_(35) PT_(36)
#undef PT_
        ptbl[37] = (unsigned long long)a.out; ptbl[38] = (unsigned long long)a.ws;
    }
    if (tid0 < 4) ((LAS unsigned*)(lds + LDS_BARW))[tid0] = 0u;
    __syncthreads();
    XcdBarrier bar; bar.bar = ctl0 + CW_BAR; bar.x = 0; bar.st = (volatile LAS unsigned*)(lds + LDS_BARW);
    if (hi - lo > 1) bar = xcd_barrier_post(ctl0 + CW_BAR, (volatile LAS unsigned*)(lds + LDS_BARW), tid0 == 0);
    int ph = 0, l0 = 0;
#define PH_ON() (ph >= lo && ph < hi)
#define PH_END() do { if (ph >= lo && ph + 1 < hi) { XcdBarrier bb_; bb_.bar = (unsigned*)lsg64((unsigned long long)bar.bar); bb_.x = bar.x; bb_.st = bar.st; xcd_barrier(bb_, lsg(wid0) == 0 && lane_id_v() == 0); PROBE_EXTRA_BAR(bb_) } ++ph; } while (0)

    if (PH_ON()) { DECL_PTRS();
        {
            constexpr int I_EVIN = 16 * 112, I_SQ = 16 * 32, I_ODIN = 16 * 64, I_GLU = 8 * 16;
            constexpr int I_PER = I_EVIN + I_SQ + I_ODIN + I_SQ + I_GLU;
            for (int it = gw; it < 2 * I_PER; it += NGW) {
                const int i = it / I_PER; int r = it % I_PER;
                if (r < I_EVIN) { transpose_item(ev_w_in + (size_t)i * 1024 * EV_N, 1024, EV_N, Wevin + (size_t)i * EV_NP * 1024, -1, 0, scr, r, 112, lane); continue; } r -= I_EVIN;
                if (r < I_SQ) { transpose_item(ev_w_out + (size_t)i * 1024 * 1024, 1024, 1024, Wevout + (size_t)i * 1024 * 1024, 1, 0, scr, r, 32, lane); continue; } r -= I_SQ;
                if (r < I_ODIN) { transpose_item(od_w_in + (size_t)i * 1024 * 2048, 1024, 2048, Wodin + (size_t)i * 2048 * 1024, -2, 0, scr, r, 64, lane); continue; } r -= I_ODIN;
                if (r < I_SQ) { transpose_item(od_w_out + (size_t)i * 1024 * 1024, 1024, 1024, Wodout + (size_t)i * 1024 * 1024, 1, 0, scr, r, 32, lane); continue; } r -= I_SQ;
                transpose_item(s5_glu_w + (size_t)i * 512 * 512, 512, 512, Wglu + (size_t)i * 512 * 512, 1, 0, scr, r, 16, lane);
            }
        }
        __syncthreads();
        {
            LAS float* cact = (LAS float*)lds;
            for (int i = tid; i < 2048; i += NTHREADS) { const float v = cin[i]; cact[i] = v / (1.0f + __expf(-v)); }
            __syncthreads();
            for (int idx = gt; idx < 4 * 4 * 6144; idx += NGT) {
                const int kq = idx / 24576, rem = idx % 24576, l = rem / 6144, n = rem % 6144;
                const float* w = ada_w + ((size_t)l * 1024 + kq * 256) * 6144 + n;
                float a0 = 0.f, a1 = 0.f;
#pragma unroll 32
                for (int k = 0; k < 256; ++k) { const float wv = w[(size_t)k * 6144]; a0 += cact[kq * 256 + k] * wv; a1 += cact[1024 + kq * 256 + k] * wv; }
                MODP[((size_t)(kq * 4 + l) * 2 + 0) * 6144 + n] = a0;
                MODP[((size_t)(kq * 4 + l) * 2 + 1) * 6144 + n] = a1;
            }
            __syncthreads();
        }
        for (int idx = gt; idx < S * 12; idx += NGT) {
            if (idx < S * 8) { const int pos = idx >> 3, j = idx & 7; const float inv = (float)pow(500000.0, -(double)(2 * j) / 16.0); const float ang = (float)pos * inv;
                COSH[idx] = (float)cos((double)ang); SINH[idx] = (float)sin((double)ang); }
            else { const int k = idx - S * 8; const int pos = k >> 2, j = k & 3; const float inv = (float)pow(500000.0, -(double)(2 * j) / 8.0); const float ang = (float)pos * inv;
                COSI[k] = (float)cos((double)ang); SINI[k] = (float)sin((double)ang); }
        }
        for (int idx = gt; idx < 2 * 32 * 64; idx += NGT) {
            const int i = idx >> 11, g = (idx >> 6) & 31;
            const float dt = expf(s5_log_dt[i * 32 + g]);
            const float lr = s5_lam_re[idx], li = s5_lam_im[idx];
            const float mag = expf(lr * dt);
            const float ar = mag * (float)cos((double)(li * dt)), ai = mag * (float)sin((double)(li * dt));
            const float den = lr * lr + li * li;
            const float cr = ((ar - 1.0f) * lr + ai * li) / den, ci = (ai * lr - (ar - 1.0f) * li) / den;
            S5A[idx * 2] = ar; S5A[idx * 2 + 1] = ai;
            { float pr = 1.f, pi_ = 0.f; for (int n = 0; n <= 64; ++n) { S5PW[((size_t)idx * 65 + n) * 2] = pr; S5PW[((size_t)idx * 65 + n) * 2 + 1] = pi_; const float nr = pr * ar - pi_ * ai, ni = pr * ai + pi_ * ar; pr = nr; pi_ = ni; } }
            { float brv[16], biv[16];
#pragma unroll
              for (int cc = 0; cc < 16; ++cc) { brv[cc] = s5_b_re[(size_t)idx * 16 + cc]; biv[cc] = s5_b_im[(size_t)idx * 16 + cc]; }
              __builtin_amdgcn_sched_barrier(0);
#pragma unroll
              for (int cc = 0; cc < 16; ++cc) { const float br = brv[cc], bi = biv[cc];
                  *(f32x2*)(S5B + ((size_t)idx * 16 + cc) * 2) = (f32x2){cr * br - ci * bi, cr * bi + ci * br}; } }
        }
        for (int idx = gt; idx < DEPTH * 48 * 1024; idx += NGT) {
            const int k = idx & 1023, col = (idx >> 10) % 48, ll = idx / (48 * 1024);
            const float w = col < 4 ? moe_wg[((size_t)ll * 1024 + k) * 4 + col] : col < 36 ? moe_we[((size_t)ll * 1024 + k) * 32 + col - 4] : 0.f;
            const unsigned hb = f2bf(w); WRH[idx] = (bf16_t)hb; WRL[idx] = (bf16_t)f2bf(w - __uint_as_float(hb << 16));
        }
        if (gw < 2) { const int i = gw;
            const float s1 = wave_sum(a_lq1[i * 64 + lane] * a_lk1[i * 64 + lane]), s2 = wave_sum(a_lq2[i * 64 + lane] * a_lk2[i * 64 + lane]);
            const float lam_init = 0.8f - 0.6f * expf(-0.3f * (float)(2 * i));
            if (lane == 0) LAM[i] = expf(s1) - expf(s2) + lam_init; }
    }
    PH_END();
    if (PH_ON()) { DECL_PTRS();
        for (int idx = gt; idx < 4 * 2 * 6144; idx += NGT) {
            const int l = idx / 12288, b = (idx / 6144) & 1, n = idx % 6144;
            float v = ada_b[l * 6144 + n];
#pragma unroll
            for (int kq = 0; kq < 4; ++kq) v += MODP[((size_t)(kq * 4 + l) * 2 + b) * 6144 + n];
            MOD[idx] = v;
        }
        for (int idx = gt; idx < 2 * 32 * 65 * 256; idx += NGT) {
            const int ci = idx & 15, co = (idx >> 4) & 15, tr = (idx >> 8) % 65, ig = idx / (65 * 256);
            float acc = 0.f;
            if (tr > 0) {
                const int tau = tr - 1;
#pragma unroll 16
                for (int p = 0; p < 64; ++p) { const int sp = ig * 64 + p;
                    const float cr = s5_c_re[((size_t)ig * 16 + co) * 64 + p], cim_ = s5_c_im[((size_t)ig * 16 + co) * 64 + p];
                    const f32x2 pw_ = *(const f32x2*)(S5PW + ((size_t)sp * 65 + tau) * 2), bb_ = *(const f32x2*)(S5B + ((size_t)sp * 16 + ci) * 2);
                    const float pr = pw_.x, pi_ = pw_.y, br = bb_.x, bi = bb_.y;
                    const float xr = cr * pr - cim_ * pi_, xi = cr * pi_ + cim_ * pr;
                    acc += xr * br - xi * bi; }
            }
            S5KT[((size_t)ig * 65 + tr) * 384 + co * 24 + ci] = (bf16_t)f2bf(acc);
        }
        constexpr int NW_ = 2 * 32 * 128 * 1024;
        for (int idx0 = gt; idx0 < NW_; idx0 += NGT * 8) {
            f32x2 pw_[8], bb_[8];
#pragma unroll
            for (int u = 0; u < 8; ++u) { const int idx = min(idx0 + u * NGT, NW_ - 1);
                const int k = idx & 1023, row = (idx >> 10) & 127, ig = idx >> 17; const int s = k >> 4, ci = k & 15, p = row >> 1; const int sp = ig * 64 + p;
                pw_[u] = *(const f32x2*)(S5PW + ((size_t)sp * 65 + (63 - s)) * 2); bb_[u] = *(const f32x2*)(S5B + ((size_t)sp * 16 + ci) * 2); }
            __builtin_amdgcn_sched_barrier(0);
#pragma unroll
            for (int u = 0; u < 8; ++u) { const int idx = idx0 + u * NGT;
                if (idx < NW_) { const int ri = (idx >> 10) & 1; const float pr = pw_[u].x, pi_ = pw_[u].y, br = bb_[u].x, bi = bb_[u].y;
                    S5WT[idx] = (bf16_t)f2bf(ri ? (pr * bi + pi_ * br) : (pr * br - pi_ * bi)); } }
            __builtin_amdgcn_sched_barrier(0);
        }
        for (int idx0 = gt; idx0 < NW_; idx0 += NGT * 8) {
            f32x2 pw_[8]; float crv[8], civ[8];
#pragma unroll
            for (int u = 0; u < 8; ++u) { const int idx = min(idx0 + u * NGT, NW_ - 1);
                const int k = idx & 127, rowt = (idx >> 7) & 1023, ig = idx >> 17; const int t = rowt >> 4, co = rowt & 15, p = k >> 1; const int sp = ig * 64 + p;
                crv[u] = s5_c_re[((size_t)ig * 16 + co) * 64 + p]; civ[u] = s5_c_im[((size_t)ig * 16 + co) * 64 + p];
                pw_[u] = *(const f32x2*)(S5PW + ((size_t)sp * 65 + t + 1) * 2); }
            __builtin_amdgcn_sched_barrier(0);
#pragma unroll
            for (int u = 0; u < 8; ++u) { const int idx = idx0 + u * NGT;
                if (idx < NW_) { const int ri = idx & 1; const float cr = crv[u], cim_ = civ[u], pr = pw_[u].x, pi_ = pw_[u].y;
                    S5A2[idx] = (bf16_t)f2bf(ri ? -(cr * pi_ + cim_ * pr) : (cr * pr - cim_ * pi_)); } }
            __builtin_amdgcn_sched_barrier(0);
        }
    }
    PH_END();
    if (PH_ON()) { DECL_PTRS();
        for (int t0 = gw * 4; t0 < T; t0 += NGW * 4) {
            const int b = t0 / S; const float* mo = MOD + (size_t)(0 * 2 + b) * 6144;
            f32x4 v[4][4], sc1[4], sh1[4];
#pragma unroll
            for (int u = 0; u < 4; ++u)
#pragma unroll
                for (int j = 0; j < 4; ++j) v[u][j] = *(const f32x4*)(xin + (size_t)(t0 + u) * 1024 + 4 * lane + 256 * j);
#pragma unroll
            for (int j = 0; j < 4; ++j) { sc1[j] = *(const f32x4*)(mo + 1024 + 4 * lane + 256 * j); sh1[j] = *(const f32x4*)(mo + 4 * lane + 256 * j); }
            __builtin_amdgcn_sched_barrier(0);
#pragma unroll
            for (int u = 0; u < 4; ++u) { float ss = 0.f;
#pragma unroll
                for (int j = 0; j < 4; ++j) ss += (v[u][j].x * v[u][j].x + v[u][j].y * v[u][j].y) + (v[u][j].z * v[u][j].z + v[u][j].w * v[u][j].w);
                const float rn = rsqrtf(wave_sum(ss) * (1.0f / 1024.0f) + EPS);
#pragma unroll
                for (int j = 0; j < 4; ++j) { const int col = 4 * lane + 256 * j;
                    u32x2 w; w.x = pk2(v[u][j].x * rn * (1.f + sc1[j].x) + sh1[j].x, v[u][j].y * rn * (1.f + sc1[j].y) + sh1[j].y); w.y = pk2(v[u][j].z * rn * (1.f + sc1[j].z) + sh1[j].z, v[u][j].w * rn * (1.f + sc1[j].w) + sh1[j].w);
                    *(u32x2*)(H + (size_t)(t0 + u) * 1024 + col) = w; } }
            __builtin_amdgcn_sched_barrier(0);
        }
    }
    PH_END();

    for (l0 = 0; l0 < DEPTH; ++l0) {
        if ((l0 & 1) == 0) {
            if (PH_ON()) { DECL_PTRS();
                pg8::Gemm g{H, Wevin + (size_t)i * EV_NP * 1024, T, EV_NP, 1024, 0}; pg8::StaticOrder So; So.init(T, EV_NP, G, c);
                EpiEvenIn E{Z, IQH, IKH, IW, a_kn + i * 64, b_kn + i * 64, b_idx_kn + i * 32, COSH, SINH, COSI, SINI};
                { PROBE_WRAP(pg8::StaticOrder, So); pg8::gemm_phase<EpiEvenIn, PROBE_SCHED(pg8::StaticOrder), true, true>(glds, g, PS_, E, tid); }
            }
            PH_END();
            if (PH_ON()) { DECL_PTRS();
                moe_convert(moe_w1 + (size_t)l * 32 * 1024 * 512, moe_w3 + (size_t)l * 32 * 1024 * 512, moe_w2 + (size_t)l * 32 * 512 * 1024, W13, W2, scr, gw, NGW, lane);
                __syncthreads();
                {
                    LAS unsigned short* kq = (LAS unsigned short*)lds;
                    const int qi = tid >> 7, ht = tid & 127;
                    LAS unsigned short* kqq = kq + qi * 16384;
                    LAS unsigned* hist = (LAS unsigned*)(lds + LDS_MISC + qi * 6400);
                    LAS unsigned* bits = hist + 1024;
                    LAS unsigned* misc = hist + 1536;
                    for (int it = 0;; ++it) {
                        const int L = it * G + c; if (L >= 8192) break;
                        const int uu = (L & 1) ? (8191 - (L >> 1)) : (L >> 1);
                        const int b = uu >> 12, pp = uu & 4095;
                        const size_t tA = (size_t)b * S + 4 * pp;
                        const int nD = 4 * pp + 4;
#pragma unroll
                        for (int q = 0; q < 8; ++q) hist[ht + 128 * q] = 0u;
                        __syncthreads();
#ifdef PROBE_MASK
                        if (a.probe_var != 2)
#endif
                        {
                            const int r32 = lane & 31, hi = lane >> 5;
                            typedef _Float16 f16x8_t __attribute__((ext_vector_type(8)));
                            f16x8_t qa[2];
#pragma unroll
                            for (int s = 0; s < 2; ++s) qa[s] = *(const f16x8_t*)(IQH + (tA + 2 * ((r32 >> 2) & 1) + (r32 >> 4)) * 256 + (4 * ((r32 >> 3) & 1) + (r32 & 3)) * 32 + 16 * s + 8 * hi);
                            f32x4 wq[4];
#pragma unroll
                            for (int q = 0; q < 4; ++q) wq[q] = *(const f32x4*)(IW + (tA + 2 * hi + (q >> 1)) * 8 + 4 * (q & 1));
                            const int ntile = (nD + 31) >> 5;
                            const _Float16* kbase = IKH + ((size_t)b * S + r32) * 32 + 8 * hi;
                            f16x8_t kb[4][2], kn[4][2];
#pragma unroll
                            for (int u = 0; u < 4; ++u) { const int tile = min(wid + NWAVES * u, ntile - 1);
                                kb[u][0] = *(const f16x8_t*)(kbase + (size_t)tile * 1024); kb[u][1] = *(const f16x8_t*)(kbase + (size_t)tile * 1024 + 16); }
                            for (int tile0 = wid; tile0 < ntile; tile0 += NWAVES * 4) {
#pragma unroll
                                for (int u = 0; u < 4; ++u) { const int tile = min(tile0 + NWAVES * (4 + u), ntile - 1);
                                    kn[u][0] = *(const f16x8_t*)(kbase + (size_t)tile * 1024); kn[u][1] = *(const f16x8_t*)(kbase + (size_t)tile * 1024 + 16); }
#pragma unroll
                                for (int u = 0; u < 4; ++u) {
                                    const int tile = tile0 + NWAVES * u;
                                    attn_body::f32x16 acc;
#pragma unroll
                                    for (int r = 0; r < 16; ++r) acc[r] = 0.f;
                                    acc = __builtin_amdgcn_mfma_f32_32x32x16_f16(qa[0], kb[u][0], acc, 0, 0, 0);
                                    acc = __builtin_amdgcn_mfma_f32_32x32x16_f16(qa[1], kb[u][1], acc, 0, 0, 0);
                                    float sq[4];
#pragma unroll
                                    for (int q = 0; q < 4; ++q) sq[q] = wq[q].x * relu_i(acc[4 * q]) + wq[q].y * relu_i(acc[4 * q + 1]) + wq[q].z * relu_i(acc[4 * q + 2]) + wq[q].w * relu_i(acc[4 * q + 3]);
                                    if (tile < ntile) {
                                        const float sa = sq[0] + sq[1], sb = sq[2] + sq[3];
                                        const unsigned h0 = (unsigned)__builtin_bit_cast(unsigned short, (_Float16)sa), h1 = (unsigned)__builtin_bit_cast(unsigned short, (_Float16)sb);
                                        const unsigned k0_ = (h0 ^ ((unsigned)__builtin_amdgcn_sbfe((int)h0, 15, 1) | 0x8000u)) & 0xFFFFu, k1_ = (h1 ^ ((unsigned)__builtin_amdgcn_sbfe((int)h1, 15, 1) | 0x8000u)) & 0xFFFFu;
                                        const int kidx = tile * 32 + r32;
                                        kq[(2 * hi) * 16384 + kidx] = (unsigned short)k0_;
                                        kq[(2 * hi + 1) * 16384 + kidx] = (unsigned short)k1_;
                                        LAS unsigned* hq0 = (LAS unsigned*)(lds + LDS_MISC + (2 * hi) * 6400); LAS unsigned* hq1 = (LAS unsigned*)(lds + LDS_MISC + (2 * hi + 1) * 6400);
                                        __hip_atomic_fetch_add(&hq0[(kidx <= 4 * pp + 2 * hi) ? ((k0_ >> 8) << 2) + (lane & 3) : 1536 + 32 + (lane & 3)], 1u, __ATOMIC_RELAXED, __HIP_MEMORY_SCOPE_WORKGROUP);
                                        __hip_atomic_fetch_add(&hq1[(kidx <= 4 * pp + 2 * hi + 1) ? ((k1_ >> 8) << 2) + (lane & 3) : 1536 + 32 + (lane & 3)], 1u, __ATOMIC_RELAXED, __HIP_MEMORY_SCOPE_WORKGROUP);
                                    }
                                }
#pragma unroll
                                for (int u = 0; u < 4; ++u) { kb[u][0] = kn[u][0]; kb[u][1] = kn[u][1]; }
                            }
                        }
                        __syncthreads();
#ifdef PROBE_MASK
                        if (a.probe_var == 1) continue;
#endif
                        const int n = 4 * pp + 1 + qi;
                        const bool small = n <= 256;
                        if (ht == 0) { misc[0] = 0u; misc[1] = 256u; misc[2] = 0u; }
                        const LAS unsigned* kq32 = (const LAS unsigned*)kqq;
                        const int npair = (n + 1) >> 1;
                        for (int pass = 0; pass < 2; ++pass) {
                            if (pass) {
#pragma unroll
                                for (int q = 0; q < 8; ++q) hist[ht + 128 * q] = 0u; }
                            __syncthreads();
                            const int shift = 8 - 8 * pass;
                            if (!small && pass) {
                                const unsigned prefix = misc[0];
                                for (int W = ht; 32 * W < n; W += 128) {
                                    const unsigned vmask = (n - 32 * W >= 32) ? 0xFFFFFFFFu : ((1u << (n - 32 * W)) - 1u);
                                    const LAS u32x4* kp = (const LAS u32x4*)(kq32 + 16 * W);
                                    unsigned ne = 0u;
                                    const unsigned pp2 = prefix | (prefix << 16);
#pragma unroll
                                    for (int q4 = 0; q4 < 4; ++q4) { const u32x4 w4 = kp[q4];
#pragma unroll
                                        for (int e = 0; e < 4; ++e) ne |= pk_gt_u16((w4[e] ^ pp2) & 0xFF00FF00u, 0u, 0x00010001u) << (4 * q4 + e); }
                                    unsigned mm = ilv16(~ne) & vmask;
                                    const LAS unsigned short* k16 = kqq + 32 * W;
                                    while (mm) { const int j = __ffs(mm) - 1; mm &= mm - 1u;
                                        __hip_atomic_fetch_add(&hist[(((unsigned)k16[j] & 255u) << 2) + (lane & 3)], 1u, __ATOMIC_RELAXED, __HIP_MEMORY_SCOPE_WORKGROUP); }
                                }
                            }
                            __syncthreads();
                            if (!small && ht < 64) {
                                unsigned cb[4];
#pragma unroll
                                for (int q = 0; q < 4; ++q) { const u32x4 a0 = *(const LAS u32x4*)(hist + (4 * ht + q) * 4); cb[q] = (a0.x + a0.y) + (a0.z + a0.w); }
                                const unsigned c0 = cb[0], c1 = cb[1], c2 = cb[2], c3 = cb[3];
                                const unsigned tot = c0 + c1 + c2 + c3;
                                unsigned Ssum = tot;
#pragma unroll
                                for (int off = 1; off < 64; off <<= 1) { const unsigned v = shi_(Ssum, lane + off); if (ht + off < 64) Ssum += v; }
                                const unsigned above = Ssum - tot, krem = misc[1];
                                if (above < krem && krem <= Ssum) {
                                    unsigned run = above, bin, eq;
                                    if (run + c3 >= krem) { bin = 3; eq = c3; }
                                    else { run += c3; if (run + c2 >= krem) { bin = 2; eq = c2; }
                                        else { run += c2; if (run + c1 >= krem) { bin = 1; eq = c1; } else { run += c1; bin = 0; eq = c0; } } }
                                    misc[0] = misc[0] | ((4u * ht + bin) << shift); misc[1] = krem - run; misc[2] = eq;
                                }
                            }
                            __syncthreads();
                        }
#ifdef PROBE_MASK
                        if (a.probe_var == 8) { __syncthreads(); continue; }
#endif
                        const unsigned Tkey = misc[0], krem = misc[1], cnteq = misc[2];
                        LAS unsigned* eqb = hist;
                        const bool all_eq = (cnteq == krem);
                        for (int W = ht; W < 512; W += 128) {
                            unsigned sel = 0u, eqm = 0u;
                            if (32 * W < n) {
                                const unsigned vmask = (n - 32 * W >= 32) ? 0xFFFFFFFFu : ((1u << (n - 32 * W)) - 1u);
                                if (small) sel = vmask;
                                else {
                                    const LAS u32x4* kp = (const LAS u32x4*)(kq32 + 16 * W);
                                    const unsigned tp2 = Tkey | (Tkey << 16);
                                    unsigned ag = 0u, al = 0u;
#pragma unroll
                                    for (int q4 = 0; q4 < 4; ++q4) { const u32x4 w4 = kp[q4];
#pragma unroll
                                        for (int e = 0; e < 4; ++e) { ag |= pk_gt_u16(w4[e], tp2, 0x00010001u) << (4 * q4 + e); al |= pk_gt_u16(tp2, w4[e], 0x00010001u) << (4 * q4 + e); } }
                                    sel = ilv16(ag); eqm = ilv16(~(ag | al));
                                    if (all_eq) { sel |= eqm; eqm = 0u; }
                                    sel &= vmask; eqm &= vmask;
                                }
                            }
                            bits[W] = sel; eqb[W] = eqm;
                        }
                        __syncthreads();
                        if (!small && !all_eq && ht < 64) {
                            unsigned wv_[8]; unsigned cnt = 0u;
#pragma unroll
                            for (int q = 0; q < 8; ++q) { wv_[q] = eqb[8 * ht + q]; cnt += (unsigned)__popc(wv_[q]); }
                            unsigned inc = cnt;
#pragma unroll
                            for (int off = 1; off < 64; off <<= 1) { const unsigned v = shi_(inc, lane - off); if (lane >= off) inc += v; }
                            unsigned before = inc - cnt;
#pragma unroll
                            for (int q = 0; q < 8; ++q) { unsigned w = wv_[q], keep = 0u;
                                while (w && before < krem) { const unsigned lowb = w & (0u - w); keep |= lowb; w ^= lowb; ++before; }
                                before += (unsigned)__popc(w);
                                if (keep) __hip_atomic_fetch_or(&bits[8 * ht + q], keep, __ATOMIC_RELAXED, __HIP_MEMORY_SCOPE_WORKGROUP); }
                        }
                        __syncthreads();
                        {
                            const int qpos = 4 * pp + qi; const int tmax = 8 * (qpos >> 9) + 7;
#pragma unroll
                            for (int j = 0; j < 2; ++j) { const int tt = 2 * ht + j;
                                if (tt <= tmax) { const unsigned W0 = bits[2 * tt], W1 = bits[2 * tt + 1];
                                    unsigned e0 = W0 & 0x0F0F0F0Fu, e1 = W1 & 0x0F0F0F0Fu, o0 = (W0 >> 4) & 0x0F0F0F0Fu, o1 = (W1 >> 4) & 0x0F0F0F0Fu;
                                    e0 = (e0 | (e0 >> 4)) & 0x00FF00FFu; e0 = (e0 | (e0 >> 8)) & 0xFFFFu; e1 = (e1 | (e1 >> 4)) & 0x00FF00FFu; e1 = (e1 | (e1 >> 8)) & 0xFFFFu;
                                    o0 = (o0 | (o0 >> 4)) & 0x00FF00FFu; o0 = (o0 | (o0 >> 8)) & 0xFFFFu; o1 = (o1 | (o1 >> 4)) & 0x00FF00FFu; o1 = (o1 | (o1 >> 8)) & 0xFFFFu;
                                    u32x2 pm; pm.x = e0 | (e1 << 16); pm.y = o0 | (o1 << 16);
                                    *(u32x2*)(MASKW + (((size_t)(b * 256 + tt)) * S + qpos) * 2) = pm; } }
                        }
                        __syncthreads();
                    }
                }
                __syncthreads();
                {
                    bf16_t* OA = YMIX;
                    const int vcu = (G % 8 == 0) ? (c % 8) * (G / 8) + c / 8 : c;
                    const int nu = (G == 256) ? 4 : (1024 - vcu + G - 1) / G;
                    for (int iu = 0; iu < nu; ++iu) {
                        const int lane = lane_id_v(), wid = lsg(wid0);
                        LAS unsigned char* L0 = lsgp(lds0);
                        int combo, qb;
                        if (G == 256) { combo = vcu >> 4; const int s_ = vcu & 15; qb = iu == 0 ? s_ : iu == 1 ? 31 - s_ : iu == 2 ? 32 + s_ : 63 - s_; }
                        else { const int u = vcu + iu * G; combo = u & 15; qb = 63 - (u >> 4); }
                        const int b = combo >> 3, hc = combo & 7;
                        const bf16_t* zb = Z + (size_t)b * S * EV_ZP;
                        if (qk_bounded(a_qn + i * 64, a_kn + i * 64, lane))
                            flash_unit<2, false, true, EV_ZP, 1024, true>(L0, zb + hc * 64, zb + 512 + hc * 64, zb + 1024 + (hc >> 1) * 128, OA + (size_t)b * S * 1024 + hc * 128, nullptr, qb, wid, lane, a_qn + i * 64, COSH, SINH);
                        else
                            flash_unit<2, false, true, EV_ZP, 1024, false>(L0, zb + hc * 64, zb + 512 + hc * 64, zb + 1024 + (hc >> 1) * 128, OA + (size_t)b * S * 1024 + hc * 128, nullptr, qb, wid, lane, a_qn + i * 64, COSH, SINH);
                    }
                }
            }
            PH_END();
            if (PH_ON()) { DECL_PTRS();
                {
                    const bf16_t* OA = YMIX; const float lamv = LAM[i]; const float lam_init = 0.8f - 0.6f * expf(-0.3f * (float)l);
                    const int h = lane >> 4, vj = (lane >> 3) & 1, d8 = (lane & 7) * 8;
                    float gn[8];
#pragma unroll
                    for (int e = 0; e < 8; ++e) gn[e] = a_subln[i * 128 + vj * 64 + d8 + e] * (1.0f - lam_init);
                    for (int t0 = gw * 4; t0 < T; t0 += NGW * 4) {
                        u32x4 r1[4], r2[4];
#pragma unroll
                        for (int u = 0; u < 4; ++u) { r1[u] = *(const u32x4*)(OA + (size_t)(t0 + u) * 1024 + ((h * 2 + 0) * 2 + vj) * 64 + d8); r2[u] = *(const u32x4*)(OA + (size_t)(t0 + u) * 1024 + ((h * 2 + 1) * 2 + vj) * 64 + d8); }
                        __builtin_amdgcn_sched_barrier(0);
#pragma unroll
                        for (int u = 0; u < 4; ++u) {
                            float o1[8], o2[8], dd[8]; unpack8(r1[u], o1); unpack8(r2[u], o2);
                            float ss = 0.f;
#pragma unroll
                            for (int e = 0; e < 8; ++e) { dd[e] = o1[e] - lamv * o2[e]; ss += dd[e] * dd[e]; }
                            ss += dpp_xor1(ss); ss += dpp_xor2(ss); ss += SHX(ss, 4); ss += SHX(ss, 8);
                            const float r = rsqrtf(ss * (1.0f / 128.0f) + EPS);
#pragma unroll
                            for (int e = 0; e < 8; ++e) dd[e] = dd[e] * r * gn[e];
                            *(u32x4*)(O + (size_t)(t0 + u) * 1024 + h * 128 + vj * 64 + d8) = pack8(dd);
                        }
                        __builtin_amdgcn_sched_barrier(0);
                    }
                }
                {
                    const int vcu = (G % 8 == 0) ? (c % 8) * (G / 8) + c / 8 : c;
                    const int nu = (G == 256) ? 2 : (512 - vcu + G - 1) / G;
                    for (int iu = 0; iu < nu; ++iu) {
                        const int lane = lane_id_v(), wid = lsg(wid0);
                        LAS unsigned char* L0 = lsgp(lds0);
                        int combo, qb;
                        if (G == 256) { combo = vcu >> 4; const int s_ = vcu & 15; qb = iu == 0 ? s_ : 31 - s_; }
                        else { const int u = vcu + iu * G; combo = u & 15; qb = 31 - (u >> 4); }
                        const int b = combo >> 3, h = combo & 7;
                        const bf16_t* zb = Z + (size_t)b * S * EV_ZP;
                        if (qk_bounded(b_qn + i * 64, b_kn + i * 64, lane))
                            flash_unit_q2<1, true, false, EV_ZP, 1024, true>(L0, zb + 1536 + h * 64, zb + 2048 + h * 64, zb + 2560 + h * 64, O + (size_t)b * S * 1024 + 512 + h * 64, MASKW + (size_t)b * 256 * S * 2, qb, wid, lane, b_qn + i * 64, COSH, SINH);
                        else
                            flash_unit_q2<1, true, false, EV_ZP, 1024, false>(L0, zb + 1536 + h * 64, zb + 2048 + h * 64, zb + 2560 + h * 64, O + (size_t)b * S * 1024 + 512 + h * 64, MASKW + (size_t)b * 256 * S * 2, qb, wid, lane, b_qn + i * 64, COSH, SINH);
                    }
                }
            }
            PH_END();
        } else {
            if (PH_ON()) { DECL_PTRS();
                pg8::Gemm g{H, Wodin + (size_t)i * OD_N * 1024, T, OD_N, 1024, 0}; pg8::StaticOrder So; So.init(T, OD_N, G, c);
                EpiOddIn E{Z, UG, c_kn + i * 64, COSH, SINH};
                { PROBE_WRAP(pg8::StaticOrder, So); pg8::gemm_phase<EpiOddIn, PROBE_SCHED(pg8::StaticOrder), true, true>(glds, g, PS_, E, tid); }
            }
            PH_END();
            if (PH_ON()) { DECL_PTRS();
                moe_convert(moe_w1 + (size_t)l * 32 * 1024 * 512, moe_w3 + (size_t)l * 32 * 1024 * 512, moe_w2 + (size_t)l * 32 * 512 * 1024, W13, W2, scr, gw, NGW, lane);
                __syncthreads();
                for (int u = gw; u < NB * 64 * 8; u += NGW) {
                    const int h = u & 7, blk = (u >> 3) & 63, b = u >> 9;
                    const int rs = lane >> 3, d8 = (lane & 7) * 8;
                    const bf16_t* kp = Z + ((size_t)b * S + blk * 256 + rs) * OD_N + 512 + h * 64 + d8;
                    u32x4 kr[32];
#pragma unroll
                    for (int j = 0; j < 32; ++j) kr[j] = *(const u32x4*)(kp + (size_t)(8 * j) * OD_N);
                    __builtin_amdgcn_sched_barrier(0);
                    float sm[8];
#pragma unroll
                    for (int e = 0; e < 8; ++e) sm[e] = 0.f;
#pragma unroll
                    for (int j = 0; j < 32; ++j) { float kv[8]; unpack8(kr[j], kv);
#pragma unroll
                        for (int e = 0; e < 8; ++e) sm[e] += kv[e]; }
#pragma unroll
                    for (int e = 0; e < 8; ++e) { sm[e] += SHX(sm[e], 8); sm[e] += SHX(sm[e], 16); sm[e] += SHX(sm[e], 32); sm[e] *= (1.0f / 256.0f); }
                    if (rs == 0) {
                        *(f32x4*)(KM + (size_t)u * 64 + d8) = (f32x4){sm[0], sm[1], sm[2], sm[3]}; *(f32x4*)(KM + (size_t)u * 64 + d8 + 4) = (f32x4){sm[4], sm[5], sm[6], sm[7]};
                        const u32x4 hw = pack8(sm); float hf[8], lo[8]; unpack8(hw, hf);
#pragma unroll
                        for (int e = 0; e < 8; ++e) lo[e] = sm[e] - hf[e];
                        *(u32x4*)(KMH + ((size_t)(b * 8 + h) * 64 + blk) * 64 + d8) = hw; *(u32x4*)(KML + ((size_t)(b * 8 + h) * 64 + blk) * 64 + d8) = pack8(lo);
                    }
                }
                {
                    const int r32 = lane & 31, hi = lane >> 5;
                    LAS unsigned char* ldsU = lds;
                    LAS float* red = (LAS float*)(lds + 69632);
                    for (int task = c; task < 512; task += G) {
                        const int g = task >> 4, cs = task & 15;
                        for (int q = tid; q < 32 * 128; q += NTHREADS) { const int j = q >> 7, off = (q & 127) * 16;
                            *(LAS u32x4*)(ldsU + j * 2064 + off) = *(const u32x4*)((const unsigned char*)UG + ((size_t)g * T + (size_t)(cs * 32 + j) * 64) * 32 + off); }
                        __syncthreads();
                        const int rb = wid & 3, kh = wid >> 2;
                        attn_body::f32x16 acc;
#pragma unroll
                        for (int r = 0; r < 16; ++r) acc[r] = 0.f;
                        const bf16_t* wrow = S5WT + ((size_t)(i * 32 + g) * 128 + rb * 32 + r32) * 1024 + hi * 8;
#pragma unroll 8
                        for (int ks = kh * 32; ks < kh * 32 + 32; ++ks) {
                            const attn_body::bf16x8 A = *(const attn_body::bf16x8*)(wrow + ks * 16);
                            const attn_body::bf16x8 B = *(const LAS attn_body::bf16x8*)(ldsU + r32 * 2064 + ks * 32 + hi * 16);
                            acc = __builtin_amdgcn_mfma_f32_32x32x16_bf16(A, B, acc, 0, 0, 0);
                        }
                        if (kh == 1) {
#pragma unroll
                            for (int r = 0; r < 16; ++r) red[(rb * 64 + lane) * 16 + r] = acc[r];
                        }
                        __syncthreads();
                        if (kh == 0) {
                            float* ep = S5E + ((size_t)(cs * 32 + r32) * 32 + g) * 128 + rb * 32 + 4 * hi;
#pragma unroll
                            for (int q4 = 0; q4 < 4; ++q4) { f32x4 o;
                                o.x = acc[4 * q4] + red[(rb * 64 + lane) * 16 + 4 * q4]; o.y = acc[4 * q4 + 1] + red[(rb * 64 + lane) * 16 + 4 * q4 + 1];
                                o.z = acc[4 * q4 + 2] + red[(rb * 64 + lane) * 16 + 4 * q4 + 2]; o.w = acc[4 * q4 + 3] + red[(rb * 64 + lane) * 16 + 4 * q4 + 3];
                                *(f32x4*)(ep + 8 * q4) = o; }
                        }
                        __syncthreads();
                    }
                }
            }
            PH_END();
            if (PH_ON()) { DECL_PTRS();
#ifndef SKIP_S5
                {
                    for (int idx = gt; idx < NB * 32 * 64; idx += NGT) {
                        const int b = idx >> 11, g = (idx >> 6) & 31, p = idx & 63;
                        const int sp = (i * 32 + g) * 64 + p;
                        const float aLr = S5PW[((size_t)sp * 65 + 64) * 2], aLi = S5PW[((size_t)sp * 65 + 64) * 2 + 1];
                        float hr = 0.f, hi_ = 0.f;
                        for (int c0 = 0; c0 < 256; c0 += 32) {
                            float er[32], ei[32];
#pragma unroll
                            for (int k = 0; k < 32; ++k) { const float* ep = S5E + ((size_t)(b * 256 + c0 + k) * 32 + g) * 128 + 2 * p; er[k] = ep[0]; ei[k] = ep[1]; }
                            __builtin_amdgcn_sched_barrier(0);
#pragma unroll
                            for (int k = 0; k < 32; ++k) {
                                *(unsigned*)(S5HC + ((size_t)(b * 256 + c0 + k) * 32 + g) * 128 + 2 * p) = pk2(hr, hi_);
                                const float nr = aLr * hr - aLi * hi_ + er[k], ni = aLr * hi_ + aLi * hr + ei[k]; hr = nr; hi_ = ni; }
                        }
                    }
                }
#endif
                {
                    unsigned* mcnt = ctl + CW_MCNT + i * 1024;
                    const int r32 = lane & 31, hi = lane >> 5;
                    for (int u = c; u < NB * 8 * 64; u += G) {
                        const int tb = u & 63, h = (u >> 6) & 7, b = u >> 9;
                        const int pos = tb * 256 + wid * 32 + r32; const size_t t = (size_t)b * S + pos;
                        float tv[3] = {-INFINITY, -INFINITY, -INFINITY}; int ti[3] = {1 << 20, 1 << 20, 1 << 20};
                        if (tb > 0) {
                            attn_body::bf16x8 qr[4];
                            load_q_normed(qr, Z + t * OD_N + h * 64, c_qn + i * 64, COSH, SINH, pos, hi, lane);
                            attn_body::f32x16 g0, g1;
#pragma unroll
                            for (int r = 0; r < 16; ++r) { g0[r] = 0.f; g1[r] = 0.f; }
                            const bf16_t* kh = KMH + ((size_t)(b * 8 + h) * 64 + r32) * 64 + hi * 8; const bf16_t* kl = KML + ((size_t)(b * 8 + h) * 64 + r32) * 64 + hi * 8;
#pragma unroll
                            for (int d0 = 0; d0 < 4; ++d0) {
                                g0 = __builtin_amdgcn_mfma_f32_32x32x16_bf16(*(const attn_body::bf16x8*)(kh + d0 * 16), qr[d0], g0, 0, 0, 0);
                                g0 = __builtin_amdgcn_mfma_f32_32x32x16_bf16(*(const attn_body::bf16x8*)(kl + d0 * 16), qr[d0], g0, 0, 0, 0);
                                if (tb > 32) { g1 = __builtin_amdgcn_mfma_f32_32x32x16_bf16(*(const attn_body::bf16x8*)(kh + 32 * 64 + d0 * 16), qr[d0], g1, 0, 0, 0);
                                               g1 = __builtin_amdgcn_mfma_f32_32x32x16_bf16(*(const attn_body::bf16x8*)(kl + 32 * 64 + d0 * 16), qr[d0], g1, 0, 0, 0); } }
#pragma unroll
                            for (int half = 0; half < 2; ++half)
#pragma unroll
                                for (int r = 0; r < 16; ++r) { const int n = half * 32 + attn_body::crow(r, hi); const float gv = (n < tb) ? (half ? g1[r] : g0[r]) : -INFINITY;
                                    if (gv > tv[0]) { tv[2] = tv[1]; ti[2] = ti[1]; tv[1] = tv[0]; ti[1] = ti[0]; tv[0] = gv; ti[0] = n; }
                                    else if (gv > tv[1]) { tv[2] = tv[1]; ti[2] = ti[1]; tv[1] = gv; ti[1] = n; }
                                    else if (gv > tv[2]) { tv[2] = gv; ti[2] = n; } }
                            float pv_[3]; int pi_[3];
#pragma unroll
                            for (int k = 0; k < 3; ++k) { pv_[k] = SHX(tv[k], 32); pi_[k] = (int)shi_((unsigned)ti[k], lane ^ 32); }
                            float mv[3]; int mi[3]; int ia = 0, ib = 0;
#pragma unroll
                            for (int k = 0; k < 3; ++k) {
                                const float av = ia == 0 ? tv[0] : ia == 1 ? tv[1] : ia == 2 ? tv[2] : -INFINITY; const int ai = ia == 0 ? ti[0] : ia == 1 ? ti[1] : ia == 2 ? ti[2] : (1 << 20);
                                const float bv = ib == 0 ? pv_[0] : ib == 1 ? pv_[1] : ib == 2 ? pv_[2] : -INFINITY; const int bi = ib == 0 ? pi_[0] : ib == 1 ? pi_[1] : ib == 2 ? pi_[2] : (1 << 20);
                                const bool ta = (av > bv) || (av == bv && ai < bi);
                                mv[k] = ta ? av : bv; mi[k] = ta ? ai : bi; if (ta) ++ia; else ++ib; }
#pragma unroll
                            for (int k = 0; k < 3; ++k) { tv[k] = mv[k]; ti[k] = mi[k]; }
                        }
#ifdef PROBE_MASK
                        if (a.probe_var == 3) { if (ti[0] + ti[1] + ti[2] == -12345) NSEL[0] = 1; continue; }
#endif
                        if (hi == 0) {
                            unsigned idx[3];
#pragma unroll
                            for (int sI = 0; sI < 3; ++sI) { idx[sI] = 0u;
                                if (tv[sI] > -INFINITY) idx[sI] = __hip_atomic_fetch_add(mcnt + (b * 8 + h) * 64 + ti[sI], 1u, __ATOMIC_RELAXED, __HIP_MEMORY_SCOPE_AGENT); }
                            int nsel = 0;
#pragma unroll
                            for (int sI = 0; sI < 3; ++sI)
                                if (tv[sI] > -INFINITY) { const int li = (b * 8 + h) * 64 + ti[sI]; MLIST[(size_t)li * 16384 + idx[sI]] = (pos << 2) | nsel; ++nsel; }
                            NSEL[t * 8 + h] = nsel;
                        }
                    }
                }
            }
            PH_END();
            if (PH_ON()) { DECL_PTRS();
                {
                    const unsigned* mcnt = ctl + CW_MCNT + i * 1024;
                    LAS int* pref = (LAS int*)(lds + LDS_MISC);
                    if (wid == 0) {
                        int loc[16]; int sum = 0;
#pragma unroll
                        for (int k = 0; k < 16; ++k) loc[k] = (int)__hip_atomic_load(mcnt + lane * 16 + k, __ATOMIC_RELAXED, __HIP_MEMORY_SCOPE_AGENT);
                        __builtin_amdgcn_sched_barrier(0);
#pragma unroll
                        for (int k = 0; k < 16; ++k) { const int cnt = loc[k]; loc[k] = sum; sum += (cnt + 255) >> 8; }
                        int inc = sum;
#pragma unroll
                        for (int off = 1; off < 64; off <<= 1) { const int v = (int)shi_((unsigned)inc, lane - off); if (lane >= off) inc += v; }
                        const int base = inc - sum;
#pragma unroll
                        for (int k = 0; k < 16; ++k) pref[lane * 16 + k] = base + loc[k];
                        if (lane == 63) pref[1024] = inc;
                    }
                    __syncthreads();
                    const int NTsel = pref[1024];
                    for (int task = c; task < NTsel + 1024; task += G) {
                        const int lane = lane_id_v(), wid = lsg(wid0), r32 = lane & 31, hi = lane >> 5;
                        LAS unsigned char* ldsKs = lsgp(lds0); LAS unsigned char* ldsVs = ldsKs + 32768;
                        LAS bf16_t* stg = (LAS bf16_t*)(ldsKs + 65536 + wid * 4096); LAS float* wsf = (LAS float*)(ldsKs + 98304 + wid * 256); LAS int* rowd = (LAS int*)(ldsKs + 100352 + wid * 128);
                        const bool own_task = task >= NTsel;
                        int li, chunk = 0;
                        if (own_task) li = task - NTsel;
                        else { int lo_ = 0, hi_ = 1023; while (lo_ < hi_) { const int mid = (lo_ + hi_ + 1) >> 1; if (pref[mid] <= task) lo_ = mid; else hi_ = mid - 1; } li = lo_; chunk = task - pref[li]; }
                        const int b = li >> 9, h = (li >> 6) & 7, blk = li & 63;
                        const int e_ = chunk * 256 + wid * 32 + r32;
                        const int cnt = own_task ? 256 : (int)__hip_atomic_load(mcnt + li, __ATOMIC_RELAXED, __HIP_MEMORY_SCOPE_AGENT);
                        const int ent_ = own_task ? 0 : MLIST[(size_t)li * 16384 + e_];
                        u32x4 kst[4], vst[4];
                        {
                            const bf16_t* kbp = Z + ((size_t)b * S + blk * 256) * OD_N + 512 + h * 64;
                            const bf16_t* vbp = Z + ((size_t)b * S + blk * 256) * OD_N + 1024 + h * 64;
#pragma unroll
                            for (int kt = 0; kt < 4; ++kt) {
                                kst[kt] = *(const u32x4*)(kbp + (size_t)(kt * 64 + lane) * OD_N + wid * 8);
                                vst[kt] = *(const u32x4*)(vbp + (size_t)(kt * 64 + 16 * (wid & 3) + (lane >> 2)) * OD_N + (wid >> 2) * 32 + (lane & 3) * 8);
                            }
                        }
                        __builtin_amdgcn_sched_barrier(0);
                        int posq, slot; bool valid;
                        if (own_task) { posq = blk * 256 + wid * 32 + r32; slot = 3; valid = true; }
                        else { valid = e_ < cnt; posq = valid ? (ent_ >> 2) : 0; slot = ent_ & 3; }
                        const size_t tq = (size_t)b * S + posq;
                        const int dest = valid ? (int)((tq * 8 + h) * 4 + slot) : -1;
                        attn_body::bf16x8 qr[4];
                        load_q_normed(qr, Z + tq * OD_N + h * 64, c_qn + i * 64, COSH, SINH, posq, hi, lane);
#pragma unroll
                        for (int kt = 0; kt < 4; ++kt) { *(LAS u32x4*)(ldsKs + kt * 8192 + wid * 1024 + lane * 16) = kst[kt]; *(LAS u32x4*)(ldsVs + kt * 8192 + wid * 1024 + lane * 16) = vst[kt]; }
                        __syncthreads();
                        attn_body::f32x16 p0[4], p1[4];
#pragma unroll
                        for (int kt = 0; kt < 4; ++kt) {
#pragma unroll
                            for (int r = 0; r < 16; ++r) { p0[kt][r] = 0.f; p1[kt][r] = 0.f; }
                            const LAS unsigned char* kb = ldsKs + kt * 8192 + hi * 1024 + r32 * 16;
#pragma unroll
                            for (int d0 = 0; d0 < 4; ++d0) {
                                const attn_body::bf16x8 b0 = *(const LAS attn_body::bf16x8*)(kb + d0 * 2048), b1 = *(const LAS attn_body::bf16x8*)(kb + d0 * 2048 + 512);
                                p0[kt] = __builtin_amdgcn_mfma_f32_32x32x16_bf16(b0, qr[d0], p0[kt], 0, 0, 0);
                                p1[kt] = __builtin_amdgcn_mfma_f32_32x32x16_bf16(b1, qr[d0], p1[kt], 0, 0, 0);
                            }
                        }
                        if (own_task) {
                            const int qrel = wid * 32 + r32;
#pragma unroll
                            for (int kt = 0; kt < 4; ++kt)
#pragma unroll
                                for (int r = 0; r < 16; ++r) { const int kv = kt * 64 + attn_body::crow(r, hi); if (kv > qrel) p0[kt][r] = -INFINITY; if (kv + 32 > qrel) p1[kt][r] = -INFINITY; }
                        }
                        float mx = -INFINITY;
#pragma unroll
                        for (int kt = 0; kt < 4; ++kt)
#pragma unroll
                            for (int r = 0; r < 16; ++r) mx = fmaxf(mx, fmaxf(p0[kt][r], p1[kt][r]));
                        mx = fmaxf(mx, SHX(mx, 32));
                        float ls = 0.f;
#pragma unroll
                        for (int kt = 0; kt < 4; ++kt)
#pragma unroll
                            for (int r = 0; r < 16; ++r) { p0[kt][r] = __builtin_amdgcn_exp2f(p0[kt][r] - mx); p1[kt][r] = __builtin_amdgcn_exp2f(p1[kt][r] - mx); ls += p0[kt][r] + p1[kt][r]; }
                        ls += SHX(ls, 32);
                        attn_body::f32x16 o[2];
#pragma unroll
                        for (int r = 0; r < 16; ++r) { o[0][r] = 0.f; o[1][r] = 0.f; }
                        const int vb0 = (int)(unsigned)(unsigned long long)ldsVs + ((lane >> 4) & 1) * 32 + (lane & 3) * 8 + (4 * hi + ((lane & 15) >> 2)) * 64;
#pragma unroll
                        for (int kt = 0; kt < 4; ++kt) {
                            u32x4 pw0, pw1, pw2, pw3;
#pragma unroll
                            for (int k = 0; k < 4; ++k) { pw0[k] = attn_body::cvtpk_s(p0[kt][2 * k], p0[kt][2 * k + 1]); pw1[k] = attn_body::cvtpk_s(p0[kt][8 + 2 * k], p0[kt][9 + 2 * k]);
                                pw2[k] = attn_body::cvtpk_s(p1[kt][2 * k], p1[kt][2 * k + 1]); pw3[k] = attn_body::cvtpk_s(p1[kt][8 + 2 * k], p1[kt][9 + 2 * k]); }
                            attn_body::pv(o, vb0 + kt * 8192, __builtin_bit_cast(attn_body::bf16x8, pw0), __builtin_bit_cast(attn_body::bf16x8, pw1), __builtin_bit_cast(attn_body::bf16x8, pw2), __builtin_bit_cast(attn_body::bf16x8, pw3));
                        }
                        if (hi == 0) { wsf[r32] = ls; rowd[r32] = dest; if (valid) { MML[(size_t)dest * 2] = mx; MML[(size_t)dest * 2 + 1] = ls; } }
                        LDS_WAIT();
#pragma unroll
                        for (int r = 0; r < 16; ++r) { const int orow = attn_body::crow(r, hi); const float rl = __builtin_amdgcn_rcpf(wsf[orow]);
                            stg[orow * 64 + r32] = (bf16_t)f2bf(o[0][r] * rl); stg[orow * 64 + 32 + r32] = (bf16_t)f2bf(o[1][r] * rl); }
                        LDS_WAIT();
#pragma unroll
                        for (int q = 0; q < 4; ++q) { const int row = q * 8 + (lane >> 3), ch = lane & 7; const int dd = rowd[row];
                            if (dd >= 0) *(u32x4*)(MPO + (size_t)dd * 64 + ch * 8) = *(const LAS u32x4*)(stg + row * 64 + ch * 8); }
                        __syncthreads();
                    }
                }
                {
                const int r32 = lane & 31, hi = lane >> 5;
                LAS unsigned char* ldsU = lds;
                LAS unsigned char* ldsK = lds + 69632;
                for (int task = c; task < 512; task += G) {
                    const int g = task >> 4, cs = task & 15, ig = i * 32 + g;
                    for (int q = tid; q < 32 * 128; q += NTHREADS) { const int j = q >> 7, off = (q & 127) * 16;
                        *(LAS u32x4*)(ldsU + j * 2064 + off) = *(const u32x4*)((const unsigned char*)UG + ((size_t)g * T + (size_t)(cs * 32 + j) * 64) * 32 + off); }
                    for (int q = tid; q < 65 * 48; q += NTHREADS) *(LAS u32x4*)(ldsK + q * 16) = *(const u32x4*)((const unsigned char*)S5KT + (size_t)ig * 65 * 768 + q * 16);
                    __syncthreads();
                    const int gc = cs * 32 + r32;
                    const float* dsk = s5_d + ig * 16;
                    const f32x4 dd0 = *(const f32x4*)(dsk + 4 * hi), dd1 = *(const f32x4*)(dsk + 8 + 4 * hi);
                    attn_body::bf16x8 hcr[8];
                    { const bf16_t* hc = S5HC + ((size_t)gc * 32 + g) * 128 + hi * 8;
#pragma unroll
                      for (int kk = 0; kk < 8; ++kk) hcr[kk] = *(const attn_body::bf16x8*)(hc + kk * 16); }
#pragma unroll 1
                    for (int rr = 0; rr < 4; ++rr) {
                        const int r = rr == 0 ? wid : rr == 1 ? 15 - wid : rr == 2 ? 16 + wid : 31 - wid;
                        attn_body::f32x16 acc;
#pragma unroll
                        for (int q = 0; q < 16; ++q) acc[q] = 0.f;
                        attn_body::bf16x8 a2r[8];
                        { const bf16_t* a2 = S5A2 + ((size_t)ig * 1024 + r * 32 + r32) * 128 + hi * 8;
#pragma unroll
                          for (int kk = 0; kk < 8; ++kk) a2r[kk] = *(const attn_body::bf16x8*)(a2 + kk * 16); }
                        __builtin_amdgcn_sched_barrier(0);
                        const LAS unsigned char* kbase = ldsK + (r32 >> 4) * 768 + (r32 & 15) * 48 + hi * 16;
                        const LAS unsigned char* ubase = ldsU + r32 * 2064 + hi * 16;
                        for (int s = 0; s <= 2 * r + 1; ++s) {
                            const attn_body::bf16x8 A = *(const LAS attn_body::bf16x8*)(kbase + (2 * r - s + 1) * 768);
                            const attn_body::bf16x8 B = *(const LAS attn_body::bf16x8*)(ubase + s * 32);
                            acc = __builtin_amdgcn_mfma_f32_32x32x16_bf16(A, B, acc, 0, 0, 0);
                        }
#pragma unroll
                        for (int kk = 0; kk < 8; ++kk) acc = __builtin_amdgcn_mfma_f32_32x32x16_bf16(a2r[kk], hcr[kk], acc, 0, 0, 0);
#pragma unroll
                        for (int q4 = 0; q4 < 4; ++q4) {
                            const int rowb = 8 * q4 + 4 * hi, dt_ = rowb >> 4, co0 = rowb & 15, t = 2 * r + dt_;
                            const u32x2 uw = *(const LAS u32x2*)(ldsU + r32 * 2064 + t * 32 + co0 * 2);
                            const f32x4 dd = (q4 & 1) ? dd1 : dd0;
                            const float y0 = acc[4 * q4] + dd.x * bflo(uw.x), y1 = acc[4 * q4 + 1] + dd.y * bfhi(uw.x), y2 = acc[4 * q4 + 2] + dd.z * bflo(uw.y), y3 = acc[4 * q4 + 3] + dd.w * bfhi(uw.y);
                            u32x2 w; w.x = pk2(gelu_tanh(y0), gelu_tanh(y1)); w.y = pk2(gelu_tanh(y2), gelu_tanh(y3));
                            *(u32x2*)(YG + ((size_t)gc * 64 + t) * 512 + g * 16 + co0) = w;
                        }
                    }
                    __syncthreads();
                }
                }
            }
            PH_END();
            if (PH_ON()) { DECL_PTRS();
                {
                    const int h = lane >> 3, d8 = (lane & 7) * 8;
                    for (int t0 = gw * 4; t0 < T; t0 += NGW * 4) {
                        int nsel[4]; f32x2 ml[4][4]; u32x4 po[4][4];
#pragma unroll
                        for (int u = 0; u < 4; ++u) { const size_t base = ((size_t)(t0 + u) * 8 + h) * 4; nsel[u] = NSEL[(size_t)(t0 + u) * 8 + h];
#pragma unroll
                            for (int s = 0; s < 4; ++s) { ml[u][s] = *(const f32x2*)(MML + (base + s) * 2); po[u][s] = *(const u32x4*)(MPO + (base + s) * 64 + d8); } }
                        __builtin_amdgcn_sched_barrier(0);
#pragma unroll
                        for (int u = 0; u < 4; ++u) {
                            float mm[4], ll[4];
#pragma unroll
                            for (int s = 0; s < 4; ++s) { const bool on = (s == 3) || (s < nsel[u]); mm[s] = on ? ml[u][s].x : -INFINITY; ll[s] = on ? ml[u][s].y : 0.f; }
                            const float M = fmaxf(fmaxf(mm[0], mm[1]), fmaxf(mm[2], mm[3]));
                            float acc[8], wsum = 0.f;
#pragma unroll
                            for (int e = 0; e < 8; ++e) acc[e] = 0.f;
#pragma unroll
                            for (int s = 0; s < 4; ++s) { const bool on = (s == 3) || (s < nsel[u]);
                                const float w = on ? ll[s] * __builtin_amdgcn_exp2f(mm[s] - M) : 0.f; float ov[8]; unpack8(po[u][s], ov); wsum += w;
#pragma unroll
                                for (int e = 0; e < 8; ++e) acc[e] += on ? w * ov[e] : 0.f; }
                            const float inv = 1.0f / wsum;
#pragma unroll
                            for (int e = 0; e < 8; ++e) acc[e] *= inv;
                            *(u32x4*)(O + (size_t)(t0 + u) * 1024 + h * 64 + d8) = pack8(acc);
                        }
                        __builtin_amdgcn_sched_barrier(0);
                    }
                }
                pg8::Gemm g{YG, Wglu + (size_t)i * 512 * 512, T, 512, 512, 0}; pg8::StaticOrder So; So.init(T, 512, G, c);
                EpiGLU E{O, YG, s5_glu_b + i * 512};
                { PROBE_WRAP(pg8::StaticOrder, So); pg8::gemm_phase<EpiGLU, PROBE_SCHED(pg8::StaticOrder), true, true>(glds, g, PS_, E, tid); }
            }
            PH_END();
        }
        if (PH_ON()) { DECL_PTRS();
            pg8::Gemm g{O, ((l & 1) ? Wodout : Wevout) + (size_t)i * 1024 * 1024, T, 1024, 1024, 0}; pg8::StaticOrder So; So.init(T, 1024, G, c);
            EpiPlain E{YMIX, 1024};
            { PROBE_WRAP(pg8::StaticOrder, So); pg8::gemm_phase<EpiPlain, PROBE_SCHED(pg8::StaticOrder), true, true>(glds, g, PS_, E, tid); }
        }
        PH_END();
        if (PH_ON()) { DECL_PTRS();
#ifdef PROBE_MASK
            const bool first_x = (l == 0 && a.probe_var != -5);
#else
            const bool first_x = (l == 0);
#endif
            const float* xs = xin;
            LAS int* r_e = (LAS int*)(lds + 0);
            LAS float* r_w = (LAS float*)(lds + 1024);
            LAS int* r_rank = (LAS int*)(lds + 2048);
            LAS int* lcnt = (LAS int*)(lds + 3072);
            LAS int* lbase = (LAS int*)(lds + 3200);
            const float* wg_l = moe_wg + (size_t)l * 1024 * 4; const float* we_l = moe_we + (size_t)l * 1024 * 32;
            for (int chunk = c; chunk < T / 128; chunk += G) {
                if (tid < 32) lcnt[tid] = 0;
                LAS float* modl = (LAS float*)(lds + 32768);
                { const float* mo_ = MOD + (size_t)(l * 2 + (int)(((size_t)chunk * 128) / S)) * 6144 + 2048;
                  for (int q = tid; q < 768; q += NTHREADS) *(LAS f32x4*)(modl + 4 * q) = *(const f32x4*)(mo_ + 4 * q); }
                __syncthreads();
                {
                    const int rloc = lane & 15, kc = lane >> 4; const int r = wid * 16 + rloc; const size_t t = (size_t)chunk * 128 + r; const int b = (int)(((size_t)chunk * 128) / S);
                    const float* mo = MOD + (size_t)(l * 2 + b) * 6144;
                    float ss;
                    if (first_x) ss = f_pass1<true>(xs + t * 1024, XB + t * 1024, YMIX + t * 1024, modl, kc);
                    else ss = f_pass1<false>(xs + t * 1024, XB + t * 1024, YMIX + t * 1024, modl, kc);
                    ss += SHX(ss, 16); ss += SHX(ss, 32);
                    const float rn = rsqrtf(ss * (1.0f / 1024.0f) + EPS);
                    f32x4 acc[3];
#pragma unroll
                    for (int ct = 0; ct < 3; ++ct) acc[ct] = (f32x4){0.f, 0.f, 0.f, 0.f};
                    const bf16_t* wh = WRH + ((size_t)l * 48 + rloc) * 1024 + 8 * kc; const bf16_t* wl = WRL + ((size_t)l * 48 + rloc) * 1024 + 8 * kc;
                    f_pass2(XB + t * 1024, H + t * 1024, modl, wh, wl, rn, kc, acc);
                    LAS float* lg = (LAS float*)(lds + 4096 + wid * 3072);
#pragma unroll
                    for (int ct = 0; ct < 3; ++ct) { lg[(4 * kc + 0) * 48 + ct * 16 + rloc] = acc[ct].x; lg[(4 * kc + 1) * 48 + ct * 16 + rloc] = acc[ct].y; lg[(4 * kc + 2) * 48 + ct * 16 + rloc] = acc[ct].z; lg[(4 * kc + 3) * 48 + ct * 16 + rloc] = acc[ct].w; }
                    LDS_WAIT();
                    if (lane < 16) {
                        const LAS float* lr = lg + lane * 48;
                        float cg[4];
#pragma unroll
                        for (int e = 0; e < 4; ++e) cg[e] = lr[e] + moe_bg[l * 4 + e];
                        int grp = 0; float cm = cg[0];
#pragma unroll
                        for (int e = 1; e < 4; ++e) if (cg[e] > cm) { cm = cg[e]; grp = e; }
                        float den = 0.f;
#pragma unroll
                        for (int e = 0; e < 4; ++e) den += __expf(cg[e] - cm);
                        const float pg = 1.0f / den;
                        float fe[8];
#pragma unroll
                        for (int e = 0; e < 8; ++e) fe[e] = lr[4 + grp * 8 + e] + moe_be[l * 32 + grp * 8 + e];
                        int j0 = 0; float f0 = fe[0];
#pragma unroll
                        for (int e = 1; e < 8; ++e) if (fe[e] > f0) { f0 = fe[e]; j0 = e; }
                        int j1 = -1; float f1 = -INFINITY;
#pragma unroll
                        for (int e = 0; e < 8; ++e) if (e != j0 && fe[e] > f1) { f1 = fe[e]; j1 = e; }
                        const float ex = __expf(f1 - f0); const float sA = 1.0f / (1.0f + ex), sB = ex / (1.0f + ex);
                        const int rr_ = wid * 16 + lane;
                        r_e[2 * rr_] = grp * 8 + j0; r_w[2 * rr_] = pg * sA; r_e[2 * rr_ + 1] = grp * 8 + j1; r_w[2 * rr_ + 1] = pg * sB;
                    }
                }
                __syncthreads();
#ifdef PROBE_MASK
                if (a.probe_var == 5) { if (tid < 256 && r_e[tid] == -777) TOKES[0] = 0; __syncthreads(); continue; }
#endif
                if (tid < 256) r_rank[tid] = __hip_atomic_fetch_add(&lcnt[r_e[tid]], 1, __ATOMIC_RELAXED, __HIP_MEMORY_SCOPE_WORKGROUP);
                __syncthreads();
                if (tid < 32) lbase[tid] = (int)__hip_atomic_fetch_add(ctl + CW_CNT + (l * 32 + tid) * 64, (unsigned)lcnt[tid], __ATOMIC_RELAXED, __HIP_MEMORY_SCOPE_AGENT);
                __syncthreads();
                if (tid < 256) { const size_t t = (size_t)chunk * 128 + (tid >> 1); const int k = tid & 1; const int e = r_e[tid]; const int slot = lbase[e] + r_rank[tid];
                    TOKES[t * 2 + k] = e * 32768 + slot; TOKW[t * 2 + k] = r_w[tid]; LTOK[e * 32768 + slot] = (int)t; }
                __syncthreads();
            }
        }
        PH_END();
        if (PH_ON()) { DECL_PTRS();
            LAS int* tile_e = (LAS int*)(lds + LDS_MISC); LAS int* rb = tile_e + 320; LAS int* nt_p = tile_e + 400;
            moe_tables(ctl, l, tile_e, rb, nt_p, tid);
            const int nR = nt_p[0];
            pg8::Gemm g{H, W13, nR * 256, 1024, 1024, (size_t)1024 * 1024 * 2}; MoeOrder Mo{4, nR * 4, G, c, tile_e};
            EpiSwiGLU E{HID}; MoeRows RW{rb, LTOK};
            { PROBE_WRAP(MoeOrder, Mo); pg8::gemm_phase<EpiSwiGLU, PROBE_SCHED(MoeOrder), true, true, MoeRows>(glds, g, PS_, E, tid, RW); }
        }
        PH_END();
        if (PH_ON()) { DECL_PTRS();
            LAS int* tile_e = (LAS int*)(lds + LDS_MISC); LAS int* rb = tile_e + 320; LAS int* nt_p = tile_e + 400;
            moe_tables(ctl, l, tile_e, rb, nt_p, tid);
            const int nR = nt_p[0];
            pg8::Gemm g{HID, W2, nR * 256, 1024, 512, (size_t)1024 * 512 * 2}; MoeOrder Mo{4, nR * 4, G, c, tile_e};
            EpiPlain E{Y, 1024};
            { PROBE_WRAP(MoeOrder, Mo); pg8::gemm_phase<EpiPlain, PROBE_SCHED(MoeOrder), true, true>(glds, g, PS_, E, tid); }
        }
        PH_END();
        if (PH_ON()) { DECL_PTRS();
            LAS int* tile_e = (LAS int*)(lds + LDS_MISC); LAS int* rb = tile_e + 320; LAS int* nt_p = tile_e + 400;
            moe_tables(ctl, l, tile_e, rb, nt_p, tid);
            constexpr int RJ = 4;
            for (int t0 = gw * RJ; t0 < T; t0 += NGW * RJ) {
                const int b = t0 / S; const float* mo = MOD + (size_t)(l * 2 + b) * 6144;
                int r0[RJ], r1[RJ]; float w0[RJ], w1[RJ];
#pragma unroll
                for (int u = 0; u < RJ; ++u) { const int t = t0 + u; { const int e0_ = TOKES[2 * t], e1_ = TOKES[2 * t + 1]; r0[u] = rb[e0_ >> 15] + (e0_ & 32767); r1[u] = rb[e1_ >> 15] + (e1_ & 32767); } w0[u] = TOKW[2 * t]; w1[u] = TOKW[2 * t + 1];
#ifdef PROBE_MASK
                    if (a.probe_var == 4 || a.probe_var == -4) { w0[u] *= 0.5f; w1[u] *= 0.5f; }
#endif
                }
                f32x4 v[RJ][4]; u32x2 ya[RJ][4], yb[RJ][4];
#pragma unroll
                for (int u = 0; u < RJ; ++u)
#pragma unroll
                    for (int j = 0; j < 4; ++j) { const int col = 4 * lane + 256 * j; { const u32x2 xw = *(const u32x2*)(XB + (size_t)(t0 + u) * 1024 + col); v[u][j] = (f32x4){bflo(xw.x), bfhi(xw.x), bflo(xw.y), bfhi(xw.y)}; }
                        ya[u][j] = *(const u32x2*)(Y + (size_t)r0[u] * 1024 + col); yb[u][j] = *(const u32x2*)(Y + (size_t)r1[u] * 1024 + col); }
                f32x4 gg[4];
#pragma unroll
                for (int j = 0; j < 4; ++j) gg[j] = *(const f32x4*)(mo + 5120 + 4 * lane + 256 * j);
                float ss[RJ];
#pragma unroll
                for (int u = 0; u < RJ; ++u) { ss[u] = 0.f;
#pragma unroll
                    for (int j = 0; j < 4; ++j) { const int col = 4 * lane + 256 * j; const f32x4 xv = v[u][j]; f32x4 nv;
                        nv.x = xv.x + gg[j].x * (w0[u] * bflo(ya[u][j].x) + w1[u] * bflo(yb[u][j].x)); nv.y = xv.y + gg[j].y * (w0[u] * bfhi(ya[u][j].x) + w1[u] * bfhi(yb[u][j].x));
                        nv.z = xv.z + gg[j].z * (w0[u] * bflo(ya[u][j].y) + w1[u] * bflo(yb[u][j].y)); nv.w = xv.w + gg[j].w * (w0[u] * bfhi(ya[u][j].y) + w1[u] * bfhi(yb[u][j].y));
                        if (l + 1 < DEPTH) { u32x2 xw; xw.x = pk2(nv.x, nv.y); xw.y = pk2(nv.z, nv.w); *(u32x2*)(XB + (size_t)(t0 + u) * 1024 + col) = xw; nv = (f32x4){bflo(xw.x), bfhi(xw.x), bflo(xw.y), bfhi(xw.y)}; }
                        else *(f32x4*)(out + (size_t)(t0 + u) * 1024 + col) = nv;
                        v[u][j] = nv; ss[u] += (nv.x * nv.x + nv.y * nv.y) + (nv.z * nv.z + nv.w * nv.w); } }
                if (l + 1 < DEPTH) {
                    const float* mn = MOD + (size_t)((l + 1) * 2 + b) * 6144;
                    f32x4 sc1[4], sh1[4];
#pragma unroll
                    for (int j = 0; j < 4; ++j) { sc1[j] = *(const f32x4*)(mn + 1024 + 4 * lane + 256 * j); sh1[j] = *(const f32x4*)(mn + 4 * lane + 256 * j); }
#pragma unroll
                    for (int u = 0; u < RJ; ++u) { const float rn = rsqrtf(wave_sum(ss[u]) * (1.0f / 1024.0f) + EPS);
#pragma unroll
                        for (int j = 0; j < 4; ++j) { const int col = 4 * lane + 256 * j;
                            u32x2 w; w.x = pk2(v[u][j].x * rn * (1.f + sc1[j].x) + sh1[j].x, v[u][j].y * rn * (1.f + sc1[j].y) + sh1[j].y); w.y = pk2(v[u][j].z * rn * (1.f + sc1[j].z) + sh1[j].z, v[u][j].w * rn * (1.f + sc1[j].w) + sh1[j].w);
                            *(u32x2*)(H + (size_t)(t0 + u) * 1024 + col) = w; } }
                }
            }
        }
        PH_END();
    }
#undef PH_ON
#undef PH_END
}

extern "C" void kernel_launch(void* const* d_in, const int* in_sizes, int n_in, void* d_out, int out_size, void* d_ws, size_t ws_size, hipStream_t stream) {
    static int grid = 0;
    if (grid == 0) {
        if (n_in != 37 || out_size != T * D || ws_size < WS_END) { fprintf(stderr, "kernel_launch: unexpected shapes (n_in %d, out %d, ws %zu); nothing launched\n", n_in, out_size, ws_size); grid = -1; return; }
        int dev = 0, cus = 0, per_cu = 0;
        if (hipGetDevice(&dev) != hipSuccess || hipDeviceGetAttribute(&cus, hipDeviceAttributeMultiprocessorCount, dev) != hipSuccess) { grid = -1; return; }
        if (hipFuncSetAttribute((const void*)fwd, hipFuncAttributeMaxDynamicSharedMemorySize, LDS_BYTES) != hipSuccess) { fprintf(stderr, "kernel_launch: hipFuncSetAttribute failed\n"); grid = -1; return; }
        if (hipOccupancyMaxActiveBlocksPerMultiprocessor(&per_cu, (const void*)fwd, NTHREADS, LDS_BYTES) != hipSuccess || per_cu < 1) fprintf(stderr, "kernel_launch: occupancy query says %d\n", per_cu);
        (void)hipGetLastError();
        grid = cus;
    }
    if (grid < 0) return;
    if (hipMemsetAsync((char*)d_ws + WS_CTL, 0, CTL_ZERO_BYTES, stream) != hipSuccess) return;
    Args a{};
    for (int i = 0; i < 37; ++i) a.in[i] = d_in[i];
    a.out = (float*)d_out; a.ws = (unsigned char*)d_ws;
#ifdef PROBE_MASK
#ifndef PROBE_VAR
#define PROBE_VAR 0
#endif
    {
        int types[N_PHASES]; int n = 0; types[n++] = 0; types[n++] = 1; types[n++] = 2;
        for (int l = 0; l < DEPTH; ++l) { if ((l & 1) == 0) { for (int k = 3; k <= 7; ++k) if (k != 4 && k != 6) types[n++] = k; } else { for (int k = 8; k <= 13; ++k) if (k != 9) types[n++] = k; } for (int k = 14; k <= 19; ++k) if (k != 16) types[n++] = k; }
        for (int p = 0; p < N_PHASES; ++p) { a.ph_lo = p; a.ph_hi = p + 1; const int reps = ((PROBE_MASK >> types[p]) & 1) ? 2 : 1;
            for (int r = 0; r < reps; ++r) { a.probe_var = (reps == 2) ? ((r == 0) ? PROBE_VAR : -PROBE_VAR) : 0; hipLaunchKernelGGL(fwd, dim3(grid), dim3(NTHREADS), LDS_BYTES, stream, a); } }
    }
#elif MK_ONE_LAUNCH
    a.ph_lo = 0; a.ph_hi = N_PHASES;
    hipLaunchKernelGGL(fwd, dim3(grid), dim3(NTHREADS), LDS_BYTES, stream, a);
#else
    for (int p = 0; p < N_PHASES; ++p) { a.ph_lo = p; a.ph_hi = p + 1; hipLaunchKernelGGL(fwd, dim3(grid), dim3(NTHREADS), LDS_BYTES, stream, a); }
#endif
}
```

```cpp
#include <hip/hip_runtime.h>
#include <cstdio>
#include <cstdint>
#include <hip/hip_bf16.h>
#include <cmath>
#ifndef MK_ONE_LAUNCH
#define MK_ONE_LAUNCH 1
#endif
namespace pg8 {
#define PG8_LAS __attribute__((address_space(3)))
typedef unsigned short bf16_t;
typedef short bf16x8 __attribute__((ext_vector_type(8)));
typedef float f32x4 __attribute__((ext_vector_type(4)));
typedef unsigned u32x4 __attribute__((ext_vector_type(4)));
constexpr int BM = 256, BK = 64, HALF = 128, HTB = HALF * BK * 2  , STAGE_BYTES = 8 * HTB, NXCD = 8, WGM = 8;

__host__ __device__ __forceinline__ int lds_byte(int r, int c) { const int st = (r >> 4) * 2 + (c >> 5), rr = r & 15, cc = c & 31, ob = rr * 64 + cc * 2; return st * 1024 + (ob ^ (((ob >> 9) & 1) << 5)); }
__host__ __device__ __forceinline__ void stage_rc(int b, int& R, int& C) { const int st = b / 1024, sb = b % 1024, swz = sb ^ (((sb >> 9) & 1) << 5); R = (st >> 1) * 16 + swz / 64; C = (st & 1) * 32 + (swz % 64) / 2; }
__host__ __device__ __forceinline__ int perm32(int rho) { const int n = rho >> 4, i = rho & 15; return 8 * (i >> 2) + 4 * n + (i & 3); }

struct Unit { int pm, pn, be; };
struct Gemm { const bf16_t* A; const bf16_t* Bt; int M, N, K; size_t bstride; };

struct StaticOrder {
    int nM, nN, nwg, G, c;
    __host__ __device__ void init(int M, int N, int G_, int c_) { nM = M / BM; nN = N / BM; nwg = nM * nN; G = G_; c = c_; }
    __host__ __device__ bool next(int i, Unit& u) const {
        const long L = (long)i * G + c; if (L >= nwg) return false;
        int wgid = (int)L; { const int q = nwg / NXCD, r = nwg % NXCD, xcd = wgid % NXCD, off = wgid / NXCD; wgid = (xcd < r ? xcd * (q + 1) : r * (q + 1) + (xcd - r) * q) + off; }
        const int nig = WGM * nN, gid = wgid / nig, fm = gid * WGM, gsz = (nM - fm) < WGM ? (nM - fm) : WGM;
        u.pm = fm + ((wgid % nig) % gsz); u.pn = (wgid % nig) / gsz; u.be = 0; return true;
    }
    __device__ __forceinline__ void a_ready(const Unit&) const {}
    __device__ __forceinline__ void done(const Unit&) const {}
};

__device__ __forceinline__ unsigned cvt_pk_bf16(float lo, float hi) { unsigned r; asm volatile("v_cvt_pk_bf16_f32 %0, %1, %2" : "=v"(r) : "v"(lo), "v"(hi)); return r; }
typedef float f32x2 __attribute__((ext_vector_type(2)));
struct NoRows { static constexpr bool GATHER = false; __device__ __forceinline__ unsigned operator()(const Unit&, int) const { return 0u; } };
template <class Epi, class Sched, bool ALIGN_EPI = false, bool SP2 = false, class Rows = NoRows>
__device__ __forceinline__ void gemm_phase(PG8_LAS unsigned char* lds, const Gemm g, const Sched& S, const Epi& E, const int tid_in, const Rows& RW = Rows()) {
    const int tid = tid_in, wid = __builtin_amdgcn_readfirstlane(tid >> 6), lane = tid & 63, wr = wid >> 2, wc = wid & 3, fr = lane & 15, fq = lane >> 4;
    const int K = g.K, nt = K / BK;
    unsigned voffA[2], voffB[2];
#pragma unroll
    for (int i = 0; i < 2; ++i) { int R, C; stage_rc(tid * 16 + i * 8192, R, C); const int Rb = Epi::PERM ? ((R & ~31) + perm32(R & 31)) : R;
        voffA[i] = (unsigned)(R * K + C) * 2u; voffB[i] = (unsigned)(Rb * K + C) * 2u; }
    const size_t kstep = (size_t)(BK * 2);
    const size_t hstep = (size_t)HALF * K * 2;
    const size_t tstep = 2 * hstep;
    const unsigned ldsw = (unsigned)wid * 1024u;
    const int aoff = lds_byte(wr * 64 + fr, fq * 8), boff = lds_byte(wc * 32 + fr, fq * 8);
#define PG8_SA(b, h) (((b) * 2 + (h)) * HTB)
#define PG8_SB(b, h) ((4 + (b) * 2 + (h)) * HTB)
#define PG8_STAGE(bufoff, gbase, voff) do { _Pragma("unroll") for (int _i = 0; _i < 2; ++_i) \
        __builtin_amdgcn_global_load_lds((const unsigned*)((const char*)(gbase) + (voff)[_i]), (PG8_LAS unsigned*)(lds + (bufoff) + ldsw + _i * 8192), 16, 0, 0); } while (0)
#define PG8_LDA(dst, b, h) do { _Pragma("unroll") for (int m = 0; m < 4; ++m) _Pragma("unroll") for (int k = 0; k < 2; ++k) dst[m][k] = *(const PG8_LAS bf16x8*)(lds + PG8_SA(b, h) + aoff + m * 2048 + k * 1024); } while (0)
#define PG8_LDB(dst, b, h) do { _Pragma("unroll") for (int n = 0; n < 2; ++n) _Pragma("unroll") for (int k = 0; k < 2; ++k) dst[n][k] = *(const PG8_LAS bf16x8*)(lds + PG8_SB(b, h) + boff + n * 2048 + k * 1024); } while (0)
#define PG8_MMA(ai, bj, At, Bt) do { __builtin_amdgcn_s_setprio(1); _Pragma("unroll") for (int m = 0; m < 4; ++m) _Pragma("unroll") for (int n = 0; n < 2; ++n) _Pragma("unroll") for (int k = 0; k < 2; ++k) \
        acc[ai][bj][m][n] = __builtin_amdgcn_mfma_f32_16x16x32_bf16(Bt[n][k], At[m][k], acc[ai][bj][m][n], 0, 0, 0); __builtin_amdgcn_s_setprio(0); } while (0)
#define PG8_WAIT_V(n) asm volatile("s_waitcnt vmcnt(" #n ")" ::: "memory")
#define PG8_WAIT_L(n) asm volatile("s_waitcnt lgkmcnt(" #n ")" ::: "memory")
#define PG8_BAR __builtin_amdgcn_s_barrier()
#define PG8_SCHED __builtin_amdgcn_sched_barrier(0)
    Unit cur, nxt; int ui = 0;
    if (!S.next(0, cur)) return;
    f32x4 acc[2][2][4][2];
#pragma unroll
    for (int a = 0; a < 2; ++a)
#pragma unroll
        for (int b = 0; b < 2; ++b)
#pragma unroll
            for (int m = 0; m < 4; ++m)
#pragma unroll
                for (int n = 0; n < 2; ++n) { float z0_ = 0.f; asm volatile("" : "+v"(z0_)); acc[a][b][m][n] = (f32x4){z0_, z0_, z0_, z0_}; }
    bf16x8 At[4][2], B0[2][2], B1[2][2];
    const char* cA = Rows::GATHER ? (const char*)g.A : (const char*)g.A + (size_t)cur.pm * tstep; const char* cB = (const char*)g.Bt + (size_t)cur.be * g.bstride + (size_t)cur.pn * tstep;
    int Rr[2], Cc[2];
#pragma unroll
    for (int i = 0; i < 2; ++i) stage_rc(tid * 16 + i * 8192, Rr[i], Cc[i]);
    unsigned voffAh[2][2], voffAn[2][2];
#pragma unroll
    for (int h = 0; h < 2; ++h)
#pragma unroll
        for (int i = 0; i < 2; ++i) { voffAh[h][i] = Rows::GATHER ? RW(cur, h * HALF + Rr[i]) + (unsigned)Cc[i] * 2u : voffA[i] + (unsigned)h * (unsigned)hstep; voffAn[h][i] = voffAh[h][i]; }
    S.a_ready(cur);
    if constexpr (SP2) {
        PG8_STAGE(PG8_SB(0, 0), cB, voffB); PG8_STAGE(PG8_SB(0, 1), cB + hstep, voffB); PG8_STAGE(PG8_SA(0, 0), cA, voffAh[0]); PG8_STAGE(PG8_SA(0, 1), cA, voffAh[1]);
        if (wr == 1) PG8_BAR;
        PG8_WAIT_V(2); PG8_BAR;
        PG8_STAGE(PG8_SB(1, 0), cB + kstep, voffB); PG8_STAGE(PG8_SA(1, 0), cA + kstep, voffAh[0]); PG8_STAGE(PG8_SB(1, 1), cB + hstep + kstep, voffB);
        PG8_WAIT_V(6); PG8_BAR;
    } else {
        PG8_STAGE(PG8_SB(0, 0), cB, voffB); PG8_STAGE(PG8_SA(0, 0), cA, voffAh[0]); PG8_STAGE(PG8_SB(0, 1), cB + hstep, voffB); PG8_STAGE(PG8_SA(0, 1), cA, voffAh[1]);
        if (wr == 1) PG8_BAR;
        PG8_WAIT_V(4); PG8_BAR;
        PG8_STAGE(PG8_SB(1, 0), cB + kstep, voffB); PG8_STAGE(PG8_SA(1, 0), cA + kstep, voffAh[0]); PG8_STAGE(PG8_SB(1, 1), cB + hstep + kstep, voffB);
        PG8_WAIT_V(6); PG8_BAR;
    }
    for (;;) {
        const bool has_next = S.next(ui + 1, nxt);
        const char* nA = Rows::GATHER ? (const char*)g.A : (has_next ? (const char*)g.A + (size_t)nxt.pm * tstep : cA);
        if constexpr (Rows::GATHER) { if (has_next) {
#pragma unroll
            for (int h = 0; h < 2; ++h)
#pragma unroll
                for (int i = 0; i < 2; ++i) voffAn[h][i] = RW(nxt, h * HALF + Rr[i]) + (unsigned)Cc[i] * 2u; } } const char* nB = has_next ? (const char*)g.Bt + (size_t)nxt.be * g.bstride + (size_t)nxt.pn * tstep : cB;
        for (int t = 0; t < nt; t += 2) {
            const bool last = (t == nt - 2); const bool gsel = Rows::GATHER && last && has_next;
            const char* a1 = cA + (size_t)(t + 1) * kstep;
            const char* a2 = last ? nA : cA + (size_t)(t + 2) * kstep; const char* b2 = last ? nB : cB + (size_t)(t + 2) * kstep;
            const char* a3 = a2 + kstep; const char* b3 = b2 + kstep;
            if (last && has_next) S.a_ready(nxt);
            if constexpr (SP2) {
            PG8_LDB(B0, 0, 0); PG8_LDB(B1, 0, 1); PG8_SCHED; PG8_LDA(At, 0, 0); PG8_STAGE(PG8_SA(1, 1), a1, voffAh[1]);
            PG8_WAIT_V(8); PG8_WAIT_L(0); PG8_BAR; PG8_MMA(0, 0, At, B0); PG8_MMA(0, 1, At, B1); PG8_BAR; PG8_SCHED;
            PG8_LDA(At, 0, 1); PG8_STAGE(PG8_SB(0, 0), b2, voffB); PG8_STAGE(PG8_SB(0, 1), b2 + hstep, voffB); PG8_STAGE(PG8_SA(0, 0), a2, (gsel ? voffAn[0] : voffAh[0]));
            PG8_WAIT_V(8); PG8_WAIT_L(0); PG8_BAR; PG8_MMA(1, 0, At, B0); PG8_MMA(1, 1, At, B1); PG8_BAR; PG8_SCHED;
            PG8_LDB(B0, 1, 0); PG8_LDB(B1, 1, 1); PG8_SCHED; PG8_LDA(At, 1, 0); PG8_STAGE(PG8_SA(0, 1), a2, (gsel ? voffAn[1] : voffAh[1]));
            PG8_WAIT_V(8); PG8_WAIT_L(0); PG8_BAR; PG8_MMA(0, 0, At, B0); PG8_MMA(0, 1, At, B1); PG8_BAR; PG8_SCHED;
            PG8_LDA(At, 1, 1); PG8_STAGE(PG8_SB(1, 0), b3, voffB); PG8_STAGE(PG8_SB(1, 1), b3 + hstep, voffB); PG8_STAGE(PG8_SA(1, 0), a3, (gsel ? voffAn[0] : voffAh[0]));
            PG8_WAIT_V(8); PG8_WAIT_L(0); PG8_BAR; PG8_MMA(1, 0, At, B0); PG8_MMA(1, 1, At, B1); PG8_BAR; PG8_SCHED;
            } else {
            PG8_LDB(B0, 0, 0); PG8_SCHED; PG8_LDA(At, 0, 0); PG8_STAGE(PG8_SA(1, 1), a1, voffAh[1]);
            PG8_WAIT_L(8); PG8_BAR; PG8_WAIT_L(0); PG8_MMA(0, 0, At, B0); PG8_BAR; PG8_SCHED;
            PG8_LDB(B1, 0, 1); PG8_STAGE(PG8_SB(0, 0), b2, voffB);
            PG8_BAR; PG8_WAIT_L(0); PG8_MMA(0, 1, At, B1); PG8_BAR;
            PG8_LDA(At, 0, 1); PG8_STAGE(PG8_SA(0, 0), a2, (gsel ? voffAn[0] : voffAh[0]));
            PG8_BAR; PG8_WAIT_L(0); PG8_MMA(1, 0, At, B0); PG8_BAR; PG8_SCHED;
            PG8_STAGE(PG8_SB(0, 1), b2 + hstep, voffB);
            PG8_WAIT_V(6); PG8_BAR; PG8_MMA(1, 1, At, B1); PG8_BAR;
            PG8_LDB(B0, 1, 0); PG8_SCHED; PG8_LDA(At, 1, 0); PG8_STAGE(PG8_SA(0, 1), a2, (gsel ? voffAn[1] : voffAh[1]));
            PG8_WAIT_L(8); PG8_BAR; PG8_WAIT_L(0); PG8_MMA(0, 0, At, B0); PG8_BAR; PG8_SCHED;
            PG8_LDB(B1, 1, 1); PG8_STAGE(PG8_SB(1, 0), b3, voffB);
            PG8_BAR; PG8_WAIT_L(0); PG8_MMA(0, 1, At, B1); PG8_BAR;
            PG8_LDA(At, 1, 1); PG8_STAGE(PG8_SA(1, 0), a3, (gsel ? voffAn[0] : voffAh[0]));
            PG8_BAR; PG8_WAIT_L(0); PG8_MMA(1, 0, At, B0); PG8_BAR; PG8_SCHED;
            PG8_STAGE(PG8_SB(1, 1), b3 + hstep, voffB);
            PG8_WAIT_V(6); PG8_BAR; PG8_MMA(1, 1, At, B1); PG8_BAR;
            }
        }
        if constexpr (ALIGN_EPI) { if (wr == 0) PG8_BAR; }
        if constexpr (!Epi::AFTER_DRAIN) { int l2_; asm volatile("v_mbcnt_lo_u32_b32 %0, -1, 0\n\tv_mbcnt_hi_u32_b32 %0, -1, %0" : "=v"(l2_)); E(acc, cur, wr, wc, l2_ & 15, l2_ >> 4); S.done(cur); }
        if (!has_next) break;
#pragma unroll
        for (int a = 0; a < 2; ++a)
#pragma unroll
            for (int b = 0; b < 2; ++b)
#pragma unroll
                for (int m = 0; m < 4; ++m)
#pragma unroll
                    for (int n = 0; n < 2; ++n) { float z0_ = 0.f; asm volatile("" : "+v"(z0_)); acc[a][b][m][n] = (f32x4){z0_, z0_, z0_, z0_}; }
        cur = nxt; cA = nA; cB = nB; ++ui;
        if constexpr (Rows::GATHER) {
#pragma unroll
            for (int h = 0; h < 2; ++h)
#pragma unroll
                for (int i = 0; i < 2; ++i) voffAh[h][i] = voffAn[h][i]; }
        if constexpr (ALIGN_EPI) { if (wr == 1) PG8_BAR; }
    }
    PG8_WAIT_V(0);
    if constexpr (!ALIGN_EPI) { if (wr == 0) PG8_BAR; }
    PG8_BAR;
    if constexpr (Epi::AFTER_DRAIN) { E.fused(acc, cur, wr, wc, fr, fq, lds, wid, lane); S.done(cur); }
#undef PG8_SA
#undef PG8_SB
#undef PG8_STAGE
#undef PG8_LDA
#undef PG8_LDB
#undef PG8_MMA
#undef PG8_WAIT_V
#undef PG8_WAIT_L
#undef PG8_BAR
#undef PG8_SCHED
}
}
namespace attn_body {
using bf16=__hip_bfloat16;
using bf16x8=__attribute__((ext_vector_type(8)))short;
using s16x4=__attribute__((ext_vector_type(4)))short;
using f32x16=__attribute__((ext_vector_type(16)))float;
using u32x4=__attribute__((ext_vector_type(4)))unsigned;
constexpr int D=64;
constexpr int NW=8,QBLK=32,QB=QBLK*NW,KVBLK=64;
constexpr int ATTN_UNIT_ROWS=QB;
__device__ __forceinline__ int crow(int r,int hi){return (r&3)+8*(r>>2)+4*hi;}
#define SBAR() __builtin_amdgcn_sched_barrier(0)
__device__ __forceinline__ void cmask(f32x16&p0,f32x16&p1,int jb,int qrel,int hi){
  const float NEG=-INFINITY; int kb=64*jb+4*hi;
  #pragma unroll
  for(int r=0;r<16;++r){int kv=kb+(r&3)+8*(r>>2); if(kv>qrel)p0[r]=NEG; if(kv+32>qrel)p1[r]=NEG;}
}

constexpr int NSLOT=3, SLOTB=8192;
constexpr int LDS_K=0, LDS_V=NSLOT*SLOTB, LDS_WS=2*NSLOT*SLOTB, LDS_OST=LDS_WS+NW*64*4, LDS_BYTES=LDS_OST+NW*4096;
constexpr float C2=0.125f*1.4426950408889634f;
__device__ __forceinline__ void glds16(const void*gsrc,unsigned lds_dst){unsigned keep;
  asm volatile("s_mov_b32 %0, m0\n\ts_mov_b32 m0, %2\n\ts_nop 0\n\tglobal_load_lds_dwordx4 %1, off\n\ts_mov_b32 m0, %0":"=&s"(keep):"v"(gsrc),"s"(lds_dst):"memory");}
__device__ __forceinline__ float max3f(float a,float b,float c){float r;asm("v_max3_f32 %0, %1, %2, %3":"=v"(r):"v"(a),"v"(b),"v"(c));return r;}
__device__ __forceinline__ float max2f(float a,float b){float r;asm("v_max_f32_e32 %0, %1, %2":"=v"(r):"v"(a),"v"(b));return r;}
__device__ __forceinline__ float fadd_s(float a,float b){float r;asm("v_add_f32_e32 %0, %1, %2":"=v"(r):"v"(a),"v"(b));return r;}
__device__ __forceinline__ float fsub_s(float a,float b){float r;asm("v_sub_f32_e32 %0, %1, %2":"=v"(r):"v"(a),"v"(b));return r;}
typedef float f32x2_t __attribute__((ext_vector_type(2))); typedef __bf16 bf16x2_t __attribute__((ext_vector_type(2)));
__device__ __forceinline__ unsigned cvtpk_s(float lo,float hi){f32x2_t v={lo,hi};bf16x2_t b=__builtin_convertvector(v,bf16x2_t);return __builtin_bit_cast(unsigned,b);}
#define WAIT_BAR(N) asm volatile("s_waitcnt vmcnt(" #N ") lgkmcnt(0)\n\ts_barrier":::"memory")

__device__ __forceinline__ void qkt(f32x16&p0,f32x16&p1,const char*Kslot,const bf16x8*qr,const f32x16&negm,int r32,int hi){
  const char*kb=Kslot+hi*1024+r32*16;
  #pragma unroll
  for(int d0=0;d0<4;++d0){
    const bf16x8 b0=*reinterpret_cast<const bf16x8*>(kb+d0*2048);
    const bf16x8 b1=*reinterpret_cast<const bf16x8*>(kb+d0*2048+512);
    if(d0==0){p0=__builtin_amdgcn_mfma_f32_32x32x16_bf16(b0,qr[0],negm,0,0,0);p1=__builtin_amdgcn_mfma_f32_32x32x16_bf16(b1,qr[0],negm,0,0,0);}
    else{p0=__builtin_amdgcn_mfma_f32_32x32x16_bf16(b0,qr[d0],p0,0,0,0);p1=__builtin_amdgcn_mfma_f32_32x32x16_bf16(b1,qr[d0],p1,0,0,0);}}
}
typedef __attribute__((address_space(3))) const char* lds_cptr;
typedef short v4i16_t __attribute__((ext_vector_type(4)));
__device__ __forceinline__ void kload8(bf16x8*kf,lds_cptr kp){
  kf[0]=*(const __attribute__((address_space(3))) bf16x8*)(kp);      kf[1]=*(const __attribute__((address_space(3))) bf16x8*)(kp+512);
  kf[2]=*(const __attribute__((address_space(3))) bf16x8*)(kp+2048); kf[3]=*(const __attribute__((address_space(3))) bf16x8*)(kp+2560);
  kf[4]=*(const __attribute__((address_space(3))) bf16x8*)(kp+4096); kf[5]=*(const __attribute__((address_space(3))) bf16x8*)(kp+4608);
  kf[6]=*(const __attribute__((address_space(3))) bf16x8*)(kp+6144); kf[7]=*(const __attribute__((address_space(3))) bf16x8*)(kp+6656);
}
__device__ __forceinline__ void kload2(bf16x8*kf,lds_cptr kp,int j){ kf[2*j]=*(const __attribute__((address_space(3))) bf16x8*)(kp+j*2048); kf[2*j+1]=*(const __attribute__((address_space(3))) bf16x8*)(kp+j*2048+512); }
__device__ __forceinline__ s16x4 vtr(lds_cptr p){ return __builtin_bit_cast(s16x4,__builtin_amdgcn_ds_read_tr16_b64_v4i16((__attribute__((address_space(3))) v4i16_t*)p)); }
__device__ __forceinline__ float rowmax(const f32x16&p0,const f32x16&p1){
  float a=max3f(p0[0],p0[1],p1[0]),b=max3f(p0[2],p0[3],p1[1]);a=max3f(a,p1[2],p1[3]);
  #pragma unroll
  for(int r=4;r<16;r+=4){a=max3f(a,p0[r],p0[r+1]);b=max3f(b,p0[r+2],p0[r+3]);a=max3f(a,p1[r],p1[r+1]);b=max3f(b,p1[r+2],p1[r+3]);}
  const float m=max2f(a,b);
  auto rr=__builtin_amdgcn_permlane32_swap(__float_as_uint(m),__float_as_uint(m),false,false);
  return max2f(__uint_as_float(rr[0]),__uint_as_float(rr[1]));
}
__device__ __forceinline__ void pv(f32x16*o,int vb,bf16x8 pa0,bf16x8 pa1,bf16x8 pa2,bf16x8 pa3){
  #pragma unroll
  for(int d0=0;d0<2;++d0){s16x4 lo[4],hi[4];
    #pragma unroll
    for(int ks=0;ks<4;++ks){
      asm volatile("ds_read_b64_tr_b16 %0,%1 offset:%c2":"=&v"(lo[ks]):"v"(vb),"i"(d0*4096+ks*1024):"memory");
      asm volatile("ds_read_b64_tr_b16 %0,%1 offset:%c2":"=&v"(hi[ks]):"v"(vb),"i"(d0*4096+ks*1024+512):"memory");}
    asm volatile("s_waitcnt lgkmcnt(0)":::"memory");SBAR();
    #define PK(k) (bf16x8){lo[k][0],lo[k][1],lo[k][2],lo[k][3],hi[k][0],hi[k][1],hi[k][2],hi[k][3]}
    o[d0]=__builtin_amdgcn_mfma_f32_32x32x16_bf16(pa0,PK(0),o[d0],0,0,0);
    o[d0]=__builtin_amdgcn_mfma_f32_32x32x16_bf16(pa1,PK(1),o[d0],0,0,0);
    o[d0]=__builtin_amdgcn_mfma_f32_32x32x16_bf16(pa2,PK(2),o[d0],0,0,0);
    o[d0]=__builtin_amdgcn_mfma_f32_32x32x16_bf16(pa3,PK(3),o[d0],0,0,0);
    #undef PK
  }
}

#ifndef ATTN_STORE16
#define ATTN_STORE16(p,v) (*(u32x4*)(p)=(v))
#endif
template<int THRL,int PIN,int POUT> __device__ __forceinline__ void attn_unit(int qb,const bf16*Qh,const bf16*__restrict__ Kh,const bf16*__restrict__ Vh,bf16*Oh,char*shm,const int wid_in){
  constexpr int DM=PIN;
  int lane; asm volatile("v_mbcnt_lo_u32_b32 %0, -1, 0\n\tv_mbcnt_hi_u32_b32 %0, -1, %0" : "=v"(lane));
  const int wid=wid_in; const int tid=wid*64+lane; const int r32=lane&31,hi=lane>>5;
  const int q0=qb*QB;
  const bf16*Qw=Qh+(long)(q0+wid*QBLK)*DM;
  const unsigned lds0=(unsigned)(uintptr_t)shm;
  float*wsf=(float*)(shm+LDS_WS)+wid*64;
  const bf16*ksrc=Kh+(long)lane*DM+wid*8;
  const bf16*vsrc=Vh+(long)(16*(wid&3)+(lane>>2))*DM+(wid>>2)*32+(lane&3)*8;
  const unsigned kdst=lds0+LDS_K+wid*1024, vdst=lds0+LDS_V+wid*1024;
  #define DMA_K(t,slot) glds16(ksrc+(long)(t)*KVBLK*DM,(unsigned)__builtin_amdgcn_readfirstlane(kdst+(slot)))
  #define DMA_V(t,slot) glds16(vsrc+(long)(t)*KVBLK*DM,(unsigned)__builtin_amdgcn_readfirstlane(vdst+(slot)))
  const int vb0=(int)(lds0+LDS_V)+((lane>>4)&1)*32+(lane&3)*8+(4*hi+((lane&15)>>2))*64;
  const char*Kbase=shm+LDS_K; bf16x8 kf[8];
  const lds_cptr shm3=(lds_cptr)shm; const lds_cptr kp0=shm3+LDS_K+hi*1024+r32*16; const lds_cptr vp0=shm3+LDS_V+((lane>>4)&1)*32+(lane&3)*8+(4*hi+((lane&15)>>2))*64;
  const int NT=(q0+QB)/KVBLK;
  DMA_K(0,0);DMA_V(0,0);DMA_K(1,SLOTB);
  bf16x8 qr[4];
  #pragma unroll
  for(int d0=0;d0<4;++d0)qr[d0]=*reinterpret_cast<const bf16x8*>(&Qw[(long)r32*DM+d0*16+hi*8]);
  float mhat=0.f,l_reg=0.f;f32x16 o[2];f32x16 negm;{float z0_=0.f;asm volatile("":"+v"(z0_));
  #pragma unroll
  for(int r=0;r<16;++r){o[0][r]=z0_;o[1][r]=z0_;negm[r]=z0_;}}asm volatile("":"+v"(negm));
  const int qrel=wid*QBLK+r32;
  #define CMASK(P0,P1,t) do{int jb_=(t)-(NT-4); if(jb_>=0)cmask(P0,P1,jb_,qrel,hi);}while(0)
  bool resc=false;
  #define START(P0,P1) do{ const float rm=rowmax(P0,P1); resc=false; \
    { const float dl=rm; mhat=fadd_s(mhat,dl); \
      _Pragma("unroll") for(int r=0;r<16;++r){P0[r]=fsub_s(P0[r],dl);P1[r]=fsub_s(P1[r],dl);} \
      _Pragma("unroll") for(int r=0;r<16;++r)negm[r]=-mhat; asm volatile("":"+v"(negm)); } \
    _Pragma("unroll") for(int r=0;r<16;++r)P0[r]=__builtin_amdgcn_exp2f(P0[r]); }while(0)
  #define RESC() do{ if(resc){ asm volatile("s_waitcnt lgkmcnt(0)":::"memory"); \
      _Pragma("unroll") for(int d_=0;d_<2;++d_) _Pragma("unroll") for(int r=0;r<16;++r)o[d_][r]*=wsf[crow(r,hi)]; } }while(0)
  f32x16 pA0,pA1,pB0,pB1;
  int sl_prev=0,sl_cur=0,sl_next=SLOTB;
  #define ROT() do{sl_prev=sl_cur;sl_cur=sl_next;sl_next=(sl_next==(NSLOT-1)*SLOTB)?0:sl_next+SLOTB;}while(0)
  DMA_K(2,2*SLOTB);
  WAIT_BAR(3);
  qkt(pA0,pA1,Kbase,qr,negm,r32,hi);asm volatile("s_nop 15\n\ts_nop 7":"+v"(pA0),"+v"(pA1));CMASK(pA0,pA1,0);
  START(pA0,pA1);
  _Pragma("unroll") for(int r=0;r<16;++r)pA1[r]=__builtin_amdgcn_exp2f(pA1[r]);
  WAIT_BAR(0);
  DMA_K(3,0);DMA_V(1,SLOTB);
  ROT();
  kload8(kf,kp0+sl_cur);
  WAIT_BAR(2);
  s16x4 vlo[8],vhi[8]; u32x4 pw0,pw1,pw2,pw3;
  #define PKW(P,B) cvtpk_s(P[B],P[B+1])
  #define PAF(k) __builtin_bit_cast(bf16x8,pw##k)
  #define VFR(i) (bf16x8){vlo[i][0],vlo[i][1],vlo[i][2],vlo[i][3],vhi[i][0],vhi[i][1],vhi[i][2],vhi[i][3]}
  #define PIN(x) asm volatile("":"+v"(x))
  #define MX3(a,b,c) __builtin_fmaxf(__builtin_fmaxf((a),(b)),(c))
  #define GAPA(MF,A0,A1,A2,A3,W0,W1,PW) do{ MF; sacc+=A0; sacc+=A1; sacc+=A2; sacc+=A3; PIN(sacc); W0; W1; PIN(PW); SBAR(); }while(0)
  #define EX(v) __builtin_amdgcn_exp2f(v)
  #define GAPB(MF,X,B) do{ MF; X[B]=EX(X[B]); X[B+1]=EX(X[B+1]); X[B+2]=EX(X[B+2]); X[B+3]=EX(X[B+3]); PIN(X); SBAR(); }while(0)
  #define VRD(i) do{ vlo[i]=vtr(vp_+(((i)>>2)*4096+((i)&3)*1024)); vhi[i]=vtr(vp_+(((i)>>2)*4096+((i)&3)*1024+512)); }while(0)
  #define KRD(G,j) do{ if(G){ kload2(kf,kp0+sl_next,j); SBAR(); } }while(0)
  #define STEP(C0,C1,P0,P1,t,GK,GV,GL) do{ SBAR(); \
    const lds_cptr vp_=vp0+sl_prev; \
    VRD(0); SBAR(); float sacc=(P0[0]+P0[1]); \
    GAPA(C0=__builtin_amdgcn_mfma_f32_32x32x16_bf16(kf[0],qr[0],negm,0,0,0), P0[2],P0[3],P0[4],P0[5],     pw0[0]=PKW(P0,0), pw0[1]=PKW(P0,2), pw0); \
    VRD(4); SBAR(); GAPA(C1=__builtin_amdgcn_mfma_f32_32x32x16_bf16(kf[1],qr[0],negm,0,0,0), P0[6],P0[7],P0[8],P0[9],     pw0[2]=PKW(P0,4), pw0[3]=PKW(P0,6), pw0); \
    VRD(1); SBAR(); GAPA(C0=__builtin_amdgcn_mfma_f32_32x32x16_bf16(kf[2],qr[1],C0,0,0,0),   P0[10],P0[11],P0[12],P0[13], pw1[0]=PKW(P0,8), pw1[1]=PKW(P0,10), pw1); \
    VRD(5); SBAR(); GAPA(C1=__builtin_amdgcn_mfma_f32_32x32x16_bf16(kf[3],qr[1],C1,0,0,0),   P0[14],P0[15],P1[0],P1[1],   pw1[2]=PKW(P0,12),pw1[3]=PKW(P0,14), pw1); \
    VRD(2); SBAR(); GAPA(C0=__builtin_amdgcn_mfma_f32_32x32x16_bf16(kf[4],qr[2],C0,0,0,0),   P1[2],P1[3],P1[4],P1[5],     pw2[0]=PKW(P1,0), pw2[1]=PKW(P1,2), pw2); \
    VRD(6); SBAR(); GAPA(C1=__builtin_amdgcn_mfma_f32_32x32x16_bf16(kf[5],qr[2],C1,0,0,0),   P1[6],P1[7],P1[8],P1[9],     pw2[2]=PKW(P1,4), pw2[3]=PKW(P1,6), pw2); \
    VRD(3); SBAR(); GAPA(C0=__builtin_amdgcn_mfma_f32_32x32x16_bf16(kf[6],qr[3],C0,0,0,0),   P1[10],P1[11],P1[12],P1[13], pw3[0]=PKW(P1,8), pw3[1]=PKW(P1,10), pw3); \
    VRD(7); SBAR(); GAPA(C1=__builtin_amdgcn_mfma_f32_32x32x16_bf16(kf[7],qr[3],C1,0,0,0),   P1[14],P1[15],0.f,0.f,       pw3[2]=PKW(P1,12),pw3[3]=PKW(P1,14), pw3); \
    l_reg+=sacc; \
    if(GK){DMA_K((t)+3,sl_cur);} if(GV){DMA_V((t)+1,sl_next);} \
    CMASK(C0,C1,t); \
    { float a=MX3(C0[0],C0[1],C1[0]),b=MX3(C0[2],C0[3],C1[1]); a=MX3(a,C1[2],C1[3]); \
      _Pragma("unroll") for(int r=4;r<16;r+=4){a=MX3(a,C0[r],C0[r+1]);b=MX3(b,C0[r+2],C0[r+3]);a=MX3(a,C1[r],C1[r+1]);b=MX3(b,C1[r+2],C1[r+3]);} \
      float rm=__builtin_fmaxf(a,b); { auto rr=__builtin_amdgcn_permlane32_swap(__float_as_uint(rm),__float_as_uint(rm),false,false); rm=__builtin_fmaxf(__uint_as_float(rr[0]),__uint_as_float(rr[1])); } \
      resc=false; \
      if(__builtin_expect(__any(rm>(float)THRL),0)){ const float dl=__builtin_fmaxf(rm,0.f); mhat+=dl; \
        _Pragma("unroll") for(int r=0;r<16;++r){C0[r]-=dl;C1[r]-=dl;} \
        _Pragma("unroll") for(int r=0;r<16;++r)negm[r]=-mhat; asm volatile("":"+v"(negm)); \
        const float f=__builtin_amdgcn_exp2f(-dl); l_reg*=f; if(hi==0)wsf[r32]=f; resc=true; } } \
    SBAR(); \
    GAPB(o[0]=__builtin_amdgcn_mfma_f32_32x32x16_bf16(PAF(0),VFR(0),o[0],0,0,0), C0,0); \
    GAPB(o[1]=__builtin_amdgcn_mfma_f32_32x32x16_bf16(PAF(0),VFR(4),o[1],0,0,0), C0,4); \
    KRD(GL,0); GAPB(o[0]=__builtin_amdgcn_mfma_f32_32x32x16_bf16(PAF(1),VFR(1),o[0],0,0,0), C0,8); \
    KRD(GL,1); GAPB(o[1]=__builtin_amdgcn_mfma_f32_32x32x16_bf16(PAF(1),VFR(5),o[1],0,0,0), C0,12); \
    KRD(GL,2); GAPB(o[0]=__builtin_amdgcn_mfma_f32_32x32x16_bf16(PAF(2),VFR(2),o[0],0,0,0), C1,0); \
    KRD(GL,3); GAPB(o[1]=__builtin_amdgcn_mfma_f32_32x32x16_bf16(PAF(2),VFR(6),o[1],0,0,0), C1,4); \
    GAPB(o[0]=__builtin_amdgcn_mfma_f32_32x32x16_bf16(PAF(3),VFR(3),o[0],0,0,0), C1,8); \
    GAPB(o[1]=__builtin_amdgcn_mfma_f32_32x32x16_bf16(PAF(3),VFR(7),o[1],0,0,0), C1,12); \
    }while(0)
  int t=1;
  #undef CMASK
  #define CMASK(P0,P1,t) do{}while(0)
  for(;t+5<NT;t+=2){
    STEP(pB0,pB1,pA0,pA1,t,true,true,true);     WAIT_BAR(2); RESC(); ROT();
    STEP(pA0,pA1,pB0,pB1,t+1,true,true,true);   WAIT_BAR(2); RESC(); ROT();
  }
  #undef CMASK
  #define CMASK(P0,P1,t) do{int jb_=(t)-(NT-4); if(jb_>=0)cmask(P0,P1,jb_,qrel,hi);}while(0)
  #define ENDW(tt) do{ if((tt)+3<NT){WAIT_BAR(2);} else if((tt)+2<NT){WAIT_BAR(1);} else {WAIT_BAR(0);} }while(0)
  for(;t+1<NT;t+=2){
    STEP(pB0,pB1,pA0,pA1,t,(t+3<NT),(t+1<NT),(t+1<NT));       ENDW(t);   RESC(); ROT();
    STEP(pA0,pA1,pB0,pB1,t+1,(t+4<NT),(t+2<NT),(t+2<NT));     ENDW(t+1); RESC(); ROT();
  }
  STEP(pB0,pB1,pA0,pA1,NT-1,false,false,false); RESC();
  { float sacc=pB0[0]+pB0[1]; _Pragma("unroll") for(int r=2;r<16;++r)sacc+=pB0[r]; _Pragma("unroll") for(int r=0;r<16;++r)sacc+=pB1[r]; l_reg+=sacc;
    pw0=(u32x4){PKW(pB0,0),PKW(pB0,2),PKW(pB0,4),PKW(pB0,6)};pw1=(u32x4){PKW(pB0,8),PKW(pB0,10),PKW(pB0,12),PKW(pB0,14)};pw2=(u32x4){PKW(pB1,0),PKW(pB1,2),PKW(pB1,4),PKW(pB1,6)};pw3=(u32x4){PKW(pB1,8),PKW(pB1,10),PKW(pB1,12),PKW(pB1,14)};
    SBAR(); pv(o,vb0+sl_cur,PAF(0),PAF(1),PAF(2),PAF(3)); }
  #undef PKW
  #undef PAF
  #undef VFR
  #undef PIN
  #undef MX3
  #undef GAPA
  #undef GAPB
  #undef EX
  #undef VRD
  #undef KRD
  #undef STEP
  #undef ENDW
  {auto rr=__builtin_amdgcn_permlane32_swap(__float_as_uint(l_reg),__float_as_uint(l_reg),false,false);l_reg=__uint_as_float(rr[0])+__uint_as_float(rr[1]);}
  if(hi==0)wsf[32+r32]=l_reg;asm volatile("s_waitcnt lgkmcnt(0)":::"memory");
  float rli[16];
  #pragma unroll
  for(int r=0;r<16;++r)rli[r]=__builtin_amdgcn_rcpf(wsf[32+crow(r,hi)]);
  bf16*Ow=Oh+(long)(q0+wid*QBLK)*POUT;
  { bf16*stg=(bf16*)(shm+LDS_OST)+wid*2048;
    #pragma unroll
    for(int r=0;r<16;++r){const int orow=crow(r,hi);
      #pragma unroll
      for(int d0=0;d0<2;++d0)stg[orow*64+d0*32+r32]=__float2bfloat16(o[d0][r]*rli[r]);}
    asm volatile("s_waitcnt lgkmcnt(0)":::"memory");
    #pragma unroll
    for(int i=0;i<4;++i){const int row=i*8+(lane>>3),ch=lane&7; const u32x4 v=*(const u32x4*)(stg+row*64+ch*8); ATTN_STORE16(Ow+(long)row*POUT+ch*8,v);} }
  asm volatile("s_waitcnt lgkmcnt(0)\n\ts_barrier":::"memory");
  #undef DMA_K
  #undef DMA_V
  #undef CMASK
  #undef START
  #undef RESC
  #undef ROT
}
constexpr int ATTN_LDS_BYTES=LDS_BYTES;
#undef SBAR
#undef WAIT_BAR
}

#define LAS __attribute__((address_space(3)))
typedef unsigned short bf16_t;
typedef float f32x4 __attribute__((ext_vector_type(4)));
typedef unsigned u32x4 __attribute__((ext_vector_type(4)));
typedef unsigned u32x2 __attribute__((ext_vector_type(2)));
typedef float f32x2 __attribute__((ext_vector_type(2)));
typedef _Float16 f16x8 __attribute__((ext_vector_type(8)));
typedef _Float16 f16x4 __attribute__((ext_vector_type(4)));

constexpr int NB = 2, S = 16384, T = NB * S, D = 1024, DEPTH = 4;
constexpr int EV_N = 3368, EV_NP = 3584, EV_ZP = 3072, OD_N = 2048;
constexpr float EPS = 1e-6f;
constexpr float LOG2E = 1.4426950408889634f;
constexpr float QSCALE = 0.125f * LOG2E;
constexpr int NWAVES = 8, NTHREADS = 512;
constexpr int LDS_BYTES = 163840;
constexpr int LDS_MISC = 131072;
constexpr int LDS_BARW = LDS_BYTES - 64;
constexpr int LDS_PTBL = LDS_BYTES - 512;

constexpr size_t MiB = 1u << 20;
constexpr size_t WS_CTL = 0, CTL_ZERO_BYTES = 1 * MiB;
constexpr size_t WS_MOD = 1 * MiB;
constexpr size_t WS_MODP = 1 * MiB + 256 * 1024;
constexpr size_t WS_ROPE = 2 * MiB;
constexpr size_t WS_S5A = 4 * MiB;
constexpr size_t WS_S5B = 4 * MiB + 64 * 1024;
constexpr size_t WS_LAM = 6 * MiB;
constexpr size_t WS_KM = 6 * MiB + 4096;
constexpr size_t WS_WRH = 6 * MiB + 512 * 1024;
constexpr size_t WS_KMH = 7 * MiB + 512 * 1024;
constexpr size_t WS_WEVIN = 8 * MiB;
constexpr size_t WS_WEVOUT = 22 * MiB;
constexpr size_t WS_WODIN = 26 * MiB;
constexpr size_t WS_WODOUT = 34 * MiB;
constexpr size_t WS_WGLU = 38 * MiB;
constexpr size_t WS_W13 = 40 * MiB;
constexpr size_t WS_W2 = 104 * MiB;
constexpr size_t WS_H = 136 * MiB;
constexpr size_t WS_O = 200 * MiB;
constexpr size_t WS_Z = 264 * MiB;
constexpr size_t WS_XG = 264 * MiB;
constexpr size_t WS_Y = 264 * MiB;
constexpr size_t WS_HID = 408 * MiB;
constexpr size_t WS_IQ = 456 * MiB;
constexpr size_t WS_YG = 456 * MiB;
constexpr size_t WS_IKW = 488 * MiB;
constexpr size_t WS_IQH = 496 * MiB;
constexpr size_t WS_IKH = 512 * MiB;
constexpr size_t WS_IW = 514 * MiB;
constexpr size_t WS_SEL = 516 * MiB;
constexpr size_t WS_YMIX = 548 * MiB;
constexpr size_t WS_LTOK = 612 * MiB;
constexpr size_t WS_TOKES = 616 * MiB;
constexpr size_t WS_TOKW = 617 * MiB;
constexpr size_t WS_TOKROW = 618 * MiB;
constexpr size_t WS_UG = 516 * MiB;
constexpr size_t WS_S5E = 496 * MiB;
constexpr size_t WS_S5HC = 488 * MiB;
constexpr size_t WS_S5KT = 620 * MiB;
constexpr size_t WS_S5WT = 624 * MiB;
constexpr size_t WS_S5A2 = 640 * MiB;
constexpr size_t WS_S5PW = 656 * MiB;
constexpr size_t WS_MLIST = 660 * MiB;
constexpr size_t WS_MPO = 724 * MiB;
constexpr size_t WS_MML = 852 * MiB;
constexpr size_t WS_MASKW = 724 * MiB;
constexpr size_t WS_NSEL = 860 * MiB;
constexpr size_t WS_XB = 862 * MiB;
constexpr size_t WS_END = 926 * MiB;
constexpr int XG_ROWS = 73728;
constexpr int CW_BAR = 4096;
constexpr int CW_MCNT = 16384;
constexpr int CW_CNT = 8192;

#define XB_TMO      128
#define XB_XCNT(j)  (256  + 64 * (j))
#define XB_XSUB(j)  (1280 + 64 * (j))
#define XB_XGEN(j)  (2304 + 64 * (j))
#define XB_TOP      3328
#define XB_TOPGEN   3392
#define XCD_BAR_WORDS 3456
#define XB_SPIN_CAP (1u << 24)

__device__ __forceinline__ unsigned xb_ld(unsigned* p)              { return __hip_atomic_load(p, __ATOMIC_RELAXED, __HIP_MEMORY_SCOPE_AGENT); }
__device__ __forceinline__ unsigned xb_add(unsigned* p, unsigned v) { return __hip_atomic_fetch_add(p, v, __ATOMIC_RELAXED, __HIP_MEMORY_SCOPE_AGENT); }
__device__ __forceinline__ unsigned xb_xcc_id() { return (unsigned)__builtin_amdgcn_s_getreg((3 << 11) | 20) & 0xFu; }
#define XB_SPIN(cond, bar) do { unsigned _sp = 0; while (cond) { __builtin_amdgcn_s_sleep(1); \
    if ((++_sp & 255u) == 0u) { if (xb_ld(&(bar)[XB_TMO])) break; if (_sp > XB_SPIN_CAP) { atomicAdd(&(bar)[XB_TMO], 1u); break; } } } } while (0)

struct XcdBarrier { unsigned* bar; unsigned x; volatile LAS unsigned* st; };

__device__ __forceinline__ XcdBarrier xcd_barrier_post(unsigned* bar, volatile LAS unsigned* st, bool leader) {
    XcdBarrier b; b.bar = bar; b.x = xb_xcc_id(); b.st = st;
    if (leader) (void)xb_add(&bar[XB_XCNT(b.x)], 1u);
    return b;
}
__device__ __forceinline__ void xcd_barrier_complete(unsigned* bar, unsigned x, unsigned& nloc, unsigned& nx) {
    const unsigned G = gridDim.x * gridDim.y * gridDim.z;
    unsigned sum, cnt, mine, sp = 0u;
    for (;;) {
        sum = 0u; cnt = 0u; mine = 0u;
#pragma unroll
        for (unsigned j = 0; j < 16; ++j) { const unsigned c = xb_ld(&bar[XB_XCNT(j)]); sum += c; cnt += (c > 0u) ? 1u : 0u; mine = (j == x) ? c : mine; }
        if (sum == G) break;
        __builtin_amdgcn_s_sleep(1);
        if ((++sp & 255u) == 0u) { if (xb_ld(&bar[XB_TMO])) break; if (sp > XB_SPIN_CAP) { atomicAdd(&bar[XB_TMO], 1u); break; } }
    }
    nloc = mine > 0u ? mine : 1u; nx = cnt > 0u ? cnt : 1u;
}
__device__ __forceinline__ void xcd_barrier(const XcdBarrier& b, bool leader) {
    asm volatile("s_waitcnt vmcnt(0)" ::: "memory");
    __syncthreads();
    if (leader) {
        unsigned* bar = b.bar;
        __builtin_amdgcn_s_waitcnt(0);
        unsigned nloc = b.st[0], nx = b.st[1];
        if (nloc == 0u) { xcd_barrier_complete(bar, b.x, nloc, nx); b.st[0] = nloc; b.st[1] = nx; }
        const unsigned old = xb_add(&bar[XB_XSUB(b.x)], 1u);
        const unsigned gen = old / nloc;
        if (old + 1u == (gen + 1u) * nloc) {
            __builtin_amdgcn_fence(__ATOMIC_RELEASE, "agent");
            asm volatile("s_waitcnt vmcnt(0)" ::: "memory");
            const unsigned og = xb_add(&bar[XB_TOP], 1u);
            const unsigned tg = og / nx;
            if (og + 1u == (tg + 1u) * nx) xb_add(&bar[XB_TOPGEN], 1u);
            else XB_SPIN(xb_ld(&bar[XB_TOPGEN]) == tg, bar);
            __builtin_amdgcn_fence(__ATOMIC_ACQUIRE, "agent");
            xb_add(&bar[XB_XGEN(b.x)], 1u);
            asm volatile("s_waitcnt vmcnt(0)" ::: "memory");
        } else {
            XB_SPIN(xb_ld(&bar[XB_XGEN(b.x)]) == gen, bar);
            __builtin_amdgcn_fence(__ATOMIC_ACQUIRE, "agent");
            asm volatile("s_waitcnt vmcnt(0)" ::: "memory");
        }
    }
    __syncthreads();
}

#define LDS_WAIT() asm volatile("s_waitcnt lgkmcnt(0)" ::: "memory")
__device__ __forceinline__ float bflo(unsigned w) { return __uint_as_float(w << 16); }
__device__ __forceinline__ float bfhi(unsigned w) { return __uint_as_float(w & 0xffff0000u); }
__device__ __forceinline__ unsigned pk2(float lo, float hi) { typedef float f32x2_ __attribute__((ext_vector_type(2))); typedef __bf16 bf16x2_ __attribute__((ext_vector_type(2))); const f32x2_ v = {lo, hi}; return __builtin_bit_cast(unsigned, __builtin_convertvector(v, bf16x2_)); }
__device__ __forceinline__ unsigned f2bf(float f) { return pk2(f, 0.f) & 0xffffu; }
__device__ __forceinline__ float shx_(float v, int m, int lane) { return __int_as_float(__builtin_amdgcn_ds_bpermute((lane ^ m) << 2, __float_as_int(v))); }
__device__ __forceinline__ unsigned shi_(unsigned v, int src) { return (unsigned)__builtin_amdgcn_ds_bpermute(src << 2, (int)v); }
#define SHX(v, m) shx_((v), (m), lane)
__device__ __forceinline__ float dpp_xor1(float v) { return __int_as_float(__builtin_amdgcn_update_dpp(0, __float_as_int(v), 0xB1, 0xF, 0xF, true)); }
__device__ __forceinline__ float dpp_xor2(float v) { return __int_as_float(__builtin_amdgcn_update_dpp(0, __float_as_int(v), 0x4E, 0xF, 0xF, true)); }
__device__ __forceinline__ float half_sum(float v) { const auto r = __builtin_amdgcn_permlane32_swap(__float_as_uint(v), __float_as_uint(v), false, false); return __uint_as_float(r[0]) + __uint_as_float(r[1]); }
__device__ __forceinline__ float half_max(float v) { const auto r = __builtin_amdgcn_permlane32_swap(__float_as_uint(v), __float_as_uint(v), false, false); return fmaxf(__uint_as_float(r[0]), __uint_as_float(r[1])); }
__device__ __forceinline__ float wave_sum_(float v, int lane) {
    v += dpp_xor1(v); v += dpp_xor2(v); v += shx_(v, 4, lane); v += shx_(v, 8, lane); v += shx_(v, 16, lane); return half_sum(v);
}

#define wave_sum(v) wave_sum_((v), lane)
__device__ __forceinline__ float wave_max_(float v, int lane) {
#pragma unroll
    for (int o = 1; o < 64; o <<= 1) v = fmaxf(v, shx_(v, o, lane));
    return v;
}
__device__ __forceinline__ bool qk_bounded(const float* gq, const float* gk, int lane) {
    const float a = wave_max_(fabsf(gq[lane]), lane), b = wave_max_(fabsf(gk[lane]), lane);
    return 64.0f * QSCALE * a * b <= 60.0f;
}
__device__ __forceinline__ void unpack8(const u32x4 w, float (&v)[8]) {
    v[0] = bflo(w.x); v[1] = bfhi(w.x); v[2] = bflo(w.y); v[3] = bfhi(w.y); v[4] = bflo(w.z); v[5] = bfhi(w.z); v[6] = bflo(w.w); v[7] = bfhi(w.w);
}
__device__ __forceinline__ u32x4 pack8(const float (&v)[8]) { u32x4 w; w.x = pk2(v[0], v[1]); w.y = pk2(v[2], v[3]); w.z = pk2(v[4], v[5]); w.w = pk2(v[6], v[7]); return w; }
__device__ __forceinline__ float gelu_tanh(float y) {
    const float z = 0.7978845608028654f * (y + 0.044715f * y * y * y);
    const float e = __builtin_amdgcn_exp2f(2.885390081777927f * z);
    const float th = 1.0f - 2.0f * __builtin_amdgcn_rcpf(e + 1.0f);
    return 0.5f * y * (1.0f + th);
}
__device__ __forceinline__ float sigmoidf_(float v) { return __builtin_amdgcn_rcpf(1.0f + __builtin_amdgcn_exp2f(-1.4426950408889634f * v)); }
__device__ __forceinline__ unsigned ordkey(float f) { const unsigned u = __float_as_uint(f); return u ^ ((unsigned)((int)u >> 31) | 0x80000000u); }

struct EpiPlain {
    static constexpr bool PERM = true, AFTER_DRAIN = false;
    bf16_t* O; int ldc;
    __device__ __forceinline__ void operator()(const pg8::f32x4 (&acc)[2][2][4][2], const pg8::Unit& u, int wr, int wc, int fr, int fq) const {
        const int row0 = u.pm * 256 + wr * 64 + fr, col0 = u.pn * 256 + wc * 32 + 8 * fq;
#pragma unroll
        for (int ai = 0; ai < 2; ++ai)
#pragma unroll
            for (int m = 0; m < 4; ++m) { bf16_t* rowp = O + (size_t)(row0 + ai * 128 + m * 16) * ldc + col0;
#pragma unroll
                for (int bj = 0; bj < 2; ++bj) { const pg8::f32x4 v0 = acc[ai][bj][m][0], v1 = acc[ai][bj][m][1];
                    u32x4 w; w.x = pk2(v0[0], v0[1]); w.y = pk2(v0[2], v0[3]); w.z = pk2(v1[0], v1[1]); w.w = pk2(v1[2], v1[3]);
                    *(u32x4*)(rowp + bj * 128) = w; } }
    }
};
__device__ __forceinline__ void epi_khead(const pg8::f32x4 (&acc)[2][2][4][2], bf16_t* Z, int ldz, int colbase, const float* gain, const float* COSH, const float* SINH, int row0, int wc, int fr, int fq) {
    const int lane = fr + 16 * fq;
    float g[2][8];
#pragma unroll
    for (int bj = 0; bj < 2; ++bj)
#pragma unroll
        for (int e = 0; e < 8; ++e) g[bj][e] = gain[bj * 32 + 8 * fq + e];
#pragma unroll
    for (int ai = 0; ai < 2; ++ai)
#pragma unroll
      for (int mp = 0; mp < 4; mp += 2) {
        f32x4 csv[2][2], snv[2][2];
#pragma unroll
        for (int mm = 0; mm < 2; ++mm) { const int pos = (row0 + ai * 128 + (mp + mm) * 16) & (S - 1);
            csv[mm][0] = *(const f32x4*)(COSH + pos * 8); csv[mm][1] = *(const f32x4*)(COSH + pos * 8 + 4); snv[mm][0] = *(const f32x4*)(SINH + pos * 8); snv[mm][1] = *(const f32x4*)(SINH + pos * 8 + 4); }
        __builtin_amdgcn_sched_barrier(0);
#pragma unroll
        for (int mm = 0; mm < 2; ++mm) { const int m = mp + mm; const int row = row0 + ai * 128 + m * 16;
            float v[2][8]; float ss = 0.f;
#pragma unroll
            for (int bj = 0; bj < 2; ++bj)
#pragma unroll
                for (int e = 0; e < 4; ++e) { v[bj][e] = acc[ai][bj][m][0][e]; v[bj][4 + e] = acc[ai][bj][m][1][e]; ss += v[bj][e] * v[bj][e] + v[bj][4 + e] * v[bj][4 + e]; }
            ss += shx_(ss, 16, lane); ss = half_sum(ss);
            const float r = rsqrtf(ss * (1.0f / 64.0f) + EPS);
#pragma unroll
            for (int bj = 0; bj < 2; ++bj)
#pragma unroll
                for (int e = 0; e < 8; ++e) v[bj][e] *= r * g[bj][e];
#pragma unroll
            for (int e = 0; e < 8; ++e) { const float oth = shx_(v[0][e], 16, lane); const float cs = csv[mm][e >> 2][e & 3], sn = snv[mm][e >> 2][e & 3];
                if (fq == 0) v[0][e] = v[0][e] * cs - oth * sn; else if (fq == 1) v[0][e] = v[0][e] * cs + oth * sn; }
            bf16_t* zp = Z + (size_t)row * ldz + colbase + wc * 64 + 8 * fq;
            *(u32x4*)zp = pack8(v[0]); *(u32x4*)(zp + 32) = pack8(v[1]); }
        __builtin_amdgcn_sched_barrier(0);
      }
}
struct EpiEvenIn {
    static constexpr bool PERM = true, AFTER_DRAIN = false;
    bf16_t* Z; _Float16* IQH; _Float16* IKH; float* IW; const float* a_kn; const float* b_kn; const float* idx_kn; const float* COSH; const float* SINH; const float* COSI; const float* SINI;
    __device__ __forceinline__ void operator()(const pg8::f32x4 (&acc)[2][2][4][2], const pg8::Unit& u, int wr, int wc, int fr, int fq) const {
        const int row0 = u.pm * 256 + wr * 64 + fr; const int lane = fr + 16 * fq;
        if (u.pn == 2 || u.pn == 3) epi_khead(acc, Z, EV_ZP, 512 + (u.pn & 1) * 256, a_kn, COSH, SINH, row0, wc, fr, fq);
        else if (u.pn == 8 || u.pn == 9) epi_khead(acc, Z, EV_ZP, 2048 + (u.pn & 1) * 256, b_kn, COSH, SINH, row0, wc, fr, fq);
        else if (u.pn < 12) {
            const int col0 = u.pn * 256 + wc * 32 + 8 * fq;
#pragma unroll
            for (int ai = 0; ai < 2; ++ai)
#pragma unroll
                for (int m = 0; m < 4; ++m) { bf16_t* rowp = Z + (size_t)(row0 + ai * 128 + m * 16) * EV_ZP + col0;
#pragma unroll
                    for (int bj = 0; bj < 2; ++bj) { const pg8::f32x4 v0 = acc[ai][bj][m][0], v1 = acc[ai][bj][m][1];
                        u32x4 w; w.x = pk2(v0[0], v0[1]); w.y = pk2(v0[2], v0[3]); w.z = pk2(v1[0], v1[1]); w.w = pk2(v1[2], v1[3]);
                        *(u32x4*)(rowp + bj * 128) = w; } }
        } else if (u.pn == 12) {
#pragma unroll
            for (int ai = 0; ai < 2; ++ai) {
                f32x4 csr[4], snr[4];
#pragma unroll
                for (int m = 0; m < 4; ++m) { const int pos = (row0 + ai * 128 + m * 16) & (S - 1); csr[m] = *(const f32x4*)(COSI + pos * 4); snr[m] = *(const f32x4*)(SINI + pos * 4); }
                __builtin_amdgcn_sched_barrier(0);
#pragma unroll
                for (int m = 0; m < 4; ++m) { const int row = row0 + ai * 128 + m * 16;
                    const f32x4 cs = csr[m], sn = snr[m];
#pragma unroll
                    for (int bj = 0; bj < 2; ++bj) { pg8::f32x4 v0 = acc[ai][bj][m][0], v1 = acc[ai][bj][m][1];
                        if (fq == 0) { const pg8::f32x4 a0 = v0, a1 = v1;
#pragma unroll
                            for (int e = 0; e < 4; ++e) { v0[e] = a0[e] * cs[e] - a1[e] * sn[e]; v1[e] = a1[e] * cs[e] + a0[e] * sn[e]; } }
                        f16x8 hq;
#pragma unroll
                        for (int e = 0; e < 4; ++e) { hq[e] = (_Float16)v0[e]; hq[4 + e] = (_Float16)v1[e]; }
                        *(f16x8*)(IQH + (size_t)row * 256 + bj * 128 + wc * 32 + 8 * fq) = hq; } }
                __builtin_amdgcn_sched_barrier(0);
            }
        } else {
            if (wc == 0) {
                float g[8];
#pragma unroll
                for (int e = 0; e < 8; ++e) g[e] = idx_kn[8 * fq + e];
#pragma unroll
                for (int ai = 0; ai < 2; ++ai)
#pragma unroll
                    for (int m = 0; m < 4; ++m) { const int row = row0 + ai * 128 + m * 16; const int pos = row & (S - 1);
                        float v[8]; float ss = 0.f;
#pragma unroll
                        for (int e = 0; e < 4; ++e) { v[e] = acc[ai][0][m][0][e]; v[4 + e] = acc[ai][0][m][1][e]; ss += v[e] * v[e] + v[4 + e] * v[4 + e]; }
                        ss += shx_(ss, 16, lane); ss = half_sum(ss);
                        const float r = rsqrtf(ss * (1.0f / 32.0f) + EPS);
#pragma unroll
                        for (int e = 0; e < 8; ++e) v[e] *= r * g[e];
                        if (fq == 0) {
#pragma unroll
                            for (int e = 0; e < 4; ++e) { const float x1 = v[e], x2 = v[4 + e]; const float cs = COSI[pos * 4 + e], sn = SINI[pos * 4 + e]; v[e] = x1 * cs - x2 * sn; v[4 + e] = x2 * cs + x1 * sn; } }
                        f16x8 hk;
#pragma unroll
                        for (int e = 0; e < 8; ++e) hk[e] = (_Float16)v[e];
                        *(f16x8*)(IKH + (size_t)row * 32 + 8 * fq) = hk; }
            } else if (wc == 1 && fq == 0) {
#pragma unroll
                for (int ai = 0; ai < 2; ++ai)
#pragma unroll
                    for (int m = 0; m < 4; ++m) { float* wp = IW + (size_t)(row0 + ai * 128 + m * 16) * 8; *(pg8::f32x4*)wp = acc[ai][0][m][0]; *(pg8::f32x4*)(wp + 4) = acc[ai][0][m][1]; }
            }
        }
    }
};
struct EpiOddIn {
    static constexpr bool PERM = true, AFTER_DRAIN = false;
    bf16_t* Z; bf16_t* UG; const float* c_kn; const float* COSH; const float* SINH;
    __device__ __forceinline__ void operator()(const pg8::f32x4 (&acc)[2][2][4][2], const pg8::Unit& u, int wr, int wc, int fr, int fq) const {
        const int row0 = u.pm * 256 + wr * 64 + fr, col0 = u.pn * 256 + wc * 32 + 8 * fq;
        if (u.pn == 2 || u.pn == 3) { epi_khead(acc, Z, OD_N, 512 + (u.pn & 1) * 256, c_kn, COSH, SINH, row0, wc, fr, fq); return; }
#pragma unroll
        for (int ai = 0; ai < 2; ++ai)
#pragma unroll
            for (int m = 0; m < 4; ++m) { const size_t row = (size_t)(row0 + ai * 128 + m * 16);
#pragma unroll
                for (int bj = 0; bj < 2; ++bj) { const pg8::f32x4 v0 = acc[ai][bj][m][0], v1 = acc[ai][bj][m][1]; const int col = col0 + bj * 128;
                    u32x4 w; w.x = pk2(v0[0], v0[1]); w.y = pk2(v0[2], v0[3]); w.z = pk2(v1[0], v1[1]); w.w = pk2(v1[2], v1[3]);
                    if (u.pn < 6) *(u32x4*)(Z + row * OD_N + col) = w;
                    else { const int cu = col - 1536; *(u32x4*)(UG + ((size_t)(cu >> 4) * T + row) * 16 + (cu & 15)) = w; } } }
    }
};
__device__ __forceinline__ void load_q_normed(attn_body::bf16x8 (&qr)[4], const bf16_t* zrow, const float* gain, const float* COSH, const float* SINH, int pos, int hi, int lane) {
    float v[4][8]; float ss = 0.f;
#pragma unroll
    for (int d0 = 0; d0 < 4; ++d0) { unpack8(*(const u32x4*)(zrow + d0 * 16 + hi * 8), v[d0]);
#pragma unroll
        for (int e = 0; e < 8; ++e) ss += v[d0][e] * v[d0][e]; }
    ss = half_sum(ss);
    const float r = rsqrtf(ss * (1.0f / 64.0f) + EPS) * QSCALE;
#pragma unroll
    for (int d0 = 0; d0 < 4; ++d0)
#pragma unroll
        for (int e = 0; e < 8; ++e) v[d0][e] *= r * gain[d0 * 16 + hi * 8 + e];
#pragma unroll
    for (int e = 0; e < 8; ++e) { const float oth = shx_(v[0][e], 32, lane); const float cs = COSH[pos * 8 + e], sn = SINH[pos * 8 + e];
        v[0][e] = hi ? v[0][e] * cs + oth * sn : v[0][e] * cs - oth * sn; }
#pragma unroll
    for (int d0 = 0; d0 < 4; ++d0) qr[d0] = __builtin_bit_cast(attn_body::bf16x8, pack8(v[d0]));
}
struct EpiSwiGLU {
    static constexpr bool PERM = true, AFTER_DRAIN = false;
    bf16_t* HID;
    __device__ __forceinline__ void operator()(const pg8::f32x4 (&acc)[2][2][4][2], const pg8::Unit& u, int wr, int wc, int fr, int fq) const {
        const int row0 = u.pm * 256 + wr * 64 + fr, col0 = (u.pn * 256 + wc * 32 + 8 * fq) >> 1;
#pragma unroll
        for (int ai = 0; ai < 2; ++ai)
#pragma unroll
            for (int m = 0; m < 4; ++m) { bf16_t* rowp = HID + (size_t)(row0 + ai * 128 + m * 16) * 512 + col0;
#pragma unroll
                for (int bj = 0; bj < 2; ++bj) { const pg8::f32x4 v0 = acc[ai][bj][m][0], v1 = acc[ai][bj][m][1];
                    const float h0 = v0[0] * sigmoidf_(v0[0]) * v0[1], h1 = v0[2] * sigmoidf_(v0[2]) * v0[3];
                    const float h2 = v1[0] * sigmoidf_(v1[0]) * v1[1], h3 = v1[2] * sigmoidf_(v1[2]) * v1[3];
                    u32x2 w; w.x = pk2(h0, h1); w.y = pk2(h2, h3);
                    *(u32x2*)(rowp + bj * 64) = w; } }
    }
};
struct EpiGLU {
    static constexpr bool PERM = true, AFTER_DRAIN = false;
    bf16_t* O; const bf16_t* YG; const float* gb;
    __device__ __forceinline__ void operator()(const pg8::f32x4 (&acc)[2][2][4][2], const pg8::Unit& u, int wr, int wc, int fr, int fq) const {
        const int row0 = u.pm * 256 + wr * 64 + fr, col0 = u.pn * 256 + wc * 32 + 8 * fq;
#pragma unroll
        for (int ai = 0; ai < 2; ++ai)
#pragma unroll
            for (int bj = 0; bj < 2; ++bj) {
                const int c = col0 + bj * 128;
                u32x4 yr[4];
#pragma unroll
                for (int m = 0; m < 4; ++m) yr[m] = *(const u32x4*)(YG + (size_t)(row0 + ai * 128 + m * 16) * 512 + c);
                const pg8::f32x4 b0 = *(const pg8::f32x4*)(gb + c), b1 = *(const pg8::f32x4*)(gb + c + 4);
                __builtin_amdgcn_sched_barrier(0);
#pragma unroll
                for (int m = 0; m < 4; ++m) { const size_t row = (size_t)(row0 + ai * 128 + m * 16);
                    const pg8::f32x4 v0 = acc[ai][bj][m][0], v1 = acc[ai][bj][m][1];
                    float y[8]; unpack8(yr[m], y);
                    float o[8];
#pragma unroll
                    for (int j = 0; j < 4; ++j) { o[j] = y[j] * sigmoidf_(v0[j] + b0[j]); o[4 + j] = y[4 + j] * sigmoidf_(v1[j] + b1[j]); }
                    *(u32x4*)(O + row * 1024 + 512 + c) = pack8(o); }
                __builtin_amdgcn_sched_barrier(0);
            }
    }
};
struct MoeOrder {
    int nN, nunits, G, c; const LAS int* tile_e;
    __device__ __forceinline__ bool next(int i, pg8::Unit& u) const { const int L = i * G + c; if (L >= nunits) return false;
        int w = L; { const int q = nunits / 8, r = nunits % 8, xcd = w % 8, off = w / 8; w = (xcd < r ? xcd * (q + 1) : r * (q + 1) + (xcd - r) * q) + off; }
        u.pm = w / nN; u.pn = w % nN; u.be = tile_e[u.pm]; return true; }
    __device__ __forceinline__ void a_ready(const pg8::Unit&) const {}
    __device__ __forceinline__ void done(const pg8::Unit&) const {}
};

__device__ __forceinline__ int wt_row(int n, int row_mul, int row_add) {
    if (row_mul > 0) return n * row_mul + row_add;
    const int tile = n >> 8, w = n & 255;
    const bool ktile = (tile == 2 || tile == 3) || (row_mul == -1 && (tile == 8 || tile == 9));
    return ktile ? tile * 256 + ((w & 63) >> 5) * 128 + (w >> 6) * 32 + (w & 31) : n;
}
__device__ __forceinline__ void transpose_item(const float* W, int K, int N, bf16_t* WT, int row_mul, int row_add, LAS float* scr, int item, int nblk, int lane) {
    const int kb = item / nblk, nb = item % nblk, k0 = 64 * kb, n0 = 32 * nb;
    const int nn = n0 + (lane & 31);
    float tv[32];
#pragma unroll
    for (int i = 0; i < 32; ++i) { const int kk = 2 * i + (lane >> 5); tv[i] = (nn < N) ? W[(size_t)(k0 + kk) * N + nn] : 0.f; }
#pragma unroll
    for (int i = 0; i < 32; ++i) { const int kk = 2 * i + (lane >> 5); scr[kk * 33 + (lane & 31)] = tv[i]; }
    LDS_WAIT(); asm volatile("" ::: "memory");
    const int c = lane & 7;
#pragma unroll
    for (int j = 0; j < 4; ++j) { const int n = (lane >> 3) + 8 * j; const LAS float* s = scr + (8 * c) * 33 + n;
        u32x4 o; o.x = pk2(s[0 * 33], s[1 * 33]); o.y = pk2(s[2 * 33], s[3 * 33]); o.z = pk2(s[4 * 33], s[5 * 33]); o.w = pk2(s[6 * 33], s[7 * 33]);
        *(u32x4*)(WT + (size_t)wt_row(n0 + n, row_mul, row_add) * K + k0 + 8 * c) = o; }
    LDS_WAIT(); asm volatile("" ::: "memory");
}
__device__ __forceinline__ void norm_mod_row(const float* xrow, const float* sh, const float* sc, bf16_t* orow, int lane) {
    f32x4 v[4]; float ss = 0.f;
#pragma unroll
    for (int j = 0; j < 4; ++j) { v[j] = *(const f32x4*)(xrow + 4 * lane + 256 * j); ss += (v[j].x * v[j].x + v[j].y * v[j].y) + (v[j].z * v[j].z + v[j].w * v[j].w); }
    const float r = rsqrtf(wave_sum(ss) * (1.0f / 1024.0f) + EPS);
#pragma unroll
    for (int j = 0; j < 4; ++j) { const f32x4 a = *(const f32x4*)(sc + 4 * lane + 256 * j), b = *(const f32x4*)(sh + 4 * lane + 256 * j);
        u32x2 w; w.x = pk2(v[j].x * r * (1.f + a.x) + b.x, v[j].y * r * (1.f + a.y) + b.y); w.y = pk2(v[j].z * r * (1.f + a.z) + b.z, v[j].w * r * (1.f + a.w) + b.w);
        *(u32x2*)(orow + 4 * lane + 256 * j) = w; }
}

__device__ __forceinline__ void attn_key(const bf16_t* kp, const bf16_t* vp, const float (&q)[64], float& m, float& l, float (&o)[64]) {
    float s = 0.f;
#pragma unroll
    for (int i = 0; i < 8; ++i) { float kv[8]; unpack8(*(const u32x4*)(kp + 8 * i), kv);
#pragma unroll
        for (int j = 0; j < 8; ++j) s += q[8 * i + j] * kv[j]; }
    const float mn = fmaxf(m, s);
    const float f = __builtin_amdgcn_exp2f(m - mn), p = __builtin_amdgcn_exp2f(s - mn);
    l = l * f + p; m = mn;
#pragma unroll
    for (int i = 0; i < 8; ++i) { float vv[8]; unpack8(*(const u32x4*)(vp + 8 * i), vv);
#pragma unroll
        for (int j = 0; j < 8; ++j) o[8 * i + j] = o[8 * i + j] * f + p * vv[j]; }
}
__device__ __forceinline__ void load_q64(const bf16_t* qp, float scale, float (&q)[64]) {
#pragma unroll
    for (int i = 0; i < 8; ++i) { float t[8]; unpack8(*(const u32x4*)(qp + 8 * i), t);
#pragma unroll
        for (int j = 0; j < 8; ++j) q[8 * i + j] = t[j] * scale; }
}

struct Args { const void* in[37]; float* out; unsigned char* ws; int ph_lo, ph_hi, probe_var, pad; };
#ifndef PROBE_GEMM_REPS
#define PROBE_GEMM_REPS 1
#endif
#if PROBE_GEMM_REPS == 2
template <class Sc> struct Twice { Sc S; int n1;
    __device__ __forceinline__ bool next(int i, pg8::Unit& u) const { return i < n1 ? S.next(i, u) : S.next(i - n1, u); }
    __device__ __forceinline__ void a_ready(const pg8::Unit&) const {}
    __device__ __forceinline__ void done(const pg8::Unit&) const {} };
#define PROBE_SCHED(T) Twice<T>
#define PROBE_WRAP(T, v) Twice<T> PS_; PS_.S = v; { int n1_ = 0; pg8::Unit tu_; while (v.next(n1_, tu_)) ++n1_; PS_.n1 = n1_; }
#else
#define PROBE_SCHED(T) T
#define PROBE_WRAP(T, v) const T& PS_ = v
#endif
#ifdef PROBE_BAR2
#define PROBE_EXTRA_BAR(b) xcd_barrier(b, lsg(wid0) == 0 && lane_id_v() == 0);
#else
#define PROBE_EXTRA_BAR(b)
#endif
constexpr int N_PHASES = 3 + 2 * (8 + 10);

template <int NV, bool MASKED, bool CAUSAL, int PIN, int POUT, bool NOMAX = false>
__device__ __forceinline__ void flash_unit(LAS unsigned char* L0, const bf16_t* Qb, const bf16_t* Kb, const bf16_t* Vb, bf16_t* Ob, const unsigned* mbase, int qb, int wid, int lane, const float* qgain, const float* COSH, const float* SINH) {
    const int r32 = lane & 31, hi = lane >> 5;
    LAS unsigned char* ldsKs = L0; LAS unsigned char* ldsVs = L0 + 16384;
    LAS float* wsf = (LAS float*)(L0 + 16384 + NV * 16384 + wid * 256);
    LAS bf16_t* stg = (LAS bf16_t*)(L0 + 16384 + NV * 16384 + 2048 + wid * 4096);
    const int qrow = qb * 256 + wid * 32 + r32;
    attn_body::bf16x8 qr[4];
    load_q_normed(qr, Qb + (size_t)qrow * PIN, qgain, COSH, SINH, qrow, hi, lane);
    const int NT = 4 * (qb + 1);
    const bf16_t* kbp = Kb + (size_t)lane * PIN + wid * 8;
    const bf16_t* vbp = Vb + (size_t)(16 * (wid & 3) + (lane >> 2)) * PIN + (wid >> 2) * 32 + (lane & 3) * 8;
    const unsigned* mwp = MASKED ? mbase + (size_t)qrow * 2 + hi : nullptr;
    u32x4 kreg = *(const u32x4*)kbp, vreg[NV]; unsigned mw = 0u, mwn = 0u;
#pragma unroll
    for (int j = 0; j < NV; ++j) vreg[j] = *(const u32x4*)(vbp + j * 64);
    if (MASKED) mw = mwp[0];
    *(LAS u32x4*)(ldsKs + wid * 1024 + lane * 16) = kreg;
#pragma unroll
    for (int j = 0; j < NV; ++j) *(LAS u32x4*)(ldsVs + j * 16384 + wid * 1024 + lane * 16) = vreg[j];
    __syncthreads();
    float mhat = 0.f, lsum = 0.f;
    attn_body::f32x16 o[2 * NV], negm;
#pragma unroll
    for (int r = 0; r < 16; ++r) { negm[r] = 0.f;
#pragma unroll
        for (int j = 0; j < 2 * NV; ++j) o[j][r] = 0.f; }
    const int vb0 = (int)(unsigned)(unsigned long long)ldsVs + ((lane >> 4) & 1) * 32 + (lane & 3) * 8 + (4 * hi + ((lane & 15) >> 2)) * 64;
    for (int t = 0; t < NT; ++t) {
        const int slot = (t & 1) * 8192;
        if (t + 1 < NT) { kreg = *(const u32x4*)(kbp + (size_t)(t + 1) * 64 * PIN);
#pragma unroll
            for (int j = 0; j < NV; ++j) vreg[j] = *(const u32x4*)(vbp + (size_t)(t + 1) * 64 * PIN + j * 64);
            if (MASKED) mwn = mwp[(size_t)(t + 1) * S * 2]; }
        attn_body::f32x16 p0 = negm, p1 = negm;
        { const LAS unsigned char* kb = ldsKs + slot + hi * 1024 + r32 * 16;
#pragma unroll
          for (int d0 = 0; d0 < 4; ++d0) {
              const attn_body::bf16x8 b0 = *(const LAS attn_body::bf16x8*)(kb + d0 * 2048), b1 = *(const LAS attn_body::bf16x8*)(kb + d0 * 2048 + 512);
              p0 = __builtin_amdgcn_mfma_f32_32x32x16_bf16(b0, qr[d0], p0, 0, 0, 0);
              p1 = __builtin_amdgcn_mfma_f32_32x32x16_bf16(b1, qr[d0], p1, 0, 0, 0); } }
        if (CAUSAL) { const int jb = t - (NT - 4); if (jb >= 0) attn_body::cmask(p0, p1, jb, wid * 32 + r32, hi); }
        float rm = 0.f;
        if (!NOMAX) { rm = fmaxf(p0[0], p1[0]);
#pragma unroll
            for (int r = 1; r < 16; ++r) rm = fmaxf(rm, fmaxf(p0[r], p1[r]));
            rm = half_max(rm); }
        bool resc = false;
        if (!NOMAX && __any(rm > 8.0f)) {
            const float dl = fmaxf(rm, 0.f); mhat += dl;
#pragma unroll
            for (int r = 0; r < 16; ++r) { p0[r] -= dl; p1[r] -= dl; negm[r] = -mhat; }
            const float f = __builtin_amdgcn_exp2f(-dl); lsum *= f; if (hi == 0) wsf[r32] = f; resc = true;
        }
        const int wb = (int)mw; float ssum = 0.f;
#pragma unroll
        for (int r = 0; r < 16; ++r) {
            float e0 = __builtin_amdgcn_exp2f(p0[r]), e1 = __builtin_amdgcn_exp2f(p1[r]);
            if (MASKED) { e0 = __uint_as_float(__float_as_uint(e0) & (unsigned)__builtin_amdgcn_sbfe(wb, r, 1)); e1 = __uint_as_float(__float_as_uint(e1) & (unsigned)__builtin_amdgcn_sbfe(wb, 16 + r, 1)); }
            p0[r] = e0; p1[r] = e1; ssum += e0 + e1; }
        lsum += ssum;
        u32x4 pw0, pw1, pw2, pw3;
#pragma unroll
        for (int k = 0; k < 4; ++k) { pw0[k] = attn_body::cvtpk_s(p0[2 * k], p0[2 * k + 1]); pw1[k] = attn_body::cvtpk_s(p0[8 + 2 * k], p0[9 + 2 * k]);
            pw2[k] = attn_body::cvtpk_s(p1[2 * k], p1[2 * k + 1]); pw3[k] = attn_body::cvtpk_s(p1[8 + 2 * k], p1[9 + 2 * k]); }
        if (resc) { LDS_WAIT();
#pragma unroll
            for (int r = 0; r < 16; ++r) { const float f = wsf[attn_body::crow(r, hi)];
#pragma unroll
                for (int j = 0; j < 2 * NV; ++j) o[j][r] *= f; } }
#pragma unroll
        for (int j = 0; j < NV; ++j)
            attn_body::pv(o + 2 * j, vb0 + j * 16384 + slot, __builtin_bit_cast(attn_body::bf16x8, pw0), __builtin_bit_cast(attn_body::bf16x8, pw1), __builtin_bit_cast(attn_body::bf16x8, pw2), __builtin_bit_cast(attn_body::bf16x8, pw3));
        if (t + 1 < NT) { const int ns = ((t + 1) & 1) * 8192; *(LAS u32x4*)(ldsKs + ns + wid * 1024 + lane * 16) = kreg;
#pragma unroll
            for (int j = 0; j < NV; ++j) *(LAS u32x4*)(ldsVs + j * 16384 + ns + wid * 1024 + lane * 16) = vreg[j]; }
        mw = mwn;
        __syncthreads();
    }
    lsum += shx_(lsum, 32, lane);
    if (hi == 0) wsf[r32] = lsum;
    LDS_WAIT();
    float rl[16];
#pragma unroll
    for (int r = 0; r < 16; ++r) rl[r] = __builtin_amdgcn_rcpf(wsf[attn_body::crow(r, hi)]);
#pragma unroll
    for (int j = 0; j < NV; ++j) {
#pragma unroll
        for (int r = 0; r < 16; ++r) { const int orow = attn_body::crow(r, hi);
            stg[orow * 64 + r32] = (bf16_t)f2bf(o[2 * j][r] * rl[r]); stg[orow * 64 + 32 + r32] = (bf16_t)f2bf(o[2 * j + 1][r] * rl[r]); }
        LDS_WAIT();
#pragma unroll
        for (int q = 0; q < 4; ++q) { const int row = q * 8 + (lane >> 3), ch = lane & 7;
            *(u32x4*)(Ob + (size_t)(qb * 256 + wid * 32 + row) * POUT + j * 64 + ch * 8) = *(const LAS u32x4*)(stg + row * 64 + ch * 8); }
        LDS_WAIT();
    }
    __syncthreads();
}
template <int NV, bool MASKED, bool CAUSAL, int PIN, int POUT, bool NOMAX = false>
__device__ __forceinline__ void flash_unit_q2(LAS unsigned char* L0, const bf16_t* Qb, const bf16_t* Kb, const bf16_t* Vb, bf16_t* Ob, const unsigned* mbase, int qb, int wid, int lane, const float* qgain, const float* COSH, const float* SINH) {
    typedef __attribute__((address_space(3))) attn_body::v4i16_t* vtr_ptr;
    const int r32 = lane & 31, hi = lane >> 5;
    LAS unsigned char* ldsKs = L0; LAS unsigned char* ldsVs = L0 + 16384;
    LAS float* wsf = (LAS float*)(L0 + 16384 + NV * 16384 + wid * 512);
    LAS bf16_t* stg = (LAS bf16_t*)(L0 + 16384 + NV * 16384 + 4096 + wid * 4096);
    const int q0 = qb * 512 + wid * 64;
    attn_body::bf16x8 qr[2][4];
#pragma unroll
    for (int nq = 0; nq < 2; ++nq) load_q_normed(qr[nq], Qb + (size_t)(q0 + nq * 32 + r32) * PIN, qgain, COSH, SINH, q0 + nq * 32 + r32, hi, lane);
    const int NT = 8 * (qb + 1);
    const bf16_t* kbp = Kb + (size_t)lane * PIN + wid * 8;
    const bf16_t* vbp = Vb + (size_t)(16 * (wid & 3) + (lane >> 2)) * PIN + (wid >> 2) * 32 + (lane & 3) * 8;
    const unsigned* mwp = MASKED ? mbase + (size_t)(q0 + r32) * 2 + hi : nullptr;
    const int stoff = wid * 1024 + lane * 16;
    u32x4 kreg = *(const u32x4*)kbp, vreg[NV]; unsigned mw[2] = {0u, 0u}, mwn[2] = {0u, 0u};
#pragma unroll
    for (int j = 0; j < NV; ++j) vreg[j] = *(const u32x4*)(vbp + j * 64);
    if (MASKED) { mw[0] = mwp[0]; mw[1] = mwp[64]; }
    *(LAS u32x4*)(ldsKs + stoff) = kreg;
#pragma unroll
    for (int j = 0; j < NV; ++j) *(LAS u32x4*)(ldsVs + j * 16384 + stoff) = vreg[j];
    __syncthreads();
    float mhat[2] = {0.f, 0.f}, lsum[2] = {0.f, 0.f}; bool refmoved = false;
    attn_body::f32x16 o[2][2 * NV];
#pragma unroll
    for (int r = 0; r < 16; ++r)
#pragma unroll
        for (int j = 0; j < 2 * NV; ++j) { o[0][j][r] = 0.f; o[1][j][r] = 0.f; }
    const LAS unsigned char* kfb = ldsKs + hi * 1024 + r32 * 16;
    const LAS unsigned char* vfb = ldsVs + ((lane >> 4) & 1) * 32 + (lane & 3) * 8 + (4 * hi + ((lane & 15) >> 2)) * 64;
    for (int t = 0; t < NT; ++t) {
        const int slot = (t & 1) * 8192;
        if (t + 1 < NT) { kreg = *(const u32x4*)(kbp + (size_t)(t + 1) * 64 * PIN);
#pragma unroll
            for (int j = 0; j < NV; ++j) vreg[j] = *(const u32x4*)(vbp + (size_t)(t + 1) * 64 * PIN + j * 64);
            if (MASKED) { mwn[0] = mwp[(size_t)(t + 1) * S * 2]; mwn[1] = mwp[(size_t)(t + 1) * S * 2 + 64]; } }
#pragma unroll
        for (int kh = 0; kh < 2; ++kh) {
            attn_body::f32x16 p[2];
#pragma unroll
            for (int r = 0; r < 16; ++r) { p[0][r] = 0.f; p[1][r] = 0.f; }
#pragma unroll
            for (int d0 = 0; d0 < 4; ++d0) {
                const attn_body::bf16x8 kf = *(const LAS attn_body::bf16x8*)(kfb + slot + d0 * 2048 + kh * 512);
                p[0] = __builtin_amdgcn_mfma_f32_32x32x16_bf16(kf, qr[0][d0], p[0], 0, 0, 0);
                p[1] = __builtin_amdgcn_mfma_f32_32x32x16_bf16(kf, qr[1][d0], p[1], 0, 0, 0); }
            if (refmoved) {
#pragma unroll
                for (int nq = 0; nq < 2; ++nq)
#pragma unroll
                    for (int r = 0; r < 16; ++r) p[nq][r] -= mhat[nq]; }
            if (CAUSAL) { const int kbase = t * 64 + kh * 32;
                if (kbase + 31 > q0) {
#pragma unroll
                    for (int nq = 0; nq < 2; ++nq)
#pragma unroll
                        for (int r = 0; r < 16; ++r) if (kbase + attn_body::crow(r, hi) > q0 + nq * 32 + r32) p[nq][r] = -INFINITY; } }
            float rm[2] = {0.f, 0.f};
            if (!NOMAX)
#pragma unroll
            for (int nq = 0; nq < 2; ++nq) { float m_ = p[nq][0];
#pragma unroll
                for (int r = 1; r < 16; ++r) m_ = fmaxf(m_, p[nq][r]);
                rm[nq] = half_max(m_); }
            bool resc = false;
            if (!NOMAX && __any(fmaxf(rm[0], rm[1]) > 8.0f)) {
#pragma unroll
                for (int nq = 0; nq < 2; ++nq) { const float dl = fmaxf(rm[nq], 0.f); mhat[nq] += dl;
#pragma unroll
                    for (int r = 0; r < 16; ++r) p[nq][r] -= dl;
                    const float f = __builtin_amdgcn_exp2f(-dl); lsum[nq] *= f; if (hi == 0) wsf[nq * 32 + r32] = f; }
                resc = true; refmoved = true;
            }
            attn_body::bf16x8 pa[2][2];
#pragma unroll
            for (int nq = 0; nq < 2; ++nq) { const int wb = (int)mw[nq]; f32x2 ss2 = {0.f, 0.f};
#pragma unroll
                for (int r = 0; r < 16; ++r) { float e = __builtin_amdgcn_exp2f(p[nq][r]);
                    if (MASKED) { unsigned mk; asm("v_bfe_i32 %0, %1, %2, 1" : "=v"(mk) : "v"(wb), "n"(kh * 16 + r)); e = __uint_as_float(__float_as_uint(e) & mk); }
                    p[nq][r] = e; }
#pragma unroll
                for (int r = 0; r < 16; r += 2) ss2 += (f32x2){p[nq][r], p[nq][r + 1]};
                lsum[nq] += ss2.x + ss2.y;
                u32x4 pw0, pw1;
#pragma unroll
                for (int k = 0; k < 4; ++k) { pw0[k] = attn_body::cvtpk_s(p[nq][2 * k], p[nq][2 * k + 1]); pw1[k] = attn_body::cvtpk_s(p[nq][8 + 2 * k], p[nq][9 + 2 * k]); }
                pa[nq][0] = __builtin_bit_cast(attn_body::bf16x8, pw0); pa[nq][1] = __builtin_bit_cast(attn_body::bf16x8, pw1); }
            if (resc) { LDS_WAIT();
#pragma unroll
                for (int nq = 0; nq < 2; ++nq)
#pragma unroll
                    for (int r = 0; r < 16; ++r) { const float f = wsf[nq * 32 + attn_body::crow(r, hi)];
#pragma unroll
                        for (int j = 0; j < 2 * NV; ++j) o[nq][j][r] *= f; } }
#pragma unroll
            for (int blk = 0; blk < 2 * NV; ++blk)
#pragma unroll
                for (int k2 = 0; k2 < 2; ++k2) {
                    const LAS unsigned char* vb = vfb + (blk >> 1) * 16384 + slot + (blk & 1) * 4096 + (kh * 2 + k2) * 1024;
                    const attn_body::s16x4 lo_ = __builtin_bit_cast(attn_body::s16x4, __builtin_amdgcn_ds_read_tr16_b64_v4i16((vtr_ptr)vb)), hi_ = __builtin_bit_cast(attn_body::s16x4, __builtin_amdgcn_ds_read_tr16_b64_v4i16((vtr_ptr)(vb + 512)));
                    const attn_body::bf16x8 vf = (attn_body::bf16x8){lo_[0], lo_[1], lo_[2], lo_[3], hi_[0], hi_[1], hi_[2], hi_[3]};
                    o[0][blk] = __builtin_amdgcn_mfma_f32_32x32x16_bf16(pa[0][k2], vf, o[0][blk], 0, 0, 0);
                    o[1][blk] = __builtin_amdgcn_mfma_f32_32x32x16_bf16(pa[1][k2], vf, o[1][blk], 0, 0, 0); }
        }
        if (t + 1 < NT) { const int ns = 8192 - slot; *(LAS u32x4*)(ldsKs + ns + stoff) = kreg;
#pragma unroll
            for (int j = 0; j < NV; ++j) *(LAS u32x4*)(ldsVs + j * 16384 + ns + stoff) = vreg[j]; }
        mw[0] = mwn[0]; mw[1] = mwn[1];
        __syncthreads();
    }
#pragma unroll
    for (int nq = 0; nq < 2; ++nq) { lsum[nq] += shx_(lsum[nq], 32, lane); if (hi == 0) wsf[nq * 32 + r32] = lsum[nq]; }
    LDS_WAIT();
#pragma unroll
    for (int nq = 0; nq < 2; ++nq)
#pragma unroll
      for (int j = 0; j < NV; ++j) {
#pragma unroll
        for (int r = 0; r < 16; ++r) { const int orow = attn_body::crow(r, hi); const float rl = __builtin_amdgcn_rcpf(wsf[nq * 32 + orow]);
            stg[orow * 64 + r32] = (bf16_t)f2bf(o[nq][2 * j][r] * rl); stg[orow * 64 + 32 + r32] = (bf16_t)f2bf(o[nq][2 * j + 1][r] * rl); }
        LDS_WAIT();
#pragma unroll
        for (int q = 0; q < 4; ++q) { const int row = q * 8 + (lane >> 3), ch = lane & 7;
            *(u32x4*)(Ob + (size_t)(q0 + nq * 32 + row) * POUT + j * 64 + ch * 8) = *(const LAS u32x4*)(stg + row * 64 + ch * 8); }
        LDS_WAIT();
      }
    __syncthreads();
}
struct MoeRows {
    static constexpr bool GATHER = true;
    const LAS int* rb; const int* LTOK;
    __device__ __forceinline__ unsigned operator()(const pg8::Unit& u, int r) const { const int e = u.be; const int slot = u.pm * 256 + r - rb[e];
        const int tok = slot < rb[32 + e] ? LTOK[e * 32768 + slot] : 0; return (unsigned)tok * 2048u; }
};
__device__ __forceinline__ void moe_convert(const float* w1, const float* w3, const float* w2, bf16_t* W13, bf16_t* W2, LAS float* scr, int gw, int NGW, int lane) {
    for (int it = gw; it < 32 * 768; it += NGW) {
        const int e = it / 768; int r = it % 768;
        if (r < 256) { transpose_item(w1 + (size_t)e * 1024 * 512, 1024, 512, W13 + (size_t)e * 1024 * 1024, 2, 0, scr, r, 16, lane); continue; } r -= 256;
        if (r < 256) { transpose_item(w3 + (size_t)e * 1024 * 512, 1024, 512, W13 + (size_t)e * 1024 * 1024, 2, 1, scr, r, 16, lane); continue; } r -= 256;
        transpose_item(w2 + (size_t)e * 512 * 1024, 512, 1024, W2 + (size_t)e * 1024 * 512, 1, 0, scr, r, 32, lane);
    }
}
__device__ __forceinline__ void moe_tables(unsigned* ctl, int l, LAS int* tile_e, LAS int* rb, LAS int* nt_p, int tid) {
    if (tid < 64) {
        const int ln = tid;
        const int cnt = ln < 32 ? (int)__hip_atomic_load(ctl + CW_CNT + (l * 32 + (ln & 31)) * 64, __ATOMIC_RELAXED, __HIP_MEMORY_SCOPE_AGENT) : 0;
        const int ntile = (cnt + 255) >> 8;
        int inc = ntile;
#pragma unroll
        for (int off = 1; off < 32; off <<= 1) { const int v = (int)shi_((unsigned)inc, ln - off); if (ln >= off) inc += v; }
        if (ln < 32) { rb[ln] = (inc - ntile) * 256; rb[32 + ln] = cnt; }
        if (ln == 31) nt_p[0] = inc;
    }
    __syncthreads();
    const int nt = nt_p[0];
    for (int t = tid; t < nt; t += NTHREADS) {
        int lo = 0, hi = 31;
        while (lo < hi) { const int mid = (lo + hi + 1) >> 1; if (rb[mid] <= t * 256) lo = mid; else hi = mid - 1; }
        tile_e[t] = lo;
    }
    __syncthreads();
}

template <bool FIRST>
__device__ __forceinline__ float f_pass1(const float* __restrict__ xs_row, bf16_t* __restrict__ xb_row, const bf16_t* __restrict__ y_row, const LAS float* gate, const int kc) {
    float ss = 0.f;
#pragma unroll 1
    for (int s0 = 0; s0 < 32; s0 += 8) {
        u32x4 xr[8], yr[8]; f32x4 xa[8], xc[8];
#pragma unroll
        for (int k = 0; k < 8; ++k) { const int col = 32 * (s0 + k) + 8 * kc;
            if constexpr (FIRST) { xa[k] = *(const f32x4*)(xs_row + col); xc[k] = *(const f32x4*)(xs_row + col + 4); } else xr[k] = *(const u32x4*)(xb_row + col);
            yr[k] = *(const u32x4*)(y_row + col); }
        __builtin_amdgcn_sched_barrier(0);
#pragma unroll
        for (int k = 0; k < 8; ++k) { const int col = 32 * (s0 + k) + 8 * kc;
            f32x4 x0, x1;
            if constexpr (FIRST) { x0 = xa[k]; x1 = xc[k]; }
            else { float xv_[8]; unpack8(xr[k], xv_); x0 = (f32x4){xv_[0], xv_[1], xv_[2], xv_[3]}; x1 = (f32x4){xv_[4], xv_[5], xv_[6], xv_[7]}; }
            float yv[8]; unpack8(yr[k], yv);
            const f32x4 g0 = *(const LAS f32x4*)(gate + col), g1 = *(const LAS f32x4*)(gate + col + 4);
            float nv_[8] = {x0.x + g0.x * yv[0], x0.y + g0.y * yv[1], x0.z + g0.z * yv[2], x0.w + g0.w * yv[3], x1.x + g1.x * yv[4], x1.y + g1.y * yv[5], x1.z + g1.z * yv[6], x1.w + g1.w * yv[7]};
            const u32x4 xw = pack8(nv_); *(u32x4*)(xb_row + col) = xw;
            float rv_[8]; unpack8(xw, rv_);
#pragma unroll
            for (int e = 0; e < 8; ++e) ss += rv_[e] * rv_[e]; }
        __builtin_amdgcn_sched_barrier(0);
    }
    return ss;
}
__device__ __forceinline__ void f_pass2(const bf16_t* __restrict__ xb_row, bf16_t* __restrict__ h_row, const LAS float* modl, const bf16_t* __restrict__ wh, const bf16_t* __restrict__ wl, const float rn, const int kc, f32x4 (&acc)[3]) {
#pragma unroll 1
    for (int s0 = 0; s0 < 32; s0 += 4) {
        u32x4 xr[4]; pg8::bf16x8 bh[4][3], bl[4][3];
#pragma unroll
        for (int k = 0; k < 4; ++k) { const int col = 32 * (s0 + k) + 8 * kc; xr[k] = *(const u32x4*)(xb_row + col);
#pragma unroll
            for (int ct = 0; ct < 3; ++ct) { bh[k][ct] = *(const pg8::bf16x8*)(wh + (size_t)ct * 16 * 1024 + 32 * (s0 + k)); bl[k][ct] = *(const pg8::bf16x8*)(wl + (size_t)ct * 16 * 1024 + 32 * (s0 + k)); } }
        __builtin_amdgcn_sched_barrier(0);
#pragma unroll
        for (int k = 0; k < 4; ++k) { const int col = 32 * (s0 + k) + 8 * kc;
            f32x4 x0, x1; { float xv_[8]; unpack8(xr[k], xv_); x0 = (f32x4){xv_[0], xv_[1], xv_[2], xv_[3]}; x1 = (f32x4){xv_[4], xv_[5], xv_[6], xv_[7]}; }
            const f32x4 c0 = *(const LAS f32x4*)(modl + 2048 + col), c1 = *(const LAS f32x4*)(modl + 2048 + col + 4), s0_ = *(const LAS f32x4*)(modl + 1024 + col), s1_ = *(const LAS f32x4*)(modl + 1024 + col + 4);
            float hv[8];
            hv[0] = x0.x * rn * (1.f + c0.x) + s0_.x; hv[1] = x0.y * rn * (1.f + c0.y) + s0_.y; hv[2] = x0.z * rn * (1.f + c0.z) + s0_.z; hv[3] = x0.w * rn * (1.f + c0.w) + s0_.w;
            hv[4] = x1.x * rn * (1.f + c1.x) + s1_.x; hv[5] = x1.y * rn * (1.f + c1.y) + s1_.y; hv[6] = x1.z * rn * (1.f + c1.z) + s1_.z; hv[7] = x1.w * rn * (1.f + c1.w) + s1_.w;
            const u32x4 hh = pack8(hv);
            *(u32x4*)(h_row + col) = hh;
            float hl[8]; { float hf[8]; unpack8(hh, hf);
#pragma unroll
                for (int e = 0; e < 8; ++e) hl[e] = hv[e] - hf[e]; }
            const u32x4 hlw = pack8(hl);
            const pg8::bf16x8 ah = __builtin_bit_cast(pg8::bf16x8, hh), al = __builtin_bit_cast(pg8::bf16x8, hlw);
#pragma unroll
            for (int ct = 0; ct < 3; ++ct) {
                acc[ct] = __builtin_amdgcn_mfma_f32_16x16x32_bf16(ah, bh[k][ct], acc[ct], 0, 0, 0);
                acc[ct] = __builtin_amdgcn_mfma_f32_16x16x32_bf16(ah, bl[k][ct], acc[ct], 0, 0, 0);
                acc[ct] = __builtin_amdgcn_mfma_f32_16x16x32_bf16(al, bh[k][ct], acc[ct], 0, 0, 0);
            } }
        __builtin_amdgcn_sched_barrier(0);
    }
}

__device__ __forceinline__ float relu_i(float x) { return __builtin_bit_cast(float, max(__builtin_bit_cast(int, x), 0)); }
__device__ __forceinline__ unsigned pk_gt_u16(unsigned a, unsigned b, unsigned ones) { unsigned d; asm("v_pk_sub_u16 %0, %1, %2 clamp" : "=v"(d) : "v"(a), "v"(b)); unsigned r; asm("v_pk_min_u16 %0, %1, %2" : "=v"(r) : "v"(d), "v"(ones)); return r; }
__device__ __forceinline__ unsigned spread16(unsigned x) { x = (x | (x << 8)) & 0x00FF00FFu; x = (x | (x << 4)) & 0x0F0F0F0Fu; x = (x | (x << 2)) & 0x33333333u; x = (x | (x << 1)) & 0x55555555u; return x; }
__device__ __forceinline__ unsigned ilv16(unsigned a) { return spread16(a & 0xFFFFu) | (spread16(a >> 16) << 1); }
__device__ __forceinline__ int lane_id_v() { int v; asm volatile("v_mbcnt_lo_u32_b32 %0, -1, 0\n\tv_mbcnt_hi_u32_b32 %0, -1, %0" : "=v"(v)); return v; }
__device__ __forceinline__ unsigned long long lsg64(unsigned long long v) { asm volatile("" : "+s"(v)); return v; }
__device__ __forceinline__ int lsg(int v) { asm volatile("" : "+s"(v)); return v; }
__device__ __forceinline__ int lvg(int v) { asm volatile("" : "+v"(v)); return v; }
__device__ __forceinline__ LAS unsigned char* lsgp(LAS unsigned char* p) { unsigned v = (unsigned)(unsigned long long)p; asm volatile("" : "+s"(v)); return (LAS unsigned char*)(unsigned long long)v; }
__device__ __forceinline__ void* ldptr(const LAS unsigned long long* tbl, int k) {
    const unsigned long long v = tbl[k];
    const unsigned lo = __builtin_amdgcn_readfirstlane((unsigned)v), hi = __builtin_amdgcn_readfirstlane((unsigned)(v >> 32));
    return (void*)(__attribute__((address_space(1))) void*)(((unsigned long long)hi << 32) | lo);
}
#define DECL_PTRS() \
    const int wid = lsg(wid0), lane = lane_id_v(), tid = wid * 64 + lane; \
    const int G = lsg(G0), c = lsg(c0), l = lsg(l0), i = l >> 1; \
    const int gw = c * NWAVES + wid, NGW = G * NWAVES, gt = c * NTHREADS + tid, NGT = G * NTHREADS; \
    LAS unsigned char* lds = (LAS unsigned char*)lsgp(lds0); LAS unsigned char* glds = lds; LAS float* scr = (LAS float*)(lds + wid * 16384); \
    const LAS unsigned long long* ptbl = (const LAS unsigned long long*)(lds + LDS_PTBL); \
    unsigned char* ws = (unsigned char*)ldptr(ptbl, 38); unsigned* ctl = (unsigned*)(ws + WS_CTL); \
    const float* xin = (const float*)ldptr(ptbl, 0); \
    const float* cin = (const float*)ldptr(ptbl, 1); \
    const float* ada_w = (const float*)ldptr(ptbl, 2); \
    const float* ada_b = (const float*)ldptr(ptbl, 3); \
    const float* moe_wg = (const float*)ldptr(ptbl, 4); \
    const float* moe_bg = (const float*)ldptr(ptbl, 5); \
    const float* moe_we = (const float*)ldptr(ptbl, 6); \
    const float* moe_be = (const float*)ldptr(ptbl, 7); \
    const float* moe_w1 = (const float*)ldptr(ptbl, 8); \
    const float* moe_w3 = (const float*)ldptr(ptbl, 9); \
    const float* moe_w2 = (const float*)ldptr(ptbl, 10); \
    const float* ev_w_in = (const float*)ldptr(ptbl, 11); \
    const float* ev_w_out = (const float*)ldptr(ptbl, 12); \
    const float* a_qn = (const float*)ldptr(ptbl, 13); \
    const float* a_kn = (const float*)ldptr(ptbl, 14); \
    const float* a_lq1 = (const float*)ldptr(ptbl, 15); \
    const float* a_lk1 = (const float*)ldptr(ptbl, 16); \
    const float* a_lq2 = (const float*)ldptr(ptbl, 17); \
    const float* a_lk2 = (const float*)ldptr(ptbl, 18); \
    const float* a_subln = (const float*)ldptr(ptbl, 19); \
    const float* b_qn = (const float*)ldptr(ptbl, 20); \
    const float* b_kn = (const float*)ldptr(ptbl, 21); \
    const float* b_idx_kn = (const float*)ldptr(ptbl, 22); \
    const float* od_w_in = (const float*)ldptr(ptbl, 23); \
    const float* od_w_out = (const float*)ldptr(ptbl, 24); \
    const float* c_qn = (const float*)ldptr(ptbl, 25); \
    const float* c_kn = (const float*)ldptr(ptbl, 26); \
    const float* s5_lam_re = (const float*)ldptr(ptbl, 27); \
    const float* s5_lam_im = (const float*)ldptr(ptbl, 28); \
    const float* s5_b_re = (const float*)ldptr(ptbl, 29); \
    const float* s5_b_im = (const float*)ldptr(ptbl, 30); \
    const float* s5_c_re = (const float*)ldptr(ptbl, 31); \
    const float* s5_c_im = (const float*)ldptr(ptbl, 32); \
    const float* s5_d = (const float*)ldptr(ptbl, 33); \
    const float* s5_log_dt = (const float*)ldptr(ptbl, 34); \
    const float* s5_glu_w = (const float*)ldptr(ptbl, 35); \
    const float* s5_glu_b = (const float*)ldptr(ptbl, 36); \
    float* out = (float*)ldptr(ptbl, 37); \
    float* MOD = (float*)(ws + WS_MOD); \
    float* MODP = (float*)(ws + WS_MODP); \
    float* COSH = (float*)(ws + WS_ROPE); \
    float* SINH = COSH + S * 8; \
    float* COSI = SINH + S * 8; \
    float* SINI = COSI + S * 4; \
    float* S5A = (float*)(ws + WS_S5A); \
    float* S5B = (float*)(ws + WS_S5B); \
    float* LAM = (float*)(ws + WS_LAM); \
    float* KM = (float*)(ws + WS_KM); \
    bf16_t* KMH = (bf16_t*)(ws + WS_KMH); \
    bf16_t* WRH = (bf16_t*)(ws + WS_WRH); \
    bf16_t* WRL = (bf16_t*)(ws + WS_WRH + 393216); \
    bf16_t* KML = (bf16_t*)(ws + WS_KMH + 131072); \
    bf16_t* Wevin = (bf16_t*)(ws + WS_WEVIN); \
    bf16_t* Wevout = (bf16_t*)(ws + WS_WEVOUT); \
    bf16_t* Wodin = (bf16_t*)(ws + WS_WODIN); \
    bf16_t* Wodout = (bf16_t*)(ws + WS_WODOUT); \
    bf16_t* Wglu = (bf16_t*)(ws + WS_WGLU); \
    bf16_t* W13 = (bf16_t*)(ws + WS_W13); \
    bf16_t* W2 = (bf16_t*)(ws + WS_W2); \
    bf16_t* H = (bf16_t*)(ws + WS_H); \
    bf16_t* O = (bf16_t*)(ws + WS_O); \
    bf16_t* Z = (bf16_t*)(ws + WS_Z); \
    bf16_t* XG = (bf16_t*)(ws + WS_XG); \
    bf16_t* Y = (bf16_t*)(ws + WS_Y); \
    bf16_t* HID = (bf16_t*)(ws + WS_HID); \
    float* IQ = (float*)(ws + WS_IQ); \
    bf16_t* YG = (bf16_t*)(ws + WS_YG); \
    float* IKW = (float*)(ws + WS_IKW); \
    _Float16* IQH = (_Float16*)(ws + WS_IQH); \
    _Float16* IKH = (_Float16*)(ws + WS_IKH); \
    float* IW = (float*)(ws + WS_IW); \
    int* SEL = (int*)(ws + WS_SEL); \
    bf16_t* YMIX = (bf16_t*)(ws + WS_YMIX); \
    int* TOKES = (int*)(ws + WS_TOKES); \
    int* LTOK = (int*)(ws + WS_LTOK); \
    float* TOKW = (float*)(ws + WS_TOKW); \
    int* TOKROW = (int*)(ws + WS_TOKROW); \
    bf16_t* UG = (bf16_t*)(ws + WS_UG); \
    float* S5E = (float*)(ws + WS_S5E); \
    bf16_t* S5HC = (bf16_t*)(ws + WS_S5HC); \
    bf16_t* S5KT = (bf16_t*)(ws + WS_S5KT); \
    bf16_t* S5WT = (bf16_t*)(ws + WS_S5WT); \
    bf16_t* S5A2 = (bf16_t*)(ws + WS_S5A2); \
    float* S5PW = (float*)(ws + WS_S5PW); \
    int* MLIST = (int*)(ws + WS_MLIST); \
    bf16_t* MPO = (bf16_t*)(ws + WS_MPO); \
    float* MML = (float*)(ws + WS_MML); \
    int* NSEL = (int*)(ws + WS_NSEL); \
    unsigned* MASKW = (unsigned*)(ws + WS_MASKW); \
    bf16_t* XB = (bf16_t*)(ws + WS_XB);
__global__ void __launch_bounds__(NTHREADS, 2) fwd(Args a) {
    extern __shared__ __attribute__((aligned(16))) unsigned char lds_raw[];
    LAS unsigned char* lds = (LAS unsigned char*)lds_raw;
    const int tid0 = threadIdx.x; const int wid0 = __builtin_amdgcn_readfirstlane(tid0 >> 6);
    const int G0 = gridDim.x, c0 = blockIdx.x;
    unsigned* ctl0 = (unsigned*)(a.ws + WS_CTL);
    LAS unsigned char* lds0 = lds;
    const int lo = a.ph_lo, hi = a.ph_hi;

    LAS unsigned long long* ptbl = (LAS unsigned long long*)(lds + LDS_PTBL);
    if (tid0 == 0) {
#define PT_(k) ptbl[k] = (unsigned long long)a.in[k];
        PT_(0) PT_(1) PT_(2) PT_(3) PT_(4) PT_(5) PT_(6) PT_(7) PT_(8) PT_(9) PT_(10) PT_(11) PT_(12) PT_(13) PT_(14) PT_(15) PT_(16) PT_(17) PT_(18)
        PT_(19) PT_(20) PT_(21) PT_(22) PT_(23) PT_(24) PT_(25) PT_(26) PT_(27) PT_(28) PT_(29) PT_(30) PT_(31) PT_(32) PT_(33) PT_(34) PT_(35) PT_(36)
#undef PT_
        ptbl[37] = (unsigned long long)a.out; ptbl[38] = (unsigned long long)a.ws;
    }
    if (tid0 < 4) ((LAS unsigned*)(lds + LDS_BARW))[tid0] = 0u;
    __syncthreads();
    XcdBarrier bar; bar.bar = ctl0 + CW_BAR; bar.x = 0; bar.st = (volatile LAS unsigned*)(lds + LDS_BARW);
    if (hi - lo > 1) bar = xcd_barrier_post(ctl0 + CW_BAR, (volatile LAS unsigned*)(lds + LDS_BARW), tid0 == 0);
    int ph = 0, l0 = 0;
#define PH_ON() (ph >= lo && ph < hi)
#define PH_END() do { if (ph >= lo && ph + 1 < hi) { XcdBarrier bb_; bb_.bar = (unsigned*)lsg64((unsigned long long)bar.bar); bb_.x = bar.x; bb_.st = bar.st; xcd_barrier(bb_, lsg(wid0) == 0 && lane_id_v() == 0); PROBE_EXTRA_BAR(bb_) } ++ph; } while (0)

    if (PH_ON()) { DECL_PTRS();
        {
            constexpr int I_EVIN = 16 * 112, I_SQ = 16 * 32, I_ODIN = 16 * 64, I_GLU = 8 * 16;
            constexpr int I_PER = I_EVIN + I_SQ + I_ODIN + I_SQ + I_GLU;
            for (int it = gw; it < 2 * I_PER; it += NGW) {
                const int i = it / I_PER; int r = it % I_PER;
                if (r < I_EVIN) { transpose_item(ev_w_in + (size_t)i * 1024 * EV_N, 1024, EV_N, Wevin + (size_t)i * EV_NP * 1024, -1, 0, scr, r, 112, lane); continue; } r -= I_EVIN;
                if (r < I_SQ) { transpose_item(ev_w_out + (size_t)i * 1024 * 1024, 1024, 1024, Wevout + (size_t)i * 1024 * 1024, 1, 0, scr, r, 32, lane); continue; } r -= I_SQ;
                if (r < I_ODIN) { transpose_item(od_w_in + (size_t)i * 1024 * 2048, 1024, 2048, Wodin + (size_t)i * 2048 * 1024, -2, 0, scr, r, 64, lane); continue; } r -= I_ODIN;
                if (r < I_SQ) { transpose_item(od_w_out + (size_t)i * 1024 * 1024, 1024, 1024, Wodout + (size_t)i * 1024 * 1024, 1, 0, scr, r, 32, lane); continue; } r -= I_SQ;
                transpose_item(s5_glu_w + (size_t)i * 512 * 512, 512, 512, Wglu + (size_t)i * 512 * 512, 1, 0, scr, r, 16, lane);
            }
        }
        __syncthreads();
        {
            LAS float* cact = (LAS float*)lds;
            for (int i = tid; i < 2048; i += NTHREADS) { const float v = cin[i]; cact[i] = v / (1.0f + __expf(-v)); }
            __syncthreads();
            for (int idx = gt; idx < 4 * 4 * 6144; idx += NGT) {
                const int kq = idx / 24576, rem = idx % 24576, l = rem / 6144, n = rem % 6144;
                const float* w = ada_w + ((size_t)l * 1024 + kq * 256) * 6144 + n;
                float a0 = 0.f, a1 = 0.f;
#pragma unroll 32
                for (int k = 0; k < 256; ++k) { const float wv = w[(size_t)k * 6144]; a0 += cact[kq * 256 + k] * wv; a1 += cact[1024 + kq * 256 + k] * wv; }
                MODP[((size_t)(kq * 4 + l) * 2 + 0) * 6144 + n] = a0;
                MODP[((size_t)(kq * 4 + l) * 2 + 1) * 6144 + n] = a1;
            }
            __syncthreads();
        }
        for (int idx = gt; idx < S * 12; idx += NGT) {
            if (idx < S * 8) { const int pos = idx >> 3, j = idx & 7; const float inv = (float)pow(500000.0, -(double)(2 * j) / 16.0); const float ang = (float)pos * inv;
                COSH[idx] = (float)cos((double)ang); SINH[idx] = (float)sin((double)ang); }
            else { const int k = idx - S * 8; const int pos = k >> 2, j = k & 3; const float inv = (float)pow(500000.0, -(double)(2 * j) / 8.0); const float ang = (float)pos * inv;
                COSI[k] = (float)cos((double)ang); SINI[k] = (float)sin((double)ang); }
        }
        for (int idx = gt; idx < 2 * 32 * 64; idx += NGT) {
            const int i = idx >> 11, g = (idx >> 6) & 31;
            const float dt = expf(s5_log_dt[i * 32 + g]);
            const float lr = s5_lam_re[idx], li = s5_lam_im[idx];
            const float mag = expf(lr * dt);
            const float ar = mag * (float)cos((double)(li * dt)), ai = mag * (float)sin((double)(li * dt));
            const float den = lr * lr + li * li;
            const float cr = ((ar - 1.0f) * lr + ai * li) / den, ci = (ai * lr - (ar - 1.0f) * li) / den;
            S5A[idx * 2] = ar; S5A[idx * 2 + 1] = ai;
            { float pr = 1.f, pi_ = 0.f; for (int n = 0; n <= 64; ++n) { S5PW[((size_t)idx * 65 + n) * 2] = pr; S5PW[((size_t)idx * 65 + n) * 2 + 1] = pi_; const float nr = pr * ar - pi_ * ai, ni = pr * ai + pi_ * ar; pr = nr; pi_ = ni; } }
            { float brv[16], biv[16];
#pragma unroll
              for (int cc = 0; cc < 16; ++cc) { brv[cc] = s5_b_re[(size_t)idx * 16 + cc]; biv[cc] = s5_b_im[(size_t)idx * 16 + cc]; }
              __builtin_amdgcn_sched_barrier(0);
#pragma unroll
              for (int cc = 0; cc < 16; ++cc) { const float br = brv[cc], bi = biv[cc];
                  *(f32x2*)(S5B + ((size_t)idx * 16 + cc) * 2) = (f32x2){cr * br - ci * bi, cr * bi + ci * br}; } }
        }
        for (int idx = gt; idx < DEPTH * 48 * 1024; idx += NGT) {
            const int k = idx & 1023, col = (idx >> 10) % 48, ll = idx / (48 * 1024);
            const float w = col < 4 ? moe_wg[((size_t)ll * 1024 + k) * 4 + col] : col < 36 ? moe_we[((size_t)ll * 1024 + k) * 32 + col - 4] : 0.f;
            const unsigned hb = f2bf(w); WRH[idx] = (bf16_t)hb; WRL[idx] = (bf16_t)f2bf(w - __uint_as_float(hb << 16));
        }
        if (gw < 2) { const int i = gw;
            const float s1 = wave_sum(a_lq1[i * 64 + lane] * a_lk1[i * 64 + lane]), s2 = wave_sum(a_lq2[i * 64 + lane] * a_lk2[i * 64 + lane]);
            const float lam_init = 0.8f - 0.6f * expf(-0.3f * (float)(2 * i));
            if (lane == 0) LAM[i] = expf(s1) - expf(s2) + lam_init; }
    }
    PH_END();
    if (PH_ON()) { DECL_PTRS();
        for (int idx = gt; idx < 4 * 2 * 6144; idx += NGT) {
            const int l = idx / 12288, b = (idx / 6144) & 1, n = idx % 6144;
            float v = ada_b[l * 6144 + n];
#pragma unroll
            for (int kq = 0; kq < 4; ++kq) v += MODP[((size_t)(kq * 4 + l) * 2 + b) * 6144 + n];
            MOD[idx] = v;
        }
        for (int idx = gt; idx < 2 * 32 * 65 * 256; idx += NGT) {
            const int ci = idx & 15, co = (idx >> 4) & 15, tr = (idx >> 8) % 65, ig = idx / (65 * 256);
            float acc = 0.f;
            if (tr > 0) {
                const int tau = tr - 1;
#pragma unroll 16
                for (int p = 0; p < 64; ++p) { const int sp = ig * 64 + p;
                    const float cr = s5_c_re[((size_t)ig * 16 + co) * 64 + p], cim_ = s5_c_im[((size_t)ig * 16 + co) * 64 + p];
                    const f32x2 pw_ = *(const f32x2*)(S5PW + ((size_t)sp * 65 + tau) * 2), bb_ = *(const f32x2*)(S5B + ((size_t)sp * 16 + ci) * 2);
                    const float pr = pw_.x, pi_ = pw_.y, br = bb_.x, bi = bb_.y;
                    const float xr = cr * pr - cim_ * pi_, xi = cr * pi_ + cim_ * pr;
                    acc += xr * br - xi * bi; }
            }
            S5KT[((size_t)ig * 65 + tr) * 384 + co * 24 + ci] = (bf16_t)f2bf(acc);
        }
        constexpr int NW_ = 2 * 32 * 128 * 1024;
        for (int idx0 = gt; idx0 < NW_; idx0 += NGT * 8) {
            f32x2 pw_[8], bb_[8];
#pragma unroll
            for (int u = 0; u < 8; ++u) { const int idx = min(idx0 + u * NGT, NW_ - 1);
                const int k = idx & 1023, row = (idx >> 10) & 127, ig = idx >> 17; const int s = k >> 4, ci = k & 15, p = row >> 1; const int sp = ig * 64 + p;
                pw_[u] = *(const f32x2*)(S5PW + ((size_t)sp * 65 + (63 - s)) * 2); bb_[u] = *(const f32x2*)(S5B + ((size_t)sp * 16 + ci) * 2); }
            __builtin_amdgcn_sched_barrier(0);
#pragma unroll
            for (int u = 0; u < 8; ++u) { const int idx = idx0 + u * NGT;
                if (idx < NW_) { const int ri = (idx >> 10) & 1; const float pr = pw_[u].x, pi_ = pw_[u].y, br = bb_[u].x, bi = bb_[u].y;
                    S5WT[idx] = (bf16_t)f2bf(ri ? (pr * bi + pi_ * br) : (pr * br - pi_ * bi)); } }
            __builtin_amdgcn_sched_barrier(0);
        }
        for (int idx0 = gt; idx0 < NW_; idx0 += NGT * 8) {
            f32x2 pw_[8]; float crv[8], civ[8];
#pragma unroll
            for (int u = 0; u < 8; ++u) { const int idx = min(idx0 + u * NGT, NW_ - 1);
                const int k = idx & 127, rowt = (idx >> 7) & 1023, ig = idx >> 17; const int t = rowt >> 4, co = rowt & 15, p = k >> 1; const int sp = ig * 64 + p;
                crv[u] = s5_c_re[((size_t)ig * 16 + co) * 64 + p]; civ[u] = s5_c_im[((size_t)ig * 16 + co) * 64 + p];
                pw_[u] = *(const f32x2*)(S5PW + ((size_t)sp * 65 + t + 1) * 2); }
            __builtin_amdgcn_sched_barrier(0);
#pragma unroll
            for (int u = 0; u < 8; ++u) { const int idx = idx0 + u * NGT;
                if (idx < NW_) { const int ri = idx & 1; const float cr = crv[u], cim_ = civ[u], pr = pw_[u].x, pi_ = pw_[u].y;
                    S5A2[idx] = (bf16_t)f2bf(ri ? -(cr * pi_ + cim_ * pr) : (cr * pr - cim_ * pi_)); } }
            __builtin_amdgcn_sched_barrier(0);
        }
    }
    PH_END();
    if (PH_ON()) { DECL_PTRS();
        for (int t0 = gw * 4; t0 < T; t0 += NGW * 4) {
            const int b = t0 / S; const float* mo = MOD + (size_t)(0 * 2 + b) * 6144;
            f32x4 v[4][4], sc1[4], sh1[4];
#pragma unroll
            for (int u = 0; u < 4; ++u)
#pragma unroll
                for (int j = 0; j < 4; ++j) v[u][j] = *(const f32x4*)(xin + (size_t)(t0 + u) * 1024 + 4 * lane + 256 * j);
#pragma unroll
            for (int j = 0; j < 4; ++j) { sc1[j] = *(const f32x4*)(mo + 1024 + 4 * lane + 256 * j); sh1[j] = *(const f32x4*)(mo + 4 * lane + 256 * j); }
            __builtin_amdgcn_sched_barrier(0);
#pragma unroll
            for (int u = 0; u < 4; ++u) { float ss = 0.f;
#pragma unroll
                for (int j = 0; j < 4; ++j) ss += (v[u][j].x * v[u][j].x + v[u][j].y * v[u][j].y) + (v[u][j].z * v[u][j].z + v[u][j].w * v[u][j].w);
                const float rn = rsqrtf(wave_sum(ss) * (1.0f / 1024.0f) + EPS);
#pragma unroll
                for (int j = 0; j < 4; ++j) { const int col = 4 * lane + 256 * j;
                    u32x2 w; w.x = pk2(v[u][j].x * rn * (1.f + sc1[j].x) + sh1[j].x, v[u][j].y * rn * (1.f + sc1[j].y) + sh1[j].y); w.y = pk2(v[u][j].z * rn * (1.f + sc1[j].z) + sh1[j].z, v[u][j].w * rn * (1.f + sc1[j].w) + sh1[j].w);
                    *(u32x2*)(H + (size_t)(t0 + u) * 1024 + col) = w; } }
            __builtin_amdgcn_sched_barrier(0);
        }
    }
    PH_END();

    for (l0 = 0; l0 < DEPTH; ++l0) {
        if ((l0 & 1) == 0) {
            if (PH_ON()) { DECL_PTRS();
                pg8::Gemm g{H, Wevin + (size_t)i * EV_NP * 1024, T, EV_NP, 1024, 0}; pg8::StaticOrder So; So.init(T, EV_NP, G, c);
                EpiEvenIn E{Z, IQH, IKH, IW, a_kn + i * 64, b_kn + i * 64, b_idx_kn + i * 32, COSH, SINH, COSI, SINI};
                { PROBE_WRAP(pg8::StaticOrder, So); pg8::gemm_phase<EpiEvenIn, PROBE_SCHED(pg8::StaticOrder), true, true>(glds, g, PS_, E, tid); }
            }
            PH_END();
            if (PH_ON()) { DECL_PTRS();
                moe_convert(moe_w1 + (size_t)l * 32 * 1024 * 512, moe_w3 + (size_t)l * 32 * 1024 * 512, moe_w2 + (size_t)l * 32 * 512 * 1024, W13, W2, scr, gw, NGW, lane);
                __syncthreads();
                {
                    LAS unsigned short* kq = (LAS unsigned short*)lds;
                    const int qi = tid >> 7, ht = tid & 127;
                    LAS unsigned short* kqq = kq + qi * 16384;
                    LAS unsigned* hist = (LAS unsigned*)(lds + LDS_MISC + qi * 6400);
                    LAS unsigned* bits = hist + 1024;
                    LAS unsigned* misc = hist + 1536;
                    for (int it = 0;; ++it) {
                        const int L = it * G + c; if (L >= 8192) break;
                        const int uu = (L & 1) ? (8191 - (L >> 1)) : (L >> 1);
                        const int b = uu >> 12, pp = uu & 4095;
                        const size_t tA = (size_t)b * S + 4 * pp;
                        const int nD = 4 * pp + 4;
#pragma unroll
                        for (int q = 0; q < 8; ++q) hist[ht + 128 * q] = 0u;
                        __syncthreads();
#ifdef PROBE_MASK
                        if (a.probe_var != 2)
#endif
                        {
                            const int r32 = lane & 31, hi = lane >> 5;
                            typedef _Float16 f16x8_t __attribute__((ext_vector_type(8)));
                            f16x8_t qa[2];
#pragma unroll
                            for (int s = 0; s < 2; ++s) qa[s] = *(const f16x8_t*)(IQH + (tA + 2 * ((r32 >> 2) & 1) + (r32 >> 4)) * 256 + (4 * ((r32 >> 3) & 1) + (r32 & 3)) * 32 + 16 * s + 8 * hi);
                            f32x4 wq[4];
#pragma unroll
                            for (int q = 0; q < 4; ++q) wq[q] = *(const f32x4*)(IW + (tA + 2 * hi + (q >> 1)) * 8 + 4 * (q & 1));
                            const int ntile = (nD + 31) >> 5;
                            const _Float16* kbase = IKH + ((size_t)b * S + r32) * 32 + 8 * hi;
                            f16x8_t kb[4][2], kn[4][2];
#pragma unroll
                            for (int u = 0; u < 4; ++u) { const int tile = min(wid + NWAVES * u, ntile - 1);
                                kb[u][0] = *(const f16x8_t*)(kbase + (size_t)tile * 1024); kb[u][1] = *(const f16x8_t*)(kbase + (size_t)tile * 1024 + 16); }
                            for (int tile0 = wid; tile0 < ntile; tile0 += NWAVES * 4) {
#pragma unroll
                                for (int u = 0; u < 4; ++u) { const int tile = min(tile0 + NWAVES * (4 + u), ntile - 1);
                                    kn[u][0] = *(const f16x8_t*)(kbase + (size_t)tile * 1024); kn[u][1] = *(const f16x8_t*)(kbase + (size_t)tile * 1024 + 16); }
#pragma unroll
                                for (int u = 0; u < 4; ++u) {
                                    const int tile = tile0 + NWAVES * u;
                                    attn_body::f32x16 acc;
#pragma unroll
                                    for (int r = 0; r < 16; ++r) acc[r] = 0.f;
                                    acc = __builtin_amdgcn_mfma_f32_32x32x16_f16(qa[0], kb[u][0], acc, 0, 0, 0);
                                    acc = __builtin_amdgcn_mfma_f32_32x32x16_f16(qa[1], kb[u][1], acc, 0, 0, 0);
                                    float sq[4];
#pragma unroll
                                    for (int q = 0; q < 4; ++q) sq[q] = wq[q].x * relu_i(acc[4 * q]) + wq[q].y * relu_i(acc[4 * q + 1]) + wq[q].z * relu_i(acc[4 * q + 2]) + wq[q].w * relu_i(acc[4 * q + 3]);
                                    if (tile < ntile) {
                                        const float sa = sq[0] + sq[1], sb = sq[2] + sq[3];
                                        const unsigned h0 = (unsigned)__builtin_bit_cast(unsigned short, (_Float16)sa), h1 = (unsigned)__builtin_bit_cast(unsigned short, (_Float16)sb);
                                        const unsigned k0_ = (h0 ^ ((unsigned)__builtin_amdgcn_sbfe((int)h0, 15, 1) | 0x8000u)) & 0xFFFFu, k1_ = (h1 ^ ((unsigned)__builtin_amdgcn_sbfe((int)h1, 15, 1) | 0x8000u)) & 0xFFFFu;
                                        const int kidx = tile * 32 + r32;
                                        kq[(2 * hi) * 16384 + kidx] = (unsigned short)k0_;
                                        kq[(2 * hi + 1) * 16384 + kidx] = (unsigned short)k1_;
                                        LAS unsigned* hq0 = (LAS unsigned*)(lds + LDS_MISC + (2 * hi) * 6400); LAS unsigned* hq1 = (LAS unsigned*)(lds + LDS_MISC + (2 * hi + 1) * 6400);
                                        __hip_atomic_fetch_add(&hq0[(kidx <= 4 * pp + 2 * hi) ? ((k0_ >> 8) << 2) + (lane & 3) : 1536 + 32 + (lane & 3)], 1u, __ATOMIC_RELAXED, __HIP_MEMORY_SCOPE_WORKGROUP);
                                        __hip_atomic_fetch_add(&hq1[(kidx <= 4 * pp + 2 * hi + 1) ? ((k1_ >> 8) << 2) + (lane & 3) : 1536 + 32 + (lane & 3)], 1u, __ATOMIC_RELAXED, __HIP_MEMORY_SCOPE_WORKGROUP);
                                    }
                                }
#pragma unroll
                                for (int u = 0; u < 4; ++u) { kb[u][0] = kn[u][0]; kb[u][1] = kn[u][1]; }
                            }
                        }
                        __syncthreads();
#ifdef PROBE_MASK
                        if (a.probe_var == 1) continue;
#endif
                        const int n = 4 * pp + 1 + qi;
                        const bool small = n <= 256;
                        if (ht == 0) { misc[0] = 0u; misc[1] = 256u; misc[2] = 0u; }
                        const LAS unsigned* kq32 = (const LAS unsigned*)kqq;
                        const int npair = (n + 1) >> 1;
                        for (int pass = 0; pass < 2; ++pass) {
                            if (pass) {
#pragma unroll
                                for (int q = 0; q < 8; ++q) hist[ht + 128 * q] = 0u; }
                            __syncthreads();
                            const int shift = 8 - 8 * pass;
                            if (!small && pass) {
                                const unsigned prefix = misc[0];
                                for (int W = ht; 32 * W < n; W += 128) {
                                    const unsigned vmask = (n - 32 * W >= 32) ? 0xFFFFFFFFu : ((1u << (n - 32 * W)) - 1u);
                                    const LAS u32x4* kp = (const LAS u32x4*)(kq32 + 16 * W);
                                    unsigned ne = 0u;
                                    const unsigned pp2 = prefix | (prefix << 16);
#pragma unroll
                                    for (int q4 = 0; q4 < 4; ++q4) { const u32x4 w4 = kp[q4];
#pragma unroll
                                        for (int e = 0; e < 4; ++e) ne |= pk_gt_u16((w4[e] ^ pp2) & 0xFF00FF00u, 0u, 0x00010001u) << (4 * q4 + e); }
                                    unsigned mm = ilv16(~ne) & vmask;
                                    const LAS unsigned short* k16 = kqq + 32 * W;
                                    while (mm) { const int j = __ffs(mm) - 1; mm &= mm - 1u;
                                        __hip_atomic_fetch_add(&hist[(((unsigned)k16[j] & 255u) << 2) + (lane & 3)], 1u, __ATOMIC_RELAXED, __HIP_MEMORY_SCOPE_WORKGROUP); }
                                }
                            }
                            __syncthreads();
                            if (!small && ht < 64) {
                                unsigned cb[4];
#pragma unroll
                                for (int q = 0; q < 4; ++q) { const u32x4 a0 = *(const LAS u32x4*)(hist + (4 * ht + q) * 4); cb[q] = (a0.x + a0.y) + (a0.z + a0.w); }
                                const unsigned c0 = cb[0], c1 = cb[1], c2 = cb[2], c3 = cb[3];
                                const unsigned tot = c0 + c1 + c2 + c3;
                                unsigned Ssum = tot;
#pragma unroll
                                for (int off = 1; off < 64; off <<= 1) { const unsigned v = shi_(Ssum, lane + off); if (ht + off < 64) Ssum += v; }
                                const unsigned above = Ssum - tot, krem = misc[1];
                                if (above < krem && krem <= Ssum) {
                                    unsigned run = above, bin, eq;
                                    if (run + c3 >= krem) { bin = 3; eq = c3; }
                                    else { run += c3; if (run + c2 >= krem) { bin = 2; eq = c2; }
                                        else { run += c2; if (run + c1 >= krem) { bin = 1; eq = c1; } else { run += c1; bin = 0; eq = c0; } } }
                                    misc[0] = misc[0] | ((4u * ht + bin) << shift); misc[1] = krem - run; misc[2] = eq;
                                }
                            }
                            __syncthreads();
                        }
#ifdef PROBE_MASK
                        if (a.probe_var == 8) { __syncthreads(); continue; }
#endif
                        const unsigned Tkey = misc[0], krem = misc[1], cnteq = misc[2];
                        LAS unsigned* eqb = hist;
                        const bool all_eq = (cnteq == krem);
                        for (int W = ht; W < 512; W += 128) {
                            unsigned sel = 0u, eqm = 0u;
                            if (32 * W < n) {
                                const unsigned vmask = (n - 32 * W >= 32) ? 0xFFFFFFFFu : ((1u << (n - 32 * W)) - 1u);
                                if (small) sel = vmask;
                                else {
                                    const LAS u32x4* kp = (const LAS u32x4*)(kq32 + 16 * W);
                                    const unsigned tp2 = Tkey | (Tkey << 16);
                                    unsigned ag = 0u, al = 0u;
#pragma unroll
                                    for (int q4 = 0; q4 < 4; ++q4) { const u32x4 w4 = kp[q4];
#pragma unroll
                                        for (int e = 0; e < 4; ++e) { ag |= pk_gt_u16(w4[e], tp2, 0x00010001u) << (4 * q4 + e); al |= pk_gt_u16(tp2, w4[e], 0x00010001u) << (4 * q4 + e); } }
                                    sel = ilv16(ag); eqm = ilv16(~(ag | al));
                                    if (all_eq) { sel |= eqm; eqm = 0u; }
                                    sel &= vmask; eqm &= vmask;
                                }
                            }
                            bits[W] = sel; eqb[W] = eqm;
                        }
                        __syncthreads();
                        if (!small && !all_eq && ht < 64) {
                            unsigned wv_[8]; unsigned cnt = 0u;
#pragma unroll
                            for (int q = 0; q < 8; ++q) { wv_[q] = eqb[8 * ht + q]; cnt += (unsigned)__popc(wv_[q]); }
                            unsigned inc = cnt;
#pragma unroll
                            for (int off = 1; off < 64; off <<= 1) { const unsigned v = shi_(inc, lane - off); if (lane >= off) inc += v; }
                            unsigned before = inc - cnt;
#pragma unroll
                            for (int q = 0; q < 8; ++q) { unsigned w = wv_[q], keep = 0u;
                                while (w && before < krem) { const unsigned lowb = w & (0u - w); keep |= lowb; w ^= lowb; ++before; }
                                before += (unsigned)__popc(w);
                                if (keep) __hip_atomic_fetch_or(&bits[8 * ht + q], keep, __ATOMIC_RELAXED, __HIP_MEMORY_SCOPE_WORKGROUP); }
                        }
                        __syncthreads();
                        {
                            const int qpos = 4 * pp + qi; const int tmax = 8 * (qpos >> 9) + 7;
#pragma unroll
                            for (int j = 0; j < 2; ++j) { const int tt = 2 * ht + j;
                                if (tt <= tmax) { const unsigned W0 = bits[2 * tt], W1 = bits[2 * tt + 1];
                                    unsigned e0 = W0 & 0x0F0F0F0Fu, e1 = W1 & 0x0F0F0F0Fu, o0 = (W0 >> 4) & 0x0F0F0F0Fu, o1 = (W1 >> 4) & 0x0F0F0F0Fu;
                                    e0 = (e0 | (e0 >> 4)) & 0x00FF00FFu; e0 = (e0 | (e0 >> 8)) & 0xFFFFu; e1 = (e1 | (e1 >> 4)) & 0x00FF00FFu; e1 = (e1 | (e1 >> 8)) & 0xFFFFu;
                                    o0 = (o0 | (o0 >> 4)) & 0x00FF00FFu; o0 = (o0 | (o0 >> 8)) & 0xFFFFu; o1 = (o1 | (o1 >> 4)) & 0x00FF00FFu; o1 = (o1 | (o1 >> 8)) & 0xFFFFu;
                                    u32x2 pm; pm.x = e0 | (e1 << 16); pm.y = o0 | (o1 << 16);
                                    *(u32x2*)(MASKW + (((size_t)(b * 256 + tt)) * S + qpos) * 2) = pm; } }
                        }
                        __syncthreads();
                    }
                }
                __syncthreads();
                {
                    bf16_t* OA = YMIX;
                    const int vcu = (G % 8 == 0) ? (c % 8) * (G / 8) + c / 8 : c;
                    const int nu = (G == 256) ? 4 : (1024 - vcu + G - 1) / G;
                    for (int iu = 0; iu < nu; ++iu) {
                        const int lane = lane_id_v(), wid = lsg(wid0);
                        LAS unsigned char* L0 = lsgp(lds0);
                        int combo, qb;
                        if (G == 256) { combo = vcu >> 4; const int s_ = vcu & 15; qb = iu == 0 ? s_ : iu == 1 ? 31 - s_ : iu == 2 ? 32 + s_ : 63 - s_; }
                        else { const int u = vcu + iu * G; combo = u & 15; qb = 63 - (u >> 4); }
                        const int b = combo >> 3, hc = combo & 7;
                        const bf16_t* zb = Z + (size_t)b * S * EV_ZP;
                        if (qk_bounded(a_qn + i * 64, a_kn + i * 64, lane))
                            flash_unit<2, false, true, EV_ZP, 1024, true>(L0, zb + hc * 64, zb + 512 + hc * 64, zb + 1024 + (hc >> 1) * 128, OA + (size_t)b * S * 1024 + hc * 128, nullptr, qb, wid, lane, a_qn + i * 64, COSH, SINH);
                        else
                            flash_unit<2, false, true, EV_ZP, 1024, false>(L0, zb + hc * 64, zb + 512 + hc * 64, zb + 1024 + (hc >> 1) * 128, OA + (size_t)b * S * 1024 + hc * 128, nullptr, qb, wid, lane, a_qn + i * 64, COSH, SINH);
                    }
                }
            }
            PH_END();
            if (PH_ON()) { DECL_PTRS();
                {
                    const bf16_t* OA = YMIX; const float lamv = LAM[i]; const float lam_init = 0.8f - 0.6f * expf(-0.3f * (float)l);
                    const int h = lane >> 4, vj = (lane >> 3) & 1, d8 = (lane & 7) * 8;
                    float gn[8];
#pragma unroll
                    for (int e = 0; e < 8; ++e) gn[e] = a_subln[i * 128 + vj * 64 + d8 + e] * (1.0f - lam_init);
                    for (int t0 = gw * 4; t0 < T; t0 += NGW * 4) {
                        u32x4 r1[4], r2[4];
#pragma unroll
                        for (int u = 0; u < 4; ++u) { r1[u] = *(const u32x4*)(OA + (size_t)(t0 + u) * 1024 + ((h * 2 + 0) * 2 + vj) * 64 + d8); r2[u] = *(const u32x4*)(OA + (size_t)(t0 + u) * 1024 + ((h * 2 + 1) * 2 + vj) * 64 + d8); }
                        __builtin_amdgcn_sched_barrier(0);
#pragma unroll
                        for (int u = 0; u < 4; ++u) {
                            float o1[8], o2[8], dd[8]; unpack8(r1[u], o1); unpack8(r2[u], o2);
                            float ss = 0.f;
#pragma unroll
                            for (int e = 0; e < 8; ++e) { dd[e] = o1[e] - lamv * o2[e]; ss += dd[e] * dd[e]; }
                            ss += dpp_xor1(ss); ss += dpp_xor2(ss); ss += SHX(ss, 4); ss += SHX(ss, 8);
                            const float r = rsqrtf(ss * (1.0f / 128.0f) + EPS);
#pragma unroll
                            for (int e = 0; e < 8; ++e) dd[e] = dd[e] * r * gn[e];
                            *(u32x4*)(O + (size_t)(t0 + u) * 1024 + h * 128 + vj * 64 + d8) = pack8(dd);
                        }
                        __builtin_amdgcn_sched_barrier(0);
                    }
                }
                {
                    const int vcu = (G % 8 == 0) ? (c % 8) * (G / 8) + c / 8 : c;
                    const int nu = (G == 256) ? 2 : (512 - vcu + G - 1) / G;
                    for (int iu = 0; iu < nu; ++iu) {
                        const int lane = lane_id_v(), wid = lsg(wid0);
                        LAS unsigned char* L0 = lsgp(lds0);
                        int combo, qb;
                        if (G == 256) { combo = vcu >> 4; const int s_ = vcu & 15; qb = iu == 0 ? s_ : 31 - s_; }
                        else { const int u = vcu + iu * G; combo = u & 15; qb = 31 - (u >> 4); }
                        const int b = combo >> 3, h = combo & 7;
                        const bf16_t* zb = Z + (size_t)b * S * EV_ZP;
                        if (qk_bounded(b_qn + i * 64, b_kn + i * 64, lane))
                            flash_unit_q2<1, true, false, EV_ZP, 1024, true>(L0, zb + 1536 + h * 64, zb + 2048 + h * 64, zb + 2560 + h * 64, O + (size_t)b * S * 1024 + 512 + h * 64, MASKW + (size_t)b * 256 * S * 2, qb, wid, lane, b_qn + i * 64, COSH, SINH);
                        else
                            flash_unit_q2<1, true, false, EV_ZP, 1024, false>(L0, zb + 1536 + h * 64, zb + 2048 + h * 64, zb + 2560 + h * 64, O + (size_t)b * S * 1024 + 512 + h * 64, MASKW + (size_t)b * 256 * S * 2, qb, wid, lane, b_qn + i * 64, COSH, SINH);
                    }
                }
            }
            PH_END();
        } else {
            if (PH_ON()) { DECL_PTRS();
                pg8::Gemm g{H, Wodin + (size_t)i * OD_N * 1024, T, OD_N, 1024, 0}; pg8::StaticOrder So; So.init(T, OD_N, G, c);
                EpiOddIn E{Z, UG, c_kn + i * 64, COSH, SINH};
                { PROBE_WRAP(pg8::StaticOrder, So); pg8::gemm_phase<EpiOddIn, PROBE_SCHED(pg8::StaticOrder), true, true>(glds, g, PS_, E, tid); }
            }
            PH_END();
            if (PH_ON()) { DECL_PTRS();
                moe_convert(moe_w1 + (size_t)l * 32 * 1024 * 512, moe_w3 + (size_t)l * 32 * 1024 * 512, moe_w2 + (size_t)l * 32 * 512 * 1024, W13, W2, scr, gw, NGW, lane);
                __syncthreads();
                for (int u = gw; u < NB * 64 * 8; u += NGW) {
                    const int h = u & 7, blk = (u >> 3) & 63, b = u >> 9;
                    const int rs = lane >> 3, d8 = (lane & 7) * 8;
                    const bf16_t* kp = Z + ((size_t)b * S + blk * 256 + rs) * OD_N + 512 + h * 64 + d8;
                    u32x4 kr[32];
#pragma unroll
                    for (int j = 0; j < 32; ++j) kr[j] = *(const u32x4*)(kp + (size_t)(8 * j) * OD_N);
                    __builtin_amdgcn_sched_barrier(0);
                    float sm[8];
#pragma unroll
                    for (int e = 0; e < 8; ++e) sm[e] = 0.f;
#pragma unroll
                    for (int j = 0; j < 32; ++j) { float kv[8]; unpack8(kr[j], kv);
#pragma unroll
                        for (int e = 0; e < 8; ++e) sm[e] += kv[e]; }
#pragma unroll
                    for (int e = 0; e < 8; ++e) { sm[e] += SHX(sm[e], 8); sm[e] += SHX(sm[e], 16); sm[e] += SHX(sm[e], 32); sm[e] *= (1.0f / 256.0f); }
                    if (rs == 0) {
                        *(f32x4*)(KM + (size_t)u * 64 + d8) = (f32x4){sm[0], sm[1], sm[2], sm[3]}; *(f32x4*)(KM + (size_t)u * 64 + d8 + 4) = (f32x4){sm[4], sm[5], sm[6], sm[7]};
                        const u32x4 hw = pack8(sm); float hf[8], lo[8]; unpack8(hw, hf);
#pragma unroll
                        for (int e = 0; e < 8; ++e) lo[e] = sm[e] - hf[e];
                        *(u32x4*)(KMH + ((size_t)(b * 8 + h) * 64 + blk) * 64 + d8) = hw; *(u32x4*)(KML + ((size_t)(b * 8 + h) * 64 + blk) * 64 + d8) = pack8(lo);
                    }
                }
                {
                    const int r32 = lane & 31, hi = lane >> 5;
                    LAS unsigned char* ldsU = lds;
                    LAS float* red = (LAS float*)(lds + 69632);
                    for (int task = c; task < 512; task += G) {
                        const int g = task >> 4, cs = task & 15;
                        for (int q = tid; q < 32 * 128; q += NTHREADS) { const int j = q >> 7, off = (q & 127) * 16;
                            *(LAS u32x4*)(ldsU + j * 2064 + off) = *(const u32x4*)((const unsigned char*)UG + ((size_t)g * T + (size_t)(cs * 32 + j) * 64) * 32 + off); }
                        __syncthreads();
                        const int rb = wid & 3, kh = wid >> 2;
                        attn_body::f32x16 acc;
#pragma unroll
                        for (int r = 0; r < 16; ++r) acc[r] = 0.f;
                        const bf16_t* wrow = S5WT + ((size_t)(i * 32 + g) * 128 + rb * 32 + r32) * 1024 + hi * 8;
#pragma unroll 8
                        for (int ks = kh * 32; ks < kh * 32 + 32; ++ks) {
                            const attn_body::bf16x8 A = *(const attn_body::bf16x8*)(wrow + ks * 16);
                            const attn_body::bf16x8 B = *(const LAS attn_body::bf16x8*)(ldsU + r32 * 2064 + ks * 32 + hi * 16);
                            acc = __builtin_amdgcn_mfma_f32_32x32x16_bf16(A, B, acc, 0, 0, 0);
                        }
                        if (kh == 1) {
#pragma unroll
                            for (int r = 0; r < 16; ++r) red[(rb * 64 + lane) * 16 + r] = acc[r];
                        }
                        __syncthreads();
                        if (kh == 0) {
                            float* ep = S5E + ((size_t)(cs * 32 + r32) * 32 + g) * 128 + rb * 32 + 4 * hi;
#pragma unroll
                            for (int q4 = 0; q4 < 4; ++q4) { f32x4 o;
                                o.x = acc[4 * q4] + red[(rb * 64 + lane) * 16 + 4 * q4]; o.y = acc[4 * q4 + 1] + red[(rb * 64 + lane) * 16 + 4 * q4 + 1];
                                o.z = acc[4 * q4 + 2] + red[(rb * 64 + lane) * 16 + 4 * q4 + 2]; o.w = acc[4 * q4 + 3] + red[(rb * 64 + lane) * 16 + 4 * q4 + 3];
                                *(f32x4*)(ep + 8 * q4) = o; }
                        }
                        __syncthreads();
                    }
                }
            }
            PH_END();
            if (PH_ON()) { DECL_PTRS();
#ifndef SKIP_S5
                {
                    for (int idx = gt; idx < NB * 32 * 64; idx += NGT) {
                        const int b = idx >> 11, g = (idx >> 6) & 31, p = idx & 63;
                        const int sp = (i * 32 + g) * 64 + p;
                        const float aLr = S5PW[((size_t)sp * 65 + 64) * 2], aLi = S5PW[((size_t)sp * 65 + 64) * 2 + 1];
                        float hr = 0.f, hi_ = 0.f;
                        for (int c0 = 0; c0 < 256; c0 += 32) {
                            float er[32], ei[32];
#pragma unroll
                            for (int k = 0; k < 32; ++k) { const float* ep = S5E + ((size_t)(b * 256 + c0 + k) * 32 + g) * 128 + 2 * p; er[k] = ep[0]; ei[k] = ep[1]; }
                            __builtin_amdgcn_sched_barrier(0);
#pragma unroll
                            for (int k = 0; k < 32; ++k) {
                                *(unsigned*)(S5HC + ((size_t)(b * 256 + c0 + k) * 32 + g) * 128 + 2 * p) = pk2(hr, hi_);
                                const float nr = aLr * hr - aLi * hi_ + er[k], ni = aLr * hi_ + aLi * hr + ei[k]; hr = nr; hi_ = ni; }
                        }
                    }
                }
#endif
                {
                    unsigned* mcnt = ctl + CW_MCNT + i * 1024;
                    const int r32 = lane & 31, hi = lane >> 5;
                    for (int u = c; u < NB * 8 * 64; u += G) {
                        const int tb = u & 63, h = (u >> 6) & 7, b = u >> 9;
                        const int pos = tb * 256 + wid * 32 + r32; const size_t t = (size_t)b * S + pos;
                        float tv[3] = {-INFINITY, -INFINITY, -INFINITY}; int ti[3] = {1 << 20, 1 << 20, 1 << 20};
                        if (tb > 0) {
                            attn_body::bf16x8 qr[4];
                            load_q_normed(qr, Z + t * OD_N + h * 64, c_qn + i * 64, COSH, SINH, pos, hi, lane);
                            attn_body::f32x16 g0, g1;
#pragma unroll
                            for (int r = 0; r < 16; ++r) { g0[r] = 0.f; g1[r] = 0.f; }
                            const bf16_t* kh = KMH + ((size_t)(b * 8 + h) * 64 + r32) * 64 + hi * 8; const bf16_t* kl = KML + ((size_t)(b * 8 + h) * 64 + r32) * 64 + hi * 8;
#pragma unroll
                            for (int d0 = 0; d0 < 4; ++d0) {
                                g0 = __builtin_amdgcn_mfma_f32_32x32x16_bf16(*(const attn_body::bf16x8*)(kh + d0 * 16), qr[d0], g0, 0, 0, 0);
                                g0 = __builtin_amdgcn_mfma_f32_32x32x16_bf16(*(const attn_body::bf16x8*)(kl + d0 * 16), qr[d0], g0, 0, 0, 0);
                                if (tb > 32) { g1 = __builtin_amdgcn_mfma_f32_32x32x16_bf16(*(const attn_body::bf16x8*)(kh + 32 * 64 + d0 * 16), qr[d0], g1, 0, 0, 0);
                                               g1 = __builtin_amdgcn_mfma_f32_32x32x16_bf16(*(const attn_body::bf16x8*)(kl + 32 * 64 + d0 * 16), qr[d0], g1, 0, 0, 0); } }
#pragma unroll
                            for (int half = 0; half < 2; ++half)
#pragma unroll
                                for (int r = 0; r < 16; ++r) { const int n = half * 32 + attn_body::crow(r, hi); const float gv = (n < tb) ? (half ? g1[r] : g0[r]) : -INFINITY;
                                    if (gv > tv[0]) { tv[2] = tv[1]; ti[2] = ti[1]; tv[1] = tv[0]; ti[1] = ti[0]; tv[0] = gv; ti[0] = n; }
                                    else if (gv > tv[1]) { tv[2] = tv[1]; ti[2] = ti[1]; tv[1] = gv; ti[1] = n; }
                                    else if (gv > tv[2]) { tv[2] = gv; ti[2] = n; } }
                            float pv_[3]; int pi_[3];
#pragma unroll
                            for (int k = 0; k < 3; ++k) { pv_[k] = SHX(tv[k], 32); pi_[k] = (int)shi_((unsigned)ti[k], lane ^ 32); }
                            float mv[3]; int mi[3]; int ia = 0, ib = 0;
#pragma unroll
                            for (int k = 0; k < 3; ++k) {
                                const float av = ia == 0 ? tv[0] : ia == 1 ? tv[1] : ia == 2 ? tv[2] : -INFINITY; const int ai = ia == 0 ? ti[0] : ia == 1 ? ti[1] : ia == 2 ? ti[2] : (1 << 20);
                                const float bv = ib == 0 ? pv_[0] : ib == 1 ? pv_[1] : ib == 2 ? pv_[2] : -INFINITY; const int bi = ib == 0 ? pi_[0] : ib == 1 ? pi_[1] : ib == 2 ? pi_[2] : (1 << 20);
                                const bool ta = (av > bv) || (av == bv && ai < bi);
                                mv[k] = ta ? av : bv; mi[k] = ta ? ai : bi; if (ta) ++ia; else ++ib; }
#pragma unroll
                            for (int k = 0; k < 3; ++k) { tv[k] = mv[k]; ti[k] = mi[k]; }
                        }
#ifdef PROBE_MASK
                        if (a.probe_var == 3) { if (ti[0] + ti[1] + ti[2] == -12345) NSEL[0] = 1; continue; }
#endif
                        if (hi == 0) {
                            unsigned idx[3];
#pragma unroll
                            for (int sI = 0; sI < 3; ++sI) { idx[sI] = 0u;
                                if (tv[sI] > -INFINITY) idx[sI] = __hip_atomic_fetch_add(mcnt + (b * 8 + h) * 64 + ti[sI], 1u, __ATOMIC_RELAXED, __HIP_MEMORY_SCOPE_AGENT); }
                            int nsel = 0;
#pragma unroll
                            for (int sI = 0; sI < 3; ++sI)
                                if (tv[sI] > -INFINITY) { const int li = (b * 8 + h) * 64 + ti[sI]; MLIST[(size_t)li * 16384 + idx[sI]] = (pos << 2) | nsel; ++nsel; }
                            NSEL[t * 8 + h] = nsel;
                        }
                    }
                }
            }
            PH_END();
            if (PH_ON()) { DECL_PTRS();
                {
                    const unsigned* mcnt = ctl + CW_MCNT + i * 1024;
                    LAS int* pref = (LAS int*)(lds + LDS_MISC);
                    if (wid == 0) {
                        int loc[16]; int sum = 0;
#pragma unroll
                        for (int k = 0; k < 16; ++k) loc[k] = (int)__hip_atomic_load(mcnt + lane * 16 + k, __ATOMIC_RELAXED, __HIP_MEMORY_SCOPE_AGENT);
                        __builtin_amdgcn_sched_barrier(0);
#pragma unroll
                        for (int k = 0; k < 16; ++k) { const int cnt = loc[k]; loc[k] = sum; sum += (cnt + 255) >> 8; }
                        int inc = sum;
#pragma unroll
                        for (int off = 1; off < 64; off <<= 1) { const int v = (int)shi_((unsigned)inc, lane - off); if (lane >= off) inc += v; }
                        const int base = inc - sum;
#pragma unroll
                        for (int k = 0; k < 16; ++k) pref[lane * 16 + k] = base + loc[k];
                        if (lane == 63) pref[1024] = inc;
                    }
                    __syncthreads();
                    const int NTsel = pref[1024];
                    auto decode = [&](int task_, int& li_o, int& chunk_o, bool& own_o) { own_o = task_ >= NTsel; chunk_o = 0;
                        if (own_o) li_o = task_ - NTsel;
                        else { int lo_ = 0, hi_ = 1023; while (lo_ < hi_) { const int mid = (lo_ + hi_ + 1) >> 1; if (pref[mid] <= task_) lo_ = mid; else hi_ = mid - 1; } li_o = lo_; chunk_o = task_ - pref[lo_]; } };
                    int nx_li = 0, nx_chunk = 0, nx_ent = 0, nx_cnt = 256; bool nx_own = true;
                    if (c < NTsel + 1024) { decode(c, nx_li, nx_chunk, nx_own);
                        if (!nx_own) { const int ln_ = lane_id_v(); nx_ent = MLIST[(size_t)nx_li * 16384 + nx_chunk * 256 + lsg(wid0) * 32 + (ln_ & 31)]; nx_cnt = (int)__hip_atomic_load(mcnt + nx_li, __ATOMIC_RELAXED, __HIP_MEMORY_SCOPE_AGENT); } }
                    for (int task = c; task < NTsel + 1024; task += G) {
                        const int lane = lane_id_v(), wid = lsg(wid0), r32 = lane & 31, hi = lane >> 5;
                        LAS unsigned char* ldsKs = lsgp(lds0); LAS unsigned char* ldsVs = ldsKs + 32768;
                        LAS bf16_t* stg = (LAS bf16_t*)(ldsKs + 65536 + wid * 4096); LAS float* wsf = (LAS float*)(ldsKs + 98304 + wid * 256); LAS int* rowd = (LAS int*)(ldsKs + 100352 + wid * 128);
                        const bool own_task = nx_own;
                        const int li = nx_li, chunk = nx_chunk;
                        const int b = li >> 9, h = (li >> 6) & 7, blk = li & 63;
                        const int e_ = chunk * 256 + wid * 32 + r32;
                        const int cnt = nx_cnt;
                        const int ent_ = nx_ent;
                        u32x4 kst[4], vst[4];
                        {
                            const bf16_t* kbp = Z + ((size_t)b * S + blk * 256) * OD_N + 512 + h * 64;
                            const bf16_t* vbp = Z + ((size_t)b * S + blk * 256) * OD_N + 1024 + h * 64;
#pragma unroll
                            for (int kt = 0; kt < 4; ++kt) {
                                kst[kt] = *(const u32x4*)(kbp + (size_t)(kt * 64 + lane) * OD_N + wid * 8);
                                vst[kt] = *(const u32x4*)(vbp + (size_t)(kt * 64 + 16 * (wid & 3) + (lane >> 2)) * OD_N + (wid >> 2) * 32 + (lane & 3) * 8);
                            }
                        }
                        __builtin_amdgcn_sched_barrier(0);
                        int posq, slot; bool valid;
                        if (own_task) { posq = blk * 256 + wid * 32 + r32; slot = 3; valid = true; }
                        else { valid = e_ < cnt; posq = valid ? (ent_ >> 2) : 0; slot = ent_ & 3; }
                        const size_t tq = (size_t)b * S + posq;
                        const int dest = valid ? (int)((tq * 8 + h) * 4 + slot) : -1;
                        attn_body::bf16x8 qr[4];
                        load_q_normed(qr, Z + tq * OD_N + h * 64, c_qn + i * 64, COSH, SINH, posq, hi, lane);
#pragma unroll
                        for (int kt = 0; kt < 4; ++kt) { *(LAS u32x4*)(ldsKs + kt * 8192 + wid * 1024 + lane * 16) = kst[kt]; *(LAS u32x4*)(ldsVs + kt * 8192 + wid * 1024 + lane * 16) = vst[kt]; }
                        nx_own = true; nx_li = 0; nx_chunk = 0; nx_ent = 0; nx_cnt = 256;
                        if (task + G < NTsel + 1024) { decode(task + G, nx_li, nx_chunk, nx_own);
                            if (!nx_own) { nx_ent = MLIST[(size_t)nx_li * 16384 + nx_chunk * 256 + wid * 32 + r32]; nx_cnt = (int)__hip_atomic_load(mcnt + nx_li, __ATOMIC_RELAXED, __HIP_MEMORY_SCOPE_AGENT); } }
                        __syncthreads();
                        attn_body::f32x16 p0[4], p1[4];
#pragma unroll
                        for (int kt = 0; kt < 4; ++kt) {
#pragma unroll
                            for (int r = 0; r < 16; ++r) { p0[kt][r] = 0.f; p1[kt][r] = 0.f; }
                            const LAS unsigned char* kb = ldsKs + kt * 8192 + hi * 1024 + r32 * 16;
#pragma unroll
                            for (int d0 = 0; d0 < 4; ++d0) {
                                const attn_body::bf16x8 b0 = *(const LAS attn_body::bf16x8*)(kb + d0 * 2048), b1 = *(const LAS attn_body::bf16x8*)(kb + d0 * 2048 + 512);
                                p0[kt] = __builtin_amdgcn_mfma_f32_32x32x16_bf16(b0, qr[d0], p0[kt], 0, 0, 0);
                                p1[kt] = __builtin_amdgcn_mfma_f32_32x32x16_bf16(b1, qr[d0], p1[kt], 0, 0, 0);
                            }
                        }
                        if (own_task) {
                            const int qrel = wid * 32 + r32;
#pragma unroll
                            for (int kt = 0; kt < 4; ++kt)
#pragma unroll
                                for (int r = 0; r < 16; ++r) { const int kv = kt * 64 + attn_body::crow(r, hi); if (kv > qrel) p0[kt][r] = -INFINITY; if (kv + 32 > qrel) p1[kt][r] = -INFINITY; }
                        }
                        float mx = -INFINITY;
#pragma unroll
                        for (int kt = 0; kt < 4; ++kt)
#pragma unroll
                            for (int r = 0; r < 16; ++r) mx = fmaxf(mx, fmaxf(p0[kt][r], p1[kt][r]));
                        mx = fmaxf(mx, SHX(mx, 32));
                        float ls = 0.f;
#pragma unroll
                        for (int kt = 0; kt < 4; ++kt)
#pragma unroll
                            for (int r = 0; r < 16; ++r) { p0[kt][r] = __builtin_amdgcn_exp2f(p0[kt][r] - mx); p1[kt][r] = __builtin_amdgcn_exp2f(p1[kt][r] - mx); ls += p0[kt][r] + p1[kt][r]; }
                        ls += SHX(ls, 32);
                        attn_body::f32x16 o[2];
#pragma unroll
                        for (int r = 0; r < 16; ++r) { o[0][r] = 0.f; o[1][r] = 0.f; }
                        const int vb0 = (int)(unsigned)(unsigned long long)ldsVs + ((lane >> 4) & 1) * 32 + (lane & 3) * 8 + (4 * hi + ((lane & 15) >> 2)) * 64;
#pragma unroll
                        for (int kt = 0; kt < 4; ++kt) {
                            u32x4 pw0, pw1, pw2, pw3;
#pragma unroll
                            for (int k = 0; k < 4; ++k) { pw0[k] = attn_body::cvtpk_s(p0[kt][2 * k], p0[kt][2 * k + 1]); pw1[k] = attn_body::cvtpk_s(p0[kt][8 + 2 * k], p0[kt][9 + 2 * k]);
                                pw2[k] = attn_body::cvtpk_s(p1[kt][2 * k], p1[kt][2 * k + 1]); pw3[k] = attn_body::cvtpk_s(p1[kt][8 + 2 * k], p1[kt][9 + 2 * k]); }
                            attn_body::pv(o, vb0 + kt * 8192, __builtin_bit_cast(attn_body::bf16x8, pw0), __builtin_bit_cast(attn_body::bf16x8, pw1), __builtin_bit_cast(attn_body::bf16x8, pw2), __builtin_bit_cast(attn_body::bf16x8, pw3));
                        }
                        if (hi == 0) { wsf[r32] = ls; rowd[r32] = dest; if (valid) { MML[(size_t)dest * 2] = mx; MML[(size_t)dest * 2 + 1] = ls; } }
                        LDS_WAIT();
#pragma unroll
                        for (int r = 0; r < 16; ++r) { const int orow = attn_body::crow(r, hi); const float rl = __builtin_amdgcn_rcpf(wsf[orow]);
                            stg[orow * 64 + r32] = (bf16_t)f2bf(o[0][r] * rl); stg[orow * 64 + 32 + r32] = (bf16_t)f2bf(o[1][r] * rl); }
                        LDS_WAIT();
#pragma unroll
                        for (int q = 0; q < 4; ++q) { const int row = q * 8 + (lane >> 3), ch = lane & 7; const int dd = rowd[row];
                            if (dd >= 0) *(u32x4*)(MPO + (size_t)dd * 64 + ch * 8) = *(const LAS u32x4*)(stg + row * 64 + ch * 8); }
                        __syncthreads();
                    }
                }
                {
                const int r32 = lane & 31, hi = lane >> 5;
                LAS unsigned char* ldsU = lds;
                LAS unsigned char* ldsK = lds + 69632;
                for (int task = c; task < 512; task += G) {
                    const int g = task >> 4, cs = task & 15, ig = i * 32 + g;
                    for (int q = tid; q < 32 * 128; q += NTHREADS) { const int j = q >> 7, off = (q & 127) * 16;
                        *(LAS u32x4*)(ldsU + j * 2064 + off) = *(const u32x4*)((const unsigned char*)UG + ((size_t)g * T + (size_t)(cs * 32 + j) * 64) * 32 + off); }
                    for (int q = tid; q < 65 * 48; q += NTHREADS) *(LAS u32x4*)(ldsK + q * 16) = *(const u32x4*)((const unsigned char*)S5KT + (size_t)ig * 65 * 768 + q * 16);
                    __syncthreads();
                    const int gc = cs * 32 + r32;
                    const float* dsk = s5_d + ig * 16;
                    const f32x4 dd0 = *(const f32x4*)(dsk + 4 * hi), dd1 = *(const f32x4*)(dsk + 8 + 4 * hi);
                    attn_body::bf16x8 hcr[8];
                    { const bf16_t* hc = S5HC + ((size_t)gc * 32 + g) * 128 + hi * 8;
#pragma unroll
                      for (int kk = 0; kk < 8; ++kk) hcr[kk] = *(const attn_body::bf16x8*)(hc + kk * 16); }
#pragma unroll 1
                    for (int rr = 0; rr < 4; ++rr) {
                        const int r = rr == 0 ? wid : rr == 1 ? 15 - wid : rr == 2 ? 16 + wid : 31 - wid;
                        attn_body::f32x16 acc;
#pragma unroll
                        for (int q = 0; q < 16; ++q) acc[q] = 0.f;
                        attn_body::bf16x8 a2r[8];
                        { const bf16_t* a2 = S5A2 + ((size_t)ig * 1024 + r * 32 + r32) * 128 + hi * 8;
#pragma unroll
                          for (int kk = 0; kk < 8; ++kk) a2r[kk] = *(const attn_body::bf16x8*)(a2 + kk * 16); }
                        __builtin_amdgcn_sched_barrier(0);
                        const LAS unsigned char* kbase = ldsK + (r32 >> 4) * 768 + (r32 & 15) * 48 + hi * 16;
                        const LAS unsigned char* ubase = ldsU + r32 * 2064 + hi * 16;
                        for (int s = 0; s <= 2 * r + 1; ++s) {
                            const attn_body::bf16x8 A = *(const LAS attn_body::bf16x8*)(kbase + (2 * r - s + 1) * 768);
                            const attn_body::bf16x8 B = *(const LAS attn_body::bf16x8*)(ubase + s * 32);
                            acc = __builtin_amdgcn_mfma_f32_32x32x16_bf16(A, B, acc, 0, 0, 0);
                        }
#pragma unroll
                        for (int kk = 0; kk < 8; ++kk) acc = __builtin_amdgcn_mfma_f32_32x32x16_bf16(a2r[kk], hcr[kk], acc, 0, 0, 0);
#pragma unroll
                        for (int q4 = 0; q4 < 4; ++q4) {
                            const int rowb = 8 * q4 + 4 * hi, dt_ = rowb >> 4, co0 = rowb & 15, t = 2 * r + dt_;
                            const u32x2 uw = *(const LAS u32x2*)(ldsU + r32 * 2064 + t * 32 + co0 * 2);
                            const f32x4 dd = (q4 & 1) ? dd1 : dd0;
                            const float y0 = acc[4 * q4] + dd.x * bflo(uw.x), y1 = acc[4 * q4 + 1] + dd.y * bfhi(uw.x), y2 = acc[4 * q4 + 2] + dd.z * bflo(uw.y), y3 = acc[4 * q4 + 3] + dd.w * bfhi(uw.y);
                            u32x2 w; w.x = pk2(gelu_tanh(y0), gelu_tanh(y1)); w.y = pk2(gelu_tanh(y2), gelu_tanh(y3));
                            *(u32x2*)(YG + ((size_t)gc * 64 + t) * 512 + g * 16 + co0) = w;
                        }
                    }
                    __syncthreads();
                }
                }
            }
            PH_END();
            if (PH_ON()) { DECL_PTRS();
                {
                    const int h = lane >> 3, d8 = (lane & 7) * 8;
                    for (int t0 = gw * 4; t0 < T; t0 += NGW * 4) {
                        int nsel[4]; f32x2 ml[4][4]; u32x4 po[4][4];
#pragma unroll
                        for (int u = 0; u < 4; ++u) { const size_t base = ((size_t)(t0 + u) * 8 + h) * 4; nsel[u] = NSEL[(size_t)(t0 + u) * 8 + h];
#pragma unroll
                            for (int s = 0; s < 4; ++s) { ml[u][s] = *(const f32x2*)(MML + (base + s) * 2); po[u][s] = *(const u32x4*)(MPO + (base + s) * 64 + d8); } }
                        __builtin_amdgcn_sched_barrier(0);
#pragma unroll
                        for (int u = 0; u < 4; ++u) {
                            float mm[4], ll[4];
#pragma unroll
                            for (int s = 0; s < 4; ++s) { const bool on = (s == 3) || (s < nsel[u]); mm[s] = on ? ml[u][s].x : -INFINITY; ll[s] = on ? ml[u][s].y : 0.f; }
                            const float M = fmaxf(fmaxf(mm[0], mm[1]), fmaxf(mm[2], mm[3]));
                            float acc[8], wsum = 0.f;
#pragma unroll
                            for (int e = 0; e < 8; ++e) acc[e] = 0.f;
#pragma unroll
                            for (int s = 0; s < 4; ++s) { const bool on = (s == 3) || (s < nsel[u]);
                                const float w = on ? ll[s] * __builtin_amdgcn_exp2f(mm[s] - M) : 0.f; float ov[8]; unpack8(po[u][s], ov); wsum += w;
#pragma unroll
                                for (int e = 0; e < 8; ++e) acc[e] += on ? w * ov[e] : 0.f; }
                            const float inv = 1.0f / wsum;
#pragma unroll
                            for (int e = 0; e < 8; ++e) acc[e] *= inv;
                            *(u32x4*)(O + (size_t)(t0 + u) * 1024 + h * 64 + d8) = pack8(acc);
                        }
                        __builtin_amdgcn_sched_barrier(0);
                    }
                }
                pg8::Gemm g{YG, Wglu + (size_t)i * 512 * 512, T, 512, 512, 0}; pg8::StaticOrder So; So.init(T, 512, G, c);
                EpiGLU E{O, YG, s5_glu_b + i * 512};
                { PROBE_WRAP(pg8::StaticOrder, So); pg8::gemm_phase<EpiGLU, PROBE_SCHED(pg8::StaticOrder), true, true>(glds, g, PS_, E, tid); }
            }
            PH_END();
        }
        if (PH_ON()) { DECL_PTRS();
            pg8::Gemm g{O, ((l & 1) ? Wodout : Wevout) + (size_t)i * 1024 * 1024, T, 1024, 1024, 0}; pg8::StaticOrder So; So.init(T, 1024, G, c);
            EpiPlain E{YMIX, 1024};
            { PROBE_WRAP(pg8::StaticOrder, So); pg8::gemm_phase<EpiPlain, PROBE_SCHED(pg8::StaticOrder), true, true>(glds, g, PS_, E, tid); }
        }
        PH_END();
        if (PH_ON()) { DECL_PTRS();
#ifdef PROBE_MASK
            const bool first_x = (l == 0 && a.probe_var != -5);
#else
            const bool first_x = (l == 0);
#endif
            const float* xs = xin;
            LAS int* r_e = (LAS int*)(lds + 0);
            LAS float* r_w = (LAS float*)(lds + 1024);
            LAS int* r_rank = (LAS int*)(lds + 2048);
            LAS int* lcnt = (LAS int*)(lds + 3072);
            LAS int* lbase = (LAS int*)(lds + 3200);
            const float* wg_l = moe_wg + (size_t)l * 1024 * 4; const float* we_l = moe_we + (size_t)l * 1024 * 32;
            for (int chunk = c; chunk < T / 128; chunk += G) {
                if (tid < 32) lcnt[tid] = 0;
                LAS float* modl = (LAS float*)(lds + 32768);
                { const float* mo_ = MOD + (size_t)(l * 2 + (int)(((size_t)chunk * 128) / S)) * 6144 + 2048;
                  for (int q = tid; q < 768; q += NTHREADS) *(LAS f32x4*)(modl + 4 * q) = *(const f32x4*)(mo_ + 4 * q); }
                __syncthreads();
                {
                    const int rloc = lane & 15, kc = lane >> 4; const int r = wid * 16 + rloc; const size_t t = (size_t)chunk * 128 + r; const int b = (int)(((size_t)chunk * 128) / S);
                    const float* mo = MOD + (size_t)(l * 2 + b) * 6144;
                    float ss;
                    if (first_x) ss = f_pass1<true>(xs + t * 1024, XB + t * 1024, YMIX + t * 1024, modl, kc);
                    else ss = f_pass1<false>(xs + t * 1024, XB + t * 1024, YMIX + t * 1024, modl, kc);
                    ss += SHX(ss, 16); ss += SHX(ss, 32);
                    const float rn = rsqrtf(ss * (1.0f / 1024.0f) + EPS);
                    f32x4 acc[3];
#pragma unroll
                    for (int ct = 0; ct < 3; ++ct) acc[ct] = (f32x4){0.f, 0.f, 0.f, 0.f};
                    const bf16_t* wh = WRH + ((size_t)l * 48 + rloc) * 1024 + 8 * kc; const bf16_t* wl = WRL + ((size_t)l * 48 + rloc) * 1024 + 8 * kc;
                    f_pass2(XB + t * 1024, H + t * 1024, modl, wh, wl, rn, kc, acc);
                    LAS float* lg = (LAS float*)(lds + 4096 + wid * 3072);
#pragma unroll
                    for (int ct = 0; ct < 3; ++ct) { lg[(4 * kc + 0) * 48 + ct * 16 + rloc] = acc[ct].x; lg[(4 * kc + 1) * 48 + ct * 16 + rloc] = acc[ct].y; lg[(4 * kc + 2) * 48 + ct * 16 + rloc] = acc[ct].z; lg[(4 * kc + 3) * 48 + ct * 16 + rloc] = acc[ct].w; }
                    LDS_WAIT();
                    if (lane < 16) {
                        const LAS float* lr = lg + lane * 48;
                        float cg[4];
#pragma unroll
                        for (int e = 0; e < 4; ++e) cg[e] = lr[e] + moe_bg[l * 4 + e];
                        int grp = 0; float cm = cg[0];
#pragma unroll
                        for (int e = 1; e < 4; ++e) if (cg[e] > cm) { cm = cg[e]; grp = e; }
                        float den = 0.f;
#pragma unroll
                        for (int e = 0; e < 4; ++e) den += __expf(cg[e] - cm);
                        const float pg = 1.0f / den;
                        float fe[8];
#pragma unroll
                        for (int e = 0; e < 8; ++e) fe[e] = lr[4 + grp * 8 + e] + moe_be[l * 32 + grp * 8 + e];
                        int j0 = 0; float f0 = fe[0];
#pragma unroll
                        for (int e = 1; e < 8; ++e) if (fe[e] > f0) { f0 = fe[e]; j0 = e; }
                        int j1 = -1; float f1 = -INFINITY;
#pragma unroll
                        for (int e = 0; e < 8; ++e) if (e != j0 && fe[e] > f1) { f1 = fe[e]; j1 = e; }
                        const float ex = __expf(f1 - f0); const float sA = 1.0f / (1.0f + ex), sB = ex / (1.0f + ex);
                        const int rr_ = wid * 16 + lane;
                        r_e[2 * rr_] = grp * 8 + j0; r_w[2 * rr_] = pg * sA; r_e[2 * rr_ + 1] = grp * 8 + j1; r_w[2 * rr_ + 1] = pg * sB;
                    }
                }
                __syncthreads();
#ifdef PROBE_MASK
                if (a.probe_var == 5) { if (tid < 256 && r_e[tid] == -777) TOKES[0] = 0; __syncthreads(); continue; }
#endif
                if (tid < 256) r_rank[tid] = __hip_atomic_fetch_add(&lcnt[r_e[tid]], 1, __ATOMIC_RELAXED, __HIP_MEMORY_SCOPE_WORKGROUP);
                __syncthreads();
                if (tid < 32) lbase[tid] = (int)__hip_atomic_fetch_add(ctl + CW_CNT + (l * 32 + tid) * 64, (unsigned)lcnt[tid], __ATOMIC_RELAXED, __HIP_MEMORY_SCOPE_AGENT);
                __syncthreads();
                if (tid < 256) { const size_t t = (size_t)chunk * 128 + (tid >> 1); const int k = tid & 1; const int e = r_e[tid]; const int slot = lbase[e] + r_rank[tid];
                    TOKES[t * 2 + k] = e * 32768 + slot; TOKW[t * 2 + k] = r_w[tid]; LTOK[e * 32768 + slot] = (int)t; }
                __syncthreads();
            }
        }
        PH_END();
        if (PH_ON()) { DECL_PTRS();
            LAS int* tile_e = (LAS int*)(lds + LDS_MISC); LAS int* rb = tile_e + 320; LAS int* nt_p = tile_e + 400;
            moe_tables(ctl, l, tile_e, rb, nt_p, tid);
            const int nR = nt_p[0];
            pg8::Gemm g{H, W13, nR * 256, 1024, 1024, (size_t)1024 * 1024 * 2}; MoeOrder Mo{4, nR * 4, G, c, tile_e};
            EpiSwiGLU E{HID}; MoeRows RW{rb, LTOK};
            { PROBE_WRAP(MoeOrder, Mo); pg8::gemm_phase<EpiSwiGLU, PROBE_SCHED(MoeOrder), true, true, MoeRows>(glds, g, PS_, E, tid, RW); }
        }
        PH_END();
        if (PH_ON()) { DECL_PTRS();
            LAS int* tile_e = (LAS int*)(lds + LDS_MISC); LAS int* rb = tile_e + 320; LAS int* nt_p = tile_e + 400;
            moe_tables(ctl, l, tile_e, rb, nt_p, tid);
            const int nR = nt_p[0];
            pg8::Gemm g{HID, W2, nR * 256, 1024, 512, (size_t)1024 * 512 * 2}; MoeOrder Mo{4, nR * 4, G, c, tile_e};
            EpiPlain E{Y, 1024};
            { PROBE_WRAP(MoeOrder, Mo); pg8::gemm_phase<EpiPlain, PROBE_SCHED(MoeOrder), true, true>(glds, g, PS_, E, tid); }
        }
        PH_END();
        if (PH_ON()) { DECL_PTRS();
            LAS int* tile_e = (LAS int*)(lds + LDS_MISC); LAS int* rb = tile_e + 320; LAS int* nt_p = tile_e + 400;
            moe_tables(ctl, l, tile_e, rb, nt_p, tid);
            constexpr int RJ = 4;
            for (int t0 = gw * RJ; t0 < T; t0 += NGW * RJ) {
                const int b = t0 / S; const float* mo = MOD + (size_t)(l * 2 + b) * 6144;
                int r0[RJ], r1[RJ]; float w0[RJ], w1[RJ];
#pragma unroll
                for (int u = 0; u < RJ; ++u) { const int t = t0 + u; { const int e0_ = TOKES[2 * t], e1_ = TOKES[2 * t + 1]; r0[u] = rb[e0_ >> 15] + (e0_ & 32767); r1[u] = rb[e1_ >> 15] + (e1_ & 32767); } w0[u] = TOKW[2 * t]; w1[u] = TOKW[2 * t + 1];
#ifdef PROBE_MASK
                    if (a.probe_var == 4 || a.probe_var == -4) { w0[u] *= 0.5f; w1[u] *= 0.5f; }
#endif
                }
                f32x4 v[RJ][4]; u32x2 ya[RJ][4], yb[RJ][4];
#pragma unroll
                for (int u = 0; u < RJ; ++u)
#pragma unroll
                    for (int j = 0; j < 4; ++j) { const int col = 4 * lane + 256 * j; { const u32x2 xw = *(const u32x2*)(XB + (size_t)(t0 + u) * 1024 + col); v[u][j] = (f32x4){bflo(xw.x), bfhi(xw.x), bflo(xw.y), bfhi(xw.y)}; }
                        ya[u][j] = *(const u32x2*)(Y + (size_t)r0[u] * 1024 + col); yb[u][j] = *(const u32x2*)(Y + (size_t)r1[u] * 1024 + col); }
                f32x4 gg[4];
#pragma unroll
                for (int j = 0; j < 4; ++j) gg[j] = *(const f32x4*)(mo + 5120 + 4 * lane + 256 * j);
                float ss[RJ];
#pragma unroll
                for (int u = 0; u < RJ; ++u) { ss[u] = 0.f;
#pragma unroll
                    for (int j = 0; j < 4; ++j) { const int col = 4 * lane + 256 * j; const f32x4 xv = v[u][j]; f32x4 nv;
                        nv.x = xv.x + gg[j].x * (w0[u] * bflo(ya[u][j].x) + w1[u] * bflo(yb[u][j].x)); nv.y = xv.y + gg[j].y * (w0[u] * bfhi(ya[u][j].x) + w1[u] * bfhi(yb[u][j].x));
                        nv.z = xv.z + gg[j].z * (w0[u] * bflo(ya[u][j].y) + w1[u] * bflo(yb[u][j].y)); nv.w = xv.w + gg[j].w * (w0[u] * bfhi(ya[u][j].y) + w1[u] * bfhi(yb[u][j].y));
                        if (l + 1 < DEPTH) { u32x2 xw; xw.x = pk2(nv.x, nv.y); xw.y = pk2(nv.z, nv.w); *(u32x2*)(XB + (size_t)(t0 + u) * 1024 + col) = xw; nv = (f32x4){bflo(xw.x), bfhi(xw.x), bflo(xw.y), bfhi(xw.y)}; }
                        else *(f32x4*)(out + (size_t)(t0 + u) * 1024 + col) = nv;
                        v[u][j] = nv; ss[u] += (nv.x * nv.x + nv.y * nv.y) + (nv.z * nv.z + nv.w * nv.w); } }
                if (l + 1 < DEPTH) {
                    const float* mn = MOD + (size_t)((l + 1) * 2 + b) * 6144;
                    f32x4 sc1[4], sh1[4];
#pragma unroll
                    for (int j = 0; j < 4; ++j) { sc1[j] = *(const f32x4*)(mn + 1024 + 4 * lane + 256 * j); sh1[j] = *(const f32x4*)(mn + 4 * lane + 256 * j); }
#pragma unroll
                    for (int u = 0; u < RJ; ++u) { const float rn = rsqrtf(wave_sum(ss[u]) * (1.0f / 1024.0f) + EPS);
#pragma unroll
                        for (int j = 0; j < 4; ++j) { const int col = 4 * lane + 256 * j;
                            u32x2 w; w.x = pk2(v[u][j].x * rn * (1.f + sc1[j].x) + sh1[j].x, v[u][j].y * rn * (1.f + sc1[j].y) + sh1[j].y); w.y = pk2(v[u][j].z * rn * (1.f + sc1[j].z) + sh1[j].z, v[u][j].w * rn * (1.f + sc1[j].w) + sh1[j].w);
                            *(u32x2*)(H + (size_t)(t0 + u) * 1024 + col) = w; } }
                }
            }
        }
        PH_END();
    }
#undef PH_ON
#undef PH_END
}

extern "C" void kernel_launch(void* const* d_in, const int* in_sizes, int n_in, void* d_out, int out_size, void* d_ws, size_t ws_size, hipStream_t stream) {
    static int grid = 0;
    if (grid == 0) {
        if (n_in != 37 || out_size != T * D || ws_size < WS_END) { fprintf(stderr, "kernel_launch: unexpected shapes (n_in %d, out %d, ws %zu); nothing launched\n", n_in, out_size, ws_size); grid = -1; return; }
        int dev = 0, cus = 0, per_cu = 0;
        if (hipGetDevice(&dev) != hipSuccess || hipDeviceGetAttribute(&cus, hipDeviceAttributeMultiprocessorCount, dev) != hipSuccess) { grid = -1; return; }
        if (hipFuncSetAttribute((const void*)fwd, hipFuncAttributeMaxDynamicSharedMemorySize, LDS_BYTES) != hipSuccess) { fprintf(stderr, "kernel_launch: hipFuncSetAttribute failed\n"); grid = -1; return; }
        if (hipOccupancyMaxActiveBlocksPerMultiprocessor(&per_cu, (const void*)fwd, NTHREADS, LDS_BYTES) != hipSuccess || per_cu < 1) fprintf(stderr, "kernel_launch: occupancy query says %d\n", per_cu);
        (void)hipGetLastError();
        grid = cus;
    }
    if (grid < 0) return;
    if (hipMemsetAsync((char*)d_ws + WS_CTL, 0, CTL_ZERO_BYTES, stream) != hipSuccess) return;
    Args a{};
    for (int i = 0; i < 37; ++i) a.in[i] = d_in[i];
    a.out = (float*)d_out; a.ws = (unsigned char*)d_ws;
#ifdef PROBE_MASK
#ifndef PROBE_VAR
#define PROBE_VAR 0
#endif
    {
        int types[N_PHASES]; int n = 0; types[n++] = 0; types[n++] = 1; types[n++] = 2;
        for (int l = 0; l < DEPTH; ++l) { if ((l & 1) == 0) { for (int k = 3; k <= 7; ++k) if (k != 4 && k != 6) types[n++] = k; } else { for (int k = 8; k <= 13; ++k) if (k != 9) types[n++] = k; } for (int k = 14; k <= 19; ++k) if (k != 16) types[n++] = k; }
        for (int p = 0; p < N_PHASES; ++p) { a.ph_lo = p; a.ph_hi = p + 1; const int reps = ((PROBE_MASK >> types[p]) & 1) ? 2 : 1;
            for (int r = 0; r < reps; ++r) { a.probe_var = (reps == 2) ? ((r == 0) ? PROBE_VAR : -PROBE_VAR) : 0; hipLaunchKernelGGL(fwd, dim3(grid), dim3(NTHREADS), LDS_BYTES, stream, a); } }
    }
#elif MK_ONE_LAUNCH
    a.ph_lo = 0; a.ph_hi = N_PHASES;
    hipLaunchKernelGGL(fwd, dim3(grid), dim3(NTHREADS), LDS_BYTES, stream, a);
#else
    for (int p = 0; p < N_PHASES; ++p) { a.ph_lo = p; a.ph_hi = p + 1; hipLaunchKernelGGL(fwd, dim3(grid), dim3(NTHREADS), LDS_BYTES, stream, a); }
#endif
}
```

```cpp
#include <hip/hip_runtime.h>
#include <cstdio>
#include <cstdint>
#include <hip/hip_bf16.h>
#include <cmath>
#ifndef MK_ONE_LAUNCH
#define MK_ONE_LAUNCH 1
#endif
namespace pg8 {
#define PG8_LAS __attribute__((address_space(3)))
typedef unsigned short bf16_t;
typedef short bf16x8 __attribute__((ext_vector_type(8)));
typedef float f32x4 __attribute__((ext_vector_type(4)));
typedef unsigned u32x4 __attribute__((ext_vector_type(4)));
constexpr int BM = 256, BK = 64, HALF = 128, HTB = HALF * BK * 2  , STAGE_BYTES = 8 * HTB, NXCD = 8, WGM = 8;

__host__ __device__ __forceinline__ int lds_byte(int r, int c) { const int st = (r >> 4) * 2 + (c >> 5), rr = r & 15, cc = c & 31, ob = rr * 64 + cc * 2; return st * 1024 + (ob ^ (((ob >> 9) & 1) << 5)); }
__host__ __device__ __forceinline__ void stage_rc(int b, int& R, int& C) { const int st = b / 1024, sb = b % 1024, swz = sb ^ (((sb >> 9) & 1) << 5); R = (st >> 1) * 16 + swz / 64; C = (st & 1) * 32 + (swz % 64) / 2; }
__host__ __device__ __forceinline__ int perm32(int rho) { const int n = rho >> 4, i = rho & 15; return 8 * (i >> 2) + 4 * n + (i & 3); }

struct Unit { int pm, pn, be; };
struct Gemm { const bf16_t* A; const bf16_t* Bt; int M, N, K; size_t bstride; };

struct StaticOrder {
    int nM, nN, nwg, G, c;
    __host__ __device__ void init(int M, int N, int G_, int c_) { nM = M / BM; nN = N / BM; nwg = nM * nN; G = G_; c = c_; }
    __host__ __device__ bool next(int i, Unit& u) const {
        const long L = (long)i * G + c; if (L >= nwg) return false;
        int wgid = (int)L; { const int q = nwg / NXCD, r = nwg % NXCD, xcd = wgid % NXCD, off = wgid / NXCD; wgid = (xcd < r ? xcd * (q + 1) : r * (q + 1) + (xcd - r) * q) + off; }
        const int nig = WGM * nN, gid = wgid / nig, fm = gid * WGM, gsz = (nM - fm) < WGM ? (nM - fm) : WGM;
        u.pm = fm + ((wgid % nig) % gsz); u.pn = (wgid % nig) / gsz; u.be = 0; return true;
    }
    __device__ __forceinline__ void a_ready(const Unit&) const {}
    __device__ __forceinline__ void done(const Unit&) const {}
};

__device__ __forceinline__ unsigned cvt_pk_bf16(float lo, float hi) { unsigned r; asm volatile("v_cvt_pk_bf16_f32 %0, %1, %2" : "=v"(r) : "v"(lo), "v"(hi)); return r; }
typedef float f32x2 __attribute__((ext_vector_type(2)));
struct NoRows { static constexpr bool GATHER = false; __device__ __forceinline__ unsigned operator()(const Unit&, int) const { return 0u; } };
template <class Epi, class Sched, bool ALIGN_EPI = false, bool SP2 = false, class Rows = NoRows>
__device__ __forceinline__ void gemm_phase(PG8_LAS unsigned char* lds, const Gemm g, const Sched& S, const Epi& E, const int tid_in, const Rows& RW = Rows()) {
    const int tid = tid_in, wid = __builtin_amdgcn_readfirstlane(tid >> 6), lane = tid & 63, wr = wid >> 2, wc = wid & 3, fr = lane & 15, fq = lane >> 4;
    const int K = g.K, nt = K / BK;
    unsigned voffA[2], voffB[2];
#pragma unroll
    for (int i = 0; i < 2; ++i) { int R, C; stage_rc(tid * 16 + i * 8192, R, C); const int Rb = Epi::PERM ? ((R & ~31) + perm32(R & 31)) : R;
        voffA[i] = (unsigned)(R * K + C) * 2u; voffB[i] = (unsigned)(Rb * K + C) * 2u; }
    const size_t kstep = (size_t)(BK * 2);
    const size_t hstep = (size_t)HALF * K * 2;
    const size_t tstep = 2 * hstep;
    const unsigned ldsw = (unsigned)wid * 1024u;
    const int aoff = lds_byte(wr * 64 + fr, fq * 8), boff = lds_byte(wc * 32 + fr, fq * 8);
#define PG8_SA(b, h) (((b) * 2 + (h)) * HTB)
#define PG8_SB(b, h) ((4 + (b) * 2 + (h)) * HTB)
#define PG8_STAGE(bufoff, gbase, voff) do { _Pragma("unroll") for (int _i = 0; _i < 2; ++_i) \
        __builtin_amdgcn_global_load_lds((const unsigned*)((const char*)(gbase) + (voff)[_i]), (PG8_LAS unsigned*)(lds + (bufoff) + ldsw + _i * 8192), 16, 0, 0); } while (0)
#define PG8_LDA(dst, b, h) do { _Pragma("unroll") for (int m = 0; m < 4; ++m) _Pragma("unroll") for (int k = 0; k < 2; ++k) dst[m][k] = *(const PG8_LAS bf16x8*)(lds + PG8_SA(b, h) + aoff + m * 2048 + k * 1024); } while (0)
#define PG8_LDB(dst, b, h) do { _Pragma("unroll") for (int n = 0; n < 2; ++n) _Pragma("unroll") for (int k = 0; k < 2; ++k) dst[n][k] = *(const PG8_LAS bf16x8*)(lds + PG8_SB(b, h) + boff + n * 2048 + k * 1024); } while (0)
#define PG8_MMA(ai, bj, At, Bt) do { __builtin_amdgcn_s_setprio(1); _Pragma("unroll") for (int m = 0; m < 4; ++m) _Pragma("unroll") for (int n = 0; n < 2; ++n) _Pragma("unroll") for (int k = 0; k < 2; ++k) \
        acc[ai][bj][m][n] = __builtin_amdgcn_mfma_f32_16x16x32_bf16(Bt[n][k], At[m][k], acc[ai][bj][m][n], 0, 0, 0); __builtin_amdgcn_s_setprio(0); } while (0)
#define PG8_WAIT_V(n) asm volatile("s_waitcnt vmcnt(" #n ")" ::: "memory")
#define PG8_WAIT_L(n) asm volatile("s_waitcnt lgkmcnt(" #n ")" ::: "memory")
#define PG8_BAR __builtin_amdgcn_s_barrier()
#define PG8_SCHED __builtin_amdgcn_sched_barrier(0)
    Unit cur, nxt; int ui = 0;
    if (!S.next(0, cur)) return;
    f32x4 acc[2][2][4][2];
#pragma unroll
    for (int a = 0; a < 2; ++a)
#pragma unroll
        for (int b = 0; b < 2; ++b)
#pragma unroll
            for (int m = 0; m < 4; ++m)
#pragma unroll
                for (int n = 0; n < 2; ++n) { float z0_ = 0.f; asm volatile("" : "+v"(z0_)); acc[a][b][m][n] = (f32x4){z0_, z0_, z0_, z0_}; }
    bf16x8 At[4][2], B0[2][2], B1[2][2];
    const char* cA = Rows::GATHER ? (const char*)g.A : (const char*)g.A + (size_t)cur.pm * tstep; const char* cB = (const char*)g.Bt + (size_t)cur.be * g.bstride + (size_t)cur.pn * tstep;
    int Rr[2], Cc[2];
#pragma unroll
    for (int i = 0; i < 2; ++i) stage_rc(tid * 16 + i * 8192, Rr[i], Cc[i]);
    unsigned voffAh[2][2], voffAn[2][2];
#pragma unroll
    for (int h = 0; h < 2; ++h)
#pragma unroll
        for (int i = 0; i < 2; ++i) { voffAh[h][i] = Rows::GATHER ? RW(cur, h * HALF + Rr[i]) + (unsigned)Cc[i] * 2u : voffA[i] + (unsigned)h * (unsigned)hstep; voffAn[h][i] = voffAh[h][i]; }
    S.a_ready(cur);
    if constexpr (SP2) {
        PG8_STAGE(PG8_SB(0, 0), cB, voffB); PG8_STAGE(PG8_SB(0, 1), cB + hstep, voffB); PG8_STAGE(PG8_SA(0, 0), cA, voffAh[0]); PG8_STAGE(PG8_SA(0, 1), cA, voffAh[1]);
        if (wr == 1) PG8_BAR;
        PG8_WAIT_V(2); PG8_BAR;
        PG8_STAGE(PG8_SB(1, 0), cB + kstep, voffB); PG8_STAGE(PG8_SA(1, 0), cA + kstep, voffAh[0]); PG8_STAGE(PG8_SB(1, 1), cB + hstep + kstep, voffB);
        PG8_WAIT_V(6); PG8_BAR;
    } else {
        PG8_STAGE(PG8_SB(0, 0), cB, voffB); PG8_STAGE(PG8_SA(0, 0), cA, voffAh[0]); PG8_STAGE(PG8_SB(0, 1), cB + hstep, voffB); PG8_STAGE(PG8_SA(0, 1), cA, voffAh[1]);
        if (wr == 1) PG8_BAR;
        PG8_WAIT_V(4); PG8_BAR;
        PG8_STAGE(PG8_SB(1, 0), cB + kstep, voffB); PG8_STAGE(PG8_SA(1, 0), cA + kstep, voffAh[0]); PG8_STAGE(PG8_SB(1, 1), cB + hstep + kstep, voffB);
        PG8_WAIT_V(6); PG8_BAR;
    }
    for (;;) {
        const bool has_next = S.next(ui + 1, nxt);
        const char* nA = Rows::GATHER ? (const char*)g.A : (has_next ? (const char*)g.A + (size_t)nxt.pm * tstep : cA);
        if constexpr (Rows::GATHER) { if (has_next) {
#pragma unroll
            for (int h = 0; h < 2; ++h)
#pragma unroll
                for (int i = 0; i < 2; ++i) voffAn[h][i] = RW(nxt, h * HALF + Rr[i]) + (unsigned)Cc[i] * 2u; } } const char* nB = has_next ? (const char*)g.Bt + (size_t)nxt.be * g.bstride + (size_t)nxt.pn * tstep : cB;
        for (int t = 0; t < nt; t += 2) {
            const bool last = (t == nt - 2); const bool gsel = Rows::GATHER && last && has_next;
            const char* a1 = cA + (size_t)(t + 1) * kstep;
            const char* a2 = last ? nA : cA + (size_t)(t + 2) * kstep; const char* b2 = last ? nB : cB + (size_t)(t + 2) * kstep;
            const char* a3 = a2 + kstep; const char* b3 = b2 + kstep;
            if (last && has_next) S.a_ready(nxt);
            if constexpr (SP2) {
            PG8_LDB(B0, 0, 0); PG8_LDB(B1, 0, 1); PG8_SCHED; PG8_LDA(At, 0, 0); PG8_STAGE(PG8_SA(1, 1), a1, voffAh[1]);
            PG8_WAIT_V(8); PG8_WAIT_L(0); PG8_BAR; PG8_MMA(0, 0, At, B0); PG8_MMA(0, 1, At, B1); PG8_BAR; PG8_SCHED;
            PG8_LDA(At, 0, 1); PG8_STAGE(PG8_SB(0, 0), b2, voffB); PG8_STAGE(PG8_SB(0, 1), b2 + hstep, voffB); PG8_STAGE(PG8_SA(0, 0), a2, (gsel ? voffAn[0] : voffAh[0]));
            PG8_WAIT_V(8); PG8_WAIT_L(0); PG8_BAR; PG8_MMA(1, 0, At, B0); PG8_MMA(1, 1, At, B1); PG8_BAR; PG8_SCHED;
            PG8_LDB(B0, 1, 0); PG8_LDB(B1, 1, 1); PG8_SCHED; PG8_LDA(At, 1, 0); PG8_STAGE(PG8_SA(0, 1), a2, (gsel ? voffAn[1] : voffAh[1]));
            PG8_WAIT_V(8); PG8_WAIT_L(0); PG8_BAR; PG8_MMA(0, 0, At, B0); PG8_MMA(0, 1, At, B1); PG8_BAR; PG8_SCHED;
            PG8_LDA(At, 1, 1); PG8_STAGE(PG8_SB(1, 0), b3, voffB); PG8_STAGE(PG8_SB(1, 1), b3 + hstep, voffB); PG8_STAGE(PG8_SA(1, 0), a3, (gsel ? voffAn[0] : voffAh[0]));
            PG8_WAIT_V(8); PG8_WAIT_L(0); PG8_BAR; PG8_MMA(1, 0, At, B0); PG8_MMA(1, 1, At, B1); PG8_BAR; PG8_SCHED;
            } else {
            PG8_LDB(B0, 0, 0); PG8_SCHED; PG8_LDA(At, 0, 0); PG8_STAGE(PG8_SA(1, 1), a1, voffAh[1]);
            PG8_WAIT_L(8); PG8_BAR; PG8_WAIT_L(0); PG8_MMA(0, 0, At, B0); PG8_BAR; PG8_SCHED;
            PG8_LDB(B1, 0, 1); PG8_STAGE(PG8_SB(0, 0), b2, voffB);
            PG8_BAR; PG8_WAIT_L(0); PG8_MMA(0, 1, At, B1); PG8_BAR;
            PG8_LDA(At, 0, 1); PG8_STAGE(PG8_SA(0, 0), a2, (gsel ? voffAn[0] : voffAh[0]));
            PG8_BAR; PG8_WAIT_L(0); PG8_MMA(1, 0, At, B0); PG8_BAR; PG8_SCHED;
            PG8_STAGE(PG8_SB(0, 1), b2 + hstep, voffB);
            PG8_WAIT_V(6); PG8_BAR; PG8_MMA(1, 1, At, B1); PG8_BAR;
            PG8_LDB(B0, 1, 0); PG8_SCHED; PG8_LDA(At, 1, 0); PG8_STAGE(PG8_SA(0, 1), a2, (gsel ? voffAn[1] : voffAh[1]));
            PG8_WAIT_L(8); PG8_BAR; PG8_WAIT_L(0); PG8_MMA(0, 0, At, B0); PG8_BAR; PG8_SCHED;
            PG8_LDB(B1, 1, 1); PG8_STAGE(PG8_SB(1, 0), b3, voffB);
            PG8_BAR; PG8_WAIT_L(0); PG8_MMA(0, 1, At, B1); PG8_BAR;
            PG8_LDA(At, 1, 1); PG8_STAGE(PG8_SA(1, 0), a3, (gsel ? voffAn[0] : voffAh[0]));
            PG8_BAR; PG8_WAIT_L(0); PG8_MMA(1, 0, At, B0); PG8_BAR; PG8_SCHED;
            PG8_STAGE(PG8_SB(1, 1), b3 + hstep, voffB);
            PG8_WAIT_V(6); PG8_BAR; PG8_MMA(1, 1, At, B1); PG8_BAR;
            }
        }
        if constexpr (ALIGN_EPI) { if (wr == 0) PG8_BAR; }
        if constexpr (!Epi::AFTER_DRAIN) { int l2_; asm volatile("v_mbcnt_lo_u32_b32 %0, -1, 0\n\tv_mbcnt_hi_u32_b32 %0, -1, %0" : "=v"(l2_)); E(acc, cur, wr, wc, l2_ & 15, l2_ >> 4); S.done(cur); }
        if (!has_next) break;
#pragma unroll
        for (int a = 0; a < 2; ++a)
#pragma unroll
            for (int b = 0; b < 2; ++b)
#pragma unroll
                for (int m = 0; m < 4; ++m)
#pragma unroll
                    for (int n = 0; n < 2; ++n) { float z0_ = 0.f; asm volatile("" : "+v"(z0_)); acc[a][b][m][n] = (f32x4){z0_, z0_, z0_, z0_}; }
        cur = nxt; cA = nA; cB = nB; ++ui;
        if constexpr (Rows::GATHER) {
#pragma unroll
            for (int h = 0; h < 2; ++h)
#pragma unroll
                for (int i = 0; i < 2; ++i) voffAh[h][i] = voffAn[h][i]; }
        if constexpr (ALIGN_EPI) { if (wr == 1) PG8_BAR; }
    }
    PG8_WAIT_V(0);
    if constexpr (!ALIGN_EPI) { if (wr == 0) PG8_BAR; }
    PG8_BAR;
    if constexpr (Epi::AFTER_DRAIN) { E.fused(acc, cur, wr, wc, fr, fq, lds, wid, lane); S.done(cur); }
#undef PG8_SA
#undef PG8_SB
#undef PG8_STAGE
#undef PG8_LDA
#undef PG8_LDB
#undef PG8_MMA
#undef PG8_WAIT_V
#undef PG8_WAIT_L
#undef PG8_BAR
#undef PG8_SCHED
}
}
namespace attn_body {
using bf16=__hip_bfloat16;
using bf16x8=__attribute__((ext_vector_type(8)))short;
using s16x4=__attribute__((ext_vector_type(4)))short;
using f32x16=__attribute__((ext_vector_type(16)))float;
using u32x4=__attribute__((ext_vector_type(4)))unsigned;
constexpr int D=64;
constexpr int NW=8,QBLK=32,QB=QBLK*NW,KVBLK=64;
constexpr int ATTN_UNIT_ROWS=QB;
__device__ __forceinline__ int crow(int r,int hi){return (r&3)+8*(r>>2)+4*hi;}
#define SBAR() __builtin_amdgcn_sched_barrier(0)
__device__ __forceinline__ void cmask(f32x16&p0,f32x16&p1,int jb,int qrel,int hi){
  const float NEG=-INFINITY; int kb=64*jb+4*hi;
  #pragma unroll
  for(int r=0;r<16;++r){int kv=kb+(r&3)+8*(r>>2); if(kv>qrel)p0[r]=NEG; if(kv+32>qrel)p1[r]=NEG;}
}

constexpr int NSLOT=3, SLOTB=8192;
constexpr int LDS_K=0, LDS_V=NSLOT*SLOTB, LDS_WS=2*NSLOT*SLOTB, LDS_OST=LDS_WS+NW*64*4, LDS_BYTES=LDS_OST+NW*4096;
constexpr float C2=0.125f*1.4426950408889634f;
__device__ __forceinline__ void glds16(const void*gsrc,unsigned lds_dst){unsigned keep;
  asm volatile("s_mov_b32 %0, m0\n\ts_mov_b32 m0, %2\n\ts_nop 0\n\tglobal_load_lds_dwordx4 %1, off\n\ts_mov_b32 m0, %0":"=&s"(keep):"v"(gsrc),"s"(lds_dst):"memory");}
__device__ __forceinline__ float max3f(float a,float b,float c){float r;asm("v_max3_f32 %0, %1, %2, %3":"=v"(r):"v"(a),"v"(b),"v"(c));return r;}
__device__ __forceinline__ float max2f(float a,float b){float r;asm("v_max_f32_e32 %0, %1, %2":"=v"(r):"v"(a),"v"(b));return r;}
__device__ __forceinline__ float fadd_s(float a,float b){float r;asm("v_add_f32_e32 %0, %1, %2":"=v"(r):"v"(a),"v"(b));return r;}
__device__ __forceinline__ float fsub_s(float a,float b){float r;asm("v_sub_f32_e32 %0, %1, %2":"=v"(r):"v"(a),"v"(b));return r;}
typedef float f32x2_t __attribute__((ext_vector_type(2))); typedef __bf16 bf16x2_t __attribute__((ext_vector_type(2)));
__device__ __forceinline__ unsigned cvtpk_s(float lo,float hi){f32x2_t v={lo,hi};bf16x2_t b=__builtin_convertvector(v,bf16x2_t);return __builtin_bit_cast(unsigned,b);}
#define WAIT_BAR(N) asm volatile("s_waitcnt vmcnt(" #N ") lgkmcnt(0)\n\ts_barrier":::"memory")

__device__ __forceinline__ void qkt(f32x16&p0,f32x16&p1,const char*Kslot,const bf16x8*qr,const f32x16&negm,int r32,int hi){
  const char*kb=Kslot+hi*1024+r32*16;
  #pragma unroll
  for(int d0=0;d0<4;++d0){
    const bf16x8 b0=*reinterpret_cast<const bf16x8*>(kb+d0*2048);
    const bf16x8 b1=*reinterpret_cast<const bf16x8*>(kb+d0*2048+512);
    if(d0==0){p0=__builtin_amdgcn_mfma_f32_32x32x16_bf16(b0,qr[0],negm,0,0,0);p1=__builtin_amdgcn_mfma_f32_32x32x16_bf16(b1,qr[0],negm,0,0,0);}
    else{p0=__builtin_amdgcn_mfma_f32_32x32x16_bf16(b0,qr[d0],p0,0,0,0);p1=__builtin_amdgcn_mfma_f32_32x32x16_bf16(b1,qr[d0],p1,0,0,0);}}
}
typedef __attribute__((address_space(3))) const char* lds_cptr;
typedef short v4i16_t __attribute__((ext_vector_type(4)));
__device__ __forceinline__ void kload8(bf16x8*kf,lds_cptr kp){
  kf[0]=*(const __attribute__((address_space(3))) bf16x8*)(kp);      kf[1]=*(const __attribute__((address_space(3))) bf16x8*)(kp+512);
  kf[2]=*(const __attribute__((address_space(3))) bf16x8*)(kp+2048); kf[3]=*(const __attribute__((address_space(3))) bf16x8*)(kp+2560);
  kf[4]=*(const __attribute__((address_space(3))) bf16x8*)(kp+4096); kf[5]=*(const __attribute__((address_space(3))) bf16x8*)(kp+4608);
  kf[6]=*(const __attribute__((address_space(3))) bf16x8*)(kp+6144); kf[7]=*(const __attribute__((address_space(3))) bf16x8*)(kp+6656);
}
__device__ __forceinline__ void kload2(bf16x8*kf,lds_cptr kp,int j){ kf[2*j]=*(const __attribute__((address_space(3))) bf16x8*)(kp+j*2048); kf[2*j+1]=*(const __attribute__((address_space(3))) bf16x8*)(kp+j*2048+512); }
__device__ __forceinline__ s16x4 vtr(lds_cptr p){ return __builtin_bit_cast(s16x4,__builtin_amdgcn_ds_read_tr16_b64_v4i16((__attribute__((address_space(3))) v4i16_t*)p)); }
__device__ __forceinline__ float rowmax(const f32x16&p0,const f32x16&p1){
  float a=max3f(p0[0],p0[1],p1[0]),b=max3f(p0[2],p0[3],p1[1]);a=max3f(a,p1[2],p1[3]);
  #pragma unroll
  for(int r=4;r<16;r+=4){a=max3f(a,p0[r],p0[r+1]);b=max3f(b,p0[r+2],p0[r+3]);a=max3f(a,p1[r],p1[r+1]);b=max3f(b,p1[r+2],p1[r+3]);}
  const float m=max2f(a,b);
  auto rr=__builtin_amdgcn_permlane32_swap(__float_as_uint(m),__float_as_uint(m),false,false);
  return max2f(__uint_as_float(rr[0]),__uint_as_float(rr[1]));
}
__device__ __forceinline__ void pv(f32x16*o,int vb,bf16x8 pa0,bf16x8 pa1,bf16x8 pa2,bf16x8 pa3){
  #pragma unroll
  for(int d0=0;d0<2;++d0){s16x4 lo[4],hi[4];
    #pragma unroll
    for(int ks=0;ks<4;++ks){
      asm volatile("ds_read_b64_tr_b16 %0,%1 offset:%c2":"=&v"(lo[ks]):"v"(vb),"i"(d0*4096+ks*1024):"memory");
      asm volatile("ds_read_b64_tr_b16 %0,%1 offset:%c2":"=&v"(hi[ks]):"v"(vb),"i"(d0*4096+ks*1024+512):"memory");}
    asm volatile("s_waitcnt lgkmcnt(0)":::"memory");SBAR();
    #define PK(k) (bf16x8){lo[k][0],lo[k][1],lo[k][2],lo[k][3],hi[k][0],hi[k][1],hi[k][2],hi[k][3]}
    o[d0]=__builtin_amdgcn_mfma_f32_32x32x16_bf16(pa0,PK(0),o[d0],0,0,0);
    o[d0]=__builtin_amdgcn_mfma_f32_32x32x16_bf16(pa1,PK(1),o[d0],0,0,0);
    o[d0]=__builtin_amdgcn_mfma_f32_32x32x16_bf16(pa2,PK(2),o[d0],0,0,0);
    o[d0]=__builtin_amdgcn_mfma_f32_32x32x16_bf16(pa3,PK(3),o[d0],0,0,0);
    #undef PK
  }
}

#ifndef ATTN_STORE16
#define ATTN_STORE16(p,v) (*(u32x4*)(p)=(v))
#endif
template<int THRL,int PIN,int POUT> __device__ __forceinline__ void attn_unit(int qb,const bf16*Qh,const bf16*__restrict__ Kh,const bf16*__restrict__ Vh,bf16*Oh,char*shm,const int wid_in){
  constexpr int DM=PIN;
  int lane; asm volatile("v_mbcnt_lo_u32_b32 %0, -1, 0\n\tv_mbcnt_hi_u32_b32 %0, -1, %0" : "=v"(lane));
  const int wid=wid_in; const int tid=wid*64+lane; const int r32=lane&31,hi=lane>>5;
  const int q0=qb*QB;
  const bf16*Qw=Qh+(long)(q0+wid*QBLK)*DM;
  const unsigned lds0=(unsigned)(uintptr_t)shm;
  float*wsf=(float*)(shm+LDS_WS)+wid*64;
  const bf16*ksrc=Kh+(long)lane*DM+wid*8;
  const bf16*vsrc=Vh+(long)(16*(wid&3)+(lane>>2))*DM+(wid>>2)*32+(lane&3)*8;
  const unsigned kdst=lds0+LDS_K+wid*1024, vdst=lds0+LDS_V+wid*1024;
  #define DMA_K(t,slot) glds16(ksrc+(long)(t)*KVBLK*DM,(unsigned)__builtin_amdgcn_readfirstlane(kdst+(slot)))
  #define DMA_V(t,slot) glds16(vsrc+(long)(t)*KVBLK*DM,(unsigned)__builtin_amdgcn_readfirstlane(vdst+(slot)))
  const int vb0=(int)(lds0+LDS_V)+((lane>>4)&1)*32+(lane&3)*8+(4*hi+((lane&15)>>2))*64;
  const char*Kbase=shm+LDS_K; bf16x8 kf[8];
  const lds_cptr shm3=(lds_cptr)shm; const lds_cptr kp0=shm3+LDS_K+hi*1024+r32*16; const lds_cptr vp0=shm3+LDS_V+((lane>>4)&1)*32+(lane&3)*8+(4*hi+((lane&15)>>2))*64;
  const int NT=(q0+QB)/KVBLK;
  DMA_K(0,0);DMA_V(0,0);DMA_K(1,SLOTB);
  bf16x8 qr[4];
  #pragma unroll
  for(int d0=0;d0<4;++d0)qr[d0]=*reinterpret_cast<const bf16x8*>(&Qw[(long)r32*DM+d0*16+hi*8]);
  float mhat=0.f,l_reg=0.f;f32x16 o[2];f32x16 negm;{float z0_=0.f;asm volatile("":"+v"(z0_));
  #pragma unroll
  for(int r=0;r<16;++r){o[0][r]=z0_;o[1][r]=z0_;negm[r]=z0_;}}asm volatile("":"+v"(negm));
  const int qrel=wid*QBLK+r32;
  #define CMASK(P0,P1,t) do{int jb_=(t)-(NT-4); if(jb_>=0)cmask(P0,P1,jb_,qrel,hi);}while(0)
  bool resc=false;
  #define START(P0,P1) do{ const float rm=rowmax(P0,P1); resc=false; \
    { const float dl=rm; mhat=fadd_s(mhat,dl); \
      _Pragma("unroll") for(int r=0;r<16;++r){P0[r]=fsub_s(P0[r],dl);P1[r]=fsub_s(P1[r],dl);} \
      _Pragma("unroll") for(int r=0;r<16;++r)negm[r]=-mhat; asm volatile("":"+v"(negm)); } \
    _Pragma("unroll") for(int r=0;r<16;++r)P0[r]=__builtin_amdgcn_exp2f(P0[r]); }while(0)
  #define RESC() do{ if(resc){ asm volatile("s_waitcnt lgkmcnt(0)":::"memory"); \
      _Pragma("unroll") for(int d_=0;d_<2;++d_) _Pragma("unroll") for(int r=0;r<16;++r)o[d_][r]*=wsf[crow(r,hi)]; } }while(0)
  f32x16 pA0,pA1,pB0,pB1;
  int sl_prev=0,sl_cur=0,sl_next=SLOTB;
  #define ROT() do{sl_prev=sl_cur;sl_cur=sl_next;sl_next=(sl_next==(NSLOT-1)*SLOTB)?0:sl_next+SLOTB;}while(0)
  DMA_K(2,2*SLOTB);
  WAIT_BAR(3);
  qkt(pA0,pA1,Kbase,qr,negm,r32,hi);asm volatile("s_nop 15\n\ts_nop 7":"+v"(pA0),"+v"(pA1));CMASK(pA0,pA1,0);
  START(pA0,pA1);
  _Pragma("unroll") for(int r=0;r<16;++r)pA1[r]=__builtin_amdgcn_exp2f(pA1[r]);
  WAIT_BAR(0);
  DMA_K(3,0);DMA_V(1,SLOTB);
  ROT();
  kload8(kf,kp0+sl_cur);
  WAIT_BAR(2);
  s16x4 vlo[8],vhi[8]; u32x4 pw0,pw1,pw2,pw3;
  #define PKW(P,B) cvtpk_s(P[B],P[B+1])
  #define PAF(k) __builtin_bit_cast(bf16x8,pw##k)
  #define VFR(i) (bf16x8){vlo[i][0],vlo[i][1],vlo[i][2],vlo[i][3],vhi[i][0],vhi[i][1],vhi[i][2],vhi[i][3]}
  #define PIN(x) asm volatile("":"+v"(x))
  #define MX3(a,b,c) __builtin_fmaxf(__builtin_fmaxf((a),(b)),(c))
  #define GAPA(MF,A0,A1,A2,A3,W0,W1,PW) do{ MF; sacc+=A0; sacc+=A1; sacc+=A2; sacc+=A3; PIN(sacc); W0; W1; PIN(PW); SBAR(); }while(0)
  #define EX(v) __builtin_amdgcn_exp2f(v)
  #define GAPB(MF,X,B) do{ MF; X[B]=EX(X[B]); X[B+1]=EX(X[B+1]); X[B+2]=EX(X[B+2]); X[B+3]=EX(X[B+3]); PIN(X); SBAR(); }while(0)
  #define VRD(i) do{ vlo[i]=vtr(vp_+(((i)>>2)*4096+((i)&3)*1024)); vhi[i]=vtr(vp_+(((i)>>2)*4096+((i)&3)*1024+512)); }while(0)
  #define KRD(G,j) do{ if(G){ kload2(kf,kp0+sl_next,j); SBAR(); } }while(0)
  #define STEP(C0,C1,P0,P1,t,GK,GV,GL) do{ SBAR(); \
    const lds_cptr vp_=vp0+sl_prev; \
    VRD(0); SBAR(); float sacc=(P0[0]+P0[1]); \
    GAPA(C0=__builtin_amdgcn_mfma_f32_32x32x16_bf16(kf[0],qr[0],negm,0,0,0), P0[2],P0[3],P0[4],P0[5],     pw0[0]=PKW(P0,0), pw0[1]=PKW(P0,2), pw0); \
    VRD(4); SBAR(); GAPA(C1=__builtin_amdgcn_mfma_f32_32x32x16_bf16(kf[1],qr[0],negm,0,0,0), P0[6],P0[7],P0[8],P0[9],     pw0[2]=PKW(P0,4), pw0[3]=PKW(P0,6), pw0); \
    VRD(1); SBAR(); GAPA(C0=__builtin_amdgcn_mfma_f32_32x32x16_bf16(kf[2],qr[1],C0,0,0,0),   P0[10],P0[11],P0[12],P0[13], pw1[0]=PKW(P0,8), pw1[1]=PKW(P0,10), pw1); \
    VRD(5); SBAR(); GAPA(C1=__builtin_amdgcn_mfma_f32_32x32x16_bf16(kf[3],qr[1],C1,0,0,0),   P0[14],P0[15],P1[0],P1[1],   pw1[2]=PKW(P0,12),pw1[3]=PKW(P0,14), pw1); \
    VRD(2); SBAR(); GAPA(C0=__builtin_amdgcn_mfma_f32_32x32x16_bf16(kf[4],qr[2],C0,0,0,0),   P1[2],P1[3],P1[4],P1[5],     pw2[0]=PKW(P1,0), pw2[1]=PKW(P1,2), pw2); \
    VRD(6); SBAR(); GAPA(C1=__builtin_amdgcn_mfma_f32_32x32x16_bf16(kf[5],qr[2],C1,0,0,0),   P1[6],P1[7],P1[8],P1[9],     pw2[2]=PKW(P1,4), pw2[3]=PKW(P1,6), pw2); \
    VRD(3); SBAR(); GAPA(C0=__builtin_amdgcn_mfma_f32_32x32x16_bf16(kf[6],qr[3],C0,0,0,0),   P1[10],P1[11],P1[12],P1[13], pw3[0]=PKW(P1,8), pw3[1]=PKW(P1,10), pw3); \
    VRD(7); SBAR(); GAPA(C1=__builtin_amdgcn_mfma_f32_32x32x16_bf16(kf[7],qr[3],C1,0,0,0),   P1[14],P1[15],0.f,0.f,       pw3[2]=PKW(P1,12),pw3[3]=PKW(P1,14), pw3); \
    l_reg+=sacc; \
    if(GK){DMA_K((t)+3,sl_cur);} if(GV){DMA_V((t)+1,sl_next);} \
    CMASK(C0,C1,t); \
    { float a=MX3(C0[0],C0[1],C1[0]),b=MX3(C0[2],C0[3],C1[1]); a=MX3(a,C1[2],C1[3]); \
      _Pragma("unroll") for(int r=4;r<16;r+=4){a=MX3(a,C0[r],C0[r+1]);b=MX3(b,C0[r+2],C0[r+3]);a=MX3(a,C1[r],C1[r+1]);b=MX3(b,C1[r+2],C1[r+3]);} \
      float rm=__builtin_fmaxf(a,b); { auto rr=__builtin_amdgcn_permlane32_swap(__float_as_uint(rm),__float_as_uint(rm),false,false); rm=__builtin_fmaxf(__uint_as_float(rr[0]),__uint_as_float(rr[1])); } \
      resc=false; \
      if(__builtin_expect(__any(rm>(float)THRL),0)){ const float dl=__builtin_fmaxf(rm,0.f); mhat+=dl; \
        _Pragma("unroll") for(int r=0;r<16;++r){C0[r]-=dl;C1[r]-=dl;} \
        _Pragma("unroll") for(int r=0;r<16;++r)negm[r]=-mhat; asm volatile("":"+v"(negm)); \
        const float f=__builtin_amdgcn_exp2f(-dl); l_reg*=f; if(hi==0)wsf[r32]=f; resc=true; } } \
    SBAR(); \
    GAPB(o[0]=__builtin_amdgcn_mfma_f32_32x32x16_bf16(PAF(0),VFR(0),o[0],0,0,0), C0,0); \
    GAPB(o[1]=__builtin_amdgcn_mfma_f32_32x32x16_bf16(PAF(0),VFR(4),o[1],0,0,0), C0,4); \
    KRD(GL,0); GAPB(o[0]=__builtin_amdgcn_mfma_f32_32x32x16_bf16(PAF(1),VFR(1),o[0],0,0,0), C0,8); \
    KRD(GL,1); GAPB(o[1]=__builtin_amdgcn_mfma_f32_32x32x16_bf16(PAF(1),VFR(5),o[1],0,0,0), C0,12); \
    KRD(GL,2); GAPB(o[0]=__builtin_amdgcn_mfma_f32_32x32x16_bf16(PAF(2),VFR(2),o[0],0,0,0), C1,0); \
    KRD(GL,3); GAPB(o[1]=__builtin_amdgcn_mfma_f32_32x32x16_bf16(PAF(2),VFR(6),o[1],0,0,0), C1,4); \
    GAPB(o[0]=__builtin_amdgcn_mfma_f32_32x32x16_bf16(PAF(3),VFR(3),o[0],0,0,0), C1,8); \
    GAPB(o[1]=__builtin_amdgcn_mfma_f32_32x32x16_bf16(PAF(3),VFR(7),o[1],0,0,0), C1,12); \
    }while(0)
  int t=1;
  #undef CMASK
  #define CMASK(P0,P1,t) do{}while(0)
  for(;t+5<NT;t+=2){
    STEP(pB0,pB1,pA0,pA1,t,true,true,true);     WAIT_BAR(2); RESC(); ROT();
    STEP(pA0,pA1,pB0,pB1,t+1,true,true,true);   WAIT_BAR(2); RESC(); ROT();
  }
  #undef CMASK
  #define CMASK(P0,P1,t) do{int jb_=(t)-(NT-4); if(jb_>=0)cmask(P0,P1,jb_,qrel,hi);}while(0)
  #define ENDW(tt) do{ if((tt)+3<NT){WAIT_BAR(2);} else if((tt)+2<NT){WAIT_BAR(1);} else {WAIT_BAR(0);} }while(0)
  for(;t+1<NT;t+=2){
    STEP(pB0,pB1,pA0,pA1,t,(t+3<NT),(t+1<NT),(t+1<NT));       ENDW(t);   RESC(); ROT();
    STEP(pA0,pA1,pB0,pB1,t+1,(t+4<NT),(t+2<NT),(t+2<NT));     ENDW(t+1); RESC(); ROT();
  }
  STEP(pB0,pB1,pA0,pA1,NT-1,false,false,false); RESC();
  { float sacc=pB0[0]+pB0[1]; _Pragma("unroll") for(int r=2;r<16;++r)sacc+=pB0[r]; _Pragma("unroll") for(int r=0;r<16;++r)sacc+=pB1[r]; l_reg+=sacc;
    pw0=(u32x4){PKW(pB0,0),PKW(pB0,2),PKW(pB0,4),PKW(pB0,6)};pw1=(u32x4){PKW(pB0,8),PKW(pB0,10),PKW(pB0,12),PKW(pB0,14)};pw2=(u32x4){PKW(pB1,0),PKW(pB1,2),PKW(pB1,4),PKW(pB1,6)};pw3=(u32x4){PKW(pB1,8),PKW(pB1,10),PKW(pB1,12),PKW(pB1,14)};
    SBAR(); pv(o,vb0+sl_cur,PAF(0),PAF(1),PAF(2),PAF(3)); }
  #undef PKW
  #undef PAF
  #undef VFR
  #undef PIN
  #undef MX3
  #undef GAPA
  #undef GAPB
  #undef EX
  #undef VRD
  #undef KRD
  #undef STEP
  #undef ENDW
  {auto rr=__builtin_amdgcn_permlane32_swap(__float_as_uint(l_reg),__float_as_uint(l_reg),false,false);l_reg=__uint_as_float(rr[0])+__uint_as_float(rr[1]);}
  if(hi==0)wsf[32+r32]=l_reg;asm volatile("s_waitcnt lgkmcnt(0)":::"memory");
  float rli[16];
  #pragma unroll
  for(int r=0;r<16;++r)rli[r]=__builtin_amdgcn_rcpf(wsf[32+crow(r,hi)]);
  bf16*Ow=Oh+(long)(q0+wid*QBLK)*POUT;
  { bf16*stg=(bf16*)(shm+LDS_OST)+wid*2048;
    #pragma unroll
    for(int r=0;r<16;++r){const int orow=crow(r,hi);
      #pragma unroll
      for(int d0=0;d0<2;++d0)stg[orow*64+d0*32+r32]=__float2bfloat16(o[d0][r]*rli[r]);}
    asm volatile("s_waitcnt lgkmcnt(0)":::"memory");
    #pragma unroll
    for(int i=0;i<4;++i){const int row=i*8+(lane>>3),ch=lane&7; const u32x4 v=*(const u32x4*)(stg+row*64+ch*8); ATTN_STORE16(Ow+(long)row*POUT+ch*8,v);} }
  asm volatile("s_waitcnt lgkmcnt(0)\n\ts_barrier":::"memory");
  #undef DMA_K
  #undef DMA_V
  #undef CMASK
  #undef START
  #undef RESC
  #undef ROT
}
constexpr int ATTN_LDS_BYTES=LDS_BYTES;
#undef SBAR
#undef WAIT_BAR
}

#define LAS __attribute__((address_space(3)))
typedef unsigned short bf16_t;
typedef float f32x4 __attribute__((ext_vector_type(4)));
typedef unsigned u32x4 __attribute__((ext_vector_type(4)));
typedef unsigned u32x2 __attribute__((ext_vector_type(2)));
typedef float f32x2 __attribute__((ext_vector_type(2)));
typedef _Float16 f16x8 __attribute__((ext_vector_type(8)));
typedef _Float16 f16x4 __attribute__((ext_vector_type(4)));

constexpr int NB = 2, S = 16384, T = NB * S, D = 1024, DEPTH = 4;
constexpr int EV_N = 3368, EV_NP = 3584, EV_ZP = 3072, OD_N = 2048;
constexpr float EPS = 1e-6f;
constexpr float LOG2E = 1.4426950408889634f;
constexpr float QSCALE = 0.125f * LOG2E;
constexpr int NWAVES = 8, NTHREADS = 512;
constexpr int LDS_BYTES = 163840;
constexpr int LDS_MISC = 131072;
constexpr int LDS_BARW = LDS_BYTES - 64;
constexpr int LDS_PTBL = LDS_BYTES - 512;

constexpr size_t MiB = 1u << 20;
constexpr size_t WS_CTL = 0, CTL_ZERO_BYTES = 1 * MiB;
constexpr size_t WS_MOD = 1 * MiB;
constexpr size_t WS_MODP = 1 * MiB + 256 * 1024;
constexpr size_t WS_ROPE = 2 * MiB;
constexpr size_t WS_S5A = 4 * MiB;
constexpr size_t WS_S5B = 4 * MiB + 64 * 1024;
constexpr size_t WS_LAM = 6 * MiB;
constexpr size_t WS_KM = 6 * MiB + 4096;
constexpr size_t WS_WRH = 6 * MiB + 512 * 1024;
constexpr size_t WS_KMH = 7 * MiB + 512 * 1024;
constexpr size_t WS_WEVIN = 8 * MiB;
constexpr size_t WS_WEVOUT = 22 * MiB;
constexpr size_t WS_WODIN = 26 * MiB;
constexpr size_t WS_WODOUT = 34 * MiB;
constexpr size_t WS_WGLU = 38 * MiB;
constexpr size_t WS_W13 = 40 * MiB;
constexpr size_t WS_W2 = 104 * MiB;
constexpr size_t WS_H = 136 * MiB;
constexpr size_t WS_O = 200 * MiB;
constexpr size_t WS_Z = 264 * MiB;
constexpr size_t WS_XG = 264 * MiB;
constexpr size_t WS_Y = 264 * MiB;
constexpr size_t WS_HID = 408 * MiB;
constexpr size_t WS_IQ = 456 * MiB;
constexpr size_t WS_YG = 456 * MiB;
constexpr size_t WS_IKW = 488 * MiB;
constexpr size_t WS_IQH = 496 * MiB;
constexpr size_t WS_IKH = 512 * MiB;
constexpr size_t WS_IW = 514 * MiB;
constexpr size_t WS_SEL = 516 * MiB;
constexpr size_t WS_YMIX = 548 * MiB;
constexpr size_t WS_LTOK = 612 * MiB;
constexpr size_t WS_TOKES = 616 * MiB;
constexpr size_t WS_TOKW = 617 * MiB;
constexpr size_t WS_TOKROW = 618 * MiB;
constexpr size_t WS_UG = 516 * MiB;
constexpr size_t WS_S5E = 496 * MiB;
constexpr size_t WS_S5HC = 488 * MiB;
constexpr size_t WS_S5KT = 620 * MiB;
constexpr size_t WS_S5WT = 624 * MiB;
constexpr size_t WS_S5A2 = 640 * MiB;
constexpr size_t WS_S5PW = 656 * MiB;
constexpr size_t WS_MLIST = 660 * MiB;
constexpr size_t WS_MPO = 724 * MiB;
constexpr size_t WS_MML = 852 * MiB;
constexpr size_t WS_MASKW = 724 * MiB;
constexpr size_t WS_NSEL = 860 * MiB;
constexpr size_t WS_XB = 862 * MiB;
constexpr size_t WS_END = 926 * MiB;
constexpr int XG_ROWS = 73728;
constexpr int CW_BAR = 4096;
constexpr int CW_MCNT = 16384;
constexpr int CW_CNT = 8192;

#define XB_TMO      128
#define XB_XCNT(j)  (256  + 64 * (j))
#define XB_XSUB(j)  (1280 + 64 * (j))
#define XB_XGEN(j)  (2304 + 64 * (j))
#define XB_TOP      3328
#define XB_TOPGEN   3392
#define XCD_BAR_WORDS 3456
#define XB_SPIN_CAP (1u << 24)

__device__ __forceinline__ unsigned xb_ld(unsigned* p)              { return __hip_atomic_load(p, __ATOMIC_RELAXED, __HIP_MEMORY_SCOPE_AGENT); }
__device__ __forceinline__ unsigned xb_add(unsigned* p, unsigned v) { return __hip_atomic_fetch_add(p, v, __ATOMIC_RELAXED, __HIP_MEMORY_SCOPE_AGENT); }
__device__ __forceinline__ unsigned xb_xcc_id() { return (unsigned)__builtin_amdgcn_s_getreg((3 << 11) | 20) & 0xFu; }
#define XB_SPIN(cond, bar) do { unsigned _sp = 0; while (cond) { __builtin_amdgcn_s_sleep(1); \
    if ((++_sp & 255u) == 0u) { if (xb_ld(&(bar)[XB_TMO])) break; if (_sp > XB_SPIN_CAP) { atomicAdd(&(bar)[XB_TMO], 1u); break; } } } } while (0)

struct XcdBarrier { unsigned* bar; unsigned x; volatile LAS unsigned* st; };

__device__ __forceinline__ XcdBarrier xcd_barrier_post(unsigned* bar, volatile LAS unsigned* st, bool leader) {
    XcdBarrier b; b.bar = bar; b.x = xb_xcc_id(); b.st = st;
    if (leader) (void)xb_add(&bar[XB_XCNT(b.x)], 1u);
    return b;
}
__device__ __forceinline__ void xcd_barrier_complete(unsigned* bar, unsigned x, unsigned& nloc, unsigned& nx) {
    const unsigned G = gridDim.x * gridDim.y * gridDim.z;
    unsigned sum, cnt, mine, sp = 0u;
    for (;;) {
        sum = 0u; cnt = 0u; mine = 0u;
#pragma unroll
        for (unsigned j = 0; j < 16; ++j) { const unsigned c = xb_ld(&bar[XB_XCNT(j)]); sum += c; cnt += (c > 0u) ? 1u : 0u; mine = (j == x) ? c : mine; }
        if (sum == G) break;
        __builtin_amdgcn_s_sleep(1);
        if ((++sp & 255u) == 0u) { if (xb_ld(&bar[XB_TMO])) break; if (sp > XB_SPIN_CAP) { atomicAdd(&bar[XB_TMO], 1u); break; } }
    }
    nloc = mine > 0u ? mine : 1u; nx = cnt > 0u ? cnt : 1u;
}
__device__ __forceinline__ void xcd_barrier(const XcdBarrier& b, bool leader) {
    asm volatile("s_waitcnt vmcnt(0)" ::: "memory");
    __syncthreads();
    if (leader) {
        unsigned* bar = b.bar;
        __builtin_amdgcn_s_waitcnt(0);
        unsigned nloc = b.st[0], nx = b.st[1];
        if (nloc == 0u) { xcd_barrier_complete(bar, b.x, nloc, nx); b.st[0] = nloc; b.st[1] = nx; }
        const unsigned old = xb_add(&bar[XB_XSUB(b.x)], 1u);
        const unsigned gen = old / nloc;
        if (old + 1u == (gen + 1u) * nloc) {
            __builtin_amdgcn_fence(__ATOMIC_RELEASE, "agent");
            asm volatile("s_waitcnt vmcnt(0)" ::: "memory");
            const unsigned og = xb_add(&bar[XB_TOP], 1u);
            const unsigned tg = og / nx;
            if (og + 1u == (tg + 1u) * nx) xb_add(&bar[XB_TOPGEN], 1u);
            else XB_SPIN(xb_ld(&bar[XB_TOPGEN]) == tg, bar);
            __builtin_amdgcn_fence(__ATOMIC_ACQUIRE, "agent");
            xb_add(&bar[XB_XGEN(b.x)], 1u);
            asm volatile("s_waitcnt vmcnt(0)" ::: "memory");
        } else {
            XB_SPIN(xb_ld(&bar[XB_XGEN(b.x)]) == gen, bar);
            __builtin_amdgcn_fence(__ATOMIC_ACQUIRE, "agent");
            asm volatile("s_waitcnt vmcnt(0)" ::: "memory");
        }
    }
    __syncthreads();
}

#define LDS_WAIT() asm volatile("s_waitcnt lgkmcnt(0)" ::: "memory")
__device__ __forceinline__ float bflo(unsigned w) { return __uint_as_float(w << 16); }
__device__ __forceinline__ float bfhi(unsigned w) { return __uint_as_float(w & 0xffff0000u); }
__device__ __forceinline__ unsigned pk2(float lo, float hi) { typedef float f32x2_ __attribute__((ext_vector_type(2))); typedef __bf16 bf16x2_ __attribute__((ext_vector_type(2))); const f32x2_ v = {lo, hi}; return __builtin_bit_cast(unsigned, __builtin_convertvector(v, bf16x2_)); }
__device__ __forceinline__ unsigned f2bf(float f) { return pk2(f, 0.f) & 0xffffu; }
__device__ __forceinline__ float shx_(float v, int m, int lane) { return __int_as_float(__builtin_amdgcn_ds_bpermute((lane ^ m) << 2, __float_as_int(v))); }
__device__ __forceinline__ unsigned shi_(unsigned v, int src) { return (unsigned)__builtin_amdgcn_ds_bpermute(src << 2, (int)v); }
#define SHX(v, m) shx_((v), (m), lane)
__device__ __forceinline__ float dpp_xor1(float v) { return __int_as_float(__builtin_amdgcn_update_dpp(0, __float_as_int(v), 0xB1, 0xF, 0xF, true)); }
__device__ __forceinline__ float dpp_xor2(float v) { return __int_as_float(__builtin_amdgcn_update_dpp(0, __float_as_int(v), 0x4E, 0xF, 0xF, true)); }
__device__ __forceinline__ float half_sum(float v) { const auto r = __builtin_amdgcn_permlane32_swap(__float_as_uint(v), __float_as_uint(v), false, false); return __uint_as_float(r[0]) + __uint_as_float(r[1]); }
__device__ __forceinline__ float half_max(float v) { const auto r = __builtin_amdgcn_permlane32_swap(__float_as_uint(v), __float_as_uint(v), false, false); return fmaxf(__uint_as_float(r[0]), __uint_as_float(r[1])); }
__device__ __forceinline__ float wave_sum_(float v, int lane) {
    v += dpp_xor1(v); v += dpp_xor2(v); v += shx_(v, 4, lane); v += shx_(v, 8, lane); v += shx_(v, 16, lane); return half_sum(v);
}

#define wave_sum(v) wave_sum_((v), lane)
__device__ __forceinline__ float wave_max_(float v, int lane) {
#pragma unroll
    for (int o = 1; o < 64; o <<= 1) v = fmaxf(v, shx_(v, o, lane));
    return v;
}
__device__ __forceinline__ bool qk_bounded(const float* gq, const float* gk, int lane) {
    const float a = wave_max_(fabsf(gq[lane]), lane), b = wave_max_(fabsf(gk[lane]), lane);
    return 64.0f * QSCALE * a * b <= 60.0f;
}
__device__ __forceinline__ void unpack8(const u32x4 w, float (&v)[8]) {
    v[0] = bflo(w.x); v[1] = bfhi(w.x); v[2] = bflo(w.y); v[3] = bfhi(w.y); v[4] = bflo(w.z); v[5] = bfhi(w.z); v[6] = bflo(w.w); v[7] = bfhi(w.w);
}
__device__ __forceinline__ u32x4 pack8(const float (&v)[8]) { u32x4 w; w.x = pk2(v[0], v[1]); w.y = pk2(v[2], v[3]); w.z = pk2(v[4], v[5]); w.w = pk2(v[6], v[7]); return w; }
__device__ __forceinline__ float gelu_tanh(float y) {
    const float z = 0.7978845608028654f * (y + 0.044715f * y * y * y);
    const float e = __builtin_amdgcn_exp2f(2.885390081777927f * z);
    const float th = 1.0f - 2.0f * __builtin_amdgcn_rcpf(e + 1.0f);
    return 0.5f * y * (1.0f + th);
}
__device__ __forceinline__ float sigmoidf_(float v) { return __builtin_amdgcn_rcpf(1.0f + __builtin_amdgcn_exp2f(-1.4426950408889634f * v)); }
__device__ __forceinline__ unsigned ordkey(float f) { const unsigned u = __float_as_uint(f); return u ^ ((unsigned)((int)u >> 31) | 0x80000000u); }

struct EpiPlain {
    static constexpr bool PERM = true, AFTER_DRAIN = false;
    bf16_t* O; int ldc;
    __device__ __forceinline__ void operator()(const pg8::f32x4 (&acc)[2][2][4][2], const pg8::Unit& u, int wr, int wc, int fr, int fq) const {
        const int row0 = u.pm * 256 + wr * 64 + fr, col0 = u.pn * 256 + wc * 32 + 8 * fq;
#pragma unroll
        for (int ai = 0; ai < 2; ++ai)
#pragma unroll
            for (int m = 0; m < 4; ++m) { bf16_t* rowp = O + (size_t)(row0 + ai * 128 + m * 16) * ldc + col0;
#pragma unroll
                for (int bj = 0; bj < 2; ++bj) { const pg8::f32x4 v0 = acc[ai][bj][m][0], v1 = acc[ai][bj][m][1];
                    u32x4 w; w.x = pk2(v0[0], v0[1]); w.y = pk2(v0[2], v0[3]); w.z = pk2(v1[0], v1[1]); w.w = pk2(v1[2], v1[3]);
                    *(u32x4*)(rowp + bj * 128) = w; } }
    }
};
__device__ __forceinline__ void epi_khead(const pg8::f32x4 (&acc)[2][2][4][2], bf16_t* Z, int ldz, int colbase, const float* gain, const float* COSH, const float* SINH, int row0, int wc, int fr, int fq) {
    const int lane = fr + 16 * fq;
    float g[2][8];
#pragma unroll
    for (int bj = 0; bj < 2; ++bj)
#pragma unroll
        for (int e = 0; e < 8; ++e) g[bj][e] = gain[bj * 32 + 8 * fq + e];
#pragma unroll
    for (int ai = 0; ai < 2; ++ai)
#pragma unroll
      for (int mp = 0; mp < 4; mp += 2) {
        f32x4 csv[2][2], snv[2][2];
#pragma unroll
        for (int mm = 0; mm < 2; ++mm) { const int pos = (row0 + ai * 128 + (mp + mm) * 16) & (S - 1);
            csv[mm][0] = *(const f32x4*)(COSH + pos * 8); csv[mm][1] = *(const f32x4*)(COSH + pos * 8 + 4); snv[mm][0] = *(const f32x4*)(SINH + pos * 8); snv[mm][1] = *(const f32x4*)(SINH + pos * 8 + 4); }
        __builtin_amdgcn_sched_barrier(0);
#pragma unroll
        for (int mm = 0; mm < 2; ++mm) { const int m = mp + mm; const int row = row0 + ai * 128 + m * 16;
            float v[2][8]; float ss = 0.f;
#pragma unroll
            for (int bj = 0; bj < 2; ++bj)
#pragma unroll
                for (int e = 0; e < 4; ++e) { v[bj][e] = acc[ai][bj][m][0][e]; v[bj][4 + e] = acc[ai][bj][m][1][e]; ss += v[bj][e] * v[bj][e] + v[bj][4 + e] * v[bj][4 + e]; }
            ss += shx_(ss, 16, lane); ss = half_sum(ss);
            const float r = rsqrtf(ss * (1.0f / 64.0f) + EPS);
#pragma unroll
            for (int bj = 0; bj < 2; ++bj)
#pragma unroll
                for (int e = 0; e < 8; ++e) v[bj][e] *= r * g[bj][e];
#pragma unroll
            for (int e = 0; e < 8; ++e) { const float oth = shx_(v[0][e], 16, lane); const float cs = csv[mm][e >> 2][e & 3], sn = snv[mm][e >> 2][e & 3];
                if (fq == 0) v[0][e] = v[0][e] * cs - oth * sn; else if (fq == 1) v[0][e] = v[0][e] * cs + oth * sn; }
            bf16_t* zp = Z + (size_t)row * ldz + colbase + wc * 64 + 8 * fq;
            *(u32x4*)zp = pack8(v[0]); *(u32x4*)(zp + 32) = pack8(v[1]); }
        __builtin_amdgcn_sched_barrier(0);
      }
}
struct EpiEvenIn {
    static constexpr bool PERM = true, AFTER_DRAIN = false;
    bf16_t* Z; _Float16* IQH; _Float16* IKH; float* IW; const float* a_kn; const float* b_kn; const float* idx_kn; const float* COSH; const float* SINH; const float* COSI; const float* SINI;
    __device__ __forceinline__ void operator()(const pg8::f32x4 (&acc)[2][2][4][2], const pg8::Unit& u, int wr, int wc, int fr, int fq) const {
        const int row0 = u.pm * 256 + wr * 64 + fr; const int lane = fr + 16 * fq;
        if (u.pn == 2 || u.pn == 3) epi_khead(acc, Z, EV_ZP, 512 + (u.pn & 1) * 256, a_kn, COSH, SINH, row0, wc, fr, fq);
        else if (u.pn == 8 || u.pn == 9) epi_khead(acc, Z, EV_ZP, 2048 + (u.pn & 1) * 256, b_kn, COSH, SINH, row0, wc, fr, fq);
        else if (u.pn < 12) {
            const int col0 = u.pn * 256 + wc * 32 + 8 * fq;
#pragma unroll
            for (int ai = 0; ai < 2; ++ai)
#pragma unroll
                for (int m = 0; m < 4; ++m) { bf16_t* rowp = Z + (size_t)(row0 + ai * 128 + m * 16) * EV_ZP + col0;
#pragma unroll
                    for (int bj = 0; bj < 2; ++bj) { const pg8::f32x4 v0 = acc[ai][bj][m][0], v1 = acc[ai][bj][m][1];
                        u32x4 w; w.x = pk2(v0[0], v0[1]); w.y = pk2(v0[2], v0[3]); w.z = pk2(v1[0], v1[1]); w.w = pk2(v1[2], v1[3]);
                        *(u32x4*)(rowp + bj * 128) = w; } }
        } else if (u.pn == 12) {
#pragma unroll
            for (int ai = 0; ai < 2; ++ai) {
                f32x4 csr[4], snr[4];
#pragma unroll
                for (int m = 0; m < 4; ++m) { const int pos = (row0 + ai * 128 + m * 16) & (S - 1); csr[m] = *(const f32x4*)(COSI + pos * 4); snr[m] = *(const f32x4*)(SINI + pos * 4); }
                __builtin_amdgcn_sched_barrier(0);
#pragma unroll
                for (int m = 0; m < 4; ++m) { const int row = row0 + ai * 128 + m * 16;
                    const f32x4 cs = csr[m], sn = snr[m];
#pragma unroll
                    for (int bj = 0; bj < 2; ++bj) { pg8::f32x4 v0 = acc[ai][bj][m][0], v1 = acc[ai][bj][m][1];
                        if (fq == 0) { const pg8::f32x4 a0 = v0, a1 = v1;
#pragma unroll
                            for (int e = 0; e < 4; ++e) { v0[e] = a0[e] * cs[e] - a1[e] * sn[e]; v1[e] = a1[e] * cs[e] + a0[e] * sn[e]; } }
                        f16x8 hq;
#pragma unroll
                        for (int e = 0; e < 4; ++e) { hq[e] = (_Float16)v0[e]; hq[4 + e] = (_Float16)v1[e]; }
                        *(f16x8*)(IQH + (size_t)row * 256 + bj * 128 + wc * 32 + 8 * fq) = hq; } }
                __builtin_amdgcn_sched_barrier(0);
            }
        } else {
            if (wc == 0) {
                float g[8];
#pragma unroll
                for (int e = 0; e < 8; ++e) g[e] = idx_kn[8 * fq + e];
#pragma unroll
                for (int ai = 0; ai < 2; ++ai) {
                  f32x4 csr[4], snr[4];
#pragma unroll
                  for (int m = 0; m < 4; ++m) { const int pos = (row0 + ai * 128 + m * 16) & (S - 1); csr[m] = *(const f32x4*)(COSI + pos * 4); snr[m] = *(const f32x4*)(SINI + pos * 4); }
                  __builtin_amdgcn_sched_barrier(0);
#pragma unroll
                    for (int m = 0; m < 4; ++m) { const int row = row0 + ai * 128 + m * 16;
                        float v[8]; float ss = 0.f;
#pragma unroll
                        for (int e = 0; e < 4; ++e) { v[e] = acc[ai][0][m][0][e]; v[4 + e] = acc[ai][0][m][1][e]; ss += v[e] * v[e] + v[4 + e] * v[4 + e]; }
                        ss += shx_(ss, 16, lane); ss = half_sum(ss);
                        const float r = rsqrtf(ss * (1.0f / 32.0f) + EPS);
#pragma unroll
                        for (int e = 0; e < 8; ++e) v[e] *= r * g[e];
                        if (fq == 0) {
#pragma unroll
                            for (int e = 0; e < 4; ++e) { const float x1 = v[e], x2 = v[4 + e]; const float cs = csr[m][e], sn = snr[m][e]; v[e] = x1 * cs - x2 * sn; v[4 + e] = x2 * cs + x1 * sn; } }
                        f16x8 hk;
#pragma unroll
                        for (int e = 0; e < 8; ++e) hk[e] = (_Float16)v[e];
                        *(f16x8*)(IKH + (size_t)row * 32 + 8 * fq) = hk; }
                  __builtin_amdgcn_sched_barrier(0);
                }
            } else if (wc == 1 && fq == 0) {
#pragma unroll
                for (int ai = 0; ai < 2; ++ai)
#pragma unroll
                    for (int m = 0; m < 4; ++m) { float* wp = IW + (size_t)(row0 + ai * 128 + m * 16) * 8; *(pg8::f32x4*)wp = acc[ai][0][m][0]; *(pg8::f32x4*)(wp + 4) = acc[ai][0][m][1]; }
            }
        }
    }
};
struct EpiOddIn {
    static constexpr bool PERM = true, AFTER_DRAIN = false;
    bf16_t* Z; bf16_t* UG; const float* c_kn; const float* COSH; const float* SINH;
    __device__ __forceinline__ void operator()(const pg8::f32x4 (&acc)[2][2][4][2], const pg8::Unit& u, int wr, int wc, int fr, int fq) const {
        const int row0 = u.pm * 256 + wr * 64 + fr, col0 = u.pn * 256 + wc * 32 + 8 * fq;
        if (u.pn == 2 || u.pn == 3) { epi_khead(acc, Z, OD_N, 512 + (u.pn & 1) * 256, c_kn, COSH, SINH, row0, wc, fr, fq); return; }
#pragma unroll
        for (int ai = 0; ai < 2; ++ai)
#pragma unroll
            for (int m = 0; m < 4; ++m) { const size_t row = (size_t)(row0 + ai * 128 + m * 16);
#pragma unroll
                for (int bj = 0; bj < 2; ++bj) { const pg8::f32x4 v0 = acc[ai][bj][m][0], v1 = acc[ai][bj][m][1]; const int col = col0 + bj * 128;
                    u32x4 w; w.x = pk2(v0[0], v0[1]); w.y = pk2(v0[2], v0[3]); w.z = pk2(v1[0], v1[1]); w.w = pk2(v1[2], v1[3]);
                    if (u.pn < 6) *(u32x4*)(Z + row * OD_N + col) = w;
                    else { const int cu = col - 1536; *(u32x4*)(UG + ((size_t)(cu >> 4) * T + row) * 16 + (cu & 15)) = w; } } }
    }
};
__device__ __forceinline__ void load_q_normed(attn_body::bf16x8 (&qr)[4], const bf16_t* zrow, const float* gain, const float* COSH, const float* SINH, int pos, int hi, int lane) {
    float v[4][8]; float ss = 0.f;
#pragma unroll
    for (int d0 = 0; d0 < 4; ++d0) { unpack8(*(const u32x4*)(zrow + d0 * 16 + hi * 8), v[d0]);
#pragma unroll
        for (int e = 0; e < 8; ++e) ss += v[d0][e] * v[d0][e]; }
    ss = half_sum(ss);
    const float r = rsqrtf(ss * (1.0f / 64.0f) + EPS) * QSCALE;
#pragma unroll
    for (int d0 = 0; d0 < 4; ++d0)
#pragma unroll
        for (int e = 0; e < 8; ++e) v[d0][e] *= r * gain[d0 * 16 + hi * 8 + e];
#pragma unroll
    for (int e = 0; e < 8; ++e) { const float oth = shx_(v[0][e], 32, lane); const float cs = COSH[pos * 8 + e], sn = SINH[pos * 8 + e];
        v[0][e] = hi ? v[0][e] * cs + oth * sn : v[0][e] * cs - oth * sn; }
#pragma unroll
    for (int d0 = 0; d0 < 4; ++d0) qr[d0] = __builtin_bit_cast(attn_body::bf16x8, pack8(v[d0]));
}
struct EpiSwiGLU {
    static constexpr bool PERM = true, AFTER_DRAIN = false;
    bf16_t* HID;
    __device__ __forceinline__ void operator()(const pg8::f32x4 (&acc)[2][2][4][2], const pg8::Unit& u, int wr, int wc, int fr, int fq) const {
        const int row0 = u.pm * 256 + wr * 64 + fr, col0 = (u.pn * 256 + wc * 32 + 8 * fq) >> 1;
#pragma unroll
        for (int ai = 0; ai < 2; ++ai)
#pragma unroll
            for (int m = 0; m < 4; ++m) { bf16_t* rowp = HID + (size_t)(row0 + ai * 128 + m * 16) * 512 + col0;
#pragma unroll
                for (int bj = 0; bj < 2; ++bj) { const pg8::f32x4 v0 = acc[ai][bj][m][0], v1 = acc[ai][bj][m][1];
                    const float h0 = v0[0] * sigmoidf_(v0[0]) * v0[1], h1 = v0[2] * sigmoidf_(v0[2]) * v0[3];
                    const float h2 = v1[0] * sigmoidf_(v1[0]) * v1[1], h3 = v1[2] * sigmoidf_(v1[2]) * v1[3];
                    u32x2 w; w.x = pk2(h0, h1); w.y = pk2(h2, h3);
                    *(u32x2*)(rowp + bj * 64) = w; } }
    }
};
struct EpiGLU {
    static constexpr bool PERM = true, AFTER_DRAIN = false;
    bf16_t* O; const bf16_t* YG; const float* gb;
    __device__ __forceinline__ void operator()(const pg8::f32x4 (&acc)[2][2][4][2], const pg8::Unit& u, int wr, int wc, int fr, int fq) const {
        const int row0 = u.pm * 256 + wr * 64 + fr, col0 = u.pn * 256 + wc * 32 + 8 * fq;
#pragma unroll
        for (int ai = 0; ai < 2; ++ai)
#pragma unroll
            for (int bj = 0; bj < 2; ++bj) {
                const int c = col0 + bj * 128;
                u32x4 yr[4];
#pragma unroll
                for (int m = 0; m < 4; ++m) yr[m] = *(const u32x4*)(YG + (size_t)(row0 + ai * 128 + m * 16) * 512 + c);
                const pg8::f32x4 b0 = *(const pg8::f32x4*)(gb + c), b1 = *(const pg8::f32x4*)(gb + c + 4);
                __builtin_amdgcn_sched_barrier(0);
#pragma unroll
                for (int m = 0; m < 4; ++m) { const size_t row = (size_t)(row0 + ai * 128 + m * 16);
                    const pg8::f32x4 v0 = acc[ai][bj][m][0], v1 = acc[ai][bj][m][1];
                    float y[8]; unpack8(yr[m], y);
                    float o[8];
#pragma unroll
                    for (int j = 0; j < 4; ++j) { o[j] = y[j] * sigmoidf_(v0[j] + b0[j]); o[4 + j] = y[4 + j] * sigmoidf_(v1[j] + b1[j]); }
                    *(u32x4*)(O + row * 1024 + 512 + c) = pack8(o); }
                __builtin_amdgcn_sched_barrier(0);
            }
    }
};
struct MoeOrder {
    int nN, nunits, G, c; const LAS int* tile_e;
    __device__ __forceinline__ bool next(int i, pg8::Unit& u) const { const int L = i * G + c; if (L >= nunits) return false;
        int w = L; { const int q = nunits / 8, r = nunits % 8, xcd = w % 8, off = w / 8; w = (xcd < r ? xcd * (q + 1) : r * (q + 1) + (xcd - r) * q) + off; }
        u.pm = w / nN; u.pn = w % nN; u.be = tile_e[u.pm]; return true; }
    __device__ __forceinline__ void a_ready(const pg8::Unit&) const {}
    __device__ __forceinline__ void done(const pg8::Unit&) const {}
};

__device__ __forceinline__ int wt_row(int n, int row_mul, int row_add) {
    if (row_mul > 0) return n * row_mul + row_add;
    const int tile = n >> 8, w = n & 255;
    const bool ktile = (tile == 2 || tile == 3) || (row_mul == -1 && (tile == 8 || tile == 9));
    return ktile ? tile * 256 + ((w & 63) >> 5) * 128 + (w >> 6) * 32 + (w & 31) : n;
}
__device__ __forceinline__ void transpose_item(const float* W, int K, int N, bf16_t* WT, int row_mul, int row_add, LAS float* scr, int item, int nblk, int lane) {
    const int kb = item / nblk, nb = item % nblk, k0 = 64 * kb, n0 = 32 * nb;
    const int nn = n0 + (lane & 31);
    float tv[32];
#pragma unroll
    for (int i = 0; i < 32; ++i) { const int kk = 2 * i + (lane >> 5); tv[i] = (nn < N) ? W[(size_t)(k0 + kk) * N + nn] : 0.f; }
#pragma unroll
    for (int i = 0; i < 32; ++i) { const int kk = 2 * i + (lane >> 5); scr[kk * 33 + (lane & 31)] = tv[i]; }
    LDS_WAIT(); asm volatile("" ::: "memory");
    const int c = lane & 7;
#pragma unroll
    for (int j = 0; j < 4; ++j) { const int n = (lane >> 3) + 8 * j; const LAS float* s = scr + (8 * c) * 33 + n;
        u32x4 o; o.x = pk2(s[0 * 33], s[1 * 33]); o.y = pk2(s[2 * 33], s[3 * 33]); o.z = pk2(s[4 * 33], s[5 * 33]); o.w = pk2(s[6 * 33], s[7 * 33]);
        *(u32x4*)(WT + (size_t)wt_row(n0 + n, row_mul, row_add) * K + k0 + 8 * c) = o; }
    LDS_WAIT(); asm volatile("" ::: "memory");
}
__device__ __forceinline__ void norm_mod_row(const float* xrow, const float* sh, const float* sc, bf16_t* orow, int lane) {
    f32x4 v[4]; float ss = 0.f;
#pragma unroll
    for (int j = 0; j < 4; ++j) { v[j] = *(const f32x4*)(xrow + 4 * lane + 256 * j); ss += (v[j].x * v[j].x + v[j].y * v[j].y) + (v[j].z * v[j].z + v[j].w * v[j].w); }
    const float r = rsqrtf(wave_sum(ss) * (1.0f / 1024.0f) + EPS);
#pragma unroll
    for (int j = 0; j < 4; ++j) { const f32x4 a = *(const f32x4*)(sc + 4 * lane + 256 * j), b = *(const f32x4*)(sh + 4 * lane + 256 * j);
        u32x2 w; w.x = pk2(v[j].x * r * (1.f + a.x) + b.x, v[j].y * r * (1.f + a.y) + b.y); w.y = pk2(v[j].z * r * (1.f + a.z) + b.z, v[j].w * r * (1.f + a.w) + b.w);
        *(u32x2*)(orow + 4 * lane + 256 * j) = w; }
}

__device__ __forceinline__ void attn_key(const bf16_t* kp, const bf16_t* vp, const float (&q)[64], float& m, float& l, float (&o)[64]) {
    float s = 0.f;
#pragma unroll
    for (int i = 0; i < 8; ++i) { float kv[8]; unpack8(*(const u32x4*)(kp + 8 * i), kv);
#pragma unroll
        for (int j = 0; j < 8; ++j) s += q[8 * i + j] * kv[j]; }
    const float mn = fmaxf(m, s);
    const float f = __builtin_amdgcn_exp2f(m - mn), p = __builtin_amdgcn_exp2f(s - mn);
    l = l * f + p; m = mn;
#pragma unroll
    for (int i = 0; i < 8; ++i) { float vv[8]; unpack8(*(const u32x4*)(vp + 8 * i), vv);
#pragma unroll
        for (int j = 0; j < 8; ++j) o[8 * i + j] = o[8 * i + j] * f + p * vv[j]; }
}
__device__ __forceinline__ void load_q64(const bf16_t* qp, float scale, float (&q)[64]) {
#pragma unroll
    for (int i = 0; i < 8; ++i) { float t[8]; unpack8(*(const u32x4*)(qp + 8 * i), t);
#pragma unroll
        for (int j = 0; j < 8; ++j) q[8 * i + j] = t[j] * scale; }
}

struct Args { const void* in[37]; float* out; unsigned char* ws; int ph_lo, ph_hi, probe_var, pad; };
#ifndef PROBE_GEMM_REPS
#define PROBE_GEMM_REPS 1
#endif
#if PROBE_GEMM_REPS == 2
template <class Sc> struct Twice { Sc S; int n1;
    __device__ __forceinline__ bool next(int i, pg8::Unit& u) const { return i < n1 ? S.next(i, u) : S.next(i - n1, u); }
    __device__ __forceinline__ void a_ready(const pg8::Unit&) const {}
    __device__ __forceinline__ void done(const pg8::Unit&) const {} };
#define PROBE_SCHED(T) Twice<T>
#define PROBE_WRAP(T, v) Twice<T> PS_; PS_.S = v; { int n1_ = 0; pg8::Unit tu_; while (v.next(n1_, tu_)) ++n1_; PS_.n1 = n1_; }
#else
#define PROBE_SCHED(T) T
#define PROBE_WRAP(T, v) const T& PS_ = v
#endif
#ifdef PROBE_BAR2
#define PROBE_EXTRA_BAR(b) xcd_barrier(b, lsg(wid0) == 0 && lane_id_v() == 0);
#else
#define PROBE_EXTRA_BAR(b)
#endif
constexpr int N_PHASES = 3 + 2 * (8 + 10);

template <int NV, bool MASKED, bool CAUSAL, int PIN, int POUT, bool NOMAX = false>
__device__ __forceinline__ void flash_unit(LAS unsigned char* L0, const bf16_t* Qb, const bf16_t* Kb, const bf16_t* Vb, bf16_t* Ob, const unsigned* mbase, int qb, int wid, int lane, const float* qgain, const float* COSH, const float* SINH) {
    const int r32 = lane & 31, hi = lane >> 5;
    LAS unsigned char* ldsKs = L0; LAS unsigned char* ldsVs = L0 + 16384;
    LAS float* wsf = (LAS float*)(L0 + 16384 + NV * 16384 + wid * 256);
    LAS bf16_t* stg = (LAS bf16_t*)(L0 + 16384 + NV * 16384 + 2048 + wid * 4096);
    const int qrow = qb * 256 + wid * 32 + r32;
    attn_body::bf16x8 qr[4];
    load_q_normed(qr, Qb + (size_t)qrow * PIN, qgain, COSH, SINH, qrow, hi, lane);
    const int NT = 4 * (qb + 1);
    const bf16_t* kbp = Kb + (size_t)lane * PIN + wid * 8;
    const bf16_t* vbp = Vb + (size_t)(16 * (wid & 3) + (lane >> 2)) * PIN + (wid >> 2) * 32 + (lane & 3) * 8;
    const unsigned* mwp = MASKED ? mbase + (size_t)qrow * 2 + hi : nullptr;
    u32x4 kreg = *(const u32x4*)kbp, vreg[NV]; unsigned mw = 0u, mwn = 0u;
#pragma unroll
    for (int j = 0; j < NV; ++j) vreg[j] = *(const u32x4*)(vbp + j * 64);
    if (MASKED) mw = mwp[0];
    *(LAS u32x4*)(ldsKs + wid * 1024 + lane * 16) = kreg;
#pragma unroll
    for (int j = 0; j < NV; ++j) *(LAS u32x4*)(ldsVs + j * 16384 + wid * 1024 + lane * 16) = vreg[j];
    __syncthreads();
    float mhat = 0.f, lsum = 0.f;
    attn_body::f32x16 o[2 * NV], negm;
#pragma unroll
    for (int r = 0; r < 16; ++r) { negm[r] = 0.f;
#pragma unroll
        for (int j = 0; j < 2 * NV; ++j) o[j][r] = 0.f; }
    const int vb0 = (int)(unsigned)(unsigned long long)ldsVs + ((lane >> 4) & 1) * 32 + (lane & 3) * 8 + (4 * hi + ((lane & 15) >> 2)) * 64;
    for (int t = 0; t < NT; ++t) {
        const int slot = (t & 1) * 8192;
        if (t + 1 < NT) { kreg = *(const u32x4*)(kbp + (size_t)(t + 1) * 64 * PIN);
#pragma unroll
            for (int j = 0; j < NV; ++j) vreg[j] = *(const u32x4*)(vbp + (size_t)(t + 1) * 64 * PIN + j * 64);
            if (MASKED) mwn = mwp[(size_t)(t + 1) * S * 2]; }
        attn_body::f32x16 p0 = negm, p1 = negm;
        { const LAS unsigned char* kb = ldsKs + slot + hi * 1024 + r32 * 16;
#pragma unroll
          for (int d0 = 0; d0 < 4; ++d0) {
              const attn_body::bf16x8 b0 = *(const LAS attn_body::bf16x8*)(kb + d0 * 2048), b1 = *(const LAS attn_body::bf16x8*)(kb + d0 * 2048 + 512);
              p0 = __builtin_amdgcn_mfma_f32_32x32x16_bf16(b0, qr[d0], p0, 0, 0, 0);
              p1 = __builtin_amdgcn_mfma_f32_32x32x16_bf16(b1, qr[d0], p1, 0, 0, 0); } }
        if (CAUSAL) { const int jb = t - (NT - 4); if (jb >= 0) attn_body::cmask(p0, p1, jb, wid * 32 + r32, hi); }
        float rm = 0.f;
        if (!NOMAX) { rm = fmaxf(p0[0], p1[0]);
#pragma unroll
            for (int r = 1; r < 16; ++r) rm = fmaxf(rm, fmaxf(p0[r], p1[r]));
            rm = half_max(rm); }
        bool resc = false;
        if (!NOMAX && __any(rm > 8.0f)) {
            const float dl = fmaxf(rm, 0.f); mhat += dl;
#pragma unroll
            for (int r = 0; r < 16; ++r) { p0[r] -= dl; p1[r] -= dl; negm[r] = -mhat; }
            const float f = __builtin_amdgcn_exp2f(-dl); lsum *= f; if (hi == 0) wsf[r32] = f; resc = true;
        }
        const int wb = (int)mw; float ssum = 0.f;
#pragma unroll
        for (int r = 0; r < 16; ++r) {
            float e0 = __builtin_amdgcn_exp2f(p0[r]), e1 = __builtin_amdgcn_exp2f(p1[r]);
            if (MASKED) { e0 = __uint_as_float(__float_as_uint(e0) & (unsigned)__builtin_amdgcn_sbfe(wb, r, 1)); e1 = __uint_as_float(__float_as_uint(e1) & (unsigned)__builtin_amdgcn_sbfe(wb, 16 + r, 1)); }
            p0[r] = e0; p1[r] = e1; ssum += e0 + e1; }
        lsum += ssum;
        u32x4 pw0, pw1, pw2, pw3;
#pragma unroll
        for (int k = 0; k < 4; ++k) { pw0[k] = attn_body::cvtpk_s(p0[2 * k], p0[2 * k + 1]); pw1[k] = attn_body::cvtpk_s(p0[8 + 2 * k], p0[9 + 2 * k]);
            pw2[k] = attn_body::cvtpk_s(p1[2 * k], p1[2 * k + 1]); pw3[k] = attn_body::cvtpk_s(p1[8 + 2 * k], p1[9 + 2 * k]); }
        if (resc) { LDS_WAIT();
#pragma unroll
            for (int r = 0; r < 16; ++r) { const float f = wsf[attn_body::crow(r, hi)];
#pragma unroll
                for (int j = 0; j < 2 * NV; ++j) o[j][r] *= f; } }
#pragma unroll
        for (int j = 0; j < NV; ++j)
            attn_body::pv(o + 2 * j, vb0 + j * 16384 + slot, __builtin_bit_cast(attn_body::bf16x8, pw0), __builtin_bit_cast(attn_body::bf16x8, pw1), __builtin_bit_cast(attn_body::bf16x8, pw2), __builtin_bit_cast(attn_body::bf16x8, pw3));
        if (t + 1 < NT) { const int ns = ((t + 1) & 1) * 8192; *(LAS u32x4*)(ldsKs + ns + wid * 1024 + lane * 16) = kreg;
#pragma unroll
            for (int j = 0; j < NV; ++j) *(LAS u32x4*)(ldsVs + j * 16384 + ns + wid * 1024 + lane * 16) = vreg[j]; }
        mw = mwn;
        __syncthreads();
    }
    lsum += shx_(lsum, 32, lane);
    if (hi == 0) wsf[r32] = lsum;
    LDS_WAIT();
    float rl[16];
#pragma unroll
    for (int r = 0; r < 16; ++r) rl[r] = __builtin_amdgcn_rcpf(wsf[attn_body::crow(r, hi)]);
#pragma unroll
    for (int j = 0; j < NV; ++j) {
#pragma unroll
        for (int r = 0; r < 16; ++r) { const int orow = attn_body::crow(r, hi);
            stg[orow * 64 + r32] = (bf16_t)f2bf(o[2 * j][r] * rl[r]); stg[orow * 64 + 32 + r32] = (bf16_t)f2bf(o[2 * j + 1][r] * rl[r]); }
        LDS_WAIT();
#pragma unroll
        for (int q = 0; q < 4; ++q) { const int row = q * 8 + (lane >> 3), ch = lane & 7;
            *(u32x4*)(Ob + (size_t)(qb * 256 + wid * 32 + row) * POUT + j * 64 + ch * 8) = *(const LAS u32x4*)(stg + row * 64 + ch * 8); }
        LDS_WAIT();
    }
    __syncthreads();
}
template <int NV, bool MASKED, bool CAUSAL, int PIN, int POUT, bool NOMAX = false>
__device__ __forceinline__ void flash_unit_q2(LAS unsigned char* L0, const bf16_t* Qb, const bf16_t* Kb, const bf16_t* Vb, bf16_t* Ob, const unsigned* mbase, int qb, int wid, int lane, const float* qgain, const float* COSH, const float* SINH) {
    typedef __attribute__((address_space(3))) attn_body::v4i16_t* vtr_ptr;
    const int r32 = lane & 31, hi = lane >> 5;
    LAS unsigned char* ldsKs = L0; LAS unsigned char* ldsVs = L0 + 16384;
    LAS float* wsf = (LAS float*)(L0 + 16384 + NV * 16384 + wid * 512);
    LAS bf16_t* stg = (LAS bf16_t*)(L0 + 16384 + NV * 16384 + 4096 + wid * 4096);
    const int q0 = qb * 512 + wid * 64;
    attn_body::bf16x8 qr[2][4];
#pragma unroll
    for (int nq = 0; nq < 2; ++nq) load_q_normed(qr[nq], Qb + (size_t)(q0 + nq * 32 + r32) * PIN, qgain, COSH, SINH, q0 + nq * 32 + r32, hi, lane);
    const int NT = 8 * (qb + 1);
    const bf16_t* kbp = Kb + (size_t)lane * PIN + wid * 8;
    const bf16_t* vbp = Vb + (size_t)(16 * (wid & 3) + (lane >> 2)) * PIN + (wid >> 2) * 32 + (lane & 3) * 8;
    const unsigned* mwp = MASKED ? mbase + (size_t)(q0 + r32) * 2 + hi : nullptr;
    const int stoff = wid * 1024 + lane * 16;
    u32x4 kreg = *(const u32x4*)kbp, vreg[NV]; unsigned mw[2] = {0u, 0u}, mwn[2] = {0u, 0u};
#pragma unroll
    for (int j = 0; j < NV; ++j) vreg[j] = *(const u32x4*)(vbp + j * 64);
    if (MASKED) { mw[0] = mwp[0]; mw[1] = mwp[64]; }
    *(LAS u32x4*)(ldsKs + stoff) = kreg;
#pragma unroll
    for (int j = 0; j < NV; ++j) *(LAS u32x4*)(ldsVs + j * 16384 + stoff) = vreg[j];
    __syncthreads();
    float mhat[2] = {0.f, 0.f}, lsum[2] = {0.f, 0.f}; bool refmoved = false;
    attn_body::f32x16 o[2][2 * NV];
#pragma unroll
    for (int r = 0; r < 16; ++r)
#pragma unroll
        for (int j = 0; j < 2 * NV; ++j) { o[0][j][r] = 0.f; o[1][j][r] = 0.f; }
    const LAS unsigned char* kfb = ldsKs + hi * 1024 + r32 * 16;
    const LAS unsigned char* vfb = ldsVs + ((lane >> 4) & 1) * 32 + (lane & 3) * 8 + (4 * hi + ((lane & 15) >> 2)) * 64;
    for (int t = 0; t < NT; ++t) {
        const int slot = (t & 1) * 8192;
        if (t + 1 < NT) { kreg = *(const u32x4*)(kbp + (size_t)(t + 1) * 64 * PIN);
#pragma unroll
            for (int j = 0; j < NV; ++j) vreg[j] = *(const u32x4*)(vbp + (size_t)(t + 1) * 64 * PIN + j * 64);
            if (MASKED) { mwn[0] = mwp[(size_t)(t + 1) * S * 2]; mwn[1] = mwp[(size_t)(t + 1) * S * 2 + 64]; } }
#pragma unroll
        for (int kh = 0; kh < 2; ++kh) {
            attn_body::f32x16 p[2];
#pragma unroll
            for (int r = 0; r < 16; ++r) { p[0][r] = 0.f; p[1][r] = 0.f; }
#pragma unroll
            for (int d0 = 0; d0 < 4; ++d0) {
                const attn_body::bf16x8 kf = *(const LAS attn_body::bf16x8*)(kfb + slot + d0 * 2048 + kh * 512);
                p[0] = __builtin_amdgcn_mfma_f32_32x32x16_bf16(kf, qr[0][d0], p[0], 0, 0, 0);
                p[1] = __builtin_amdgcn_mfma_f32_32x32x16_bf16(kf, qr[1][d0], p[1], 0, 0, 0); }
            if (refmoved) {
#pragma unroll
                for (int nq = 0; nq < 2; ++nq)
#pragma unroll
                    for (int r = 0; r < 16; ++r) p[nq][r] -= mhat[nq]; }
            if (CAUSAL) { const int kbase = t * 64 + kh * 32;
                if (kbase + 31 > q0) {
#pragma unroll
                    for (int nq = 0; nq < 2; ++nq)
#pragma unroll
                        for (int r = 0; r < 16; ++r) if (kbase + attn_body::crow(r, hi) > q0 + nq * 32 + r32) p[nq][r] = -INFINITY; } }
            float rm[2] = {0.f, 0.f};
            if (!NOMAX)
#pragma unroll
            for (int nq = 0; nq < 2; ++nq) { float m_ = p[nq][0];
#pragma unroll
                for (int r = 1; r < 16; ++r) m_ = fmaxf(m_, p[nq][r]);
                rm[nq] = half_max(m_); }
            bool resc = false;
            if (!NOMAX && __any(fmaxf(rm[0], rm[1]) > 8.0f)) {
#pragma unroll
                for (int nq = 0; nq < 2; ++nq) { const float dl = fmaxf(rm[nq], 0.f); mhat[nq] += dl;
#pragma unroll
                    for (int r = 0; r < 16; ++r) p[nq][r] -= dl;
                    const float f = __builtin_amdgcn_exp2f(-dl); lsum[nq] *= f; if (hi == 0) wsf[nq * 32 + r32] = f; }
                resc = true; refmoved = true;
            }
            attn_body::bf16x8 pa[2][2];
#pragma unroll
            for (int nq = 0; nq < 2; ++nq) { const int wb = (int)mw[nq]; f32x2 ss2 = {0.f, 0.f};
#pragma unroll
                for (int r = 0; r < 16; ++r) { float e = __builtin_amdgcn_exp2f(p[nq][r]);
                    if (MASKED) { unsigned mk; asm("v_bfe_i32 %0, %1, %2, 1" : "=v"(mk) : "v"(wb), "n"(kh * 16 + r)); e = __uint_as_float(__float_as_uint(e) & mk); }
                    p[nq][r] = e; }
#pragma unroll
                for (int r = 0; r < 16; r += 2) ss2 += (f32x2){p[nq][r], p[nq][r + 1]};
                lsum[nq] += ss2.x + ss2.y;
                u32x4 pw0, pw1;
#pragma unroll
                for (int k = 0; k < 4; ++k) { pw0[k] = attn_body::cvtpk_s(p[nq][2 * k], p[nq][2 * k + 1]); pw1[k] = attn_body::cvtpk_s(p[nq][8 + 2 * k], p[nq][9 + 2 * k]); }
                pa[nq][0] = __builtin_bit_cast(attn_body::bf16x8, pw0); pa[nq][1] = __builtin_bit_cast(attn_body::bf16x8, pw1); }
            if (resc) { LDS_WAIT();
#pragma unroll
                for (int nq = 0; nq < 2; ++nq)
#pragma unroll
                    for (int r = 0; r < 16; ++r) { const float f = wsf[nq * 32 + attn_body::crow(r, hi)];
#pragma unroll
                        for (int j = 0; j < 2 * NV; ++j) o[nq][j][r] *= f; } }
#pragma unroll
            for (int blk = 0; blk < 2 * NV; ++blk)
#pragma unroll
                for (int k2 = 0; k2 < 2; ++k2) {
                    const LAS unsigned char* vb = vfb + (blk >> 1) * 16384 + slot + (blk & 1) * 4096 + (kh * 2 + k2) * 1024;
                    const attn_body::s16x4 lo_ = __builtin_bit_cast(attn_body::s16x4, __builtin_amdgcn_ds_read_tr16_b64_v4i16((vtr_ptr)vb)), hi_ = __builtin_bit_cast(attn_body::s16x4, __builtin_amdgcn_ds_read_tr16_b64_v4i16((vtr_ptr)(vb + 512)));
                    const attn_body::bf16x8 vf = (attn_body::bf16x8){lo_[0], lo_[1], lo_[2], lo_[3], hi_[0], hi_[1], hi_[2], hi_[3]};
                    o[0][blk] = __builtin_amdgcn_mfma_f32_32x32x16_bf16(pa[0][k2], vf, o[0][blk], 0, 0, 0);
                    o[1][blk] = __builtin_amdgcn_mfma_f32_32x32x16_bf16(pa[1][k2], vf, o[1][blk], 0, 0, 0); }
        }
        if (t + 1 < NT) { const int ns = 8192 - slot; *(LAS u32x4*)(ldsKs + ns + stoff) = kreg;
#pragma unroll
            for (int j = 0; j < NV; ++j) *(LAS u32x4*)(ldsVs + j * 16384 + ns + stoff) = vreg[j]; }
        mw[0] = mwn[0]; mw[1] = mwn[1];
        __syncthreads();
    }
#pragma unroll
    for (int nq = 0; nq < 2; ++nq) { lsum[nq] += shx_(lsum[nq], 32, lane); if (hi == 0) wsf[nq * 32 + r32] = lsum[nq]; }
    LDS_WAIT();
#pragma unroll
    for (int nq = 0; nq < 2; ++nq)
#pragma unroll
      for (int j = 0; j < NV; ++j) {
#pragma unroll
        for (int r = 0; r < 16; ++r) { const int orow = attn_body::crow(r, hi); const float rl = __builtin_amdgcn_rcpf(wsf[nq * 32 + orow]);
            stg[orow * 64 + r32] = (bf16_t)f2bf(o[nq][2 * j][r] * rl); stg[orow * 64 + 32 + r32] = (bf16_t)f2bf(o[nq][2 * j + 1][r] * rl); }
        LDS_WAIT();
#pragma unroll
        for (int q = 0; q < 4; ++q) { const int row = q * 8 + (lane >> 3), ch = lane & 7;
            *(u32x4*)(Ob + (size_t)(q0 + nq * 32 + row) * POUT + j * 64 + ch * 8) = *(const LAS u32x4*)(stg + row * 64 + ch * 8); }
        LDS_WAIT();
      }
    __syncthreads();
}
struct MoeRows {
    static constexpr bool GATHER = true;
    const LAS int* rb; const int* LTOK;
    __device__ __forceinline__ unsigned operator()(const pg8::Unit& u, int r) const { const int e = u.be; const int slot = u.pm * 256 + r - rb[e];
        const int tok = slot < rb[32 + e] ? LTOK[e * 32768 + slot] : 0; return (unsigned)tok * 2048u; }
};
__device__ __forceinline__ void moe_convert(const float* w1, const float* w3, const float* w2, bf16_t* W13, bf16_t* W2, LAS float* scr, int gw, int NGW, int lane) {
    for (int it = gw; it < 32 * 768; it += NGW) {
        const int e = it / 768; int r = it % 768;
        if (r < 256) { transpose_item(w1 + (size_t)e * 1024 * 512, 1024, 512, W13 + (size_t)e * 1024 * 1024, 2, 0, scr, r, 16, lane); continue; } r -= 256;
        if (r < 256) { transpose_item(w3 + (size_t)e * 1024 * 512, 1024, 512, W13 + (size_t)e * 1024 * 1024, 2, 1, scr, r, 16, lane); continue; } r -= 256;
        transpose_item(w2 + (size_t)e * 512 * 1024, 512, 1024, W2 + (size_t)e * 1024 * 512, 1, 0, scr, r, 32, lane);
    }
}
__device__ __forceinline__ void moe_tables(unsigned* ctl, int l, LAS int* tile_e, LAS int* rb, LAS int* nt_p, int tid) {
    if (tid < 64) {
        const int ln = tid;
        const int cnt = ln < 32 ? (int)__hip_atomic_load(ctl + CW_CNT + (l * 32 + (ln & 31)) * 64, __ATOMIC_RELAXED, __HIP_MEMORY_SCOPE_AGENT) : 0;
        const int ntile = (cnt + 255) >> 8;
        int inc = ntile;
#pragma unroll
        for (int off = 1; off < 32; off <<= 1) { const int v = (int)shi_((unsigned)inc, ln - off); if (ln >= off) inc += v; }
        if (ln < 32) { rb[ln] = (inc - ntile) * 256; rb[32 + ln] = cnt; }
        if (ln == 31) nt_p[0] = inc;
    }
    __syncthreads();
    const int nt = nt_p[0];
    for (int t = tid; t < nt; t += NTHREADS) {
        int lo = 0, hi = 31;
        while (lo < hi) { const int mid = (lo + hi + 1) >> 1; if (rb[mid] <= t * 256) lo = mid; else hi = mid - 1; }
        tile_e[t] = lo;
    }
    __syncthreads();
}

template <bool FIRST>
__device__ __forceinline__ float f_pass1(const float* __restrict__ xs_row, bf16_t* __restrict__ xb_row, const bf16_t* __restrict__ y_row, const LAS float* gate, const int kc) {
    float ss = 0.f;
#pragma unroll 1
    for (int s0 = 0; s0 < 32; s0 += 8) {
        u32x4 xr[8], yr[8]; f32x4 xa[8], xc[8];
#pragma unroll
        for (int k = 0; k < 8; ++k) { const int col = 32 * (s0 + k) + 8 * kc;
            if constexpr (FIRST) { xa[k] = *(const f32x4*)(xs_row + col); xc[k] = *(const f32x4*)(xs_row + col + 4); } else xr[k] = *(const u32x4*)(xb_row + col);
            yr[k] = *(const u32x4*)(y_row + col); }
        __builtin_amdgcn_sched_barrier(0);
#pragma unroll
        for (int k = 0; k < 8; ++k) { const int col = 32 * (s0 + k) + 8 * kc;
            f32x4 x0, x1;
            if constexpr (FIRST) { x0 = xa[k]; x1 = xc[k]; }
            else { float xv_[8]; unpack8(xr[k], xv_); x0 = (f32x4){xv_[0], xv_[1], xv_[2], xv_[3]}; x1 = (f32x4){xv_[4], xv_[5], xv_[6], xv_[7]}; }
            float yv[8]; unpack8(yr[k], yv);
            const f32x4 g0 = *(const LAS f32x4*)(gate + col), g1 = *(const LAS f32x4*)(gate + col + 4);
            float nv_[8] = {x0.x + g0.x * yv[0], x0.y + g0.y * yv[1], x0.z + g0.z * yv[2], x0.w + g0.w * yv[3], x1.x + g1.x * yv[4], x1.y + g1.y * yv[5], x1.z + g1.z * yv[6], x1.w + g1.w * yv[7]};
            const u32x4 xw = pack8(nv_); *(u32x4*)(xb_row + col) = xw;
            float rv_[8]; unpack8(xw, rv_);
#pragma unroll
            for (int e = 0; e < 8; ++e) ss += rv_[e] * rv_[e]; }
        __builtin_amdgcn_sched_barrier(0);
    }
    return ss;
}
__device__ __forceinline__ void f_pass2(const bf16_t* __restrict__ xb_row, bf16_t* __restrict__ h_row, const LAS float* modl, const bf16_t* __restrict__ wh, const bf16_t* __restrict__ wl, const float rn, const int kc, f32x4 (&acc)[3]) {
#pragma unroll 1
    for (int s0 = 0; s0 < 32; s0 += 4) {
        u32x4 xr[4]; pg8::bf16x8 bh[4][3], bl[4][3];
#pragma unroll
        for (int k = 0; k < 4; ++k) { const int col = 32 * (s0 + k) + 8 * kc; xr[k] = *(const u32x4*)(xb_row + col);
#pragma unroll
            for (int ct = 0; ct < 3; ++ct) { bh[k][ct] = *(const pg8::bf16x8*)(wh + (size_t)ct * 16 * 1024 + 32 * (s0 + k)); bl[k][ct] = *(const pg8::bf16x8*)(wl + (size_t)ct * 16 * 1024 + 32 * (s0 + k)); } }
        __builtin_amdgcn_sched_barrier(0);
#pragma unroll
        for (int k = 0; k < 4; ++k) { const int col = 32 * (s0 + k) + 8 * kc;
            f32x4 x0, x1; { float xv_[8]; unpack8(xr[k], xv_); x0 = (f32x4){xv_[0], xv_[1], xv_[2], xv_[3]}; x1 = (f32x4){xv_[4], xv_[5], xv_[6], xv_[7]}; }
            const f32x4 c0 = *(const LAS f32x4*)(modl + 2048 + col), c1 = *(const LAS f32x4*)(modl + 2048 + col + 4), s0_ = *(const LAS f32x4*)(modl + 1024 + col), s1_ = *(const LAS f32x4*)(modl + 1024 + col + 4);
            float hv[8];
            hv[0] = x0.x * rn * (1.f + c0.x) + s0_.x; hv[1] = x0.y * rn * (1.f + c0.y) + s0_.y; hv[2] = x0.z * rn * (1.f + c0.z) + s0_.z; hv[3] = x0.w * rn * (1.f + c0.w) + s0_.w;
            hv[4] = x1.x * rn * (1.f + c1.x) + s1_.x; hv[5] = x1.y * rn * (1.f + c1.y) + s1_.y; hv[6] = x1.z * rn * (1.f + c1.z) + s1_.z; hv[7] = x1.w * rn * (1.f + c1.w) + s1_.w;
            const u32x4 hh = pack8(hv);
            *(u32x4*)(h_row + col) = hh;
            float hl[8]; { float hf[8]; unpack8(hh, hf);
#pragma unroll
                for (int e = 0; e < 8; ++e) hl[e] = hv[e] - hf[e]; }
            const u32x4 hlw = pack8(hl);
            const pg8::bf16x8 ah = __builtin_bit_cast(pg8::bf16x8, hh), al = __builtin_bit_cast(pg8::bf16x8, hlw);
#pragma unroll
            for (int ct = 0; ct < 3; ++ct) {
                acc[ct] = __builtin_amdgcn_mfma_f32_16x16x32_bf16(ah, bh[k][ct], acc[ct], 0, 0, 0);
                acc[ct] = __builtin_amdgcn_mfma_f32_16x16x32_bf16(ah, bl[k][ct], acc[ct], 0, 0, 0);
                acc[ct] = __builtin_amdgcn_mfma_f32_16x16x32_bf16(al, bh[k][ct], acc[ct], 0, 0, 0);
            } }
        __builtin_amdgcn_sched_barrier(0);
    }
}

__device__ __forceinline__ float relu_i(float x) { return __builtin_bit_cast(float, max(__builtin_bit_cast(int, x), 0)); }
__device__ __forceinline__ unsigned pk_gt_u16(unsigned a, unsigned b, unsigned ones) { unsigned d; asm("v_pk_sub_u16 %0, %1, %2 clamp" : "=v"(d) : "v"(a), "v"(b)); unsigned r; asm("v_pk_min_u16 %0, %1, %2" : "=v"(r) : "v"(d), "v"(ones)); return r; }
__device__ __forceinline__ unsigned spread16(unsigned x) { x = (x | (x << 8)) & 0x00FF00FFu; x = (x | (x << 4)) & 0x0F0F0F0Fu; x = (x | (x << 2)) & 0x33333333u; x = (x | (x << 1)) & 0x55555555u; return x; }
__device__ __forceinline__ unsigned ilv16(unsigned a) { return spread16(a & 0xFFFFu) | (spread16(a >> 16) << 1); }
__device__ __forceinline__ int lane_id_v() { int v; asm volatile("v_mbcnt_lo_u32_b32 %0, -1, 0\n\tv_mbcnt_hi_u32_b32 %0, -1, %0" : "=v"(v)); return v; }
__device__ __forceinline__ unsigned long long lsg64(unsigned long long v) { asm volatile("" : "+s"(v)); return v; }
__device__ __forceinline__ int lsg(int v) { asm volatile("" : "+s"(v)); return v; }
__device__ __forceinline__ int lvg(int v) { asm volatile("" : "+v"(v)); return v; }
__device__ __forceinline__ LAS unsigned char* lsgp(LAS unsigned char* p) { unsigned v = (unsigned)(unsigned long long)p; asm volatile("" : "+s"(v)); return (LAS unsigned char*)(unsigned long long)v; }
__device__ __forceinline__ void* ldptr(const LAS unsigned long long* tbl, int k) {
    const unsigned long long v = tbl[k];
    const unsigned lo = __builtin_amdgcn_readfirstlane((unsigned)v), hi = __builtin_amdgcn_readfirstlane((unsigned)(v >> 32));
    return (void*)(__attribute__((address_space(1))) void*)(((unsigned long long)hi << 32) | lo);
}
#define DECL_PTRS() \
    const int wid = lsg(wid0), lane = lane_id_v(), tid = wid * 64 + lane; \
    const int G = lsg(G0), c = lsg(c0), l = lsg(l0), i = l >> 1; \
    const int gw = c * NWAVES + wid, NGW = G * NWAVES, gt = c * NTHREADS + tid, NGT = G * NTHREADS; \
    LAS unsigned char* lds = (LAS unsigned char*)lsgp(lds0); LAS unsigned char* glds = lds; LAS float* scr = (LAS float*)(lds + wid * 16384); \
    const LAS unsigned long long* ptbl = (const LAS unsigned long long*)(lds + LDS_PTBL); \
    unsigned char* ws = (unsigned char*)ldptr(ptbl, 38); unsigned* ctl = (unsigned*)(ws + WS_CTL); \
    const float* xin = (const float*)ldptr(ptbl, 0); \
    const float* cin = (const float*)ldptr(ptbl, 1); \
    const float* ada_w = (const float*)ldptr(ptbl, 2); \
    const float* ada_b = (const float*)ldptr(ptbl, 3); \
    const float* moe_wg = (const float*)ldptr(ptbl, 4); \
    const float* moe_bg = (const float*)ldptr(ptbl, 5); \
    const float* moe_we = (const float*)ldptr(ptbl, 6); \
    const float* moe_be = (const float*)ldptr(ptbl, 7); \
    const float* moe_w1 = (const float*)ldptr(ptbl, 8); \
    const float* moe_w3 = (const float*)ldptr(ptbl, 9); \
    const float* moe_w2 = (const float*)ldptr(ptbl, 10); \
    const float* ev_w_in = (const float*)ldptr(ptbl, 11); \
    const float* ev_w_out = (const float*)ldptr(ptbl, 12); \
    const float* a_qn = (const float*)ldptr(ptbl, 13); \
    const float* a_kn = (const float*)ldptr(ptbl, 14); \
    const float* a_lq1 = (const float*)ldptr(ptbl, 15); \
    const float* a_lk1 = (const float*)ldptr(ptbl, 16); \
    const float* a_lq2 = (const float*)ldptr(ptbl, 17); \
    const float* a_lk2 = (const float*)ldptr(ptbl, 18); \
    const float* a_subln = (const float*)ldptr(ptbl, 19); \
    const float* b_qn = (const float*)ldptr(ptbl, 20); \
    const float* b_kn = (const float*)ldptr(ptbl, 21); \
    const float* b_idx_kn = (const float*)ldptr(ptbl, 22); \
    const float* od_w_in = (const float*)ldptr(ptbl, 23); \
    const float* od_w_out = (const float*)ldptr(ptbl, 24); \
    const float* c_qn = (const float*)ldptr(ptbl, 25); \
    const float* c_kn = (const float*)ldptr(ptbl, 26); \
    const float* s5_lam_re = (const float*)ldptr(ptbl, 27); \
    const float* s5_lam_im = (const float*)ldptr(ptbl, 28); \
    const float* s5_b_re = (const float*)ldptr(ptbl, 29); \
    const float* s5_b_im = (const float*)ldptr(ptbl, 30); \
    const float* s5_c_re = (const float*)ldptr(ptbl, 31); \
    const float* s5_c_im = (const float*)ldptr(ptbl, 32); \
    const float* s5_d = (const float*)ldptr(ptbl, 33); \
    const float* s5_log_dt = (const float*)ldptr(ptbl, 34); \
    const float* s5_glu_w = (const float*)ldptr(ptbl, 35); \
    const float* s5_glu_b = (const float*)ldptr(ptbl, 36); \
    float* out = (float*)ldptr(ptbl, 37); \
    float* MOD = (float*)(ws + WS_MOD); \
    float* MODP = (float*)(ws + WS_MODP); \
    float* COSH = (float*)(ws + WS_ROPE); \
    float* SINH = COSH + S * 8; \
    float* COSI = SINH + S * 8; \
    float* SINI = COSI + S * 4; \
    float* S5A = (float*)(ws + WS_S5A); \
    float* S5B = (float*)(ws + WS_S5B); \
    float* LAM = (float*)(ws + WS_LAM); \
    float* KM = (float*)(ws + WS_KM); \
    bf16_t* KMH = (bf16_t*)(ws + WS_KMH); \
    bf16_t* WRH = (bf16_t*)(ws + WS_WRH); \
    bf16_t* WRL = (bf16_t*)(ws + WS_WRH + 393216); \
    bf16_t* KML = (bf16_t*)(ws + WS_KMH + 131072); \
    bf16_t* Wevin = (bf16_t*)(ws + WS_WEVIN); \
    bf16_t* Wevout = (bf16_t*)(ws + WS_WEVOUT); \
    bf16_t* Wodin = (bf16_t*)(ws + WS_WODIN); \
    bf16_t* Wodout = (bf16_t*)(ws + WS_WODOUT); \
    bf16_t* Wglu = (bf16_t*)(ws + WS_WGLU); \
    bf16_t* W13 = (bf16_t*)(ws + WS_W13); \
    bf16_t* W2 = (bf16_t*)(ws + WS_W2); \
    bf16_t* H = (bf16_t*)(ws + WS_H); \
    bf16_t* O = (bf16_t*)(ws + WS_O); \
    bf16_t* Z = (bf16_t*)(ws + WS_Z); \
    bf16_t* XG = (bf16_t*)(ws + WS_XG); \
    bf16_t* Y = (bf16_t*)(ws + WS_Y); \
    bf16_t* HID = (bf16_t*)(ws + WS_HID); \
    float* IQ = (float*)(ws + WS_IQ); \
    bf16_t* YG = (bf16_t*)(ws + WS_YG); \
    float* IKW = (float*)(ws + WS_IKW); \
    _Float16* IQH = (_Float16*)(ws + WS_IQH); \
    _Float16* IKH = (_Float16*)(ws + WS_IKH); \
    float* IW = (float*)(ws + WS_IW); \
    int* SEL = (int*)(ws + WS_SEL); \
    bf16_t* YMIX = (bf16_t*)(ws + WS_YMIX); \
    int* TOKES = (int*)(ws + WS_TOKES); \
    int* LTOK = (int*)(ws + WS_LTOK); \
    float* TOKW = (float*)(ws + WS_TOKW); \
    int* TOKROW = (int*)(ws + WS_TOKROW); \
    bf16_t* UG = (bf16_t*)(ws + WS_UG); \
    float* S5E = (float*)(ws + WS_S5E); \
    bf16_t* S5HC = (bf16_t*)(ws + WS_S5HC); \
    bf16_t* S5KT = (bf16_t*)(ws + WS_S5KT); \
    bf16_t* S5WT = (bf16_t*)(ws + WS_S5WT); \
    bf16_t* S5A2 = (bf16_t*)(ws + WS_S5A2); \
    float* S5PW = (float*)(ws + WS_S5PW); \
    int* MLIST = (int*)(ws + WS_MLIST); \
    bf16_t* MPO = (bf16_t*)(ws + WS_MPO); \
    float* MML = (float*)(ws + WS_MML); \
    int* NSEL = (int*)(ws + WS_NSEL); \
    unsigned* MASKW = (unsigned*)(ws + WS_MASKW); \
    bf16_t* XB = (bf16_t*)(ws + WS_XB);
__global__ void __launch_bounds__(NTHREADS, 2) fwd(Args a) {
    extern __shared__ __attribute__((aligned(16))) unsigned char lds_raw[];
    LAS unsigned char* lds = (LAS unsigned char*)lds_raw;
    const int tid0 = threadIdx.x; const int wid0 = __builtin_amdgcn_readfirstlane(tid0 >> 6);
    const int G0 = gridDim.x, c0 = blockIdx.x;
    unsigned* ctl0 = (unsigned*)(a.ws + WS_CTL);
    LAS unsigned char* lds0 = lds;
    const int lo = a.ph_lo, hi = a.ph_hi;

    LAS unsigned long long* ptbl = (LAS unsigned long long*)(lds + LDS_PTBL);
    if (tid0 == 0) {
#define PT_(k) ptbl[k] = (unsigned long long)a.in[k];
        PT_(0) PT_(1) PT_(2) PT_(3) PT_(4) PT_(5) PT_(6) PT_(7) PT_(8) PT_(9) PT_(10) PT_(11) PT_(12) PT_(13) PT_(14) PT_(15) PT_(16) PT_(17) PT_(18)
        PT_(19) PT_(20) PT_(21) PT_(22) PT_(23) PT_(24) PT_(25) PT_(26) PT_(27) PT_(28) PT_(29) PT_(30) PT_(31) PT_(32) PT_(33) PT_(34) PT_(35) PT_(36)
#undef PT_
        ptbl[37] = (unsigned long long)a.out; ptbl[38] = (unsigned long long)a.ws;
    }
    if (tid0 < 4) ((LAS unsigned*)(lds + LDS_BARW))[tid0] = 0u;
    __syncthreads();
    XcdBarrier bar; bar.bar = ctl0 + CW_BAR; bar.x = 0; bar.st = (volatile LAS unsigned*)(lds + LDS_BARW);
    if (hi - lo > 1) bar = xcd_barrier_post(ctl0 + CW_BAR, (volatile LAS unsigned*)(lds + LDS_BARW), tid0 == 0);
    int ph = 0, l0 = 0;
#define PH_ON() (ph >= lo && ph < hi)
#define PH_END() do { if (ph >= lo && ph + 1 < hi) { XcdBarrier bb_; bb_.bar = (unsigned*)lsg64((unsigned long long)bar.bar); bb_.x = bar.x; bb_.st = bar.st; xcd_barrier(bb_, lsg(wid0) == 0 && lane_id_v() == 0); PROBE_EXTRA_BAR(bb_) } ++ph; } while (0)

    if (PH_ON()) { DECL_PTRS();
        {
            constexpr int I_EVIN = 16 * 112, I_SQ = 16 * 32, I_ODIN = 16 * 64, I_GLU = 8 * 16;
            constexpr int I_PER = I_EVIN + I_SQ + I_ODIN + I_SQ + I_GLU;
            for (int it = gw; it < 2 * I_PER; it += NGW) {
                const int i = it / I_PER; int r = it % I_PER;
                if (r < I_EVIN) { transpose_item(ev_w_in + (size_t)i * 1024 * EV_N, 1024, EV_N, Wevin + (size_t)i * EV_NP * 1024, -1, 0, scr, r, 112, lane); continue; } r -= I_EVIN;
                if (r < I_SQ) { transpose_item(ev_w_out + (size_t)i * 1024 * 1024, 1024, 1024, Wevout + (size_t)i * 1024 * 1024, 1, 0, scr, r, 32, lane); continue; } r -= I_SQ;
                if (r < I_ODIN) { transpose_item(od_w_in + (size_t)i * 1024 * 2048, 1024, 2048, Wodin + (size_t)i * 2048 * 1024, -2, 0, scr, r, 64, lane); continue; } r -= I_ODIN;
                if (r < I_SQ) { transpose_item(od_w_out + (size_t)i * 1024 * 1024, 1024, 1024, Wodout + (size_t)i * 1024 * 1024, 1, 0, scr, r, 32, lane); continue; } r -= I_SQ;
                transpose_item(s5_glu_w + (size_t)i * 512 * 512, 512, 512, Wglu + (size_t)i * 512 * 512, 1, 0, scr, r, 16, lane);
            }
        }
        __syncthreads();
        {
            LAS float* cact = (LAS float*)lds;
            for (int i = tid; i < 2048; i += NTHREADS) { const float v = cin[i]; cact[i] = v / (1.0f + __expf(-v)); }
            __syncthreads();
            for (int idx = gt; idx < 4 * 4 * 6144; idx += NGT) {
                const int kq = idx / 24576, rem = idx % 24576, l = rem / 6144, n = rem % 6144;
                const float* w = ada_w + ((size_t)l * 1024 + kq * 256) * 6144 + n;
                float a0 = 0.f, a1 = 0.f;
#pragma unroll 32
                for (int k = 0; k < 256; ++k) { const float wv = w[(size_t)k * 6144]; a0 += cact[kq * 256 + k] * wv; a1 += cact[1024 + kq * 256 + k] * wv; }
                MODP[((size_t)(kq * 4 + l) * 2 + 0) * 6144 + n] = a0;
                MODP[((size_t)(kq * 4 + l) * 2 + 1) * 6144 + n] = a1;
            }
            __syncthreads();
        }
        for (int idx = gt; idx < S * 12; idx += NGT) {
            if (idx < S * 8) { const int pos = idx >> 3, j = idx & 7; const float inv = (float)pow(500000.0, -(double)(2 * j) / 16.0); const float ang = (float)pos * inv;
                COSH[idx] = (float)cos((double)ang); SINH[idx] = (float)sin((double)ang); }
            else { const int k = idx - S * 8; const int pos = k >> 2, j = k & 3; const float inv = (float)pow(500000.0, -(double)(2 * j) / 8.0); const float ang = (float)pos * inv;
                COSI[k] = (float)cos((double)ang); SINI[k] = (float)sin((double)ang); }
        }
        for (int idx = gt; idx < 2 * 32 * 64; idx += NGT) {
            const int i = idx >> 11, g = (idx >> 6) & 31;
            const float dt = expf(s5_log_dt[i * 32 + g]);
            const float lr = s5_lam_re[idx], li = s5_lam_im[idx];
            const float mag = expf(lr * dt);
            const float ar = mag * (float)cos((double)(li * dt)), ai = mag * (float)sin((double)(li * dt));
            const float den = lr * lr + li * li;
            const float cr = ((ar - 1.0f) * lr + ai * li) / den, ci = (ai * lr - (ar - 1.0f) * li) / den;
            S5A[idx * 2] = ar; S5A[idx * 2 + 1] = ai;
            { float pr = 1.f, pi_ = 0.f; for (int n = 0; n <= 64; ++n) { S5PW[((size_t)idx * 65 + n) * 2] = pr; S5PW[((size_t)idx * 65 + n) * 2 + 1] = pi_; const float nr = pr * ar - pi_ * ai, ni = pr * ai + pi_ * ar; pr = nr; pi_ = ni; } }
            { float brv[16], biv[16];
#pragma unroll
              for (int cc = 0; cc < 16; ++cc) { brv[cc] = s5_b_re[(size_t)idx * 16 + cc]; biv[cc] = s5_b_im[(size_t)idx * 16 + cc]; }
              __builtin_amdgcn_sched_barrier(0);
#pragma unroll
              for (int cc = 0; cc < 16; ++cc) { const float br = brv[cc], bi = biv[cc];
                  *(f32x2*)(S5B + ((size_t)idx * 16 + cc) * 2) = (f32x2){cr * br - ci * bi, cr * bi + ci * br}; } }
        }
        for (int idx = gt; idx < DEPTH * 48 * 1024; idx += NGT) {
            const int k = idx & 1023, col = (idx >> 10) % 48, ll = idx / (48 * 1024);
            const float w = col < 4 ? moe_wg[((size_t)ll * 1024 + k) * 4 + col] : col < 36 ? moe_we[((size_t)ll * 1024 + k) * 32 + col - 4] : 0.f;
            const unsigned hb = f2bf(w); WRH[idx] = (bf16_t)hb; WRL[idx] = (bf16_t)f2bf(w - __uint_as_float(hb << 16));
        }
        if (gw < 2) { const int i = gw;
            const float s1 = wave_sum(a_lq1[i * 64 + lane] * a_lk1[i * 64 + lane]), s2 = wave_sum(a_lq2[i * 64 + lane] * a_lk2[i * 64 + lane]);
            const float lam_init = 0.8f - 0.6f * expf(-0.3f * (float)(2 * i));
            if (lane == 0) LAM[i] = expf(s1) - expf(s2) + lam_init; }
    }
    PH_END();
    if (PH_ON()) { DECL_PTRS();
        for (int idx = gt; idx < 4 * 2 * 6144; idx += NGT) {
            const int l = idx / 12288, b = (idx / 6144) & 1, n = idx % 6144;
            float v = ada_b[l * 6144 + n];
#pragma unroll
            for (int kq = 0; kq < 4; ++kq) v += MODP[((size_t)(kq * 4 + l) * 2 + b) * 6144 + n];
            MOD[idx] = v;
        }
        for (int idx = gt; idx < 2 * 32 * 65 * 256; idx += NGT) {
            const int ci = idx & 15, co = (idx >> 4) & 15, tr = (idx >> 8) % 65, ig = idx / (65 * 256);
            float acc = 0.f;
            if (tr > 0) {
                const int tau = tr - 1;
#pragma unroll 16
                for (int p = 0; p < 64; ++p) { const int sp = ig * 64 + p;
                    const float cr = s5_c_re[((size_t)ig * 16 + co) * 64 + p], cim_ = s5_c_im[((size_t)ig * 16 + co) * 64 + p];
                    const f32x2 pw_ = *(const f32x2*)(S5PW + ((size_t)sp * 65 + tau) * 2), bb_ = *(const f32x2*)(S5B + ((size_t)sp * 16 + ci) * 2);
                    const float pr = pw_.x, pi_ = pw_.y, br = bb_.x, bi = bb_.y;
                    const float xr = cr * pr - cim_ * pi_, xi = cr * pi_ + cim_ * pr;
                    acc += xr * br - xi * bi; }
            }
            S5KT[((size_t)ig * 65 + tr) * 384 + co * 24 + ci] = (bf16_t)f2bf(acc);
        }
        constexpr int NW_ = 2 * 32 * 128 * 1024;
        for (int idx0 = gt; idx0 < NW_; idx0 += NGT * 8) {
            f32x2 pw_[8], bb_[8];
#pragma unroll
            for (int u = 0; u < 8; ++u) { const int idx = min(idx0 + u * NGT, NW_ - 1);
                const int k = idx & 1023, row = (idx >> 10) & 127, ig = idx >> 17; const int s = k >> 4, ci = k & 15, p = row >> 1; const int sp = ig * 64 + p;
                pw_[u] = *(const f32x2*)(S5PW + ((size_t)sp * 65 + (63 - s)) * 2); bb_[u] = *(const f32x2*)(S5B + ((size_t)sp * 16 + ci) * 2); }
            __builtin_amdgcn_sched_barrier(0);
#pragma unroll
            for (int u = 0; u < 8; ++u) { const int idx = idx0 + u * NGT;
                if (idx < NW_) { const int ri = (idx >> 10) & 1; const float pr = pw_[u].x, pi_ = pw_[u].y, br = bb_[u].x, bi = bb_[u].y;
                    S5WT[idx] = (bf16_t)f2bf(ri ? (pr * bi + pi_ * br) : (pr * br - pi_ * bi)); } }
            __builtin_amdgcn_sched_barrier(0);
        }
        for (int idx0 = gt; idx0 < NW_; idx0 += NGT * 8) {
            f32x2 pw_[8]; float crv[8], civ[8];
#pragma unroll
            for (int u = 0; u < 8; ++u) { const int idx = min(idx0 + u * NGT, NW_ - 1);
                const int k = idx & 127, rowt = (idx >> 7) & 1023, ig = idx >> 17; const int t = rowt >> 4, co = rowt & 15, p = k >> 1; const int sp = ig * 64 + p;
                crv[u] = s5_c_re[((size_t)ig * 16 + co) * 64 + p]; civ[u] = s5_c_im[((size_t)ig * 16 + co) * 64 + p];
                pw_[u] = *(const f32x2*)(S5PW + ((size_t)sp * 65 + t + 1) * 2); }
            __builtin_amdgcn_sched_barrier(0);
#pragma unroll
            for (int u = 0; u < 8; ++u) { const int idx = idx0 + u * NGT;
                if (idx < NW_) { const int ri = idx & 1; const float cr = crv[u], cim_ = civ[u], pr = pw_[u].x, pi_ = pw_[u].y;
                    S5A2[idx] = (bf16_t)f2bf(ri ? -(cr * pi_ + cim_ * pr) : (cr * pr - cim_ * pi_)); } }
            __builtin_amdgcn_sched_barrier(0);
        }
    }
    PH_END();
    if (PH_ON()) { DECL_PTRS();
        for (int t0 = gw * 4; t0 < T; t0 += NGW * 4) {
            const int b = t0 / S; const float* mo = MOD + (size_t)(0 * 2 + b) * 6144;
            f32x4 v[4][4], sc1[4], sh1[4];
#pragma unroll
            for (int u = 0; u < 4; ++u)
#pragma unroll
                for (int j = 0; j < 4; ++j) v[u][j] = *(const f32x4*)(xin + (size_t)(t0 + u) * 1024 + 4 * lane + 256 * j);
#pragma unroll
            for (int j = 0; j < 4; ++j) { sc1[j] = *(const f32x4*)(mo + 1024 + 4 * lane + 256 * j); sh1[j] = *(const f32x4*)(mo + 4 * lane + 256 * j); }
            __builtin_amdgcn_sched_barrier(0);
#pragma unroll
            for (int u = 0; u < 4; ++u) { float ss = 0.f;
#pragma unroll
                for (int j = 0; j < 4; ++j) ss += (v[u][j].x * v[u][j].x + v[u][j].y * v[u][j].y) + (v[u][j].z * v[u][j].z + v[u][j].w * v[u][j].w);
                const float rn = rsqrtf(wave_sum(ss) * (1.0f / 1024.0f) + EPS);
#pragma unroll
                for (int j = 0; j < 4; ++j) { const int col = 4 * lane + 256 * j;
                    u32x2 w; w.x = pk2(v[u][j].x * rn * (1.f + sc1[j].x) + sh1[j].x, v[u][j].y * rn * (1.f + sc1[j].y) + sh1[j].y); w.y = pk2(v[u][j].z * rn * (1.f + sc1[j].z) + sh1[j].z, v[u][j].w * rn * (1.f + sc1[j].w) + sh1[j].w);
                    *(u32x2*)(H + (size_t)(t0 + u) * 1024 + col) = w; } }
            __builtin_amdgcn_sched_barrier(0);
        }
    }
    PH_END();

    for (l0 = 0; l0 < DEPTH; ++l0) {
        if ((l0 & 1) == 0) {
            if (PH_ON()) { DECL_PTRS();
                pg8::Gemm g{H, Wevin + (size_t)i * EV_NP * 1024, T, EV_NP, 1024, 0}; pg8::StaticOrder So; So.init(T, EV_NP, G, c);
                EpiEvenIn E{Z, IQH, IKH, IW, a_kn + i * 64, b_kn + i * 64, b_idx_kn + i * 32, COSH, SINH, COSI, SINI};
                { PROBE_WRAP(pg8::StaticOrder, So); pg8::gemm_phase<EpiEvenIn, PROBE_SCHED(pg8::StaticOrder), true, true>(glds, g, PS_, E, tid); }
            }
            PH_END();
            if (PH_ON()) { DECL_PTRS();
                moe_convert(moe_w1 + (size_t)l * 32 * 1024 * 512, moe_w3 + (size_t)l * 32 * 1024 * 512, moe_w2 + (size_t)l * 32 * 512 * 1024, W13, W2, scr, gw, NGW, lane);
                __syncthreads();
                {
                    LAS unsigned short* kq = (LAS unsigned short*)lds;
                    const int qi = tid >> 7, ht = tid & 127;
                    LAS unsigned short* kqq = kq + qi * 16384;
                    LAS unsigned* hist = (LAS unsigned*)(lds + LDS_MISC + qi * 6400);
                    LAS unsigned* bits = hist + 1024;
                    LAS unsigned* misc = hist + 1536;
                    typedef _Float16 f16x8_t __attribute__((ext_vector_type(8)));
                    f16x8_t qaN[2], kbN[4][2]; f32x4 wqN[4];
                    auto issue_unit = [&](int it_) {
                        const int lane_ = lane_id_v(), r32 = lane_ & 31, hi = lane_ >> 5, wid_ = lsg(wid0);
                        const int L_ = min(it_ * G + c, 8191);
                        const int uu_ = (L_ & 1) ? (8191 - (L_ >> 1)) : (L_ >> 1); const int b_ = uu_ >> 12, pp_ = uu_ & 4095;
                        const size_t tA_ = (size_t)b_ * S + 4 * pp_; const int ntile_ = (4 * pp_ + 4 + 31) >> 5;
#pragma unroll
                        for (int s = 0; s < 2; ++s) qaN[s] = *(const f16x8_t*)(IQH + (tA_ + 2 * ((r32 >> 2) & 1) + (r32 >> 4)) * 256 + (4 * ((r32 >> 3) & 1) + (r32 & 3)) * 32 + 16 * s + 8 * hi);
#pragma unroll
                        for (int q = 0; q < 4; ++q) wqN[q] = *(const f32x4*)(IW + (tA_ + 2 * hi + (q >> 1)) * 8 + 4 * (q & 1));
                        const _Float16* kbase_ = IKH + ((size_t)b_ * S + r32) * 32 + 8 * hi;
#pragma unroll
                        for (int u = 0; u < 4; ++u) { const int tile = min(wid_ + NWAVES * u, ntile_ - 1);
                            kbN[u][0] = *(const f16x8_t*)(kbase_ + (size_t)tile * 1024); kbN[u][1] = *(const f16x8_t*)(kbase_ + (size_t)tile * 1024 + 16); } };
                    issue_unit(0);
                    for (int it = 0;; ++it) {
                        const int L = it * G + c; if (L >= 8192) break;
                        const int uu = (L & 1) ? (8191 - (L >> 1)) : (L >> 1);
                        const int b = uu >> 12, pp = uu & 4095;
                        const size_t tA = (size_t)b * S + 4 * pp;
                        const int nD = 4 * pp + 4;
#pragma unroll
                        for (int q = 0; q < 8; ++q) hist[ht + 128 * q] = 0u;
                        __syncthreads();
#ifdef PROBE_MASK
                        if (a.probe_var != 2)
#endif
                        {
                            const int r32 = lane & 31, hi = lane >> 5;
                            f16x8_t qa[2]; qa[0] = qaN[0]; qa[1] = qaN[1];
                            f32x4 wq[4];
#pragma unroll
                            for (int q = 0; q < 4; ++q) wq[q] = wqN[q];
                            const int ntile = (nD + 31) >> 5;
                            const _Float16* kbase = IKH + ((size_t)b * S + r32) * 32 + 8 * hi;
                            f16x8_t kb[4][2], kn[4][2];
#pragma unroll
                            for (int u = 0; u < 4; ++u) { kb[u][0] = kbN[u][0]; kb[u][1] = kbN[u][1]; }
                            for (int tile0 = wid; tile0 < ntile; tile0 += NWAVES * 4) {
#pragma unroll
                                for (int u = 0; u < 4; ++u) { const int tile = min(tile0 + NWAVES * (4 + u), ntile - 1);
                                    kn[u][0] = *(const f16x8_t*)(kbase + (size_t)tile * 1024); kn[u][1] = *(const f16x8_t*)(kbase + (size_t)tile * 1024 + 16); }
#pragma unroll
                                for (int u = 0; u < 4; ++u) {
                                    const int tile = tile0 + NWAVES * u;
                                    attn_body::f32x16 acc;
#pragma unroll
                                    for (int r = 0; r < 16; ++r) acc[r] = 0.f;
                                    acc = __builtin_amdgcn_mfma_f32_32x32x16_f16(qa[0], kb[u][0], acc, 0, 0, 0);
                                    acc = __builtin_amdgcn_mfma_f32_32x32x16_f16(qa[1], kb[u][1], acc, 0, 0, 0);
                                    float sq[4];
#pragma unroll
                                    for (int q = 0; q < 4; ++q) sq[q] = wq[q].x * relu_i(acc[4 * q]) + wq[q].y * relu_i(acc[4 * q + 1]) + wq[q].z * relu_i(acc[4 * q + 2]) + wq[q].w * relu_i(acc[4 * q + 3]);
                                    if (tile < ntile) {
                                        const float sa = sq[0] + sq[1], sb = sq[2] + sq[3];
                                        const unsigned h0 = (unsigned)__builtin_bit_cast(unsigned short, (_Float16)sa), h1 = (unsigned)__builtin_bit_cast(unsigned short, (_Float16)sb);
                                        const unsigned k0_ = (h0 ^ ((unsigned)__builtin_amdgcn_sbfe((int)h0, 15, 1) | 0x8000u)) & 0xFFFFu, k1_ = (h1 ^ ((unsigned)__builtin_amdgcn_sbfe((int)h1, 15, 1) | 0x8000u)) & 0xFFFFu;
                                        const int kidx = tile * 32 + r32;
                                        kq[(2 * hi) * 16384 + kidx] = (unsigned short)k0_;
                                        kq[(2 * hi + 1) * 16384 + kidx] = (unsigned short)k1_;
                                        LAS unsigned* hq0 = (LAS unsigned*)(lds + LDS_MISC + (2 * hi) * 6400); LAS unsigned* hq1 = (LAS unsigned*)(lds + LDS_MISC + (2 * hi + 1) * 6400);
                                        __hip_atomic_fetch_add(&hq0[(kidx <= 4 * pp + 2 * hi) ? ((k0_ >> 8) << 2) + (lane & 3) : 1536 + 32 + (lane & 3)], 1u, __ATOMIC_RELAXED, __HIP_MEMORY_SCOPE_WORKGROUP);
                                        __hip_atomic_fetch_add(&hq1[(kidx <= 4 * pp + 2 * hi + 1) ? ((k1_ >> 8) << 2) + (lane & 3) : 1536 + 32 + (lane & 3)], 1u, __ATOMIC_RELAXED, __HIP_MEMORY_SCOPE_WORKGROUP);
                                    }
                                }
#pragma unroll
                                for (int u = 0; u < 4; ++u) { kb[u][0] = kn[u][0]; kb[u][1] = kn[u][1]; }
                            }
                            issue_unit(it + 1);
                        }
                        __syncthreads();
#ifdef PROBE_MASK
                        if (a.probe_var == 1) continue;
#endif
                        const int n = 4 * pp + 1 + qi;
                        const bool small = n <= 256;
                        if (ht == 0) { misc[0] = 0u; misc[1] = 256u; misc[2] = 0u; }
                        const LAS unsigned* kq32 = (const LAS unsigned*)kqq;
                        const int npair = (n + 1) >> 1;
                        for (int pass = 0; pass < 2; ++pass) {
                            if (pass) {
#pragma unroll
                                for (int q = 0; q < 8; ++q) hist[ht + 128 * q] = 0u; }
                            __syncthreads();
                            const int shift = 8 - 8 * pass;
                            if (!small && pass) {
                                const unsigned prefix = misc[0];
                                for (int W = ht; 32 * W < n; W += 128) {
                                    const unsigned vmask = (n - 32 * W >= 32) ? 0xFFFFFFFFu : ((1u << (n - 32 * W)) - 1u);
                                    const LAS u32x4* kp = (const LAS u32x4*)(kq32 + 16 * W);
                                    unsigned ne = 0u;
                                    const unsigned pp2 = prefix | (prefix << 16);
#pragma unroll
                                    for (int q4 = 0; q4 < 4; ++q4) { const u32x4 w4 = kp[q4];
#pragma unroll
                                        for (int e = 0; e < 4; ++e) ne |= pk_gt_u16((w4[e] ^ pp2) & 0xFF00FF00u, 0u, 0x00010001u) << (4 * q4 + e); }
                                    unsigned mm = ilv16(~ne) & vmask;
                                    const LAS unsigned short* k16 = kqq + 32 * W;
                                    while (mm) { const int j = __ffs(mm) - 1; mm &= mm - 1u;
                                        __hip_atomic_fetch_add(&hist[(((unsigned)k16[j] & 255u) << 2) + (lane & 3)], 1u, __ATOMIC_RELAXED, __HIP_MEMORY_SCOPE_WORKGROUP); }
                                }
                            }
                            __syncthreads();
                            if (!small && ht < 64) {
                                unsigned cb[4];
#pragma unroll
                                for (int q = 0; q < 4; ++q) { const u32x4 a0 = *(const LAS u32x4*)(hist + (4 * ht + q) * 4); cb[q] = (a0.x + a0.y) + (a0.z + a0.w); }
                                const unsigned c0 = cb[0], c1 = cb[1], c2 = cb[2], c3 = cb[3];
                                const unsigned tot = c0 + c1 + c2 + c3;
                                unsigned Ssum = tot;
#pragma unroll
                                for (int off = 1; off < 64; off <<= 1) { const unsigned v = shi_(Ssum, lane + off); if (ht + off < 64) Ssum += v; }
                                const unsigned above = Ssum - tot, krem = misc[1];
                                if (above < krem && krem <= Ssum) {
                                    unsigned run = above, bin, eq;
                                    if (run + c3 >= krem) { bin = 3; eq = c3; }
                                    else { run += c3; if (run + c2 >= krem) { bin = 2; eq = c2; }
                                        else { run += c2; if (run + c1 >= krem) { bin = 1; eq = c1; } else { run += c1; bin = 0; eq = c0; } } }
                                    misc[0] = misc[0] | ((4u * ht + bin) << shift); misc[1] = krem - run; misc[2] = eq;
                                }
                            }
                            __syncthreads();
                        }
#ifdef PROBE_MASK
                        if (a.probe_var == 8) { __syncthreads(); continue; }
#endif
                        const unsigned Tkey = misc[0], krem = misc[1], cnteq = misc[2];
                        LAS unsigned* eqb = hist;
                        const bool all_eq = (cnteq == krem);
                        for (int W = ht; W < 512; W += 128) {
                            unsigned sel = 0u, eqm = 0u;
                            if (32 * W < n) {
                                const unsigned vmask = (n - 32 * W >= 32) ? 0xFFFFFFFFu : ((1u << (n - 32 * W)) - 1u);
                                if (small) sel = vmask;
                                else {
                                    const LAS u32x4* kp = (const LAS u32x4*)(kq32 + 16 * W);
                                    const unsigned tp2 = Tkey | (Tkey << 16);
                                    unsigned ag = 0u, al = 0u;
#pragma unroll
                                    for (int q4 = 0; q4 < 4; ++q4) { const u32x4 w4 = kp[q4];
#pragma unroll
                                        for (int e = 0; e < 4; ++e) { ag |= pk_gt_u16(w4[e], tp2, 0x00010001u) << (4 * q4 + e); al |= pk_gt_u16(tp2, w4[e], 0x00010001u) << (4 * q4 + e); } }
                                    sel = ilv16(ag); eqm = ilv16(~(ag | al));
                                    if (all_eq) { sel |= eqm; eqm = 0u; }
                                    sel &= vmask; eqm &= vmask;
                                }
                            }
                            bits[W] = sel; eqb[W] = eqm;
                        }
                        __syncthreads();
                        if (!small && !all_eq && ht < 64) {
                            unsigned wv_[8]; unsigned cnt = 0u;
#pragma unroll
                            for (int q = 0; q < 8; ++q) { wv_[q] = eqb[8 * ht + q]; cnt += (unsigned)__popc(wv_[q]); }
                            unsigned inc = cnt;
#pragma unroll
                            for (int off = 1; off < 64; off <<= 1) { const unsigned v = shi_(inc, lane - off); if (lane >= off) inc += v; }
                            unsigned before = inc - cnt;
#pragma unroll
                            for (int q = 0; q < 8; ++q) { unsigned w = wv_[q], keep = 0u;
                                while (w && before < krem) { const unsigned lowb = w & (0u - w); keep |= lowb; w ^= lowb; ++before; }
                                before += (unsigned)__popc(w);
                                if (keep) __hip_atomic_fetch_or(&bits[8 * ht + q], keep, __ATOMIC_RELAXED, __HIP_MEMORY_SCOPE_WORKGROUP); }
                        }
                        __syncthreads();
                        {
                            const int qpos = 4 * pp + qi; const int tmax = 8 * (qpos >> 9) + 7;
#pragma unroll
                            for (int j = 0; j < 2; ++j) { const int tt = 2 * ht + j;
                                if (tt <= tmax) { const unsigned W0 = bits[2 * tt], W1 = bits[2 * tt + 1];
                                    unsigned e0 = W0 & 0x0F0F0F0Fu, e1 = W1 & 0x0F0F0F0Fu, o0 = (W0 >> 4) & 0x0F0F0F0Fu, o1 = (W1 >> 4) & 0x0F0F0F0Fu;
                                    e0 = (e0 | (e0 >> 4)) & 0x00FF00FFu; e0 = (e0 | (e0 >> 8)) & 0xFFFFu; e1 = (e1 | (e1 >> 4)) & 0x00FF00FFu; e1 = (e1 | (e1 >> 8)) & 0xFFFFu;
                                    o0 = (o0 | (o0 >> 4)) & 0x00FF00FFu; o0 = (o0 | (o0 >> 8)) & 0xFFFFu; o1 = (o1 | (o1 >> 4)) & 0x00FF00FFu; o1 = (o1 | (o1 >> 8)) & 0xFFFFu;
                                    u32x2 pm; pm.x = e0 | (e1 << 16); pm.y = o0 | (o1 << 16);
                                    *(u32x2*)(MASKW + (((size_t)(b * 256 + tt)) * S + qpos) * 2) = pm; } }
                        }
                        __syncthreads();
                    }
                }
                __syncthreads();
                {
                    bf16_t* OA = YMIX;
                    const int vcu = (G % 8 == 0) ? (c % 8) * (G / 8) + c / 8 : c;
                    const int nu = (G == 256) ? 4 : (1024 - vcu + G - 1) / G;
                    for (int iu = 0; iu < nu; ++iu) {
                        const int lane = lane_id_v(), wid = lsg(wid0);
                        LAS unsigned char* L0 = lsgp(lds0);
                        int combo, qb;
                        if (G == 256) { combo = vcu >> 4; const int s_ = vcu & 15; qb = iu == 0 ? s_ : iu == 1 ? 31 - s_ : iu == 2 ? 32 + s_ : 63 - s_; }
                        else { const int u = vcu + iu * G; combo = u & 15; qb = 63 - (u >> 4); }
                        const int b = combo >> 3, hc = combo & 7;
                        const bf16_t* zb = Z + (size_t)b * S * EV_ZP;
                        if (qk_bounded(a_qn + i * 64, a_kn + i * 64, lane))
                            flash_unit<2, false, true, EV_ZP, 1024, true>(L0, zb + hc * 64, zb + 512 + hc * 64, zb + 1024 + (hc >> 1) * 128, OA + (size_t)b * S * 1024 + hc * 128, nullptr, qb, wid, lane, a_qn + i * 64, COSH, SINH);
                        else
                            flash_unit<2, false, true, EV_ZP, 1024, false>(L0, zb + hc * 64, zb + 512 + hc * 64, zb + 1024 + (hc >> 1) * 128, OA + (size_t)b * S * 1024 + hc * 128, nullptr, qb, wid, lane, a_qn + i * 64, COSH, SINH);
                    }
                }
            }
            PH_END();
            if (PH_ON()) { DECL_PTRS();
                {
                    const bf16_t* OA = YMIX; const float lamv = LAM[i]; const float lam_init = 0.8f - 0.6f * expf(-0.3f * (float)l);
                    const int h = lane >> 4, vj = (lane >> 3) & 1, d8 = (lane & 7) * 8;
                    float gn[8];
#pragma unroll
                    for (int e = 0; e < 8; ++e) gn[e] = a_subln[i * 128 + vj * 64 + d8 + e] * (1.0f - lam_init);
                    for (int t0 = gw * 4; t0 < T; t0 += NGW * 4) {
                        u32x4 r1[4], r2[4];
#pragma unroll
                        for (int u = 0; u < 4; ++u) { r1[u] = *(const u32x4*)(OA + (size_t)(t0 + u) * 1024 + ((h * 2 + 0) * 2 + vj) * 64 + d8); r2[u] = *(const u32x4*)(OA + (size_t)(t0 + u) * 1024 + ((h * 2 + 1) * 2 + vj) * 64 + d8); }
                        __builtin_amdgcn_sched_barrier(0);
#pragma unroll
                        for (int u = 0; u < 4; ++u) {
                            float o1[8], o2[8], dd[8]; unpack8(r1[u], o1); unpack8(r2[u], o2);
                            float ss = 0.f;
#pragma unroll
                            for (int e = 0; e < 8; ++e) { dd[e] = o1[e] - lamv * o2[e]; ss += dd[e] * dd[e]; }
                            ss += dpp_xor1(ss); ss += dpp_xor2(ss); ss += SHX(ss, 4); ss += SHX(ss, 8);
                            const float r = rsqrtf(ss * (1.0f / 128.0f) + EPS);
#pragma unroll
                            for (int e = 0; e < 8; ++e) dd[e] = dd[e] * r * gn[e];
                            *(u32x4*)(O + (size_t)(t0 + u) * 1024 + h * 128 + vj * 64 + d8) = pack8(dd);
                        }
                        __builtin_amdgcn_sched_barrier(0);
                    }
                }
                {
                    const int vcu = (G % 8 == 0) ? (c % 8) * (G / 8) + c / 8 : c;
                    const int nu = (G == 256) ? 2 : (512 - vcu + G - 1) / G;
                    for (int iu = 0; iu < nu; ++iu) {
                        const int lane = lane_id_v(), wid = lsg(wid0);
                        LAS unsigned char* L0 = lsgp(lds0);
                        int combo, qb;
                        if (G == 256) { combo = vcu >> 4; const int s_ = vcu & 15; qb = iu == 0 ? s_ : 31 - s_; }
                        else { const int u = vcu + iu * G; combo = u & 15; qb = 31 - (u >> 4); }
                        const int b = combo >> 3, h = combo & 7;
                        const bf16_t* zb = Z + (size_t)b * S * EV_ZP;
                        if (qk_bounded(b_qn + i * 64, b_kn + i * 64, lane))
                            flash_unit_q2<1, true, false, EV_ZP, 1024, true>(L0, zb + 1536 + h * 64, zb + 2048 + h * 64, zb + 2560 + h * 64, O + (size_t)b * S * 1024 + 512 + h * 64, MASKW + (size_t)b * 256 * S * 2, qb, wid, lane, b_qn + i * 64, COSH, SINH);
                        else
                            flash_unit_q2<1, true, false, EV_ZP, 1024, false>(L0, zb + 1536 + h * 64, zb + 2048 + h * 64, zb + 2560 + h * 64, O + (size_t)b * S * 1024 + 512 + h * 64, MASKW + (size_t)b * 256 * S * 2, qb, wid, lane, b_qn + i * 64, COSH, SINH);
                    }
                }
            }
            PH_END();
        } else {
            if (PH_ON()) { DECL_PTRS();
                pg8::Gemm g{H, Wodin + (size_t)i * OD_N * 1024, T, OD_N, 1024, 0}; pg8::StaticOrder So; So.init(T, OD_N, G, c);
                EpiOddIn E{Z, UG, c_kn + i * 64, COSH, SINH};
                { PROBE_WRAP(pg8::StaticOrder, So); pg8::gemm_phase<EpiOddIn, PROBE_SCHED(pg8::StaticOrder), true, true>(glds, g, PS_, E, tid); }
            }
            PH_END();
            if (PH_ON()) { DECL_PTRS();
                moe_convert(moe_w1 + (size_t)l * 32 * 1024 * 512, moe_w3 + (size_t)l * 32 * 1024 * 512, moe_w2 + (size_t)l * 32 * 512 * 1024, W13, W2, scr, gw, NGW, lane);
                __syncthreads();
                for (int u = gw; u < NB * 64 * 8; u += NGW) {
                    const int h = u & 7, blk = (u >> 3) & 63, b = u >> 9;
                    const int rs = lane >> 3, d8 = (lane & 7) * 8;
                    const bf16_t* kp = Z + ((size_t)b * S + blk * 256 + rs) * OD_N + 512 + h * 64 + d8;
                    u32x4 kr[32];
#pragma unroll
                    for (int j = 0; j < 32; ++j) kr[j] = *(const u32x4*)(kp + (size_t)(8 * j) * OD_N);
                    __builtin_amdgcn_sched_barrier(0);
                    float sm[8];
#pragma unroll
                    for (int e = 0; e < 8; ++e) sm[e] = 0.f;
#pragma unroll
                    for (int j = 0; j < 32; ++j) { float kv[8]; unpack8(kr[j], kv);
#pragma unroll
                        for (int e = 0; e < 8; ++e) sm[e] += kv[e]; }
#pragma unroll
                    for (int e = 0; e < 8; ++e) { sm[e] += SHX(sm[e], 8); sm[e] += SHX(sm[e], 16); sm[e] += SHX(sm[e], 32); sm[e] *= (1.0f / 256.0f); }
                    if (rs == 0) {
                        *(f32x4*)(KM + (size_t)u * 64 + d8) = (f32x4){sm[0], sm[1], sm[2], sm[3]}; *(f32x4*)(KM + (size_t)u * 64 + d8 + 4) = (f32x4){sm[4], sm[5], sm[6], sm[7]};
                        const u32x4 hw = pack8(sm); float hf[8], lo[8]; unpack8(hw, hf);
#pragma unroll
                        for (int e = 0; e < 8; ++e) lo[e] = sm[e] - hf[e];
                        *(u32x4*)(KMH + ((size_t)(b * 8 + h) * 64 + blk) * 64 + d8) = hw; *(u32x4*)(KML + ((size_t)(b * 8 + h) * 64 + blk) * 64 + d8) = pack8(lo);
                    }
                }
                {
                    const int r32 = lane & 31, hi = lane >> 5;
                    LAS unsigned char* ldsU = lds;
                    LAS float* red = (LAS float*)(lds + 69632);
                    for (int task = c; task < 512; task += G) {
                        const int g = task >> 4, cs = task & 15;
                        for (int q = tid; q < 32 * 128; q += NTHREADS) { const int j = q >> 7, off = (q & 127) * 16;
                            *(LAS u32x4*)(ldsU + j * 2064 + off) = *(const u32x4*)((const unsigned char*)UG + ((size_t)g * T + (size_t)(cs * 32 + j) * 64) * 32 + off); }
                        __syncthreads();
                        const int rb = wid & 3, kh = wid >> 2;
                        attn_body::f32x16 acc;
#pragma unroll
                        for (int r = 0; r < 16; ++r) acc[r] = 0.f;
                        const bf16_t* wrow = S5WT + ((size_t)(i * 32 + g) * 128 + rb * 32 + r32) * 1024 + hi * 8;
#pragma unroll 8
                        for (int ks = kh * 32; ks < kh * 32 + 32; ++ks) {
                            const attn_body::bf16x8 A = *(const attn_body::bf16x8*)(wrow + ks * 16);
                            const attn_body::bf16x8 B = *(const LAS attn_body::bf16x8*)(ldsU + r32 * 2064 + ks * 32 + hi * 16);
                            acc = __builtin_amdgcn_mfma_f32_32x32x16_bf16(A, B, acc, 0, 0, 0);
                        }
                        if (kh == 1) {
#pragma unroll
                            for (int r = 0; r < 16; ++r) red[(rb * 64 + lane) * 16 + r] = acc[r];
                        }
                        __syncthreads();
                        if (kh == 0) {
                            float* ep = S5E + ((size_t)(cs * 32 + r32) * 32 + g) * 128 + rb * 32 + 4 * hi;
#pragma unroll
                            for (int q4 = 0; q4 < 4; ++q4) { f32x4 o;
                                o.x = acc[4 * q4] + red[(rb * 64 + lane) * 16 + 4 * q4]; o.y = acc[4 * q4 + 1] + red[(rb * 64 + lane) * 16 + 4 * q4 + 1];
                                o.z = acc[4 * q4 + 2] + red[(rb * 64 + lane) * 16 + 4 * q4 + 2]; o.w = acc[4 * q4 + 3] + red[(rb * 64 + lane) * 16 + 4 * q4 + 3];
                                *(f32x4*)(ep + 8 * q4) = o; }
                        }
                        __syncthreads();
                    }
                }
            }
            PH_END();
            if (PH_ON()) { DECL_PTRS();
#ifndef SKIP_S5
                {
                    for (int idx = gt; idx < NB * 32 * 64; idx += NGT) {
                        const int b = idx >> 11, g = (idx >> 6) & 31, p = idx & 63;
                        const int sp = (i * 32 + g) * 64 + p;
                        const float aLr = S5PW[((size_t)sp * 65 + 64) * 2], aLi = S5PW[((size_t)sp * 65 + 64) * 2 + 1];
                        float hr = 0.f, hi_ = 0.f;
                        for (int c0 = 0; c0 < 256; c0 += 32) {
                            float er[32], ei[32];
#pragma unroll
                            for (int k = 0; k < 32; ++k) { const float* ep = S5E + ((size_t)(b * 256 + c0 + k) * 32 + g) * 128 + 2 * p; er[k] = ep[0]; ei[k] = ep[1]; }
                            __builtin_amdgcn_sched_barrier(0);
#pragma unroll
                            for (int k = 0; k < 32; ++k) {
                                *(unsigned*)(S5HC + ((size_t)(b * 256 + c0 + k) * 32 + g) * 128 + 2 * p) = pk2(hr, hi_);
                                const float nr = aLr * hr - aLi * hi_ + er[k], ni = aLr * hi_ + aLi * hr + ei[k]; hr = nr; hi_ = ni; }
                        }
                    }
                }
#endif
                {
                    unsigned* mcnt = ctl + CW_MCNT + i * 1024;
                    const int r32 = lane & 31, hi = lane >> 5;
                    for (int u = c; u < NB * 8 * 64; u += G) {
                        const int tb = u & 63, h = (u >> 6) & 7, b = u >> 9;
                        const int pos = tb * 256 + wid * 32 + r32; const size_t t = (size_t)b * S + pos;
                        float tv[3] = {-INFINITY, -INFINITY, -INFINITY}; int ti[3] = {1 << 20, 1 << 20, 1 << 20};
                        if (tb > 0) {
                            attn_body::bf16x8 qr[4];
                            load_q_normed(qr, Z + t * OD_N + h * 64, c_qn + i * 64, COSH, SINH, pos, hi, lane);
                            attn_body::f32x16 g0, g1;
#pragma unroll
                            for (int r = 0; r < 16; ++r) { g0[r] = 0.f; g1[r] = 0.f; }
                            const bf16_t* kh = KMH + ((size_t)(b * 8 + h) * 64 + r32) * 64 + hi * 8; const bf16_t* kl = KML + ((size_t)(b * 8 + h) * 64 + r32) * 64 + hi * 8;
#pragma unroll
                            for (int d0 = 0; d0 < 4; ++d0) {
                                g0 = __builtin_amdgcn_mfma_f32_32x32x16_bf16(*(const attn_body::bf16x8*)(kh + d0 * 16), qr[d0], g0, 0, 0, 0);
                                g0 = __builtin_amdgcn_mfma_f32_32x32x16_bf16(*(const attn_body::bf16x8*)(kl + d0 * 16), qr[d0], g0, 0, 0, 0);
                                if (tb > 32) { g1 = __builtin_amdgcn_mfma_f32_32x32x16_bf16(*(const attn_body::bf16x8*)(kh + 32 * 64 + d0 * 16), qr[d0], g1, 0, 0, 0);
                                               g1 = __builtin_amdgcn_mfma_f32_32x32x16_bf16(*(const attn_body::bf16x8*)(kl + 32 * 64 + d0 * 16), qr[d0], g1, 0, 0, 0); } }
#pragma unroll
                            for (int half = 0; half < 2; ++half)
#pragma unroll
                                for (int r = 0; r < 16; ++r) { const int n = half * 32 + attn_body::crow(r, hi); const float gv = (n < tb) ? (half ? g1[r] : g0[r]) : -INFINITY;
                                    if (gv > tv[0]) { tv[2] = tv[1]; ti[2] = ti[1]; tv[1] = tv[0]; ti[1] = ti[0]; tv[0] = gv; ti[0] = n; }
                                    else if (gv > tv[1]) { tv[2] = tv[1]; ti[2] = ti[1]; tv[1] = gv; ti[1] = n; }
                                    else if (gv > tv[2]) { tv[2] = gv; ti[2] = n; } }
                            float pv_[3]; int pi_[3];
#pragma unroll
                            for (int k = 0; k < 3; ++k) { pv_[k] = SHX(tv[k], 32); pi_[k] = (int)shi_((unsigned)ti[k], lane ^ 32); }
                            float mv[3]; int mi[3]; int ia = 0, ib = 0;
#pragma unroll
                            for (int k = 0; k < 3; ++k) {
                                const float av = ia == 0 ? tv[0] : ia == 1 ? tv[1] : ia == 2 ? tv[2] : -INFINITY; const int ai = ia == 0 ? ti[0] : ia == 1 ? ti[1] : ia == 2 ? ti[2] : (1 << 20);
                                const float bv = ib == 0 ? pv_[0] : ib == 1 ? pv_[1] : ib == 2 ? pv_[2] : -INFINITY; const int bi = ib == 0 ? pi_[0] : ib == 1 ? pi_[1] : ib == 2 ? pi_[2] : (1 << 20);
                                const bool ta = (av > bv) || (av == bv && ai < bi);
                                mv[k] = ta ? av : bv; mi[k] = ta ? ai : bi; if (ta) ++ia; else ++ib; }
#pragma unroll
                            for (int k = 0; k < 3; ++k) { tv[k] = mv[k]; ti[k] = mi[k]; }
                        }
#ifdef PROBE_MASK
                        if (a.probe_var == 3) { if (ti[0] + ti[1] + ti[2] == -12345) NSEL[0] = 1; continue; }
#endif
                        if (hi == 0) {
                            unsigned idx[3];
#pragma unroll
                            for (int sI = 0; sI < 3; ++sI) { idx[sI] = 0u;
                                if (tv[sI] > -INFINITY) idx[sI] = __hip_atomic_fetch_add(mcnt + (b * 8 + h) * 64 + ti[sI], 1u, __ATOMIC_RELAXED, __HIP_MEMORY_SCOPE_AGENT); }
                            int nsel = 0;
#pragma unroll
                            for (int sI = 0; sI < 3; ++sI)
                                if (tv[sI] > -INFINITY) { const int li = (b * 8 + h) * 64 + ti[sI]; MLIST[(size_t)li * 16384 + idx[sI]] = (pos << 2) | nsel; ++nsel; }
                            NSEL[t * 8 + h] = nsel;
                        }
                    }
                }
            }
            PH_END();
            if (PH_ON()) { DECL_PTRS();
                {
                    const unsigned* mcnt = ctl + CW_MCNT + i * 1024;
                    LAS int* pref = (LAS int*)(lds + LDS_MISC);
                    if (wid == 0) {
                        int loc[16]; int sum = 0;
#pragma unroll
                        for (int k = 0; k < 16; ++k) loc[k] = (int)__hip_atomic_load(mcnt + lane * 16 + k, __ATOMIC_RELAXED, __HIP_MEMORY_SCOPE_AGENT);
                        __builtin_amdgcn_sched_barrier(0);
#pragma unroll
                        for (int k = 0; k < 16; ++k) { const int cnt = loc[k]; loc[k] = sum; sum += (cnt + 255) >> 8; }
                        int inc = sum;
#pragma unroll
                        for (int off = 1; off < 64; off <<= 1) { const int v = (int)shi_((unsigned)inc, lane - off); if (lane >= off) inc += v; }
                        const int base = inc - sum;
#pragma unroll
                        for (int k = 0; k < 16; ++k) pref[lane * 16 + k] = base + loc[k];
                        if (lane == 63) pref[1024] = inc;
                    }
                    __syncthreads();
                    const int NTsel = pref[1024];
                    auto decode = [&](int task_, int& li_o, int& chunk_o, bool& own_o) { own_o = task_ >= NTsel; chunk_o = 0;
                        if (own_o) li_o = task_ - NTsel;
                        else { int lo_ = 0, hi_ = 1023; while (lo_ < hi_) { const int mid = (lo_ + hi_ + 1) >> 1; if (pref[mid] <= task_) lo_ = mid; else hi_ = mid - 1; } li_o = lo_; chunk_o = task_ - pref[lo_]; } };
                    int nx_li = 0, nx_chunk = 0, nx_ent = 0, nx_cnt = 256; bool nx_own = true;
                    if (c < NTsel + 1024) { decode(c, nx_li, nx_chunk, nx_own);
                        if (!nx_own) { const int ln_ = lane_id_v(); nx_ent = MLIST[(size_t)nx_li * 16384 + nx_chunk * 256 + lsg(wid0) * 32 + (ln_ & 31)]; nx_cnt = (int)__hip_atomic_load(mcnt + nx_li, __ATOMIC_RELAXED, __HIP_MEMORY_SCOPE_AGENT); } }
                    for (int task = c; task < NTsel + 1024; task += G) {
                        const int lane = lane_id_v(), wid = lsg(wid0), r32 = lane & 31, hi = lane >> 5;
                        LAS unsigned char* ldsKs = lsgp(lds0); LAS unsigned char* ldsVs = ldsKs + 32768;
                        LAS bf16_t* stg = (LAS bf16_t*)(ldsKs + 65536 + wid * 4096); LAS float* wsf = (LAS float*)(ldsKs + 98304 + wid * 256); LAS int* rowd = (LAS int*)(ldsKs + 100352 + wid * 128);
                        const bool own_task = nx_own;
                        const int li = nx_li, chunk = nx_chunk;
                        const int b = li >> 9, h = (li >> 6) & 7, blk = li & 63;
                        const int e_ = chunk * 256 + wid * 32 + r32;
                        const int cnt = nx_cnt;
                        const int ent_ = nx_ent;
                        u32x4 kst[4], vst[4];
                        {
                            const bf16_t* kbp = Z + ((size_t)b * S + blk * 256) * OD_N + 512 + h * 64;
                            const bf16_t* vbp = Z + ((size_t)b * S + blk * 256) * OD_N + 1024 + h * 64;
#pragma unroll
                            for (int kt = 0; kt < 4; ++kt) {
                                kst[kt] = *(const u32x4*)(kbp + (size_t)(kt * 64 + lane) * OD_N + wid * 8);
                                vst[kt] = *(const u32x4*)(vbp + (size_t)(kt * 64 + 16 * (wid & 3) + (lane >> 2)) * OD_N + (wid >> 2) * 32 + (lane & 3) * 8);
                            }
                        }
                        __builtin_amdgcn_sched_barrier(0);
                        int posq, slot; bool valid;
                        if (own_task) { posq = blk * 256 + wid * 32 + r32; slot = 3; valid = true; }
                        else { valid = e_ < cnt; posq = valid ? (ent_ >> 2) : 0; slot = ent_ & 3; }
                        const size_t tq = (size_t)b * S + posq;
                        const int dest = valid ? (int)((tq * 8 + h) * 4 + slot) : -1;
                        attn_body::bf16x8 qr[4];
                        load_q_normed(qr, Z + tq * OD_N + h * 64, c_qn + i * 64, COSH, SINH, posq, hi, lane);
#pragma unroll
                        for (int kt = 0; kt < 4; ++kt) { *(LAS u32x4*)(ldsKs + kt * 8192 + wid * 1024 + lane * 16) = kst[kt]; *(LAS u32x4*)(ldsVs + kt * 8192 + wid * 1024 + lane * 16) = vst[kt]; }
                        nx_own = true; nx_li = 0; nx_chunk = 0; nx_ent = 0; nx_cnt = 256;
                        if (task + G < NTsel + 1024) { decode(task + G, nx_li, nx_chunk, nx_own);
                            if (!nx_own) { nx_ent = MLIST[(size_t)nx_li * 16384 + nx_chunk * 256 + wid * 32 + r32]; nx_cnt = (int)__hip_atomic_load(mcnt + nx_li, __ATOMIC_RELAXED, __HIP_MEMORY_SCOPE_AGENT); } }
                        __syncthreads();
                        attn_body::f32x16 p0[4], p1[4];
#pragma unroll
                        for (int kt = 0; kt < 4; ++kt) {
#pragma unroll
                            for (int r = 0; r < 16; ++r) { p0[kt][r] = 0.f; p1[kt][r] = 0.f; }
                            const LAS unsigned char* kb = ldsKs + kt * 8192 + hi * 1024 + r32 * 16;
#pragma unroll
                            for (int d0 = 0; d0 < 4; ++d0) {
                                const attn_body::bf16x8 b0 = *(const LAS attn_body::bf16x8*)(kb + d0 * 2048), b1 = *(const LAS attn_body::bf16x8*)(kb + d0 * 2048 + 512);
                                p0[kt] = __builtin_amdgcn_mfma_f32_32x32x16_bf16(b0, qr[d0], p0[kt], 0, 0, 0);
                                p1[kt] = __builtin_amdgcn_mfma_f32_32x32x16_bf16(b1, qr[d0], p1[kt], 0, 0, 0);
                            }
                        }
                        if (own_task) {
                            const int qrel = wid * 32 + r32;
#pragma unroll
                            for (int kt = 0; kt < 4; ++kt)
#pragma unroll
                                for (int r = 0; r < 16; ++r) { const int kv = kt * 64 + attn_body::crow(r, hi); if (kv > qrel) p0[kt][r] = -INFINITY; if (kv + 32 > qrel) p1[kt][r] = -INFINITY; }
                        }
                        float mx = -INFINITY;
#pragma unroll
                        for (int kt = 0; kt < 4; ++kt)
#pragma unroll
                            for (int r = 0; r < 16; ++r) mx = fmaxf(mx, fmaxf(p0[kt][r], p1[kt][r]));
                        mx = fmaxf(mx, SHX(mx, 32));
                        float ls = 0.f;
#pragma unroll
                        for (int kt = 0; kt < 4; ++kt)
#pragma unroll
                            for (int r = 0; r < 16; ++r) { p0[kt][r] = __builtin_amdgcn_exp2f(p0[kt][r] - mx); p1[kt][r] = __builtin_amdgcn_exp2f(p1[kt][r] - mx); ls += p0[kt][r] + p1[kt][r]; }
                        ls += SHX(ls, 32);
                        attn_body::f32x16 o[2];
#pragma unroll
                        for (int r = 0; r < 16; ++r) { o[0][r] = 0.f; o[1][r] = 0.f; }
                        const int vb0 = (int)(unsigned)(unsigned long long)ldsVs + ((lane >> 4) & 1) * 32 + (lane & 3) * 8 + (4 * hi + ((lane & 15) >> 2)) * 64;
#pragma unroll
                        for (int kt = 0; kt < 4; ++kt) {
                            u32x4 pw0, pw1, pw2, pw3;
#pragma unroll
                            for (int k = 0; k < 4; ++k) { pw0[k] = attn_body::cvtpk_s(p0[kt][2 * k], p0[kt][2 * k + 1]); pw1[k] = attn_body::cvtpk_s(p0[kt][8 + 2 * k], p0[kt][9 + 2 * k]);
                                pw2[k] = attn_body::cvtpk_s(p1[kt][2 * k], p1[kt][2 * k + 1]); pw3[k] = attn_body::cvtpk_s(p1[kt][8 + 2 * k], p1[kt][9 + 2 * k]); }
                            attn_body::pv(o, vb0 + kt * 8192, __builtin_bit_cast(attn_body::bf16x8, pw0), __builtin_bit_cast(attn_body::bf16x8, pw1), __builtin_bit_cast(attn_body::bf16x8, pw2), __builtin_bit_cast(attn_body::bf16x8, pw3));
                        }
                        if (hi == 0) { wsf[r32] = ls; rowd[r32] = dest; if (valid) { MML[(size_t)dest * 2] = mx; MML[(size_t)dest * 2 + 1] = ls; } }
                        LDS_WAIT();
#pragma unroll
                        for (int r = 0; r < 16; ++r) { const int orow = attn_body::crow(r, hi); const float rl = __builtin_amdgcn_rcpf(wsf[orow]);
                            stg[orow * 64 + r32] = (bf16_t)f2bf(o[0][r] * rl); stg[orow * 64 + 32 + r32] = (bf16_t)f2bf(o[1][r] * rl); }
                        LDS_WAIT();
#pragma unroll
                        for (int q = 0; q < 4; ++q) { const int row = q * 8 + (lane >> 3), ch = lane & 7; const int dd = rowd[row];
                            if (dd >= 0) *(u32x4*)(MPO + (size_t)dd * 64 + ch * 8) = *(const LAS u32x4*)(stg + row * 64 + ch * 8); }
                        __syncthreads();
                    }
                }
                {
                const int r32 = lane & 31, hi = lane >> 5;
                LAS unsigned char* ldsU = lds;
                LAS unsigned char* ldsK = lds + 69632;
                for (int task = c; task < 512; task += G) {
                    const int g = task >> 4, cs = task & 15, ig = i * 32 + g;
                    for (int q = tid; q < 32 * 128; q += NTHREADS) { const int j = q >> 7, off = (q & 127) * 16;
                        *(LAS u32x4*)(ldsU + j * 2064 + off) = *(const u32x4*)((const unsigned char*)UG + ((size_t)g * T + (size_t)(cs * 32 + j) * 64) * 32 + off); }
                    for (int q = tid; q < 65 * 48; q += NTHREADS) *(LAS u32x4*)(ldsK + q * 16) = *(const u32x4*)((const unsigned char*)S5KT + (size_t)ig * 65 * 768 + q * 16);
                    __syncthreads();
                    const int gc = cs * 32 + r32;
                    const float* dsk = s5_d + ig * 16;
                    const f32x4 dd0 = *(const f32x4*)(dsk + 4 * hi), dd1 = *(const f32x4*)(dsk + 8 + 4 * hi);
                    attn_body::bf16x8 hcr[8];
                    { const bf16_t* hc = S5HC + ((size_t)gc * 32 + g) * 128 + hi * 8;
#pragma unroll
                      for (int kk = 0; kk < 8; ++kk) hcr[kk] = *(const attn_body::bf16x8*)(hc + kk * 16); }
#pragma unroll 1
                    for (int rr = 0; rr < 4; ++rr) {
                        const int r = rr == 0 ? wid : rr == 1 ? 15 - wid : rr == 2 ? 16 + wid : 31 - wid;
                        attn_body::f32x16 acc;
#pragma unroll
                        for (int q = 0; q < 16; ++q) acc[q] = 0.f;
                        attn_body::bf16x8 a2r[8];
                        { const bf16_t* a2 = S5A2 + ((size_t)ig * 1024 + r * 32 + r32) * 128 + hi * 8;
#pragma unroll
                          for (int kk = 0; kk < 8; ++kk) a2r[kk] = *(const attn_body::bf16x8*)(a2 + kk * 16); }
                        __builtin_amdgcn_sched_barrier(0);
                        const LAS unsigned char* kbase = ldsK + (r32 >> 4) * 768 + (r32 & 15) * 48 + hi * 16;
                        const LAS unsigned char* ubase = ldsU + r32 * 2064 + hi * 16;
                        for (int s = 0; s <= 2 * r + 1; ++s) {
                            const attn_body::bf16x8 A = *(const LAS attn_body::bf16x8*)(kbase + (2 * r - s + 1) * 768);
                            const attn_body::bf16x8 B = *(const LAS attn_body::bf16x8*)(ubase + s * 32);
                            acc = __builtin_amdgcn_mfma_f32_32x32x16_bf16(A, B, acc, 0, 0, 0);
                        }
#pragma unroll
                        for (int kk = 0; kk < 8; ++kk) acc = __builtin_amdgcn_mfma_f32_32x32x16_bf16(a2r[kk], hcr[kk], acc, 0, 0, 0);
#pragma unroll
                        for (int q4 = 0; q4 < 4; ++q4) {
                            const int rowb = 8 * q4 + 4 * hi, dt_ = rowb >> 4, co0 = rowb & 15, t = 2 * r + dt_;
                            const u32x2 uw = *(const LAS u32x2*)(ldsU + r32 * 2064 + t * 32 + co0 * 2);
                            const f32x4 dd = (q4 & 1) ? dd1 : dd0;
                            const float y0 = acc[4 * q4] + dd.x * bflo(uw.x), y1 = acc[4 * q4 + 1] + dd.y * bfhi(uw.x), y2 = acc[4 * q4 + 2] + dd.z * bflo(uw.y), y3 = acc[4 * q4 + 3] + dd.w * bfhi(uw.y);
                            u32x2 w; w.x = pk2(gelu_tanh(y0), gelu_tanh(y1)); w.y = pk2(gelu_tanh(y2), gelu_tanh(y3));
                            *(u32x2*)(YG + ((size_t)gc * 64 + t) * 512 + g * 16 + co0) = w;
                        }
                    }
                    __syncthreads();
                }
                }
            }
            PH_END();
            if (PH_ON()) { DECL_PTRS();
                {
                    const int h = lane >> 3, d8 = (lane & 7) * 8;
                    for (int t0 = gw * 4; t0 < T; t0 += NGW * 4) {
                        int nsel[4]; f32x2 ml[4][4]; u32x4 po[4][4];
#pragma unroll
                        for (int u = 0; u < 4; ++u) { const size_t base = ((size_t)(t0 + u) * 8 + h) * 4; nsel[u] = NSEL[(size_t)(t0 + u) * 8 + h];
#pragma unroll
                            for (int s = 0; s < 4; ++s) { ml[u][s] = *(const f32x2*)(MML + (base + s) * 2); po[u][s] = *(const u32x4*)(MPO + (base + s) * 64 + d8); } }
                        __builtin_amdgcn_sched_barrier(0);
#pragma unroll
                        for (int u = 0; u < 4; ++u) {
                            float mm[4], ll[4];
#pragma unroll
                            for (int s = 0; s < 4; ++s) { const bool on = (s == 3) || (s < nsel[u]); mm[s] = on ? ml[u][s].x : -INFINITY; ll[s] = on ? ml[u][s].y : 0.f; }
                            const float M = fmaxf(fmaxf(mm[0], mm[1]), fmaxf(mm[2], mm[3]));
                            float acc[8], wsum = 0.f;
#pragma unroll
                            for (int e = 0; e < 8; ++e) acc[e] = 0.f;
#pragma unroll
                            for (int s = 0; s < 4; ++s) { const bool on = (s == 3) || (s < nsel[u]);
                                const float w = on ? ll[s] * __builtin_amdgcn_exp2f(mm[s] - M) : 0.f; float ov[8]; unpack8(po[u][s], ov); wsum += w;
#pragma unroll
                                for (int e = 0; e < 8; ++e) acc[e] += on ? w * ov[e] : 0.f; }
                            const float inv = 1.0f / wsum;
#pragma unroll
                            for (int e = 0; e < 8; ++e) acc[e] *= inv;
                            *(u32x4*)(O + (size_t)(t0 + u) * 1024 + h * 64 + d8) = pack8(acc);
                        }
                        __builtin_amdgcn_sched_barrier(0);
                    }
                }
                pg8::Gemm g{YG, Wglu + (size_t)i * 512 * 512, T, 512, 512, 0}; pg8::StaticOrder So; So.init(T, 512, G, c);
                EpiGLU E{O, YG, s5_glu_b + i * 512};
                { PROBE_WRAP(pg8::StaticOrder, So); pg8::gemm_phase<EpiGLU, PROBE_SCHED(pg8::StaticOrder), true, true>(glds, g, PS_, E, tid); }
            }
            PH_END();
        }
        if (PH_ON()) { DECL_PTRS();
            pg8::Gemm g{O, ((l & 1) ? Wodout : Wevout) + (size_t)i * 1024 * 1024, T, 1024, 1024, 0}; pg8::StaticOrder So; So.init(T, 1024, G, c);
            EpiPlain E{YMIX, 1024};
            { PROBE_WRAP(pg8::StaticOrder, So); pg8::gemm_phase<EpiPlain, PROBE_SCHED(pg8::StaticOrder), true, true>(glds, g, PS_, E, tid); }
        }
        PH_END();
        if (PH_ON()) { DECL_PTRS();
#ifdef PROBE_MASK
            const bool first_x = (l == 0 && a.probe_var != -5);
#else
            const bool first_x = (l == 0);
#endif
            const float* xs = xin;
            LAS int* r_e = (LAS int*)(lds + 0);
            LAS float* r_w = (LAS float*)(lds + 1024);
            LAS int* r_rank = (LAS int*)(lds + 2048);
            LAS int* lcnt = (LAS int*)(lds + 3072);
            LAS int* lbase = (LAS int*)(lds + 3200);
            const float* wg_l = moe_wg + (size_t)l * 1024 * 4; const float* we_l = moe_we + (size_t)l * 1024 * 32;
            for (int chunk = c; chunk < T / 128; chunk += G) {
                if (tid < 32) lcnt[tid] = 0;
                LAS float* modl = (LAS float*)(lds + 32768);
                { const float* mo_ = MOD + (size_t)(l * 2 + (int)(((size_t)chunk * 128) / S)) * 6144 + 2048;
                  for (int q = tid; q < 768; q += NTHREADS) *(LAS f32x4*)(modl + 4 * q) = *(const f32x4*)(mo_ + 4 * q); }
                __syncthreads();
                {
                    const int rloc = lane & 15, kc = lane >> 4; const int r = wid * 16 + rloc; const size_t t = (size_t)chunk * 128 + r; const int b = (int)(((size_t)chunk * 128) / S);
                    const float* mo = MOD + (size_t)(l * 2 + b) * 6144;
                    float ss;
                    if (first_x) ss = f_pass1<true>(xs + t * 1024, XB + t * 1024, YMIX + t * 1024, modl, kc);
                    else ss = f_pass1<false>(xs + t * 1024, XB + t * 1024, YMIX + t * 1024, modl, kc);
                    ss += SHX(ss, 16); ss += SHX(ss, 32);
                    const float rn = rsqrtf(ss * (1.0f / 1024.0f) + EPS);
                    f32x4 acc[3];
#pragma unroll
                    for (int ct = 0; ct < 3; ++ct) acc[ct] = (f32x4){0.f, 0.f, 0.f, 0.f};
                    const bf16_t* wh = WRH + ((size_t)l * 48 + rloc) * 1024 + 8 * kc; const bf16_t* wl = WRL + ((size_t)l * 48 + rloc) * 1024 + 8 * kc;
                    f_pass2(XB + t * 1024, H + t * 1024, modl, wh, wl, rn, kc, acc);
                    LAS float* lg = (LAS float*)(lds + 4096 + wid * 3072);
#pragma unroll
                    for (int ct = 0; ct < 3; ++ct) { lg[(4 * kc + 0) * 48 + ct * 16 + rloc] = acc[ct].x; lg[(4 * kc + 1) * 48 + ct * 16 + rloc] = acc[ct].y; lg[(4 * kc + 2) * 48 + ct * 16 + rloc] = acc[ct].z; lg[(4 * kc + 3) * 48 + ct * 16 + rloc] = acc[ct].w; }
                    LDS_WAIT();
                    if (lane < 16) {
                        const LAS float* lr = lg + lane * 48;
                        float cg[4];
#pragma unroll
                        for (int e = 0; e < 4; ++e) cg[e] = lr[e] + moe_bg[l * 4 + e];
                        int grp = 0; float cm = cg[0];
#pragma unroll
                        for (int e = 1; e < 4; ++e) if (cg[e] > cm) { cm = cg[e]; grp = e; }
                        float den = 0.f;
#pragma unroll
                        for (int e = 0; e < 4; ++e) den += __expf(cg[e] - cm);
                        const float pg = 1.0f / den;
                        float fe[8];
#pragma unroll
                        for (int e = 0; e < 8; ++e) fe[e] = lr[4 + grp * 8 + e] + moe_be[l * 32 + grp * 8 + e];
                        int j0 = 0; float f0 = fe[0];
#pragma unroll
                        for (int e = 1; e < 8; ++e) if (fe[e] > f0) { f0 = fe[e]; j0 = e; }
                        int j1 = -1; float f1 = -INFINITY;
#pragma unroll
                        for (int e = 0; e < 8; ++e) if (e != j0 && fe[e] > f1) { f1 = fe[e]; j1 = e; }
                        const float ex = __expf(f1 - f0); const float sA = 1.0f / (1.0f + ex), sB = ex / (1.0f + ex);
                        const int rr_ = wid * 16 + lane;
                        r_e[2 * rr_] = grp * 8 + j0; r_w[2 * rr_] = pg * sA; r_e[2 * rr_ + 1] = grp * 8 + j1; r_w[2 * rr_ + 1] = pg * sB;
                    }
                }
                __syncthreads();
#ifdef PROBE_MASK
                if (a.probe_var == 5) { if (tid < 256 && r_e[tid] == -777) TOKES[0] = 0; __syncthreads(); continue; }
#endif
                if (tid < 256) r_rank[tid] = __hip_atomic_fetch_add(&lcnt[r_e[tid]], 1, __ATOMIC_RELAXED, __HIP_MEMORY_SCOPE_WORKGROUP);
                __syncthreads();
                if (tid < 32) lbase[tid] = (int)__hip_atomic_fetch_add(ctl + CW_CNT + (l * 32 + tid) * 64, (unsigned)lcnt[tid], __ATOMIC_RELAXED, __HIP_MEMORY_SCOPE_AGENT);
                __syncthreads();
                if (tid < 256) { const size_t t = (size_t)chunk * 128 + (tid >> 1); const int k = tid & 1; const int e = r_e[tid]; const int slot = lbase[e] + r_rank[tid];
                    TOKES[t * 2 + k] = e * 32768 + slot; TOKW[t * 2 + k] = r_w[tid]; LTOK[e * 32768 + slot] = (int)t; }
                __syncthreads();
            }
        }
        PH_END();
        if (PH_ON()) { DECL_PTRS();
            LAS int* tile_e = (LAS int*)(lds + LDS_MISC); LAS int* rb = tile_e + 320; LAS int* nt_p = tile_e + 400;
            moe_tables(ctl, l, tile_e, rb, nt_p, tid);
            const int nR = nt_p[0];
            pg8::Gemm g{H, W13, nR * 256, 1024, 1024, (size_t)1024 * 1024 * 2}; MoeOrder Mo{4, nR * 4, G, c, tile_e};
            EpiSwiGLU E{HID}; MoeRows RW{rb, LTOK};
            { PROBE_WRAP(MoeOrder, Mo); pg8::gemm_phase<EpiSwiGLU, PROBE_SCHED(MoeOrder), true, true, MoeRows>(glds, g, PS_, E, tid, RW); }
        }
        PH_END();
        if (PH_ON()) { DECL_PTRS();
            LAS int* tile_e = (LAS int*)(lds + LDS_MISC); LAS int* rb = tile_e + 320; LAS int* nt_p = tile_e + 400;
            moe_tables(ctl, l, tile_e, rb, nt_p, tid);
            const int nR = nt_p[0];
            pg8::Gemm g{HID, W2, nR * 256, 1024, 512, (size_t)1024 * 512 * 2}; MoeOrder Mo{4, nR * 4, G, c, tile_e};
            EpiPlain E{Y, 1024};
            { PROBE_WRAP(MoeOrder, Mo); pg8::gemm_phase<EpiPlain, PROBE_SCHED(MoeOrder), true, true>(glds, g, PS_, E, tid); }
        }
        PH_END();
        if (PH_ON()) { DECL_PTRS();
            LAS int* tile_e = (LAS int*)(lds + LDS_MISC); LAS int* rb = tile_e + 320; LAS int* nt_p = tile_e + 400;
            moe_tables(ctl, l, tile_e, rb, nt_p, tid);
            constexpr int RJ = 4;
            for (int t0 = gw * RJ; t0 < T; t0 += NGW * RJ) {
                const int b = t0 / S; const float* mo = MOD + (size_t)(l * 2 + b) * 6144;
                int r0[RJ], r1[RJ]; float w0[RJ], w1[RJ];
#pragma unroll
                for (int u = 0; u < RJ; ++u) { const int t = t0 + u; { const int e0_ = TOKES[2 * t], e1_ = TOKES[2 * t + 1]; r0[u] = rb[e0_ >> 15] + (e0_ & 32767); r1[u] = rb[e1_ >> 15] + (e1_ & 32767); } w0[u] = TOKW[2 * t]; w1[u] = TOKW[2 * t + 1];
#ifdef PROBE_MASK
                    if (a.probe_var == 4 || a.probe_var == -4) { w0[u] *= 0.5f; w1[u] *= 0.5f; }
#endif
                }
                f32x4 v[RJ][4]; u32x2 ya[RJ][4], yb[RJ][4];
#pragma unroll
                for (int u = 0; u < RJ; ++u)
#pragma unroll
                    for (int j = 0; j < 4; ++j) { const int col = 4 * lane + 256 * j; { const u32x2 xw = *(const u32x2*)(XB + (size_t)(t0 + u) * 1024 + col); v[u][j] = (f32x4){bflo(xw.x), bfhi(xw.x), bflo(xw.y), bfhi(xw.y)}; }
                        ya[u][j] = *(const u32x2*)(Y + (size_t)r0[u] * 1024 + col); yb[u][j] = *(const u32x2*)(Y + (size_t)r1[u] * 1024 + col); }
                f32x4 gg[4];
#pragma unroll
                for (int j = 0; j < 4; ++j) gg[j] = *(const f32x4*)(mo + 5120 + 4 * lane + 256 * j);
                float ss[RJ];
#pragma unroll
                for (int u = 0; u < RJ; ++u) { ss[u] = 0.f;
#pragma unroll
                    for (int j = 0; j < 4; ++j) { const int col = 4 * lane + 256 * j; const f32x4 xv = v[u][j]; f32x4 nv;
                        nv.x = xv.x + gg[j].x * (w0[u] * bflo(ya[u][j].x) + w1[u] * bflo(yb[u][j].x)); nv.y = xv.y + gg[j].y * (w0[u] * bfhi(ya[u][j].x) + w1[u] * bfhi(yb[u][j].x));
                        nv.z = xv.z + gg[j].z * (w0[u] * bflo(ya[u][j].y) + w1[u] * bflo(yb[u][j].y)); nv.w = xv.w + gg[j].w * (w0[u] * bfhi(ya[u][j].y) + w1[u] * bfhi(yb[u][j].y));
                        if (l + 1 < DEPTH) { u32x2 xw; xw.x = pk2(nv.x, nv.y); xw.y = pk2(nv.z, nv.w); *(u32x2*)(XB + (size_t)(t0 + u) * 1024 + col) = xw; nv = (f32x4){bflo(xw.x), bfhi(xw.x), bflo(xw.y), bfhi(xw.y)}; }
                        else *(f32x4*)(out + (size_t)(t0 + u) * 1024 + col) = nv;
                        v[u][j] = nv; ss[u] += (nv.x * nv.x + nv.y * nv.y) + (nv.z * nv.z + nv.w * nv.w); } }
                if (l + 1 < DEPTH) {
                    const float* mn = MOD + (size_t)((l + 1) * 2 + b) * 6144;
                    f32x4 sc1[4], sh1[4];
#pragma unroll
                    for (int j = 0; j < 4; ++j) { sc1[j] = *(const f32x4*)(mn + 1024 + 4 * lane + 256 * j); sh1[j] = *(const f32x4*)(mn + 4 * lane + 256 * j); }
#pragma unroll
                    for (int u = 0; u < RJ; ++u) { const float rn = rsqrtf(wave_sum(ss[u]) * (1.0f / 1024.0f) + EPS);
#pragma unroll
                        for (int j = 0; j < 4; ++j) { const int col = 4 * lane + 256 * j;
                            u32x2 w; w.x = pk2(v[u][j].x * rn * (1.f + sc1[j].x) + sh1[j].x, v[u][j].y * rn * (1.f + sc1[j].y) + sh1[j].y); w.y = pk2(v[u][j].z * rn * (1.f + sc1[j].z) + sh1[j].z, v[u][j].w * rn * (1.f + sc1[j].w) + sh1[j].w);
                            *(u32x2*)(H + (size_t)(t0 + u) * 1024 + col) = w; } }
                }
            }
        }
        PH_END();
    }
#undef PH_ON
#undef PH_END
}

extern "C" void kernel_launch(void* const* d_in, const int* in_sizes, int n_in, void* d_out, int out_size, void* d_ws, size_t ws_size, hipStream_t stream) {
    static int grid = 0;
    if (grid == 0) {
        if (n_in != 37 || out_size != T * D || ws_size < WS_END) { fprintf(stderr, "kernel_launch: unexpected shapes (n_in %d, out %d, ws %zu); nothing launched\n", n_in, out_size, ws_size); grid = -1; return; }
        int dev = 0, cus = 0, per_cu = 0;
        if (hipGetDevice(&dev) != hipSuccess || hipDeviceGetAttribute(&cus, hipDeviceAttributeMultiprocessorCount, dev) != hipSuccess) { grid = -1; return; }
        if (hipFuncSetAttribute((const void*)fwd, hipFuncAttributeMaxDynamicSharedMemorySize, LDS_BYTES) != hipSuccess) { fprintf(stderr, "kernel_launch: hipFuncSetAttribute failed\n"); grid = -1; return; }
        if (hipOccupancyMaxActiveBlocksPerMultiprocessor(&per_cu, (const void*)fwd, NTHREADS, LDS_BYTES) != hipSuccess || per_cu < 1) fprintf(stderr, "kernel_launch: occupancy query says %d\n", per_cu);
        (void)hipGetLastError();
        grid = cus;
    }
    if (grid < 0) return;
    if (hipMemsetAsync((char*)d_ws + WS_CTL, 0, CTL_ZERO_BYTES, stream) != hipSuccess) return;
    Args a{};
    for (int i = 0; i < 37; ++i) a.in[i] = d_in[i];
    a.out = (float*)d_out; a.ws = (unsigned char*)d_ws;
#ifdef PROBE_MASK
#ifndef PROBE_VAR
#define PROBE_VAR 0
#endif
    {
        int types[N_PHASES]; int n = 0; types[n++] = 0; types[n++] = 1; types[n++] = 2;
        for (int l = 0; l < DEPTH; ++l) { if ((l & 1) == 0) { for (int k = 3; k <= 7; ++k) if (k != 4 && k != 6) types[n++] = k; } else { for (int k = 8; k <= 13; ++k) if (k != 9) types[n++] = k; } for (int k = 14; k <= 19; ++k) if (k != 16) types[n++] = k; }
        for (int p = 0; p < N_PHASES; ++p) { a.ph_lo = p; a.ph_hi = p + 1; const int reps = ((PROBE_MASK >> types[p]) & 1) ? 2 : 1;
            for (int r = 0; r < reps; ++r) { a.probe_var = (reps == 2) ? ((r == 0) ? PROBE_VAR : -PROBE_VAR) : 0; hipLaunchKernelGGL(fwd, dim3(grid), dim3(NTHREADS), LDS_BYTES, stream, a); } }
    }
#elif MK_ONE_LAUNCH
    a.ph_lo = 0; a.ph_hi = N_PHASES;
    hipLaunchKernelGGL(fwd, dim3(grid), dim3(NTHREADS), LDS_BYTES, stream, a);
#else
    for (int p = 0; p < N_PHASES; ++p) { a.ph_lo = p; a.ph_hi = p + 1; hipLaunchKernelGGL(fwd, dim3(grid), dim3(NTHREADS), LDS_BYTES, stream, a); }
#endif
}
```

```cpp
#include <hip/hip_runtime.h>
#include <cstdio>
#include <cstdint>
#include <hip/hip_bf16.h>
#include <cmath>
#ifndef MK_ONE_LAUNCH
#define MK_ONE_LAUNCH 1
#endif
namespace pg8 {
#define PG8_LAS __attribute__((address_space(3)))
typedef unsigned short bf16_t;
typedef short bf16x8 __attribute__((ext_vector_type(8)));
typedef float f32x4 __attribute__((ext_vector_type(4)));
typedef unsigned u32x4 __attribute__((ext_vector_type(4)));
constexpr int BM = 256, BK = 64, HALF = 128, HTB = HALF * BK * 2  , STAGE_BYTES = 8 * HTB, NXCD = 8, WGM = 8;

__host__ __device__ __forceinline__ int lds_byte(int r, int c) { const int st = (r >> 4) * 2 + (c >> 5), rr = r & 15, cc = c & 31, ob = rr * 64 + cc * 2; return st * 1024 + (ob ^ (((ob >> 9) & 1) << 5)); }
__host__ __device__ __forceinline__ void stage_rc(int b, int& R, int& C) { const int st = b / 1024, sb = b % 1024, swz = sb ^ (((sb >> 9) & 1) << 5); R = (st >> 1) * 16 + swz / 64; C = (st & 1) * 32 + (swz % 64) / 2; }
__host__ __device__ __forceinline__ int perm32(int rho) { const int n = rho >> 4, i = rho & 15; return 8 * (i >> 2) + 4 * n + (i & 3); }

struct Unit { int pm, pn, be; };
struct Gemm { const bf16_t* A; const bf16_t* Bt; int M, N, K; size_t bstride; };

struct StaticOrder {
    int nM, nN, nwg, G, c;
    __host__ __device__ void init(int M, int N, int G_, int c_) { nM = M / BM; nN = N / BM; nwg = nM * nN; G = G_; c = c_; }
    __host__ __device__ bool next(int i, Unit& u) const {
        const long L = (long)i * G + c; if (L >= nwg) return false;
        int wgid = (int)L; { const int q = nwg / NXCD, r = nwg % NXCD, xcd = wgid % NXCD, off = wgid / NXCD; wgid = (xcd < r ? xcd * (q + 1) : r * (q + 1) + (xcd - r) * q) + off; }
        const int nig = WGM * nN, gid = wgid / nig, fm = gid * WGM, gsz = (nM - fm) < WGM ? (nM - fm) : WGM;
        u.pm = fm + ((wgid % nig) % gsz); u.pn = (wgid % nig) / gsz; u.be = 0; return true;
    }
    __device__ __forceinline__ void a_ready(const Unit&) const {}
    __device__ __forceinline__ void done(const Unit&) const {}
};

__device__ __forceinline__ unsigned cvt_pk_bf16(float lo, float hi) { unsigned r; asm volatile("v_cvt_pk_bf16_f32 %0, %1, %2" : "=v"(r) : "v"(lo), "v"(hi)); return r; }
typedef float f32x2 __attribute__((ext_vector_type(2)));
struct NoRows { static constexpr bool GATHER = false; __device__ __forceinline__ unsigned operator()(const Unit&, int) const { return 0u; } };
template <class Epi, class Sched, bool ALIGN_EPI = false, bool SP2 = false, class Rows = NoRows>
__device__ __forceinline__ void gemm_phase(PG8_LAS unsigned char* lds, const Gemm g, const Sched& S, const Epi& E, const int tid_in, const Rows& RW = Rows()) {
    const int tid = tid_in, wid = __builtin_amdgcn_readfirstlane(tid >> 6), lane = tid & 63, wr = wid >> 2, wc = wid & 3, fr = lane & 15, fq = lane >> 4;
    const int K = g.K, nt = K / BK;
    unsigned voffA[2], voffB[2];
#pragma unroll
    for (int i = 0; i < 2; ++i) { int R, C; stage_rc(tid * 16 + i * 8192, R, C); const int Rb = Epi::PERM ? ((R & ~31) + perm32(R & 31)) : R;
        voffA[i] = (unsigned)(R * K + C) * 2u; voffB[i] = (unsigned)(Rb * K + C) * 2u; }
    const size_t kstep = (size_t)(BK * 2);
    const size_t hstep = (size_t)HALF * K * 2;
    const size_t tstep = 2 * hstep;
    const unsigned ldsw = (unsigned)wid * 1024u;
    const int aoff = lds_byte(wr * 64 + fr, fq * 8), boff = lds_byte(wc * 32 + fr, fq * 8);
#define PG8_SA(b, h) (((b) * 2 + (h)) * HTB)
#define PG8_SB(b, h) ((4 + (b) * 2 + (h)) * HTB)
#define PG8_STAGE(bufoff, gbase, voff) do { _Pragma("unroll") for (int _i = 0; _i < 2; ++_i) \
        __builtin_amdgcn_global_load_lds((const unsigned*)((const char*)(gbase) + (voff)[_i]), (PG8_LAS unsigned*)(lds + (bufoff) + ldsw + _i * 8192), 16, 0, 0); } while (0)
#define PG8_LDA(dst, b, h) do { _Pragma("unroll") for (int m = 0; m < 4; ++m) _Pragma("unroll") for (int k = 0; k < 2; ++k) dst[m][k] = *(const PG8_LAS bf16x8*)(lds + PG8_SA(b, h) + aoff + m * 2048 + k * 1024); } while (0)
#define PG8_LDB(dst, b, h) do { _Pragma("unroll") for (int n = 0; n < 2; ++n) _Pragma("unroll") for (int k = 0; k < 2; ++k) dst[n][k] = *(const PG8_LAS bf16x8*)(lds + PG8_SB(b, h) + boff + n * 2048 + k * 1024); } while (0)
#define PG8_MMA(ai, bj, At, Bt) do { __builtin_amdgcn_s_setprio(1); _Pragma("unroll") for (int m = 0; m < 4; ++m) _Pragma("unroll") for (int n = 0; n < 2; ++n) _Pragma("unroll") for (int k = 0; k < 2; ++k) \
        acc[ai][bj][m][n] = __builtin_amdgcn_mfma_f32_16x16x32_bf16(Bt[n][k], At[m][k], acc[ai][bj][m][n], 0, 0, 0); __builtin_amdgcn_s_setprio(0); } while (0)
#define PG8_WAIT_V(n) asm volatile("s_waitcnt vmcnt(" #n ")" ::: "memory")
#define PG8_WAIT_L(n) asm volatile("s_waitcnt lgkmcnt(" #n ")" ::: "memory")
#define PG8_BAR __builtin_amdgcn_s_barrier()
#define PG8_SCHED __builtin_amdgcn_sched_barrier(0)
    Unit cur, nxt; int ui = 0;
    if (!S.next(0, cur)) return;
    f32x4 acc[2][2][4][2];
#pragma unroll
    for (int a = 0; a < 2; ++a)
#pragma unroll
        for (int b = 0; b < 2; ++b)
#pragma unroll
            for (int m = 0; m < 4; ++m)
#pragma unroll
                for (int n = 0; n < 2; ++n) { float z0_ = 0.f; asm volatile("" : "+v"(z0_)); acc[a][b][m][n] = (f32x4){z0_, z0_, z0_, z0_}; }
    bf16x8 At[4][2], B0[2][2], B1[2][2];
    const char* cA = Rows::GATHER ? (const char*)g.A : (const char*)g.A + (size_t)cur.pm * tstep; const char* cB = (const char*)g.Bt + (size_t)cur.be * g.bstride + (size_t)cur.pn * tstep;
    int Rr[2], Cc[2];
#pragma unroll
    for (int i = 0; i < 2; ++i) stage_rc(tid * 16 + i * 8192, Rr[i], Cc[i]);
    unsigned voffAh[2][2], voffAn[2][2];
#pragma unroll
    for (int h = 0; h < 2; ++h)
#pragma unroll
        for (int i = 0; i < 2; ++i) { voffAh[h][i] = Rows::GATHER ? RW(cur, h * HALF + Rr[i]) + (unsigned)Cc[i] * 2u : voffA[i] + (unsigned)h * (unsigned)hstep; voffAn[h][i] = voffAh[h][i]; }
    S.a_ready(cur);
    if constexpr (SP2) {
        PG8_STAGE(PG8_SB(0, 0), cB, voffB); PG8_STAGE(PG8_SB(0, 1), cB + hstep, voffB); PG8_STAGE(PG8_SA(0, 0), cA, voffAh[0]); PG8_STAGE(PG8_SA(0, 1), cA, voffAh[1]);
        if (wr == 1) PG8_BAR;
        PG8_WAIT_V(2); PG8_BAR;
        PG8_STAGE(PG8_SB(1, 0), cB + kstep, voffB); PG8_STAGE(PG8_SA(1, 0), cA + kstep, voffAh[0]); PG8_STAGE(PG8_SB(1, 1), cB + hstep + kstep, voffB);
        PG8_WAIT_V(6); PG8_BAR;
    } else {
        PG8_STAGE(PG8_SB(0, 0), cB, voffB); PG8_STAGE(PG8_SA(0, 0), cA, voffAh[0]); PG8_STAGE(PG8_SB(0, 1), cB + hstep, voffB); PG8_STAGE(PG8_SA(0, 1), cA, voffAh[1]);
        if (wr == 1) PG8_BAR;
        PG8_WAIT_V(4); PG8_BAR;
        PG8_STAGE(PG8_SB(1, 0), cB + kstep, voffB); PG8_STAGE(PG8_SA(1, 0), cA + kstep, voffAh[0]); PG8_STAGE(PG8_SB(1, 1), cB + hstep + kstep, voffB);
        PG8_WAIT_V(6); PG8_BAR;
    }
    for (;;) {
        const bool has_next = S.next(ui + 1, nxt);
        const char* nA = Rows::GATHER ? (const char*)g.A : (has_next ? (const char*)g.A + (size_t)nxt.pm * tstep : cA);
        if constexpr (Rows::GATHER) { if (has_next) {
#pragma unroll
            for (int h = 0; h < 2; ++h)
#pragma unroll
                for (int i = 0; i < 2; ++i) voffAn[h][i] = RW(nxt, h * HALF + Rr[i]) + (unsigned)Cc[i] * 2u; } } const char* nB = has_next ? (const char*)g.Bt + (size_t)nxt.be * g.bstride + (size_t)nxt.pn * tstep : cB;
        for (int t = 0; t < nt; t += 2) {
            const bool last = (t == nt - 2); const bool gsel = Rows::GATHER && last && has_next;
            const char* a1 = cA + (size_t)(t + 1) * kstep;
            const char* a2 = last ? nA : cA + (size_t)(t + 2) * kstep; const char* b2 = last ? nB : cB + (size_t)(t + 2) * kstep;
            const char* a3 = a2 + kstep; const char* b3 = b2 + kstep;
            if (last && has_next) S.a_ready(nxt);
            if constexpr (SP2) {
            PG8_LDB(B0, 0, 0); PG8_LDB(B1, 0, 1); PG8_SCHED; PG8_LDA(At, 0, 0); PG8_STAGE(PG8_SA(1, 1), a1, voffAh[1]);
            PG8_WAIT_V(8); PG8_WAIT_L(0); PG8_BAR; PG8_MMA(0, 0, At, B0); PG8_MMA(0, 1, At, B1); PG8_BAR; PG8_SCHED;
            PG8_LDA(At, 0, 1); PG8_STAGE(PG8_SB(0, 0), b2, voffB); PG8_STAGE(PG8_SB(0, 1), b2 + hstep, voffB); PG8_STAGE(PG8_SA(0, 0), a2, (gsel ? voffAn[0] : voffAh[0]));
            PG8_WAIT_V(8); PG8_WAIT_L(0); PG8_BAR; PG8_MMA(1, 0, At, B0); PG8_MMA(1, 1, At, B1); PG8_BAR; PG8_SCHED;
            PG8_LDB(B0, 1, 0); PG8_LDB(B1, 1, 1); PG8_SCHED; PG8_LDA(At, 1, 0); PG8_STAGE(PG8_SA(0, 1), a2, (gsel ? voffAn[1] : voffAh[1]));
            PG8_WAIT_V(8); PG8_WAIT_L(0); PG8_BAR; PG8_MMA(0, 0, At, B0); PG8_MMA(0, 1, At, B1); PG8_BAR; PG8_SCHED;
            PG8_LDA(At, 1, 1); PG8_STAGE(PG8_SB(1, 0), b3, voffB); PG8_STAGE(PG8_SB(1, 1), b3 + hstep, voffB); PG8_STAGE(PG8_SA(1, 0), a3, (gsel ? voffAn[0] : voffAh[0]));
            PG8_WAIT_V(8); PG8_WAIT_L(0); PG8_BAR; PG8_MMA(1, 0, At, B0); PG8_MMA(1, 1, At, B1); PG8_BAR; PG8_SCHED;
            } else {
            PG8_LDB(B0, 0, 0); PG8_SCHED; PG8_LDA(At, 0, 0); PG8_STAGE(PG8_SA(1, 1), a1, voffAh[1]);
            PG8_WAIT_L(8); PG8_BAR; PG8_WAIT_L(0); PG8_MMA(0, 0, At, B0); PG8_BAR; PG8_SCHED;
            PG8_LDB(B1, 0, 1); PG8_STAGE(PG8_SB(0, 0), b2, voffB);
            PG8_BAR; PG8_WAIT_L(0); PG8_MMA(0, 1, At, B1); PG8_BAR;
            PG8_LDA(At, 0, 1); PG8_STAGE(PG8_SA(0, 0), a2, (gsel ? voffAn[0] : voffAh[0]));
            PG8_BAR; PG8_WAIT_L(0); PG8_MMA(1, 0, At, B0); PG8_BAR; PG8_SCHED;
            PG8_STAGE(PG8_SB(0, 1), b2 + hstep, voffB);
            PG8_WAIT_V(6); PG8_BAR; PG8_MMA(1, 1, At, B1); PG8_BAR;
            PG8_LDB(B0, 1, 0); PG8_SCHED; PG8_LDA(At, 1, 0); PG8_STAGE(PG8_SA(0, 1), a2, (gsel ? voffAn[1] : voffAh[1]));
            PG8_WAIT_L(8); PG8_BAR; PG8_WAIT_L(0); PG8_MMA(0, 0, At, B0); PG8_BAR; PG8_SCHED;
            PG8_LDB(B1, 1, 1); PG8_STAGE(PG8_SB(1, 0), b3, voffB);
            PG8_BAR; PG8_WAIT_L(0); PG8_MMA(0, 1, At, B1); PG8_BAR;
            PG8_LDA(At, 1, 1); PG8_STAGE(PG8_SA(1, 0), a3, (gsel ? voffAn[0] : voffAh[0]));
            PG8_BAR; PG8_WAIT_L(0); PG8_MMA(1, 0, At, B0); PG8_BAR; PG8_SCHED;
            PG8_STAGE(PG8_SB(1, 1), b3 + hstep, voffB);
            PG8_WAIT_V(6); PG8_BAR; PG8_MMA(1, 1, At, B1); PG8_BAR;
            }
        }
        if constexpr (ALIGN_EPI) { if (wr == 0) PG8_BAR; }
        if constexpr (!Epi::AFTER_DRAIN) { int l2_; asm volatile("v_mbcnt_lo_u32_b32 %0, -1, 0\n\tv_mbcnt_hi_u32_b32 %0, -1, %0" : "=v"(l2_)); E(acc, cur, wr, wc, l2_ & 15, l2_ >> 4); S.done(cur); }
        if (!has_next) break;
#pragma unroll
        for (int a = 0; a < 2; ++a)
#pragma unroll
            for (int b = 0; b < 2; ++b)
#pragma unroll
                for (int m = 0; m < 4; ++m)
#pragma unroll
                    for (int n = 0; n < 2; ++n) { float z0_ = 0.f; asm volatile("" : "+v"(z0_)); acc[a][b][m][n] = (f32x4){z0_, z0_, z0_, z0_}; }
        cur = nxt; cA = nA; cB = nB; ++ui;
        if constexpr (Rows::GATHER) {
#pragma unroll
            for (int h = 0; h < 2; ++h)
#pragma unroll
                for (int i = 0; i < 2; ++i) voffAh[h][i] = voffAn[h][i]; }
        if constexpr (ALIGN_EPI) { if (wr == 1) PG8_BAR; }
    }
    PG8_WAIT_V(0);
    if constexpr (!ALIGN_EPI) { if (wr == 0) PG8_BAR; }
    PG8_BAR;
    if constexpr (Epi::AFTER_DRAIN) { E.fused(acc, cur, wr, wc, fr, fq, lds, wid, lane); S.done(cur); }
#undef PG8_SA
#undef PG8_SB
#undef PG8_STAGE
#undef PG8_LDA
#undef PG8_LDB
#undef PG8_MMA
#undef PG8_WAIT_V
#undef PG8_WAIT_L
#undef PG8_BAR
#undef PG8_SCHED
}
}
namespace attn_body {
using bf16=__hip_bfloat16;
using bf16x8=__attribute__((ext_vector_type(8)))short;
using s16x4=__attribute__((ext_vector_type(4)))short;
using f32x16=__attribute__((ext_vector_type(16)))float;
using u32x4=__attribute__((ext_vector_type(4)))unsigned;
constexpr int D=64;
constexpr int NW=8,QBLK=32,QB=QBLK*NW,KVBLK=64;
constexpr int ATTN_UNIT_ROWS=QB;
__device__ __forceinline__ int crow(int r,int hi){return (r&3)+8*(r>>2)+4*hi;}
#define SBAR() __builtin_amdgcn_sched_barrier(0)
__device__ __forceinline__ void cmask(f32x16&p0,f32x16&p1,int jb,int qrel,int hi){
  const float NEG=-INFINITY; int kb=64*jb+4*hi;
  #pragma unroll
  for(int r=0;r<16;++r){int kv=kb+(r&3)+8*(r>>2); if(kv>qrel)p0[r]=NEG; if(kv+32>qrel)p1[r]=NEG;}
}

constexpr int NSLOT=3, SLOTB=8192;
constexpr int LDS_K=0, LDS_V=NSLOT*SLOTB, LDS_WS=2*NSLOT*SLOTB, LDS_OST=LDS_WS+NW*64*4, LDS_BYTES=LDS_OST+NW*4096;
constexpr float C2=0.125f*1.4426950408889634f;
__device__ __forceinline__ void glds16(const void*gsrc,unsigned lds_dst){unsigned keep;
  asm volatile("s_mov_b32 %0, m0\n\ts_mov_b32 m0, %2\n\ts_nop 0\n\tglobal_load_lds_dwordx4 %1, off\n\ts_mov_b32 m0, %0":"=&s"(keep):"v"(gsrc),"s"(lds_dst):"memory");}
__device__ __forceinline__ float max3f(float a,float b,float c){float r;asm("v_max3_f32 %0, %1, %2, %3":"=v"(r):"v"(a),"v"(b),"v"(c));return r;}
__device__ __forceinline__ float max2f(float a,float b){float r;asm("v_max_f32_e32 %0, %1, %2":"=v"(r):"v"(a),"v"(b));return r;}
__device__ __forceinline__ float fadd_s(float a,float b){float r;asm("v_add_f32_e32 %0, %1, %2":"=v"(r):"v"(a),"v"(b));return r;}
__device__ __forceinline__ float fsub_s(float a,float b){float r;asm("v_sub_f32_e32 %0, %1, %2":"=v"(r):"v"(a),"v"(b));return r;}
typedef float f32x2_t __attribute__((ext_vector_type(2))); typedef __bf16 bf16x2_t __attribute__((ext_vector_type(2)));
__device__ __forceinline__ unsigned cvtpk_s(float lo,float hi){f32x2_t v={lo,hi};bf16x2_t b=__builtin_convertvector(v,bf16x2_t);return __builtin_bit_cast(unsigned,b);}
#define WAIT_BAR(N) asm volatile("s_waitcnt vmcnt(" #N ") lgkmcnt(0)\n\ts_barrier":::"memory")

__device__ __forceinline__ void qkt(f32x16&p0,f32x16&p1,const char*Kslot,const bf16x8*qr,const f32x16&negm,int r32,int hi){
  const char*kb=Kslot+hi*1024+r32*16;
  #pragma unroll
  for(int d0=0;d0<4;++d0){
    const bf16x8 b0=*reinterpret_cast<const bf16x8*>(kb+d0*2048);
    const bf16x8 b1=*reinterpret_cast<const bf16x8*>(kb+d0*2048+512);
    if(d0==0){p0=__builtin_amdgcn_mfma_f32_32x32x16_bf16(b0,qr[0],negm,0,0,0);p1=__builtin_amdgcn_mfma_f32_32x32x16_bf16(b1,qr[0],negm,0,0,0);}
    else{p0=__builtin_amdgcn_mfma_f32_32x32x16_bf16(b0,qr[d0],p0,0,0,0);p1=__builtin_amdgcn_mfma_f32_32x32x16_bf16(b1,qr[d0],p1,0,0,0);}}
}
typedef __attribute__((address_space(3))) const char* lds_cptr;
typedef short v4i16_t __attribute__((ext_vector_type(4)));
__device__ __forceinline__ void kload8(bf16x8*kf,lds_cptr kp){
  kf[0]=*(const __attribute__((address_space(3))) bf16x8*)(kp);      kf[1]=*(const __attribute__((address_space(3))) bf16x8*)(kp+512);
  kf[2]=*(const __attribute__((address_space(3))) bf16x8*)(kp+2048); kf[3]=*(const __attribute__((address_space(3))) bf16x8*)(kp+2560);
  kf[4]=*(const __attribute__((address_space(3))) bf16x8*)(kp+4096); kf[5]=*(const __attribute__((address_space(3))) bf16x8*)(kp+4608);
  kf[6]=*(const __attribute__((address_space(3))) bf16x8*)(kp+6144); kf[7]=*(const __attribute__((address_space(3))) bf16x8*)(kp+6656);
}
__device__ __forceinline__ void kload2(bf16x8*kf,lds_cptr kp,int j){ kf[2*j]=*(const __attribute__((address_space(3))) bf16x8*)(kp+j*2048); kf[2*j+1]=*(const __attribute__((address_space(3))) bf16x8*)(kp+j*2048+512); }
__device__ __forceinline__ s16x4 vtr(lds_cptr p){ return __builtin_bit_cast(s16x4,__builtin_amdgcn_ds_read_tr16_b64_v4i16((__attribute__((address_space(3))) v4i16_t*)p)); }
__device__ __forceinline__ float rowmax(const f32x16&p0,const f32x16&p1){
  float a=max3f(p0[0],p0[1],p1[0]),b=max3f(p0[2],p0[3],p1[1]);a=max3f(a,p1[2],p1[3]);
  #pragma unroll
  for(int r=4;r<16;r+=4){a=max3f(a,p0[r],p0[r+1]);b=max3f(b,p0[r+2],p0[r+3]);a=max3f(a,p1[r],p1[r+1]);b=max3f(b,p1[r+2],p1[r+3]);}
  const float m=max2f(a,b);
  auto rr=__builtin_amdgcn_permlane32_swap(__float_as_uint(m),__float_as_uint(m),false,false);
  return max2f(__uint_as_float(rr[0]),__uint_as_float(rr[1]));
}
__device__ __forceinline__ void pv(f32x16*o,int vb,bf16x8 pa0,bf16x8 pa1,bf16x8 pa2,bf16x8 pa3){
  #pragma unroll
  for(int d0=0;d0<2;++d0){s16x4 lo[4],hi[4];
    #pragma unroll
    for(int ks=0;ks<4;++ks){
      asm volatile("ds_read_b64_tr_b16 %0,%1 offset:%c2":"=&v"(lo[ks]):"v"(vb),"i"(d0*4096+ks*1024):"memory");
      asm volatile("ds_read_b64_tr_b16 %0,%1 offset:%c2":"=&v"(hi[ks]):"v"(vb),"i"(d0*4096+ks*1024+512):"memory");}
    asm volatile("s_waitcnt lgkmcnt(0)":::"memory");SBAR();
    #define PK(k) (bf16x8){lo[k][0],lo[k][1],lo[k][2],lo[k][3],hi[k][0],hi[k][1],hi[k][2],hi[k][3]}
    o[d0]=__builtin_amdgcn_mfma_f32_32x32x16_bf16(pa0,PK(0),o[d0],0,0,0);
    o[d0]=__builtin_amdgcn_mfma_f32_32x32x16_bf16(pa1,PK(1),o[d0],0,0,0);
    o[d0]=__builtin_amdgcn_mfma_f32_32x32x16_bf16(pa2,PK(2),o[d0],0,0,0);
    o[d0]=__builtin_amdgcn_mfma_f32_32x32x16_bf16(pa3,PK(3),o[d0],0,0,0);
    #undef PK
  }
}

#ifndef ATTN_STORE16
#define ATTN_STORE16(p,v) (*(u32x4*)(p)=(v))
#endif
template<int THRL,int PIN,int POUT> __device__ __forceinline__ void attn_unit(int qb,const bf16*Qh,const bf16*__restrict__ Kh,const bf16*__restrict__ Vh,bf16*Oh,char*shm,const int wid_in){
  constexpr int DM=PIN;
  int lane; asm volatile("v_mbcnt_lo_u32_b32 %0, -1, 0\n\tv_mbcnt_hi_u32_b32 %0, -1, %0" : "=v"(lane));
  const int wid=wid_in; const int tid=wid*64+lane; const int r32=lane&31,hi=lane>>5;
  const int q0=qb*QB;
  const bf16*Qw=Qh+(long)(q0+wid*QBLK)*DM;
  const unsigned lds0=(unsigned)(uintptr_t)shm;
  float*wsf=(float*)(shm+LDS_WS)+wid*64;
  const bf16*ksrc=Kh+(long)lane*DM+wid*8;
  const bf16*vsrc=Vh+(long)(16*(wid&3)+(lane>>2))*DM+(wid>>2)*32+(lane&3)*8;
  const unsigned kdst=lds0+LDS_K+wid*1024, vdst=lds0+LDS_V+wid*1024;
  #define DMA_K(t,slot) glds16(ksrc+(long)(t)*KVBLK*DM,(unsigned)__builtin_amdgcn_readfirstlane(kdst+(slot)))
  #define DMA_V(t,slot) glds16(vsrc+(long)(t)*KVBLK*DM,(unsigned)__builtin_amdgcn_readfirstlane(vdst+(slot)))
  const int vb0=(int)(lds0+LDS_V)+((lane>>4)&1)*32+(lane&3)*8+(4*hi+((lane&15)>>2))*64;
  const char*Kbase=shm+LDS_K; bf16x8 kf[8];
  const lds_cptr shm3=(lds_cptr)shm; const lds_cptr kp0=shm3+LDS_K+hi*1024+r32*16; const lds_cptr vp0=shm3+LDS_V+((lane>>4)&1)*32+(lane&3)*8+(4*hi+((lane&15)>>2))*64;
  const int NT=(q0+QB)/KVBLK;
  DMA_K(0,0);DMA_V(0,0);DMA_K(1,SLOTB);
  bf16x8 qr[4];
  #pragma unroll
  for(int d0=0;d0<4;++d0)qr[d0]=*reinterpret_cast<const bf16x8*>(&Qw[(long)r32*DM+d0*16+hi*8]);
  float mhat=0.f,l_reg=0.f;f32x16 o[2];f32x16 negm;{float z0_=0.f;asm volatile("":"+v"(z0_));
  #pragma unroll
  for(int r=0;r<16;++r){o[0][r]=z0_;o[1][r]=z0_;negm[r]=z0_;}}asm volatile("":"+v"(negm));
  const int qrel=wid*QBLK+r32;
  #define CMASK(P0,P1,t) do{int jb_=(t)-(NT-4); if(jb_>=0)cmask(P0,P1,jb_,qrel,hi);}while(0)
  bool resc=false;
  #define START(P0,P1) do{ const float rm=rowmax(P0,P1); resc=false; \
    { const float dl=rm; mhat=fadd_s(mhat,dl); \
      _Pragma("unroll") for(int r=0;r<16;++r){P0[r]=fsub_s(P0[r],dl);P1[r]=fsub_s(P1[r],dl);} \
      _Pragma("unroll") for(int r=0;r<16;++r)negm[r]=-mhat; asm volatile("":"+v"(negm)); } \
    _Pragma("unroll") for(int r=0;r<16;++r)P0[r]=__builtin_amdgcn_exp2f(P0[r]); }while(0)
  #define RESC() do{ if(resc){ asm volatile("s_waitcnt lgkmcnt(0)":::"memory"); \
      _Pragma("unroll") for(int d_=0;d_<2;++d_) _Pragma("unroll") for(int r=0;r<16;++r)o[d_][r]*=wsf[crow(r,hi)]; } }while(0)
  f32x16 pA0,pA1,pB0,pB1;
  int sl_prev=0,sl_cur=0,sl_next=SLOTB;
  #define ROT() do{sl_prev=sl_cur;sl_cur=sl_next;sl_next=(sl_next==(NSLOT-1)*SLOTB)?0:sl_next+SLOTB;}while(0)
  DMA_K(2,2*SLOTB);
  WAIT_BAR(3);
  qkt(pA0,pA1,Kbase,qr,negm,r32,hi);asm volatile("s_nop 15\n\ts_nop 7":"+v"(pA0),"+v"(pA1));CMASK(pA0,pA1,0);
  START(pA0,pA1);
  _Pragma("unroll") for(int r=0;r<16;++r)pA1[r]=__builtin_amdgcn_exp2f(pA1[r]);
  WAIT_BAR(0);
  DMA_K(3,0);DMA_V(1,SLOTB);
  ROT();
  kload8(kf,kp0+sl_cur);
  WAIT_BAR(2);
  s16x4 vlo[8],vhi[8]; u32x4 pw0,pw1,pw2,pw3;
  #define PKW(P,B) cvtpk_s(P[B],P[B+1])
  #define PAF(k) __builtin_bit_cast(bf16x8,pw##k)
  #define VFR(i) (bf16x8){vlo[i][0],vlo[i][1],vlo[i][2],vlo[i][3],vhi[i][0],vhi[i][1],vhi[i][2],vhi[i][3]}
  #define PIN(x) asm volatile("":"+v"(x))
  #define MX3(a,b,c) __builtin_fmaxf(__builtin_fmaxf((a),(b)),(c))
  #define GAPA(MF,A0,A1,A2,A3,W0,W1,PW) do{ MF; sacc+=A0; sacc+=A1; sacc+=A2; sacc+=A3; PIN(sacc); W0; W1; PIN(PW); SBAR(); }while(0)
  #define EX(v) __builtin_amdgcn_exp2f(v)
  #define GAPB(MF,X,B) do{ MF; X[B]=EX(X[B]); X[B+1]=EX(X[B+1]); X[B+2]=EX(X[B+2]); X[B+3]=EX(X[B+3]); PIN(X); SBAR(); }while(0)
  #define VRD(i) do{ vlo[i]=vtr(vp_+(((i)>>2)*4096+((i)&3)*1024)); vhi[i]=vtr(vp_+(((i)>>2)*4096+((i)&3)*1024+512)); }while(0)
  #define KRD(G,j) do{ if(G){ kload2(kf,kp0+sl_next,j); SBAR(); } }while(0)
  #define STEP(C0,C1,P0,P1,t,GK,GV,GL) do{ SBAR(); \
    const lds_cptr vp_=vp0+sl_prev; \
    VRD(0); SBAR(); float sacc=(P0[0]+P0[1]); \
    GAPA(C0=__builtin_amdgcn_mfma_f32_32x32x16_bf16(kf[0],qr[0],negm,0,0,0), P0[2],P0[3],P0[4],P0[5],     pw0[0]=PKW(P0,0), pw0[1]=PKW(P0,2), pw0); \
    VRD(4); SBAR(); GAPA(C1=__builtin_amdgcn_mfma_f32_32x32x16_bf16(kf[1],qr[0],negm,0,0,0), P0[6],P0[7],P0[8],P0[9],     pw0[2]=PKW(P0,4), pw0[3]=PKW(P0,6), pw0); \
    VRD(1); SBAR(); GAPA(C0=__builtin_amdgcn_mfma_f32_32x32x16_bf16(kf[2],qr[1],C0,0,0,0),   P0[10],P0[11],P0[12],P0[13], pw1[0]=PKW(P0,8), pw1[1]=PKW(P0,10), pw1); \
    VRD(5); SBAR(); GAPA(C1=__builtin_amdgcn_mfma_f32_32x32x16_bf16(kf[3],qr[1],C1,0,0,0),   P0[14],P0[15],P1[0],P1[1],   pw1[2]=PKW(P0,12),pw1[3]=PKW(P0,14), pw1); \
    VRD(2); SBAR(); GAPA(C0=__builtin_amdgcn_mfma_f32_32x32x16_bf16(kf[4],qr[2],C0,0,0,0),   P1[2],P1[3],P1[4],P1[5],     pw2[0]=PKW(P1,0), pw2[1]=PKW(P1,2), pw2); \
    VRD(6); SBAR(); GAPA(C1=__builtin_amdgcn_mfma_f32_32x32x16_bf16(kf[5],qr[2],C1,0,0,0),   P1[6],P1[7],P1[8],P1[9],     pw2[2]=PKW(P1,4), pw2[3]=PKW(P1,6), pw2); \
    VRD(3); SBAR(); GAPA(C0=__builtin_amdgcn_mfma_f32_32x32x16_bf16(kf[6],qr[3],C0,0,0,0),   P1[10],P1[11],P1[12],P1[13], pw3[0]=PKW(P1,8), pw3[1]=PKW(P1,10), pw3); \
    VRD(7); SBAR(); GAPA(C1=__builtin_amdgcn_mfma_f32_32x32x16_bf16(kf[7],qr[3],C1,0,0,0),   P1[14],P1[15],0.f,0.f,       pw3[2]=PKW(P1,12),pw3[3]=PKW(P1,14), pw3); \
    l_reg+=sacc; \
    if(GK){DMA_K((t)+3,sl_cur);} if(GV){DMA_V((t)+1,sl_next);} \
    CMASK(C0,C1,t); \
    { float a=MX3(C0[0],C0[1],C1[0]),b=MX3(C0[2],C0[3],C1[1]); a=MX3(a,C1[2],C1[3]); \
      _Pragma("unroll") for(int r=4;r<16;r+=4){a=MX3(a,C0[r],C0[r+1]);b=MX3(b,C0[r+2],C0[r+3]);a=MX3(a,C1[r],C1[r+1]);b=MX3(b,C1[r+2],C1[r+3]);} \
      float rm=__builtin_fmaxf(a,b); { auto rr=__builtin_amdgcn_permlane32_swap(__float_as_uint(rm),__float_as_uint(rm),false,false); rm=__builtin_fmaxf(__uint_as_float(rr[0]),__uint_as_float(rr[1])); } \
      resc=false; \
      if(__builtin_expect(__any(rm>(float)THRL),0)){ const float dl=__builtin_fmaxf(rm,0.f); mhat+=dl; \
        _Pragma("unroll") for(int r=0;r<16;++r){C0[r]-=dl;C1[r]-=dl;} \
        _Pragma("unroll") for(int r=0;r<16;++r)negm[r]=-mhat; asm volatile("":"+v"(negm)); \
        const float f=__builtin_amdgcn_exp2f(-dl); l_reg*=f; if(hi==0)wsf[r32]=f; resc=true; } } \
    SBAR(); \
    GAPB(o[0]=__builtin_amdgcn_mfma_f32_32x32x16_bf16(PAF(0),VFR(0),o[0],0,0,0), C0,0); \
    GAPB(o[1]=__builtin_amdgcn_mfma_f32_32x32x16_bf16(PAF(0),VFR(4),o[1],0,0,0), C0,4); \
    KRD(GL,0); GAPB(o[0]=__builtin_amdgcn_mfma_f32_32x32x16_bf16(PAF(1),VFR(1),o[0],0,0,0), C0,8); \
    KRD(GL,1); GAPB(o[1]=__builtin_amdgcn_mfma_f32_32x32x16_bf16(PAF(1),VFR(5),o[1],0,0,0), C0,12); \
    KRD(GL,2); GAPB(o[0]=__builtin_amdgcn_mfma_f32_32x32x16_bf16(PAF(2),VFR(2),o[0],0,0,0), C1,0); \
    KRD(GL,3); GAPB(o[1]=__builtin_amdgcn_mfma_f32_32x32x16_bf16(PAF(2),VFR(6),o[1],0,0,0), C1,4); \
    GAPB(o[0]=__builtin_amdgcn_mfma_f32_32x32x16_bf16(PAF(3),VFR(3),o[0],0,0,0), C1,8); \
    GAPB(o[1]=__builtin_amdgcn_mfma_f32_32x32x16_bf16(PAF(3),VFR(7),o[1],0,0,0), C1,12); \
    }while(0)
  int t=1;
  #undef CMASK
  #define CMASK(P0,P1,t) do{}while(0)
  for(;t+5<NT;t+=2){
    STEP(pB0,pB1,pA0,pA1,t,true,true,true);     WAIT_BAR(2); RESC(); ROT();
    STEP(pA0,pA1,pB0,pB1,t+1,true,true,true);   WAIT_BAR(2); RESC(); ROT();
  }
  #undef CMASK
  #define CMASK(P0,P1,t) do{int jb_=(t)-(NT-4); if(jb_>=0)cmask(P0,P1,jb_,qrel,hi);}while(0)
  #define ENDW(tt) do{ if((tt)+3<NT){WAIT_BAR(2);} else if((tt)+2<NT){WAIT_BAR(1);} else {WAIT_BAR(0);} }while(0)
  for(;t+1<NT;t+=2){
    STEP(pB0,pB1,pA0,pA1,t,(t+3<NT),(t+1<NT),(t+1<NT));       ENDW(t);   RESC(); ROT();
    STEP(pA0,pA1,pB0,pB1,t+1,(t+4<NT),(t+2<NT),(t+2<NT));     ENDW(t+1); RESC(); ROT();
  }
  STEP(pB0,pB1,pA0,pA1,NT-1,false,false,false); RESC();
  { float sacc=pB0[0]+pB0[1]; _Pragma("unroll") for(int r=2;r<16;++r)sacc+=pB0[r]; _Pragma("unroll") for(int r=0;r<16;++r)sacc+=pB1[r]; l_reg+=sacc;
    pw0=(u32x4){PKW(pB0,0),PKW(pB0,2),PKW(pB0,4),PKW(pB0,6)};pw1=(u32x4){PKW(pB0,8),PKW(pB0,10),PKW(pB0,12),PKW(pB0,14)};pw2=(u32x4){PKW(pB1,0),PKW(pB1,2),PKW(pB1,4),PKW(pB1,6)};pw3=(u32x4){PKW(pB1,8),PKW(pB1,10),PKW(pB1,12),PKW(pB1,14)};
    SBAR(); pv(o,vb0+sl_cur,PAF(0),PAF(1),PAF(2),PAF(3)); }
  #undef PKW
  #undef PAF
  #undef VFR
  #undef PIN
  #undef MX3
  #undef GAPA
  #undef GAPB
  #undef EX
  #undef VRD
  #undef KRD
  #undef STEP
  #undef ENDW
  {auto rr=__builtin_amdgcn_permlane32_swap(__float_as_uint(l_reg),__float_as_uint(l_reg),false,false);l_reg=__uint_as_float(rr[0])+__uint_as_float(rr[1]);}
  if(hi==0)wsf[32+r32]=l_reg;asm volatile("s_waitcnt lgkmcnt(0)":::"memory");
  float rli[16];
  #pragma unroll
  for(int r=0;r<16;++r)rli[r]=__builtin_amdgcn_rcpf(wsf[32+crow(r,hi)]);
  bf16*Ow=Oh+(long)(q0+wid*QBLK)*POUT;
  { bf16*stg=(bf16*)(shm+LDS_OST)+wid*2048;
    #pragma unroll
    for(int r=0;r<16;++r){const int orow=crow(r,hi);
      #pragma unroll
      for(int d0=0;d0<2;++d0)stg[orow*64+d0*32+r32]=__float2bfloat16(o[d0][r]*rli[r]);}
    asm volatile("s_waitcnt lgkmcnt(0)":::"memory");
    #pragma unroll
    for(int i=0;i<4;++i){const int row=i*8+(lane>>3),ch=lane&7; const u32x4 v=*(const u32x4*)(stg+row*64+ch*8); ATTN_STORE16(Ow+(long)row*POUT+ch*8,v);} }
  asm volatile("s_waitcnt lgkmcnt(0)\n\ts_barrier":::"memory");
  #undef DMA_K
  #undef DMA_V
  #undef CMASK
  #undef START
  #undef RESC
  #undef ROT
}
constexpr int ATTN_LDS_BYTES=LDS_BYTES;
#undef SBAR
#undef WAIT_BAR
}

#define LAS __attribute__((address_space(3)))
typedef unsigned short bf16_t;
typedef float f32x4 __attribute__((ext_vector_type(4)));
typedef unsigned u32x4 __attribute__((ext_vector_type(4)));
typedef unsigned u32x2 __attribute__((ext_vector_type(2)));
typedef float f32x2 __attribute__((ext_vector_type(2)));
typedef _Float16 f16x8 __attribute__((ext_vector_type(8)));
typedef _Float16 f16x4 __attribute__((ext_vector_type(4)));

constexpr int NB = 2, S = 16384, T = NB * S, D = 1024, DEPTH = 4;
constexpr int EV_N = 3368, EV_NP = 3584, EV_ZP = 3072, OD_N = 2048;
constexpr float EPS = 1e-6f;
constexpr float LOG2E = 1.4426950408889634f;
constexpr float QSCALE = 0.125f * LOG2E;
constexpr int NWAVES = 8, NTHREADS = 512;
constexpr int LDS_BYTES = 163840;
constexpr int LDS_MISC = 131072;
constexpr int LDS_BARW = LDS_BYTES - 64;
constexpr int LDS_PTBL = LDS_BYTES - 512;

constexpr size_t MiB = 1u << 20;
constexpr size_t WS_CTL = 0, CTL_ZERO_BYTES = 1 * MiB;
constexpr size_t WS_MOD = 1 * MiB;
constexpr size_t WS_MODP = 1 * MiB + 256 * 1024;
constexpr size_t WS_ROPE = 2 * MiB;
constexpr size_t WS_S5A = 4 * MiB;
constexpr size_t WS_S5B = 4 * MiB + 64 * 1024;
constexpr size_t WS_LAM = 6 * MiB;
constexpr size_t WS_KM = 6 * MiB + 4096;
constexpr size_t WS_WRH = 6 * MiB + 512 * 1024;
constexpr size_t WS_KMH = 7 * MiB + 512 * 1024;
constexpr size_t WS_WEVIN = 8 * MiB;
constexpr size_t WS_WEVOUT = 22 * MiB;
constexpr size_t WS_WODIN = 26 * MiB;
constexpr size_t WS_WODOUT = 34 * MiB;
constexpr size_t WS_WGLU = 38 * MiB;
constexpr size_t WS_W13 = 40 * MiB;
constexpr size_t WS_W2 = 104 * MiB;
constexpr size_t WS_H = 136 * MiB;
constexpr size_t WS_O = 200 * MiB;
constexpr size_t WS_Z = 264 * MiB;
constexpr size_t WS_XG = 264 * MiB;
constexpr size_t WS_Y = 264 * MiB;
constexpr size_t WS_HID = 408 * MiB;
constexpr size_t WS_IQ = 456 * MiB;
constexpr size_t WS_YG = 456 * MiB;
constexpr size_t WS_IKW = 488 * MiB;
constexpr size_t WS_IQH = 496 * MiB;
constexpr size_t WS_IKH = 512 * MiB;
constexpr size_t WS_IW = 514 * MiB;
constexpr size_t WS_SEL = 516 * MiB;
constexpr size_t WS_YMIX = 548 * MiB;
constexpr size_t WS_LTOK = 612 * MiB;
constexpr size_t WS_TOKES = 616 * MiB;
constexpr size_t WS_TOKW = 617 * MiB;
constexpr size_t WS_TOKROW = 618 * MiB;
constexpr size_t WS_UG = 516 * MiB;
constexpr size_t WS_S5E = 496 * MiB;
constexpr size_t WS_S5HC = 488 * MiB;
constexpr size_t WS_S5KT = 620 * MiB;
constexpr size_t WS_S5WT = 624 * MiB;
constexpr size_t WS_S5A2 = 640 * MiB;
constexpr size_t WS_S5PW = 656 * MiB;
constexpr size_t WS_MLIST = 660 * MiB;
constexpr size_t WS_MPO = 724 * MiB;
constexpr size_t WS_MML = 852 * MiB;
constexpr size_t WS_MASKW = 724 * MiB;
constexpr size_t WS_NSEL = 860 * MiB;
constexpr size_t WS_XB = 862 * MiB;
constexpr size_t WS_END = 926 * MiB;
constexpr int XG_ROWS = 73728;
constexpr int CW_BAR = 4096;
constexpr int CW_MCNT = 16384;
constexpr int CW_CNT = 8192;

#define XB_TMO      128
#define XB_XCNT(j)  (256  + 64 * (j))
#define XB_XSUB(j)  (1280 + 64 * (j))
#define XB_XGEN(j)  (2304 + 64 * (j))
#define XB_TOP      3328
#define XB_TOPGEN   3392
#define XCD_BAR_WORDS 3456
#define XB_SPIN_CAP (1u << 24)

__device__ __forceinline__ unsigned xb_ld(unsigned* p)              { return __hip_atomic_load(p, __ATOMIC_RELAXED, __HIP_MEMORY_SCOPE_AGENT); }
__device__ __forceinline__ unsigned xb_add(unsigned* p, unsigned v) { return __hip_atomic_fetch_add(p, v, __ATOMIC_RELAXED, __HIP_MEMORY_SCOPE_AGENT); }
__device__ __forceinline__ unsigned xb_xcc_id() { return (unsigned)__builtin_amdgcn_s_getreg((3 << 11) | 20) & 0xFu; }
#define XB_SPIN(cond, bar) do { unsigned _sp = 0; while (cond) { __builtin_amdgcn_s_sleep(1); \
    if ((++_sp & 255u) == 0u) { if (xb_ld(&(bar)[XB_TMO])) break; if (_sp > XB_SPIN_CAP) { atomicAdd(&(bar)[XB_TMO], 1u); break; } } } } while (0)

struct XcdBarrier { unsigned* bar; unsigned x; volatile LAS unsigned* st; };

__device__ __forceinline__ XcdBarrier xcd_barrier_post(unsigned* bar, volatile LAS unsigned* st, bool leader) {
    XcdBarrier b; b.bar = bar; b.x = xb_xcc_id(); b.st = st;
    if (leader) (void)xb_add(&bar[XB_XCNT(b.x)], 1u);
    return b;
}
__device__ __forceinline__ void xcd_barrier_complete(unsigned* bar, unsigned x, unsigned& nloc, unsigned& nx) {
    const unsigned G = gridDim.x * gridDim.y * gridDim.z;
    unsigned sum, cnt, mine, sp = 0u;
    for (;;) {
        sum = 0u; cnt = 0u; mine = 0u;
#pragma unroll
        for (unsigned j = 0; j < 16; ++j) { const unsigned c = xb_ld(&bar[XB_XCNT(j)]); sum += c; cnt += (c > 0u) ? 1u : 0u; mine = (j == x) ? c : mine; }
        if (sum == G) break;
        __builtin_amdgcn_s_sleep(1);
        if ((++sp & 255u) == 0u) { if (xb_ld(&bar[XB_TMO])) break; if (sp > XB_SPIN_CAP) { atomicAdd(&bar[XB_TMO], 1u); break; } }
    }
    nloc = mine > 0u ? mine : 1u; nx = cnt > 0u ? cnt : 1u;
}
__device__ __forceinline__ void xcd_barrier(const XcdBarrier& b, bool leader) {
    asm volatile("s_waitcnt vmcnt(0)" ::: "memory");
    __syncthreads();
    if (leader) {
        unsigned* bar = b.bar;
        __builtin_amdgcn_s_waitcnt(0);
        unsigned nloc = b.st[0], nx = b.st[1];
        if (nloc == 0u) { xcd_barrier_complete(bar, b.x, nloc, nx); b.st[0] = nloc; b.st[1] = nx; }
        const unsigned old = xb_add(&bar[XB_XSUB(b.x)], 1u);
        const unsigned gen = old / nloc;
        if (old + 1u == (gen + 1u) * nloc) {
            __builtin_amdgcn_fence(__ATOMIC_RELEASE, "agent");
            asm volatile("s_waitcnt vmcnt(0)" ::: "memory");
            const unsigned og = xb_add(&bar[XB_TOP], 1u);
            const unsigned tg = og / nx;
            if (og + 1u == (tg + 1u) * nx) xb_add(&bar[XB_TOPGEN], 1u);
            else XB_SPIN(xb_ld(&bar[XB_TOPGEN]) == tg, bar);
            __builtin_amdgcn_fence(__ATOMIC_ACQUIRE, "agent");
            xb_add(&bar[XB_XGEN(b.x)], 1u);
            asm volatile("s_waitcnt vmcnt(0)" ::: "memory");
        } else {
            XB_SPIN(xb_ld(&bar[XB_XGEN(b.x)]) == gen, bar);
            __builtin_amdgcn_fence(__ATOMIC_ACQUIRE, "agent");
            asm volatile("s_waitcnt vmcnt(0)" ::: "memory");
        }
    }
    __syncthreads();
}

#define LDS_WAIT() asm volatile("s_waitcnt lgkmcnt(0)" ::: "memory")
__device__ __forceinline__ float bflo(unsigned w) { return __uint_as_float(w << 16); }
__device__ __forceinline__ float bfhi(unsigned w) { return __uint_as_float(w & 0xffff0000u); }
__device__ __forceinline__ unsigned pk2(float lo, float hi) { typedef float f32x2_ __attribute__((ext_vector_type(2))); typedef __bf16 bf16x2_ __attribute__((ext_vector_type(2))); const f32x2_ v = {lo, hi}; return __builtin_bit_cast(unsigned, __builtin_convertvector(v, bf16x2_)); }
__device__ __forceinline__ unsigned f2bf(float f) { return pk2(f, 0.f) & 0xffffu; }
__device__ __forceinline__ float shx_(float v, int m, int lane) { return __int_as_float(__builtin_amdgcn_ds_bpermute((lane ^ m) << 2, __float_as_int(v))); }
__device__ __forceinline__ unsigned shi_(unsigned v, int src) { return (unsigned)__builtin_amdgcn_ds_bpermute(src << 2, (int)v); }
#define SHX(v, m) shx_((v), (m), lane)
__device__ __forceinline__ float dpp_xor1(float v) { return __int_as_float(__builtin_amdgcn_update_dpp(0, __float_as_int(v), 0xB1, 0xF, 0xF, true)); }
__device__ __forceinline__ float dpp_xor2(float v) { return __int_as_float(__builtin_amdgcn_update_dpp(0, __float_as_int(v), 0x4E, 0xF, 0xF, true)); }
__device__ __forceinline__ float half_sum(float v) { const auto r = __builtin_amdgcn_permlane32_swap(__float_as_uint(v), __float_as_uint(v), false, false); return __uint_as_float(r[0]) + __uint_as_float(r[1]); }
__device__ __forceinline__ float half_max(float v) { const auto r = __builtin_amdgcn_permlane32_swap(__float_as_uint(v), __float_as_uint(v), false, false); return fmaxf(__uint_as_float(r[0]), __uint_as_float(r[1])); }
__device__ __forceinline__ float wave_sum_(float v, int lane) {
    v += dpp_xor1(v); v += dpp_xor2(v); v += shx_(v, 4, lane); v += shx_(v, 8, lane); v += shx_(v, 16, lane); return half_sum(v);
}

#define wave_sum(v) wave_sum_((v), lane)
__device__ __forceinline__ float wave_max_(float v, int lane) {
#pragma unroll
    for (int o = 1; o < 64; o <<= 1) v = fmaxf(v, shx_(v, o, lane));
    return v;
}
__device__ __forceinline__ bool qk_bounded(const float* gq, const float* gk, int lane) {
    const float a = wave_max_(fabsf(gq[lane]), lane), b = wave_max_(fabsf(gk[lane]), lane);
    return 64.0f * QSCALE * a * b <= 60.0f;
}
__device__ __forceinline__ void unpack8(const u32x4 w, float (&v)[8]) {
    v[0] = bflo(w.x); v[1] = bfhi(w.x); v[2] = bflo(w.y); v[3] = bfhi(w.y); v[4] = bflo(w.z); v[5] = bfhi(w.z); v[6] = bflo(w.w); v[7] = bfhi(w.w);
}
__device__ __forceinline__ u32x4 pack8(const float (&v)[8]) { u32x4 w; w.x = pk2(v[0], v[1]); w.y = pk2(v[2], v[3]); w.z = pk2(v[4], v[5]); w.w = pk2(v[6], v[7]); return w; }
__device__ __forceinline__ float gelu_tanh(float y) {
    const float z = 0.7978845608028654f * (y + 0.044715f * y * y * y);
    const float e = __builtin_amdgcn_exp2f(2.885390081777927f * z);
    const float th = 1.0f - 2.0f * __builtin_amdgcn_rcpf(e + 1.0f);
    return 0.5f * y * (1.0f + th);
}
__device__ __forceinline__ float sigmoidf_(float v) { return __builtin_amdgcn_rcpf(1.0f + __builtin_amdgcn_exp2f(-1.4426950408889634f * v)); }
__device__ __forceinline__ unsigned ordkey(float f) { const unsigned u = __float_as_uint(f); return u ^ ((unsigned)((int)u >> 31) | 0x80000000u); }

struct EpiPlain {
    static constexpr bool PERM = true, AFTER_DRAIN = false;
    bf16_t* O; int ldc;
    __device__ __forceinline__ void operator()(const pg8::f32x4 (&acc)[2][2][4][2], const pg8::Unit& u, int wr, int wc, int fr, int fq) const {
        const int row0 = u.pm * 256 + wr * 64 + fr, col0 = u.pn * 256 + wc * 32 + 8 * fq;
#pragma unroll
        for (int ai = 0; ai < 2; ++ai)
#pragma unroll
            for (int m = 0; m < 4; ++m) { bf16_t* rowp = O + (size_t)(row0 + ai * 128 + m * 16) * ldc + col0;
#pragma unroll
                for (int bj = 0; bj < 2; ++bj) { const pg8::f32x4 v0 = acc[ai][bj][m][0], v1 = acc[ai][bj][m][1];
                    u32x4 w; w.x = pk2(v0[0], v0[1]); w.y = pk2(v0[2], v0[3]); w.z = pk2(v1[0], v1[1]); w.w = pk2(v1[2], v1[3]);
                    *(u32x4*)(rowp + bj * 128) = w; } }
    }
};
__device__ __forceinline__ void epi_khead(const pg8::f32x4 (&acc)[2][2][4][2], bf16_t* Z, int ldz, int colbase, const float* gain, const float* COSH, const float* SINH, int row0, int wc, int fr, int fq) {
    const int lane = fr + 16 * fq;
    float g[2][8];
#pragma unroll
    for (int bj = 0; bj < 2; ++bj)
#pragma unroll
        for (int e = 0; e < 8; ++e) g[bj][e] = gain[bj * 32 + 8 * fq + e];
#pragma unroll
    for (int ai = 0; ai < 2; ++ai)
#pragma unroll
      for (int mp = 0; mp < 4; mp += 2) {
        f32x4 csv[2][2], snv[2][2];
#pragma unroll
        for (int mm = 0; mm < 2; ++mm) { const int pos = (row0 + ai * 128 + (mp + mm) * 16) & (S - 1);
            csv[mm][0] = *(const f32x4*)(COSH + pos * 8); csv[mm][1] = *(const f32x4*)(COSH + pos * 8 + 4); snv[mm][0] = *(const f32x4*)(SINH + pos * 8); snv[mm][1] = *(const f32x4*)(SINH + pos * 8 + 4); }
        __builtin_amdgcn_sched_barrier(0);
#pragma unroll
        for (int mm = 0; mm < 2; ++mm) { const int m = mp + mm; const int row = row0 + ai * 128 + m * 16;
            float v[2][8]; float ss = 0.f;
#pragma unroll
            for (int bj = 0; bj < 2; ++bj)
#pragma unroll
                for (int e = 0; e < 4; ++e) { v[bj][e] = acc[ai][bj][m][0][e]; v[bj][4 + e] = acc[ai][bj][m][1][e]; ss += v[bj][e] * v[bj][e] + v[bj][4 + e] * v[bj][4 + e]; }
            ss += shx_(ss, 16, lane); ss = half_sum(ss);
            const float r = rsqrtf(ss * (1.0f / 64.0f) + EPS);
#pragma unroll
            for (int bj = 0; bj < 2; ++bj)
#pragma unroll
                for (int e = 0; e < 8; ++e) v[bj][e] *= r * g[bj][e];
#pragma unroll
            for (int e = 0; e < 8; ++e) { const float oth = shx_(v[0][e], 16, lane); const float cs = csv[mm][e >> 2][e & 3], sn = snv[mm][e >> 2][e & 3];
                if (fq == 0) v[0][e] = v[0][e] * cs - oth * sn; else if (fq == 1) v[0][e] = v[0][e] * cs + oth * sn; }
            bf16_t* zp = Z + (size_t)row * ldz + colbase + wc * 64 + 8 * fq;
            *(u32x4*)zp = pack8(v[0]); *(u32x4*)(zp + 32) = pack8(v[1]); }
        __builtin_amdgcn_sched_barrier(0);
      }
}
struct EpiEvenIn {
    static constexpr bool PERM = true, AFTER_DRAIN = false;
    bf16_t* Z; _Float16* IQH; _Float16* IKH; float* IW; const float* a_kn; const float* b_kn; const float* idx_kn; const float* COSH; const float* SINH; const float* COSI; const float* SINI;
    __device__ __forceinline__ void operator()(const pg8::f32x4 (&acc)[2][2][4][2], const pg8::Unit& u, int wr, int wc, int fr, int fq) const {
        const int row0 = u.pm * 256 + wr * 64 + fr; const int lane = fr + 16 * fq;
        if (u.pn == 2 || u.pn == 3) epi_khead(acc, Z, EV_ZP, 512 + (u.pn & 1) * 256, a_kn, COSH, SINH, row0, wc, fr, fq);
        else if (u.pn == 8 || u.pn == 9) epi_khead(acc, Z, EV_ZP, 2048 + (u.pn & 1) * 256, b_kn, COSH, SINH, row0, wc, fr, fq);
        else if (u.pn < 12) {
            const int col0 = u.pn * 256 + wc * 32 + 8 * fq;
#pragma unroll
            for (int ai = 0; ai < 2; ++ai)
#pragma unroll
                for (int m = 0; m < 4; ++m) { bf16_t* rowp = Z + (size_t)(row0 + ai * 128 + m * 16) * EV_ZP + col0;
#pragma unroll
                    for (int bj = 0; bj < 2; ++bj) { const pg8::f32x4 v0 = acc[ai][bj][m][0], v1 = acc[ai][bj][m][1];
                        u32x4 w; w.x = pk2(v0[0], v0[1]); w.y = pk2(v0[2], v0[3]); w.z = pk2(v1[0], v1[1]); w.w = pk2(v1[2], v1[3]);
                        *(u32x4*)(rowp + bj * 128) = w; } }
        } else if (u.pn == 12) {
#pragma unroll
            for (int ai = 0; ai < 2; ++ai) {
                f32x4 csr[4], snr[4];
#pragma unroll
                for (int m = 0; m < 4; ++m) { const int pos = (row0 + ai * 128 + m * 16) & (S - 1); csr[m] = *(const f32x4*)(COSI + pos * 4); snr[m] = *(const f32x4*)(SINI + pos * 4); }
                __builtin_amdgcn_sched_barrier(0);
#pragma unroll
                for (int m = 0; m < 4; ++m) { const int row = row0 + ai * 128 + m * 16;
                    const f32x4 cs = csr[m], sn = snr[m];
#pragma unroll
                    for (int bj = 0; bj < 2; ++bj) { pg8::f32x4 v0 = acc[ai][bj][m][0], v1 = acc[ai][bj][m][1];
                        if (fq == 0) { const pg8::f32x4 a0 = v0, a1 = v1;
#pragma unroll
                            for (int e = 0; e < 4; ++e) { v0[e] = a0[e] * cs[e] - a1[e] * sn[e]; v1[e] = a1[e] * cs[e] + a0[e] * sn[e]; } }
                        f16x8 hq;
#pragma unroll
                        for (int e = 0; e < 4; ++e) { hq[e] = (_Float16)v0[e]; hq[4 + e] = (_Float16)v1[e]; }
                        *(f16x8*)(IQH + (size_t)row * 256 + bj * 128 + wc * 32 + 8 * fq) = hq; } }
                __builtin_amdgcn_sched_barrier(0);
            }
        } else {
            if (wc == 0) {
                float g[8];
#pragma unroll
                for (int e = 0; e < 8; ++e) g[e] = idx_kn[8 * fq + e];
#pragma unroll
                for (int ai = 0; ai < 2; ++ai) {
                  f32x4 csr[4], snr[4];
#pragma unroll
                  for (int m = 0; m < 4; ++m) { const int pos = (row0 + ai * 128 + m * 16) & (S - 1); csr[m] = *(const f32x4*)(COSI + pos * 4); snr[m] = *(const f32x4*)(SINI + pos * 4); }
                  __builtin_amdgcn_sched_barrier(0);
#pragma unroll
                    for (int m = 0; m < 4; ++m) { const int row = row0 + ai * 128 + m * 16;
                        float v[8]; float ss = 0.f;
#pragma unroll
                        for (int e = 0; e < 4; ++e) { v[e] = acc[ai][0][m][0][e]; v[4 + e] = acc[ai][0][m][1][e]; ss += v[e] * v[e] + v[4 + e] * v[4 + e]; }
                        ss += shx_(ss, 16, lane); ss = half_sum(ss);
                        const float r = rsqrtf(ss * (1.0f / 32.0f) + EPS);
#pragma unroll
                        for (int e = 0; e < 8; ++e) v[e] *= r * g[e];
                        if (fq == 0) {
#pragma unroll
                            for (int e = 0; e < 4; ++e) { const float x1 = v[e], x2 = v[4 + e]; const float cs = csr[m][e], sn = snr[m][e]; v[e] = x1 * cs - x2 * sn; v[4 + e] = x2 * cs + x1 * sn; } }
                        f16x8 hk;
#pragma unroll
                        for (int e = 0; e < 8; ++e) hk[e] = (_Float16)v[e];
                        *(f16x8*)(IKH + (size_t)row * 32 + 8 * fq) = hk; }
                  __builtin_amdgcn_sched_barrier(0);
                }
            } else if (wc == 1 && fq == 0) {
#pragma unroll
                for (int ai = 0; ai < 2; ++ai)
#pragma unroll
                    for (int m = 0; m < 4; ++m) { float* wp = IW + (size_t)(row0 + ai * 128 + m * 16) * 8; *(pg8::f32x4*)wp = acc[ai][0][m][0]; *(pg8::f32x4*)(wp + 4) = acc[ai][0][m][1]; }
            }
        }
    }
};
struct EpiOddIn {
    static constexpr bool PERM = true, AFTER_DRAIN = false;
    bf16_t* Z; bf16_t* UG; const float* c_kn; const float* COSH; const float* SINH;
    __device__ __forceinline__ void operator()(const pg8::f32x4 (&acc)[2][2][4][2], const pg8::Unit& u, int wr, int wc, int fr, int fq) const {
        const int row0 = u.pm * 256 + wr * 64 + fr, col0 = u.pn * 256 + wc * 32 + 8 * fq;
        if (u.pn == 2 || u.pn == 3) { epi_khead(acc, Z, OD_N, 512 + (u.pn & 1) * 256, c_kn, COSH, SINH, row0, wc, fr, fq); return; }
#pragma unroll
        for (int ai = 0; ai < 2; ++ai)
#pragma unroll
            for (int m = 0; m < 4; ++m) { const size_t row = (size_t)(row0 + ai * 128 + m * 16);
#pragma unroll
                for (int bj = 0; bj < 2; ++bj) { const pg8::f32x4 v0 = acc[ai][bj][m][0], v1 = acc[ai][bj][m][1]; const int col = col0 + bj * 128;
                    u32x4 w; w.x = pk2(v0[0], v0[1]); w.y = pk2(v0[2], v0[3]); w.z = pk2(v1[0], v1[1]); w.w = pk2(v1[2], v1[3]);
                    if (u.pn < 6) *(u32x4*)(Z + row * OD_N + col) = w;
                    else { const int cu = col - 1536; *(u32x4*)(UG + ((size_t)(cu >> 4) * T + row) * 16 + (cu & 15)) = w; } } }
    }
};
__device__ __forceinline__ void load_q_normed(attn_body::bf16x8 (&qr)[4], const bf16_t* zrow, const float* gain, const float* COSH, const float* SINH, int pos, int hi, int lane) {
    float v[4][8]; float ss = 0.f;
#pragma unroll
    for (int d0 = 0; d0 < 4; ++d0) { unpack8(*(const u32x4*)(zrow + d0 * 16 + hi * 8), v[d0]);
#pragma unroll
        for (int e = 0; e < 8; ++e) ss += v[d0][e] * v[d0][e]; }
    ss = half_sum(ss);
    const float r = rsqrtf(ss * (1.0f / 64.0f) + EPS) * QSCALE;
#pragma unroll
    for (int d0 = 0; d0 < 4; ++d0)
#pragma unroll
        for (int e = 0; e < 8; ++e) v[d0][e] *= r * gain[d0 * 16 + hi * 8 + e];
#pragma unroll
    for (int e = 0; e < 8; ++e) { const float oth = shx_(v[0][e], 32, lane); const float cs = COSH[pos * 8 + e], sn = SINH[pos * 8 + e];
        v[0][e] = hi ? v[0][e] * cs + oth * sn : v[0][e] * cs - oth * sn; }
#pragma unroll
    for (int d0 = 0; d0 < 4; ++d0) qr[d0] = __builtin_bit_cast(attn_body::bf16x8, pack8(v[d0]));
}
struct EpiSwiGLU {
    static constexpr bool PERM = true, AFTER_DRAIN = false;
    bf16_t* HID;
    __device__ __forceinline__ void operator()(const pg8::f32x4 (&acc)[2][2][4][2], const pg8::Unit& u, int wr, int wc, int fr, int fq) const {
        const int row0 = u.pm * 256 + wr * 64 + fr, col0 = (u.pn * 256 + wc * 32 + 8 * fq) >> 1;
#pragma unroll
        for (int ai = 0; ai < 2; ++ai)
#pragma unroll
            for (int m = 0; m < 4; ++m) { bf16_t* rowp = HID + (size_t)(row0 + ai * 128 + m * 16) * 512 + col0;
#pragma unroll
                for (int bj = 0; bj < 2; ++bj) { const pg8::f32x4 v0 = acc[ai][bj][m][0], v1 = acc[ai][bj][m][1];
                    const float h0 = v0[0] * sigmoidf_(v0[0]) * v0[1], h1 = v0[2] * sigmoidf_(v0[2]) * v0[3];
                    const float h2 = v1[0] * sigmoidf_(v1[0]) * v1[1], h3 = v1[2] * sigmoidf_(v1[2]) * v1[3];
                    u32x2 w; w.x = pk2(h0, h1); w.y = pk2(h2, h3);
                    *(u32x2*)(rowp + bj * 64) = w; } }
    }
};
struct EpiGLU {
    static constexpr bool PERM = true, AFTER_DRAIN = false;
    bf16_t* O; const bf16_t* YG; const float* gb;
    __device__ __forceinline__ void operator()(const pg8::f32x4 (&acc)[2][2][4][2], const pg8::Unit& u, int wr, int wc, int fr, int fq) const {
        const int row0 = u.pm * 256 + wr * 64 + fr, col0 = u.pn * 256 + wc * 32 + 8 * fq;
#pragma unroll
        for (int ai = 0; ai < 2; ++ai)
#pragma unroll
            for (int bj = 0; bj < 2; ++bj) {
                const int c = col0 + bj * 128;
                u32x4 yr[4];
#pragma unroll
                for (int m = 0; m < 4; ++m) yr[m] = *(const u32x4*)(YG + (size_t)(row0 + ai * 128 + m * 16) * 512 + c);
                const pg8::f32x4 b0 = *(const pg8::f32x4*)(gb + c), b1 = *(const pg8::f32x4*)(gb + c + 4);
                __builtin_amdgcn_sched_barrier(0);
#pragma unroll
                for (int m = 0; m < 4; ++m) { const size_t row = (size_t)(row0 + ai * 128 + m * 16);
                    const pg8::f32x4 v0 = acc[ai][bj][m][0], v1 = acc[ai][bj][m][1];
                    float y[8]; unpack8(yr[m], y);
                    float o[8];
#pragma unroll
                    for (int j = 0; j < 4; ++j) { o[j] = y[j] * sigmoidf_(v0[j] + b0[j]); o[4 + j] = y[4 + j] * sigmoidf_(v1[j] + b1[j]); }
                    *(u32x4*)(O + row * 1024 + 512 + c) = pack8(o); }
                __builtin_amdgcn_sched_barrier(0);
            }
    }
};
struct MoeOrder {
    int nN, nunits, G, c; const LAS int* tile_e;
    __device__ __forceinline__ bool next(int i, pg8::Unit& u) const { const int L = i * G + c; if (L >= nunits) return false;
        int w = L; { const int q = nunits / 8, r = nunits % 8, xcd = w % 8, off = w / 8; w = (xcd < r ? xcd * (q + 1) : r * (q + 1) + (xcd - r) * q) + off; }
        u.pm = w / nN; u.pn = w % nN; u.be = tile_e[u.pm]; return true; }
    __device__ __forceinline__ void a_ready(const pg8::Unit&) const {}
    __device__ __forceinline__ void done(const pg8::Unit&) const {}
};

__device__ __forceinline__ int wt_row(int n, int row_mul, int row_add) {
    if (row_mul > 0) return n * row_mul + row_add;
    const int tile = n >> 8, w = n & 255;
    const bool ktile = (tile == 2 || tile == 3) || (row_mul == -1 && (tile == 8 || tile == 9));
    return ktile ? tile * 256 + ((w & 63) >> 5) * 128 + (w >> 6) * 32 + (w & 31) : n;
}
__device__ __forceinline__ void transpose_item(const float* W, int K, int N, bf16_t* WT, int row_mul, int row_add, LAS float* scr, int item, int nblk, int lane) {
    const int kb = item / nblk, nb = item % nblk, k0 = 64 * kb, n0 = 32 * nb;
    const int nn = n0 + (lane & 31);
    float tv[32];
#pragma unroll
    for (int i = 0; i < 32; ++i) { const int kk = 2 * i + (lane >> 5); tv[i] = (nn < N) ? W[(size_t)(k0 + kk) * N + nn] : 0.f; }
#pragma unroll
    for (int i = 0; i < 32; ++i) { const int kk = 2 * i + (lane >> 5); scr[kk * 33 + (lane & 31)] = tv[i]; }
    LDS_WAIT(); asm volatile("" ::: "memory");
    const int c = lane & 7;
#pragma unroll
    for (int j = 0; j < 4; ++j) { const int n = (lane >> 3) + 8 * j; const LAS float* s = scr + (8 * c) * 33 + n;
        u32x4 o; o.x = pk2(s[0 * 33], s[1 * 33]); o.y = pk2(s[2 * 33], s[3 * 33]); o.z = pk2(s[4 * 33], s[5 * 33]); o.w = pk2(s[6 * 33], s[7 * 33]);
        *(u32x4*)(WT + (size_t)wt_row(n0 + n, row_mul, row_add) * K + k0 + 8 * c) = o; }
    LDS_WAIT(); asm volatile("" ::: "memory");
}
__device__ __forceinline__ void norm_mod_row(const float* xrow, const float* sh, const float* sc, bf16_t* orow, int lane) {
    f32x4 v[4]; float ss = 0.f;
#pragma unroll
    for (int j = 0; j < 4; ++j) { v[j] = *(const f32x4*)(xrow + 4 * lane + 256 * j); ss += (v[j].x * v[j].x + v[j].y * v[j].y) + (v[j].z * v[j].z + v[j].w * v[j].w); }
    const float r = rsqrtf(wave_sum(ss) * (1.0f / 1024.0f) + EPS);
#pragma unroll
    for (int j = 0; j < 4; ++j) { const f32x4 a = *(const f32x4*)(sc + 4 * lane + 256 * j), b = *(const f32x4*)(sh + 4 * lane + 256 * j);
        u32x2 w; w.x = pk2(v[j].x * r * (1.f + a.x) + b.x, v[j].y * r * (1.f + a.y) + b.y); w.y = pk2(v[j].z * r * (1.f + a.z) + b.z, v[j].w * r * (1.f + a.w) + b.w);
        *(u32x2*)(orow + 4 * lane + 256 * j) = w; }
}

__device__ __forceinline__ void attn_key(const bf16_t* kp, const bf16_t* vp, const float (&q)[64], float& m, float& l, float (&o)[64]) {
    float s = 0.f;
#pragma unroll
    for (int i = 0; i < 8; ++i) { float kv[8]; unpack8(*(const u32x4*)(kp + 8 * i), kv);
#pragma unroll
        for (int j = 0; j < 8; ++j) s += q[8 * i + j] * kv[j]; }
    const float mn = fmaxf(m, s);
    const float f = __builtin_amdgcn_exp2f(m - mn), p = __builtin_amdgcn_exp2f(s - mn);
    l = l * f + p; m = mn;
#pragma unroll
    for (int i = 0; i < 8; ++i) { float vv[8]; unpack8(*(const u32x4*)(vp + 8 * i), vv);
#pragma unroll
        for (int j = 0; j < 8; ++j) o[8 * i + j] = o[8 * i + j] * f + p * vv[j]; }
}
__device__ __forceinline__ void load_q64(const bf16_t* qp, float scale, float (&q)[64]) {
#pragma unroll
    for (int i = 0; i < 8; ++i) { float t[8]; unpack8(*(const u32x4*)(qp + 8 * i), t);
#pragma unroll
        for (int j = 0; j < 8; ++j) q[8 * i + j] = t[j] * scale; }
}

struct Args { const void* in[37]; float* out; unsigned char* ws; int ph_lo, ph_hi, probe_var, pad; };
#ifndef PROBE_GEMM_REPS
#define PROBE_GEMM_REPS 1
#endif
#if PROBE_GEMM_REPS == 2
template <class Sc> struct Twice { Sc S; int n1;
    __device__ __forceinline__ bool next(int i, pg8::Unit& u) const { return i < n1 ? S.next(i, u) : S.next(i - n1, u); }
    __device__ __forceinline__ void a_ready(const pg8::Unit&) const {}
    __device__ __forceinline__ void done(const pg8::Unit&) const {} };
#define PROBE_SCHED(T) Twice<T>
#define PROBE_WRAP(T, v) Twice<T> PS_; PS_.S = v; { int n1_ = 0; pg8::Unit tu_; while (v.next(n1_, tu_)) ++n1_; PS_.n1 = n1_; }
#else
#define PROBE_SCHED(T) T
#define PROBE_WRAP(T, v) const T& PS_ = v
#endif
#ifdef PROBE_BAR2
#define PROBE_EXTRA_BAR(b) xcd_barrier(b, lsg(wid0) == 0 && lane_id_v() == 0);
#else
#define PROBE_EXTRA_BAR(b)
#endif
constexpr int N_PHASES = 3 + 2 * (8 + 10);

template <int NV, bool MASKED, bool CAUSAL, int PIN, int POUT, bool NOMAX = false>
__device__ __forceinline__ void flash_unit(LAS unsigned char* L0, const bf16_t* Qb, const bf16_t* Kb, const bf16_t* Vb, bf16_t* Ob, const unsigned* mbase, int qb, int wid, int lane, const float* qgain, const float* COSH, const float* SINH) {
    const int r32 = lane & 31, hi = lane >> 5;
    LAS unsigned char* ldsKs = L0; LAS unsigned char* ldsVs = L0 + 16384;
    LAS float* wsf = (LAS float*)(L0 + 16384 + NV * 16384 + wid * 256);
    LAS bf16_t* stg = (LAS bf16_t*)(L0 + 16384 + NV * 16384 + 2048 + wid * 4096);
    const int qrow = qb * 256 + wid * 32 + r32;
    attn_body::bf16x8 qr[4];
    load_q_normed(qr, Qb + (size_t)qrow * PIN, qgain, COSH, SINH, qrow, hi, lane);
    const int NT = 4 * (qb + 1);
    const bf16_t* kbp = Kb + (size_t)lane * PIN + wid * 8;
    const bf16_t* vbp = Vb + (size_t)(16 * (wid & 3) + (lane >> 2)) * PIN + (wid >> 2) * 32 + (lane & 3) * 8;
    const unsigned* mwp = MASKED ? mbase + (size_t)qrow * 2 + hi : nullptr;
    u32x4 kreg = *(const u32x4*)kbp, vreg[NV]; unsigned mw = 0u, mwn = 0u;
#pragma unroll
    for (int j = 0; j < NV; ++j) vreg[j] = *(const u32x4*)(vbp + j * 64);
    if (MASKED) mw = mwp[0];
    *(LAS u32x4*)(ldsKs + wid * 1024 + lane * 16) = kreg;
#pragma unroll
    for (int j = 0; j < NV; ++j) *(LAS u32x4*)(ldsVs + j * 16384 + wid * 1024 + lane * 16) = vreg[j];
    __syncthreads();
    float mhat = 0.f, lsum = 0.f;
    attn_body::f32x16 o[2 * NV], negm;
#pragma unroll
    for (int r = 0; r < 16; ++r) { negm[r] = 0.f;
#pragma unroll
        for (int j = 0; j < 2 * NV; ++j) o[j][r] = 0.f; }
    const int vb0 = (int)(unsigned)(unsigned long long)ldsVs + ((lane >> 4) & 1) * 32 + (lane & 3) * 8 + (4 * hi + ((lane & 15) >> 2)) * 64;
    for (int t = 0; t < NT; ++t) {
        const int slot = (t & 1) * 8192;
        if (t + 1 < NT) { kreg = *(const u32x4*)(kbp + (size_t)(t + 1) * 64 * PIN);
#pragma unroll
            for (int j = 0; j < NV; ++j) vreg[j] = *(const u32x4*)(vbp + (size_t)(t + 1) * 64 * PIN + j * 64);
            if (MASKED) mwn = mwp[(size_t)(t + 1) * S * 2]; }
        attn_body::f32x16 p0 = negm, p1 = negm;
        { const LAS unsigned char* kb = ldsKs + slot + hi * 1024 + r32 * 16;
#pragma unroll
          for (int d0 = 0; d0 < 4; ++d0) {
              const attn_body::bf16x8 b0 = *(const LAS attn_body::bf16x8*)(kb + d0 * 2048), b1 = *(const LAS attn_body::bf16x8*)(kb + d0 * 2048 + 512);
              p0 = __builtin_amdgcn_mfma_f32_32x32x16_bf16(b0, qr[d0], p0, 0, 0, 0);
              p1 = __builtin_amdgcn_mfma_f32_32x32x16_bf16(b1, qr[d0], p1, 0, 0, 0); } }
        if (CAUSAL) { const int jb = t - (NT - 4); if (jb >= 0) attn_body::cmask(p0, p1, jb, wid * 32 + r32, hi); }
        float rm = 0.f;
        if (!NOMAX) { rm = fmaxf(p0[0], p1[0]);
#pragma unroll
            for (int r = 1; r < 16; ++r) rm = fmaxf(rm, fmaxf(p0[r], p1[r]));
            rm = half_max(rm); }
        bool resc = false;
        if (!NOMAX && __any(rm > 8.0f)) {
            const float dl = fmaxf(rm, 0.f); mhat += dl;
#pragma unroll
            for (int r = 0; r < 16; ++r) { p0[r] -= dl; p1[r] -= dl; negm[r] = -mhat; }
            const float f = __builtin_amdgcn_exp2f(-dl); lsum *= f; if (hi == 0) wsf[r32] = f; resc = true;
        }
        const int wb = (int)mw; float ssum = 0.f;
#pragma unroll
        for (int r = 0; r < 16; ++r) {
            float e0 = __builtin_amdgcn_exp2f(p0[r]), e1 = __builtin_amdgcn_exp2f(p1[r]);
            if (MASKED) { e0 = __uint_as_float(__float_as_uint(e0) & (unsigned)__builtin_amdgcn_sbfe(wb, r, 1)); e1 = __uint_as_float(__float_as_uint(e1) & (unsigned)__builtin_amdgcn_sbfe(wb, 16 + r, 1)); }
            p0[r] = e0; p1[r] = e1; ssum += e0 + e1; }
        lsum += ssum;
        u32x4 pw0, pw1, pw2, pw3;
#pragma unroll
        for (int k = 0; k < 4; ++k) { pw0[k] = attn_body::cvtpk_s(p0[2 * k], p0[2 * k + 1]); pw1[k] = attn_body::cvtpk_s(p0[8 + 2 * k], p0[9 + 2 * k]);
            pw2[k] = attn_body::cvtpk_s(p1[2 * k], p1[2 * k + 1]); pw3[k] = attn_body::cvtpk_s(p1[8 + 2 * k], p1[9 + 2 * k]); }
        if (resc) { LDS_WAIT();
#pragma unroll
            for (int r = 0; r < 16; ++r) { const float f = wsf[attn_body::crow(r, hi)];
#pragma unroll
                for (int j = 0; j < 2 * NV; ++j) o[j][r] *= f; } }
#pragma unroll
        for (int j = 0; j < NV; ++j)
            attn_body::pv(o + 2 * j, vb0 + j * 16384 + slot, __builtin_bit_cast(attn_body::bf16x8, pw0), __builtin_bit_cast(attn_body::bf16x8, pw1), __builtin_bit_cast(attn_body::bf16x8, pw2), __builtin_bit_cast(attn_body::bf16x8, pw3));
        if (t + 1 < NT) { const int ns = ((t + 1) & 1) * 8192; *(LAS u32x4*)(ldsKs + ns + wid * 1024 + lane * 16) = kreg;
#pragma unroll
            for (int j = 0; j < NV; ++j) *(LAS u32x4*)(ldsVs + j * 16384 + ns + wid * 1024 + lane * 16) = vreg[j]; }
        mw = mwn;
        __syncthreads();
    }
    lsum += shx_(lsum, 32, lane);
    if (hi == 0) wsf[r32] = lsum;
    LDS_WAIT();
    float rl[16];
#pragma unroll
    for (int r = 0; r < 16; ++r) rl[r] = __builtin_amdgcn_rcpf(wsf[attn_body::crow(r, hi)]);
#pragma unroll
    for (int j = 0; j < NV; ++j) {
#pragma unroll
        for (int r = 0; r < 16; ++r) { const int orow = attn_body::crow(r, hi);
            stg[orow * 64 + r32] = (bf16_t)f2bf(o[2 * j][r] * rl[r]); stg[orow * 64 + 32 + r32] = (bf16_t)f2bf(o[2 * j + 1][r] * rl[r]); }
        LDS_WAIT();
#pragma unroll
        for (int q = 0; q < 4; ++q) { const int row = q * 8 + (lane >> 3), ch = lane & 7;
            *(u32x4*)(Ob + (size_t)(qb * 256 + wid * 32 + row) * POUT + j * 64 + ch * 8) = *(const LAS u32x4*)(stg + row * 64 + ch * 8); }
        LDS_WAIT();
    }
    __syncthreads();
}
template <int NV, bool MASKED, bool CAUSAL, int PIN, int POUT, bool NOMAX = false>
__device__ __forceinline__ void flash_unit_q2(LAS unsigned char* L0, const bf16_t* Qb, const bf16_t* Kb, const bf16_t* Vb, bf16_t* Ob, const unsigned* mbase, int qb, int wid, int lane, const float* qgain, const float* COSH, const float* SINH) {
    typedef __attribute__((address_space(3))) attn_body::v4i16_t* vtr_ptr;
    const int r32 = lane & 31, hi = lane >> 5;
    LAS unsigned char* ldsKs = L0; LAS unsigned char* ldsVs = L0 + 16384;
    LAS float* wsf = (LAS float*)(L0 + 16384 + NV * 16384 + wid * 512);
    LAS bf16_t* stg = (LAS bf16_t*)(L0 + 16384 + NV * 16384 + 4096 + wid * 4096);
    const int q0 = qb * 512 + wid * 64;
    attn_body::bf16x8 qr[2][4];
#pragma unroll
    for (int nq = 0; nq < 2; ++nq) load_q_normed(qr[nq], Qb + (size_t)(q0 + nq * 32 + r32) * PIN, qgain, COSH, SINH, q0 + nq * 32 + r32, hi, lane);
    const int NT = 8 * (qb + 1);
    const bf16_t* kbp = Kb + (size_t)lane * PIN + wid * 8;
    const bf16_t* vbp = Vb + (size_t)(16 * (wid & 3) + (lane >> 2)) * PIN + (wid >> 2) * 32 + (lane & 3) * 8;
    const unsigned* mwp = MASKED ? mbase + (size_t)(q0 + r32) * 2 + hi : nullptr;
    const int stoff = wid * 1024 + lane * 16;
    u32x4 kreg = *(const u32x4*)kbp, vreg[NV]; unsigned mw[2] = {0u, 0u}, mwn[2] = {0u, 0u};
#pragma unroll
    for (int j = 0; j < NV; ++j) vreg[j] = *(const u32x4*)(vbp + j * 64);
    if (MASKED) { mw[0] = mwp[0]; mw[1] = mwp[64]; }
    *(LAS u32x4*)(ldsKs + stoff) = kreg;
#pragma unroll
    for (int j = 0; j < NV; ++j) *(LAS u32x4*)(ldsVs + j * 16384 + stoff) = vreg[j];
    __syncthreads();
    float mhat[2] = {0.f, 0.f}, lsum[2] = {0.f, 0.f}; bool refmoved = false;
    attn_body::f32x16 o[2][2 * NV];
#pragma unroll
    for (int r = 0; r < 16; ++r)
#pragma unroll
        for (int j = 0; j < 2 * NV; ++j) { o[0][j][r] = 0.f; o[1][j][r] = 0.f; }
    const LAS unsigned char* kfb = ldsKs + hi * 1024 + r32 * 16;
    const LAS unsigned char* vfb = ldsVs + ((lane >> 4) & 1) * 32 + (lane & 3) * 8 + (4 * hi + ((lane & 15) >> 2)) * 64;
    for (int t = 0; t < NT; ++t) {
        const int slot = (t & 1) * 8192;
        {
            const int tn = min(t + 1, NT - 1);
            if (MASKED) { mwn[0] = mwp[(size_t)tn * S * 2]; mwn[1] = mwp[(size_t)tn * S * 2 + 64]; }
            kreg = *(const u32x4*)(kbp + (size_t)tn * 64 * PIN);
#pragma unroll
            for (int j = 0; j < NV; ++j) vreg[j] = *(const u32x4*)(vbp + (size_t)tn * 64 * PIN + j * 64); }
#pragma unroll
        for (int kh = 0; kh < 2; ++kh) {
            attn_body::f32x16 p[2];
#pragma unroll
            for (int r = 0; r < 16; ++r) { p[0][r] = 0.f; p[1][r] = 0.f; }
#pragma unroll
            for (int d0 = 0; d0 < 4; ++d0) {
                const attn_body::bf16x8 kf = *(const LAS attn_body::bf16x8*)(kfb + slot + d0 * 2048 + kh * 512);
                p[0] = __builtin_amdgcn_mfma_f32_32x32x16_bf16(kf, qr[0][d0], p[0], 0, 0, 0);
                p[1] = __builtin_amdgcn_mfma_f32_32x32x16_bf16(kf, qr[1][d0], p[1], 0, 0, 0); }
            if (refmoved) {
#pragma unroll
                for (int nq = 0; nq < 2; ++nq)
#pragma unroll
                    for (int r = 0; r < 16; ++r) p[nq][r] -= mhat[nq]; }
            if (CAUSAL) { const int kbase = t * 64 + kh * 32;
                if (kbase + 31 > q0) {
#pragma unroll
                    for (int nq = 0; nq < 2; ++nq)
#pragma unroll
                        for (int r = 0; r < 16; ++r) if (kbase + attn_body::crow(r, hi) > q0 + nq * 32 + r32) p[nq][r] = -INFINITY; } }
            float rm[2] = {0.f, 0.f};
            if (!NOMAX)
#pragma unroll
            for (int nq = 0; nq < 2; ++nq) { float m_ = p[nq][0];
#pragma unroll
                for (int r = 1; r < 16; ++r) m_ = fmaxf(m_, p[nq][r]);
                rm[nq] = half_max(m_); }
            bool resc = false;
            if (!NOMAX && __any(fmaxf(rm[0], rm[1]) > 8.0f)) {
#pragma unroll
                for (int nq = 0; nq < 2; ++nq) { const float dl = fmaxf(rm[nq], 0.f); mhat[nq] += dl;
#pragma unroll
                    for (int r = 0; r < 16; ++r) p[nq][r] -= dl;
                    const float f = __builtin_amdgcn_exp2f(-dl); lsum[nq] *= f; if (hi == 0) wsf[nq * 32 + r32] = f; }
                resc = true; refmoved = true;
            }
            attn_body::bf16x8 pa[2][2];
#pragma unroll
            for (int nq = 0; nq < 2; ++nq) { const int wb = (int)mw[nq]; f32x2 ss2 = {0.f, 0.f};
#pragma unroll
                for (int r = 0; r < 16; ++r) { float e = __builtin_amdgcn_exp2f(p[nq][r]);
                    if (MASKED) { unsigned mk; asm("v_bfe_i32 %0, %1, %2, 1" : "=v"(mk) : "v"(wb), "n"(kh * 16 + r)); e = __uint_as_float(__float_as_uint(e) & mk); }
                    p[nq][r] = e; }
#pragma unroll
                for (int r = 0; r < 16; r += 2) ss2 += (f32x2){p[nq][r], p[nq][r + 1]};
                lsum[nq] += ss2.x + ss2.y;
                u32x4 pw0, pw1;
#pragma unroll
                for (int k = 0; k < 4; ++k) { pw0[k] = attn_body::cvtpk_s(p[nq][2 * k], p[nq][2 * k + 1]); pw1[k] = attn_body::cvtpk_s(p[nq][8 + 2 * k], p[nq][9 + 2 * k]); }
                pa[nq][0] = __builtin_bit_cast(attn_body::bf16x8, pw0); pa[nq][1] = __builtin_bit_cast(attn_body::bf16x8, pw1); }
            if (resc) { LDS_WAIT();
#pragma unroll
                for (int nq = 0; nq < 2; ++nq)
#pragma unroll
                    for (int r = 0; r < 16; ++r) { const float f = wsf[nq * 32 + attn_body::crow(r, hi)];
#pragma unroll
                        for (int j = 0; j < 2 * NV; ++j) o[nq][j][r] *= f; } }
#pragma unroll
            for (int blk = 0; blk < 2 * NV; ++blk)
#pragma unroll
                for (int k2 = 0; k2 < 2; ++k2) {
                    const LAS unsigned char* vb = vfb + (blk >> 1) * 16384 + slot + (blk & 1) * 4096 + (kh * 2 + k2) * 1024;
                    const attn_body::s16x4 lo_ = __builtin_bit_cast(attn_body::s16x4, __builtin_amdgcn_ds_read_tr16_b64_v4i16((vtr_ptr)vb)), hi_ = __builtin_bit_cast(attn_body::s16x4, __builtin_amdgcn_ds_read_tr16_b64_v4i16((vtr_ptr)(vb + 512)));
                    const attn_body::bf16x8 vf = (attn_body::bf16x8){lo_[0], lo_[1], lo_[2], lo_[3], hi_[0], hi_[1], hi_[2], hi_[3]};
                    o[0][blk] = __builtin_amdgcn_mfma_f32_32x32x16_bf16(pa[0][k2], vf, o[0][blk], 0, 0, 0);
                    o[1][blk] = __builtin_amdgcn_mfma_f32_32x32x16_bf16(pa[1][k2], vf, o[1][blk], 0, 0, 0); }
        }
        if (t + 1 < NT) { const int ns = 8192 - slot; *(LAS u32x4*)(ldsKs + ns + stoff) = kreg;
#pragma unroll
            for (int j = 0; j < NV; ++j) *(LAS u32x4*)(ldsVs + j * 16384 + ns + stoff) = vreg[j]; }
        mw[0] = mwn[0]; mw[1] = mwn[1];
        __syncthreads();
    }
#pragma unroll
    for (int nq = 0; nq < 2; ++nq) { lsum[nq] += shx_(lsum[nq], 32, lane); if (hi == 0) wsf[nq * 32 + r32] = lsum[nq]; }
    LDS_WAIT();
#pragma unroll
    for (int nq = 0; nq < 2; ++nq)
#pragma unroll
      for (int j = 0; j < NV; ++j) {
#pragma unroll
        for (int r = 0; r < 16; ++r) { const int orow = attn_body::crow(r, hi); const float rl = __builtin_amdgcn_rcpf(wsf[nq * 32 + orow]);
            stg[orow * 64 + r32] = (bf16_t)f2bf(o[nq][2 * j][r] * rl); stg[orow * 64 + 32 + r32] = (bf16_t)f2bf(o[nq][2 * j + 1][r] * rl); }
        LDS_WAIT();
#pragma unroll
        for (int q = 0; q < 4; ++q) { const int row = q * 8 + (lane >> 3), ch = lane & 7;
            *(u32x4*)(Ob + (size_t)(q0 + nq * 32 + row) * POUT + j * 64 + ch * 8) = *(const LAS u32x4*)(stg + row * 64 + ch * 8); }
        LDS_WAIT();
      }
    __syncthreads();
}
struct MoeRows {
    static constexpr bool GATHER = true;
    const LAS int* rb; const int* LTOK;
    __device__ __forceinline__ unsigned operator()(const pg8::Unit& u, int r) const { const int e = u.be; const int slot = u.pm * 256 + r - rb[e];
        const int tok = slot < rb[32 + e] ? LTOK[e * 32768 + slot] : 0; return (unsigned)tok * 2048u; }
};
__device__ __forceinline__ void moe_convert(const float* w1, const float* w3, const float* w2, bf16_t* W13, bf16_t* W2, LAS float* scr, int gw, int NGW, int lane) {
    for (int it = gw; it < 32 * 768; it += NGW) {
        const int e = it / 768; int r = it % 768;
        if (r < 256) { transpose_item(w1 + (size_t)e * 1024 * 512, 1024, 512, W13 + (size_t)e * 1024 * 1024, 2, 0, scr, r, 16, lane); continue; } r -= 256;
        if (r < 256) { transpose_item(w3 + (size_t)e * 1024 * 512, 1024, 512, W13 + (size_t)e * 1024 * 1024, 2, 1, scr, r, 16, lane); continue; } r -= 256;
        transpose_item(w2 + (size_t)e * 512 * 1024, 512, 1024, W2 + (size_t)e * 1024 * 512, 1, 0, scr, r, 32, lane);
    }
}
__device__ __forceinline__ void moe_tables(unsigned* ctl, int l, LAS int* tile_e, LAS int* rb, LAS int* nt_p, int tid) {
    if (tid < 64) {
        const int ln = tid;
        const int cnt = ln < 32 ? (int)__hip_atomic_load(ctl + CW_CNT + (l * 32 + (ln & 31)) * 64, __ATOMIC_RELAXED, __HIP_MEMORY_SCOPE_AGENT) : 0;
        const int ntile = (cnt + 255) >> 8;
        int inc = ntile;
#pragma unroll
        for (int off = 1; off < 32; off <<= 1) { const int v = (int)shi_((unsigned)inc, ln - off); if (ln >= off) inc += v; }
        if (ln < 32) { rb[ln] = (inc - ntile) * 256; rb[32 + ln] = cnt; }
        if (ln == 31) nt_p[0] = inc;
    }
    __syncthreads();
    const int nt = nt_p[0];
    for (int t = tid; t < nt; t += NTHREADS) {
        int lo = 0, hi = 31;
        while (lo < hi) { const int mid = (lo + hi + 1) >> 1; if (rb[mid] <= t * 256) lo = mid; else hi = mid - 1; }
        tile_e[t] = lo;
    }
    __syncthreads();
}

template <bool FIRST>
__device__ __forceinline__ float f_pass1(const float* __restrict__ xs_row, bf16_t* __restrict__ xb_row, const bf16_t* __restrict__ y_row, const LAS float* gate, const int kc) {
    float ss = 0.f;
#pragma unroll 1
    for (int s0 = 0; s0 < 32; s0 += 8) {
        u32x4 xr[8], yr[8]; f32x4 xa[8], xc[8];
#pragma unroll
        for (int k = 0; k < 8; ++k) { const int col = 32 * (s0 + k) + 8 * kc;
            if constexpr (FIRST) { xa[k] = *(const f32x4*)(xs_row + col); xc[k] = *(const f32x4*)(xs_row + col + 4); } else xr[k] = *(const u32x4*)(xb_row + col);
            yr[k] = *(const u32x4*)(y_row + col); }
        __builtin_amdgcn_sched_barrier(0);
#pragma unroll
        for (int k = 0; k < 8; ++k) { const int col = 32 * (s0 + k) + 8 * kc;
            f32x4 x0, x1;
            if constexpr (FIRST) { x0 = xa[k]; x1 = xc[k]; }
            else { float xv_[8]; unpack8(xr[k], xv_); x0 = (f32x4){xv_[0], xv_[1], xv_[2], xv_[3]}; x1 = (f32x4){xv_[4], xv_[5], xv_[6], xv_[7]}; }
            float yv[8]; unpack8(yr[k], yv);
            const f32x4 g0 = *(const LAS f32x4*)(gate + col), g1 = *(const LAS f32x4*)(gate + col + 4);
            float nv_[8] = {x0.x + g0.x * yv[0], x0.y + g0.y * yv[1], x0.z + g0.z * yv[2], x0.w + g0.w * yv[3], x1.x + g1.x * yv[4], x1.y + g1.y * yv[5], x1.z + g1.z * yv[6], x1.w + g1.w * yv[7]};
            const u32x4 xw = pack8(nv_); *(u32x4*)(xb_row + col) = xw;
            float rv_[8]; unpack8(xw, rv_);
#pragma unroll
            for (int e = 0; e < 8; ++e) ss += rv_[e] * rv_[e]; }
        __builtin_amdgcn_sched_barrier(0);
    }
    return ss;
}
__device__ __forceinline__ void f_pass2(const bf16_t* __restrict__ xb_row, bf16_t* __restrict__ h_row, const LAS float* modl, const bf16_t* __restrict__ wh, const bf16_t* __restrict__ wl, const float rn, const int kc, f32x4 (&acc)[3]) {
#pragma unroll 1
    for (int s0 = 0; s0 < 32; s0 += 4) {
        u32x4 xr[4]; pg8::bf16x8 bh[4][3], bl[4][3];
#pragma unroll
        for (int k = 0; k < 4; ++k) { const int col = 32 * (s0 + k) + 8 * kc; xr[k] = *(const u32x4*)(xb_row + col);
#pragma unroll
            for (int ct = 0; ct < 3; ++ct) { bh[k][ct] = *(const pg8::bf16x8*)(wh + (size_t)ct * 16 * 1024 + 32 * (s0 + k)); bl[k][ct] = *(const pg8::bf16x8*)(wl + (size_t)ct * 16 * 1024 + 32 * (s0 + k)); } }
        __builtin_amdgcn_sched_barrier(0);
#pragma unroll
        for (int k = 0; k < 4; ++k) { const int col = 32 * (s0 + k) + 8 * kc;
            f32x4 x0, x1; { float xv_[8]; unpack8(xr[k], xv_); x0 = (f32x4){xv_[0], xv_[1], xv_[2], xv_[3]}; x1 = (f32x4){xv_[4], xv_[5], xv_[6], xv_[7]}; }
            const f32x4 c0 = *(const LAS f32x4*)(modl + 2048 + col), c1 = *(const LAS f32x4*)(modl + 2048 + col + 4), s0_ = *(const LAS f32x4*)(modl + 1024 + col), s1_ = *(const LAS f32x4*)(modl + 1024 + col + 4);
            float hv[8];
            hv[0] = x0.x * rn * (1.f + c0.x) + s0_.x; hv[1] = x0.y * rn * (1.f + c0.y) + s0_.y; hv[2] = x0.z * rn * (1.f + c0.z) + s0_.z; hv[3] = x0.w * rn * (1.f + c0.w) + s0_.w;
            hv[4] = x1.x * rn * (1.f + c1.x) + s1_.x; hv[5] = x1.y * rn * (1.f + c1.y) + s1_.y; hv[6] = x1.z * rn * (1.f + c1.z) + s1_.z; hv[7] = x1.w * rn * (1.f + c1.w) + s1_.w;
            const u32x4 hh = pack8(hv);
            *(u32x4*)(h_row + col) = hh;
            float hl[8]; { float hf[8]; unpack8(hh, hf);
#pragma unroll
                for (int e = 0; e < 8; ++e) hl[e] = hv[e] - hf[e]; }
            const u32x4 hlw = pack8(hl);
            const pg8::bf16x8 ah = __builtin_bit_cast(pg8::bf16x8, hh), al = __builtin_bit_cast(pg8::bf16x8, hlw);
#pragma unroll
            for (int ct = 0; ct < 3; ++ct) {
                acc[ct] = __builtin_amdgcn_mfma_f32_16x16x32_bf16(ah, bh[k][ct], acc[ct], 0, 0, 0);
                acc[ct] = __builtin_amdgcn_mfma_f32_16x16x32_bf16(ah, bl[k][ct], acc[ct], 0, 0, 0);
                acc[ct] = __builtin_amdgcn_mfma_f32_16x16x32_bf16(al, bh[k][ct], acc[ct], 0, 0, 0);
            } }
        __builtin_amdgcn_sched_barrier(0);
    }
}

__device__ __forceinline__ float relu_i(float x) { return __builtin_bit_cast(float, max(__builtin_bit_cast(int, x), 0)); }
__device__ __forceinline__ unsigned pk_gt_u16(unsigned a, unsigned b, unsigned ones) { unsigned d; asm("v_pk_sub_u16 %0, %1, %2 clamp" : "=v"(d) : "v"(a), "v"(b)); unsigned r; asm("v_pk_min_u16 %0, %1, %2" : "=v"(r) : "v"(d), "v"(ones)); return r; }
__device__ __forceinline__ unsigned spread16(unsigned x) { x = (x | (x << 8)) & 0x00FF00FFu; x = (x | (x << 4)) & 0x0F0F0F0Fu; x = (x | (x << 2)) & 0x33333333u; x = (x | (x << 1)) & 0x55555555u; return x; }
__device__ __forceinline__ unsigned ilv16(unsigned a) { return spread16(a & 0xFFFFu) | (spread16(a >> 16) << 1); }
__device__ __forceinline__ int lane_id_v() { int v; asm volatile("v_mbcnt_lo_u32_b32 %0, -1, 0\n\tv_mbcnt_hi_u32_b32 %0, -1, %0" : "=v"(v)); return v; }
__device__ __forceinline__ unsigned long long lsg64(unsigned long long v) { asm volatile("" : "+s"(v)); return v; }
__device__ __forceinline__ int lsg(int v) { asm volatile("" : "+s"(v)); return v; }
__device__ __forceinline__ int lvg(int v) { asm volatile("" : "+v"(v)); return v; }
__device__ __forceinline__ LAS unsigned char* lsgp(LAS unsigned char* p) { unsigned v = (unsigned)(unsigned long long)p; asm volatile("" : "+s"(v)); return (LAS unsigned char*)(unsigned long long)v; }
__device__ __forceinline__ void* ldptr(const LAS unsigned long long* tbl, int k) {
    const unsigned long long v = tbl[k];
    const unsigned lo = __builtin_amdgcn_readfirstlane((unsigned)v), hi = __builtin_amdgcn_readfirstlane((unsigned)(v >> 32));
    return (void*)(__attribute__((address_space(1))) void*)(((unsigned long long)hi << 32) | lo);
}
#define DECL_PTRS() \
    const int wid = lsg(wid0), lane = lane_id_v(), tid = wid * 64 + lane; \
    const int G = lsg(G0), c = lsg(c0), l = lsg(l0), i = l >> 1; \
    const int gw = c * NWAVES + wid, NGW = G * NWAVES, gt = c * NTHREADS + tid, NGT = G * NTHREADS; \
    LAS unsigned char* lds = (LAS unsigned char*)lsgp(lds0); LAS unsigned char* glds = lds; LAS float* scr = (LAS float*)(lds + wid * 16384); \
    const LAS unsigned long long* ptbl = (const LAS unsigned long long*)(lds + LDS_PTBL); \
    unsigned char* ws = (unsigned char*)ldptr(ptbl, 38); unsigned* ctl = (unsigned*)(ws + WS_CTL); \
    const float* xin = (const float*)ldptr(ptbl, 0); \
    const float* cin = (const float*)ldptr(ptbl, 1); \
    const float* ada_w = (const float*)ldptr(ptbl, 2); \
    const float* ada_b = (const float*)ldptr(ptbl, 3); \
    const float* moe_wg = (const float*)ldptr(ptbl, 4); \
    const float* moe_bg = (const float*)ldptr(ptbl, 5); \
    const float* moe_we = (const float*)ldptr(ptbl, 6); \
    const float* moe_be = (const float*)ldptr(ptbl, 7); \
    const float* moe_w1 = (const float*)ldptr(ptbl, 8); \
    const float* moe_w3 = (const float*)ldptr(ptbl, 9); \
    const float* moe_w2 = (const float*)ldptr(ptbl, 10); \
    const float* ev_w_in = (const float*)ldptr(ptbl, 11); \
    const float* ev_w_out = (const float*)ldptr(ptbl, 12); \
    const float* a_qn = (const float*)ldptr(ptbl, 13); \
    const float* a_kn = (const float*)ldptr(ptbl, 14); \
    const float* a_lq1 = (const float*)ldptr(ptbl, 15); \
    const float* a_lk1 = (const float*)ldptr(ptbl, 16); \
    const float* a_lq2 = (const float*)ldptr(ptbl, 17); \
    const float* a_lk2 = (const float*)ldptr(ptbl, 18); \
    const float* a_subln = (const float*)ldptr(ptbl, 19); \
    const float* b_qn = (const float*)ldptr(ptbl, 20); \
    const float* b_kn = (const float*)ldptr(ptbl, 21); \
    const float* b_idx_kn = (const float*)ldptr(ptbl, 22); \
    const float* od_w_in = (const float*)ldptr(ptbl, 23); \
    const float* od_w_out = (const float*)ldptr(ptbl, 24); \
    const float* c_qn = (const float*)ldptr(ptbl, 25); \
    const float* c_kn = (const float*)ldptr(ptbl, 26); \
    const float* s5_lam_re = (const float*)ldptr(ptbl, 27); \
    const float* s5_lam_im = (const float*)ldptr(ptbl, 28); \
    const float* s5_b_re = (const float*)ldptr(ptbl, 29); \
    const float* s5_b_im = (const float*)ldptr(ptbl, 30); \
    const float* s5_c_re = (const float*)ldptr(ptbl, 31); \
    const float* s5_c_im = (const float*)ldptr(ptbl, 32); \
    const float* s5_d = (const float*)ldptr(ptbl, 33); \
    const float* s5_log_dt = (const float*)ldptr(ptbl, 34); \
    const float* s5_glu_w = (const float*)ldptr(ptbl, 35); \
    const float* s5_glu_b = (const float*)ldptr(ptbl, 36); \
    float* out = (float*)ldptr(ptbl, 37); \
    float* MOD = (float*)(ws + WS_MOD); \
    float* MODP = (float*)(ws + WS_MODP); \
    float* COSH = (float*)(ws + WS_ROPE); \
    float* SINH = COSH + S * 8; \
    float* COSI = SINH + S * 8; \
    float* SINI = COSI + S * 4; \
    float* S5A = (float*)(ws + WS_S5A); \
    float* S5B = (float*)(ws + WS_S5B); \
    float* LAM = (float*)(ws + WS_LAM); \
    float* KM = (float*)(ws + WS_KM); \
    bf16_t* KMH = (bf16_t*)(ws + WS_KMH); \
    bf16_t* WRH = (bf16_t*)(ws + WS_WRH); \
    bf16_t* WRL = (bf16_t*)(ws + WS_WRH + 393216); \
    bf16_t* KML = (bf16_t*)(ws + WS_KMH + 131072); \
    bf16_t* Wevin = (bf16_t*)(ws + WS_WEVIN); \
    bf16_t* Wevout = (bf16_t*)(ws + WS_WEVOUT); \
    bf16_t* Wodin = (bf16_t*)(ws + WS_WODIN); \
    bf16_t* Wodout = (bf16_t*)(ws + WS_WODOUT); \
    bf16_t* Wglu = (bf16_t*)(ws + WS_WGLU); \
    bf16_t* W13 = (bf16_t*)(ws + WS_W13); \
    bf16_t* W2 = (bf16_t*)(ws + WS_W2); \
    bf16_t* H = (bf16_t*)(ws + WS_H); \
    bf16_t* O = (bf16_t*)(ws + WS_O); \
    bf16_t* Z = (bf16_t*)(ws + WS_Z); \
    bf16_t* XG = (bf16_t*)(ws + WS_XG); \
    bf16_t* Y = (bf16_t*)(ws + WS_Y); \
    bf16_t* HID = (bf16_t*)(ws + WS_HID); \
    float* IQ = (float*)(ws + WS_IQ); \
    bf16_t* YG = (bf16_t*)(ws + WS_YG); \
    float* IKW = (float*)(ws + WS_IKW); \
    _Float16* IQH = (_Float16*)(ws + WS_IQH); \
    _Float16* IKH = (_Float16*)(ws + WS_IKH); \
    float* IW = (float*)(ws + WS_IW); \
    int* SEL = (int*)(ws + WS_SEL); \
    bf16_t* YMIX = (bf16_t*)(ws + WS_YMIX); \
    int* TOKES = (int*)(ws + WS_TOKES); \
    int* LTOK = (int*)(ws + WS_LTOK); \
    float* TOKW = (float*)(ws + WS_TOKW); \
    int* TOKROW = (int*)(ws + WS_TOKROW); \
    bf16_t* UG = (bf16_t*)(ws + WS_UG); \
    float* S5E = (float*)(ws + WS_S5E); \
    bf16_t* S5HC = (bf16_t*)(ws + WS_S5HC); \
    bf16_t* S5KT = (bf16_t*)(ws + WS_S5KT); \
    bf16_t* S5WT = (bf16_t*)(ws + WS_S5WT); \
    bf16_t* S5A2 = (bf16_t*)(ws + WS_S5A2); \
    float* S5PW = (float*)(ws + WS_S5PW); \
    int* MLIST = (int*)(ws + WS_MLIST); \
    bf16_t* MPO = (bf16_t*)(ws + WS_MPO); \
    float* MML = (float*)(ws + WS_MML); \
    int* NSEL = (int*)(ws + WS_NSEL); \
    unsigned* MASKW = (unsigned*)(ws + WS_MASKW); \
    bf16_t* XB = (bf16_t*)(ws + WS_XB);
__global__ void __launch_bounds__(NTHREADS, 2) fwd(Args a) {
    extern __shared__ __attribute__((aligned(16))) unsigned char lds_raw[];
    LAS unsigned char* lds = (LAS unsigned char*)lds_raw;
    const int tid0 = threadIdx.x; const int wid0 = __builtin_amdgcn_readfirstlane(tid0 >> 6);
    const int G0 = gridDim.x, c0 = blockIdx.x;
    unsigned* ctl0 = (unsigned*)(a.ws + WS_CTL);
    LAS unsigned char* lds0 = lds;
    const int lo = a.ph_lo, hi = a.ph_hi;

    LAS unsigned long long* ptbl = (LAS unsigned long long*)(lds + LDS_PTBL);
    if (tid0 == 0) {
#define PT_(k) ptbl[k] = (unsigned long long)a.in[k];
        PT_(0) PT_(1) PT_(2) PT_(3) PT_(4) PT_(5) PT_(6) PT_(7) PT_(8) PT_(9) PT_(10) PT_(11) PT_(12) PT_(13) PT_(14) PT_(15) PT_(16) PT_(17) PT_(18)
        PT_(19) PT_(20) PT_(21) PT_(22) PT_(23) PT_(24) PT_(25) PT_(26) PT_(27) PT_(28) PT_(29) PT_(30) PT_(31) PT_(32) PT_(33) PT_(34) PT_(35) PT_(36)
#undef PT_
        ptbl[37] = (unsigned long long)a.out; ptbl[38] = (unsigned long long)a.ws;
    }
    if (tid0 < 4) ((LAS unsigned*)(lds + LDS_BARW))[tid0] = 0u;
    __syncthreads();
    XcdBarrier bar; bar.bar = ctl0 + CW_BAR; bar.x = 0; bar.st = (volatile LAS unsigned*)(lds + LDS_BARW);
    if (hi - lo > 1) bar = xcd_barrier_post(ctl0 + CW_BAR, (volatile LAS unsigned*)(lds + LDS_BARW), tid0 == 0);
    int ph = 0, l0 = 0;
#define PH_ON() (ph >= lo && ph < hi)
#define PH_END() do { if (ph >= lo && ph + 1 < hi) { XcdBarrier bb_; bb_.bar = (unsigned*)lsg64((unsigned long long)bar.bar); bb_.x = bar.x; bb_.st = bar.st; xcd_barrier(bb_, lsg(wid0) == 0 && lane_id_v() == 0); PROBE_EXTRA_BAR(bb_) } ++ph; } while (0)

    if (PH_ON()) { DECL_PTRS();
        {
            constexpr int I_EVIN = 16 * 112, I_SQ = 16 * 32, I_ODIN = 16 * 64, I_GLU = 8 * 16;
            constexpr int I_PER = I_EVIN + I_SQ + I_ODIN + I_SQ + I_GLU;
            for (int it = gw; it < 2 * I_PER; it += NGW) {
                const int i = it / I_PER; int r = it % I_PER;
                if (r < I_EVIN) { transpose_item(ev_w_in + (size_t)i * 1024 * EV_N, 1024, EV_N, Wevin + (size_t)i * EV_NP * 1024, -1, 0, scr, r, 112, lane); continue; } r -= I_EVIN;
                if (r < I_SQ) { transpose_item(ev_w_out + (size_t)i * 1024 * 1024, 1024, 1024, Wevout + (size_t)i * 1024 * 1024, 1, 0, scr, r, 32, lane); continue; } r -= I_SQ;
                if (r < I_ODIN) { transpose_item(od_w_in + (size_t)i * 1024 * 2048, 1024, 2048, Wodin + (size_t)i * 2048 * 1024, -2, 0, scr, r, 64, lane); continue; } r -= I_ODIN;
                if (r < I_SQ) { transpose_item(od_w_out + (size_t)i * 1024 * 1024, 1024, 1024, Wodout + (size_t)i * 1024 * 1024, 1, 0, scr, r, 32, lane); continue; } r -= I_SQ;
                transpose_item(s5_glu_w + (size_t)i * 512 * 512, 512, 512, Wglu + (size_t)i * 512 * 512, 1, 0, scr, r, 16, lane);
            }
        }
        __syncthreads();
        {
            LAS float* cact = (LAS float*)lds;
            for (int i = tid; i < 2048; i += NTHREADS) { const float v = cin[i]; cact[i] = v / (1.0f + __expf(-v)); }
            __syncthreads();
            for (int idx = gt; idx < 4 * 4 * 6144; idx += NGT) {
                const int kq = idx / 24576, rem = idx % 24576, l = rem / 6144, n = rem % 6144;
                const float* w = ada_w + ((size_t)l * 1024 + kq * 256) * 6144 + n;
                float a0 = 0.f, a1 = 0.f;
#pragma unroll 32
                for (int k = 0; k < 256; ++k) { const float wv = w[(size_t)k * 6144]; a0 += cact[kq * 256 + k] * wv; a1 += cact[1024 + kq * 256 + k] * wv; }
                MODP[((size_t)(kq * 4 + l) * 2 + 0) * 6144 + n] = a0;
                MODP[((size_t)(kq * 4 + l) * 2 + 1) * 6144 + n] = a1;
            }
            __syncthreads();
        }
        for (int idx = gt; idx < S * 12; idx += NGT) {
            if (idx < S * 8) { const int pos = idx >> 3, j = idx & 7; const float inv = (float)pow(500000.0, -(double)(2 * j) / 16.0); const float ang = (float)pos * inv;
                COSH[idx] = (float)cos((double)ang); SINH[idx] = (float)sin((double)ang); }
            else { const int k = idx - S * 8; const int pos = k >> 2, j = k & 3; const float inv = (float)pow(500000.0, -(double)(2 * j) / 8.0); const float ang = (float)pos * inv;
                COSI[k] = (float)cos((double)ang); SINI[k] = (float)sin((double)ang); }
        }
        for (int idx = gt; idx < 2 * 32 * 64; idx += NGT) {
            const int i = idx >> 11, g = (idx >> 6) & 31;
            const float dt = expf(s5_log_dt[i * 32 + g]);
            const float lr = s5_lam_re[idx], li = s5_lam_im[idx];
            const float mag = expf(lr * dt);
            const float ar = mag * (float)cos((double)(li * dt)), ai = mag * (float)sin((double)(li * dt));
            const float den = lr * lr + li * li;
            const float cr = ((ar - 1.0f) * lr + ai * li) / den, ci = (ai * lr - (ar - 1.0f) * li) / den;
            S5A[idx * 2] = ar; S5A[idx * 2 + 1] = ai;
            { float pr = 1.f, pi_ = 0.f; for (int n = 0; n <= 64; ++n) { S5PW[((size_t)idx * 65 + n) * 2] = pr; S5PW[((size_t)idx * 65 + n) * 2 + 1] = pi_; const float nr = pr * ar - pi_ * ai, ni = pr * ai + pi_ * ar; pr = nr; pi_ = ni; } }
            { float brv[16], biv[16];
#pragma unroll
              for (int cc = 0; cc < 16; ++cc) { brv[cc] = s5_b_re[(size_t)idx * 16 + cc]; biv[cc] = s5_b_im[(size_t)idx * 16 + cc]; }
              __builtin_amdgcn_sched_barrier(0);
#pragma unroll
              for (int cc = 0; cc < 16; ++cc) { const float br = brv[cc], bi = biv[cc];
                  *(f32x2*)(S5B + ((size_t)idx * 16 + cc) * 2) = (f32x2){cr * br - ci * bi, cr * bi + ci * br}; } }
        }
        for (int idx = gt; idx < DEPTH * 48 * 1024; idx += NGT) {
            const int k = idx & 1023, col = (idx >> 10) % 48, ll = idx / (48 * 1024);
            const float w = col < 4 ? moe_wg[((size_t)ll * 1024 + k) * 4 + col] : col < 36 ? moe_we[((size_t)ll * 1024 + k) * 32 + col - 4] : 0.f;
            const unsigned hb = f2bf(w); WRH[idx] = (bf16_t)hb; WRL[idx] = (bf16_t)f2bf(w - __uint_as_float(hb << 16));
        }
        if (gw < 2) { const int i = gw;
            const float s1 = wave_sum(a_lq1[i * 64 + lane] * a_lk1[i * 64 + lane]), s2 = wave_sum(a_lq2[i * 64 + lane] * a_lk2[i * 64 + lane]);
            const float lam_init = 0.8f - 0.6f * expf(-0.3f * (float)(2 * i));
            if (lane == 0) LAM[i] = expf(s1) - expf(s2) + lam_init; }
    }
    PH_END();
    if (PH_ON()) { DECL_PTRS();
        for (int idx = gt; idx < 4 * 2 * 6144; idx += NGT) {
            const int l = idx / 12288, b = (idx / 6144) & 1, n = idx % 6144;
            float v = ada_b[l * 6144 + n];
#pragma unroll
            for (int kq = 0; kq < 4; ++kq) v += MODP[((size_t)(kq * 4 + l) * 2 + b) * 6144 + n];
            MOD[idx] = v;
        }
        for (int idx = gt; idx < 2 * 32 * 65 * 256; idx += NGT) {
            const int ci = idx & 15, co = (idx >> 4) & 15, tr = (idx >> 8) % 65, ig = idx / (65 * 256);
            float acc = 0.f;
            if (tr > 0) {
                const int tau = tr - 1;
#pragma unroll 16
                for (int p = 0; p < 64; ++p) { const int sp = ig * 64 + p;
                    const float cr = s5_c_re[((size_t)ig * 16 + co) * 64 + p], cim_ = s5_c_im[((size_t)ig * 16 + co) * 64 + p];
                    const f32x2 pw_ = *(const f32x2*)(S5PW + ((size_t)sp * 65 + tau) * 2), bb_ = *(const f32x2*)(S5B + ((size_t)sp * 16 + ci) * 2);
                    const float pr = pw_.x, pi_ = pw_.y, br = bb_.x, bi = bb_.y;
                    const float xr = cr * pr - cim_ * pi_, xi = cr * pi_ + cim_ * pr;
                    acc += xr * br - xi * bi; }
            }
            S5KT[((size_t)ig * 65 + tr) * 384 + co * 24 + ci] = (bf16_t)f2bf(acc);
        }
        constexpr int NW_ = 2 * 32 * 128 * 1024;
        for (int idx0 = gt; idx0 < NW_; idx0 += NGT * 8) {
            f32x2 pw_[8], bb_[8];
#pragma unroll
            for (int u = 0; u < 8; ++u) { const int idx = min(idx0 + u * NGT, NW_ - 1);
                const int k = idx & 1023, row = (idx >> 10) & 127, ig = idx >> 17; const int s = k >> 4, ci = k & 15, p = row >> 1; const int sp = ig * 64 + p;
                pw_[u] = *(const f32x2*)(S5PW + ((size_t)sp * 65 + (63 - s)) * 2); bb_[u] = *(const f32x2*)(S5B + ((size_t)sp * 16 + ci) * 2); }
            __builtin_amdgcn_sched_barrier(0);
#pragma unroll
            for (int u = 0; u < 8; ++u) { const int idx = idx0 + u * NGT;
                if (idx < NW_) { const int ri = (idx >> 10) & 1; const float pr = pw_[u].x, pi_ = pw_[u].y, br = bb_[u].x, bi = bb_[u].y;
                    S5WT[idx] = (bf16_t)f2bf(ri ? (pr * bi + pi_ * br) : (pr * br - pi_ * bi)); } }
            __builtin_amdgcn_sched_barrier(0);
        }
        for (int idx0 = gt; idx0 < NW_; idx0 += NGT * 8) {
            f32x2 pw_[8]; float crv[8], civ[8];
#pragma unroll
            for (int u = 0; u < 8; ++u) { const int idx = min(idx0 + u * NGT, NW_ - 1);
                const int k = idx & 127, rowt = (idx >> 7) & 1023, ig = idx >> 17; const int t = rowt >> 4, co = rowt & 15, p = k >> 1; const int sp = ig * 64 + p;
                crv[u] = s5_c_re[((size_t)ig * 16 + co) * 64 + p]; civ[u] = s5_c_im[((size_t)ig * 16 + co) * 64 + p];
                pw_[u] = *(const f32x2*)(S5PW + ((size_t)sp * 65 + t + 1) * 2); }
            __builtin_amdgcn_sched_barrier(0);
#pragma unroll
            for (int u = 0; u < 8; ++u) { const int idx = idx0 + u * NGT;
                if (idx < NW_) { const int ri = idx & 1; const float cr = crv[u], cim_ = civ[u], pr = pw_[u].x, pi_ = pw_[u].y;
                    S5A2[idx] = (bf16_t)f2bf(ri ? -(cr * pi_ + cim_ * pr) : (cr * pr - cim_ * pi_)); } }
            __builtin_amdgcn_sched_barrier(0);
        }
    }
    PH_END();
    if (PH_ON()) { DECL_PTRS();
        for (int t0 = gw * 4; t0 < T; t0 += NGW * 4) {
            const int b = t0 / S; const float* mo = MOD + (size_t)(0 * 2 + b) * 6144;
            f32x4 v[4][4], sc1[4], sh1[4];
#pragma unroll
            for (int u = 0; u < 4; ++u)
#pragma unroll
                for (int j = 0; j < 4; ++j) v[u][j] = *(const f32x4*)(xin + (size_t)(t0 + u) * 1024 + 4 * lane + 256 * j);
#pragma unroll
            for (int j = 0; j < 4; ++j) { sc1[j] = *(const f32x4*)(mo + 1024 + 4 * lane + 256 * j); sh1[j] = *(const f32x4*)(mo + 4 * lane + 256 * j); }
            __builtin_amdgcn_sched_barrier(0);
#pragma unroll
            for (int u = 0; u < 4; ++u) { float ss = 0.f;
#pragma unroll
                for (int j = 0; j < 4; ++j) ss += (v[u][j].x * v[u][j].x + v[u][j].y * v[u][j].y) + (v[u][j].z * v[u][j].z + v[u][j].w * v[u][j].w);
                const float rn = rsqrtf(wave_sum(ss) * (1.0f / 1024.0f) + EPS);
#pragma unroll
                for (int j = 0; j < 4; ++j) { const int col = 4 * lane + 256 * j;
                    u32x2 w; w.x = pk2(v[u][j].x * rn * (1.f + sc1[j].x) + sh1[j].x, v[u][j].y * rn * (1.f + sc1[j].y) + sh1[j].y); w.y = pk2(v[u][j].z * rn * (1.f + sc1[j].z) + sh1[j].z, v[u][j].w * rn * (1.f + sc1[j].w) + sh1[j].w);
                    *(u32x2*)(H + (size_t)(t0 + u) * 1024 + col) = w; } }
            __builtin_amdgcn_sched_barrier(0);
        }
    }
    PH_END();

    for (l0 = 0; l0 < DEPTH; ++l0) {
        if ((l0 & 1) == 0) {
            if (PH_ON()) { DECL_PTRS();
                pg8::Gemm g{H, Wevin + (size_t)i * EV_NP * 1024, T, EV_NP, 1024, 0}; pg8::StaticOrder So; So.init(T, EV_NP, G, c);
                EpiEvenIn E{Z, IQH, IKH, IW, a_kn + i * 64, b_kn + i * 64, b_idx_kn + i * 32, COSH, SINH, COSI, SINI};
                { PROBE_WRAP(pg8::StaticOrder, So); pg8::gemm_phase<EpiEvenIn, PROBE_SCHED(pg8::StaticOrder), true, true>(glds, g, PS_, E, tid); }
            }
            PH_END();
            if (PH_ON()) { DECL_PTRS();
                moe_convert(moe_w1 + (size_t)l * 32 * 1024 * 512, moe_w3 + (size_t)l * 32 * 1024 * 512, moe_w2 + (size_t)l * 32 * 512 * 1024, W13, W2, scr, gw, NGW, lane);
                __syncthreads();
                {
                    LAS unsigned short* kq = (LAS unsigned short*)lds;
                    const int qi = tid >> 7, ht = tid & 127;
                    LAS unsigned short* kqq = kq + qi * 16384;
                    LAS unsigned* hist = (LAS unsigned*)(lds + LDS_MISC + qi * 6400);
                    LAS unsigned* bits = hist + 1024;
                    LAS unsigned* misc = hist + 1536;
                    typedef _Float16 f16x8_t __attribute__((ext_vector_type(8)));
                    f16x8_t qaN[2], kbN[4][2]; f32x4 wqN[4];
                    auto issue_unit = [&](int it_) {
                        const int lane_ = lane_id_v(), r32 = lane_ & 31, hi = lane_ >> 5, wid_ = lsg(wid0);
                        const int L_ = min(it_ * G + c, 8191);
                        const int uu_ = (L_ & 1) ? (8191 - (L_ >> 1)) : (L_ >> 1); const int b_ = uu_ >> 12, pp_ = uu_ & 4095;
                        const size_t tA_ = (size_t)b_ * S + 4 * pp_; const int ntile_ = (4 * pp_ + 4 + 31) >> 5;
#pragma unroll
                        for (int s = 0; s < 2; ++s) qaN[s] = *(const f16x8_t*)(IQH + (tA_ + 2 * ((r32 >> 2) & 1) + (r32 >> 4)) * 256 + (4 * ((r32 >> 3) & 1) + (r32 & 3)) * 32 + 16 * s + 8 * hi);
#pragma unroll
                        for (int q = 0; q < 4; ++q) wqN[q] = *(const f32x4*)(IW + (tA_ + 2 * hi + (q >> 1)) * 8 + 4 * (q & 1));
                        const _Float16* kbase_ = IKH + ((size_t)b_ * S + r32) * 32 + 8 * hi;
#pragma unroll
                        for (int u = 0; u < 4; ++u) { const int tile = min(wid_ + NWAVES * u, ntile_ - 1);
                            kbN[u][0] = *(const f16x8_t*)(kbase_ + (size_t)tile * 1024); kbN[u][1] = *(const f16x8_t*)(kbase_ + (size_t)tile * 1024 + 16); } };
                    issue_unit(0);
                    for (int it = 0;; ++it) {
                        const int L = it * G + c; if (L >= 8192) break;
                        const int uu = (L & 1) ? (8191 - (L >> 1)) : (L >> 1);
                        const int b = uu >> 12, pp = uu & 4095;
                        const size_t tA = (size_t)b * S + 4 * pp;
                        const int nD = 4 * pp + 4;
#pragma unroll
                        for (int q = 0; q < 8; ++q) hist[ht + 128 * q] = 0u;
                        __syncthreads();
#ifdef PROBE_MASK
                        if (a.probe_var != 2)
#endif
                        {
                            const int r32 = lane & 31, hi = lane >> 5;
                            f16x8_t qa[2]; qa[0] = qaN[0]; qa[1] = qaN[1];
                            f32x4 wq[4];
#pragma unroll
                            for (int q = 0; q < 4; ++q) wq[q] = wqN[q];
                            const int ntile = (nD + 31) >> 5;
                            const _Float16* kbase = IKH + ((size_t)b * S + r32) * 32 + 8 * hi;
                            f16x8_t kb[4][2], kn[4][2];
#pragma unroll
                            for (int u = 0; u < 4; ++u) { kb[u][0] = kbN[u][0]; kb[u][1] = kbN[u][1]; }
                            for (int tile0 = wid; tile0 < ntile; tile0 += NWAVES * 4) {
#pragma unroll
                                for (int u = 0; u < 4; ++u) { const int tile = min(tile0 + NWAVES * (4 + u), ntile - 1);
                                    kn[u][0] = *(const f16x8_t*)(kbase + (size_t)tile * 1024); kn[u][1] = *(const f16x8_t*)(kbase + (size_t)tile * 1024 + 16); }
#pragma unroll
                                for (int u = 0; u < 4; ++u) {
                                    const int tile = tile0 + NWAVES * u;
                                    attn_body::f32x16 acc;
#pragma unroll
                                    for (int r = 0; r < 16; ++r) acc[r] = 0.f;
                                    acc = __builtin_amdgcn_mfma_f32_32x32x16_f16(qa[0], kb[u][0], acc, 0, 0, 0);
                                    acc = __builtin_amdgcn_mfma_f32_32x32x16_f16(qa[1], kb[u][1], acc, 0, 0, 0);
                                    float sq[4];
#pragma unroll
                                    for (int q = 0; q < 4; ++q) sq[q] = wq[q].x * relu_i(acc[4 * q]) + wq[q].y * relu_i(acc[4 * q + 1]) + wq[q].z * relu_i(acc[4 * q + 2]) + wq[q].w * relu_i(acc[4 * q + 3]);
                                    if (tile < ntile) {
                                        const float sa = sq[0] + sq[1], sb = sq[2] + sq[3];
                                        const unsigned h0 = (unsigned)__builtin_bit_cast(unsigned short, (_Float16)sa), h1 = (unsigned)__builtin_bit_cast(unsigned short, (_Float16)sb);
                                        const unsigned k0_ = (h0 ^ ((unsigned)__builtin_amdgcn_sbfe((int)h0, 15, 1) | 0x8000u)) & 0xFFFFu, k1_ = (h1 ^ ((unsigned)__builtin_amdgcn_sbfe((int)h1, 15, 1) | 0x8000u)) & 0xFFFFu;
                                        const int kidx = tile * 32 + r32;
                                        kq[(2 * hi) * 16384 + kidx] = (unsigned short)k0_;
                                        kq[(2 * hi + 1) * 16384 + kidx] = (unsigned short)k1_;
                                        LAS unsigned* hq0 = (LAS unsigned*)(lds + LDS_MISC + (2 * hi) * 6400); LAS unsigned* hq1 = (LAS unsigned*)(lds + LDS_MISC + (2 * hi + 1) * 6400);
                                        __hip_atomic_fetch_add(&hq0[(kidx <= 4 * pp + 2 * hi) ? ((k0_ >> 8) << 2) + (lane & 3) : 1536 + 32 + (lane & 3)], 1u, __ATOMIC_RELAXED, __HIP_MEMORY_SCOPE_WORKGROUP);
                                        __hip_atomic_fetch_add(&hq1[(kidx <= 4 * pp + 2 * hi + 1) ? ((k1_ >> 8) << 2) + (lane & 3) : 1536 + 32 + (lane & 3)], 1u, __ATOMIC_RELAXED, __HIP_MEMORY_SCOPE_WORKGROUP);
                                    }
                                }
#pragma unroll
                                for (int u = 0; u < 4; ++u) { kb[u][0] = kn[u][0]; kb[u][1] = kn[u][1]; }
                            }
                            issue_unit(it + 1);
                        }
                        __syncthreads();
#ifdef PROBE_MASK
                        if (a.probe_var == 1) continue;
#endif
                        const int n = 4 * pp + 1 + qi;
                        const bool small = n <= 256;
                        if (ht == 0) { misc[0] = 0u; misc[1] = 256u; misc[2] = 0u; }
                        const LAS unsigned* kq32 = (const LAS unsigned*)kqq;
                        const int npair = (n + 1) >> 1;
                        for (int pass = 0; pass < 2; ++pass) {
                            if (pass) {
#pragma unroll
                                for (int q = 0; q < 8; ++q) hist[ht + 128 * q] = 0u; }
                            __syncthreads();
                            const int shift = 8 - 8 * pass;
                            if (!small && pass) {
                                const unsigned prefix = misc[0];
                                for (int W = ht; 32 * W < n; W += 128) {
                                    const unsigned vmask = (n - 32 * W >= 32) ? 0xFFFFFFFFu : ((1u << (n - 32 * W)) - 1u);
                                    const LAS u32x4* kp = (const LAS u32x4*)(kq32 + 16 * W);
                                    unsigned ne = 0u;
                                    const unsigned pp2 = prefix | (prefix << 16);
#pragma unroll
                                    for (int q4 = 0; q4 < 4; ++q4) { const u32x4 w4 = kp[q4];
#pragma unroll
                                        for (int e = 0; e < 4; ++e) ne |= pk_gt_u16((w4[e] ^ pp2) & 0xFF00FF00u, 0u, 0x00010001u) << (4 * q4 + e); }
                                    unsigned mm = ilv16(~ne) & vmask;
                                    const LAS unsigned short* k16 = kqq + 32 * W;
                                    while (mm) { const int j = __ffs(mm) - 1; mm &= mm - 1u;
                                        __hip_atomic_fetch_add(&hist[(((unsigned)k16[j] & 255u) << 2) + (lane & 3)], 1u, __ATOMIC_RELAXED, __HIP_MEMORY_SCOPE_WORKGROUP); }
                                }
                            }
                            __syncthreads();
                            if (!small && ht < 64) {
                                unsigned cb[4];
#pragma unroll
                                for (int q = 0; q < 4; ++q) { const u32x4 a0 = *(const LAS u32x4*)(hist + (4 * ht + q) * 4); cb[q] = (a0.x + a0.y) + (a0.z + a0.w); }
                                const unsigned c0 = cb[0], c1 = cb[1], c2 = cb[2], c3 = cb[3];
                                const unsigned tot = c0 + c1 + c2 + c3;
                                unsigned Ssum = tot;
#pragma unroll
                                for (int off = 1; off < 64; off <<= 1) { const unsigned v = shi_(Ssum, lane + off); if (ht + off < 64) Ssum += v; }
                                const unsigned above = Ssum - tot, krem = misc[1];
                                if (above < krem && krem <= Ssum) {
                                    unsigned run = above, bin, eq;
                                    if (run + c3 >= krem) { bin = 3; eq = c3; }
                                    else { run += c3; if (run + c2 >= krem) { bin = 2; eq = c2; }
                                        else { run += c2; if (run + c1 >= krem) { bin = 1; eq = c1; } else { run += c1; bin = 0; eq = c0; } } }
                                    misc[0] = misc[0] | ((4u * ht + bin) << shift); misc[1] = krem - run; misc[2] = eq;
                                }
                            }
                            __syncthreads();
                        }
#ifdef PROBE_MASK
                        if (a.probe_var == 8) { __syncthreads(); continue; }
#endif
                        const unsigned Tkey = misc[0], krem = misc[1], cnteq = misc[2];
                        LAS unsigned* eqb = hist;
                        const bool all_eq = (cnteq == krem);
                        for (int W = ht; W < 512; W += 128) {
                            unsigned sel = 0u, eqm = 0u;
                            if (32 * W < n) {
                                const unsigned vmask = (n - 32 * W >= 32) ? 0xFFFFFFFFu : ((1u << (n - 32 * W)) - 1u);
                                if (small) sel = vmask;
                                else {
                                    const LAS u32x4* kp = (const LAS u32x4*)(kq32 + 16 * W);
                                    const unsigned tp2 = Tkey | (Tkey << 16);
                                    unsigned ag = 0u, al = 0u;
#pragma unroll
                                    for (int q4 = 0; q4 < 4; ++q4) { const u32x4 w4 = kp[q4];
#pragma unroll
                                        for (int e = 0; e < 4; ++e) { ag |= pk_gt_u16(w4[e], tp2, 0x00010001u) << (4 * q4 + e); al |= pk_gt_u16(tp2, w4[e], 0x00010001u) << (4 * q4 + e); } }
                                    sel = ilv16(ag); eqm = ilv16(~(ag | al));
                                    if (all_eq) { sel |= eqm; eqm = 0u; }
                                    sel &= vmask; eqm &= vmask;
                                }
                            }
                            bits[W] = sel; eqb[W] = eqm;
                        }
                        __syncthreads();
                        if (!small && !all_eq && ht < 64) {
                            unsigned wv_[8]; unsigned cnt = 0u;
#pragma unroll
                            for (int q = 0; q < 8; ++q) { wv_[q] = eqb[8 * ht + q]; cnt += (unsigned)__popc(wv_[q]); }
                            unsigned inc = cnt;
#pragma unroll
                            for (int off = 1; off < 64; off <<= 1) { const unsigned v = shi_(inc, lane - off); if (lane >= off) inc += v; }
                            unsigned before = inc - cnt;
#pragma unroll
                            for (int q = 0; q < 8; ++q) { unsigned w = wv_[q], keep = 0u;
                                while (w && before < krem) { const unsigned lowb = w & (0u - w); keep |= lowb; w ^= lowb; ++before; }
                                before += (unsigned)__popc(w);
                                if (keep) __hip_atomic_fetch_or(&bits[8 * ht + q], keep, __ATOMIC_RELAXED, __HIP_MEMORY_SCOPE_WORKGROUP); }
                        }
                        __syncthreads();
                        {
                            const int qpos = 4 * pp + qi; const int tmax = 8 * (qpos >> 9) + 7;
#pragma unroll
                            for (int j = 0; j < 2; ++j) { const int tt = 2 * ht + j;
                                if (tt <= tmax) { const unsigned W0 = bits[2 * tt], W1 = bits[2 * tt + 1];
                                    unsigned e0 = W0 & 0x0F0F0F0Fu, e1 = W1 & 0x0F0F0F0Fu, o0 = (W0 >> 4) & 0x0F0F0F0Fu, o1 = (W1 >> 4) & 0x0F0F0F0Fu;
                                    e0 = (e0 | (e0 >> 4)) & 0x00FF00FFu; e0 = (e0 | (e0 >> 8)) & 0xFFFFu; e1 = (e1 | (e1 >> 4)) & 0x00FF00FFu; e1 = (e1 | (e1 >> 8)) & 0xFFFFu;
                                    o0 = (o0 | (o0 >> 4)) & 0x00FF00FFu; o0 = (o0 | (o0 >> 8)) & 0xFFFFu; o1 = (o1 | (o1 >> 4)) & 0x00FF00FFu; o1 = (o1 | (o1 >> 8)) & 0xFFFFu;
                                    u32x2 pm; pm.x = e0 | (e1 << 16); pm.y = o0 | (o1 << 16);
                                    *(u32x2*)(MASKW + (((size_t)(b * 256 + tt)) * S + qpos) * 2) = pm; } }
                        }
                        __syncthreads();
                    }
                }
                __syncthreads();
                {
                    bf16_t* OA = YMIX;
                    const int vcu = (G % 8 == 0) ? (c % 8) * (G / 8) + c / 8 : c;
                    const int nu = (G == 256) ? 4 : (1024 - vcu + G - 1) / G;
                    for (int iu = 0; iu < nu; ++iu) {
                        const int lane = lane_id_v(), wid = lsg(wid0);
                        LAS unsigned char* L0 = lsgp(lds0);
                        int combo, qb;
                        if (G == 256) { combo = vcu >> 4; const int s_ = vcu & 15; qb = iu == 0 ? s_ : iu == 1 ? 31 - s_ : iu == 2 ? 32 + s_ : 63 - s_; }
                        else { const int u = vcu + iu * G; combo = u & 15; qb = 63 - (u >> 4); }
                        const int b = combo >> 3, hc = combo & 7;
                        const bf16_t* zb = Z + (size_t)b * S * EV_ZP;
                        if (qk_bounded(a_qn + i * 64, a_kn + i * 64, lane))
                            flash_unit<2, false, true, EV_ZP, 1024, true>(L0, zb + hc * 64, zb + 512 + hc * 64, zb + 1024 + (hc >> 1) * 128, OA + (size_t)b * S * 1024 + hc * 128, nullptr, qb, wid, lane, a_qn + i * 64, COSH, SINH);
                        else
                            flash_unit<2, false, true, EV_ZP, 1024, false>(L0, zb + hc * 64, zb + 512 + hc * 64, zb + 1024 + (hc >> 1) * 128, OA + (size_t)b * S * 1024 + hc * 128, nullptr, qb, wid, lane, a_qn + i * 64, COSH, SINH);
                    }
                }
            }
            PH_END();
            if (PH_ON()) { DECL_PTRS();
                {
                    const bf16_t* OA = YMIX; const float lamv = LAM[i]; const float lam_init = 0.8f - 0.6f * expf(-0.3f * (float)l);
                    const int h = lane >> 4, vj = (lane >> 3) & 1, d8 = (lane & 7) * 8;
                    float gn[8];
#pragma unroll
                    for (int e = 0; e < 8; ++e) gn[e] = a_subln[i * 128 + vj * 64 + d8 + e] * (1.0f - lam_init);
                    for (int t0 = gw * 4; t0 < T; t0 += NGW * 4) {
                        u32x4 r1[4], r2[4];
#pragma unroll
                        for (int u = 0; u < 4; ++u) { r1[u] = *(const u32x4*)(OA + (size_t)(t0 + u) * 1024 + ((h * 2 + 0) * 2 + vj) * 64 + d8); r2[u] = *(const u32x4*)(OA + (size_t)(t0 + u) * 1024 + ((h * 2 + 1) * 2 + vj) * 64 + d8); }
                        __builtin_amdgcn_sched_barrier(0);
#pragma unroll
                        for (int u = 0; u < 4; ++u) {
                            float o1[8], o2[8], dd[8]; unpack8(r1[u], o1); unpack8(r2[u], o2);
                            float ss = 0.f;
#pragma unroll
                            for (int e = 0; e < 8; ++e) { dd[e] = o1[e] - lamv * o2[e]; ss += dd[e] * dd[e]; }
                            ss += dpp_xor1(ss); ss += dpp_xor2(ss); ss += SHX(ss, 4); ss += SHX(ss, 8);
                            const float r = rsqrtf(ss * (1.0f / 128.0f) + EPS);
#pragma unroll
                            for (int e = 0; e < 8; ++e) dd[e] = dd[e] * r * gn[e];
                            *(u32x4*)(O + (size_t)(t0 + u) * 1024 + h * 128 + vj * 64 + d8) = pack8(dd);
                        }
                        __builtin_amdgcn_sched_barrier(0);
                    }
                }
                {
                    const int vcu = (G % 8 == 0) ? (c % 8) * (G / 8) + c / 8 : c;
                    const int nu = (G == 256) ? 2 : (512 - vcu + G - 1) / G;
                    for (int iu = 0; iu < nu; ++iu) {
                        const int lane = lane_id_v(), wid = lsg(wid0);
                        LAS unsigned char* L0 = lsgp(lds0);
                        int combo, qb;
                        if (G == 256) { combo = vcu >> 4; const int s_ = vcu & 15; qb = iu == 0 ? s_ : 31 - s_; }
                        else { const int u = vcu + iu * G; combo = u & 15; qb = 31 - (u >> 4); }
                        const int b = combo >> 3, h = combo & 7;
                        const bf16_t* zb = Z + (size_t)b * S * EV_ZP;
                        if (qk_bounded(b_qn + i * 64, b_kn + i * 64, lane))
                            flash_unit_q2<1, true, false, EV_ZP, 1024, true>(L0, zb + 1536 + h * 64, zb + 2048 + h * 64, zb + 2560 + h * 64, O + (size_t)b * S * 1024 + 512 + h * 64, MASKW + (size_t)b * 256 * S * 2, qb, wid, lane, b_qn + i * 64, COSH, SINH);
                        else
                            flash_unit_q2<1, true, false, EV_ZP, 1024, false>(L0, zb + 1536 + h * 64, zb + 2048 + h * 64, zb + 2560 + h * 64, O + (size_t)b * S * 1024 + 512 + h * 64, MASKW + (size_t)b * 256 * S * 2, qb, wid, lane, b_qn + i * 64, COSH, SINH);
                    }
                }
            }
            PH_END();
        } else {
            if (PH_ON()) { DECL_PTRS();
                pg8::Gemm g{H, Wodin + (size_t)i * OD_N * 1024, T, OD_N, 1024, 0}; pg8::StaticOrder So; So.init(T, OD_N, G, c);
                EpiOddIn E{Z, UG, c_kn + i * 64, COSH, SINH};
                { PROBE_WRAP(pg8::StaticOrder, So); pg8::gemm_phase<EpiOddIn, PROBE_SCHED(pg8::StaticOrder), true, true>(glds, g, PS_, E, tid); }
            }
            PH_END();
            if (PH_ON()) { DECL_PTRS();
                moe_convert(moe_w1 + (size_t)l * 32 * 1024 * 512, moe_w3 + (size_t)l * 32 * 1024 * 512, moe_w2 + (size_t)l * 32 * 512 * 1024, W13, W2, scr, gw, NGW, lane);
                __syncthreads();
                for (int u = gw; u < NB * 64 * 8; u += NGW) {
                    const int h = u & 7, blk = (u >> 3) & 63, b = u >> 9;
                    const int rs = lane >> 3, d8 = (lane & 7) * 8;
                    const bf16_t* kp = Z + ((size_t)b * S + blk * 256 + rs) * OD_N + 512 + h * 64 + d8;
                    u32x4 kr[32];
#pragma unroll
                    for (int j = 0; j < 32; ++j) kr[j] = *(const u32x4*)(kp + (size_t)(8 * j) * OD_N);
                    __builtin_amdgcn_sched_barrier(0);
                    float sm[8];
#pragma unroll
                    for (int e = 0; e < 8; ++e) sm[e] = 0.f;
#pragma unroll
                    for (int j = 0; j < 32; ++j) { float kv[8]; unpack8(kr[j], kv);
#pragma unroll
                        for (int e = 0; e < 8; ++e) sm[e] += kv[e]; }
#pragma unroll
                    for (int e = 0; e < 8; ++e) { sm[e] += SHX(sm[e], 8); sm[e] += SHX(sm[e], 16); sm[e] += SHX(sm[e], 32); sm[e] *= (1.0f / 256.0f); }
                    if (rs == 0) {
                        *(f32x4*)(KM + (size_t)u * 64 + d8) = (f32x4){sm[0], sm[1], sm[2], sm[3]}; *(f32x4*)(KM + (size_t)u * 64 + d8 + 4) = (f32x4){sm[4], sm[5], sm[6], sm[7]};
                        const u32x4 hw = pack8(sm); float hf[8], lo[8]; unpack8(hw, hf);
#pragma unroll
                        for (int e = 0; e < 8; ++e) lo[e] = sm[e] - hf[e];
                        *(u32x4*)(KMH + ((size_t)(b * 8 + h) * 64 + blk) * 64 + d8) = hw; *(u32x4*)(KML + ((size_t)(b * 8 + h) * 64 + blk) * 64 + d8) = pack8(lo);
                    }
                }
                {
                    const int r32 = lane & 31, hi = lane >> 5;
                    LAS unsigned char* ldsU = lds;
                    LAS float* red = (LAS float*)(lds + 69632);
                    for (int task = c; task < 512; task += G) {
                        const int g = task >> 4, cs = task & 15;
                        for (int q = tid; q < 32 * 128; q += NTHREADS) { const int j = q >> 7, off = (q & 127) * 16;
                            *(LAS u32x4*)(ldsU + j * 2064 + off) = *(const u32x4*)((const unsigned char*)UG + ((size_t)g * T + (size_t)(cs * 32 + j) * 64) * 32 + off); }
                        __syncthreads();
                        const int rb = wid & 3, kh = wid >> 2;
                        attn_body::f32x16 acc;
#pragma unroll
                        for (int r = 0; r < 16; ++r) acc[r] = 0.f;
                        const bf16_t* wrow = S5WT + ((size_t)(i * 32 + g) * 128 + rb * 32 + r32) * 1024 + hi * 8;
#pragma unroll 8
                        for (int ks = kh * 32; ks < kh * 32 + 32; ++ks) {
                            const attn_body::bf16x8 A = *(const attn_body::bf16x8*)(wrow + ks * 16);
                            const attn_body::bf16x8 B = *(const LAS attn_body::bf16x8*)(ldsU + r32 * 2064 + ks * 32 + hi * 16);
                            acc = __builtin_amdgcn_mfma_f32_32x32x16_bf16(A, B, acc, 0, 0, 0);
                        }
                        if (kh == 1) {
#pragma unroll
                            for (int r = 0; r < 16; ++r) red[(rb * 64 + lane) * 16 + r] = acc[r];
                        }
                        __syncthreads();
                        if (kh == 0) {
                            float* ep = S5E + ((size_t)(cs * 32 + r32) * 32 + g) * 128 + rb * 32 + 4 * hi;
#pragma unroll
                            for (int q4 = 0; q4 < 4; ++q4) { f32x4 o;
                                o.x = acc[4 * q4] + red[(rb * 64 + lane) * 16 + 4 * q4]; o.y = acc[4 * q4 + 1] + red[(rb * 64 + lane) * 16 + 4 * q4 + 1];
                                o.z = acc[4 * q4 + 2] + red[(rb * 64 + lane) * 16 + 4 * q4 + 2]; o.w = acc[4 * q4 + 3] + red[(rb * 64 + lane) * 16 + 4 * q4 + 3];
                                *(f32x4*)(ep + 8 * q4) = o; }
                        }
                        __syncthreads();
                    }
                }
            }
            PH_END();
            if (PH_ON()) { DECL_PTRS();
#ifndef SKIP_S5
                {
                    for (int idx = gt; idx < NB * 32 * 64; idx += NGT) {
                        const int b = idx >> 11, g = (idx >> 6) & 31, p = idx & 63;
                        const int sp = (i * 32 + g) * 64 + p;
                        const float aLr = S5PW[((size_t)sp * 65 + 64) * 2], aLi = S5PW[((size_t)sp * 65 + 64) * 2 + 1];
                        float hr = 0.f, hi_ = 0.f;
                        for (int c0 = 0; c0 < 256; c0 += 32) {
                            float er[32], ei[32];
#pragma unroll
                            for (int k = 0; k < 32; ++k) { const float* ep = S5E + ((size_t)(b * 256 + c0 + k) * 32 + g) * 128 + 2 * p; er[k] = ep[0]; ei[k] = ep[1]; }
                            __builtin_amdgcn_sched_barrier(0);
#pragma unroll
                            for (int k = 0; k < 32; ++k) {
                                *(unsigned*)(S5HC + ((size_t)(b * 256 + c0 + k) * 32 + g) * 128 + 2 * p) = pk2(hr, hi_);
                                const float nr = aLr * hr - aLi * hi_ + er[k], ni = aLr * hi_ + aLi * hr + ei[k]; hr = nr; hi_ = ni; }
                        }
                    }
                }
#endif
                {
                    unsigned* mcnt = ctl + CW_MCNT + i * 1024;
                    const int r32 = lane & 31, hi = lane >> 5;
                    for (int u = c; u < NB * 8 * 64; u += G) {
                        const int tb = u & 63, h = (u >> 6) & 7, b = u >> 9;
                        const int pos = tb * 256 + wid * 32 + r32; const size_t t = (size_t)b * S + pos;
                        float tv[3] = {-INFINITY, -INFINITY, -INFINITY}; int ti[3] = {1 << 20, 1 << 20, 1 << 20};
                        if (tb > 0) {
                            attn_body::bf16x8 qr[4];
                            load_q_normed(qr, Z + t * OD_N + h * 64, c_qn + i * 64, COSH, SINH, pos, hi, lane);
                            attn_body::f32x16 g0, g1;
#pragma unroll
                            for (int r = 0; r < 16; ++r) { g0[r] = 0.f; g1[r] = 0.f; }
                            const bf16_t* kh = KMH + ((size_t)(b * 8 + h) * 64 + r32) * 64 + hi * 8; const bf16_t* kl = KML + ((size_t)(b * 8 + h) * 64 + r32) * 64 + hi * 8;
#pragma unroll
                            for (int d0 = 0; d0 < 4; ++d0) {
                                g0 = __builtin_amdgcn_mfma_f32_32x32x16_bf16(*(const attn_body::bf16x8*)(kh + d0 * 16), qr[d0], g0, 0, 0, 0);
                                g0 = __builtin_amdgcn_mfma_f32_32x32x16_bf16(*(const attn_body::bf16x8*)(kl + d0 * 16), qr[d0], g0, 0, 0, 0);
                                if (tb > 32) { g1 = __builtin_amdgcn_mfma_f32_32x32x16_bf16(*(const attn_body::bf16x8*)(kh + 32 * 64 + d0 * 16), qr[d0], g1, 0, 0, 0);
                                               g1 = __builtin_amdgcn_mfma_f32_32x32x16_bf16(*(const attn_body::bf16x8*)(kl + 32 * 64 + d0 * 16), qr[d0], g1, 0, 0, 0); } }
#pragma unroll
                            for (int half = 0; half < 2; ++half)
#pragma unroll
                                for (int r = 0; r < 16; ++r) { const int n = half * 32 + attn_body::crow(r, hi); const float gv = (n < tb) ? (half ? g1[r] : g0[r]) : -INFINITY;
                                    if (gv > tv[0]) { tv[2] = tv[1]; ti[2] = ti[1]; tv[1] = tv[0]; ti[1] = ti[0]; tv[0] = gv; ti[0] = n; }
                                    else if (gv > tv[1]) { tv[2] = tv[1]; ti[2] = ti[1]; tv[1] = gv; ti[1] = n; }
                                    else if (gv > tv[2]) { tv[2] = gv; ti[2] = n; } }
                            float pv_[3]; int pi_[3];
#pragma unroll
                            for (int k = 0; k < 3; ++k) { pv_[k] = SHX(tv[k], 32); pi_[k] = (int)shi_((unsigned)ti[k], lane ^ 32); }
                            float mv[3]; int mi[3]; int ia = 0, ib = 0;
#pragma unroll
                            for (int k = 0; k < 3; ++k) {
                                const float av = ia == 0 ? tv[0] : ia == 1 ? tv[1] : ia == 2 ? tv[2] : -INFINITY; const int ai = ia == 0 ? ti[0] : ia == 1 ? ti[1] : ia == 2 ? ti[2] : (1 << 20);
                                const float bv = ib == 0 ? pv_[0] : ib == 1 ? pv_[1] : ib == 2 ? pv_[2] : -INFINITY; const int bi = ib == 0 ? pi_[0] : ib == 1 ? pi_[1] : ib == 2 ? pi_[2] : (1 << 20);
                                const bool ta = (av > bv) || (av == bv && ai < bi);
                                mv[k] = ta ? av : bv; mi[k] = ta ? ai : bi; if (ta) ++ia; else ++ib; }
#pragma unroll
                            for (int k = 0; k < 3; ++k) { tv[k] = mv[k]; ti[k] = mi[k]; }
                        }
#ifdef PROBE_MASK
                        if (a.probe_var == 3) { if (ti[0] + ti[1] + ti[2] == -12345) NSEL[0] = 1; continue; }
#endif
                        if (hi == 0) {
                            unsigned idx[3];
#pragma unroll
                            for (int sI = 0; sI < 3; ++sI) { idx[sI] = 0u;
                                if (tv[sI] > -INFINITY) idx[sI] = __hip_atomic_fetch_add(mcnt + (b * 8 + h) * 64 + ti[sI], 1u, __ATOMIC_RELAXED, __HIP_MEMORY_SCOPE_AGENT); }
                            int nsel = 0;
#pragma unroll
                            for (int sI = 0; sI < 3; ++sI)
                                if (tv[sI] > -INFINITY) { const int li = (b * 8 + h) * 64 + ti[sI]; MLIST[(size_t)li * 16384 + idx[sI]] = (pos << 2) | nsel; ++nsel; }
                            NSEL[t * 8 + h] = nsel;
                        }
                    }
                }
            }
            PH_END();
            if (PH_ON()) { DECL_PTRS();
                {
                    const unsigned* mcnt = ctl + CW_MCNT + i * 1024;
                    LAS int* pref = (LAS int*)(lds + LDS_MISC);
                    if (wid == 0) {
                        int loc[16]; int sum = 0;
#pragma unroll
                        for (int k = 0; k < 16; ++k) loc[k] = (int)__hip_atomic_load(mcnt + lane * 16 + k, __ATOMIC_RELAXED, __HIP_MEMORY_SCOPE_AGENT);
                        __builtin_amdgcn_sched_barrier(0);
#pragma unroll
                        for (int k = 0; k < 16; ++k) { const int cnt = loc[k]; loc[k] = sum; sum += (cnt + 255) >> 8; }
                        int inc = sum;
#pragma unroll
                        for (int off = 1; off < 64; off <<= 1) { const int v = (int)shi_((unsigned)inc, lane - off); if (lane >= off) inc += v; }
                        const int base = inc - sum;
#pragma unroll
                        for (int k = 0; k < 16; ++k) pref[lane * 16 + k] = base + loc[k];
                        if (lane == 63) pref[1024] = inc;
                    }
                    __syncthreads();
                    const int NTsel = pref[1024];
                    auto decode = [&](int task_, int& li_o, int& chunk_o, bool& own_o) { own_o = task_ >= NTsel; chunk_o = 0;
                        if (own_o) li_o = task_ - NTsel;
                        else { int lo_ = 0, hi_ = 1023; while (lo_ < hi_) { const int mid = (lo_ + hi_ + 1) >> 1; if (pref[mid] <= task_) lo_ = mid; else hi_ = mid - 1; } li_o = lo_; chunk_o = task_ - pref[lo_]; } };
                    int nx_li = 0, nx_chunk = 0, nx_ent = 0, nx_cnt = 256; bool nx_own = true;
                    if (c < NTsel + 1024) { decode(c, nx_li, nx_chunk, nx_own);
                        if (!nx_own) { const int ln_ = lane_id_v(); nx_ent = MLIST[(size_t)nx_li * 16384 + nx_chunk * 256 + lsg(wid0) * 32 + (ln_ & 31)]; nx_cnt = (int)__hip_atomic_load(mcnt + nx_li, __ATOMIC_RELAXED, __HIP_MEMORY_SCOPE_AGENT); } }
                    for (int task = c; task < NTsel + 1024; task += G) {
                        const int lane = lane_id_v(), wid = lsg(wid0), r32 = lane & 31, hi = lane >> 5;
                        LAS unsigned char* ldsKs = lsgp(lds0); LAS unsigned char* ldsVs = ldsKs + 32768;
                        LAS bf16_t* stg = (LAS bf16_t*)(ldsKs + 65536 + wid * 4096); LAS float* wsf = (LAS float*)(ldsKs + 98304 + wid * 256); LAS int* rowd = (LAS int*)(ldsKs + 100352 + wid * 128);
                        const bool own_task = nx_own;
                        const int li = nx_li, chunk = nx_chunk;
                        const int b = li >> 9, h = (li >> 6) & 7, blk = li & 63;
                        const int e_ = chunk * 256 + wid * 32 + r32;
                        const int cnt = nx_cnt;
                        const int ent_ = nx_ent;
                        u32x4 kst[4], vst[4];
                        {
                            const bf16_t* kbp = Z + ((size_t)b * S + blk * 256) * OD_N + 512 + h * 64;
                            const bf16_t* vbp = Z + ((size_t)b * S + blk * 256) * OD_N + 1024 + h * 64;
#pragma unroll
                            for (int kt = 0; kt < 4; ++kt) {
                                kst[kt] = *(const u32x4*)(kbp + (size_t)(kt * 64 + lane) * OD_N + wid * 8);
                                vst[kt] = *(const u32x4*)(vbp + (size_t)(kt * 64 + 16 * (wid & 3) + (lane >> 2)) * OD_N + (wid >> 2) * 32 + (lane & 3) * 8);
                            }
                        }
                        __builtin_amdgcn_sched_barrier(0);
                        int posq, slot; bool valid;
                        if (own_task) { posq = blk * 256 + wid * 32 + r32; slot = 3; valid = true; }
                        else { valid = e_ < cnt; posq = valid ? (ent_ >> 2) : 0; slot = ent_ & 3; }
                        const size_t tq = (size_t)b * S + posq;
                        const int dest = valid ? (int)((tq * 8 + h) * 4 + slot) : -1;
                        attn_body::bf16x8 qr[4];
                        load_q_normed(qr, Z + tq * OD_N + h * 64, c_qn + i * 64, COSH, SINH, posq, hi, lane);
#pragma unroll
                        for (int kt = 0; kt < 4; ++kt) { *(LAS u32x4*)(ldsKs + kt * 8192 + wid * 1024 + lane * 16) = kst[kt]; *(LAS u32x4*)(ldsVs + kt * 8192 + wid * 1024 + lane * 16) = vst[kt]; }
                        nx_own = true; nx_li = 0; nx_chunk = 0; nx_ent = 0; nx_cnt = 256;
                        if (task + G < NTsel + 1024) { decode(task + G, nx_li, nx_chunk, nx_own);
                            if (!nx_own) { nx_ent = MLIST[(size_t)nx_li * 16384 + nx_chunk * 256 + wid * 32 + r32]; nx_cnt = (int)__hip_atomic_load(mcnt + nx_li, __ATOMIC_RELAXED, __HIP_MEMORY_SCOPE_AGENT); } }
                        __syncthreads();
                        attn_body::f32x16 p0[4], p1[4];
#pragma unroll
                        for (int kt = 0; kt < 4; ++kt) {
#pragma unroll
                            for (int r = 0; r < 16; ++r) { p0[kt][r] = 0.f; p1[kt][r] = 0.f; }
                            const LAS unsigned char* kb = ldsKs + kt * 8192 + hi * 1024 + r32 * 16;
#pragma unroll
                            for (int d0 = 0; d0 < 4; ++d0) {
                                const attn_body::bf16x8 b0 = *(const LAS attn_body::bf16x8*)(kb + d0 * 2048), b1 = *(const LAS attn_body::bf16x8*)(kb + d0 * 2048 + 512);
                                p0[kt] = __builtin_amdgcn_mfma_f32_32x32x16_bf16(b0, qr[d0], p0[kt], 0, 0, 0);
                                p1[kt] = __builtin_amdgcn_mfma_f32_32x32x16_bf16(b1, qr[d0], p1[kt], 0, 0, 0);
                            }
                        }
                        if (own_task) {
                            const int qrel = wid * 32 + r32;
#pragma unroll
                            for (int kt = 0; kt < 4; ++kt)
#pragma unroll
                                for (int r = 0; r < 16; ++r) { const int kv = kt * 64 + attn_body::crow(r, hi); if (kv > qrel) p0[kt][r] = -INFINITY; if (kv + 32 > qrel) p1[kt][r] = -INFINITY; }
                        }
                        float mx = -INFINITY;
#pragma unroll
                        for (int kt = 0; kt < 4; ++kt)
#pragma unroll
                            for (int r = 0; r < 16; ++r) mx = fmaxf(mx, fmaxf(p0[kt][r], p1[kt][r]));
                        mx = fmaxf(mx, SHX(mx, 32));
                        float ls = 0.f;
#pragma unroll
                        for (int kt = 0; kt < 4; ++kt)
#pragma unroll
                            for (int r = 0; r < 16; ++r) { p0[kt][r] = __builtin_amdgcn_exp2f(p0[kt][r] - mx); p1[kt][r] = __builtin_amdgcn_exp2f(p1[kt][r] - mx); ls += p0[kt][r] + p1[kt][r]; }
                        ls += SHX(ls, 32);
                        attn_body::f32x16 o[2];
#pragma unroll
                        for (int r = 0; r < 16; ++r) { o[0][r] = 0.f; o[1][r] = 0.f; }
                        const int vb0 = (int)(unsigned)(unsigned long long)ldsVs + ((lane >> 4) & 1) * 32 + (lane & 3) * 8 + (4 * hi + ((lane & 15) >> 2)) * 64;
#pragma unroll
                        for (int kt = 0; kt < 4; ++kt) {
                            u32x4 pw0, pw1, pw2, pw3;
#pragma unroll
                            for (int k = 0; k < 4; ++k) { pw0[k] = attn_body::cvtpk_s(p0[kt][2 * k], p0[kt][2 * k + 1]); pw1[k] = attn_body::cvtpk_s(p0[kt][8 + 2 * k], p0[kt][9 + 2 * k]);
                                pw2[k] = attn_body::cvtpk_s(p1[kt][2 * k], p1[kt][2 * k + 1]); pw3[k] = attn_body::cvtpk_s(p1[kt][8 + 2 * k], p1[kt][9 + 2 * k]); }
                            attn_body::pv(o, vb0 + kt * 8192, __builtin_bit_cast(attn_body::bf16x8, pw0), __builtin_bit_cast(attn_body::bf16x8, pw1), __builtin_bit_cast(attn_body::bf16x8, pw2), __builtin_bit_cast(attn_body::bf16x8, pw3));
                        }
                        if (hi == 0) { wsf[r32] = ls; rowd[r32] = dest; if (valid) { MML[(size_t)dest * 2] = mx; MML[(size_t)dest * 2 + 1] = ls; } }
                        LDS_WAIT();
#pragma unroll
                        for (int r = 0; r < 16; ++r) { const int orow = attn_body::crow(r, hi); const float rl = __builtin_amdgcn_rcpf(wsf[orow]);
                            stg[orow * 64 + r32] = (bf16_t)f2bf(o[0][r] * rl); stg[orow * 64 + 32 + r32] = (bf16_t)f2bf(o[1][r] * rl); }
                        LDS_WAIT();
#pragma unroll
                        for (int q = 0; q < 4; ++q) { const int row = q * 8 + (lane >> 3), ch = lane & 7; const int dd = rowd[row];
                            if (dd >= 0) *(u32x4*)(MPO + (size_t)dd * 64 + ch * 8) = *(const LAS u32x4*)(stg + row * 64 + ch * 8); }
                        __syncthreads();
                    }
                }
                {
                const int r32 = lane & 31, hi = lane >> 5;
                LAS unsigned char* ldsU = lds;
                LAS unsigned char* ldsK = lds + 69632;
                for (int task = c; task < 512; task += G) {
                    const int g = task >> 4, cs = task & 15, ig = i * 32 + g;
                    for (int q = tid; q < 32 * 128; q += NTHREADS) { const int j = q >> 7, off = (q & 127) * 16;
                        *(LAS u32x4*)(ldsU + j * 2064 + off) = *(const u32x4*)((const unsigned char*)UG + ((size_t)g * T + (size_t)(cs * 32 + j) * 64) * 32 + off); }
                    for (int q = tid; q < 65 * 48; q += NTHREADS) *(LAS u32x4*)(ldsK + q * 16) = *(const u32x4*)((const unsigned char*)S5KT + (size_t)ig * 65 * 768 + q * 16);
                    __syncthreads();
                    const int gc = cs * 32 + r32;
                    const float* dsk = s5_d + ig * 16;
                    const f32x4 dd0 = *(const f32x4*)(dsk + 4 * hi), dd1 = *(const f32x4*)(dsk + 8 + 4 * hi);
                    attn_body::bf16x8 hcr[8];
                    { const bf16_t* hc = S5HC + ((size_t)gc * 32 + g) * 128 + hi * 8;
#pragma unroll
                      for (int kk = 0; kk < 8; ++kk) hcr[kk] = *(const attn_body::bf16x8*)(hc + kk * 16); }
#pragma unroll 1
                    for (int rr = 0; rr < 4; ++rr) {
                        const int r = rr == 0 ? wid : rr == 1 ? 15 - wid : rr == 2 ? 16 + wid : 31 - wid;
                        attn_body::f32x16 acc;
#pragma unroll
                        for (int q = 0; q < 16; ++q) acc[q] = 0.f;
                        attn_body::bf16x8 a2r[8];
                        { const bf16_t* a2 = S5A2 + ((size_t)ig * 1024 + r * 32 + r32) * 128 + hi * 8;
#pragma unroll
                          for (int kk = 0; kk < 8; ++kk) a2r[kk] = *(const attn_body::bf16x8*)(a2 + kk * 16); }
                        __builtin_amdgcn_sched_barrier(0);
                        const LAS unsigned char* kbase = ldsK + (r32 >> 4) * 768 + (r32 & 15) * 48 + hi * 16;
                        const LAS unsigned char* ubase = ldsU + r32 * 2064 + hi * 16;
                        for (int s = 0; s <= 2 * r + 1; ++s) {
                            const attn_body::bf16x8 A = *(const LAS attn_body::bf16x8*)(kbase + (2 * r - s + 1) * 768);
                            const attn_body::bf16x8 B = *(const LAS attn_body::bf16x8*)(ubase + s * 32);
                            acc = __builtin_amdgcn_mfma_f32_32x32x16_bf16(A, B, acc, 0, 0, 0);
                        }
#pragma unroll
                        for (int kk = 0; kk < 8; ++kk) acc = __builtin_amdgcn_mfma_f32_32x32x16_bf16(a2r[kk], hcr[kk], acc, 0, 0, 0);
#pragma unroll
                        for (int q4 = 0; q4 < 4; ++q4) {
                            const int rowb = 8 * q4 + 4 * hi, dt_ = rowb >> 4, co0 = rowb & 15, t = 2 * r + dt_;
                            const u32x2 uw = *(const LAS u32x2*)(ldsU + r32 * 2064 + t * 32 + co0 * 2);
                            const f32x4 dd = (q4 & 1) ? dd1 : dd0;
                            const float y0 = acc[4 * q4] + dd.x * bflo(uw.x), y1 = acc[4 * q4 + 1] + dd.y * bfhi(uw.x), y2 = acc[4 * q4 + 2] + dd.z * bflo(uw.y), y3 = acc[4 * q4 + 3] + dd.w * bfhi(uw.y);
                            u32x2 w; w.x = pk2(gelu_tanh(y0), gelu_tanh(y1)); w.y = pk2(gelu_tanh(y2), gelu_tanh(y3));
                            *(u32x2*)(YG + ((size_t)gc * 64 + t) * 512 + g * 16 + co0) = w;
                        }
                    }
                    __syncthreads();
                }
                }
            }
            PH_END();
            if (PH_ON()) { DECL_PTRS();
                {
                    const int h = lane >> 3, d8 = (lane & 7) * 8;
                    for (int t0 = gw * 4; t0 < T; t0 += NGW * 4) {
                        int nsel[4]; f32x2 ml[4][4]; u32x4 po[4][4];
#pragma unroll
                        for (int u = 0; u < 4; ++u) { const size_t base = ((size_t)(t0 + u) * 8 + h) * 4; nsel[u] = NSEL[(size_t)(t0 + u) * 8 + h];
#pragma unroll
                            for (int s = 0; s < 4; ++s) { ml[u][s] = *(const f32x2*)(MML + (base + s) * 2); po[u][s] = *(const u32x4*)(MPO + (base + s) * 64 + d8); } }
                        __builtin_amdgcn_sched_barrier(0);
#pragma unroll
                        for (int u = 0; u < 4; ++u) {
                            float mm[4], ll[4];
#pragma unroll
                            for (int s = 0; s < 4; ++s) { const bool on = (s == 3) || (s < nsel[u]); mm[s] = on ? ml[u][s].x : -INFINITY; ll[s] = on ? ml[u][s].y : 0.f; }
                            const float M = fmaxf(fmaxf(mm[0], mm[1]), fmaxf(mm[2], mm[3]));
                            float acc[8], wsum = 0.f;
#pragma unroll
                            for (int e = 0; e < 8; ++e) acc[e] = 0.f;
#pragma unroll
                            for (int s = 0; s < 4; ++s) { const bool on = (s == 3) || (s < nsel[u]);
                                const float w = on ? ll[s] * __builtin_amdgcn_exp2f(mm[s] - M) : 0.f; float ov[8]; unpack8(po[u][s], ov); wsum += w;
#pragma unroll
                                for (int e = 0; e < 8; ++e) acc[e] += on ? w * ov[e] : 0.f; }
                            const float inv = 1.0f / wsum;
#pragma unroll
                            for (int e = 0; e < 8; ++e) acc[e] *= inv;
                            *(u32x4*)(O + (size_t)(t0 + u) * 1024 + h * 64 + d8) = pack8(acc);
                        }
                        __builtin_amdgcn_sched_barrier(0);
                    }
                }
                pg8::Gemm g{YG, Wglu + (size_t)i * 512 * 512, T, 512, 512, 0}; pg8::StaticOrder So; So.init(T, 512, G, c);
                EpiGLU E{O, YG, s5_glu_b + i * 512};
                { PROBE_WRAP(pg8::StaticOrder, So); pg8::gemm_phase<EpiGLU, PROBE_SCHED(pg8::StaticOrder), true, true>(glds, g, PS_, E, tid); }
            }
            PH_END();
        }
        if (PH_ON()) { DECL_PTRS();
            pg8::Gemm g{O, ((l & 1) ? Wodout : Wevout) + (size_t)i * 1024 * 1024, T, 1024, 1024, 0}; pg8::StaticOrder So; So.init(T, 1024, G, c);
            EpiPlain E{YMIX, 1024};
            { PROBE_WRAP(pg8::StaticOrder, So); pg8::gemm_phase<EpiPlain, PROBE_SCHED(pg8::StaticOrder), true, true>(glds, g, PS_, E, tid); }
        }
        PH_END();
        if (PH_ON()) { DECL_PTRS();
#ifdef PROBE_MASK
            const bool first_x = (l == 0 && a.probe_var != -5);
#else
            const bool first_x = (l == 0);
#endif
            const float* xs = xin;
            LAS int* r_e = (LAS int*)(lds + 0);
            LAS float* r_w = (LAS float*)(lds + 1024);
            LAS int* r_rank = (LAS int*)(lds + 2048);
            LAS int* lcnt = (LAS int*)(lds + 3072);
            LAS int* lbase = (LAS int*)(lds + 3200);
            const float* wg_l = moe_wg + (size_t)l * 1024 * 4; const float* we_l = moe_we + (size_t)l * 1024 * 32;
            for (int chunk = c; chunk < T / 128; chunk += G) {
                if (tid < 32) lcnt[tid] = 0;
                LAS float* modl = (LAS float*)(lds + 32768);
                { const float* mo_ = MOD + (size_t)(l * 2 + (int)(((size_t)chunk * 128) / S)) * 6144 + 2048;
                  for (int q = tid; q < 768; q += NTHREADS) *(LAS f32x4*)(modl + 4 * q) = *(const f32x4*)(mo_ + 4 * q); }
                __syncthreads();
                {
                    const int rloc = lane & 15, kc = lane >> 4; const int r = wid * 16 + rloc; const size_t t = (size_t)chunk * 128 + r; const int b = (int)(((size_t)chunk * 128) / S);
                    const float* mo = MOD + (size_t)(l * 2 + b) * 6144;
                    float ss;
                    if (first_x) ss = f_pass1<true>(xs + t * 1024, XB + t * 1024, YMIX + t * 1024, modl, kc);
                    else ss = f_pass1<false>(xs + t * 1024, XB + t * 1024, YMIX + t * 1024, modl, kc);
                    ss += SHX(ss, 16); ss += SHX(ss, 32);
                    const float rn = rsqrtf(ss * (1.0f / 1024.0f) + EPS);
                    f32x4 acc[3];
#pragma unroll
                    for (int ct = 0; ct < 3; ++ct) acc[ct] = (f32x4){0.f, 0.f, 0.f, 0.f};
                    const bf16_t* wh = WRH + ((size_t)l * 48 + rloc) * 1024 + 8 * kc; const bf16_t* wl = WRL + ((size_t)l * 48 + rloc) * 1024 + 8 * kc;
                    f_pass2(XB + t * 1024, H + t * 1024, modl, wh, wl, rn, kc, acc);
                    LAS float* lg = (LAS float*)(lds + 4096 + wid * 3072);
#pragma unroll
                    for (int ct = 0; ct < 3; ++ct) { lg[(4 * kc + 0) * 48 + ct * 16 + rloc] = acc[ct].x; lg[(4 * kc + 1) * 48 + ct * 16 + rloc] = acc[ct].y; lg[(4 * kc + 2) * 48 + ct * 16 + rloc] = acc[ct].z; lg[(4 * kc + 3) * 48 + ct * 16 + rloc] = acc[ct].w; }
                    LDS_WAIT();
                    if (lane < 16) {
                        const LAS float* lr = lg + lane * 48;
                        float cg[4];
#pragma unroll
                        for (int e = 0; e < 4; ++e) cg[e] = lr[e] + moe_bg[l * 4 + e];
                        int grp = 0; float cm = cg[0];
#pragma unroll
                        for (int e = 1; e < 4; ++e) if (cg[e] > cm) { cm = cg[e]; grp = e; }
                        float den = 0.f;
#pragma unroll
                        for (int e = 0; e < 4; ++e) den += __expf(cg[e] - cm);
                        const float pg = 1.0f / den;
                        float fe[8];
#pragma unroll
                        for (int e = 0; e < 8; ++e) fe[e] = lr[4 + grp * 8 + e] + moe_be[l * 32 + grp * 8 + e];
                        int j0 = 0; float f0 = fe[0];
#pragma unroll
                        for (int e = 1; e < 8; ++e) if (fe[e] > f0) { f0 = fe[e]; j0 = e; }
                        int j1 = -1; float f1 = -INFINITY;
#pragma unroll
                        for (int e = 0; e < 8; ++e) if (e != j0 && fe[e] > f1) { f1 = fe[e]; j1 = e; }
                        const float ex = __expf(f1 - f0); const float sA = 1.0f / (1.0f + ex), sB = ex / (1.0f + ex);
                        const int rr_ = wid * 16 + lane;
                        r_e[2 * rr_] = grp * 8 + j0; r_w[2 * rr_] = pg * sA; r_e[2 * rr_ + 1] = grp * 8 + j1; r_w[2 * rr_ + 1] = pg * sB;
                    }
                }
                __syncthreads();
#ifdef PROBE_MASK
                if (a.probe_var == 5) { if (tid < 256 && r_e[tid] == -777) TOKES[0] = 0; __syncthreads(); continue; }
#endif
                if (tid < 256) r_rank[tid] = __hip_atomic_fetch_add(&lcnt[r_e[tid]], 1, __ATOMIC_RELAXED, __HIP_MEMORY_SCOPE_WORKGROUP);
                __syncthreads();
                if (tid < 32) lbase[tid] = (int)__hip_atomic_fetch_add(ctl + CW_CNT + (l * 32 + tid) * 64, (unsigned)lcnt[tid], __ATOMIC_RELAXED, __HIP_MEMORY_SCOPE_AGENT);
                __syncthreads();
                if (tid < 256) { const size_t t = (size_t)chunk * 128 + (tid >> 1); const int k = tid & 1; const int e = r_e[tid]; const int slot = lbase[e] + r_rank[tid];
                    TOKES[t * 2 + k] = e * 32768 + slot; TOKW[t * 2 + k] = r_w[tid]; LTOK[e * 32768 + slot] = (int)t; }
                __syncthreads();
            }
        }
        PH_END();
        if (PH_ON()) { DECL_PTRS();
            LAS int* tile_e = (LAS int*)(lds + LDS_MISC); LAS int* rb = tile_e + 320; LAS int* nt_p = tile_e + 400;
            moe_tables(ctl, l, tile_e, rb, nt_p, tid);
            const int nR = nt_p[0];
            pg8::Gemm g{H, W13, nR * 256, 1024, 1024, (size_t)1024 * 1024 * 2}; MoeOrder Mo{4, nR * 4, G, c, tile_e};
            EpiSwiGLU E{HID}; MoeRows RW{rb, LTOK};
            { PROBE_WRAP(MoeOrder, Mo); pg8::gemm_phase<EpiSwiGLU, PROBE_SCHED(MoeOrder), true, true, MoeRows>(glds, g, PS_, E, tid, RW); }
        }
        PH_END();
        if (PH_ON()) { DECL_PTRS();
            LAS int* tile_e = (LAS int*)(lds + LDS_MISC); LAS int* rb = tile_e + 320; LAS int* nt_p = tile_e + 400;
            moe_tables(ctl, l, tile_e, rb, nt_p, tid);
            const int nR = nt_p[0];
            pg8::Gemm g{HID, W2, nR * 256, 1024, 512, (size_t)1024 * 512 * 2}; MoeOrder Mo{4, nR * 4, G, c, tile_e};
            EpiPlain E{Y, 1024};
            { PROBE_WRAP(MoeOrder, Mo); pg8::gemm_phase<EpiPlain, PROBE_SCHED(MoeOrder), true, true>(glds, g, PS_, E, tid); }
        }
        PH_END();
        if (PH_ON()) { DECL_PTRS();
            LAS int* tile_e = (LAS int*)(lds + LDS_MISC); LAS int* rb = tile_e + 320; LAS int* nt_p = tile_e + 400;
            moe_tables(ctl, l, tile_e, rb, nt_p, tid);
            constexpr int RJ = 4;
            for (int t0 = gw * RJ; t0 < T; t0 += NGW * RJ) {
                const int b = t0 / S; const float* mo = MOD + (size_t)(l * 2 + b) * 6144;
                int r0[RJ], r1[RJ]; float w0[RJ], w1[RJ];
#pragma unroll
                for (int u = 0; u < RJ; ++u) { const int t = t0 + u; { const int e0_ = TOKES[2 * t], e1_ = TOKES[2 * t + 1]; r0[u] = rb[e0_ >> 15] + (e0_ & 32767); r1[u] = rb[e1_ >> 15] + (e1_ & 32767); } w0[u] = TOKW[2 * t]; w1[u] = TOKW[2 * t + 1];
#ifdef PROBE_MASK
                    if (a.probe_var == 4 || a.probe_var == -4) { w0[u] *= 0.5f; w1[u] *= 0.5f; }
#endif
                }
                f32x4 v[RJ][4]; u32x2 ya[RJ][4], yb[RJ][4];
#pragma unroll
                for (int u = 0; u < RJ; ++u)
#pragma unroll
                    for (int j = 0; j < 4; ++j) { const int col = 4 * lane + 256 * j; { const u32x2 xw = *(const u32x2*)(XB + (size_t)(t0 + u) * 1024 + col); v[u][j] = (f32x4){bflo(xw.x), bfhi(xw.x), bflo(xw.y), bfhi(xw.y)}; }
                        ya[u][j] = *(const u32x2*)(Y + (size_t)r0[u] * 1024 + col); yb[u][j] = *(const u32x2*)(Y + (size_t)r1[u] * 1024 + col); }
                f32x4 gg[4];
#pragma unroll
                for (int j = 0; j < 4; ++j) gg[j] = *(const f32x4*)(mo + 5120 + 4 * lane + 256 * j);
                float ss[RJ];
#pragma unroll
                for (int u = 0; u < RJ; ++u) { ss[u] = 0.f;
#pragma unroll
                    for (int j = 0; j < 4; ++j) { const int col = 4 * lane + 256 * j; const f32x4 xv = v[u][j]; f32x4 nv;
                        nv.x = xv.x + gg[j].x * (w0[u] * bflo(ya[u][j].x) + w1[u] * bflo(yb[u][j].x)); nv.y = xv.y + gg[j].y * (w0[u] * bfhi(ya[u][j].x) + w1[u] * bfhi(yb[u][j].x));
                        nv.z = xv.z + gg[j].z * (w0[u] * bflo(ya[u][j].y) + w1[u] * bflo(yb[u][j].y)); nv.w = xv.w + gg[j].w * (w0[u] * bfhi(ya[u][j].y) + w1[u] * bfhi(yb[u][j].y));
                        if (l + 1 < DEPTH) { u32x2 xw; xw.x = pk2(nv.x, nv.y); xw.y = pk2(nv.z, nv.w); *(u32x2*)(XB + (size_t)(t0 + u) * 1024 + col) = xw; nv = (f32x4){bflo(xw.x), bfhi(xw.x), bflo(xw.y), bfhi(xw.y)}; }
                        else *(f32x4*)(out + (size_t)(t0 + u) * 1024 + col) = nv;
                        v[u][j] = nv; ss[u] += (nv.x * nv.x + nv.y * nv.y) + (nv.z * nv.z + nv.w * nv.w); } }
                if (l + 1 < DEPTH) {
                    const float* mn = MOD + (size_t)((l + 1) * 2 + b) * 6144;
                    f32x4 sc1[4], sh1[4];
#pragma unroll
                    for (int j = 0; j < 4; ++j) { sc1[j] = *(const f32x4*)(mn + 1024 + 4 * lane + 256 * j); sh1[j] = *(const f32x4*)(mn + 4 * lane + 256 * j); }
#pragma unroll
                    for (int u = 0; u < RJ; ++u) { const float rn = rsqrtf(wave_sum(ss[u]) * (1.0f / 1024.0f) + EPS);
#pragma unroll
                        for (int j = 0; j < 4; ++j) { const int col = 4 * lane + 256 * j;
                            u32x2 w; w.x = pk2(v[u][j].x * rn * (1.f + sc1[j].x) + sh1[j].x, v[u][j].y * rn * (1.f + sc1[j].y) + sh1[j].y); w.y = pk2(v[u][j].z * rn * (1.f + sc1[j].z) + sh1[j].z, v[u][j].w * rn * (1.f + sc1[j].w) + sh1[j].w);
                            *(u32x2*)(H + (size_t)(t0 + u) * 1024 + col) = w; } }
                }
            }
        }
        PH_END();
    }
#undef PH_ON
#undef PH_END
}

extern "C" void kernel_launch(void* const* d_in, const int* in_sizes, int n_in, void* d_out, int out_size, void* d_ws, size_t ws_size, hipStream_t stream) {
    static int grid = 0;
    if (grid == 0) {
        if (n_in != 37 || out_size != T * D || ws_size < WS_END) { fprintf(stderr, "kernel_launch: unexpected shapes (n_in %d, out %d, ws %zu); nothing launched\n", n_in, out_size, ws_size); grid = -1; return; }
        int dev = 0, cus = 0, per_cu = 0;
        if (hipGetDevice(&dev) != hipSuccess || hipDeviceGetAttribute(&cus, hipDeviceAttributeMultiprocessorCount, dev) != hipSuccess) { grid = -1; return; }
        if (hipFuncSetAttribute((const void*)fwd, hipFuncAttributeMaxDynamicSharedMemorySize, LDS_BYTES) != hipSuccess) { fprintf(stderr, "kernel_launch: hipFuncSetAttribute failed\n"); grid = -1; return; }
        if (hipOccupancyMaxActiveBlocksPerMultiprocessor(&per_cu, (const void*)fwd, NTHREADS, LDS_BYTES) != hipSuccess || per_cu < 1) fprintf(stderr, "kernel_launch: occupancy query says %d\n", per_cu);
        (void)hipGetLastError();
        grid = cus;
    }
    if (grid < 0) return;
    if (hipMemsetAsync((char*)d_ws + WS_CTL, 0, CTL_ZERO_BYTES, stream) != hipSuccess) return;
    Args a{};
    for (int i = 0; i < 37; ++i) a.in[i] = d_in[i];
    a.out = (float*)d_out; a.ws = (unsigned char*)d_ws;
#ifdef PROBE_MASK
#ifndef PROBE_VAR
#define PROBE_VAR 0
#endif
    {
        int types[N_PHASES]; int n = 0; types[n++] = 0; types[n++] = 1; types[n++] = 2;
        for (int l = 0; l < DEPTH; ++l) { if ((l & 1) == 0) { for (int k = 3; k <= 7; ++k) if (k != 4 && k != 6) types[n++] = k; } else { for (int k = 8; k <= 13; ++k) if (k != 9) types[n++] = k; } for (int k = 14; k <= 19; ++k) if (k != 16) types[n++] = k; }
        for (int p = 0; p < N_PHASES; ++p) { a.ph_lo = p; a.ph_hi = p + 1; const int reps = ((PROBE_MASK >> types[p]) & 1) ? 2 : 1;
            for (int r = 0; r < reps; ++r) { a.probe_var = (reps == 2) ? ((r == 0) ? PROBE_VAR : -PROBE_VAR) : 0; hipLaunchKernelGGL(fwd, dim3(grid), dim3(NTHREADS), LDS_BYTES, stream, a); } }
    }
#elif MK_ONE_LAUNCH
    a.ph_lo = 0; a.ph_hi = N_PHASES;
    hipLaunchKernelGGL(fwd, dim3(grid), dim3(NTHREADS), LDS_BYTES, stream, a);
#else
    for (int p = 0; p < N_PHASES; ++p) { a.ph_lo = p; a.ph_hi = p + 1; hipLaunchKernelGGL(fwd, dim3(grid), dim3(NTHREADS), LDS_BYTES, stream, a); }
#endif
}
```

```cpp
#include <hip/hip_runtime.h>
#include <cstdio>
#include <cstdint>
#include <hip/hip_bf16.h>
#include <cmath>
#ifndef MK_ONE_LAUNCH
#define MK_ONE_LAUNCH 1
#endif
namespace pg8 {
#define PG8_LAS __attribute__((address_space(3)))
typedef unsigned short bf16_t;
typedef short bf16x8 __attribute__((ext_vector_type(8)));
typedef float f32x4 __attribute__((ext_vector_type(4)));
typedef unsigned u32x4 __attribute__((ext_vector_type(4)));
constexpr int BM = 256, BK = 64, HALF = 128, HTB = HALF * BK * 2  , STAGE_BYTES = 8 * HTB, NXCD = 8, WGM = 8;

__host__ __device__ __forceinline__ int lds_byte(int r, int c) { const int st = (r >> 4) * 2 + (c >> 5), rr = r & 15, cc = c & 31, ob = rr * 64 + cc * 2; return st * 1024 + (ob ^ (((ob >> 9) & 1) << 5)); }
__host__ __device__ __forceinline__ void stage_rc(int b, int& R, int& C) { const int st = b / 1024, sb = b % 1024, swz = sb ^ (((sb >> 9) & 1) << 5); R = (st >> 1) * 16 + swz / 64; C = (st & 1) * 32 + (swz % 64) / 2; }
__host__ __device__ __forceinline__ int perm32(int rho) { const int n = rho >> 4, i = rho & 15; return 8 * (i >> 2) + 4 * n + (i & 3); }

struct Unit { int pm, pn, be; };
struct Gemm { const bf16_t* A; const bf16_t* Bt; int M, N, K; size_t bstride; };

struct StaticOrder {
    int nM, nN, nwg, G, c;
    __host__ __device__ void init(int M, int N, int G_, int c_) { nM = M / BM; nN = N / BM; nwg = nM * nN; G = G_; c = c_; }
    __host__ __device__ bool next(int i, Unit& u) const {
        const long L = (long)i * G + c; if (L >= nwg) return false;
        int wgid = (int)L; { const int q = nwg / NXCD, r = nwg % NXCD, xcd = wgid % NXCD, off = wgid / NXCD; wgid = (xcd < r ? xcd * (q + 1) : r * (q + 1) + (xcd - r) * q) + off; }
        const int nig = WGM * nN, gid = wgid / nig, fm = gid * WGM, gsz = (nM - fm) < WGM ? (nM - fm) : WGM;
        u.pm = fm + ((wgid % nig) % gsz); u.pn = (wgid % nig) / gsz; u.be = 0; return true;
    }
    __device__ __forceinline__ void a_ready(const Unit&) const {}
    __device__ __forceinline__ void done(const Unit&) const {}
};

__device__ __forceinline__ unsigned cvt_pk_bf16(float lo, float hi) { unsigned r; asm volatile("v_cvt_pk_bf16_f32 %0, %1, %2" : "=v"(r) : "v"(lo), "v"(hi)); return r; }
typedef float f32x2 __attribute__((ext_vector_type(2)));
struct NoRows { static constexpr bool GATHER = false; __device__ __forceinline__ unsigned operator()(const Unit&, int) const { return 0u; } };
template <class Epi, class Sched, bool ALIGN_EPI = false, bool SP2 = false, class Rows = NoRows>
__device__ __forceinline__ void gemm_phase(PG8_LAS unsigned char* lds, const Gemm g, const Sched& S, const Epi& E, const int tid_in, const Rows& RW = Rows()) {
    const int tid = tid_in, wid = __builtin_amdgcn_readfirstlane(tid >> 6), lane = tid & 63, wr = wid >> 2, wc = wid & 3, fr = lane & 15, fq = lane >> 4;
    const int K = g.K, nt = K / BK;
    unsigned voffA[2], voffB[2];
#pragma unroll
    for (int i = 0; i < 2; ++i) { int R, C; stage_rc(tid * 16 + i * 8192, R, C); const int Rb = Epi::PERM ? ((R & ~31) + perm32(R & 31)) : R;
        voffA[i] = (unsigned)(R * K + C) * 2u; voffB[i] = (unsigned)(Rb * K + C) * 2u; }
    const size_t kstep = (size_t)(BK * 2);
    const size_t hstep = (size_t)HALF * K * 2;
    const size_t tstep = 2 * hstep;
    const unsigned ldsw = (unsigned)wid * 1024u;
    const int aoff = lds_byte(wr * 64 + fr, fq * 8), boff = lds_byte(wc * 32 + fr, fq * 8);
#define PG8_SA(b, h) (((b) * 2 + (h)) * HTB)
#define PG8_SB(b, h) ((4 + (b) * 2 + (h)) * HTB)
#define PG8_STAGE(bufoff, gbase, voff) do { _Pragma("unroll") for (int _i = 0; _i < 2; ++_i) \
        __builtin_amdgcn_global_load_lds((const unsigned*)((const char*)(gbase) + (voff)[_i]), (PG8_LAS unsigned*)(lds + (bufoff) + ldsw + _i * 8192), 16, 0, 0); } while (0)
#define PG8_LDA(dst, b, h) do { _Pragma("unroll") for (int m = 0; m < 4; ++m) _Pragma("unroll") for (int k = 0; k < 2; ++k) dst[m][k] = *(const PG8_LAS bf16x8*)(lds + PG8_SA(b, h) + aoff + m * 2048 + k * 1024); } while (0)
#define PG8_LDB(dst, b, h) do { _Pragma("unroll") for (int n = 0; n < 2; ++n) _Pragma("unroll") for (int k = 0; k < 2; ++k) dst[n][k] = *(const PG8_LAS bf16x8*)(lds + PG8_SB(b, h) + boff + n * 2048 + k * 1024); } while (0)
#define PG8_MMA(ai, bj, At, Bt) do { __builtin_amdgcn_s_setprio(1); _Pragma("unroll") for (int m = 0; m < 4; ++m) _Pragma("unroll") for (int n = 0; n < 2; ++n) _Pragma("unroll") for (int k = 0; k < 2; ++k) \
        acc[ai][bj][m][n] = __builtin_amdgcn_mfma_f32_16x16x32_bf16(Bt[n][k], At[m][k], acc[ai][bj][m][n], 0, 0, 0); __builtin_amdgcn_s_setprio(0); } while (0)
#define PG8_WAIT_V(n) asm volatile("s_waitcnt vmcnt(" #n ")" ::: "memory")
#define PG8_WAIT_L(n) asm volatile("s_waitcnt lgkmcnt(" #n ")" ::: "memory")
#define PG8_BAR __builtin_amdgcn_s_barrier()
#define PG8_SCHED __builtin_amdgcn_sched_barrier(0)
    Unit cur, nxt; int ui = 0;
    if (!S.next(0, cur)) return;
    f32x4 acc[2][2][4][2];
#pragma unroll
    for (int a = 0; a < 2; ++a)
#pragma unroll
        for (int b = 0; b < 2; ++b)
#pragma unroll
            for (int m = 0; m < 4; ++m)
#pragma unroll
                for (int n = 0; n < 2; ++n) { float z0_ = 0.f; asm volatile("" : "+v"(z0_)); acc[a][b][m][n] = (f32x4){z0_, z0_, z0_, z0_}; }
    bf16x8 At[4][2], B0[2][2], B1[2][2];
    const char* cA = Rows::GATHER ? (const char*)g.A : (const char*)g.A + (size_t)cur.pm * tstep; const char* cB = (const char*)g.Bt + (size_t)cur.be * g.bstride + (size_t)cur.pn * tstep;
    int Rr[2], Cc[2];
#pragma unroll
    for (int i = 0; i < 2; ++i) stage_rc(tid * 16 + i * 8192, Rr[i], Cc[i]);
    unsigned voffAh[2][2], voffAn[2][2];
#pragma unroll
    for (int h = 0; h < 2; ++h)
#pragma unroll
        for (int i = 0; i < 2; ++i) { voffAh[h][i] = Rows::GATHER ? RW(cur, h * HALF + Rr[i]) + (unsigned)Cc[i] * 2u : voffA[i] + (unsigned)h * (unsigned)hstep; voffAn[h][i] = voffAh[h][i]; }
    S.a_ready(cur);
    if constexpr (SP2) {
        PG8_STAGE(PG8_SB(0, 0), cB, voffB); PG8_STAGE(PG8_SB(0, 1), cB + hstep, voffB); PG8_STAGE(PG8_SA(0, 0), cA, voffAh[0]); PG8_STAGE(PG8_SA(0, 1), cA, voffAh[1]);
        if (wr == 1) PG8_BAR;
        PG8_WAIT_V(2); PG8_BAR;
        PG8_STAGE(PG8_SB(1, 0), cB + kstep, voffB); PG8_STAGE(PG8_SA(1, 0), cA + kstep, voffAh[0]); PG8_STAGE(PG8_SB(1, 1), cB + hstep + kstep, voffB);
        PG8_WAIT_V(6); PG8_BAR;
    } else {
        PG8_STAGE(PG8_SB(0, 0), cB, voffB); PG8_STAGE(PG8_SA(0, 0), cA, voffAh[0]); PG8_STAGE(PG8_SB(0, 1), cB + hstep, voffB); PG8_STAGE(PG8_SA(0, 1), cA, voffAh[1]);
        if (wr == 1) PG8_BAR;
        PG8_WAIT_V(4); PG8_BAR;
        PG8_STAGE(PG8_SB(1, 0), cB + kstep, voffB); PG8_STAGE(PG8_SA(1, 0), cA + kstep, voffAh[0]); PG8_STAGE(PG8_SB(1, 1), cB + hstep + kstep, voffB);
        PG8_WAIT_V(6); PG8_BAR;
    }
    for (;;) {
        const bool has_next = S.next(ui + 1, nxt);
        const char* nA = Rows::GATHER ? (const char*)g.A : (has_next ? (const char*)g.A + (size_t)nxt.pm * tstep : cA);
        if constexpr (Rows::GATHER) { if (has_next) {
#pragma unroll
            for (int h = 0; h < 2; ++h)
#pragma unroll
                for (int i = 0; i < 2; ++i) voffAn[h][i] = RW(nxt, h * HALF + Rr[i]) + (unsigned)Cc[i] * 2u; } } const char* nB = has_next ? (const char*)g.Bt + (size_t)nxt.be * g.bstride + (size_t)nxt.pn * tstep : cB;
        for (int t = 0; t < nt; t += 2) {
            const bool last = (t == nt - 2); const bool gsel = Rows::GATHER && last && has_next;
            const char* a1 = cA + (size_t)(t + 1) * kstep;
            const char* a2 = last ? nA : cA + (size_t)(t + 2) * kstep; const char* b2 = last ? nB : cB + (size_t)(t + 2) * kstep;
            const char* a3 = a2 + kstep; const char* b3 = b2 + kstep;
            if (last && has_next) S.a_ready(nxt);
            if constexpr (SP2) {
            PG8_LDB(B0, 0, 0); PG8_LDB(B1, 0, 1); PG8_SCHED; PG8_LDA(At, 0, 0); PG8_STAGE(PG8_SA(1, 1), a1, voffAh[1]);
            PG8_WAIT_V(8); PG8_WAIT_L(0); PG8_BAR; PG8_MMA(0, 0, At, B0); PG8_MMA(0, 1, At, B1); PG8_BAR; PG8_SCHED;
            PG8_LDA(At, 0, 1); PG8_STAGE(PG8_SB(0, 0), b2, voffB); PG8_STAGE(PG8_SB(0, 1), b2 + hstep, voffB); PG8_STAGE(PG8_SA(0, 0), a2, (gsel ? voffAn[0] : voffAh[0]));
            PG8_WAIT_V(8); PG8_WAIT_L(0); PG8_BAR; PG8_MMA(1, 0, At, B0); PG8_MMA(1, 1, At, B1); PG8_BAR; PG8_SCHED;
            PG8_LDB(B0, 1, 0); PG8_LDB(B1, 1, 1); PG8_SCHED; PG8_LDA(At, 1, 0); PG8_STAGE(PG8_SA(0, 1), a2, (gsel ? voffAn[1] : voffAh[1]));
            PG8_WAIT_V(8); PG8_WAIT_L(0); PG8_BAR; PG8_MMA(0, 0, At, B0); PG8_MMA(0, 1, At, B1); PG8_BAR; PG8_SCHED;
            PG8_LDA(At, 1, 1); PG8_STAGE(PG8_SB(1, 0), b3, voffB); PG8_STAGE(PG8_SB(1, 1), b3 + hstep, voffB); PG8_STAGE(PG8_SA(1, 0), a3, (gsel ? voffAn[0] : voffAh[0]));
            PG8_WAIT_V(8); PG8_WAIT_L(0); PG8_BAR; PG8_MMA(1, 0, At, B0); PG8_MMA(1, 1, At, B1); PG8_BAR; PG8_SCHED;
            } else {
            PG8_LDB(B0, 0, 0); PG8_SCHED; PG8_LDA(At, 0, 0); PG8_STAGE(PG8_SA(1, 1), a1, voffAh[1]);
            PG8_WAIT_L(8); PG8_BAR; PG8_WAIT_L(0); PG8_MMA(0, 0, At, B0); PG8_BAR; PG8_SCHED;
            PG8_LDB(B1, 0, 1); PG8_STAGE(PG8_SB(0, 0), b2, voffB);
            PG8_BAR; PG8_WAIT_L(0); PG8_MMA(0, 1, At, B1); PG8_BAR;
            PG8_LDA(At, 0, 1); PG8_STAGE(PG8_SA(0, 0), a2, (gsel ? voffAn[0] : voffAh[0]));
            PG8_BAR; PG8_WAIT_L(0); PG8_MMA(1, 0, At, B0); PG8_BAR; PG8_SCHED;
            PG8_STAGE(PG8_SB(0, 1), b2 + hstep, voffB);
            PG8_WAIT_V(6); PG8_BAR; PG8_MMA(1, 1, At, B1); PG8_BAR;
            PG8_LDB(B0, 1, 0); PG8_SCHED; PG8_LDA(At, 1, 0); PG8_STAGE(PG8_SA(0, 1), a2, (gsel ? voffAn[1] : voffAh[1]));
            PG8_WAIT_L(8); PG8_BAR; PG8_WAIT_L(0); PG8_MMA(0, 0, At, B0); PG8_BAR; PG8_SCHED;
            PG8_LDB(B1, 1, 1); PG8_STAGE(PG8_SB(1, 0), b3, voffB);
            PG8_BAR; PG8_WAIT_L(0); PG8_MMA(0, 1, At, B1); PG8_BAR;
            PG8_LDA(At, 1, 1); PG8_STAGE(PG8_SA(1, 0), a3, (gsel ? voffAn[0] : voffAh[0]));
            PG8_BAR; PG8_WAIT_L(0); PG8_MMA(1, 0, At, B0); PG8_BAR; PG8_SCHED;
            PG8_STAGE(PG8_SB(1, 1), b3 + hstep, voffB);
            PG8_WAIT_V(6); PG8_BAR; PG8_MMA(1, 1, At, B1); PG8_BAR;
            }
        }
        if constexpr (ALIGN_EPI) { if (wr == 0) PG8_BAR; }
        if constexpr (!Epi::AFTER_DRAIN) { int l2_; asm volatile("v_mbcnt_lo_u32_b32 %0, -1, 0\n\tv_mbcnt_hi_u32_b32 %0, -1, %0" : "=v"(l2_)); E(acc, cur, wr, wc, l2_ & 15, l2_ >> 4); S.done(cur); }
        if (!has_next) break;
#pragma unroll
        for (int a = 0; a < 2; ++a)
#pragma unroll
            for (int b = 0; b < 2; ++b)
#pragma unroll
                for (int m = 0; m < 4; ++m)
#pragma unroll
                    for (int n = 0; n < 2; ++n) { float z0_ = 0.f; asm volatile("" : "+v"(z0_)); acc[a][b][m][n] = (f32x4){z0_, z0_, z0_, z0_}; }
        cur = nxt; cA = nA; cB = nB; ++ui;
        if constexpr (Rows::GATHER) {
#pragma unroll
            for (int h = 0; h < 2; ++h)
#pragma unroll
                for (int i = 0; i < 2; ++i) voffAh[h][i] = voffAn[h][i]; }
        if constexpr (ALIGN_EPI) { if (wr == 1) PG8_BAR; }
    }
    PG8_WAIT_V(0);
    if constexpr (!ALIGN_EPI) { if (wr == 0) PG8_BAR; }
    PG8_BAR;
    if constexpr (Epi::AFTER_DRAIN) { E.fused(acc, cur, wr, wc, fr, fq, lds, wid, lane); S.done(cur); }
#undef PG8_SA
#undef PG8_SB
#undef PG8_STAGE
#undef PG8_LDA
#undef PG8_LDB
#undef PG8_MMA
#undef PG8_WAIT_V
#undef PG8_WAIT_L
#undef PG8_BAR
#undef PG8_SCHED
}
}
namespace attn_body {
using bf16=__hip_bfloat16;
using bf16x8=__attribute__((ext_vector_type(8)))short;
using s16x4=__attribute__((ext_vector_type(4)))short;
using f32x16=__attribute__((ext_vector_type(16)))float;
using u32x4=__attribute__((ext_vector_type(4)))unsigned;
constexpr int D=64;
constexpr int NW=8,QBLK=32,QB=QBLK*NW,KVBLK=64;
constexpr int ATTN_UNIT_ROWS=QB;
__device__ __forceinline__ int crow(int r,int hi){return (r&3)+8*(r>>2)+4*hi;}
#define SBAR() __builtin_amdgcn_sched_barrier(0)
__device__ __forceinline__ void cmask(f32x16&p0,f32x16&p1,int jb,int qrel,int hi){
  const float NEG=-INFINITY; int kb=64*jb+4*hi;
  #pragma unroll
  for(int r=0;r<16;++r){int kv=kb+(r&3)+8*(r>>2); if(kv>qrel)p0[r]=NEG; if(kv+32>qrel)p1[r]=NEG;}
}

constexpr int NSLOT=3, SLOTB=8192;
constexpr int LDS_K=0, LDS_V=NSLOT*SLOTB, LDS_WS=2*NSLOT*SLOTB, LDS_OST=LDS_WS+NW*64*4, LDS_BYTES=LDS_OST+NW*4096;
constexpr float C2=0.125f*1.4426950408889634f;
__device__ __forceinline__ void glds16(const void*gsrc,unsigned lds_dst){unsigned keep;
  asm volatile("s_mov_b32 %0, m0\n\ts_mov_b32 m0, %2\n\ts_nop 0\n\tglobal_load_lds_dwordx4 %1, off\n\ts_mov_b32 m0, %0":"=&s"(keep):"v"(gsrc),"s"(lds_dst):"memory");}
__device__ __forceinline__ float max3f(float a,float b,float c){float r;asm("v_max3_f32 %0, %1, %2, %3":"=v"(r):"v"(a),"v"(b),"v"(c));return r;}
__device__ __forceinline__ float max2f(float a,float b){float r;asm("v_max_f32_e32 %0, %1, %2":"=v"(r):"v"(a),"v"(b));return r;}
__device__ __forceinline__ float fadd_s(float a,float b){float r;asm("v_add_f32_e32 %0, %1, %2":"=v"(r):"v"(a),"v"(b));return r;}
__device__ __forceinline__ float fsub_s(float a,float b){float r;asm("v_sub_f32_e32 %0, %1, %2":"=v"(r):"v"(a),"v"(b));return r;}
typedef float f32x2_t __attribute__((ext_vector_type(2))); typedef __bf16 bf16x2_t __attribute__((ext_vector_type(2)));
__device__ __forceinline__ unsigned cvtpk_s(float lo,float hi){f32x2_t v={lo,hi};bf16x2_t b=__builtin_convertvector(v,bf16x2_t);return __builtin_bit_cast(unsigned,b);}
#define WAIT_BAR(N) asm volatile("s_waitcnt vmcnt(" #N ") lgkmcnt(0)\n\ts_barrier":::"memory")

__device__ __forceinline__ void qkt(f32x16&p0,f32x16&p1,const char*Kslot,const bf16x8*qr,const f32x16&negm,int r32,int hi){
  const char*kb=Kslot+hi*1024+r32*16;
  #pragma unroll
  for(int d0=0;d0<4;++d0){
    const bf16x8 b0=*reinterpret_cast<const bf16x8*>(kb+d0*2048);
    const bf16x8 b1=*reinterpret_cast<const bf16x8*>(kb+d0*2048+512);
    if(d0==0){p0=__builtin_amdgcn_mfma_f32_32x32x16_bf16(b0,qr[0],negm,0,0,0);p1=__builtin_amdgcn_mfma_f32_32x32x16_bf16(b1,qr[0],negm,0,0,0);}
    else{p0=__builtin_amdgcn_mfma_f32_32x32x16_bf16(b0,qr[d0],p0,0,0,0);p1=__builtin_amdgcn_mfma_f32_32x32x16_bf16(b1,qr[d0],p1,0,0,0);}}
}
typedef __attribute__((address_space(3))) const char* lds_cptr;
typedef short v4i16_t __attribute__((ext_vector_type(4)));
__device__ __forceinline__ void kload8(bf16x8*kf,lds_cptr kp){
  kf[0]=*(const __attribute__((address_space(3))) bf16x8*)(kp);      kf[1]=*(const __attribute__((address_space(3))) bf16x8*)(kp+512);
  kf[2]=*(const __attribute__((address_space(3))) bf16x8*)(kp+2048); kf[3]=*(const __attribute__((address_space(3))) bf16x8*)(kp+2560);
  kf[4]=*(const __attribute__((address_space(3))) bf16x8*)(kp+4096); kf[5]=*(const __attribute__((address_space(3))) bf16x8*)(kp+4608);
  kf[6]=*(const __attribute__((address_space(3))) bf16x8*)(kp+6144); kf[7]=*(const __attribute__((address_space(3))) bf16x8*)(kp+6656);
}
__device__ __forceinline__ void kload2(bf16x8*kf,lds_cptr kp,int j){ kf[2*j]=*(const __attribute__((address_space(3))) bf16x8*)(kp+j*2048); kf[2*j+1]=*(const __attribute__((address_space(3))) bf16x8*)(kp+j*2048+512); }
__device__ __forceinline__ s16x4 vtr(lds_cptr p){ return __builtin_bit_cast(s16x4,__builtin_amdgcn_ds_read_tr16_b64_v4i16((__attribute__((address_space(3))) v4i16_t*)p)); }
__device__ __forceinline__ float rowmax(const f32x16&p0,const f32x16&p1){
  float a=max3f(p0[0],p0[1],p1[0]),b=max3f(p0[2],p0[3],p1[1]);a=max3f(a,p1[2],p1[3]);
  #pragma unroll
  for(int r=4;r<16;r+=4){a=max3f(a,p0[r],p0[r+1]);b=max3f(b,p0[r+2],p0[r+3]);a=max3f(a,p1[r],p1[r+1]);b=max3f(b,p1[r+2],p1[r+3]);}
  const float m=max2f(a,b);
  auto rr=__builtin_amdgcn_permlane32_swap(__float_as_uint(m),__float_as_uint(m),false,false);
  return max2f(__uint_as_float(rr[0]),__uint_as_float(rr[1]));
}
__device__ __forceinline__ void pv(f32x16*o,int vb,bf16x8 pa0,bf16x8 pa1,bf16x8 pa2,bf16x8 pa3){
  #pragma unroll
  for(int d0=0;d0<2;++d0){s16x4 lo[4],hi[4];
    #pragma unroll
    for(int ks=0;ks<4;++ks){
      asm volatile("ds_read_b64_tr_b16 %0,%1 offset:%c2":"=&v"(lo[ks]):"v"(vb),"i"(d0*4096+ks*1024):"memory");
      asm volatile("ds_read_b64_tr_b16 %0,%1 offset:%c2":"=&v"(hi[ks]):"v"(vb),"i"(d0*4096+ks*1024+512):"memory");}
    asm volatile("s_waitcnt lgkmcnt(0)":::"memory");SBAR();
    #define PK(k) (bf16x8){lo[k][0],lo[k][1],lo[k][2],lo[k][3],hi[k][0],hi[k][1],hi[k][2],hi[k][3]}
    o[d0]=__builtin_amdgcn_mfma_f32_32x32x16_bf16(pa0,PK(0),o[d0],0,0,0);
    o[d0]=__builtin_amdgcn_mfma_f32_32x32x16_bf16(pa1,PK(1),o[d0],0,0,0);
    o[d0]=__builtin_amdgcn_mfma_f32_32x32x16_bf16(pa2,PK(2),o[d0],0,0,0);
    o[d0]=__builtin_amdgcn_mfma_f32_32x32x16_bf16(pa3,PK(3),o[d0],0,0,0);
    #undef PK
  }
}

#ifndef ATTN_STORE16
#define ATTN_STORE16(p,v) (*(u32x4*)(p)=(v))
#endif
template<int THRL,int PIN,int POUT> __device__ __forceinline__ void attn_unit(int qb,const bf16*Qh,const bf16*__restrict__ Kh,const bf16*__restrict__ Vh,bf16*Oh,char*shm,const int wid_in){
  constexpr int DM=PIN;
  int lane; asm volatile("v_mbcnt_lo_u32_b32 %0, -1, 0\n\tv_mbcnt_hi_u32_b32 %0, -1, %0" : "=v"(lane));
  const int wid=wid_in; const int tid=wid*64+lane; const int r32=lane&31,hi=lane>>5;
  const int q0=qb*QB;
  const bf16*Qw=Qh+(long)(q0+wid*QBLK)*DM;
  const unsigned lds0=(unsigned)(uintptr_t)shm;
  float*wsf=(float*)(shm+LDS_WS)+wid*64;
  const bf16*ksrc=Kh+(long)lane*DM+wid*8;
  const bf16*vsrc=Vh+(long)(16*(wid&3)+(lane>>2))*DM+(wid>>2)*32+(lane&3)*8;
  const unsigned kdst=lds0+LDS_K+wid*1024, vdst=lds0+LDS_V+wid*1024;
  #define DMA_K(t,slot) glds16(ksrc+(long)(t)*KVBLK*DM,(unsigned)__builtin_amdgcn_readfirstlane(kdst+(slot)))
  #define DMA_V(t,slot) glds16(vsrc+(long)(t)*KVBLK*DM,(unsigned)__builtin_amdgcn_readfirstlane(vdst+(slot)))
  const int vb0=(int)(lds0+LDS_V)+((lane>>4)&1)*32+(lane&3)*8+(4*hi+((lane&15)>>2))*64;
  const char*Kbase=shm+LDS_K; bf16x8 kf[8];
  const lds_cptr shm3=(lds_cptr)shm; const lds_cptr kp0=shm3+LDS_K+hi*1024+r32*16; const lds_cptr vp0=shm3+LDS_V+((lane>>4)&1)*32+(lane&3)*8+(4*hi+((lane&15)>>2))*64;
  const int NT=(q0+QB)/KVBLK;
  DMA_K(0,0);DMA_V(0,0);DMA_K(1,SLOTB);
  bf16x8 qr[4];
  #pragma unroll
  for(int d0=0;d0<4;++d0)qr[d0]=*reinterpret_cast<const bf16x8*>(&Qw[(long)r32*DM+d0*16+hi*8]);
  float mhat=0.f,l_reg=0.f;f32x16 o[2];f32x16 negm;{float z0_=0.f;asm volatile("":"+v"(z0_));
  #pragma unroll
  for(int r=0;r<16;++r){o[0][r]=z0_;o[1][r]=z0_;negm[r]=z0_;}}asm volatile("":"+v"(negm));
  const int qrel=wid*QBLK+r32;
  #define CMASK(P0,P1,t) do{int jb_=(t)-(NT-4); if(jb_>=0)cmask(P0,P1,jb_,qrel,hi);}while(0)
  bool resc=false;
  #define START(P0,P1) do{ const float rm=rowmax(P0,P1); resc=false; \
    { const float dl=rm; mhat=fadd_s(mhat,dl); \
      _Pragma("unroll") for(int r=0;r<16;++r){P0[r]=fsub_s(P0[r],dl);P1[r]=fsub_s(P1[r],dl);} \
      _Pragma("unroll") for(int r=0;r<16;++r)negm[r]=-mhat; asm volatile("":"+v"(negm)); } \
    _Pragma("unroll") for(int r=0;r<16;++r)P0[r]=__builtin_amdgcn_exp2f(P0[r]); }while(0)
  #define RESC() do{ if(resc){ asm volatile("s_waitcnt lgkmcnt(0)":::"memory"); \
      _Pragma("unroll") for(int d_=0;d_<2;++d_) _Pragma("unroll") for(int r=0;r<16;++r)o[d_][r]*=wsf[crow(r,hi)]; } }while(0)
  f32x16 pA0,pA1,pB0,pB1;
  int sl_prev=0,sl_cur=0,sl_next=SLOTB;
  #define ROT() do{sl_prev=sl_cur;sl_cur=sl_next;sl_next=(sl_next==(NSLOT-1)*SLOTB)?0:sl_next+SLOTB;}while(0)
  DMA_K(2,2*SLOTB);
  WAIT_BAR(3);
  qkt(pA0,pA1,Kbase,qr,negm,r32,hi);asm volatile("s_nop 15\n\ts_nop 7":"+v"(pA0),"+v"(pA1));CMASK(pA0,pA1,0);
  START(pA0,pA1);
  _Pragma("unroll") for(int r=0;r<16;++r)pA1[r]=__builtin_amdgcn_exp2f(pA1[r]);
  WAIT_BAR(0);
  DMA_K(3,0);DMA_V(1,SLOTB);
  ROT();
  kload8(kf,kp0+sl_cur);
  WAIT_BAR(2);
  s16x4 vlo[8],vhi[8]; u32x4 pw0,pw1,pw2,pw3;
  #define PKW(P,B) cvtpk_s(P[B],P[B+1])
  #define PAF(k) __builtin_bit_cast(bf16x8,pw##k)
  #define VFR(i) (bf16x8){vlo[i][0],vlo[i][1],vlo[i][2],vlo[i][3],vhi[i][0],vhi[i][1],vhi[i][2],vhi[i][3]}
  #define PIN(x) asm volatile("":"+v"(x))
  #define MX3(a,b,c) __builtin_fmaxf(__builtin_fmaxf((a),(b)),(c))
  #define GAPA(MF,A0,A1,A2,A3,W0,W1,PW) do{ MF; sacc+=A0; sacc+=A1; sacc+=A2; sacc+=A3; PIN(sacc); W0; W1; PIN(PW); SBAR(); }while(0)
  #define EX(v) __builtin_amdgcn_exp2f(v)
  #define GAPB(MF,X,B) do{ MF; X[B]=EX(X[B]); X[B+1]=EX(X[B+1]); X[B+2]=EX(X[B+2]); X[B+3]=EX(X[B+3]); PIN(X); SBAR(); }while(0)
  #define VRD(i) do{ vlo[i]=vtr(vp_+(((i)>>2)*4096+((i)&3)*1024)); vhi[i]=vtr(vp_+(((i)>>2)*4096+((i)&3)*1024+512)); }while(0)
  #define KRD(G,j) do{ if(G){ kload2(kf,kp0+sl_next,j); SBAR(); } }while(0)
  #define STEP(C0,C1,P0,P1,t,GK,GV,GL) do{ SBAR(); \
    const lds_cptr vp_=vp0+sl_prev; \
    VRD(0); SBAR(); float sacc=(P0[0]+P0[1]); \
    GAPA(C0=__builtin_amdgcn_mfma_f32_32x32x16_bf16(kf[0],qr[0],negm,0,0,0), P0[2],P0[3],P0[4],P0[5],     pw0[0]=PKW(P0,0), pw0[1]=PKW(P0,2), pw0); \
    VRD(4); SBAR(); GAPA(C1=__builtin_amdgcn_mfma_f32_32x32x16_bf16(kf[1],qr[0],negm,0,0,0), P0[6],P0[7],P0[8],P0[9],     pw0[2]=PKW(P0,4), pw0[3]=PKW(P0,6), pw0); \
    VRD(1); SBAR(); GAPA(C0=__builtin_amdgcn_mfma_f32_32x32x16_bf16(kf[2],qr[1],C0,0,0,0),   P0[10],P0[11],P0[12],P0[13], pw1[0]=PKW(P0,8), pw1[1]=PKW(P0,10), pw1); \
    VRD(5); SBAR(); GAPA(C1=__builtin_amdgcn_mfma_f32_32x32x16_bf16(kf[3],qr[1],C1,0,0,0),   P0[14],P0[15],P1[0],P1[1],   pw1[2]=PKW(P0,12),pw1[3]=PKW(P0,14), pw1); \
    VRD(2); SBAR(); GAPA(C0=__builtin_amdgcn_mfma_f32_32x32x16_bf16(kf[4],qr[2],C0,0,0,0),   P1[2],P1[3],P1[4],P1[5],     pw2[0]=PKW(P1,0), pw2[1]=PKW(P1,2), pw2); \
    VRD(6); SBAR(); GAPA(C1=__builtin_amdgcn_mfma_f32_32x32x16_bf16(kf[5],qr[2],C1,0,0,0),   P1[6],P1[7],P1[8],P1[9],     pw2[2]=PKW(P1,4), pw2[3]=PKW(P1,6), pw2); \
    VRD(3); SBAR(); GAPA(C0=__builtin_amdgcn_mfma_f32_32x32x16_bf16(kf[6],qr[3],C0,0,0,0),   P1[10],P1[11],P1[12],P1[13], pw3[0]=PKW(P1,8), pw3[1]=PKW(P1,10), pw3); \
    VRD(7); SBAR(); GAPA(C1=__builtin_amdgcn_mfma_f32_32x32x16_bf16(kf[7],qr[3],C1,0,0,0),   P1[14],P1[15],0.f,0.f,       pw3[2]=PKW(P1,12),pw3[3]=PKW(P1,14), pw3); \
    l_reg+=sacc; \
    if(GK){DMA_K((t)+3,sl_cur);} if(GV){DMA_V((t)+1,sl_next);} \
    CMASK(C0,C1,t); \
    { float a=MX3(C0[0],C0[1],C1[0]),b=MX3(C0[2],C0[3],C1[1]); a=MX3(a,C1[2],C1[3]); \
      _Pragma("unroll") for(int r=4;r<16;r+=4){a=MX3(a,C0[r],C0[r+1]);b=MX3(b,C0[r+2],C0[r+3]);a=MX3(a,C1[r],C1[r+1]);b=MX3(b,C1[r+2],C1[r+3]);} \
      float rm=__builtin_fmaxf(a,b); { auto rr=__builtin_amdgcn_permlane32_swap(__float_as_uint(rm),__float_as_uint(rm),false,false); rm=__builtin_fmaxf(__uint_as_float(rr[0]),__uint_as_float(rr[1])); } \
      resc=false; \
      if(__builtin_expect(__any(rm>(float)THRL),0)){ const float dl=__builtin_fmaxf(rm,0.f); mhat+=dl; \
        _Pragma("unroll") for(int r=0;r<16;++r){C0[r]-=dl;C1[r]-=dl;} \
        _Pragma("unroll") for(int r=0;r<16;++r)negm[r]=-mhat; asm volatile("":"+v"(negm)); \
        const float f=__builtin_amdgcn_exp2f(-dl); l_reg*=f; if(hi==0)wsf[r32]=f; resc=true; } } \
    SBAR(); \
    GAPB(o[0]=__builtin_amdgcn_mfma_f32_32x32x16_bf16(PAF(0),VFR(0),o[0],0,0,0), C0,0); \
    GAPB(o[1]=__builtin_amdgcn_mfma_f32_32x32x16_bf16(PAF(0),VFR(4),o[1],0,0,0), C0,4); \
    KRD(GL,0); GAPB(o[0]=__builtin_amdgcn_mfma_f32_32x32x16_bf16(PAF(1),VFR(1),o[0],0,0,0), C0,8); \
    KRD(GL,1); GAPB(o[1]=__builtin_amdgcn_mfma_f32_32x32x16_bf16(PAF(1),VFR(5),o[1],0,0,0), C0,12); \
    KRD(GL,2); GAPB(o[0]=__builtin_amdgcn_mfma_f32_32x32x16_bf16(PAF(2),VFR(2),o[0],0,0,0), C1,0); \
    KRD(GL,3); GAPB(o[1]=__builtin_amdgcn_mfma_f32_32x32x16_bf16(PAF(2),VFR(6),o[1],0,0,0), C1,4); \
    GAPB(o[0]=__builtin_amdgcn_mfma_f32_32x32x16_bf16(PAF(3),VFR(3),o[0],0,0,0), C1,8); \
    GAPB(o[1]=__builtin_amdgcn_mfma_f32_32x32x16_bf16(PAF(3),VFR(7),o[1],0,0,0), C1,12); \
    }while(0)
  int t=1;
  #undef CMASK
  #define CMASK(P0,P1,t) do{}while(0)
  for(;t+5<NT;t+=2){
    STEP(pB0,pB1,pA0,pA1,t,true,true,true);     WAIT_BAR(2); RESC(); ROT();
    STEP(pA0,pA1,pB0,pB1,t+1,true,true,true);   WAIT_BAR(2); RESC(); ROT();
  }
  #undef CMASK
  #define CMASK(P0,P1,t) do{int jb_=(t)-(NT-4); if(jb_>=0)cmask(P0,P1,jb_,qrel,hi);}while(0)
  #define ENDW(tt) do{ if((tt)+3<NT){WAIT_BAR(2);} else if((tt)+2<NT){WAIT_BAR(1);} else {WAIT_BAR(0);} }while(0)
  for(;t+1<NT;t+=2){
    STEP(pB0,pB1,pA0,pA1,t,(t+3<NT),(t+1<NT),(t+1<NT));       ENDW(t);   RESC(); ROT();
    STEP(pA0,pA1,pB0,pB1,t+1,(t+4<NT),(t+2<NT),(t+2<NT));     ENDW(t+1); RESC(); ROT();
  }
  STEP(pB0,pB1,pA0,pA1,NT-1,false,false,false); RESC();
  { float sacc=pB0[0]+pB0[1]; _Pragma("unroll") for(int r=2;r<16;++r)sacc+=pB0[r]; _Pragma("unroll") for(int r=0;r<16;++r)sacc+=pB1[r]; l_reg+=sacc;
    pw0=(u32x4){PKW(pB0,0),PKW(pB0,2),PKW(pB0,4),PKW(pB0,6)};pw1=(u32x4){PKW(pB0,8),PKW(pB0,10),PKW(pB0,12),PKW(pB0,14)};pw2=(u32x4){PKW(pB1,0),PKW(pB1,2),PKW(pB1,4),PKW(pB1,6)};pw3=(u32x4){PKW(pB1,8),PKW(pB1,10),PKW(pB1,12),PKW(pB1,14)};
    SBAR(); pv(o,vb0+sl_cur,PAF(0),PAF(1),PAF(2),PAF(3)); }
  #undef PKW
  #undef PAF
  #undef VFR
  #undef PIN
  #undef MX3
  #undef GAPA
  #undef GAPB
  #undef EX
  #undef VRD
  #undef KRD
  #undef STEP
  #undef ENDW
  {auto rr=__builtin_amdgcn_permlane32_swap(__float_as_uint(l_reg),__float_as_uint(l_reg),false,false);l_reg=__uint_as_float(rr[0])+__uint_as_float(rr[1]);}
  if(hi==0)wsf[32+r32]=l_reg;asm volatile("s_waitcnt lgkmcnt(0)":::"memory");
  float rli[16];
  #pragma unroll
  for(int r=0;r<16;++r)rli[r]=__builtin_amdgcn_rcpf(wsf[32+crow(r,hi)]);
  bf16*Ow=Oh+(long)(q0+wid*QBLK)*POUT;
  { bf16*stg=(bf16*)(shm+LDS_OST)+wid*2048;
    #pragma unroll
    for(int r=0;r<16;++r){const int orow=crow(r,hi);
      #pragma unroll
      for(int d0=0;d0<2;++d0)stg[orow*64+d0*32+r32]=__float2bfloat16(o[d0][r]*rli[r]);}
    asm volatile("s_waitcnt lgkmcnt(0)":::"memory");
    #pragma unroll
    for(int i=0;i<4;++i){const int row=i*8+(lane>>3),ch=lane&7; const u32x4 v=*(const u32x4*)(stg+row*64+ch*8); ATTN_STORE16(Ow+(long)row*POUT+ch*8,v);} }
  asm volatile("s_waitcnt lgkmcnt(0)\n\ts_barrier":::"memory");
  #undef DMA_K
  #undef DMA_V
  #undef CMASK
  #undef START
  #undef RESC
  #undef ROT
}
constexpr int ATTN_LDS_BYTES=LDS_BYTES;
#undef SBAR
#undef WAIT_BAR
}

#define LAS __attribute__((address_space(3)))
typedef unsigned short bf16_t;
typedef float f32x4 __attribute__((ext_vector_type(4)));
typedef unsigned u32x4 __attribute__((ext_vector_type(4)));
typedef unsigned u32x2 __attribute__((ext_vector_type(2)));
typedef float f32x2 __attribute__((ext_vector_type(2)));
typedef _Float16 f16x8 __attribute__((ext_vector_type(8)));
typedef _Float16 f16x4 __attribute__((ext_vector_type(4)));

constexpr int NB = 2, S = 16384, T = NB * S, D = 1024, DEPTH = 4;
constexpr int EV_N = 3368, EV_NP = 3584, EV_ZP = 3072, OD_N = 2048;
constexpr float EPS = 1e-6f;
constexpr float LOG2E = 1.4426950408889634f;
constexpr float QSCALE = 0.125f * LOG2E;
constexpr int NWAVES = 8, NTHREADS = 512;
constexpr int LDS_BYTES = 163840;
constexpr int LDS_MISC = 131072;
constexpr int LDS_BARW = LDS_BYTES - 64;
constexpr int LDS_PTBL = LDS_BYTES - 512;

constexpr size_t MiB = 1u << 20;
constexpr size_t WS_CTL = 0, CTL_ZERO_BYTES = 1 * MiB;
constexpr size_t WS_MOD = 1 * MiB;
constexpr size_t WS_MODP = 1 * MiB + 256 * 1024;
constexpr size_t WS_ROPE = 2 * MiB;
constexpr size_t WS_S5A = 4 * MiB;
constexpr size_t WS_S5B = 4 * MiB + 64 * 1024;
constexpr size_t WS_LAM = 6 * MiB;
constexpr size_t WS_KM = 6 * MiB + 4096;
constexpr size_t WS_WRH = 6 * MiB + 512 * 1024;
constexpr size_t WS_KMH = 7 * MiB + 512 * 1024;
constexpr size_t WS_WEVIN = 8 * MiB;
constexpr size_t WS_WEVOUT = 22 * MiB;
constexpr size_t WS_WODIN = 26 * MiB;
constexpr size_t WS_WODOUT = 34 * MiB;
constexpr size_t WS_WGLU = 38 * MiB;
constexpr size_t WS_W13 = 40 * MiB;
constexpr size_t WS_W2 = 104 * MiB;
constexpr size_t WS_H = 136 * MiB;
constexpr size_t WS_O = 200 * MiB;
constexpr size_t WS_Z = 264 * MiB;
constexpr size_t WS_XG = 264 * MiB;
constexpr size_t WS_Y = 264 * MiB;
constexpr size_t WS_HID = 408 * MiB;
constexpr size_t WS_IQ = 456 * MiB;
constexpr size_t WS_YG = 456 * MiB;
constexpr size_t WS_IKW = 488 * MiB;
constexpr size_t WS_IQH = 496 * MiB;
constexpr size_t WS_IKH = 512 * MiB;
constexpr size_t WS_IW = 514 * MiB;
constexpr size_t WS_SEL = 516 * MiB;
constexpr size_t WS_YMIX = 548 * MiB;
constexpr size_t WS_LTOK = 612 * MiB;
constexpr size_t WS_TOKES = 616 * MiB;
constexpr size_t WS_TOKW = 617 * MiB;
constexpr size_t WS_TOKROW = 618 * MiB;
constexpr size_t WS_UG = 516 * MiB;
constexpr size_t WS_S5E = 496 * MiB;
constexpr size_t WS_S5HC = 488 * MiB;
constexpr size_t WS_S5KT = 620 * MiB;
constexpr size_t WS_S5WT = 624 * MiB;
constexpr size_t WS_S5A2 = 640 * MiB;
constexpr size_t WS_S5PW = 656 * MiB;
constexpr size_t WS_MLIST = 660 * MiB;
constexpr size_t WS_MPO = 724 * MiB;
constexpr size_t WS_MML = 852 * MiB;
constexpr size_t WS_MASKW = 724 * MiB;
constexpr size_t WS_NSEL = 860 * MiB;
constexpr size_t WS_XB = 862 * MiB;
constexpr size_t WS_END = 926 * MiB;
constexpr int XG_ROWS = 73728;
constexpr int CW_BAR = 4096;
constexpr int CW_MCNT = 16384;
constexpr int CW_CNT = 8192;

#define XB_TMO      128
#define XB_XCNT(j)  (256  + 64 * (j))
#define XB_XSUB(j)  (1280 + 64 * (j))
#define XB_XGEN(j)  (2304 + 64 * (j))
#define XB_TOP      3328
#define XB_TOPGEN   3392
#define XCD_BAR_WORDS 3456
#define XB_SPIN_CAP (1u << 24)

__device__ __forceinline__ unsigned xb_ld(unsigned* p)              { return __hip_atomic_load(p, __ATOMIC_RELAXED, __HIP_MEMORY_SCOPE_AGENT); }
__device__ __forceinline__ unsigned xb_add(unsigned* p, unsigned v) { return __hip_atomic_fetch_add(p, v, __ATOMIC_RELAXED, __HIP_MEMORY_SCOPE_AGENT); }
__device__ __forceinline__ unsigned xb_xcc_id() { return (unsigned)__builtin_amdgcn_s_getreg((3 << 11) | 20) & 0xFu; }
#define XB_SPIN(cond, bar) do { unsigned _sp = 0; while (cond) { __builtin_amdgcn_s_sleep(1); \
    if ((++_sp & 255u) == 0u) { if (xb_ld(&(bar)[XB_TMO])) break; if (_sp > XB_SPIN_CAP) { atomicAdd(&(bar)[XB_TMO], 1u); break; } } } } while (0)

struct XcdBarrier { unsigned* bar; unsigned x; volatile LAS unsigned* st; };

__device__ __forceinline__ XcdBarrier xcd_barrier_post(unsigned* bar, volatile LAS unsigned* st, bool leader) {
    XcdBarrier b; b.bar = bar; b.x = xb_xcc_id(); b.st = st;
    if (leader) (void)xb_add(&bar[XB_XCNT(b.x)], 1u);
    return b;
}
__device__ __forceinline__ void xcd_barrier_complete(unsigned* bar, unsigned x, unsigned& nloc, unsigned& nx) {
    const unsigned G = gridDim.x * gridDim.y * gridDim.z;
    unsigned sum, cnt, mine, sp = 0u;
    for (;;) {
        sum = 0u; cnt = 0u; mine = 0u;
#pragma unroll
        for (unsigned j = 0; j < 16; ++j) { const unsigned c = xb_ld(&bar[XB_XCNT(j)]); sum += c; cnt += (c > 0u) ? 1u : 0u; mine = (j == x) ? c : mine; }
        if (sum == G) break;
        __builtin_amdgcn_s_sleep(1);
        if ((++sp & 255u) == 0u) { if (xb_ld(&bar[XB_TMO])) break; if (sp > XB_SPIN_CAP) { atomicAdd(&bar[XB_TMO], 1u); break; } }
    }
    nloc = mine > 0u ? mine : 1u; nx = cnt > 0u ? cnt : 1u;
}
__device__ __forceinline__ void xcd_barrier(const XcdBarrier& b, bool leader) {
    asm volatile("s_waitcnt vmcnt(0)" ::: "memory");
    __syncthreads();
    if (leader) {
        unsigned* bar = b.bar;
        __builtin_amdgcn_s_waitcnt(0);
        unsigned nloc = b.st[0], nx = b.st[1];
        if (nloc == 0u) { xcd_barrier_complete(bar, b.x, nloc, nx); b.st[0] = nloc; b.st[1] = nx; }
        const unsigned old = xb_add(&bar[XB_XSUB(b.x)], 1u);
        const unsigned gen = old / nloc;
        if (old + 1u == (gen + 1u) * nloc) {
            __builtin_amdgcn_fence(__ATOMIC_RELEASE, "agent");
            asm volatile("s_waitcnt vmcnt(0)" ::: "memory");
            const unsigned og = xb_add(&bar[XB_TOP], 1u);
            const unsigned tg = og / nx;
            if (og + 1u == (tg + 1u) * nx) xb_add(&bar[XB_TOPGEN], 1u);
            else XB_SPIN(xb_ld(&bar[XB_TOPGEN]) == tg, bar);
            __builtin_amdgcn_fence(__ATOMIC_ACQUIRE, "agent");
            xb_add(&bar[XB_XGEN(b.x)], 1u);
            asm volatile("s_waitcnt vmcnt(0)" ::: "memory");
        } else {
            XB_SPIN(xb_ld(&bar[XB_XGEN(b.x)]) == gen, bar);
            __builtin_amdgcn_fence(__ATOMIC_ACQUIRE, "agent");
            asm volatile("s_waitcnt vmcnt(0)" ::: "memory");
        }
    }
    __syncthreads();
}

#define LDS_WAIT() asm volatile("s_waitcnt lgkmcnt(0)" ::: "memory")
__device__ __forceinline__ float bflo(unsigned w) { return __uint_as_float(w << 16); }
__device__ __forceinline__ float bfhi(unsigned w) { return __uint_as_float(w & 0xffff0000u); }
__device__ __forceinline__ unsigned pk2(float lo, float hi) { typedef float f32x2_ __attribute__((ext_vector_type(2))); typedef __bf16 bf16x2_ __attribute__((ext_vector_type(2))); const f32x2_ v = {lo, hi}; return __builtin_bit_cast(unsigned, __builtin_convertvector(v, bf16x2_)); }
__device__ __forceinline__ unsigned f2bf(float f) { return pk2(f, 0.f) & 0xffffu; }
__device__ __forceinline__ float shx_(float v, int m, int lane) { return __int_as_float(__builtin_amdgcn_ds_bpermute((lane ^ m) << 2, __float_as_int(v))); }
__device__ __forceinline__ unsigned shi_(unsigned v, int src) { return (unsigned)__builtin_amdgcn_ds_bpermute(src << 2, (int)v); }
#define SHX(v, m) shx_((v), (m), lane)
__device__ __forceinline__ float dpp_xor1(float v) { return __int_as_float(__builtin_amdgcn_update_dpp(0, __float_as_int(v), 0xB1, 0xF, 0xF, true)); }
__device__ __forceinline__ float dpp_xor2(float v) { return __int_as_float(__builtin_amdgcn_update_dpp(0, __float_as_int(v), 0x4E, 0xF, 0xF, true)); }
__device__ __forceinline__ float half_sum(float v) { const auto r = __builtin_amdgcn_permlane32_swap(__float_as_uint(v), __float_as_uint(v), false, false); return __uint_as_float(r[0]) + __uint_as_float(r[1]); }
__device__ __forceinline__ float half_max(float v) { const auto r = __builtin_amdgcn_permlane32_swap(__float_as_uint(v), __float_as_uint(v), false, false); return fmaxf(__uint_as_float(r[0]), __uint_as_float(r[1])); }
__device__ __forceinline__ float wave_sum_(float v, int lane) {
    v += dpp_xor1(v); v += dpp_xor2(v); v += shx_(v, 4, lane); v += shx_(v, 8, lane); v += shx_(v, 16, lane); return half_sum(v);
}

#define wave_sum(v) wave_sum_((v), lane)
__device__ __forceinline__ float wave_max_(float v, int lane) {
#pragma unroll
    for (int o = 1; o < 64; o <<= 1) v = fmaxf(v, shx_(v, o, lane));
    return v;
}
__device__ __forceinline__ bool qk_bounded(const float* gq, const float* gk, int lane) {
    const float a = wave_max_(fabsf(gq[lane]), lane), b = wave_max_(fabsf(gk[lane]), lane);
    return 64.0f * QSCALE * a * b <= 60.0f;
}
__device__ __forceinline__ void unpack8(const u32x4 w, float (&v)[8]) {
    v[0] = bflo(w.x); v[1] = bfhi(w.x); v[2] = bflo(w.y); v[3] = bfhi(w.y); v[4] = bflo(w.z); v[5] = bfhi(w.z); v[6] = bflo(w.w); v[7] = bfhi(w.w);
}
__device__ __forceinline__ u32x4 pack8(const float (&v)[8]) { u32x4 w; w.x = pk2(v[0], v[1]); w.y = pk2(v[2], v[3]); w.z = pk2(v[4], v[5]); w.w = pk2(v[6], v[7]); return w; }
__device__ __forceinline__ float gelu_tanh(float y) {
    const float z = 0.7978845608028654f * (y + 0.044715f * y * y * y);
    const float e = __builtin_amdgcn_exp2f(2.885390081777927f * z);
    const float th = 1.0f - 2.0f * __builtin_amdgcn_rcpf(e + 1.0f);
    return 0.5f * y * (1.0f + th);
}
__device__ __forceinline__ float sigmoidf_(float v) { return __builtin_amdgcn_rcpf(1.0f + __builtin_amdgcn_exp2f(-1.4426950408889634f * v)); }
__device__ __forceinline__ unsigned ordkey(float f) { const unsigned u = __float_as_uint(f); return u ^ ((unsigned)((int)u >> 31) | 0x80000000u); }

struct EpiPlain {
    static constexpr bool PERM = true, AFTER_DRAIN = false;
    bf16_t* O; int ldc;
    __device__ __forceinline__ void operator()(const pg8::f32x4 (&acc)[2][2][4][2], const pg8::Unit& u, int wr, int wc, int fr, int fq) const {
        const int row0 = u.pm * 256 + wr * 64 + fr, col0 = u.pn * 256 + wc * 32 + 8 * fq;
#pragma unroll
        for (int ai = 0; ai < 2; ++ai)
#pragma unroll
            for (int m = 0; m < 4; ++m) { bf16_t* rowp = O + (size_t)(row0 + ai * 128 + m * 16) * ldc + col0;
#pragma unroll
                for (int bj = 0; bj < 2; ++bj) { const pg8::f32x4 v0 = acc[ai][bj][m][0], v1 = acc[ai][bj][m][1];
                    u32x4 w; w.x = pk2(v0[0], v0[1]); w.y = pk2(v0[2], v0[3]); w.z = pk2(v1[0], v1[1]); w.w = pk2(v1[2], v1[3]);
                    *(u32x4*)(rowp + bj * 128) = w; } }
    }
};
__device__ __forceinline__ void epi_khead(const pg8::f32x4 (&acc)[2][2][4][2], bf16_t* Z, int ldz, int colbase, const float* gain, const float* COSH, const float* SINH, int row0, int wc, int fr, int fq) {
    const int lane = fr + 16 * fq;
    float g[2][8];
#pragma unroll
    for (int bj = 0; bj < 2; ++bj)
#pragma unroll
        for (int e = 0; e < 8; ++e) g[bj][e] = gain[bj * 32 + 8 * fq + e];
#pragma unroll
    for (int ai = 0; ai < 2; ++ai)
#pragma unroll
      for (int mp = 0; mp < 4; mp += 2) {
        f32x4 csv[2][2], snv[2][2];
#pragma unroll
        for (int mm = 0; mm < 2; ++mm) { const int pos = (row0 + ai * 128 + (mp + mm) * 16) & (S - 1);
            csv[mm][0] = *(const f32x4*)(COSH + pos * 8); csv[mm][1] = *(const f32x4*)(COSH + pos * 8 + 4); snv[mm][0] = *(const f32x4*)(SINH + pos * 8); snv[mm][1] = *(const f32x4*)(SINH + pos * 8 + 4); }
        __builtin_amdgcn_sched_barrier(0);
#pragma unroll
        for (int mm = 0; mm < 2; ++mm) { const int m = mp + mm; const int row = row0 + ai * 128 + m * 16;
            float v[2][8]; float ss = 0.f;
#pragma unroll
            for (int bj = 0; bj < 2; ++bj)
#pragma unroll
                for (int e = 0; e < 4; ++e) { v[bj][e] = acc[ai][bj][m][0][e]; v[bj][4 + e] = acc[ai][bj][m][1][e]; ss += v[bj][e] * v[bj][e] + v[bj][4 + e] * v[bj][4 + e]; }
            ss += shx_(ss, 16, lane); ss = half_sum(ss);
            const float r = rsqrtf(ss * (1.0f / 64.0f) + EPS);
#pragma unroll
            for (int bj = 0; bj < 2; ++bj)
#pragma unroll
                for (int e = 0; e < 8; ++e) v[bj][e] *= r * g[bj][e];
#pragma unroll
            for (int e = 0; e < 8; ++e) { const float oth = shx_(v[0][e], 16, lane); const float cs = csv[mm][e >> 2][e & 3], sn = snv[mm][e >> 2][e & 3];
                if (fq == 0) v[0][e] = v[0][e] * cs - oth * sn; else if (fq == 1) v[0][e] = v[0][e] * cs + oth * sn; }
            bf16_t* zp = Z + (size_t)row * ldz + colbase + wc * 64 + 8 * fq;
            *(u32x4*)zp = pack8(v[0]); *(u32x4*)(zp + 32) = pack8(v[1]); }
        __builtin_amdgcn_sched_barrier(0);
      }
}
struct EpiEvenIn {
    static constexpr bool PERM = true, AFTER_DRAIN = false;
    bf16_t* Z; _Float16* IQH; _Float16* IKH; float* IW; const float* a_kn; const float* b_kn; const float* idx_kn; const float* COSH; const float* SINH; const float* COSI; const float* SINI;
    __device__ __forceinline__ void operator()(const pg8::f32x4 (&acc)[2][2][4][2], const pg8::Unit& u, int wr, int wc, int fr, int fq) const {
        const int row0 = u.pm * 256 + wr * 64 + fr; const int lane = fr + 16 * fq;
        if (u.pn == 2 || u.pn == 3) epi_khead(acc, Z, EV_ZP, 512 + (u.pn & 1) * 256, a_kn, COSH, SINH, row0, wc, fr, fq);
        else if (u.pn == 8 || u.pn == 9) epi_khead(acc, Z, EV_ZP, 2048 + (u.pn & 1) * 256, b_kn, COSH, SINH, row0, wc, fr, fq);
        else if (u.pn < 12) {
            const int col0 = u.pn * 256 + wc * 32 + 8 * fq;
#pragma unroll
            for (int ai = 0; ai < 2; ++ai)
#pragma unroll
                for (int m = 0; m < 4; ++m) { bf16_t* rowp = Z + (size_t)(row0 + ai * 128 + m * 16) * EV_ZP + col0;
#pragma unroll
                    for (int bj = 0; bj < 2; ++bj) { const pg8::f32x4 v0 = acc[ai][bj][m][0], v1 = acc[ai][bj][m][1];
                        u32x4 w; w.x = pk2(v0[0], v0[1]); w.y = pk2(v0[2], v0[3]); w.z = pk2(v1[0], v1[1]); w.w = pk2(v1[2], v1[3]);
                        *(u32x4*)(rowp + bj * 128) = w; } }
        } else if (u.pn == 12) {
#pragma unroll
            for (int ai = 0; ai < 2; ++ai) {
                f32x4 csr[4], snr[4];
#pragma unroll
                for (int m = 0; m < 4; ++m) { const int pos = (row0 + ai * 128 + m * 16) & (S - 1); csr[m] = *(const f32x4*)(COSI + pos * 4); snr[m] = *(const f32x4*)(SINI + pos * 4); }
                __builtin_amdgcn_sched_barrier(0);
#pragma unroll
                for (int m = 0; m < 4; ++m) { const int row = row0 + ai * 128 + m * 16;
                    const f32x4 cs = csr[m], sn = snr[m];
#pragma unroll
                    for (int bj = 0; bj < 2; ++bj) { pg8::f32x4 v0 = acc[ai][bj][m][0], v1 = acc[ai][bj][m][1];
                        if (fq == 0) { const pg8::f32x4 a0 = v0, a1 = v1;
#pragma unroll
                            for (int e = 0; e < 4; ++e) { v0[e] = a0[e] * cs[e] - a1[e] * sn[e]; v1[e] = a1[e] * cs[e] + a0[e] * sn[e]; } }
                        f16x8 hq;
#pragma unroll
                        for (int e = 0; e < 4; ++e) { hq[e] = (_Float16)v0[e]; hq[4 + e] = (_Float16)v1[e]; }
                        *(f16x8*)(IQH + (size_t)row * 256 + bj * 128 + wc * 32 + 8 * fq) = hq; } }
                __builtin_amdgcn_sched_barrier(0);
            }
        } else {
            if (wc == 0) {
                float g[8];
#pragma unroll
                for (int e = 0; e < 8; ++e) g[e] = idx_kn[8 * fq + e];
#pragma unroll
                for (int ai = 0; ai < 2; ++ai) {
                  f32x4 csr[4], snr[4];
#pragma unroll
                  for (int m = 0; m < 4; ++m) { const int pos = (row0 + ai * 128 + m * 16) & (S - 1); csr[m] = *(const f32x4*)(COSI + pos * 4); snr[m] = *(const f32x4*)(SINI + pos * 4); }
                  __builtin_amdgcn_sched_barrier(0);
#pragma unroll
                    for (int m = 0; m < 4; ++m) { const int row = row0 + ai * 128 + m * 16;
                        float v[8]; float ss = 0.f;
#pragma unroll
                        for (int e = 0; e < 4; ++e) { v[e] = acc[ai][0][m][0][e]; v[4 + e] = acc[ai][0][m][1][e]; ss += v[e] * v[e] + v[4 + e] * v[4 + e]; }
                        ss += shx_(ss, 16, lane); ss = half_sum(ss);
                        const float r = rsqrtf(ss * (1.0f / 32.0f) + EPS);
#pragma unroll
                        for (int e = 0; e < 8; ++e) v[e] *= r * g[e];
                        if (fq == 0) {
#pragma unroll
                            for (int e = 0; e < 4; ++e) { const float x1 = v[e], x2 = v[4 + e]; const float cs = csr[m][e], sn = snr[m][e]; v[e] = x1 * cs - x2 * sn; v[4 + e] = x2 * cs + x1 * sn; } }
                        f16x8 hk;
#pragma unroll
                        for (int e = 0; e < 8; ++e) hk[e] = (_Float16)v[e];
                        *(f16x8*)(IKH + (size_t)row * 32 + 8 * fq) = hk; }
                  __builtin_amdgcn_sched_barrier(0);
                }
            } else if (wc == 1 && fq == 0) {
#pragma unroll
                for (int ai = 0; ai < 2; ++ai)
#pragma unroll
                    for (int m = 0; m < 4; ++m) { float* wp = IW + (size_t)(row0 + ai * 128 + m * 16) * 8; *(pg8::f32x4*)wp = acc[ai][0][m][0]; *(pg8::f32x4*)(wp + 4) = acc[ai][0][m][1]; }
            }
        }
    }
};
struct EpiOddIn {
    static constexpr bool PERM = true, AFTER_DRAIN = false;
    bf16_t* Z; bf16_t* UG; const float* c_kn; const float* COSH; const float* SINH;
    __device__ __forceinline__ void operator()(const pg8::f32x4 (&acc)[2][2][4][2], const pg8::Unit& u, int wr, int wc, int fr, int fq) const {
        const int row0 = u.pm * 256 + wr * 64 + fr, col0 = u.pn * 256 + wc * 32 + 8 * fq;
        if (u.pn == 2 || u.pn == 3) { epi_khead(acc, Z, OD_N, 512 + (u.pn & 1) * 256, c_kn, COSH, SINH, row0, wc, fr, fq); return; }
#pragma unroll
        for (int ai = 0; ai < 2; ++ai)
#pragma unroll
            for (int m = 0; m < 4; ++m) { const size_t row = (size_t)(row0 + ai * 128 + m * 16);
#pragma unroll
                for (int bj = 0; bj < 2; ++bj) { const pg8::f32x4 v0 = acc[ai][bj][m][0], v1 = acc[ai][bj][m][1]; const int col = col0 + bj * 128;
                    u32x4 w; w.x = pk2(v0[0], v0[1]); w.y = pk2(v0[2], v0[3]); w.z = pk2(v1[0], v1[1]); w.w = pk2(v1[2], v1[3]);
                    if (u.pn < 6) *(u32x4*)(Z + row * OD_N + col) = w;
                    else { const int cu = col - 1536; *(u32x4*)(UG + ((size_t)(cu >> 4) * T + row) * 16 + (cu & 15)) = w; } } }
    }
};
__device__ __forceinline__ void load_q_normed(attn_body::bf16x8 (&qr)[4], const bf16_t* zrow, const float* gain, const float* COSH, const float* SINH, int pos, int hi, int lane) {
    float v[4][8]; float ss = 0.f;
#pragma unroll
    for (int d0 = 0; d0 < 4; ++d0) { unpack8(*(const u32x4*)(zrow + d0 * 16 + hi * 8), v[d0]);
#pragma unroll
        for (int e = 0; e < 8; ++e) ss += v[d0][e] * v[d0][e]; }
    ss = half_sum(ss);
    const float r = rsqrtf(ss * (1.0f / 64.0f) + EPS) * QSCALE;
#pragma unroll
    for (int d0 = 0; d0 < 4; ++d0)
#pragma unroll
        for (int e = 0; e < 8; ++e) v[d0][e] *= r * gain[d0 * 16 + hi * 8 + e];
#pragma unroll
    for (int e = 0; e < 8; ++e) { const float oth = shx_(v[0][e], 32, lane); const float cs = COSH[pos * 8 + e], sn = SINH[pos * 8 + e];
        v[0][e] = hi ? v[0][e] * cs + oth * sn : v[0][e] * cs - oth * sn; }
#pragma unroll
    for (int d0 = 0; d0 < 4; ++d0) qr[d0] = __builtin_bit_cast(attn_body::bf16x8, pack8(v[d0]));
}
struct EpiSwiGLU {
    static constexpr bool PERM = true, AFTER_DRAIN = false;
    bf16_t* HID;
    __device__ __forceinline__ void operator()(const pg8::f32x4 (&acc)[2][2][4][2], const pg8::Unit& u, int wr, int wc, int fr, int fq) const {
        const int row0 = u.pm * 256 + wr * 64 + fr, col0 = (u.pn * 256 + wc * 32 + 8 * fq) >> 1;
#pragma unroll
        for (int ai = 0; ai < 2; ++ai)
#pragma unroll
            for (int m = 0; m < 4; ++m) { bf16_t* rowp = HID + (size_t)(row0 + ai * 128 + m * 16) * 512 + col0;
#pragma unroll
                for (int bj = 0; bj < 2; ++bj) { const pg8::f32x4 v0 = acc[ai][bj][m][0], v1 = acc[ai][bj][m][1];
                    const float h0 = v0[0] * sigmoidf_(v0[0]) * v0[1], h1 = v0[2] * sigmoidf_(v0[2]) * v0[3];
                    const float h2 = v1[0] * sigmoidf_(v1[0]) * v1[1], h3 = v1[2] * sigmoidf_(v1[2]) * v1[3];
                    u32x2 w; w.x = pk2(h0, h1); w.y = pk2(h2, h3);
                    *(u32x2*)(rowp + bj * 64) = w; } }
    }
};
struct EpiGLU {
    static constexpr bool PERM = true, AFTER_DRAIN = false;
    bf16_t* O; const bf16_t* YG; const float* gb;
    __device__ __forceinline__ void operator()(const pg8::f32x4 (&acc)[2][2][4][2], const pg8::Unit& u, int wr, int wc, int fr, int fq) const {
        const int row0 = u.pm * 256 + wr * 64 + fr, col0 = u.pn * 256 + wc * 32 + 8 * fq;
#pragma unroll
        for (int ai = 0; ai < 2; ++ai)
#pragma unroll
            for (int bj = 0; bj < 2; ++bj) {
                const int c = col0 + bj * 128;
                u32x4 yr[4];
#pragma unroll
                for (int m = 0; m < 4; ++m) yr[m] = *(const u32x4*)(YG + (size_t)(row0 + ai * 128 + m * 16) * 512 + c);
                const pg8::f32x4 b0 = *(const pg8::f32x4*)(gb + c), b1 = *(const pg8::f32x4*)(gb + c + 4);
                __builtin_amdgcn_sched_barrier(0);
#pragma unroll
                for (int m = 0; m < 4; ++m) { const size_t row = (size_t)(row0 + ai * 128 + m * 16);
                    const pg8::f32x4 v0 = acc[ai][bj][m][0], v1 = acc[ai][bj][m][1];
                    float y[8]; unpack8(yr[m], y);
                    float o[8];
#pragma unroll
                    for (int j = 0; j < 4; ++j) { o[j] = y[j] * sigmoidf_(v0[j] + b0[j]); o[4 + j] = y[4 + j] * sigmoidf_(v1[j] + b1[j]); }
                    *(u32x4*)(O + row * 1024 + 512 + c) = pack8(o); }
                __builtin_amdgcn_sched_barrier(0);
            }
    }
};
struct MoeOrder {
    int nN, nunits, G, c; const LAS int* tile_e;
    __device__ __forceinline__ bool next(int i, pg8::Unit& u) const { const int L = i * G + c; if (L >= nunits) return false;
        int w = L; { const int q = nunits / 8, r = nunits % 8, xcd = w % 8, off = w / 8; w = (xcd < r ? xcd * (q + 1) : r * (q + 1) + (xcd - r) * q) + off; }
        u.pm = w / nN; u.pn = w % nN; u.be = tile_e[u.pm]; return true; }
    __device__ __forceinline__ void a_ready(const pg8::Unit&) const {}
    __device__ __forceinline__ void done(const pg8::Unit&) const {}
};

__device__ __forceinline__ int wt_row(int n, int row_mul, int row_add) {
    if (row_mul > 0) return n * row_mul + row_add;
    const int tile = n >> 8, w = n & 255;
    const bool ktile = (tile == 2 || tile == 3) || (row_mul == -1 && (tile == 8 || tile == 9));
    return ktile ? tile * 256 + ((w & 63) >> 5) * 128 + (w >> 6) * 32 + (w & 31) : n;
}
__device__ __forceinline__ void transpose_item(const float* W, int K, int N, bf16_t* WT, int row_mul, int row_add, LAS float* scr, int item, int nblk, int lane) {
    const int kb = item / nblk, nb = item % nblk, k0 = 64 * kb, n0 = 32 * nb;
    const int nn = n0 + (lane & 31);
    float tv[32];
#pragma unroll
    for (int i = 0; i < 32; ++i) { const int kk = 2 * i + (lane >> 5); tv[i] = (nn < N) ? W[(size_t)(k0 + kk) * N + nn] : 0.f; }
#pragma unroll
    for (int i = 0; i < 32; ++i) { const int kk = 2 * i + (lane >> 5); scr[kk * 33 + (lane & 31)] = tv[i]; }
    LDS_WAIT(); asm volatile("" ::: "memory");
    const int c = lane & 7;
#pragma unroll
    for (int j = 0; j < 4; ++j) { const int n = (lane >> 3) + 8 * j; const LAS float* s = scr + (8 * c) * 33 + n;
        u32x4 o; o.x = pk2(s[0 * 33], s[1 * 33]); o.y = pk2(s[2 * 33], s[3 * 33]); o.z = pk2(s[4 * 33], s[5 * 33]); o.w = pk2(s[6 * 33], s[7 * 33]);
        *(u32x4*)(WT + (size_t)wt_row(n0 + n, row_mul, row_add) * K + k0 + 8 * c) = o; }
    LDS_WAIT(); asm volatile("" ::: "memory");
}
__device__ __forceinline__ void norm_mod_row(const float* xrow, const float* sh, const float* sc, bf16_t* orow, int lane) {
    f32x4 v[4]; float ss = 0.f;
#pragma unroll
    for (int j = 0; j < 4; ++j) { v[j] = *(const f32x4*)(xrow + 4 * lane + 256 * j); ss += (v[j].x * v[j].x + v[j].y * v[j].y) + (v[j].z * v[j].z + v[j].w * v[j].w); }
    const float r = rsqrtf(wave_sum(ss) * (1.0f / 1024.0f) + EPS);
#pragma unroll
    for (int j = 0; j < 4; ++j) { const f32x4 a = *(const f32x4*)(sc + 4 * lane + 256 * j), b = *(const f32x4*)(sh + 4 * lane + 256 * j);
        u32x2 w; w.x = pk2(v[j].x * r * (1.f + a.x) + b.x, v[j].y * r * (1.f + a.y) + b.y); w.y = pk2(v[j].z * r * (1.f + a.z) + b.z, v[j].w * r * (1.f + a.w) + b.w);
        *(u32x2*)(orow + 4 * lane + 256 * j) = w; }
}

__device__ __forceinline__ void attn_key(const bf16_t* kp, const bf16_t* vp, const float (&q)[64], float& m, float& l, float (&o)[64]) {
    float s = 0.f;
#pragma unroll
    for (int i = 0; i < 8; ++i) { float kv[8]; unpack8(*(const u32x4*)(kp + 8 * i), kv);
#pragma unroll
        for (int j = 0; j < 8; ++j) s += q[8 * i + j] * kv[j]; }
    const float mn = fmaxf(m, s);
    const float f = __builtin_amdgcn_exp2f(m - mn), p = __builtin_amdgcn_exp2f(s - mn);
    l = l * f + p; m = mn;
#pragma unroll
    for (int i = 0; i < 8; ++i) { float vv[8]; unpack8(*(const u32x4*)(vp + 8 * i), vv);
#pragma unroll
        for (int j = 0; j < 8; ++j) o[8 * i + j] = o[8 * i + j] * f + p * vv[j]; }
}
__device__ __forceinline__ void load_q64(const bf16_t* qp, float scale, float (&q)[64]) {
#pragma unroll
    for (int i = 0; i < 8; ++i) { float t[8]; unpack8(*(const u32x4*)(qp + 8 * i), t);
#pragma unroll
        for (int j = 0; j < 8; ++j) q[8 * i + j] = t[j] * scale; }
}

struct Args { const void* in[37]; float* out; unsigned char* ws; int ph_lo, ph_hi, probe_var, pad; };
#ifndef PROBE_GEMM_REPS
#define PROBE_GEMM_REPS 1
#endif
#if PROBE_GEMM_REPS == 2
template <class Sc> struct Twice { Sc S; int n1;
    __device__ __forceinline__ bool next(int i, pg8::Unit& u) const { return i < n1 ? S.next(i, u) : S.next(i - n1, u); }
    __device__ __forceinline__ void a_ready(const pg8::Unit&) const {}
    __device__ __forceinline__ void done(const pg8::Unit&) const {} };
#define PROBE_SCHED(T) Twice<T>
#define PROBE_WRAP(T, v) Twice<T> PS_; PS_.S = v; { int n1_ = 0; pg8::Unit tu_; while (v.next(n1_, tu_)) ++n1_; PS_.n1 = n1_; }
#else
#define PROBE_SCHED(T) T
#define PROBE_WRAP(T, v) const T& PS_ = v
#endif
#ifdef PROBE_BAR2
#define PROBE_EXTRA_BAR(b) xcd_barrier(b, lsg(wid0) == 0 && lane_id_v() == 0);
#else
#define PROBE_EXTRA_BAR(b)
#endif
constexpr int N_PHASES = 3 + 2 * (8 + 10);

template <int NV, bool MASKED, bool CAUSAL, int PIN, int POUT, bool NOMAX = false>
__device__ __forceinline__ void flash_unit(LAS unsigned char* L0, const bf16_t* Qb, const bf16_t* Kb, const bf16_t* Vb, bf16_t* Ob, const unsigned* mbase, int qb, int wid, int lane, const float* qgain, const float* COSH, const float* SINH) {
    const int r32 = lane & 31, hi = lane >> 5;
    LAS unsigned char* ldsKs = L0; LAS unsigned char* ldsVs = L0 + 16384;
    LAS float* wsf = (LAS float*)(L0 + 16384 + NV * 16384 + wid * 256);
    LAS bf16_t* stg = (LAS bf16_t*)(L0 + 16384 + NV * 16384 + 2048 + wid * 4096);
    const int qrow = qb * 256 + wid * 32 + r32;
    attn_body::bf16x8 qr[4];
    load_q_normed(qr, Qb + (size_t)qrow * PIN, qgain, COSH, SINH, qrow, hi, lane);
    const int NT = 4 * (qb + 1);
    const bf16_t* kbp = Kb + (size_t)lane * PIN + wid * 8;
    const bf16_t* vbp = Vb + (size_t)(16 * (wid & 3) + (lane >> 2)) * PIN + (wid >> 2) * 32 + (lane & 3) * 8;
    const unsigned* mwp = MASKED ? mbase + (size_t)qrow * 2 + hi : nullptr;
    u32x4 kreg = *(const u32x4*)kbp, vreg[NV]; unsigned mw = 0u, mwn = 0u;
#pragma unroll
    for (int j = 0; j < NV; ++j) vreg[j] = *(const u32x4*)(vbp + j * 64);
    if (MASKED) mw = mwp[0];
    *(LAS u32x4*)(ldsKs + wid * 1024 + lane * 16) = kreg;
#pragma unroll
    for (int j = 0; j < NV; ++j) *(LAS u32x4*)(ldsVs + j * 16384 + wid * 1024 + lane * 16) = vreg[j];
    __syncthreads();
    float mhat = 0.f, lsum = 0.f;
    attn_body::f32x16 o[2 * NV], negm;
#pragma unroll
    for (int r = 0; r < 16; ++r) { negm[r] = 0.f;
#pragma unroll
        for (int j = 0; j < 2 * NV; ++j) o[j][r] = 0.f; }
    const int vb0 = (int)(unsigned)(unsigned long long)ldsVs + ((lane >> 4) & 1) * 32 + (lane & 3) * 8 + (4 * hi + ((lane & 15) >> 2)) * 64;
    for (int t = 0; t < NT; ++t) {
        const int slot = (t & 1) * 8192;
        if (t + 1 < NT) { kreg = *(const u32x4*)(kbp + (size_t)(t + 1) * 64 * PIN);
#pragma unroll
            for (int j = 0; j < NV; ++j) vreg[j] = *(const u32x4*)(vbp + (size_t)(t + 1) * 64 * PIN + j * 64);
            if (MASKED) mwn = mwp[(size_t)(t + 1) * S * 2]; }
        attn_body::f32x16 p0 = negm, p1 = negm;
        { const LAS unsigned char* kb = ldsKs + slot + hi * 1024 + r32 * 16;
#pragma unroll
          for (int d0 = 0; d0 < 4; ++d0) {
              const attn_body::bf16x8 b0 = *(const LAS attn_body::bf16x8*)(kb + d0 * 2048), b1 = *(const LAS attn_body::bf16x8*)(kb + d0 * 2048 + 512);
              p0 = __builtin_amdgcn_mfma_f32_32x32x16_bf16(b0, qr[d0], p0, 0, 0, 0);
              p1 = __builtin_amdgcn_mfma_f32_32x32x16_bf16(b1, qr[d0], p1, 0, 0, 0); } }
        if (CAUSAL) { const int jb = t - (NT - 4); if (jb >= 0) attn_body::cmask(p0, p1, jb, wid * 32 + r32, hi); }
        float rm = 0.f;
        if (!NOMAX) { rm = fmaxf(p0[0], p1[0]);
#pragma unroll
            for (int r = 1; r < 16; ++r) rm = fmaxf(rm, fmaxf(p0[r], p1[r]));
            rm = half_max(rm); }
        bool resc = false;
        if (!NOMAX && __any(rm > 8.0f)) {
            const float dl = fmaxf(rm, 0.f); mhat += dl;
#pragma unroll
            for (int r = 0; r < 16; ++r) { p0[r] -= dl; p1[r] -= dl; negm[r] = -mhat; }
            const float f = __builtin_amdgcn_exp2f(-dl); lsum *= f; if (hi == 0) wsf[r32] = f; resc = true;
        }
        const int wb = (int)mw; float ssum = 0.f;
#pragma unroll
        for (int r = 0; r < 16; ++r) {
            float e0 = __builtin_amdgcn_exp2f(p0[r]), e1 = __builtin_amdgcn_exp2f(p1[r]);
            if (MASKED) { e0 = __uint_as_float(__float_as_uint(e0) & (unsigned)__builtin_amdgcn_sbfe(wb, r, 1)); e1 = __uint_as_float(__float_as_uint(e1) & (unsigned)__builtin_amdgcn_sbfe(wb, 16 + r, 1)); }
            p0[r] = e0; p1[r] = e1; ssum += e0 + e1; }
        lsum += ssum;
        u32x4 pw0, pw1, pw2, pw3;
#pragma unroll
        for (int k = 0; k < 4; ++k) { pw0[k] = attn_body::cvtpk_s(p0[2 * k], p0[2 * k + 1]); pw1[k] = attn_body::cvtpk_s(p0[8 + 2 * k], p0[9 + 2 * k]);
            pw2[k] = attn_body::cvtpk_s(p1[2 * k], p1[2 * k + 1]); pw3[k] = attn_body::cvtpk_s(p1[8 + 2 * k], p1[9 + 2 * k]); }
        if (resc) { LDS_WAIT();
#pragma unroll
            for (int r = 0; r < 16; ++r) { const float f = wsf[attn_body::crow(r, hi)];
#pragma unroll
                for (int j = 0; j < 2 * NV; ++j) o[j][r] *= f; } }
#pragma unroll
        for (int j = 0; j < NV; ++j)
            attn_body::pv(o + 2 * j, vb0 + j * 16384 + slot, __builtin_bit_cast(attn_body::bf16x8, pw0), __builtin_bit_cast(attn_body::bf16x8, pw1), __builtin_bit_cast(attn_body::bf16x8, pw2), __builtin_bit_cast(attn_body::bf16x8, pw3));
        if (t + 1 < NT) { const int ns = ((t + 1) & 1) * 8192; *(LAS u32x4*)(ldsKs + ns + wid * 1024 + lane * 16) = kreg;
#pragma unroll
            for (int j = 0; j < NV; ++j) *(LAS u32x4*)(ldsVs + j * 16384 + ns + wid * 1024 + lane * 16) = vreg[j]; }
        mw = mwn;
        __syncthreads();
    }
    lsum += shx_(lsum, 32, lane);
    if (hi == 0) wsf[r32] = lsum;
    LDS_WAIT();
    float rl[16];
#pragma unroll
    for (int r = 0; r < 16; ++r) rl[r] = __builtin_amdgcn_rcpf(wsf[attn_body::crow(r, hi)]);
#pragma unroll
    for (int j = 0; j < NV; ++j) {
#pragma unroll
        for (int r = 0; r < 16; ++r) { const int orow = attn_body::crow(r, hi);
            stg[orow * 64 + r32] = (bf16_t)f2bf(o[2 * j][r] * rl[r]); stg[orow * 64 + 32 + r32] = (bf16_t)f2bf(o[2 * j + 1][r] * rl[r]); }
        LDS_WAIT();
#pragma unroll
        for (int q = 0; q < 4; ++q) { const int row = q * 8 + (lane >> 3), ch = lane & 7;
            *(u32x4*)(Ob + (size_t)(qb * 256 + wid * 32 + row) * POUT + j * 64 + ch * 8) = *(const LAS u32x4*)(stg + row * 64 + ch * 8); }
        LDS_WAIT();
    }
    __syncthreads();
}
template <int NV, bool MASKED, bool CAUSAL, int PIN, int POUT, bool NOMAX = false>
__device__ __forceinline__ void flash_unit_q2(LAS unsigned char* L0, const bf16_t* Qb, const bf16_t* Kb, const bf16_t* Vb, bf16_t* Ob, const unsigned* mbase, int qb, int wid, int lane, const float* qgain, const float* COSH, const float* SINH) {
    typedef __attribute__((address_space(3))) attn_body::v4i16_t* vtr_ptr;
    const int r32 = lane & 31, hi = lane >> 5;
    LAS unsigned char* ldsKs = L0; LAS unsigned char* ldsVs = L0 + 16384;
    LAS float* wsf = (LAS float*)(L0 + 16384 + NV * 16384 + wid * 512);
    LAS bf16_t* stg = (LAS bf16_t*)(L0 + 16384 + NV * 16384 + 4096 + wid * 4096);
    const int q0 = qb * 512 + wid * 64;
    attn_body::bf16x8 qr[2][4];
#pragma unroll
    for (int nq = 0; nq < 2; ++nq) load_q_normed(qr[nq], Qb + (size_t)(q0 + nq * 32 + r32) * PIN, qgain, COSH, SINH, q0 + nq * 32 + r32, hi, lane);
    const int NT = 8 * (qb + 1);
    const bf16_t* kbp = Kb + (size_t)lane * PIN + wid * 8;
    const bf16_t* vbp = Vb + (size_t)(16 * (wid & 3) + (lane >> 2)) * PIN + (wid >> 2) * 32 + (lane & 3) * 8;
    const unsigned* mwp = MASKED ? mbase + (size_t)(q0 + r32) * 2 + hi : nullptr;
    const int stoff = wid * 1024 + lane * 16;
    u32x4 kreg = *(const u32x4*)kbp, vreg[NV]; unsigned mw[2] = {0u, 0u}, mwn[2] = {0u, 0u};
#pragma unroll
    for (int j = 0; j < NV; ++j) vreg[j] = *(const u32x4*)(vbp + j * 64);
    if (MASKED) { mw[0] = mwp[0]; mw[1] = mwp[64]; }
    *(LAS u32x4*)(ldsKs + stoff) = kreg;
#pragma unroll
    for (int j = 0; j < NV; ++j) *(LAS u32x4*)(ldsVs + j * 16384 + stoff) = vreg[j];
    __syncthreads();
    float mhat[2] = {0.f, 0.f}, lsum[2] = {0.f, 0.f}; bool refmoved = false;
    attn_body::f32x16 o[2][2 * NV];
#pragma unroll
    for (int r = 0; r < 16; ++r)
#pragma unroll
        for (int j = 0; j < 2 * NV; ++j) { o[0][j][r] = 0.f; o[1][j][r] = 0.f; }
    const LAS unsigned char* kfb = ldsKs + hi * 1024 + r32 * 16;
    const LAS unsigned char* vfb = ldsVs + ((lane >> 4) & 1) * 32 + (lane & 3) * 8 + (4 * hi + ((lane & 15) >> 2)) * 64;
    for (int t = 0; t < NT; ++t) {
        const int slot = (t & 1) * 8192;
        {
            const int tn = min(t + 1, NT - 1);
            if (MASKED) { mwn[0] = mwp[(size_t)tn * S * 2]; mwn[1] = mwp[(size_t)tn * S * 2 + 64]; }
            kreg = *(const u32x4*)(kbp + (size_t)tn * 64 * PIN);
#pragma unroll
            for (int j = 0; j < NV; ++j) vreg[j] = *(const u32x4*)(vbp + (size_t)tn * 64 * PIN + j * 64); }
#pragma unroll
        for (int kh = 0; kh < 2; ++kh) {
            attn_body::f32x16 p[2];
#pragma unroll
            for (int r = 0; r < 16; ++r) { p[0][r] = 0.f; p[1][r] = 0.f; }
#pragma unroll
            for (int d0 = 0; d0 < 4; ++d0) {
                const attn_body::bf16x8 kf = *(const LAS attn_body::bf16x8*)(kfb + slot + d0 * 2048 + kh * 512);
                p[0] = __builtin_amdgcn_mfma_f32_32x32x16_bf16(kf, qr[0][d0], p[0], 0, 0, 0);
                p[1] = __builtin_amdgcn_mfma_f32_32x32x16_bf16(kf, qr[1][d0], p[1], 0, 0, 0); }
            if (refmoved) {
#pragma unroll
                for (int nq = 0; nq < 2; ++nq)
#pragma unroll
                    for (int r = 0; r < 16; ++r) p[nq][r] -= mhat[nq]; }
            if (CAUSAL) { const int kbase = t * 64 + kh * 32;
                if (kbase + 31 > q0) {
#pragma unroll
                    for (int nq = 0; nq < 2; ++nq)
#pragma unroll
                        for (int r = 0; r < 16; ++r) if (kbase + attn_body::crow(r, hi) > q0 + nq * 32 + r32) p[nq][r] = -INFINITY; } }
            float rm[2] = {0.f, 0.f};
            if (!NOMAX)
#pragma unroll
            for (int nq = 0; nq < 2; ++nq) { float m_ = p[nq][0];
#pragma unroll
                for (int r = 1; r < 16; ++r) m_ = fmaxf(m_, p[nq][r]);
                rm[nq] = half_max(m_); }
            bool resc = false;
            if (!NOMAX && __any(fmaxf(rm[0], rm[1]) > 8.0f)) {
#pragma unroll
                for (int nq = 0; nq < 2; ++nq) { const float dl = fmaxf(rm[nq], 0.f); mhat[nq] += dl;
#pragma unroll
                    for (int r = 0; r < 16; ++r) p[nq][r] -= dl;
                    const float f = __builtin_amdgcn_exp2f(-dl); lsum[nq] *= f; if (hi == 0) wsf[nq * 32 + r32] = f; }
                resc = true; refmoved = true;
            }
            attn_body::bf16x8 pa[2][2];
#pragma unroll
            for (int nq = 0; nq < 2; ++nq) { const int wb = (int)mw[nq]; f32x2 ss2 = {0.f, 0.f};
#pragma unroll
                for (int r = 0; r < 16; ++r) { float e = __builtin_amdgcn_exp2f(p[nq][r]);
                    if (MASKED) { unsigned mk; asm("v_bfe_i32 %0, %1, %2, 1" : "=v"(mk) : "v"(wb), "n"(kh * 16 + r)); e = __uint_as_float(__float_as_uint(e) & mk); }
                    p[nq][r] = e; }
#pragma unroll
                for (int r = 0; r < 16; r += 2) ss2 += (f32x2){p[nq][r], p[nq][r + 1]};
                lsum[nq] += ss2.x + ss2.y;
                u32x4 pw0, pw1;
#pragma unroll
                for (int k = 0; k < 4; ++k) { pw0[k] = attn_body::cvtpk_s(p[nq][2 * k], p[nq][2 * k + 1]); pw1[k] = attn_body::cvtpk_s(p[nq][8 + 2 * k], p[nq][9 + 2 * k]); }
                pa[nq][0] = __builtin_bit_cast(attn_body::bf16x8, pw0); pa[nq][1] = __builtin_bit_cast(attn_body::bf16x8, pw1); }
            if (resc) { LDS_WAIT();
#pragma unroll
                for (int nq = 0; nq < 2; ++nq)
#pragma unroll
                    for (int r = 0; r < 16; ++r) { const float f = wsf[nq * 32 + attn_body::crow(r, hi)];
#pragma unroll
                        for (int j = 0; j < 2 * NV; ++j) o[nq][j][r] *= f; } }
#pragma unroll
            for (int blk = 0; blk < 2 * NV; ++blk)
#pragma unroll
                for (int k2 = 0; k2 < 2; ++k2) {
                    const LAS unsigned char* vb = vfb + (blk >> 1) * 16384 + slot + (blk & 1) * 4096 + (kh * 2 + k2) * 1024;
                    const attn_body::s16x4 lo_ = __builtin_bit_cast(attn_body::s16x4, __builtin_amdgcn_ds_read_tr16_b64_v4i16((vtr_ptr)vb)), hi_ = __builtin_bit_cast(attn_body::s16x4, __builtin_amdgcn_ds_read_tr16_b64_v4i16((vtr_ptr)(vb + 512)));
                    const attn_body::bf16x8 vf = (attn_body::bf16x8){lo_[0], lo_[1], lo_[2], lo_[3], hi_[0], hi_[1], hi_[2], hi_[3]};
                    o[0][blk] = __builtin_amdgcn_mfma_f32_32x32x16_bf16(pa[0][k2], vf, o[0][blk], 0, 0, 0);
                    o[1][blk] = __builtin_amdgcn_mfma_f32_32x32x16_bf16(pa[1][k2], vf, o[1][blk], 0, 0, 0); }
        }
        if (t + 1 < NT) { const int ns = 8192 - slot; *(LAS u32x4*)(ldsKs + ns + stoff) = kreg;
#pragma unroll
            for (int j = 0; j < NV; ++j) *(LAS u32x4*)(ldsVs + j * 16384 + ns + stoff) = vreg[j]; }
        mw[0] = mwn[0]; mw[1] = mwn[1];
        __syncthreads();
    }
#pragma unroll
    for (int nq = 0; nq < 2; ++nq) { lsum[nq] += shx_(lsum[nq], 32, lane); if (hi == 0) wsf[nq * 32 + r32] = lsum[nq]; }
    LDS_WAIT();
#pragma unroll
    for (int nq = 0; nq < 2; ++nq)
#pragma unroll
      for (int j = 0; j < NV; ++j) {
#pragma unroll
        for (int r = 0; r < 16; ++r) { const int orow = attn_body::crow(r, hi); const float rl = __builtin_amdgcn_rcpf(wsf[nq * 32 + orow]);
            stg[orow * 64 + r32] = (bf16_t)f2bf(o[nq][2 * j][r] * rl); stg[orow * 64 + 32 + r32] = (bf16_t)f2bf(o[nq][2 * j + 1][r] * rl); }
        LDS_WAIT();
#pragma unroll
        for (int q = 0; q < 4; ++q) { const int row = q * 8 + (lane >> 3), ch = lane & 7;
            *(u32x4*)(Ob + (size_t)(q0 + nq * 32 + row) * POUT + j * 64 + ch * 8) = *(const LAS u32x4*)(stg + row * 64 + ch * 8); }
        LDS_WAIT();
      }
    __syncthreads();
}
struct MoeRows {
    static constexpr bool GATHER = true;
    const LAS int* rb; const int* LTOK;
    __device__ __forceinline__ unsigned operator()(const pg8::Unit& u, int r) const { const int e = u.be; const int slot = u.pm * 256 + r - rb[e];
        const int tok = slot < rb[32 + e] ? LTOK[e * 32768 + slot] : 0; return (unsigned)tok * 2048u; }
};
__device__ __forceinline__ void moe_convert(const float* w1, const float* w3, const float* w2, bf16_t* W13, bf16_t* W2, LAS float* scr, int gw, int NGW, int lane) {
    for (int it = gw; it < 32 * 768; it += NGW) {
        const int e = it / 768; int r = it % 768;
        if (r < 256) { transpose_item(w1 + (size_t)e * 1024 * 512, 1024, 512, W13 + (size_t)e * 1024 * 1024, 2, 0, scr, r, 16, lane); continue; } r -= 256;
        if (r < 256) { transpose_item(w3 + (size_t)e * 1024 * 512, 1024, 512, W13 + (size_t)e * 1024 * 1024, 2, 1, scr, r, 16, lane); continue; } r -= 256;
        transpose_item(w2 + (size_t)e * 512 * 1024, 512, 1024, W2 + (size_t)e * 1024 * 512, 1, 0, scr, r, 32, lane);
    }
}
__device__ __forceinline__ void moe_tables(unsigned* ctl, int l, LAS int* tile_e, LAS int* rb, LAS int* nt_p, int tid) {
    if (tid < 64) {
        const int ln = tid;
        const int cnt = ln < 32 ? (int)__hip_atomic_load(ctl + CW_CNT + (l * 32 + (ln & 31)) * 64, __ATOMIC_RELAXED, __HIP_MEMORY_SCOPE_AGENT) : 0;
        const int ntile = (cnt + 255) >> 8;
        int inc = ntile;
#pragma unroll
        for (int off = 1; off < 32; off <<= 1) { const int v = (int)shi_((unsigned)inc, ln - off); if (ln >= off) inc += v; }
        if (ln < 32) { rb[ln] = (inc - ntile) * 256; rb[32 + ln] = cnt; }
        if (ln == 31) nt_p[0] = inc;
    }
    __syncthreads();
    const int nt = nt_p[0];
    for (int t = tid; t < nt; t += NTHREADS) {
        int lo = 0, hi = 31;
        while (lo < hi) { const int mid = (lo + hi + 1) >> 1; if (rb[mid] <= t * 256) lo = mid; else hi = mid - 1; }
        tile_e[t] = lo;
    }
    __syncthreads();
}

template <bool FIRST>
__device__ __forceinline__ float f_pass1(const float* __restrict__ xs_row, bf16_t* __restrict__ xb_row, const bf16_t* __restrict__ y_row, const LAS float* gate, const int kc) {
    float ss = 0.f;
#pragma unroll 1
    for (int s0 = 0; s0 < 32; s0 += 8) {
        u32x4 xr[8], yr[8]; f32x4 xa[8], xc[8];
#pragma unroll
        for (int k = 0; k < 8; ++k) { const int col = 32 * (s0 + k) + 8 * kc;
            if constexpr (FIRST) { xa[k] = *(const f32x4*)(xs_row + col); xc[k] = *(const f32x4*)(xs_row + col + 4); } else xr[k] = *(const u32x4*)(xb_row + col);
            yr[k] = *(const u32x4*)(y_row + col); }
        __builtin_amdgcn_sched_barrier(0);
#pragma unroll
        for (int k = 0; k < 8; ++k) { const int col = 32 * (s0 + k) + 8 * kc;
            f32x4 x0, x1;
            if constexpr (FIRST) { x0 = xa[k]; x1 = xc[k]; }
            else { float xv_[8]; unpack8(xr[k], xv_); x0 = (f32x4){xv_[0], xv_[1], xv_[2], xv_[3]}; x1 = (f32x4){xv_[4], xv_[5], xv_[6], xv_[7]}; }
            float yv[8]; unpack8(yr[k], yv);
            const f32x4 g0 = *(const LAS f32x4*)(gate + col), g1 = *(const LAS f32x4*)(gate + col + 4);
            float nv_[8] = {x0.x + g0.x * yv[0], x0.y + g0.y * yv[1], x0.z + g0.z * yv[2], x0.w + g0.w * yv[3], x1.x + g1.x * yv[4], x1.y + g1.y * yv[5], x1.z + g1.z * yv[6], x1.w + g1.w * yv[7]};
            const u32x4 xw = pack8(nv_); *(u32x4*)(xb_row + col) = xw;
            float rv_[8]; unpack8(xw, rv_);
#pragma unroll
            for (int e = 0; e < 8; ++e) ss += rv_[e] * rv_[e]; }
        __builtin_amdgcn_sched_barrier(0);
    }
    return ss;
}
__device__ __forceinline__ void f_pass2(const bf16_t* __restrict__ xb_row, bf16_t* __restrict__ h_row, const LAS float* modl, const bf16_t* __restrict__ wh, const bf16_t* __restrict__ wl, const float rn, const int kc, f32x4 (&acc)[3]) {
#pragma unroll 1
    for (int s0 = 0; s0 < 32; s0 += 4) {
        u32x4 xr[4]; pg8::bf16x8 bh[4][3], bl[4][3];
#pragma unroll
        for (int k = 0; k < 4; ++k) { const int col = 32 * (s0 + k) + 8 * kc; xr[k] = *(const u32x4*)(xb_row + col);
#pragma unroll
            for (int ct = 0; ct < 3; ++ct) { bh[k][ct] = *(const pg8::bf16x8*)(wh + (size_t)ct * 16 * 1024 + 32 * (s0 + k)); bl[k][ct] = *(const pg8::bf16x8*)(wl + (size_t)ct * 16 * 1024 + 32 * (s0 + k)); } }
        __builtin_amdgcn_sched_barrier(0);
#pragma unroll
        for (int k = 0; k < 4; ++k) { const int col = 32 * (s0 + k) + 8 * kc;
            f32x4 x0, x1; { float xv_[8]; unpack8(xr[k], xv_); x0 = (f32x4){xv_[0], xv_[1], xv_[2], xv_[3]}; x1 = (f32x4){xv_[4], xv_[5], xv_[6], xv_[7]}; }
            const f32x4 c0 = *(const LAS f32x4*)(modl + 2048 + col), c1 = *(const LAS f32x4*)(modl + 2048 + col + 4), s0_ = *(const LAS f32x4*)(modl + 1024 + col), s1_ = *(const LAS f32x4*)(modl + 1024 + col + 4);
            float hv[8];
            hv[0] = x0.x * rn * (1.f + c0.x) + s0_.x; hv[1] = x0.y * rn * (1.f + c0.y) + s0_.y; hv[2] = x0.z * rn * (1.f + c0.z) + s0_.z; hv[3] = x0.w * rn * (1.f + c0.w) + s0_.w;
            hv[4] = x1.x * rn * (1.f + c1.x) + s1_.x; hv[5] = x1.y * rn * (1.f + c1.y) + s1_.y; hv[6] = x1.z * rn * (1.f + c1.z) + s1_.z; hv[7] = x1.w * rn * (1.f + c1.w) + s1_.w;
            const u32x4 hh = pack8(hv);
            *(u32x4*)(h_row + col) = hh;
            float hl[8]; { float hf[8]; unpack8(hh, hf);
#pragma unroll
                for (int e = 0; e < 8; ++e) hl[e] = hv[e] - hf[e]; }
            const u32x4 hlw = pack8(hl);
            const pg8::bf16x8 ah = __builtin_bit_cast(pg8::bf16x8, hh), al = __builtin_bit_cast(pg8::bf16x8, hlw);
#pragma unroll
            for (int ct = 0; ct < 3; ++ct) {
                acc[ct] = __builtin_amdgcn_mfma_f32_16x16x32_bf16(ah, bh[k][ct], acc[ct], 0, 0, 0);
                acc[ct] = __builtin_amdgcn_mfma_f32_16x16x32_bf16(ah, bl[k][ct], acc[ct], 0, 0, 0);
                acc[ct] = __builtin_amdgcn_mfma_f32_16x16x32_bf16(al, bh[k][ct], acc[ct], 0, 0, 0);
            } }
        __builtin_amdgcn_sched_barrier(0);
    }
}

__device__ __forceinline__ float relu_i(float x) { return __builtin_bit_cast(float, max(__builtin_bit_cast(int, x), 0)); }
__device__ __forceinline__ unsigned pk_gt_u16(unsigned a, unsigned b, unsigned ones) { unsigned d; asm("v_pk_sub_u16 %0, %1, %2 clamp" : "=v"(d) : "v"(a), "v"(b)); unsigned r; asm("v_pk_min_u16 %0, %1, %2" : "=v"(r) : "v"(d), "v"(ones)); return r; }
__device__ __forceinline__ unsigned spread16(unsigned x) { x = (x | (x << 8)) & 0x00FF00FFu; x = (x | (x << 4)) & 0x0F0F0F0Fu; x = (x | (x << 2)) & 0x33333333u; x = (x | (x << 1)) & 0x55555555u; return x; }
__device__ __forceinline__ unsigned ilv16(unsigned a) { return spread16(a & 0xFFFFu) | (spread16(a >> 16) << 1); }
__device__ __forceinline__ int lane_id_v() { int v; asm volatile("v_mbcnt_lo_u32_b32 %0, -1, 0\n\tv_mbcnt_hi_u32_b32 %0, -1, %0" : "=v"(v)); return v; }
__device__ __forceinline__ unsigned long long lsg64(unsigned long long v) { asm volatile("" : "+s"(v)); return v; }
__device__ __forceinline__ int lsg(int v) { asm volatile("" : "+s"(v)); return v; }
__device__ __forceinline__ int lvg(int v) { asm volatile("" : "+v"(v)); return v; }
__device__ __forceinline__ LAS unsigned char* lsgp(LAS unsigned char* p) { unsigned v = (unsigned)(unsigned long long)p; asm volatile("" : "+s"(v)); return (LAS unsigned char*)(unsigned long long)v; }
__device__ __forceinline__ void* ldptr(const LAS unsigned long long* tbl, int k) {
    const unsigned long long v = tbl[k];
    const unsigned lo = __builtin_amdgcn_readfirstlane((unsigned)v), hi = __builtin_amdgcn_readfirstlane((unsigned)(v >> 32));
    return (void*)(__attribute__((address_space(1))) void*)(((unsigned long long)hi << 32) | lo);
}
#define DECL_PTRS() \
    const int wid = lsg(wid0), lane = lane_id_v(), tid = wid * 64 + lane; \
    const int G = lsg(G0), c = lsg(c0), l = lsg(l0), i = l >> 1; \
    const int gw = c * NWAVES + wid, NGW = G * NWAVES, gt = c * NTHREADS + tid, NGT = G * NTHREADS; \
    LAS unsigned char* lds = (LAS unsigned char*)lsgp(lds0); LAS unsigned char* glds = lds; LAS float* scr = (LAS float*)(lds + wid * 16384); \
    const LAS unsigned long long* ptbl = (const LAS unsigned long long*)(lds + LDS_PTBL); \
    unsigned char* ws = (unsigned char*)ldptr(ptbl, 38); unsigned* ctl = (unsigned*)(ws + WS_CTL); \
    const float* xin = (const float*)ldptr(ptbl, 0); \
    const float* cin = (const float*)ldptr(ptbl, 1); \
    const float* ada_w = (const float*)ldptr(ptbl, 2); \
    const float* ada_b = (const float*)ldptr(ptbl, 3); \
    const float* moe_wg = (const float*)ldptr(ptbl, 4); \
    const float* moe_bg = (const float*)ldptr(ptbl, 5); \
    const float* moe_we = (const float*)ldptr(ptbl, 6); \
    const float* moe_be = (const float*)ldptr(ptbl, 7); \
    const float* moe_w1 = (const float*)ldptr(ptbl, 8); \
    const float* moe_w3 = (const float*)ldptr(ptbl, 9); \
    const float* moe_w2 = (const float*)ldptr(ptbl, 10); \
    const float* ev_w_in = (const float*)ldptr(ptbl, 11); \
    const float* ev_w_out = (const float*)ldptr(ptbl, 12); \
    const float* a_qn = (const float*)ldptr(ptbl, 13); \
    const float* a_kn = (const float*)ldptr(ptbl, 14); \
    const float* a_lq1 = (const float*)ldptr(ptbl, 15); \
    const float* a_lk1 = (const float*)ldptr(ptbl, 16); \
    const float* a_lq2 = (const float*)ldptr(ptbl, 17); \
    const float* a_lk2 = (const float*)ldptr(ptbl, 18); \
    const float* a_subln = (const float*)ldptr(ptbl, 19); \
    const float* b_qn = (const float*)ldptr(ptbl, 20); \
    const float* b_kn = (const float*)ldptr(ptbl, 21); \
    const float* b_idx_kn = (const float*)ldptr(ptbl, 22); \
    const float* od_w_in = (const float*)ldptr(ptbl, 23); \
    const float* od_w_out = (const float*)ldptr(ptbl, 24); \
    const float* c_qn = (const float*)ldptr(ptbl, 25); \
    const float* c_kn = (const float*)ldptr(ptbl, 26); \
    const float* s5_lam_re = (const float*)ldptr(ptbl, 27); \
    const float* s5_lam_im = (const float*)ldptr(ptbl, 28); \
    const float* s5_b_re = (const float*)ldptr(ptbl, 29); \
    const float* s5_b_im = (const float*)ldptr(ptbl, 30); \
    const float* s5_c_re = (const float*)ldptr(ptbl, 31); \
    const float* s5_c_im = (const float*)ldptr(ptbl, 32); \
    const float* s5_d = (const float*)ldptr(ptbl, 33); \
    const float* s5_log_dt = (const float*)ldptr(ptbl, 34); \
    const float* s5_glu_w = (const float*)ldptr(ptbl, 35); \
    const float* s5_glu_b = (const float*)ldptr(ptbl, 36); \
    float* out = (float*)ldptr(ptbl, 37); \
    float* MOD = (float*)(ws + WS_MOD); \
    float* MODP = (float*)(ws + WS_MODP); \
    float* COSH = (float*)(ws + WS_ROPE); \
    float* SINH = COSH + S * 8; \
    float* COSI = SINH + S * 8; \
    float* SINI = COSI + S * 4; \
    float* S5A = (float*)(ws + WS_S5A); \
    float* S5B = (float*)(ws + WS_S5B); \
    float* LAM = (float*)(ws + WS_LAM); \
    float* KM = (float*)(ws + WS_KM); \
    bf16_t* KMH = (bf16_t*)(ws + WS_KMH); \
    bf16_t* WRH = (bf16_t*)(ws + WS_WRH); \
    bf16_t* WRL = (bf16_t*)(ws + WS_WRH + 393216); \
    bf16_t* KML = (bf16_t*)(ws + WS_KMH + 131072); \
    bf16_t* Wevin = (bf16_t*)(ws + WS_WEVIN); \
    bf16_t* Wevout = (bf16_t*)(ws + WS_WEVOUT); \
    bf16_t* Wodin = (bf16_t*)(ws + WS_WODIN); \
    bf16_t* Wodout = (bf16_t*)(ws + WS_WODOUT); \
    bf16_t* Wglu = (bf16_t*)(ws + WS_WGLU); \
    bf16_t* W13 = (bf16_t*)(ws + WS_W13); \
    bf16_t* W2 = (bf16_t*)(ws + WS_W2); \
    bf16_t* H = (bf16_t*)(ws + WS_H); \
    bf16_t* O = (bf16_t*)(ws + WS_O); \
    bf16_t* Z = (bf16_t*)(ws + WS_Z); \
    bf16_t* XG = (bf16_t*)(ws + WS_XG); \
    bf16_t* Y = (bf16_t*)(ws + WS_Y); \
    bf16_t* HID = (bf16_t*)(ws + WS_HID); \
    float* IQ = (float*)(ws + WS_IQ); \
    bf16_t* YG = (bf16_t*)(ws + WS_YG); \
    float* IKW = (float*)(ws + WS_IKW); \
    _Float16* IQH = (_Float16*)(ws + WS_IQH); \
    _Float16* IKH = (_Float16*)(ws + WS_IKH); \
    float* IW = (float*)(ws + WS_IW); \
    int* SEL = (int*)(ws + WS_SEL); \
    bf16_t* YMIX = (bf16_t*)(ws + WS_YMIX); \
    int* TOKES = (int*)(ws + WS_TOKES); \
    int* LTOK = (int*)(ws + WS_LTOK); \
    float* TOKW = (float*)(ws + WS_TOKW); \
    int* TOKROW = (int*)(ws + WS_TOKROW); \
    bf16_t* UG = (bf16_t*)(ws + WS_UG); \
    float* S5E = (float*)(ws + WS_S5E); \
    bf16_t* S5HC = (bf16_t*)(ws + WS_S5HC); \
    bf16_t* S5KT = (bf16_t*)(ws + WS_S5KT); \
    bf16_t* S5WT = (bf16_t*)(ws + WS_S5WT); \
    bf16_t* S5A2 = (bf16_t*)(ws + WS_S5A2); \
    float* S5PW = (float*)(ws + WS_S5PW); \
    int* MLIST = (int*)(ws + WS_MLIST); \
    bf16_t* MPO = (bf16_t*)(ws + WS_MPO); \
    float* MML = (float*)(ws + WS_MML); \
    int* NSEL = (int*)(ws + WS_NSEL); \
    unsigned* MASKW = (unsigned*)(ws + WS_MASKW); \
    bf16_t* XB = (bf16_t*)(ws + WS_XB);
__global__ void __launch_bounds__(NTHREADS, 2) fwd(Args a) {
    extern __shared__ __attribute__((aligned(16))) unsigned char lds_raw[];
    LAS unsigned char* lds = (LAS unsigned char*)lds_raw;
    const int tid0 = threadIdx.x; const int wid0 = __builtin_amdgcn_readfirstlane(tid0 >> 6);
    const int G0 = gridDim.x, c0 = blockIdx.x;
    unsigned* ctl0 = (unsigned*)(a.ws + WS_CTL);
    LAS unsigned char* lds0 = lds;
    const int lo = a.ph_lo, hi = a.ph_hi;

    LAS unsigned long long* ptbl = (LAS unsigned long long*)(lds + LDS_PTBL);
    if (tid0 == 0) {
#define PT_(k) ptbl[k] = (unsigned long long)a.in[k];
        PT_(0) PT_(1) PT_(2) PT_(3) PT_(4) PT_(5) PT_(6) PT_(7) PT_(8) PT_(9) PT_(10) PT_(11) PT_(12) PT_(13) PT_(14) PT_(15) PT_(16) PT_(17) PT_(18)
        PT_(19) PT_(20) PT_(21) PT_(22) PT_(23) PT_(24) PT_(25) PT_(26) PT_(27) PT_(28) PT_(29) PT_(30) PT_(31) PT_(32) PT_(33) PT_(34) PT_(35) PT_(36)
#undef PT_
        ptbl[37] = (unsigned long long)a.out; ptbl[38] = (unsigned long long)a.ws;
    }
    if (tid0 < 4) ((LAS unsigned*)(lds + LDS_BARW))[tid0] = 0u;
    __syncthreads();
    XcdBarrier bar; bar.bar = ctl0 + CW_BAR; bar.x = 0; bar.st = (volatile LAS unsigned*)(lds + LDS_BARW);
    if (hi - lo > 1) bar = xcd_barrier_post(ctl0 + CW_BAR, (volatile LAS unsigned*)(lds + LDS_BARW), tid0 == 0);
    int ph = 0, l0 = 0;
#define PH_ON() (ph >= lo && ph < hi)
#define PH_END() do { if (ph >= lo && ph + 1 < hi) { XcdBarrier bb_; bb_.bar = (unsigned*)lsg64((unsigned long long)bar.bar); bb_.x = bar.x; bb_.st = bar.st; xcd_barrier(bb_, lsg(wid0) == 0 && lane_id_v() == 0); PROBE_EXTRA_BAR(bb_) } ++ph; } while (0)

    if (PH_ON()) { DECL_PTRS();
        {
            constexpr int I_EVIN = 16 * 112, I_SQ = 16 * 32, I_ODIN = 16 * 64, I_GLU = 8 * 16;
            constexpr int I_PER = I_EVIN + I_SQ + I_ODIN + I_SQ + I_GLU;
            for (int it = gw; it < 2 * I_PER; it += NGW) {
                const int i = it / I_PER; int r = it % I_PER;
                if (r < I_EVIN) { transpose_item(ev_w_in + (size_t)i * 1024 * EV_N, 1024, EV_N, Wevin + (size_t)i * EV_NP * 1024, -1, 0, scr, r, 112, lane); continue; } r -= I_EVIN;
                if (r < I_SQ) { transpose_item(ev_w_out + (size_t)i * 1024 * 1024, 1024, 1024, Wevout + (size_t)i * 1024 * 1024, 1, 0, scr, r, 32, lane); continue; } r -= I_SQ;
                if (r < I_ODIN) { transpose_item(od_w_in + (size_t)i * 1024 * 2048, 1024, 2048, Wodin + (size_t)i * 2048 * 1024, -2, 0, scr, r, 64, lane); continue; } r -= I_ODIN;
                if (r < I_SQ) { transpose_item(od_w_out + (size_t)i * 1024 * 1024, 1024, 1024, Wodout + (size_t)i * 1024 * 1024, 1, 0, scr, r, 32, lane); continue; } r -= I_SQ;
                transpose_item(s5_glu_w + (size_t)i * 512 * 512, 512, 512, Wglu + (size_t)i * 512 * 512, 1, 0, scr, r, 16, lane);
            }
        }
        __syncthreads();
        {
            LAS float* cact = (LAS float*)lds;
            for (int i = tid; i < 2048; i += NTHREADS) { const float v = cin[i]; cact[i] = v / (1.0f + __expf(-v)); }
            __syncthreads();
            for (int idx = gt; idx < 4 * 4 * 6144; idx += NGT) {
                const int kq = idx / 24576, rem = idx % 24576, l = rem / 6144, n = rem % 6144;
                const float* w = ada_w + ((size_t)l * 1024 + kq * 256) * 6144 + n;
                float a0 = 0.f, a1 = 0.f;
#pragma unroll 32
                for (int k = 0; k < 256; ++k) { const float wv = w[(size_t)k * 6144]; a0 += cact[kq * 256 + k] * wv; a1 += cact[1024 + kq * 256 + k] * wv; }
                MODP[((size_t)(kq * 4 + l) * 2 + 0) * 6144 + n] = a0;
                MODP[((size_t)(kq * 4 + l) * 2 + 1) * 6144 + n] = a1;
            }
            __syncthreads();
        }
        for (int idx = gt; idx < S * 12; idx += NGT) {
            if (idx < S * 8) { const int pos = idx >> 3, j = idx & 7; const float inv = (float)pow(500000.0, -(double)(2 * j) / 16.0); const float ang = (float)pos * inv;
                COSH[idx] = (float)cos((double)ang); SINH[idx] = (float)sin((double)ang); }
            else { const int k = idx - S * 8; const int pos = k >> 2, j = k & 3; const float inv = (float)pow(500000.0, -(double)(2 * j) / 8.0); const float ang = (float)pos * inv;
                COSI[k] = (float)cos((double)ang); SINI[k] = (float)sin((double)ang); }
        }
        for (int idx = gt; idx < 2 * 32 * 64; idx += NGT) {
            const int i = idx >> 11, g = (idx >> 6) & 31;
            const float dt = expf(s5_log_dt[i * 32 + g]);
            const float lr = s5_lam_re[idx], li = s5_lam_im[idx];
            const float mag = expf(lr * dt);
            const float ar = mag * (float)cos((double)(li * dt)), ai = mag * (float)sin((double)(li * dt));
            const float den = lr * lr + li * li;
            const float cr = ((ar - 1.0f) * lr + ai * li) / den, ci = (ai * lr - (ar - 1.0f) * li) / den;
            S5A[idx * 2] = ar; S5A[idx * 2 + 1] = ai;
            { float pr = 1.f, pi_ = 0.f; for (int n = 0; n <= 64; ++n) { S5PW[((size_t)idx * 65 + n) * 2] = pr; S5PW[((size_t)idx * 65 + n) * 2 + 1] = pi_; const float nr = pr * ar - pi_ * ai, ni = pr * ai + pi_ * ar; pr = nr; pi_ = ni; } }
            { float brv[16], biv[16];
#pragma unroll
              for (int cc = 0; cc < 16; ++cc) { brv[cc] = s5_b_re[(size_t)idx * 16 + cc]; biv[cc] = s5_b_im[(size_t)idx * 16 + cc]; }
              __builtin_amdgcn_sched_barrier(0);
#pragma unroll
              for (int cc = 0; cc < 16; ++cc) { const float br = brv[cc], bi = biv[cc];
                  *(f32x2*)(S5B + ((size_t)idx * 16 + cc) * 2) = (f32x2){cr * br - ci * bi, cr * bi + ci * br}; } }
        }
        for (int idx = gt; idx < DEPTH * 48 * 1024; idx += NGT) {
            const int k = idx & 1023, col = (idx >> 10) % 48, ll = idx / (48 * 1024);
            const float w = col < 4 ? moe_wg[((size_t)ll * 1024 + k) * 4 + col] : col < 36 ? moe_we[((size_t)ll * 1024 + k) * 32 + col - 4] : 0.f;
            const unsigned hb = f2bf(w); WRH[idx] = (bf16_t)hb; WRL[idx] = (bf16_t)f2bf(w - __uint_as_float(hb << 16));
        }
        if (gw < 2) { const int i = gw;
            const float s1 = wave_sum(a_lq1[i * 64 + lane] * a_lk1[i * 64 + lane]), s2 = wave_sum(a_lq2[i * 64 + lane] * a_lk2[i * 64 + lane]);
            const float lam_init = 0.8f - 0.6f * expf(-0.3f * (float)(2 * i));
            if (lane == 0) LAM[i] = expf(s1) - expf(s2) + lam_init; }
    }
    PH_END();
    if (PH_ON()) { DECL_PTRS();
        for (int idx = gt; idx < 4 * 2 * 6144; idx += NGT) {
            const int l = idx / 12288, b = (idx / 6144) & 1, n = idx % 6144;
            float v = ada_b[l * 6144 + n];
#pragma unroll
            for (int kq = 0; kq < 4; ++kq) v += MODP[((size_t)(kq * 4 + l) * 2 + b) * 6144 + n];
            MOD[idx] = v;
        }
        for (int idx = gt; idx < 2 * 32 * 65 * 256; idx += NGT) {
            const int ci = idx & 15, co = (idx >> 4) & 15, tr = (idx >> 8) % 65, ig = idx / (65 * 256);
            float acc = 0.f;
            if (tr > 0) {
                const int tau = tr - 1;
#pragma unroll 16
                for (int p = 0; p < 64; ++p) { const int sp = ig * 64 + p;
                    const float cr = s5_c_re[((size_t)ig * 16 + co) * 64 + p], cim_ = s5_c_im[((size_t)ig * 16 + co) * 64 + p];
                    const f32x2 pw_ = *(const f32x2*)(S5PW + ((size_t)sp * 65 + tau) * 2), bb_ = *(const f32x2*)(S5B + ((size_t)sp * 16 + ci) * 2);
                    const float pr = pw_.x, pi_ = pw_.y, br = bb_.x, bi = bb_.y;
                    const float xr = cr * pr - cim_ * pi_, xi = cr * pi_ + cim_ * pr;
                    acc += xr * br - xi * bi; }
            }
            S5KT[((size_t)ig * 65 + tr) * 384 + co * 24 + ci] = (bf16_t)f2bf(acc);
        }
        constexpr int NW_ = 2 * 32 * 128 * 1024;
        for (int idx0 = gt; idx0 < NW_; idx0 += NGT * 8) {
            f32x2 pw_[8], bb_[8];
#pragma unroll
            for (int u = 0; u < 8; ++u) { const int idx = min(idx0 + u * NGT, NW_ - 1);
                const int k = idx & 1023, row = (idx >> 10) & 127, ig = idx >> 17; const int s = k >> 4, ci = k & 15, p = row >> 1; const int sp = ig * 64 + p;
                pw_[u] = *(const f32x2*)(S5PW + ((size_t)sp * 65 + (63 - s)) * 2); bb_[u] = *(const f32x2*)(S5B + ((size_t)sp * 16 + ci) * 2); }
            __builtin_amdgcn_sched_barrier(0);
#pragma unroll
            for (int u = 0; u < 8; ++u) { const int idx = idx0 + u * NGT;
                if (idx < NW_) { const int ri = (idx >> 10) & 1; const float pr = pw_[u].x, pi_ = pw_[u].y, br = bb_[u].x, bi = bb_[u].y;
                    S5WT[idx] = (bf16_t)f2bf(ri ? (pr * bi + pi_ * br) : (pr * br - pi_ * bi)); } }
            __builtin_amdgcn_sched_barrier(0);
        }
        for (int idx0 = gt; idx0 < NW_; idx0 += NGT * 8) {
            f32x2 pw_[8]; float crv[8], civ[8];
#pragma unroll
            for (int u = 0; u < 8; ++u) { const int idx = min(idx0 + u * NGT, NW_ - 1);
                const int k = idx & 127, rowt = (idx >> 7) & 1023, ig = idx >> 17; const int t = rowt >> 4, co = rowt & 15, p = k >> 1; const int sp = ig * 64 + p;
                crv[u] = s5_c_re[((size_t)ig * 16 + co) * 64 + p]; civ[u] = s5_c_im[((size_t)ig * 16 + co) * 64 + p];
                pw_[u] = *(const f32x2*)(S5PW + ((size_t)sp * 65 + t + 1) * 2); }
            __builtin_amdgcn_sched_barrier(0);
#pragma unroll
            for (int u = 0; u < 8; ++u) { const int idx = idx0 + u * NGT;
                if (idx < NW_) { const int ri = idx & 1; const float cr = crv[u], cim_ = civ[u], pr = pw_[u].x, pi_ = pw_[u].y;
                    S5A2[idx] = (bf16_t)f2bf(ri ? -(cr * pi_ + cim_ * pr) : (cr * pr - cim_ * pi_)); } }
            __builtin_amdgcn_sched_barrier(0);
        }
    }
    PH_END();
    if (PH_ON()) { DECL_PTRS();
        for (int t0 = gw * 4; t0 < T; t0 += NGW * 4) {
            const int b = t0 / S; const float* mo = MOD + (size_t)(0 * 2 + b) * 6144;
            f32x4 v[4][4], sc1[4], sh1[4];
#pragma unroll
            for (int u = 0; u < 4; ++u)
#pragma unroll
                for (int j = 0; j < 4; ++j) v[u][j] = *(const f32x4*)(xin + (size_t)(t0 + u) * 1024 + 4 * lane + 256 * j);
#pragma unroll
            for (int j = 0; j < 4; ++j) { sc1[j] = *(const f32x4*)(mo + 1024 + 4 * lane + 256 * j); sh1[j] = *(const f32x4*)(mo + 4 * lane + 256 * j); }
            __builtin_amdgcn_sched_barrier(0);
#pragma unroll
            for (int u = 0; u < 4; ++u) { float ss = 0.f;
#pragma unroll
                for (int j = 0; j < 4; ++j) ss += (v[u][j].x * v[u][j].x + v[u][j].y * v[u][j].y) + (v[u][j].z * v[u][j].z + v[u][j].w * v[u][j].w);
                const float rn = rsqrtf(wave_sum(ss) * (1.0f / 1024.0f) + EPS);
#pragma unroll
                for (int j = 0; j < 4; ++j) { const int col = 4 * lane + 256 * j;
                    u32x2 w; w.x = pk2(v[u][j].x * rn * (1.f + sc1[j].x) + sh1[j].x, v[u][j].y * rn * (1.f + sc1[j].y) + sh1[j].y); w.y = pk2(v[u][j].z * rn * (1.f + sc1[j].z) + sh1[j].z, v[u][j].w * rn * (1.f + sc1[j].w) + sh1[j].w);
                    *(u32x2*)(H + (size_t)(t0 + u) * 1024 + col) = w; } }
            __builtin_amdgcn_sched_barrier(0);
        }
    }
    PH_END();

    for (l0 = 0; l0 < DEPTH; ++l0) {
        if ((l0 & 1) == 0) {
            if (PH_ON()) { DECL_PTRS();
                pg8::Gemm g{H, Wevin + (size_t)i * EV_NP * 1024, T, EV_NP, 1024, 0}; pg8::StaticOrder So; So.init(T, EV_NP, G, c);
                EpiEvenIn E{Z, IQH, IKH, IW, a_kn + i * 64, b_kn + i * 64, b_idx_kn + i * 32, COSH, SINH, COSI, SINI};
                { PROBE_WRAP(pg8::StaticOrder, So); pg8::gemm_phase<EpiEvenIn, PROBE_SCHED(pg8::StaticOrder), true, true>(glds, g, PS_, E, tid); }
            }
            PH_END();
            if (PH_ON()) { DECL_PTRS();
                moe_convert(moe_w1 + (size_t)l * 32 * 1024 * 512, moe_w3 + (size_t)l * 32 * 1024 * 512, moe_w2 + (size_t)l * 32 * 512 * 1024, W13, W2, scr, gw, NGW, lane);
                __syncthreads();
                {
                    LAS unsigned short* kq = (LAS unsigned short*)lds;
                    const int qi = tid >> 7, ht = tid & 127;
                    LAS unsigned short* kqq = kq + qi * 16384;
                    LAS unsigned* hist = (LAS unsigned*)(lds + LDS_MISC + qi * 6400);
                    LAS unsigned* bits = hist + 1024;
                    LAS unsigned* misc = hist + 1536;
                    typedef _Float16 f16x8_t __attribute__((ext_vector_type(8)));
                    f16x8_t qaN[2], kbN[4][2]; f32x4 wqN[4];
                    auto issue_unit = [&](int it_) {
                        const int lane_ = lane_id_v(), r32 = lane_ & 31, hi = lane_ >> 5, wid_ = lsg(wid0);
                        const int L_ = min(it_ * G + c, 8191);
                        const int uu_ = (L_ & 1) ? (8191 - (L_ >> 1)) : (L_ >> 1); const int b_ = uu_ >> 12, pp_ = uu_ & 4095;
                        const size_t tA_ = (size_t)b_ * S + 4 * pp_; const int ntile_ = (4 * pp_ + 4 + 31) >> 5;
#pragma unroll
                        for (int s = 0; s < 2; ++s) qaN[s] = *(const f16x8_t*)(IQH + (tA_ + 2 * ((r32 >> 2) & 1) + (r32 >> 4)) * 256 + (4 * ((r32 >> 3) & 1) + (r32 & 3)) * 32 + 16 * s + 8 * hi);
#pragma unroll
                        for (int q = 0; q < 4; ++q) wqN[q] = *(const f32x4*)(IW + (tA_ + 2 * hi + (q >> 1)) * 8 + 4 * (q & 1));
                        const _Float16* kbase_ = IKH + ((size_t)b_ * S + r32) * 32 + 8 * hi;
#pragma unroll
                        for (int u = 0; u < 4; ++u) { const int tile = min(wid_ + NWAVES * u, ntile_ - 1);
                            kbN[u][0] = *(const f16x8_t*)(kbase_ + (size_t)tile * 1024); kbN[u][1] = *(const f16x8_t*)(kbase_ + (size_t)tile * 1024 + 16); } };
                    issue_unit(0);
                    for (int it = 0;; ++it) {
                        const int L = it * G + c; if (L >= 8192) break;
                        const int uu = (L & 1) ? (8191 - (L >> 1)) : (L >> 1);
                        const int b = uu >> 12, pp = uu & 4095;
                        const size_t tA = (size_t)b * S + 4 * pp;
                        const int nD = 4 * pp + 4;
#pragma unroll
                        for (int q = 0; q < 8; ++q) hist[ht + 128 * q] = 0u;
                        __syncthreads();
#ifdef PROBE_MASK
                        if (a.probe_var != 2)
#endif
                        {
                            const int r32 = lane & 31, hi = lane >> 5;
                            f16x8_t qa[2]; qa[0] = qaN[0]; qa[1] = qaN[1];
                            f32x4 wq[4];
#pragma unroll
                            for (int q = 0; q < 4; ++q) wq[q] = wqN[q];
                            const int ntile = (nD + 31) >> 5;
                            const _Float16* kbase = IKH + ((size_t)b * S + r32) * 32 + 8 * hi;
                            f16x8_t kb[4][2], kn[4][2];
#pragma unroll
                            for (int u = 0; u < 4; ++u) { kb[u][0] = kbN[u][0]; kb[u][1] = kbN[u][1]; }
                            for (int tile0 = wid; tile0 < ntile; tile0 += NWAVES * 4) {
#pragma unroll
                                for (int u = 0; u < 4; ++u) { const int tile = min(tile0 + NWAVES * (4 + u), ntile - 1);
                                    kn[u][0] = *(const f16x8_t*)(kbase + (size_t)tile * 1024); kn[u][1] = *(const f16x8_t*)(kbase + (size_t)tile * 1024 + 16); }
#pragma unroll
                                for (int u = 0; u < 4; ++u) {
                                    const int tile = tile0 + NWAVES * u;
                                    attn_body::f32x16 acc;
#pragma unroll
                                    for (int r = 0; r < 16; ++r) acc[r] = 0.f;
                                    acc = __builtin_amdgcn_mfma_f32_32x32x16_f16(qa[0], kb[u][0], acc, 0, 0, 0);
                                    acc = __builtin_amdgcn_mfma_f32_32x32x16_f16(qa[1], kb[u][1], acc, 0, 0, 0);
                                    float sq[4];
#pragma unroll
                                    for (int q = 0; q < 4; ++q) sq[q] = wq[q].x * relu_i(acc[4 * q]) + wq[q].y * relu_i(acc[4 * q + 1]) + wq[q].z * relu_i(acc[4 * q + 2]) + wq[q].w * relu_i(acc[4 * q + 3]);
                                    if (tile < ntile) {
                                        const float sa = sq[0] + sq[1], sb = sq[2] + sq[3];
                                        const unsigned h0 = (unsigned)__builtin_bit_cast(unsigned short, (_Float16)sa), h1 = (unsigned)__builtin_bit_cast(unsigned short, (_Float16)sb);
                                        const unsigned k0_ = (h0 ^ ((unsigned)__builtin_amdgcn_sbfe((int)h0, 15, 1) | 0x8000u)) & 0xFFFFu, k1_ = (h1 ^ ((unsigned)__builtin_amdgcn_sbfe((int)h1, 15, 1) | 0x8000u)) & 0xFFFFu;
                                        const int kidx = tile * 32 + r32;
                                        kq[(2 * hi) * 16384 + kidx] = (unsigned short)k0_;
                                        kq[(2 * hi + 1) * 16384 + kidx] = (unsigned short)k1_;
                                        LAS unsigned* hq0 = (LAS unsigned*)(lds + LDS_MISC + (2 * hi) * 6400); LAS unsigned* hq1 = (LAS unsigned*)(lds + LDS_MISC + (2 * hi + 1) * 6400);
                                        __hip_atomic_fetch_add(&hq0[(kidx <= 4 * pp + 2 * hi) ? ((k0_ >> 8) << 2) + (lane & 3) : 1536 + 32 + (lane & 3)], 1u, __ATOMIC_RELAXED, __HIP_MEMORY_SCOPE_WORKGROUP);
                                        __hip_atomic_fetch_add(&hq1[(kidx <= 4 * pp + 2 * hi + 1) ? ((k1_ >> 8) << 2) + (lane & 3) : 1536 + 32 + (lane & 3)], 1u, __ATOMIC_RELAXED, __HIP_MEMORY_SCOPE_WORKGROUP);
                                    }
                                }
#pragma unroll
                                for (int u = 0; u < 4; ++u) { kb[u][0] = kn[u][0]; kb[u][1] = kn[u][1]; }
                            }
                            issue_unit(it + 1);
                        }
                        __syncthreads();
#ifdef PROBE_MASK
                        if (a.probe_var == 1) continue;
#endif
                        const int n = 4 * pp + 1 + qi;
                        const bool small = n <= 256;
                        if (ht == 0) { misc[0] = 0u; misc[1] = 256u; misc[2] = 0u; }
                        const LAS unsigned* kq32 = (const LAS unsigned*)kqq;
                        const int npair = (n + 1) >> 1;
                        for (int pass = 0; pass < 2; ++pass) {
                            if (pass) {
#pragma unroll
                                for (int q = 0; q < 8; ++q) hist[ht + 128 * q] = 0u; }
                            __syncthreads();
                            const int shift = 8 - 8 * pass;
                            if (!small && pass) {
                                const unsigned prefix = misc[0];
                                for (int W = ht; 32 * W < n; W += 128) {
                                    const unsigned vmask = (n - 32 * W >= 32) ? 0xFFFFFFFFu : ((1u << (n - 32 * W)) - 1u);
                                    const LAS u32x4* kp = (const LAS u32x4*)(kq32 + 16 * W);
                                    unsigned ne = 0u;
                                    const unsigned pp2 = prefix | (prefix << 16);
#pragma unroll
                                    for (int q4 = 0; q4 < 4; ++q4) { const u32x4 w4 = kp[q4];
#pragma unroll
                                        for (int e = 0; e < 4; ++e) ne |= pk_gt_u16((w4[e] ^ pp2) & 0xFF00FF00u, 0u, 0x00010001u) << (4 * q4 + e); }
                                    unsigned mm = ilv16(~ne) & vmask;
                                    const LAS unsigned short* k16 = kqq + 32 * W;
                                    while (mm) { const int j = __ffs(mm) - 1; mm &= mm - 1u;
                                        __hip_atomic_fetch_add(&hist[(((unsigned)k16[j] & 255u) << 2) + (lane & 3)], 1u, __ATOMIC_RELAXED, __HIP_MEMORY_SCOPE_WORKGROUP); }
                                }
                            }
                            __syncthreads();
                            if (!small && ht < 64) {
                                unsigned cb[4];
#pragma unroll
                                for (int q = 0; q < 4; ++q) { const u32x4 a0 = *(const LAS u32x4*)(hist + (4 * ht + q) * 4); cb[q] = (a0.x + a0.y) + (a0.z + a0.w); }
                                const unsigned c0 = cb[0], c1 = cb[1], c2 = cb[2], c3 = cb[3];
                                const unsigned tot = c0 + c1 + c2 + c3;
                                unsigned Ssum = tot;
#pragma unroll
                                for (int off = 1; off < 64; off <<= 1) { const unsigned v = shi_(Ssum, lane + off); if (ht + off < 64) Ssum += v; }
                                const unsigned above = Ssum - tot, krem = misc[1];
                                if (above < krem && krem <= Ssum) {
                                    unsigned run = above, bin, eq;
                                    if (run + c3 >= krem) { bin = 3; eq = c3; }
                                    else { run += c3; if (run + c2 >= krem) { bin = 2; eq = c2; }
                                        else { run += c2; if (run + c1 >= krem) { bin = 1; eq = c1; } else { run += c1; bin = 0; eq = c0; } } }
                                    misc[0] = misc[0] | ((4u * ht + bin) << shift); misc[1] = krem - run; misc[2] = eq;
                                }
                            }
                            __syncthreads();
                        }
#ifdef PROBE_MASK
                        if (a.probe_var == 8) { __syncthreads(); continue; }
#endif
                        const unsigned Tkey = misc[0], krem = misc[1], cnteq = misc[2];
                        LAS unsigned* eqb = hist;
                        const bool all_eq = (cnteq == krem);
                        for (int W = ht; W < 512; W += 128) {
                            unsigned sel = 0u, eqm = 0u;
                            if (32 * W < n) {
                                const unsigned vmask = (n - 32 * W >= 32) ? 0xFFFFFFFFu : ((1u << (n - 32 * W)) - 1u);
                                if (small) sel = vmask;
                                else {
                                    const LAS u32x4* kp = (const LAS u32x4*)(kq32 + 16 * W);
                                    const unsigned tp2 = Tkey | (Tkey << 16);
                                    unsigned ag = 0u, al = 0u;
#pragma unroll
                                    for (int q4 = 0; q4 < 4; ++q4) { const u32x4 w4 = kp[q4];
#pragma unroll
                                        for (int e = 0; e < 4; ++e) { ag |= pk_gt_u16(w4[e], tp2, 0x00010001u) << (4 * q4 + e); al |= pk_gt_u16(tp2, w4[e], 0x00010001u) << (4 * q4 + e); } }
                                    sel = ilv16(ag); eqm = ilv16(~(ag | al));
                                    if (all_eq) { sel |= eqm; eqm = 0u; }
                                    sel &= vmask; eqm &= vmask;
                                }
                            }
                            bits[W] = sel; eqb[W] = eqm;
                        }
                        __syncthreads();
                        if (!small && !all_eq && ht < 64) {
                            unsigned wv_[8]; unsigned cnt = 0u;
#pragma unroll
                            for (int q = 0; q < 8; ++q) { wv_[q] = eqb[8 * ht + q]; cnt += (unsigned)__popc(wv_[q]); }
                            unsigned inc = cnt;
#pragma unroll
                            for (int off = 1; off < 64; off <<= 1) { const unsigned v = shi_(inc, lane - off); if (lane >= off) inc += v; }
                            unsigned before = inc - cnt;
#pragma unroll
                            for (int q = 0; q < 8; ++q) { unsigned w = wv_[q], keep = 0u;
                                while (w && before < krem) { const unsigned lowb = w & (0u - w); keep |= lowb; w ^= lowb; ++before; }
                                before += (unsigned)__popc(w);
                                if (keep) __hip_atomic_fetch_or(&bits[8 * ht + q], keep, __ATOMIC_RELAXED, __HIP_MEMORY_SCOPE_WORKGROUP); }
                        }
                        __syncthreads();
                        {
                            const int qpos = 4 * pp + qi; const int tmax = 8 * (qpos >> 9) + 7;
#pragma unroll
                            for (int j = 0; j < 2; ++j) { const int tt = 2 * ht + j;
                                if (tt <= tmax) { const unsigned W0 = bits[2 * tt], W1 = bits[2 * tt + 1];
                                    unsigned e0 = W0 & 0x0F0F0F0Fu, e1 = W1 & 0x0F0F0F0Fu, o0 = (W0 >> 4) & 0x0F0F0F0Fu, o1 = (W1 >> 4) & 0x0F0F0F0Fu;
                                    e0 = (e0 | (e0 >> 4)) & 0x00FF00FFu; e0 = (e0 | (e0 >> 8)) & 0xFFFFu; e1 = (e1 | (e1 >> 4)) & 0x00FF00FFu; e1 = (e1 | (e1 >> 8)) & 0xFFFFu;
                                    o0 = (o0 | (o0 >> 4)) & 0x00FF00FFu; o0 = (o0 | (o0 >> 8)) & 0xFFFFu; o1 = (o1 | (o1 >> 4)) & 0x00FF00FFu; o1 = (o1 | (o1 >> 8)) & 0xFFFFu;
                                    u32x2 pm; pm.x = e0 | (e1 << 16); pm.y = o0 | (o1 << 16);
                                    *(u32x2*)(MASKW + (((size_t)(b * 256 + tt)) * S + qpos) * 2) = pm; } }
                        }
                        __syncthreads();
                    }
                }
                __syncthreads();
                {
                    bf16_t* OA = YMIX;
                    const int vcu = (G % 8 == 0) ? (c % 8) * (G / 8) + c / 8 : c;
                    const int nu = (G == 256) ? 4 : (1024 - vcu + G - 1) / G;
                    for (int iu = 0; iu < nu; ++iu) {
                        const int lane = lane_id_v(), wid = lsg(wid0);
                        LAS unsigned char* L0 = lsgp(lds0);
                        int combo, qb;
                        if (G == 256) { combo = vcu >> 4; const int s_ = vcu & 15; qb = iu == 0 ? s_ : iu == 1 ? 31 - s_ : iu == 2 ? 32 + s_ : 63 - s_; }
                        else { const int u = vcu + iu * G; combo = u & 15; qb = 63 - (u >> 4); }
                        const int b = combo >> 3, hc = combo & 7;
                        const bf16_t* zb = Z + (size_t)b * S * EV_ZP;
                        if (qk_bounded(a_qn + i * 64, a_kn + i * 64, lane))
                            flash_unit<2, false, true, EV_ZP, 1024, true>(L0, zb + hc * 64, zb + 512 + hc * 64, zb + 1024 + (hc >> 1) * 128, OA + (size_t)b * S * 1024 + hc * 128, nullptr, qb, wid, lane, a_qn + i * 64, COSH, SINH);
                        else
                            flash_unit<2, false, true, EV_ZP, 1024, false>(L0, zb + hc * 64, zb + 512 + hc * 64, zb + 1024 + (hc >> 1) * 128, OA + (size_t)b * S * 1024 + hc * 128, nullptr, qb, wid, lane, a_qn + i * 64, COSH, SINH);
                    }
                }
            }
            PH_END();
            if (PH_ON()) { DECL_PTRS();
                {
                    const bf16_t* OA = YMIX; const float lamv = LAM[i]; const float lam_init = 0.8f - 0.6f * expf(-0.3f * (float)l);
                    const int h = lane >> 4, vj = (lane >> 3) & 1, d8 = (lane & 7) * 8;
                    float gn[8];
#pragma unroll
                    for (int e = 0; e < 8; ++e) gn[e] = a_subln[i * 128 + vj * 64 + d8 + e] * (1.0f - lam_init);
                    for (int t0 = gw * 4; t0 < T; t0 += NGW * 4) {
                        u32x4 r1[4], r2[4];
#pragma unroll
                        for (int u = 0; u < 4; ++u) { r1[u] = *(const u32x4*)(OA + (size_t)(t0 + u) * 1024 + ((h * 2 + 0) * 2 + vj) * 64 + d8); r2[u] = *(const u32x4*)(OA + (size_t)(t0 + u) * 1024 + ((h * 2 + 1) * 2 + vj) * 64 + d8); }
                        __builtin_amdgcn_sched_barrier(0);
#pragma unroll
                        for (int u = 0; u < 4; ++u) {
                            float o1[8], o2[8], dd[8]; unpack8(r1[u], o1); unpack8(r2[u], o2);
                            float ss = 0.f;
#pragma unroll
                            for (int e = 0; e < 8; ++e) { dd[e] = o1[e] - lamv * o2[e]; ss += dd[e] * dd[e]; }
                            ss += dpp_xor1(ss); ss += dpp_xor2(ss); ss += SHX(ss, 4); ss += SHX(ss, 8);
                            const float r = rsqrtf(ss * (1.0f / 128.0f) + EPS);
#pragma unroll
                            for (int e = 0; e < 8; ++e) dd[e] = dd[e] * r * gn[e];
                            *(u32x4*)(O + (size_t)(t0 + u) * 1024 + h * 128 + vj * 64 + d8) = pack8(dd);
                        }
                        __builtin_amdgcn_sched_barrier(0);
                    }
                }
                {
                    const int vcu = (G % 8 == 0) ? (c % 8) * (G / 8) + c / 8 : c;
                    const int nu = (G == 256) ? 2 : (512 - vcu + G - 1) / G;
                    for (int iu = 0; iu < nu; ++iu) {
                        const int lane = lane_id_v(), wid = lsg(wid0);
                        LAS unsigned char* L0 = lsgp(lds0);
                        int combo, qb;
                        if (G == 256) { combo = vcu >> 4; const int s_ = vcu & 15; qb = iu == 0 ? s_ : 31 - s_; }
                        else { const int u = vcu + iu * G; combo = u & 15; qb = 31 - (u >> 4); }
                        const int b = combo >> 3, h = combo & 7;
                        const bf16_t* zb = Z + (size_t)b * S * EV_ZP;
                        if (qk_bounded(b_qn + i * 64, b_kn + i * 64, lane))
                            flash_unit_q2<1, true, false, EV_ZP, 1024, true>(L0, zb + 1536 + h * 64, zb + 2048 + h * 64, zb + 2560 + h * 64, O + (size_t)b * S * 1024 + 512 + h * 64, MASKW + (size_t)b * 256 * S * 2, qb, wid, lane, b_qn + i * 64, COSH, SINH);
                        else
                            flash_unit_q2<1, true, false, EV_ZP, 1024, false>(L0, zb + 1536 + h * 64, zb + 2048 + h * 64, zb + 2560 + h * 64, O + (size_t)b * S * 1024 + 512 + h * 64, MASKW + (size_t)b * 256 * S * 2, qb, wid, lane, b_qn + i * 64, COSH, SINH);
                    }
                }
            }
            PH_END();
        } else {
            if (PH_ON()) { DECL_PTRS();
                pg8::Gemm g{H, Wodin + (size_t)i * OD_N * 1024, T, OD_N, 1024, 0}; pg8::StaticOrder So; So.init(T, OD_N, G, c);
                EpiOddIn E{Z, UG, c_kn + i * 64, COSH, SINH};
                { PROBE_WRAP(pg8::StaticOrder, So); pg8::gemm_phase<EpiOddIn, PROBE_SCHED(pg8::StaticOrder), true, true>(glds, g, PS_, E, tid); }
            }
            PH_END();
            if (PH_ON()) { DECL_PTRS();
                moe_convert(moe_w1 + (size_t)l * 32 * 1024 * 512, moe_w3 + (size_t)l * 32 * 1024 * 512, moe_w2 + (size_t)l * 32 * 512 * 1024, W13, W2, scr, gw, NGW, lane);
                __syncthreads();
                for (int u = gw; u < NB * 64 * 8; u += NGW) {
                    const int h = u & 7, blk = (u >> 3) & 63, b = u >> 9;
                    const int rs = lane >> 3, d8 = (lane & 7) * 8;
                    const bf16_t* kp = Z + ((size_t)b * S + blk * 256 + rs) * OD_N + 512 + h * 64 + d8;
                    u32x4 kr[32];
#pragma unroll
                    for (int j = 0; j < 32; ++j) kr[j] = *(const u32x4*)(kp + (size_t)(8 * j) * OD_N);
                    __builtin_amdgcn_sched_barrier(0);
                    float sm[8];
#pragma unroll
                    for (int e = 0; e < 8; ++e) sm[e] = 0.f;
#pragma unroll
                    for (int j = 0; j < 32; ++j) { float kv[8]; unpack8(kr[j], kv);
#pragma unroll
                        for (int e = 0; e < 8; ++e) sm[e] += kv[e]; }
#pragma unroll
                    for (int e = 0; e < 8; ++e) { sm[e] += SHX(sm[e], 8); sm[e] += SHX(sm[e], 16); sm[e] += SHX(sm[e], 32); sm[e] *= (1.0f / 256.0f); }
                    if (rs == 0) {
                        *(f32x4*)(KM + (size_t)u * 64 + d8) = (f32x4){sm[0], sm[1], sm[2], sm[3]}; *(f32x4*)(KM + (size_t)u * 64 + d8 + 4) = (f32x4){sm[4], sm[5], sm[6], sm[7]};
                        const u32x4 hw = pack8(sm); float hf[8], lo[8]; unpack8(hw, hf);
#pragma unroll
                        for (int e = 0; e < 8; ++e) lo[e] = sm[e] - hf[e];
                        *(u32x4*)(KMH + ((size_t)(b * 8 + h) * 64 + blk) * 64 + d8) = hw; *(u32x4*)(KML + ((size_t)(b * 8 + h) * 64 + blk) * 64 + d8) = pack8(lo);
                    }
                }
                {
                    const int r32 = lane & 31, hi = lane >> 5;
                    LAS unsigned char* ldsU = lds;
                    LAS float* red = (LAS float*)(lds + 69632);
                    for (int task = c; task < 512; task += G) {
                        const int g = task >> 4, cs = task & 15;
                        for (int q = tid; q < 32 * 128; q += NTHREADS) { const int j = q >> 7, off = (q & 127) * 16;
                            *(LAS u32x4*)(ldsU + j * 2064 + off) = *(const u32x4*)((const unsigned char*)UG + ((size_t)g * T + (size_t)(cs * 32 + j) * 64) * 32 + off); }
                        __syncthreads();
                        const int rb = wid & 3, kh = wid >> 2;
                        attn_body::f32x16 acc;
#pragma unroll
                        for (int r = 0; r < 16; ++r) acc[r] = 0.f;
                        const bf16_t* wrow = S5WT + ((size_t)(i * 32 + g) * 128 + rb * 32 + r32) * 1024 + hi * 8;
#pragma unroll 1
                        for (int ks0 = kh * 32; ks0 < kh * 32 + 32; ks0 += 16) {
                            attn_body::bf16x8 Af[16];
#pragma unroll
                            for (int k = 0; k < 16; ++k) Af[k] = *(const attn_body::bf16x8*)(wrow + (ks0 + k) * 16);
                            __builtin_amdgcn_sched_barrier(0);
#pragma unroll
                            for (int k = 0; k < 16; ++k) {
                                const attn_body::bf16x8 B = *(const LAS attn_body::bf16x8*)(ldsU + r32 * 2064 + (ks0 + k) * 32 + hi * 16);
                                acc = __builtin_amdgcn_mfma_f32_32x32x16_bf16(Af[k], B, acc, 0, 0, 0); }
                            __builtin_amdgcn_sched_barrier(0);
                        }
                        if (kh == 1) {
#pragma unroll
                            for (int r = 0; r < 16; ++r) red[(rb * 64 + lane) * 16 + r] = acc[r];
                        }
                        __syncthreads();
                        if (kh == 0) {
                            float* ep = S5E + ((size_t)(cs * 32 + r32) * 32 + g) * 128 + rb * 32 + 4 * hi;
#pragma unroll
                            for (int q4 = 0; q4 < 4; ++q4) { f32x4 o;
                                o.x = acc[4 * q4] + red[(rb * 64 + lane) * 16 + 4 * q4]; o.y = acc[4 * q4 + 1] + red[(rb * 64 + lane) * 16 + 4 * q4 + 1];
                                o.z = acc[4 * q4 + 2] + red[(rb * 64 + lane) * 16 + 4 * q4 + 2]; o.w = acc[4 * q4 + 3] + red[(rb * 64 + lane) * 16 + 4 * q4 + 3];
                                *(f32x4*)(ep + 8 * q4) = o; }
                        }
                        __syncthreads();
                    }
                }
            }
            PH_END();
            if (PH_ON()) { DECL_PTRS();
#ifndef SKIP_S5
                {
                    for (int idx = gt; idx < NB * 32 * 64; idx += NGT) {
                        const int b = idx >> 11, g = (idx >> 6) & 31, p = idx & 63;
                        const int sp = (i * 32 + g) * 64 + p;
                        const float aLr = S5PW[((size_t)sp * 65 + 64) * 2], aLi = S5PW[((size_t)sp * 65 + 64) * 2 + 1];
                        float hr = 0.f, hi_ = 0.f;
                        for (int c0 = 0; c0 < 256; c0 += 32) {
                            float er[32], ei[32];
#pragma unroll
                            for (int k = 0; k < 32; ++k) { const float* ep = S5E + ((size_t)(b * 256 + c0 + k) * 32 + g) * 128 + 2 * p; er[k] = ep[0]; ei[k] = ep[1]; }
                            __builtin_amdgcn_sched_barrier(0);
#pragma unroll
                            for (int k = 0; k < 32; ++k) asm volatile("" : "+v"(er[k]), "+v"(ei[k]));
#pragma unroll
                            for (int k = 0; k < 32; ++k) {
                                *(unsigned*)(S5HC + ((size_t)(b * 256 + c0 + k) * 32 + g) * 128 + 2 * p) = pk2(hr, hi_);
                                const float nr = aLr * hr - aLi * hi_ + er[k], ni = aLr * hi_ + aLi * hr + ei[k]; hr = nr; hi_ = ni; }
                        }
                    }
                }
#endif
                {
                    unsigned* mcnt = ctl + CW_MCNT + i * 1024;
                    const int r32 = lane & 31, hi = lane >> 5;
                    for (int u = c; u < NB * 8 * 64; u += G) {
                        const int tb = u & 63, h = (u >> 6) & 7, b = u >> 9;
                        const int pos = tb * 256 + wid * 32 + r32; const size_t t = (size_t)b * S + pos;
                        float tv[3] = {-INFINITY, -INFINITY, -INFINITY}; int ti[3] = {1 << 20, 1 << 20, 1 << 20};
                        if (tb > 0) {
                            const bf16_t* kh = KMH + ((size_t)(b * 8 + h) * 64 + r32) * 64 + hi * 8; const bf16_t* kl = KML + ((size_t)(b * 8 + h) * 64 + r32) * 64 + hi * 8;
                            attn_body::bf16x8 mh[2][4], ml_[2][4];
#pragma unroll
                            for (int half = 0; half < 2; ++half)
#pragma unroll
                                for (int d0 = 0; d0 < 4; ++d0) { mh[half][d0] = *(const attn_body::bf16x8*)(kh + half * 32 * 64 + d0 * 16); ml_[half][d0] = *(const attn_body::bf16x8*)(kl + half * 32 * 64 + d0 * 16); }
                            __builtin_amdgcn_sched_barrier(0);
                            attn_body::bf16x8 qr[4];
                            load_q_normed(qr, Z + t * OD_N + h * 64, c_qn + i * 64, COSH, SINH, pos, hi, lane);
                            attn_body::f32x16 g0, g1;
#pragma unroll
                            for (int r = 0; r < 16; ++r) { g0[r] = 0.f; g1[r] = 0.f; }
#pragma unroll
                            for (int d0 = 0; d0 < 4; ++d0) {
                                g0 = __builtin_amdgcn_mfma_f32_32x32x16_bf16(mh[0][d0], qr[d0], g0, 0, 0, 0);
                                g0 = __builtin_amdgcn_mfma_f32_32x32x16_bf16(ml_[0][d0], qr[d0], g0, 0, 0, 0);
                                g1 = __builtin_amdgcn_mfma_f32_32x32x16_bf16(mh[1][d0], qr[d0], g1, 0, 0, 0);
                                g1 = __builtin_amdgcn_mfma_f32_32x32x16_bf16(ml_[1][d0], qr[d0], g1, 0, 0, 0); }
#pragma unroll
                            for (int half = 0; half < 2; ++half)
#pragma unroll
                                for (int r = 0; r < 16; ++r) { const int n = half * 32 + attn_body::crow(r, hi); const float gv = (n < tb) ? (half ? g1[r] : g0[r]) : -INFINITY;
                                    if (gv > tv[0]) { tv[2] = tv[1]; ti[2] = ti[1]; tv[1] = tv[0]; ti[1] = ti[0]; tv[0] = gv; ti[0] = n; }
                                    else if (gv > tv[1]) { tv[2] = tv[1]; ti[2] = ti[1]; tv[1] = gv; ti[1] = n; }
                                    else if (gv > tv[2]) { tv[2] = gv; ti[2] = n; } }
                            float pv_[3]; int pi_[3];
#pragma unroll
                            for (int k = 0; k < 3; ++k) { pv_[k] = SHX(tv[k], 32); pi_[k] = (int)shi_((unsigned)ti[k], lane ^ 32); }
                            float mv[3]; int mi[3]; int ia = 0, ib = 0;
#pragma unroll
                            for (int k = 0; k < 3; ++k) {
                                const float av = ia == 0 ? tv[0] : ia == 1 ? tv[1] : ia == 2 ? tv[2] : -INFINITY; const int ai = ia == 0 ? ti[0] : ia == 1 ? ti[1] : ia == 2 ? ti[2] : (1 << 20);
                                const float bv = ib == 0 ? pv_[0] : ib == 1 ? pv_[1] : ib == 2 ? pv_[2] : -INFINITY; const int bi = ib == 0 ? pi_[0] : ib == 1 ? pi_[1] : ib == 2 ? pi_[2] : (1 << 20);
                                const bool ta = (av > bv) || (av == bv && ai < bi);
                                mv[k] = ta ? av : bv; mi[k] = ta ? ai : bi; if (ta) ++ia; else ++ib; }
#pragma unroll
                            for (int k = 0; k < 3; ++k) { tv[k] = mv[k]; ti[k] = mi[k]; }
                        }
#ifdef PROBE_MASK
                        if (a.probe_var == 3) { if (ti[0] + ti[1] + ti[2] == -12345) NSEL[0] = 1; continue; }
#endif
                        if (hi == 0) {
                            unsigned idx[3];
#pragma unroll
                            for (int sI = 0; sI < 3; ++sI) { idx[sI] = 0u;
                                if (tv[sI] > -INFINITY) idx[sI] = __hip_atomic_fetch_add(mcnt + (b * 8 + h) * 64 + ti[sI], 1u, __ATOMIC_RELAXED, __HIP_MEMORY_SCOPE_AGENT); }
                            int nsel = 0;
#pragma unroll
                            for (int sI = 0; sI < 3; ++sI)
                                if (tv[sI] > -INFINITY) { const int li = (b * 8 + h) * 64 + ti[sI]; MLIST[(size_t)li * 16384 + idx[sI]] = (pos << 2) | nsel; ++nsel; }
                            NSEL[t * 8 + h] = nsel;
                        }
                    }
                }
            }
            PH_END();
            if (PH_ON()) { DECL_PTRS();
                {
                    const unsigned* mcnt = ctl + CW_MCNT + i * 1024;
                    LAS int* pref = (LAS int*)(lds + LDS_MISC);
                    if (wid == 0) {
                        int loc[16]; int sum = 0;
#pragma unroll
                        for (int k = 0; k < 16; ++k) loc[k] = (int)__hip_atomic_load(mcnt + lane * 16 + k, __ATOMIC_RELAXED, __HIP_MEMORY_SCOPE_AGENT);
                        __builtin_amdgcn_sched_barrier(0);
#pragma unroll
                        for (int k = 0; k < 16; ++k) { const int cnt = loc[k]; loc[k] = sum; sum += (cnt + 255) >> 8; }
                        int inc = sum;
#pragma unroll
                        for (int off = 1; off < 64; off <<= 1) { const int v = (int)shi_((unsigned)inc, lane - off); if (lane >= off) inc += v; }
                        const int base = inc - sum;
#pragma unroll
                        for (int k = 0; k < 16; ++k) pref[lane * 16 + k] = base + loc[k];
                        if (lane == 63) pref[1024] = inc;
                    }
                    __syncthreads();
                    const int NTsel = pref[1024];
                    auto decode = [&](int task_, int& li_o, int& chunk_o, bool& own_o) { own_o = task_ >= NTsel; chunk_o = 0;
                        if (own_o) li_o = task_ - NTsel;
                        else { int lo_ = 0, hi_ = 1023; while (lo_ < hi_) { const int mid = (lo_ + hi_ + 1) >> 1; if (pref[mid] <= task_) lo_ = mid; else hi_ = mid - 1; } li_o = lo_; chunk_o = task_ - pref[lo_]; } };
                    int nx_li = 0, nx_chunk = 0, nx_ent = 0, nx_cnt = 256; bool nx_own = true;
                    if (c < NTsel + 1024) { decode(c, nx_li, nx_chunk, nx_own);
                        if (!nx_own) { const int ln_ = lane_id_v(); nx_ent = MLIST[(size_t)nx_li * 16384 + nx_chunk * 256 + lsg(wid0) * 32 + (ln_ & 31)]; nx_cnt = (int)__hip_atomic_load(mcnt + nx_li, __ATOMIC_RELAXED, __HIP_MEMORY_SCOPE_AGENT); } }
                    for (int task = c; task < NTsel + 1024; task += G) {
                        const int lane = lane_id_v(), wid = lsg(wid0), r32 = lane & 31, hi = lane >> 5;
                        LAS unsigned char* ldsKs = lsgp(lds0); LAS unsigned char* ldsVs = ldsKs + 32768;
                        LAS bf16_t* stg = (LAS bf16_t*)(ldsKs + 65536 + wid * 4096); LAS float* wsf = (LAS float*)(ldsKs + 98304 + wid * 256); LAS int* rowd = (LAS int*)(ldsKs + 100352 + wid * 128);
                        const bool own_task = nx_own;
                        const int li = nx_li, chunk = nx_chunk;
                        const int b = li >> 9, h = (li >> 6) & 7, blk = li & 63;
                        const int e_ = chunk * 256 + wid * 32 + r32;
                        const int cnt = nx_cnt;
                        const int ent_ = nx_ent;
                        u32x4 kst[4], vst[4];
                        {
                            const bf16_t* kbp = Z + ((size_t)b * S + blk * 256) * OD_N + 512 + h * 64;
                            const bf16_t* vbp = Z + ((size_t)b * S + blk * 256) * OD_N + 1024 + h * 64;
#pragma unroll
                            for (int kt = 0; kt < 4; ++kt) {
                                kst[kt] = *(const u32x4*)(kbp + (size_t)(kt * 64 + lane) * OD_N + wid * 8);
                                vst[kt] = *(const u32x4*)(vbp + (size_t)(kt * 64 + 16 * (wid & 3) + (lane >> 2)) * OD_N + (wid >> 2) * 32 + (lane & 3) * 8);
                            }
                        }
                        __builtin_amdgcn_sched_barrier(0);
                        int posq, slot; bool valid;
                        if (own_task) { posq = blk * 256 + wid * 32 + r32; slot = 3; valid = true; }
                        else { valid = e_ < cnt; posq = valid ? (ent_ >> 2) : 0; slot = ent_ & 3; }
                        const size_t tq = (size_t)b * S + posq;
                        const int dest = valid ? (int)((tq * 8 + h) * 4 + slot) : -1;
                        attn_body::bf16x8 qr[4];
                        load_q_normed(qr, Z + tq * OD_N + h * 64, c_qn + i * 64, COSH, SINH, posq, hi, lane);
#pragma unroll
                        for (int kt = 0; kt < 4; ++kt) { *(LAS u32x4*)(ldsKs + kt * 8192 + wid * 1024 + lane * 16) = kst[kt]; *(LAS u32x4*)(ldsVs + kt * 8192 + wid * 1024 + lane * 16) = vst[kt]; }
                        nx_own = true; nx_li = 0; nx_chunk = 0; nx_ent = 0; nx_cnt = 256;
                        if (task + G < NTsel + 1024) { decode(task + G, nx_li, nx_chunk, nx_own);
                            if (!nx_own) { nx_ent = MLIST[(size_t)nx_li * 16384 + nx_chunk * 256 + wid * 32 + r32]; nx_cnt = (int)__hip_atomic_load(mcnt + nx_li, __ATOMIC_RELAXED, __HIP_MEMORY_SCOPE_AGENT); } }
                        __syncthreads();
                        attn_body::f32x16 p0[4], p1[4];
#pragma unroll
                        for (int kt = 0; kt < 4; ++kt) {
#pragma unroll
                            for (int r = 0; r < 16; ++r) { p0[kt][r] = 0.f; p1[kt][r] = 0.f; }
                            const LAS unsigned char* kb = ldsKs + kt * 8192 + hi * 1024 + r32 * 16;
#pragma unroll
                            for (int d0 = 0; d0 < 4; ++d0) {
                                const attn_body::bf16x8 b0 = *(const LAS attn_body::bf16x8*)(kb + d0 * 2048), b1 = *(const LAS attn_body::bf16x8*)(kb + d0 * 2048 + 512);
                                p0[kt] = __builtin_amdgcn_mfma_f32_32x32x16_bf16(b0, qr[d0], p0[kt], 0, 0, 0);
                                p1[kt] = __builtin_amdgcn_mfma_f32_32x32x16_bf16(b1, qr[d0], p1[kt], 0, 0, 0);
                            }
                        }
                        if (own_task) {
                            const int qrel = wid * 32 + r32;
#pragma unroll
                            for (int kt = 0; kt < 4; ++kt)
#pragma unroll
                                for (int r = 0; r < 16; ++r) { const int kv = kt * 64 + attn_body::crow(r, hi); if (kv > qrel) p0[kt][r] = -INFINITY; if (kv + 32 > qrel) p1[kt][r] = -INFINITY; }
                        }
                        float mx = -INFINITY;
#pragma unroll
                        for (int kt = 0; kt < 4; ++kt)
#pragma unroll
                            for (int r = 0; r < 16; ++r) mx = fmaxf(mx, fmaxf(p0[kt][r], p1[kt][r]));
                        mx = fmaxf(mx, SHX(mx, 32));
                        float ls = 0.f;
#pragma unroll
                        for (int kt = 0; kt < 4; ++kt)
#pragma unroll
                            for (int r = 0; r < 16; ++r) { p0[kt][r] = __builtin_amdgcn_exp2f(p0[kt][r] - mx); p1[kt][r] = __builtin_amdgcn_exp2f(p1[kt][r] - mx); ls += p0[kt][r] + p1[kt][r]; }
                        ls += SHX(ls, 32);
                        attn_body::f32x16 o[2];
#pragma unroll
                        for (int r = 0; r < 16; ++r) { o[0][r] = 0.f; o[1][r] = 0.f; }
                        const int vb0 = (int)(unsigned)(unsigned long long)ldsVs + ((lane >> 4) & 1) * 32 + (lane & 3) * 8 + (4 * hi + ((lane & 15) >> 2)) * 64;
#pragma unroll
                        for (int kt = 0; kt < 4; ++kt) {
                            u32x4 pw0, pw1, pw2, pw3;
#pragma unroll
                            for (int k = 0; k < 4; ++k) { pw0[k] = attn_body::cvtpk_s(p0[kt][2 * k], p0[kt][2 * k + 1]); pw1[k] = attn_body::cvtpk_s(p0[kt][8 + 2 * k], p0[kt][9 + 2 * k]);
                                pw2[k] = attn_body::cvtpk_s(p1[kt][2 * k], p1[kt][2 * k + 1]); pw3[k] = attn_body::cvtpk_s(p1[kt][8 + 2 * k], p1[kt][9 + 2 * k]); }
                            attn_body::pv(o, vb0 + kt * 8192, __builtin_bit_cast(attn_body::bf16x8, pw0), __builtin_bit_cast(attn_body::bf16x8, pw1), __builtin_bit_cast(attn_body::bf16x8, pw2), __builtin_bit_cast(attn_body::bf16x8, pw3));
                        }
                        if (hi == 0) { wsf[r32] = ls; rowd[r32] = dest; if (valid) { MML[(size_t)dest * 2] = mx; MML[(size_t)dest * 2 + 1] = ls; } }
                        LDS_WAIT();
#pragma unroll
                        for (int r = 0; r < 16; ++r) { const int orow = attn_body::crow(r, hi); const float rl = __builtin_amdgcn_rcpf(wsf[orow]);
                            stg[orow * 64 + r32] = (bf16_t)f2bf(o[0][r] * rl); stg[orow * 64 + 32 + r32] = (bf16_t)f2bf(o[1][r] * rl); }
                        LDS_WAIT();
#pragma unroll
                        for (int q = 0; q < 4; ++q) { const int row = q * 8 + (lane >> 3), ch = lane & 7; const int dd = rowd[row];
                            if (dd >= 0) *(u32x4*)(MPO + (size_t)dd * 64 + ch * 8) = *(const LAS u32x4*)(stg + row * 64 + ch * 8); }
                        __syncthreads();
                    }
                }
                {
                const int r32 = lane & 31, hi = lane >> 5;
                LAS unsigned char* ldsU = lds;
                LAS unsigned char* ldsK = lds + 69632;
                for (int task = c; task < 512; task += G) {
                    const int g = task >> 4, cs = task & 15, ig = i * 32 + g;
                    for (int q = tid; q < 32 * 128; q += NTHREADS) { const int j = q >> 7, off = (q & 127) * 16;
                        *(LAS u32x4*)(ldsU + j * 2064 + off) = *(const u32x4*)((const unsigned char*)UG + ((size_t)g * T + (size_t)(cs * 32 + j) * 64) * 32 + off); }
                    for (int q = tid; q < 65 * 48; q += NTHREADS) *(LAS u32x4*)(ldsK + q * 16) = *(const u32x4*)((const unsigned char*)S5KT + (size_t)ig * 65 * 768 + q * 16);
                    __syncthreads();
                    const int gc = cs * 32 + r32;
                    const float* dsk = s5_d + ig * 16;
                    const f32x4 dd0 = *(const f32x4*)(dsk + 4 * hi), dd1 = *(const f32x4*)(dsk + 8 + 4 * hi);
                    attn_body::bf16x8 hcr[8];
                    { const bf16_t* hc = S5HC + ((size_t)gc * 32 + g) * 128 + hi * 8;
#pragma unroll
                      for (int kk = 0; kk < 8; ++kk) hcr[kk] = *(const attn_body::bf16x8*)(hc + kk * 16); }
#pragma unroll 1
                    for (int rr = 0; rr < 4; ++rr) {
                        const int r = rr == 0 ? wid : rr == 1 ? 15 - wid : rr == 2 ? 16 + wid : 31 - wid;
                        attn_body::f32x16 acc;
#pragma unroll
                        for (int q = 0; q < 16; ++q) acc[q] = 0.f;
                        attn_body::bf16x8 a2r[8];
                        { const bf16_t* a2 = S5A2 + ((size_t)ig * 1024 + r * 32 + r32) * 128 + hi * 8;
#pragma unroll
                          for (int kk = 0; kk < 8; ++kk) a2r[kk] = *(const attn_body::bf16x8*)(a2 + kk * 16); }
                        __builtin_amdgcn_sched_barrier(0);
                        const LAS unsigned char* kbase = ldsK + (r32 >> 4) * 768 + (r32 & 15) * 48 + hi * 16;
                        const LAS unsigned char* ubase = ldsU + r32 * 2064 + hi * 16;
                        for (int s = 0; s <= 2 * r + 1; ++s) {
                            const attn_body::bf16x8 A = *(const LAS attn_body::bf16x8*)(kbase + (2 * r - s + 1) * 768);
                            const attn_body::bf16x8 B = *(const LAS attn_body::bf16x8*)(ubase + s * 32);
                            acc = __builtin_amdgcn_mfma_f32_32x32x16_bf16(A, B, acc, 0, 0, 0);
                        }
#pragma unroll
                        for (int kk = 0; kk < 8; ++kk) acc = __builtin_amdgcn_mfma_f32_32x32x16_bf16(a2r[kk], hcr[kk], acc, 0, 0, 0);
#pragma unroll
                        for (int q4 = 0; q4 < 4; ++q4) {
                            const int rowb = 8 * q4 + 4 * hi, dt_ = rowb >> 4, co0 = rowb & 15, t = 2 * r + dt_;
                            const u32x2 uw = *(const LAS u32x2*)(ldsU + r32 * 2064 + t * 32 + co0 * 2);
                            const f32x4 dd = (q4 & 1) ? dd1 : dd0;
                            const float y0 = acc[4 * q4] + dd.x * bflo(uw.x), y1 = acc[4 * q4 + 1] + dd.y * bfhi(uw.x), y2 = acc[4 * q4 + 2] + dd.z * bflo(uw.y), y3 = acc[4 * q4 + 3] + dd.w * bfhi(uw.y);
                            u32x2 w; w.x = pk2(gelu_tanh(y0), gelu_tanh(y1)); w.y = pk2(gelu_tanh(y2), gelu_tanh(y3));
                            *(u32x2*)(YG + ((size_t)gc * 64 + t) * 512 + g * 16 + co0) = w;
                        }
                    }
                    __syncthreads();
                }
                }
            }
            PH_END();
            if (PH_ON()) { DECL_PTRS();
                {
                    const int h = lane >> 3, d8 = (lane & 7) * 8;
                    for (int t0 = gw * 4; t0 < T; t0 += NGW * 4) {
                        int nsel[4]; f32x2 ml[4][4]; u32x4 po[4][4];
#pragma unroll
                        for (int u = 0; u < 4; ++u) { const size_t base = ((size_t)(t0 + u) * 8 + h) * 4; nsel[u] = NSEL[(size_t)(t0 + u) * 8 + h];
#pragma unroll
                            for (int s = 0; s < 4; ++s) { ml[u][s] = *(const f32x2*)(MML + (base + s) * 2); po[u][s] = *(const u32x4*)(MPO + (base + s) * 64 + d8); } }
                        __builtin_amdgcn_sched_barrier(0);
#pragma unroll
                        for (int u = 0; u < 4; ++u) {
                            float mm[4], ll[4];
#pragma unroll
                            for (int s = 0; s < 4; ++s) { const bool on = (s == 3) || (s < nsel[u]); mm[s] = on ? ml[u][s].x : -INFINITY; ll[s] = on ? ml[u][s].y : 0.f; }
                            const float M = fmaxf(fmaxf(mm[0], mm[1]), fmaxf(mm[2], mm[3]));
                            float acc[8], wsum = 0.f;
#pragma unroll
                            for (int e = 0; e < 8; ++e) acc[e] = 0.f;
#pragma unroll
                            for (int s = 0; s < 4; ++s) { const bool on = (s == 3) || (s < nsel[u]);
                                const float w = on ? ll[s] * __builtin_amdgcn_exp2f(mm[s] - M) : 0.f; float ov[8]; unpack8(po[u][s], ov); wsum += w;
#pragma unroll
                                for (int e = 0; e < 8; ++e) acc[e] += on ? w * ov[e] : 0.f; }
                            const float inv = 1.0f / wsum;
#pragma unroll
                            for (int e = 0; e < 8; ++e) acc[e] *= inv;
                            *(u32x4*)(O + (size_t)(t0 + u) * 1024 + h * 64 + d8) = pack8(acc);
                        }
                        __builtin_amdgcn_sched_barrier(0);
                    }
                }
                pg8::Gemm g{YG, Wglu + (size_t)i * 512 * 512, T, 512, 512, 0}; pg8::StaticOrder So; So.init(T, 512, G, c);
                EpiGLU E{O, YG, s5_glu_b + i * 512};
                { PROBE_WRAP(pg8::StaticOrder, So); pg8::gemm_phase<EpiGLU, PROBE_SCHED(pg8::StaticOrder), true, true>(glds, g, PS_, E, tid); }
            }
            PH_END();
        }
        if (PH_ON()) { DECL_PTRS();
            pg8::Gemm g{O, ((l & 1) ? Wodout : Wevout) + (size_t)i * 1024 * 1024, T, 1024, 1024, 0}; pg8::StaticOrder So; So.init(T, 1024, G, c);
            EpiPlain E{YMIX, 1024};
            { PROBE_WRAP(pg8::StaticOrder, So); pg8::gemm_phase<EpiPlain, PROBE_SCHED(pg8::StaticOrder), true, true>(glds, g, PS_, E, tid); }
        }
        PH_END();
        if (PH_ON()) { DECL_PTRS();
#ifdef PROBE_MASK
            const bool first_x = (l == 0 && a.probe_var != -5);
#else
            const bool first_x = (l == 0);
#endif
            const float* xs = xin;
            LAS int* r_e = (LAS int*)(lds + 0);
            LAS float* r_w = (LAS float*)(lds + 1024);
            LAS int* r_rank = (LAS int*)(lds + 2048);
            LAS int* lcnt = (LAS int*)(lds + 3072);
            LAS int* lbase = (LAS int*)(lds + 3200);
            const float* wg_l = moe_wg + (size_t)l * 1024 * 4; const float* we_l = moe_we + (size_t)l * 1024 * 32;
            for (int chunk = c; chunk < T / 128; chunk += G) {
                if (tid < 32) lcnt[tid] = 0;
                LAS float* modl = (LAS float*)(lds + 32768);
                { const float* mo_ = MOD + (size_t)(l * 2 + (int)(((size_t)chunk * 128) / S)) * 6144 + 2048;
                  for (int q = tid; q < 768; q += NTHREADS) *(LAS f32x4*)(modl + 4 * q) = *(const f32x4*)(mo_ + 4 * q); }
                __syncthreads();
                {
                    const int rloc = lane & 15, kc = lane >> 4; const int r = wid * 16 + rloc; const size_t t = (size_t)chunk * 128 + r; const int b = (int)(((size_t)chunk * 128) / S);
                    const float* mo = MOD + (size_t)(l * 2 + b) * 6144;
                    float ss;
                    if (first_x) ss = f_pass1<true>(xs + t * 1024, XB + t * 1024, YMIX + t * 1024, modl, kc);
                    else ss = f_pass1<false>(xs + t * 1024, XB + t * 1024, YMIX + t * 1024, modl, kc);
                    ss += SHX(ss, 16); ss += SHX(ss, 32);
                    const float rn = rsqrtf(ss * (1.0f / 1024.0f) + EPS);
                    f32x4 acc[3];
#pragma unroll
                    for (int ct = 0; ct < 3; ++ct) acc[ct] = (f32x4){0.f, 0.f, 0.f, 0.f};
                    const bf16_t* wh = WRH + ((size_t)l * 48 + rloc) * 1024 + 8 * kc; const bf16_t* wl = WRL + ((size_t)l * 48 + rloc) * 1024 + 8 * kc;
                    f_pass2(XB + t * 1024, H + t * 1024, modl, wh, wl, rn, kc, acc);
                    LAS float* lg = (LAS float*)(lds + 4096 + wid * 3072);
#pragma unroll
                    for (int ct = 0; ct < 3; ++ct) { lg[(4 * kc + 0) * 48 + ct * 16 + rloc] = acc[ct].x; lg[(4 * kc + 1) * 48 + ct * 16 + rloc] = acc[ct].y; lg[(4 * kc + 2) * 48 + ct * 16 + rloc] = acc[ct].z; lg[(4 * kc + 3) * 48 + ct * 16 + rloc] = acc[ct].w; }
                    LDS_WAIT();
                    if (lane < 16) {
                        const LAS float* lr = lg + lane * 48;
                        float cg[4];
#pragma unroll
                        for (int e = 0; e < 4; ++e) cg[e] = lr[e] + moe_bg[l * 4 + e];
                        int grp = 0; float cm = cg[0];
#pragma unroll
                        for (int e = 1; e < 4; ++e) if (cg[e] > cm) { cm = cg[e]; grp = e; }
                        float den = 0.f;
#pragma unroll
                        for (int e = 0; e < 4; ++e) den += __expf(cg[e] - cm);
                        const float pg = 1.0f / den;
                        float fe[8];
#pragma unroll
                        for (int e = 0; e < 8; ++e) fe[e] = lr[4 + grp * 8 + e] + moe_be[l * 32 + grp * 8 + e];
                        int j0 = 0; float f0 = fe[0];
#pragma unroll
                        for (int e = 1; e < 8; ++e) if (fe[e] > f0) { f0 = fe[e]; j0 = e; }
                        int j1 = -1; float f1 = -INFINITY;
#pragma unroll
                        for (int e = 0; e < 8; ++e) if (e != j0 && fe[e] > f1) { f1 = fe[e]; j1 = e; }
                        const float ex = __expf(f1 - f0); const float sA = 1.0f / (1.0f + ex), sB = ex / (1.0f + ex);
                        const int rr_ = wid * 16 + lane;
                        r_e[2 * rr_] = grp * 8 + j0; r_w[2 * rr_] = pg * sA; r_e[2 * rr_ + 1] = grp * 8 + j1; r_w[2 * rr_ + 1] = pg * sB;
                    }
                }
                __syncthreads();
#ifdef PROBE_MASK
                if (a.probe_var == 5) { if (tid < 256 && r_e[tid] == -777) TOKES[0] = 0; __syncthreads(); continue; }
#endif
                if (tid < 256) r_rank[tid] = __hip_atomic_fetch_add(&lcnt[r_e[tid]], 1, __ATOMIC_RELAXED, __HIP_MEMORY_SCOPE_WORKGROUP);
                __syncthreads();
                if (tid < 32) lbase[tid] = (int)__hip_atomic_fetch_add(ctl + CW_CNT + (l * 32 + tid) * 64, (unsigned)lcnt[tid], __ATOMIC_RELAXED, __HIP_MEMORY_SCOPE_AGENT);
                __syncthreads();
                if (tid < 256) { const size_t t = (size_t)chunk * 128 + (tid >> 1); const int k = tid & 1; const int e = r_e[tid]; const int slot = lbase[e] + r_rank[tid];
                    TOKES[t * 2 + k] = e * 32768 + slot; TOKW[t * 2 + k] = r_w[tid]; LTOK[e * 32768 + slot] = (int)t; }
                __syncthreads();
            }
        }
        PH_END();
        if (PH_ON()) { DECL_PTRS();
            LAS int* tile_e = (LAS int*)(lds + LDS_MISC); LAS int* rb = tile_e + 320; LAS int* nt_p = tile_e + 400;
            moe_tables(ctl, l, tile_e, rb, nt_p, tid);
            const int nR = nt_p[0];
            pg8::Gemm g{H, W13, nR * 256, 1024, 1024, (size_t)1024 * 1024 * 2}; MoeOrder Mo{4, nR * 4, G, c, tile_e};
            EpiSwiGLU E{HID}; MoeRows RW{rb, LTOK};
            { PROBE_WRAP(MoeOrder, Mo); pg8::gemm_phase<EpiSwiGLU, PROBE_SCHED(MoeOrder), true, true, MoeRows>(glds, g, PS_, E, tid, RW); }
        }
        PH_END();
        if (PH_ON()) { DECL_PTRS();
            LAS int* tile_e = (LAS int*)(lds + LDS_MISC); LAS int* rb = tile_e + 320; LAS int* nt_p = tile_e + 400;
            moe_tables(ctl, l, tile_e, rb, nt_p, tid);
            const int nR = nt_p[0];
            pg8::Gemm g{HID, W2, nR * 256, 1024, 512, (size_t)1024 * 512 * 2}; MoeOrder Mo{4, nR * 4, G, c, tile_e};
            EpiPlain E{Y, 1024};
            { PROBE_WRAP(MoeOrder, Mo); pg8::gemm_phase<EpiPlain, PROBE_SCHED(MoeOrder), true, true>(glds, g, PS_, E, tid); }
        }
        PH_END();
        if (PH_ON()) { DECL_PTRS();
            LAS int* tile_e = (LAS int*)(lds + LDS_MISC); LAS int* rb = tile_e + 320; LAS int* nt_p = tile_e + 400;
            moe_tables(ctl, l, tile_e, rb, nt_p, tid);
            constexpr int RJ = 4;
            for (int t0 = gw * RJ; t0 < T; t0 += NGW * RJ) {
                const int b = t0 / S; const float* mo = MOD + (size_t)(l * 2 + b) * 6144;
                int r0[RJ], r1[RJ]; float w0[RJ], w1[RJ];
#pragma unroll
                for (int u = 0; u < RJ; ++u) { const int t = t0 + u; { const int e0_ = TOKES[2 * t], e1_ = TOKES[2 * t + 1]; r0[u] = rb[e0_ >> 15] + (e0_ & 32767); r1[u] = rb[e1_ >> 15] + (e1_ & 32767); } w0[u] = TOKW[2 * t]; w1[u] = TOKW[2 * t + 1];
#ifdef PROBE_MASK
                    if (a.probe_var == 4 || a.probe_var == -4) { w0[u] *= 0.5f; w1[u] *= 0.5f; }
#endif
                }
                f32x4 v[RJ][4]; u32x2 ya[RJ][4], yb[RJ][4];
#pragma unroll
                for (int u = 0; u < RJ; ++u)
#pragma unroll
                    for (int j = 0; j < 4; ++j) { const int col = 4 * lane + 256 * j; { const u32x2 xw = *(const u32x2*)(XB + (size_t)(t0 + u) * 1024 + col); v[u][j] = (f32x4){bflo(xw.x), bfhi(xw.x), bflo(xw.y), bfhi(xw.y)}; }
                        ya[u][j] = *(const u32x2*)(Y + (size_t)r0[u] * 1024 + col); yb[u][j] = *(const u32x2*)(Y + (size_t)r1[u] * 1024 + col); }
                f32x4 gg[4];
#pragma unroll
                for (int j = 0; j < 4; ++j) gg[j] = *(const f32x4*)(mo + 5120 + 4 * lane + 256 * j);
                float ss[RJ];
#pragma unroll
                for (int u = 0; u < RJ; ++u) { ss[u] = 0.f;
#pragma unroll
                    for (int j = 0; j < 4; ++j) { const int col = 4 * lane + 256 * j; const f32x4 xv = v[u][j]; f32x4 nv;
                        nv.x = xv.x + gg[j].x * (w0[u] * bflo(ya[u][j].x) + w1[u] * bflo(yb[u][j].x)); nv.y = xv.y + gg[j].y * (w0[u] * bfhi(ya[u][j].x) + w1[u] * bfhi(yb[u][j].x));
                        nv.z = xv.z + gg[j].z * (w0[u] * bflo(ya[u][j].y) + w1[u] * bflo(yb[u][j].y)); nv.w = xv.w + gg[j].w * (w0[u] * bfhi(ya[u][j].y) + w1[u] * bfhi(yb[u][j].y));
                        if (l + 1 < DEPTH) { u32x2 xw; xw.x = pk2(nv.x, nv.y); xw.y = pk2(nv.z, nv.w); *(u32x2*)(XB + (size_t)(t0 + u) * 1024 + col) = xw; nv = (f32x4){bflo(xw.x), bfhi(xw.x), bflo(xw.y), bfhi(xw.y)}; }
                        else *(f32x4*)(out + (size_t)(t0 + u) * 1024 + col) = nv;
                        v[u][j] = nv; ss[u] += (nv.x * nv.x + nv.y * nv.y) + (nv.z * nv.z + nv.w * nv.w); } }
                if (l + 1 < DEPTH) {
                    const float* mn = MOD + (size_t)((l + 1) * 2 + b) * 6144;
                    f32x4 sc1[4], sh1[4];
#pragma unroll
                    for (int j = 0; j < 4; ++j) { sc1[j] = *(const f32x4*)(mn + 1024 + 4 * lane + 256 * j); sh1[j] = *(const f32x4*)(mn + 4 * lane + 256 * j); }
#pragma unroll
                    for (int u = 0; u < RJ; ++u) { const float rn = rsqrtf(wave_sum(ss[u]) * (1.0f / 1024.0f) + EPS);
#pragma unroll
                        for (int j = 0; j < 4; ++j) { const int col = 4 * lane + 256 * j;
                            u32x2 w; w.x = pk2(v[u][j].x * rn * (1.f + sc1[j].x) + sh1[j].x, v[u][j].y * rn * (1.f + sc1[j].y) + sh1[j].y); w.y = pk2(v[u][j].z * rn * (1.f + sc1[j].z) + sh1[j].z, v[u][j].w * rn * (1.f + sc1[j].w) + sh1[j].w);
                            *(u32x2*)(H + (size_t)(t0 + u) * 1024 + col) = w; } }
                }
            }
        }
        PH_END();
    }
#undef PH_ON
#undef PH_END
}

extern "C" void kernel_launch(void* const* d_in, const int* in_sizes, int n_in, void* d_out, int out_size, void* d_ws, size_t ws_size, hipStream_t stream) {
    static int grid = 0;
    if (grid == 0) {
        if (n_in != 37 || out_size != T * D || ws_size < WS_END) { fprintf(stderr, "kernel_launch: unexpected shapes (n_in %d, out %d, ws %zu); nothing launched\n", n_in, out_size, ws_size); grid = -1; return; }
        int dev = 0, cus = 0, per_cu = 0;
        if (hipGetDevice(&dev) != hipSuccess || hipDeviceGetAttribute(&cus, hipDeviceAttributeMultiprocessorCount, dev) != hipSuccess) { grid = -1; return; }
        if (hipFuncSetAttribute((const void*)fwd, hipFuncAttributeMaxDynamicSharedMemorySize, LDS_BYTES) != hipSuccess) { fprintf(stderr, "kernel_launch: hipFuncSetAttribute failed\n"); grid = -1; return; }
        if (hipOccupancyMaxActiveBlocksPerMultiprocessor(&per_cu, (const void*)fwd, NTHREADS, LDS_BYTES) != hipSuccess || per_cu < 1) fprintf(stderr, "kernel_launch: occupancy query says %d\n", per_cu);
        (void)hipGetLastError();
        grid = cus;
    }
    if (grid < 0) return;
    if (hipMemsetAsync((char*)d_ws + WS_CTL, 0, CTL_ZERO_BYTES, stream) != hipSuccess) return;
    Args a{};
    for (int i = 0; i < 37; ++i) a.in[i] = d_in[i];
    a.out = (float*)d_out; a.ws = (unsigned char*)d_ws;
#ifdef PROBE_MASK
#ifndef PROBE_VAR
#define PROBE_VAR 0
#endif
    {
        int types[N_PHASES]; int n = 0; types[n++] = 0; types[n++] = 1; types[n++] = 2;
        for (int l = 0; l < DEPTH; ++l) { if ((l & 1) == 0) { for (int k = 3; k <= 7; ++k) if (k != 4 && k != 6) types[n++] = k; } else { for (int k = 8; k <= 13; ++k) if (k != 9) types[n++] = k; } for (int k = 14; k <= 19; ++k) if (k != 16) types[n++] = k; }
        for (int p = 0; p < N_PHASES; ++p) { a.ph_lo = p; a.ph_hi = p + 1; const int reps = ((PROBE_MASK >> types[p]) & 1) ? 2 : 1;
            for (int r = 0; r < reps; ++r) { a.probe_var = (reps == 2) ? ((r == 0) ? PROBE_VAR : -PROBE_VAR) : 0; hipLaunchKernelGGL(fwd, dim3(grid), dim3(NTHREADS), LDS_BYTES, stream, a); } }
    }
#elif MK_ONE_LAUNCH
    a.ph_lo = 0; a.ph_hi = N_PHASES;
    hipLaunchKernelGGL(fwd, dim3(grid), dim3(NTHREADS), LDS_BYTES, stream, a);
#else
    for (int p = 0; p < N_PHASES; ++p) { a.ph_lo = p; a.ph_hi = p + 1; hipLaunchKernelGGL(fwd, dim3(grid), dim3(NTHREADS), LDS_BYTES, stream, a); }
#endif
}
```

```cpp
#include <hip/hip_runtime.h>
#include <cstdio>
#include <cstdint>
#include <hip/hip_bf16.h>
#include <cmath>
#ifndef MK_ONE_LAUNCH
#define MK_ONE_LAUNCH 1
#endif
namespace pg8 {
#define PG8_LAS __attribute__((address_space(3)))
typedef unsigned short bf16_t;
typedef short bf16x8 __attribute__((ext_vector_type(8)));
typedef float f32x4 __attribute__((ext_vector_type(4)));
typedef unsigned u32x4 __attribute__((ext_vector_type(4)));
constexpr int BM = 256, BK = 64, HALF = 128, HTB = HALF * BK * 2  , STAGE_BYTES = 8 * HTB, NXCD = 8, WGM = 8;

__host__ __device__ __forceinline__ int lds_byte(int r, int c) { const int st = (r >> 4) * 2 + (c >> 5), rr = r & 15, cc = c & 31, ob = rr * 64 + cc * 2; return st * 1024 + (ob ^ (((ob >> 9) & 1) << 5)); }
__host__ __device__ __forceinline__ void stage_rc(int b, int& R, int& C) { const int st = b / 1024, sb = b % 1024, swz = sb ^ (((sb >> 9) & 1) << 5); R = (st >> 1) * 16 + swz / 64; C = (st & 1) * 32 + (swz % 64) / 2; }
__host__ __device__ __forceinline__ int perm32(int rho) { const int n = rho >> 4, i = rho & 15; return 8 * (i >> 2) + 4 * n + (i & 3); }

struct Unit { int pm, pn, be; };
struct Gemm { const bf16_t* A; const bf16_t* Bt; int M, N, K; size_t bstride; };

struct StaticOrder {
    int nM, nN, nwg, G, c;
    __host__ __device__ void init(int M, int N, int G_, int c_) { nM = M / BM; nN = N / BM; nwg = nM * nN; G = G_; c = c_; }
    __host__ __device__ bool next(int i, Unit& u) const {
        const long L = (long)i * G + c; if (L >= nwg) return false;
        int wgid = (int)L; { const int q = nwg / NXCD, r = nwg % NXCD, xcd = wgid % NXCD, off = wgid / NXCD; wgid = (xcd < r ? xcd * (q + 1) : r * (q + 1) + (xcd - r) * q) + off; }
        const int nig = WGM * nN, gid = wgid / nig, fm = gid * WGM, gsz = (nM - fm) < WGM ? (nM - fm) : WGM;
        u.pm = fm + ((wgid % nig) % gsz); u.pn = (wgid % nig) / gsz; u.be = 0; return true;
    }
    __device__ __forceinline__ void a_ready(const Unit&) const {}
    __device__ __forceinline__ void done(const Unit&) const {}
};

__device__ __forceinline__ unsigned cvt_pk_bf16(float lo, float hi) { unsigned r; asm volatile("v_cvt_pk_bf16_f32 %0, %1, %2" : "=v"(r) : "v"(lo), "v"(hi)); return r; }
typedef float f32x2 __attribute__((ext_vector_type(2)));
struct NoRows { static constexpr bool GATHER = false; __device__ __forceinline__ unsigned operator()(const Unit&, int) const { return 0u; } };
template <class Epi, class Sched, bool ALIGN_EPI = false, bool SP2 = false, class Rows = NoRows>
__device__ __forceinline__ void gemm_phase(PG8_LAS unsigned char* lds, const Gemm g, const Sched& S, const Epi& E, const int tid_in, const Rows& RW = Rows()) {
    const int tid = tid_in, wid = __builtin_amdgcn_readfirstlane(tid >> 6), lane = tid & 63, wr = wid >> 2, wc = wid & 3, fr = lane & 15, fq = lane >> 4;
    const int K = g.K, nt = K / BK;
    unsigned voffA[2], voffB[2];
#pragma unroll
    for (int i = 0; i < 2; ++i) { int R, C; stage_rc(tid * 16 + i * 8192, R, C); const int Rb = Epi::PERM ? ((R & ~31) + perm32(R & 31)) : R;
        voffA[i] = (unsigned)(R * K + C) * 2u; voffB[i] = (unsigned)(Rb * K + C) * 2u; }
    const size_t kstep = (size_t)(BK * 2);
    const size_t hstep = (size_t)HALF * K * 2;
    const size_t tstep = 2 * hstep;
    const unsigned ldsw = (unsigned)wid * 1024u;
    const int aoff = lds_byte(wr * 64 + fr, fq * 8), boff = lds_byte(wc * 32 + fr, fq * 8);
#define PG8_SA(b, h) (((b) * 2 + (h)) * HTB)
#define PG8_SB(b, h) ((4 + (b) * 2 + (h)) * HTB)
#define PG8_STAGE(bufoff, gbase, voff) do { _Pragma("unroll") for (int _i = 0; _i < 2; ++_i) \
        __builtin_amdgcn_global_load_lds((const unsigned*)((const char*)(gbase) + (voff)[_i]), (PG8_LAS unsigned*)(lds + (bufoff) + ldsw + _i * 8192), 16, 0, 0); } while (0)
#define PG8_LDA(dst, b, h) do { _Pragma("unroll") for (int m = 0; m < 4; ++m) _Pragma("unroll") for (int k = 0; k < 2; ++k) dst[m][k] = *(const PG8_LAS bf16x8*)(lds + PG8_SA(b, h) + aoff + m * 2048 + k * 1024); } while (0)
#define PG8_LDB(dst, b, h) do { _Pragma("unroll") for (int n = 0; n < 2; ++n) _Pragma("unroll") for (int k = 0; k < 2; ++k) dst[n][k] = *(const PG8_LAS bf16x8*)(lds + PG8_SB(b, h) + boff + n * 2048 + k * 1024); } while (0)
#define PG8_MMA(ai, bj, At, Bt) do { __builtin_amdgcn_s_setprio(1); _Pragma("unroll") for (int m = 0; m < 4; ++m) _Pragma("unroll") for (int n = 0; n < 2; ++n) _Pragma("unroll") for (int k = 0; k < 2; ++k) \
        acc[ai][bj][m][n] = __builtin_amdgcn_mfma_f32_16x16x32_bf16(Bt[n][k], At[m][k], acc[ai][bj][m][n], 0, 0, 0); __builtin_amdgcn_s_setprio(0); } while (0)
#define PG8_WAIT_V(n) asm volatile("s_waitcnt vmcnt(" #n ")" ::: "memory")
#define PG8_WAIT_L(n) asm volatile("s_waitcnt lgkmcnt(" #n ")" ::: "memory")
#define PG8_BAR __builtin_amdgcn_s_barrier()
#define PG8_SCHED __builtin_amdgcn_sched_barrier(0)
    Unit cur, nxt; int ui = 0;
    if (!S.next(0, cur)) return;
    f32x4 acc[2][2][4][2];
#pragma unroll
    for (int a = 0; a < 2; ++a)
#pragma unroll
        for (int b = 0; b < 2; ++b)
#pragma unroll
            for (int m = 0; m < 4; ++m)
#pragma unroll
                for (int n = 0; n < 2; ++n) { float z0_ = 0.f; asm volatile("" : "+v"(z0_)); acc[a][b][m][n] = (f32x4){z0_, z0_, z0_, z0_}; }
    bf16x8 At[4][2], B0[2][2], B1[2][2];
    const char* cA = Rows::GATHER ? (const char*)g.A : (const char*)g.A + (size_t)cur.pm * tstep; const char* cB = (const char*)g.Bt + (size_t)cur.be * g.bstride + (size_t)cur.pn * tstep;
    int Rr[2], Cc[2];
#pragma unroll
    for (int i = 0; i < 2; ++i) stage_rc(tid * 16 + i * 8192, Rr[i], Cc[i]);
    unsigned voffAh[2][2], voffAn[2][2];
#pragma unroll
    for (int h = 0; h < 2; ++h)
#pragma unroll
        for (int i = 0; i < 2; ++i) { voffAh[h][i] = Rows::GATHER ? RW(cur, h * HALF + Rr[i]) + (unsigned)Cc[i] * 2u : voffA[i] + (unsigned)h * (unsigned)hstep; voffAn[h][i] = voffAh[h][i]; }
    S.a_ready(cur);
    if constexpr (SP2) {
        PG8_STAGE(PG8_SB(0, 0), cB, voffB); PG8_STAGE(PG8_SB(0, 1), cB + hstep, voffB); PG8_STAGE(PG8_SA(0, 0), cA, voffAh[0]); PG8_STAGE(PG8_SA(0, 1), cA, voffAh[1]);
        if (wr == 1) PG8_BAR;
        PG8_WAIT_V(2); PG8_BAR;
        PG8_STAGE(PG8_SB(1, 0), cB + kstep, voffB); PG8_STAGE(PG8_SA(1, 0), cA + kstep, voffAh[0]); PG8_STAGE(PG8_SB(1, 1), cB + hstep + kstep, voffB);
        PG8_WAIT_V(6); PG8_BAR;
    } else {
        PG8_STAGE(PG8_SB(0, 0), cB, voffB); PG8_STAGE(PG8_SA(0, 0), cA, voffAh[0]); PG8_STAGE(PG8_SB(0, 1), cB + hstep, voffB); PG8_STAGE(PG8_SA(0, 1), cA, voffAh[1]);
        if (wr == 1) PG8_BAR;
        PG8_WAIT_V(4); PG8_BAR;
        PG8_STAGE(PG8_SB(1, 0), cB + kstep, voffB); PG8_STAGE(PG8_SA(1, 0), cA + kstep, voffAh[0]); PG8_STAGE(PG8_SB(1, 1), cB + hstep + kstep, voffB);
        PG8_WAIT_V(6); PG8_BAR;
    }
    for (;;) {
        const bool has_next = S.next(ui + 1, nxt);
        const char* nA = Rows::GATHER ? (const char*)g.A : (has_next ? (const char*)g.A + (size_t)nxt.pm * tstep : cA);
        if constexpr (Rows::GATHER) { if (has_next) {
#pragma unroll
            for (int h = 0; h < 2; ++h)
#pragma unroll
                for (int i = 0; i < 2; ++i) voffAn[h][i] = RW(nxt, h * HALF + Rr[i]) + (unsigned)Cc[i] * 2u; } } const char* nB = has_next ? (const char*)g.Bt + (size_t)nxt.be * g.bstride + (size_t)nxt.pn * tstep : cB;
        for (int t = 0; t < nt; t += 2) {
            const bool last = (t == nt - 2); const bool gsel = Rows::GATHER && last && has_next;
            const char* a1 = cA + (size_t)(t + 1) * kstep;
            const char* a2 = last ? nA : cA + (size_t)(t + 2) * kstep; const char* b2 = last ? nB : cB + (size_t)(t + 2) * kstep;
            const char* a3 = a2 + kstep; const char* b3 = b2 + kstep;
            if (last && has_next) S.a_ready(nxt);
            if constexpr (SP2) {
            PG8_LDB(B0, 0, 0); PG8_LDB(B1, 0, 1); PG8_SCHED; PG8_LDA(At, 0, 0); PG8_STAGE(PG8_SA(1, 1), a1, voffAh[1]);
            PG8_WAIT_V(8); PG8_WAIT_L(0); PG8_BAR; PG8_MMA(0, 0, At, B0); PG8_MMA(0, 1, At, B1); PG8_BAR; PG8_SCHED;
            PG8_LDA(At, 0, 1); PG8_STAGE(PG8_SB(0, 0), b2, voffB); PG8_STAGE(PG8_SB(0, 1), b2 + hstep, voffB); PG8_STAGE(PG8_SA(0, 0), a2, (gsel ? voffAn[0] : voffAh[0]));
            PG8_WAIT_V(8); PG8_WAIT_L(0); PG8_BAR; PG8_MMA(1, 0, At, B0); PG8_MMA(1, 1, At, B1); PG8_BAR; PG8_SCHED;
            PG8_LDB(B0, 1, 0); PG8_LDB(B1, 1, 1); PG8_SCHED; PG8_LDA(At, 1, 0); PG8_STAGE(PG8_SA(0, 1), a2, (gsel ? voffAn[1] : voffAh[1]));
            PG8_WAIT_V(8); PG8_WAIT_L(0); PG8_BAR; PG8_MMA(0, 0, At, B0); PG8_MMA(0, 1, At, B1); PG8_BAR; PG8_SCHED;
            PG8_LDA(At, 1, 1); PG8_STAGE(PG8_SB(1, 0), b3, voffB); PG8_STAGE(PG8_SB(1, 1), b3 + hstep, voffB); PG8_STAGE(PG8_SA(1, 0), a3, (gsel ? voffAn[0] : voffAh[0]));
            PG8_WAIT_V(8); PG8_WAIT_L(0); PG8_BAR; PG8_MMA(1, 0, At, B0); PG8_MMA(1, 1, At, B1); PG8_BAR; PG8_SCHED;
            } else {
            PG8_LDB(B0, 0, 0); PG8_SCHED; PG8_LDA(At, 0, 0); PG8_STAGE(PG8_SA(1, 1), a1, voffAh[1]);
            PG8_WAIT_L(8); PG8_BAR; PG8_WAIT_L(0); PG8_MMA(0, 0, At, B0); PG8_BAR; PG8_SCHED;
            PG8_LDB(B1, 0, 1); PG8_STAGE(PG8_SB(0, 0), b2, voffB);
            PG8_BAR; PG8_WAIT_L(0); PG8_MMA(0, 1, At, B1); PG8_BAR;
            PG8_LDA(At, 0, 1); PG8_STAGE(PG8_SA(0, 0), a2, (gsel ? voffAn[0] : voffAh[0]));
            PG8_BAR; PG8_WAIT_L(0); PG8_MMA(1, 0, At, B0); PG8_BAR; PG8_SCHED;
            PG8_STAGE(PG8_SB(0, 1), b2 + hstep, voffB);
            PG8_WAIT_V(6); PG8_BAR; PG8_MMA(1, 1, At, B1); PG8_BAR;
            PG8_LDB(B0, 1, 0); PG8_SCHED; PG8_LDA(At, 1, 0); PG8_STAGE(PG8_SA(0, 1), a2, (gsel ? voffAn[1] : voffAh[1]));
            PG8_WAIT_L(8); PG8_BAR; PG8_WAIT_L(0); PG8_MMA(0, 0, At, B0); PG8_BAR; PG8_SCHED;
            PG8_LDB(B1, 1, 1); PG8_STAGE(PG8_SB(1, 0), b3, voffB);
            PG8_BAR; PG8_WAIT_L(0); PG8_MMA(0, 1, At, B1); PG8_BAR;
            PG8_LDA(At, 1, 1); PG8_STAGE(PG8_SA(1, 0), a3, (gsel ? voffAn[0] : voffAh[0]));
            PG8_BAR; PG8_WAIT_L(0); PG8_MMA(1, 0, At, B0); PG8_BAR; PG8_SCHED;
            PG8_STAGE(PG8_SB(1, 1), b3 + hstep, voffB);
            PG8_WAIT_V(6); PG8_BAR; PG8_MMA(1, 1, At, B1); PG8_BAR;
            }
        }
        if constexpr (ALIGN_EPI) { if (wr == 0) PG8_BAR; }
        if constexpr (!Epi::AFTER_DRAIN) { int l2_; asm volatile("v_mbcnt_lo_u32_b32 %0, -1, 0\n\tv_mbcnt_hi_u32_b32 %0, -1, %0" : "=v"(l2_)); E(acc, cur, wr, wc, l2_ & 15, l2_ >> 4); S.done(cur); }
        if (!has_next) break;
#pragma unroll
        for (int a = 0; a < 2; ++a)
#pragma unroll
            for (int b = 0; b < 2; ++b)
#pragma unroll
                for (int m = 0; m < 4; ++m)
#pragma unroll
                    for (int n = 0; n < 2; ++n) { float z0_ = 0.f; asm volatile("" : "+v"(z0_)); acc[a][b][m][n] = (f32x4){z0_, z0_, z0_, z0_}; }
        cur = nxt; cA = nA; cB = nB; ++ui;
        if constexpr (Rows::GATHER) {
#pragma unroll
            for (int h = 0; h < 2; ++h)
#pragma unroll
                for (int i = 0; i < 2; ++i) voffAh[h][i] = voffAn[h][i]; }
        if constexpr (ALIGN_EPI) { if (wr == 1) PG8_BAR; }
    }
    PG8_WAIT_V(0);
    if constexpr (!ALIGN_EPI) { if (wr == 0) PG8_BAR; }
    PG8_BAR;
    if constexpr (Epi::AFTER_DRAIN) { E.fused(acc, cur, wr, wc, fr, fq, lds, wid, lane); S.done(cur); }
#undef PG8_SA
#undef PG8_SB
#undef PG8_STAGE
#undef PG8_LDA
#undef PG8_LDB
#undef PG8_MMA
#undef PG8_WAIT_V
#undef PG8_WAIT_L
#undef PG8_BAR
#undef PG8_SCHED
}
}
namespace attn_body {
using bf16=__hip_bfloat16;
using bf16x8=__attribute__((ext_vector_type(8)))short;
using s16x4=__attribute__((ext_vector_type(4)))short;
using f32x16=__attribute__((ext_vector_type(16)))float;
using u32x4=__attribute__((ext_vector_type(4)))unsigned;
constexpr int D=64;
constexpr int NW=8,QBLK=32,QB=QBLK*NW,KVBLK=64;
constexpr int ATTN_UNIT_ROWS=QB;
__device__ __forceinline__ int crow(int r,int hi){return (r&3)+8*(r>>2)+4*hi;}
#define SBAR() __builtin_amdgcn_sched_barrier(0)
__device__ __forceinline__ void cmask(f32x16&p0,f32x16&p1,int jb,int qrel,int hi){
  const float NEG=-INFINITY; int kb=64*jb+4*hi;
  #pragma unroll
  for(int r=0;r<16;++r){int kv=kb+(r&3)+8*(r>>2); if(kv>qrel)p0[r]=NEG; if(kv+32>qrel)p1[r]=NEG;}
}

constexpr int NSLOT=3, SLOTB=8192;
constexpr int LDS_K=0, LDS_V=NSLOT*SLOTB, LDS_WS=2*NSLOT*SLOTB, LDS_OST=LDS_WS+NW*64*4, LDS_BYTES=LDS_OST+NW*4096;
constexpr float C2=0.125f*1.4426950408889634f;
__device__ __forceinline__ void glds16(const void*gsrc,unsigned lds_dst){unsigned keep;
  asm volatile("s_mov_b32 %0, m0\n\ts_mov_b32 m0, %2\n\ts_nop 0\n\tglobal_load_lds_dwordx4 %1, off\n\ts_mov_b32 m0, %0":"=&s"(keep):"v"(gsrc),"s"(lds_dst):"memory");}
__device__ __forceinline__ float max3f(float a,float b,float c){float r;asm("v_max3_f32 %0, %1, %2, %3":"=v"(r):"v"(a),"v"(b),"v"(c));return r;}
__device__ __forceinline__ float max2f(float a,float b){float r;asm("v_max_f32_e32 %0, %1, %2":"=v"(r):"v"(a),"v"(b));return r;}
__device__ __forceinline__ float fadd_s(float a,float b){float r;asm("v_add_f32_e32 %0, %1, %2":"=v"(r):"v"(a),"v"(b));return r;}
__device__ __forceinline__ float fsub_s(float a,float b){float r;asm("v_sub_f32_e32 %0, %1, %2":"=v"(r):"v"(a),"v"(b));return r;}
typedef float f32x2_t __attribute__((ext_vector_type(2))); typedef __bf16 bf16x2_t __attribute__((ext_vector_type(2)));
__device__ __forceinline__ unsigned cvtpk_s(float lo,float hi){f32x2_t v={lo,hi};bf16x2_t b=__builtin_convertvector(v,bf16x2_t);return __builtin_bit_cast(unsigned,b);}
#define WAIT_BAR(N) asm volatile("s_waitcnt vmcnt(" #N ") lgkmcnt(0)\n\ts_barrier":::"memory")

__device__ __forceinline__ void qkt(f32x16&p0,f32x16&p1,const char*Kslot,const bf16x8*qr,const f32x16&negm,int r32,int hi){
  const char*kb=Kslot+hi*1024+r32*16;
  #pragma unroll
  for(int d0=0;d0<4;++d0){
    const bf16x8 b0=*reinterpret_cast<const bf16x8*>(kb+d0*2048);
    const bf16x8 b1=*reinterpret_cast<const bf16x8*>(kb+d0*2048+512);
    if(d0==0){p0=__builtin_amdgcn_mfma_f32_32x32x16_bf16(b0,qr[0],negm,0,0,0);p1=__builtin_amdgcn_mfma_f32_32x32x16_bf16(b1,qr[0],negm,0,0,0);}
    else{p0=__builtin_amdgcn_mfma_f32_32x32x16_bf16(b0,qr[d0],p0,0,0,0);p1=__builtin_amdgcn_mfma_f32_32x32x16_bf16(b1,qr[d0],p1,0,0,0);}}
}
typedef __attribute__((address_space(3))) const char* lds_cptr;
typedef short v4i16_t __attribute__((ext_vector_type(4)));
__device__ __forceinline__ void kload8(bf16x8*kf,lds_cptr kp){
  kf[0]=*(const __attribute__((address_space(3))) bf16x8*)(kp);      kf[1]=*(const __attribute__((address_space(3))) bf16x8*)(kp+512);
  kf[2]=*(const __attribute__((address_space(3))) bf16x8*)(kp+2048); kf[3]=*(const __attribute__((address_space(3))) bf16x8*)(kp+2560);
  kf[4]=*(const __attribute__((address_space(3))) bf16x8*)(kp+4096); kf[5]=*(const __attribute__((address_space(3))) bf16x8*)(kp+4608);
  kf[6]=*(const __attribute__((address_space(3))) bf16x8*)(kp+6144); kf[7]=*(const __attribute__((address_space(3))) bf16x8*)(kp+6656);
}
__device__ __forceinline__ void kload2(bf16x8*kf,lds_cptr kp,int j){ kf[2*j]=*(const __attribute__((address_space(3))) bf16x8*)(kp+j*2048); kf[2*j+1]=*(const __attribute__((address_space(3))) bf16x8*)(kp+j*2048+512); }
__device__ __forceinline__ s16x4 vtr(lds_cptr p){ return __builtin_bit_cast(s16x4,__builtin_amdgcn_ds_read_tr16_b64_v4i16((__attribute__((address_space(3))) v4i16_t*)p)); }
__device__ __forceinline__ float rowmax(const f32x16&p0,const f32x16&p1){
  float a=max3f(p0[0],p0[1],p1[0]),b=max3f(p0[2],p0[3],p1[1]);a=max3f(a,p1[2],p1[3]);
  #pragma unroll
  for(int r=4;r<16;r+=4){a=max3f(a,p0[r],p0[r+1]);b=max3f(b,p0[r+2],p0[r+3]);a=max3f(a,p1[r],p1[r+1]);b=max3f(b,p1[r+2],p1[r+3]);}
  const float m=max2f(a,b);
  auto rr=__builtin_amdgcn_permlane32_swap(__float_as_uint(m),__float_as_uint(m),false,false);
  return max2f(__uint_as_float(rr[0]),__uint_as_float(rr[1]));
}
__device__ __forceinline__ void pv(f32x16*o,int vb,bf16x8 pa0,bf16x8 pa1,bf16x8 pa2,bf16x8 pa3){
  #pragma unroll
  for(int d0=0;d0<2;++d0){s16x4 lo[4],hi[4];
    #pragma unroll
    for(int ks=0;ks<4;++ks){
      asm volatile("ds_read_b64_tr_b16 %0,%1 offset:%c2":"=&v"(lo[ks]):"v"(vb),"i"(d0*4096+ks*1024):"memory");
      asm volatile("ds_read_b64_tr_b16 %0,%1 offset:%c2":"=&v"(hi[ks]):"v"(vb),"i"(d0*4096+ks*1024+512):"memory");}
    asm volatile("s_waitcnt lgkmcnt(0)":::"memory");SBAR();
    #define PK(k) (bf16x8){lo[k][0],lo[k][1],lo[k][2],lo[k][3],hi[k][0],hi[k][1],hi[k][2],hi[k][3]}
    o[d0]=__builtin_amdgcn_mfma_f32_32x32x16_bf16(pa0,PK(0),o[d0],0,0,0);
    o[d0]=__builtin_amdgcn_mfma_f32_32x32x16_bf16(pa1,PK(1),o[d0],0,0,0);
    o[d0]=__builtin_amdgcn_mfma_f32_32x32x16_bf16(pa2,PK(2),o[d0],0,0,0);
    o[d0]=__builtin_amdgcn_mfma_f32_32x32x16_bf16(pa3,PK(3),o[d0],0,0,0);
    #undef PK
  }
}

#ifndef ATTN_STORE16
#define ATTN_STORE16(p,v) (*(u32x4*)(p)=(v))
#endif
template<int THRL,int PIN,int POUT> __device__ __forceinline__ void attn_unit(int qb,const bf16*Qh,const bf16*__restrict__ Kh,const bf16*__restrict__ Vh,bf16*Oh,char*shm,const int wid_in){
  constexpr int DM=PIN;
  int lane; asm volatile("v_mbcnt_lo_u32_b32 %0, -1, 0\n\tv_mbcnt_hi_u32_b32 %0, -1, %0" : "=v"(lane));
  const int wid=wid_in; const int tid=wid*64+lane; const int r32=lane&31,hi=lane>>5;
  const int q0=qb*QB;
  const bf16*Qw=Qh+(long)(q0+wid*QBLK)*DM;
  const unsigned lds0=(unsigned)(uintptr_t)shm;
  float*wsf=(float*)(shm+LDS_WS)+wid*64;
  const bf16*ksrc=Kh+(long)lane*DM+wid*8;
  const bf16*vsrc=Vh+(long)(16*(wid&3)+(lane>>2))*DM+(wid>>2)*32+(lane&3)*8;
  const unsigned kdst=lds0+LDS_K+wid*1024, vdst=lds0+LDS_V+wid*1024;
  #define DMA_K(t,slot) glds16(ksrc+(long)(t)*KVBLK*DM,(unsigned)__builtin_amdgcn_readfirstlane(kdst+(slot)))
  #define DMA_V(t,slot) glds16(vsrc+(long)(t)*KVBLK*DM,(unsigned)__builtin_amdgcn_readfirstlane(vdst+(slot)))
  const int vb0=(int)(lds0+LDS_V)+((lane>>4)&1)*32+(lane&3)*8+(4*hi+((lane&15)>>2))*64;
  const char*Kbase=shm+LDS_K; bf16x8 kf[8];
  const lds_cptr shm3=(lds_cptr)shm; const lds_cptr kp0=shm3+LDS_K+hi*1024+r32*16; const lds_cptr vp0=shm3+LDS_V+((lane>>4)&1)*32+(lane&3)*8+(4*hi+((lane&15)>>2))*64;
  const int NT=(q0+QB)/KVBLK;
  DMA_K(0,0);DMA_V(0,0);DMA_K(1,SLOTB);
  bf16x8 qr[4];
  #pragma unroll
  for(int d0=0;d0<4;++d0)qr[d0]=*reinterpret_cast<const bf16x8*>(&Qw[(long)r32*DM+d0*16+hi*8]);
  float mhat=0.f,l_reg=0.f;f32x16 o[2];f32x16 negm;{float z0_=0.f;asm volatile("":"+v"(z0_));
  #pragma unroll
  for(int r=0;r<16;++r){o[0][r]=z0_;o[1][r]=z0_;negm[r]=z0_;}}asm volatile("":"+v"(negm));
  const int qrel=wid*QBLK+r32;
  #define CMASK(P0,P1,t) do{int jb_=(t)-(NT-4); if(jb_>=0)cmask(P0,P1,jb_,qrel,hi);}while(0)
  bool resc=false;
  #define START(P0,P1) do{ const float rm=rowmax(P0,P1); resc=false; \
    { const float dl=rm; mhat=fadd_s(mhat,dl); \
      _Pragma("unroll") for(int r=0;r<16;++r){P0[r]=fsub_s(P0[r],dl);P1[r]=fsub_s(P1[r],dl);} \
      _Pragma("unroll") for(int r=0;r<16;++r)negm[r]=-mhat; asm volatile("":"+v"(negm)); } \
    _Pragma("unroll") for(int r=0;r<16;++r)P0[r]=__builtin_amdgcn_exp2f(P0[r]); }while(0)
  #define RESC() do{ if(resc){ asm volatile("s_waitcnt lgkmcnt(0)":::"memory"); \
      _Pragma("unroll") for(int d_=0;d_<2;++d_) _Pragma("unroll") for(int r=0;r<16;++r)o[d_][r]*=wsf[crow(r,hi)]; } }while(0)
  f32x16 pA0,pA1,pB0,pB1;
  int sl_prev=0,sl_cur=0,sl_next=SLOTB;
  #define ROT() do{sl_prev=sl_cur;sl_cur=sl_next;sl_next=(sl_next==(NSLOT-1)*SLOTB)?0:sl_next+SLOTB;}while(0)
  DMA_K(2,2*SLOTB);
  WAIT_BAR(3);
  qkt(pA0,pA1,Kbase,qr,negm,r32,hi);asm volatile("s_nop 15\n\ts_nop 7":"+v"(pA0),"+v"(pA1));CMASK(pA0,pA1,0);
  START(pA0,pA1);
  _Pragma("unroll") for(int r=0;r<16;++r)pA1[r]=__builtin_amdgcn_exp2f(pA1[r]);
  WAIT_BAR(0);
  DMA_K(3,0);DMA_V(1,SLOTB);
  ROT();
  kload8(kf,kp0+sl_cur);
  WAIT_BAR(2);
  s16x4 vlo[8],vhi[8]; u32x4 pw0,pw1,pw2,pw3;
  #define PKW(P,B) cvtpk_s(P[B],P[B+1])
  #define PAF(k) __builtin_bit_cast(bf16x8,pw##k)
  #define VFR(i) (bf16x8){vlo[i][0],vlo[i][1],vlo[i][2],vlo[i][3],vhi[i][0],vhi[i][1],vhi[i][2],vhi[i][3]}
  #define PIN(x) asm volatile("":"+v"(x))
  #define MX3(a,b,c) __builtin_fmaxf(__builtin_fmaxf((a),(b)),(c))
  #define GAPA(MF,A0,A1,A2,A3,W0,W1,PW) do{ MF; sacc+=A0; sacc+=A1; sacc+=A2; sacc+=A3; PIN(sacc); W0; W1; PIN(PW); SBAR(); }while(0)
  #define EX(v) __builtin_amdgcn_exp2f(v)
  #define GAPB(MF,X,B) do{ MF; X[B]=EX(X[B]); X[B+1]=EX(X[B+1]); X[B+2]=EX(X[B+2]); X[B+3]=EX(X[B+3]); PIN(X); SBAR(); }while(0)
  #define VRD(i) do{ vlo[i]=vtr(vp_+(((i)>>2)*4096+((i)&3)*1024)); vhi[i]=vtr(vp_+(((i)>>2)*4096+((i)&3)*1024+512)); }while(0)
  #define KRD(G,j) do{ if(G){ kload2(kf,kp0+sl_next,j); SBAR(); } }while(0)
  #define STEP(C0,C1,P0,P1,t,GK,GV,GL) do{ SBAR(); \
    const lds_cptr vp_=vp0+sl_prev; \
    VRD(0); SBAR(); float sacc=(P0[0]+P0[1]); \
    GAPA(C0=__builtin_amdgcn_mfma_f32_32x32x16_bf16(kf[0],qr[0],negm,0,0,0), P0[2],P0[3],P0[4],P0[5],     pw0[0]=PKW(P0,0), pw0[1]=PKW(P0,2), pw0); \
    VRD(4); SBAR(); GAPA(C1=__builtin_amdgcn_mfma_f32_32x32x16_bf16(kf[1],qr[0],negm,0,0,0), P0[6],P0[7],P0[8],P0[9],     pw0[2]=PKW(P0,4), pw0[3]=PKW(P0,6), pw0); \
    VRD(1); SBAR(); GAPA(C0=__builtin_amdgcn_mfma_f32_32x32x16_bf16(kf[2],qr[1],C0,0,0,0),   P0[10],P0[11],P0[12],P0[13], pw1[0]=PKW(P0,8), pw1[1]=PKW(P0,10), pw1); \
    VRD(5); SBAR(); GAPA(C1=__builtin_amdgcn_mfma_f32_32x32x16_bf16(kf[3],qr[1],C1,0,0,0),   P0[14],P0[15],P1[0],P1[1],   pw1[2]=PKW(P0,12),pw1[3]=PKW(P0,14), pw1); \
    VRD(2); SBAR(); GAPA(C0=__builtin_amdgcn_mfma_f32_32x32x16_bf16(kf[4],qr[2],C0,0,0,0),   P1[2],P1[3],P1[4],P1[5],     pw2[0]=PKW(P1,0), pw2[1]=PKW(P1,2), pw2); \
    VRD(6); SBAR(); GAPA(C1=__builtin_amdgcn_mfma_f32_32x32x16_bf16(kf[5],qr[2],C1,0,0,0),   P1[6],P1[7],P1[8],P1[9],     pw2[2]=PKW(P1,4), pw2[3]=PKW(P1,6), pw2); \
    VRD(3); SBAR(); GAPA(C0=__builtin_amdgcn_mfma_f32_32x32x16_bf16(kf[6],qr[3],C0,0,0,0),   P1[10],P1[11],P1[12],P1[13], pw3[0]=PKW(P1,8), pw3[1]=PKW(P1,10), pw3); \
    VRD(7); SBAR(); GAPA(C1=__builtin_amdgcn_mfma_f32_32x32x16_bf16(kf[7],qr[3],C1,0,0,0),   P1[14],P1[15],0.f,0.f,       pw3[2]=PKW(P1,12),pw3[3]=PKW(P1,14), pw3); \
    l_reg+=sacc; \
    if(GK){DMA_K((t)+3,sl_cur);} if(GV){DMA_V((t)+1,sl_next);} \
    CMASK(C0,C1,t); \
    { float a=MX3(C0[0],C0[1],C1[0]),b=MX3(C0[2],C0[3],C1[1]); a=MX3(a,C1[2],C1[3]); \
      _Pragma("unroll") for(int r=4;r<16;r+=4){a=MX3(a,C0[r],C0[r+1]);b=MX3(b,C0[r+2],C0[r+3]);a=MX3(a,C1[r],C1[r+1]);b=MX3(b,C1[r+2],C1[r+3]);} \
      float rm=__builtin_fmaxf(a,b); { auto rr=__builtin_amdgcn_permlane32_swap(__float_as_uint(rm),__float_as_uint(rm),false,false); rm=__builtin_fmaxf(__uint_as_float(rr[0]),__uint_as_float(rr[1])); } \
      resc=false; \
      if(__builtin_expect(__any(rm>(float)THRL),0)){ const float dl=__builtin_fmaxf(rm,0.f); mhat+=dl; \
        _Pragma("unroll") for(int r=0;r<16;++r){C0[r]-=dl;C1[r]-=dl;} \
        _Pragma("unroll") for(int r=0;r<16;++r)negm[r]=-mhat; asm volatile("":"+v"(negm)); \
        const float f=__builtin_amdgcn_exp2f(-dl); l_reg*=f; if(hi==0)wsf[r32]=f; resc=true; } } \
    SBAR(); \
    GAPB(o[0]=__builtin_amdgcn_mfma_f32_32x32x16_bf16(PAF(0),VFR(0),o[0],0,0,0), C0,0); \
    GAPB(o[1]=__builtin_amdgcn_mfma_f32_32x32x16_bf16(PAF(0),VFR(4),o[1],0,0,0), C0,4); \
    KRD(GL,0); GAPB(o[0]=__builtin_amdgcn_mfma_f32_32x32x16_bf16(PAF(1),VFR(1),o[0],0,0,0), C0,8); \
    KRD(GL,1); GAPB(o[1]=__builtin_amdgcn_mfma_f32_32x32x16_bf16(PAF(1),VFR(5),o[1],0,0,0), C0,12); \
    KRD(GL,2); GAPB(o[0]=__builtin_amdgcn_mfma_f32_32x32x16_bf16(PAF(2),VFR(2),o[0],0,0,0), C1,0); \
    KRD(GL,3); GAPB(o[1]=__builtin_amdgcn_mfma_f32_32x32x16_bf16(PAF(2),VFR(6),o[1],0,0,0), C1,4); \
    GAPB(o[0]=__builtin_amdgcn_mfma_f32_32x32x16_bf16(PAF(3),VFR(3),o[0],0,0,0), C1,8); \
    GAPB(o[1]=__builtin_amdgcn_mfma_f32_32x32x16_bf16(PAF(3),VFR(7),o[1],0,0,0), C1,12); \
    }while(0)
  int t=1;
  #undef CMASK
  #define CMASK(P0,P1,t) do{}while(0)
  for(;t+5<NT;t+=2){
    STEP(pB0,pB1,pA0,pA1,t,true,true,true);     WAIT_BAR(2); RESC(); ROT();
    STEP(pA0,pA1,pB0,pB1,t+1,true,true,true);   WAIT_BAR(2); RESC(); ROT();
  }
  #undef CMASK
  #define CMASK(P0,P1,t) do{int jb_=(t)-(NT-4); if(jb_>=0)cmask(P0,P1,jb_,qrel,hi);}while(0)
  #define ENDW(tt) do{ if((tt)+3<NT){WAIT_BAR(2);} else if((tt)+2<NT){WAIT_BAR(1);} else {WAIT_BAR(0);} }while(0)
  for(;t+1<NT;t+=2){
    STEP(pB0,pB1,pA0,pA1,t,(t+3<NT),(t+1<NT),(t+1<NT));       ENDW(t);   RESC(); ROT();
    STEP(pA0,pA1,pB0,pB1,t+1,(t+4<NT),(t+2<NT),(t+2<NT));     ENDW(t+1); RESC(); ROT();
  }
  STEP(pB0,pB1,pA0,pA1,NT-1,false,false,false); RESC();
  { float sacc=pB0[0]+pB0[1]; _Pragma("unroll") for(int r=2;r<16;++r)sacc+=pB0[r]; _Pragma("unroll") for(int r=0;r<16;++r)sacc+=pB1[r]; l_reg+=sacc;
    pw0=(u32x4){PKW(pB0,0),PKW(pB0,2),PKW(pB0,4),PKW(pB0,6)};pw1=(u32x4){PKW(pB0,8),PKW(pB0,10),PKW(pB0,12),PKW(pB0,14)};pw2=(u32x4){PKW(pB1,0),PKW(pB1,2),PKW(pB1,4),PKW(pB1,6)};pw3=(u32x4){PKW(pB1,8),PKW(pB1,10),PKW(pB1,12),PKW(pB1,14)};
    SBAR(); pv(o,vb0+sl_cur,PAF(0),PAF(1),PAF(2),PAF(3)); }
  #undef PKW
  #undef PAF
  #undef VFR
  #undef PIN
  #undef MX3
  #undef GAPA
  #undef GAPB
  #undef EX
  #undef VRD
  #undef KRD
  #undef STEP
  #undef ENDW
  {auto rr=__builtin_amdgcn_permlane32_swap(__float_as_uint(l_reg),__float_as_uint(l_reg),false,false);l_reg=__uint_as_float(rr[0])+__uint_as_float(rr[1]);}
  if(hi==0)wsf[32+r32]=l_reg;asm volatile("s_waitcnt lgkmcnt(0)":::"memory");
  float rli[16];
  #pragma unroll
  for(int r=0;r<16;++r)rli[r]=__builtin_amdgcn_rcpf(wsf[32+crow(r,hi)]);
  bf16*Ow=Oh+(long)(q0+wid*QBLK)*POUT;
  { bf16*stg=(bf16*)(shm+LDS_OST)+wid*2048;
    #pragma unroll
    for(int r=0;r<16;++r){const int orow=crow(r,hi);
      #pragma unroll
      for(int d0=0;d0<2;++d0)stg[orow*64+d0*32+r32]=__float2bfloat16(o[d0][r]*rli[r]);}
    asm volatile("s_waitcnt lgkmcnt(0)":::"memory");
    #pragma unroll
    for(int i=0;i<4;++i){const int row=i*8+(lane>>3),ch=lane&7; const u32x4 v=*(const u32x4*)(stg+row*64+ch*8); ATTN_STORE16(Ow+(long)row*POUT+ch*8,v);} }
  asm volatile("s_waitcnt lgkmcnt(0)\n\ts_barrier":::"memory");
  #undef DMA_K
  #undef DMA_V
  #undef CMASK
  #undef START
  #undef RESC
  #undef ROT
}
constexpr int ATTN_LDS_BYTES=LDS_BYTES;
#undef SBAR
#undef WAIT_BAR
}

#define LAS __attribute__((address_space(3)))
typedef unsigned short bf16_t;
typedef float f32x4 __attribute__((ext_vector_type(4)));
typedef unsigned u32x4 __attribute__((ext_vector_type(4)));
typedef unsigned u32x2 __attribute__((ext_vector_type(2)));
typedef float f32x2 __attribute__((ext_vector_type(2)));
typedef _Float16 f16x8 __attribute__((ext_vector_type(8)));
typedef _Float16 f16x4 __attribute__((ext_vector_type(4)));

constexpr int NB = 2, S = 16384, T = NB * S, D = 1024, DEPTH = 4;
constexpr int EV_N = 3368, EV_NP = 3584, EV_ZP = 3072, OD_N = 2048;
constexpr float EPS = 1e-6f;
constexpr float LOG2E = 1.4426950408889634f;
constexpr float QSCALE = 0.125f * LOG2E;
constexpr int NWAVES = 8, NTHREADS = 512;
constexpr int LDS_BYTES = 163840;
constexpr int LDS_MISC = 131072;
constexpr int LDS_BARW = LDS_BYTES - 64;
constexpr int LDS_PTBL = LDS_BYTES - 512;

constexpr size_t MiB = 1u << 20;
constexpr size_t WS_CTL = 0, CTL_ZERO_BYTES = 1 * MiB;
constexpr size_t WS_MOD = 1 * MiB;
constexpr size_t WS_MODP = 1 * MiB + 256 * 1024;
constexpr size_t WS_ROPE = 2 * MiB;
constexpr size_t WS_S5A = 4 * MiB;
constexpr size_t WS_S5B = 4 * MiB + 64 * 1024;
constexpr size_t WS_LAM = 6 * MiB;
constexpr size_t WS_KM = 6 * MiB + 4096;
constexpr size_t WS_WRH = 6 * MiB + 512 * 1024;
constexpr size_t WS_KMH = 7 * MiB + 512 * 1024;
constexpr size_t WS_WEVIN = 8 * MiB;
constexpr size_t WS_WEVOUT = 22 * MiB;
constexpr size_t WS_WODIN = 26 * MiB;
constexpr size_t WS_WODOUT = 34 * MiB;
constexpr size_t WS_WGLU = 38 * MiB;
constexpr size_t WS_W13 = 40 * MiB;
constexpr size_t WS_W2 = 104 * MiB;
constexpr size_t WS_H = 136 * MiB;
constexpr size_t WS_O = 200 * MiB;
constexpr size_t WS_Z = 264 * MiB;
constexpr size_t WS_XG = 264 * MiB;
constexpr size_t WS_Y = 264 * MiB;
constexpr size_t WS_HID = 408 * MiB;
constexpr size_t WS_IQ = 456 * MiB;
constexpr size_t WS_YG = 456 * MiB;
constexpr size_t WS_IKW = 488 * MiB;
constexpr size_t WS_IQH = 496 * MiB;
constexpr size_t WS_IKH = 512 * MiB;
constexpr size_t WS_IW = 514 * MiB;
constexpr size_t WS_SEL = 516 * MiB;
constexpr size_t WS_YMIX = 548 * MiB;
constexpr size_t WS_LTOK = 612 * MiB;
constexpr size_t WS_TOKES = 616 * MiB;
constexpr size_t WS_TOKW = 617 * MiB;
constexpr size_t WS_TOKROW = 618 * MiB;
constexpr size_t WS_UG = 516 * MiB;
constexpr size_t WS_S5E = 496 * MiB;
constexpr size_t WS_S5HC = 488 * MiB;
constexpr size_t WS_S5KT = 620 * MiB;
constexpr size_t WS_S5WT = 624 * MiB;
constexpr size_t WS_S5A2 = 640 * MiB;
constexpr size_t WS_S5PW = 656 * MiB;
constexpr size_t WS_MLIST = 660 * MiB;
constexpr size_t WS_MPO = 724 * MiB;
constexpr size_t WS_MML = 852 * MiB;
constexpr size_t WS_MASKW = 724 * MiB;
constexpr size_t WS_NSEL = 860 * MiB;
constexpr size_t WS_XB = 862 * MiB;
constexpr size_t WS_END = 926 * MiB;
constexpr int XG_ROWS = 73728;
constexpr int CW_BAR = 4096;
constexpr int CW_MCNT = 16384;
constexpr int CW_CNT = 8192;

#define XB_TMO      128
#define XB_XCNT(j)  (256  + 64 * (j))
#define XB_XSUB(j)  (1280 + 64 * (j))
#define XB_XGEN(j)  (2304 + 64 * (j))
#define XB_TOP      3328
#define XB_TOPGEN   3392
#define XCD_BAR_WORDS 3456
#define XB_SPIN_CAP (1u << 24)

__device__ __forceinline__ unsigned xb_ld(unsigned* p)              { return __hip_atomic_load(p, __ATOMIC_RELAXED, __HIP_MEMORY_SCOPE_AGENT); }
__device__ __forceinline__ unsigned xb_add(unsigned* p, unsigned v) { return __hip_atomic_fetch_add(p, v, __ATOMIC_RELAXED, __HIP_MEMORY_SCOPE_AGENT); }
__device__ __forceinline__ unsigned xb_xcc_id() { return (unsigned)__builtin_amdgcn_s_getreg((3 << 11) | 20) & 0xFu; }
#define XB_SPIN(cond, bar) do { unsigned _sp = 0; while (cond) { __builtin_amdgcn_s_sleep(1); \
    if ((++_sp & 255u) == 0u) { if (xb_ld(&(bar)[XB_TMO])) break; if (_sp > XB_SPIN_CAP) { atomicAdd(&(bar)[XB_TMO], 1u); break; } } } } while (0)

struct XcdBarrier { unsigned* bar; unsigned x; volatile LAS unsigned* st; };

__device__ __forceinline__ XcdBarrier xcd_barrier_post(unsigned* bar, volatile LAS unsigned* st, bool leader) {
    XcdBarrier b; b.bar = bar; b.x = xb_xcc_id(); b.st = st;
    if (leader) (void)xb_add(&bar[XB_XCNT(b.x)], 1u);
    return b;
}
__device__ __forceinline__ void xcd_barrier_complete(unsigned* bar, unsigned x, unsigned& nloc, unsigned& nx) {
    const unsigned G = gridDim.x * gridDim.y * gridDim.z;
    unsigned sum, cnt, mine, sp = 0u;
    for (;;) {
        sum = 0u; cnt = 0u; mine = 0u;
#pragma unroll
        for (unsigned j = 0; j < 16; ++j) { const unsigned c = xb_ld(&bar[XB_XCNT(j)]); sum += c; cnt += (c > 0u) ? 1u : 0u; mine = (j == x) ? c : mine; }
        if (sum == G) break;
        __builtin_amdgcn_s_sleep(1);
        if ((++sp & 255u) == 0u) { if (xb_ld(&bar[XB_TMO])) break; if (sp > XB_SPIN_CAP) { atomicAdd(&bar[XB_TMO], 1u); break; } }
    }
    nloc = mine > 0u ? mine : 1u; nx = cnt > 0u ? cnt : 1u;
}
__device__ __forceinline__ void xcd_barrier(const XcdBarrier& b, bool leader) {
    asm volatile("s_waitcnt vmcnt(0)" ::: "memory");
    __syncthreads();
    if (leader) {
        unsigned* bar = b.bar;
        __builtin_amdgcn_s_waitcnt(0);
        unsigned nloc = b.st[0], nx = b.st[1];
        if (nloc == 0u) { xcd_barrier_complete(bar, b.x, nloc, nx); b.st[0] = nloc; b.st[1] = nx; }
        const unsigned old = xb_add(&bar[XB_XSUB(b.x)], 1u);
        const unsigned gen = old / nloc;
        if (old + 1u == (gen + 1u) * nloc) {
            __builtin_amdgcn_fence(__ATOMIC_RELEASE, "agent");
            asm volatile("s_waitcnt vmcnt(0)" ::: "memory");
            const unsigned og = xb_add(&bar[XB_TOP], 1u);
            const unsigned tg = og / nx;
            if (og + 1u == (tg + 1u) * nx) xb_add(&bar[XB_TOPGEN], 1u);
            else XB_SPIN(xb_ld(&bar[XB_TOPGEN]) == tg, bar);
            __builtin_amdgcn_fence(__ATOMIC_ACQUIRE, "agent");
            xb_add(&bar[XB_XGEN(b.x)], 1u);
            asm volatile("s_waitcnt vmcnt(0)" ::: "memory");
        } else {
            XB_SPIN(xb_ld(&bar[XB_XGEN(b.x)]) == gen, bar);
            __builtin_amdgcn_fence(__ATOMIC_ACQUIRE, "agent");
            asm volatile("s_waitcnt vmcnt(0)" ::: "memory");
        }
    }
    __syncthreads();
}

#define LDS_WAIT() asm volatile("s_waitcnt lgkmcnt(0)" ::: "memory")
__device__ __forceinline__ float bflo(unsigned w) { return __uint_as_float(w << 16); }
__device__ __forceinline__ float bfhi(unsigned w) { return __uint_as_float(w & 0xffff0000u); }
__device__ __forceinline__ unsigned pk2(float lo, float hi) { typedef float f32x2_ __attribute__((ext_vector_type(2))); typedef __bf16 bf16x2_ __attribute__((ext_vector_type(2))); const f32x2_ v = {lo, hi}; return __builtin_bit_cast(unsigned, __builtin_convertvector(v, bf16x2_)); }
__device__ __forceinline__ unsigned f2bf(float f) { return pk2(f, 0.f) & 0xffffu; }
__device__ __forceinline__ float shx_(float v, int m, int lane) { return __int_as_float(__builtin_amdgcn_ds_bpermute((lane ^ m) << 2, __float_as_int(v))); }
__device__ __forceinline__ unsigned shi_(unsigned v, int src) { return (unsigned)__builtin_amdgcn_ds_bpermute(src << 2, (int)v); }
#define SHX(v, m) shx_((v), (m), lane)
__device__ __forceinline__ float dpp_xor1(float v) { return __int_as_float(__builtin_amdgcn_update_dpp(0, __float_as_int(v), 0xB1, 0xF, 0xF, true)); }
__device__ __forceinline__ float dpp_xor2(float v) { return __int_as_float(__builtin_amdgcn_update_dpp(0, __float_as_int(v), 0x4E, 0xF, 0xF, true)); }
__device__ __forceinline__ float half_sum(float v) { const auto r = __builtin_amdgcn_permlane32_swap(__float_as_uint(v), __float_as_uint(v), false, false); return __uint_as_float(r[0]) + __uint_as_float(r[1]); }
__device__ __forceinline__ float half_max(float v) { const auto r = __builtin_amdgcn_permlane32_swap(__float_as_uint(v), __float_as_uint(v), false, false); return fmaxf(__uint_as_float(r[0]), __uint_as_float(r[1])); }
__device__ __forceinline__ float wave_sum_(float v, int lane) {
    v += dpp_xor1(v); v += dpp_xor2(v); v += shx_(v, 4, lane); v += shx_(v, 8, lane); v += shx_(v, 16, lane); return half_sum(v);
}

#define wave_sum(v) wave_sum_((v), lane)
__device__ __forceinline__ float wave_max_(float v, int lane) {
#pragma unroll
    for (int o = 1; o < 64; o <<= 1) v = fmaxf(v, shx_(v, o, lane));
    return v;
}
__device__ __forceinline__ bool qk_bounded(const float* gq, const float* gk, int lane) {
    const float a = wave_max_(fabsf(gq[lane]), lane), b = wave_max_(fabsf(gk[lane]), lane);
    return 64.0f * QSCALE * a * b <= 60.0f;
}
__device__ __forceinline__ void unpack8(const u32x4 w, float (&v)[8]) {
    v[0] = bflo(w.x); v[1] = bfhi(w.x); v[2] = bflo(w.y); v[3] = bfhi(w.y); v[4] = bflo(w.z); v[5] = bfhi(w.z); v[6] = bflo(w.w); v[7] = bfhi(w.w);
}
__device__ __forceinline__ u32x4 pack8(const float (&v)[8]) { u32x4 w; w.x = pk2(v[0], v[1]); w.y = pk2(v[2], v[3]); w.z = pk2(v[4], v[5]); w.w = pk2(v[6], v[7]); return w; }
__device__ __forceinline__ float gelu_tanh(float y) {
    const float z = 0.7978845608028654f * (y + 0.044715f * y * y * y);
    const float e = __builtin_amdgcn_exp2f(2.885390081777927f * z);
    const float th = 1.0f - 2.0f * __builtin_amdgcn_rcpf(e + 1.0f);
    return 0.5f * y * (1.0f + th);
}
__device__ __forceinline__ float sigmoidf_(float v) { return __builtin_amdgcn_rcpf(1.0f + __builtin_amdgcn_exp2f(-1.4426950408889634f * v)); }
__device__ __forceinline__ unsigned ordkey(float f) { const unsigned u = __float_as_uint(f); return u ^ ((unsigned)((int)u >> 31) | 0x80000000u); }

struct EpiPlain {
    static constexpr bool PERM = true, AFTER_DRAIN = false;
    bf16_t* O; int ldc;
    __device__ __forceinline__ void operator()(const pg8::f32x4 (&acc)[2][2][4][2], const pg8::Unit& u, int wr, int wc, int fr, int fq) const {
        const int row0 = u.pm * 256 + wr * 64 + fr, col0 = u.pn * 256 + wc * 32 + 8 * fq;
#pragma unroll
        for (int ai = 0; ai < 2; ++ai)
#pragma unroll
            for (int m = 0; m < 4; ++m) { bf16_t* rowp = O + (size_t)(row0 + ai * 128 + m * 16) * ldc + col0;
#pragma unroll
                for (int bj = 0; bj < 2; ++bj) { const pg8::f32x4 v0 = acc[ai][bj][m][0], v1 = acc[ai][bj][m][1];
                    u32x4 w; w.x = pk2(v0[0], v0[1]); w.y = pk2(v0[2], v0[3]); w.z = pk2(v1[0], v1[1]); w.w = pk2(v1[2], v1[3]);
                    *(u32x4*)(rowp + bj * 128) = w; } }
    }
};
__device__ __forceinline__ void epi_khead(const pg8::f32x4 (&acc)[2][2][4][2], bf16_t* Z, int ldz, int colbase, const float* gain, const float* COSH, const float* SINH, int row0, int wc, int fr, int fq) {
    const int lane = fr + 16 * fq;
    float g[2][8];
#pragma unroll
    for (int bj = 0; bj < 2; ++bj)
#pragma unroll
        for (int e = 0; e < 8; ++e) g[bj][e] = gain[bj * 32 + 8 * fq + e];
#pragma unroll
    for (int ai = 0; ai < 2; ++ai)
#pragma unroll
      for (int mp = 0; mp < 4; mp += 2) {
        f32x4 csv[2][2], snv[2][2];
#pragma unroll
        for (int mm = 0; mm < 2; ++mm) { const int pos = (row0 + ai * 128 + (mp + mm) * 16) & (S - 1);
            csv[mm][0] = *(const f32x4*)(COSH + pos * 8); csv[mm][1] = *(const f32x4*)(COSH + pos * 8 + 4); snv[mm][0] = *(const f32x4*)(SINH + pos * 8); snv[mm][1] = *(const f32x4*)(SINH + pos * 8 + 4); }
        __builtin_amdgcn_sched_barrier(0);
#pragma unroll
        for (int mm = 0; mm < 2; ++mm) { const int m = mp + mm; const int row = row0 + ai * 128 + m * 16;
            float v[2][8]; float ss = 0.f;
#pragma unroll
            for (int bj = 0; bj < 2; ++bj)
#pragma unroll
                for (int e = 0; e < 4; ++e) { v[bj][e] = acc[ai][bj][m][0][e]; v[bj][4 + e] = acc[ai][bj][m][1][e]; ss += v[bj][e] * v[bj][e] + v[bj][4 + e] * v[bj][4 + e]; }
            ss += shx_(ss, 16, lane); ss = half_sum(ss);
            const float r = rsqrtf(ss * (1.0f / 64.0f) + EPS);
#pragma unroll
            for (int bj = 0; bj < 2; ++bj)
#pragma unroll
                for (int e = 0; e < 8; ++e) v[bj][e] *= r * g[bj][e];
#pragma unroll
            for (int e = 0; e < 8; ++e) { const float oth = shx_(v[0][e], 16, lane); const float cs = csv[mm][e >> 2][e & 3], sn = snv[mm][e >> 2][e & 3];
                if (fq == 0) v[0][e] = v[0][e] * cs - oth * sn; else if (fq == 1) v[0][e] = v[0][e] * cs + oth * sn; }
            bf16_t* zp = Z + (size_t)row * ldz + colbase + wc * 64 + 8 * fq;
            *(u32x4*)zp = pack8(v[0]); *(u32x4*)(zp + 32) = pack8(v[1]); }
        __builtin_amdgcn_sched_barrier(0);
      }
}
struct EpiEvenIn {
    static constexpr bool PERM = true, AFTER_DRAIN = false;
    bf16_t* Z; _Float16* IQH; _Float16* IKH; float* IW; const float* a_kn; const float* b_kn; const float* idx_kn; const float* COSH; const float* SINH; const float* COSI; const float* SINI;
    __device__ __forceinline__ void operator()(const pg8::f32x4 (&acc)[2][2][4][2], const pg8::Unit& u, int wr, int wc, int fr, int fq) const {
        const int row0 = u.pm * 256 + wr * 64 + fr; const int lane = fr + 16 * fq;
        if (u.pn == 2 || u.pn == 3) epi_khead(acc, Z, EV_ZP, 512 + (u.pn & 1) * 256, a_kn, COSH, SINH, row0, wc, fr, fq);
        else if (u.pn == 8 || u.pn == 9) epi_khead(acc, Z, EV_ZP, 2048 + (u.pn & 1) * 256, b_kn, COSH, SINH, row0, wc, fr, fq);
        else if (u.pn < 12) {
            const int col0 = u.pn * 256 + wc * 32 + 8 * fq;
#pragma unroll
            for (int ai = 0; ai < 2; ++ai)
#pragma unroll
                for (int m = 0; m < 4; ++m) { bf16_t* rowp = Z + (size_t)(row0 + ai * 128 + m * 16) * EV_ZP + col0;
#pragma unroll
                    for (int bj = 0; bj < 2; ++bj) { const pg8::f32x4 v0 = acc[ai][bj][m][0], v1 = acc[ai][bj][m][1];
                        u32x4 w; w.x = pk2(v0[0], v0[1]); w.y = pk2(v0[2], v0[3]); w.z = pk2(v1[0], v1[1]); w.w = pk2(v1[2], v1[3]);
                        *(u32x4*)(rowp + bj * 128) = w; } }
        } else if (u.pn == 12) {
#pragma unroll
            for (int ai = 0; ai < 2; ++ai) {
                f32x4 csr[4], snr[4];
#pragma unroll
                for (int m = 0; m < 4; ++m) { const int pos = (row0 + ai * 128 + m * 16) & (S - 1); csr[m] = *(const f32x4*)(COSI + pos * 4); snr[m] = *(const f32x4*)(SINI + pos * 4); }
                __builtin_amdgcn_sched_barrier(0);
#pragma unroll
                for (int m = 0; m < 4; ++m) { const int row = row0 + ai * 128 + m * 16;
                    const f32x4 cs = csr[m], sn = snr[m];
#pragma unroll
                    for (int bj = 0; bj < 2; ++bj) { pg8::f32x4 v0 = acc[ai][bj][m][0], v1 = acc[ai][bj][m][1];
                        if (fq == 0) { const pg8::f32x4 a0 = v0, a1 = v1;
#pragma unroll
                            for (int e = 0; e < 4; ++e) { v0[e] = a0[e] * cs[e] - a1[e] * sn[e]; v1[e] = a1[e] * cs[e] + a0[e] * sn[e]; } }
                        f16x8 hq;
#pragma unroll
                        for (int e = 0; e < 4; ++e) { hq[e] = (_Float16)v0[e]; hq[4 + e] = (_Float16)v1[e]; }
                        *(f16x8*)(IQH + (size_t)row * 256 + bj * 128 + wc * 32 + 8 * fq) = hq; } }
                __builtin_amdgcn_sched_barrier(0);
            }
        } else {
            if (wc == 0) {
                float g[8];
#pragma unroll
                for (int e = 0; e < 8; ++e) g[e] = idx_kn[8 * fq + e];
#pragma unroll
                for (int ai = 0; ai < 2; ++ai) {
                  f32x4 csr[4], snr[4];
#pragma unroll
                  for (int m = 0; m < 4; ++m) { const int pos = (row0 + ai * 128 + m * 16) & (S - 1); csr[m] = *(const f32x4*)(COSI + pos * 4); snr[m] = *(const f32x4*)(SINI + pos * 4); }
                  __builtin_amdgcn_sched_barrier(0);
#pragma unroll
                    for (int m = 0; m < 4; ++m) { const int row = row0 + ai * 128 + m * 16;
                        float v[8]; float ss = 0.f;
#pragma unroll
                        for (int e = 0; e < 4; ++e) { v[e] = acc[ai][0][m][0][e]; v[4 + e] = acc[ai][0][m][1][e]; ss += v[e] * v[e] + v[4 + e] * v[4 + e]; }
                        ss += shx_(ss, 16, lane); ss = half_sum(ss);
                        const float r = rsqrtf(ss * (1.0f / 32.0f) + EPS);
#pragma unroll
                        for (int e = 0; e < 8; ++e) v[e] *= r * g[e];
                        if (fq == 0) {
#pragma unroll
                            for (int e = 0; e < 4; ++e) { const float x1 = v[e], x2 = v[4 + e]; const float cs = csr[m][e], sn = snr[m][e]; v[e] = x1 * cs - x2 * sn; v[4 + e] = x2 * cs + x1 * sn; } }
                        f16x8 hk;
#pragma unroll
                        for (int e = 0; e < 8; ++e) hk[e] = (_Float16)v[e];
                        *(f16x8*)(IKH + (size_t)row * 32 + 8 * fq) = hk; }
                  __builtin_amdgcn_sched_barrier(0);
                }
            } else if (wc == 1 && fq == 0) {
#pragma unroll
                for (int ai = 0; ai < 2; ++ai)
#pragma unroll
                    for (int m = 0; m < 4; ++m) { float* wp = IW + (size_t)(row0 + ai * 128 + m * 16) * 8; *(pg8::f32x4*)wp = acc[ai][0][m][0]; *(pg8::f32x4*)(wp + 4) = acc[ai][0][m][1]; }
            }
        }
    }
};
struct EpiOddIn {
    static constexpr bool PERM = true, AFTER_DRAIN = false;
    bf16_t* Z; bf16_t* UG; const float* c_kn; const float* COSH; const float* SINH;
    __device__ __forceinline__ void operator()(const pg8::f32x4 (&acc)[2][2][4][2], const pg8::Unit& u, int wr, int wc, int fr, int fq) const {
        const int row0 = u.pm * 256 + wr * 64 + fr, col0 = u.pn * 256 + wc * 32 + 8 * fq;
        if (u.pn == 2 || u.pn == 3) { epi_khead(acc, Z, OD_N, 512 + (u.pn & 1) * 256, c_kn, COSH, SINH, row0, wc, fr, fq); return; }
#pragma unroll
        for (int ai = 0; ai < 2; ++ai)
#pragma unroll
            for (int m = 0; m < 4; ++m) { const size_t row = (size_t)(row0 + ai * 128 + m * 16);
#pragma unroll
                for (int bj = 0; bj < 2; ++bj) { const pg8::f32x4 v0 = acc[ai][bj][m][0], v1 = acc[ai][bj][m][1]; const int col = col0 + bj * 128;
                    u32x4 w; w.x = pk2(v0[0], v0[1]); w.y = pk2(v0[2], v0[3]); w.z = pk2(v1[0], v1[1]); w.w = pk2(v1[2], v1[3]);
                    if (u.pn < 6) *(u32x4*)(Z + row * OD_N + col) = w;
                    else { const int cu = col - 1536; *(u32x4*)(UG + ((size_t)(cu >> 4) * T + row) * 16 + (cu & 15)) = w; } } }
    }
};
__device__ __forceinline__ void load_q_normed(attn_body::bf16x8 (&qr)[4], const bf16_t* zrow, const float* gain, const float* COSH, const float* SINH, int pos, int hi, int lane) {
    float v[4][8]; float ss = 0.f;
#pragma unroll
    for (int d0 = 0; d0 < 4; ++d0) { unpack8(*(const u32x4*)(zrow + d0 * 16 + hi * 8), v[d0]);
#pragma unroll
        for (int e = 0; e < 8; ++e) ss += v[d0][e] * v[d0][e]; }
    ss = half_sum(ss);
    const float r = rsqrtf(ss * (1.0f / 64.0f) + EPS) * QSCALE;
#pragma unroll
    for (int d0 = 0; d0 < 4; ++d0)
#pragma unroll
        for (int e = 0; e < 8; ++e) v[d0][e] *= r * gain[d0 * 16 + hi * 8 + e];
#pragma unroll
    for (int e = 0; e < 8; ++e) { const float oth = shx_(v[0][e], 32, lane); const float cs = COSH[pos * 8 + e], sn = SINH[pos * 8 + e];
        v[0][e] = hi ? v[0][e] * cs + oth * sn : v[0][e] * cs - oth * sn; }
#pragma unroll
    for (int d0 = 0; d0 < 4; ++d0) qr[d0] = __builtin_bit_cast(attn_body::bf16x8, pack8(v[d0]));
}
struct EpiSwiGLU {
    static constexpr bool PERM = true, AFTER_DRAIN = false;
    bf16_t* HID;
    __device__ __forceinline__ void operator()(const pg8::f32x4 (&acc)[2][2][4][2], const pg8::Unit& u, int wr, int wc, int fr, int fq) const {
        const int row0 = u.pm * 256 + wr * 64 + fr, col0 = (u.pn * 256 + wc * 32 + 8 * fq) >> 1;
#pragma unroll
        for (int ai = 0; ai < 2; ++ai)
#pragma unroll
            for (int m = 0; m < 4; ++m) { bf16_t* rowp = HID + (size_t)(row0 + ai * 128 + m * 16) * 512 + col0;
#pragma unroll
                for (int bj = 0; bj < 2; ++bj) { const pg8::f32x4 v0 = acc[ai][bj][m][0], v1 = acc[ai][bj][m][1];
                    const float h0 = v0[0] * sigmoidf_(v0[0]) * v0[1], h1 = v0[2] * sigmoidf_(v0[2]) * v0[3];
                    const float h2 = v1[0] * sigmoidf_(v1[0]) * v1[1], h3 = v1[2] * sigmoidf_(v1[2]) * v1[3];
                    u32x2 w; w.x = pk2(h0, h1); w.y = pk2(h2, h3);
                    *(u32x2*)(rowp + bj * 64) = w; } }
    }
};
struct EpiGLU {
    static constexpr bool PERM = true, AFTER_DRAIN = false;
    bf16_t* O; const bf16_t* YG; const float* gb;
    __device__ __forceinline__ void operator()(const pg8::f32x4 (&acc)[2][2][4][2], const pg8::Unit& u, int wr, int wc, int fr, int fq) const {
        const int row0 = u.pm * 256 + wr * 64 + fr, col0 = u.pn * 256 + wc * 32 + 8 * fq;
#pragma unroll
        for (int ai = 0; ai < 2; ++ai)
#pragma unroll
            for (int bj = 0; bj < 2; ++bj) {
                const int c = col0 + bj * 128;
                u32x4 yr[4];
#pragma unroll
                for (int m = 0; m < 4; ++m) yr[m] = *(const u32x4*)(YG + (size_t)(row0 + ai * 128 + m * 16) * 512 + c);
                const pg8::f32x4 b0 = *(const pg8::f32x4*)(gb + c), b1 = *(const pg8::f32x4*)(gb + c + 4);
                __builtin_amdgcn_sched_barrier(0);
#pragma unroll
                for (int m = 0; m < 4; ++m) { const size_t row = (size_t)(row0 + ai * 128 + m * 16);
                    const pg8::f32x4 v0 = acc[ai][bj][m][0], v1 = acc[ai][bj][m][1];
                    float y[8]; unpack8(yr[m], y);
                    float o[8];
#pragma unroll
                    for (int j = 0; j < 4; ++j) { o[j] = y[j] * sigmoidf_(v0[j] + b0[j]); o[4 + j] = y[4 + j] * sigmoidf_(v1[j] + b1[j]); }
                    *(u32x4*)(O + row * 1024 + 512 + c) = pack8(o); }
                __builtin_amdgcn_sched_barrier(0);
            }
    }
};
struct MoeOrder {
    int nN, nunits, G, c; const LAS int* tile_e;
    __device__ __forceinline__ bool next(int i, pg8::Unit& u) const { const int L = i * G + c; if (L >= nunits) return false;
        int w = L; { const int q = nunits / 8, r = nunits % 8, xcd = w % 8, off = w / 8; w = (xcd < r ? xcd * (q + 1) : r * (q + 1) + (xcd - r) * q) + off; }
        u.pm = w / nN; u.pn = w % nN; u.be = tile_e[u.pm]; return true; }
    __device__ __forceinline__ void a_ready(const pg8::Unit&) const {}
    __device__ __forceinline__ void done(const pg8::Unit&) const {}
};

__device__ __forceinline__ int wt_row(int n, int row_mul, int row_add) {
    if (row_mul > 0) return n * row_mul + row_add;
    const int tile = n >> 8, w = n & 255;
    const bool ktile = (tile == 2 || tile == 3) || (row_mul == -1 && (tile == 8 || tile == 9));
    return ktile ? tile * 256 + ((w & 63) >> 5) * 128 + (w >> 6) * 32 + (w & 31) : n;
}
__device__ __forceinline__ void transpose_item(const float* W, int K, int N, bf16_t* WT, int row_mul, int row_add, LAS float* scr, int item, int nblk, int lane) {
    const int kb = item / nblk, nb = item % nblk, k0 = 64 * kb, n0 = 32 * nb;
    const int nn = n0 + (lane & 31);
    float tv[32];
#pragma unroll
    for (int i = 0; i < 32; ++i) { const int kk = 2 * i + (lane >> 5); tv[i] = (nn < N) ? W[(size_t)(k0 + kk) * N + nn] : 0.f; }
#pragma unroll
    for (int i = 0; i < 32; ++i) { const int kk = 2 * i + (lane >> 5); scr[kk * 33 + (lane & 31)] = tv[i]; }
    LDS_WAIT(); asm volatile("" ::: "memory");
    const int c = lane & 7;
#pragma unroll
    for (int j = 0; j < 4; ++j) { const int n = (lane >> 3) + 8 * j; const LAS float* s = scr + (8 * c) * 33 + n;
        u32x4 o; o.x = pk2(s[0 * 33], s[1 * 33]); o.y = pk2(s[2 * 33], s[3 * 33]); o.z = pk2(s[4 * 33], s[5 * 33]); o.w = pk2(s[6 * 33], s[7 * 33]);
        *(u32x4*)(WT + (size_t)wt_row(n0 + n, row_mul, row_add) * K + k0 + 8 * c) = o; }
    LDS_WAIT(); asm volatile("" ::: "memory");
}
__device__ __forceinline__ void norm_mod_row(const float* xrow, const float* sh, const float* sc, bf16_t* orow, int lane) {
    f32x4 v[4]; float ss = 0.f;
#pragma unroll
    for (int j = 0; j < 4; ++j) { v[j] = *(const f32x4*)(xrow + 4 * lane + 256 * j); ss += (v[j].x * v[j].x + v[j].y * v[j].y) + (v[j].z * v[j].z + v[j].w * v[j].w); }
    const float r = rsqrtf(wave_sum(ss) * (1.0f / 1024.0f) + EPS);
#pragma unroll
    for (int j = 0; j < 4; ++j) { const f32x4 a = *(const f32x4*)(sc + 4 * lane + 256 * j), b = *(const f32x4*)(sh + 4 * lane + 256 * j);
        u32x2 w; w.x = pk2(v[j].x * r * (1.f + a.x) + b.x, v[j].y * r * (1.f + a.y) + b.y); w.y = pk2(v[j].z * r * (1.f + a.z) + b.z, v[j].w * r * (1.f + a.w) + b.w);
        *(u32x2*)(orow + 4 * lane + 256 * j) = w; }
}

__device__ __forceinline__ void attn_key(const bf16_t* kp, const bf16_t* vp, const float (&q)[64], float& m, float& l, float (&o)[64]) {
    float s = 0.f;
#pragma unroll
    for (int i = 0; i < 8; ++i) { float kv[8]; unpack8(*(const u32x4*)(kp + 8 * i), kv);
#pragma unroll
        for (int j = 0; j < 8; ++j) s += q[8 * i + j] * kv[j]; }
    const float mn = fmaxf(m, s);
    const float f = __builtin_amdgcn_exp2f(m - mn), p = __builtin_amdgcn_exp2f(s - mn);
    l = l * f + p; m = mn;
#pragma unroll
    for (int i = 0; i < 8; ++i) { float vv[8]; unpack8(*(const u32x4*)(vp + 8 * i), vv);
#pragma unroll
        for (int j = 0; j < 8; ++j) o[8 * i + j] = o[8 * i + j] * f + p * vv[j]; }
}
__device__ __forceinline__ void load_q64(const bf16_t* qp, float scale, float (&q)[64]) {
#pragma unroll
    for (int i = 0; i < 8; ++i) { float t[8]; unpack8(*(const u32x4*)(qp + 8 * i), t);
#pragma unroll
        for (int j = 0; j < 8; ++j) q[8 * i + j] = t[j] * scale; }
}

struct Args { const void* in[37]; float* out; unsigned char* ws; int ph_lo, ph_hi, probe_var, pad; };
#ifndef PROBE_GEMM_REPS
#define PROBE_GEMM_REPS 1
#endif
#if PROBE_GEMM_REPS == 2
template <class Sc> struct Twice { Sc S; int n1;
    __device__ __forceinline__ bool next(int i, pg8::Unit& u) const { return i < n1 ? S.next(i, u) : S.next(i - n1, u); }
    __device__ __forceinline__ void a_ready(const pg8::Unit&) const {}
    __device__ __forceinline__ void done(const pg8::Unit&) const {} };
#define PROBE_SCHED(T) Twice<T>
#define PROBE_WRAP(T, v) Twice<T> PS_; PS_.S = v; { int n1_ = 0; pg8::Unit tu_; while (v.next(n1_, tu_)) ++n1_; PS_.n1 = n1_; }
#else
#define PROBE_SCHED(T) T
#define PROBE_WRAP(T, v) const T& PS_ = v
#endif
#ifdef PROBE_BAR2
#define PROBE_EXTRA_BAR(b) xcd_barrier(b, lsg(wid0) == 0 && lane_id_v() == 0);
#else
#define PROBE_EXTRA_BAR(b)
#endif
constexpr int N_PHASES = 3 + 2 * (8 + 10);

template <int NV, bool MASKED, bool CAUSAL, int PIN, int POUT, bool NOMAX = false>
__device__ __forceinline__ void flash_unit(LAS unsigned char* L0, const bf16_t* Qb, const bf16_t* Kb, const bf16_t* Vb, bf16_t* Ob, const unsigned* mbase, int qb, int wid, int lane, const float* qgain, const float* COSH, const float* SINH) {
    const int r32 = lane & 31, hi = lane >> 5;
    LAS unsigned char* ldsKs = L0; LAS unsigned char* ldsVs = L0 + 16384;
    LAS float* wsf = (LAS float*)(L0 + 16384 + NV * 16384 + wid * 256);
    LAS bf16_t* stg = (LAS bf16_t*)(L0 + 16384 + NV * 16384 + 2048 + wid * 4096);
    const int qrow = qb * 256 + wid * 32 + r32;
    attn_body::bf16x8 qr[4];
    load_q_normed(qr, Qb + (size_t)qrow * PIN, qgain, COSH, SINH, qrow, hi, lane);
    const int NT = 4 * (qb + 1);
    const bf16_t* kbp = Kb + (size_t)lane * PIN + wid * 8;
    const bf16_t* vbp = Vb + (size_t)(16 * (wid & 3) + (lane >> 2)) * PIN + (wid >> 2) * 32 + (lane & 3) * 8;
    const unsigned* mwp = MASKED ? mbase + (size_t)qrow * 2 + hi : nullptr;
    u32x4 kreg = *(const u32x4*)kbp, vreg[NV]; unsigned mw = 0u, mwn = 0u;
#pragma unroll
    for (int j = 0; j < NV; ++j) vreg[j] = *(const u32x4*)(vbp + j * 64);
    if (MASKED) mw = mwp[0];
    *(LAS u32x4*)(ldsKs + wid * 1024 + lane * 16) = kreg;
#pragma unroll
    for (int j = 0; j < NV; ++j) *(LAS u32x4*)(ldsVs + j * 16384 + wid * 1024 + lane * 16) = vreg[j];
    __syncthreads();
    float mhat = 0.f, lsum = 0.f;
    attn_body::f32x16 o[2 * NV], negm;
#pragma unroll
    for (int r = 0; r < 16; ++r) { negm[r] = 0.f;
#pragma unroll
        for (int j = 0; j < 2 * NV; ++j) o[j][r] = 0.f; }
    const int vb0 = (int)(unsigned)(unsigned long long)ldsVs + ((lane >> 4) & 1) * 32 + (lane & 3) * 8 + (4 * hi + ((lane & 15) >> 2)) * 64;
    for (int t = 0; t < NT; ++t) {
        const int slot = (t & 1) * 8192;
        if (t + 1 < NT) { kreg = *(const u32x4*)(kbp + (size_t)(t + 1) * 64 * PIN);
#pragma unroll
            for (int j = 0; j < NV; ++j) vreg[j] = *(const u32x4*)(vbp + (size_t)(t + 1) * 64 * PIN + j * 64);
            if (MASKED) mwn = mwp[(size_t)(t + 1) * S * 2]; }
        attn_body::f32x16 p0 = negm, p1 = negm;
        { const LAS unsigned char* kb = ldsKs + slot + hi * 1024 + r32 * 16;
#pragma unroll
          for (int d0 = 0; d0 < 4; ++d0) {
              const attn_body::bf16x8 b0 = *(const LAS attn_body::bf16x8*)(kb + d0 * 2048), b1 = *(const LAS attn_body::bf16x8*)(kb + d0 * 2048 + 512);
              p0 = __builtin_amdgcn_mfma_f32_32x32x16_bf16(b0, qr[d0], p0, 0, 0, 0);
              p1 = __builtin_amdgcn_mfma_f32_32x32x16_bf16(b1, qr[d0], p1, 0, 0, 0); } }
        if (CAUSAL) { const int jb = t - (NT - 4); if (jb >= 0) attn_body::cmask(p0, p1, jb, wid * 32 + r32, hi); }
        float rm = 0.f;
        if (!NOMAX) { rm = fmaxf(p0[0], p1[0]);
#pragma unroll
            for (int r = 1; r < 16; ++r) rm = fmaxf(rm, fmaxf(p0[r], p1[r]));
            rm = half_max(rm); }
        bool resc = false;
        if (!NOMAX && __any(rm > 8.0f)) {
            const float dl = fmaxf(rm, 0.f); mhat += dl;
#pragma unroll
            for (int r = 0; r < 16; ++r) { p0[r] -= dl; p1[r] -= dl; negm[r] = -mhat; }
            const float f = __builtin_amdgcn_exp2f(-dl); lsum *= f; if (hi == 0) wsf[r32] = f; resc = true;
        }
        const int wb = (int)mw; float ssum = 0.f;
#pragma unroll
        for (int r = 0; r < 16; ++r) {
            float e0 = __builtin_amdgcn_exp2f(p0[r]), e1 = __builtin_amdgcn_exp2f(p1[r]);
            if (MASKED) { e0 = __uint_as_float(__float_as_uint(e0) & (unsigned)__builtin_amdgcn_sbfe(wb, r, 1)); e1 = __uint_as_float(__float_as_uint(e1) & (unsigned)__builtin_amdgcn_sbfe(wb, 16 + r, 1)); }
            p0[r] = e0; p1[r] = e1; ssum += e0 + e1; }
        lsum += ssum;
        u32x4 pw0, pw1, pw2, pw3;
#pragma unroll
        for (int k = 0; k < 4; ++k) { pw0[k] = attn_body::cvtpk_s(p0[2 * k], p0[2 * k + 1]); pw1[k] = attn_body::cvtpk_s(p0[8 + 2 * k], p0[9 + 2 * k]);
            pw2[k] = attn_body::cvtpk_s(p1[2 * k], p1[2 * k + 1]); pw3[k] = attn_body::cvtpk_s(p1[8 + 2 * k], p1[9 + 2 * k]); }
        if (resc) { LDS_WAIT();
#pragma unroll
            for (int r = 0; r < 16; ++r) { const float f = wsf[attn_body::crow(r, hi)];
#pragma unroll
                for (int j = 0; j < 2 * NV; ++j) o[j][r] *= f; } }
#pragma unroll
        for (int j = 0; j < NV; ++j)
            attn_body::pv(o + 2 * j, vb0 + j * 16384 + slot, __builtin_bit_cast(attn_body::bf16x8, pw0), __builtin_bit_cast(attn_body::bf16x8, pw1), __builtin_bit_cast(attn_body::bf16x8, pw2), __builtin_bit_cast(attn_body::bf16x8, pw3));
        if (t + 1 < NT) { const int ns = ((t + 1) & 1) * 8192; *(LAS u32x4*)(ldsKs + ns + wid * 1024 + lane * 16) = kreg;
#pragma unroll
            for (int j = 0; j < NV; ++j) *(LAS u32x4*)(ldsVs + j * 16384 + ns + wid * 1024 + lane * 16) = vreg[j]; }
        mw = mwn;
        __syncthreads();
    }
    lsum += shx_(lsum, 32, lane);
    if (hi == 0) wsf[r32] = lsum;
    LDS_WAIT();
    float rl[16];
#pragma unroll
    for (int r = 0; r < 16; ++r) rl[r] = __builtin_amdgcn_rcpf(wsf[attn_body::crow(r, hi)]);
#pragma unroll
    for (int j = 0; j < NV; ++j) {
#pragma unroll
        for (int r = 0; r < 16; ++r) { const int orow = attn_body::crow(r, hi);
            stg[orow * 64 + r32] = (bf16_t)f2bf(o[2 * j][r] * rl[r]); stg[orow * 64 + 32 + r32] = (bf16_t)f2bf(o[2 * j + 1][r] * rl[r]); }
        LDS_WAIT();
#pragma unroll
        for (int q = 0; q < 4; ++q) { const int row = q * 8 + (lane >> 3), ch = lane & 7;
            *(u32x4*)(Ob + (size_t)(qb * 256 + wid * 32 + row) * POUT + j * 64 + ch * 8) = *(const LAS u32x4*)(stg + row * 64 + ch * 8); }
        LDS_WAIT();
    }
    __syncthreads();
}
template <int NV, bool MASKED, bool CAUSAL, int PIN, int POUT, bool NOMAX = false>
__device__ __forceinline__ void flash_unit_q2(LAS unsigned char* L0, const bf16_t* Qb, const bf16_t* Kb, const bf16_t* Vb, bf16_t* Ob, const unsigned* mbase, int qb, int wid, int lane, const float* qgain, const float* COSH, const float* SINH) {
    typedef __attribute__((address_space(3))) attn_body::v4i16_t* vtr_ptr;
    const int r32 = lane & 31, hi = lane >> 5;
    LAS unsigned char* ldsKs = L0; LAS unsigned char* ldsVs = L0 + 16384;
    LAS float* wsf = (LAS float*)(L0 + 16384 + NV * 16384 + wid * 512);
    LAS bf16_t* stg = (LAS bf16_t*)(L0 + 16384 + NV * 16384 + 4096 + wid * 4096);
    const int q0 = qb * 512 + wid * 64;
    attn_body::bf16x8 qr[2][4];
#pragma unroll
    for (int nq = 0; nq < 2; ++nq) load_q_normed(qr[nq], Qb + (size_t)(q0 + nq * 32 + r32) * PIN, qgain, COSH, SINH, q0 + nq * 32 + r32, hi, lane);
    const int NT = 8 * (qb + 1);
    const bf16_t* kbp = Kb + (size_t)lane * PIN + wid * 8;
    const bf16_t* vbp = Vb + (size_t)(16 * (wid & 3) + (lane >> 2)) * PIN + (wid >> 2) * 32 + (lane & 3) * 8;
    const unsigned* mwp = MASKED ? mbase + (size_t)(q0 + r32) * 2 + hi : nullptr;
    const int stoff = wid * 1024 + lane * 16;
    u32x4 kreg = *(const u32x4*)kbp, vreg[NV]; unsigned mw[2] = {0u, 0u}, mwn[2] = {0u, 0u};
#pragma unroll
    for (int j = 0; j < NV; ++j) vreg[j] = *(const u32x4*)(vbp + j * 64);
    if (MASKED) { mw[0] = mwp[0]; mw[1] = mwp[64]; }
    *(LAS u32x4*)(ldsKs + stoff) = kreg;
#pragma unroll
    for (int j = 0; j < NV; ++j) *(LAS u32x4*)(ldsVs + j * 16384 + stoff) = vreg[j];
    __syncthreads();
    float mhat[2] = {0.f, 0.f}, lsum[2] = {0.f, 0.f}; bool refmoved = false;
    attn_body::f32x16 o[2][2 * NV];
#pragma unroll
    for (int r = 0; r < 16; ++r)
#pragma unroll
        for (int j = 0; j < 2 * NV; ++j) { o[0][j][r] = 0.f; o[1][j][r] = 0.f; }
    const LAS unsigned char* kfb = ldsKs + hi * 1024 + r32 * 16;
    const LAS unsigned char* vfb = ldsVs + ((lane >> 4) & 1) * 32 + (lane & 3) * 8 + (4 * hi + ((lane & 15) >> 2)) * 64;
    for (int t = 0; t < NT; ++t) {
        const int slot = (t & 1) * 8192;
        {
            const int tn = min(t + 1, NT - 1);
            if (MASKED) { mwn[0] = mwp[(size_t)tn * S * 2]; mwn[1] = mwp[(size_t)tn * S * 2 + 64]; }
            kreg = *(const u32x4*)(kbp + (size_t)tn * 64 * PIN);
#pragma unroll
            for (int j = 0; j < NV; ++j) vreg[j] = *(const u32x4*)(vbp + (size_t)tn * 64 * PIN + j * 64); }
#pragma unroll
        for (int kh = 0; kh < 2; ++kh) {
            attn_body::f32x16 p[2];
#pragma unroll
            for (int r = 0; r < 16; ++r) { p[0][r] = 0.f; p[1][r] = 0.f; }
#pragma unroll
            for (int d0 = 0; d0 < 4; ++d0) {
                const attn_body::bf16x8 kf = *(const LAS attn_body::bf16x8*)(kfb + slot + d0 * 2048 + kh * 512);
                p[0] = __builtin_amdgcn_mfma_f32_32x32x16_bf16(kf, qr[0][d0], p[0], 0, 0, 0);
                p[1] = __builtin_amdgcn_mfma_f32_32x32x16_bf16(kf, qr[1][d0], p[1], 0, 0, 0); }
            if (refmoved) {
#pragma unroll
                for (int nq = 0; nq < 2; ++nq)
#pragma unroll
                    for (int r = 0; r < 16; ++r) p[nq][r] -= mhat[nq]; }
            if (CAUSAL) { const int kbase = t * 64 + kh * 32;
                if (kbase + 31 > q0) {
#pragma unroll
                    for (int nq = 0; nq < 2; ++nq)
#pragma unroll
                        for (int r = 0; r < 16; ++r) if (kbase + attn_body::crow(r, hi) > q0 + nq * 32 + r32) p[nq][r] = -INFINITY; } }
            float rm[2] = {0.f, 0.f};
            if (!NOMAX)
#pragma unroll
            for (int nq = 0; nq < 2; ++nq) { float m_ = p[nq][0];
#pragma unroll
                for (int r = 1; r < 16; ++r) m_ = fmaxf(m_, p[nq][r]);
                rm[nq] = half_max(m_); }
            bool resc = false;
            if (!NOMAX && __any(fmaxf(rm[0], rm[1]) > 8.0f)) {
#pragma unroll
                for (int nq = 0; nq < 2; ++nq) { const float dl = fmaxf(rm[nq], 0.f); mhat[nq] += dl;
#pragma unroll
                    for (int r = 0; r < 16; ++r) p[nq][r] -= dl;
                    const float f = __builtin_amdgcn_exp2f(-dl); lsum[nq] *= f; if (hi == 0) wsf[nq * 32 + r32] = f; }
                resc = true; refmoved = true;
            }
            attn_body::bf16x8 pa[2][2];
#pragma unroll
            for (int nq = 0; nq < 2; ++nq) { const int wb = (int)mw[nq]; f32x2 ss2 = {0.f, 0.f};
#pragma unroll
                for (int r = 0; r < 16; ++r) { float e = __builtin_amdgcn_exp2f(p[nq][r]);
                    if (MASKED) { unsigned mk; asm("v_bfe_i32 %0, %1, %2, 1" : "=v"(mk) : "v"(wb), "n"(kh * 16 + r)); e = __uint_as_float(__float_as_uint(e) & mk); }
                    p[nq][r] = e; }
#pragma unroll
                for (int r = 0; r < 16; r += 2) ss2 += (f32x2){p[nq][r], p[nq][r + 1]};
                lsum[nq] += ss2.x + ss2.y;
                u32x4 pw0, pw1;
#pragma unroll
                for (int k = 0; k < 4; ++k) { pw0[k] = attn_body::cvtpk_s(p[nq][2 * k], p[nq][2 * k + 1]); pw1[k] = attn_body::cvtpk_s(p[nq][8 + 2 * k], p[nq][9 + 2 * k]); }
                pa[nq][0] = __builtin_bit_cast(attn_body::bf16x8, pw0); pa[nq][1] = __builtin_bit_cast(attn_body::bf16x8, pw1); }
            if (resc) { LDS_WAIT();
#pragma unroll
                for (int nq = 0; nq < 2; ++nq)
#pragma unroll
                    for (int r = 0; r < 16; ++r) { const float f = wsf[nq * 32 + attn_body::crow(r, hi)];
#pragma unroll
                        for (int j = 0; j < 2 * NV; ++j) o[nq][j][r] *= f; } }
#pragma unroll
            for (int blk = 0; blk < 2 * NV; ++blk)
#pragma unroll
                for (int k2 = 0; k2 < 2; ++k2) {
                    const LAS unsigned char* vb = vfb + (blk >> 1) * 16384 + slot + (blk & 1) * 4096 + (kh * 2 + k2) * 1024;
                    const attn_body::s16x4 lo_ = __builtin_bit_cast(attn_body::s16x4, __builtin_amdgcn_ds_read_tr16_b64_v4i16((vtr_ptr)vb)), hi_ = __builtin_bit_cast(attn_body::s16x4, __builtin_amdgcn_ds_read_tr16_b64_v4i16((vtr_ptr)(vb + 512)));
                    const attn_body::bf16x8 vf = (attn_body::bf16x8){lo_[0], lo_[1], lo_[2], lo_[3], hi_[0], hi_[1], hi_[2], hi_[3]};
                    o[0][blk] = __builtin_amdgcn_mfma_f32_32x32x16_bf16(pa[0][k2], vf, o[0][blk], 0, 0, 0);
                    o[1][blk] = __builtin_amdgcn_mfma_f32_32x32x16_bf16(pa[1][k2], vf, o[1][blk], 0, 0, 0); }
        }
        if (t + 1 < NT) { const int ns = 8192 - slot; *(LAS u32x4*)(ldsKs + ns + stoff) = kreg;
#pragma unroll
            for (int j = 0; j < NV; ++j) *(LAS u32x4*)(ldsVs + j * 16384 + ns + stoff) = vreg[j]; }
        mw[0] = mwn[0]; mw[1] = mwn[1];
        __syncthreads();
    }
#pragma unroll
    for (int nq = 0; nq < 2; ++nq) { lsum[nq] += shx_(lsum[nq], 32, lane); if (hi == 0) wsf[nq * 32 + r32] = lsum[nq]; }
    LDS_WAIT();
#pragma unroll
    for (int nq = 0; nq < 2; ++nq)
#pragma unroll
      for (int j = 0; j < NV; ++j) {
#pragma unroll
        for (int r = 0; r < 16; ++r) { const int orow = attn_body::crow(r, hi); const float rl = __builtin_amdgcn_rcpf(wsf[nq * 32 + orow]);
            stg[orow * 64 + r32] = (bf16_t)f2bf(o[nq][2 * j][r] * rl); stg[orow * 64 + 32 + r32] = (bf16_t)f2bf(o[nq][2 * j + 1][r] * rl); }
        LDS_WAIT();
#pragma unroll
        for (int q = 0; q < 4; ++q) { const int row = q * 8 + (lane >> 3), ch = lane & 7;
            *(u32x4*)(Ob + (size_t)(q0 + nq * 32 + row) * POUT + j * 64 + ch * 8) = *(const LAS u32x4*)(stg + row * 64 + ch * 8); }
        LDS_WAIT();
      }
    __syncthreads();
}
struct MoeRows {
    static constexpr bool GATHER = true;
    const LAS int* rb; const int* LTOK;
    __device__ __forceinline__ unsigned operator()(const pg8::Unit& u, int r) const { const int e = u.be; const int slot = min(u.pm * 256 + r - rb[e], rb[32 + e] - 1);
        const int tok = LTOK[e * 32768 + slot]; return (unsigned)tok * 2048u; }
};
__device__ __forceinline__ void moe_convert(const float* w1, const float* w3, const float* w2, bf16_t* W13, bf16_t* W2, LAS float* scr, int gw, int NGW, int lane) {
    for (int it = gw; it < 32 * 768; it += NGW) {
        const int e = it / 768; int r = it % 768;
        if (r < 256) { transpose_item(w1 + (size_t)e * 1024 * 512, 1024, 512, W13 + (size_t)e * 1024 * 1024, 2, 0, scr, r, 16, lane); continue; } r -= 256;
        if (r < 256) { transpose_item(w3 + (size_t)e * 1024 * 512, 1024, 512, W13 + (size_t)e * 1024 * 1024, 2, 1, scr, r, 16, lane); continue; } r -= 256;
        transpose_item(w2 + (size_t)e * 512 * 1024, 512, 1024, W2 + (size_t)e * 1024 * 512, 1, 0, scr, r, 32, lane);
    }
}
__device__ __forceinline__ void moe_tables(unsigned* ctl, int l, LAS int* tile_e, LAS int* rb, LAS int* nt_p, int tid) {
    if (tid < 64) {
        const int ln = tid;
        const int cnt = ln < 32 ? (int)__hip_atomic_load(ctl + CW_CNT + (l * 32 + (ln & 31)) * 64, __ATOMIC_RELAXED, __HIP_MEMORY_SCOPE_AGENT) : 0;
        const int ntile = (cnt + 255) >> 8;
        int inc = ntile;
#pragma unroll
        for (int off = 1; off < 32; off <<= 1) { const int v = (int)shi_((unsigned)inc, ln - off); if (ln >= off) inc += v; }
        if (ln < 32) { rb[ln] = (inc - ntile) * 256; rb[32 + ln] = cnt; }
        if (ln == 31) nt_p[0] = inc;
    }
    __syncthreads();
    const int nt = nt_p[0];
    for (int t = tid; t < nt; t += NTHREADS) {
        int lo = 0, hi = 31;
        while (lo < hi) { const int mid = (lo + hi + 1) >> 1; if (rb[mid] <= t * 256) lo = mid; else hi = mid - 1; }
        tile_e[t] = lo;
    }
    __syncthreads();
}

template <bool FIRST>
__device__ __forceinline__ float f_pass1(const float* __restrict__ xs_row, bf16_t* __restrict__ xb_row, const bf16_t* __restrict__ y_row, const LAS float* gate, const int kc) {
    float ss = 0.f;
#pragma unroll 1
    for (int s0 = 0; s0 < 32; s0 += 8) {
        u32x4 xr[8], yr[8]; f32x4 xa[8], xc[8];
#pragma unroll
        for (int k = 0; k < 8; ++k) { const int col = 32 * (s0 + k) + 8 * kc;
            if constexpr (FIRST) { xa[k] = *(const f32x4*)(xs_row + col); xc[k] = *(const f32x4*)(xs_row + col + 4); } else xr[k] = *(const u32x4*)(xb_row + col);
            yr[k] = *(const u32x4*)(y_row + col); }
        __builtin_amdgcn_sched_barrier(0);
#pragma unroll
        for (int k = 0; k < 8; ++k) { const int col = 32 * (s0 + k) + 8 * kc;
            f32x4 x0, x1;
            if constexpr (FIRST) { x0 = xa[k]; x1 = xc[k]; }
            else { float xv_[8]; unpack8(xr[k], xv_); x0 = (f32x4){xv_[0], xv_[1], xv_[2], xv_[3]}; x1 = (f32x4){xv_[4], xv_[5], xv_[6], xv_[7]}; }
            float yv[8]; unpack8(yr[k], yv);
            const f32x4 g0 = *(const LAS f32x4*)(gate + col), g1 = *(const LAS f32x4*)(gate + col + 4);
            float nv_[8] = {x0.x + g0.x * yv[0], x0.y + g0.y * yv[1], x0.z + g0.z * yv[2], x0.w + g0.w * yv[3], x1.x + g1.x * yv[4], x1.y + g1.y * yv[5], x1.z + g1.z * yv[6], x1.w + g1.w * yv[7]};
            const u32x4 xw = pack8(nv_); *(u32x4*)(xb_row + col) = xw;
            float rv_[8]; unpack8(xw, rv_);
#pragma unroll
            for (int e = 0; e < 8; ++e) ss += rv_[e] * rv_[e]; }
        __builtin_amdgcn_sched_barrier(0);
    }
    return ss;
}
__device__ __forceinline__ void f_pass2(const bf16_t* __restrict__ xb_row, bf16_t* __restrict__ h_row, const LAS float* modl, const bf16_t* __restrict__ wh, const bf16_t* __restrict__ wl, const float rn, const int kc, f32x4 (&acc)[3]) {
#pragma unroll 1
    for (int s0 = 0; s0 < 32; s0 += 4) {
        u32x4 xr[4]; pg8::bf16x8 bh[4][3], bl[4][3];
#pragma unroll
        for (int k = 0; k < 4; ++k) { const int col = 32 * (s0 + k) + 8 * kc; xr[k] = *(const u32x4*)(xb_row + col);
#pragma unroll
            for (int ct = 0; ct < 3; ++ct) { bh[k][ct] = *(const pg8::bf16x8*)(wh + (size_t)ct * 16 * 1024 + 32 * (s0 + k)); bl[k][ct] = *(const pg8::bf16x8*)(wl + (size_t)ct * 16 * 1024 + 32 * (s0 + k)); } }
        __builtin_amdgcn_sched_barrier(0);
#pragma unroll
        for (int k = 0; k < 4; ++k) { const int col = 32 * (s0 + k) + 8 * kc;
            f32x4 x0, x1; { float xv_[8]; unpack8(xr[k], xv_); x0 = (f32x4){xv_[0], xv_[1], xv_[2], xv_[3]}; x1 = (f32x4){xv_[4], xv_[5], xv_[6], xv_[7]}; }
            const f32x4 c0 = *(const LAS f32x4*)(modl + 2048 + col), c1 = *(const LAS f32x4*)(modl + 2048 + col + 4), s0_ = *(const LAS f32x4*)(modl + 1024 + col), s1_ = *(const LAS f32x4*)(modl + 1024 + col + 4);
            float hv[8];
            hv[0] = x0.x * rn * (1.f + c0.x) + s0_.x; hv[1] = x0.y * rn * (1.f + c0.y) + s0_.y; hv[2] = x0.z * rn * (1.f + c0.z) + s0_.z; hv[3] = x0.w * rn * (1.f + c0.w) + s0_.w;
            hv[4] = x1.x * rn * (1.f + c1.x) + s1_.x; hv[5] = x1.y * rn * (1.f + c1.y) + s1_.y; hv[6] = x1.z * rn * (1.f + c1.z) + s1_.z; hv[7] = x1.w * rn * (1.f + c1.w) + s1_.w;
            const u32x4 hh = pack8(hv);
            *(u32x4*)(h_row + col) = hh;
            float hl[8]; { float hf[8]; unpack8(hh, hf);
#pragma unroll
                for (int e = 0; e < 8; ++e) hl[e] = hv[e] - hf[e]; }
            const u32x4 hlw = pack8(hl);
            const pg8::bf16x8 ah = __builtin_bit_cast(pg8::bf16x8, hh), al = __builtin_bit_cast(pg8::bf16x8, hlw);
#pragma unroll
            for (int ct = 0; ct < 3; ++ct) {
                acc[ct] = __builtin_amdgcn_mfma_f32_16x16x32_bf16(ah, bh[k][ct], acc[ct], 0, 0, 0);
                acc[ct] = __builtin_amdgcn_mfma_f32_16x16x32_bf16(ah, bl[k][ct], acc[ct], 0, 0, 0);
                acc[ct] = __builtin_amdgcn_mfma_f32_16x16x32_bf16(al, bh[k][ct], acc[ct], 0, 0, 0);
            } }
        __builtin_amdgcn_sched_barrier(0);
    }
}

__device__ __forceinline__ float relu_i(float x) { return __builtin_bit_cast(float, max(__builtin_bit_cast(int, x), 0)); }
__device__ __forceinline__ unsigned pk_gt_u16(unsigned a, unsigned b, unsigned ones) { unsigned d; asm("v_pk_sub_u16 %0, %1, %2 clamp" : "=v"(d) : "v"(a), "v"(b)); unsigned r; asm("v_pk_min_u16 %0, %1, %2" : "=v"(r) : "v"(d), "v"(ones)); return r; }
__device__ __forceinline__ unsigned spread16(unsigned x) { x = (x | (x << 8)) & 0x00FF00FFu; x = (x | (x << 4)) & 0x0F0F0F0Fu; x = (x | (x << 2)) & 0x33333333u; x = (x | (x << 1)) & 0x55555555u; return x; }
__device__ __forceinline__ unsigned ilv16(unsigned a) { return spread16(a & 0xFFFFu) | (spread16(a >> 16) << 1); }
__device__ __forceinline__ int lane_id_v() { int v; asm volatile("v_mbcnt_lo_u32_b32 %0, -1, 0\n\tv_mbcnt_hi_u32_b32 %0, -1, %0" : "=v"(v)); return v; }
__device__ __forceinline__ unsigned long long lsg64(unsigned long long v) { asm volatile("" : "+s"(v)); return v; }
__device__ __forceinline__ int lsg(int v) { asm volatile("" : "+s"(v)); return v; }
__device__ __forceinline__ int lvg(int v) { asm volatile("" : "+v"(v)); return v; }
__device__ __forceinline__ LAS unsigned char* lsgp(LAS unsigned char* p) { unsigned v = (unsigned)(unsigned long long)p; asm volatile("" : "+s"(v)); return (LAS unsigned char*)(unsigned long long)v; }
__device__ __forceinline__ void* ldptr(const LAS unsigned long long* tbl, int k) {
    const unsigned long long v = tbl[k];
    const unsigned lo = __builtin_amdgcn_readfirstlane((unsigned)v), hi = __builtin_amdgcn_readfirstlane((unsigned)(v >> 32));
    return (void*)(__attribute__((address_space(1))) void*)(((unsigned long long)hi << 32) | lo);
}
#define DECL_PTRS() \
    const int wid = lsg(wid0), lane = lane_id_v(), tid = wid * 64 + lane; \
    const int G = lsg(G0), c = lsg(c0), l = lsg(l0), i = l >> 1; \
    const int gw = c * NWAVES + wid, NGW = G * NWAVES, gt = c * NTHREADS + tid, NGT = G * NTHREADS; \
    LAS unsigned char* lds = (LAS unsigned char*)lsgp(lds0); LAS unsigned char* glds = lds; LAS float* scr = (LAS float*)(lds + wid * 16384); \
    const LAS unsigned long long* ptbl = (const LAS unsigned long long*)(lds + LDS_PTBL); \
    unsigned char* ws = (unsigned char*)ldptr(ptbl, 38); unsigned* ctl = (unsigned*)(ws + WS_CTL); \
    const float* xin = (const float*)ldptr(ptbl, 0); \
    const float* cin = (const float*)ldptr(ptbl, 1); \
    const float* ada_w = (const float*)ldptr(ptbl, 2); \
    const float* ada_b = (const float*)ldptr(ptbl, 3); \
    const float* moe_wg = (const float*)ldptr(ptbl, 4); \
    const float* moe_bg = (const float*)ldptr(ptbl, 5); \
    const float* moe_we = (const float*)ldptr(ptbl, 6); \
    const float* moe_be = (const float*)ldptr(ptbl, 7); \
    const float* moe_w1 = (const float*)ldptr(ptbl, 8); \
    const float* moe_w3 = (const float*)ldptr(ptbl, 9); \
    const float* moe_w2 = (const float*)ldptr(ptbl, 10); \
    const float* ev_w_in = (const float*)ldptr(ptbl, 11); \
    const float* ev_w_out = (const float*)ldptr(ptbl, 12); \
    const float* a_qn = (const float*)ldptr(ptbl, 13); \
    const float* a_kn = (const float*)ldptr(ptbl, 14); \
    const float* a_lq1 = (const float*)ldptr(ptbl, 15); \
    const float* a_lk1 = (const float*)ldptr(ptbl, 16); \
    const float* a_lq2 = (const float*)ldptr(ptbl, 17); \
    const float* a_lk2 = (const float*)ldptr(ptbl, 18); \
    const float* a_subln = (const float*)ldptr(ptbl, 19); \
    const float* b_qn = (const float*)ldptr(ptbl, 20); \
    const float* b_kn = (const float*)ldptr(ptbl, 21); \
    const float* b_idx_kn = (const float*)ldptr(ptbl, 22); \
    const float* od_w_in = (const float*)ldptr(ptbl, 23); \
    const float* od_w_out = (const float*)ldptr(ptbl, 24); \
    const float* c_qn = (const float*)ldptr(ptbl, 25); \
    const float* c_kn = (const float*)ldptr(ptbl, 26); \
    const float* s5_lam_re = (const float*)ldptr(ptbl, 27); \
    const float* s5_lam_im = (const float*)ldptr(ptbl, 28); \
    const float* s5_b_re = (const float*)ldptr(ptbl, 29); \
    const float* s5_b_im = (const float*)ldptr(ptbl, 30); \
    const float* s5_c_re = (const float*)ldptr(ptbl, 31); \
    const float* s5_c_im = (const float*)ldptr(ptbl, 32); \
    const float* s5_d = (const float*)ldptr(ptbl, 33); \
    const float* s5_log_dt = (const float*)ldptr(ptbl, 34); \
    const float* s5_glu_w = (const float*)ldptr(ptbl, 35); \
    const float* s5_glu_b = (const float*)ldptr(ptbl, 36); \
    float* out = (float*)ldptr(ptbl, 37); \
    float* MOD = (float*)(ws + WS_MOD); \
    float* MODP = (float*)(ws + WS_MODP); \
    float* COSH = (float*)(ws + WS_ROPE); \
    float* SINH = COSH + S * 8; \
    float* COSI = SINH + S * 8; \
    float* SINI = COSI + S * 4; \
    float* S5A = (float*)(ws + WS_S5A); \
    float* S5B = (float*)(ws + WS_S5B); \
    float* LAM = (float*)(ws + WS_LAM); \
    float* KM = (float*)(ws + WS_KM); \
    bf16_t* KMH = (bf16_t*)(ws + WS_KMH); \
    bf16_t* WRH = (bf16_t*)(ws + WS_WRH); \
    bf16_t* WRL = (bf16_t*)(ws + WS_WRH + 393216); \
    bf16_t* KML = (bf16_t*)(ws + WS_KMH + 131072); \
    bf16_t* Wevin = (bf16_t*)(ws + WS_WEVIN); \
    bf16_t* Wevout = (bf16_t*)(ws + WS_WEVOUT); \
    bf16_t* Wodin = (bf16_t*)(ws + WS_WODIN); \
    bf16_t* Wodout = (bf16_t*)(ws + WS_WODOUT); \
    bf16_t* Wglu = (bf16_t*)(ws + WS_WGLU); \
    bf16_t* W13 = (bf16_t*)(ws + WS_W13); \
    bf16_t* W2 = (bf16_t*)(ws + WS_W2); \
    bf16_t* H = (bf16_t*)(ws + WS_H); \
    bf16_t* O = (bf16_t*)(ws + WS_O); \
    bf16_t* Z = (bf16_t*)(ws + WS_Z); \
    bf16_t* XG = (bf16_t*)(ws + WS_XG); \
    bf16_t* Y = (bf16_t*)(ws + WS_Y); \
    bf16_t* HID = (bf16_t*)(ws + WS_HID); \
    float* IQ = (float*)(ws + WS_IQ); \
    bf16_t* YG = (bf16_t*)(ws + WS_YG); \
    float* IKW = (float*)(ws + WS_IKW); \
    _Float16* IQH = (_Float16*)(ws + WS_IQH); \
    _Float16* IKH = (_Float16*)(ws + WS_IKH); \
    float* IW = (float*)(ws + WS_IW); \
    int* SEL = (int*)(ws + WS_SEL); \
    bf16_t* YMIX = (bf16_t*)(ws + WS_YMIX); \
    int* TOKES = (int*)(ws + WS_TOKES); \
    int* LTOK = (int*)(ws + WS_LTOK); \
    float* TOKW = (float*)(ws + WS_TOKW); \
    int* TOKROW = (int*)(ws + WS_TOKROW); \
    bf16_t* UG = (bf16_t*)(ws + WS_UG); \
    float* S5E = (float*)(ws + WS_S5E); \
    bf16_t* S5HC = (bf16_t*)(ws + WS_S5HC); \
    bf16_t* S5KT = (bf16_t*)(ws + WS_S5KT); \
    bf16_t* S5WT = (bf16_t*)(ws + WS_S5WT); \
    bf16_t* S5A2 = (bf16_t*)(ws + WS_S5A2); \
    float* S5PW = (float*)(ws + WS_S5PW); \
    int* MLIST = (int*)(ws + WS_MLIST); \
    bf16_t* MPO = (bf16_t*)(ws + WS_MPO); \
    float* MML = (float*)(ws + WS_MML); \
    int* NSEL = (int*)(ws + WS_NSEL); \
    unsigned* MASKW = (unsigned*)(ws + WS_MASKW); \
    bf16_t* XB = (bf16_t*)(ws + WS_XB);
__global__ void __launch_bounds__(NTHREADS, 2) fwd(Args a) {
    extern __shared__ __attribute__((aligned(16))) unsigned char lds_raw[];
    LAS unsigned char* lds = (LAS unsigned char*)lds_raw;
    const int tid0 = threadIdx.x; const int wid0 = __builtin_amdgcn_readfirstlane(tid0 >> 6);
    const int G0 = gridDim.x, c0 = blockIdx.x;
    unsigned* ctl0 = (unsigned*)(a.ws + WS_CTL);
    LAS unsigned char* lds0 = lds;
    const int lo = a.ph_lo, hi = a.ph_hi;

    LAS unsigned long long* ptbl = (LAS unsigned long long*)(lds + LDS_PTBL);
    if (tid0 == 0) {
#define PT_(k) ptbl[k] = (unsigned long long)a.in[k];
        PT_(0) PT_(1) PT_(2) PT_(3) PT_(4) PT_(5) PT_(6) PT_(7) PT_(8) PT_(9) PT_(10) PT_(11) PT_(12) PT_(13) PT_(14) PT_(15) PT_(16) PT_(17) PT_(18)
        PT_(19) PT_(20) PT_(21) PT_(22) PT_(23) PT_(24) PT_(25) PT_(26) PT_(27) PT_(28) PT_(29) PT_(30) PT_(31) PT_(32) PT_(33) PT_(34) PT_(35) PT_(36)
#undef PT_
        ptbl[37] = (unsigned long long)a.out; ptbl[38] = (unsigned long long)a.ws;
    }
    if (tid0 < 4) ((LAS unsigned*)(lds + LDS_BARW))[tid0] = 0u;
    __syncthreads();
    XcdBarrier bar; bar.bar = ctl0 + CW_BAR; bar.x = 0; bar.st = (volatile LAS unsigned*)(lds + LDS_BARW);
    if (hi - lo > 1) bar = xcd_barrier_post(ctl0 + CW_BAR, (volatile LAS unsigned*)(lds + LDS_BARW), tid0 == 0);
    int ph = 0, l0 = 0;
#define PH_ON() (ph >= lo && ph < hi)
#define PH_END() do { if (ph >= lo && ph + 1 < hi) { XcdBarrier bb_; bb_.bar = (unsigned*)lsg64((unsigned long long)bar.bar); bb_.x = bar.x; bb_.st = bar.st; xcd_barrier(bb_, lsg(wid0) == 0 && lane_id_v() == 0); PROBE_EXTRA_BAR(bb_) } ++ph; } while (0)

    if (PH_ON()) { DECL_PTRS();
        {
            constexpr int I_EVIN = 16 * 112, I_SQ = 16 * 32, I_ODIN = 16 * 64, I_GLU = 8 * 16;
            constexpr int I_PER = I_EVIN + I_SQ + I_ODIN + I_SQ + I_GLU;
            for (int it = gw; it < 2 * I_PER; it += NGW) {
                const int i = it / I_PER; int r = it % I_PER;
                if (r < I_EVIN) { transpose_item(ev_w_in + (size_t)i * 1024 * EV_N, 1024, EV_N, Wevin + (size_t)i * EV_NP * 1024, -1, 0, scr, r, 112, lane); continue; } r -= I_EVIN;
                if (r < I_SQ) { transpose_item(ev_w_out + (size_t)i * 1024 * 1024, 1024, 1024, Wevout + (size_t)i * 1024 * 1024, 1, 0, scr, r, 32, lane); continue; } r -= I_SQ;
                if (r < I_ODIN) { transpose_item(od_w_in + (size_t)i * 1024 * 2048, 1024, 2048, Wodin + (size_t)i * 2048 * 1024, -2, 0, scr, r, 64, lane); continue; } r -= I_ODIN;
                if (r < I_SQ) { transpose_item(od_w_out + (size_t)i * 1024 * 1024, 1024, 1024, Wodout + (size_t)i * 1024 * 1024, 1, 0, scr, r, 32, lane); continue; } r -= I_SQ;
                transpose_item(s5_glu_w + (size_t)i * 512 * 512, 512, 512, Wglu + (size_t)i * 512 * 512, 1, 0, scr, r, 16, lane);
            }
        }
        __syncthreads();
        {
            LAS float* cact = (LAS float*)lds;
            for (int i = tid; i < 2048; i += NTHREADS) { const float v = cin[i]; cact[i] = v / (1.0f + __expf(-v)); }
            __syncthreads();
            for (int idx = gt; idx < 4 * 4 * 6144; idx += NGT) {
                const int kq = idx / 24576, rem = idx % 24576, l = rem / 6144, n = rem % 6144;
                const float* w = ada_w + ((size_t)l * 1024 + kq * 256) * 6144 + n;
                float a0 = 0.f, a1 = 0.f;
#pragma unroll 32
                for (int k = 0; k < 256; ++k) { const float wv = w[(size_t)k * 6144]; a0 += cact[kq * 256 + k] * wv; a1 += cact[1024 + kq * 256 + k] * wv; }
                MODP[((size_t)(kq * 4 + l) * 2 + 0) * 6144 + n] = a0;
                MODP[((size_t)(kq * 4 + l) * 2 + 1) * 6144 + n] = a1;
            }
            __syncthreads();
        }
        for (int idx = gt; idx < S * 12; idx += NGT) {
            if (idx < S * 8) { const int pos = idx >> 3, j = idx & 7; const float inv = (float)pow(500000.0, -(double)(2 * j) / 16.0); const float ang = (float)pos * inv;
                COSH[idx] = (float)cos((double)ang); SINH[idx] = (float)sin((double)ang); }
            else { const int k = idx - S * 8; const int pos = k >> 2, j = k & 3; const float inv = (float)pow(500000.0, -(double)(2 * j) / 8.0); const float ang = (float)pos * inv;
                COSI[k] = (float)cos((double)ang); SINI[k] = (float)sin((double)ang); }
        }
        for (int idx = gt; idx < 2 * 32 * 64; idx += NGT) {
            const int i = idx >> 11, g = (idx >> 6) & 31;
            const float dt = expf(s5_log_dt[i * 32 + g]);
            const float lr = s5_lam_re[idx], li = s5_lam_im[idx];
            const float mag = expf(lr * dt);
            const float ar = mag * (float)cos((double)(li * dt)), ai = mag * (float)sin((double)(li * dt));
            const float den = lr * lr + li * li;
            const float cr = ((ar - 1.0f) * lr + ai * li) / den, ci = (ai * lr - (ar - 1.0f) * li) / den;
            S5A[idx * 2] = ar; S5A[idx * 2 + 1] = ai;
            { float pr = 1.f, pi_ = 0.f; for (int n = 0; n <= 64; ++n) { S5PW[((size_t)idx * 65 + n) * 2] = pr; S5PW[((size_t)idx * 65 + n) * 2 + 1] = pi_; const float nr = pr * ar - pi_ * ai, ni = pr * ai + pi_ * ar; pr = nr; pi_ = ni; } }
            { float brv[16], biv[16];
#pragma unroll
              for (int cc = 0; cc < 16; ++cc) { brv[cc] = s5_b_re[(size_t)idx * 16 + cc]; biv[cc] = s5_b_im[(size_t)idx * 16 + cc]; }
              __builtin_amdgcn_sched_barrier(0);
#pragma unroll
              for (int cc = 0; cc < 16; ++cc) { const float br = brv[cc], bi = biv[cc];
                  *(f32x2*)(S5B + ((size_t)idx * 16 + cc) * 2) = (f32x2){cr * br - ci * bi, cr * bi + ci * br}; } }
        }
        for (int idx = gt; idx < DEPTH * 48 * 1024; idx += NGT) {
            const int k = idx & 1023, col = (idx >> 10) % 48, ll = idx / (48 * 1024);
            const float w = col < 4 ? moe_wg[((size_t)ll * 1024 + k) * 4 + col] : col < 36 ? moe_we[((size_t)ll * 1024 + k) * 32 + col - 4] : 0.f;
            const unsigned hb = f2bf(w); WRH[idx] = (bf16_t)hb; WRL[idx] = (bf16_t)f2bf(w - __uint_as_float(hb << 16));
        }
        if (gw < 2) { const int i = gw;
            const float s1 = wave_sum(a_lq1[i * 64 + lane] * a_lk1[i * 64 + lane]), s2 = wave_sum(a_lq2[i * 64 + lane] * a_lk2[i * 64 + lane]);
            const float lam_init = 0.8f - 0.6f * expf(-0.3f * (float)(2 * i));
            if (lane == 0) LAM[i] = expf(s1) - expf(s2) + lam_init; }
    }
    PH_END();
    if (PH_ON()) { DECL_PTRS();
        for (int idx = gt; idx < 4 * 2 * 6144; idx += NGT) {
            const int l = idx / 12288, b = (idx / 6144) & 1, n = idx % 6144;
            float v = ada_b[l * 6144 + n];
#pragma unroll
            for (int kq = 0; kq < 4; ++kq) v += MODP[((size_t)(kq * 4 + l) * 2 + b) * 6144 + n];
            MOD[idx] = v;
        }
        for (int idx = gt; idx < 2 * 32 * 65 * 256; idx += NGT) {
            const int ci = idx & 15, co = (idx >> 4) & 15, tr = (idx >> 8) % 65, ig = idx / (65 * 256);
            float acc = 0.f;
            if (tr > 0) {
                const int tau = tr - 1;
#pragma unroll 16
                for (int p = 0; p < 64; ++p) { const int sp = ig * 64 + p;
                    const float cr = s5_c_re[((size_t)ig * 16 + co) * 64 + p], cim_ = s5_c_im[((size_t)ig * 16 + co) * 64 + p];
                    const f32x2 pw_ = *(const f32x2*)(S5PW + ((size_t)sp * 65 + tau) * 2), bb_ = *(const f32x2*)(S5B + ((size_t)sp * 16 + ci) * 2);
                    const float pr = pw_.x, pi_ = pw_.y, br = bb_.x, bi = bb_.y;
                    const float xr = cr * pr - cim_ * pi_, xi = cr * pi_ + cim_ * pr;
                    acc += xr * br - xi * bi; }
            }
            S5KT[((size_t)ig * 65 + tr) * 384 + co * 24 + ci] = (bf16_t)f2bf(acc);
        }
        constexpr int NW_ = 2 * 32 * 128 * 1024;
        for (int idx0 = gt; idx0 < NW_; idx0 += NGT * 8) {
            f32x2 pw_[8], bb_[8];
#pragma unroll
            for (int u = 0; u < 8; ++u) { const int idx = min(idx0 + u * NGT, NW_ - 1);
                const int k = idx & 1023, row = (idx >> 10) & 127, ig = idx >> 17; const int s = k >> 4, ci = k & 15, p = row >> 1; const int sp = ig * 64 + p;
                pw_[u] = *(const f32x2*)(S5PW + ((size_t)sp * 65 + (63 - s)) * 2); bb_[u] = *(const f32x2*)(S5B + ((size_t)sp * 16 + ci) * 2); }
            __builtin_amdgcn_sched_barrier(0);
#pragma unroll
            for (int u = 0; u < 8; ++u) { const int idx = idx0 + u * NGT;
                if (idx < NW_) { const int ri = (idx >> 10) & 1; const float pr = pw_[u].x, pi_ = pw_[u].y, br = bb_[u].x, bi = bb_[u].y;
                    S5WT[idx] = (bf16_t)f2bf(ri ? (pr * bi + pi_ * br) : (pr * br - pi_ * bi)); } }
            __builtin_amdgcn_sched_barrier(0);
        }
        for (int idx0 = gt; idx0 < NW_; idx0 += NGT * 8) {
            f32x2 pw_[8]; float crv[8], civ[8];
#pragma unroll
            for (int u = 0; u < 8; ++u) { const int idx = min(idx0 + u * NGT, NW_ - 1);
                const int k = idx & 127, rowt = (idx >> 7) & 1023, ig = idx >> 17; const int t = rowt >> 4, co = rowt & 15, p = k >> 1; const int sp = ig * 64 + p;
                crv[u] = s5_c_re[((size_t)ig * 16 + co) * 64 + p]; civ[u] = s5_c_im[((size_t)ig * 16 + co) * 64 + p];
                pw_[u] = *(const f32x2*)(S5PW + ((size_t)sp * 65 + t + 1) * 2); }
            __builtin_amdgcn_sched_barrier(0);
#pragma unroll
            for (int u = 0; u < 8; ++u) { const int idx = idx0 + u * NGT;
                if (idx < NW_) { const int ri = idx & 1; const float cr = crv[u], cim_ = civ[u], pr = pw_[u].x, pi_ = pw_[u].y;
                    S5A2[idx] = (bf16_t)f2bf(ri ? -(cr * pi_ + cim_ * pr) : (cr * pr - cim_ * pi_)); } }
            __builtin_amdgcn_sched_barrier(0);
        }
    }
    PH_END();
    if (PH_ON()) { DECL_PTRS();
        for (int t0 = gw * 4; t0 < T; t0 += NGW * 4) {
            const int b = t0 / S; const float* mo = MOD + (size_t)(0 * 2 + b) * 6144;
            f32x4 v[4][4], sc1[4], sh1[4];
#pragma unroll
            for (int u = 0; u < 4; ++u)
#pragma unroll
                for (int j = 0; j < 4; ++j) v[u][j] = *(const f32x4*)(xin + (size_t)(t0 + u) * 1024 + 4 * lane + 256 * j);
#pragma unroll
            for (int j = 0; j < 4; ++j) { sc1[j] = *(const f32x4*)(mo + 1024 + 4 * lane + 256 * j); sh1[j] = *(const f32x4*)(mo + 4 * lane + 256 * j); }
            __builtin_amdgcn_sched_barrier(0);
#pragma unroll
            for (int u = 0; u < 4; ++u) { float ss = 0.f;
#pragma unroll
                for (int j = 0; j < 4; ++j) ss += (v[u][j].x * v[u][j].x + v[u][j].y * v[u][j].y) + (v[u][j].z * v[u][j].z + v[u][j].w * v[u][j].w);
                const float rn = rsqrtf(wave_sum(ss) * (1.0f / 1024.0f) + EPS);
#pragma unroll
                for (int j = 0; j < 4; ++j) { const int col = 4 * lane + 256 * j;
                    u32x2 w; w.x = pk2(v[u][j].x * rn * (1.f + sc1[j].x) + sh1[j].x, v[u][j].y * rn * (1.f + sc1[j].y) + sh1[j].y); w.y = pk2(v[u][j].z * rn * (1.f + sc1[j].z) + sh1[j].z, v[u][j].w * rn * (1.f + sc1[j].w) + sh1[j].w);
                    *(u32x2*)(H + (size_t)(t0 + u) * 1024 + col) = w; } }
            __builtin_amdgcn_sched_barrier(0);
        }
    }
    PH_END();

    for (l0 = 0; l0 < DEPTH; ++l0) {
        if ((l0 & 1) == 0) {
            if (PH_ON()) { DECL_PTRS();
                pg8::Gemm g{H, Wevin + (size_t)i * EV_NP * 1024, T, EV_NP, 1024, 0}; pg8::StaticOrder So; So.init(T, EV_NP, G, c);
                EpiEvenIn E{Z, IQH, IKH, IW, a_kn + i * 64, b_kn + i * 64, b_idx_kn + i * 32, COSH, SINH, COSI, SINI};
                { PROBE_WRAP(pg8::StaticOrder, So); pg8::gemm_phase<EpiEvenIn, PROBE_SCHED(pg8::StaticOrder), true, true>(glds, g, PS_, E, tid); }
            }
            PH_END();
            if (PH_ON()) { DECL_PTRS();
                moe_convert(moe_w1 + (size_t)l * 32 * 1024 * 512, moe_w3 + (size_t)l * 32 * 1024 * 512, moe_w2 + (size_t)l * 32 * 512 * 1024, W13, W2, scr, gw, NGW, lane);
                __syncthreads();
                {
                    LAS unsigned short* kq = (LAS unsigned short*)lds;
                    const int qi = tid >> 7, ht = tid & 127;
                    LAS unsigned short* kqq = kq + qi * 16384;
                    LAS unsigned* hist = (LAS unsigned*)(lds + LDS_MISC + qi * 6400);
                    LAS unsigned* bits = hist + 1024;
                    LAS unsigned* misc = hist + 1536;
                    typedef _Float16 f16x8_t __attribute__((ext_vector_type(8)));
                    f16x8_t qaN[2], kbN[4][2]; f32x4 wqN[4];
                    auto issue_unit = [&](int it_) {
                        const int lane_ = lane_id_v(), r32 = lane_ & 31, hi = lane_ >> 5, wid_ = lsg(wid0);
                        const int L_ = min(it_ * G + c, 8191);
                        const int uu_ = (L_ & 1) ? (8191 - (L_ >> 1)) : (L_ >> 1); const int b_ = uu_ >> 12, pp_ = uu_ & 4095;
                        const size_t tA_ = (size_t)b_ * S + 4 * pp_; const int ntile_ = (4 * pp_ + 4 + 31) >> 5;
#pragma unroll
                        for (int s = 0; s < 2; ++s) qaN[s] = *(const f16x8_t*)(IQH + (tA_ + 2 * ((r32 >> 2) & 1) + (r32 >> 4)) * 256 + (4 * ((r32 >> 3) & 1) + (r32 & 3)) * 32 + 16 * s + 8 * hi);
#pragma unroll
                        for (int q = 0; q < 4; ++q) wqN[q] = *(const f32x4*)(IW + (tA_ + 2 * hi + (q >> 1)) * 8 + 4 * (q & 1));
                        const _Float16* kbase_ = IKH + ((size_t)b_ * S + r32) * 32 + 8 * hi;
#pragma unroll
                        for (int u = 0; u < 4; ++u) { const int tile = min(wid_ + NWAVES * u, ntile_ - 1);
                            kbN[u][0] = *(const f16x8_t*)(kbase_ + (size_t)tile * 1024); kbN[u][1] = *(const f16x8_t*)(kbase_ + (size_t)tile * 1024 + 16); } };
                    issue_unit(0);
                    for (int it = 0;; ++it) {
                        const int L = it * G + c; if (L >= 8192) break;
                        const int uu = (L & 1) ? (8191 - (L >> 1)) : (L >> 1);
                        const int b = uu >> 12, pp = uu & 4095;
                        const size_t tA = (size_t)b * S + 4 * pp;
                        const int nD = 4 * pp + 4;
#pragma unroll
                        for (int q = 0; q < 8; ++q) hist[ht + 128 * q] = 0u;
                        __syncthreads();
#ifdef PROBE_MASK
                        if (a.probe_var != 2)
#endif
                        {
                            const int r32 = lane & 31, hi = lane >> 5;
                            f16x8_t qa[2]; qa[0] = qaN[0]; qa[1] = qaN[1];
                            f32x4 wq[4];
#pragma unroll
                            for (int q = 0; q < 4; ++q) wq[q] = wqN[q];
                            const int ntile = (nD + 31) >> 5;
                            const _Float16* kbase = IKH + ((size_t)b * S + r32) * 32 + 8 * hi;
                            f16x8_t kb[4][2], kn[4][2];
#pragma unroll
                            for (int u = 0; u < 4; ++u) { kb[u][0] = kbN[u][0]; kb[u][1] = kbN[u][1]; }
                            for (int tile0 = wid; tile0 < ntile; tile0 += NWAVES * 4) {
#pragma unroll
                                for (int u = 0; u < 4; ++u) { const int tile = min(tile0 + NWAVES * (4 + u), ntile - 1);
                                    kn[u][0] = *(const f16x8_t*)(kbase + (size_t)tile * 1024); kn[u][1] = *(const f16x8_t*)(kbase + (size_t)tile * 1024 + 16); }
#pragma unroll
                                for (int u = 0; u < 4; ++u) {
                                    const int tile = tile0 + NWAVES * u;
                                    attn_body::f32x16 acc;
#pragma unroll
                                    for (int r = 0; r < 16; ++r) acc[r] = 0.f;
                                    acc = __builtin_amdgcn_mfma_f32_32x32x16_f16(qa[0], kb[u][0], acc, 0, 0, 0);
                                    acc = __builtin_amdgcn_mfma_f32_32x32x16_f16(qa[1], kb[u][1], acc, 0, 0, 0);
                                    float sq[4];
#pragma unroll
                                    for (int q = 0; q < 4; ++q) sq[q] = wq[q].x * relu_i(acc[4 * q]) + wq[q].y * relu_i(acc[4 * q + 1]) + wq[q].z * relu_i(acc[4 * q + 2]) + wq[q].w * relu_i(acc[4 * q + 3]);
                                    if (tile < ntile) {
                                        const float sa = sq[0] + sq[1], sb = sq[2] + sq[3];
                                        const unsigned h0 = (unsigned)__builtin_bit_cast(unsigned short, (_Float16)sa), h1 = (unsigned)__builtin_bit_cast(unsigned short, (_Float16)sb);
                                        const unsigned k0_ = (h0 ^ ((unsigned)__builtin_amdgcn_sbfe((int)h0, 15, 1) | 0x8000u)) & 0xFFFFu, k1_ = (h1 ^ ((unsigned)__builtin_amdgcn_sbfe((int)h1, 15, 1) | 0x8000u)) & 0xFFFFu;
                                        const int kidx = tile * 32 + r32;
                                        kq[(2 * hi) * 16384 + kidx] = (unsigned short)k0_;
                                        kq[(2 * hi + 1) * 16384 + kidx] = (unsigned short)k1_;
                                        LAS unsigned* hq0 = (LAS unsigned*)(lds + LDS_MISC + (2 * hi) * 6400); LAS unsigned* hq1 = (LAS unsigned*)(lds + LDS_MISC + (2 * hi + 1) * 6400);
                                        __hip_atomic_fetch_add(&hq0[(kidx <= 4 * pp + 2 * hi) ? ((k0_ >> 8) << 2) + (lane & 3) : 1536 + 32 + (lane & 3)], 1u, __ATOMIC_RELAXED, __HIP_MEMORY_SCOPE_WORKGROUP);
                                        __hip_atomic_fetch_add(&hq1[(kidx <= 4 * pp + 2 * hi + 1) ? ((k1_ >> 8) << 2) + (lane & 3) : 1536 + 32 + (lane & 3)], 1u, __ATOMIC_RELAXED, __HIP_MEMORY_SCOPE_WORKGROUP);
                                    }
                                }
#pragma unroll
                                for (int u = 0; u < 4; ++u) { kb[u][0] = kn[u][0]; kb[u][1] = kn[u][1]; }
                            }
                            issue_unit(it + 1);
                        }
                        __syncthreads();
#ifdef PROBE_MASK
                        if (a.probe_var == 1) continue;
#endif
                        const int n = 4 * pp + 1 + qi;
                        const bool small = n <= 256;
                        if (ht == 0) { misc[0] = 0u; misc[1] = 256u; misc[2] = 0u; }
                        const LAS unsigned* kq32 = (const LAS unsigned*)kqq;
                        const int npair = (n + 1) >> 1;
                        for (int pass = 0; pass < 2; ++pass) {
                            if (pass) {
#pragma unroll
                                for (int q = 0; q < 8; ++q) hist[ht + 128 * q] = 0u; }
                            __syncthreads();
                            const int shift = 8 - 8 * pass;
                            if (!small && pass) {
                                const unsigned prefix = misc[0];
                                for (int W = ht; 32 * W < n; W += 128) {
                                    const unsigned vmask = (n - 32 * W >= 32) ? 0xFFFFFFFFu : ((1u << (n - 32 * W)) - 1u);
                                    const LAS u32x4* kp = (const LAS u32x4*)(kq32 + 16 * W);
                                    unsigned ne = 0u;
                                    const unsigned pp2 = prefix | (prefix << 16);
#pragma unroll
                                    for (int q4 = 0; q4 < 4; ++q4) { const u32x4 w4 = kp[q4];
#pragma unroll
                                        for (int e = 0; e < 4; ++e) ne |= pk_gt_u16((w4[e] ^ pp2) & 0xFF00FF00u, 0u, 0x00010001u) << (4 * q4 + e); }
                                    unsigned mm = ilv16(~ne) & vmask;
                                    const LAS unsigned short* k16 = kqq + 32 * W;
                                    while (mm) { const int j = __ffs(mm) - 1; mm &= mm - 1u;
                                        __hip_atomic_fetch_add(&hist[(((unsigned)k16[j] & 255u) << 2) + (lane & 3)], 1u, __ATOMIC_RELAXED, __HIP_MEMORY_SCOPE_WORKGROUP); }
                                }
                            }
                            __syncthreads();
                            if (!small && ht < 64) {
                                unsigned cb[4];
#pragma unroll
                                for (int q = 0; q < 4; ++q) { const u32x4 a0 = *(const LAS u32x4*)(hist + (4 * ht + q) * 4); cb[q] = (a0.x + a0.y) + (a0.z + a0.w); }
                                const unsigned c0 = cb[0], c1 = cb[1], c2 = cb[2], c3 = cb[3];
                                const unsigned tot = c0 + c1 + c2 + c3;
                                unsigned Ssum = tot;
#pragma unroll
                                for (int off = 1; off < 64; off <<= 1) { const unsigned v = shi_(Ssum, lane + off); if (ht + off < 64) Ssum += v; }
                                const unsigned above = Ssum - tot, krem = misc[1];
                                if (above < krem && krem <= Ssum) {
                                    unsigned run = above, bin, eq;
                                    if (run + c3 >= krem) { bin = 3; eq = c3; }
                                    else { run += c3; if (run + c2 >= krem) { bin = 2; eq = c2; }
                                        else { run += c2; if (run + c1 >= krem) { bin = 1; eq = c1; } else { run += c1; bin = 0; eq = c0; } } }
                                    misc[0] = misc[0] | ((4u * ht + bin) << shift); misc[1] = krem - run; misc[2] = eq;
                                }
                            }
                            __syncthreads();
                        }
#ifdef PROBE_MASK
                        if (a.probe_var == 8) { __syncthreads(); continue; }
#endif
                        const unsigned Tkey = misc[0], krem = misc[1], cnteq = misc[2];
                        LAS unsigned* eqb = hist;
                        const bool all_eq = (cnteq == krem);
                        for (int W = ht; W < 512; W += 128) {
                            unsigned sel = 0u, eqm = 0u;
                            if (32 * W < n) {
                                const unsigned vmask = (n - 32 * W >= 32) ? 0xFFFFFFFFu : ((1u << (n - 32 * W)) - 1u);
                                if (small) sel = vmask;
                                else {
                                    const LAS u32x4* kp = (const LAS u32x4*)(kq32 + 16 * W);
                                    const unsigned tp2 = Tkey | (Tkey << 16);
                                    unsigned ag = 0u, al = 0u;
#pragma unroll
                                    for (int q4 = 0; q4 < 4; ++q4) { const u32x4 w4 = kp[q4];
#pragma unroll
                                        for (int e = 0; e < 4; ++e) { ag |= pk_gt_u16(w4[e], tp2, 0x00010001u) << (4 * q4 + e); al |= pk_gt_u16(tp2, w4[e], 0x00010001u) << (4 * q4 + e); } }
                                    sel = ilv16(ag); eqm = ilv16(~(ag | al));
                                    if (all_eq) { sel |= eqm; eqm = 0u; }
                                    sel &= vmask; eqm &= vmask;
                                }
                            }
                            bits[W] = sel; eqb[W] = eqm;
                        }
                        __syncthreads();
                        if (!small && !all_eq && ht < 64) {
                            unsigned wv_[8]; unsigned cnt = 0u;
#pragma unroll
                            for (int q = 0; q < 8; ++q) { wv_[q] = eqb[8 * ht + q]; cnt += (unsigned)__popc(wv_[q]); }
                            unsigned inc = cnt;
#pragma unroll
                            for (int off = 1; off < 64; off <<= 1) { const unsigned v = shi_(inc, lane - off); if (lane >= off) inc += v; }
                            unsigned before = inc - cnt;
#pragma unroll
                            for (int q = 0; q < 8; ++q) { unsigned w = wv_[q], keep = 0u;
                                while (w && before < krem) { const unsigned lowb = w & (0u - w); keep |= lowb; w ^= lowb; ++before; }
                                before += (unsigned)__popc(w);
                                if (keep) __hip_atomic_fetch_or(&bits[8 * ht + q], keep, __ATOMIC_RELAXED, __HIP_MEMORY_SCOPE_WORKGROUP); }
                        }
                        __syncthreads();
                        {
                            const int qpos = 4 * pp + qi; const int tmax = 8 * (qpos >> 9) + 7;
#pragma unroll
                            for (int j = 0; j < 2; ++j) { const int tt = 2 * ht + j;
                                if (tt <= tmax) { const unsigned W0 = bits[2 * tt], W1 = bits[2 * tt + 1];
                                    unsigned e0 = W0 & 0x0F0F0F0Fu, e1 = W1 & 0x0F0F0F0Fu, o0 = (W0 >> 4) & 0x0F0F0F0Fu, o1 = (W1 >> 4) & 0x0F0F0F0Fu;
                                    e0 = (e0 | (e0 >> 4)) & 0x00FF00FFu; e0 = (e0 | (e0 >> 8)) & 0xFFFFu; e1 = (e1 | (e1 >> 4)) & 0x00FF00FFu; e1 = (e1 | (e1 >> 8)) & 0xFFFFu;
                                    o0 = (o0 | (o0 >> 4)) & 0x00FF00FFu; o0 = (o0 | (o0 >> 8)) & 0xFFFFu; o1 = (o1 | (o1 >> 4)) & 0x00FF00FFu; o1 = (o1 | (o1 >> 8)) & 0xFFFFu;
                                    u32x2 pm; pm.x = e0 | (e1 << 16); pm.y = o0 | (o1 << 16);
                                    *(u32x2*)(MASKW + (((size_t)(b * 256 + tt)) * S + qpos) * 2) = pm; } }
                        }
                        __syncthreads();
                    }
                }
                __syncthreads();
                {
                    bf16_t* OA = YMIX;
                    const int vcu = (G % 8 == 0) ? (c % 8) * (G / 8) + c / 8 : c;
                    const int nu = (G == 256) ? 4 : (1024 - vcu + G - 1) / G;
                    const bool nomax_a = qk_bounded(a_qn + i * 64, a_kn + i * 64, lane);
                    for (int iu = 0; iu < nu; ++iu) {
                        const int lane = lane_id_v(), wid = lsg(wid0);
                        LAS unsigned char* L0 = lsgp(lds0);
                        int combo, qb;
                        if (G == 256) { combo = vcu >> 4; const int s_ = vcu & 15; qb = iu == 0 ? s_ : iu == 1 ? 31 - s_ : iu == 2 ? 32 + s_ : 63 - s_; }
                        else { const int u = vcu + iu * G; combo = u & 15; qb = 63 - (u >> 4); }
                        const int b = combo >> 3, hc = combo & 7;
                        const bf16_t* zb = Z + (size_t)b * S * EV_ZP;
                        if (nomax_a)
                            flash_unit<2, false, true, EV_ZP, 1024, true>(L0, zb + hc * 64, zb + 512 + hc * 64, zb + 1024 + (hc >> 1) * 128, OA + (size_t)b * S * 1024 + hc * 128, nullptr, qb, wid, lane, a_qn + i * 64, COSH, SINH);
                        else
                            flash_unit<2, false, true, EV_ZP, 1024, false>(L0, zb + hc * 64, zb + 512 + hc * 64, zb + 1024 + (hc >> 1) * 128, OA + (size_t)b * S * 1024 + hc * 128, nullptr, qb, wid, lane, a_qn + i * 64, COSH, SINH);
                    }
                }
            }
            PH_END();
            if (PH_ON()) { DECL_PTRS();
                {
                    const bf16_t* OA = YMIX; const float lamv = LAM[i]; const float lam_init = 0.8f - 0.6f * expf(-0.3f * (float)l);
                    const int h = lane >> 4, vj = (lane >> 3) & 1, d8 = (lane & 7) * 8;
                    float gn[8];
#pragma unroll
                    for (int e = 0; e < 8; ++e) gn[e] = a_subln[i * 128 + vj * 64 + d8 + e] * (1.0f - lam_init);
                    for (int t0 = gw * 4; t0 < T; t0 += NGW * 4) {
                        u32x4 r1[4], r2[4];
#pragma unroll
                        for (int u = 0; u < 4; ++u) { r1[u] = *(const u32x4*)(OA + (size_t)(t0 + u) * 1024 + ((h * 2 + 0) * 2 + vj) * 64 + d8); r2[u] = *(const u32x4*)(OA + (size_t)(t0 + u) * 1024 + ((h * 2 + 1) * 2 + vj) * 64 + d8); }
                        __builtin_amdgcn_sched_barrier(0);
#pragma unroll
                        for (int u = 0; u < 4; ++u) {
                            float o1[8], o2[8], dd[8]; unpack8(r1[u], o1); unpack8(r2[u], o2);
                            float ss = 0.f;
#pragma unroll
                            for (int e = 0; e < 8; ++e) { dd[e] = o1[e] - lamv * o2[e]; ss += dd[e] * dd[e]; }
                            ss += dpp_xor1(ss); ss += dpp_xor2(ss); ss += SHX(ss, 4); ss += SHX(ss, 8);
                            const float r = rsqrtf(ss * (1.0f / 128.0f) + EPS);
#pragma unroll
                            for (int e = 0; e < 8; ++e) dd[e] = dd[e] * r * gn[e];
                            *(u32x4*)(O + (size_t)(t0 + u) * 1024 + h * 128 + vj * 64 + d8) = pack8(dd);
                        }
                        __builtin_amdgcn_sched_barrier(0);
                    }
                }
                {
                    const int vcu = (G % 8 == 0) ? (c % 8) * (G / 8) + c / 8 : c;
                    const int nu = (G == 256) ? 2 : (512 - vcu + G - 1) / G;
                    const bool nomax_b = qk_bounded(b_qn + i * 64, b_kn + i * 64, lane);
                    for (int iu = 0; iu < nu; ++iu) {
                        const int lane = lane_id_v(), wid = lsg(wid0);
                        LAS unsigned char* L0 = lsgp(lds0);
                        int combo, qb;
                        if (G == 256) { combo = vcu >> 4; const int s_ = vcu & 15; qb = iu == 0 ? s_ : 31 - s_; }
                        else { const int u = vcu + iu * G; combo = u & 15; qb = 31 - (u >> 4); }
                        const int b = combo >> 3, h = combo & 7;
                        const bf16_t* zb = Z + (size_t)b * S * EV_ZP;
                        if (nomax_b)
                            flash_unit_q2<1, true, false, EV_ZP, 1024, true>(L0, zb + 1536 + h * 64, zb + 2048 + h * 64, zb + 2560 + h * 64, O + (size_t)b * S * 1024 + 512 + h * 64, MASKW + (size_t)b * 256 * S * 2, qb, wid, lane, b_qn + i * 64, COSH, SINH);
                        else
                            flash_unit_q2<1, true, false, EV_ZP, 1024, false>(L0, zb + 1536 + h * 64, zb + 2048 + h * 64, zb + 2560 + h * 64, O + (size_t)b * S * 1024 + 512 + h * 64, MASKW + (size_t)b * 256 * S * 2, qb, wid, lane, b_qn + i * 64, COSH, SINH);
                    }
                }
            }
            PH_END();
        } else {
            if (PH_ON()) { DECL_PTRS();
                pg8::Gemm g{H, Wodin + (size_t)i * OD_N * 1024, T, OD_N, 1024, 0}; pg8::StaticOrder So; So.init(T, OD_N, G, c);
                EpiOddIn E{Z, UG, c_kn + i * 64, COSH, SINH};
                { PROBE_WRAP(pg8::StaticOrder, So); pg8::gemm_phase<EpiOddIn, PROBE_SCHED(pg8::StaticOrder), true, true>(glds, g, PS_, E, tid); }
            }
            PH_END();
            if (PH_ON()) { DECL_PTRS();
                moe_convert(moe_w1 + (size_t)l * 32 * 1024 * 512, moe_w3 + (size_t)l * 32 * 1024 * 512, moe_w2 + (size_t)l * 32 * 512 * 1024, W13, W2, scr, gw, NGW, lane);
                __syncthreads();
                for (int u = gw; u < NB * 64 * 8; u += NGW) {
                    const int h = u & 7, blk = (u >> 3) & 63, b = u >> 9;
                    const int rs = lane >> 3, d8 = (lane & 7) * 8;
                    const bf16_t* kp = Z + ((size_t)b * S + blk * 256 + rs) * OD_N + 512 + h * 64 + d8;
                    u32x4 kr[32];
#pragma unroll
                    for (int j = 0; j < 32; ++j) kr[j] = *(const u32x4*)(kp + (size_t)(8 * j) * OD_N);
                    __builtin_amdgcn_sched_barrier(0);
                    float sm[8];
#pragma unroll
                    for (int e = 0; e < 8; ++e) sm[e] = 0.f;
#pragma unroll
                    for (int j = 0; j < 32; ++j) { float kv[8]; unpack8(kr[j], kv);
#pragma unroll
                        for (int e = 0; e < 8; ++e) sm[e] += kv[e]; }
#pragma unroll
                    for (int e = 0; e < 8; ++e) { sm[e] += SHX(sm[e], 8); sm[e] += SHX(sm[e], 16); sm[e] += SHX(sm[e], 32); sm[e] *= (1.0f / 256.0f); }
                    if (rs == 0) {
                        *(f32x4*)(KM + (size_t)u * 64 + d8) = (f32x4){sm[0], sm[1], sm[2], sm[3]}; *(f32x4*)(KM + (size_t)u * 64 + d8 + 4) = (f32x4){sm[4], sm[5], sm[6], sm[7]};
                        const u32x4 hw = pack8(sm); float hf[8], lo[8]; unpack8(hw, hf);
#pragma unroll
                        for (int e = 0; e < 8; ++e) lo[e] = sm[e] - hf[e];
                        *(u32x4*)(KMH + ((size_t)(b * 8 + h) * 64 + blk) * 64 + d8) = hw; *(u32x4*)(KML + ((size_t)(b * 8 + h) * 64 + blk) * 64 + d8) = pack8(lo);
                    }
                }
                {
                    const int r32 = lane & 31, hi = lane >> 5;
                    LAS unsigned char* ldsU = lds;
                    LAS float* red = (LAS float*)(lds + 69632);
                    for (int task = c; task < 512; task += G) {
                        const int g = task >> 4, cs = task & 15;
                        for (int q = tid; q < 32 * 128; q += NTHREADS) { const int j = q >> 7, off = (q & 127) * 16;
                            *(LAS u32x4*)(ldsU + j * 2064 + off) = *(const u32x4*)((const unsigned char*)UG + ((size_t)g * T + (size_t)(cs * 32 + j) * 64) * 32 + off); }
                        __syncthreads();
                        const int rb = wid & 3, kh = wid >> 2;
                        attn_body::f32x16 acc;
#pragma unroll
                        for (int r = 0; r < 16; ++r) acc[r] = 0.f;
                        const bf16_t* wrow = S5WT + ((size_t)(i * 32 + g) * 128 + rb * 32 + r32) * 1024 + hi * 8;
#pragma unroll 1
                        for (int ks0 = kh * 32; ks0 < kh * 32 + 32; ks0 += 16) {
                            attn_body::bf16x8 Af[16];
#pragma unroll
                            for (int k = 0; k < 16; ++k) Af[k] = *(const attn_body::bf16x8*)(wrow + (ks0 + k) * 16);
                            __builtin_amdgcn_sched_barrier(0);
#pragma unroll
                            for (int k = 0; k < 16; ++k) {
                                const attn_body::bf16x8 B = *(const LAS attn_body::bf16x8*)(ldsU + r32 * 2064 + (ks0 + k) * 32 + hi * 16);
                                acc = __builtin_amdgcn_mfma_f32_32x32x16_bf16(Af[k], B, acc, 0, 0, 0); }
                            __builtin_amdgcn_sched_barrier(0);
                        }
                        if (kh == 1) {
#pragma unroll
                            for (int r = 0; r < 16; ++r) red[(rb * 64 + lane) * 16 + r] = acc[r];
                        }
                        __syncthreads();
                        if (kh == 0) {
                            float* ep = S5E + ((size_t)(cs * 32 + r32) * 32 + g) * 128 + rb * 32 + 4 * hi;
#pragma unroll
                            for (int q4 = 0; q4 < 4; ++q4) { f32x4 o;
                                o.x = acc[4 * q4] + red[(rb * 64 + lane) * 16 + 4 * q4]; o.y = acc[4 * q4 + 1] + red[(rb * 64 + lane) * 16 + 4 * q4 + 1];
                                o.z = acc[4 * q4 + 2] + red[(rb * 64 + lane) * 16 + 4 * q4 + 2]; o.w = acc[4 * q4 + 3] + red[(rb * 64 + lane) * 16 + 4 * q4 + 3];
                                *(f32x4*)(ep + 8 * q4) = o; }
                        }
                        __syncthreads();
                    }
                }
            }
            PH_END();
            if (PH_ON()) { DECL_PTRS();
#ifndef SKIP_S5
                {
                    for (int idx = gt; idx < NB * 32 * 64; idx += NGT) {
                        const int b = idx >> 11, g = (idx >> 6) & 31, p = idx & 63;
                        const int sp = (i * 32 + g) * 64 + p;
                        const float aLr = S5PW[((size_t)sp * 65 + 64) * 2], aLi = S5PW[((size_t)sp * 65 + 64) * 2 + 1];
                        float hr = 0.f, hi_ = 0.f;
                        for (int c0 = 0; c0 < 256; c0 += 32) {
                            float er[32], ei[32];
#pragma unroll
                            for (int k = 0; k < 32; ++k) { const float* ep = S5E + ((size_t)(b * 256 + c0 + k) * 32 + g) * 128 + 2 * p; er[k] = ep[0]; ei[k] = ep[1]; }
                            __builtin_amdgcn_sched_barrier(0);
#pragma unroll
                            for (int k = 0; k < 32; ++k) asm volatile("" : "+v"(er[k]), "+v"(ei[k]));
#pragma unroll
                            for (int k = 0; k < 32; ++k) {
                                *(unsigned*)(S5HC + ((size_t)(b * 256 + c0 + k) * 32 + g) * 128 + 2 * p) = pk2(hr, hi_);
                                const float nr = aLr * hr - aLi * hi_ + er[k], ni = aLr * hi_ + aLi * hr + ei[k]; hr = nr; hi_ = ni; }
                        }
                    }
                }
#endif
                {
                    unsigned* mcnt = ctl + CW_MCNT + i * 1024;
                    const int r32 = lane & 31, hi = lane >> 5;
                    for (int u = c; u < NB * 8 * 64; u += G) {
                        const int tb = u & 63, h = (u >> 6) & 7, b = u >> 9;
                        const int pos = tb * 256 + wid * 32 + r32; const size_t t = (size_t)b * S + pos;
                        float tv[3] = {-INFINITY, -INFINITY, -INFINITY}; int ti[3] = {1 << 20, 1 << 20, 1 << 20};
                        if (tb > 0) {
                            const bf16_t* kh = KMH + ((size_t)(b * 8 + h) * 64 + r32) * 64 + hi * 8; const bf16_t* kl = KML + ((size_t)(b * 8 + h) * 64 + r32) * 64 + hi * 8;
                            attn_body::bf16x8 mh[2][4], ml_[2][4];
#pragma unroll
                            for (int half = 0; half < 2; ++half)
#pragma unroll
                                for (int d0 = 0; d0 < 4; ++d0) { mh[half][d0] = *(const attn_body::bf16x8*)(kh + half * 32 * 64 + d0 * 16); ml_[half][d0] = *(const attn_body::bf16x8*)(kl + half * 32 * 64 + d0 * 16); }
                            __builtin_amdgcn_sched_barrier(0);
                            attn_body::bf16x8 qr[4];
                            load_q_normed(qr, Z + t * OD_N + h * 64, c_qn + i * 64, COSH, SINH, pos, hi, lane);
                            attn_body::f32x16 g0, g1;
#pragma unroll
                            for (int r = 0; r < 16; ++r) { g0[r] = 0.f; g1[r] = 0.f; }
#pragma unroll
                            for (int d0 = 0; d0 < 4; ++d0) {
                                g0 = __builtin_amdgcn_mfma_f32_32x32x16_bf16(mh[0][d0], qr[d0], g0, 0, 0, 0);
                                g0 = __builtin_amdgcn_mfma_f32_32x32x16_bf16(ml_[0][d0], qr[d0], g0, 0, 0, 0);
                                g1 = __builtin_amdgcn_mfma_f32_32x32x16_bf16(mh[1][d0], qr[d0], g1, 0, 0, 0);
                                g1 = __builtin_amdgcn_mfma_f32_32x32x16_bf16(ml_[1][d0], qr[d0], g1, 0, 0, 0); }
#pragma unroll
                            for (int half = 0; half < 2; ++half)
#pragma unroll
                                for (int r = 0; r < 16; ++r) { const int n = half * 32 + attn_body::crow(r, hi); const float gv = (n < tb) ? (half ? g1[r] : g0[r]) : -INFINITY;
                                    if (gv > tv[0]) { tv[2] = tv[1]; ti[2] = ti[1]; tv[1] = tv[0]; ti[1] = ti[0]; tv[0] = gv; ti[0] = n; }
                                    else if (gv > tv[1]) { tv[2] = tv[1]; ti[2] = ti[1]; tv[1] = gv; ti[1] = n; }
                                    else if (gv > tv[2]) { tv[2] = gv; ti[2] = n; } }
                            float pv_[3]; int pi_[3];
#pragma unroll
                            for (int k = 0; k < 3; ++k) { pv_[k] = SHX(tv[k], 32); pi_[k] = (int)shi_((unsigned)ti[k], lane ^ 32); }
                            float mv[3]; int mi[3]; int ia = 0, ib = 0;
#pragma unroll
                            for (int k = 0; k < 3; ++k) {
                                const float av = ia == 0 ? tv[0] : ia == 1 ? tv[1] : ia == 2 ? tv[2] : -INFINITY; const int ai = ia == 0 ? ti[0] : ia == 1 ? ti[1] : ia == 2 ? ti[2] : (1 << 20);
                                const float bv = ib == 0 ? pv_[0] : ib == 1 ? pv_[1] : ib == 2 ? pv_[2] : -INFINITY; const int bi = ib == 0 ? pi_[0] : ib == 1 ? pi_[1] : ib == 2 ? pi_[2] : (1 << 20);
                                const bool ta = (av > bv) || (av == bv && ai < bi);
                                mv[k] = ta ? av : bv; mi[k] = ta ? ai : bi; if (ta) ++ia; else ++ib; }
#pragma unroll
                            for (int k = 0; k < 3; ++k) { tv[k] = mv[k]; ti[k] = mi[k]; }
                        }
#ifdef PROBE_MASK
                        if (a.probe_var == 3) { if (ti[0] + ti[1] + ti[2] == -12345) NSEL[0] = 1; continue; }
#endif
                        if (hi == 0) {
                            unsigned idx[3];
#pragma unroll
                            for (int sI = 0; sI < 3; ++sI) { idx[sI] = 0u;
                                if (tv[sI] > -INFINITY) idx[sI] = __hip_atomic_fetch_add(mcnt + (b * 8 + h) * 64 + ti[sI], 1u, __ATOMIC_RELAXED, __HIP_MEMORY_SCOPE_AGENT); }
                            int nsel = 0;
#pragma unroll
                            for (int sI = 0; sI < 3; ++sI)
                                if (tv[sI] > -INFINITY) { const int li = (b * 8 + h) * 64 + ti[sI]; MLIST[(size_t)li * 16384 + idx[sI]] = (pos << 2) | nsel; ++nsel; }
                            NSEL[t * 8 + h] = nsel;
                        }
                    }
                }
            }
            PH_END();
            if (PH_ON()) { DECL_PTRS();
                {
                    const unsigned* mcnt = ctl + CW_MCNT + i * 1024;
                    LAS int* pref = (LAS int*)(lds + LDS_MISC);
                    if (wid == 0) {
                        int loc[16]; int sum = 0;
#pragma unroll
                        for (int k = 0; k < 16; ++k) loc[k] = (int)__hip_atomic_load(mcnt + lane * 16 + k, __ATOMIC_RELAXED, __HIP_MEMORY_SCOPE_AGENT);
                        __builtin_amdgcn_sched_barrier(0);
#pragma unroll
                        for (int k = 0; k < 16; ++k) { const int cnt = loc[k]; loc[k] = sum; sum += (cnt + 255) >> 8; }
                        int inc = sum;
#pragma unroll
                        for (int off = 1; off < 64; off <<= 1) { const int v = (int)shi_((unsigned)inc, lane - off); if (lane >= off) inc += v; }
                        const int base = inc - sum;
#pragma unroll
                        for (int k = 0; k < 16; ++k) pref[lane * 16 + k] = base + loc[k];
                        if (lane == 63) pref[1024] = inc;
                    }
                    __syncthreads();
                    const int NTsel = pref[1024];
                    auto decode = [&](int task_, int& li_o, int& chunk_o, bool& own_o) { own_o = task_ >= NTsel; chunk_o = 0;
                        if (own_o) li_o = task_ - NTsel;
                        else { int lo_ = 0, hi_ = 1023; while (lo_ < hi_) { const int mid = (lo_ + hi_ + 1) >> 1; if (pref[mid] <= task_) lo_ = mid; else hi_ = mid - 1; } li_o = lo_; chunk_o = task_ - pref[lo_]; } };
                    int nx_li = 0, nx_chunk = 0, nx_ent = 0, nx_cnt = 256; bool nx_own = true;
                    if (c < NTsel + 1024) { decode(c, nx_li, nx_chunk, nx_own);
                        if (!nx_own) { const int ln_ = lane_id_v(); nx_ent = MLIST[(size_t)nx_li * 16384 + nx_chunk * 256 + lsg(wid0) * 32 + (ln_ & 31)]; nx_cnt = (int)__hip_atomic_load(mcnt + nx_li, __ATOMIC_RELAXED, __HIP_MEMORY_SCOPE_AGENT); } }
                    for (int task = c; task < NTsel + 1024; task += G) {
                        const int lane = lane_id_v(), wid = lsg(wid0), r32 = lane & 31, hi = lane >> 5;
                        LAS unsigned char* ldsKs = lsgp(lds0); LAS unsigned char* ldsVs = ldsKs + 32768;
                        LAS bf16_t* stg = (LAS bf16_t*)(ldsKs + 65536 + wid * 4096); LAS float* wsf = (LAS float*)(ldsKs + 98304 + wid * 256); LAS int* rowd = (LAS int*)(ldsKs + 100352 + wid * 128);
                        const bool own_task = nx_own;
                        const int li = nx_li, chunk = nx_chunk;
                        const int b = li >> 9, h = (li >> 6) & 7, blk = li & 63;
                        const int e_ = chunk * 256 + wid * 32 + r32;
                        const int cnt = nx_cnt;
                        const int ent_ = nx_ent;
                        u32x4 kst[4], vst[4];
                        {
                            const bf16_t* kbp = Z + ((size_t)b * S + blk * 256) * OD_N + 512 + h * 64;
                            const bf16_t* vbp = Z + ((size_t)b * S + blk * 256) * OD_N + 1024 + h * 64;
#pragma unroll
                            for (int kt = 0; kt < 4; ++kt) {
                                kst[kt] = *(const u32x4*)(kbp + (size_t)(kt * 64 + lane) * OD_N + wid * 8);
                                vst[kt] = *(const u32x4*)(vbp + (size_t)(kt * 64 + 16 * (wid & 3) + (lane >> 2)) * OD_N + (wid >> 2) * 32 + (lane & 3) * 8);
                            }
                        }
                        __builtin_amdgcn_sched_barrier(0);
                        int posq, slot; bool valid;
                        if (own_task) { posq = blk * 256 + wid * 32 + r32; slot = 3; valid = true; }
                        else { valid = e_ < cnt; posq = valid ? (ent_ >> 2) : 0; slot = ent_ & 3; }
                        const size_t tq = (size_t)b * S + posq;
                        const int dest = valid ? (int)((tq * 8 + h) * 4 + slot) : -1;
                        attn_body::bf16x8 qr[4];
                        load_q_normed(qr, Z + tq * OD_N + h * 64, c_qn + i * 64, COSH, SINH, posq, hi, lane);
#pragma unroll
                        for (int kt = 0; kt < 4; ++kt) { *(LAS u32x4*)(ldsKs + kt * 8192 + wid * 1024 + lane * 16) = kst[kt]; *(LAS u32x4*)(ldsVs + kt * 8192 + wid * 1024 + lane * 16) = vst[kt]; }
                        nx_own = true; nx_li = 0; nx_chunk = 0; nx_ent = 0; nx_cnt = 256;
                        if (task + G < NTsel + 1024) { decode(task + G, nx_li, nx_chunk, nx_own);
                            if (!nx_own) { nx_ent = MLIST[(size_t)nx_li * 16384 + nx_chunk * 256 + wid * 32 + r32]; nx_cnt = (int)__hip_atomic_load(mcnt + nx_li, __ATOMIC_RELAXED, __HIP_MEMORY_SCOPE_AGENT); } }
                        __syncthreads();
                        attn_body::f32x16 p0[4], p1[4];
#pragma unroll
                        for (int kt = 0; kt < 4; ++kt) {
#pragma unroll
                            for (int r = 0; r < 16; ++r) { p0[kt][r] = 0.f; p1[kt][r] = 0.f; }
                            const LAS unsigned char* kb = ldsKs + kt * 8192 + hi * 1024 + r32 * 16;
#pragma unroll
                            for (int d0 = 0; d0 < 4; ++d0) {
                                const attn_body::bf16x8 b0 = *(const LAS attn_body::bf16x8*)(kb + d0 * 2048), b1 = *(const LAS attn_body::bf16x8*)(kb + d0 * 2048 + 512);
                                p0[kt] = __builtin_amdgcn_mfma_f32_32x32x16_bf16(b0, qr[d0], p0[kt], 0, 0, 0);
                                p1[kt] = __builtin_amdgcn_mfma_f32_32x32x16_bf16(b1, qr[d0], p1[kt], 0, 0, 0);
                            }
                        }
                        if (own_task) {
                            const int qrel = wid * 32 + r32;
#pragma unroll
                            for (int kt = 0; kt < 4; ++kt)
#pragma unroll
                                for (int r = 0; r < 16; ++r) { const int kv = kt * 64 + attn_body::crow(r, hi); if (kv > qrel) p0[kt][r] = -INFINITY; if (kv + 32 > qrel) p1[kt][r] = -INFINITY; }
                        }
                        float mx = -INFINITY;
#pragma unroll
                        for (int kt = 0; kt < 4; ++kt)
#pragma unroll
                            for (int r = 0; r < 16; ++r) mx = fmaxf(mx, fmaxf(p0[kt][r], p1[kt][r]));
                        mx = fmaxf(mx, SHX(mx, 32));
                        float ls = 0.f;
#pragma unroll
                        for (int kt = 0; kt < 4; ++kt)
#pragma unroll
                            for (int r = 0; r < 16; ++r) { p0[kt][r] = __builtin_amdgcn_exp2f(p0[kt][r] - mx); p1[kt][r] = __builtin_amdgcn_exp2f(p1[kt][r] - mx); ls += p0[kt][r] + p1[kt][r]; }
                        ls += SHX(ls, 32);
                        attn_body::f32x16 o[2];
#pragma unroll
                        for (int r = 0; r < 16; ++r) { o[0][r] = 0.f; o[1][r] = 0.f; }
                        const int vb0 = (int)(unsigned)(unsigned long long)ldsVs + ((lane >> 4) & 1) * 32 + (lane & 3) * 8 + (4 * hi + ((lane & 15) >> 2)) * 64;
#pragma unroll
                        for (int kt = 0; kt < 4; ++kt) {
                            u32x4 pw0, pw1, pw2, pw3;
#pragma unroll
                            for (int k = 0; k < 4; ++k) { pw0[k] = attn_body::cvtpk_s(p0[kt][2 * k], p0[kt][2 * k + 1]); pw1[k] = attn_body::cvtpk_s(p0[kt][8 + 2 * k], p0[kt][9 + 2 * k]);
                                pw2[k] = attn_body::cvtpk_s(p1[kt][2 * k], p1[kt][2 * k + 1]); pw3[k] = attn_body::cvtpk_s(p1[kt][8 + 2 * k], p1[kt][9 + 2 * k]); }
                            attn_body::pv(o, vb0 + kt * 8192, __builtin_bit_cast(attn_body::bf16x8, pw0), __builtin_bit_cast(attn_body::bf16x8, pw1), __builtin_bit_cast(attn_body::bf16x8, pw2), __builtin_bit_cast(attn_body::bf16x8, pw3));
                        }
                        if (hi == 0) { wsf[r32] = ls; rowd[r32] = dest; if (valid) { MML[(size_t)dest * 2] = mx; MML[(size_t)dest * 2 + 1] = ls; } }
                        LDS_WAIT();
#pragma unroll
                        for (int r = 0; r < 16; ++r) { const int orow = attn_body::crow(r, hi); const float rl = __builtin_amdgcn_rcpf(wsf[orow]);
                            stg[orow * 64 + r32] = (bf16_t)f2bf(o[0][r] * rl); stg[orow * 64 + 32 + r32] = (bf16_t)f2bf(o[1][r] * rl); }
                        LDS_WAIT();
#pragma unroll
                        for (int q = 0; q < 4; ++q) { const int row = q * 8 + (lane >> 3), ch = lane & 7; const int dd = rowd[row];
                            if (dd >= 0) *(u32x4*)(MPO + (size_t)dd * 64 + ch * 8) = *(const LAS u32x4*)(stg + row * 64 + ch * 8); }
                        __syncthreads();
                    }
                }
                {
                const int r32 = lane & 31, hi = lane >> 5;
                LAS unsigned char* ldsU = lds;
                LAS unsigned char* ldsK = lds + 69632;
                for (int task = c; task < 512; task += G) {
                    const int g = task >> 4, cs = task & 15, ig = i * 32 + g;
                    for (int q = tid; q < 32 * 128; q += NTHREADS) { const int j = q >> 7, off = (q & 127) * 16;
                        *(LAS u32x4*)(ldsU + j * 2064 + off) = *(const u32x4*)((const unsigned char*)UG + ((size_t)g * T + (size_t)(cs * 32 + j) * 64) * 32 + off); }
                    for (int q = tid; q < 65 * 48; q += NTHREADS) *(LAS u32x4*)(ldsK + q * 16) = *(const u32x4*)((const unsigned char*)S5KT + (size_t)ig * 65 * 768 + q * 16);
                    __syncthreads();
                    const int gc = cs * 32 + r32;
                    const float* dsk = s5_d + ig * 16;
                    const f32x4 dd0 = *(const f32x4*)(dsk + 4 * hi), dd1 = *(const f32x4*)(dsk + 8 + 4 * hi);
                    attn_body::bf16x8 hcr[8];
                    { const bf16_t* hc = S5HC + ((size_t)gc * 32 + g) * 128 + hi * 8;
#pragma unroll
                      for (int kk = 0; kk < 8; ++kk) hcr[kk] = *(const attn_body::bf16x8*)(hc + kk * 16); }
#pragma unroll 1
                    for (int rr = 0; rr < 4; ++rr) {
                        const int r = rr == 0 ? wid : rr == 1 ? 15 - wid : rr == 2 ? 16 + wid : 31 - wid;
                        attn_body::f32x16 acc;
#pragma unroll
                        for (int q = 0; q < 16; ++q) acc[q] = 0.f;
                        attn_body::bf16x8 a2r[8];
                        { const bf16_t* a2 = S5A2 + ((size_t)ig * 1024 + r * 32 + r32) * 128 + hi * 8;
#pragma unroll
                          for (int kk = 0; kk < 8; ++kk) a2r[kk] = *(const attn_body::bf16x8*)(a2 + kk * 16); }
                        __builtin_amdgcn_sched_barrier(0);
                        const LAS unsigned char* kbase = ldsK + (r32 >> 4) * 768 + (r32 & 15) * 48 + hi * 16;
                        const LAS unsigned char* ubase = ldsU + r32 * 2064 + hi * 16;
                        for (int s = 0; s <= 2 * r + 1; ++s) {
                            const attn_body::bf16x8 A = *(const LAS attn_body::bf16x8*)(kbase + (2 * r - s + 1) * 768);
                            const attn_body::bf16x8 B = *(const LAS attn_body::bf16x8*)(ubase + s * 32);
                            acc = __builtin_amdgcn_mfma_f32_32x32x16_bf16(A, B, acc, 0, 0, 0);
                        }
#pragma unroll
                        for (int kk = 0; kk < 8; ++kk) acc = __builtin_amdgcn_mfma_f32_32x32x16_bf16(a2r[kk], hcr[kk], acc, 0, 0, 0);
#pragma unroll
                        for (int q4 = 0; q4 < 4; ++q4) {
                            const int rowb = 8 * q4 + 4 * hi, dt_ = rowb >> 4, co0 = rowb & 15, t = 2 * r + dt_;
                            const u32x2 uw = *(const LAS u32x2*)(ldsU + r32 * 2064 + t * 32 + co0 * 2);
                            const f32x4 dd = (q4 & 1) ? dd1 : dd0;
                            const float y0 = acc[4 * q4] + dd.x * bflo(uw.x), y1 = acc[4 * q4 + 1] + dd.y * bfhi(uw.x), y2 = acc[4 * q4 + 2] + dd.z * bflo(uw.y), y3 = acc[4 * q4 + 3] + dd.w * bfhi(uw.y);
                            u32x2 w; w.x = pk2(gelu_tanh(y0), gelu_tanh(y1)); w.y = pk2(gelu_tanh(y2), gelu_tanh(y3));
                            *(u32x2*)(YG + ((size_t)gc * 64 + t) * 512 + g * 16 + co0) = w;
                        }
                    }
                    __syncthreads();
                }
                }
            }
            PH_END();
            if (PH_ON()) { DECL_PTRS();
                {
                    const int h = lane >> 3, d8 = (lane & 7) * 8;
                    for (int t0 = gw * 4; t0 < T; t0 += NGW * 4) {
                        int nsel[4]; f32x2 ml[4][4]; u32x4 po[4][4];
#pragma unroll
                        for (int u = 0; u < 4; ++u) { const size_t base = ((size_t)(t0 + u) * 8 + h) * 4; nsel[u] = NSEL[(size_t)(t0 + u) * 8 + h];
#pragma unroll
                            for (int s = 0; s < 4; ++s) { ml[u][s] = *(const f32x2*)(MML + (base + s) * 2); po[u][s] = *(const u32x4*)(MPO + (base + s) * 64 + d8); } }
                        __builtin_amdgcn_sched_barrier(0);
#pragma unroll
                        for (int u = 0; u < 4; ++u) {
                            float mm[4], ll[4];
#pragma unroll
                            for (int s = 0; s < 4; ++s) { const bool on = (s == 3) || (s < nsel[u]); mm[s] = on ? ml[u][s].x : -INFINITY; ll[s] = on ? ml[u][s].y : 0.f; }
                            const float M = fmaxf(fmaxf(mm[0], mm[1]), fmaxf(mm[2], mm[3]));
                            float acc[8], wsum = 0.f;
#pragma unroll
                            for (int e = 0; e < 8; ++e) acc[e] = 0.f;
#pragma unroll
                            for (int s = 0; s < 4; ++s) { const bool on = (s == 3) || (s < nsel[u]);
                                const float w = on ? ll[s] * __builtin_amdgcn_exp2f(mm[s] - M) : 0.f; float ov[8]; unpack8(po[u][s], ov); wsum += w;
#pragma unroll
                                for (int e = 0; e < 8; ++e) acc[e] += on ? w * ov[e] : 0.f; }
                            const float inv = 1.0f / wsum;
#pragma unroll
                            for (int e = 0; e < 8; ++e) acc[e] *= inv;
                            *(u32x4*)(O + (size_t)(t0 + u) * 1024 + h * 64 + d8) = pack8(acc);
                        }
                        __builtin_amdgcn_sched_barrier(0);
                    }
                }
                pg8::Gemm g{YG, Wglu + (size_t)i * 512 * 512, T, 512, 512, 0}; pg8::StaticOrder So; So.init(T, 512, G, c);
                EpiGLU E{O, YG, s5_glu_b + i * 512};
                { PROBE_WRAP(pg8::StaticOrder, So); pg8::gemm_phase<EpiGLU, PROBE_SCHED(pg8::StaticOrder), true, true>(glds, g, PS_, E, tid); }
            }
            PH_END();
        }
        if (PH_ON()) { DECL_PTRS();
            pg8::Gemm g{O, ((l & 1) ? Wodout : Wevout) + (size_t)i * 1024 * 1024, T, 1024, 1024, 0}; pg8::StaticOrder So; So.init(T, 1024, G, c);
            EpiPlain E{YMIX, 1024};
            { PROBE_WRAP(pg8::StaticOrder, So); pg8::gemm_phase<EpiPlain, PROBE_SCHED(pg8::StaticOrder), true, true>(glds, g, PS_, E, tid); }
        }
        PH_END();
        if (PH_ON()) { DECL_PTRS();
#ifdef PROBE_MASK
            const bool first_x = (l == 0 && a.probe_var != -5);
#else
            const bool first_x = (l == 0);
#endif
            const float* xs = xin;
            LAS int* r_e = (LAS int*)(lds + 0);
            LAS float* r_w = (LAS float*)(lds + 1024);
            LAS int* r_rank = (LAS int*)(lds + 2048);
            LAS int* lcnt = (LAS int*)(lds + 3072);
            LAS int* lbase = (LAS int*)(lds + 3200);
            const float* wg_l = moe_wg + (size_t)l * 1024 * 4; const float* we_l = moe_we + (size_t)l * 1024 * 32;
            for (int chunk = c; chunk < T / 128; chunk += G) {
                if (tid < 32) lcnt[tid] = 0;
                LAS float* modl = (LAS float*)(lds + 32768);
                { const float* mo_ = MOD + (size_t)(l * 2 + (int)(((size_t)chunk * 128) / S)) * 6144 + 2048;
                  for (int q = tid; q < 768; q += NTHREADS) *(LAS f32x4*)(modl + 4 * q) = *(const f32x4*)(mo_ + 4 * q); }
                __syncthreads();
                {
                    const int rloc = lane & 15, kc = lane >> 4; const int r = wid * 16 + rloc; const size_t t = (size_t)chunk * 128 + r; const int b = (int)(((size_t)chunk * 128) / S);
                    const float* mo = MOD + (size_t)(l * 2 + b) * 6144;
                    float ss;
                    if (first_x) ss = f_pass1<true>(xs + t * 1024, XB + t * 1024, YMIX + t * 1024, modl, kc);
                    else ss = f_pass1<false>(xs + t * 1024, XB + t * 1024, YMIX + t * 1024, modl, kc);
                    ss += SHX(ss, 16); ss += SHX(ss, 32);
                    const float rn = rsqrtf(ss * (1.0f / 1024.0f) + EPS);
                    f32x4 acc[3];
#pragma unroll
                    for (int ct = 0; ct < 3; ++ct) acc[ct] = (f32x4){0.f, 0.f, 0.f, 0.f};
                    const bf16_t* wh = WRH + ((size_t)l * 48 + rloc) * 1024 + 8 * kc; const bf16_t* wl = WRL + ((size_t)l * 48 + rloc) * 1024 + 8 * kc;
                    f_pass2(XB + t * 1024, H + t * 1024, modl, wh, wl, rn, kc, acc);
                    LAS float* lg = (LAS float*)(lds + 4096 + wid * 3072);
#pragma unroll
                    for (int ct = 0; ct < 3; ++ct) { lg[(4 * kc + 0) * 48 + ct * 16 + rloc] = acc[ct].x; lg[(4 * kc + 1) * 48 + ct * 16 + rloc] = acc[ct].y; lg[(4 * kc + 2) * 48 + ct * 16 + rloc] = acc[ct].z; lg[(4 * kc + 3) * 48 + ct * 16 + rloc] = acc[ct].w; }
                    LDS_WAIT();
                    if (lane < 16) {
                        const LAS float* lr = lg + lane * 48;
                        float cg[4];
#pragma unroll
                        for (int e = 0; e < 4; ++e) cg[e] = lr[e] + moe_bg[l * 4 + e];
                        int grp = 0; float cm = cg[0];
#pragma unroll
                        for (int e = 1; e < 4; ++e) if (cg[e] > cm) { cm = cg[e]; grp = e; }
                        float den = 0.f;
#pragma unroll
                        for (int e = 0; e < 4; ++e) den += __expf(cg[e] - cm);
                        const float pg = 1.0f / den;
                        float fe[8];
#pragma unroll
                        for (int e = 0; e < 8; ++e) fe[e] = lr[4 + grp * 8 + e] + moe_be[l * 32 + grp * 8 + e];
                        int j0 = 0; float f0 = fe[0];
#pragma unroll
                        for (int e = 1; e < 8; ++e) if (fe[e] > f0) { f0 = fe[e]; j0 = e; }
                        int j1 = -1; float f1 = -INFINITY;
#pragma unroll
                        for (int e = 0; e < 8; ++e) if (e != j0 && fe[e] > f1) { f1 = fe[e]; j1 = e; }
                        const float ex = __expf(f1 - f0); const float sA = 1.0f / (1.0f + ex), sB = ex / (1.0f + ex);
                        const int rr_ = wid * 16 + lane;
                        r_e[2 * rr_] = grp * 8 + j0; r_w[2 * rr_] = pg * sA; r_e[2 * rr_ + 1] = grp * 8 + j1; r_w[2 * rr_ + 1] = pg * sB;
                    }
                }
                __syncthreads();
#ifdef PROBE_MASK
                if (a.probe_var == 5) { if (tid < 256 && r_e[tid] == -777) TOKES[0] = 0; __syncthreads(); continue; }
#endif
                if (tid < 256) r_rank[tid] = __hip_atomic_fetch_add(&lcnt[r_e[tid]], 1, __ATOMIC_RELAXED, __HIP_MEMORY_SCOPE_WORKGROUP);
                __syncthreads();
                if (tid < 32) lbase[tid] = (int)__hip_atomic_fetch_add(ctl + CW_CNT + (l * 32 + tid) * 64, (unsigned)lcnt[tid], __ATOMIC_RELAXED, __HIP_MEMORY_SCOPE_AGENT);
                __syncthreads();
                if (tid < 256) { const size_t t = (size_t)chunk * 128 + (tid >> 1); const int k = tid & 1; const int e = r_e[tid]; const int slot = lbase[e] + r_rank[tid];
                    TOKES[t * 2 + k] = e * 32768 + slot; TOKW[t * 2 + k] = r_w[tid]; LTOK[e * 32768 + slot] = (int)t; }
                __syncthreads();
            }
        }
        PH_END();
        if (PH_ON()) { DECL_PTRS();
            LAS int* tile_e = (LAS int*)(lds + LDS_MISC); LAS int* rb = tile_e + 320; LAS int* nt_p = tile_e + 400;
            moe_tables(ctl, l, tile_e, rb, nt_p, tid);
            const int nR = nt_p[0];
            pg8::Gemm g{H, W13, nR * 256, 1024, 1024, (size_t)1024 * 1024 * 2}; MoeOrder Mo{4, nR * 4, G, c, tile_e};
            EpiSwiGLU E{HID}; MoeRows RW{rb, LTOK};
            { PROBE_WRAP(MoeOrder, Mo); pg8::gemm_phase<EpiSwiGLU, PROBE_SCHED(MoeOrder), true, true, MoeRows>(glds, g, PS_, E, tid, RW); }
        }
        PH_END();
        if (PH_ON()) { DECL_PTRS();
            LAS int* tile_e = (LAS int*)(lds + LDS_MISC); LAS int* rb = tile_e + 320; LAS int* nt_p = tile_e + 400;
            moe_tables(ctl, l, tile_e, rb, nt_p, tid);
            const int nR = nt_p[0];
            pg8::Gemm g{HID, W2, nR * 256, 1024, 512, (size_t)1024 * 512 * 2}; MoeOrder Mo{4, nR * 4, G, c, tile_e};
            EpiPlain E{Y, 1024};
            { PROBE_WRAP(MoeOrder, Mo); pg8::gemm_phase<EpiPlain, PROBE_SCHED(MoeOrder), true, true>(glds, g, PS_, E, tid); }
        }
        PH_END();
        if (PH_ON()) { DECL_PTRS();
            LAS int* tile_e = (LAS int*)(lds + LDS_MISC); LAS int* rb = tile_e + 320; LAS int* nt_p = tile_e + 400;
            moe_tables(ctl, l, tile_e, rb, nt_p, tid);
            constexpr int RJ = 4;
            for (int t0 = gw * RJ; t0 < T; t0 += NGW * RJ) {
                const int b = t0 / S; const float* mo = MOD + (size_t)(l * 2 + b) * 6144;
                int r0[RJ], r1[RJ]; float w0[RJ], w1[RJ];
#pragma unroll
                for (int u = 0; u < RJ; ++u) { const int t = t0 + u; { const int e0_ = TOKES[2 * t], e1_ = TOKES[2 * t + 1]; r0[u] = rb[e0_ >> 15] + (e0_ & 32767); r1[u] = rb[e1_ >> 15] + (e1_ & 32767); } w0[u] = TOKW[2 * t]; w1[u] = TOKW[2 * t + 1];
#ifdef PROBE_MASK
                    if (a.probe_var == 4 || a.probe_var == -4) { w0[u] *= 0.5f; w1[u] *= 0.5f; }
#endif
                }
                f32x4 v[RJ][4]; u32x2 ya[RJ][4], yb[RJ][4];
#pragma unroll
                for (int u = 0; u < RJ; ++u)
#pragma unroll
                    for (int j = 0; j < 4; ++j) { const int col = 4 * lane + 256 * j; { const u32x2 xw = *(const u32x2*)(XB + (size_t)(t0 + u) * 1024 + col); v[u][j] = (f32x4){bflo(xw.x), bfhi(xw.x), bflo(xw.y), bfhi(xw.y)}; }
                        ya[u][j] = *(const u32x2*)(Y + (size_t)r0[u] * 1024 + col); yb[u][j] = *(const u32x2*)(Y + (size_t)r1[u] * 1024 + col); }
                f32x4 gg[4];
#pragma unroll
                for (int j = 0; j < 4; ++j) gg[j] = *(const f32x4*)(mo + 5120 + 4 * lane + 256 * j);
                float ss[RJ];
#pragma unroll
                for (int u = 0; u < RJ; ++u) { ss[u] = 0.f;
#pragma unroll
                    for (int j = 0; j < 4; ++j) { const int col = 4 * lane + 256 * j; const f32x4 xv = v[u][j]; f32x4 nv;
                        nv.x = xv.x + gg[j].x * (w0[u] * bflo(ya[u][j].x) + w1[u] * bflo(yb[u][j].x)); nv.y = xv.y + gg[j].y * (w0[u] * bfhi(ya[u][j].x) + w1[u] * bfhi(yb[u][j].x));
                        nv.z = xv.z + gg[j].z * (w0[u] * bflo(ya[u][j].y) + w1[u] * bflo(yb[u][j].y)); nv.w = xv.w + gg[j].w * (w0[u] * bfhi(ya[u][j].y) + w1[u] * bfhi(yb[u][j].y));
                        if (l + 1 < DEPTH) { u32x2 xw; xw.x = pk2(nv.x, nv.y); xw.y = pk2(nv.z, nv.w); *(u32x2*)(XB + (size_t)(t0 + u) * 1024 + col) = xw; nv = (f32x4){bflo(xw.x), bfhi(xw.x), bflo(xw.y), bfhi(xw.y)}; }
                        else *(f32x4*)(out + (size_t)(t0 + u) * 1024 + col) = nv;
                        v[u][j] = nv; ss[u] += (nv.x * nv.x + nv.y * nv.y) + (nv.z * nv.z + nv.w * nv.w); } }
                if (l + 1 < DEPTH) {
                    const float* mn = MOD + (size_t)((l + 1) * 2 + b) * 6144;
                    f32x4 sc1[4], sh1[4];
#pragma unroll
                    for (int j = 0; j < 4; ++j) { sc1[j] = *(const f32x4*)(mn + 1024 + 4 * lane + 256 * j); sh1[j] = *(const f32x4*)(mn + 4 * lane + 256 * j); }
#pragma unroll
                    for (int u = 0; u < RJ; ++u) { const float rn = rsqrtf(wave_sum(ss[u]) * (1.0f / 1024.0f) + EPS);
#pragma unroll
                        for (int j = 0; j < 4; ++j) { const int col = 4 * lane + 256 * j;
                            u32x2 w; w.x = pk2(v[u][j].x * rn * (1.f + sc1[j].x) + sh1[j].x, v[u][j].y * rn * (1.f + sc1[j].y) + sh1[j].y); w.y = pk2(v[u][j].z * rn * (1.f + sc1[j].z) + sh1[j].z, v[u][j].w * rn * (1.f + sc1[j].w) + sh1[j].w);
                            *(u32x2*)(H + (size_t)(t0 + u) * 1024 + col) = w; } }
                }
            }
        }
        PH_END();
    }
#undef PH_ON
#undef PH_END
}

extern "C" void kernel_launch(void* const* d_in, const int* in_sizes, int n_in, void* d_out, int out_size, void* d_ws, size_t ws_size, hipStream_t stream) {
    static int grid = 0;
    if (grid == 0) {
        if (n_in != 37 || out_size != T * D || ws_size < WS_END) { fprintf(stderr, "kernel_launch: unexpected shapes (n_in %d, out %d, ws %zu); nothing launched\n", n_in, out_size, ws_size); grid = -1; return; }
        int dev = 0, cus = 0, per_cu = 0;
        if (hipGetDevice(&dev) != hipSuccess || hipDeviceGetAttribute(&cus, hipDeviceAttributeMultiprocessorCount, dev) != hipSuccess) { grid = -1; return; }
        if (hipFuncSetAttribute((const void*)fwd, hipFuncAttributeMaxDynamicSharedMemorySize, LDS_BYTES) != hipSuccess) { fprintf(stderr, "kernel_launch: hipFuncSetAttribute failed\n"); grid = -1; return; }
        if (hipOccupancyMaxActiveBlocksPerMultiprocessor(&per_cu, (const void*)fwd, NTHREADS, LDS_BYTES) != hipSuccess || per_cu < 1) fprintf(stderr, "kernel_launch: occupancy query says %d\n", per_cu);
        (void)hipGetLastError();
        grid = cus;
    }
    if (grid < 0) return;
    if (hipMemsetAsync((char*)d_ws + WS_CTL, 0, CTL_ZERO_BYTES, stream) != hipSuccess) return;
    Args a{};
    for (int i = 0; i < 37; ++i) a.in[i] = d_in[i];
    a.out = (float*)d_out; a.ws = (unsigned char*)d_ws;
#ifdef PROBE_MASK
#ifndef PROBE_VAR
#define PROBE_VAR 0
#endif
    {
        int types[N_PHASES]; int n = 0; types[n++] = 0; types[n++] = 1; types[n++] = 2;
        for (int l = 0; l < DEPTH; ++l) { if ((l & 1) == 0) { for (int k = 3; k <= 7; ++k) if (k != 4 && k != 6) types[n++] = k; } else { for (int k = 8; k <= 13; ++k) if (k != 9) types[n++] = k; } for (int k = 14; k <= 19; ++k) if (k != 16) types[n++] = k; }
        for (int p = 0; p < N_PHASES; ++p) { a.ph_lo = p; a.ph_hi = p + 1; const int reps = ((PROBE_MASK >> types[p]) & 1) ? 2 : 1;
            for (int r = 0; r < reps; ++r) { a.probe_var = (reps == 2) ? ((r == 0) ? PROBE_VAR : -PROBE_VAR) : 0; hipLaunchKernelGGL(fwd, dim3(grid), dim3(NTHREADS), LDS_BYTES, stream, a); } }
    }
#elif MK_ONE_LAUNCH
    a.ph_lo = 0; a.ph_hi = N_PHASES;
    hipLaunchKernelGGL(fwd, dim3(grid), dim3(NTHREADS), LDS_BYTES, stream, a);
#else
    for (int p = 0; p < N_PHASES; ++p) { a.ph_lo = p; a.ph_hi = p + 1; hipLaunchKernelGGL(fwd, dim3(grid), dim3(NTHREADS), LDS_BYTES, stream, a); }
#endif
}
```

```cpp
#include <hip/hip_runtime.h>
#include <cstdio>
#include <cstdint>
#include <hip/hip_bf16.h>
#include <cmath>
#ifndef MK_ONE_LAUNCH
#define MK_ONE_LAUNCH 1
#endif
namespace pg8 {
#define PG8_LAS __attribute__((address_space(3)))
typedef unsigned short bf16_t;
typedef short bf16x8 __attribute__((ext_vector_type(8)));
typedef float f32x4 __attribute__((ext_vector_type(4)));
typedef unsigned u32x4 __attribute__((ext_vector_type(4)));
constexpr int BM = 256, BK = 64, HALF = 128, HTB = HALF * BK * 2  , STAGE_BYTES = 8 * HTB, NXCD = 8, WGM = 8;

__host__ __device__ __forceinline__ int lds_byte(int r, int c) { const int st = (r >> 4) * 2 + (c >> 5), rr = r & 15, cc = c & 31, ob = rr * 64 + cc * 2; return st * 1024 + (ob ^ (((ob >> 9) & 1) << 5)); }
__host__ __device__ __forceinline__ void stage_rc(int b, int& R, int& C) { const int st = b / 1024, sb = b % 1024, swz = sb ^ (((sb >> 9) & 1) << 5); R = (st >> 1) * 16 + swz / 64; C = (st & 1) * 32 + (swz % 64) / 2; }
__host__ __device__ __forceinline__ int perm32(int rho) { const int n = rho >> 4, i = rho & 15; return 8 * (i >> 2) + 4 * n + (i & 3); }

struct Unit { int pm, pn, be; };
struct Gemm { const bf16_t* A; const bf16_t* Bt; int M, N, K; size_t bstride; };

struct StaticOrder {
    int nM, nN, nwg, G, c;
    __host__ __device__ void init(int M, int N, int G_, int c_) { nM = M / BM; nN = N / BM; nwg = nM * nN; G = G_; c = c_; }
    __host__ __device__ bool next(int i, Unit& u) const {
        const long L = (long)i * G + c; if (L >= nwg) return false;
        int wgid = (int)L; { const int q = nwg / NXCD, r = nwg % NXCD, xcd = wgid % NXCD, off = wgid / NXCD; wgid = (xcd < r ? xcd * (q + 1) : r * (q + 1) + (xcd - r) * q) + off; }
        const int nig = WGM * nN, gid = wgid / nig, fm = gid * WGM, gsz = (nM - fm) < WGM ? (nM - fm) : WGM;
        u.pm = fm + ((wgid % nig) % gsz); u.pn = (wgid % nig) / gsz; u.be = 0; return true;
    }
    __device__ __forceinline__ void a_ready(const Unit&) const {}
    __device__ __forceinline__ void done(const Unit&) const {}
};

__device__ __forceinline__ unsigned cvt_pk_bf16(float lo, float hi) { unsigned r; asm volatile("v_cvt_pk_bf16_f32 %0, %1, %2" : "=v"(r) : "v"(lo), "v"(hi)); return r; }
typedef float f32x2 __attribute__((ext_vector_type(2)));
struct NoRows { static constexpr bool GATHER = false; __device__ __forceinline__ unsigned operator()(const Unit&, int) const { return 0u; } };
template <class Epi, class Sched, bool ALIGN_EPI = false, bool SP2 = false, class Rows = NoRows>
__device__ __forceinline__ void gemm_phase(PG8_LAS unsigned char* lds, const Gemm g, const Sched& S, const Epi& E, const int tid_in, const Rows& RW = Rows()) {
    const int tid = tid_in, wid = __builtin_amdgcn_readfirstlane(tid >> 6), lane = tid & 63, wr = wid >> 2, wc = wid & 3, fr = lane & 15, fq = lane >> 4;
    const int K = g.K, nt = K / BK;
    unsigned voffA[2], voffB[2];
#pragma unroll
    for (int i = 0; i < 2; ++i) { int R, C; stage_rc(tid * 16 + i * 8192, R, C); const int Rb = Epi::PERM ? ((R & ~31) + perm32(R & 31)) : R;
        voffA[i] = (unsigned)(R * K + C) * 2u; voffB[i] = (unsigned)(Rb * K + C) * 2u; }
    const size_t kstep = (size_t)(BK * 2);
    const size_t hstep = (size_t)HALF * K * 2;
    const size_t tstep = 2 * hstep;
    const unsigned ldsw = (unsigned)wid * 1024u;
    const int aoff = lds_byte(wr * 64 + fr, fq * 8), boff = lds_byte(wc * 32 + fr, fq * 8);
#define PG8_SA(b, h) (((b) * 2 + (h)) * HTB)
#define PG8_SB(b, h) ((4 + (b) * 2 + (h)) * HTB)
#define PG8_STAGE(bufoff, gbase, voff) do { _Pragma("unroll") for (int _i = 0; _i < 2; ++_i) \
        __builtin_amdgcn_global_load_lds((const unsigned*)((const char*)(gbase) + (voff)[_i]), (PG8_LAS unsigned*)(lds + (bufoff) + ldsw + _i * 8192), 16, 0, 0); } while (0)
#define PG8_LDA(dst, b, h) do { _Pragma("unroll") for (int m = 0; m < 4; ++m) _Pragma("unroll") for (int k = 0; k < 2; ++k) dst[m][k] = *(const PG8_LAS bf16x8*)(lds + PG8_SA(b, h) + aoff + m * 2048 + k * 1024); } while (0)
#define PG8_LDB(dst, b, h) do { _Pragma("unroll") for (int n = 0; n < 2; ++n) _Pragma("unroll") for (int k = 0; k < 2; ++k) dst[n][k] = *(const PG8_LAS bf16x8*)(lds + PG8_SB(b, h) + boff + n * 2048 + k * 1024); } while (0)
#define PG8_MMA(ai, bj, At, Bt) do { __builtin_amdgcn_s_setprio(1); _Pragma("unroll") for (int m = 0; m < 4; ++m) _Pragma("unroll") for (int n = 0; n < 2; ++n) _Pragma("unroll") for (int k = 0; k < 2; ++k) \
        acc[ai][bj][m][n] = __builtin_amdgcn_mfma_f32_16x16x32_bf16(Bt[n][k], At[m][k], acc[ai][bj][m][n], 0, 0, 0); __builtin_amdgcn_s_setprio(0); } while (0)
#define PG8_WAIT_V(n) asm volatile("s_waitcnt vmcnt(" #n ")" ::: "memory")
#define PG8_WAIT_L(n) asm volatile("s_waitcnt lgkmcnt(" #n ")" ::: "memory")
#define PG8_BAR __builtin_amdgcn_s_barrier()
#define PG8_SCHED __builtin_amdgcn_sched_barrier(0)
    Unit cur, nxt; int ui = 0;
    if (!S.next(0, cur)) return;
    f32x4 acc[2][2][4][2];
#pragma unroll
    for (int a = 0; a < 2; ++a)
#pragma unroll
        for (int b = 0; b < 2; ++b)
#pragma unroll
            for (int m = 0; m < 4; ++m)
#pragma unroll
                for (int n = 0; n < 2; ++n) { float z0_ = 0.f; asm volatile("" : "+v"(z0_)); acc[a][b][m][n] = (f32x4){z0_, z0_, z0_, z0_}; }
    bf16x8 At[4][2], B0[2][2], B1[2][2];
    const char* cA = Rows::GATHER ? (const char*)g.A : (const char*)g.A + (size_t)cur.pm * tstep; const char* cB = (const char*)g.Bt + (size_t)cur.be * g.bstride + (size_t)cur.pn * tstep;
    int Rr[2], Cc[2];
#pragma unroll
    for (int i = 0; i < 2; ++i) stage_rc(tid * 16 + i * 8192, Rr[i], Cc[i]);
    unsigned voffAh[2][2], voffAn[2][2];
#pragma unroll
    for (int h = 0; h < 2; ++h)
#pragma unroll
        for (int i = 0; i < 2; ++i) { voffAh[h][i] = Rows::GATHER ? RW(cur, h * HALF + Rr[i]) + (unsigned)Cc[i] * 2u : voffA[i] + (unsigned)h * (unsigned)hstep; voffAn[h][i] = voffAh[h][i]; }
    S.a_ready(cur);
    if constexpr (SP2) {
        PG8_STAGE(PG8_SB(0, 0), cB, voffB); PG8_STAGE(PG8_SB(0, 1), cB + hstep, voffB); PG8_STAGE(PG8_SA(0, 0), cA, voffAh[0]); PG8_STAGE(PG8_SA(0, 1), cA, voffAh[1]);
        if (wr == 1) PG8_BAR;
        PG8_WAIT_V(2); PG8_BAR;
        PG8_STAGE(PG8_SB(1, 0), cB + kstep, voffB); PG8_STAGE(PG8_SA(1, 0), cA + kstep, voffAh[0]); PG8_STAGE(PG8_SB(1, 1), cB + hstep + kstep, voffB);
        PG8_WAIT_V(6); PG8_BAR;
    } else {
        PG8_STAGE(PG8_SB(0, 0), cB, voffB); PG8_STAGE(PG8_SA(0, 0), cA, voffAh[0]); PG8_STAGE(PG8_SB(0, 1), cB + hstep, voffB); PG8_STAGE(PG8_SA(0, 1), cA, voffAh[1]);
        if (wr == 1) PG8_BAR;
        PG8_WAIT_V(4); PG8_BAR;
        PG8_STAGE(PG8_SB(1, 0), cB + kstep, voffB); PG8_STAGE(PG8_SA(1, 0), cA + kstep, voffAh[0]); PG8_STAGE(PG8_SB(1, 1), cB + hstep + kstep, voffB);
        PG8_WAIT_V(6); PG8_BAR;
    }
    for (;;) {
        const bool has_next = S.next(ui + 1, nxt);
        const char* nA = Rows::GATHER ? (const char*)g.A : (has_next ? (const char*)g.A + (size_t)nxt.pm * tstep : cA);
        if constexpr (Rows::GATHER) { if (has_next) {
#pragma unroll
            for (int h = 0; h < 2; ++h)
#pragma unroll
                for (int i = 0; i < 2; ++i) voffAn[h][i] = RW(nxt, h * HALF + Rr[i]) + (unsigned)Cc[i] * 2u; } } const char* nB = has_next ? (const char*)g.Bt + (size_t)nxt.be * g.bstride + (size_t)nxt.pn * tstep : cB;
        for (int t = 0; t < nt; t += 2) {
            const bool last = (t == nt - 2); const bool gsel = Rows::GATHER && last && has_next;
            const char* a1 = cA + (size_t)(t + 1) * kstep;
            const char* a2 = last ? nA : cA + (size_t)(t + 2) * kstep; const char* b2 = last ? nB : cB + (size_t)(t + 2) * kstep;
            const char* a3 = a2 + kstep; const char* b3 = b2 + kstep;
            if (last && has_next) S.a_ready(nxt);
            if constexpr (SP2) {
            PG8_LDB(B0, 0, 0); PG8_LDB(B1, 0, 1); PG8_SCHED; PG8_LDA(At, 0, 0); PG8_STAGE(PG8_SA(1, 1), a1, voffAh[1]);
            PG8_WAIT_V(8); PG8_WAIT_L(0); PG8_BAR; PG8_MMA(0, 0, At, B0); PG8_MMA(0, 1, At, B1); PG8_BAR; PG8_SCHED;
            PG8_LDA(At, 0, 1); PG8_STAGE(PG8_SB(0, 0), b2, voffB); PG8_STAGE(PG8_SB(0, 1), b2 + hstep, voffB); PG8_STAGE(PG8_SA(0, 0), a2, (gsel ? voffAn[0] : voffAh[0]));
            PG8_WAIT_V(8); PG8_WAIT_L(0); PG8_BAR; PG8_MMA(1, 0, At, B0); PG8_MMA(1, 1, At, B1); PG8_BAR; PG8_SCHED;
            PG8_LDB(B0, 1, 0); PG8_LDB(B1, 1, 1); PG8_SCHED; PG8_LDA(At, 1, 0); PG8_STAGE(PG8_SA(0, 1), a2, (gsel ? voffAn[1] : voffAh[1]));
            PG8_WAIT_V(8); PG8_WAIT_L(0); PG8_BAR; PG8_MMA(0, 0, At, B0); PG8_MMA(0, 1, At, B1); PG8_BAR; PG8_SCHED;
            PG8_LDA(At, 1, 1); PG8_STAGE(PG8_SB(1, 0), b3, voffB); PG8_STAGE(PG8_SB(1, 1), b3 + hstep, voffB); PG8_STAGE(PG8_SA(1, 0), a3, (gsel ? voffAn[0] : voffAh[0]));
            PG8_WAIT_V(8); PG8_WAIT_L(0); PG8_BAR; PG8_MMA(1, 0, At, B0); PG8_MMA(1, 1, At, B1); PG8_BAR; PG8_SCHED;
            } else {
            PG8_LDB(B0, 0, 0); PG8_SCHED; PG8_LDA(At, 0, 0); PG8_STAGE(PG8_SA(1, 1), a1, voffAh[1]);
            PG8_WAIT_L(8); PG8_BAR; PG8_WAIT_L(0); PG8_MMA(0, 0, At, B0); PG8_BAR; PG8_SCHED;
            PG8_LDB(B1, 0, 1); PG8_STAGE(PG8_SB(0, 0), b2, voffB);
            PG8_BAR; PG8_WAIT_L(0); PG8_MMA(0, 1, At, B1); PG8_BAR;
            PG8_LDA(At, 0, 1); PG8_STAGE(PG8_SA(0, 0), a2, (gsel ? voffAn[0] : voffAh[0]));
            PG8_BAR; PG8_WAIT_L(0); PG8_MMA(1, 0, At, B0); PG8_BAR; PG8_SCHED;
            PG8_STAGE(PG8_SB(0, 1), b2 + hstep, voffB);
            PG8_WAIT_V(6); PG8_BAR; PG8_MMA(1, 1, At, B1); PG8_BAR;
            PG8_LDB(B0, 1, 0); PG8_SCHED; PG8_LDA(At, 1, 0); PG8_STAGE(PG8_SA(0, 1), a2, (gsel ? voffAn[1] : voffAh[1]));
            PG8_WAIT_L(8); PG8_BAR; PG8_WAIT_L(0); PG8_MMA(0, 0, At, B0); PG8_BAR; PG8_SCHED;
            PG8_LDB(B1, 1, 1); PG8_STAGE(PG8_SB(1, 0), b3, voffB);
            PG8_BAR; PG8_WAIT_L(0); PG8_MMA(0, 1, At, B1); PG8_BAR;
            PG8_LDA(At, 1, 1); PG8_STAGE(PG8_SA(1, 0), a3, (gsel ? voffAn[0] : voffAh[0]));
            PG8_BAR; PG8_WAIT_L(0); PG8_MMA(1, 0, At, B0); PG8_BAR; PG8_SCHED;
            PG8_STAGE(PG8_SB(1, 1), b3 + hstep, voffB);
            PG8_WAIT_V(6); PG8_BAR; PG8_MMA(1, 1, At, B1); PG8_BAR;
            }
        }
        if constexpr (ALIGN_EPI) { if (wr == 0) PG8_BAR; }
        if constexpr (!Epi::AFTER_DRAIN) { int l2_; asm volatile("v_mbcnt_lo_u32_b32 %0, -1, 0\n\tv_mbcnt_hi_u32_b32 %0, -1, %0" : "=v"(l2_)); E(acc, cur, wr, wc, l2_ & 15, l2_ >> 4); S.done(cur); }
        if (!has_next) break;
#pragma unroll
        for (int a = 0; a < 2; ++a)
#pragma unroll
            for (int b = 0; b < 2; ++b)
#pragma unroll
                for (int m = 0; m < 4; ++m)
#pragma unroll
                    for (int n = 0; n < 2; ++n) { float z0_ = 0.f; asm volatile("" : "+v"(z0_)); acc[a][b][m][n] = (f32x4){z0_, z0_, z0_, z0_}; }
        cur = nxt; cA = nA; cB = nB; ++ui;
        if constexpr (Rows::GATHER) {
#pragma unroll
            for (int h = 0; h < 2; ++h)
#pragma unroll
                for (int i = 0; i < 2; ++i) voffAh[h][i] = voffAn[h][i]; }
        if constexpr (ALIGN_EPI) { if (wr == 1) PG8_BAR; }
    }
    PG8_WAIT_V(0);
    if constexpr (!ALIGN_EPI) { if (wr == 0) PG8_BAR; }
    PG8_BAR;
    if constexpr (Epi::AFTER_DRAIN) { E.fused(acc, cur, wr, wc, fr, fq, lds, wid, lane); S.done(cur); }
#undef PG8_SA
#undef PG8_SB
#undef PG8_STAGE
#undef PG8_LDA
#undef PG8_LDB
#undef PG8_MMA
#undef PG8_WAIT_V
#undef PG8_WAIT_L
#undef PG8_BAR
#undef PG8_SCHED
}
}
namespace attn_body {
using bf16=__hip_bfloat16;
using bf16x8=__attribute__((ext_vector_type(8)))short;
using s16x4=__attribute__((ext_vector_type(4)))short;
using f32x16=__attribute__((ext_vector_type(16)))float;
using u32x4=__attribute__((ext_vector_type(4)))unsigned;
constexpr int D=64;
constexpr int NW=8,QBLK=32,QB=QBLK*NW,KVBLK=64;
constexpr int ATTN_UNIT_ROWS=QB;
__device__ __forceinline__ int crow(int r,int hi){return (r&3)+8*(r>>2)+4*hi;}
#define SBAR() __builtin_amdgcn_sched_barrier(0)
__device__ __forceinline__ void cmask(f32x16&p0,f32x16&p1,int jb,int qrel,int hi){
  const float NEG=-INFINITY; int kb=64*jb+4*hi;
  #pragma unroll
  for(int r=0;r<16;++r){int kv=kb+(r&3)+8*(r>>2); if(kv>qrel)p0[r]=NEG; if(kv+32>qrel)p1[r]=NEG;}
}

constexpr int NSLOT=3, SLOTB=8192;
constexpr int LDS_K=0, LDS_V=NSLOT*SLOTB, LDS_WS=2*NSLOT*SLOTB, LDS_OST=LDS_WS+NW*64*4, LDS_BYTES=LDS_OST+NW*4096;
constexpr float C2=0.125f*1.4426950408889634f;
__device__ __forceinline__ void glds16(const void*gsrc,unsigned lds_dst){unsigned keep;
  asm volatile("s_mov_b32 %0, m0\n\ts_mov_b32 m0, %2\n\ts_nop 0\n\tglobal_load_lds_dwordx4 %1, off\n\ts_mov_b32 m0, %0":"=&s"(keep):"v"(gsrc),"s"(lds_dst):"memory");}
__device__ __forceinline__ float max3f(float a,float b,float c){float r;asm("v_max3_f32 %0, %1, %2, %3":"=v"(r):"v"(a),"v"(b),"v"(c));return r;}
__device__ __forceinline__ float max2f(float a,float b){float r;asm("v_max_f32_e32 %0, %1, %2":"=v"(r):"v"(a),"v"(b));return r;}
__device__ __forceinline__ float fadd_s(float a,float b){float r;asm("v_add_f32_e32 %0, %1, %2":"=v"(r):"v"(a),"v"(b));return r;}
__device__ __forceinline__ float fsub_s(float a,float b){float r;asm("v_sub_f32_e32 %0, %1, %2":"=v"(r):"v"(a),"v"(b));return r;}
typedef float f32x2_t __attribute__((ext_vector_type(2))); typedef __bf16 bf16x2_t __attribute__((ext_vector_type(2)));
__device__ __forceinline__ unsigned cvtpk_s(float lo,float hi){f32x2_t v={lo,hi};bf16x2_t b=__builtin_convertvector(v,bf16x2_t);return __builtin_bit_cast(unsigned,b);}
#define WAIT_BAR(N) asm volatile("s_waitcnt vmcnt(" #N ") lgkmcnt(0)\n\ts_barrier":::"memory")

__device__ __forceinline__ void qkt(f32x16&p0,f32x16&p1,const char*Kslot,const bf16x8*qr,const f32x16&negm,int r32,int hi){
  const char*kb=Kslot+hi*1024+r32*16;
  #pragma unroll
  for(int d0=0;d0<4;++d0){
    const bf16x8 b0=*reinterpret_cast<const bf16x8*>(kb+d0*2048);
    const bf16x8 b1=*reinterpret_cast<const bf16x8*>(kb+d0*2048+512);
    if(d0==0){p0=__builtin_amdgcn_mfma_f32_32x32x16_bf16(b0,qr[0],negm,0,0,0);p1=__builtin_amdgcn_mfma_f32_32x32x16_bf16(b1,qr[0],negm,0,0,0);}
    else{p0=__builtin_amdgcn_mfma_f32_32x32x16_bf16(b0,qr[d0],p0,0,0,0);p1=__builtin_amdgcn_mfma_f32_32x32x16_bf16(b1,qr[d0],p1,0,0,0);}}
}
typedef __attribute__((address_space(3))) const char* lds_cptr;
typedef short v4i16_t __attribute__((ext_vector_type(4)));
__device__ __forceinline__ void kload8(bf16x8*kf,lds_cptr kp){
  kf[0]=*(const __attribute__((address_space(3))) bf16x8*)(kp);      kf[1]=*(const __attribute__((address_space(3))) bf16x8*)(kp+512);
  kf[2]=*(const __attribute__((address_space(3))) bf16x8*)(kp+2048); kf[3]=*(const __attribute__((address_space(3))) bf16x8*)(kp+2560);
  kf[4]=*(const __attribute__((address_space(3))) bf16x8*)(kp+4096); kf[5]=*(const __attribute__((address_space(3))) bf16x8*)(kp+4608);
  kf[6]=*(const __attribute__((address_space(3))) bf16x8*)(kp+6144); kf[7]=*(const __attribute__((address_space(3))) bf16x8*)(kp+6656);
}
__device__ __forceinline__ void kload2(bf16x8*kf,lds_cptr kp,int j){ kf[2*j]=*(const __attribute__((address_space(3))) bf16x8*)(kp+j*2048); kf[2*j+1]=*(const __attribute__((address_space(3))) bf16x8*)(kp+j*2048+512); }
__device__ __forceinline__ s16x4 vtr(lds_cptr p){ return __builtin_bit_cast(s16x4,__builtin_amdgcn_ds_read_tr16_b64_v4i16((__attribute__((address_space(3))) v4i16_t*)p)); }
__device__ __forceinline__ float rowmax(const f32x16&p0,const f32x16&p1){
  float a=max3f(p0[0],p0[1],p1[0]),b=max3f(p0[2],p0[3],p1[1]);a=max3f(a,p1[2],p1[3]);
  #pragma unroll
  for(int r=4;r<16;r+=4){a=max3f(a,p0[r],p0[r+1]);b=max3f(b,p0[r+2],p0[r+3]);a=max3f(a,p1[r],p1[r+1]);b=max3f(b,p1[r+2],p1[r+3]);}
  const float m=max2f(a,b);
  auto rr=__builtin_amdgcn_permlane32_swap(__float_as_uint(m),__float_as_uint(m),false,false);
  return max2f(__uint_as_float(rr[0]),__uint_as_float(rr[1]));
}
__device__ __forceinline__ void pv(f32x16*o,int vb,bf16x8 pa0,bf16x8 pa1,bf16x8 pa2,bf16x8 pa3){
  #pragma unroll
  for(int d0=0;d0<2;++d0){s16x4 lo[4],hi[4];
    #pragma unroll
    for(int ks=0;ks<4;++ks){
      asm volatile("ds_read_b64_tr_b16 %0,%1 offset:%c2":"=&v"(lo[ks]):"v"(vb),"i"(d0*4096+ks*1024):"memory");
      asm volatile("ds_read_b64_tr_b16 %0,%1 offset:%c2":"=&v"(hi[ks]):"v"(vb),"i"(d0*4096+ks*1024+512):"memory");}
    asm volatile("s_waitcnt lgkmcnt(0)":::"memory");SBAR();
    #define PK(k) (bf16x8){lo[k][0],lo[k][1],lo[k][2],lo[k][3],hi[k][0],hi[k][1],hi[k][2],hi[k][3]}
    o[d0]=__builtin_amdgcn_mfma_f32_32x32x16_bf16(pa0,PK(0),o[d0],0,0,0);
    o[d0]=__builtin_amdgcn_mfma_f32_32x32x16_bf16(pa1,PK(1),o[d0],0,0,0);
    o[d0]=__builtin_amdgcn_mfma_f32_32x32x16_bf16(pa2,PK(2),o[d0],0,0,0);
    o[d0]=__builtin_amdgcn_mfma_f32_32x32x16_bf16(pa3,PK(3),o[d0],0,0,0);
    #undef PK
  }
}

#ifndef ATTN_STORE16
#define ATTN_STORE16(p,v) (*(u32x4*)(p)=(v))
#endif
template<int THRL,int PIN,int POUT> __device__ __forceinline__ void attn_unit(int qb,const bf16*Qh,const bf16*__restrict__ Kh,const bf16*__restrict__ Vh,bf16*Oh,char*shm,const int wid_in){
  constexpr int DM=PIN;
  int lane; asm volatile("v_mbcnt_lo_u32_b32 %0, -1, 0\n\tv_mbcnt_hi_u32_b32 %0, -1, %0" : "=v"(lane));
  const int wid=wid_in; const int tid=wid*64+lane; const int r32=lane&31,hi=lane>>5;
  const int q0=qb*QB;
  const bf16*Qw=Qh+(long)(q0+wid*QBLK)*DM;
  const unsigned lds0=(unsigned)(uintptr_t)shm;
  float*wsf=(float*)(shm+LDS_WS)+wid*64;
  const bf16*ksrc=Kh+(long)lane*DM+wid*8;
  const bf16*vsrc=Vh+(long)(16*(wid&3)+(lane>>2))*DM+(wid>>2)*32+(lane&3)*8;
  const unsigned kdst=lds0+LDS_K+wid*1024, vdst=lds0+LDS_V+wid*1024;
  #define DMA_K(t,slot) glds16(ksrc+(long)(t)*KVBLK*DM,(unsigned)__builtin_amdgcn_readfirstlane(kdst+(slot)))
  #define DMA_V(t,slot) glds16(vsrc+(long)(t)*KVBLK*DM,(unsigned)__builtin_amdgcn_readfirstlane(vdst+(slot)))
  const int vb0=(int)(lds0+LDS_V)+((lane>>4)&1)*32+(lane&3)*8+(4*hi+((lane&15)>>2))*64;
  const char*Kbase=shm+LDS_K; bf16x8 kf[8];
  const lds_cptr shm3=(lds_cptr)shm; const lds_cptr kp0=shm3+LDS_K+hi*1024+r32*16; const lds_cptr vp0=shm3+LDS_V+((lane>>4)&1)*32+(lane&3)*8+(4*hi+((lane&15)>>2))*64;
  const int NT=(q0+QB)/KVBLK;
  DMA_K(0,0);DMA_V(0,0);DMA_K(1,SLOTB);
  bf16x8 qr[4];
  #pragma unroll
  for(int d0=0;d0<4;++d0)qr[d0]=*reinterpret_cast<const bf16x8*>(&Qw[(long)r32*DM+d0*16+hi*8]);
  float mhat=0.f,l_reg=0.f;f32x16 o[2];f32x16 negm;{float z0_=0.f;asm volatile("":"+v"(z0_));
  #pragma unroll
  for(int r=0;r<16;++r){o[0][r]=z0_;o[1][r]=z0_;negm[r]=z0_;}}asm volatile("":"+v"(negm));
  const int qrel=wid*QBLK+r32;
  #define CMASK(P0,P1,t) do{int jb_=(t)-(NT-4); if(jb_>=0)cmask(P0,P1,jb_,qrel,hi);}while(0)
  bool resc=false;
  #define START(P0,P1) do{ const float rm=rowmax(P0,P1); resc=false; \
    { const float dl=rm; mhat=fadd_s(mhat,dl); \
      _Pragma("unroll") for(int r=0;r<16;++r){P0[r]=fsub_s(P0[r],dl);P1[r]=fsub_s(P1[r],dl);} \
      _Pragma("unroll") for(int r=0;r<16;++r)negm[r]=-mhat; asm volatile("":"+v"(negm)); } \
    _Pragma("unroll") for(int r=0;r<16;++r)P0[r]=__builtin_amdgcn_exp2f(P0[r]); }while(0)
  #define RESC() do{ if(resc){ asm volatile("s_waitcnt lgkmcnt(0)":::"memory"); \
      _Pragma("unroll") for(int d_=0;d_<2;++d_) _Pragma("unroll") for(int r=0;r<16;++r)o[d_][r]*=wsf[crow(r,hi)]; } }while(0)
  f32x16 pA0,pA1,pB0,pB1;
  int sl_prev=0,sl_cur=0,sl_next=SLOTB;
  #define ROT() do{sl_prev=sl_cur;sl_cur=sl_next;sl_next=(sl_next==(NSLOT-1)*SLOTB)?0:sl_next+SLOTB;}while(0)
  DMA_K(2,2*SLOTB);
  WAIT_BAR(3);
  qkt(pA0,pA1,Kbase,qr,negm,r32,hi);asm volatile("s_nop 15\n\ts_nop 7":"+v"(pA0),"+v"(pA1));CMASK(pA0,pA1,0);
  START(pA0,pA1);
  _Pragma("unroll") for(int r=0;r<16;++r)pA1[r]=__builtin_amdgcn_exp2f(pA1[r]);
  WAIT_BAR(0);
  DMA_K(3,0);DMA_V(1,SLOTB);
  ROT();
  kload8(kf,kp0+sl_cur);
  WAIT_BAR(2);
  s16x4 vlo[8],vhi[8]; u32x4 pw0,pw1,pw2,pw3;
  #define PKW(P,B) cvtpk_s(P[B],P[B+1])
  #define PAF(k) __builtin_bit_cast(bf16x8,pw##k)
  #define VFR(i) (bf16x8){vlo[i][0],vlo[i][1],vlo[i][2],vlo[i][3],vhi[i][0],vhi[i][1],vhi[i][2],vhi[i][3]}
  #define PIN(x) asm volatile("":"+v"(x))
  #define MX3(a,b,c) __builtin_fmaxf(__builtin_fmaxf((a),(b)),(c))
  #define GAPA(MF,A0,A1,A2,A3,W0,W1,PW) do{ MF; sacc+=A0; sacc+=A1; sacc+=A2; sacc+=A3; PIN(sacc); W0; W1; PIN(PW); SBAR(); }while(0)
  #define EX(v) __builtin_amdgcn_exp2f(v)
  #define GAPB(MF,X,B) do{ MF; X[B]=EX(X[B]); X[B+1]=EX(X[B+1]); X[B+2]=EX(X[B+2]); X[B+3]=EX(X[B+3]); PIN(X); SBAR(); }while(0)
  #define VRD(i) do{ vlo[i]=vtr(vp_+(((i)>>2)*4096+((i)&3)*1024)); vhi[i]=vtr(vp_+(((i)>>2)*4096+((i)&3)*1024+512)); }while(0)
  #define KRD(G,j) do{ if(G){ kload2(kf,kp0+sl_next,j); SBAR(); } }while(0)
  #define STEP(C0,C1,P0,P1,t,GK,GV,GL) do{ SBAR(); \
    const lds_cptr vp_=vp0+sl_prev; \
    VRD(0); SBAR(); float sacc=(P0[0]+P0[1]); \
    GAPA(C0=__builtin_amdgcn_mfma_f32_32x32x16_bf16(kf[0],qr[0],negm,0,0,0), P0[2],P0[3],P0[4],P0[5],     pw0[0]=PKW(P0,0), pw0[1]=PKW(P0,2), pw0); \
    VRD(4); SBAR(); GAPA(C1=__builtin_amdgcn_mfma_f32_32x32x16_bf16(kf[1],qr[0],negm,0,0,0), P0[6],P0[7],P0[8],P0[9],     pw0[2]=PKW(P0,4), pw0[3]=PKW(P0,6), pw0); \
    VRD(1); SBAR(); GAPA(C0=__builtin_amdgcn_mfma_f32_32x32x16_bf16(kf[2],qr[1],C0,0,0,0),   P0[10],P0[11],P0[12],P0[13], pw1[0]=PKW(P0,8), pw1[1]=PKW(P0,10), pw1); \
    VRD(5); SBAR(); GAPA(C1=__builtin_amdgcn_mfma_f32_32x32x16_bf16(kf[3],qr[1],C1,0,0,0),   P0[14],P0[15],P1[0],P1[1],   pw1[2]=PKW(P0,12),pw1[3]=PKW(P0,14), pw1); \
    VRD(2); SBAR(); GAPA(C0=__builtin_amdgcn_mfma_f32_32x32x16_bf16(kf[4],qr[2],C0,0,0,0),   P1[2],P1[3],P1[4],P1[5],     pw2[0]=PKW(P1,0), pw2[1]=PKW(P1,2), pw2); \
    VRD(6); SBAR(); GAPA(C1=__builtin_amdgcn_mfma_f32_32x32x16_bf16(kf[5],qr[2],C1,0,0,0),   P1[6],P1[7],P1[8],P1[9],     pw2[2]=PKW(P1,4), pw2[3]=PKW(P1,6), pw2); \
    VRD(3); SBAR(); GAPA(C0=__builtin_amdgcn_mfma_f32_32x32x16_bf16(kf[6],qr[3],C0,0,0,0),   P1[10],P1[11],P1[12],P1[13], pw3[0]=PKW(P1,8), pw3[1]=PKW(P1,10), pw3); \
    VRD(7); SBAR(); GAPA(C1=__builtin_amdgcn_mfma_f32_32x32x16_bf16(kf[7],qr[3],C1,0,0,0),   P1[14],P1[15],0.f,0.f,       pw3[2]=PKW(P1,12),pw3[3]=PKW(P1,14), pw3); \
    l_reg+=sacc; \
    if(GK){DMA_K((t)+3,sl_cur);} if(GV){DMA_V((t)+1,sl_next);} \
    CMASK(C0,C1,t); \
    { float a=MX3(C0[0],C0[1],C1[0]),b=MX3(C0[2],C0[3],C1[1]); a=MX3(a,C1[2],C1[3]); \
      _Pragma("unroll") for(int r=4;r<16;r+=4){a=MX3(a,C0[r],C0[r+1]);b=MX3(b,C0[r+2],C0[r+3]);a=MX3(a,C1[r],C1[r+1]);b=MX3(b,C1[r+2],C1[r+3]);} \
      float rm=__builtin_fmaxf(a,b); { auto rr=__builtin_amdgcn_permlane32_swap(__float_as_uint(rm),__float_as_uint(rm),false,false); rm=__builtin_fmaxf(__uint_as_float(rr[0]),__uint_as_float(rr[1])); } \
      resc=false; \
      if(__builtin_expect(__any(rm>(float)THRL),0)){ const float dl=__builtin_fmaxf(rm,0.f); mhat+=dl; \
        _Pragma("unroll") for(int r=0;r<16;++r){C0[r]-=dl;C1[r]-=dl;} \
        _Pragma("unroll") for(int r=0;r<16;++r)negm[r]=-mhat; asm volatile("":"+v"(negm)); \
        const float f=__builtin_amdgcn_exp2f(-dl); l_reg*=f; if(hi==0)wsf[r32]=f; resc=true; } } \
    SBAR(); \
    GAPB(o[0]=__builtin_amdgcn_mfma_f32_32x32x16_bf16(PAF(0),VFR(0),o[0],0,0,0), C0,0); \
    GAPB(o[1]=__builtin_amdgcn_mfma_f32_32x32x16_bf16(PAF(0),VFR(4),o[1],0,0,0), C0,4); \
    KRD(GL,0); GAPB(o[0]=__builtin_amdgcn_mfma_f32_32x32x16_bf16(PAF(1),VFR(1),o[0],0,0,0), C0,8); \
    KRD(GL,1); GAPB(o[1]=__builtin_amdgcn_mfma_f32_32x32x16_bf16(PAF(1),VFR(5),o[1],0,0,0), C0,12); \
    KRD(GL,2); GAPB(o[0]=__builtin_amdgcn_mfma_f32_32x32x16_bf16(PAF(2),VFR(2),o[0],0,0,0), C1,0); \
    KRD(GL,3); GAPB(o[1]=__builtin_amdgcn_mfma_f32_32x32x16_bf16(PAF(2),VFR(6),o[1],0,0,0), C1,4); \
    GAPB(o[0]=__builtin_amdgcn_mfma_f32_32x32x16_bf16(PAF(3),VFR(3),o[0],0,0,0), C1,8); \
    GAPB(o[1]=__builtin_amdgcn_mfma_f32_32x32x16_bf16(PAF(3),VFR(7),o[1],0,0,0), C1,12); \
    }while(0)
  int t=1;
  #undef CMASK
  #define CMASK(P0,P1,t) do{}while(0)
  for(;t+5<NT;t+=2){
    STEP(pB0,pB1,pA0,pA1,t,true,true,true);     WAIT_BAR(2); RESC(); ROT();
    STEP(pA0,pA1,pB0,pB1,t+1,true,true,true);   WAIT_BAR(2); RESC(); ROT();
  }
  #undef CMASK
  #define CMASK(P0,P1,t) do{int jb_=(t)-(NT-4); if(jb_>=0)cmask(P0,P1,jb_,qrel,hi);}while(0)
  #define ENDW(tt) do{ if((tt)+3<NT){WAIT_BAR(2);} else if((tt)+2<NT){WAIT_BAR(1);} else {WAIT_BAR(0);} }while(0)
  for(;t+1<NT;t+=2){
    STEP(pB0,pB1,pA0,pA1,t,(t+3<NT),(t+1<NT),(t+1<NT));       ENDW(t);   RESC(); ROT();
    STEP(pA0,pA1,pB0,pB1,t+1,(t+4<NT),(t+2<NT),(t+2<NT));     ENDW(t+1); RESC(); ROT();
  }
  STEP(pB0,pB1,pA0,pA1,NT-1,false,false,false); RESC();
  { float sacc=pB0[0]+pB0[1]; _Pragma("unroll") for(int r=2;r<16;++r)sacc+=pB0[r]; _Pragma("unroll") for(int r=0;r<16;++r)sacc+=pB1[r]; l_reg+=sacc;
    pw0=(u32x4){PKW(pB0,0),PKW(pB0,2),PKW(pB0,4),PKW(pB0,6)};pw1=(u32x4){PKW(pB0,8),PKW(pB0,10),PKW(pB0,12),PKW(pB0,14)};pw2=(u32x4){PKW(pB1,0),PKW(pB1,2),PKW(pB1,4),PKW(pB1,6)};pw3=(u32x4){PKW(pB1,8),PKW(pB1,10),PKW(pB1,12),PKW(pB1,14)};
    SBAR(); pv(o,vb0+sl_cur,PAF(0),PAF(1),PAF(2),PAF(3)); }
  #undef PKW
  #undef PAF
  #undef VFR
  #undef PIN
  #undef MX3
  #undef GAPA
  #undef GAPB
  #undef EX
  #undef VRD
  #undef KRD
  #undef STEP
  #undef ENDW
  {auto rr=__builtin_amdgcn_permlane32_swap(__float_as_uint(l_reg),__float_as_uint(l_reg),false,false);l_reg=__uint_as_float(rr[0])+__uint_as_float(rr[1]);}
  if(hi==0)wsf[32+r32]=l_reg;asm volatile("s_waitcnt lgkmcnt(0)":::"memory");
  float rli[16];
  #pragma unroll
  for(int r=0;r<16;++r)rli[r]=__builtin_amdgcn_rcpf(wsf[32+crow(r,hi)]);
  bf16*Ow=Oh+(long)(q0+wid*QBLK)*POUT;
  { bf16*stg=(bf16*)(shm+LDS_OST)+wid*2048;
    #pragma unroll
    for(int r=0;r<16;++r){const int orow=crow(r,hi);
      #pragma unroll
      for(int d0=0;d0<2;++d0)stg[orow*64+d0*32+r32]=__float2bfloat16(o[d0][r]*rli[r]);}
    asm volatile("s_waitcnt lgkmcnt(0)":::"memory");
    #pragma unroll
    for(int i=0;i<4;++i){const int row=i*8+(lane>>3),ch=lane&7; const u32x4 v=*(const u32x4*)(stg+row*64+ch*8); ATTN_STORE16(Ow+(long)row*POUT+ch*8,v);} }
  asm volatile("s_waitcnt lgkmcnt(0)\n\ts_barrier":::"memory");
  #undef DMA_K
  #undef DMA_V
  #undef CMASK
  #undef START
  #undef RESC
  #undef ROT
}
constexpr int ATTN_LDS_BYTES=LDS_BYTES;
#undef SBAR
#undef WAIT_BAR
}

#define LAS __attribute__((address_space(3)))
typedef unsigned short bf16_t;
typedef float f32x4 __attribute__((ext_vector_type(4)));
typedef unsigned u32x4 __attribute__((ext_vector_type(4)));
typedef unsigned u32x2 __attribute__((ext_vector_type(2)));
typedef float f32x2 __attribute__((ext_vector_type(2)));
typedef _Float16 f16x8 __attribute__((ext_vector_type(8)));
typedef _Float16 f16x4 __attribute__((ext_vector_type(4)));

constexpr int NB = 2, S = 16384, T = NB * S, D = 1024, DEPTH = 4;
constexpr int EV_N = 3368, EV_NP = 3584, EV_ZP = 3072, OD_N = 2048;
constexpr float EPS = 1e-6f;
constexpr float LOG2E = 1.4426950408889634f;
constexpr float QSCALE = 0.125f * LOG2E;
constexpr int NWAVES = 8, NTHREADS = 512;
constexpr int LDS_BYTES = 163840;
constexpr int LDS_MISC = 131072;
constexpr int LDS_BARW = LDS_BYTES - 64;
constexpr int LDS_PTBL = LDS_BYTES - 512;

constexpr size_t MiB = 1u << 20;
constexpr size_t WS_CTL = 0, CTL_ZERO_BYTES = 1 * MiB;
constexpr size_t WS_MOD = 1 * MiB;
constexpr size_t WS_MODP = 1 * MiB + 256 * 1024;
constexpr size_t WS_ROPE = 2 * MiB;
constexpr size_t WS_S5A = 4 * MiB;
constexpr size_t WS_S5B = 4 * MiB + 64 * 1024;
constexpr size_t WS_LAM = 6 * MiB;
constexpr size_t WS_KM = 6 * MiB + 4096;
constexpr size_t WS_WRH = 6 * MiB + 512 * 1024;
constexpr size_t WS_KMH = 7 * MiB + 512 * 1024;
constexpr size_t WS_WEVIN = 8 * MiB;
constexpr size_t WS_WEVOUT = 22 * MiB;
constexpr size_t WS_WODIN = 26 * MiB;
constexpr size_t WS_WODOUT = 34 * MiB;
constexpr size_t WS_WGLU = 38 * MiB;
constexpr size_t WS_W13 = 40 * MiB;
constexpr size_t WS_W2 = 104 * MiB;
constexpr size_t WS_H = 136 * MiB;
constexpr size_t WS_O = 200 * MiB;
constexpr size_t WS_Z = 264 * MiB;
constexpr size_t WS_XG = 264 * MiB;
constexpr size_t WS_Y = 264 * MiB;
constexpr size_t WS_HID = 408 * MiB;
constexpr size_t WS_IQ = 456 * MiB;
constexpr size_t WS_YG = 456 * MiB;
constexpr size_t WS_IKW = 488 * MiB;
constexpr size_t WS_IQH = 496 * MiB;
constexpr size_t WS_IKH = 512 * MiB;
constexpr size_t WS_IW = 514 * MiB;
constexpr size_t WS_SEL = 516 * MiB;
constexpr size_t WS_YMIX = 548 * MiB;
constexpr size_t WS_LTOK = 612 * MiB;
constexpr size_t WS_TOKES = 616 * MiB;
constexpr size_t WS_TOKW = 617 * MiB;
constexpr size_t WS_TOKROW = 618 * MiB;
constexpr size_t WS_UG = 516 * MiB;
constexpr size_t WS_S5E = 496 * MiB;
constexpr size_t WS_S5HC = 488 * MiB;
constexpr size_t WS_S5KT = 620 * MiB;
constexpr size_t WS_S5WT = 624 * MiB;
constexpr size_t WS_S5A2 = 640 * MiB;
constexpr size_t WS_S5PW = 656 * MiB;
constexpr size_t WS_MLIST = 660 * MiB;
constexpr size_t WS_MPO = 724 * MiB;
constexpr size_t WS_MML = 852 * MiB;
constexpr size_t WS_MASKW = 724 * MiB;
constexpr size_t WS_NSEL = 860 * MiB;
constexpr size_t WS_XB = 862 * MiB;
constexpr size_t WS_END = 926 * MiB;
constexpr int XG_ROWS = 73728;
constexpr int CW_BAR = 4096;
constexpr int CW_MCNT = 16384;
constexpr int CW_CNT = 8192;

#define XB_TMO      128
#define XB_XCNT(j)  (256  + 64 * (j))
#define XB_XSUB(j)  (1280 + 64 * (j))
#define XB_XGEN(j)  (2304 + 64 * (j))
#define XB_TOP      3328
#define XB_TOPGEN   3392
#define XCD_BAR_WORDS 3456
#define XB_SPIN_CAP (1u << 24)

__device__ __forceinline__ unsigned xb_ld(unsigned* p)              { return __hip_atomic_load(p, __ATOMIC_RELAXED, __HIP_MEMORY_SCOPE_AGENT); }
__device__ __forceinline__ unsigned xb_add(unsigned* p, unsigned v) { return __hip_atomic_fetch_add(p, v, __ATOMIC_RELAXED, __HIP_MEMORY_SCOPE_AGENT); }
__device__ __forceinline__ unsigned xb_xcc_id() { return (unsigned)__builtin_amdgcn_s_getreg((3 << 11) | 20) & 0xFu; }
#define XB_SPIN(cond, bar) do { unsigned _sp = 0; while (cond) { __builtin_amdgcn_s_sleep(1); \
    if ((++_sp & 255u) == 0u) { if (xb_ld(&(bar)[XB_TMO])) break; if (_sp > XB_SPIN_CAP) { atomicAdd(&(bar)[XB_TMO], 1u); break; } } } } while (0)

struct XcdBarrier { unsigned* bar; unsigned x; volatile LAS unsigned* st; };

__device__ __forceinline__ XcdBarrier xcd_barrier_post(unsigned* bar, volatile LAS unsigned* st, bool leader) {
    XcdBarrier b; b.bar = bar; b.x = xb_xcc_id(); b.st = st;
    if (leader) (void)xb_add(&bar[XB_XCNT(b.x)], 1u);
    return b;
}
__device__ __forceinline__ void xcd_barrier_complete(unsigned* bar, unsigned x, unsigned& nloc, unsigned& nx) {
    const unsigned G = gridDim.x * gridDim.y * gridDim.z;
    unsigned sum, cnt, mine, sp = 0u;
    for (;;) {
        sum = 0u; cnt = 0u; mine = 0u;
#pragma unroll
        for (unsigned j = 0; j < 16; ++j) { const unsigned c = xb_ld(&bar[XB_XCNT(j)]); sum += c; cnt += (c > 0u) ? 1u : 0u; mine = (j == x) ? c : mine; }
        if (sum == G) break;
        __builtin_amdgcn_s_sleep(1);
        if ((++sp & 255u) == 0u) { if (xb_ld(&bar[XB_TMO])) break; if (sp > XB_SPIN_CAP) { atomicAdd(&bar[XB_TMO], 1u); break; } }
    }
    nloc = mine > 0u ? mine : 1u; nx = cnt > 0u ? cnt : 1u;
}
__device__ __forceinline__ void xcd_barrier(const XcdBarrier& b, bool leader) {
    asm volatile("s_waitcnt vmcnt(0)" ::: "memory");
    __syncthreads();
    if (leader) {
        unsigned* bar = b.bar;
        __builtin_amdgcn_s_waitcnt(0);
        unsigned nloc = b.st[0], nx = b.st[1];
        if (nloc == 0u) { xcd_barrier_complete(bar, b.x, nloc, nx); b.st[0] = nloc; b.st[1] = nx; }
        const unsigned old = xb_add(&bar[XB_XSUB(b.x)], 1u);
        const unsigned gen = old / nloc;
        if (old + 1u == (gen + 1u) * nloc) {
            __builtin_amdgcn_fence(__ATOMIC_RELEASE, "agent");
            asm volatile("s_waitcnt vmcnt(0)" ::: "memory");
            const unsigned og = xb_add(&bar[XB_TOP], 1u);
            const unsigned tg = og / nx;
            if (og + 1u == (tg + 1u) * nx) xb_add(&bar[XB_TOPGEN], 1u);
            else XB_SPIN(xb_ld(&bar[XB_TOPGEN]) == tg, bar);
            __builtin_amdgcn_fence(__ATOMIC_ACQUIRE, "agent");
            xb_add(&bar[XB_XGEN(b.x)], 1u);
            asm volatile("s_waitcnt vmcnt(0)" ::: "memory");
        } else {
            XB_SPIN(xb_ld(&bar[XB_XGEN(b.x)]) == gen, bar);
            __builtin_amdgcn_fence(__ATOMIC_ACQUIRE, "agent");
            asm volatile("s_waitcnt vmcnt(0)" ::: "memory");
        }
    }
    __syncthreads();
}

#define LDS_WAIT() asm volatile("s_waitcnt lgkmcnt(0)" ::: "memory")
__device__ __forceinline__ float bflo(unsigned w) { return __uint_as_float(w << 16); }
__device__ __forceinline__ float bfhi(unsigned w) { return __uint_as_float(w & 0xffff0000u); }
__device__ __forceinline__ unsigned pk2(float lo, float hi) { typedef float f32x2_ __attribute__((ext_vector_type(2))); typedef __bf16 bf16x2_ __attribute__((ext_vector_type(2))); const f32x2_ v = {lo, hi}; return __builtin_bit_cast(unsigned, __builtin_convertvector(v, bf16x2_)); }
__device__ __forceinline__ unsigned f2bf(float f) { return pk2(f, 0.f) & 0xffffu; }
__device__ __forceinline__ float shx_(float v, int m, int lane) { return __int_as_float(__builtin_amdgcn_ds_bpermute((lane ^ m) << 2, __float_as_int(v))); }
__device__ __forceinline__ unsigned shi_(unsigned v, int src) { return (unsigned)__builtin_amdgcn_ds_bpermute(src << 2, (int)v); }
#define SHX(v, m) shx_((v), (m), lane)
__device__ __forceinline__ float dpp_xor1(float v) { return __int_as_float(__builtin_amdgcn_update_dpp(0, __float_as_int(v), 0xB1, 0xF, 0xF, true)); }
__device__ __forceinline__ float dpp_xor2(float v) { return __int_as_float(__builtin_amdgcn_update_dpp(0, __float_as_int(v), 0x4E, 0xF, 0xF, true)); }
__device__ __forceinline__ float half_sum(float v) { const auto r = __builtin_amdgcn_permlane32_swap(__float_as_uint(v), __float_as_uint(v), false, false); return __uint_as_float(r[0]) + __uint_as_float(r[1]); }
__device__ __forceinline__ float half_max(float v) { const auto r = __builtin_amdgcn_permlane32_swap(__float_as_uint(v), __float_as_uint(v), false, false); return fmaxf(__uint_as_float(r[0]), __uint_as_float(r[1])); }
__device__ __forceinline__ float wave_sum_(float v, int lane) {
    v += dpp_xor1(v); v += dpp_xor2(v); v += shx_(v, 4, lane); v += shx_(v, 8, lane); v += shx_(v, 16, lane); return half_sum(v);
}

#define wave_sum(v) wave_sum_((v), lane)
__device__ __forceinline__ float wave_max_(float v, int lane) {
#pragma unroll
    for (int o = 1; o < 64; o <<= 1) v = fmaxf(v, shx_(v, o, lane));
    return v;
}
__device__ __forceinline__ bool qk_bounded(const float* gq, const float* gk, int lane) {
    const float a = wave_max_(fabsf(gq[lane]), lane), b = wave_max_(fabsf(gk[lane]), lane);
    return 64.0f * QSCALE * a * b <= 60.0f;
}
__device__ __forceinline__ void unpack8(const u32x4 w, float (&v)[8]) {
    v[0] = bflo(w.x); v[1] = bfhi(w.x); v[2] = bflo(w.y); v[3] = bfhi(w.y); v[4] = bflo(w.z); v[5] = bfhi(w.z); v[6] = bflo(w.w); v[7] = bfhi(w.w);
}
__device__ __forceinline__ u32x4 pack8(const float (&v)[8]) { u32x4 w; w.x = pk2(v[0], v[1]); w.y = pk2(v[2], v[3]); w.z = pk2(v[4], v[5]); w.w = pk2(v[6], v[7]); return w; }
__device__ __forceinline__ float gelu_tanh(float y) {
    const float z = 0.7978845608028654f * (y + 0.044715f * y * y * y);
    const float e = __builtin_amdgcn_exp2f(2.885390081777927f * z);
    const float th = 1.0f - 2.0f * __builtin_amdgcn_rcpf(e + 1.0f);
    return 0.5f * y * (1.0f + th);
}
__device__ __forceinline__ float sigmoidf_(float v) { return __builtin_amdgcn_rcpf(1.0f + __builtin_amdgcn_exp2f(-1.4426950408889634f * v)); }
__device__ __forceinline__ unsigned ordkey(float f) { const unsigned u = __float_as_uint(f); return u ^ ((unsigned)((int)u >> 31) | 0x80000000u); }

struct EpiPlain {
    static constexpr bool PERM = true, AFTER_DRAIN = false;
    bf16_t* O; int ldc;
    __device__ __forceinline__ void operator()(const pg8::f32x4 (&acc)[2][2][4][2], const pg8::Unit& u, int wr, int wc, int fr, int fq) const {
        const int row0 = u.pm * 256 + wr * 64 + fr, col0 = u.pn * 256 + wc * 32 + 8 * fq;
#pragma unroll
        for (int ai = 0; ai < 2; ++ai)
#pragma unroll
            for (int m = 0; m < 4; ++m) { bf16_t* rowp = O + (size_t)(row0 + ai * 128 + m * 16) * ldc + col0;
#pragma unroll
                for (int bj = 0; bj < 2; ++bj) { const pg8::f32x4 v0 = acc[ai][bj][m][0], v1 = acc[ai][bj][m][1];
                    u32x4 w; w.x = pk2(v0[0], v0[1]); w.y = pk2(v0[2], v0[3]); w.z = pk2(v1[0], v1[1]); w.w = pk2(v1[2], v1[3]);
                    *(u32x4*)(rowp + bj * 128) = w; } }
    }
};
__device__ __forceinline__ void epi_khead(const pg8::f32x4 (&acc)[2][2][4][2], bf16_t* Z, int ldz, int colbase, const float* gain, const float* COSH, const float* SINH, int row0, int wc, int fr, int fq) {
    const int lane = fr + 16 * fq;
    float g[2][8];
#pragma unroll
    for (int bj = 0; bj < 2; ++bj)
#pragma unroll
        for (int e = 0; e < 8; ++e) g[bj][e] = gain[bj * 32 + 8 * fq + e];
#pragma unroll
    for (int ai = 0; ai < 2; ++ai)
#pragma unroll
      for (int mp = 0; mp < 4; mp += 2) {
        f32x4 csv[2][2], snv[2][2];
#pragma unroll
        for (int mm = 0; mm < 2; ++mm) { const int pos = (row0 + ai * 128 + (mp + mm) * 16) & (S - 1);
            csv[mm][0] = *(const f32x4*)(COSH + pos * 8); csv[mm][1] = *(const f32x4*)(COSH + pos * 8 + 4); snv[mm][0] = *(const f32x4*)(SINH + pos * 8); snv[mm][1] = *(const f32x4*)(SINH + pos * 8 + 4); }
        __builtin_amdgcn_sched_barrier(0);
#pragma unroll
        for (int mm = 0; mm < 2; ++mm) { const int m = mp + mm; const int row = row0 + ai * 128 + m * 16;
            float v[2][8]; float ss = 0.f;
#pragma unroll
            for (int bj = 0; bj < 2; ++bj)
#pragma unroll
                for (int e = 0; e < 4; ++e) { v[bj][e] = acc[ai][bj][m][0][e]; v[bj][4 + e] = acc[ai][bj][m][1][e]; ss += v[bj][e] * v[bj][e] + v[bj][4 + e] * v[bj][4 + e]; }
            ss += shx_(ss, 16, lane); ss = half_sum(ss);
            const float r = rsqrtf(ss * (1.0f / 64.0f) + EPS);
#pragma unroll
            for (int bj = 0; bj < 2; ++bj)
#pragma unroll
                for (int e = 0; e < 8; ++e) v[bj][e] *= r * g[bj][e];
#pragma unroll
            for (int e = 0; e < 8; ++e) { const float oth = shx_(v[0][e], 16, lane); const float cs = csv[mm][e >> 2][e & 3], sn = snv[mm][e >> 2][e & 3];
                if (fq == 0) v[0][e] = v[0][e] * cs - oth * sn; else if (fq == 1) v[0][e] = v[0][e] * cs + oth * sn; }
            bf16_t* zp = Z + (size_t)row * ldz + colbase + wc * 64 + 8 * fq;
            *(u32x4*)zp = pack8(v[0]); *(u32x4*)(zp + 32) = pack8(v[1]); }
        __builtin_amdgcn_sched_barrier(0);
      }
}
struct EpiEvenIn {
    static constexpr bool PERM = true, AFTER_DRAIN = false;
    bf16_t* Z; _Float16* IQH; _Float16* IKH; float* IW; const float* a_kn; const float* b_kn; const float* idx_kn; const float* COSH; const float* SINH; const float* COSI; const float* SINI;
    __device__ __forceinline__ void operator()(const pg8::f32x4 (&acc)[2][2][4][2], const pg8::Unit& u, int wr, int wc, int fr, int fq) const {
        const int row0 = u.pm * 256 + wr * 64 + fr; const int lane = fr + 16 * fq;
        if (u.pn == 2 || u.pn == 3) epi_khead(acc, Z, EV_ZP, 512 + (u.pn & 1) * 256, a_kn, COSH, SINH, row0, wc, fr, fq);
        else if (u.pn == 8 || u.pn == 9) epi_khead(acc, Z, EV_ZP, 2048 + (u.pn & 1) * 256, b_kn, COSH, SINH, row0, wc, fr, fq);
        else if (u.pn < 12) {
            const int col0 = u.pn * 256 + wc * 32 + 8 * fq;
#pragma unroll
            for (int ai = 0; ai < 2; ++ai)
#pragma unroll
                for (int m = 0; m < 4; ++m) { bf16_t* rowp = Z + (size_t)(row0 + ai * 128 + m * 16) * EV_ZP + col0;
#pragma unroll
                    for (int bj = 0; bj < 2; ++bj) { const pg8::f32x4 v0 = acc[ai][bj][m][0], v1 = acc[ai][bj][m][1];
                        u32x4 w; w.x = pk2(v0[0], v0[1]); w.y = pk2(v0[2], v0[3]); w.z = pk2(v1[0], v1[1]); w.w = pk2(v1[2], v1[3]);
                        *(u32x4*)(rowp + bj * 128) = w; } }
        } else if (u.pn == 12) {
#pragma unroll
            for (int ai = 0; ai < 2; ++ai) {
                f32x4 csr[4], snr[4];
#pragma unroll
                for (int m = 0; m < 4; ++m) { const int pos = (row0 + ai * 128 + m * 16) & (S - 1); csr[m] = *(const f32x4*)(COSI + pos * 4); snr[m] = *(const f32x4*)(SINI + pos * 4); }
                __builtin_amdgcn_sched_barrier(0);
#pragma unroll
                for (int m = 0; m < 4; ++m) { const int row = row0 + ai * 128 + m * 16;
                    const f32x4 cs = csr[m], sn = snr[m];
#pragma unroll
                    for (int bj = 0; bj < 2; ++bj) { pg8::f32x4 v0 = acc[ai][bj][m][0], v1 = acc[ai][bj][m][1];
                        if (fq == 0) { const pg8::f32x4 a0 = v0, a1 = v1;
#pragma unroll
                            for (int e = 0; e < 4; ++e) { v0[e] = a0[e] * cs[e] - a1[e] * sn[e]; v1[e] = a1[e] * cs[e] + a0[e] * sn[e]; } }
                        f16x8 hq;
#pragma unroll
                        for (int e = 0; e < 4; ++e) { hq[e] = (_Float16)v0[e]; hq[4 + e] = (_Float16)v1[e]; }
                        *(f16x8*)(IQH + (size_t)row * 256 + bj * 128 + wc * 32 + 8 * fq) = hq; } }
                __builtin_amdgcn_sched_barrier(0);
            }
        } else {
            if (wc == 0) {
                float g[8];
#pragma unroll
                for (int e = 0; e < 8; ++e) g[e] = idx_kn[8 * fq + e];
#pragma unroll
                for (int ai = 0; ai < 2; ++ai) {
                  f32x4 csr[4], snr[4];
#pragma unroll
                  for (int m = 0; m < 4; ++m) { const int pos = (row0 + ai * 128 + m * 16) & (S - 1); csr[m] = *(const f32x4*)(COSI + pos * 4); snr[m] = *(const f32x4*)(SINI + pos * 4); }
                  __builtin_amdgcn_sched_barrier(0);
#pragma unroll
                    for (int m = 0; m < 4; ++m) { const int row = row0 + ai * 128 + m * 16;
                        float v[8]; float ss = 0.f;
#pragma unroll
                        for (int e = 0; e < 4; ++e) { v[e] = acc[ai][0][m][0][e]; v[4 + e] = acc[ai][0][m][1][e]; ss += v[e] * v[e] + v[4 + e] * v[4 + e]; }
                        ss += shx_(ss, 16, lane); ss = half_sum(ss);
                        const float r = rsqrtf(ss * (1.0f / 32.0f) + EPS);
#pragma unroll
                        for (int e = 0; e < 8; ++e) v[e] *= r * g[e];
                        if (fq == 0) {
#pragma unroll
                            for (int e = 0; e < 4; ++e) { const float x1 = v[e], x2 = v[4 + e]; const float cs = csr[m][e], sn = snr[m][e]; v[e] = x1 * cs - x2 * sn; v[4 + e] = x2 * cs + x1 * sn; } }
                        f16x8 hk;
#pragma unroll
                        for (int e = 0; e < 8; ++e) hk[e] = (_Float16)v[e];
                        *(f16x8*)(IKH + (size_t)row * 32 + 8 * fq) = hk; }
                  __builtin_amdgcn_sched_barrier(0);
                }
            } else if (wc == 1 && fq == 0) {
#pragma unroll
                for (int ai = 0; ai < 2; ++ai)
#pragma unroll
                    for (int m = 0; m < 4; ++m) { float* wp = IW + (size_t)(row0 + ai * 128 + m * 16) * 8; *(pg8::f32x4*)wp = acc[ai][0][m][0]; *(pg8::f32x4*)(wp + 4) = acc[ai][0][m][1]; }
            }
        }
    }
};
struct EpiOddIn {
    static constexpr bool PERM = true, AFTER_DRAIN = false;
    bf16_t* Z; bf16_t* UG; const float* c_kn; const float* COSH; const float* SINH;
    __device__ __forceinline__ void operator()(const pg8::f32x4 (&acc)[2][2][4][2], const pg8::Unit& u, int wr, int wc, int fr, int fq) const {
        const int row0 = u.pm * 256 + wr * 64 + fr, col0 = u.pn * 256 + wc * 32 + 8 * fq;
        if (u.pn == 2 || u.pn == 3) { epi_khead(acc, Z, OD_N, 512 + (u.pn & 1) * 256, c_kn, COSH, SINH, row0, wc, fr, fq); return; }
#pragma unroll
        for (int ai = 0; ai < 2; ++ai)
#pragma unroll
            for (int m = 0; m < 4; ++m) { const size_t row = (size_t)(row0 + ai * 128 + m * 16);
#pragma unroll
                for (int bj = 0; bj < 2; ++bj) { const pg8::f32x4 v0 = acc[ai][bj][m][0], v1 = acc[ai][bj][m][1]; const int col = col0 + bj * 128;
                    u32x4 w; w.x = pk2(v0[0], v0[1]); w.y = pk2(v0[2], v0[3]); w.z = pk2(v1[0], v1[1]); w.w = pk2(v1[2], v1[3]);
                    if (u.pn < 6) *(u32x4*)(Z + row * OD_N + col) = w;
                    else { const int cu = col - 1536; *(u32x4*)(UG + ((size_t)(cu >> 4) * T + row) * 16 + (cu & 15)) = w; } } }
    }
};
__device__ __forceinline__ void load_q_normed(attn_body::bf16x8 (&qr)[4], const bf16_t* zrow, const float* gain, const float* COSH, const float* SINH, int pos, int hi, int lane) {
    float v[4][8]; float ss = 0.f;
#pragma unroll
    for (int d0 = 0; d0 < 4; ++d0) { unpack8(*(const u32x4*)(zrow + d0 * 16 + hi * 8), v[d0]);
#pragma unroll
        for (int e = 0; e < 8; ++e) ss += v[d0][e] * v[d0][e]; }
    ss = half_sum(ss);
    const float r = rsqrtf(ss * (1.0f / 64.0f) + EPS) * QSCALE;
#pragma unroll
    for (int d0 = 0; d0 < 4; ++d0)
#pragma unroll
        for (int e = 0; e < 8; ++e) v[d0][e] *= r * gain[d0 * 16 + hi * 8 + e];
#pragma unroll
    for (int e = 0; e < 8; ++e) { const float oth = shx_(v[0][e], 32, lane); const float cs = COSH[pos * 8 + e], sn = SINH[pos * 8 + e];
        v[0][e] = hi ? v[0][e] * cs + oth * sn : v[0][e] * cs - oth * sn; }
#pragma unroll
    for (int d0 = 0; d0 < 4; ++d0) qr[d0] = __builtin_bit_cast(attn_body::bf16x8, pack8(v[d0]));
}
struct EpiSwiGLU {
    static constexpr bool PERM = true, AFTER_DRAIN = false;
    bf16_t* HID;
    __device__ __forceinline__ void operator()(const pg8::f32x4 (&acc)[2][2][4][2], const pg8::Unit& u, int wr, int wc, int fr, int fq) const {
        const int row0 = u.pm * 256 + wr * 64 + fr, col0 = (u.pn * 256 + wc * 32 + 8 * fq) >> 1;
#pragma unroll
        for (int ai = 0; ai < 2; ++ai)
#pragma unroll
            for (int m = 0; m < 4; ++m) { bf16_t* rowp = HID + (size_t)(row0 + ai * 128 + m * 16) * 512 + col0;
#pragma unroll
                for (int bj = 0; bj < 2; ++bj) { const pg8::f32x4 v0 = acc[ai][bj][m][0], v1 = acc[ai][bj][m][1];
                    const float h0 = v0[0] * sigmoidf_(v0[0]) * v0[1], h1 = v0[2] * sigmoidf_(v0[2]) * v0[3];
                    const float h2 = v1[0] * sigmoidf_(v1[0]) * v1[1], h3 = v1[2] * sigmoidf_(v1[2]) * v1[3];
                    u32x2 w; w.x = pk2(h0, h1); w.y = pk2(h2, h3);
                    *(u32x2*)(rowp + bj * 64) = w; } }
    }
};
struct EpiGLU {
    static constexpr bool PERM = true, AFTER_DRAIN = false;
    bf16_t* O; const bf16_t* YG; const float* gb;
    __device__ __forceinline__ void operator()(const pg8::f32x4 (&acc)[2][2][4][2], const pg8::Unit& u, int wr, int wc, int fr, int fq) const {
        const int row0 = u.pm * 256 + wr * 64 + fr, col0 = u.pn * 256 + wc * 32 + 8 * fq;
#pragma unroll
        for (int ai = 0; ai < 2; ++ai)
#pragma unroll
            for (int bj = 0; bj < 2; ++bj) {
                const int c = col0 + bj * 128;
                u32x4 yr[4];
#pragma unroll
                for (int m = 0; m < 4; ++m) yr[m] = *(const u32x4*)(YG + (size_t)(row0 + ai * 128 + m * 16) * 512 + c);
                const pg8::f32x4 b0 = *(const pg8::f32x4*)(gb + c), b1 = *(const pg8::f32x4*)(gb + c + 4);
                __builtin_amdgcn_sched_barrier(0);
#pragma unroll
                for (int m = 0; m < 4; ++m) { const size_t row = (size_t)(row0 + ai * 128 + m * 16);
                    const pg8::f32x4 v0 = acc[ai][bj][m][0], v1 = acc[ai][bj][m][1];
                    float y[8]; unpack8(yr[m], y);
                    float o[8];
#pragma unroll
                    for (int j = 0; j < 4; ++j) { o[j] = y[j] * sigmoidf_(v0[j] + b0[j]); o[4 + j] = y[4 + j] * sigmoidf_(v1[j] + b1[j]); }
                    *(u32x4*)(O + row * 1024 + 512 + c) = pack8(o); }
                __builtin_amdgcn_sched_barrier(0);
            }
    }
};
struct MoeOrder {
    int nN, nunits, G, c; const LAS int* tile_e;
    __device__ __forceinline__ bool next(int i, pg8::Unit& u) const { const int L = i * G + c; if (L >= nunits) return false;
        int w = L; { const int q = nunits / 8, r = nunits % 8, xcd = w % 8, off = w / 8; w = (xcd < r ? xcd * (q + 1) : r * (q + 1) + (xcd - r) * q) + off; }
        u.pm = w / nN; u.pn = w % nN; u.be = tile_e[u.pm]; return true; }
    __device__ __forceinline__ void a_ready(const pg8::Unit&) const {}
    __device__ __forceinline__ void done(const pg8::Unit&) const {}
};

__device__ __forceinline__ int wt_row(int n, int row_mul, int row_add) {
    if (row_mul > 0) return n * row_mul + row_add;
    const int tile = n >> 8, w = n & 255;
    const bool ktile = (tile == 2 || tile == 3) || (row_mul == -1 && (tile == 8 || tile == 9));
    return ktile ? tile * 256 + ((w & 63) >> 5) * 128 + (w >> 6) * 32 + (w & 31) : n;
}
__device__ __forceinline__ void transpose_item(const float* W, int K, int N, bf16_t* WT, int row_mul, int row_add, LAS float* scr, int item, int nblk, int lane) {
    const int kb = item / nblk, nb = item % nblk, k0 = 64 * kb, n0 = 32 * nb;
    const int nn = n0 + (lane & 31);
    float tv[32];
#pragma unroll
    for (int i = 0; i < 32; ++i) { const int kk = 2 * i + (lane >> 5); tv[i] = (nn < N) ? W[(size_t)(k0 + kk) * N + nn] : 0.f; }
#pragma unroll
    for (int i = 0; i < 32; ++i) { const int kk = 2 * i + (lane >> 5); scr[kk * 33 + (lane & 31)] = tv[i]; }
    LDS_WAIT(); asm volatile("" ::: "memory");
    const int c = lane & 7;
#pragma unroll
    for (int j = 0; j < 4; ++j) { const int n = (lane >> 3) + 8 * j; const LAS float* s = scr + (8 * c) * 33 + n;
        u32x4 o; o.x = pk2(s[0 * 33], s[1 * 33]); o.y = pk2(s[2 * 33], s[3 * 33]); o.z = pk2(s[4 * 33], s[5 * 33]); o.w = pk2(s[6 * 33], s[7 * 33]);
        *(u32x4*)(WT + (size_t)wt_row(n0 + n, row_mul, row_add) * K + k0 + 8 * c) = o; }
    LDS_WAIT(); asm volatile("" ::: "memory");
}
__device__ __forceinline__ void norm_mod_row(const float* xrow, const float* sh, const float* sc, bf16_t* orow, int lane) {
    f32x4 v[4]; float ss = 0.f;
#pragma unroll
    for (int j = 0; j < 4; ++j) { v[j] = *(const f32x4*)(xrow + 4 * lane + 256 * j); ss += (v[j].x * v[j].x + v[j].y * v[j].y) + (v[j].z * v[j].z + v[j].w * v[j].w); }
    const float r = rsqrtf(wave_sum(ss) * (1.0f / 1024.0f) + EPS);
#pragma unroll
    for (int j = 0; j < 4; ++j) { const f32x4 a = *(const f32x4*)(sc + 4 * lane + 256 * j), b = *(const f32x4*)(sh + 4 * lane + 256 * j);
        u32x2 w; w.x = pk2(v[j].x * r * (1.f + a.x) + b.x, v[j].y * r * (1.f + a.y) + b.y); w.y = pk2(v[j].z * r * (1.f + a.z) + b.z, v[j].w * r * (1.f + a.w) + b.w);
        *(u32x2*)(orow + 4 * lane + 256 * j) = w; }
}

__device__ __forceinline__ void attn_key(const bf16_t* kp, const bf16_t* vp, const float (&q)[64], float& m, float& l, float (&o)[64]) {
    float s = 0.f;
#pragma unroll
    for (int i = 0; i < 8; ++i) { float kv[8]; unpack8(*(const u32x4*)(kp + 8 * i), kv);
#pragma unroll
        for (int j = 0; j < 8; ++j) s += q[8 * i + j] * kv[j]; }
    const float mn = fmaxf(m, s);
    const float f = __builtin_amdgcn_exp2f(m - mn), p = __builtin_amdgcn_exp2f(s - mn);
    l = l * f + p; m = mn;
#pragma unroll
    for (int i = 0; i < 8; ++i) { float vv[8]; unpack8(*(const u32x4*)(vp + 8 * i), vv);
#pragma unroll
        for (int j = 0; j < 8; ++j) o[8 * i + j] = o[8 * i + j] * f + p * vv[j]; }
}
__device__ __forceinline__ void load_q64(const bf16_t* qp, float scale, float (&q)[64]) {
#pragma unroll
    for (int i = 0; i < 8; ++i) { float t[8]; unpack8(*(const u32x4*)(qp + 8 * i), t);
#pragma unroll
        for (int j = 0; j < 8; ++j) q[8 * i + j] = t[j] * scale; }
}

struct Args { const void* in[37]; float* out; unsigned char* ws; int ph_lo, ph_hi, probe_var, pad; };
#ifndef PROBE_GEMM_REPS
#define PROBE_GEMM_REPS 1
#endif
#if PROBE_GEMM_REPS == 2
template <class Sc> struct Twice { Sc S; int n1;
    __device__ __forceinline__ bool next(int i, pg8::Unit& u) const { return i < n1 ? S.next(i, u) : S.next(i - n1, u); }
    __device__ __forceinline__ void a_ready(const pg8::Unit&) const {}
    __device__ __forceinline__ void done(const pg8::Unit&) const {} };
#define PROBE_SCHED(T) Twice<T>
#define PROBE_WRAP(T, v) Twice<T> PS_; PS_.S = v; { int n1_ = 0; pg8::Unit tu_; while (v.next(n1_, tu_)) ++n1_; PS_.n1 = n1_; }
#else
#define PROBE_SCHED(T) T
#define PROBE_WRAP(T, v) const T& PS_ = v
#endif
#ifdef PROBE_BAR2
#define PROBE_EXTRA_BAR(b) xcd_barrier(b, lsg(wid0) == 0 && lane_id_v() == 0);
#else
#define PROBE_EXTRA_BAR(b)
#endif
constexpr int N_PHASES = 3 + 2 * (8 + 10);

template <int NV, bool MASKED, bool CAUSAL, int PIN, int POUT, bool NOMAX = false>
__device__ __forceinline__ void flash_unit(LAS unsigned char* L0, const bf16_t* Qb, const bf16_t* Kb, const bf16_t* Vb, bf16_t* Ob, const unsigned* mbase, int qb, int wid, int lane, const float* qgain, const float* COSH, const float* SINH) {
    const int r32 = lane & 31, hi = lane >> 5;
    LAS unsigned char* ldsKs = L0; LAS unsigned char* ldsVs = L0 + 16384;
    LAS float* wsf = (LAS float*)(L0 + 16384 + NV * 16384 + wid * 256);
    LAS bf16_t* stg = (LAS bf16_t*)(L0 + 16384 + NV * 16384 + 2048 + wid * 4096);
    const int qrow = qb * 256 + wid * 32 + r32;
    const int NT = 4 * (qb + 1);
    const bf16_t* kbp = Kb + (size_t)lane * PIN + wid * 8;
    const bf16_t* vbp = Vb + (size_t)(16 * (wid & 3) + (lane >> 2)) * PIN + (wid >> 2) * 32 + (lane & 3) * 8;
    const unsigned* mwp = MASKED ? mbase + (size_t)qrow * 2 + hi : nullptr;
    u32x4 kreg = *(const u32x4*)kbp, vreg[NV]; unsigned mw = 0u, mwn = 0u;
#pragma unroll
    for (int j = 0; j < NV; ++j) vreg[j] = *(const u32x4*)(vbp + j * 64);
    if (MASKED) mw = mwp[0];
    __builtin_amdgcn_sched_barrier(0);
    attn_body::bf16x8 qr[4];
    load_q_normed(qr, Qb + (size_t)qrow * PIN, qgain, COSH, SINH, qrow, hi, lane);
    *(LAS u32x4*)(ldsKs + wid * 1024 + lane * 16) = kreg;
#pragma unroll
    for (int j = 0; j < NV; ++j) *(LAS u32x4*)(ldsVs + j * 16384 + wid * 1024 + lane * 16) = vreg[j];
    __syncthreads();
    float mhat = 0.f, lsum = 0.f;
    attn_body::f32x16 o[2 * NV], negm;
#pragma unroll
    for (int r = 0; r < 16; ++r) { negm[r] = 0.f;
#pragma unroll
        for (int j = 0; j < 2 * NV; ++j) o[j][r] = 0.f; }
    const int vb0 = (int)(unsigned)(unsigned long long)ldsVs + ((lane >> 4) & 1) * 32 + (lane & 3) * 8 + (4 * hi + ((lane & 15) >> 2)) * 64;
    for (int t = 0; t < NT; ++t) {
        const int slot = (t & 1) * 8192;
        if (t + 1 < NT) { kreg = *(const u32x4*)(kbp + (size_t)(t + 1) * 64 * PIN);
#pragma unroll
            for (int j = 0; j < NV; ++j) vreg[j] = *(const u32x4*)(vbp + (size_t)(t + 1) * 64 * PIN + j * 64);
            if (MASKED) mwn = mwp[(size_t)(t + 1) * S * 2]; }
        attn_body::f32x16 p0 = negm, p1 = negm;
        { const LAS unsigned char* kb = ldsKs + slot + hi * 1024 + r32 * 16;
#pragma unroll
          for (int d0 = 0; d0 < 4; ++d0) {
              const attn_body::bf16x8 b0 = *(const LAS attn_body::bf16x8*)(kb + d0 * 2048), b1 = *(const LAS attn_body::bf16x8*)(kb + d0 * 2048 + 512);
              p0 = __builtin_amdgcn_mfma_f32_32x32x16_bf16(b0, qr[d0], p0, 0, 0, 0);
              p1 = __builtin_amdgcn_mfma_f32_32x32x16_bf16(b1, qr[d0], p1, 0, 0, 0); } }
        if (CAUSAL) { const int jb = t - (NT - 4); if (jb >= 0) attn_body::cmask(p0, p1, jb, wid * 32 + r32, hi); }
        float rm = 0.f;
        if (!NOMAX) { rm = fmaxf(p0[0], p1[0]);
#pragma unroll
            for (int r = 1; r < 16; ++r) rm = fmaxf(rm, fmaxf(p0[r], p1[r]));
            rm = half_max(rm); }
        bool resc = false;
        if (!NOMAX && __any(rm > 8.0f)) {
            const float dl = fmaxf(rm, 0.f); mhat += dl;
#pragma unroll
            for (int r = 0; r < 16; ++r) { p0[r] -= dl; p1[r] -= dl; negm[r] = -mhat; }
            const float f = __builtin_amdgcn_exp2f(-dl); lsum *= f; if (hi == 0) wsf[r32] = f; resc = true;
        }
        const int wb = (int)mw; float ssum = 0.f;
#pragma unroll
        for (int r = 0; r < 16; ++r) {
            float e0 = __builtin_amdgcn_exp2f(p0[r]), e1 = __builtin_amdgcn_exp2f(p1[r]);
            if (MASKED) { e0 = __uint_as_float(__float_as_uint(e0) & (unsigned)__builtin_amdgcn_sbfe(wb, r, 1)); e1 = __uint_as_float(__float_as_uint(e1) & (unsigned)__builtin_amdgcn_sbfe(wb, 16 + r, 1)); }
            p0[r] = e0; p1[r] = e1; ssum += e0 + e1; }
        lsum += ssum;
        u32x4 pw0, pw1, pw2, pw3;
#pragma unroll
        for (int k = 0; k < 4; ++k) { pw0[k] = attn_body::cvtpk_s(p0[2 * k], p0[2 * k + 1]); pw1[k] = attn_body::cvtpk_s(p0[8 + 2 * k], p0[9 + 2 * k]);
            pw2[k] = attn_body::cvtpk_s(p1[2 * k], p1[2 * k + 1]); pw3[k] = attn_body::cvtpk_s(p1[8 + 2 * k], p1[9 + 2 * k]); }
        if (resc) { LDS_WAIT();
#pragma unroll
            for (int r = 0; r < 16; ++r) { const float f = wsf[attn_body::crow(r, hi)];
#pragma unroll
                for (int j = 0; j < 2 * NV; ++j) o[j][r] *= f; } }
#pragma unroll
        for (int j = 0; j < NV; ++j)
            attn_body::pv(o + 2 * j, vb0 + j * 16384 + slot, __builtin_bit_cast(attn_body::bf16x8, pw0), __builtin_bit_cast(attn_body::bf16x8, pw1), __builtin_bit_cast(attn_body::bf16x8, pw2), __builtin_bit_cast(attn_body::bf16x8, pw3));
        if (t + 1 < NT) { const int ns = ((t + 1) & 1) * 8192; *(LAS u32x4*)(ldsKs + ns + wid * 1024 + lane * 16) = kreg;
#pragma unroll
            for (int j = 0; j < NV; ++j) *(LAS u32x4*)(ldsVs + j * 16384 + ns + wid * 1024 + lane * 16) = vreg[j]; }
        mw = mwn;
        __syncthreads();
    }
    lsum += shx_(lsum, 32, lane);
    if (hi == 0) wsf[r32] = lsum;
    LDS_WAIT();
    float rl[16];
#pragma unroll
    for (int r = 0; r < 16; ++r) rl[r] = __builtin_amdgcn_rcpf(wsf[attn_body::crow(r, hi)]);
#pragma unroll
    for (int j = 0; j < NV; ++j) {
#pragma unroll
        for (int r = 0; r < 16; ++r) { const int orow = attn_body::crow(r, hi);
            stg[orow * 64 + r32] = (bf16_t)f2bf(o[2 * j][r] * rl[r]); stg[orow * 64 + 32 + r32] = (bf16_t)f2bf(o[2 * j + 1][r] * rl[r]); }
        LDS_WAIT();
#pragma unroll
        for (int q = 0; q < 4; ++q) { const int row = q * 8 + (lane >> 3), ch = lane & 7;
            *(u32x4*)(Ob + (size_t)(qb * 256 + wid * 32 + row) * POUT + j * 64 + ch * 8) = *(const LAS u32x4*)(stg + row * 64 + ch * 8); }
        LDS_WAIT();
    }
    __syncthreads();
}
template <int NV, bool MASKED, bool CAUSAL, int PIN, int POUT, bool NOMAX = false>
__device__ __forceinline__ void flash_unit_q2(LAS unsigned char* L0, const bf16_t* Qb, const bf16_t* Kb, const bf16_t* Vb, bf16_t* Ob, const unsigned* mbase, int qb, int wid, int lane, const float* qgain, const float* COSH, const float* SINH) {
    typedef __attribute__((address_space(3))) attn_body::v4i16_t* vtr_ptr;
    const int r32 = lane & 31, hi = lane >> 5;
    LAS unsigned char* ldsKs = L0; LAS unsigned char* ldsVs = L0 + 16384;
    LAS float* wsf = (LAS float*)(L0 + 16384 + NV * 16384 + wid * 512);
    LAS bf16_t* stg = (LAS bf16_t*)(L0 + 16384 + NV * 16384 + 4096 + wid * 4096);
    const int q0 = qb * 512 + wid * 64;
    const int NT = 8 * (qb + 1);
    const bf16_t* kbp = Kb + (size_t)lane * PIN + wid * 8;
    const bf16_t* vbp = Vb + (size_t)(16 * (wid & 3) + (lane >> 2)) * PIN + (wid >> 2) * 32 + (lane & 3) * 8;
    const unsigned* mwp = MASKED ? mbase + (size_t)(q0 + r32) * 2 + hi : nullptr;
    const int stoff = wid * 1024 + lane * 16;
    u32x4 kreg = *(const u32x4*)kbp, vreg[NV]; unsigned mw[2] = {0u, 0u}, mwn[2] = {0u, 0u};
#pragma unroll
    for (int j = 0; j < NV; ++j) vreg[j] = *(const u32x4*)(vbp + j * 64);
    if (MASKED) { mw[0] = mwp[0]; mw[1] = mwp[64]; }
    __builtin_amdgcn_sched_barrier(0);
    attn_body::bf16x8 qr[2][4];
#pragma unroll
    for (int nq = 0; nq < 2; ++nq) load_q_normed(qr[nq], Qb + (size_t)(q0 + nq * 32 + r32) * PIN, qgain, COSH, SINH, q0 + nq * 32 + r32, hi, lane);
    *(LAS u32x4*)(ldsKs + stoff) = kreg;
#pragma unroll
    for (int j = 0; j < NV; ++j) *(LAS u32x4*)(ldsVs + j * 16384 + stoff) = vreg[j];
    __syncthreads();
    float mhat[2] = {0.f, 0.f}, lsum[2] = {0.f, 0.f}; bool refmoved = false;
    attn_body::f32x16 o[2][2 * NV];
#pragma unroll
    for (int r = 0; r < 16; ++r)
#pragma unroll
        for (int j = 0; j < 2 * NV; ++j) { o[0][j][r] = 0.f; o[1][j][r] = 0.f; }
    const LAS unsigned char* kfb = ldsKs + hi * 1024 + r32 * 16;
    const LAS unsigned char* vfb = ldsVs + ((lane >> 4) & 1) * 32 + (lane & 3) * 8 + (4 * hi + ((lane & 15) >> 2)) * 64;
    for (int t = 0; t < NT; ++t) {
        const int slot = (t & 1) * 8192;
        {
            const int tn = min(t + 1, NT - 1);
            if (MASKED) { mwn[0] = mwp[(size_t)tn * S * 2]; mwn[1] = mwp[(size_t)tn * S * 2 + 64]; }
            kreg = *(const u32x4*)(kbp + (size_t)tn * 64 * PIN);
#pragma unroll
            for (int j = 0; j < NV; ++j) vreg[j] = *(const u32x4*)(vbp + (size_t)tn * 64 * PIN + j * 64); }
#pragma unroll
        for (int kh = 0; kh < 2; ++kh) {
            attn_body::f32x16 p[2];
#pragma unroll
            for (int r = 0; r < 16; ++r) { p[0][r] = 0.f; p[1][r] = 0.f; }
#pragma unroll
            for (int d0 = 0; d0 < 4; ++d0) {
                const attn_body::bf16x8 kf = *(const LAS attn_body::bf16x8*)(kfb + slot + d0 * 2048 + kh * 512);
                p[0] = __builtin_amdgcn_mfma_f32_32x32x16_bf16(kf, qr[0][d0], p[0], 0, 0, 0);
                p[1] = __builtin_amdgcn_mfma_f32_32x32x16_bf16(kf, qr[1][d0], p[1], 0, 0, 0); }
            if (refmoved) {
#pragma unroll
                for (int nq = 0; nq < 2; ++nq)
#pragma unroll
                    for (int r = 0; r < 16; ++r) p[nq][r] -= mhat[nq]; }
            if (CAUSAL) { const int kbase = t * 64 + kh * 32;
                if (kbase + 31 > q0) {
#pragma unroll
                    for (int nq = 0; nq < 2; ++nq)
#pragma unroll
                        for (int r = 0; r < 16; ++r) if (kbase + attn_body::crow(r, hi) > q0 + nq * 32 + r32) p[nq][r] = -INFINITY; } }
            float rm[2] = {0.f, 0.f};
            if (!NOMAX)
#pragma unroll
            for (int nq = 0; nq < 2; ++nq) { float m_ = p[nq][0];
#pragma unroll
                for (int r = 1; r < 16; ++r) m_ = fmaxf(m_, p[nq][r]);
                rm[nq] = half_max(m_); }
            bool resc = false;
            if (!NOMAX && __any(fmaxf(rm[0], rm[1]) > 8.0f)) {
#pragma unroll
                for (int nq = 0; nq < 2; ++nq) { const float dl = fmaxf(rm[nq], 0.f); mhat[nq] += dl;
#pragma unroll
                    for (int r = 0; r < 16; ++r) p[nq][r] -= dl;
                    const float f = __builtin_amdgcn_exp2f(-dl); lsum[nq] *= f; if (hi == 0) wsf[nq * 32 + r32] = f; }
                resc = true; refmoved = true;
            }
            attn_body::bf16x8 pa[2][2];
#pragma unroll
            for (int nq = 0; nq < 2; ++nq) { const int wb = (int)mw[nq]; f32x2 ss2 = {0.f, 0.f};
#pragma unroll
                for (int r = 0; r < 16; ++r) { float e = __builtin_amdgcn_exp2f(p[nq][r]);
                    if (MASKED) { unsigned mk; asm("v_bfe_i32 %0, %1, %2, 1" : "=v"(mk) : "v"(wb), "n"(kh * 16 + r)); e = __uint_as_float(__float_as_uint(e) & mk); }
                    p[nq][r] = e; }
#pragma unroll
                for (int r = 0; r < 16; r += 2) ss2 += (f32x2){p[nq][r], p[nq][r + 1]};
                lsum[nq] += ss2.x + ss2.y;
                u32x4 pw0, pw1;
#pragma unroll
                for (int k = 0; k < 4; ++k) { pw0[k] = attn_body::cvtpk_s(p[nq][2 * k], p[nq][2 * k + 1]); pw1[k] = attn_body::cvtpk_s(p[nq][8 + 2 * k], p[nq][9 + 2 * k]); }
                pa[nq][0] = __builtin_bit_cast(attn_body::bf16x8, pw0); pa[nq][1] = __builtin_bit_cast(attn_body::bf16x8, pw1); }
            if (resc) { LDS_WAIT();
#pragma unroll
                for (int nq = 0; nq < 2; ++nq)
#pragma unroll
                    for (int r = 0; r < 16; ++r) { const float f = wsf[nq * 32 + attn_body::crow(r, hi)];
#pragma unroll
                        for (int j = 0; j < 2 * NV; ++j) o[nq][j][r] *= f; } }
#pragma unroll
            for (int blk = 0; blk < 2 * NV; ++blk)
#pragma unroll
                for (int k2 = 0; k2 < 2; ++k2) {
                    const LAS unsigned char* vb = vfb + (blk >> 1) * 16384 + slot + (blk & 1) * 4096 + (kh * 2 + k2) * 1024;
                    const attn_body::s16x4 lo_ = __builtin_bit_cast(attn_body::s16x4, __builtin_amdgcn_ds_read_tr16_b64_v4i16((vtr_ptr)vb)), hi_ = __builtin_bit_cast(attn_body::s16x4, __builtin_amdgcn_ds_read_tr16_b64_v4i16((vtr_ptr)(vb + 512)));
                    const attn_body::bf16x8 vf = (attn_body::bf16x8){lo_[0], lo_[1], lo_[2], lo_[3], hi_[0], hi_[1], hi_[2], hi_[3]};
                    o[0][blk] = __builtin_amdgcn_mfma_f32_32x32x16_bf16(pa[0][k2], vf, o[0][blk], 0, 0, 0);
                    o[1][blk] = __builtin_amdgcn_mfma_f32_32x32x16_bf16(pa[1][k2], vf, o[1][blk], 0, 0, 0); }
        }
        if (t + 1 < NT) { const int ns = 8192 - slot; *(LAS u32x4*)(ldsKs + ns + stoff) = kreg;
#pragma unroll
            for (int j = 0; j < NV; ++j) *(LAS u32x4*)(ldsVs + j * 16384 + ns + stoff) = vreg[j]; }
        mw[0] = mwn[0]; mw[1] = mwn[1];
        __syncthreads();
    }
#pragma unroll
    for (int nq = 0; nq < 2; ++nq) { lsum[nq] += shx_(lsum[nq], 32, lane); if (hi == 0) wsf[nq * 32 + r32] = lsum[nq]; }
    LDS_WAIT();
#pragma unroll
    for (int nq = 0; nq < 2; ++nq)
#pragma unroll
      for (int j = 0; j < NV; ++j) {
#pragma unroll
        for (int r = 0; r < 16; ++r) { const int orow = attn_body::crow(r, hi); const float rl = __builtin_amdgcn_rcpf(wsf[nq * 32 + orow]);
            stg[orow * 64 + r32] = (bf16_t)f2bf(o[nq][2 * j][r] * rl); stg[orow * 64 + 32 + r32] = (bf16_t)f2bf(o[nq][2 * j + 1][r] * rl); }
        LDS_WAIT();
#pragma unroll
        for (int q = 0; q < 4; ++q) { const int row = q * 8 + (lane >> 3), ch = lane & 7;
            *(u32x4*)(Ob + (size_t)(q0 + nq * 32 + row) * POUT + j * 64 + ch * 8) = *(const LAS u32x4*)(stg + row * 64 + ch * 8); }
        LDS_WAIT();
      }
    __syncthreads();
}
struct MoeRows {
    static constexpr bool GATHER = true;
    const LAS int* rb; const int* LTOK;
    __device__ __forceinline__ unsigned operator()(const pg8::Unit& u, int r) const { const int e = u.be; const int slot = min(u.pm * 256 + r - rb[e], rb[32 + e] - 1);
        const int tok = LTOK[e * 32768 + slot]; return (unsigned)tok * 2048u; }
};
__device__ __forceinline__ void moe_convert(const float* w1, const float* w3, const float* w2, bf16_t* W13, bf16_t* W2, LAS float* scr, int gw, int NGW, int lane) {
    for (int it = gw; it < 32 * 768; it += NGW) {
        const int e = it / 768; int r = it % 768;
        if (r < 256) { transpose_item(w1 + (size_t)e * 1024 * 512, 1024, 512, W13 + (size_t)e * 1024 * 1024, 2, 0, scr, r, 16, lane); continue; } r -= 256;
        if (r < 256) { transpose_item(w3 + (size_t)e * 1024 * 512, 1024, 512, W13 + (size_t)e * 1024 * 1024, 2, 1, scr, r, 16, lane); continue; } r -= 256;
        transpose_item(w2 + (size_t)e * 512 * 1024, 512, 1024, W2 + (size_t)e * 1024 * 512, 1, 0, scr, r, 32, lane);
    }
}
__device__ __forceinline__ void moe_tables(unsigned* ctl, int l, LAS int* tile_e, LAS int* rb, LAS int* nt_p, int tid) {
    if (tid < 64) {
        const int ln = tid;
        const int cnt = ln < 32 ? (int)__hip_atomic_load(ctl + CW_CNT + (l * 32 + (ln & 31)) * 64, __ATOMIC_RELAXED, __HIP_MEMORY_SCOPE_AGENT) : 0;
        const int ntile = (cnt + 255) >> 8;
        int inc = ntile;
#pragma unroll
        for (int off = 1; off < 32; off <<= 1) { const int v = (int)shi_((unsigned)inc, ln - off); if (ln >= off) inc += v; }
        if (ln < 32) { rb[ln] = (inc - ntile) * 256; rb[32 + ln] = cnt; }
        if (ln == 31) nt_p[0] = inc;
    }
    __syncthreads();
    const int nt = nt_p[0];
    for (int t = tid; t < nt; t += NTHREADS) {
        int lo = 0, hi = 31;
        while (lo < hi) { const int mid = (lo + hi + 1) >> 1; if (rb[mid] <= t * 256) lo = mid; else hi = mid - 1; }
        tile_e[t] = lo;
    }
    __syncthreads();
}

template <bool FIRST>
__device__ __forceinline__ float f_pass1(const float* __restrict__ xs_row, bf16_t* __restrict__ xb_row, const bf16_t* __restrict__ y_row, const LAS float* gate, const int kc) {
    float ss = 0.f;
#pragma unroll 1
    for (int s0 = 0; s0 < 32; s0 += 8) {
        u32x4 xr[8], yr[8]; f32x4 xa[8], xc[8];
#pragma unroll
        for (int k = 0; k < 8; ++k) { const int col = 32 * (s0 + k) + 8 * kc;
            if constexpr (FIRST) { xa[k] = *(const f32x4*)(xs_row + col); xc[k] = *(const f32x4*)(xs_row + col + 4); } else xr[k] = *(const u32x4*)(xb_row + col);
            yr[k] = *(const u32x4*)(y_row + col); }
        __builtin_amdgcn_sched_barrier(0);
#pragma unroll
        for (int k = 0; k < 8; ++k) { const int col = 32 * (s0 + k) + 8 * kc;
            f32x4 x0, x1;
            if constexpr (FIRST) { x0 = xa[k]; x1 = xc[k]; }
            else { float xv_[8]; unpack8(xr[k], xv_); x0 = (f32x4){xv_[0], xv_[1], xv_[2], xv_[3]}; x1 = (f32x4){xv_[4], xv_[5], xv_[6], xv_[7]}; }
            float yv[8]; unpack8(yr[k], yv);
            const f32x4 g0 = *(const LAS f32x4*)(gate + col), g1 = *(const LAS f32x4*)(gate + col + 4);
            float nv_[8] = {x0.x + g0.x * yv[0], x0.y + g0.y * yv[1], x0.z + g0.z * yv[2], x0.w + g0.w * yv[3], x1.x + g1.x * yv[4], x1.y + g1.y * yv[5], x1.z + g1.z * yv[6], x1.w + g1.w * yv[7]};
            const u32x4 xw = pack8(nv_); *(u32x4*)(xb_row + col) = xw;
            float rv_[8]; unpack8(xw, rv_);
#pragma unroll
            for (int e = 0; e < 8; ++e) ss += rv_[e] * rv_[e]; }
        __builtin_amdgcn_sched_barrier(0);
    }
    return ss;
}
__device__ __forceinline__ void f_pass2(const bf16_t* __restrict__ xb_row, bf16_t* __restrict__ h_row, const LAS float* modl, const bf16_t* __restrict__ wh, const bf16_t* __restrict__ wl, const float rn, const int kc, f32x4 (&acc)[3]) {
#pragma unroll 1
    for (int s0 = 0; s0 < 32; s0 += 4) {
        u32x4 xr[4]; pg8::bf16x8 bh[4][3], bl[4][3];
#pragma unroll
        for (int k = 0; k < 4; ++k) { const int col = 32 * (s0 + k) + 8 * kc; xr[k] = *(const u32x4*)(xb_row + col);
#pragma unroll
            for (int ct = 0; ct < 3; ++ct) { bh[k][ct] = *(const pg8::bf16x8*)(wh + (size_t)ct * 16 * 1024 + 32 * (s0 + k)); bl[k][ct] = *(const pg8::bf16x8*)(wl + (size_t)ct * 16 * 1024 + 32 * (s0 + k)); } }
        __builtin_amdgcn_sched_barrier(0);
#pragma unroll
        for (int k = 0; k < 4; ++k) { const int col = 32 * (s0 + k) + 8 * kc;
            f32x4 x0, x1; { float xv_[8]; unpack8(xr[k], xv_); x0 = (f32x4){xv_[0], xv_[1], xv_[2], xv_[3]}; x1 = (f32x4){xv_[4], xv_[5], xv_[6], xv_[7]}; }
            const f32x4 c0 = *(const LAS f32x4*)(modl + 2048 + col), c1 = *(const LAS f32x4*)(modl + 2048 + col + 4), s0_ = *(const LAS f32x4*)(modl + 1024 + col), s1_ = *(const LAS f32x4*)(modl + 1024 + col + 4);
            float hv[8];
            hv[0] = x0.x * rn * (1.f + c0.x) + s0_.x; hv[1] = x0.y * rn * (1.f + c0.y) + s0_.y; hv[2] = x0.z * rn * (1.f + c0.z) + s0_.z; hv[3] = x0.w * rn * (1.f + c0.w) + s0_.w;
            hv[4] = x1.x * rn * (1.f + c1.x) + s1_.x; hv[5] = x1.y * rn * (1.f + c1.y) + s1_.y; hv[6] = x1.z * rn * (1.f + c1.z) + s1_.z; hv[7] = x1.w * rn * (1.f + c1.w) + s1_.w;
            const u32x4 hh = pack8(hv);
            *(u32x4*)(h_row + col) = hh;
            float hl[8]; { float hf[8]; unpack8(hh, hf);
#pragma unroll
                for (int e = 0; e < 8; ++e) hl[e] = hv[e] - hf[e]; }
            const u32x4 hlw = pack8(hl);
            const pg8::bf16x8 ah = __builtin_bit_cast(pg8::bf16x8, hh), al = __builtin_bit_cast(pg8::bf16x8, hlw);
#pragma unroll
            for (int ct = 0; ct < 3; ++ct) {
                acc[ct] = __builtin_amdgcn_mfma_f32_16x16x32_bf16(ah, bh[k][ct], acc[ct], 0, 0, 0);
                acc[ct] = __builtin_amdgcn_mfma_f32_16x16x32_bf16(ah, bl[k][ct], acc[ct], 0, 0, 0);
                acc[ct] = __builtin_amdgcn_mfma_f32_16x16x32_bf16(al, bh[k][ct], acc[ct], 0, 0, 0);
            } }
        __builtin_amdgcn_sched_barrier(0);
    }
}

__device__ __forceinline__ float relu_i(float x) { return __builtin_bit_cast(float, max(__builtin_bit_cast(int, x), 0)); }
__device__ __forceinline__ unsigned pk_gt_u16(unsigned a, unsigned b, unsigned ones) { unsigned d; asm("v_pk_sub_u16 %0, %1, %2 clamp" : "=v"(d) : "v"(a), "v"(b)); unsigned r; asm("v_pk_min_u16 %0, %1, %2" : "=v"(r) : "v"(d), "v"(ones)); return r; }
__device__ __forceinline__ unsigned spread16(unsigned x) { x = (x | (x << 8)) & 0x00FF00FFu; x = (x | (x << 4)) & 0x0F0F0F0Fu; x = (x | (x << 2)) & 0x33333333u; x = (x | (x << 1)) & 0x55555555u; return x; }
__device__ __forceinline__ unsigned ilv16(unsigned a) { return spread16(a & 0xFFFFu) | (spread16(a >> 16) << 1); }
__device__ __forceinline__ int lane_id_v() { int v; asm volatile("v_mbcnt_lo_u32_b32 %0, -1, 0\n\tv_mbcnt_hi_u32_b32 %0, -1, %0" : "=v"(v)); return v; }
__device__ __forceinline__ unsigned long long lsg64(unsigned long long v) { asm volatile("" : "+s"(v)); return v; }
__device__ __forceinline__ int lsg(int v) { asm volatile("" : "+s"(v)); return v; }
__device__ __forceinline__ int lvg(int v) { asm volatile("" : "+v"(v)); return v; }
__device__ __forceinline__ LAS unsigned char* lsgp(LAS unsigned char* p) { unsigned v = (unsigned)(unsigned long long)p; asm volatile("" : "+s"(v)); return (LAS unsigned char*)(unsigned long long)v; }
__device__ __forceinline__ void* ldptr(const LAS unsigned long long* tbl, int k) {
    const unsigned long long v = tbl[k];
    const unsigned lo = __builtin_amdgcn_readfirstlane((unsigned)v), hi = __builtin_amdgcn_readfirstlane((unsigned)(v >> 32));
    return (void*)(__attribute__((address_space(1))) void*)(((unsigned long long)hi << 32) | lo);
}
#define DECL_PTRS() \
    const int wid = lsg(wid0), lane = lane_id_v(), tid = wid * 64 + lane; \
    const int G = lsg(G0), c = lsg(c0), l = lsg(l0), i = l >> 1; \
    const int gw = c * NWAVES + wid, NGW = G * NWAVES, gt = c * NTHREADS + tid, NGT = G * NTHREADS; \
    LAS unsigned char* lds = (LAS unsigned char*)lsgp(lds0); LAS unsigned char* glds = lds; LAS float* scr = (LAS float*)(lds + wid * 16384); \
    const LAS unsigned long long* ptbl = (const LAS unsigned long long*)(lds + LDS_PTBL); \
    unsigned char* ws = (unsigned char*)ldptr(ptbl, 38); unsigned* ctl = (unsigned*)(ws + WS_CTL); \
    const float* xin = (const float*)ldptr(ptbl, 0); \
    const float* cin = (const float*)ldptr(ptbl, 1); \
    const float* ada_w = (const float*)ldptr(ptbl, 2); \
    const float* ada_b = (const float*)ldptr(ptbl, 3); \
    const float* moe_wg = (const float*)ldptr(ptbl, 4); \
    const float* moe_bg = (const float*)ldptr(ptbl, 5); \
    const float* moe_we = (const float*)ldptr(ptbl, 6); \
    const float* moe_be = (const float*)ldptr(ptbl, 7); \
    const float* moe_w1 = (const float*)ldptr(ptbl, 8); \
    const float* moe_w3 = (const float*)ldptr(ptbl, 9); \
    const float* moe_w2 = (const float*)ldptr(ptbl, 10); \
    const float* ev_w_in = (const float*)ldptr(ptbl, 11); \
    const float* ev_w_out = (const float*)ldptr(ptbl, 12); \
    const float* a_qn = (const float*)ldptr(ptbl, 13); \
    const float* a_kn = (const float*)ldptr(ptbl, 14); \
    const float* a_lq1 = (const float*)ldptr(ptbl, 15); \
    const float* a_lk1 = (const float*)ldptr(ptbl, 16); \
    const float* a_lq2 = (const float*)ldptr(ptbl, 17); \
    const float* a_lk2 = (const float*)ldptr(ptbl, 18); \
    const float* a_subln = (const float*)ldptr(ptbl, 19); \
    const float* b_qn = (const float*)ldptr(ptbl, 20); \
    const float* b_kn = (const float*)ldptr(ptbl, 21); \
    const float* b_idx_kn = (const float*)ldptr(ptbl, 22); \
    const float* od_w_in = (const float*)ldptr(ptbl, 23); \
    const float* od_w_out = (const float*)ldptr(ptbl, 24); \
    const float* c_qn = (const float*)ldptr(ptbl, 25); \
    const float* c_kn = (const float*)ldptr(ptbl, 26); \
    const float* s5_lam_re = (const float*)ldptr(ptbl, 27); \
    const float* s5_lam_im = (const float*)ldptr(ptbl, 28); \
    const float* s5_b_re = (const float*)ldptr(ptbl, 29); \
    const float* s5_b_im = (const float*)ldptr(ptbl, 30); \
    const float* s5_c_re = (const float*)ldptr(ptbl, 31); \
    const float* s5_c_im = (const float*)ldptr(ptbl, 32); \
    const float* s5_d = (const float*)ldptr(ptbl, 33); \
    const float* s5_log_dt = (const float*)ldptr(ptbl, 34); \
    const float* s5_glu_w = (const float*)ldptr(ptbl, 35); \
    const float* s5_glu_b = (const float*)ldptr(ptbl, 36); \
    float* out = (float*)ldptr(ptbl, 37); \
    float* MOD = (float*)(ws + WS_MOD); \
    float* MODP = (float*)(ws + WS_MODP); \
    float* COSH = (float*)(ws + WS_ROPE); \
    float* SINH = COSH + S * 8; \
    float* COSI = SINH + S * 8; \
    float* SINI = COSI + S * 4; \
    float* S5A = (float*)(ws + WS_S5A); \
    float* S5B = (float*)(ws + WS_S5B); \
    float* LAM = (float*)(ws + WS_LAM); \
    float* KM = (float*)(ws + WS_KM); \
    bf16_t* KMH = (bf16_t*)(ws + WS_KMH); \
    bf16_t* WRH = (bf16_t*)(ws + WS_WRH); \
    bf16_t* WRL = (bf16_t*)(ws + WS_WRH + 393216); \
    bf16_t* KML = (bf16_t*)(ws + WS_KMH + 131072); \
    bf16_t* Wevin = (bf16_t*)(ws + WS_WEVIN); \
    bf16_t* Wevout = (bf16_t*)(ws + WS_WEVOUT); \
    bf16_t* Wodin = (bf16_t*)(ws + WS_WODIN); \
    bf16_t* Wodout = (bf16_t*)(ws + WS_WODOUT); \
    bf16_t* Wglu = (bf16_t*)(ws + WS_WGLU); \
    bf16_t* W13 = (bf16_t*)(ws + WS_W13); \
    bf16_t* W2 = (bf16_t*)(ws + WS_W2); \
    bf16_t* H = (bf16_t*)(ws + WS_H); \
    bf16_t* O = (bf16_t*)(ws + WS_O); \
    bf16_t* Z = (bf16_t*)(ws + WS_Z); \
    bf16_t* XG = (bf16_t*)(ws + WS_XG); \
    bf16_t* Y = (bf16_t*)(ws + WS_Y); \
    bf16_t* HID = (bf16_t*)(ws + WS_HID); \
    float* IQ = (float*)(ws + WS_IQ); \
    bf16_t* YG = (bf16_t*)(ws + WS_YG); \
    float* IKW = (float*)(ws + WS_IKW); \
    _Float16* IQH = (_Float16*)(ws + WS_IQH); \
    _Float16* IKH = (_Float16*)(ws + WS_IKH); \
    float* IW = (float*)(ws + WS_IW); \
    int* SEL = (int*)(ws + WS_SEL); \
    bf16_t* YMIX = (bf16_t*)(ws + WS_YMIX); \
    int* TOKES = (int*)(ws + WS_TOKES); \
    int* LTOK = (int*)(ws + WS_LTOK); \
    float* TOKW = (float*)(ws + WS_TOKW); \
    int* TOKROW = (int*)(ws + WS_TOKROW); \
    bf16_t* UG = (bf16_t*)(ws + WS_UG); \
    float* S5E = (float*)(ws + WS_S5E); \
    bf16_t* S5HC = (bf16_t*)(ws + WS_S5HC); \
    bf16_t* S5KT = (bf16_t*)(ws + WS_S5KT); \
    bf16_t* S5WT = (bf16_t*)(ws + WS_S5WT); \
    bf16_t* S5A2 = (bf16_t*)(ws + WS_S5A2); \
    float* S5PW = (float*)(ws + WS_S5PW); \
    int* MLIST = (int*)(ws + WS_MLIST); \
    bf16_t* MPO = (bf16_t*)(ws + WS_MPO); \
    float* MML = (float*)(ws + WS_MML); \
    int* NSEL = (int*)(ws + WS_NSEL); \
    unsigned* MASKW = (unsigned*)(ws + WS_MASKW); \
    bf16_t* XB = (bf16_t*)(ws + WS_XB);
__global__ void __launch_bounds__(NTHREADS, 2) fwd(Args a) {
    extern __shared__ __attribute__((aligned(16))) unsigned char lds_raw[];
    LAS unsigned char* lds = (LAS unsigned char*)lds_raw;
    const int tid0 = threadIdx.x; const int wid0 = __builtin_amdgcn_readfirstlane(tid0 >> 6);
    const int G0 = gridDim.x, c0 = blockIdx.x;
    unsigned* ctl0 = (unsigned*)(a.ws + WS_CTL);
    LAS unsigned char* lds0 = lds;
    const int lo = a.ph_lo, hi = a.ph_hi;

    LAS unsigned long long* ptbl = (LAS unsigned long long*)(lds + LDS_PTBL);
    if (tid0 == 0) {
#define PT_(k) ptbl[k] = (unsigned long long)a.in[k];
        PT_(0) PT_(1) PT_(2) PT_(3) PT_(4) PT_(5) PT_(6) PT_(7) PT_(8) PT_(9) PT_(10) PT_(11) PT_(12) PT_(13) PT_(14) PT_(15) PT_(16) PT_(17) PT_(18)
        PT_(19) PT_(20) PT_(21) PT_(22) PT_(23) PT_(24) PT_(25) PT_(26) PT_(27) PT_(28) PT_(29) PT_(30) PT_(31) PT_(32) PT_(33) PT_(34) PT_(35) PT_(36)
#undef PT_
        ptbl[37] = (unsigned long long)a.out; ptbl[38] = (unsigned long long)a.ws;
    }
    if (tid0 < 4) ((LAS unsigned*)(lds + LDS_BARW))[tid0] = 0u;
    __syncthreads();
    XcdBarrier bar; bar.bar = ctl0 + CW_BAR; bar.x = 0; bar.st = (volatile LAS unsigned*)(lds + LDS_BARW);
    if (hi - lo > 1) bar = xcd_barrier_post(ctl0 + CW_BAR, (volatile LAS unsigned*)(lds + LDS_BARW), tid0 == 0);
    int ph = 0, l0 = 0;
#define PH_ON() (ph >= lo && ph < hi)
#define PH_END() do { if (ph >= lo && ph + 1 < hi) { XcdBarrier bb_; bb_.bar = (unsigned*)lsg64((unsigned long long)bar.bar); bb_.x = bar.x; bb_.st = bar.st; xcd_barrier(bb_, lsg(wid0) == 0 && lane_id_v() == 0); PROBE_EXTRA_BAR(bb_) } ++ph; } while (0)

    if (PH_ON()) { DECL_PTRS();
        {
            constexpr int I_EVIN = 16 * 112, I_SQ = 16 * 32, I_ODIN = 16 * 64, I_GLU = 8 * 16;
            constexpr int I_PER = I_EVIN + I_SQ + I_ODIN + I_SQ + I_GLU;
            for (int it = gw; it < 2 * I_PER; it += NGW) {
                const int i = it / I_PER; int r = it % I_PER;
                if (r < I_EVIN) { transpose_item(ev_w_in + (size_t)i * 1024 * EV_N, 1024, EV_N, Wevin + (size_t)i * EV_NP * 1024, -1, 0, scr, r, 112, lane); continue; } r -= I_EVIN;
                if (r < I_SQ) { transpose_item(ev_w_out + (size_t)i * 1024 * 1024, 1024, 1024, Wevout + (size_t)i * 1024 * 1024, 1, 0, scr, r, 32, lane); continue; } r -= I_SQ;
                if (r < I_ODIN) { transpose_item(od_w_in + (size_t)i * 1024 * 2048, 1024, 2048, Wodin + (size_t)i * 2048 * 1024, -2, 0, scr, r, 64, lane); continue; } r -= I_ODIN;
                if (r < I_SQ) { transpose_item(od_w_out + (size_t)i * 1024 * 1024, 1024, 1024, Wodout + (size_t)i * 1024 * 1024, 1, 0, scr, r, 32, lane); continue; } r -= I_SQ;
                transpose_item(s5_glu_w + (size_t)i * 512 * 512, 512, 512, Wglu + (size_t)i * 512 * 512, 1, 0, scr, r, 16, lane);
            }
        }
        __syncthreads();
        {
            LAS float* cact = (LAS float*)lds;
            for (int i = tid; i < 2048; i += NTHREADS) { const float v = cin[i]; cact[i] = v / (1.0f + __expf(-v)); }
            __syncthreads();
            for (int idx = gt; idx < 4 * 4 * 6144; idx += NGT) {
                const int kq = idx / 24576, rem = idx % 24576, l = rem / 6144, n = rem % 6144;
                const float* w = ada_w + ((size_t)l * 1024 + kq * 256) * 6144 + n;
                float a0 = 0.f, a1 = 0.f;
#pragma unroll 32
                for (int k = 0; k < 256; ++k) { const float wv = w[(size_t)k * 6144]; a0 += cact[kq * 256 + k] * wv; a1 += cact[1024 + kq * 256 + k] * wv; }
                MODP[((size_t)(kq * 4 + l) * 2 + 0) * 6144 + n] = a0;
                MODP[((size_t)(kq * 4 + l) * 2 + 1) * 6144 + n] = a1;
            }
            __syncthreads();
        }
        for (int idx = gt; idx < S * 12; idx += NGT) {
            if (idx < S * 8) { const int pos = idx >> 3, j = idx & 7; const float inv = (float)pow(500000.0, -(double)(2 * j) / 16.0); const float ang = (float)pos * inv;
                COSH[idx] = (float)cos((double)ang); SINH[idx] = (float)sin((double)ang); }
            else { const int k = idx - S * 8; const int pos = k >> 2, j = k & 3; const float inv = (float)pow(500000.0, -(double)(2 * j) / 8.0); const float ang = (float)pos * inv;
                COSI[k] = (float)cos((double)ang); SINI[k] = (float)sin((double)ang); }
        }
        for (int idx = gt; idx < 2 * 32 * 64; idx += NGT) {
            const int i = idx >> 11, g = (idx >> 6) & 31;
            const float dt = expf(s5_log_dt[i * 32 + g]);
            const float lr = s5_lam_re[idx], li = s5_lam_im[idx];
            const float mag = expf(lr * dt);
            const float ar = mag * (float)cos((double)(li * dt)), ai = mag * (float)sin((double)(li * dt));
            const float den = lr * lr + li * li;
            const float cr = ((ar - 1.0f) * lr + ai * li) / den, ci = (ai * lr - (ar - 1.0f) * li) / den;
            S5A[idx * 2] = ar; S5A[idx * 2 + 1] = ai;
            { float pr = 1.f, pi_ = 0.f; for (int n = 0; n <= 64; ++n) { S5PW[((size_t)idx * 65 + n) * 2] = pr; S5PW[((size_t)idx * 65 + n) * 2 + 1] = pi_; const float nr = pr * ar - pi_ * ai, ni = pr * ai + pi_ * ar; pr = nr; pi_ = ni; } }
            { float brv[16], biv[16];
#pragma unroll
              for (int cc = 0; cc < 16; ++cc) { brv[cc] = s5_b_re[(size_t)idx * 16 + cc]; biv[cc] = s5_b_im[(size_t)idx * 16 + cc]; }
              __builtin_amdgcn_sched_barrier(0);
#pragma unroll
              for (int cc = 0; cc < 16; ++cc) { const float br = brv[cc], bi = biv[cc];
                  *(f32x2*)(S5B + ((size_t)idx * 16 + cc) * 2) = (f32x2){cr * br - ci * bi, cr * bi + ci * br}; } }
        }
        for (int idx = gt; idx < DEPTH * 48 * 1024; idx += NGT) {
            const int k = idx & 1023, col = (idx >> 10) % 48, ll = idx / (48 * 1024);
            const float w = col < 4 ? moe_wg[((size_t)ll * 1024 + k) * 4 + col] : col < 36 ? moe_we[((size_t)ll * 1024 + k) * 32 + col - 4] : 0.f;
            const unsigned hb = f2bf(w); WRH[idx] = (bf16_t)hb; WRL[idx] = (bf16_t)f2bf(w - __uint_as_float(hb << 16));
        }
        if (gw < 2) { const int i = gw;
            const float s1 = wave_sum(a_lq1[i * 64 + lane] * a_lk1[i * 64 + lane]), s2 = wave_sum(a_lq2[i * 64 + lane] * a_lk2[i * 64 + lane]);
            const float lam_init = 0.8f - 0.6f * expf(-0.3f * (float)(2 * i));
            if (lane == 0) LAM[i] = expf(s1) - expf(s2) + lam_init; }
    }
    PH_END();
    if (PH_ON()) { DECL_PTRS();
        for (int idx = gt; idx < 4 * 2 * 6144; idx += NGT) {
            const int l = idx / 12288, b = (idx / 6144) & 1, n = idx % 6144;
            float v = ada_b[l * 6144 + n];
#pragma unroll
            for (int kq = 0; kq < 4; ++kq) v += MODP[((size_t)(kq * 4 + l) * 2 + b) * 6144 + n];
            MOD[idx] = v;
        }
        for (int idx = gt; idx < 2 * 32 * 65 * 256; idx += NGT) {
            const int ci = idx & 15, co = (idx >> 4) & 15, tr = (idx >> 8) % 65, ig = idx / (65 * 256);
            float acc = 0.f;
            if (tr > 0) {
                const int tau = tr - 1;
#pragma unroll 16
                for (int p = 0; p < 64; ++p) { const int sp = ig * 64 + p;
                    const float cr = s5_c_re[((size_t)ig * 16 + co) * 64 + p], cim_ = s5_c_im[((size_t)ig * 16 + co) * 64 + p];
                    const f32x2 pw_ = *(const f32x2*)(S5PW + ((size_t)sp * 65 + tau) * 2), bb_ = *(const f32x2*)(S5B + ((size_t)sp * 16 + ci) * 2);
                    const float pr = pw_.x, pi_ = pw_.y, br = bb_.x, bi = bb_.y;
                    const float xr = cr * pr - cim_ * pi_, xi = cr * pi_ + cim_ * pr;
                    acc += xr * br - xi * bi; }
            }
            S5KT[((size_t)ig * 65 + tr) * 384 + co * 24 + ci] = (bf16_t)f2bf(acc);
        }
        constexpr int NW_ = 2 * 32 * 128 * 1024;
        for (int idx0 = gt; idx0 < NW_; idx0 += NGT * 8) {
            f32x2 pw_[8], bb_[8];
#pragma unroll
            for (int u = 0; u < 8; ++u) { const int idx = min(idx0 + u * NGT, NW_ - 1);
                const int k = idx & 1023, row = (idx >> 10) & 127, ig = idx >> 17; const int s = k >> 4, ci = k & 15, p = row >> 1; const int sp = ig * 64 + p;
                pw_[u] = *(const f32x2*)(S5PW + ((size_t)sp * 65 + (63 - s)) * 2); bb_[u] = *(const f32x2*)(S5B + ((size_t)sp * 16 + ci) * 2); }
            __builtin_amdgcn_sched_barrier(0);
#pragma unroll
            for (int u = 0; u < 8; ++u) { const int idx = idx0 + u * NGT;
                if (idx < NW_) { const int ri = (idx >> 10) & 1; const float pr = pw_[u].x, pi_ = pw_[u].y, br = bb_[u].x, bi = bb_[u].y;
                    S5WT[idx] = (bf16_t)f2bf(ri ? (pr * bi + pi_ * br) : (pr * br - pi_ * bi)); } }
            __builtin_amdgcn_sched_barrier(0);
        }
        for (int idx0 = gt; idx0 < NW_; idx0 += NGT * 8) {
            f32x2 pw_[8]; float crv[8], civ[8];
#pragma unroll
            for (int u = 0; u < 8; ++u) { const int idx = min(idx0 + u * NGT, NW_ - 1);
                const int k = idx & 127, rowt = (idx >> 7) & 1023, ig = idx >> 17; const int t = rowt >> 4, co = rowt & 15, p = k >> 1; const int sp = ig * 64 + p;
                crv[u] = s5_c_re[((size_t)ig * 16 + co) * 64 + p]; civ[u] = s5_c_im[((size_t)ig * 16 + co) * 64 + p];
                pw_[u] = *(const f32x2*)(S5PW + ((size_t)sp * 65 + t + 1) * 2); }
            __builtin_amdgcn_sched_barrier(0);
#pragma unroll
            for (int u = 0; u < 8; ++u) { const int idx = idx0 + u * NGT;
                if (idx < NW_) { const int ri = idx & 1; const float cr = crv[u], cim_ = civ[u], pr = pw_[u].x, pi_ = pw_[u].y;
                    S5A2[idx] = (bf16_t)f2bf(ri ? -(cr * pi_ + cim_ * pr) : (cr * pr - cim_ * pi_)); } }
            __builtin_amdgcn_sched_barrier(0);
        }
    }
    PH_END();
    if (PH_ON()) { DECL_PTRS();
        for (int t0 = gw * 4; t0 < T; t0 += NGW * 4) {
            const int b = t0 / S; const float* mo = MOD + (size_t)(0 * 2 + b) * 6144;
            f32x4 v[4][4], sc1[4], sh1[4];
#pragma unroll
            for (int u = 0; u < 4; ++u)
#pragma unroll
                for (int j = 0; j < 4; ++j) v[u][j] = *(const f32x4*)(xin + (size_t)(t0 + u) * 1024 + 4 * lane + 256 * j);
#pragma unroll
            for (int j = 0; j < 4; ++j) { sc1[j] = *(const f32x4*)(mo + 1024 + 4 * lane + 256 * j); sh1[j] = *(const f32x4*)(mo + 4 * lane + 256 * j); }
            __builtin_amdgcn_sched_barrier(0);
#pragma unroll
            for (int u = 0; u < 4; ++u) { float ss = 0.f;
#pragma unroll
                for (int j = 0; j < 4; ++j) ss += (v[u][j].x * v[u][j].x + v[u][j].y * v[u][j].y) + (v[u][j].z * v[u][j].z + v[u][j].w * v[u][j].w);
                const float rn = rsqrtf(wave_sum(ss) * (1.0f / 1024.0f) + EPS);
#pragma unroll
                for (int j = 0; j < 4; ++j) { const int col = 4 * lane + 256 * j;
                    u32x2 w; w.x = pk2(v[u][j].x * rn * (1.f + sc1[j].x) + sh1[j].x, v[u][j].y * rn * (1.f + sc1[j].y) + sh1[j].y); w.y = pk2(v[u][j].z * rn * (1.f + sc1[j].z) + sh1[j].z, v[u][j].w * rn * (1.f + sc1[j].w) + sh1[j].w);
                    *(u32x2*)(H + (size_t)(t0 + u) * 1024 + col) = w; } }
            __builtin_amdgcn_sched_barrier(0);
        }
    }
    PH_END();

    for (l0 = 0; l0 < DEPTH; ++l0) {
        if ((l0 & 1) == 0) {
            if (PH_ON()) { DECL_PTRS();
                pg8::Gemm g{H, Wevin + (size_t)i * EV_NP * 1024, T, EV_NP, 1024, 0}; pg8::StaticOrder So; So.init(T, EV_NP, G, c);
                EpiEvenIn E{Z, IQH, IKH, IW, a_kn + i * 64, b_kn + i * 64, b_idx_kn + i * 32, COSH, SINH, COSI, SINI};
                { PROBE_WRAP(pg8::StaticOrder, So); pg8::gemm_phase<EpiEvenIn, PROBE_SCHED(pg8::StaticOrder), true, true>(glds, g, PS_, E, tid); }
            }
            PH_END();
            if (PH_ON()) { DECL_PTRS();
                moe_convert(moe_w1 + (size_t)l * 32 * 1024 * 512, moe_w3 + (size_t)l * 32 * 1024 * 512, moe_w2 + (size_t)l * 32 * 512 * 1024, W13, W2, scr, gw, NGW, lane);
                __syncthreads();
                {
                    LAS unsigned short* kq = (LAS unsigned short*)lds;
                    const int qi = tid >> 7, ht = tid & 127;
                    LAS unsigned short* kqq = kq + qi * 16384;
                    LAS unsigned* hist = (LAS unsigned*)(lds + LDS_MISC + qi * 6400);
                    LAS unsigned* bits = hist + 1024;
                    LAS unsigned* misc = hist + 1536;
                    typedef _Float16 f16x8_t __attribute__((ext_vector_type(8)));
                    f16x8_t qaN[2], kbN[4][2]; f32x4 wqN[4];
                    auto issue_unit = [&](int it_) {
                        const int lane_ = lane_id_v(), r32 = lane_ & 31, hi = lane_ >> 5, wid_ = lsg(wid0);
                        const int L_ = min(it_ * G + c, 8191);
                        const int uu_ = (L_ & 1) ? (8191 - (L_ >> 1)) : (L_ >> 1); const int b_ = uu_ >> 12, pp_ = uu_ & 4095;
                        const size_t tA_ = (size_t)b_ * S + 4 * pp_; const int ntile_ = (4 * pp_ + 4 + 31) >> 5;
#pragma unroll
                        for (int s = 0; s < 2; ++s) qaN[s] = *(const f16x8_t*)(IQH + (tA_ + 2 * ((r32 >> 2) & 1) + (r32 >> 4)) * 256 + (4 * ((r32 >> 3) & 1) + (r32 & 3)) * 32 + 16 * s + 8 * hi);
#pragma unroll
                        for (int q = 0; q < 4; ++q) wqN[q] = *(const f32x4*)(IW + (tA_ + 2 * hi + (q >> 1)) * 8 + 4 * (q & 1));
                        const _Float16* kbase_ = IKH + ((size_t)b_ * S + r32) * 32 + 8 * hi;
#pragma unroll
                        for (int u = 0; u < 4; ++u) { const int tile = min(wid_ + NWAVES * u, ntile_ - 1);
                            kbN[u][0] = *(const f16x8_t*)(kbase_ + (size_t)tile * 1024); kbN[u][1] = *(const f16x8_t*)(kbase_ + (size_t)tile * 1024 + 16); } };
                    issue_unit(0);
                    for (int it = 0;; ++it) {
                        const int L = it * G + c; if (L >= 8192) break;
                        const int uu = (L & 1) ? (8191 - (L >> 1)) : (L >> 1);
                        const int b = uu >> 12, pp = uu & 4095;
                        const size_t tA = (size_t)b * S + 4 * pp;
                        const int nD = 4 * pp + 4;
#pragma unroll
                        for (int q = 0; q < 8; ++q) hist[ht + 128 * q] = 0u;
                        __syncthreads();
#ifdef PROBE_MASK
                        if (a.probe_var != 2)
#endif
                        {
                            const int r32 = lane & 31, hi = lane >> 5;
                            f16x8_t qa[2]; qa[0] = qaN[0]; qa[1] = qaN[1];
                            f32x4 wq[4];
#pragma unroll
                            for (int q = 0; q < 4; ++q) wq[q] = wqN[q];
                            const int ntile = (nD + 31) >> 5;
                            const _Float16* kbase = IKH + ((size_t)b * S + r32) * 32 + 8 * hi;
                            f16x8_t kb[4][2], kn[4][2];
#pragma unroll
                            for (int u = 0; u < 4; ++u) { kb[u][0] = kbN[u][0]; kb[u][1] = kbN[u][1]; }
                            for (int tile0 = wid; tile0 < ntile; tile0 += NWAVES * 4) {
#pragma unroll
                                for (int u = 0; u < 4; ++u) { const int tile = min(tile0 + NWAVES * (4 + u), ntile - 1);
                                    kn[u][0] = *(const f16x8_t*)(kbase + (size_t)tile * 1024); kn[u][1] = *(const f16x8_t*)(kbase + (size_t)tile * 1024 + 16); }
#pragma unroll
                                for (int u = 0; u < 4; ++u) {
                                    const int tile = tile0 + NWAVES * u;
                                    attn_body::f32x16 acc;
#pragma unroll
                                    for (int r = 0; r < 16; ++r) acc[r] = 0.f;
                                    acc = __builtin_amdgcn_mfma_f32_32x32x16_f16(qa[0], kb[u][0], acc, 0, 0, 0);
                                    acc = __builtin_amdgcn_mfma_f32_32x32x16_f16(qa[1], kb[u][1], acc, 0, 0, 0);
                                    float sq[4];
#pragma unroll
                                    for (int q = 0; q < 4; ++q) sq[q] = wq[q].x * relu_i(acc[4 * q]) + wq[q].y * relu_i(acc[4 * q + 1]) + wq[q].z * relu_i(acc[4 * q + 2]) + wq[q].w * relu_i(acc[4 * q + 3]);
                                    if (tile < ntile) {
                                        const float sa = sq[0] + sq[1], sb = sq[2] + sq[3];
                                        const unsigned h0 = (unsigned)__builtin_bit_cast(unsigned short, (_Float16)sa), h1 = (unsigned)__builtin_bit_cast(unsigned short, (_Float16)sb);
                                        const unsigned k0_ = (h0 ^ ((unsigned)__builtin_amdgcn_sbfe((int)h0, 15, 1) | 0x8000u)) & 0xFFFFu, k1_ = (h1 ^ ((unsigned)__builtin_amdgcn_sbfe((int)h1, 15, 1) | 0x8000u)) & 0xFFFFu;
                                        const int kidx = tile * 32 + r32;
                                        kq[(2 * hi) * 16384 + kidx] = (unsigned short)k0_;
                                        kq[(2 * hi + 1) * 16384 + kidx] = (unsigned short)k1_;
                                        LAS unsigned* hq0 = (LAS unsigned*)(lds + LDS_MISC + (2 * hi) * 6400); LAS unsigned* hq1 = (LAS unsigned*)(lds + LDS_MISC + (2 * hi + 1) * 6400);
                                        __hip_atomic_fetch_add(&hq0[(kidx <= 4 * pp + 2 * hi) ? ((k0_ >> 8) << 2) + (lane & 3) : 1536 + 32 + (lane & 3)], 1u, __ATOMIC_RELAXED, __HIP_MEMORY_SCOPE_WORKGROUP);
                                        __hip_atomic_fetch_add(&hq1[(kidx <= 4 * pp + 2 * hi + 1) ? ((k1_ >> 8) << 2) + (lane & 3) : 1536 + 32 + (lane & 3)], 1u, __ATOMIC_RELAXED, __HIP_MEMORY_SCOPE_WORKGROUP);
                                    }
                                }
#pragma unroll
                                for (int u = 0; u < 4; ++u) { kb[u][0] = kn[u][0]; kb[u][1] = kn[u][1]; }
                            }
                            issue_unit(it + 1);
                        }
                        __syncthreads();
#ifdef PROBE_MASK
                        if (a.probe_var == 1) continue;
#endif
                        const int n = 4 * pp + 1 + qi;
                        const bool small = n <= 256;
                        if (ht == 0) { misc[0] = 0u; misc[1] = 256u; misc[2] = 0u; }
                        const LAS unsigned* kq32 = (const LAS unsigned*)kqq;
                        const int npair = (n + 1) >> 1;
                        for (int pass = 0; pass < 2; ++pass) {
                            if (pass) {
#pragma unroll
                                for (int q = 0; q < 8; ++q) hist[ht + 128 * q] = 0u; }
                            __syncthreads();
                            const int shift = 8 - 8 * pass;
                            if (!small && pass) {
                                const unsigned prefix = misc[0];
                                for (int W = ht; 32 * W < n; W += 128) {
                                    const unsigned vmask = (n - 32 * W >= 32) ? 0xFFFFFFFFu : ((1u << (n - 32 * W)) - 1u);
                                    const LAS u32x4* kp = (const LAS u32x4*)(kq32 + 16 * W);
                                    unsigned ne = 0u;
                                    const unsigned pp2 = prefix | (prefix << 16);
#pragma unroll
                                    for (int q4 = 0; q4 < 4; ++q4) { const u32x4 w4 = kp[q4];
#pragma unroll
                                        for (int e = 0; e < 4; ++e) ne |= pk_gt_u16((w4[e] ^ pp2) & 0xFF00FF00u, 0u, 0x00010001u) << (4 * q4 + e); }
                                    unsigned mm = ilv16(~ne) & vmask;
                                    const LAS unsigned short* k16 = kqq + 32 * W;
                                    while (mm) { const int j = __ffs(mm) - 1; mm &= mm - 1u;
                                        __hip_atomic_fetch_add(&hist[(((unsigned)k16[j] & 255u) << 2) + (lane & 3)], 1u, __ATOMIC_RELAXED, __HIP_MEMORY_SCOPE_WORKGROUP); }
                                }
                            }
                            __syncthreads();
                            if (!small && ht < 64) {
                                unsigned cb[4];
#pragma unroll
                                for (int q = 0; q < 4; ++q) { const u32x4 a0 = *(const LAS u32x4*)(hist + (4 * ht + q) * 4); cb[q] = (a0.x + a0.y) + (a0.z + a0.w); }
                                const unsigned c0 = cb[0], c1 = cb[1], c2 = cb[2], c3 = cb[3];
                                const unsigned tot = c0 + c1 + c2 + c3;
                                unsigned Ssum = tot;
#pragma unroll
                                for (int off = 1; off < 64; off <<= 1) { const unsigned v = shi_(Ssum, lane + off); if (ht + off < 64) Ssum += v; }
                                const unsigned above = Ssum - tot, krem = misc[1];
                                if (above < krem && krem <= Ssum) {
                                    unsigned run = above, bin, eq;
                                    if (run + c3 >= krem) { bin = 3; eq = c3; }
                                    else { run += c3; if (run + c2 >= krem) { bin = 2; eq = c2; }
                                        else { run += c2; if (run + c1 >= krem) { bin = 1; eq = c1; } else { run += c1; bin = 0; eq = c0; } } }
                                    misc[0] = misc[0] | ((4u * ht + bin) << shift); misc[1] = krem - run; misc[2] = eq;
                                }
                            }
                            __syncthreads();
                        }
#ifdef PROBE_MASK
                        if (a.probe_var == 8) { __syncthreads(); continue; }
#endif
                        const unsigned Tkey = misc[0], krem = misc[1], cnteq = misc[2];
                        LAS unsigned* eqb = hist;
                        const bool all_eq = (cnteq == krem);
                        for (int W = ht; W < 512; W += 128) {
                            unsigned sel = 0u, eqm = 0u;
                            if (32 * W < n) {
                                const unsigned vmask = (n - 32 * W >= 32) ? 0xFFFFFFFFu : ((1u << (n - 32 * W)) - 1u);
                                if (small) sel = vmask;
                                else {
                                    const LAS u32x4* kp = (const LAS u32x4*)(kq32 + 16 * W);
                                    const unsigned tp2 = Tkey | (Tkey << 16);
                                    unsigned ag = 0u, al = 0u;
#pragma unroll
                                    for (int q4 = 0; q4 < 4; ++q4) { const u32x4 w4 = kp[q4];
#pragma unroll
                                        for (int e = 0; e < 4; ++e) { ag |= pk_gt_u16(w4[e], tp2, 0x00010001u) << (4 * q4 + e); al |= pk_gt_u16(tp2, w4[e], 0x00010001u) << (4 * q4 + e); } }
                                    sel = ilv16(ag); eqm = ilv16(~(ag | al));
                                    if (all_eq) { sel |= eqm; eqm = 0u; }
                                    sel &= vmask; eqm &= vmask;
                                }
                            }
                            bits[W] = sel; eqb[W] = eqm;
                        }
                        __syncthreads();
                        if (!small && !all_eq && ht < 64) {
                            unsigned wv_[8]; unsigned cnt = 0u;
#pragma unroll
                            for (int q = 0; q < 8; ++q) { wv_[q] = eqb[8 * ht + q]; cnt += (unsigned)__popc(wv_[q]); }
                            unsigned inc = cnt;
#pragma unroll
                            for (int off = 1; off < 64; off <<= 1) { const unsigned v = shi_(inc, lane - off); if (lane >= off) inc += v; }
                            unsigned before = inc - cnt;
#pragma unroll
                            for (int q = 0; q < 8; ++q) { unsigned w = wv_[q], keep = 0u;
                                while (w && before < krem) { const unsigned lowb = w & (0u - w); keep |= lowb; w ^= lowb; ++before; }
                                before += (unsigned)__popc(w);
                                if (keep) __hip_atomic_fetch_or(&bits[8 * ht + q], keep, __ATOMIC_RELAXED, __HIP_MEMORY_SCOPE_WORKGROUP); }
                        }
                        __syncthreads();
                        {
                            const int qpos = 4 * pp + qi; const int tmax = 8 * (qpos >> 9) + 7;
#pragma unroll
                            for (int j = 0; j < 2; ++j) { const int tt = 2 * ht + j;
                                if (tt <= tmax) { const unsigned W0 = bits[2 * tt], W1 = bits[2 * tt + 1];
                                    unsigned e0 = W0 & 0x0F0F0F0Fu, e1 = W1 & 0x0F0F0F0Fu, o0 = (W0 >> 4) & 0x0F0F0F0Fu, o1 = (W1 >> 4) & 0x0F0F0F0Fu;
                                    e0 = (e0 | (e0 >> 4)) & 0x00FF00FFu; e0 = (e0 | (e0 >> 8)) & 0xFFFFu; e1 = (e1 | (e1 >> 4)) & 0x00FF00FFu; e1 = (e1 | (e1 >> 8)) & 0xFFFFu;
                                    o0 = (o0 | (o0 >> 4)) & 0x00FF00FFu; o0 = (o0 | (o0 >> 8)) & 0xFFFFu; o1 = (o1 | (o1 >> 4)) & 0x00FF00FFu; o1 = (o1 | (o1 >> 8)) & 0xFFFFu;
                                    u32x2 pm; pm.x = e0 | (e1 << 16); pm.y = o0 | (o1 << 16);
                                    *(u32x2*)(MASKW + (((size_t)(b * 256 + tt)) * S + qpos) * 2) = pm; } }
                        }
                        __syncthreads();
                    }
                }
                __syncthreads();
                {
                    bf16_t* OA = YMIX;
                    const int vcu = (G % 8 == 0) ? (c % 8) * (G / 8) + c / 8 : c;
                    const int nu = (G == 256) ? 4 : (1024 - vcu + G - 1) / G;
                    const bool nomax_a = qk_bounded(a_qn + i * 64, a_kn + i * 64, lane);
                    for (int iu = 0; iu < nu; ++iu) {
                        const int lane = lane_id_v(), wid = lsg(wid0);
                        LAS unsigned char* L0 = lsgp(lds0);
                        int combo, qb;
                        if (G == 256) { combo = vcu >> 4; const int s_ = vcu & 15; qb = iu == 0 ? s_ : iu == 1 ? 31 - s_ : iu == 2 ? 32 + s_ : 63 - s_; }
                        else { const int u = vcu + iu * G; combo = u & 15; qb = 63 - (u >> 4); }
                        const int b = combo >> 3, hc = combo & 7;
                        const bf16_t* zb = Z + (size_t)b * S * EV_ZP;
                        if (nomax_a)
                            flash_unit<2, false, true, EV_ZP, 1024, true>(L0, zb + hc * 64, zb + 512 + hc * 64, zb + 1024 + (hc >> 1) * 128, OA + (size_t)b * S * 1024 + hc * 128, nullptr, qb, wid, lane, a_qn + i * 64, COSH, SINH);
                        else
                            flash_unit<2, false, true, EV_ZP, 1024, false>(L0, zb + hc * 64, zb + 512 + hc * 64, zb + 1024 + (hc >> 1) * 128, OA + (size_t)b * S * 1024 + hc * 128, nullptr, qb, wid, lane, a_qn + i * 64, COSH, SINH);
                    }
                }
            }
            PH_END();
            if (PH_ON()) { DECL_PTRS();
                {
                    const bf16_t* OA = YMIX; const float lamv = LAM[i]; const float lam_init = 0.8f - 0.6f * expf(-0.3f * (float)l);
                    const int h = lane >> 4, vj = (lane >> 3) & 1, d8 = (lane & 7) * 8;
                    float gn[8];
#pragma unroll
                    for (int e = 0; e < 8; ++e) gn[e] = a_subln[i * 128 + vj * 64 + d8 + e] * (1.0f - lam_init);
                    for (int t0 = gw * 4; t0 < T; t0 += NGW * 4) {
                        u32x4 r1[4], r2[4];
#pragma unroll
                        for (int u = 0; u < 4; ++u) { r1[u] = *(const u32x4*)(OA + (size_t)(t0 + u) * 1024 + ((h * 2 + 0) * 2 + vj) * 64 + d8); r2[u] = *(const u32x4*)(OA + (size_t)(t0 + u) * 1024 + ((h * 2 + 1) * 2 + vj) * 64 + d8); }
                        __builtin_amdgcn_sched_barrier(0);
#pragma unroll
                        for (int u = 0; u < 4; ++u) {
                            float o1[8], o2[8], dd[8]; unpack8(r1[u], o1); unpack8(r2[u], o2);
                            float ss = 0.f;
#pragma unroll
                            for (int e = 0; e < 8; ++e) { dd[e] = o1[e] - lamv * o2[e]; ss += dd[e] * dd[e]; }
                            ss += dpp_xor1(ss); ss += dpp_xor2(ss); ss += SHX(ss, 4); ss += SHX(ss, 8);
                            const float r = rsqrtf(ss * (1.0f / 128.0f) + EPS);
#pragma unroll
                            for (int e = 0; e < 8; ++e) dd[e] = dd[e] * r * gn[e];
                            *(u32x4*)(O + (size_t)(t0 + u) * 1024 + h * 128 + vj * 64 + d8) = pack8(dd);
                        }
                        __builtin_amdgcn_sched_barrier(0);
                    }
                }
                {
                    const int vcu = (G % 8 == 0) ? (c % 8) * (G / 8) + c / 8 : c;
                    const int nu = (G == 256) ? 2 : (512 - vcu + G - 1) / G;
                    const bool nomax_b = qk_bounded(b_qn + i * 64, b_kn + i * 64, lane);
                    for (int iu = 0; iu < nu; ++iu) {
                        const int lane = lane_id_v(), wid = lsg(wid0);
                        LAS unsigned char* L0 = lsgp(lds0);
                        int combo, qb;
                        if (G == 256) { combo = vcu >> 4; const int s_ = vcu & 15; qb = iu == 0 ? s_ : 31 - s_; }
                        else { const int u = vcu + iu * G; combo = u & 15; qb = 31 - (u >> 4); }
                        const int b = combo >> 3, h = combo & 7;
                        const bf16_t* zb = Z + (size_t)b * S * EV_ZP;
                        if (nomax_b)
                            flash_unit_q2<1, true, false, EV_ZP, 1024, true>(L0, zb + 1536 + h * 64, zb + 2048 + h * 64, zb + 2560 + h * 64, O + (size_t)b * S * 1024 + 512 + h * 64, MASKW + (size_t)b * 256 * S * 2, qb, wid, lane, b_qn + i * 64, COSH, SINH);
                        else
                            flash_unit_q2<1, true, false, EV_ZP, 1024, false>(L0, zb + 1536 + h * 64, zb + 2048 + h * 64, zb + 2560 + h * 64, O + (size_t)b * S * 1024 + 512 + h * 64, MASKW + (size_t)b * 256 * S * 2, qb, wid, lane, b_qn + i * 64, COSH, SINH);
                    }
                }
            }
            PH_END();
        } else {
            if (PH_ON()) { DECL_PTRS();
                pg8::Gemm g{H, Wodin + (size_t)i * OD_N * 1024, T, OD_N, 1024, 0}; pg8::StaticOrder So; So.init(T, OD_N, G, c);
                EpiOddIn E{Z, UG, c_kn + i * 64, COSH, SINH};
                { PROBE_WRAP(pg8::StaticOrder, So); pg8::gemm_phase<EpiOddIn, PROBE_SCHED(pg8::StaticOrder), true, true>(glds, g, PS_, E, tid); }
            }
            PH_END();
            if (PH_ON()) { DECL_PTRS();
                moe_convert(moe_w1 + (size_t)l * 32 * 1024 * 512, moe_w3 + (size_t)l * 32 * 1024 * 512, moe_w2 + (size_t)l * 32 * 512 * 1024, W13, W2, scr, gw, NGW, lane);
                __syncthreads();
                for (int u = gw; u < NB * 64 * 8; u += NGW) {
                    const int h = u & 7, blk = (u >> 3) & 63, b = u >> 9;
                    const int rs = lane >> 3, d8 = (lane & 7) * 8;
                    const bf16_t* kp = Z + ((size_t)b * S + blk * 256 + rs) * OD_N + 512 + h * 64 + d8;
                    u32x4 kr[32];
#pragma unroll
                    for (int j = 0; j < 32; ++j) kr[j] = *(const u32x4*)(kp + (size_t)(8 * j) * OD_N);
                    __builtin_amdgcn_sched_barrier(0);
                    float sm[8];
#pragma unroll
                    for (int e = 0; e < 8; ++e) sm[e] = 0.f;
#pragma unroll
                    for (int j = 0; j < 32; ++j) { float kv[8]; unpack8(kr[j], kv);
#pragma unroll
                        for (int e = 0; e < 8; ++e) sm[e] += kv[e]; }
#pragma unroll
                    for (int e = 0; e < 8; ++e) { sm[e] += SHX(sm[e], 8); sm[e] += SHX(sm[e], 16); sm[e] += SHX(sm[e], 32); sm[e] *= (1.0f / 256.0f); }
                    if (rs == 0) {
                        *(f32x4*)(KM + (size_t)u * 64 + d8) = (f32x4){sm[0], sm[1], sm[2], sm[3]}; *(f32x4*)(KM + (size_t)u * 64 + d8 + 4) = (f32x4){sm[4], sm[5], sm[6], sm[7]};
                        const u32x4 hw = pack8(sm); float hf[8], lo[8]; unpack8(hw, hf);
#pragma unroll
                        for (int e = 0; e < 8; ++e) lo[e] = sm[e] - hf[e];
                        *(u32x4*)(KMH + ((size_t)(b * 8 + h) * 64 + blk) * 64 + d8) = hw; *(u32x4*)(KML + ((size_t)(b * 8 + h) * 64 + blk) * 64 + d8) = pack8(lo);
                    }
                }
                {
                    const int r32 = lane & 31, hi = lane >> 5;
                    LAS unsigned char* ldsU = lds;
                    LAS float* red = (LAS float*)(lds + 69632);
                    for (int task = c; task < 512; task += G) {
                        const int g = task >> 4, cs = task & 15;
                        for (int q = tid; q < 32 * 128; q += NTHREADS) { const int j = q >> 7, off = (q & 127) * 16;
                            *(LAS u32x4*)(ldsU + j * 2064 + off) = *(const u32x4*)((const unsigned char*)UG + ((size_t)g * T + (size_t)(cs * 32 + j) * 64) * 32 + off); }
                        __syncthreads();
                        const int rb = wid & 3, kh = wid >> 2;
                        attn_body::f32x16 acc;
#pragma unroll
                        for (int r = 0; r < 16; ++r) acc[r] = 0.f;
                        const bf16_t* wrow = S5WT + ((size_t)(i * 32 + g) * 128 + rb * 32 + r32) * 1024 + hi * 8;
#pragma unroll 1
                        for (int ks0 = kh * 32; ks0 < kh * 32 + 32; ks0 += 16) {
                            attn_body::bf16x8 Af[16];
#pragma unroll
                            for (int k = 0; k < 16; ++k) Af[k] = *(const attn_body::bf16x8*)(wrow + (ks0 + k) * 16);
                            __builtin_amdgcn_sched_barrier(0);
#pragma unroll
                            for (int k = 0; k < 16; ++k) {
                                const attn_body::bf16x8 B = *(const LAS attn_body::bf16x8*)(ldsU + r32 * 2064 + (ks0 + k) * 32 + hi * 16);
                                acc = __builtin_amdgcn_mfma_f32_32x32x16_bf16(Af[k], B, acc, 0, 0, 0); }
                            __builtin_amdgcn_sched_barrier(0);
                        }
                        if (kh == 1) {
#pragma unroll
                            for (int r = 0; r < 16; ++r) red[(rb * 64 + lane) * 16 + r] = acc[r];
                        }
                        __syncthreads();
                        if (kh == 0) {
                            float* ep = S5E + ((size_t)(cs * 32 + r32) * 32 + g) * 128 + rb * 32 + 4 * hi;
#pragma unroll
                            for (int q4 = 0; q4 < 4; ++q4) { f32x4 o;
                                o.x = acc[4 * q4] + red[(rb * 64 + lane) * 16 + 4 * q4]; o.y = acc[4 * q4 + 1] + red[(rb * 64 + lane) * 16 + 4 * q4 + 1];
                                o.z = acc[4 * q4 + 2] + red[(rb * 64 + lane) * 16 + 4 * q4 + 2]; o.w = acc[4 * q4 + 3] + red[(rb * 64 + lane) * 16 + 4 * q4 + 3];
                                *(f32x4*)(ep + 8 * q4) = o; }
                        }
                        __syncthreads();
                    }
                }
            }
            PH_END();
            if (PH_ON()) { DECL_PTRS();
#ifndef SKIP_S5
                {
                    for (int idx = gt; idx < NB * 32 * 64; idx += NGT) {
                        const int b = idx >> 11, g = (idx >> 6) & 31, p = idx & 63;
                        const int sp = (i * 32 + g) * 64 + p;
                        const float aLr = S5PW[((size_t)sp * 65 + 64) * 2], aLi = S5PW[((size_t)sp * 65 + 64) * 2 + 1];
                        float hr = 0.f, hi_ = 0.f;
                        for (int c0 = 0; c0 < 256; c0 += 32) {
                            float er[32], ei[32];
#pragma unroll
                            for (int k = 0; k < 32; ++k) { const float* ep = S5E + ((size_t)(b * 256 + c0 + k) * 32 + g) * 128 + 2 * p; er[k] = ep[0]; ei[k] = ep[1]; }
                            __builtin_amdgcn_sched_barrier(0);
#pragma unroll
                            for (int k = 0; k < 32; ++k) asm volatile("" : "+v"(er[k]), "+v"(ei[k]));
#pragma unroll
                            for (int k = 0; k < 32; ++k) {
                                *(unsigned*)(S5HC + ((size_t)(b * 256 + c0 + k) * 32 + g) * 128 + 2 * p) = pk2(hr, hi_);
                                const float nr = aLr * hr - aLi * hi_ + er[k], ni = aLr * hi_ + aLi * hr + ei[k]; hr = nr; hi_ = ni; }
                        }
                    }
                }
#endif
                {
                    unsigned* mcnt = ctl + CW_MCNT + i * 1024;
                    const int r32 = lane & 31, hi = lane >> 5;
                    for (int u = c; u < NB * 8 * 64; u += G) {
                        const int tb = u & 63, h = (u >> 6) & 7, b = u >> 9;
                        const int pos = tb * 256 + wid * 32 + r32; const size_t t = (size_t)b * S + pos;
                        float tv[3] = {-INFINITY, -INFINITY, -INFINITY}; int ti[3] = {1 << 20, 1 << 20, 1 << 20};
                        if (tb > 0) {
                            const bf16_t* kh = KMH + ((size_t)(b * 8 + h) * 64 + r32) * 64 + hi * 8; const bf16_t* kl = KML + ((size_t)(b * 8 + h) * 64 + r32) * 64 + hi * 8;
                            attn_body::bf16x8 mh[2][4], ml_[2][4];
#pragma unroll
                            for (int half = 0; half < 2; ++half)
#pragma unroll
                                for (int d0 = 0; d0 < 4; ++d0) { mh[half][d0] = *(const attn_body::bf16x8*)(kh + half * 32 * 64 + d0 * 16); ml_[half][d0] = *(const attn_body::bf16x8*)(kl + half * 32 * 64 + d0 * 16); }
                            __builtin_amdgcn_sched_barrier(0);
                            attn_body::bf16x8 qr[4];
                            load_q_normed(qr, Z + t * OD_N + h * 64, c_qn + i * 64, COSH, SINH, pos, hi, lane);
                            attn_body::f32x16 g0, g1;
#pragma unroll
                            for (int r = 0; r < 16; ++r) { g0[r] = 0.f; g1[r] = 0.f; }
#pragma unroll
                            for (int d0 = 0; d0 < 4; ++d0) {
                                g0 = __builtin_amdgcn_mfma_f32_32x32x16_bf16(mh[0][d0], qr[d0], g0, 0, 0, 0);
                                g0 = __builtin_amdgcn_mfma_f32_32x32x16_bf16(ml_[0][d0], qr[d0], g0, 0, 0, 0);
                                g1 = __builtin_amdgcn_mfma_f32_32x32x16_bf16(mh[1][d0], qr[d0], g1, 0, 0, 0);
                                g1 = __builtin_amdgcn_mfma_f32_32x32x16_bf16(ml_[1][d0], qr[d0], g1, 0, 0, 0); }
#pragma unroll
                            for (int half = 0; half < 2; ++half)
#pragma unroll
                                for (int r = 0; r < 16; ++r) { const int n = half * 32 + attn_body::crow(r, hi); const float gv = (n < tb) ? (half ? g1[r] : g0[r]) : -INFINITY;
                                    if (gv > tv[0]) { tv[2] = tv[1]; ti[2] = ti[1]; tv[1] = tv[0]; ti[1] = ti[0]; tv[0] = gv; ti[0] = n; }
                                    else if (gv > tv[1]) { tv[2] = tv[1]; ti[2] = ti[1]; tv[1] = gv; ti[1] = n; }
                                    else if (gv > tv[2]) { tv[2] = gv; ti[2] = n; } }
                            float pv_[3]; int pi_[3];
#pragma unroll
                            for (int k = 0; k < 3; ++k) { pv_[k] = SHX(tv[k], 32); pi_[k] = (int)shi_((unsigned)ti[k], lane ^ 32); }
                            float mv[3]; int mi[3]; int ia = 0, ib = 0;
#pragma unroll
                            for (int k = 0; k < 3; ++k) {
                                const float av = ia == 0 ? tv[0] : ia == 1 ? tv[1] : ia == 2 ? tv[2] : -INFINITY; const int ai = ia == 0 ? ti[0] : ia == 1 ? ti[1] : ia == 2 ? ti[2] : (1 << 20);
                                const float bv = ib == 0 ? pv_[0] : ib == 1 ? pv_[1] : ib == 2 ? pv_[2] : -INFINITY; const int bi = ib == 0 ? pi_[0] : ib == 1 ? pi_[1] : ib == 2 ? pi_[2] : (1 << 20);
                                const bool ta = (av > bv) || (av == bv && ai < bi);
                                mv[k] = ta ? av : bv; mi[k] = ta ? ai : bi; if (ta) ++ia; else ++ib; }
#pragma unroll
                            for (int k = 0; k < 3; ++k) { tv[k] = mv[k]; ti[k] = mi[k]; }
                        }
#ifdef PROBE_MASK
                        if (a.probe_var == 3) { if (ti[0] + ti[1] + ti[2] == -12345) NSEL[0] = 1; continue; }
#endif
                        if (hi == 0) {
                            unsigned idx[3];
#pragma unroll
                            for (int sI = 0; sI < 3; ++sI) { idx[sI] = 0u;
                                if (tv[sI] > -INFINITY) idx[sI] = __hip_atomic_fetch_add(mcnt + (b * 8 + h) * 64 + ti[sI], 1u, __ATOMIC_RELAXED, __HIP_MEMORY_SCOPE_AGENT); }
                            int nsel = 0;
#pragma unroll
                            for (int sI = 0; sI < 3; ++sI)
                                if (tv[sI] > -INFINITY) { const int li = (b * 8 + h) * 64 + ti[sI]; MLIST[(size_t)li * 16384 + idx[sI]] = (pos << 2) | nsel; ++nsel; }
                            NSEL[t * 8 + h] = nsel;
                        }
                    }
                }
            }
            PH_END();
            if (PH_ON()) { DECL_PTRS();
                {
                    const unsigned* mcnt = ctl + CW_MCNT + i * 1024;
                    LAS int* pref = (LAS int*)(lds + LDS_MISC);
                    if (wid == 0) {
                        int loc[16]; int sum = 0;
#pragma unroll
                        for (int k = 0; k < 16; ++k) loc[k] = (int)__hip_atomic_load(mcnt + lane * 16 + k, __ATOMIC_RELAXED, __HIP_MEMORY_SCOPE_AGENT);
                        __builtin_amdgcn_sched_barrier(0);
#pragma unroll
                        for (int k = 0; k < 16; ++k) { const int cnt = loc[k]; loc[k] = sum; sum += (cnt + 255) >> 8; }
                        int inc = sum;
#pragma unroll
                        for (int off = 1; off < 64; off <<= 1) { const int v = (int)shi_((unsigned)inc, lane - off); if (lane >= off) inc += v; }
                        const int base = inc - sum;
#pragma unroll
                        for (int k = 0; k < 16; ++k) pref[lane * 16 + k] = base + loc[k];
                        if (lane == 63) pref[1024] = inc;
                    }
                    __syncthreads();
                    const int NTsel = pref[1024];
                    auto decode = [&](int task_, int& li_o, int& chunk_o, bool& own_o) { own_o = task_ >= NTsel; chunk_o = 0;
                        if (own_o) li_o = task_ - NTsel;
                        else { int lo_ = 0, hi_ = 1023; while (lo_ < hi_) { const int mid = (lo_ + hi_ + 1) >> 1; if (pref[mid] <= task_) lo_ = mid; else hi_ = mid - 1; } li_o = lo_; chunk_o = task_ - pref[lo_]; } };
                    int nx_li = 0, nx_chunk = 0, nx_ent = 0, nx_cnt = 256; bool nx_own = true;
                    if (c < NTsel + 1024) { decode(c, nx_li, nx_chunk, nx_own);
                        if (!nx_own) { const int ln_ = lane_id_v(); nx_ent = MLIST[(size_t)nx_li * 16384 + nx_chunk * 256 + lsg(wid0) * 32 + (ln_ & 31)]; nx_cnt = (int)__hip_atomic_load(mcnt + nx_li, __ATOMIC_RELAXED, __HIP_MEMORY_SCOPE_AGENT); } }
                    for (int task = c; task < NTsel + 1024; task += G) {
                        const int lane = lane_id_v(), wid = lsg(wid0), r32 = lane & 31, hi = lane >> 5;
                        LAS unsigned char* ldsKs = lsgp(lds0); LAS unsigned char* ldsVs = ldsKs + 32768;
                        LAS bf16_t* stg = (LAS bf16_t*)(ldsKs + 65536 + wid * 4096); LAS float* wsf = (LAS float*)(ldsKs + 98304 + wid * 256); LAS int* rowd = (LAS int*)(ldsKs + 100352 + wid * 128);
                        const bool own_task = nx_own;
                        const int li = nx_li, chunk = nx_chunk;
                        const int b = li >> 9, h = (li >> 6) & 7, blk = li & 63;
                        const int e_ = chunk * 256 + wid * 32 + r32;
                        const int cnt = nx_cnt;
                        const int ent_ = nx_ent;
                        u32x4 kst[4], vst[4];
                        {
                            const bf16_t* kbp = Z + ((size_t)b * S + blk * 256) * OD_N + 512 + h * 64;
                            const bf16_t* vbp = Z + ((size_t)b * S + blk * 256) * OD_N + 1024 + h * 64;
#pragma unroll
                            for (int kt = 0; kt < 4; ++kt) {
                                kst[kt] = *(const u32x4*)(kbp + (size_t)(kt * 64 + lane) * OD_N + wid * 8);
                                vst[kt] = *(const u32x4*)(vbp + (size_t)(kt * 64 + 16 * (wid & 3) + (lane >> 2)) * OD_N + (wid >> 2) * 32 + (lane & 3) * 8);
                            }
                        }
                        __builtin_amdgcn_sched_barrier(0);
                        int posq, slot; bool valid;
                        if (own_task) { posq = blk * 256 + wid * 32 + r32; slot = 3; valid = true; }
                        else { valid = e_ < cnt; posq = valid ? (ent_ >> 2) : 0; slot = ent_ & 3; }
                        const size_t tq = (size_t)b * S + posq;
                        const int dest = valid ? (int)((tq * 8 + h) * 4 + slot) : -1;
                        attn_body::bf16x8 qr[4];
                        load_q_normed(qr, Z + tq * OD_N + h * 64, c_qn + i * 64, COSH, SINH, posq, hi, lane);
#pragma unroll
                        for (int kt = 0; kt < 4; ++kt) { *(LAS u32x4*)(ldsKs + kt * 8192 + wid * 1024 + lane * 16) = kst[kt]; *(LAS u32x4*)(ldsVs + kt * 8192 + wid * 1024 + lane * 16) = vst[kt]; }
                        nx_own = true; nx_li = 0; nx_chunk = 0; nx_ent = 0; nx_cnt = 256;
                        if (task + G < NTsel + 1024) { decode(task + G, nx_li, nx_chunk, nx_own);
                            if (!nx_own) { nx_ent = MLIST[(size_t)nx_li * 16384 + nx_chunk * 256 + wid * 32 + r32]; nx_cnt = (int)__hip_atomic_load(mcnt + nx_li, __ATOMIC_RELAXED, __HIP_MEMORY_SCOPE_AGENT); } }
                        __syncthreads();
                        attn_body::f32x16 p0[4], p1[4];
#pragma unroll
                        for (int kt = 0; kt < 4; ++kt) {
#pragma unroll
                            for (int r = 0; r < 16; ++r) { p0[kt][r] = 0.f; p1[kt][r] = 0.f; }
                            const LAS unsigned char* kb = ldsKs + kt * 8192 + hi * 1024 + r32 * 16;
#pragma unroll
                            for (int d0 = 0; d0 < 4; ++d0) {
                                const attn_body::bf16x8 b0 = *(const LAS attn_body::bf16x8*)(kb + d0 * 2048), b1 = *(const LAS attn_body::bf16x8*)(kb + d0 * 2048 + 512);
                                p0[kt] = __builtin_amdgcn_mfma_f32_32x32x16_bf16(b0, qr[d0], p0[kt], 0, 0, 0);
                                p1[kt] = __builtin_amdgcn_mfma_f32_32x32x16_bf16(b1, qr[d0], p1[kt], 0, 0, 0);
                            }
                        }
                        if (own_task) {
                            const int qrel = wid * 32 + r32;
#pragma unroll
                            for (int kt = 0; kt < 4; ++kt)
#pragma unroll
                                for (int r = 0; r < 16; ++r) { const int kv = kt * 64 + attn_body::crow(r, hi); if (kv > qrel) p0[kt][r] = -INFINITY; if (kv + 32 > qrel) p1[kt][r] = -INFINITY; }
                        }
                        float mx = -INFINITY;
#pragma unroll
                        for (int kt = 0; kt < 4; ++kt)
#pragma unroll
                            for (int r = 0; r < 16; ++r) mx = fmaxf(mx, fmaxf(p0[kt][r], p1[kt][r]));
                        mx = fmaxf(mx, SHX(mx, 32));
                        float ls = 0.f;
#pragma unroll
                        for (int kt = 0; kt < 4; ++kt)
#pragma unroll
                            for (int r = 0; r < 16; ++r) { p0[kt][r] = __builtin_amdgcn_exp2f(p0[kt][r] - mx); p1[kt][r] = __builtin_amdgcn_exp2f(p1[kt][r] - mx); ls += p0[kt][r] + p1[kt][r]; }
                        ls += SHX(ls, 32);
                        attn_body::f32x16 o[2];
#pragma unroll
                        for (int r = 0; r < 16; ++r) { o[0][r] = 0.f; o[1][r] = 0.f; }
                        const int vb0 = (int)(unsigned)(unsigned long long)ldsVs + ((lane >> 4) & 1) * 32 + (lane & 3) * 8 + (4 * hi + ((lane & 15) >> 2)) * 64;
#pragma unroll
                        for (int kt = 0; kt < 4; ++kt) {
                            u32x4 pw0, pw1, pw2, pw3;
#pragma unroll
                            for (int k = 0; k < 4; ++k) { pw0[k] = attn_body::cvtpk_s(p0[kt][2 * k], p0[kt][2 * k + 1]); pw1[k] = attn_body::cvtpk_s(p0[kt][8 + 2 * k], p0[kt][9 + 2 * k]);
                                pw2[k] = attn_body::cvtpk_s(p1[kt][2 * k], p1[kt][2 * k + 1]); pw3[k] = attn_body::cvtpk_s(p1[kt][8 + 2 * k], p1[kt][9 + 2 * k]); }
                            attn_body::pv(o, vb0 + kt * 8192, __builtin_bit_cast(attn_body::bf16x8, pw0), __builtin_bit_cast(attn_body::bf16x8, pw1), __builtin_bit_cast(attn_body::bf16x8, pw2), __builtin_bit_cast(attn_body::bf16x8, pw3));
                        }
                        if (hi == 0) { wsf[r32] = ls; rowd[r32] = dest; if (valid) { MML[(size_t)dest * 2] = mx; MML[(size_t)dest * 2 + 1] = ls; } }
                        LDS_WAIT();
#pragma unroll
                        for (int r = 0; r < 16; ++r) { const int orow = attn_body::crow(r, hi); const float rl = __builtin_amdgcn_rcpf(wsf[orow]);
                            stg[orow * 64 + r32] = (bf16_t)f2bf(o[0][r] * rl); stg[orow * 64 + 32 + r32] = (bf16_t)f2bf(o[1][r] * rl); }
                        LDS_WAIT();
#pragma unroll
                        for (int q = 0; q < 4; ++q) { const int row = q * 8 + (lane >> 3), ch = lane & 7; const int dd = rowd[row];
                            if (dd >= 0) *(u32x4*)(MPO + (size_t)dd * 64 + ch * 8) = *(const LAS u32x4*)(stg + row * 64 + ch * 8); }
                        __syncthreads();
                    }
                }
                {
                const int r32 = lane & 31, hi = lane >> 5;
                LAS unsigned char* ldsU = lds;
                LAS unsigned char* ldsK = lds + 69632;
                for (int task = c; task < 512; task += G) {
                    const int g = task >> 4, cs = task & 15, ig = i * 32 + g;
                    for (int q = tid; q < 32 * 128; q += NTHREADS) { const int j = q >> 7, off = (q & 127) * 16;
                        *(LAS u32x4*)(ldsU + j * 2064 + off) = *(const u32x4*)((const unsigned char*)UG + ((size_t)g * T + (size_t)(cs * 32 + j) * 64) * 32 + off); }
                    for (int q = tid; q < 65 * 48; q += NTHREADS) *(LAS u32x4*)(ldsK + q * 16) = *(const u32x4*)((const unsigned char*)S5KT + (size_t)ig * 65 * 768 + q * 16);
                    __syncthreads();
                    const int gc = cs * 32 + r32;
                    const float* dsk = s5_d + ig * 16;
                    const f32x4 dd0 = *(const f32x4*)(dsk + 4 * hi), dd1 = *(const f32x4*)(dsk + 8 + 4 * hi);
                    attn_body::bf16x8 hcr[8];
                    { const bf16_t* hc = S5HC + ((size_t)gc * 32 + g) * 128 + hi * 8;
#pragma unroll
                      for (int kk = 0; kk < 8; ++kk) hcr[kk] = *(const attn_body::bf16x8*)(hc + kk * 16); }
#pragma unroll 1
                    for (int rr = 0; rr < 4; ++rr) {
                        const int r = rr == 0 ? wid : rr == 1 ? 15 - wid : rr == 2 ? 16 + wid : 31 - wid;
                        attn_body::f32x16 acc;
#pragma unroll
                        for (int q = 0; q < 16; ++q) acc[q] = 0.f;
                        attn_body::bf16x8 a2r[8];
                        { const bf16_t* a2 = S5A2 + ((size_t)ig * 1024 + r * 32 + r32) * 128 + hi * 8;
#pragma unroll
                          for (int kk = 0; kk < 8; ++kk) a2r[kk] = *(const attn_body::bf16x8*)(a2 + kk * 16); }
                        __builtin_amdgcn_sched_barrier(0);
                        const LAS unsigned char* kbase = ldsK + (r32 >> 4) * 768 + (r32 & 15) * 48 + hi * 16;
                        const LAS unsigned char* ubase = ldsU + r32 * 2064 + hi * 16;
                        for (int s = 0; s <= 2 * r + 1; ++s) {
                            const attn_body::bf16x8 A = *(const LAS attn_body::bf16x8*)(kbase + (2 * r - s + 1) * 768);
                            const attn_body::bf16x8 B = *(const LAS attn_body::bf16x8*)(ubase + s * 32);
                            acc = __builtin_amdgcn_mfma_f32_32x32x16_bf16(A, B, acc, 0, 0, 0);
                        }
#pragma unroll
                        for (int kk = 0; kk < 8; ++kk) acc = __builtin_amdgcn_mfma_f32_32x32x16_bf16(a2r[kk], hcr[kk], acc, 0, 0, 0);
#pragma unroll
                        for (int q4 = 0; q4 < 4; ++q4) {
                            const int rowb = 8 * q4 + 4 * hi, dt_ = rowb >> 4, co0 = rowb & 15, t = 2 * r + dt_;
                            const u32x2 uw = *(const LAS u32x2*)(ldsU + r32 * 2064 + t * 32 + co0 * 2);
                            const f32x4 dd = (q4 & 1) ? dd1 : dd0;
                            const float y0 = acc[4 * q4] + dd.x * bflo(uw.x), y1 = acc[4 * q4 + 1] + dd.y * bfhi(uw.x), y2 = acc[4 * q4 + 2] + dd.z * bflo(uw.y), y3 = acc[4 * q4 + 3] + dd.w * bfhi(uw.y);
                            u32x2 w; w.x = pk2(gelu_tanh(y0), gelu_tanh(y1)); w.y = pk2(gelu_tanh(y2), gelu_tanh(y3));
                            *(u32x2*)(YG + ((size_t)gc * 64 + t) * 512 + g * 16 + co0) = w;
                        }
                    }
                    __syncthreads();
                }
                }
            }
            PH_END();
            if (PH_ON()) { DECL_PTRS();
                {
                    const int h = lane >> 3, d8 = (lane & 7) * 8;
                    for (int t0 = gw * 4; t0 < T; t0 += NGW * 4) {
                        int nsel[4]; f32x2 ml[4][4]; u32x4 po[4][4];
#pragma unroll
                        for (int u = 0; u < 4; ++u) { const size_t base = ((size_t)(t0 + u) * 8 + h) * 4; nsel[u] = NSEL[(size_t)(t0 + u) * 8 + h];
#pragma unroll
                            for (int s = 0; s < 4; ++s) { ml[u][s] = *(const f32x2*)(MML + (base + s) * 2); po[u][s] = *(const u32x4*)(MPO + (base + s) * 64 + d8); } }
                        __builtin_amdgcn_sched_barrier(0);
#pragma unroll
                        for (int u = 0; u < 4; ++u) {
                            float mm[4], ll[4];
#pragma unroll
                            for (int s = 0; s < 4; ++s) { const bool on = (s == 3) || (s < nsel[u]); mm[s] = on ? ml[u][s].x : -INFINITY; ll[s] = on ? ml[u][s].y : 0.f; }
                            const float M = fmaxf(fmaxf(mm[0], mm[1]), fmaxf(mm[2], mm[3]));
                            float acc[8], wsum = 0.f;
#pragma unroll
                            for (int e = 0; e < 8; ++e) acc[e] = 0.f;
#pragma unroll
                            for (int s = 0; s < 4; ++s) { const bool on = (s == 3) || (s < nsel[u]);
                                const float w = on ? ll[s] * __builtin_amdgcn_exp2f(mm[s] - M) : 0.f; float ov[8]; unpack8(po[u][s], ov); wsum += w;
#pragma unroll
                                for (int e = 0; e < 8; ++e) acc[e] += on ? w * ov[e] : 0.f; }
                            const float inv = 1.0f / wsum;
#pragma unroll
                            for (int e = 0; e < 8; ++e) acc[e] *= inv;
                            *(u32x4*)(O + (size_t)(t0 + u) * 1024 + h * 64 + d8) = pack8(acc);
                        }
                        __builtin_amdgcn_sched_barrier(0);
                    }
                }
                pg8::Gemm g{YG, Wglu + (size_t)i * 512 * 512, T, 512, 512, 0}; pg8::StaticOrder So; So.init(T, 512, G, c);
                EpiGLU E{O, YG, s5_glu_b + i * 512};
                { PROBE_WRAP(pg8::StaticOrder, So); pg8::gemm_phase<EpiGLU, PROBE_SCHED(pg8::StaticOrder), true, true>(glds, g, PS_, E, tid); }
            }
            PH_END();
        }
        if (PH_ON()) { DECL_PTRS();
            pg8::Gemm g{O, ((l & 1) ? Wodout : Wevout) + (size_t)i * 1024 * 1024, T, 1024, 1024, 0}; pg8::StaticOrder So; So.init(T, 1024, G, c);
            EpiPlain E{YMIX, 1024};
            { PROBE_WRAP(pg8::StaticOrder, So); pg8::gemm_phase<EpiPlain, PROBE_SCHED(pg8::StaticOrder), true, true>(glds, g, PS_, E, tid); }
        }
        PH_END();
        if (PH_ON()) { DECL_PTRS();
#ifdef PROBE_MASK
            const bool first_x = (l == 0 && a.probe_var != -5);
#else
            const bool first_x = (l == 0);
#endif
            const float* xs = xin;
            LAS int* r_e = (LAS int*)(lds + 0);
            LAS float* r_w = (LAS float*)(lds + 1024);
            LAS int* r_rank = (LAS int*)(lds + 2048);
            LAS int* lcnt = (LAS int*)(lds + 3072);
            LAS int* lbase = (LAS int*)(lds + 3200);
            const float* wg_l = moe_wg + (size_t)l * 1024 * 4; const float* we_l = moe_we + (size_t)l * 1024 * 32;
            for (int chunk = c; chunk < T / 128; chunk += G) {
                if (tid < 32) lcnt[tid] = 0;
                LAS float* modl = (LAS float*)(lds + 32768);
                { const float* mo_ = MOD + (size_t)(l * 2 + (int)(((size_t)chunk * 128) / S)) * 6144 + 2048;
                  for (int q = tid; q < 768; q += NTHREADS) *(LAS f32x4*)(modl + 4 * q) = *(const f32x4*)(mo_ + 4 * q); }
                __syncthreads();
                {
                    const int rloc = lane & 15, kc = lane >> 4; const int r = wid * 16 + rloc; const size_t t = (size_t)chunk * 128 + r; const int b = (int)(((size_t)chunk * 128) / S);
                    const float* mo = MOD + (size_t)(l * 2 + b) * 6144;
                    float ss;
                    if (first_x) ss = f_pass1<true>(xs + t * 1024, XB + t * 1024, YMIX + t * 1024, modl, kc);
                    else ss = f_pass1<false>(xs + t * 1024, XB + t * 1024, YMIX + t * 1024, modl, kc);
                    ss += SHX(ss, 16); ss += SHX(ss, 32);
                    const float rn = rsqrtf(ss * (1.0f / 1024.0f) + EPS);
                    f32x4 acc[3];
#pragma unroll
                    for (int ct = 0; ct < 3; ++ct) acc[ct] = (f32x4){0.f, 0.f, 0.f, 0.f};
                    const bf16_t* wh = WRH + ((size_t)l * 48 + rloc) * 1024 + 8 * kc; const bf16_t* wl = WRL + ((size_t)l * 48 + rloc) * 1024 + 8 * kc;
                    f_pass2(XB + t * 1024, H + t * 1024, modl, wh, wl, rn, kc, acc);
                    LAS float* lg = (LAS float*)(lds + 4096 + wid * 3072);
#pragma unroll
                    for (int ct = 0; ct < 3; ++ct) { lg[(4 * kc + 0) * 48 + ct * 16 + rloc] = acc[ct].x; lg[(4 * kc + 1) * 48 + ct * 16 + rloc] = acc[ct].y; lg[(4 * kc + 2) * 48 + ct * 16 + rloc] = acc[ct].z; lg[(4 * kc + 3) * 48 + ct * 16 + rloc] = acc[ct].w; }
                    LDS_WAIT();
                    if (lane < 16) {
                        const LAS float* lr = lg + lane * 48;
                        float cg[4];
#pragma unroll
                        for (int e = 0; e < 4; ++e) cg[e] = lr[e] + moe_bg[l * 4 + e];
                        int grp = 0; float cm = cg[0];
#pragma unroll
                        for (int e = 1; e < 4; ++e) if (cg[e] > cm) { cm = cg[e]; grp = e; }
                        float den = 0.f;
#pragma unroll
                        for (int e = 0; e < 4; ++e) den += __expf(cg[e] - cm);
                        const float pg = 1.0f / den;
                        float fe[8];
#pragma unroll
                        for (int e = 0; e < 8; ++e) fe[e] = lr[4 + grp * 8 + e] + moe_be[l * 32 + grp * 8 + e];
                        int j0 = 0; float f0 = fe[0];
#pragma unroll
                        for (int e = 1; e < 8; ++e) if (fe[e] > f0) { f0 = fe[e]; j0 = e; }
                        int j1 = -1; float f1 = -INFINITY;
#pragma unroll
                        for (int e = 0; e < 8; ++e) if (e != j0 && fe[e] > f1) { f1 = fe[e]; j1 = e; }
                        const float ex = __expf(f1 - f0); const float sA = 1.0f / (1.0f + ex), sB = ex / (1.0f + ex);
                        const int rr_ = wid * 16 + lane;
                        r_e[2 * rr_] = grp * 8 + j0; r_w[2 * rr_] = pg * sA; r_e[2 * rr_ + 1] = grp * 8 + j1; r_w[2 * rr_ + 1] = pg * sB;
                    }
                }
                __syncthreads();
#ifdef PROBE_MASK
                if (a.probe_var == 5) { if (tid < 256 && r_e[tid] == -777) TOKES[0] = 0; __syncthreads(); continue; }
#endif
                if (tid < 256) r_rank[tid] = __hip_atomic_fetch_add(&lcnt[r_e[tid]], 1, __ATOMIC_RELAXED, __HIP_MEMORY_SCOPE_WORKGROUP);
                __syncthreads();
                if (tid < 32) lbase[tid] = (int)__hip_atomic_fetch_add(ctl + CW_CNT + (l * 32 + tid) * 64, (unsigned)lcnt[tid], __ATOMIC_RELAXED, __HIP_MEMORY_SCOPE_AGENT);
                __syncthreads();
                if (tid < 256) { const size_t t = (size_t)chunk * 128 + (tid >> 1); const int k = tid & 1; const int e = r_e[tid]; const int slot = lbase[e] + r_rank[tid];
                    TOKES[t * 2 + k] = e * 32768 + slot; TOKW[t * 2 + k] = r_w[tid]; LTOK[e * 32768 + slot] = (int)t; }
                __syncthreads();
            }
        }
        PH_END();
        if (PH_ON()) { DECL_PTRS();
            LAS int* tile_e = (LAS int*)(lds + LDS_MISC); LAS int* rb = tile_e + 320; LAS int* nt_p = tile_e + 400;
            moe_tables(ctl, l, tile_e, rb, nt_p, tid);
            const int nR = nt_p[0];
            pg8::Gemm g{H, W13, nR * 256, 1024, 1024, (size_t)1024 * 1024 * 2}; MoeOrder Mo{4, nR * 4, G, c, tile_e};
            EpiSwiGLU E{HID}; MoeRows RW{rb, LTOK};
            { PROBE_WRAP(MoeOrder, Mo); pg8::gemm_phase<EpiSwiGLU, PROBE_SCHED(MoeOrder), true, true, MoeRows>(glds, g, PS_, E, tid, RW); }
        }
        PH_END();
        if (PH_ON()) { DECL_PTRS();
            LAS int* tile_e = (LAS int*)(lds + LDS_MISC); LAS int* rb = tile_e + 320; LAS int* nt_p = tile_e + 400;
            moe_tables(ctl, l, tile_e, rb, nt_p, tid);
            const int nR = nt_p[0];
            pg8::Gemm g{HID, W2, nR * 256, 1024, 512, (size_t)1024 * 512 * 2}; MoeOrder Mo{4, nR * 4, G, c, tile_e};
            EpiPlain E{Y, 1024};
            { PROBE_WRAP(MoeOrder, Mo); pg8::gemm_phase<EpiPlain, PROBE_SCHED(MoeOrder), true, true>(glds, g, PS_, E, tid); }
        }
        PH_END();
        if (PH_ON()) { DECL_PTRS();
            LAS int* tile_e = (LAS int*)(lds + LDS_MISC); LAS int* rb = tile_e + 320; LAS int* nt_p = tile_e + 400;
            moe_tables(ctl, l, tile_e, rb, nt_p, tid);
            constexpr int RJ = 4;
            for (int t0 = gw * RJ; t0 < T; t0 += NGW * RJ) {
                const int b = t0 / S; const float* mo = MOD + (size_t)(l * 2 + b) * 6144;
                int r0[RJ], r1[RJ]; float w0[RJ], w1[RJ];
#pragma unroll
                for (int u = 0; u < RJ; ++u) { const int t = t0 + u; { const int e0_ = TOKES[2 * t], e1_ = TOKES[2 * t + 1]; r0[u] = rb[e0_ >> 15] + (e0_ & 32767); r1[u] = rb[e1_ >> 15] + (e1_ & 32767); } w0[u] = TOKW[2 * t]; w1[u] = TOKW[2 * t + 1];
#ifdef PROBE_MASK
                    if (a.probe_var == 4 || a.probe_var == -4) { w0[u] *= 0.5f; w1[u] *= 0.5f; }
#endif
                }
                f32x4 v[RJ][4]; u32x2 ya[RJ][4], yb[RJ][4];
#pragma unroll
                for (int u = 0; u < RJ; ++u)
#pragma unroll
                    for (int j = 0; j < 4; ++j) { const int col = 4 * lane + 256 * j; { const u32x2 xw = *(const u32x2*)(XB + (size_t)(t0 + u) * 1024 + col); v[u][j] = (f32x4){bflo(xw.x), bfhi(xw.x), bflo(xw.y), bfhi(xw.y)}; }
                        ya[u][j] = *(const u32x2*)(Y + (size_t)r0[u] * 1024 + col); yb[u][j] = *(const u32x2*)(Y + (size_t)r1[u] * 1024 + col); }
                f32x4 gg[4];
#pragma unroll
                for (int j = 0; j < 4; ++j) gg[j] = *(const f32x4*)(mo + 5120 + 4 * lane + 256 * j);
                float ss[RJ];
#pragma unroll
                for (int u = 0; u < RJ; ++u) { ss[u] = 0.f;
#pragma unroll
                    for (int j = 0; j < 4; ++j) { const int col = 4 * lane + 256 * j; const f32x4 xv = v[u][j]; f32x4 nv;
                        nv.x = xv.x + gg[j].x * (w0[u] * bflo(ya[u][j].x) + w1[u] * bflo(yb[u][j].x)); nv.y = xv.y + gg[j].y * (w0[u] * bfhi(ya[u][j].x) + w1[u] * bfhi(yb[u][j].x));
                        nv.z = xv.z + gg[j].z * (w0[u] * bflo(ya[u][j].y) + w1[u] * bflo(yb[u][j].y)); nv.w = xv.w + gg[j].w * (w0[u] * bfhi(ya[u][j].y) + w1[u] * bfhi(yb[u][j].y));
                        if (l + 1 < DEPTH) { u32x2 xw; xw.x = pk2(nv.x, nv.y); xw.y = pk2(nv.z, nv.w); *(u32x2*)(XB + (size_t)(t0 + u) * 1024 + col) = xw; nv = (f32x4){bflo(xw.x), bfhi(xw.x), bflo(xw.y), bfhi(xw.y)}; }
                        else *(f32x4*)(out + (size_t)(t0 + u) * 1024 + col) = nv;
                        v[u][j] = nv; ss[u] += (nv.x * nv.x + nv.y * nv.y) + (nv.z * nv.z + nv.w * nv.w); } }
                if (l + 1 < DEPTH) {
                    const float* mn = MOD + (size_t)((l + 1) * 2 + b) * 6144;
                    f32x4 sc1[4], sh1[4];
#pragma unroll
                    for (int j = 0; j < 4; ++j) { sc1[j] = *(const f32x4*)(mn + 1024 + 4 * lane + 256 * j); sh1[j] = *(const f32x4*)(mn + 4 * lane + 256 * j); }
#pragma unroll
                    for (int u = 0; u < RJ; ++u) { const float rn = rsqrtf(wave_sum(ss[u]) * (1.0f / 1024.0f) + EPS);
#pragma unroll
                        for (int j = 0; j < 4; ++j) { const int col = 4 * lane + 256 * j;
                            u32x2 w; w.x = pk2(v[u][j].x * rn * (1.f + sc1[j].x) + sh1[j].x, v[u][j].y * rn * (1.f + sc1[j].y) + sh1[j].y); w.y = pk2(v[u][j].z * rn * (1.f + sc1[j].z) + sh1[j].z, v[u][j].w * rn * (1.f + sc1[j].w) + sh1[j].w);
                            *(u32x2*)(H + (size_t)(t0 + u) * 1024 + col) = w; } }
                }
            }
        }
        PH_END();
    }
#undef PH_ON
#undef PH_END
}

extern "C" void kernel_launch(void* const* d_in, const int* in_sizes, int n_in, void* d_out, int out_size, void* d_ws, size_t ws_size, hipStream_t stream) {
    static int grid = 0;
    if (grid == 0) {
        if (n_in != 37 || out_size != T * D || ws_size < WS_END) { fprintf(stderr, "kernel_launch: unexpected shapes (n_in %d, out %d, ws %zu); nothing launched\n", n_in, out_size, ws_size); grid = -1; return; }
        int dev = 0, cus = 0, per_cu = 0;
        if (hipGetDevice(&dev) != hipSuccess || hipDeviceGetAttribute(&cus, hipDeviceAttributeMultiprocessorCount, dev) != hipSuccess) { grid = -1; return; }
        if (hipFuncSetAttribute((const void*)fwd, hipFuncAttributeMaxDynamicSharedMemorySize, LDS_BYTES) != hipSuccess) { fprintf(stderr, "kernel_launch: hipFuncSetAttribute failed\n"); grid = -1; return; }
        if (hipOccupancyMaxActiveBlocksPerMultiprocessor(&per_cu, (const void*)fwd, NTHREADS, LDS_BYTES) != hipSuccess || per_cu < 1) fprintf(stderr, "kernel_launch: occupancy query says %d\n", per_cu);
        (void)hipGetLastError();
        grid = cus;
    }
    if (grid < 0) return;
    if (hipMemsetAsync((char*)d_ws + WS_CTL, 0, CTL_ZERO_BYTES, stream) != hipSuccess) return;
    Args a{};
    for (int i = 0; i < 37; ++i) a.in[i] = d_in[i];
    a.out = (float*)d_out; a.ws = (unsigned char*)d_ws;
#ifdef PROBE_MASK
#ifndef PROBE_VAR
#define PROBE_VAR 0
#endif
    {
        int types[N_PHASES]; int n = 0; types[n++] = 0; types[n++] = 1; types[n++] = 2;
        for (int l = 0; l < DEPTH; ++l) { if ((l & 1) == 0) { for (int k = 3; k <= 7; ++k) if (k != 4 && k != 6) types[n++] = k; } else { for (int k = 8; k <= 13; ++k) if (k != 9) types[n++] = k; } for (int k = 14; k <= 19; ++k) if (k != 16) types[n++] = k; }
        for (int p = 0; p < N_PHASES; ++p) { a.ph_lo = p; a.ph_hi = p + 1; const int reps = ((PROBE_MASK >> types[p]) & 1) ? 2 : 1;
            for (int r = 0; r < reps; ++r) { a.probe_var = (reps == 2) ? ((r == 0) ? PROBE_VAR : -PROBE_VAR) : 0; hipLaunchKernelGGL(fwd, dim3(grid), dim3(NTHREADS), LDS_BYTES, stream, a); } }
    }
#elif MK_ONE_LAUNCH
    a.ph_lo = 0; a.ph_hi = N_PHASES;
    hipLaunchKernelGGL(fwd, dim3(grid), dim3(NTHREADS), LDS_BYTES, stream, a);
#else
    for (int p = 0; p < N_PHASES; ++p) { a.ph_lo = p; a.ph_hi = p + 1; hipLaunchKernelGGL(fwd, dim3(grid), dim3(NTHREADS), LDS_BYTES, stream, a); }
#endif
}
```

```cpp
#include <hip/hip_runtime.h>
#include <cstdio>
#include <cstdint>
#include <hip/hip_bf16.h>
#include <cmath>
#ifndef MK_ONE_LAUNCH
#define MK_ONE_LAUNCH 1
#endif
namespace pg8 {
#define PG8_LAS __attribute__((address_space(3)))
typedef unsigned short bf16_t;
typedef short bf16x8 __attribute__((ext_vector_type(8)));
typedef float f32x4 __attribute__((ext_vector_type(4)));
typedef unsigned u32x4 __attribute__((ext_vector_type(4)));
constexpr int BM = 256, BK = 64, HALF = 128, HTB = HALF * BK * 2  , STAGE_BYTES = 8 * HTB, NXCD = 8, WGM = 8;

__host__ __device__ __forceinline__ int lds_byte(int r, int c) { const int st = (r >> 4) * 2 + (c >> 5), rr = r & 15, cc = c & 31, ob = rr * 64 + cc * 2; return st * 1024 + (ob ^ (((ob >> 9) & 1) << 5)); }
__host__ __device__ __forceinline__ void stage_rc(int b, int& R, int& C) { const int st = b / 1024, sb = b % 1024, swz = sb ^ (((sb >> 9) & 1) << 5); R = (st >> 1) * 16 + swz / 64; C = (st & 1) * 32 + (swz % 64) / 2; }
__host__ __device__ __forceinline__ int perm32(int rho) { const int n = rho >> 4, i = rho & 15; return 8 * (i >> 2) + 4 * n + (i & 3); }

struct Unit { int pm, pn, be; };
struct Gemm { const bf16_t* A; const bf16_t* Bt; int M, N, K; size_t bstride; };

struct StaticOrder {
    int nM, nN, nwg, G, c;
    __host__ __device__ void init(int M, int N, int G_, int c_) { nM = M / BM; nN = N / BM; nwg = nM * nN; G = G_; c = c_; }
    __host__ __device__ bool next(int i, Unit& u) const {
        const long L = (long)i * G + c; if (L >= nwg) return false;
        int wgid = (int)L; { const int q = nwg / NXCD, r = nwg % NXCD, xcd = wgid % NXCD, off = wgid / NXCD; wgid = (xcd < r ? xcd * (q + 1) : r * (q + 1) + (xcd - r) * q) + off; }
        const int nig = WGM * nN, gid = wgid / nig, fm = gid * WGM, gsz = (nM - fm) < WGM ? (nM - fm) : WGM;
        u.pm = fm + ((wgid % nig) % gsz); u.pn = (wgid % nig) / gsz; u.be = 0; return true;
    }
    __device__ __forceinline__ void a_ready(const Unit&) const {}
    __device__ __forceinline__ void done(const Unit&) const {}
};

__device__ __forceinline__ unsigned cvt_pk_bf16(float lo, float hi) { unsigned r; asm volatile("v_cvt_pk_bf16_f32 %0, %1, %2" : "=v"(r) : "v"(lo), "v"(hi)); return r; }
typedef float f32x2 __attribute__((ext_vector_type(2)));
struct NoRows { static constexpr bool GATHER = false; __device__ __forceinline__ unsigned operator()(const Unit&, int) const { return 0u; } };
template <class Epi, class Sched, bool ALIGN_EPI = false, bool SP2 = false, class Rows = NoRows>
__device__ __forceinline__ void gemm_phase(PG8_LAS unsigned char* lds, const Gemm g, const Sched& S, const Epi& E, const int tid_in, const Rows& RW = Rows()) {
    const int tid = tid_in, wid = __builtin_amdgcn_readfirstlane(tid >> 6), lane = tid & 63, wr = wid >> 2, wc = wid & 3, fr = lane & 15, fq = lane >> 4;
    const int K = g.K, nt = K / BK;
    unsigned voffA[2], voffB[2];
#pragma unroll
    for (int i = 0; i < 2; ++i) { int R, C; stage_rc(tid * 16 + i * 8192, R, C); const int Rb = Epi::PERM ? ((R & ~31) + perm32(R & 31)) : R;
        voffA[i] = (unsigned)(R * K + C) * 2u; voffB[i] = (unsigned)(Rb * K + C) * 2u; }
    const size_t kstep = (size_t)(BK * 2);
    const size_t hstep = (size_t)HALF * K * 2;
    const size_t tstep = 2 * hstep;
    const unsigned ldsw = (unsigned)wid * 1024u;
    const int aoff = lds_byte(wr * 64 + fr, fq * 8), boff = lds_byte(wc * 32 + fr, fq * 8);
#define PG8_SA(b, h) (((b) * 2 + (h)) * HTB)
#define PG8_SB(b, h) ((4 + (b) * 2 + (h)) * HTB)
#define PG8_STAGE(bufoff, gbase, voff) do { _Pragma("unroll") for (int _i = 0; _i < 2; ++_i) \
        __builtin_amdgcn_global_load_lds((const unsigned*)((const char*)(gbase) + (voff)[_i]), (PG8_LAS unsigned*)(lds + (bufoff) + ldsw + _i * 8192), 16, 0, 0); } while (0)
#define PG8_LDA(dst, b, h) do { _Pragma("unroll") for (int m = 0; m < 4; ++m) _Pragma("unroll") for (int k = 0; k < 2; ++k) dst[m][k] = *(const PG8_LAS bf16x8*)(lds + PG8_SA(b, h) + aoff + m * 2048 + k * 1024); } while (0)
#define PG8_LDB(dst, b, h) do { _Pragma("unroll") for (int n = 0; n < 2; ++n) _Pragma("unroll") for (int k = 0; k < 2; ++k) dst[n][k] = *(const PG8_LAS bf16x8*)(lds + PG8_SB(b, h) + boff + n * 2048 + k * 1024); } while (0)
#define PG8_MMA(ai, bj, At, Bt) do { __builtin_amdgcn_s_setprio(1); _Pragma("unroll") for (int m = 0; m < 4; ++m) _Pragma("unroll") for (int n = 0; n < 2; ++n) _Pragma("unroll") for (int k = 0; k < 2; ++k) \
        acc[ai][bj][m][n] = __builtin_amdgcn_mfma_f32_16x16x32_bf16(Bt[n][k], At[m][k], acc[ai][bj][m][n], 0, 0, 0); __builtin_amdgcn_s_setprio(0); } while (0)
#define PG8_WAIT_V(n) asm volatile("s_waitcnt vmcnt(" #n ")" ::: "memory")
#define PG8_WAIT_L(n) asm volatile("s_waitcnt lgkmcnt(" #n ")" ::: "memory")
#define PG8_BAR __builtin_amdgcn_s_barrier()
#define PG8_SCHED __builtin_amdgcn_sched_barrier(0)
    Unit cur, nxt; int ui = 0;
    if (!S.next(0, cur)) return;
    f32x4 acc[2][2][4][2];
#pragma unroll
    for (int a = 0; a < 2; ++a)
#pragma unroll
        for (int b = 0; b < 2; ++b)
#pragma unroll
            for (int m = 0; m < 4; ++m)
#pragma unroll
                for (int n = 0; n < 2; ++n) { float z0_ = 0.f; asm volatile("" : "+v"(z0_)); acc[a][b][m][n] = (f32x4){z0_, z0_, z0_, z0_}; }
    bf16x8 At[4][2], B0[2][2], B1[2][2];
    const char* cA = Rows::GATHER ? (const char*)g.A : (const char*)g.A + (size_t)cur.pm * tstep; const char* cB = (const char*)g.Bt + (size_t)cur.be * g.bstride + (size_t)cur.pn * tstep;
    int Rr[2], Cc[2];
#pragma unroll
    for (int i = 0; i < 2; ++i) stage_rc(tid * 16 + i * 8192, Rr[i], Cc[i]);
    unsigned voffAh[2][2], voffAn[2][2];
#pragma unroll
    for (int h = 0; h < 2; ++h)
#pragma unroll
        for (int i = 0; i < 2; ++i) { voffAh[h][i] = Rows::GATHER ? RW(cur, h * HALF + Rr[i]) + (unsigned)Cc[i] * 2u : voffA[i] + (unsigned)h * (unsigned)hstep; voffAn[h][i] = voffAh[h][i]; }
    S.a_ready(cur);
    if constexpr (SP2) {
        PG8_STAGE(PG8_SB(0, 0), cB, voffB); PG8_STAGE(PG8_SB(0, 1), cB + hstep, voffB); PG8_STAGE(PG8_SA(0, 0), cA, voffAh[0]); PG8_STAGE(PG8_SA(0, 1), cA, voffAh[1]);
        if (wr == 1) PG8_BAR;
        PG8_WAIT_V(2); PG8_BAR;
        PG8_STAGE(PG8_SB(1, 0), cB + kstep, voffB); PG8_STAGE(PG8_SA(1, 0), cA + kstep, voffAh[0]); PG8_STAGE(PG8_SB(1, 1), cB + hstep + kstep, voffB);
        PG8_WAIT_V(6); PG8_BAR;
    } else {
        PG8_STAGE(PG8_SB(0, 0), cB, voffB); PG8_STAGE(PG8_SA(0, 0), cA, voffAh[0]); PG8_STAGE(PG8_SB(0, 1), cB + hstep, voffB); PG8_STAGE(PG8_SA(0, 1), cA, voffAh[1]);
        if (wr == 1) PG8_BAR;
        PG8_WAIT_V(4); PG8_BAR;
        PG8_STAGE(PG8_SB(1, 0), cB + kstep, voffB); PG8_STAGE(PG8_SA(1, 0), cA + kstep, voffAh[0]); PG8_STAGE(PG8_SB(1, 1), cB + hstep + kstep, voffB);
        PG8_WAIT_V(6); PG8_BAR;
    }
    for (;;) {
        const bool has_next = S.next(ui + 1, nxt);
        const char* nA = Rows::GATHER ? (const char*)g.A : (has_next ? (const char*)g.A + (size_t)nxt.pm * tstep : cA);
        if constexpr (Rows::GATHER) { if (has_next) {
#pragma unroll
            for (int h = 0; h < 2; ++h)
#pragma unroll
                for (int i = 0; i < 2; ++i) voffAn[h][i] = RW(nxt, h * HALF + Rr[i]) + (unsigned)Cc[i] * 2u; } } const char* nB = has_next ? (const char*)g.Bt + (size_t)nxt.be * g.bstride + (size_t)nxt.pn * tstep : cB;
        for (int t = 0; t < nt; t += 2) {
            const bool last = (t == nt - 2); const bool gsel = Rows::GATHER && last && has_next;
            const char* a1 = cA + (size_t)(t + 1) * kstep;
            const char* a2 = last ? nA : cA + (size_t)(t + 2) * kstep; const char* b2 = last ? nB : cB + (size_t)(t + 2) * kstep;
            const char* a3 = a2 + kstep; const char* b3 = b2 + kstep;
            if (last && has_next) S.a_ready(nxt);
            if constexpr (SP2) {
            PG8_LDB(B0, 0, 0); PG8_LDB(B1, 0, 1); PG8_SCHED; PG8_LDA(At, 0, 0); PG8_STAGE(PG8_SA(1, 1), a1, voffAh[1]);
            PG8_WAIT_V(8); PG8_WAIT_L(0); PG8_BAR; PG8_MMA(0, 0, At, B0); PG8_MMA(0, 1, At, B1); PG8_BAR; PG8_SCHED;
            PG8_LDA(At, 0, 1); PG8_STAGE(PG8_SB(0, 0), b2, voffB); PG8_STAGE(PG8_SB(0, 1), b2 + hstep, voffB); PG8_STAGE(PG8_SA(0, 0), a2, (gsel ? voffAn[0] : voffAh[0]));
            PG8_WAIT_V(8); PG8_WAIT_L(0); PG8_BAR; PG8_MMA(1, 0, At, B0); PG8_MMA(1, 1, At, B1); PG8_BAR; PG8_SCHED;
            PG8_LDB(B0, 1, 0); PG8_LDB(B1, 1, 1); PG8_SCHED; PG8_LDA(At, 1, 0); PG8_STAGE(PG8_SA(0, 1), a2, (gsel ? voffAn[1] : voffAh[1]));
            PG8_WAIT_V(8); PG8_WAIT_L(0); PG8_BAR; PG8_MMA(0, 0, At, B0); PG8_MMA(0, 1, At, B1); PG8_BAR; PG8_SCHED;
            PG8_LDA(At, 1, 1); PG8_STAGE(PG8_SB(1, 0), b3, voffB); PG8_STAGE(PG8_SB(1, 1), b3 + hstep, voffB); PG8_STAGE(PG8_SA(1, 0), a3, (gsel ? voffAn[0] : voffAh[0]));
            PG8_WAIT_V(8); PG8_WAIT_L(0); PG8_BAR; PG8_MMA(1, 0, At, B0); PG8_MMA(1, 1, At, B1); PG8_BAR; PG8_SCHED;
            } else {
            PG8_LDB(B0, 0, 0); PG8_SCHED; PG8_LDA(At, 0, 0); PG8_STAGE(PG8_SA(1, 1), a1, voffAh[1]);
            PG8_WAIT_L(8); PG8_BAR; PG8_WAIT_L(0); PG8_MMA(0, 0, At, B0); PG8_BAR; PG8_SCHED;
            PG8_LDB(B1, 0, 1); PG8_STAGE(PG8_SB(0, 0), b2, voffB);
            PG8_BAR; PG8_WAIT_L(0); PG8_MMA(0, 1, At, B1); PG8_BAR;
            PG8_LDA(At, 0, 1); PG8_STAGE(PG8_SA(0, 0), a2, (gsel ? voffAn[0] : voffAh[0]));
            PG8_BAR; PG8_WAIT_L(0); PG8_MMA(1, 0, At, B0); PG8_BAR; PG8_SCHED;
            PG8_STAGE(PG8_SB(0, 1), b2 + hstep, voffB);
            PG8_WAIT_V(6); PG8_BAR; PG8_MMA(1, 1, At, B1); PG8_BAR;
            PG8_LDB(B0, 1, 0); PG8_SCHED; PG8_LDA(At, 1, 0); PG8_STAGE(PG8_SA(0, 1), a2, (gsel ? voffAn[1] : voffAh[1]));
            PG8_WAIT_L(8); PG8_BAR; PG8_WAIT_L(0); PG8_MMA(0, 0, At, B0); PG8_BAR; PG8_SCHED;
            PG8_LDB(B1, 1, 1); PG8_STAGE(PG8_SB(1, 0), b3, voffB);
            PG8_BAR; PG8_WAIT_L(0); PG8_MMA(0, 1, At, B1); PG8_BAR;
            PG8_LDA(At, 1, 1); PG8_STAGE(PG8_SA(1, 0), a3, (gsel ? voffAn[0] : voffAh[0]));
            PG8_BAR; PG8_WAIT_L(0); PG8_MMA(1, 0, At, B0); PG8_BAR; PG8_SCHED;
            PG8_STAGE(PG8_SB(1, 1), b3 + hstep, voffB);
            PG8_WAIT_V(6); PG8_BAR; PG8_MMA(1, 1, At, B1); PG8_BAR;
            }
        }
        if constexpr (ALIGN_EPI) { if (wr == 0) PG8_BAR; }
        if constexpr (!Epi::AFTER_DRAIN) { int l2_; asm volatile("v_mbcnt_lo_u32_b32 %0, -1, 0\n\tv_mbcnt_hi_u32_b32 %0, -1, %0" : "=v"(l2_)); E(acc, cur, wr, wc, l2_ & 15, l2_ >> 4); S.done(cur); }
        if (!has_next) break;
#pragma unroll
        for (int a = 0; a < 2; ++a)
#pragma unroll
            for (int b = 0; b < 2; ++b)
#pragma unroll
                for (int m = 0; m < 4; ++m)
#pragma unroll
                    for (int n = 0; n < 2; ++n) { float z0_ = 0.f; asm volatile("" : "+v"(z0_)); acc[a][b][m][n] = (f32x4){z0_, z0_, z0_, z0_}; }
        cur = nxt; cA = nA; cB = nB; ++ui;
        if constexpr (Rows::GATHER) {
#pragma unroll
            for (int h = 0; h < 2; ++h)
#pragma unroll
                for (int i = 0; i < 2; ++i) voffAh[h][i] = voffAn[h][i]; }
        if constexpr (ALIGN_EPI) { if (wr == 1) PG8_BAR; }
    }
    PG8_WAIT_V(0);
    if constexpr (!ALIGN_EPI) { if (wr == 0) PG8_BAR; }
    PG8_BAR;
    if constexpr (Epi::AFTER_DRAIN) { E.fused(acc, cur, wr, wc, fr, fq, lds, wid, lane); S.done(cur); }
#undef PG8_SA
#undef PG8_SB
#undef PG8_STAGE
#undef PG8_LDA
#undef PG8_LDB
#undef PG8_MMA
#undef PG8_WAIT_V
#undef PG8_WAIT_L
#undef PG8_BAR
#undef PG8_SCHED
}
}
namespace attn_body {
using bf16=__hip_bfloat16;
using bf16x8=__attribute__((ext_vector_type(8)))short;
using s16x4=__attribute__((ext_vector_type(4)))short;
using f32x16=__attribute__((ext_vector_type(16)))float;
using u32x4=__attribute__((ext_vector_type(4)))unsigned;
constexpr int D=64;
constexpr int NW=8,QBLK=32,QB=QBLK*NW,KVBLK=64;
constexpr int ATTN_UNIT_ROWS=QB;
__device__ __forceinline__ int crow(int r,int hi){return (r&3)+8*(r>>2)+4*hi;}
#define SBAR() __builtin_amdgcn_sched_barrier(0)
__device__ __forceinline__ void cmask(f32x16&p0,f32x16&p1,int jb,int qrel,int hi){
  const float NEG=-INFINITY; int kb=64*jb+4*hi;
  #pragma unroll
  for(int r=0;r<16;++r){int kv=kb+(r&3)+8*(r>>2); if(kv>qrel)p0[r]=NEG; if(kv+32>qrel)p1[r]=NEG;}
}

constexpr int NSLOT=3, SLOTB=8192;
constexpr int LDS_K=0, LDS_V=NSLOT*SLOTB, LDS_WS=2*NSLOT*SLOTB, LDS_OST=LDS_WS+NW*64*4, LDS_BYTES=LDS_OST+NW*4096;
constexpr float C2=0.125f*1.4426950408889634f;
__device__ __forceinline__ void glds16(const void*gsrc,unsigned lds_dst){unsigned keep;
  asm volatile("s_mov_b32 %0, m0\n\ts_mov_b32 m0, %2\n\ts_nop 0\n\tglobal_load_lds_dwordx4 %1, off\n\ts_mov_b32 m0, %0":"=&s"(keep):"v"(gsrc),"s"(lds_dst):"memory");}
__device__ __forceinline__ float max3f(float a,float b,float c){float r;asm("v_max3_f32 %0, %1, %2, %3":"=v"(r):"v"(a),"v"(b),"v"(c));return r;}
__device__ __forceinline__ float max2f(float a,float b){float r;asm("v_max_f32_e32 %0, %1, %2":"=v"(r):"v"(a),"v"(b));return r;}
__device__ __forceinline__ float fadd_s(float a,float b){float r;asm("v_add_f32_e32 %0, %1, %2":"=v"(r):"v"(a),"v"(b));return r;}
__device__ __forceinline__ float fsub_s(float a,float b){float r;asm("v_sub_f32_e32 %0, %1, %2":"=v"(r):"v"(a),"v"(b));return r;}
typedef float f32x2_t __attribute__((ext_vector_type(2))); typedef __bf16 bf16x2_t __attribute__((ext_vector_type(2)));
__device__ __forceinline__ unsigned cvtpk_s(float lo,float hi){f32x2_t v={lo,hi};bf16x2_t b=__builtin_convertvector(v,bf16x2_t);return __builtin_bit_cast(unsigned,b);}
#define WAIT_BAR(N) asm volatile("s_waitcnt vmcnt(" #N ") lgkmcnt(0)\n\ts_barrier":::"memory")

__device__ __forceinline__ void qkt(f32x16&p0,f32x16&p1,const char*Kslot,const bf16x8*qr,const f32x16&negm,int r32,int hi){
  const char*kb=Kslot+hi*1024+r32*16;
  #pragma unroll
  for(int d0=0;d0<4;++d0){
    const bf16x8 b0=*reinterpret_cast<const bf16x8*>(kb+d0*2048);
    const bf16x8 b1=*reinterpret_cast<const bf16x8*>(kb+d0*2048+512);
    if(d0==0){p0=__builtin_amdgcn_mfma_f32_32x32x16_bf16(b0,qr[0],negm,0,0,0);p1=__builtin_amdgcn_mfma_f32_32x32x16_bf16(b1,qr[0],negm,0,0,0);}
    else{p0=__builtin_amdgcn_mfma_f32_32x32x16_bf16(b0,qr[d0],p0,0,0,0);p1=__builtin_amdgcn_mfma_f32_32x32x16_bf16(b1,qr[d0],p1,0,0,0);}}
}
typedef __attribute__((address_space(3))) const char* lds_cptr;
typedef short v4i16_t __attribute__((ext_vector_type(4)));
__device__ __forceinline__ void kload8(bf16x8*kf,lds_cptr kp){
  kf[0]=*(const __attribute__((address_space(3))) bf16x8*)(kp);      kf[1]=*(const __attribute__((address_space(3))) bf16x8*)(kp+512);
  kf[2]=*(const __attribute__((address_space(3))) bf16x8*)(kp+2048); kf[3]=*(const __attribute__((address_space(3))) bf16x8*)(kp+2560);
  kf[4]=*(const __attribute__((address_space(3))) bf16x8*)(kp+4096); kf[5]=*(const __attribute__((address_space(3))) bf16x8*)(kp+4608);
  kf[6]=*(const __attribute__((address_space(3))) bf16x8*)(kp+6144); kf[7]=*(const __attribute__((address_space(3))) bf16x8*)(kp+6656);
}
__device__ __forceinline__ void kload2(bf16x8*kf,lds_cptr kp,int j){ kf[2*j]=*(const __attribute__((address_space(3))) bf16x8*)(kp+j*2048); kf[2*j+1]=*(const __attribute__((address_space(3))) bf16x8*)(kp+j*2048+512); }
__device__ __forceinline__ s16x4 vtr(lds_cptr p){ return __builtin_bit_cast(s16x4,__builtin_amdgcn_ds_read_tr16_b64_v4i16((__attribute__((address_space(3))) v4i16_t*)p)); }
__device__ __forceinline__ float rowmax(const f32x16&p0,const f32x16&p1){
  float a=max3f(p0[0],p0[1],p1[0]),b=max3f(p0[2],p0[3],p1[1]);a=max3f(a,p1[2],p1[3]);
  #pragma unroll
  for(int r=4;r<16;r+=4){a=max3f(a,p0[r],p0[r+1]);b=max3f(b,p0[r+2],p0[r+3]);a=max3f(a,p1[r],p1[r+1]);b=max3f(b,p1[r+2],p1[r+3]);}
  const float m=max2f(a,b);
  auto rr=__builtin_amdgcn_permlane32_swap(__float_as_uint(m),__float_as_uint(m),false,false);
  return max2f(__uint_as_float(rr[0]),__uint_as_float(rr[1]));
}
__device__ __forceinline__ void pv(f32x16*o,int vb,bf16x8 pa0,bf16x8 pa1,bf16x8 pa2,bf16x8 pa3){
  #pragma unroll
  for(int d0=0;d0<2;++d0){s16x4 lo[4],hi[4];
    #pragma unroll
    for(int ks=0;ks<4;++ks){
      asm volatile("ds_read_b64_tr_b16 %0,%1 offset:%c2":"=&v"(lo[ks]):"v"(vb),"i"(d0*4096+ks*1024):"memory");
      asm volatile("ds_read_b64_tr_b16 %0,%1 offset:%c2":"=&v"(hi[ks]):"v"(vb),"i"(d0*4096+ks*1024+512):"memory");}
    asm volatile("s_waitcnt lgkmcnt(0)":::"memory");SBAR();
    #define PK(k) (bf16x8){lo[k][0],lo[k][1],lo[k][2],lo[k][3],hi[k][0],hi[k][1],hi[k][2],hi[k][3]}
    o[d0]=__builtin_amdgcn_mfma_f32_32x32x16_bf16(pa0,PK(0),o[d0],0,0,0);
    o[d0]=__builtin_amdgcn_mfma_f32_32x32x16_bf16(pa1,PK(1),o[d0],0,0,0);
    o[d0]=__builtin_amdgcn_mfma_f32_32x32x16_bf16(pa2,PK(2),o[d0],0,0,0);
    o[d0]=__builtin_amdgcn_mfma_f32_32x32x16_bf16(pa3,PK(3),o[d0],0,0,0);
    #undef PK
  }
}

#ifndef ATTN_STORE16
#define ATTN_STORE16(p,v) (*(u32x4*)(p)=(v))
#endif
template<int THRL,int PIN,int POUT> __device__ __forceinline__ void attn_unit(int qb,const bf16*Qh,const bf16*__restrict__ Kh,const bf16*__restrict__ Vh,bf16*Oh,char*shm,const int wid_in){
  constexpr int DM=PIN;
  int lane; asm volatile("v_mbcnt_lo_u32_b32 %0, -1, 0\n\tv_mbcnt_hi_u32_b32 %0, -1, %0" : "=v"(lane));
  const int wid=wid_in; const int tid=wid*64+lane; const int r32=lane&31,hi=lane>>5;
  const int q0=qb*QB;
  const bf16*Qw=Qh+(long)(q0+wid*QBLK)*DM;
  const unsigned lds0=(unsigned)(uintptr_t)shm;
  float*wsf=(float*)(shm+LDS_WS)+wid*64;
  const bf16*ksrc=Kh+(long)lane*DM+wid*8;
  const bf16*vsrc=Vh+(long)(16*(wid&3)+(lane>>2))*DM+(wid>>2)*32+(lane&3)*8;
  const unsigned kdst=lds0+LDS_K+wid*1024, vdst=lds0+LDS_V+wid*1024;
  #define DMA_K(t,slot) glds16(ksrc+(long)(t)*KVBLK*DM,(unsigned)__builtin_amdgcn_readfirstlane(kdst+(slot)))
  #define DMA_V(t,slot) glds16(vsrc+(long)(t)*KVBLK*DM,(unsigned)__builtin_amdgcn_readfirstlane(vdst+(slot)))
  const int vb0=(int)(lds0+LDS_V)+((lane>>4)&1)*32+(lane&3)*8+(4*hi+((lane&15)>>2))*64;
  const char*Kbase=shm+LDS_K; bf16x8 kf[8];
  const lds_cptr shm3=(lds_cptr)shm; const lds_cptr kp0=shm3+LDS_K+hi*1024+r32*16; const lds_cptr vp0=shm3+LDS_V+((lane>>4)&1)*32+(lane&3)*8+(4*hi+((lane&15)>>2))*64;
  const int NT=(q0+QB)/KVBLK;
  DMA_K(0,0);DMA_V(0,0);DMA_K(1,SLOTB);
  bf16x8 qr[4];
  #pragma unroll
  for(int d0=0;d0<4;++d0)qr[d0]=*reinterpret_cast<const bf16x8*>(&Qw[(long)r32*DM+d0*16+hi*8]);
  float mhat=0.f,l_reg=0.f;f32x16 o[2];f32x16 negm;{float z0_=0.f;asm volatile("":"+v"(z0_));
  #pragma unroll
  for(int r=0;r<16;++r){o[0][r]=z0_;o[1][r]=z0_;negm[r]=z0_;}}asm volatile("":"+v"(negm));
  const int qrel=wid*QBLK+r32;
  #define CMASK(P0,P1,t) do{int jb_=(t)-(NT-4); if(jb_>=0)cmask(P0,P1,jb_,qrel,hi);}while(0)
  bool resc=false;
  #define START(P0,P1) do{ const float rm=rowmax(P0,P1); resc=false; \
    { const float dl=rm; mhat=fadd_s(mhat,dl); \
      _Pragma("unroll") for(int r=0;r<16;++r){P0[r]=fsub_s(P0[r],dl);P1[r]=fsub_s(P1[r],dl);} \
      _Pragma("unroll") for(int r=0;r<16;++r)negm[r]=-mhat; asm volatile("":"+v"(negm)); } \
    _Pragma("unroll") for(int r=0;r<16;++r)P0[r]=__builtin_amdgcn_exp2f(P0[r]); }while(0)
  #define RESC() do{ if(resc){ asm volatile("s_waitcnt lgkmcnt(0)":::"memory"); \
      _Pragma("unroll") for(int d_=0;d_<2;++d_) _Pragma("unroll") for(int r=0;r<16;++r)o[d_][r]*=wsf[crow(r,hi)]; } }while(0)
  f32x16 pA0,pA1,pB0,pB1;
  int sl_prev=0,sl_cur=0,sl_next=SLOTB;
  #define ROT() do{sl_prev=sl_cur;sl_cur=sl_next;sl_next=(sl_next==(NSLOT-1)*SLOTB)?0:sl_next+SLOTB;}while(0)
  DMA_K(2,2*SLOTB);
  WAIT_BAR(3);
  qkt(pA0,pA1,Kbase,qr,negm,r32,hi);asm volatile("s_nop 15\n\ts_nop 7":"+v"(pA0),"+v"(pA1));CMASK(pA0,pA1,0);
  START(pA0,pA1);
  _Pragma("unroll") for(int r=0;r<16;++r)pA1[r]=__builtin_amdgcn_exp2f(pA1[r]);
  WAIT_BAR(0);
  DMA_K(3,0);DMA_V(1,SLOTB);
  ROT();
  kload8(kf,kp0+sl_cur);
  WAIT_BAR(2);
  s16x4 vlo[8],vhi[8]; u32x4 pw0,pw1,pw2,pw3;
  #define PKW(P,B) cvtpk_s(P[B],P[B+1])
  #define PAF(k) __builtin_bit_cast(bf16x8,pw##k)
  #define VFR(i) (bf16x8){vlo[i][0],vlo[i][1],vlo[i][2],vlo[i][3],vhi[i][0],vhi[i][1],vhi[i][2],vhi[i][3]}
  #define PIN(x) asm volatile("":"+v"(x))
  #define MX3(a,b,c) __builtin_fmaxf(__builtin_fmaxf((a),(b)),(c))
  #define GAPA(MF,A0,A1,A2,A3,W0,W1,PW) do{ MF; sacc+=A0; sacc+=A1; sacc+=A2; sacc+=A3; PIN(sacc); W0; W1; PIN(PW); SBAR(); }while(0)
  #define EX(v) __builtin_amdgcn_exp2f(v)
  #define GAPB(MF,X,B) do{ MF; X[B]=EX(X[B]); X[B+1]=EX(X[B+1]); X[B+2]=EX(X[B+2]); X[B+3]=EX(X[B+3]); PIN(X); SBAR(); }while(0)
  #define VRD(i) do{ vlo[i]=vtr(vp_+(((i)>>2)*4096+((i)&3)*1024)); vhi[i]=vtr(vp_+(((i)>>2)*4096+((i)&3)*1024+512)); }while(0)
  #define KRD(G,j) do{ if(G){ kload2(kf,kp0+sl_next,j); SBAR(); } }while(0)
  #define STEP(C0,C1,P0,P1,t,GK,GV,GL) do{ SBAR(); \
    const lds_cptr vp_=vp0+sl_prev; \
    VRD(0); SBAR(); float sacc=(P0[0]+P0[1]); \
    GAPA(C0=__builtin_amdgcn_mfma_f32_32x32x16_bf16(kf[0],qr[0],negm,0,0,0), P0[2],P0[3],P0[4],P0[5],     pw0[0]=PKW(P0,0), pw0[1]=PKW(P0,2), pw0); \
    VRD(4); SBAR(); GAPA(C1=__builtin_amdgcn_mfma_f32_32x32x16_bf16(kf[1],qr[0],negm,0,0,0), P0[6],P0[7],P0[8],P0[9],     pw0[2]=PKW(P0,4), pw0[3]=PKW(P0,6), pw0); \
    VRD(1); SBAR(); GAPA(C0=__builtin_amdgcn_mfma_f32_32x32x16_bf16(kf[2],qr[1],C0,0,0,0),   P0[10],P0[11],P0[12],P0[13], pw1[0]=PKW(P0,8), pw1[1]=PKW(P0,10), pw1); \
    VRD(5); SBAR(); GAPA(C1=__builtin_amdgcn_mfma_f32_32x32x16_bf16(kf[3],qr[1],C1,0,0,0),   P0[14],P0[15],P1[0],P1[1],   pw1[2]=PKW(P0,12),pw1[3]=PKW(P0,14), pw1); \
    VRD(2); SBAR(); GAPA(C0=__builtin_amdgcn_mfma_f32_32x32x16_bf16(kf[4],qr[2],C0,0,0,0),   P1[2],P1[3],P1[4],P1[5],     pw2[0]=PKW(P1,0), pw2[1]=PKW(P1,2), pw2); \
    VRD(6); SBAR(); GAPA(C1=__builtin_amdgcn_mfma_f32_32x32x16_bf16(kf[5],qr[2],C1,0,0,0),   P1[6],P1[7],P1[8],P1[9],     pw2[2]=PKW(P1,4), pw2[3]=PKW(P1,6), pw2); \
    VRD(3); SBAR(); GAPA(C0=__builtin_amdgcn_mfma_f32_32x32x16_bf16(kf[6],qr[3],C0,0,0,0),   P1[10],P1[11],P1[12],P1[13], pw3[0]=PKW(P1,8), pw3[1]=PKW(P1,10), pw3); \
    VRD(7); SBAR(); GAPA(C1=__builtin_amdgcn_mfma_f32_32x32x16_bf16(kf[7],qr[3],C1,0,0,0),   P1[14],P1[15],0.f,0.f,       pw3[2]=PKW(P1,12),pw3[3]=PKW(P1,14), pw3); \
    l_reg+=sacc; \
    if(GK){DMA_K((t)+3,sl_cur);} if(GV){DMA_V((t)+1,sl_next);} \
    CMASK(C0,C1,t); \
    { float a=MX3(C0[0],C0[1],C1[0]),b=MX3(C0[2],C0[3],C1[1]); a=MX3(a,C1[2],C1[3]); \
      _Pragma("unroll") for(int r=4;r<16;r+=4){a=MX3(a,C0[r],C0[r+1]);b=MX3(b,C0[r+2],C0[r+3]);a=MX3(a,C1[r],C1[r+1]);b=MX3(b,C1[r+2],C1[r+3]);} \
      float rm=__builtin_fmaxf(a,b); { auto rr=__builtin_amdgcn_permlane32_swap(__float_as_uint(rm),__float_as_uint(rm),false,false); rm=__builtin_fmaxf(__uint_as_float(rr[0]),__uint_as_float(rr[1])); } \
      resc=false; \
      if(__builtin_expect(__any(rm>(float)THRL),0)){ const float dl=__builtin_fmaxf(rm,0.f); mhat+=dl; \
        _Pragma("unroll") for(int r=0;r<16;++r){C0[r]-=dl;C1[r]-=dl;} \
        _Pragma("unroll") for(int r=0;r<16;++r)negm[r]=-mhat; asm volatile("":"+v"(negm)); \
        const float f=__builtin_amdgcn_exp2f(-dl); l_reg*=f; if(hi==0)wsf[r32]=f; resc=true; } } \
    SBAR(); \
    GAPB(o[0]=__builtin_amdgcn_mfma_f32_32x32x16_bf16(PAF(0),VFR(0),o[0],0,0,0), C0,0); \
    GAPB(o[1]=__builtin_amdgcn_mfma_f32_32x32x16_bf16(PAF(0),VFR(4),o[1],0,0,0), C0,4); \
    KRD(GL,0); GAPB(o[0]=__builtin_amdgcn_mfma_f32_32x32x16_bf16(PAF(1),VFR(1),o[0],0,0,0), C0,8); \
    KRD(GL,1); GAPB(o[1]=__builtin_amdgcn_mfma_f32_32x32x16_bf16(PAF(1),VFR(5),o[1],0,0,0), C0,12); \
    KRD(GL,2); GAPB(o[0]=__builtin_amdgcn_mfma_f32_32x32x16_bf16(PAF(2),VFR(2),o[0],0,0,0), C1,0); \
    KRD(GL,3); GAPB(o[1]=__builtin_amdgcn_mfma_f32_32x32x16_bf16(PAF(2),VFR(6),o[1],0,0,0), C1,4); \
    GAPB(o[0]=__builtin_amdgcn_mfma_f32_32x32x16_bf16(PAF(3),VFR(3),o[0],0,0,0), C1,8); \
    GAPB(o[1]=__builtin_amdgcn_mfma_f32_32x32x16_bf16(PAF(3),VFR(7),o[1],0,0,0), C1,12); \
    }while(0)
  int t=1;
  #undef CMASK
  #define CMASK(P0,P1,t) do{}while(0)
  for(;t+5<NT;t+=2){
    STEP(pB0,pB1,pA0,pA1,t,true,true,true);     WAIT_BAR(2); RESC(); ROT();
    STEP(pA0,pA1,pB0,pB1,t+1,true,true,true);   WAIT_BAR(2); RESC(); ROT();
  }
  #undef CMASK
  #define CMASK(P0,P1,t) do{int jb_=(t)-(NT-4); if(jb_>=0)cmask(P0,P1,jb_,qrel,hi);}while(0)
  #define ENDW(tt) do{ if((tt)+3<NT){WAIT_BAR(2);} else if((tt)+2<NT){WAIT_BAR(1);} else {WAIT_BAR(0);} }while(0)
  for(;t+1<NT;t+=2){
    STEP(pB0,pB1,pA0,pA1,t,(t+3<NT),(t+1<NT),(t+1<NT));       ENDW(t);   RESC(); ROT();
    STEP(pA0,pA1,pB0,pB1,t+1,(t+4<NT),(t+2<NT),(t+2<NT));     ENDW(t+1); RESC(); ROT();
  }
  STEP(pB0,pB1,pA0,pA1,NT-1,false,false,false); RESC();
  { float sacc=pB0[0]+pB0[1]; _Pragma("unroll") for(int r=2;r<16;++r)sacc+=pB0[r]; _Pragma("unroll") for(int r=0;r<16;++r)sacc+=pB1[r]; l_reg+=sacc;
    pw0=(u32x4){PKW(pB0,0),PKW(pB0,2),PKW(pB0,4),PKW(pB0,6)};pw1=(u32x4){PKW(pB0,8),PKW(pB0,10),PKW(pB0,12),PKW(pB0,14)};pw2=(u32x4){PKW(pB1,0),PKW(pB1,2),PKW(pB1,4),PKW(pB1,6)};pw3=(u32x4){PKW(pB1,8),PKW(pB1,10),PKW(pB1,12),PKW(pB1,14)};
    SBAR(); pv(o,vb0+sl_cur,PAF(0),PAF(1),PAF(2),PAF(3)); }
  #undef PKW
  #undef PAF
  #undef VFR
  #undef PIN
  #undef MX3
  #undef GAPA
  #undef GAPB
  #undef EX
  #undef VRD
  #undef KRD
  #undef STEP
  #undef ENDW
  {auto rr=__builtin_amdgcn_permlane32_swap(__float_as_uint(l_reg),__float_as_uint(l_reg),false,false);l_reg=__uint_as_float(rr[0])+__uint_as_float(rr[1]);}
  if(hi==0)wsf[32+r32]=l_reg;asm volatile("s_waitcnt lgkmcnt(0)":::"memory");
  float rli[16];
  #pragma unroll
  for(int r=0;r<16;++r)rli[r]=__builtin_amdgcn_rcpf(wsf[32+crow(r,hi)]);
  bf16*Ow=Oh+(long)(q0+wid*QBLK)*POUT;
  { bf16*stg=(bf16*)(shm+LDS_OST)+wid*2048;
    #pragma unroll
    for(int r=0;r<16;++r){const int orow=crow(r,hi);
      #pragma unroll
      for(int d0=0;d0<2;++d0)stg[orow*64+d0*32+r32]=__float2bfloat16(o[d0][r]*rli[r]);}
    asm volatile("s_waitcnt lgkmcnt(0)":::"memory");
    #pragma unroll
    for(int i=0;i<4;++i){const int row=i*8+(lane>>3),ch=lane&7; const u32x4 v=*(const u32x4*)(stg+row*64+ch*8); ATTN_STORE16(Ow+(long)row*POUT+ch*8,v);} }
  asm volatile("s_waitcnt lgkmcnt(0)\n\ts_barrier":::"memory");
  #undef DMA_K
  #undef DMA_V
  #undef CMASK
  #undef START
  #undef RESC
  #undef ROT
}
constexpr int ATTN_LDS_BYTES=LDS_BYTES;
#undef SBAR
#undef WAIT_BAR
}

#define LAS __attribute__((address_space(3)))
typedef unsigned short bf16_t;
typedef float f32x4 __attribute__((ext_vector_type(4)));
typedef unsigned u32x4 __attribute__((ext_vector_type(4)));
typedef unsigned u32x2 __attribute__((ext_vector_type(2)));
typedef float f32x2 __attribute__((ext_vector_type(2)));
typedef _Float16 f16x8 __attribute__((ext_vector_type(8)));
typedef _Float16 f16x4 __attribute__((ext_vector_type(4)));

constexpr int NB = 2, S = 16384, T = NB * S, D = 1024, DEPTH = 4;
constexpr int EV_N = 3368, EV_NP = 3584, EV_ZP = 3072, OD_N = 2048;
constexpr float EPS = 1e-6f;
constexpr float LOG2E = 1.4426950408889634f;
constexpr float QSCALE = 0.125f * LOG2E;
constexpr int NWAVES = 8, NTHREADS = 512;
constexpr int LDS_BYTES = 163840;
constexpr int LDS_MISC = 131072;
constexpr int LDS_BARW = LDS_BYTES - 64;
constexpr int LDS_PTBL = LDS_BYTES - 512;

constexpr size_t MiB = 1u << 20;
constexpr size_t WS_CTL = 0, CTL_ZERO_BYTES = 1 * MiB;
constexpr size_t WS_MOD = 1 * MiB;
constexpr size_t WS_MODP = 1 * MiB + 256 * 1024;
constexpr size_t WS_ROPE = 2 * MiB;
constexpr size_t WS_S5A = 4 * MiB;
constexpr size_t WS_S5B = 4 * MiB + 64 * 1024;
constexpr size_t WS_LAM = 6 * MiB;
constexpr size_t WS_KM = 6 * MiB + 4096;
constexpr size_t WS_WRH = 6 * MiB + 512 * 1024;
constexpr size_t WS_KMH = 7 * MiB + 512 * 1024;
constexpr size_t WS_WEVIN = 8 * MiB;
constexpr size_t WS_WEVOUT = 22 * MiB;
constexpr size_t WS_WODIN = 26 * MiB;
constexpr size_t WS_WODOUT = 34 * MiB;
constexpr size_t WS_WGLU = 38 * MiB;
constexpr size_t WS_W13 = 40 * MiB;
constexpr size_t WS_W2 = 104 * MiB;
constexpr size_t WS_H = 136 * MiB;
constexpr size_t WS_O = 200 * MiB;
constexpr size_t WS_Z = 264 * MiB;
constexpr size_t WS_XG = 264 * MiB;
constexpr size_t WS_Y = 264 * MiB;
constexpr size_t WS_HID = 408 * MiB;
constexpr size_t WS_IQ = 456 * MiB;
constexpr size_t WS_YG = 456 * MiB;
constexpr size_t WS_IKW = 488 * MiB;
constexpr size_t WS_IQH = 496 * MiB;
constexpr size_t WS_IKH = 512 * MiB;
constexpr size_t WS_IW = 514 * MiB;
constexpr size_t WS_SEL = 516 * MiB;
constexpr size_t WS_YMIX = 548 * MiB;
constexpr size_t WS_LTOK = 612 * MiB;
constexpr size_t WS_TOKES = 616 * MiB;
constexpr size_t WS_TOKW = 617 * MiB;
constexpr size_t WS_TOKROW = 618 * MiB;
constexpr size_t WS_UG = 516 * MiB;
constexpr size_t WS_S5E = 496 * MiB;
constexpr size_t WS_S5HC = 488 * MiB;
constexpr size_t WS_S5KT = 620 * MiB;
constexpr size_t WS_S5WT = 624 * MiB;
constexpr size_t WS_S5A2 = 640 * MiB;
constexpr size_t WS_S5PW = 656 * MiB;
constexpr size_t WS_MLIST = 660 * MiB;
constexpr size_t WS_MPO = 724 * MiB;
constexpr size_t WS_MML = 852 * MiB;
constexpr size_t WS_MASKW = 724 * MiB;
constexpr size_t WS_NSEL = 860 * MiB;
constexpr size_t WS_XB = 862 * MiB;
constexpr size_t WS_END = 926 * MiB;
constexpr int XG_ROWS = 73728;
constexpr int CW_BAR = 4096;
constexpr int CW_MCNT = 16384;
constexpr int CW_CNT = 8192;

#define XB_TMO      128
#define XB_XCNT(j)  (256  + 64 * (j))
#define XB_XSUB(j)  (1280 + 64 * (j))
#define XB_XGEN(j)  (2304 + 64 * (j))
#define XB_TOP      3328
#define XB_TOPGEN   3392
#define XCD_BAR_WORDS 3456
#define XB_SPIN_CAP (1u << 24)

__device__ __forceinline__ unsigned xb_ld(unsigned* p)              { return __hip_atomic_load(p, __ATOMIC_RELAXED, __HIP_MEMORY_SCOPE_AGENT); }
__device__ __forceinline__ unsigned xb_add(unsigned* p, unsigned v) { return __hip_atomic_fetch_add(p, v, __ATOMIC_RELAXED, __HIP_MEMORY_SCOPE_AGENT); }
__device__ __forceinline__ unsigned xb_xcc_id() { return (unsigned)__builtin_amdgcn_s_getreg((3 << 11) | 20) & 0xFu; }
#define XB_SPIN(cond, bar) do { unsigned _sp = 0; while (cond) { __builtin_amdgcn_s_sleep(1); \
    if ((++_sp & 255u) == 0u) { if (xb_ld(&(bar)[XB_TMO])) break; if (_sp > XB_SPIN_CAP) { atomicAdd(&(bar)[XB_TMO], 1u); break; } } } } while (0)

struct XcdBarrier { unsigned* bar; unsigned x; volatile LAS unsigned* st; };

__device__ __forceinline__ XcdBarrier xcd_barrier_post(unsigned* bar, volatile LAS unsigned* st, bool leader) {
    XcdBarrier b; b.bar = bar; b.x = xb_xcc_id(); b.st = st;
    if (leader) (void)xb_add(&bar[XB_XCNT(b.x)], 1u);
    return b;
}
__device__ __forceinline__ void xcd_barrier_complete(unsigned* bar, unsigned x, unsigned& nloc, unsigned& nx) {
    const unsigned G = gridDim.x * gridDim.y * gridDim.z;
    unsigned sum, cnt, mine, sp = 0u;
    for (;;) {
        sum = 0u; cnt = 0u; mine = 0u;
#pragma unroll
        for (unsigned j = 0; j < 16; ++j) { const unsigned c = xb_ld(&bar[XB_XCNT(j)]); sum += c; cnt += (c > 0u) ? 1u : 0u; mine = (j == x) ? c : mine; }
        if (sum == G) break;
        __builtin_amdgcn_s_sleep(1);
        if ((++sp & 255u) == 0u) { if (xb_ld(&bar[XB_TMO])) break; if (sp > XB_SPIN_CAP) { atomicAdd(&bar[XB_TMO], 1u); break; } }
    }
    nloc = mine > 0u ? mine : 1u; nx = cnt > 0u ? cnt : 1u;
}
__device__ __forceinline__ void xcd_barrier(const XcdBarrier& b, bool leader) {
    asm volatile("s_waitcnt vmcnt(0)" ::: "memory");
    __syncthreads();
    if (leader) {
        unsigned* bar = b.bar;
        __builtin_amdgcn_s_waitcnt(0);
        unsigned nloc = b.st[0], nx = b.st[1];
        if (nloc == 0u) { xcd_barrier_complete(bar, b.x, nloc, nx); b.st[0] = nloc; b.st[1] = nx; }
        const unsigned old = xb_add(&bar[XB_XSUB(b.x)], 1u);
        const unsigned gen = old / nloc;
        if (old + 1u == (gen + 1u) * nloc) {
            __builtin_amdgcn_fence(__ATOMIC_RELEASE, "agent");
            asm volatile("s_waitcnt vmcnt(0)" ::: "memory");
            const unsigned og = xb_add(&bar[XB_TOP], 1u);
            const unsigned tg = og / nx;
            if (og + 1u == (tg + 1u) * nx) xb_add(&bar[XB_TOPGEN], 1u);
            else XB_SPIN(xb_ld(&bar[XB_TOPGEN]) == tg, bar);
            __builtin_amdgcn_fence(__ATOMIC_ACQUIRE, "agent");
            xb_add(&bar[XB_XGEN(b.x)], 1u);
            asm volatile("s_waitcnt vmcnt(0)" ::: "memory");
        } else {
            XB_SPIN(xb_ld(&bar[XB_XGEN(b.x)]) == gen, bar);
            __builtin_amdgcn_fence(__ATOMIC_ACQUIRE, "agent");
            asm volatile("s_waitcnt vmcnt(0)" ::: "memory");
        }
    }
    __syncthreads();
}

#define LDS_WAIT() asm volatile("s_waitcnt lgkmcnt(0)" ::: "memory")
__device__ __forceinline__ float bflo(unsigned w) { return __uint_as_float(w << 16); }
__device__ __forceinline__ float bfhi(unsigned w) { return __uint_as_float(w & 0xffff0000u); }
__device__ __forceinline__ unsigned pk2(float lo, float hi) { typedef float f32x2_ __attribute__((ext_vector_type(2))); typedef __bf16 bf16x2_ __attribute__((ext_vector_type(2))); const f32x2_ v = {lo, hi}; return __builtin_bit_cast(unsigned, __builtin_convertvector(v, bf16x2_)); }
__device__ __forceinline__ unsigned f2bf(float f) { return pk2(f, 0.f) & 0xffffu; }
__device__ __forceinline__ float shx_(float v, int m, int lane) { return __int_as_float(__builtin_amdgcn_ds_bpermute((lane ^ m) << 2, __float_as_int(v))); }
__device__ __forceinline__ unsigned shi_(unsigned v, int src) { return (unsigned)__builtin_amdgcn_ds_bpermute(src << 2, (int)v); }
#define SHX(v, m) shx_((v), (m), lane)
__device__ __forceinline__ float dpp_xor1(float v) { return __int_as_float(__builtin_amdgcn_update_dpp(0, __float_as_int(v), 0xB1, 0xF, 0xF, true)); }
__device__ __forceinline__ float dpp_xor2(float v) { return __int_as_float(__builtin_amdgcn_update_dpp(0, __float_as_int(v), 0x4E, 0xF, 0xF, true)); }
__device__ __forceinline__ float half_sum(float v) { const auto r = __builtin_amdgcn_permlane32_swap(__float_as_uint(v), __float_as_uint(v), false, false); return __uint_as_float(r[0]) + __uint_as_float(r[1]); }
__device__ __forceinline__ float half_max(float v) { const auto r = __builtin_amdgcn_permlane32_swap(__float_as_uint(v), __float_as_uint(v), false, false); return fmaxf(__uint_as_float(r[0]), __uint_as_float(r[1])); }
__device__ __forceinline__ float wave_sum_(float v, int lane) {
    v += dpp_xor1(v); v += dpp_xor2(v); v += shx_(v, 4, lane); v += shx_(v, 8, lane); v += shx_(v, 16, lane); return half_sum(v);
}

#define wave_sum(v) wave_sum_((v), lane)
__device__ __forceinline__ float wave_max_(float v, int lane) {
#pragma unroll
    for (int o = 1; o < 64; o <<= 1) v = fmaxf(v, shx_(v, o, lane));
    return v;
}
__device__ __forceinline__ bool qk_bounded(const float* gq, const float* gk, int lane) {
    const float a = wave_max_(fabsf(gq[lane]), lane), b = wave_max_(fabsf(gk[lane]), lane);
    return 64.0f * QSCALE * a * b <= 60.0f;
}
__device__ __forceinline__ void unpack8(const u32x4 w, float (&v)[8]) {
    v[0] = bflo(w.x); v[1] = bfhi(w.x); v[2] = bflo(w.y); v[3] = bfhi(w.y); v[4] = bflo(w.z); v[5] = bfhi(w.z); v[6] = bflo(w.w); v[7] = bfhi(w.w);
}
__device__ __forceinline__ u32x4 pack8(const float (&v)[8]) { u32x4 w; w.x = pk2(v[0], v[1]); w.y = pk2(v[2], v[3]); w.z = pk2(v[4], v[5]); w.w = pk2(v[6], v[7]); return w; }
__device__ __forceinline__ float gelu_tanh(float y) {
    const float z = 0.7978845608028654f * (y + 0.044715f * y * y * y);
    const float e = __builtin_amdgcn_exp2f(2.885390081777927f * z);
    const float th = 1.0f - 2.0f * __builtin_amdgcn_rcpf(e + 1.0f);
    return 0.5f * y * (1.0f + th);
}
__device__ __forceinline__ float sigmoidf_(float v) { return __builtin_amdgcn_rcpf(1.0f + __builtin_amdgcn_exp2f(-1.4426950408889634f * v)); }
__device__ __forceinline__ unsigned ordkey(float f) { const unsigned u = __float_as_uint(f); return u ^ ((unsigned)((int)u >> 31) | 0x80000000u); }

struct EpiPlain {
    static constexpr bool PERM = true, AFTER_DRAIN = false;
    bf16_t* O; int ldc;
    __device__ __forceinline__ void operator()(const pg8::f32x4 (&acc)[2][2][4][2], const pg8::Unit& u, int wr, int wc, int fr, int fq) const {
        const int row0 = u.pm * 256 + wr * 64 + fr, col0 = u.pn * 256 + wc * 32 + 8 * fq;
#pragma unroll
        for (int ai = 0; ai < 2; ++ai)
#pragma unroll
            for (int m = 0; m < 4; ++m) { bf16_t* rowp = O + (size_t)(row0 + ai * 128 + m * 16) * ldc + col0;
#pragma unroll
                for (int bj = 0; bj < 2; ++bj) { const pg8::f32x4 v0 = acc[ai][bj][m][0], v1 = acc[ai][bj][m][1];
                    u32x4 w; w.x = pk2(v0[0], v0[1]); w.y = pk2(v0[2], v0[3]); w.z = pk2(v1[0], v1[1]); w.w = pk2(v1[2], v1[3]);
                    *(u32x4*)(rowp + bj * 128) = w; } }
    }
};
__device__ __forceinline__ void epi_khead(const pg8::f32x4 (&acc)[2][2][4][2], bf16_t* Z, int ldz, int colbase, const float* gain, const float* COSH, const float* SINH, int row0, int wc, int fr, int fq) {
    const int lane = fr + 16 * fq;
    float g[2][8];
#pragma unroll
    for (int bj = 0; bj < 2; ++bj)
#pragma unroll
        for (int e = 0; e < 8; ++e) g[bj][e] = gain[bj * 32 + 8 * fq + e];
#pragma unroll
    for (int ai = 0; ai < 2; ++ai)
#pragma unroll
      for (int mp = 0; mp < 4; mp += 2) {
        f32x4 csv[2][2], snv[2][2];
#pragma unroll
        for (int mm = 0; mm < 2; ++mm) { const int pos = (row0 + ai * 128 + (mp + mm) * 16) & (S - 1);
            csv[mm][0] = *(const f32x4*)(COSH + pos * 8); csv[mm][1] = *(const f32x4*)(COSH + pos * 8 + 4); snv[mm][0] = *(const f32x4*)(SINH + pos * 8); snv[mm][1] = *(const f32x4*)(SINH + pos * 8 + 4); }
        __builtin_amdgcn_sched_barrier(0);
#pragma unroll
        for (int mm = 0; mm < 2; ++mm) { const int m = mp + mm; const int row = row0 + ai * 128 + m * 16;
            float v[2][8]; float ss = 0.f;
#pragma unroll
            for (int bj = 0; bj < 2; ++bj)
#pragma unroll
                for (int e = 0; e < 4; ++e) { v[bj][e] = acc[ai][bj][m][0][e]; v[bj][4 + e] = acc[ai][bj][m][1][e]; ss += v[bj][e] * v[bj][e] + v[bj][4 + e] * v[bj][4 + e]; }
            ss += shx_(ss, 16, lane); ss = half_sum(ss);
            const float r = rsqrtf(ss * (1.0f / 64.0f) + EPS);
#pragma unroll
            for (int bj = 0; bj < 2; ++bj)
#pragma unroll
                for (int e = 0; e < 8; ++e) v[bj][e] *= r * g[bj][e];
#pragma unroll
            for (int e = 0; e < 8; ++e) { const float oth = shx_(v[0][e], 16, lane); const float cs = csv[mm][e >> 2][e & 3], sn = snv[mm][e >> 2][e & 3];
                if (fq == 0) v[0][e] = v[0][e] * cs - oth * sn; else if (fq == 1) v[0][e] = v[0][e] * cs + oth * sn; }
            bf16_t* zp = Z + (size_t)row * ldz + colbase + wc * 64 + 8 * fq;
            *(u32x4*)zp = pack8(v[0]); *(u32x4*)(zp + 32) = pack8(v[1]); }
        __builtin_amdgcn_sched_barrier(0);
      }
}
struct EpiEvenIn {
    static constexpr bool PERM = true, AFTER_DRAIN = false;
    bf16_t* Z; _Float16* IQH; _Float16* IKH; float* IW; const float* a_kn; const float* b_kn; const float* idx_kn; const float* COSH; const float* SINH; const float* COSI; const float* SINI;
    __device__ __forceinline__ void operator()(const pg8::f32x4 (&acc)[2][2][4][2], const pg8::Unit& u, int wr, int wc, int fr, int fq) const {
        const int row0 = u.pm * 256 + wr * 64 + fr; const int lane = fr + 16 * fq;
        if (u.pn == 2 || u.pn == 3) epi_khead(acc, Z, EV_ZP, 512 + (u.pn & 1) * 256, a_kn, COSH, SINH, row0, wc, fr, fq);
        else if (u.pn == 8 || u.pn == 9) epi_khead(acc, Z, EV_ZP, 2048 + (u.pn & 1) * 256, b_kn, COSH, SINH, row0, wc, fr, fq);
        else if (u.pn < 12) {
            const int col0 = u.pn * 256 + wc * 32 + 8 * fq;
#pragma unroll
            for (int ai = 0; ai < 2; ++ai)
#pragma unroll
                for (int m = 0; m < 4; ++m) { bf16_t* rowp = Z + (size_t)(row0 + ai * 128 + m * 16) * EV_ZP + col0;
#pragma unroll
                    for (int bj = 0; bj < 2; ++bj) { const pg8::f32x4 v0 = acc[ai][bj][m][0], v1 = acc[ai][bj][m][1];
                        u32x4 w; w.x = pk2(v0[0], v0[1]); w.y = pk2(v0[2], v0[3]); w.z = pk2(v1[0], v1[1]); w.w = pk2(v1[2], v1[3]);
                        *(u32x4*)(rowp + bj * 128) = w; } }
        } else if (u.pn == 12) {
#pragma unroll
            for (int ai = 0; ai < 2; ++ai) {
                f32x4 csr[4], snr[4];
#pragma unroll
                for (int m = 0; m < 4; ++m) { const int pos = (row0 + ai * 128 + m * 16) & (S - 1); csr[m] = *(const f32x4*)(COSI + pos * 4); snr[m] = *(const f32x4*)(SINI + pos * 4); }
                __builtin_amdgcn_sched_barrier(0);
#pragma unroll
                for (int m = 0; m < 4; ++m) { const int row = row0 + ai * 128 + m * 16;
                    const f32x4 cs = csr[m], sn = snr[m];
#pragma unroll
                    for (int bj = 0; bj < 2; ++bj) { pg8::f32x4 v0 = acc[ai][bj][m][0], v1 = acc[ai][bj][m][1];
                        if (fq == 0) { const pg8::f32x4 a0 = v0, a1 = v1;
#pragma unroll
                            for (int e = 0; e < 4; ++e) { v0[e] = a0[e] * cs[e] - a1[e] * sn[e]; v1[e] = a1[e] * cs[e] + a0[e] * sn[e]; } }
                        f16x8 hq;
#pragma unroll
                        for (int e = 0; e < 4; ++e) { hq[e] = (_Float16)v0[e]; hq[4 + e] = (_Float16)v1[e]; }
                        *(f16x8*)(IQH + (size_t)row * 256 + bj * 128 + wc * 32 + 8 * fq) = hq; } }
                __builtin_amdgcn_sched_barrier(0);
            }
        } else {
            if (wc == 0) {
                float g[8];
#pragma unroll
                for (int e = 0; e < 8; ++e) g[e] = idx_kn[8 * fq + e];
#pragma unroll
                for (int ai = 0; ai < 2; ++ai) {
                  f32x4 csr[4], snr[4];
#pragma unroll
                  for (int m = 0; m < 4; ++m) { const int pos = (row0 + ai * 128 + m * 16) & (S - 1); csr[m] = *(const f32x4*)(COSI + pos * 4); snr[m] = *(const f32x4*)(SINI + pos * 4); }
                  __builtin_amdgcn_sched_barrier(0);
#pragma unroll
                    for (int m = 0; m < 4; ++m) { const int row = row0 + ai * 128 + m * 16;
                        float v[8]; float ss = 0.f;
#pragma unroll
                        for (int e = 0; e < 4; ++e) { v[e] = acc[ai][0][m][0][e]; v[4 + e] = acc[ai][0][m][1][e]; ss += v[e] * v[e] + v[4 + e] * v[4 + e]; }
                        ss += shx_(ss, 16, lane); ss = half_sum(ss);
                        const float r = rsqrtf(ss * (1.0f / 32.0f) + EPS);
#pragma unroll
                        for (int e = 0; e < 8; ++e) v[e] *= r * g[e];
                        if (fq == 0) {
#pragma unroll
                            for (int e = 0; e < 4; ++e) { const float x1 = v[e], x2 = v[4 + e]; const float cs = csr[m][e], sn = snr[m][e]; v[e] = x1 * cs - x2 * sn; v[4 + e] = x2 * cs + x1 * sn; } }
                        f16x8 hk;
#pragma unroll
                        for (int e = 0; e < 8; ++e) hk[e] = (_Float16)v[e];
                        *(f16x8*)(IKH + (size_t)row * 32 + 8 * fq) = hk; }
                  __builtin_amdgcn_sched_barrier(0);
                }
            } else if (wc == 1 && fq == 0) {
#pragma unroll
                for (int ai = 0; ai < 2; ++ai)
#pragma unroll
                    for (int m = 0; m < 4; ++m) { float* wp = IW + (size_t)(row0 + ai * 128 + m * 16) * 8; *(pg8::f32x4*)wp = acc[ai][0][m][0]; *(pg8::f32x4*)(wp + 4) = acc[ai][0][m][1]; }
            }
        }
    }
};
struct EpiOddIn {
    static constexpr bool PERM = true, AFTER_DRAIN = false;
    bf16_t* Z; bf16_t* UG; const float* c_kn; const float* COSH; const float* SINH;
    __device__ __forceinline__ void operator()(const pg8::f32x4 (&acc)[2][2][4][2], const pg8::Unit& u, int wr, int wc, int fr, int fq) const {
        const int row0 = u.pm * 256 + wr * 64 + fr, col0 = u.pn * 256 + wc * 32 + 8 * fq;
        if (u.pn == 2 || u.pn == 3) { epi_khead(acc, Z, OD_N, 512 + (u.pn & 1) * 256, c_kn, COSH, SINH, row0, wc, fr, fq); return; }
#pragma unroll
        for (int ai = 0; ai < 2; ++ai)
#pragma unroll
            for (int m = 0; m < 4; ++m) { const size_t row = (size_t)(row0 + ai * 128 + m * 16);
#pragma unroll
                for (int bj = 0; bj < 2; ++bj) { const pg8::f32x4 v0 = acc[ai][bj][m][0], v1 = acc[ai][bj][m][1]; const int col = col0 + bj * 128;
                    u32x4 w; w.x = pk2(v0[0], v0[1]); w.y = pk2(v0[2], v0[3]); w.z = pk2(v1[0], v1[1]); w.w = pk2(v1[2], v1[3]);
                    if (u.pn < 6) *(u32x4*)(Z + row * OD_N + col) = w;
                    else { const int cu = col - 1536; *(u32x4*)(UG + ((size_t)(cu >> 4) * T + row) * 16 + (cu & 15)) = w; } } }
    }
};
__device__ __forceinline__ void load_q_normed(attn_body::bf16x8 (&qr)[4], const bf16_t* zrow, const float* gain, const float* COSH, const float* SINH, int pos, int hi, int lane) {
    float v[4][8]; float ss = 0.f;
#pragma unroll
    for (int d0 = 0; d0 < 4; ++d0) { unpack8(*(const u32x4*)(zrow + d0 * 16 + hi * 8), v[d0]);
#pragma unroll
        for (int e = 0; e < 8; ++e) ss += v[d0][e] * v[d0][e]; }
    ss = half_sum(ss);
    const float r = rsqrtf(ss * (1.0f / 64.0f) + EPS) * QSCALE;
#pragma unroll
    for (int d0 = 0; d0 < 4; ++d0)
#pragma unroll
        for (int e = 0; e < 8; ++e) v[d0][e] *= r * gain[d0 * 16 + hi * 8 + e];
#pragma unroll
    for (int e = 0; e < 8; ++e) { const float oth = shx_(v[0][e], 32, lane); const float cs = COSH[pos * 8 + e], sn = SINH[pos * 8 + e];
        v[0][e] = hi ? v[0][e] * cs + oth * sn : v[0][e] * cs - oth * sn; }
#pragma unroll
    for (int d0 = 0; d0 < 4; ++d0) qr[d0] = __builtin_bit_cast(attn_body::bf16x8, pack8(v[d0]));
}
struct EpiSwiGLU {
    static constexpr bool PERM = true, AFTER_DRAIN = false;
    bf16_t* HID;
    __device__ __forceinline__ void operator()(const pg8::f32x4 (&acc)[2][2][4][2], const pg8::Unit& u, int wr, int wc, int fr, int fq) const {
        const int row0 = u.pm * 256 + wr * 64 + fr, col0 = (u.pn * 256 + wc * 32 + 8 * fq) >> 1;
#pragma unroll
        for (int ai = 0; ai < 2; ++ai)
#pragma unroll
            for (int m = 0; m < 4; ++m) { bf16_t* rowp = HID + (size_t)(row0 + ai * 128 + m * 16) * 512 + col0;
#pragma unroll
                for (int bj = 0; bj < 2; ++bj) { const pg8::f32x4 v0 = acc[ai][bj][m][0], v1 = acc[ai][bj][m][1];
                    const float h0 = v0[0] * sigmoidf_(v0[0]) * v0[1], h1 = v0[2] * sigmoidf_(v0[2]) * v0[3];
                    const float h2 = v1[0] * sigmoidf_(v1[0]) * v1[1], h3 = v1[2] * sigmoidf_(v1[2]) * v1[3];
                    u32x2 w; w.x = pk2(h0, h1); w.y = pk2(h2, h3);
                    *(u32x2*)(rowp + bj * 64) = w; } }
    }
};
struct EpiGLU {
    static constexpr bool PERM = true, AFTER_DRAIN = false;
    bf16_t* O; const bf16_t* YG; const float* gb;
    __device__ __forceinline__ void operator()(const pg8::f32x4 (&acc)[2][2][4][2], const pg8::Unit& u, int wr, int wc, int fr, int fq) const {
        const int row0 = u.pm * 256 + wr * 64 + fr, col0 = u.pn * 256 + wc * 32 + 8 * fq;
#pragma unroll
        for (int ai = 0; ai < 2; ++ai)
#pragma unroll
            for (int bj = 0; bj < 2; ++bj) {
                const int c = col0 + bj * 128;
                u32x4 yr[4];
#pragma unroll
                for (int m = 0; m < 4; ++m) yr[m] = *(const u32x4*)(YG + (size_t)(row0 + ai * 128 + m * 16) * 512 + c);
                const pg8::f32x4 b0 = *(const pg8::f32x4*)(gb + c), b1 = *(const pg8::f32x4*)(gb + c + 4);
                __builtin_amdgcn_sched_barrier(0);
#pragma unroll
                for (int m = 0; m < 4; ++m) { const size_t row = (size_t)(row0 + ai * 128 + m * 16);
                    const pg8::f32x4 v0 = acc[ai][bj][m][0], v1 = acc[ai][bj][m][1];
                    float y[8]; unpack8(yr[m], y);
                    float o[8];
#pragma unroll
                    for (int j = 0; j < 4; ++j) { o[j] = y[j] * sigmoidf_(v0[j] + b0[j]); o[4 + j] = y[4 + j] * sigmoidf_(v1[j] + b1[j]); }
                    *(u32x4*)(O + row * 1024 + 512 + c) = pack8(o); }
                __builtin_amdgcn_sched_barrier(0);
            }
    }
};
struct MoeOrder {
    int nN, nunits, G, c; const LAS int* tile_e;
    __device__ __forceinline__ bool next(int i, pg8::Unit& u) const { const int L = i * G + c; if (L >= nunits) return false;
        int w = L; { const int q = nunits / 8, r = nunits % 8, xcd = w % 8, off = w / 8; w = (xcd < r ? xcd * (q + 1) : r * (q + 1) + (xcd - r) * q) + off; }
        u.pm = w / nN; u.pn = w % nN; u.be = tile_e[u.pm]; return true; }
    __device__ __forceinline__ void a_ready(const pg8::Unit&) const {}
    __device__ __forceinline__ void done(const pg8::Unit&) const {}
};

__device__ __forceinline__ int wt_row(int n, int row_mul, int row_add) {
    if (row_mul > 0) return n * row_mul + row_add;
    const int tile = n >> 8, w = n & 255;
    const bool ktile = (tile == 2 || tile == 3) || (row_mul == -1 && (tile == 8 || tile == 9));
    return ktile ? tile * 256 + ((w & 63) >> 5) * 128 + (w >> 6) * 32 + (w & 31) : n;
}
__device__ __forceinline__ void transpose_item(const float* W, int K, int N, bf16_t* WT, int row_mul, int row_add, LAS float* scr, int item, int nblk, int lane) {
    const int kb = item / nblk, nb = item % nblk, k0 = 64 * kb, n0 = 32 * nb;
    const int nn = n0 + (lane & 31);
    float tv[32];
#pragma unroll
    for (int i = 0; i < 32; ++i) { const int kk = 2 * i + (lane >> 5); tv[i] = (nn < N) ? W[(size_t)(k0 + kk) * N + nn] : 0.f; }
#pragma unroll
    for (int i = 0; i < 32; ++i) { const int kk = 2 * i + (lane >> 5); scr[kk * 33 + (lane & 31)] = tv[i]; }
    LDS_WAIT(); asm volatile("" ::: "memory");
    const int c = lane & 7;
#pragma unroll
    for (int j = 0; j < 4; ++j) { const int n = (lane >> 3) + 8 * j; const LAS float* s = scr + (8 * c) * 33 + n;
        u32x4 o; o.x = pk2(s[0 * 33], s[1 * 33]); o.y = pk2(s[2 * 33], s[3 * 33]); o.z = pk2(s[4 * 33], s[5 * 33]); o.w = pk2(s[6 * 33], s[7 * 33]);
        *(u32x4*)(WT + (size_t)wt_row(n0 + n, row_mul, row_add) * K + k0 + 8 * c) = o; }
    LDS_WAIT(); asm volatile("" ::: "memory");
}
__device__ __forceinline__ void norm_mod_row(const float* xrow, const float* sh, const float* sc, bf16_t* orow, int lane) {
    f32x4 v[4]; float ss = 0.f;
#pragma unroll
    for (int j = 0; j < 4; ++j) { v[j] = *(const f32x4*)(xrow + 4 * lane + 256 * j); ss += (v[j].x * v[j].x + v[j].y * v[j].y) + (v[j].z * v[j].z + v[j].w * v[j].w); }
    const float r = rsqrtf(wave_sum(ss) * (1.0f / 1024.0f) + EPS);
#pragma unroll
    for (int j = 0; j < 4; ++j) { const f32x4 a = *(const f32x4*)(sc + 4 * lane + 256 * j), b = *(const f32x4*)(sh + 4 * lane + 256 * j);
        u32x2 w; w.x = pk2(v[j].x * r * (1.f + a.x) + b.x, v[j].y * r * (1.f + a.y) + b.y); w.y = pk2(v[j].z * r * (1.f + a.z) + b.z, v[j].w * r * (1.f + a.w) + b.w);
        *(u32x2*)(orow + 4 * lane + 256 * j) = w; }
}

__device__ __forceinline__ void attn_key(const bf16_t* kp, const bf16_t* vp, const float (&q)[64], float& m, float& l, float (&o)[64]) {
    float s = 0.f;
#pragma unroll
    for (int i = 0; i < 8; ++i) { float kv[8]; unpack8(*(const u32x4*)(kp + 8 * i), kv);
#pragma unroll
        for (int j = 0; j < 8; ++j) s += q[8 * i + j] * kv[j]; }
    const float mn = fmaxf(m, s);
    const float f = __builtin_amdgcn_exp2f(m - mn), p = __builtin_amdgcn_exp2f(s - mn);
    l = l * f + p; m = mn;
#pragma unroll
    for (int i = 0; i < 8; ++i) { float vv[8]; unpack8(*(const u32x4*)(vp + 8 * i), vv);
#pragma unroll
        for (int j = 0; j < 8; ++j) o[8 * i + j] = o[8 * i + j] * f + p * vv[j]; }
}
__device__ __forceinline__ void load_q64(const bf16_t* qp, float scale, float (&q)[64]) {
#pragma unroll
    for (int i = 0; i < 8; ++i) { float t[8]; unpack8(*(const u32x4*)(qp + 8 * i), t);
#pragma unroll
        for (int j = 0; j < 8; ++j) q[8 * i + j] = t[j] * scale; }
}

struct Args { const void* in[37]; float* out; unsigned char* ws; int ph_lo, ph_hi, probe_var, pad; };
#ifndef PROBE_GEMM_REPS
#define PROBE_GEMM_REPS 1
#endif
#if PROBE_GEMM_REPS == 2
template <class Sc> struct Twice { Sc S; int n1;
    __device__ __forceinline__ bool next(int i, pg8::Unit& u) const { return i < n1 ? S.next(i, u) : S.next(i - n1, u); }
    __device__ __forceinline__ void a_ready(const pg8::Unit&) const {}
    __device__ __forceinline__ void done(const pg8::Unit&) const {} };
#define PROBE_SCHED(T) Twice<T>
#define PROBE_WRAP(T, v) Twice<T> PS_; PS_.S = v; { int n1_ = 0; pg8::Unit tu_; while (v.next(n1_, tu_)) ++n1_; PS_.n1 = n1_; }
#else
#define PROBE_SCHED(T) T
#define PROBE_WRAP(T, v) const T& PS_ = v
#endif
#ifdef PROBE_BAR2
#define PROBE_EXTRA_BAR(b) xcd_barrier(b, lsg(wid0) == 0 && lane_id_v() == 0);
#else
#define PROBE_EXTRA_BAR(b)
#endif
constexpr int N_PHASES = 3 + 2 * (8 + 10);

template <int NV, bool MASKED, bool CAUSAL, int PIN, int POUT, bool NOMAX = false>
__device__ __forceinline__ void flash_unit(LAS unsigned char* L0, const bf16_t* Qb, const bf16_t* Kb, const bf16_t* Vb, bf16_t* Ob, const unsigned* mbase, int qb, int wid, int lane, const float* qgain, const float* COSH, const float* SINH) {
    const int r32 = lane & 31, hi = lane >> 5;
    LAS unsigned char* ldsKs = L0; LAS unsigned char* ldsVs = L0 + 16384;
    LAS float* wsf = (LAS float*)(L0 + 16384 + NV * 16384 + wid * 256);
    LAS bf16_t* stg = (LAS bf16_t*)(L0 + 16384 + NV * 16384 + 2048 + wid * 4096);
    const int qrow = qb * 256 + wid * 32 + r32;
    const int NT = 4 * (qb + 1);
    const bf16_t* kbp = Kb + (size_t)lane * PIN + wid * 8;
    const bf16_t* vbp = Vb + (size_t)(16 * (wid & 3) + (lane >> 2)) * PIN + (wid >> 2) * 32 + (lane & 3) * 8;
    const unsigned* mwp = MASKED ? mbase + (size_t)qrow * 2 + hi : nullptr;
    u32x4 kreg = *(const u32x4*)kbp, vreg[NV]; unsigned mw = 0u, mwn = 0u;
#pragma unroll
    for (int j = 0; j < NV; ++j) vreg[j] = *(const u32x4*)(vbp + j * 64);
    if (MASKED) mw = mwp[0];
    __builtin_amdgcn_sched_barrier(0);
    attn_body::bf16x8 qr[4];
    load_q_normed(qr, Qb + (size_t)qrow * PIN, qgain, COSH, SINH, qrow, hi, lane);
    *(LAS u32x4*)(ldsKs + wid * 1024 + lane * 16) = kreg;
#pragma unroll
    for (int j = 0; j < NV; ++j) *(LAS u32x4*)(ldsVs + j * 16384 + wid * 1024 + lane * 16) = vreg[j];
    __syncthreads();
    float mhat = 0.f, lsum = 0.f;
    attn_body::f32x16 o[2 * NV], negm;
#pragma unroll
    for (int r = 0; r < 16; ++r) { negm[r] = 0.f;
#pragma unroll
        for (int j = 0; j < 2 * NV; ++j) o[j][r] = 0.f; }
    const int vb0 = (int)(unsigned)(unsigned long long)ldsVs + ((lane >> 4) & 1) * 32 + (lane & 3) * 8 + (4 * hi + ((lane & 15) >> 2)) * 64;
    for (int t = 0; t < NT; ++t) {
        const int slot = (t & 1) * 8192;
        if (t + 1 < NT) { kreg = *(const u32x4*)(kbp + (size_t)(t + 1) * 64 * PIN);
#pragma unroll
            for (int j = 0; j < NV; ++j) vreg[j] = *(const u32x4*)(vbp + (size_t)(t + 1) * 64 * PIN + j * 64);
            if (MASKED) mwn = mwp[(size_t)(t + 1) * S * 2]; }
        attn_body::f32x16 p0 = negm, p1 = negm;
        { const LAS unsigned char* kb = ldsKs + slot + hi * 1024 + r32 * 16;
#pragma unroll
          for (int d0 = 0; d0 < 4; ++d0) {
              const attn_body::bf16x8 b0 = *(const LAS attn_body::bf16x8*)(kb + d0 * 2048), b1 = *(const LAS attn_body::bf16x8*)(kb + d0 * 2048 + 512);
              p0 = __builtin_amdgcn_mfma_f32_32x32x16_bf16(b0, qr[d0], p0, 0, 0, 0);
              p1 = __builtin_amdgcn_mfma_f32_32x32x16_bf16(b1, qr[d0], p1, 0, 0, 0); } }
        if (CAUSAL) { const int jb = t - (NT - 4); if (jb >= 0) attn_body::cmask(p0, p1, jb, wid * 32 + r32, hi); }
        float rm = 0.f;
        if (!NOMAX) { rm = fmaxf(p0[0], p1[0]);
#pragma unroll
            for (int r = 1; r < 16; ++r) rm = fmaxf(rm, fmaxf(p0[r], p1[r]));
            rm = half_max(rm); }
        bool resc = false;
        if (!NOMAX && __any(rm > 8.0f)) {
            const float dl = fmaxf(rm, 0.f); mhat += dl;
#pragma unroll
            for (int r = 0; r < 16; ++r) { p0[r] -= dl; p1[r] -= dl; negm[r] = -mhat; }
            const float f = __builtin_amdgcn_exp2f(-dl); lsum *= f; if (hi == 0) wsf[r32] = f; resc = true;
        }
        const int wb = (int)mw; float ssum = 0.f;
#pragma unroll
        for (int r = 0; r < 16; ++r) {
            float e0 = __builtin_amdgcn_exp2f(p0[r]), e1 = __builtin_amdgcn_exp2f(p1[r]);
            if (MASKED) { e0 = __uint_as_float(__float_as_uint(e0) & (unsigned)__builtin_amdgcn_sbfe(wb, r, 1)); e1 = __uint_as_float(__float_as_uint(e1) & (unsigned)__builtin_amdgcn_sbfe(wb, 16 + r, 1)); }
            p0[r] = e0; p1[r] = e1; ssum += e0 + e1; }
        lsum += ssum;
        u32x4 pw0, pw1, pw2, pw3;
#pragma unroll
        for (int k = 0; k < 4; ++k) { pw0[k] = attn_body::cvtpk_s(p0[2 * k], p0[2 * k + 1]); pw1[k] = attn_body::cvtpk_s(p0[8 + 2 * k], p0[9 + 2 * k]);
            pw2[k] = attn_body::cvtpk_s(p1[2 * k], p1[2 * k + 1]); pw3[k] = attn_body::cvtpk_s(p1[8 + 2 * k], p1[9 + 2 * k]); }
        if (resc) { LDS_WAIT();
#pragma unroll
            for (int r = 0; r < 16; ++r) { const float f = wsf[attn_body::crow(r, hi)];
#pragma unroll
                for (int j = 0; j < 2 * NV; ++j) o[j][r] *= f; } }
#pragma unroll
        for (int j = 0; j < NV; ++j)
            attn_body::pv(o + 2 * j, vb0 + j * 16384 + slot, __builtin_bit_cast(attn_body::bf16x8, pw0), __builtin_bit_cast(attn_body::bf16x8, pw1), __builtin_bit_cast(attn_body::bf16x8, pw2), __builtin_bit_cast(attn_body::bf16x8, pw3));
        if (t + 1 < NT) { const int ns = ((t + 1) & 1) * 8192; *(LAS u32x4*)(ldsKs + ns + wid * 1024 + lane * 16) = kreg;
#pragma unroll
            for (int j = 0; j < NV; ++j) *(LAS u32x4*)(ldsVs + j * 16384 + ns + wid * 1024 + lane * 16) = vreg[j]; }
        mw = mwn;
        __syncthreads();
    }
    lsum += shx_(lsum, 32, lane);
    if (hi == 0) wsf[r32] = lsum;
    LDS_WAIT();
    float rl[16];
#pragma unroll
    for (int r = 0; r < 16; ++r) rl[r] = __builtin_amdgcn_rcpf(wsf[attn_body::crow(r, hi)]);
#pragma unroll
    for (int j = 0; j < NV; ++j) {
#pragma unroll
        for (int r = 0; r < 16; ++r) { const int orow = attn_body::crow(r, hi);
            stg[orow * 64 + r32] = (bf16_t)f2bf(o[2 * j][r] * rl[r]); stg[orow * 64 + 32 + r32] = (bf16_t)f2bf(o[2 * j + 1][r] * rl[r]); }
        LDS_WAIT();
#pragma unroll
        for (int q = 0; q < 4; ++q) { const int row = q * 8 + (lane >> 3), ch = lane & 7;
            *(u32x4*)(Ob + (size_t)(qb * 256 + wid * 32 + row) * POUT + j * 64 + ch * 8) = *(const LAS u32x4*)(stg + row * 64 + ch * 8); }
        LDS_WAIT();
    }
    __syncthreads();
}
template <int NV, bool MASKED, bool CAUSAL, int PIN, int POUT, bool NOMAX = false>
__device__ __forceinline__ void flash_unit_q2(LAS unsigned char* L0, const bf16_t* Qb, const bf16_t* Kb, const bf16_t* Vb, bf16_t* Ob, const unsigned* mbase, int qb, int wid, int lane, const float* qgain, const float* COSH, const float* SINH) {
    typedef __attribute__((address_space(3))) attn_body::v4i16_t* vtr_ptr;
    const int r32 = lane & 31, hi = lane >> 5;
    LAS unsigned char* ldsKs = L0; LAS unsigned char* ldsVs = L0 + 16384;
    LAS float* wsf = (LAS float*)(L0 + 16384 + NV * 16384 + wid * 512);
    LAS bf16_t* stg = (LAS bf16_t*)(L0 + 16384 + NV * 16384 + 4096 + wid * 4096);
    const int q0 = qb * 512 + wid * 64;
    const int NT = 8 * (qb + 1);
    const bf16_t* kbp = Kb + (size_t)lane * PIN + wid * 8;
    const bf16_t* vbp = Vb + (size_t)(16 * (wid & 3) + (lane >> 2)) * PIN + (wid >> 2) * 32 + (lane & 3) * 8;
    const unsigned* mwp = MASKED ? mbase + (size_t)(q0 + r32) * 2 + hi : nullptr;
    const int stoff = wid * 1024 + lane * 16;
    u32x4 kreg = *(const u32x4*)kbp, vreg[NV]; unsigned mw[2] = {0u, 0u}, mwn[2] = {0u, 0u};
#pragma unroll
    for (int j = 0; j < NV; ++j) vreg[j] = *(const u32x4*)(vbp + j * 64);
    if (MASKED) { mw[0] = mwp[0]; mw[1] = mwp[64]; }
    __builtin_amdgcn_sched_barrier(0);
    attn_body::bf16x8 qr[2][4];
#pragma unroll
    for (int nq = 0; nq < 2; ++nq) load_q_normed(qr[nq], Qb + (size_t)(q0 + nq * 32 + r32) * PIN, qgain, COSH, SINH, q0 + nq * 32 + r32, hi, lane);
    *(LAS u32x4*)(ldsKs + stoff) = kreg;
#pragma unroll
    for (int j = 0; j < NV; ++j) *(LAS u32x4*)(ldsVs + j * 16384 + stoff) = vreg[j];
    __syncthreads();
    float mhat[2] = {0.f, 0.f}, lsum[2] = {0.f, 0.f}; bool refmoved = false;
    attn_body::f32x16 o[2][2 * NV];
#pragma unroll
    for (int r = 0; r < 16; ++r)
#pragma unroll
        for (int j = 0; j < 2 * NV; ++j) { o[0][j][r] = 0.f; o[1][j][r] = 0.f; }
    const LAS unsigned char* kfb = ldsKs + hi * 1024 + r32 * 16;
    const LAS unsigned char* vfb = ldsVs + ((lane >> 4) & 1) * 32 + (lane & 3) * 8 + (4 * hi + ((lane & 15) >> 2)) * 64;
    for (int t = 0; t < NT; ++t) {
        const int slot = (t & 1) * 8192;
        {
            const int tn = min(t + 1, NT - 1);
            if (MASKED) { mwn[0] = mwp[(size_t)tn * S * 2]; mwn[1] = mwp[(size_t)tn * S * 2 + 64]; }
            kreg = *(const u32x4*)(kbp + (size_t)tn * 64 * PIN);
#pragma unroll
            for (int j = 0; j < NV; ++j) vreg[j] = *(const u32x4*)(vbp + (size_t)tn * 64 * PIN + j * 64); }
        if constexpr (NOMAX && !CAUSAL && MASKED) {
            auto expel = [&](attn_body::f32x16& pv, const int wb, auto RBc) { constexpr int RB = decltype(RBc)::value;
                float e = __builtin_amdgcn_exp2f(pv[RB & 15]); unsigned mk; asm("v_bfe_i32 %0, %1, %2, 1" : "=v"(mk) : "v"(wb), "n"(RB)); pv[RB & 15] = __uint_as_float(__float_as_uint(e) & mk); };
            auto pack = [&](attn_body::f32x16 (&pq)[2], attn_body::bf16x8 (&pa)[2][2]) {
#pragma unroll
                for (int nq = 0; nq < 2; ++nq) { f32x2 ss2 = {0.f, 0.f};
#pragma unroll
                    for (int r = 0; r < 16; r += 2) ss2 += (f32x2){pq[nq][r], pq[nq][r + 1]};
                    lsum[nq] += ss2.x + ss2.y;
                    u32x4 pw0, pw1;
#pragma unroll
                    for (int k = 0; k < 4; ++k) { pw0[k] = attn_body::cvtpk_s(pq[nq][2 * k], pq[nq][2 * k + 1]); pw1[k] = attn_body::cvtpk_s(pq[nq][8 + 2 * k], pq[nq][9 + 2 * k]); }
                    pa[nq][0] = __builtin_bit_cast(attn_body::bf16x8, pw0); pa[nq][1] = __builtin_bit_cast(attn_body::bf16x8, pw1); } };
            auto pvstep = [&](attn_body::bf16x8 (&pa)[2][2], const int kh) {
#pragma unroll
                for (int blk = 0; blk < 2 * NV; ++blk)
#pragma unroll
                    for (int k2 = 0; k2 < 2; ++k2) {
                        const LAS unsigned char* vb = vfb + (blk >> 1) * 16384 + slot + (blk & 1) * 4096 + (kh * 2 + k2) * 1024;
                        const attn_body::s16x4 lo_ = __builtin_bit_cast(attn_body::s16x4, __builtin_amdgcn_ds_read_tr16_b64_v4i16((vtr_ptr)vb)), hi_ = __builtin_bit_cast(attn_body::s16x4, __builtin_amdgcn_ds_read_tr16_b64_v4i16((vtr_ptr)(vb + 512)));
                        const attn_body::bf16x8 vf = (attn_body::bf16x8){lo_[0], lo_[1], lo_[2], lo_[3], hi_[0], hi_[1], hi_[2], hi_[3]};
                        o[0][blk] = __builtin_amdgcn_mfma_f32_32x32x16_bf16(pa[0][k2], vf, o[0][blk], 0, 0, 0);
                        o[1][blk] = __builtin_amdgcn_mfma_f32_32x32x16_bf16(pa[1][k2], vf, o[1][blk], 0, 0, 0); } };
            attn_body::f32x16 pA[2], pB[2];
#pragma unroll
            for (int r = 0; r < 16; ++r) { pA[0][r] = 0.f; pA[1][r] = 0.f; pB[0][r] = 0.f; pB[1][r] = 0.f; }
#pragma unroll
            for (int d0 = 0; d0 < 4; ++d0) {
                const attn_body::bf16x8 kf = *(const LAS attn_body::bf16x8*)(kfb + slot + d0 * 2048);
                pA[0] = __builtin_amdgcn_mfma_f32_32x32x16_bf16(kf, qr[0][d0], pA[0], 0, 0, 0);
                pA[1] = __builtin_amdgcn_mfma_f32_32x32x16_bf16(kf, qr[1][d0], pA[1], 0, 0, 0); }
            attn_body::bf16x8 kf1[4];
#pragma unroll
            for (int d0 = 0; d0 < 4; ++d0) kf1[d0] = *(const LAS attn_body::bf16x8*)(kfb + slot + d0 * 2048 + 512);
            __builtin_amdgcn_sched_barrier(0);
            const int wb0 = (int)mw[0], wb1 = (int)mw[1];
#define Q2_CHUNK(C)  { pB[(C) & 1] = __builtin_amdgcn_mfma_f32_32x32x16_bf16(kf1[(C) >> 1], qr[(C) & 1][(C) >> 1], pB[(C) & 1], 0, 0, 0); \
                       { const int wbc = ((C) >> 2) ? wb1 : wb0; constexpr int R0 = ((C) & 3) * 4; \
                         expel(pA[(C) >> 2], wbc, std::integral_constant<int, R0>{}); expel(pA[(C) >> 2], wbc, std::integral_constant<int, R0 + 1>{}); \
                         expel(pA[(C) >> 2], wbc, std::integral_constant<int, R0 + 2>{}); expel(pA[(C) >> 2], wbc, std::integral_constant<int, R0 + 3>{}); } \
                       __builtin_amdgcn_sched_barrier(0); }
            Q2_CHUNK(0) Q2_CHUNK(1) Q2_CHUNK(2) Q2_CHUNK(3) Q2_CHUNK(4) Q2_CHUNK(5) Q2_CHUNK(6) Q2_CHUNK(7)
#undef Q2_CHUNK
            attn_body::bf16x8 pa[2][2];
            pack(pA, pa); pvstep(pa, 0);
#define Q2_EL(NQ, R) expel(pB[NQ], (NQ) ? wb1 : wb0, std::integral_constant<int, 16 + (R)>{});
#define Q2_ROW(NQ) Q2_EL(NQ, 0) Q2_EL(NQ, 1) Q2_EL(NQ, 2) Q2_EL(NQ, 3) Q2_EL(NQ, 4) Q2_EL(NQ, 5) Q2_EL(NQ, 6) Q2_EL(NQ, 7) Q2_EL(NQ, 8) Q2_EL(NQ, 9) Q2_EL(NQ, 10) Q2_EL(NQ, 11) Q2_EL(NQ, 12) Q2_EL(NQ, 13) Q2_EL(NQ, 14) Q2_EL(NQ, 15)
            Q2_ROW(0) Q2_ROW(1)
#undef Q2_ROW
#undef Q2_EL
            pack(pB, pa); pvstep(pa, 1);
        } else {
#pragma unroll
        for (int kh = 0; kh < 2; ++kh) {
            attn_body::f32x16 p[2];
#pragma unroll
            for (int r = 0; r < 16; ++r) { p[0][r] = 0.f; p[1][r] = 0.f; }
#pragma unroll
            for (int d0 = 0; d0 < 4; ++d0) {
                const attn_body::bf16x8 kf = *(const LAS attn_body::bf16x8*)(kfb + slot + d0 * 2048 + kh * 512);
                p[0] = __builtin_amdgcn_mfma_f32_32x32x16_bf16(kf, qr[0][d0], p[0], 0, 0, 0);
                p[1] = __builtin_amdgcn_mfma_f32_32x32x16_bf16(kf, qr[1][d0], p[1], 0, 0, 0); }
            if (refmoved) {
#pragma unroll
                for (int nq = 0; nq < 2; ++nq)
#pragma unroll
                    for (int r = 0; r < 16; ++r) p[nq][r] -= mhat[nq]; }
            if (CAUSAL) { const int kbase = t * 64 + kh * 32;
                if (kbase + 31 > q0) {
#pragma unroll
                    for (int nq = 0; nq < 2; ++nq)
#pragma unroll
                        for (int r = 0; r < 16; ++r) if (kbase + attn_body::crow(r, hi) > q0 + nq * 32 + r32) p[nq][r] = -INFINITY; } }
            float rm[2] = {0.f, 0.f};
            if (!NOMAX)
#pragma unroll
            for (int nq = 0; nq < 2; ++nq) { float m_ = p[nq][0];
#pragma unroll
                for (int r = 1; r < 16; ++r) m_ = fmaxf(m_, p[nq][r]);
                rm[nq] = half_max(m_); }
            bool resc = false;
            if (!NOMAX && __any(fmaxf(rm[0], rm[1]) > 8.0f)) {
#pragma unroll
                for (int nq = 0; nq < 2; ++nq) { const float dl = fmaxf(rm[nq], 0.f); mhat[nq] += dl;
#pragma unroll
                    for (int r = 0; r < 16; ++r) p[nq][r] -= dl;
                    const float f = __builtin_amdgcn_exp2f(-dl); lsum[nq] *= f; if (hi == 0) wsf[nq * 32 + r32] = f; }
                resc = true; refmoved = true;
            }
            attn_body::bf16x8 pa[2][2];
#pragma unroll
            for (int nq = 0; nq < 2; ++nq) { const int wb = (int)mw[nq]; f32x2 ss2 = {0.f, 0.f};
#pragma unroll
                for (int r = 0; r < 16; ++r) { float e = __builtin_amdgcn_exp2f(p[nq][r]);
                    if (MASKED) { unsigned mk; asm("v_bfe_i32 %0, %1, %2, 1" : "=v"(mk) : "v"(wb), "n"(kh * 16 + r)); e = __uint_as_float(__float_as_uint(e) & mk); }
                    p[nq][r] = e; }
#pragma unroll
                for (int r = 0; r < 16; r += 2) ss2 += (f32x2){p[nq][r], p[nq][r + 1]};
                lsum[nq] += ss2.x + ss2.y;
                u32x4 pw0, pw1;
#pragma unroll
                for (int k = 0; k < 4; ++k) { pw0[k] = attn_body::cvtpk_s(p[nq][2 * k], p[nq][2 * k + 1]); pw1[k] = attn_body::cvtpk_s(p[nq][8 + 2 * k], p[nq][9 + 2 * k]); }
                pa[nq][0] = __builtin_bit_cast(attn_body::bf16x8, pw0); pa[nq][1] = __builtin_bit_cast(attn_body::bf16x8, pw1); }
            if (resc) { LDS_WAIT();
#pragma unroll
                for (int nq = 0; nq < 2; ++nq)
#pragma unroll
                    for (int r = 0; r < 16; ++r) { const float f = wsf[nq * 32 + attn_body::crow(r, hi)];
#pragma unroll
                        for (int j = 0; j < 2 * NV; ++j) o[nq][j][r] *= f; } }
#pragma unroll
            for (int blk = 0; blk < 2 * NV; ++blk)
#pragma unroll
                for (int k2 = 0; k2 < 2; ++k2) {
                    const LAS unsigned char* vb = vfb + (blk >> 1) * 16384 + slot + (blk & 1) * 4096 + (kh * 2 + k2) * 1024;
                    const attn_body::s16x4 lo_ = __builtin_bit_cast(attn_body::s16x4, __builtin_amdgcn_ds_read_tr16_b64_v4i16((vtr_ptr)vb)), hi_ = __builtin_bit_cast(attn_body::s16x4, __builtin_amdgcn_ds_read_tr16_b64_v4i16((vtr_ptr)(vb + 512)));
                    const attn_body::bf16x8 vf = (attn_body::bf16x8){lo_[0], lo_[1], lo_[2], lo_[3], hi_[0], hi_[1], hi_[2], hi_[3]};
                    o[0][blk] = __builtin_amdgcn_mfma_f32_32x32x16_bf16(pa[0][k2], vf, o[0][blk], 0, 0, 0);
                    o[1][blk] = __builtin_amdgcn_mfma_f32_32x32x16_bf16(pa[1][k2], vf, o[1][blk], 0, 0, 0); }
        }
        }
        if (t + 1 < NT) { const int ns = 8192 - slot; *(LAS u32x4*)(ldsKs + ns + stoff) = kreg;
#pragma unroll
            for (int j = 0; j < NV; ++j) *(LAS u32x4*)(ldsVs + j * 16384 + ns + stoff) = vreg[j]; }
        mw[0] = mwn[0]; mw[1] = mwn[1];
        __syncthreads();
    }
#pragma unroll
    for (int nq = 0; nq < 2; ++nq) { lsum[nq] += shx_(lsum[nq], 32, lane); if (hi == 0) wsf[nq * 32 + r32] = lsum[nq]; }
    LDS_WAIT();
#pragma unroll
    for (int nq = 0; nq < 2; ++nq)
#pragma unroll
      for (int j = 0; j < NV; ++j) {
#pragma unroll
        for (int r = 0; r < 16; ++r) { const int orow = attn_body::crow(r, hi); const float rl = __builtin_amdgcn_rcpf(wsf[nq * 32 + orow]);
            stg[orow * 64 + r32] = (bf16_t)f2bf(o[nq][2 * j][r] * rl); stg[orow * 64 + 32 + r32] = (bf16_t)f2bf(o[nq][2 * j + 1][r] * rl); }
        LDS_WAIT();
#pragma unroll
        for (int q = 0; q < 4; ++q) { const int row = q * 8 + (lane >> 3), ch = lane & 7;
            *(u32x4*)(Ob + (size_t)(q0 + nq * 32 + row) * POUT + j * 64 + ch * 8) = *(const LAS u32x4*)(stg + row * 64 + ch * 8); }
        LDS_WAIT();
      }
    __syncthreads();
}
struct MoeRows {
    static constexpr bool GATHER = true;
    const LAS int* rb; const int* LTOK;
    __device__ __forceinline__ unsigned operator()(const pg8::Unit& u, int r) const { const int e = u.be; const int slot = min(u.pm * 256 + r - rb[e], rb[32 + e] - 1);
        const int tok = LTOK[e * 32768 + slot]; return (unsigned)tok * 2048u; }
};
__device__ __forceinline__ void moe_convert(const float* w1, const float* w3, const float* w2, bf16_t* W13, bf16_t* W2, LAS float* scr, int gw, int NGW, int lane) {
    for (int it = gw; it < 32 * 768; it += NGW) {
        const int e = it / 768; int r = it % 768;
        if (r < 256) { transpose_item(w1 + (size_t)e * 1024 * 512, 1024, 512, W13 + (size_t)e * 1024 * 1024, 2, 0, scr, r, 16, lane); continue; } r -= 256;
        if (r < 256) { transpose_item(w3 + (size_t)e * 1024 * 512, 1024, 512, W13 + (size_t)e * 1024 * 1024, 2, 1, scr, r, 16, lane); continue; } r -= 256;
        transpose_item(w2 + (size_t)e * 512 * 1024, 512, 1024, W2 + (size_t)e * 1024 * 512, 1, 0, scr, r, 32, lane);
    }
}
__device__ __forceinline__ void moe_tables(unsigned* ctl, int l, LAS int* tile_e, LAS int* rb, LAS int* nt_p, int tid) {
    if (tid < 64) {
        const int ln = tid;
        const int cnt = ln < 32 ? (int)__hip_atomic_load(ctl + CW_CNT + (l * 32 + (ln & 31)) * 64, __ATOMIC_RELAXED, __HIP_MEMORY_SCOPE_AGENT) : 0;
        const int ntile = (cnt + 255) >> 8;
        int inc = ntile;
#pragma unroll
        for (int off = 1; off < 32; off <<= 1) { const int v = (int)shi_((unsigned)inc, ln - off); if (ln >= off) inc += v; }
        if (ln < 32) { rb[ln] = (inc - ntile) * 256; rb[32 + ln] = cnt; }
        if (ln == 31) nt_p[0] = inc;
    }
    __syncthreads();
    const int nt = nt_p[0];
    for (int t = tid; t < nt; t += NTHREADS) {
        int lo = 0, hi = 31;
        while (lo < hi) { const int mid = (lo + hi + 1) >> 1; if (rb[mid] <= t * 256) lo = mid; else hi = mid - 1; }
        tile_e[t] = lo;
    }
    __syncthreads();
}

template <bool FIRST>
__device__ __forceinline__ float f_pass1(const float* __restrict__ xs_row, bf16_t* __restrict__ xb_row, const bf16_t* __restrict__ y_row, const LAS float* gate, const int kc) {
    float ss = 0.f;
#pragma unroll 1
    for (int s0 = 0; s0 < 32; s0 += 8) {
        u32x4 xr[8], yr[8]; f32x4 xa[8], xc[8];
#pragma unroll
        for (int k = 0; k < 8; ++k) { const int col = 32 * (s0 + k) + 8 * kc;
            if constexpr (FIRST) { xa[k] = *(const f32x4*)(xs_row + col); xc[k] = *(const f32x4*)(xs_row + col + 4); } else xr[k] = *(const u32x4*)(xb_row + col);
            yr[k] = *(const u32x4*)(y_row + col); }
        __builtin_amdgcn_sched_barrier(0);
#pragma unroll
        for (int k = 0; k < 8; ++k) { const int col = 32 * (s0 + k) + 8 * kc;
            f32x4 x0, x1;
            if constexpr (FIRST) { x0 = xa[k]; x1 = xc[k]; }
            else { float xv_[8]; unpack8(xr[k], xv_); x0 = (f32x4){xv_[0], xv_[1], xv_[2], xv_[3]}; x1 = (f32x4){xv_[4], xv_[5], xv_[6], xv_[7]}; }
            float yv[8]; unpack8(yr[k], yv);
            const f32x4 g0 = *(const LAS f32x4*)(gate + col), g1 = *(const LAS f32x4*)(gate + col + 4);
            float nv_[8] = {x0.x + g0.x * yv[0], x0.y + g0.y * yv[1], x0.z + g0.z * yv[2], x0.w + g0.w * yv[3], x1.x + g1.x * yv[4], x1.y + g1.y * yv[5], x1.z + g1.z * yv[6], x1.w + g1.w * yv[7]};
            const u32x4 xw = pack8(nv_); *(u32x4*)(xb_row + col) = xw;
            float rv_[8]; unpack8(xw, rv_);
#pragma unroll
            for (int e = 0; e < 8; ++e) ss += rv_[e] * rv_[e]; }
        __builtin_amdgcn_sched_barrier(0);
    }
    return ss;
}
__device__ __forceinline__ void f_pass2(const bf16_t* __restrict__ xb_row, bf16_t* __restrict__ h_row, const LAS float* modl, const bf16_t* __restrict__ wh, const bf16_t* __restrict__ wl, const float rn, const int kc, f32x4 (&acc)[3]) {
#pragma unroll 1
    for (int s0 = 0; s0 < 32; s0 += 4) {
        u32x4 xr[4]; pg8::bf16x8 bh[4][3], bl[4][3];
#pragma unroll
        for (int k = 0; k < 4; ++k) { const int col = 32 * (s0 + k) + 8 * kc; xr[k] = *(const u32x4*)(xb_row + col);
#pragma unroll
            for (int ct = 0; ct < 3; ++ct) { bh[k][ct] = *(const pg8::bf16x8*)(wh + (size_t)ct * 16 * 1024 + 32 * (s0 + k)); bl[k][ct] = *(const pg8::bf16x8*)(wl + (size_t)ct * 16 * 1024 + 32 * (s0 + k)); } }
        __builtin_amdgcn_sched_barrier(0);
#pragma unroll
        for (int k = 0; k < 4; ++k) { const int col = 32 * (s0 + k) + 8 * kc;
            f32x4 x0, x1; { float xv_[8]; unpack8(xr[k], xv_); x0 = (f32x4){xv_[0], xv_[1], xv_[2], xv_[3]}; x1 = (f32x4){xv_[4], xv_[5], xv_[6], xv_[7]}; }
            const f32x4 c0 = *(const LAS f32x4*)(modl + 2048 + col), c1 = *(const LAS f32x4*)(modl + 2048 + col + 4), s0_ = *(const LAS f32x4*)(modl + 1024 + col), s1_ = *(const LAS f32x4*)(modl + 1024 + col + 4);
            float hv[8];
            hv[0] = x0.x * rn * (1.f + c0.x) + s0_.x; hv[1] = x0.y * rn * (1.f + c0.y) + s0_.y; hv[2] = x0.z * rn * (1.f + c0.z) + s0_.z; hv[3] = x0.w * rn * (1.f + c0.w) + s0_.w;
            hv[4] = x1.x * rn * (1.f + c1.x) + s1_.x; hv[5] = x1.y * rn * (1.f + c1.y) + s1_.y; hv[6] = x1.z * rn * (1.f + c1.z) + s1_.z; hv[7] = x1.w * rn * (1.f + c1.w) + s1_.w;
            const u32x4 hh = pack8(hv);
            *(u32x4*)(h_row + col) = hh;
            float hl[8]; { float hf[8]; unpack8(hh, hf);
#pragma unroll
                for (int e = 0; e < 8; ++e) hl[e] = hv[e] - hf[e]; }
            const u32x4 hlw = pack8(hl);
            const pg8::bf16x8 ah = __builtin_bit_cast(pg8::bf16x8, hh), al = __builtin_bit_cast(pg8::bf16x8, hlw);
#pragma unroll
            for (int ct = 0; ct < 3; ++ct) {
                acc[ct] = __builtin_amdgcn_mfma_f32_16x16x32_bf16(ah, bh[k][ct], acc[ct], 0, 0, 0);
                acc[ct] = __builtin_amdgcn_mfma_f32_16x16x32_bf16(ah, bl[k][ct], acc[ct], 0, 0, 0);
                acc[ct] = __builtin_amdgcn_mfma_f32_16x16x32_bf16(al, bh[k][ct], acc[ct], 0, 0, 0);
            } }
        __builtin_amdgcn_sched_barrier(0);
    }
}

__device__ __forceinline__ float relu_i(float x) { return __builtin_bit_cast(float, max(__builtin_bit_cast(int, x), 0)); }
__device__ __forceinline__ unsigned pk_gt_u16(unsigned a, unsigned b, unsigned ones) { unsigned d; asm("v_pk_sub_u16 %0, %1, %2 clamp" : "=v"(d) : "v"(a), "v"(b)); unsigned r; asm("v_pk_min_u16 %0, %1, %2" : "=v"(r) : "v"(d), "v"(ones)); return r; }
__device__ __forceinline__ unsigned spread16(unsigned x) { x = (x | (x << 8)) & 0x00FF00FFu; x = (x | (x << 4)) & 0x0F0F0F0Fu; x = (x | (x << 2)) & 0x33333333u; x = (x | (x << 1)) & 0x55555555u; return x; }
__device__ __forceinline__ unsigned ilv16(unsigned a) { return spread16(a & 0xFFFFu) | (spread16(a >> 16) << 1); }
__device__ __forceinline__ int lane_id_v() { int v; asm volatile("v_mbcnt_lo_u32_b32 %0, -1, 0\n\tv_mbcnt_hi_u32_b32 %0, -1, %0" : "=v"(v)); return v; }
__device__ __forceinline__ unsigned long long lsg64(unsigned long long v) { asm volatile("" : "+s"(v)); return v; }
__device__ __forceinline__ int lsg(int v) { asm volatile("" : "+s"(v)); return v; }
__device__ __forceinline__ int lvg(int v) { asm volatile("" : "+v"(v)); return v; }
__device__ __forceinline__ LAS unsigned char* lsgp(LAS unsigned char* p) { unsigned v = (unsigned)(unsigned long long)p; asm volatile("" : "+s"(v)); return (LAS unsigned char*)(unsigned long long)v; }
__device__ __forceinline__ void* ldptr(const LAS unsigned long long* tbl, int k) {
    const unsigned long long v = tbl[k];
    const unsigned lo = __builtin_amdgcn_readfirstlane((unsigned)v), hi = __builtin_amdgcn_readfirstlane((unsigned)(v >> 32));
    return (void*)(__attribute__((address_space(1))) void*)(((unsigned long long)hi << 32) | lo);
}
#define DECL_PTRS() \
    const int wid = lsg(wid0), lane = lane_id_v(), tid = wid * 64 + lane; \
    const int G = lsg(G0), c = lsg(c0), l = lsg(l0), i = l >> 1; \
    const int gw = c * NWAVES + wid, NGW = G * NWAVES, gt = c * NTHREADS + tid, NGT = G * NTHREADS; \
    LAS unsigned char* lds = (LAS unsigned char*)lsgp(lds0); LAS unsigned char* glds = lds; LAS float* scr = (LAS float*)(lds + wid * 16384); \
    const LAS unsigned long long* ptbl = (const LAS unsigned long long*)(lds + LDS_PTBL); \
    unsigned char* ws = (unsigned char*)ldptr(ptbl, 38); unsigned* ctl = (unsigned*)(ws + WS_CTL); \
    const float* xin = (const float*)ldptr(ptbl, 0); \
    const float* cin = (const float*)ldptr(ptbl, 1); \
    const float* ada_w = (const float*)ldptr(ptbl, 2); \
    const float* ada_b = (const float*)ldptr(ptbl, 3); \
    const float* moe_wg = (const float*)ldptr(ptbl, 4); \
    const float* moe_bg = (const float*)ldptr(ptbl, 5); \
    const float* moe_we = (const float*)ldptr(ptbl, 6); \
    const float* moe_be = (const float*)ldptr(ptbl, 7); \
    const float* moe_w1 = (const float*)ldptr(ptbl, 8); \
    const float* moe_w3 = (const float*)ldptr(ptbl, 9); \
    const float* moe_w2 = (const float*)ldptr(ptbl, 10); \
    const float* ev_w_in = (const float*)ldptr(ptbl, 11); \
    const float* ev_w_out = (const float*)ldptr(ptbl, 12); \
    const float* a_qn = (const float*)ldptr(ptbl, 13); \
    const float* a_kn = (const float*)ldptr(ptbl, 14); \
    const float* a_lq1 = (const float*)ldptr(ptbl, 15); \
    const float* a_lk1 = (const float*)ldptr(ptbl, 16); \
    const float* a_lq2 = (const float*)ldptr(ptbl, 17); \
    const float* a_lk2 = (const float*)ldptr(ptbl, 18); \
    const float* a_subln = (const float*)ldptr(ptbl, 19); \
    const float* b_qn = (const float*)ldptr(ptbl, 20); \
    const float* b_kn = (const float*)ldptr(ptbl, 21); \
    const float* b_idx_kn = (const float*)ldptr(ptbl, 22); \
    const float* od_w_in = (const float*)ldptr(ptbl, 23); \
    const float* od_w_out = (const float*)ldptr(ptbl, 24); \
    const float* c_qn = (const float*)ldptr(ptbl, 25); \
    const float* c_kn = (const float*)ldptr(ptbl, 26); \
    const float* s5_lam_re = (const float*)ldptr(ptbl, 27); \
    const float* s5_lam_im = (const float*)ldptr(ptbl, 28); \
    const float* s5_b_re = (const float*)ldptr(ptbl, 29); \
    const float* s5_b_im = (const float*)ldptr(ptbl, 30); \
    const float* s5_c_re = (const float*)ldptr(ptbl, 31); \
    const float* s5_c_im = (const float*)ldptr(ptbl, 32); \
    const float* s5_d = (const float*)ldptr(ptbl, 33); \
    const float* s5_log_dt = (const float*)ldptr(ptbl, 34); \
    const float* s5_glu_w = (const float*)ldptr(ptbl, 35); \
    const float* s5_glu_b = (const float*)ldptr(ptbl, 36); \
    float* out = (float*)ldptr(ptbl, 37); \
    float* MOD = (float*)(ws + WS_MOD); \
    float* MODP = (float*)(ws + WS_MODP); \
    float* COSH = (float*)(ws + WS_ROPE); \
    float* SINH = COSH + S * 8; \
    float* COSI = SINH + S * 8; \
    float* SINI = COSI + S * 4; \
    float* S5A = (float*)(ws + WS_S5A); \
    float* S5B = (float*)(ws + WS_S5B); \
    float* LAM = (float*)(ws + WS_LAM); \
    float* KM = (float*)(ws + WS_KM); \
    bf16_t* KMH = (bf16_t*)(ws + WS_KMH); \
    bf16_t* WRH = (bf16_t*)(ws + WS_WRH); \
    bf16_t* WRL = (bf16_t*)(ws + WS_WRH + 393216); \
    bf16_t* KML = (bf16_t*)(ws + WS_KMH + 131072); \
    bf16_t* Wevin = (bf16_t*)(ws + WS_WEVIN); \
    bf16_t* Wevout = (bf16_t*)(ws + WS_WEVOUT); \
    bf16_t* Wodin = (bf16_t*)(ws + WS_WODIN); \
    bf16_t* Wodout = (bf16_t*)(ws + WS_WODOUT); \
    bf16_t* Wglu = (bf16_t*)(ws + WS_WGLU); \
    bf16_t* W13 = (bf16_t*)(ws + WS_W13); \
    bf16_t* W2 = (bf16_t*)(ws + WS_W2); \
    bf16_t* H = (bf16_t*)(ws + WS_H); \
    bf16_t* O = (bf16_t*)(ws + WS_O); \
    bf16_t* Z = (bf16_t*)(ws + WS_Z); \
    bf16_t* XG = (bf16_t*)(ws + WS_XG); \
    bf16_t* Y = (bf16_t*)(ws + WS_Y); \
    bf16_t* HID = (bf16_t*)(ws + WS_HID); \
    float* IQ = (float*)(ws + WS_IQ); \
    bf16_t* YG = (bf16_t*)(ws + WS_YG); \
    float* IKW = (float*)(ws + WS_IKW); \
    _Float16* IQH = (_Float16*)(ws + WS_IQH); \
    _Float16* IKH = (_Float16*)(ws + WS_IKH); \
    float* IW = (float*)(ws + WS_IW); \
    int* SEL = (int*)(ws + WS_SEL); \
    bf16_t* YMIX = (bf16_t*)(ws + WS_YMIX); \
    int* TOKES = (int*)(ws + WS_TOKES); \
    int* LTOK = (int*)(ws + WS_LTOK); \
    float* TOKW = (float*)(ws + WS_TOKW); \
    int* TOKROW = (int*)(ws + WS_TOKROW); \
    bf16_t* UG = (bf16_t*)(ws + WS_UG); \
    float* S5E = (float*)(ws + WS_S5E); \
    bf16_t* S5HC = (bf16_t*)(ws + WS_S5HC); \
    bf16_t* S5KT = (bf16_t*)(ws + WS_S5KT); \
    bf16_t* S5WT = (bf16_t*)(ws + WS_S5WT); \
    bf16_t* S5A2 = (bf16_t*)(ws + WS_S5A2); \
    float* S5PW = (float*)(ws + WS_S5PW); \
    int* MLIST = (int*)(ws + WS_MLIST); \
    bf16_t* MPO = (bf16_t*)(ws + WS_MPO); \
    float* MML = (float*)(ws + WS_MML); \
    int* NSEL = (int*)(ws + WS_NSEL); \
    unsigned* MASKW = (unsigned*)(ws + WS_MASKW); \
    bf16_t* XB = (bf16_t*)(ws + WS_XB);
__global__ void __launch_bounds__(NTHREADS, 2) fwd(Args a) {
    extern __shared__ __attribute__((aligned(16))) unsigned char lds_raw[];
    LAS unsigned char* lds = (LAS unsigned char*)lds_raw;
    const int tid0 = threadIdx.x; const int wid0 = __builtin_amdgcn_readfirstlane(tid0 >> 6);
    const int G0 = gridDim.x, c0 = blockIdx.x;
    unsigned* ctl0 = (unsigned*)(a.ws + WS_CTL);
    LAS unsigned char* lds0 = lds;
    const int lo = a.ph_lo, hi = a.ph_hi;

    LAS unsigned long long* ptbl = (LAS unsigned long long*)(lds + LDS_PTBL);
    if (tid0 == 0) {
#define PT_(k) ptbl[k] = (unsigned long long)a.in[k];
        PT_(0) PT_(1) PT_(2) PT_(3) PT_(4) PT_(5) PT_(6) PT_(7) PT_(8) PT_(9) PT_(10) PT_(11) PT_(12) PT_(13) PT_(14) PT_(15) PT_(16) PT_(17) PT_(18)
        PT_(19) PT_(20) PT_(21) PT_(22) PT_(23) PT_(24) PT_(25) PT_(26) PT_(27) PT_(28) PT_(29) PT_(30) PT_(31) PT_(32) PT_(33) PT_(34) PT_(35) PT_(36)
#undef PT_
        ptbl[37] = (unsigned long long)a.out; ptbl[38] = (unsigned long long)a.ws;
    }
    if (tid0 < 4) ((LAS unsigned*)(lds + LDS_BARW))[tid0] = 0u;
    __syncthreads();
    XcdBarrier bar; bar.bar = ctl0 + CW_BAR; bar.x = 0; bar.st = (volatile LAS unsigned*)(lds + LDS_BARW);
    if (hi - lo > 1) bar = xcd_barrier_post(ctl0 + CW_BAR, (volatile LAS unsigned*)(lds + LDS_BARW), tid0 == 0);
    int ph = 0, l0 = 0;
#define PH_ON() (ph >= lo && ph < hi)
#define PH_END() do { if (ph >= lo && ph + 1 < hi) { XcdBarrier bb_; bb_.bar = (unsigned*)lsg64((unsigned long long)bar.bar); bb_.x = bar.x; bb_.st = bar.st; xcd_barrier(bb_, lsg(wid0) == 0 && lane_id_v() == 0); PROBE_EXTRA_BAR(bb_) } ++ph; } while (0)

    if (PH_ON()) { DECL_PTRS();
        {
            constexpr int I_EVIN = 16 * 112, I_SQ = 16 * 32, I_ODIN = 16 * 64, I_GLU = 8 * 16;
            constexpr int I_PER = I_EVIN + I_SQ + I_ODIN + I_SQ + I_GLU;
            for (int it = gw; it < 2 * I_PER; it += NGW) {
                const int i = it / I_PER; int r = it % I_PER;
                if (r < I_EVIN) { transpose_item(ev_w_in + (size_t)i * 1024 * EV_N, 1024, EV_N, Wevin + (size_t)i * EV_NP * 1024, -1, 0, scr, r, 112, lane); continue; } r -= I_EVIN;
                if (r < I_SQ) { transpose_item(ev_w_out + (size_t)i * 1024 * 1024, 1024, 1024, Wevout + (size_t)i * 1024 * 1024, 1, 0, scr, r, 32, lane); continue; } r -= I_SQ;
                if (r < I_ODIN) { transpose_item(od_w_in + (size_t)i * 1024 * 2048, 1024, 2048, Wodin + (size_t)i * 2048 * 1024, -2, 0, scr, r, 64, lane); continue; } r -= I_ODIN;
                if (r < I_SQ) { transpose_item(od_w_out + (size_t)i * 1024 * 1024, 1024, 1024, Wodout + (size_t)i * 1024 * 1024, 1, 0, scr, r, 32, lane); continue; } r -= I_SQ;
                transpose_item(s5_glu_w + (size_t)i * 512 * 512, 512, 512, Wglu + (size_t)i * 512 * 512, 1, 0, scr, r, 16, lane);
            }
        }
        __syncthreads();
        {
            LAS float* cact = (LAS float*)lds;
            for (int i = tid; i < 2048; i += NTHREADS) { const float v = cin[i]; cact[i] = v / (1.0f + __expf(-v)); }
            __syncthreads();
            for (int idx = gt; idx < 4 * 4 * 6144; idx += NGT) {
                const int kq = idx / 24576, rem = idx % 24576, l = rem / 6144, n = rem % 6144;
                const float* w = ada_w + ((size_t)l * 1024 + kq * 256) * 6144 + n;
                float a0 = 0.f, a1 = 0.f;
#pragma unroll 32
                for (int k = 0; k < 256; ++k) { const float wv = w[(size_t)k * 6144]; a0 += cact[kq * 256 + k] * wv; a1 += cact[1024 + kq * 256 + k] * wv; }
                MODP[((size_t)(kq * 4 + l) * 2 + 0) * 6144 + n] = a0;
                MODP[((size_t)(kq * 4 + l) * 2 + 1) * 6144 + n] = a1;
            }
            __syncthreads();
        }
        for (int idx = gt; idx < S * 12; idx += NGT) {
            if (idx < S * 8) { const int pos = idx >> 3, j = idx & 7; const float inv = (float)pow(500000.0, -(double)(2 * j) / 16.0); const float ang = (float)pos * inv;
                COSH[idx] = (float)cos((double)ang); SINH[idx] = (float)sin((double)ang); }
            else { const int k = idx - S * 8; const int pos = k >> 2, j = k & 3; const float inv = (float)pow(500000.0, -(double)(2 * j) / 8.0); const float ang = (float)pos * inv;
                COSI[k] = (float)cos((double)ang); SINI[k] = (float)sin((double)ang); }
        }
        for (int idx = gt; idx < 2 * 32 * 64; idx += NGT) {
            const int i = idx >> 11, g = (idx >> 6) & 31;
            const float dt = expf(s5_log_dt[i * 32 + g]);
            const float lr = s5_lam_re[idx], li = s5_lam_im[idx];
            const float mag = expf(lr * dt);
            const float ar = mag * (float)cos((double)(li * dt)), ai = mag * (float)sin((double)(li * dt));
            const float den = lr * lr + li * li;
            const float cr = ((ar - 1.0f) * lr + ai * li) / den, ci = (ai * lr - (ar - 1.0f) * li) / den;
            S5A[idx * 2] = ar; S5A[idx * 2 + 1] = ai;
            { float pr = 1.f, pi_ = 0.f; for (int n = 0; n <= 64; ++n) { S5PW[((size_t)idx * 65 + n) * 2] = pr; S5PW[((size_t)idx * 65 + n) * 2 + 1] = pi_; const float nr = pr * ar - pi_ * ai, ni = pr * ai + pi_ * ar; pr = nr; pi_ = ni; } }
            { float brv[16], biv[16];
#pragma unroll
              for (int cc = 0; cc < 16; ++cc) { brv[cc] = s5_b_re[(size_t)idx * 16 + cc]; biv[cc] = s5_b_im[(size_t)idx * 16 + cc]; }
              __builtin_amdgcn_sched_barrier(0);
#pragma unroll
              for (int cc = 0; cc < 16; ++cc) { const float br = brv[cc], bi = biv[cc];
                  *(f32x2*)(S5B + ((size_t)idx * 16 + cc) * 2) = (f32x2){cr * br - ci * bi, cr * bi + ci * br}; } }
        }
        for (int idx = gt; idx < DEPTH * 48 * 1024; idx += NGT) {
            const int k = idx & 1023, col = (idx >> 10) % 48, ll = idx / (48 * 1024);
            const float w = col < 4 ? moe_wg[((size_t)ll * 1024 + k) * 4 + col] : col < 36 ? moe_we[((size_t)ll * 1024 + k) * 32 + col - 4] : 0.f;
            const unsigned hb = f2bf(w); WRH[idx] = (bf16_t)hb; WRL[idx] = (bf16_t)f2bf(w - __uint_as_float(hb << 16));
        }
        if (gw < 2) { const int i = gw;
            const float s1 = wave_sum(a_lq1[i * 64 + lane] * a_lk1[i * 64 + lane]), s2 = wave_sum(a_lq2[i * 64 + lane] * a_lk2[i * 64 + lane]);
            const float lam_init = 0.8f - 0.6f * expf(-0.3f * (float)(2 * i));
            if (lane == 0) LAM[i] = expf(s1) - expf(s2) + lam_init; }
    }
    PH_END();
    if (PH_ON()) { DECL_PTRS();
        for (int idx = gt; idx < 4 * 2 * 6144; idx += NGT) {
            const int l = idx / 12288, b = (idx / 6144) & 1, n = idx % 6144;
            float v = ada_b[l * 6144 + n];
#pragma unroll
            for (int kq = 0; kq < 4; ++kq) v += MODP[((size_t)(kq * 4 + l) * 2 + b) * 6144 + n];
            MOD[idx] = v;
        }
        for (int idx = gt; idx < 2 * 32 * 65 * 256; idx += NGT) {
            const int ci = idx & 15, co = (idx >> 4) & 15, tr = (idx >> 8) % 65, ig = idx / (65 * 256);
            float acc = 0.f;
            if (tr > 0) {
                const int tau = tr - 1;
#pragma unroll 16
                for (int p = 0; p < 64; ++p) { const int sp = ig * 64 + p;
                    const float cr = s5_c_re[((size_t)ig * 16 + co) * 64 + p], cim_ = s5_c_im[((size_t)ig * 16 + co) * 64 + p];
                    const f32x2 pw_ = *(const f32x2*)(S5PW + ((size_t)sp * 65 + tau) * 2), bb_ = *(const f32x2*)(S5B + ((size_t)sp * 16 + ci) * 2);
                    const float pr = pw_.x, pi_ = pw_.y, br = bb_.x, bi = bb_.y;
                    const float xr = cr * pr - cim_ * pi_, xi = cr * pi_ + cim_ * pr;
                    acc += xr * br - xi * bi; }
            }
            S5KT[((size_t)ig * 65 + tr) * 384 + co * 24 + ci] = (bf16_t)f2bf(acc);
        }
        constexpr int NW_ = 2 * 32 * 128 * 1024;
        for (int idx0 = gt; idx0 < NW_; idx0 += NGT * 8) {
            f32x2 pw_[8], bb_[8];
#pragma unroll
            for (int u = 0; u < 8; ++u) { const int idx = min(idx0 + u * NGT, NW_ - 1);
                const int k = idx & 1023, row = (idx >> 10) & 127, ig = idx >> 17; const int s = k >> 4, ci = k & 15, p = row >> 1; const int sp = ig * 64 + p;
                pw_[u] = *(const f32x2*)(S5PW + ((size_t)sp * 65 + (63 - s)) * 2); bb_[u] = *(const f32x2*)(S5B + ((size_t)sp * 16 + ci) * 2); }
            __builtin_amdgcn_sched_barrier(0);
#pragma unroll
            for (int u = 0; u < 8; ++u) { const int idx = idx0 + u * NGT;
                if (idx < NW_) { const int ri = (idx >> 10) & 1; const float pr = pw_[u].x, pi_ = pw_[u].y, br = bb_[u].x, bi = bb_[u].y;
                    S5WT[idx] = (bf16_t)f2bf(ri ? (pr * bi + pi_ * br) : (pr * br - pi_ * bi)); } }
            __builtin_amdgcn_sched_barrier(0);
        }
        for (int idx0 = gt; idx0 < NW_; idx0 += NGT * 8) {
            f32x2 pw_[8]; float crv[8], civ[8];
#pragma unroll
            for (int u = 0; u < 8; ++u) { const int idx = min(idx0 + u * NGT, NW_ - 1);
                const int k = idx & 127, rowt = (idx >> 7) & 1023, ig = idx >> 17; const int t = rowt >> 4, co = rowt & 15, p = k >> 1; const int sp = ig * 64 + p;
                crv[u] = s5_c_re[((size_t)ig * 16 + co) * 64 + p]; civ[u] = s5_c_im[((size_t)ig * 16 + co) * 64 + p];
                pw_[u] = *(const f32x2*)(S5PW + ((size_t)sp * 65 + t + 1) * 2); }
            __builtin_amdgcn_sched_barrier(0);
#pragma unroll
            for (int u = 0; u < 8; ++u) { const int idx = idx0 + u * NGT;
                if (idx < NW_) { const int ri = idx & 1; const float cr = crv[u], cim_ = civ[u], pr = pw_[u].x, pi_ = pw_[u].y;
                    S5A2[idx] = (bf16_t)f2bf(ri ? -(cr * pi_ + cim_ * pr) : (cr * pr - cim_ * pi_)); } }
            __builtin_amdgcn_sched_barrier(0);
        }
    }
    PH_END();
    if (PH_ON()) { DECL_PTRS();
        for (int t0 = gw * 4; t0 < T; t0 += NGW * 4) {
            const int b = t0 / S; const float* mo = MOD + (size_t)(0 * 2 + b) * 6144;
            f32x4 v[4][4], sc1[4], sh1[4];
#pragma unroll
            for (int u = 0; u < 4; ++u)
#pragma unroll
                for (int j = 0; j < 4; ++j) v[u][j] = *(const f32x4*)(xin + (size_t)(t0 + u) * 1024 + 4 * lane + 256 * j);
#pragma unroll
            for (int j = 0; j < 4; ++j) { sc1[j] = *(const f32x4*)(mo + 1024 + 4 * lane + 256 * j); sh1[j] = *(const f32x4*)(mo + 4 * lane + 256 * j); }
            __builtin_amdgcn_sched_barrier(0);
#pragma unroll
            for (int u = 0; u < 4; ++u) { float ss = 0.f;
#pragma unroll
                for (int j = 0; j < 4; ++j) ss += (v[u][j].x * v[u][j].x + v[u][j].y * v[u][j].y) + (v[u][j].z * v[u][j].z + v[u][j].w * v[u][j].w);
                const float rn = rsqrtf(wave_sum(ss) * (1.0f / 1024.0f) + EPS);
#pragma unroll
                for (int j = 0; j < 4; ++j) { const int col = 4 * lane + 256 * j;
                    u32x2 w; w.x = pk2(v[u][j].x * rn * (1.f + sc1[j].x) + sh1[j].x, v[u][j].y * rn * (1.f + sc1[j].y) + sh1[j].y); w.y = pk2(v[u][j].z * rn * (1.f + sc1[j].z) + sh1[j].z, v[u][j].w * rn * (1.f + sc1[j].w) + sh1[j].w);
                    *(u32x2*)(H + (size_t)(t0 + u) * 1024 + col) = w; } }
            __builtin_amdgcn_sched_barrier(0);
        }
    }
    PH_END();

    for (l0 = 0; l0 < DEPTH; ++l0) {
        if ((l0 & 1) == 0) {
            if (PH_ON()) { DECL_PTRS();
                pg8::Gemm g{H, Wevin + (size_t)i * EV_NP * 1024, T, EV_NP, 1024, 0}; pg8::StaticOrder So; So.init(T, EV_NP, G, c);
                EpiEvenIn E{Z, IQH, IKH, IW, a_kn + i * 64, b_kn + i * 64, b_idx_kn + i * 32, COSH, SINH, COSI, SINI};
                { PROBE_WRAP(pg8::StaticOrder, So); pg8::gemm_phase<EpiEvenIn, PROBE_SCHED(pg8::StaticOrder), true, true>(glds, g, PS_, E, tid); }
            }
            PH_END();
            if (PH_ON()) { DECL_PTRS();
                {
                    LAS unsigned short* kq = (LAS unsigned short*)lds;
                    const int qi = tid >> 7, ht = tid & 127;
                    LAS unsigned short* kqq = kq + qi * 16384;
                    LAS unsigned* hist = (LAS unsigned*)(lds + LDS_MISC + qi * 6400);
                    LAS unsigned* bits = hist + 1024;
                    LAS unsigned* misc = hist + 1536;
                    typedef _Float16 f16x8_t __attribute__((ext_vector_type(8)));
                    f16x8_t qaN[2], kbN[4][2]; f32x4 wqN[4];
                    auto issue_unit = [&](int it_) {
                        const int lane_ = lane_id_v(), r32 = lane_ & 31, hi = lane_ >> 5, wid_ = lsg(wid0);
                        const int L_ = min(it_ * G + c, 8191);
                        const int uu_ = (L_ & 1) ? (8191 - (L_ >> 1)) : (L_ >> 1); const int b_ = uu_ >> 12, pp_ = uu_ & 4095;
                        const size_t tA_ = (size_t)b_ * S + 4 * pp_; const int ntile_ = (4 * pp_ + 4 + 31) >> 5;
#pragma unroll
                        for (int s = 0; s < 2; ++s) qaN[s] = *(const f16x8_t*)(IQH + (tA_ + 2 * ((r32 >> 2) & 1) + (r32 >> 4)) * 256 + (4 * ((r32 >> 3) & 1) + (r32 & 3)) * 32 + 16 * s + 8 * hi);
#pragma unroll
                        for (int q = 0; q < 4; ++q) wqN[q] = *(const f32x4*)(IW + (tA_ + 2 * hi + (q >> 1)) * 8 + 4 * (q & 1));
                        const _Float16* kbase_ = IKH + ((size_t)b_ * S + r32) * 32 + 8 * hi;
#pragma unroll
                        for (int u = 0; u < 4; ++u) { const int tile = min(wid_ + NWAVES * u, ntile_ - 1);
                            kbN[u][0] = *(const f16x8_t*)(kbase_ + (size_t)tile * 1024); kbN[u][1] = *(const f16x8_t*)(kbase_ + (size_t)tile * 1024 + 16); } };
                    issue_unit(0);
                    for (int it = 0;; ++it) {
                        const int L = it * G + c; if (L >= 8192) break;
                        const int uu = (L & 1) ? (8191 - (L >> 1)) : (L >> 1);
                        const int b = uu >> 12, pp = uu & 4095;
                        const size_t tA = (size_t)b * S + 4 * pp;
                        const int nD = 4 * pp + 4;
#pragma unroll
                        for (int q = 0; q < 8; ++q) hist[ht + 128 * q] = 0u;
                        __syncthreads();
#ifdef PROBE_MASK
                        if (a.probe_var != 2)
#endif
                        {
                            const int r32 = lane & 31, hi = lane >> 5;
                            f16x8_t qa[2]; qa[0] = qaN[0]; qa[1] = qaN[1];
                            f32x4 wq[4];
#pragma unroll
                            for (int q = 0; q < 4; ++q) wq[q] = wqN[q];
                            const int ntile = (nD + 31) >> 5;
                            const _Float16* kbase = IKH + ((size_t)b * S + r32) * 32 + 8 * hi;
                            f16x8_t kb[4][2], kn[4][2];
#pragma unroll
                            for (int u = 0; u < 4; ++u) { kb[u][0] = kbN[u][0]; kb[u][1] = kbN[u][1]; }
                            for (int tile0 = wid; tile0 < ntile; tile0 += NWAVES * 4) {
#pragma unroll
                                for (int u = 0; u < 4; ++u) { const int tile = min(tile0 + NWAVES * (4 + u), ntile - 1);
                                    kn[u][0] = *(const f16x8_t*)(kbase + (size_t)tile * 1024); kn[u][1] = *(const f16x8_t*)(kbase + (size_t)tile * 1024 + 16); }
#pragma unroll
                                for (int u = 0; u < 4; ++u) {
                                    const int tile = tile0 + NWAVES * u;
                                    attn_body::f32x16 acc;
#pragma unroll
                                    for (int r = 0; r < 16; ++r) acc[r] = 0.f;
                                    acc = __builtin_amdgcn_mfma_f32_32x32x16_f16(qa[0], kb[u][0], acc, 0, 0, 0);
                                    acc = __builtin_amdgcn_mfma_f32_32x32x16_f16(qa[1], kb[u][1], acc, 0, 0, 0);
                                    float sq[4];
#pragma unroll
                                    for (int q = 0; q < 4; ++q) sq[q] = wq[q].x * relu_i(acc[4 * q]) + wq[q].y * relu_i(acc[4 * q + 1]) + wq[q].z * relu_i(acc[4 * q + 2]) + wq[q].w * relu_i(acc[4 * q + 3]);
                                    if (tile < ntile) {
                                        const float sa = sq[0] + sq[1], sb = sq[2] + sq[3];
                                        const unsigned h0 = (unsigned)__builtin_bit_cast(unsigned short, (_Float16)sa), h1 = (unsigned)__builtin_bit_cast(unsigned short, (_Float16)sb);
                                        const unsigned k0_ = (h0 ^ ((unsigned)__builtin_amdgcn_sbfe((int)h0, 15, 1) | 0x8000u)) & 0xFFFFu, k1_ = (h1 ^ ((unsigned)__builtin_amdgcn_sbfe((int)h1, 15, 1) | 0x8000u)) & 0xFFFFu;
                                        const int kidx = tile * 32 + r32;
                                        kq[(2 * hi) * 16384 + kidx] = (unsigned short)k0_;
                                        kq[(2 * hi + 1) * 16384 + kidx] = (unsigned short)k1_;
                                        LAS unsigned* hq0 = (LAS unsigned*)(lds + LDS_MISC + (2 * hi) * 6400); LAS unsigned* hq1 = (LAS unsigned*)(lds + LDS_MISC + (2 * hi + 1) * 6400);
                                        __hip_atomic_fetch_add(&hq0[(kidx <= 4 * pp + 2 * hi) ? ((k0_ >> 8) << 2) + (lane & 3) : 1536 + 32 + (lane & 3)], 1u, __ATOMIC_RELAXED, __HIP_MEMORY_SCOPE_WORKGROUP);
                                        __hip_atomic_fetch_add(&hq1[(kidx <= 4 * pp + 2 * hi + 1) ? ((k1_ >> 8) << 2) + (lane & 3) : 1536 + 32 + (lane & 3)], 1u, __ATOMIC_RELAXED, __HIP_MEMORY_SCOPE_WORKGROUP);
                                    }
                                }
#pragma unroll
                                for (int u = 0; u < 4; ++u) { kb[u][0] = kn[u][0]; kb[u][1] = kn[u][1]; }
                            }
                            issue_unit(it + 1);
                        }
                        __syncthreads();
#ifdef PROBE_MASK
                        if (a.probe_var == 1) continue;
#endif
                        const int n = 4 * pp + 1 + qi;
                        const bool small = n <= 256;
                        if (ht == 0) { misc[0] = 0u; misc[1] = 256u; misc[2] = 0u; }
                        const LAS unsigned* kq32 = (const LAS unsigned*)kqq;
                        const int npair = (n + 1) >> 1;
                        for (int pass = 0; pass < 2; ++pass) {
                            if (pass) {
#pragma unroll
                                for (int q = 0; q < 8; ++q) hist[ht + 128 * q] = 0u; }
                            __syncthreads();
                            const int shift = 8 - 8 * pass;
                            if (!small && pass) {
                                const unsigned prefix = misc[0];
                                for (int W = ht; 32 * W < n; W += 128) {
                                    const unsigned vmask = (n - 32 * W >= 32) ? 0xFFFFFFFFu : ((1u << (n - 32 * W)) - 1u);
                                    const LAS u32x4* kp = (const LAS u32x4*)(kq32 + 16 * W);
                                    unsigned ne = 0u;
                                    const unsigned pp2 = prefix | (prefix << 16);
#pragma unroll
                                    for (int q4 = 0; q4 < 4; ++q4) { const u32x4 w4 = kp[q4];
#pragma unroll
                                        for (int e = 0; e < 4; ++e) ne |= pk_gt_u16((w4[e] ^ pp2) & 0xFF00FF00u, 0u, 0x00010001u) << (4 * q4 + e); }
                                    unsigned mm = ilv16(~ne) & vmask;
                                    const LAS unsigned short* k16 = kqq + 32 * W;
                                    while (mm) { const int j = __ffs(mm) - 1; mm &= mm - 1u;
                                        __hip_atomic_fetch_add(&hist[(((unsigned)k16[j] & 255u) << 2) + (lane & 3)], 1u, __ATOMIC_RELAXED, __HIP_MEMORY_SCOPE_WORKGROUP); }
                                }
                            }
                            __syncthreads();
                            if (!small && ht < 64) {
                                unsigned cb[4];
#pragma unroll
                                for (int q = 0; q < 4; ++q) { const u32x4 a0 = *(const LAS u32x4*)(hist + (4 * ht + q) * 4); cb[q] = (a0.x + a0.y) + (a0.z + a0.w); }
                                const unsigned c0 = cb[0], c1 = cb[1], c2 = cb[2], c3 = cb[3];
                                const unsigned tot = c0 + c1 + c2 + c3;
                                unsigned Ssum = tot;
#pragma unroll
                                for (int off = 1; off < 64; off <<= 1) { const unsigned v = shi_(Ssum, lane + off); if (ht + off < 64) Ssum += v; }
                                const unsigned above = Ssum - tot, krem = misc[1];
                                if (above < krem && krem <= Ssum) {
                                    unsigned run = above, bin, eq;
                                    if (run + c3 >= krem) { bin = 3; eq = c3; }
                                    else { run += c3; if (run + c2 >= krem) { bin = 2; eq = c2; }
                                        else { run += c2; if (run + c1 >= krem) { bin = 1; eq = c1; } else { run += c1; bin = 0; eq = c0; } } }
                                    misc[0] = misc[0] | ((4u * ht + bin) << shift); misc[1] = krem - run; misc[2] = eq;
                                }
                            }
                            __syncthreads();
                        }
#ifdef PROBE_MASK
                        if (a.probe_var == 8) { __syncthreads(); continue; }
#endif
                        const unsigned Tkey = misc[0], krem = misc[1], cnteq = misc[2];
                        LAS unsigned* eqb = hist;
                        const bool all_eq = (cnteq == krem);
                        for (int W = ht; W < 512; W += 128) {
                            unsigned sel = 0u, eqm = 0u;
                            if (32 * W < n) {
                                const unsigned vmask = (n - 32 * W >= 32) ? 0xFFFFFFFFu : ((1u << (n - 32 * W)) - 1u);
                                if (small) sel = vmask;
                                else {
                                    const LAS u32x4* kp = (const LAS u32x4*)(kq32 + 16 * W);
                                    const unsigned tp2 = Tkey | (Tkey << 16);
                                    unsigned ag = 0u, al = 0u;
#pragma unroll
                                    for (int q4 = 0; q4 < 4; ++q4) { const u32x4 w4 = kp[q4];
#pragma unroll
                                        for (int e = 0; e < 4; ++e) { ag |= pk_gt_u16(w4[e], tp2, 0x00010001u) << (4 * q4 + e); al |= pk_gt_u16(tp2, w4[e], 0x00010001u) << (4 * q4 + e); } }
                                    sel = ilv16(ag); eqm = ilv16(~(ag | al));
                                    if (all_eq) { sel |= eqm; eqm = 0u; }
                                    sel &= vmask; eqm &= vmask;
                                }
                            }
                            bits[W] = sel; eqb[W] = eqm;
                        }
                        __syncthreads();
                        if (!small && !all_eq && ht < 64) {
                            unsigned wv_[8]; unsigned cnt = 0u;
#pragma unroll
                            for (int q = 0; q < 8; ++q) { wv_[q] = eqb[8 * ht + q]; cnt += (unsigned)__popc(wv_[q]); }
                            unsigned inc = cnt;
#pragma unroll
                            for (int off = 1; off < 64; off <<= 1) { const unsigned v = shi_(inc, lane - off); if (lane >= off) inc += v; }
                            unsigned before = inc - cnt;
#pragma unroll
                            for (int q = 0; q < 8; ++q) { unsigned w = wv_[q], keep = 0u;
                                while (w && before < krem) { const unsigned lowb = w & (0u - w); keep |= lowb; w ^= lowb; ++before; }
                                before += (unsigned)__popc(w);
                                if (keep) __hip_atomic_fetch_or(&bits[8 * ht + q], keep, __ATOMIC_RELAXED, __HIP_MEMORY_SCOPE_WORKGROUP); }
                        }
                        __syncthreads();
                        {
                            const int qpos = 4 * pp + qi; const int tmax = 8 * (qpos >> 9) + 7;
#pragma unroll
                            for (int j = 0; j < 2; ++j) { const int tt = 2 * ht + j;
                                if (tt <= tmax) { const unsigned W0 = bits[2 * tt], W1 = bits[2 * tt + 1];
                                    unsigned e0 = W0 & 0x0F0F0F0Fu, e1 = W1 & 0x0F0F0F0Fu, o0 = (W0 >> 4) & 0x0F0F0F0Fu, o1 = (W1 >> 4) & 0x0F0F0F0Fu;
                                    e0 = (e0 | (e0 >> 4)) & 0x00FF00FFu; e0 = (e0 | (e0 >> 8)) & 0xFFFFu; e1 = (e1 | (e1 >> 4)) & 0x00FF00FFu; e1 = (e1 | (e1 >> 8)) & 0xFFFFu;
                                    o0 = (o0 | (o0 >> 4)) & 0x00FF00FFu; o0 = (o0 | (o0 >> 8)) & 0xFFFFu; o1 = (o1 | (o1 >> 4)) & 0x00FF00FFu; o1 = (o1 | (o1 >> 8)) & 0xFFFFu;
                                    u32x2 pm; pm.x = e0 | (e1 << 16); pm.y = o0 | (o1 << 16);
                                    *(u32x2*)(MASKW + (((size_t)(b * 256 + tt)) * S + qpos) * 2) = pm; } }
                        }
                        __syncthreads();
                    }
                }
                __syncthreads();
                {
                    bf16_t* OA = YMIX;
                    const int vcu = (G % 8 == 0) ? (c % 8) * (G / 8) + c / 8 : c;
                    const int nu = (G == 256) ? 4 : (1024 - vcu + G - 1) / G;
                    const bool nomax_a = qk_bounded(a_qn + i * 64, a_kn + i * 64, lane);
                    for (int iu = 0; iu < nu; ++iu) {
                        const int lane = lane_id_v(), wid = lsg(wid0);
                        LAS unsigned char* L0 = lsgp(lds0);
                        int combo, qb;
                        if (G == 256) { combo = vcu >> 4; const int s_ = vcu & 15; qb = iu == 0 ? s_ : iu == 1 ? 31 - s_ : iu == 2 ? 32 + s_ : 63 - s_; }
                        else { const int u = vcu + iu * G; combo = u & 15; qb = 63 - (u >> 4); }
                        const int b = combo >> 3, hc = combo & 7;
                        const bf16_t* zb = Z + (size_t)b * S * EV_ZP;
                        if (nomax_a)
                            flash_unit<2, false, true, EV_ZP, 1024, true>(L0, zb + hc * 64, zb + 512 + hc * 64, zb + 1024 + (hc >> 1) * 128, OA + (size_t)b * S * 1024 + hc * 128, nullptr, qb, wid, lane, a_qn + i * 64, COSH, SINH);
                        else
                            flash_unit<2, false, true, EV_ZP, 1024, false>(L0, zb + hc * 64, zb + 512 + hc * 64, zb + 1024 + (hc >> 1) * 128, OA + (size_t)b * S * 1024 + hc * 128, nullptr, qb, wid, lane, a_qn + i * 64, COSH, SINH);
                    }
                }
                            __syncthreads();
                moe_convert(moe_w1 + (size_t)l * 32 * 1024 * 512, moe_w3 + (size_t)l * 32 * 1024 * 512, moe_w2 + (size_t)l * 32 * 512 * 1024, W13, W2, scr, gw, NGW, lane);
            }
            PH_END();
            if (PH_ON()) { DECL_PTRS();
                {
                    const int vcu = (G % 8 == 0) ? (c % 8) * (G / 8) + c / 8 : c;
                    const int nu = (G == 256) ? 2 : (512 - vcu + G - 1) / G;
                    const bool nomax_b = qk_bounded(b_qn + i * 64, b_kn + i * 64, lane);
                    for (int iu = 0; iu < nu; ++iu) {
                        const int lane = lane_id_v(), wid = lsg(wid0);
                        LAS unsigned char* L0 = lsgp(lds0);
                        int combo, qb;
                        if (G == 256) { combo = vcu >> 4; const int s_ = vcu & 15; qb = iu == 0 ? s_ : 31 - s_; }
                        else { const int u = vcu + iu * G; combo = u & 15; qb = 31 - (u >> 4); }
                        const int b = combo >> 3, h = combo & 7;
                        const bf16_t* zb = Z + (size_t)b * S * EV_ZP;
                        if (nomax_b)
                            flash_unit_q2<1, true, false, EV_ZP, 1024, true>(L0, zb + 1536 + h * 64, zb + 2048 + h * 64, zb + 2560 + h * 64, O + (size_t)b * S * 1024 + 512 + h * 64, MASKW + (size_t)b * 256 * S * 2, qb, wid, lane, b_qn + i * 64, COSH, SINH);
                        else
                            flash_unit_q2<1, true, false, EV_ZP, 1024, false>(L0, zb + 1536 + h * 64, zb + 2048 + h * 64, zb + 2560 + h * 64, O + (size_t)b * S * 1024 + 512 + h * 64, MASKW + (size_t)b * 256 * S * 2, qb, wid, lane, b_qn + i * 64, COSH, SINH);
                    }
                }
                {
                    const bf16_t* OA = YMIX; const float lamv = LAM[i]; const float lam_init = 0.8f - 0.6f * expf(-0.3f * (float)l);
                    const int h = lane >> 4, vj = (lane >> 3) & 1, d8 = (lane & 7) * 8;
                    float gn[8];
#pragma unroll
                    for (int e = 0; e < 8; ++e) gn[e] = a_subln[i * 128 + vj * 64 + d8 + e] * (1.0f - lam_init);
                    for (int t0 = gw * 4; t0 < T; t0 += NGW * 4) {
                        u32x4 r1[4], r2[4];
#pragma unroll
                        for (int u = 0; u < 4; ++u) { r1[u] = *(const u32x4*)(OA + (size_t)(t0 + u) * 1024 + ((h * 2 + 0) * 2 + vj) * 64 + d8); r2[u] = *(const u32x4*)(OA + (size_t)(t0 + u) * 1024 + ((h * 2 + 1) * 2 + vj) * 64 + d8); }
                        __builtin_amdgcn_sched_barrier(0);
#pragma unroll
                        for (int u = 0; u < 4; ++u) {
                            float o1[8], o2[8], dd[8]; unpack8(r1[u], o1); unpack8(r2[u], o2);
                            float ss = 0.f;
#pragma unroll
                            for (int e = 0; e < 8; ++e) { dd[e] = o1[e] - lamv * o2[e]; ss += dd[e] * dd[e]; }
                            ss += dpp_xor1(ss); ss += dpp_xor2(ss); ss += SHX(ss, 4); ss += SHX(ss, 8);
                            const float r = rsqrtf(ss * (1.0f / 128.0f) + EPS);
#pragma unroll
                            for (int e = 0; e < 8; ++e) dd[e] = dd[e] * r * gn[e];
                            *(u32x4*)(O + (size_t)(t0 + u) * 1024 + h * 128 + vj * 64 + d8) = pack8(dd);
                        }
                        __builtin_amdgcn_sched_barrier(0);
                    }
                }
            }
            PH_END();
        } else {
            if (PH_ON()) { DECL_PTRS();
                pg8::Gemm g{H, Wodin + (size_t)i * OD_N * 1024, T, OD_N, 1024, 0}; pg8::StaticOrder So; So.init(T, OD_N, G, c);
                EpiOddIn E{Z, UG, c_kn + i * 64, COSH, SINH};
                { PROBE_WRAP(pg8::StaticOrder, So); pg8::gemm_phase<EpiOddIn, PROBE_SCHED(pg8::StaticOrder), true, true>(glds, g, PS_, E, tid); }
            }
            PH_END();
            if (PH_ON()) { DECL_PTRS();
                for (int u = gw; u < NB * 64 * 8; u += NGW) {
                    const int h = u & 7, blk = (u >> 3) & 63, b = u >> 9;
                    const int rs = lane >> 3, d8 = (lane & 7) * 8;
                    const bf16_t* kp = Z + ((size_t)b * S + blk * 256 + rs) * OD_N + 512 + h * 64 + d8;
                    u32x4 kr[32];
#pragma unroll
                    for (int j = 0; j < 32; ++j) kr[j] = *(const u32x4*)(kp + (size_t)(8 * j) * OD_N);
                    __builtin_amdgcn_sched_barrier(0);
                    float sm[8];
#pragma unroll
                    for (int e = 0; e < 8; ++e) sm[e] = 0.f;
#pragma unroll
                    for (int j = 0; j < 32; ++j) { float kv[8]; unpack8(kr[j], kv);
#pragma unroll
                        for (int e = 0; e < 8; ++e) sm[e] += kv[e]; }
#pragma unroll
                    for (int e = 0; e < 8; ++e) { sm[e] += SHX(sm[e], 8); sm[e] += SHX(sm[e], 16); sm[e] += SHX(sm[e], 32); sm[e] *= (1.0f / 256.0f); }
                    if (rs == 0) {
                        *(f32x4*)(KM + (size_t)u * 64 + d8) = (f32x4){sm[0], sm[1], sm[2], sm[3]}; *(f32x4*)(KM + (size_t)u * 64 + d8 + 4) = (f32x4){sm[4], sm[5], sm[6], sm[7]};
                        const u32x4 hw = pack8(sm); float hf[8], lo[8]; unpack8(hw, hf);
#pragma unroll
                        for (int e = 0; e < 8; ++e) lo[e] = sm[e] - hf[e];
                        *(u32x4*)(KMH + ((size_t)(b * 8 + h) * 64 + blk) * 64 + d8) = hw; *(u32x4*)(KML + ((size_t)(b * 8 + h) * 64 + blk) * 64 + d8) = pack8(lo);
                    }
                }
                {
                    const int r32 = lane & 31, hi = lane >> 5;
                    LAS unsigned char* ldsU = lds;
                    LAS float* red = (LAS float*)(lds + 69632);
                    for (int task = c; task < 512; task += G) {
                        const int g = task >> 4, cs = task & 15;
                        for (int q = tid; q < 32 * 128; q += NTHREADS) { const int j = q >> 7, off = (q & 127) * 16;
                            *(LAS u32x4*)(ldsU + j * 2064 + off) = *(const u32x4*)((const unsigned char*)UG + ((size_t)g * T + (size_t)(cs * 32 + j) * 64) * 32 + off); }
                        __syncthreads();
                        const int rb = wid & 3, kh = wid >> 2;
                        attn_body::f32x16 acc;
#pragma unroll
                        for (int r = 0; r < 16; ++r) acc[r] = 0.f;
                        const bf16_t* wrow = S5WT + ((size_t)(i * 32 + g) * 128 + rb * 32 + r32) * 1024 + hi * 8;
#pragma unroll 1
                        for (int ks0 = kh * 32; ks0 < kh * 32 + 32; ks0 += 16) {
                            attn_body::bf16x8 Af[16];
#pragma unroll
                            for (int k = 0; k < 16; ++k) Af[k] = *(const attn_body::bf16x8*)(wrow + (ks0 + k) * 16);
                            __builtin_amdgcn_sched_barrier(0);
#pragma unroll
                            for (int k = 0; k < 16; ++k) {
                                const attn_body::bf16x8 B = *(const LAS attn_body::bf16x8*)(ldsU + r32 * 2064 + (ks0 + k) * 32 + hi * 16);
                                acc = __builtin_amdgcn_mfma_f32_32x32x16_bf16(Af[k], B, acc, 0, 0, 0); }
                            __builtin_amdgcn_sched_barrier(0);
                        }
                        if (kh == 1) {
#pragma unroll
                            for (int r = 0; r < 16; ++r) red[(rb * 64 + lane) * 16 + r] = acc[r];
                        }
                        __syncthreads();
                        if (kh == 0) {
                            float* ep = S5E + ((size_t)(cs * 32 + r32) * 32 + g) * 128 + rb * 32 + 4 * hi;
#pragma unroll
                            for (int q4 = 0; q4 < 4; ++q4) { f32x4 o;
                                o.x = acc[4 * q4] + red[(rb * 64 + lane) * 16 + 4 * q4]; o.y = acc[4 * q4 + 1] + red[(rb * 64 + lane) * 16 + 4 * q4 + 1];
                                o.z = acc[4 * q4 + 2] + red[(rb * 64 + lane) * 16 + 4 * q4 + 2]; o.w = acc[4 * q4 + 3] + red[(rb * 64 + lane) * 16 + 4 * q4 + 3];
                                *(f32x4*)(ep + 8 * q4) = o; }
                        }
                        __syncthreads();
                    }
                }
            }
            PH_END();
            if (PH_ON()) { DECL_PTRS();
#ifndef SKIP_S5
                {
                    for (int idx = gt; idx < NB * 32 * 64; idx += NGT) {
                        const int b = idx >> 11, g = (idx >> 6) & 31, p = idx & 63;
                        const int sp = (i * 32 + g) * 64 + p;
                        const float aLr = S5PW[((size_t)sp * 65 + 64) * 2], aLi = S5PW[((size_t)sp * 65 + 64) * 2 + 1];
                        float hr = 0.f, hi_ = 0.f;
                        for (int c0 = 0; c0 < 256; c0 += 32) {
                            float er[32], ei[32];
#pragma unroll
                            for (int k = 0; k < 32; ++k) { const float* ep = S5E + ((size_t)(b * 256 + c0 + k) * 32 + g) * 128 + 2 * p; er[k] = ep[0]; ei[k] = ep[1]; }
                            __builtin_amdgcn_sched_barrier(0);
#pragma unroll
                            for (int k = 0; k < 32; ++k) asm volatile("" : "+v"(er[k]), "+v"(ei[k]));
#pragma unroll
                            for (int k = 0; k < 32; ++k) {
                                *(unsigned*)(S5HC + ((size_t)(b * 256 + c0 + k) * 32 + g) * 128 + 2 * p) = pk2(hr, hi_);
                                const float nr = aLr * hr - aLi * hi_ + er[k], ni = aLr * hi_ + aLi * hr + ei[k]; hr = nr; hi_ = ni; }
                        }
                    }
                }
#endif
                {
                    unsigned* mcnt = ctl + CW_MCNT + i * 1024;
                    const int r32 = lane & 31, hi = lane >> 5;
                    for (int u = c; u < NB * 8 * 64; u += G) {
                        const int tb = u & 63, h = (u >> 6) & 7, b = u >> 9;
                        const int pos = tb * 256 + wid * 32 + r32; const size_t t = (size_t)b * S + pos;
                        float tv[3] = {-INFINITY, -INFINITY, -INFINITY}; int ti[3] = {1 << 20, 1 << 20, 1 << 20};
                        if (tb > 0) {
                            const bf16_t* kh = KMH + ((size_t)(b * 8 + h) * 64 + r32) * 64 + hi * 8; const bf16_t* kl = KML + ((size_t)(b * 8 + h) * 64 + r32) * 64 + hi * 8;
                            attn_body::bf16x8 mh[2][4], ml_[2][4];
#pragma unroll
                            for (int half = 0; half < 2; ++half)
#pragma unroll
                                for (int d0 = 0; d0 < 4; ++d0) { mh[half][d0] = *(const attn_body::bf16x8*)(kh + half * 32 * 64 + d0 * 16); ml_[half][d0] = *(const attn_body::bf16x8*)(kl + half * 32 * 64 + d0 * 16); }
                            __builtin_amdgcn_sched_barrier(0);
                            attn_body::bf16x8 qr[4];
                            load_q_normed(qr, Z + t * OD_N + h * 64, c_qn + i * 64, COSH, SINH, pos, hi, lane);
                            attn_body::f32x16 g0, g1;
#pragma unroll
                            for (int r = 0; r < 16; ++r) { g0[r] = 0.f; g1[r] = 0.f; }
#pragma unroll
                            for (int d0 = 0; d0 < 4; ++d0) {
                                g0 = __builtin_amdgcn_mfma_f32_32x32x16_bf16(mh[0][d0], qr[d0], g0, 0, 0, 0);
                                g0 = __builtin_amdgcn_mfma_f32_32x32x16_bf16(ml_[0][d0], qr[d0], g0, 0, 0, 0);
                                g1 = __builtin_amdgcn_mfma_f32_32x32x16_bf16(mh[1][d0], qr[d0], g1, 0, 0, 0);
                                g1 = __builtin_amdgcn_mfma_f32_32x32x16_bf16(ml_[1][d0], qr[d0], g1, 0, 0, 0); }
#pragma unroll
                            for (int half = 0; half < 2; ++half)
#pragma unroll
                                for (int r = 0; r < 16; ++r) { const int n = half * 32 + attn_body::crow(r, hi); const float gv = (n < tb) ? (half ? g1[r] : g0[r]) : -INFINITY;
                                    if (gv > tv[0]) { tv[2] = tv[1]; ti[2] = ti[1]; tv[1] = tv[0]; ti[1] = ti[0]; tv[0] = gv; ti[0] = n; }
                                    else if (gv > tv[1]) { tv[2] = tv[1]; ti[2] = ti[1]; tv[1] = gv; ti[1] = n; }
                                    else if (gv > tv[2]) { tv[2] = gv; ti[2] = n; } }
                            float pv_[3]; int pi_[3];
#pragma unroll
                            for (int k = 0; k < 3; ++k) { pv_[k] = SHX(tv[k], 32); pi_[k] = (int)shi_((unsigned)ti[k], lane ^ 32); }
                            float mv[3]; int mi[3]; int ia = 0, ib = 0;
#pragma unroll
                            for (int k = 0; k < 3; ++k) {
                                const float av = ia == 0 ? tv[0] : ia == 1 ? tv[1] : ia == 2 ? tv[2] : -INFINITY; const int ai = ia == 0 ? ti[0] : ia == 1 ? ti[1] : ia == 2 ? ti[2] : (1 << 20);
                                const float bv = ib == 0 ? pv_[0] : ib == 1 ? pv_[1] : ib == 2 ? pv_[2] : -INFINITY; const int bi = ib == 0 ? pi_[0] : ib == 1 ? pi_[1] : ib == 2 ? pi_[2] : (1 << 20);
                                const bool ta = (av > bv) || (av == bv && ai < bi);
                                mv[k] = ta ? av : bv; mi[k] = ta ? ai : bi; if (ta) ++ia; else ++ib; }
#pragma unroll
                            for (int k = 0; k < 3; ++k) { tv[k] = mv[k]; ti[k] = mi[k]; }
                        }
#ifdef PROBE_MASK
                        if (a.probe_var == 3) { if (ti[0] + ti[1] + ti[2] == -12345) NSEL[0] = 1; continue; }
#endif
                        if (hi == 0) {
                            unsigned idx[3];
#pragma unroll
                            for (int sI = 0; sI < 3; ++sI) { idx[sI] = 0u;
                                if (tv[sI] > -INFINITY) idx[sI] = __hip_atomic_fetch_add(mcnt + (b * 8 + h) * 64 + ti[sI], 1u, __ATOMIC_RELAXED, __HIP_MEMORY_SCOPE_AGENT); }
                            int nsel = 0;
#pragma unroll
                            for (int sI = 0; sI < 3; ++sI)
                                if (tv[sI] > -INFINITY) { const int li = (b * 8 + h) * 64 + ti[sI]; MLIST[(size_t)li * 16384 + idx[sI]] = (pos << 2) | nsel; ++nsel; }
                            NSEL[t * 8 + h] = nsel;
                        }
                    }
                }
            }
            PH_END();
            if (PH_ON()) { DECL_PTRS();
                {
                    const unsigned* mcnt = ctl + CW_MCNT + i * 1024;
                    LAS int* pref = (LAS int*)(lds + LDS_MISC);
                    if (wid == 0) {
                        int loc[16]; int sum = 0;
#pragma unroll
                        for (int k = 0; k < 16; ++k) loc[k] = (int)__hip_atomic_load(mcnt + lane * 16 + k, __ATOMIC_RELAXED, __HIP_MEMORY_SCOPE_AGENT);
                        __builtin_amdgcn_sched_barrier(0);
#pragma unroll
                        for (int k = 0; k < 16; ++k) { const int cnt = loc[k]; loc[k] = sum; sum += (cnt + 255) >> 8; }
                        int inc = sum;
#pragma unroll
                        for (int off = 1; off < 64; off <<= 1) { const int v = (int)shi_((unsigned)inc, lane - off); if (lane >= off) inc += v; }
                        const int base = inc - sum;
#pragma unroll
                        for (int k = 0; k < 16; ++k) pref[lane * 16 + k] = base + loc[k];
                        if (lane == 63) pref[1024] = inc;
                    }
                    __syncthreads();
                    const int NTsel = pref[1024];
                    auto decode = [&](int task_, int& li_o, int& chunk_o, bool& own_o) { own_o = task_ >= NTsel; chunk_o = 0;
                        if (own_o) li_o = task_ - NTsel;
                        else { int lo_ = 0, hi_ = 1023; while (lo_ < hi_) { const int mid = (lo_ + hi_ + 1) >> 1; if (pref[mid] <= task_) lo_ = mid; else hi_ = mid - 1; } li_o = lo_; chunk_o = task_ - pref[lo_]; } };
                    int nx_li = 0, nx_chunk = 0, nx_ent = 0, nx_cnt = 256; bool nx_own = true;
                    if (c < NTsel + 1024) { decode(c, nx_li, nx_chunk, nx_own);
                        if (!nx_own) { const int ln_ = lane_id_v(); nx_ent = MLIST[(size_t)nx_li * 16384 + nx_chunk * 256 + lsg(wid0) * 32 + (ln_ & 31)]; nx_cnt = (int)__hip_atomic_load(mcnt + nx_li, __ATOMIC_RELAXED, __HIP_MEMORY_SCOPE_AGENT); } }
                    for (int task = c; task < NTsel + 1024; task += G) {
                        const int lane = lane_id_v(), wid = lsg(wid0), r32 = lane & 31, hi = lane >> 5;
                        LAS unsigned char* ldsKs = lsgp(lds0); LAS unsigned char* ldsVs = ldsKs + 32768;
                        LAS bf16_t* stg = (LAS bf16_t*)(ldsKs + 65536 + wid * 4096); LAS float* wsf = (LAS float*)(ldsKs + 98304 + wid * 256); LAS int* rowd = (LAS int*)(ldsKs + 100352 + wid * 128);
                        const bool own_task = nx_own;
                        const int li = nx_li, chunk = nx_chunk;
                        const int b = li >> 9, h = (li >> 6) & 7, blk = li & 63;
                        const int e_ = chunk * 256 + wid * 32 + r32;
                        const int cnt = nx_cnt;
                        const int ent_ = nx_ent;
                        u32x4 kst[4], vst[4];
                        {
                            const bf16_t* kbp = Z + ((size_t)b * S + blk * 256) * OD_N + 512 + h * 64;
                            const bf16_t* vbp = Z + ((size_t)b * S + blk * 256) * OD_N + 1024 + h * 64;
#pragma unroll
                            for (int kt = 0; kt < 4; ++kt) {
                                kst[kt] = *(const u32x4*)(kbp + (size_t)(kt * 64 + lane) * OD_N + wid * 8);
                                vst[kt] = *(const u32x4*)(vbp + (size_t)(kt * 64 + 16 * (wid & 3) + (lane >> 2)) * OD_N + (wid >> 2) * 32 + (lane & 3) * 8);
                            }
                        }
                        __builtin_amdgcn_sched_barrier(0);
                        int posq, slot; bool valid;
                        if (own_task) { posq = blk * 256 + wid * 32 + r32; slot = 3; valid = true; }
                        else { valid = e_ < cnt; posq = valid ? (ent_ >> 2) : 0; slot = ent_ & 3; }
                        const size_t tq = (size_t)b * S + posq;
                        const int dest = valid ? (int)((tq * 8 + h) * 4 + slot) : -1;
                        attn_body::bf16x8 qr[4];
                        load_q_normed(qr, Z + tq * OD_N + h * 64, c_qn + i * 64, COSH, SINH, posq, hi, lane);
#pragma unroll
                        for (int kt = 0; kt < 4; ++kt) { *(LAS u32x4*)(ldsKs + kt * 8192 + wid * 1024 + lane * 16) = kst[kt]; *(LAS u32x4*)(ldsVs + kt * 8192 + wid * 1024 + lane * 16) = vst[kt]; }
                        nx_own = true; nx_li = 0; nx_chunk = 0; nx_ent = 0; nx_cnt = 256;
                        if (task + G < NTsel + 1024) { decode(task + G, nx_li, nx_chunk, nx_own);
                            if (!nx_own) { nx_ent = MLIST[(size_t)nx_li * 16384 + nx_chunk * 256 + wid * 32 + r32]; nx_cnt = (int)__hip_atomic_load(mcnt + nx_li, __ATOMIC_RELAXED, __HIP_MEMORY_SCOPE_AGENT); } }
                        __syncthreads();
                        attn_body::f32x16 p0[4], p1[4];
#pragma unroll
                        for (int kt = 0; kt < 4; ++kt) {
#pragma unroll
                            for (int r = 0; r < 16; ++r) { p0[kt][r] = 0.f; p1[kt][r] = 0.f; }
                            const LAS unsigned char* kb = ldsKs + kt * 8192 + hi * 1024 + r32 * 16;
#pragma unroll
                            for (int d0 = 0; d0 < 4; ++d0) {
                                const attn_body::bf16x8 b0 = *(const LAS attn_body::bf16x8*)(kb + d0 * 2048), b1 = *(const LAS attn_body::bf16x8*)(kb + d0 * 2048 + 512);
                                p0[kt] = __builtin_amdgcn_mfma_f32_32x32x16_bf16(b0, qr[d0], p0[kt], 0, 0, 0);
                                p1[kt] = __builtin_amdgcn_mfma_f32_32x32x16_bf16(b1, qr[d0], p1[kt], 0, 0, 0);
                            }
                        }
                        if (own_task) {
                            const int qrel = wid * 32 + r32;
#pragma unroll
                            for (int kt = 0; kt < 4; ++kt)
#pragma unroll
                                for (int r = 0; r < 16; ++r) { const int kv = kt * 64 + attn_body::crow(r, hi); if (kv > qrel) p0[kt][r] = -INFINITY; if (kv + 32 > qrel) p1[kt][r] = -INFINITY; }
                        }
                        float mx = -INFINITY;
#pragma unroll
                        for (int kt = 0; kt < 4; ++kt)
#pragma unroll
                            for (int r = 0; r < 16; ++r) mx = fmaxf(mx, fmaxf(p0[kt][r], p1[kt][r]));
                        mx = fmaxf(mx, SHX(mx, 32));
                        float ls = 0.f;
#pragma unroll
                        for (int kt = 0; kt < 4; ++kt)
#pragma unroll
                            for (int r = 0; r < 16; ++r) { p0[kt][r] = __builtin_amdgcn_exp2f(p0[kt][r] - mx); p1[kt][r] = __builtin_amdgcn_exp2f(p1[kt][r] - mx); ls += p0[kt][r] + p1[kt][r]; }
                        ls += SHX(ls, 32);
                        attn_body::f32x16 o[2];
#pragma unroll
                        for (int r = 0; r < 16; ++r) { o[0][r] = 0.f; o[1][r] = 0.f; }
                        const int vb0 = (int)(unsigned)(unsigned long long)ldsVs + ((lane >> 4) & 1) * 32 + (lane & 3) * 8 + (4 * hi + ((lane & 15) >> 2)) * 64;
#pragma unroll
                        for (int kt = 0; kt < 4; ++kt) {
                            u32x4 pw0, pw1, pw2, pw3;
#pragma unroll
                            for (int k = 0; k < 4; ++k) { pw0[k] = attn_body::cvtpk_s(p0[kt][2 * k], p0[kt][2 * k + 1]); pw1[k] = attn_body::cvtpk_s(p0[kt][8 + 2 * k], p0[kt][9 + 2 * k]);
                                pw2[k] = attn_body::cvtpk_s(p1[kt][2 * k], p1[kt][2 * k + 1]); pw3[k] = attn_body::cvtpk_s(p1[kt][8 + 2 * k], p1[kt][9 + 2 * k]); }
                            attn_body::pv(o, vb0 + kt * 8192, __builtin_bit_cast(attn_body::bf16x8, pw0), __builtin_bit_cast(attn_body::bf16x8, pw1), __builtin_bit_cast(attn_body::bf16x8, pw2), __builtin_bit_cast(attn_body::bf16x8, pw3));
                        }
                        if (hi == 0) { wsf[r32] = ls; rowd[r32] = dest; if (valid) { MML[(size_t)dest * 2] = mx; MML[(size_t)dest * 2 + 1] = ls; } }
                        LDS_WAIT();
#pragma unroll
                        for (int r = 0; r < 16; ++r) { const int orow = attn_body::crow(r, hi); const float rl = __builtin_amdgcn_rcpf(wsf[orow]);
                            stg[orow * 64 + r32] = (bf16_t)f2bf(o[0][r] * rl); stg[orow * 64 + 32 + r32] = (bf16_t)f2bf(o[1][r] * rl); }
                        LDS_WAIT();
#pragma unroll
                        for (int q = 0; q < 4; ++q) { const int row = q * 8 + (lane >> 3), ch = lane & 7; const int dd = rowd[row];
                            if (dd >= 0) *(u32x4*)(MPO + (size_t)dd * 64 + ch * 8) = *(const LAS u32x4*)(stg + row * 64 + ch * 8); }
                        __syncthreads();
                    }
                }
                {
                const int r32 = lane & 31, hi = lane >> 5;
                LAS unsigned char* ldsU = lds;
                LAS unsigned char* ldsK = lds + 69632;
                for (int task = c; task < 512; task += G) {
                    const int g = task >> 4, cs = task & 15, ig = i * 32 + g;
                    for (int q = tid; q < 32 * 128; q += NTHREADS) { const int j = q >> 7, off = (q & 127) * 16;
                        *(LAS u32x4*)(ldsU + j * 2064 + off) = *(const u32x4*)((const unsigned char*)UG + ((size_t)g * T + (size_t)(cs * 32 + j) * 64) * 32 + off); }
                    for (int q = tid; q < 65 * 48; q += NTHREADS) *(LAS u32x4*)(ldsK + q * 16) = *(const u32x4*)((const unsigned char*)S5KT + (size_t)ig * 65 * 768 + q * 16);
                    __syncthreads();
                    const int gc = cs * 32 + r32;
                    const float* dsk = s5_d + ig * 16;
                    const f32x4 dd0 = *(const f32x4*)(dsk + 4 * hi), dd1 = *(const f32x4*)(dsk + 8 + 4 * hi);
                    attn_body::bf16x8 hcr[8];
                    { const bf16_t* hc = S5HC + ((size_t)gc * 32 + g) * 128 + hi * 8;
#pragma unroll
                      for (int kk = 0; kk < 8; ++kk) hcr[kk] = *(const attn_body::bf16x8*)(hc + kk * 16); }
#pragma unroll 1
                    for (int rr = 0; rr < 4; ++rr) {
                        const int r = rr == 0 ? wid : rr == 1 ? 15 - wid : rr == 2 ? 16 + wid : 31 - wid;
                        attn_body::f32x16 acc;
#pragma unroll
                        for (int q = 0; q < 16; ++q) acc[q] = 0.f;
                        attn_body::bf16x8 a2r[8];
                        { const bf16_t* a2 = S5A2 + ((size_t)ig * 1024 + r * 32 + r32) * 128 + hi * 8;
#pragma unroll
                          for (int kk = 0; kk < 8; ++kk) a2r[kk] = *(const attn_body::bf16x8*)(a2 + kk * 16); }
                        __builtin_amdgcn_sched_barrier(0);
                        const LAS unsigned char* kbase = ldsK + (r32 >> 4) * 768 + (r32 & 15) * 48 + hi * 16;
                        const LAS unsigned char* ubase = ldsU + r32 * 2064 + hi * 16;
                        for (int s = 0; s <= 2 * r + 1; ++s) {
                            const attn_body::bf16x8 A = *(const LAS attn_body::bf16x8*)(kbase + (2 * r - s + 1) * 768);
                            const attn_body::bf16x8 B = *(const LAS attn_body::bf16x8*)(ubase + s * 32);
                            acc = __builtin_amdgcn_mfma_f32_32x32x16_bf16(A, B, acc, 0, 0, 0);
                        }
#pragma unroll
                        for (int kk = 0; kk < 8; ++kk) acc = __builtin_amdgcn_mfma_f32_32x32x16_bf16(a2r[kk], hcr[kk], acc, 0, 0, 0);
#pragma unroll
                        for (int q4 = 0; q4 < 4; ++q4) {
                            const int rowb = 8 * q4 + 4 * hi, dt_ = rowb >> 4, co0 = rowb & 15, t = 2 * r + dt_;
                            const u32x2 uw = *(const LAS u32x2*)(ldsU + r32 * 2064 + t * 32 + co0 * 2);
                            const f32x4 dd = (q4 & 1) ? dd1 : dd0;
                            const float y0 = acc[4 * q4] + dd.x * bflo(uw.x), y1 = acc[4 * q4 + 1] + dd.y * bfhi(uw.x), y2 = acc[4 * q4 + 2] + dd.z * bflo(uw.y), y3 = acc[4 * q4 + 3] + dd.w * bfhi(uw.y);
                            u32x2 w; w.x = pk2(gelu_tanh(y0), gelu_tanh(y1)); w.y = pk2(gelu_tanh(y2), gelu_tanh(y3));
                            *(u32x2*)(YG + ((size_t)gc * 64 + t) * 512 + g * 16 + co0) = w;
                        }
                    }
                    __syncthreads();
                }
                }
                                        __syncthreads();
                moe_convert(moe_w1 + (size_t)l * 32 * 1024 * 512, moe_w3 + (size_t)l * 32 * 1024 * 512, moe_w2 + (size_t)l * 32 * 512 * 1024, W13, W2, scr, gw, NGW, lane);
            }
            PH_END();
            if (PH_ON()) { DECL_PTRS();
                pg8::Gemm g{YG, Wglu + (size_t)i * 512 * 512, T, 512, 512, 0}; pg8::StaticOrder So; So.init(T, 512, G, c);
                EpiGLU E{O, YG, s5_glu_b + i * 512};
                { PROBE_WRAP(pg8::StaticOrder, So); pg8::gemm_phase<EpiGLU, PROBE_SCHED(pg8::StaticOrder), true, true>(glds, g, PS_, E, tid); }
                {
                    const int h = lane >> 3, d8 = (lane & 7) * 8;
                    for (int t0 = gw * 4; t0 < T; t0 += NGW * 4) {
                        int nsel[4]; f32x2 ml[4][4]; u32x4 po[4][4];
#pragma unroll
                        for (int u = 0; u < 4; ++u) { const size_t base = ((size_t)(t0 + u) * 8 + h) * 4; nsel[u] = NSEL[(size_t)(t0 + u) * 8 + h];
#pragma unroll
                            for (int s = 0; s < 4; ++s) { ml[u][s] = *(const f32x2*)(MML + (base + s) * 2); po[u][s] = *(const u32x4*)(MPO + (base + s) * 64 + d8); } }
                        __builtin_amdgcn_sched_barrier(0);
#pragma unroll
                        for (int u = 0; u < 4; ++u) {
                            float mm[4], ll[4];
#pragma unroll
                            for (int s = 0; s < 4; ++s) { const bool on = (s == 3) || (s < nsel[u]); mm[s] = on ? ml[u][s].x : -INFINITY; ll[s] = on ? ml[u][s].y : 0.f; }
                            const float M = fmaxf(fmaxf(mm[0], mm[1]), fmaxf(mm[2], mm[3]));
                            float acc[8], wsum = 0.f;
#pragma unroll
                            for (int e = 0; e < 8; ++e) acc[e] = 0.f;
#pragma unroll
                            for (int s = 0; s < 4; ++s) { const bool on = (s == 3) || (s < nsel[u]);
                                const float w = on ? ll[s] * __builtin_amdgcn_exp2f(mm[s] - M) : 0.f; float ov[8]; unpack8(po[u][s], ov); wsum += w;
#pragma unroll
                                for (int e = 0; e < 8; ++e) acc[e] += on ? w * ov[e] : 0.f; }
                            const float inv = 1.0f / wsum;
#pragma unroll
                            for (int e = 0; e < 8; ++e) acc[e] *= inv;
                            *(u32x4*)(O + (size_t)(t0 + u) * 1024 + h * 64 + d8) = pack8(acc);
                        }
                        __builtin_amdgcn_sched_barrier(0);
                    }
                }
            }
            PH_END();
        }
        if (PH_ON()) { DECL_PTRS();
            pg8::Gemm g{O, ((l & 1) ? Wodout : Wevout) + (size_t)i * 1024 * 1024, T, 1024, 1024, 0}; pg8::StaticOrder So; So.init(T, 1024, G, c);
            EpiPlain E{YMIX, 1024};
            { PROBE_WRAP(pg8::StaticOrder, So); pg8::gemm_phase<EpiPlain, PROBE_SCHED(pg8::StaticOrder), true, true>(glds, g, PS_, E, tid); }
        }
        PH_END();
        if (PH_ON()) { DECL_PTRS();
#ifdef PROBE_MASK
            const bool first_x = (l == 0 && a.probe_var != -5);
#else
            const bool first_x = (l == 0);
#endif
            const float* xs = xin;
            LAS int* r_e = (LAS int*)(lds + 0);
            LAS float* r_w = (LAS float*)(lds + 1024);
            LAS int* r_rank = (LAS int*)(lds + 2048);
            LAS int* lcnt = (LAS int*)(lds + 3072);
            LAS int* lbase = (LAS int*)(lds + 3200);
            const float* wg_l = moe_wg + (size_t)l * 1024 * 4; const float* we_l = moe_we + (size_t)l * 1024 * 32;
            for (int chunk = c; chunk < T / 128; chunk += G) {
                if (tid < 32) lcnt[tid] = 0;
                LAS float* modl = (LAS float*)(lds + 32768);
                { const float* mo_ = MOD + (size_t)(l * 2 + (int)(((size_t)chunk * 128) / S)) * 6144 + 2048;
                  for (int q = tid; q < 768; q += NTHREADS) *(LAS f32x4*)(modl + 4 * q) = *(const f32x4*)(mo_ + 4 * q); }
                __syncthreads();
                {
                    const int rloc = lane & 15, kc = lane >> 4; const int r = wid * 16 + rloc; const size_t t = (size_t)chunk * 128 + r; const int b = (int)(((size_t)chunk * 128) / S);
                    const float* mo = MOD + (size_t)(l * 2 + b) * 6144;
                    float ss;
                    if (first_x) ss = f_pass1<true>(xs + t * 1024, XB + t * 1024, YMIX + t * 1024, modl, kc);
                    else ss = f_pass1<false>(xs + t * 1024, XB + t * 1024, YMIX + t * 1024, modl, kc);
                    ss += SHX(ss, 16); ss += SHX(ss, 32);
                    const float rn = rsqrtf(ss * (1.0f / 1024.0f) + EPS);
                    f32x4 acc[3];
#pragma unroll
                    for (int ct = 0; ct < 3; ++ct) acc[ct] = (f32x4){0.f, 0.f, 0.f, 0.f};
                    const bf16_t* wh = WRH + ((size_t)l * 48 + rloc) * 1024 + 8 * kc; const bf16_t* wl = WRL + ((size_t)l * 48 + rloc) * 1024 + 8 * kc;
                    f_pass2(XB + t * 1024, H + t * 1024, modl, wh, wl, rn, kc, acc);
                    LAS float* lg = (LAS float*)(lds + 4096 + wid * 3072);
#pragma unroll
                    for (int ct = 0; ct < 3; ++ct) { lg[(4 * kc + 0) * 48 + ct * 16 + rloc] = acc[ct].x; lg[(4 * kc + 1) * 48 + ct * 16 + rloc] = acc[ct].y; lg[(4 * kc + 2) * 48 + ct * 16 + rloc] = acc[ct].z; lg[(4 * kc + 3) * 48 + ct * 16 + rloc] = acc[ct].w; }
                    LDS_WAIT();
                    if (lane < 16) {
                        const LAS float* lr = lg + lane * 48;
                        float cg[4];
#pragma unroll
                        for (int e = 0; e < 4; ++e) cg[e] = lr[e] + moe_bg[l * 4 + e];
                        int grp = 0; float cm = cg[0];
#pragma unroll
                        for (int e = 1; e < 4; ++e) if (cg[e] > cm) { cm = cg[e]; grp = e; }
                        float den = 0.f;
#pragma unroll
                        for (int e = 0; e < 4; ++e) den += __expf(cg[e] - cm);
                        const float pg = 1.0f / den;
                        float fe[8];
#pragma unroll
                        for (int e = 0; e < 8; ++e) fe[e] = lr[4 + grp * 8 + e] + moe_be[l * 32 + grp * 8 + e];
                        int j0 = 0; float f0 = fe[0];
#pragma unroll
                        for (int e = 1; e < 8; ++e) if (fe[e] > f0) { f0 = fe[e]; j0 = e; }
                        int j1 = -1; float f1 = -INFINITY;
#pragma unroll
                        for (int e = 0; e < 8; ++e) if (e != j0 && fe[e] > f1) { f1 = fe[e]; j1 = e; }
                        const float ex = __expf(f1 - f0); const float sA = 1.0f / (1.0f + ex), sB = ex / (1.0f + ex);
                        const int rr_ = wid * 16 + lane;
                        r_e[2 * rr_] = grp * 8 + j0; r_w[2 * rr_] = pg * sA; r_e[2 * rr_ + 1] = grp * 8 + j1; r_w[2 * rr_ + 1] = pg * sB;
                    }
                }
                __syncthreads();
#ifdef PROBE_MASK
                if (a.probe_var == 5) { if (tid < 256 && r_e[tid] == -777) TOKES[0] = 0; __syncthreads(); continue; }
#endif
                if (tid < 256) r_rank[tid] = __hip_atomic_fetch_add(&lcnt[r_e[tid]], 1, __ATOMIC_RELAXED, __HIP_MEMORY_SCOPE_WORKGROUP);
                __syncthreads();
                if (tid < 32) lbase[tid] = (int)__hip_atomic_fetch_add(ctl + CW_CNT + (l * 32 + tid) * 64, (unsigned)lcnt[tid], __ATOMIC_RELAXED, __HIP_MEMORY_SCOPE_AGENT);
                __syncthreads();
                if (tid < 256) { const size_t t = (size_t)chunk * 128 + (tid >> 1); const int k = tid & 1; const int e = r_e[tid]; const int slot = lbase[e] + r_rank[tid];
                    TOKES[t * 2 + k] = e * 32768 + slot; TOKW[t * 2 + k] = r_w[tid]; LTOK[e * 32768 + slot] = (int)t; }
                __syncthreads();
            }
        }
        PH_END();
        if (PH_ON()) { DECL_PTRS();
            LAS int* tile_e = (LAS int*)(lds + LDS_MISC); LAS int* rb = tile_e + 320; LAS int* nt_p = tile_e + 400;
            moe_tables(ctl, l, tile_e, rb, nt_p, tid);
            const int nR = nt_p[0];
            pg8::Gemm g{H, W13, nR * 256, 1024, 1024, (size_t)1024 * 1024 * 2}; MoeOrder Mo{4, nR * 4, G, c, tile_e};
            EpiSwiGLU E{HID}; MoeRows RW{rb, LTOK};
            { PROBE_WRAP(MoeOrder, Mo); pg8::gemm_phase<EpiSwiGLU, PROBE_SCHED(MoeOrder), true, true, MoeRows>(glds, g, PS_, E, tid, RW); }
        }
        PH_END();
        if (PH_ON()) { DECL_PTRS();
            LAS int* tile_e = (LAS int*)(lds + LDS_MISC); LAS int* rb = tile_e + 320; LAS int* nt_p = tile_e + 400;
            moe_tables(ctl, l, tile_e, rb, nt_p, tid);
            const int nR = nt_p[0];
            pg8::Gemm g{HID, W2, nR * 256, 1024, 512, (size_t)1024 * 512 * 2}; MoeOrder Mo{4, nR * 4, G, c, tile_e};
            EpiPlain E{Y, 1024};
            { PROBE_WRAP(MoeOrder, Mo); pg8::gemm_phase<EpiPlain, PROBE_SCHED(MoeOrder), true, true>(glds, g, PS_, E, tid); }
        }
        PH_END();
        if (PH_ON()) { DECL_PTRS();
            LAS int* tile_e = (LAS int*)(lds + LDS_MISC); LAS int* rb = tile_e + 320; LAS int* nt_p = tile_e + 400;
            moe_tables(ctl, l, tile_e, rb, nt_p, tid);
            constexpr int RJ = 4;
            for (int t0 = gw * RJ; t0 < T; t0 += NGW * RJ) {
                const int b = t0 / S; const float* mo = MOD + (size_t)(l * 2 + b) * 6144;
                int r0[RJ], r1[RJ]; float w0[RJ], w1[RJ];
#pragma unroll
                for (int u = 0; u < RJ; ++u) { const int t = t0 + u; { const int e0_ = TOKES[2 * t], e1_ = TOKES[2 * t + 1]; r0[u] = rb[e0_ >> 15] + (e0_ & 32767); r1[u] = rb[e1_ >> 15] + (e1_ & 32767); } w0[u] = TOKW[2 * t]; w1[u] = TOKW[2 * t + 1];
#ifdef PROBE_MASK
                    if (a.probe_var == 4 || a.probe_var == -4) { w0[u] *= 0.5f; w1[u] *= 0.5f; }
#endif
                }
                f32x4 v[RJ][4]; u32x2 ya[RJ][4], yb[RJ][4];
#pragma unroll
                for (int u = 0; u < RJ; ++u)
#pragma unroll
                    for (int j = 0; j < 4; ++j) { const int col = 4 * lane + 256 * j; { const u32x2 xw = *(const u32x2*)(XB + (size_t)(t0 + u) * 1024 + col); v[u][j] = (f32x4){bflo(xw.x), bfhi(xw.x), bflo(xw.y), bfhi(xw.y)}; }
                        ya[u][j] = *(const u32x2*)(Y + (size_t)r0[u] * 1024 + col); yb[u][j] = *(const u32x2*)(Y + (size_t)r1[u] * 1024 + col); }
                f32x4 gg[4];
#pragma unroll
                for (int j = 0; j < 4; ++j) gg[j] = *(const f32x4*)(mo + 5120 + 4 * lane + 256 * j);
                float ss[RJ];
#pragma unroll
                for (int u = 0; u < RJ; ++u) { ss[u] = 0.f;
#pragma unroll
                    for (int j = 0; j < 4; ++j) { const int col = 4 * lane + 256 * j; const f32x4 xv = v[u][j]; f32x4 nv;
                        nv.x = xv.x + gg[j].x * (w0[u] * bflo(ya[u][j].x) + w1[u] * bflo(yb[u][j].x)); nv.y = xv.y + gg[j].y * (w0[u] * bfhi(ya[u][j].x) + w1[u] * bfhi(yb[u][j].x));
                        nv.z = xv.z + gg[j].z * (w0[u] * bflo(ya[u][j].y) + w1[u] * bflo(yb[u][j].y)); nv.w = xv.w + gg[j].w * (w0[u] * bfhi(ya[u][j].y) + w1[u] * bfhi(yb[u][j].y));
                        if (l + 1 < DEPTH) { u32x2 xw; xw.x = pk2(nv.x, nv.y); xw.y = pk2(nv.z, nv.w); *(u32x2*)(XB + (size_t)(t0 + u) * 1024 + col) = xw; nv = (f32x4){bflo(xw.x), bfhi(xw.x), bflo(xw.y), bfhi(xw.y)}; }
                        else *(f32x4*)(out + (size_t)(t0 + u) * 1024 + col) = nv;
                        v[u][j] = nv; ss[u] += (nv.x * nv.x + nv.y * nv.y) + (nv.z * nv.z + nv.w * nv.w); } }
                if (l + 1 < DEPTH) {
                    const float* mn = MOD + (size_t)((l + 1) * 2 + b) * 6144;
                    f32x4 sc1[4], sh1[4];
#pragma unroll
                    for (int j = 0; j < 4; ++j) { sc1[j] = *(const f32x4*)(mn + 1024 + 4 * lane + 256 * j); sh1[j] = *(const f32x4*)(mn + 4 * lane + 256 * j); }
#pragma unroll
                    for (int u = 0; u < RJ; ++u) { const float rn = rsqrtf(wave_sum(ss[u]) * (1.0f / 1024.0f) + EPS);
#pragma unroll
                        for (int j = 0; j < 4; ++j) { const int col = 4 * lane + 256 * j;
                            u32x2 w; w.x = pk2(v[u][j].x * rn * (1.f + sc1[j].x) + sh1[j].x, v[u][j].y * rn * (1.f + sc1[j].y) + sh1[j].y); w.y = pk2(v[u][j].z * rn * (1.f + sc1[j].z) + sh1[j].z, v[u][j].w * rn * (1.f + sc1[j].w) + sh1[j].w);
                            *(u32x2*)(H + (size_t)(t0 + u) * 1024 + col) = w; } }
                }
            }
        }
        PH_END();
    }
#undef PH_ON
#undef PH_END
}

extern "C" void kernel_launch(void* const* d_in, const int* in_sizes, int n_in, void* d_out, int out_size, void* d_ws, size_t ws_size, hipStream_t stream) {
    static int grid = 0;
    if (grid == 0) {
        if (n_in != 37 || out_size != T * D || ws_size < WS_END) { fprintf(stderr, "kernel_launch: unexpected shapes (n_in %d, out %d, ws %zu); nothing launched\n", n_in, out_size, ws_size); grid = -1; return; }
        int dev = 0, cus = 0, per_cu = 0;
        if (hipGetDevice(&dev) != hipSuccess || hipDeviceGetAttribute(&cus, hipDeviceAttributeMultiprocessorCount, dev) != hipSuccess) { grid = -1; return; }
        if (hipFuncSetAttribute((const void*)fwd, hipFuncAttributeMaxDynamicSharedMemorySize, LDS_BYTES) != hipSuccess) { fprintf(stderr, "kernel_launch: hipFuncSetAttribute failed\n"); grid = -1; return; }
        if (hipOccupancyMaxActiveBlocksPerMultiprocessor(&per_cu, (const void*)fwd, NTHREADS, LDS_BYTES) != hipSuccess || per_cu < 1) fprintf(stderr, "kernel_launch: occupancy query says %d\n", per_cu);
        (void)hipGetLastError();
        grid = cus;
    }
    if (grid < 0) return;
    if (hipMemsetAsync((char*)d_ws + WS_CTL, 0, CTL_ZERO_BYTES, stream) != hipSuccess) return;
    Args a{};
    for (int i = 0; i < 37; ++i) a.in[i] = d_in[i];
    a.out = (float*)d_out; a.ws = (unsigned char*)d_ws;
#ifdef PROBE_MASK
#ifndef PROBE_VAR
#define PROBE_VAR 0
#endif
    {
        int types[N_PHASES]; int n = 0; types[n++] = 0; types[n++] = 1; types[n++] = 2;
        for (int l = 0; l < DEPTH; ++l) { if ((l & 1) == 0) { for (int k = 3; k <= 7; ++k) if (k != 4 && k != 6) types[n++] = k; } else { for (int k = 8; k <= 13; ++k) if (k != 9) types[n++] = k; } for (int k = 14; k <= 19; ++k) if (k != 16) types[n++] = k; }
        for (int p = 0; p < N_PHASES; ++p) { a.ph_lo = p; a.ph_hi = p + 1; const int reps = ((PROBE_MASK >> types[p]) & 1) ? 2 : 1;
            for (int r = 0; r < reps; ++r) { a.probe_var = (reps == 2) ? ((r == 0) ? PROBE_VAR : -PROBE_VAR) : 0; hipLaunchKernelGGL(fwd, dim3(grid), dim3(NTHREADS), LDS_BYTES, stream, a); } }
    }
#elif MK_ONE_LAUNCH
    a.ph_lo = 0; a.ph_hi = N_PHASES;
    hipLaunchKernelGGL(fwd, dim3(grid), dim3(NTHREADS), LDS_BYTES, stream, a);
#else
    for (int p = 0; p < N_PHASES; ++p) { a.ph_lo = p; a.ph_hi = p + 1; hipLaunchKernelGGL(fwd, dim3(grid), dim3(NTHREADS), LDS_BYTES, stream, a); }
#endif
}
```
